# Optimizing an MI355X kernel written in HIP

```python
import jax, jax.numpy as jnp
from jax import lax
import numpy as np

D_MODEL = 1024
BATCH = 16
SEQ = 2048
DEPTH = 2

CHUNK = 64
HEAD_DIM = 128
EPS = 1e-6
N_HEADS_A = 4
A_WIDTH = N_HEADS_A * HEAD_DIM
IDX_HEADS = 8
IDX_DIM = 64
IDX_TOPK_MAX = 256
N_HEADS_B = 4
GLA_DK = 64
GLA_DV = 128
GLA_GATE_RANK = 16
GLA_TAU = 16.0
B_WIDTH = N_HEADS_B * GLA_DV
N_HEADS_C = 8
C_WIDTH = N_HEADS_C * HEAD_DIM
SB_QBLOCK = 128
ROPE_THETA = 500000.0
ROPE_FRACTION = 4
D_FF = 4 * D_MODEL
N_EVEN = (DEPTH + 1) // 2
N_ODD = DEPTH // 2
AB_SIZES = (
    A_WIDTH, A_WIDTH, A_WIDTH,
    IDX_HEADS * IDX_DIM, IDX_DIM, IDX_HEADS,
    N_HEADS_B * GLA_DK, N_HEADS_B * GLA_DK,
    B_WIDTH,
    GLA_GATE_RANK,
    B_WIDTH,
)
AB_PROJ = sum(AB_SIZES)

kernel_name = "hybrid_dsa_gla_stickbreak_encoder"


def _split(a, sizes):
    out, o = [], 0
    for s in sizes:
        out.append(a[..., o:o + s])
        o += s
    return out


def rmsnorm(x, g):
    xf = x.astype(jnp.float32)
    y = xf * lax.rsqrt(jnp.mean(xf * xf, axis=-1, keepdims=True) + EPS)
    return (y * g.astype(jnp.float32)).astype(x.dtype)


def rope_partial(x, pos):
    d = x.shape[-1]
    rot = d // ROPE_FRACTION
    half = rot // 2
    inv = jnp.power(ROPE_THETA, -jnp.arange(half, dtype=jnp.float32) * 2.0 / rot)
    ang = pos.astype(jnp.float32)[:, None] * inv[None, :]
    cos = jnp.cos(ang)[None, :, None, :]
    sin = jnp.sin(ang)[None, :, None, :]
    xf = x.astype(jnp.float32)
    x1, x2, rest = xf[..., :half], xf[..., half:rot], xf[..., rot:]
    out = jnp.concatenate([x1 * cos - x2 * sin, x2 * cos + x1 * sin, rest], axis=-1)
    return out.astype(x.dtype)


def dsa_attention(q, k, v, iq, ik, iw):
    bsz, s_len, n_h, d_h = q.shape
    topk = min(IDX_TOPK_MAX, s_len // 4)
    n_blk = s_len // CHUNK
    key_pos = jnp.arange(s_len)

    def blk_fn(args):
        c, qb, iqb, iwb = args
        logits = jnp.einsum('bthd,bsd->bths', iqb, ik).astype(jnp.float32) * IDX_DIM ** -0.5
        score = jnp.einsum('bths,bth->bts', jax.nn.relu(logits),
                           iwb.astype(jnp.float32) * IDX_HEADS ** -0.5)
        limit = (c + 1) * CHUNK
        score = jnp.where((key_pos < limit)[None, None, :], score, -jnp.inf)
        _, idx = lax.top_k(score, topk)
        valid = idx < limit
        ks = jax.vmap(lambda a, i: a[i])(k, idx)
        vs = jax.vmap(lambda a, i: a[i])(v, idx)
        s = jnp.einsum('bthd,btkhd->bthk', qb, ks).astype(jnp.float32) * HEAD_DIM ** -0.5
        s = jnp.where(valid[:, :, None, :], s, -jnp.inf)
        p = jax.nn.softmax(s, axis=-1)
        return jnp.einsum('bthk,btkhd->bthd', p.astype(v.dtype), vs)

    def to_blocks(a):
        return a.reshape(bsz, n_blk, CHUNK, *a.shape[2:]).swapaxes(0, 1)

    out = lax.map(blk_fn, (jnp.arange(n_blk), to_blocks(q), to_blocks(iq), to_blocks(iw)))
    return out.swapaxes(0, 1).reshape(bsz, s_len, n_h, d_h)


def gla_chunked(q, k, v, lg):
    bsz, s_len, n_h, dk = q.shape
    dv = v.shape[-1]
    n_c = s_len // CHUNK
    causal = jnp.tril(jnp.ones((CHUNK, CHUNK), dtype=bool))

    def chunks(a):
        return a.astype(jnp.float32).reshape(bsz, n_c, CHUNK, n_h, a.shape[-1]).transpose(1, 0, 3, 2, 4)

    def step(state, inp):
        qc, kc, vc, gc = inp
        b = jnp.cumsum(gc, axis=2)
        o_inter = jnp.einsum('bhtd,bhde->bhte', qc * jnp.exp(b), state)
        diff = b[:, :, :, None, :] - b[:, :, None, :, :]
        decay = jnp.exp(jnp.where(causal[:, :, None], diff, -jnp.inf))
        att = jnp.einsum('bhtd,bhsd,bhtsd->bhts', qc, kc, decay)
        o = o_inter + jnp.einsum('bhts,bhse->bhte', att, vc)
        b_last = b[:, :, -1:, :]
        state = (jnp.exp(b_last[:, :, 0, :])[..., None] * state
                 + jnp.einsum('bhsd,bhse->bhde', kc * jnp.exp(b_last - b), vc))
        return state, o

    s0 = jnp.zeros((bsz, n_h, dk, dv), jnp.float32)
    _, o = lax.scan(step, s0, (chunks(q), chunks(k), chunks(v), chunks(lg)))
    return o.transpose(1, 0, 3, 2, 4).reshape(bsz, s_len, n_h, dv)


def stick_breaking(q, k, v):
    bsz, s_len, n_h, d_h = q.shape
    n_blk = s_len // SB_QBLOCK
    key_pos = jnp.arange(s_len)

    def blk_fn(args):
        i, qb = args
        z = jnp.einsum('bthd,bshd->bhts', qb, k).astype(jnp.float32) * d_h ** -0.5
        t_pos = i * SB_QBLOCK + jnp.arange(SB_QBLOCK)
        mask = key_pos[None, :] < t_pos[:, None]
        lo = jnp.where(mask, jax.nn.log_sigmoid(-z), 0.0)
        rc = lax.cumsum(lo, axis=3, reverse=True)
        log_a = jax.nn.log_sigmoid(z) + (rc - lo)
        a = jnp.where(mask, jnp.exp(log_a), 0.0)
        return jnp.einsum('bhts,bshd->bthd', a.astype(v.dtype), v)

    qb = q.reshape(bsz, n_blk, SB_QBLOCK, n_h, d_h).swapaxes(0, 1)
    out = lax.map(blk_fn, (jnp.arange(n_blk), qb))
    return out.swapaxes(0, 1).reshape(bsz, s_len, n_h, d_h)


def mixer_ab(n, pos, w_in, gq, gk, w_gate_up, b_gate, g_gla, w_out):
    bsz, s_len, _ = n.shape
    proj = n @ w_in
    (qa, ka, va, iq, ik, iw, qb, kb, vb, g_low, og) = _split(proj, AB_SIZES)
    qa = rope_partial(rmsnorm(qa.reshape(bsz, s_len, N_HEADS_A, HEAD_DIM), gq), pos)
    ka = rope_partial(rmsnorm(ka.reshape(bsz, s_len, N_HEADS_A, HEAD_DIM), gk), pos)
    va = va.reshape(bsz, s_len, N_HEADS_A, HEAD_DIM)
    iq = rope_partial(iq.reshape(bsz, s_len, IDX_HEADS, IDX_DIM), pos)
    ik = rope_partial(ik[:, :, None, :], pos)[:, :, 0, :]
    oa = dsa_attention(qa, ka, va, iq, ik, iw).reshape(bsz, s_len, A_WIDTH)
    qb = qb.reshape(bsz, s_len, N_HEADS_B, GLA_DK) * GLA_DK ** -0.5
    kb = kb.reshape(bsz, s_len, N_HEADS_B, GLA_DK)
    vb = vb.reshape(bsz, s_len, N_HEADS_B, GLA_DV)
    gate = (g_low @ w_gate_up + b_gate).astype(jnp.float32)
    lg = (jax.nn.log_sigmoid(gate) / GLA_TAU).reshape(bsz, s_len, N_HEADS_B, GLA_DK)
    ob = gla_chunked(qb, kb, vb, lg).astype(n.dtype)
    ob = rmsnorm(ob, g_gla).reshape(bsz, s_len, B_WIDTH) * jax.nn.silu(og)
    return jnp.concatenate([oa, ob], axis=-1) @ w_out


def mixer_c(n, w_in, gq, gk, w_out):
    bsz, s_len, _ = n.shape
    q, k, v = _split(n @ w_in, (C_WIDTH, C_WIDTH, C_WIDTH))
    q = rmsnorm(q.reshape(bsz, s_len, N_HEADS_C, HEAD_DIM), gq)
    k = rmsnorm(k.reshape(bsz, s_len, N_HEADS_C, HEAD_DIM), gk)
    v = v.reshape(bsz, s_len, N_HEADS_C, HEAD_DIM)
    return stick_breaking(q, k, v).reshape(bsz, s_len, C_WIDTH) @ w_out


def squared_relu_mlp(n, w_up, w_down):
    return jnp.square(jax.nn.relu(n @ w_up)) @ w_down


def setup_inputs(seed: int = 0) -> dict:
    key = jax.random.key(seed)
    ks = jax.random.split(key, 16)
    f32 = jnp.float32

    def w(k, shape, fan_in):
        return jax.random.normal(k, shape, f32) * fan_in ** -0.5

    def gain(k, shape):
        return 1.0 + 0.02 * jax.random.normal(k, shape, f32)

    return {
        "x": jax.random.normal(ks[0], (BATCH, SEQ, D_MODEL), f32),
        "g_mix": gain(ks[1], (DEPTH, D_MODEL)),
        "g_ffn": gain(ks[2], (DEPTH, D_MODEL)),
        "w_in_ab": w(ks[3], (N_EVEN, D_MODEL, AB_PROJ), D_MODEL),
        "gq_a": gain(ks[4], (N_EVEN, HEAD_DIM)),
        "gk_a": gain(ks[5], (N_EVEN, HEAD_DIM)),
        "w_gate_up": w(ks[6], (N_EVEN, GLA_GATE_RANK, N_HEADS_B * GLA_DK), GLA_GATE_RANK),
        "b_gate": 0.1 * jax.random.normal(ks[7], (N_EVEN, N_HEADS_B * GLA_DK), f32),
        "g_gla": gain(ks[8], (N_EVEN, GLA_DV)),
        "w_out_ab": w(ks[9], (N_EVEN, A_WIDTH + B_WIDTH, D_MODEL), A_WIDTH + B_WIDTH),
        "w_in_c": w(ks[10], (N_ODD, D_MODEL, 3 * C_WIDTH), D_MODEL),
        "gq_c": gain(ks[11], (N_ODD, HEAD_DIM)),
        "gk_c": gain(ks[12], (N_ODD, HEAD_DIM)),
        "w_out_c": w(ks[13], (N_ODD, C_WIDTH, D_MODEL), C_WIDTH),
        "w_up": w(ks[14], (DEPTH, D_MODEL, D_FF), D_MODEL),
        "w_down": w(ks[15], (DEPTH, D_FF, D_MODEL), D_FF),
    }


def reference(x, g_mix, g_ffn, w_in_ab, gq_a, gk_a, w_gate_up, b_gate, g_gla, w_out_ab,
              w_in_c, gq_c, gk_c, w_out_c, w_up, w_down):
    pos = jnp.arange(x.shape[1])
    h = x
    for layer in range(DEPTH):
        n = rmsnorm(h, g_mix[layer])
        if layer % 2 == 0:
            i = layer // 2
            h = h + mixer_ab(n, pos, w_in_ab[i], gq_a[i], gk_a[i], w_gate_up[i],
                             b_gate[i], g_gla[i], w_out_ab[i])
        else:
            i = layer // 2
            h = h + mixer_c(n, w_in_c[i], gq_c[i], gk_c[i], w_out_c[i])
        h = h + squared_relu_mlp(rmsnorm(h, g_ffn[layer]), w_up[layer], w_down[layer])
    return h
```

```cpp
#include <hip/hip_runtime.h>
#include <hip/hip_cooperative_groups.h>
#include <cstdio>
#include <cstdint>
namespace cg = cooperative_groups;

#ifndef FUSED
#define FUSED 1
#endif

constexpr int D = 1024, SEQ = 2048, BATCH = 16, MTOK = BATCH * SEQ, FF = 4096;
constexpr int ABP = 3672;
constexpr int OFF_QA = 0, OFF_KA = 512, OFF_VA = 1024, OFF_IQ = 1536, OFF_IK = 2048, OFF_IW = 2112, OFF_QB = 2120, OFF_KB = 2376,
              OFF_VB = 2632, OFF_GL = 3144, OFF_OG = 3160;
constexpr int TG = 8192;
constexpr int NGROUP = MTOK / TG;
constexpr int NT = 256;
constexpr float EPS = 1e-6f;

struct Params {
    const float *x, *g_mix, *g_ffn, *w_in_ab, *gq_a, *gk_a, *w_gate_up, *b_gate, *g_gla, *w_out_ab, *w_in_c, *gq_c, *gk_c, *w_out_c, *w_up, *w_down;
    float* out;
    float *nbuf, *proj, *qa_n, *ka_n, *iq_r, *ik_r, *lg, *cat, *gla_o, *hid;
    unsigned* mask;
};

__device__ __forceinline__ float wave_sum(float v) {
#pragma unroll
    for (int o = 1; o < 64; o <<= 1) v += __shfl_xor(v, o);
    return v;
}
__device__ __forceinline__ float wave_max(float v) {
#pragma unroll
    for (int o = 1; o < 64; o <<= 1) v = fmaxf(v, __shfl_xor(v, o));
    return v;
}
__device__ __forceinline__ float log_sigmoid(float x) { return fminf(x, 0.f) - log1pf(expf(-fabsf(x))); }

__device__ void ph_rmsnorm(const float* in, const float* g, float* outp, int rows, int bid, int nb) {
    const int lane = threadIdx.x & 63, wv = threadIdx.x >> 6, nwb = NT / 64;
    for (int r = bid * nwb + wv; r < rows; r += nb * nwb) {
        const float4* xr = (const float4*)(in + (size_t)r * D);
        float4 v[4]; float s = 0.f;
#pragma unroll
        for (int j = 0; j < 4; ++j) { v[j] = xr[lane + 64 * j]; s += v[j].x * v[j].x + v[j].y * v[j].y + v[j].z * v[j].z + v[j].w * v[j].w; }
        s = wave_sum(s);
        const float rs = rsqrtf(s * (1.f / D) + EPS);
        float4* orow = (float4*)(outp + (size_t)r * D);
#pragma unroll
        for (int j = 0; j < 4; ++j) { const float4 gg = ((const float4*)g)[lane + 64 * j]; float4 o; o.x = v[j].x * rs * gg.x; o.y = v[j].y * rs * gg.y; o.z = v[j].z * rs * gg.z; o.w = v[j].w * rs * gg.w; orow[lane + 64 * j] = o; }
    }
}

__device__ void ph_gemm(const float* __restrict__ A, int lda, const float* __restrict__ W, int ldw, float* C, int ldc, const float* R, int ldr,
                        int M, int N, int K, int mode, float* sm, int bid, int nb) {
    float* As = sm;
    float* Bs = sm + 16 * 132;
    const int tid = threadIdx.x, tx = tid & 15, ty = tid >> 4;
    const int ntn = (N + 127) / 128, ntm = M / 128;
    for (int tile = bid; tile < ntn * ntm; tile += nb) {
        const int tm = tile / ntn, tn = tile % ntn;
        float acc[8][8];
#pragma unroll
        for (int i = 0; i < 8; ++i)
#pragma unroll
            for (int j = 0; j < 8; ++j) acc[i][j] = 0.f;
        for (int k0 = 0; k0 < K; k0 += 16) {
#pragma unroll
            for (int i = 0; i < 2; ++i) {
                const int idx = tid + i * 256;
                { const int row = idx >> 2, c4 = idx & 3; const float4 v = *(const float4*)(A + (size_t)(tm * 128 + row) * lda + k0 + c4 * 4);
                  As[(c4 * 4 + 0) * 132 + row] = v.x; As[(c4 * 4 + 1) * 132 + row] = v.y; As[(c4 * 4 + 2) * 132 + row] = v.z; As[(c4 * 4 + 3) * 132 + row] = v.w; }
                { const int row = idx >> 5, c4 = idx & 31; const int n = tn * 128 + c4 * 4; float4 v = make_float4(0.f, 0.f, 0.f, 0.f);
                  if (n < N) v = *(const float4*)(W + (size_t)(k0 + row) * ldw + n);
                  *(float4*)(Bs + row * 132 + c4 * 4) = v; }
            }
            __syncthreads();
#pragma unroll
            for (int k = 0; k < 16; ++k) {
                float a[8], b[8];
                *(float4*)&a[0] = *(const float4*)(As + k * 132 + ty * 8); *(float4*)&a[4] = *(const float4*)(As + k * 132 + ty * 8 + 4);
                *(float4*)&b[0] = *(const float4*)(Bs + k * 132 + tx * 8); *(float4*)&b[4] = *(const float4*)(Bs + k * 132 + tx * 8 + 4);
#pragma unroll
                for (int i = 0; i < 8; ++i)
#pragma unroll
                    for (int j = 0; j < 8; ++j) acc[i][j] = fmaf(a[i], b[j], acc[i][j]);
            }
            __syncthreads();
        }
#pragma unroll
        for (int i = 0; i < 8; ++i) {
            const int row = tm * 128 + ty * 8 + i;
#pragma unroll
            for (int j4 = 0; j4 < 2; ++j4) {
                const int n = tn * 128 + tx * 8 + j4 * 4;
                if (n < N) {
                    float4 v = make_float4(acc[i][j4 * 4 + 0], acc[i][j4 * 4 + 1], acc[i][j4 * 4 + 2], acc[i][j4 * 4 + 3]);
                    if (mode == 1) { const float4 r = *(const float4*)(R + (size_t)row * ldr + n); v.x += r.x; v.y += r.y; v.z += r.z; v.w += r.w; }
                    else if (mode == 2) { v.x = fmaxf(v.x, 0.f); v.y = fmaxf(v.y, 0.f); v.z = fmaxf(v.z, 0.f); v.w = fmaxf(v.w, 0.f); v.x *= v.x; v.y *= v.y; v.z *= v.z; v.w *= v.w; }
                    *(float4*)(C + (size_t)row * ldc + n) = v;
                }
            }
        }
    }
}

__device__ void ph_prep_a(const Params& p, int bid, int nb) {
    const int lane = threadIdx.x & 63, wv = threadIdx.x >> 6, nwb = NT / 64;
    for (int tl = bid * nwb + wv; tl < TG; tl += nb * nwb) {
        const float pos = (float)(tl & (SEQ - 1));
        const float* pr = p.proj + (size_t)tl * ABP;
        float c128 = 1.f, s128 = 0.f;
        if (lane < 32) { const int i = lane & 15; const float inv = powf(500000.0f, -(float)i * 2.0f / 32.0f); const float ang = pos * inv; c128 = cosf(ang); s128 = sinf(ang); }
#pragma unroll
        for (int which = 0; which < 2; ++which) {
            const float* src = pr + (which == 0 ? OFF_QA : OFF_KA);
            const float* gn = which == 0 ? p.gq_a : p.gk_a;
            float* dst = (which == 0 ? p.qa_n : p.ka_n) + (size_t)tl * 512;
            for (int h = 0; h < 4; ++h) {
                float a = src[h * 128 + lane], b = src[h * 128 + 64 + lane];
                const float ss = wave_sum(a * a + b * b);
                const float rs = rsqrtf(ss * (1.f / 128.f) + EPS);
                a = a * rs * gn[lane]; b = b * rs * gn[64 + lane];
                const float other = __shfl_xor(a, 16);
                float o = a;
                if (lane < 16) o = a * c128 - other * s128;
                else if (lane < 32) o = a * c128 + other * s128;
                dst[h * 128 + lane] = o; dst[h * 128 + 64 + lane] = b;
            }
        }
        float c64 = 1.f, s64 = 0.f;
        if (lane < 16) { const int i = lane & 7; const float inv = powf(500000.0f, -(float)i * 2.0f / 16.0f); const float ang = pos * inv; c64 = cosf(ang); s64 = sinf(ang); }
        for (int h = 0; h < 9; ++h) {
            const float* src = (h < 8) ? pr + OFF_IQ + h * 64 : pr + OFF_IK;
            float* dst = (h < 8) ? p.iq_r + (size_t)tl * 512 + h * 64 : p.ik_r + (size_t)tl * 64;
            const float a = src[lane];
            const float other = __shfl_xor(a, 8);
            float o = a;
            if (lane < 8) o = a * c64 - other * s64;
            else if (lane < 16) o = a * c64 + other * s64;
            dst[lane] = o;
        }
    }
}

__device__ void ph_gate(const Params& p, int bid, int nb) {
    for (int i = bid * NT + threadIdx.x; i < TG * 256; i += nb * NT) {
        const int tl = i >> 8, j = i & 255;
        const float* gl = p.proj + (size_t)tl * ABP + OFF_GL;
        float acc = 0.f;
#pragma unroll
        for (int r = 0; r < 16; ++r) acc = fmaf(gl[r], p.w_gate_up[r * 256 + j], acc);
        acc += p.b_gate[j];
        p.lg[i] = log_sigmoid(acc) * (1.f / 16.f);
    }
}

__device__ void ph_indexer(const Params& p, float* sm, int bid, int nb) {
    float* sc = sm;
    float* qv = sm + 2048;
    float* wv = qv + 512;
    unsigned* mw = (unsigned*)(wv + 8);
    const int tid = threadIdx.x;
    for (int tl = bid; tl < TG; tl += nb) {
        const int pos = tl & (SEQ - 1), seq0 = tl - pos, limit = ((pos >> 6) + 1) << 6;
        for (int i = tid; i < 512; i += NT) qv[i] = p.iq_r[(size_t)tl * 512 + i];
        if (tid < 8) wv[tid] = p.proj[(size_t)tl * ABP + OFF_IW + tid] * 0.35355339059327373f;
        if (tid < 64) mw[tid] = 0u;
        __syncthreads();
        for (int s = tid; s < limit; s += NT) {
            const float* kp = p.ik_r + (size_t)(seq0 + s) * 64;
            float acc[8];
#pragma unroll
            for (int h = 0; h < 8; ++h) acc[h] = 0.f;
            for (int d = 0; d < 64; ++d) { const float kd = kp[d];
#pragma unroll
                for (int h = 0; h < 8; ++h) acc[h] = fmaf(qv[h * 64 + d], kd, acc[h]); }
            float score = 0.f;
#pragma unroll
            for (int h = 0; h < 8; ++h) score += fmaxf(acc[h] * 0.125f, 0.f) * wv[h];
            sc[s] = score;
        }
        __syncthreads();
        if (limit <= 256) { if (tid < 64) mw[tid] = (tid * 32 < limit) ? 0xffffffffu : 0u; }
        else {
            for (int s = tid; s < limit; s += NT) {
                const float v = sc[s]; int cnt = 0;
                for (int j = 0; j < limit; ++j) { const float u = sc[j]; cnt += ((u > v) || (u == v && j < s)) ? 1 : 0; }
                if (cnt < 256) atomicOr(&mw[s >> 5], 1u << (s & 31));
            }
        }
        __syncthreads();
        if (tid < 64) p.mask[(size_t)tl * 64 + tid] = mw[tid];
        __syncthreads();
    }
}

__device__ __forceinline__ float block_sum(float v, float* red) {
    v = wave_sum(v);
    __syncthreads();
    if ((threadIdx.x & 63) == 0) red[threadIdx.x >> 6] = v;
    __syncthreads();
    float r = 0.f;
    for (int i = 0; i < NT / 64; ++i) r += red[i];
    return r;
}
__device__ __forceinline__ float block_max(float v, float* red) {
    v = wave_max(v);
    __syncthreads();
    if ((threadIdx.x & 63) == 0) red[threadIdx.x >> 6] = v;
    __syncthreads();
    float r = red[0];
    for (int i = 1; i < NT / 64; ++i) r = fmaxf(r, red[i]);
    return r;
}

__device__ void ph_dsa(const Params& p, float* sm, int bid, int nb) {
    unsigned* mw = (unsigned*)sm;
    int* pre = (int*)(sm + 64);
    int* idx = (int*)(sm + 192);
    float* pp = sm + 448;
    float* q = sm + 704;
    float* red = sm + 1216;
    const int tid = threadIdx.x;
    for (int tl = bid; tl < TG; tl += nb) {
        const int pos = tl & (SEQ - 1), seq0 = tl - pos;
        if (tid < 64) mw[tid] = p.mask[(size_t)tl * 64 + tid];
        for (int i = tid; i < 512; i += NT) q[i] = p.qa_n[(size_t)tl * 512 + i];
        __syncthreads();
        if (tid == 0) { int a = 0; for (int w = 0; w < 64; ++w) { pre[w] = a; a += __popc(mw[w]); } pre[64] = a; }
        __syncthreads();
        const int n = pre[64];
        for (int s = tid; s < SEQ; s += NT) { const unsigned w = mw[s >> 5]; if ((w >> (s & 31)) & 1u) idx[pre[s >> 5] + __popc(w & ((1u << (s & 31)) - 1u))] = s; }
        __syncthreads();
        for (int h = 0; h < 4; ++h) {
            float sv = -INFINITY;
            if (tid < n) { const float* kp = p.ka_n + (size_t)(seq0 + idx[tid]) * 512 + h * 128; float a = 0.f;
                for (int d = 0; d < 128; ++d) a = fmaf(q[h * 128 + d], kp[d], a);
                sv = a * 0.08838834764831845f; }
            const float m = block_max(sv, red);
            const float e = (tid < n) ? expf(sv - m) : 0.f;
            const float l = block_sum(e, red);
            pp[tid] = e;
            __syncthreads();
            if (tid < 128) { float o = 0.f;
                for (int j = 0; j < n; ++j) o = fmaf(pp[j], p.proj[(size_t)(seq0 + idx[j]) * ABP + OFF_VA + h * 128 + tid], o);
                p.cat[(size_t)tl * D + h * 128 + tid] = o / l; }
            __syncthreads();
        }
    }
}

__device__ void ph_gla(const Params& p, float* sm, int bid, int nb) {
    float* sq = sm; float* sk = sm + 1024; float* sd = sm + 2048;
    const int tid = threadIdx.x;
    for (int item = bid; item < (TG / SEQ) * 4; item += nb) {
        const int bl = item >> 2, h = item & 3, seq0 = bl * SEQ;
        float S[64];
#pragma unroll
        for (int d = 0; d < 64; ++d) S[d] = 0.f;
        for (int t0 = 0; t0 < SEQ; t0 += 16) {
            for (int i = tid; i < 1024; i += NT) { const int tt = i >> 6, d = i & 63; const size_t tok = seq0 + t0 + tt;
                sq[i] = p.proj[tok * ABP + OFF_QB + h * 64 + d] * 0.125f; sk[i] = p.proj[tok * ABP + OFF_KB + h * 64 + d]; sd[i] = expf(p.lg[tok * 256 + h * 64 + d]); }
            __syncthreads();
            if (tid < 128) {
                for (int tt = 0; tt < 16; ++tt) { const size_t tok = seq0 + t0 + tt;
                    const float v = p.proj[tok * ABP + OFF_VB + h * 128 + tid]; float o = 0.f;
#pragma unroll
                    for (int d = 0; d < 64; ++d) { S[d] = fmaf(sd[tt * 64 + d], S[d], sk[tt * 64 + d] * v); o = fmaf(sq[tt * 64 + d], S[d], o); }
                    p.gla_o[tok * 512 + h * 128 + tid] = o; }
            }
            __syncthreads();
        }
    }
}

__device__ void ph_gla_out(const Params& p, int bid, int nb) {
    const int lane = threadIdx.x & 63, wv = threadIdx.x >> 6, nwb = NT / 64;
    for (int it = bid * nwb + wv; it < TG * 4; it += nb * nwb) {
        const int tl = it >> 2, h = it & 3;
        const float a = p.gla_o[(size_t)tl * 512 + h * 128 + lane], b = p.gla_o[(size_t)tl * 512 + h * 128 + 64 + lane];
        const float rs = rsqrtf(wave_sum(a * a + b * b) * (1.f / 128.f) + EPS);
        const float oa = p.proj[(size_t)tl * ABP + OFF_OG + h * 128 + lane], ob = p.proj[(size_t)tl * ABP + OFF_OG + h * 128 + 64 + lane];
        p.cat[(size_t)tl * D + 512 + h * 128 + lane] = a * rs * p.g_gla[lane] * (oa / (1.f + expf(-oa)));
        p.cat[(size_t)tl * D + 512 + h * 128 + 64 + lane] = b * rs * p.g_gla[64 + lane] * (ob / (1.f + expf(-ob)));
    }
}

__device__ void ph_prep_c(const Params& p, float* qn, float* kn, int bid, int nb) {
    const int lane = threadIdx.x & 63, wv = threadIdx.x >> 6, nwb = NT / 64;
    for (int it = bid * nwb + wv; it < TG * 16; it += nb * nwb) {
        const int tl = it >> 4, hh = it & 15, isk = hh >> 3, h = hh & 7;
        const float* src = p.proj + (size_t)tl * 3072 + isk * 1024 + h * 128;
        const float* gn = isk ? p.gk_c : p.gq_c;
        float* dst = (isk ? kn : qn) + (size_t)tl * D + h * 128;
        const float a = src[lane], b = src[64 + lane];
        const float rs = rsqrtf(wave_sum(a * a + b * b) * (1.f / 128.f) + EPS);
        dst[lane] = a * rs * gn[lane]; dst[64 + lane] = b * rs * gn[64 + lane];
    }
}

__device__ void ph_sb(const Params& p, const float* qn, const float* kn, int bid, int nb) {
    const int lane = threadIdx.x & 63, wv = threadIdx.x >> 6, nwb = NT / 64;
    for (int it = bid * nwb + wv; it < TG * 8; it += nb * nwb) {
        const int tl = it >> 3, h = it & 7, pos = tl & (SEQ - 1), seq0 = tl - pos;
        const float2 q = *(const float2*)(qn + (size_t)tl * D + h * 128 + 2 * lane);
        float R = 0.f, o0 = 0.f, o1 = 0.f;
        for (int s = pos - 1; s >= 0; --s) {
            const float2 k = *(const float2*)(kn + (size_t)(seq0 + s) * D + h * 128 + 2 * lane);
            const float z = wave_sum(q.x * k.x + q.y * k.y) * 0.08838834764831845f;
            const float sp = log1pf(expf(-fabsf(z)));
            const float lsp = fminf(z, 0.f) - sp, lsn = fminf(-z, 0.f) - sp;
            const float a = expf(lsp + R);
            const float2 v = *(const float2*)(p.proj + (size_t)(seq0 + s) * 3072 + 2048 + h * 128 + 2 * lane);
            o0 = fmaf(a, v.x, o0); o1 = fmaf(a, v.y, o1);
            R += lsn;
        }
        *(float2*)(p.cat + (size_t)tl * D + h * 128 + 2 * lane) = make_float2(o0, o1);
    }
}

constexpr int NPHASE = 18;
__device__ __forceinline__ void run_phase(const Params& p, int ph, int g, float* sm, int bid, int nb) {
    const size_t t0 = (size_t)g * TG;
    const float* xg = p.x + t0 * D; float* og = p.out + t0 * D;
    float* qn = p.qa_n;
    float* kn = p.iq_r;
    const float* gA = nullptr; const float* gW = nullptr; float* gC = nullptr; const float* gR = nullptr; int lda = 0, ldw = 0, ldc = 0, gN = 0, gK = 0, mode = 0;
    switch (ph) {
    case 1: gA = p.nbuf; lda = D; gW = p.w_in_ab; ldw = ABP; gC = p.proj; ldc = ABP; gN = ABP; gK = D; mode = 0; break;
    case 6: gA = p.cat; lda = D; gW = p.w_out_ab; ldw = D; gC = og; ldc = D; gR = xg; gN = D; gK = D; mode = 1; break;
    case 8: gA = p.nbuf; lda = D; gW = p.w_up; ldw = FF; gC = p.hid; ldc = FF; gN = FF; gK = D; mode = 2; break;
    case 9: gA = p.hid; lda = FF; gW = p.w_down; ldw = D; gC = og; ldc = D; gR = og; gN = D; gK = FF; mode = 1; break;
    case 11: gA = p.nbuf; lda = D; gW = p.w_in_c; ldw = 3072; gC = p.proj; ldc = 3072; gN = 3072; gK = D; mode = 0; break;
    case 14: gA = p.cat; lda = D; gW = p.w_out_c; ldw = D; gC = og; ldc = D; gR = og; gN = D; gK = D; mode = 1; break;
    case 16: gA = p.nbuf; lda = D; gW = p.w_up + (size_t)D * FF; ldw = FF; gC = p.hid; ldc = FF; gN = FF; gK = D; mode = 2; break;
    case 17: gA = p.hid; lda = FF; gW = p.w_down + (size_t)FF * D; ldw = D; gC = og; ldc = D; gR = og; gN = D; gK = FF; mode = 1; break;
    default: break;
    }
    if (gA) { ph_gemm(gA, lda, gW, ldw, gC, ldc, gR, D, TG, gN, gK, mode, sm, bid, nb); return; }
    const float* nin = nullptr; const float* ng = nullptr;
    switch (ph) {
    case 0: nin = xg; ng = p.g_mix; break;
    case 7: nin = og; ng = p.g_ffn; break;
    case 10: nin = og; ng = p.g_mix + D; break;
    case 15: nin = og; ng = p.g_ffn + D; break;
    default: break;
    }
    if (nin) { ph_rmsnorm(nin, ng, p.nbuf, TG, bid, nb); return; }
    switch (ph) {
    case 2: ph_prep_a(p, bid, nb); ph_gate(p, bid, nb); break;
    case 3: ph_indexer(p, sm, bid, nb); break;
    case 4: ph_gla(p, sm, bid, nb); break;
    case 5: ph_dsa(p, sm, bid, nb); ph_gla_out(p, bid, nb); break;
    case 12: ph_prep_c(p, qn, kn, bid, nb); break;
    case 13: ph_sb(p, qn, kn, bid, nb); break;
    default: break;
    }
}

template <int PH> __global__ void __launch_bounds__(NT) k_phase(Params p, int g) {
    __shared__ __attribute__((aligned(16))) float sm[4352];
    run_phase(p, PH, g, sm, blockIdx.x, gridDim.x);
}
template <int PH> static void launch_phases(const Params& p, int g, hipStream_t stream) {
    hipLaunchKernelGGL(k_phase<PH>, dim3(2048), dim3(NT), 0, stream, p, g);
    if constexpr (PH + 1 < NPHASE) launch_phases<PH + 1>(p, g, stream);
}

__global__ void __launch_bounds__(NT) k_fused(Params p) {
    __shared__ __attribute__((aligned(16))) float sm[4352];
    cg::grid_group grid = cg::this_grid();
    for (int g = 0; g < NGROUP; ++g)
        for (int ph = 0; ph < NPHASE; ++ph) { run_phase(p, ph, g, sm, blockIdx.x, gridDim.x); grid.sync(); }
}

extern "C" void kernel_launch(void* const* d_in, const int* in_sizes, int n_in, void* d_out, int out_size, void* d_ws, size_t ws_size, hipStream_t stream) {
    Params p{};
    p.x = (const float*)d_in[0]; p.g_mix = (const float*)d_in[1]; p.g_ffn = (const float*)d_in[2]; p.w_in_ab = (const float*)d_in[3];
    p.gq_a = (const float*)d_in[4]; p.gk_a = (const float*)d_in[5]; p.w_gate_up = (const float*)d_in[6]; p.b_gate = (const float*)d_in[7];
    p.g_gla = (const float*)d_in[8]; p.w_out_ab = (const float*)d_in[9]; p.w_in_c = (const float*)d_in[10]; p.gq_c = (const float*)d_in[11];
    p.gk_c = (const float*)d_in[12]; p.w_out_c = (const float*)d_in[13]; p.w_up = (const float*)d_in[14]; p.w_down = (const float*)d_in[15];
    p.out = (float*)d_out;
    char* ws = (char*)d_ws; size_t off = 0;
    auto carve = [&](size_t bytes) { char* r = ws + off; off += (bytes + 255) & ~(size_t)255; return r; };
    p.nbuf = (float*)carve((size_t)TG * D * 4);
    p.proj = (float*)carve((size_t)TG * ABP * 4);
    p.qa_n = (float*)carve((size_t)TG * 512 * 4);
    p.ka_n = (float*)carve((size_t)TG * 512 * 4);
    p.iq_r = (float*)carve((size_t)TG * 512 * 4);
    p.gla_o = (float*)carve((size_t)TG * 512 * 4);
    p.ik_r = (float*)carve((size_t)TG * 64 * 4);
    p.lg = (float*)carve((size_t)TG * 256 * 4);
    p.cat = (float*)carve((size_t)TG * D * 4);
    p.hid = (float*)carve((size_t)TG * FF * 4);
    p.mask = (unsigned*)carve((size_t)TG * 64 * 4);
    if (off > ws_size) { fprintf(stderr, "kernel_launch: workspace too small (%zu > %zu)\n", off, ws_size); return; }
#if FUSED
    static int grid = 0;
    if (!grid) { int dev = 0, cus = 0, per = 0; hipGetDevice(&dev); hipDeviceGetAttribute(&cus, hipDeviceAttributeMultiprocessorCount, dev);
        hipOccupancyMaxActiveBlocksPerMultiprocessor(&per, k_fused, NT, 0); if (per > 4) per = 4; grid = cus * per; }
    void* args[] = {&p};
    hipError_t e = hipLaunchCooperativeKernel((void*)k_fused, dim3(grid), dim3(NT), args, 0, stream);
    if (e != hipSuccess) fprintf(stderr, "cooperative launch failed: %s (grid %d)\n", hipGetErrorString(e), grid);
#else
    for (int g = 0; g < NGROUP; ++g)
        launch_phases<0>(p, g, stream);
#endif
}
```

```cpp
#include <hip/hip_runtime.h>
#include <cstdio>
#include <cstdint>
namespace pg8 {
#define PG8_LAS __attribute__((address_space(3)))
typedef unsigned short bf16_t;
typedef short bf16x8 __attribute__((ext_vector_type(8)));
typedef float f32x4 __attribute__((ext_vector_type(4)));
typedef unsigned u32x4 __attribute__((ext_vector_type(4)));
constexpr int BM = 256, BK = 64, HALF = 128, HTB = HALF * BK * 2  , STAGE_BYTES = 8 * HTB, NXCD = 8, WGM = 8;

__host__ __device__ __forceinline__ int lds_byte(int r, int c) { const int st = (r >> 4) * 2 + (c >> 5), rr = r & 15, cc = c & 31, ob = rr * 64 + cc * 2; return st * 1024 + (ob ^ (((ob >> 9) & 1) << 5)); }
__host__ __device__ __forceinline__ void stage_rc(int b, int& R, int& C) { const int st = b / 1024, sb = b % 1024, swz = sb ^ (((sb >> 9) & 1) << 5); R = (st >> 1) * 16 + swz / 64; C = (st & 1) * 32 + (swz % 64) / 2; }
__host__ __device__ __forceinline__ int perm32(int rho) { const int n = rho >> 4, i = rho & 15; return 8 * (i >> 2) + 4 * n + (i & 3); }

struct Unit { int pm, pn; };
struct Gemm { const bf16_t* A; const bf16_t* Bt; int M, N, K; };

struct StaticOrder {
    int nM, nN, nwg, G, c;
    __host__ __device__ void init(int M, int N, int G_, int c_) { nM = M / BM; nN = N / BM; nwg = nM * nN; G = G_; c = c_; }
    __host__ __device__ bool next(int i, Unit& u) const {
        const long L = (long)i * G + c; if (L >= nwg) return false;
        int wgid = (int)L; { const int q = nwg / NXCD, r = nwg % NXCD, xcd = wgid % NXCD, off = wgid / NXCD; wgid = (xcd < r ? xcd * (q + 1) : r * (q + 1) + (xcd - r) * q) + off; }
        const int nig = WGM * nN, gid = wgid / nig, fm = gid * WGM, gsz = (nM - fm) < WGM ? (nM - fm) : WGM;
        u.pm = fm + ((wgid % nig) % gsz); u.pn = (wgid % nig) / gsz; return true;
    }
    __device__ __forceinline__ void a_ready(const Unit&) const {}
    __device__ __forceinline__ void done(const Unit&) const {}
};

__device__ __forceinline__ unsigned cvt_pk_bf16(float lo, float hi) { unsigned r; asm volatile("v_cvt_pk_bf16_f32 %0, %1, %2" : "=v"(r) : "v"(lo), "v"(hi)); return r; }
__device__ __forceinline__ float row_rstd(const float* ssqp, int row) {
    const f32x4* p = (const f32x4*)(ssqp + (size_t)row * 16);
    const f32x4 a = p[0], b = p[1], c = p[2], d = p[3];
    const float s = (((a[0] + a[1]) + (a[2] + a[3])) + ((b[0] + b[1]) + (b[2] + b[3]))) + (((c[0] + c[1]) + (c[2] + c[3])) + ((d[0] + d[1]) + (d[2] + d[3])));
    return rsqrtf(s * (1.0f / 1024.0f) + 1e-6f);
}
template <int ACT  > struct EpiScale {
    static constexpr bool PERM = true, AFTER_DRAIN = false;
    bf16_t* O; int ldc; const float* ssqp;
    __device__ __forceinline__ void operator()(const f32x4 (&acc)[2][2][4][2], const Unit& u, int wr, int wc, int fr, int fq) const {
        const int row0 = u.pm * BM + wr * 64 + fr, col0 = u.pn * BM + wc * 32 + 8 * fq;
#pragma unroll
        for (int ai = 0; ai < 2; ++ai)
#pragma unroll
            for (int m = 0; m < 4; ++m) {
                const int row = row0 + ai * HALF + m * 16;
                const float rs = row_rstd(ssqp, row);
                bf16_t* rowp = O + (size_t)row * ldc + col0;
#pragma unroll
                for (int bj = 0; bj < 2; ++bj) {
                    f32x4 v0 = acc[ai][bj][m][0] * rs, v1 = acc[ai][bj][m][1] * rs;
                    if (ACT == 1) {
#pragma unroll
                        for (int e = 0; e < 4; ++e) { const float a0 = fmaxf(v0[e], 0.f), a1 = fmaxf(v1[e], 0.f); v0[e] = a0 * a0; v1[e] = a1 * a1; }
                    }
                    u32x4 w; w.x = cvt_pk_bf16(v0[0], v0[1]); w.y = cvt_pk_bf16(v0[2], v0[3]); w.z = cvt_pk_bf16(v1[0], v1[1]); w.w = cvt_pk_bf16(v1[2], v1[3]);
                    *(u32x4*)(rowp + bj * HALF) = w;
                }
            }
    }
};
template <int WRITE_HB> struct EpiResid {
    static constexpr bool PERM = true, AFTER_DRAIN = false;
    const float* R; float* out; bf16_t* hb; float* ssqp;
    __device__ __forceinline__ void operator()(const f32x4 (&acc)[2][2][4][2], const Unit& u, int wr, int wc, int fr, int fq) const {
        const int row0 = u.pm * BM + wr * 64 + fr, col0 = u.pn * BM + wc * 32 + 8 * fq;
#pragma unroll
        for (int ai = 0; ai < 2; ++ai)
#pragma unroll
            for (int m = 0; m < 4; ++m) {
                const int row = row0 + ai * HALF + m * 16;
                const size_t off = (size_t)row * 1024 + col0;
                float ss = 0.f;
#pragma unroll
                for (int bj = 0; bj < 2; ++bj) {
                    const f32x4 r0 = *(const f32x4*)(R + off + bj * HALF), r1 = *(const f32x4*)(R + off + bj * HALF + 4);
                    const f32x4 v0 = acc[ai][bj][m][0] + r0, v1 = acc[ai][bj][m][1] + r1;
                    *(f32x4*)(out + off + bj * HALF) = v0; *(f32x4*)(out + off + bj * HALF + 4) = v1;
                    if (WRITE_HB) {
                        u32x4 w; w.x = cvt_pk_bf16(v0[0], v0[1]); w.y = cvt_pk_bf16(v0[2], v0[3]); w.z = cvt_pk_bf16(v1[0], v1[1]); w.w = cvt_pk_bf16(v1[2], v1[3]);
                        *(u32x4*)(hb + off + bj * HALF) = w;
                        ss += ((v0[0] * v0[0] + v0[1] * v0[1]) + (v0[2] * v0[2] + v0[3] * v0[3])) + ((v1[0] * v1[0] + v1[1] * v1[1]) + (v1[2] * v1[2] + v1[3] * v1[3]));
                    }
                }
                if (WRITE_HB) { ss += __shfl_xor(ss, 16); ss += __shfl_xor(ss, 32); if (fq == 0) ssqp[(size_t)row * 16 + u.pn * 4 + wc] = ss; }
            }
    }
};
template <class Epi, class Sched, bool ALIGN_EPI = false, bool SP2 = false>
__device__ __forceinline__ void gemm_phase(PG8_LAS unsigned char* lds, const Gemm g, const Sched& S, const Epi& E) {
    const int tid = threadIdx.x, wid = __builtin_amdgcn_readfirstlane(tid >> 6), lane = tid & 63, wr = wid >> 2, wc = wid & 3, fr = lane & 15, fq = lane >> 4;
    const int K = g.K, nt = K / BK;
    unsigned voffA[2], voffB[2];
#pragma unroll
    for (int i = 0; i < 2; ++i) { int R, C; stage_rc(tid * 16 + i * 8192, R, C); const int Rb = Epi::PERM ? ((R & ~31) + perm32(R & 31)) : R;
        voffA[i] = (unsigned)(R * K + C) * 2u; voffB[i] = (unsigned)(Rb * K + C) * 2u; }
    const size_t kstep = (size_t)(BK * 2);
    const size_t hstep = (size_t)HALF * K * 2;
    const size_t tstep = 2 * hstep;
    const unsigned ldsw = (unsigned)wid * 1024u;
    const int aoff = lds_byte(wr * 64 + fr, fq * 8), boff = lds_byte(wc * 32 + fr, fq * 8);
#define PG8_SA(b, h) (((b) * 2 + (h)) * HTB)
#define PG8_SB(b, h) ((4 + (b) * 2 + (h)) * HTB)
#define PG8_STAGE(bufoff, gbase, voff) do { _Pragma("unroll") for (int _i = 0; _i < 2; ++_i) \
        __builtin_amdgcn_global_load_lds((const unsigned*)((const char*)(gbase) + (voff)[_i]), (PG8_LAS unsigned*)(lds + (bufoff) + ldsw + _i * 8192), 16, 0, 0); } while (0)
#define PG8_LDA(dst, b, h) do { _Pragma("unroll") for (int m = 0; m < 4; ++m) _Pragma("unroll") for (int k = 0; k < 2; ++k) dst[m][k] = *(const PG8_LAS bf16x8*)(lds + PG8_SA(b, h) + aoff + m * 2048 + k * 1024); } while (0)
#define PG8_LDB(dst, b, h) do { _Pragma("unroll") for (int n = 0; n < 2; ++n) _Pragma("unroll") for (int k = 0; k < 2; ++k) dst[n][k] = *(const PG8_LAS bf16x8*)(lds + PG8_SB(b, h) + boff + n * 2048 + k * 1024); } while (0)
#define PG8_MMA(ai, bj, At, Bt) do { __builtin_amdgcn_s_setprio(1); _Pragma("unroll") for (int m = 0; m < 4; ++m) _Pragma("unroll") for (int n = 0; n < 2; ++n) _Pragma("unroll") for (int k = 0; k < 2; ++k) \
        acc[ai][bj][m][n] = __builtin_amdgcn_mfma_f32_16x16x32_bf16(Bt[n][k], At[m][k], acc[ai][bj][m][n], 0, 0, 0); __builtin_amdgcn_s_setprio(0); } while (0)
#define PG8_WAIT_V(n) asm volatile("s_waitcnt vmcnt(" #n ")" ::: "memory")
#define PG8_WAIT_L(n) asm volatile("s_waitcnt lgkmcnt(" #n ")" ::: "memory")
#define PG8_BAR __builtin_amdgcn_s_barrier()
#define PG8_SCHED __builtin_amdgcn_sched_barrier(0)
    Unit cur, nxt; int ui = 0;
    if (!S.next(0, cur)) return;
    f32x4 acc[2][2][4][2];
#pragma unroll
    for (int a = 0; a < 2; ++a)
#pragma unroll
        for (int b = 0; b < 2; ++b)
#pragma unroll
            for (int m = 0; m < 4; ++m)
#pragma unroll
                for (int n = 0; n < 2; ++n) acc[a][b][m][n] = (f32x4){0.f, 0.f, 0.f, 0.f};
    bf16x8 At[4][2], B0[2][2], B1[2][2];
    const char* cA = (const char*)g.A + (size_t)cur.pm * tstep; const char* cB = (const char*)g.Bt + (size_t)cur.pn * tstep;
    S.a_ready(cur);
    if constexpr (SP2) {
        PG8_STAGE(PG8_SB(0, 0), cB, voffB); PG8_STAGE(PG8_SB(0, 1), cB + hstep, voffB); PG8_STAGE(PG8_SA(0, 0), cA, voffA); PG8_STAGE(PG8_SA(0, 1), cA + hstep, voffA);
        if (wr == 1) PG8_BAR;
        PG8_WAIT_V(2); PG8_BAR;
        PG8_STAGE(PG8_SB(1, 0), cB + kstep, voffB); PG8_STAGE(PG8_SA(1, 0), cA + kstep, voffA); PG8_STAGE(PG8_SB(1, 1), cB + hstep + kstep, voffB);
        PG8_WAIT_V(6); PG8_BAR;
    } else {
        PG8_STAGE(PG8_SB(0, 0), cB, voffB); PG8_STAGE(PG8_SA(0, 0), cA, voffA); PG8_STAGE(PG8_SB(0, 1), cB + hstep, voffB); PG8_STAGE(PG8_SA(0, 1), cA + hstep, voffA);
        if (wr == 1) PG8_BAR;
        PG8_WAIT_V(4); PG8_BAR;
        PG8_STAGE(PG8_SB(1, 0), cB + kstep, voffB); PG8_STAGE(PG8_SA(1, 0), cA + kstep, voffA); PG8_STAGE(PG8_SB(1, 1), cB + hstep + kstep, voffB);
        PG8_WAIT_V(6); PG8_BAR;
    }
    for (;;) {
        const bool has_next = S.next(ui + 1, nxt);
        const char* nA = has_next ? (const char*)g.A + (size_t)nxt.pm * tstep : cA; const char* nB = has_next ? (const char*)g.Bt + (size_t)nxt.pn * tstep : cB;
        for (int t = 0; t < nt; t += 2) {
            const bool last = (t == nt - 2);
            const char* a1 = cA + (size_t)(t + 1) * kstep;
            const char* a2 = last ? nA : cA + (size_t)(t + 2) * kstep; const char* b2 = last ? nB : cB + (size_t)(t + 2) * kstep;
            const char* a3 = a2 + kstep; const char* b3 = b2 + kstep;
            if (last && has_next) S.a_ready(nxt);
            if constexpr (SP2) {
            PG8_LDB(B0, 0, 0); PG8_LDB(B1, 0, 1); PG8_SCHED; PG8_LDA(At, 0, 0); PG8_STAGE(PG8_SA(1, 1), a1 + hstep, voffA);
            PG8_WAIT_V(8); PG8_WAIT_L(0); PG8_BAR; PG8_MMA(0, 0, At, B0); PG8_MMA(0, 1, At, B1); PG8_BAR; PG8_SCHED;
            PG8_LDA(At, 0, 1); PG8_STAGE(PG8_SB(0, 0), b2, voffB); PG8_STAGE(PG8_SB(0, 1), b2 + hstep, voffB); PG8_STAGE(PG8_SA(0, 0), a2, voffA);
            PG8_WAIT_V(8); PG8_WAIT_L(0); PG8_BAR; PG8_MMA(1, 0, At, B0); PG8_MMA(1, 1, At, B1); PG8_BAR; PG8_SCHED;
            PG8_LDB(B0, 1, 0); PG8_LDB(B1, 1, 1); PG8_SCHED; PG8_LDA(At, 1, 0); PG8_STAGE(PG8_SA(0, 1), a2 + hstep, voffA);
            PG8_WAIT_V(8); PG8_WAIT_L(0); PG8_BAR; PG8_MMA(0, 0, At, B0); PG8_MMA(0, 1, At, B1); PG8_BAR; PG8_SCHED;
            PG8_LDA(At, 1, 1); PG8_STAGE(PG8_SB(1, 0), b3, voffB); PG8_STAGE(PG8_SB(1, 1), b3 + hstep, voffB); PG8_STAGE(PG8_SA(1, 0), a3, voffA);
            PG8_WAIT_V(8); PG8_WAIT_L(0); PG8_BAR; PG8_MMA(1, 0, At, B0); PG8_MMA(1, 1, At, B1); PG8_BAR; PG8_SCHED;
            } else {
            PG8_LDB(B0, 0, 0); PG8_SCHED; PG8_LDA(At, 0, 0); PG8_STAGE(PG8_SA(1, 1), a1 + hstep, voffA);
            PG8_WAIT_L(8); PG8_BAR; PG8_WAIT_L(0); PG8_MMA(0, 0, At, B0); PG8_BAR; PG8_SCHED;
            PG8_LDB(B1, 0, 1); PG8_STAGE(PG8_SB(0, 0), b2, voffB);
            PG8_BAR; PG8_WAIT_L(0); PG8_MMA(0, 1, At, B1); PG8_BAR;
            PG8_LDA(At, 0, 1); PG8_STAGE(PG8_SA(0, 0), a2, voffA);
            PG8_BAR; PG8_WAIT_L(0); PG8_MMA(1, 0, At, B0); PG8_BAR; PG8_SCHED;
            PG8_STAGE(PG8_SB(0, 1), b2 + hstep, voffB);
            PG8_WAIT_V(6); PG8_BAR; PG8_MMA(1, 1, At, B1); PG8_BAR;
            PG8_LDB(B0, 1, 0); PG8_SCHED; PG8_LDA(At, 1, 0); PG8_STAGE(PG8_SA(0, 1), a2 + hstep, voffA);
            PG8_WAIT_L(8); PG8_BAR; PG8_WAIT_L(0); PG8_MMA(0, 0, At, B0); PG8_BAR; PG8_SCHED;
            PG8_LDB(B1, 1, 1); PG8_STAGE(PG8_SB(1, 0), b3, voffB);
            PG8_BAR; PG8_WAIT_L(0); PG8_MMA(0, 1, At, B1); PG8_BAR;
            PG8_LDA(At, 1, 1); PG8_STAGE(PG8_SA(1, 0), a3, voffA);
            PG8_BAR; PG8_WAIT_L(0); PG8_MMA(1, 0, At, B0); PG8_BAR; PG8_SCHED;
            PG8_STAGE(PG8_SB(1, 1), b3 + hstep, voffB);
            PG8_WAIT_V(6); PG8_BAR; PG8_MMA(1, 1, At, B1); PG8_BAR;
            }
        }
        if constexpr (ALIGN_EPI) { if (wr == 0) PG8_BAR; }
        if constexpr (!Epi::AFTER_DRAIN) { E(acc, cur, wr, wc, fr, fq); S.done(cur); }
        if (!has_next) break;
#pragma unroll
        for (int a = 0; a < 2; ++a)
#pragma unroll
            for (int b = 0; b < 2; ++b)
#pragma unroll
                for (int m = 0; m < 4; ++m)
#pragma unroll
                    for (int n = 0; n < 2; ++n) acc[a][b][m][n] = (f32x4){0.f, 0.f, 0.f, 0.f};
        cur = nxt; cA = nA; cB = nB; ++ui;
        if constexpr (ALIGN_EPI) { if (wr == 1) PG8_BAR; }
    }
    PG8_WAIT_V(0);
    if constexpr (!ALIGN_EPI) { if (wr == 0) PG8_BAR; }
    PG8_BAR;
    if constexpr (Epi::AFTER_DRAIN) { E.fused(acc, cur, wr, wc, fr, fq, lds, wid, lane); S.done(cur); }
#undef PG8_SA
#undef PG8_SB
#undef PG8_STAGE
#undef PG8_LDA
#undef PG8_LDB
#undef PG8_MMA
#undef PG8_WAIT_V
#undef PG8_WAIT_L
#undef PG8_BAR
#undef PG8_SCHED
}
}
#include <cmath>
constexpr int NWAVES = 8, NTHR = 512;
constexpr int BATCH = 16, SEQ = 2048, M = BATCH * SEQ, D = 1024, FF = 4096, NAB = 3840, NC = 3072, ABP_OLD = 3672;
constexpr int C_QA = 0, C_KA = 512, C_VA = 1024, C_IQ = 1536, C_QB = 2048, C_KB = 2304, C_VB = 2560, C_OG = 3072, C_IK = 3584, C_IW = 3648, C_GL = 3656;
constexpr float EPS = 1e-6f;
constexpr size_t MiB = 1u << 20;
constexpr size_t WS_CTL = 0, CTL_ZERO_BYTES = 1 * MiB;
constexpr size_t WS_WAB = 1 * MiB, WS_WOAB = 9 * MiB, WS_WUP0 = 11 * MiB, WS_WDN0 = 19 * MiB, WS_WINC = 27 * MiB, WS_WOC = 33 * MiB, WS_WUP1 = 35 * MiB, WS_WDN1 = 43 * MiB;
constexpr size_t WS_SSQ = 51 * MiB, SSQ_BYTES = 2 * MiB;
constexpr size_t WS_XB = 60 * MiB;
constexpr size_t WS_CAT = 124 * MiB;
constexpr size_t WS_MASK = 188 * MiB;
constexpr size_t WS_R1 = 196 * MiB;
constexpr size_t WS_END = 452 * MiB;
constexpr int CW_BAR = 4096;
constexpr int RING_BYTES = 131072;
constexpr int LDS_BYTES = 163840;
constexpr int MISC_OFF = LDS_BYTES - 256;
#define GAS __attribute__((address_space(1)))
#define LAS __attribute__((address_space(3)))
typedef unsigned short bf16;
typedef unsigned v4u __attribute__((ext_vector_type(4)));
typedef float f32x4 __attribute__((ext_vector_type(4)));
typedef short bf16x8 __attribute__((ext_vector_type(8)));
typedef GAS unsigned gu32;
typedef GAS unsigned long long gu64;
#define RLX_AGENT __ATOMIC_RELAXED, __HIP_MEMORY_SCOPE_AGENT
#define LDS_WAIT() asm volatile("s_waitcnt lgkmcnt(0)" ::: "memory")
#define VM_WAIT() asm volatile("s_waitcnt vmcnt(0)" ::: "memory")
__device__ __forceinline__ unsigned long long rt() { return __builtin_amdgcn_s_memrealtime(); }
__device__ __forceinline__ unsigned f2bf(float f) { unsigned u = __builtin_bit_cast(unsigned, f); return (u + 0x7fffu + ((u >> 16) & 1u)) >> 16; }
__device__ __forceinline__ unsigned pk2(float lo, float hi) { return f2bf(lo) | (f2bf(hi) << 16); }
#define XB_TMO      128
#define XB_XCNT(j)  (256  + 64 * (j))
#define XB_XSUB(j)  (1280 + 64 * (j))
#define XB_XGEN(j)  (2304 + 64 * (j))
#define XB_TOP      3328
#define XB_TOPGEN   3392
#define XCD_BAR_WORDS 3456
#define XB_SPIN_CAP (1u << 18)

__device__ __forceinline__ unsigned xb_ld(unsigned* p)              { return __hip_atomic_load(p, __ATOMIC_RELAXED, __HIP_MEMORY_SCOPE_AGENT); }
__device__ __forceinline__ unsigned xb_add(unsigned* p, unsigned v) { return __hip_atomic_fetch_add(p, v, __ATOMIC_RELAXED, __HIP_MEMORY_SCOPE_AGENT); }
__device__ __forceinline__ unsigned xb_xcc_id() { return (unsigned)__builtin_amdgcn_s_getreg((3 << 11) | 20) & 0xFu; }
#define XB_SPIN(cond, bar) do { unsigned _sp = 0; while (cond) { __builtin_amdgcn_s_sleep(1); \
    if ((++_sp & 255u) == 0u) { if (xb_ld(&(bar)[XB_TMO])) break; if (_sp > XB_SPIN_CAP) { atomicAdd(&(bar)[XB_TMO], 1u); break; } } } } while (0)

struct XcdBarrier {
    unsigned* bar; unsigned x;
    volatile LAS unsigned* st;
};

__device__ __forceinline__ XcdBarrier xcd_barrier_post(unsigned* bar, volatile LAS unsigned* st) {
    XcdBarrier b; b.bar = bar; b.x = xb_xcc_id(); b.st = st;
    if (threadIdx.x == 0) (void)xb_add(&bar[XB_XCNT(b.x)], 1u);
    return b;
}
__device__ __forceinline__ void xcd_barrier_complete(unsigned* bar, unsigned x, unsigned& nloc, unsigned& nx) {
    const unsigned G = gridDim.x * gridDim.y * gridDim.z;
    unsigned sum, cnt, mine, sp = 0u;
    for (;;) {
        sum = 0u; cnt = 0u; mine = 0u;
#pragma unroll
        for (unsigned j = 0; j < 16; ++j) { const unsigned c = xb_ld(&bar[XB_XCNT(j)]); sum += c; cnt += (c > 0u) ? 1u : 0u; mine = (j == x) ? c : mine; }
        if (sum == G) break;
        __builtin_amdgcn_s_sleep(1);
        if ((++sp & 255u) == 0u) { if (xb_ld(&bar[XB_TMO])) break; if (sp > XB_SPIN_CAP) { atomicAdd(&bar[XB_TMO], 1u); break; } }
    }
    nloc = mine > 0u ? mine : 1u; nx = cnt > 0u ? cnt : 1u;
}

__device__ __forceinline__ void xcd_barrier(const XcdBarrier& b) {
    asm volatile("s_waitcnt vmcnt(0)" ::: "memory");
    __syncthreads();
    if (threadIdx.x == 0) {
        unsigned* bar = b.bar;
        __builtin_amdgcn_s_waitcnt(0);
        unsigned nloc = b.st[0], nx = b.st[1];
        if (nloc == 0u) { xcd_barrier_complete(bar, b.x, nloc, nx); b.st[0] = nloc; b.st[1] = nx; }
        const unsigned old = xb_add(&bar[XB_XSUB(b.x)], 1u);
        const unsigned gen = old / nloc;
        if (old + 1u == (gen + 1u) * nloc) {
            __builtin_amdgcn_fence(__ATOMIC_RELEASE, "agent");
            asm volatile("s_waitcnt vmcnt(0)" ::: "memory");
            const unsigned og = xb_add(&bar[XB_TOP], 1u);
            const unsigned tg = og / nx;
            if (og + 1u == (tg + 1u) * nx) xb_add(&bar[XB_TOPGEN], 1u);
            else XB_SPIN(xb_ld(&bar[XB_TOPGEN]) == tg, bar);
            __builtin_amdgcn_fence(__ATOMIC_ACQUIRE, "agent");
            xb_add(&bar[XB_XGEN(b.x)], 1u);
            asm volatile("s_waitcnt vmcnt(0)" ::: "memory");
        } else {
            XB_SPIN(xb_ld(&bar[XB_XGEN(b.x)]) == gen, bar);
            __builtin_amdgcn_fence(__ATOMIC_ACQUIRE, "agent");
            asm volatile("s_waitcnt vmcnt(0)" ::: "memory");
        }
    }
    __syncthreads();
}
struct Frame {
    LAS unsigned char* lds;
    volatile LAS unsigned* MISC;
    gu32* ctl;
    int tid, lane, wave, vcu, G;
    const float *x, *g_mix, *g_ffn, *w_in_ab, *gq_a, *gk_a, *w_gate_up, *b_gate, *g_gla, *w_out_ab, *w_in_c, *gq_c, *gk_c, *w_out_c, *w_up, *w_down;
    float* out;
    bf16 *Wab, *Woab, *Wup0, *Wdn0, *Winc, *Woc, *Wup1, *Wdn1;
    bf16 *XB, *CAT, *R1;
    float* SSQ; unsigned* MASK;
};
__device__ __forceinline__ float bf2f(bf16 v) { return __builtin_bit_cast(float, (unsigned)v << 16); }
__device__ __forceinline__ float wave_sum(float v) {
#pragma unroll
    for (int o = 1; o < 64; o <<= 1) v += __shfl_xor(v, o);
    return v;
}
__device__ __forceinline__ float wave_max(float v) {
#pragma unroll
    for (int o = 1; o < 64; o <<= 1) v = fmaxf(v, __shfl_xor(v, o));
    return v;
}
__device__ __forceinline__ float log_sigmoid(float x) { return fminf(x, 0.f) - log1pf(expf(-fabsf(x))); }

__device__ __forceinline__ int oldcol_ab(int n) {
    if (n < 2048) return n;
    if (n < 2304) return 2120 + (n - 2048);
    if (n < 2560) return 2376 + (n - 2304);
    if (n < 3072) return 2632 + (n - 2560);
    if (n < 3584) return 3160 + (n - 3072);
    if (n < 3648) return 2048 + (n - 3584);
    if (n < 3656) return 2112 + (n - 3648);
    if (n < 3672) return 3144 + (n - 3656);
    return -1;
}
__device__ __forceinline__ void p0_transpose_item(const float* W, int ldw, int K, const float* gain, bf16* WT, bool map, LAS float* scr, int item, int nblk, int lane) {
    const int kb = item / nblk, nb = item % nblk, k0 = 64 * kb, n0 = 32 * nb;
    int oc = n0 + (lane & 31); if (map) oc = oldcol_ab(oc);
#pragma unroll 8
    for (int i = 0; i < 32; ++i) { const int kk = 2 * i + (lane >> 5); float v = 0.f;
        if (oc >= 0) { v = W[(size_t)(k0 + kk) * ldw + oc]; if (gain) v *= gain[k0 + kk]; }
        scr[kk * 33 + (lane & 31)] = v; }
    LDS_WAIT(); asm volatile("" ::: "memory");
    const int c = lane & 7;
#pragma unroll
    for (int j = 0; j < 4; ++j) { const int n = (lane >> 3) + 8 * j; const LAS float* s = scr + (8 * c) * 33 + n;
        v4u o; o.x = pk2(s[0 * 33], s[1 * 33]); o.y = pk2(s[2 * 33], s[3 * 33]); o.z = pk2(s[4 * 33], s[5 * 33]); o.w = pk2(s[6 * 33], s[7 * 33]);
        *(GAS v4u*)(WT + (size_t)(n0 + n) * K + k0 + 8 * c) = o; }
    LDS_WAIT(); asm volatile("" ::: "memory");
}
__device__ __forceinline__ void ph_prologue(Frame& F) {
    LAS float* scr = (LAS float*)(F.lds + F.wave * 16384);
    const int gw = F.vcu * NWAVES + F.wave, NGW = F.G * NWAVES;
    constexpr int I_AB = (D / 64) * (NAB / 32), I_O = (D / 64) * (D / 32), I_UP = (D / 64) * (FF / 32), I_DN = (FF / 64) * (D / 32), I_C = (D / 64) * (NC / 32);
    constexpr int NITEMS = I_AB + 2 * I_O + 2 * I_UP + 2 * I_DN + I_C;
    for (int it = gw; it < NITEMS; it += NGW) {
        int r = it;
        if (r < I_AB) { p0_transpose_item(F.w_in_ab, ABP_OLD, D, F.g_mix, F.Wab, true, scr, r, NAB / 32, F.lane); continue; } r -= I_AB;
        if (r < I_O) { p0_transpose_item(F.w_out_ab, D, D, nullptr, F.Woab, false, scr, r, D / 32, F.lane); continue; } r -= I_O;
        if (r < I_UP) { p0_transpose_item(F.w_up, FF, D, F.g_ffn, F.Wup0, false, scr, r, FF / 32, F.lane); continue; } r -= I_UP;
        if (r < I_DN) { p0_transpose_item(F.w_down, D, FF, nullptr, F.Wdn0, false, scr, r, D / 32, F.lane); continue; } r -= I_DN;
        if (r < I_C) { p0_transpose_item(F.w_in_c, NC, D, F.g_mix + D, F.Winc, false, scr, r, NC / 32, F.lane); continue; } r -= I_C;
        if (r < I_O) { p0_transpose_item(F.w_out_c, D, D, nullptr, F.Woc, false, scr, r, D / 32, F.lane); continue; } r -= I_O;
        if (r < I_UP) { p0_transpose_item(F.w_up + (size_t)D * FF, FF, D, F.g_ffn + D, F.Wup1, false, scr, r, FF / 32, F.lane); continue; } r -= I_UP;
        p0_transpose_item(F.w_down + (size_t)FF * D, D, FF, nullptr, F.Wdn1, false, scr, r, D / 32, F.lane);
    }
    for (int m = gw; m < M; m += NGW) {
        const GAS f32x4* xr = (const GAS f32x4*)(F.x + (size_t)m * D) + F.lane;
        f32x4 v[4]; float s = 0.f;
#pragma unroll
        for (int j = 0; j < 4; ++j) { v[j] = xr[64 * j]; s += (v[j].x * v[j].x + v[j].y * v[j].y) + (v[j].z * v[j].z + v[j].w * v[j].w); }
        s = wave_sum(s);
        GAS unsigned long long* o8 = (GAS unsigned long long*)(F.XB + (size_t)m * D) + F.lane;
#pragma unroll
        for (int j = 0; j < 4; ++j) o8[64 * j] = (unsigned long long)pk2(v[j].x, v[j].y) | ((unsigned long long)pk2(v[j].z, v[j].w) << 32);
        if (F.lane < 16) F.SSQ[(size_t)m * 16 + F.lane] = (F.lane == 0) ? s : 0.f;
    }
}
__device__ __forceinline__ void ph_prep_a(Frame& F) {
    const int gw = F.vcu * NWAVES + F.wave, NGW = F.G * NWAVES, lane = F.lane;
    for (int tok = gw; tok < M; tok += NGW) {
        const float pos = (float)(tok & (SEQ - 1));
        bf16* pr = F.R1 + (size_t)tok * NAB;
        float c128 = 1.f, s128 = 0.f;
        if (lane < 32) { const int i = lane & 15; const float inv = powf(500000.0f, -(float)i * 2.0f / 32.0f); const float ang = pos * inv; c128 = cosf(ang); s128 = sinf(ang); }
#pragma unroll
        for (int which = 0; which < 2; ++which) {
            const int base = which == 0 ? C_QA : C_KA;
            const float* gn = which == 0 ? F.gq_a : F.gk_a;
            for (int h = 0; h < 4; ++h) {
                float a = bf2f(pr[base + h * 128 + lane]), b = bf2f(pr[base + h * 128 + 64 + lane]);
                const float ss = wave_sum(a * a + b * b);
                const float rs = rsqrtf(ss * (1.f / 128.f) + EPS);
                a = a * rs * gn[lane]; b = b * rs * gn[64 + lane];
                const float other = __shfl_xor(a, 16);
                float o = a;
                if (lane < 16) o = a * c128 - other * s128;
                else if (lane < 32) o = a * c128 + other * s128;
                pr[base + h * 128 + lane] = (bf16)f2bf(o); pr[base + h * 128 + 64 + lane] = (bf16)f2bf(b);
            }
        }
        float c64 = 1.f, s64 = 0.f;
        if (lane < 16) { const int i = lane & 7; const float inv = powf(500000.0f, -(float)i * 2.0f / 16.0f); const float ang = pos * inv; c64 = cosf(ang); s64 = sinf(ang); }
        for (int h = 0; h < 9; ++h) {
            const int col = (h < 8) ? C_IQ + h * 64 : C_IK;
            const float a = bf2f(pr[col + lane]);
            const float other = __shfl_xor(a, 8);
            float o = a;
            if (lane < 8) o = a * c64 - other * s64;
            else if (lane < 16) o = a * c64 + other * s64;
            pr[col + lane] = (bf16)f2bf(o);
        }
    }
}
__device__ __forceinline__ void ph_indexer_naive(Frame& F) {
    LAS float* sc = (LAS float*)F.lds;
    LAS float* qv = sc + 2048;
    LAS float* wv = qv + 512;
    LAS unsigned* mw = (LAS unsigned*)(wv + 8);
    const int tid = F.tid;
    for (int tok = F.vcu; tok < M; tok += F.G) {
        const int pos = tok & (SEQ - 1), seq0 = tok - pos, limit = ((pos >> 6) + 1) << 6;
        const bf16* pr = F.R1 + (size_t)tok * NAB;
        qv[tid] = bf2f(pr[C_IQ + tid]);
        if (tid < 8) wv[tid] = bf2f(pr[C_IW + tid]) * 0.35355339059327373f;
        if (tid < 64) mw[tid] = 0u;
        __syncthreads();
        for (int s = tid; s < limit; s += NTHR) {
            const bf16* kp = F.R1 + (size_t)(seq0 + s) * NAB + C_IK;
            float acc[8];
#pragma unroll
            for (int h = 0; h < 8; ++h) acc[h] = 0.f;
            for (int d = 0; d < 64; ++d) { const float kd = bf2f(kp[d]);
#pragma unroll
                for (int h = 0; h < 8; ++h) acc[h] = fmaf(qv[h * 64 + d], kd, acc[h]); }
            float score = 0.f;
#pragma unroll
            for (int h = 0; h < 8; ++h) score += fmaxf(acc[h] * 0.125f, 0.f) * wv[h];
            sc[s] = score;
        }
        __syncthreads();
        if (limit <= 256) { if (tid < 64) mw[tid] = (tid * 32 < limit) ? 0xffffffffu : 0u; }
        else {
            for (int s = tid; s < limit; s += NTHR) {
                const float v = sc[s]; int cnt = 0;
                for (int j = 0; j < limit; ++j) { const float u = sc[j]; cnt += ((u > v) || (u == v && j < s)) ? 1 : 0; }
                if (cnt < 256) atomicOr((unsigned*)&mw[s >> 5], 1u << (s & 31));
            }
        }
        __syncthreads();
        if (tid < 64) F.MASK[(size_t)tok * 64 + tid] = mw[tid];
        __syncthreads();
    }
}
__device__ __forceinline__ float block_sum(float v, LAS float* red, int tid) {
    v = wave_sum(v);
    __syncthreads();
    if ((tid & 63) == 0) red[tid >> 6] = v;
    __syncthreads();
    float r = 0.f;
#pragma unroll
    for (int i = 0; i < NWAVES; ++i) r += red[i];
    return r;
}
__device__ __forceinline__ float block_max(float v, LAS float* red, int tid) {
    v = wave_max(v);
    __syncthreads();
    if ((tid & 63) == 0) red[tid >> 6] = v;
    __syncthreads();
    float r = red[0];
#pragma unroll
    for (int i = 1; i < NWAVES; ++i) r = fmaxf(r, red[i]);
    return r;
}
__device__ __forceinline__ void ph_dsa_naive(Frame& F) {
    LAS unsigned* mw = (LAS unsigned*)F.lds;
    LAS int* pre = (LAS int*)(mw + 64);
    LAS int* idx = pre + 128;
    LAS float* pp = (LAS float*)(idx + 256);
    LAS float* q = pp + 512;
    LAS float* red = q + 512;
    const int tid = F.tid;
    for (int tok = F.vcu; tok < M; tok += F.G) {
        const int pos = tok & (SEQ - 1), seq0 = tok - pos;
        if (tid < 64) mw[tid] = F.MASK[(size_t)tok * 64 + tid];
        q[tid] = bf2f(F.R1[(size_t)tok * NAB + C_QA + tid]);
        __syncthreads();
        if (tid == 0) { int a = 0; for (int w = 0; w < 64; ++w) { pre[w] = a; a += __popc(mw[w]); } pre[64] = a; }
        __syncthreads();
        const int n = pre[64];
        for (int s = tid; s < SEQ; s += NTHR) { const unsigned w = mw[s >> 5]; if ((w >> (s & 31)) & 1u) idx[pre[s >> 5] + __popc(w & ((1u << (s & 31)) - 1u))] = s; }
        __syncthreads();
        for (int h = 0; h < 4; ++h) {
            float sv = -INFINITY;
            if (tid < n) { const bf16* kp = F.R1 + (size_t)(seq0 + idx[tid]) * NAB + C_KA + h * 128; float a = 0.f;
                for (int d = 0; d < 128; ++d) a = fmaf(q[h * 128 + d], bf2f(kp[d]), a);
                sv = a * 0.08838834764831845f; }
            const float m = block_max(sv, red, tid);
            const float e = (tid < n) ? expf(sv - m) : 0.f;
            const float l = block_sum(e, red, tid);
            pp[tid] = e;
            __syncthreads();
            if (tid < 128) { float o = 0.f;
                for (int j = 0; j < n; ++j) o = fmaf(pp[j], bf2f(F.R1[(size_t)(seq0 + idx[j]) * NAB + C_VA + h * 128 + tid]), o);
                F.CAT[(size_t)tok * D + h * 128 + tid] = (bf16)f2bf(o / l); }
            __syncthreads();
        }
    }
}
__device__ __forceinline__ void ph_gla_naive(Frame& F) {
    LAS float* sq = (LAS float*)F.lds; LAS float* sk = sq + 1024; LAS float* sd = sk + 1024;
    LAS float* sg = sd + 1024;
    LAS float* red = sg + 256;
    const int tid = F.tid, lane = F.lane;
    for (int item = F.vcu; item < BATCH * 4; item += F.G) {
        const int b = item >> 2, h = item & 3, seq0 = b * SEQ;
        float S[64];
#pragma unroll
        for (int d = 0; d < 64; ++d) S[d] = 0.f;
        for (int t0 = 0; t0 < SEQ; t0 += 16) {
            if (tid < 256) { const int tt = tid >> 4, r = tid & 15; sg[tid] = bf2f(F.R1[(size_t)(seq0 + t0 + tt) * NAB + C_GL + r]); }
            __syncthreads();
            for (int i = tid; i < 1024; i += NTHR) { const int tt = i >> 6, d = i & 63; const bf16* pr = F.R1 + (size_t)(seq0 + t0 + tt) * NAB;
                sq[i] = bf2f(pr[C_QB + h * 64 + d]) * 0.125f; sk[i] = bf2f(pr[C_KB + h * 64 + d]);
                float g = F.b_gate[h * 64 + d];
#pragma unroll
                for (int r = 0; r < 16; ++r) g = fmaf(sg[tt * 16 + r], F.w_gate_up[r * 256 + h * 64 + d], g);
                sd[i] = expf(log_sigmoid(g) * (1.f / 16.f)); }
            __syncthreads();
            float o[16];
            if (tid < 128) {
#pragma unroll
                for (int tt = 0; tt < 16; ++tt) {
                    const float v = bf2f(F.R1[(size_t)(seq0 + t0 + tt) * NAB + C_VB + h * 128 + tid]); float a = 0.f;
#pragma unroll
                    for (int d = 0; d < 64; ++d) { S[d] = fmaf(sd[tt * 64 + d], S[d], sk[tt * 64 + d] * v); a = fmaf(sq[tt * 64 + d], S[d], a); }
                    o[tt] = a;
                    const float ws = wave_sum(a * a);
                    if (lane == 0) red[tt * 2 + (tid >> 6)] = ws;
                }
            }
            __syncthreads();
            if (tid < 128) {
#pragma unroll
                for (int tt = 0; tt < 16; ++tt) {
                    const size_t tok = seq0 + t0 + tt;
                    const float rs = rsqrtf((red[tt * 2] + red[tt * 2 + 1]) * (1.f / 128.f) + EPS);
                    const float og = bf2f(F.R1[tok * NAB + C_OG + h * 128 + tid]);
                    F.CAT[tok * D + 512 + h * 128 + tid] = (bf16)f2bf(o[tt] * rs * F.g_gla[tid] * (og / (1.f + expf(-og))));
                }
            }
            __syncthreads();
        }
    }
}
__device__ __forceinline__ void ph_prep_c(Frame& F) {
    const int gw = F.vcu * NWAVES + F.wave, NGW = F.G * NWAVES, lane = F.lane;
    for (int it = gw; it < M * 16; it += NGW) {
        const int tok = it >> 4, hh = it & 15, isk = hh >> 3, h = hh & 7;
        bf16* p = F.R1 + (size_t)tok * NC + isk * 1024 + h * 128;
        const float* gn = isk ? F.gk_c : F.gq_c;
        const float a = bf2f(p[lane]), b = bf2f(p[64 + lane]);
        const float rs = rsqrtf(wave_sum(a * a + b * b) * (1.f / 128.f) + EPS);
        p[lane] = (bf16)f2bf(a * rs * gn[lane]); p[64 + lane] = (bf16)f2bf(b * rs * gn[64 + lane]);
    }
}
__device__ __forceinline__ void ph_sb_naive(Frame& F) {
    const int gw = F.vcu * NWAVES + F.wave, NGW = F.G * NWAVES, lane = F.lane;
    for (int it = gw; it < M * 8; it += NGW) {
        const int tok = it >> 3, h = it & 7, pos = tok & (SEQ - 1), seq0 = tok - pos;
        const unsigned qq = *(const unsigned*)(F.R1 + (size_t)tok * NC + h * 128 + 2 * lane);
        const float q0 = __builtin_bit_cast(float, qq << 16), q1 = __builtin_bit_cast(float, qq & 0xffff0000u);
        float R = 0.f, o0 = 0.f, o1 = 0.f;
        for (int s = pos - 1; s >= 0; --s) {
            const bf16* pr = F.R1 + (size_t)(seq0 + s) * NC + h * 128 + 2 * lane;
            const unsigned kk = *(const unsigned*)(pr + 1024), vv = *(const unsigned*)(pr + 2048);
            const float k0 = __builtin_bit_cast(float, kk << 16), k1 = __builtin_bit_cast(float, kk & 0xffff0000u);
            const float z = wave_sum(q0 * k0 + q1 * k1) * 0.08838834764831845f;
            const float sp = log1pf(expf(-fabsf(z)));
            const float lsp = fminf(z, 0.f) - sp, lsn = fminf(-z, 0.f) - sp;
            const float a = expf(lsp + R);
            o0 = fmaf(a, __builtin_bit_cast(float, vv << 16), o0); o1 = fmaf(a, __builtin_bit_cast(float, vv & 0xffff0000u), o1);
            R += lsn;
        }
        *(unsigned*)(F.CAT + (size_t)tok * D + h * 128 + 2 * lane) = pk2(o0, o1);
    }
}
#ifndef MK_PER_PHASE
#define MK_PER_PHASE 0
#endif
constexpr int NPH = 14;
struct Args { const float* in[16]; float* out; unsigned char* ws; int ph_lo, ph_hi; };
__global__ void __launch_bounds__(NTHR, 2) mk_fwd(Args args) {
    extern __shared__ __attribute__((aligned(16))) unsigned char lds[];
    Frame F;
    F.lds = (LAS unsigned char*)lds;
    F.MISC = (volatile LAS unsigned*)(F.lds + MISC_OFF);
    F.tid = threadIdx.x; F.lane = F.tid & 63; F.wave = __builtin_amdgcn_readfirstlane(F.tid >> 6);
    F.G = gridDim.x; { const int bx = blockIdx.x; F.vcu = (F.G % 8 == 0) ? (bx % 8) * (F.G / 8) + bx / 8 : bx; }
    unsigned char* ws = args.ws;
    F.ctl = (gu32*)(ws + WS_CTL);
    F.x = args.in[0]; F.g_mix = args.in[1]; F.g_ffn = args.in[2]; F.w_in_ab = args.in[3]; F.gq_a = args.in[4]; F.gk_a = args.in[5]; F.w_gate_up = args.in[6]; F.b_gate = args.in[7];
    F.g_gla = args.in[8]; F.w_out_ab = args.in[9]; F.w_in_c = args.in[10]; F.gq_c = args.in[11]; F.gk_c = args.in[12]; F.w_out_c = args.in[13]; F.w_up = args.in[14]; F.w_down = args.in[15];
    F.out = args.out;
    F.Wab = (bf16*)(ws + WS_WAB); F.Woab = (bf16*)(ws + WS_WOAB); F.Wup0 = (bf16*)(ws + WS_WUP0); F.Wdn0 = (bf16*)(ws + WS_WDN0);
    F.Winc = (bf16*)(ws + WS_WINC); F.Woc = (bf16*)(ws + WS_WOC); F.Wup1 = (bf16*)(ws + WS_WUP1); F.Wdn1 = (bf16*)(ws + WS_WDN1);
    F.XB = (bf16*)(ws + WS_XB); F.CAT = (bf16*)(ws + WS_CAT); F.R1 = (bf16*)(ws + WS_R1); F.SSQ = (float*)(ws + WS_SSQ); F.MASK = (unsigned*)(ws + WS_MASK);
    for (int u = F.tid; u < (LDS_BYTES - MISC_OFF) / 4; u += NTHR) ((LAS unsigned*)(F.lds + MISC_OFF))[u] = 0u;
    __syncthreads();
    XcdBarrier bar; bar.bar = (unsigned*)(F.ctl + CW_BAR); bar.x = 0; bar.st = nullptr;
    if (!MK_PER_PHASE) bar = xcd_barrier_post((unsigned*)(F.ctl + CW_BAR), F.MISC + 8);
    const int lo = args.ph_lo, hi = args.ph_hi;
#define IN(k) (lo <= (k) && (k) < hi)
#define SEAM(k) do { if (IN(k) && IN((k) + 1)) xcd_barrier(bar); } while (0)
    float* const SSQ0 = F.SSQ, *SSQ1 = F.SSQ + (size_t)M * 16, *SSQ2 = F.SSQ + (size_t)2 * M * 16, *SSQ3 = F.SSQ + (size_t)3 * M * 16;
    typedef pg8::StaticOrder SO;
    if (IN(0)) { ph_prologue(F); } SEAM(0);
    if (IN(1)) { pg8::Gemm g{F.XB, F.Wab, M, NAB, D}; SO S; S.init(M, NAB, F.G, (int)blockIdx.x); pg8::EpiScale<0> E{F.R1, NAB, SSQ0};
        pg8::gemm_phase<pg8::EpiScale<0>, SO, true, true>(F.lds, g, S, E); } SEAM(1);
    if (IN(2)) { ph_prep_a(F); } SEAM(2);
    if (IN(3)) { ph_indexer_naive(F); } SEAM(3);
    if (IN(4)) { ph_dsa_naive(F); __syncthreads(); ph_gla_naive(F); } SEAM(4);
    if (IN(5)) { pg8::Gemm g{F.CAT, F.Woab, M, D, D}; SO S; S.init(M, D, F.G, (int)blockIdx.x); pg8::EpiResid<1> E{F.x, F.out, F.XB, SSQ1};
        pg8::gemm_phase<pg8::EpiResid<1>, SO, true, true>(F.lds, g, S, E); } SEAM(5);
    if (IN(6)) { pg8::Gemm g{F.XB, F.Wup0, M, FF, D}; SO S; S.init(M, FF, F.G, (int)blockIdx.x); pg8::EpiScale<1> E{F.R1, FF, SSQ1};
        pg8::gemm_phase<pg8::EpiScale<1>, SO, true, true>(F.lds, g, S, E); } SEAM(6);
    if (IN(7)) { pg8::Gemm g{F.R1, F.Wdn0, M, D, FF}; SO S; S.init(M, D, F.G, (int)blockIdx.x); pg8::EpiResid<1> E{F.out, F.out, F.XB, SSQ2};
        pg8::gemm_phase<pg8::EpiResid<1>, SO, true, true>(F.lds, g, S, E); } SEAM(7);
    if (IN(8)) { pg8::Gemm g{F.XB, F.Winc, M, NC, D}; SO S; S.init(M, NC, F.G, (int)blockIdx.x); pg8::EpiScale<0> E{F.R1, NC, SSQ2};
        pg8::gemm_phase<pg8::EpiScale<0>, SO, true, true>(F.lds, g, S, E); } SEAM(8);
    if (IN(9)) { ph_prep_c(F); } SEAM(9);
    if (IN(10)) { ph_sb_naive(F); } SEAM(10);
    if (IN(11)) { pg8::Gemm g{F.CAT, F.Woc, M, D, D}; SO S; S.init(M, D, F.G, (int)blockIdx.x); pg8::EpiResid<1> E{F.out, F.out, F.XB, SSQ3};
        pg8::gemm_phase<pg8::EpiResid<1>, SO, true, true>(F.lds, g, S, E); } SEAM(11);
    if (IN(12)) { pg8::Gemm g{F.XB, F.Wup1, M, FF, D}; SO S; S.init(M, FF, F.G, (int)blockIdx.x); pg8::EpiScale<1> E{F.R1, FF, SSQ3};
        pg8::gemm_phase<pg8::EpiScale<1>, SO, true, true>(F.lds, g, S, E); } SEAM(12);
    if (IN(13)) { pg8::Gemm g{F.R1, F.Wdn1, M, D, FF}; SO S; S.init(M, D, F.G, (int)blockIdx.x); pg8::EpiResid<0> E{F.out, F.out, nullptr, nullptr};
        pg8::gemm_phase<pg8::EpiResid<0>, SO, true, true>(F.lds, g, S, E); }
#undef IN
#undef SEAM
}

extern "C" void kernel_launch(void* const* d_in, const int* in_sizes, int n_in, void* d_out, int out_size, void* d_ws, size_t ws_size, hipStream_t stream) {
    static int grid = 0;
    if (grid == 0) {
        if (n_in != 16 || in_sizes[0] != M * D || out_size != M * D || ws_size < WS_END) { fprintf(stderr, "kernel_launch: unexpected shapes / workspace (%d inputs, ws %zu)\n", n_in, ws_size); grid = -1; return; }
        int dev = 0, cus = 0;
        if (hipGetDevice(&dev) != hipSuccess || hipDeviceGetAttribute(&cus, hipDeviceAttributeMultiprocessorCount, dev) != hipSuccess) { grid = -1; return; }
        if (hipFuncSetAttribute((const void*)mk_fwd, hipFuncAttributeMaxDynamicSharedMemorySize, LDS_BYTES) != hipSuccess) { fprintf(stderr, "kernel_launch: hipFuncSetAttribute failed\n"); grid = -1; return; }
        (void)hipGetLastError();
        grid = cus;
    }
    if (grid < 0) return;
    if (hipMemsetAsync((char*)d_ws + WS_CTL, 0, CTL_ZERO_BYTES, stream) != hipSuccess) { fprintf(stderr, "kernel_launch: memset failed\n"); return; }
    Args a{};
    for (int i = 0; i < 16; ++i) a.in[i] = (const float*)d_in[i];
    a.out = (float*)d_out; a.ws = (unsigned char*)d_ws;
#if MK_PER_PHASE
    for (int ph = 0; ph < NPH; ++ph) { a.ph_lo = ph; a.ph_hi = ph + 1; hipLaunchKernelGGL(mk_fwd, dim3(grid), dim3(NTHR), LDS_BYTES, stream, a); }
#else
    a.ph_lo = 0; a.ph_hi = NPH;
    hipLaunchKernelGGL(mk_fwd, dim3(grid), dim3(NTHR), LDS_BYTES, stream, a);
#endif
    const hipError_t le = hipPeekAtLastError();
    if (le != hipSuccess) fprintf(stderr, "kernel_launch: launch failed: %s\n", hipGetErrorName(le));
}
```

```cpp
#include <hip/hip_runtime.h>
#include <cstdio>
#include <cstdint>
namespace pg8 {
#define PG8_LAS __attribute__((address_space(3)))
typedef unsigned short bf16_t;
typedef short bf16x8 __attribute__((ext_vector_type(8)));
typedef float f32x4 __attribute__((ext_vector_type(4)));
typedef unsigned u32x4 __attribute__((ext_vector_type(4)));
constexpr int BM = 256, BK = 64, HALF = 128, HTB = HALF * BK * 2  , STAGE_BYTES = 8 * HTB, NXCD = 8, WGM = 8;

__host__ __device__ __forceinline__ int lds_byte(int r, int c) { const int st = (r >> 4) * 2 + (c >> 5), rr = r & 15, cc = c & 31, ob = rr * 64 + cc * 2; return st * 1024 + (ob ^ (((ob >> 9) & 1) << 5)); }
__host__ __device__ __forceinline__ void stage_rc(int b, int& R, int& C) { const int st = b / 1024, sb = b % 1024, swz = sb ^ (((sb >> 9) & 1) << 5); R = (st >> 1) * 16 + swz / 64; C = (st & 1) * 32 + (swz % 64) / 2; }
__host__ __device__ __forceinline__ int perm32(int rho) { const int n = rho >> 4, i = rho & 15; return 8 * (i >> 2) + 4 * n + (i & 3); }

struct Unit { int pm, pn; };
struct Gemm { const bf16_t* A; const bf16_t* Bt; int M, N, K; };

struct StaticOrder {
    int nM, nN, nwg, G, c;
    __host__ __device__ void init(int M, int N, int G_, int c_) { nM = M / BM; nN = N / BM; nwg = nM * nN; G = G_; c = c_; }
    __host__ __device__ bool next(int i, Unit& u) const {
        const long L = (long)i * G + c; if (L >= nwg) return false;
        int wgid = (int)L; { const int q = nwg / NXCD, r = nwg % NXCD, xcd = wgid % NXCD, off = wgid / NXCD; wgid = (xcd < r ? xcd * (q + 1) : r * (q + 1) + (xcd - r) * q) + off; }
        const int nig = WGM * nN, gid = wgid / nig, fm = gid * WGM, gsz = (nM - fm) < WGM ? (nM - fm) : WGM;
        u.pm = fm + ((wgid % nig) % gsz); u.pn = (wgid % nig) / gsz; return true;
    }
    __device__ __forceinline__ void a_ready(const Unit&) const {}
    __device__ __forceinline__ void done(const Unit&) const {}
};

__device__ __forceinline__ unsigned cvt_pk_bf16(float lo, float hi) { unsigned r; asm volatile("v_cvt_pk_bf16_f32 %0, %1, %2" : "=v"(r) : "v"(lo), "v"(hi)); return r; }
__device__ __forceinline__ float row_rstd(const float* ssqp, int row) {
    const f32x4* p = (const f32x4*)(ssqp + (size_t)row * 16);
    const f32x4 a = p[0], b = p[1], c = p[2], d = p[3];
    const float s = (((a[0] + a[1]) + (a[2] + a[3])) + ((b[0] + b[1]) + (b[2] + b[3]))) + (((c[0] + c[1]) + (c[2] + c[3])) + ((d[0] + d[1]) + (d[2] + d[3])));
    return rsqrtf(s * (1.0f / 1024.0f) + 1e-6f);
}
template <int ACT  > struct EpiScale {
    static constexpr bool PERM = true, AFTER_DRAIN = false;
    bf16_t* O; int ldc; const float* ssqp;
    __device__ __forceinline__ void operator()(const f32x4 (&acc)[2][2][4][2], const Unit& u, int wr, int wc, int fr, int fq) const {
        const int row0 = u.pm * BM + wr * 64 + fr, col0 = u.pn * BM + wc * 32 + 8 * fq;
#pragma unroll
        for (int ai = 0; ai < 2; ++ai)
#pragma unroll
            for (int m = 0; m < 4; ++m) {
                const int row = row0 + ai * HALF + m * 16;
                const float rs = row_rstd(ssqp, row);
                bf16_t* rowp = O + (size_t)row * ldc + col0;
#pragma unroll
                for (int bj = 0; bj < 2; ++bj) {
                    f32x4 v0 = acc[ai][bj][m][0] * rs, v1 = acc[ai][bj][m][1] * rs;
                    if (ACT == 1) {
#pragma unroll
                        for (int e = 0; e < 4; ++e) { const float a0 = fmaxf(v0[e], 0.f), a1 = fmaxf(v1[e], 0.f); v0[e] = a0 * a0; v1[e] = a1 * a1; }
                    }
                    u32x4 w; w.x = cvt_pk_bf16(v0[0], v0[1]); w.y = cvt_pk_bf16(v0[2], v0[3]); w.z = cvt_pk_bf16(v1[0], v1[1]); w.w = cvt_pk_bf16(v1[2], v1[3]);
                    *(u32x4*)(rowp + bj * HALF) = w;
                }
            }
    }
};
template <int WRITE_HB> struct EpiResid {
    static constexpr bool PERM = true, AFTER_DRAIN = false;
    const float* R; float* out; bf16_t* hb; float* ssqp;
    __device__ __forceinline__ void operator()(const f32x4 (&acc)[2][2][4][2], const Unit& u, int wr, int wc, int fr, int fq) const {
        const int row0 = u.pm * BM + wr * 64 + fr, col0 = u.pn * BM + wc * 32 + 8 * fq;
#pragma unroll
        for (int ai = 0; ai < 2; ++ai)
#pragma unroll
            for (int m = 0; m < 4; ++m) {
                const int row = row0 + ai * HALF + m * 16;
                const size_t off = (size_t)row * 1024 + col0;
                float ss = 0.f;
#pragma unroll
                for (int bj = 0; bj < 2; ++bj) {
                    const f32x4 r0 = *(const f32x4*)(R + off + bj * HALF), r1 = *(const f32x4*)(R + off + bj * HALF + 4);
                    const f32x4 v0 = acc[ai][bj][m][0] + r0, v1 = acc[ai][bj][m][1] + r1;
                    *(f32x4*)(out + off + bj * HALF) = v0; *(f32x4*)(out + off + bj * HALF + 4) = v1;
                    if (WRITE_HB) {
                        u32x4 w; w.x = cvt_pk_bf16(v0[0], v0[1]); w.y = cvt_pk_bf16(v0[2], v0[3]); w.z = cvt_pk_bf16(v1[0], v1[1]); w.w = cvt_pk_bf16(v1[2], v1[3]);
                        *(u32x4*)(hb + off + bj * HALF) = w;
                        ss += ((v0[0] * v0[0] + v0[1] * v0[1]) + (v0[2] * v0[2] + v0[3] * v0[3])) + ((v1[0] * v1[0] + v1[1] * v1[1]) + (v1[2] * v1[2] + v1[3] * v1[3]));
                    }
                }
                if (WRITE_HB) { ss += __shfl_xor(ss, 16); ss += __shfl_xor(ss, 32); if (fq == 0) ssqp[(size_t)row * 16 + u.pn * 4 + wc] = ss; }
            }
    }
};
template <class Epi, class Sched, bool ALIGN_EPI = false, bool SP2 = false>
__device__ __forceinline__ void gemm_phase(PG8_LAS unsigned char* lds, const Gemm g, const Sched& S, const Epi& E) {
    const int tid = threadIdx.x, wid = __builtin_amdgcn_readfirstlane(tid >> 6), lane = tid & 63, wr = wid >> 2, wc = wid & 3, fr = lane & 15, fq = lane >> 4;
    const int K = g.K, nt = K / BK;
    unsigned voffA[2], voffB[2];
#pragma unroll
    for (int i = 0; i < 2; ++i) { int R, C; stage_rc(tid * 16 + i * 8192, R, C); const int Rb = Epi::PERM ? ((R & ~31) + perm32(R & 31)) : R;
        voffA[i] = (unsigned)(R * K + C) * 2u; voffB[i] = (unsigned)(Rb * K + C) * 2u; }
    const size_t kstep = (size_t)(BK * 2);
    const size_t hstep = (size_t)HALF * K * 2;
    const size_t tstep = 2 * hstep;
    const unsigned ldsw = (unsigned)wid * 1024u;
    const int aoff = lds_byte(wr * 64 + fr, fq * 8), boff = lds_byte(wc * 32 + fr, fq * 8);
#define PG8_SA(b, h) (((b) * 2 + (h)) * HTB)
#define PG8_SB(b, h) ((4 + (b) * 2 + (h)) * HTB)
#define PG8_STAGE(bufoff, gbase, voff) do { _Pragma("unroll") for (int _i = 0; _i < 2; ++_i) \
        __builtin_amdgcn_global_load_lds((const unsigned*)((const char*)(gbase) + (voff)[_i]), (PG8_LAS unsigned*)(lds + (bufoff) + ldsw + _i * 8192), 16, 0, 0); } while (0)
#define PG8_LDA(dst, b, h) do { _Pragma("unroll") for (int m = 0; m < 4; ++m) _Pragma("unroll") for (int k = 0; k < 2; ++k) dst[m][k] = *(const PG8_LAS bf16x8*)(lds + PG8_SA(b, h) + aoff + m * 2048 + k * 1024); } while (0)
#define PG8_LDB(dst, b, h) do { _Pragma("unroll") for (int n = 0; n < 2; ++n) _Pragma("unroll") for (int k = 0; k < 2; ++k) dst[n][k] = *(const PG8_LAS bf16x8*)(lds + PG8_SB(b, h) + boff + n * 2048 + k * 1024); } while (0)
#define PG8_MMA(ai, bj, At, Bt) do { __builtin_amdgcn_s_setprio(1); _Pragma("unroll") for (int m = 0; m < 4; ++m) _Pragma("unroll") for (int n = 0; n < 2; ++n) _Pragma("unroll") for (int k = 0; k < 2; ++k) \
        acc[ai][bj][m][n] = __builtin_amdgcn_mfma_f32_16x16x32_bf16(Bt[n][k], At[m][k], acc[ai][bj][m][n], 0, 0, 0); __builtin_amdgcn_s_setprio(0); } while (0)
#define PG8_WAIT_V(n) asm volatile("s_waitcnt vmcnt(" #n ")" ::: "memory")
#define PG8_WAIT_L(n) asm volatile("s_waitcnt lgkmcnt(" #n ")" ::: "memory")
#define PG8_BAR __builtin_amdgcn_s_barrier()
#define PG8_SCHED __builtin_amdgcn_sched_barrier(0)
    Unit cur, nxt; int ui = 0;
    if (!S.next(0, cur)) return;
    f32x4 acc[2][2][4][2];
#pragma unroll
    for (int a = 0; a < 2; ++a)
#pragma unroll
        for (int b = 0; b < 2; ++b)
#pragma unroll
            for (int m = 0; m < 4; ++m)
#pragma unroll
                for (int n = 0; n < 2; ++n) acc[a][b][m][n] = (f32x4){0.f, 0.f, 0.f, 0.f};
    bf16x8 At[4][2], B0[2][2], B1[2][2];
    const char* cA = (const char*)g.A + (size_t)cur.pm * tstep; const char* cB = (const char*)g.Bt + (size_t)cur.pn * tstep;
    S.a_ready(cur);
    if constexpr (SP2) {
        PG8_STAGE(PG8_SB(0, 0), cB, voffB); PG8_STAGE(PG8_SB(0, 1), cB + hstep, voffB); PG8_STAGE(PG8_SA(0, 0), cA, voffA); PG8_STAGE(PG8_SA(0, 1), cA + hstep, voffA);
        if (wr == 1) PG8_BAR;
        PG8_WAIT_V(2); PG8_BAR;
        PG8_STAGE(PG8_SB(1, 0), cB + kstep, voffB); PG8_STAGE(PG8_SA(1, 0), cA + kstep, voffA); PG8_STAGE(PG8_SB(1, 1), cB + hstep + kstep, voffB);
        PG8_WAIT_V(6); PG8_BAR;
    } else {
        PG8_STAGE(PG8_SB(0, 0), cB, voffB); PG8_STAGE(PG8_SA(0, 0), cA, voffA); PG8_STAGE(PG8_SB(0, 1), cB + hstep, voffB); PG8_STAGE(PG8_SA(0, 1), cA + hstep, voffA);
        if (wr == 1) PG8_BAR;
        PG8_WAIT_V(4); PG8_BAR;
        PG8_STAGE(PG8_SB(1, 0), cB + kstep, voffB); PG8_STAGE(PG8_SA(1, 0), cA + kstep, voffA); PG8_STAGE(PG8_SB(1, 1), cB + hstep + kstep, voffB);
        PG8_WAIT_V(6); PG8_BAR;
    }
    for (;;) {
        const bool has_next = S.next(ui + 1, nxt);
        const char* nA = has_next ? (const char*)g.A + (size_t)nxt.pm * tstep : cA; const char* nB = has_next ? (const char*)g.Bt + (size_t)nxt.pn * tstep : cB;
        for (int t = 0; t < nt; t += 2) {
            const bool last = (t == nt - 2);
            const char* a1 = cA + (size_t)(t + 1) * kstep;
            const char* a2 = last ? nA : cA + (size_t)(t + 2) * kstep; const char* b2 = last ? nB : cB + (size_t)(t + 2) * kstep;
            const char* a3 = a2 + kstep; const char* b3 = b2 + kstep;
            if (last && has_next) S.a_ready(nxt);
            if constexpr (SP2) {
            PG8_LDB(B0, 0, 0); PG8_LDB(B1, 0, 1); PG8_SCHED; PG8_LDA(At, 0, 0); PG8_STAGE(PG8_SA(1, 1), a1 + hstep, voffA);
            PG8_WAIT_V(8); PG8_WAIT_L(0); PG8_BAR; PG8_MMA(0, 0, At, B0); PG8_MMA(0, 1, At, B1); PG8_BAR; PG8_SCHED;
            PG8_LDA(At, 0, 1); PG8_STAGE(PG8_SB(0, 0), b2, voffB); PG8_STAGE(PG8_SB(0, 1), b2 + hstep, voffB); PG8_STAGE(PG8_SA(0, 0), a2, voffA);
            PG8_WAIT_V(8); PG8_WAIT_L(0); PG8_BAR; PG8_MMA(1, 0, At, B0); PG8_MMA(1, 1, At, B1); PG8_BAR; PG8_SCHED;
            PG8_LDB(B0, 1, 0); PG8_LDB(B1, 1, 1); PG8_SCHED; PG8_LDA(At, 1, 0); PG8_STAGE(PG8_SA(0, 1), a2 + hstep, voffA);
            PG8_WAIT_V(8); PG8_WAIT_L(0); PG8_BAR; PG8_MMA(0, 0, At, B0); PG8_MMA(0, 1, At, B1); PG8_BAR; PG8_SCHED;
            PG8_LDA(At, 1, 1); PG8_STAGE(PG8_SB(1, 0), b3, voffB); PG8_STAGE(PG8_SB(1, 1), b3 + hstep, voffB); PG8_STAGE(PG8_SA(1, 0), a3, voffA);
            PG8_WAIT_V(8); PG8_WAIT_L(0); PG8_BAR; PG8_MMA(1, 0, At, B0); PG8_MMA(1, 1, At, B1); PG8_BAR; PG8_SCHED;
            } else {
            PG8_LDB(B0, 0, 0); PG8_SCHED; PG8_LDA(At, 0, 0); PG8_STAGE(PG8_SA(1, 1), a1 + hstep, voffA);
            PG8_WAIT_L(8); PG8_BAR; PG8_WAIT_L(0); PG8_MMA(0, 0, At, B0); PG8_BAR; PG8_SCHED;
            PG8_LDB(B1, 0, 1); PG8_STAGE(PG8_SB(0, 0), b2, voffB);
            PG8_BAR; PG8_WAIT_L(0); PG8_MMA(0, 1, At, B1); PG8_BAR;
            PG8_LDA(At, 0, 1); PG8_STAGE(PG8_SA(0, 0), a2, voffA);
            PG8_BAR; PG8_WAIT_L(0); PG8_MMA(1, 0, At, B0); PG8_BAR; PG8_SCHED;
            PG8_STAGE(PG8_SB(0, 1), b2 + hstep, voffB);
            PG8_WAIT_V(6); PG8_BAR; PG8_MMA(1, 1, At, B1); PG8_BAR;
            PG8_LDB(B0, 1, 0); PG8_SCHED; PG8_LDA(At, 1, 0); PG8_STAGE(PG8_SA(0, 1), a2 + hstep, voffA);
            PG8_WAIT_L(8); PG8_BAR; PG8_WAIT_L(0); PG8_MMA(0, 0, At, B0); PG8_BAR; PG8_SCHED;
            PG8_LDB(B1, 1, 1); PG8_STAGE(PG8_SB(1, 0), b3, voffB);
            PG8_BAR; PG8_WAIT_L(0); PG8_MMA(0, 1, At, B1); PG8_BAR;
            PG8_LDA(At, 1, 1); PG8_STAGE(PG8_SA(1, 0), a3, voffA);
            PG8_BAR; PG8_WAIT_L(0); PG8_MMA(1, 0, At, B0); PG8_BAR; PG8_SCHED;
            PG8_STAGE(PG8_SB(1, 1), b3 + hstep, voffB);
            PG8_WAIT_V(6); PG8_BAR; PG8_MMA(1, 1, At, B1); PG8_BAR;
            }
        }
        if constexpr (ALIGN_EPI) { if (wr == 0) PG8_BAR; }
        if constexpr (!Epi::AFTER_DRAIN) { E(acc, cur, wr, wc, fr, fq); S.done(cur); }
        if (!has_next) break;
#pragma unroll
        for (int a = 0; a < 2; ++a)
#pragma unroll
            for (int b = 0; b < 2; ++b)
#pragma unroll
                for (int m = 0; m < 4; ++m)
#pragma unroll
                    for (int n = 0; n < 2; ++n) acc[a][b][m][n] = (f32x4){0.f, 0.f, 0.f, 0.f};
        cur = nxt; cA = nA; cB = nB; ++ui;
        if constexpr (ALIGN_EPI) { if (wr == 1) PG8_BAR; }
    }
    PG8_WAIT_V(0);
    if constexpr (!ALIGN_EPI) { if (wr == 0) PG8_BAR; }
    PG8_BAR;
    if constexpr (Epi::AFTER_DRAIN) { E.fused(acc, cur, wr, wc, fr, fq, lds, wid, lane); S.done(cur); }
#undef PG8_SA
#undef PG8_SB
#undef PG8_STAGE
#undef PG8_LDA
#undef PG8_LDB
#undef PG8_MMA
#undef PG8_WAIT_V
#undef PG8_WAIT_L
#undef PG8_BAR
#undef PG8_SCHED
}
}
#include <cmath>
constexpr int NWAVES = 8, NTHR = 512;
constexpr int BATCH = 16, SEQ = 2048, M = BATCH * SEQ, D = 1024, FF = 4096, NAB = 3840, NC = 3072, ABP_OLD = 3672;
constexpr int C_QA = 0, C_KA = 512, C_VA = 1024, C_IQ = 1536, C_QB = 2048, C_KB = 2304, C_VB = 2560, C_OG = 3072, C_IK = 3584, C_IW = 3648, C_GL = 3656;
constexpr float EPS = 1e-6f;
constexpr size_t MiB = 1u << 20;
constexpr size_t WS_CTL = 0, CTL_ZERO_BYTES = 1 * MiB;
constexpr size_t WS_WAB = 1 * MiB, WS_WOAB = 9 * MiB, WS_WUP0 = 11 * MiB, WS_WDN0 = 19 * MiB, WS_WINC = 27 * MiB, WS_WOC = 33 * MiB, WS_WUP1 = 35 * MiB, WS_WDN1 = 43 * MiB;
constexpr size_t WS_SSQ = 51 * MiB, SSQ_BYTES = 2 * MiB;
constexpr size_t WS_XB = 60 * MiB;
constexpr size_t WS_CAT = 124 * MiB;
constexpr size_t WS_MASK = 188 * MiB;
constexpr size_t WS_R1 = 196 * MiB;
constexpr size_t WS_END = 452 * MiB;
constexpr int CW_BAR = 4096;
constexpr int RING_BYTES = 131072;
constexpr int LDS_BYTES = 163840;
constexpr int MISC_OFF = LDS_BYTES - 256;
#define GAS __attribute__((address_space(1)))
#define LAS __attribute__((address_space(3)))
typedef unsigned short bf16;
typedef unsigned v4u __attribute__((ext_vector_type(4)));
typedef float f32x4 __attribute__((ext_vector_type(4)));
typedef short bf16x8 __attribute__((ext_vector_type(8)));
typedef GAS unsigned gu32;
typedef GAS unsigned long long gu64;
#define RLX_AGENT __ATOMIC_RELAXED, __HIP_MEMORY_SCOPE_AGENT
#define LDS_WAIT() asm volatile("s_waitcnt lgkmcnt(0)" ::: "memory")
#define VM_WAIT() asm volatile("s_waitcnt vmcnt(0)" ::: "memory")
__device__ __forceinline__ unsigned long long rt() { return __builtin_amdgcn_s_memrealtime(); }
__device__ __forceinline__ unsigned f2bf(float f) { unsigned u = __builtin_bit_cast(unsigned, f); return (u + 0x7fffu + ((u >> 16) & 1u)) >> 16; }
__device__ __forceinline__ unsigned pk2(float lo, float hi) { return f2bf(lo) | (f2bf(hi) << 16); }
#define XB_TMO      128
#define XB_XCNT(j)  (256  + 64 * (j))
#define XB_XSUB(j)  (1280 + 64 * (j))
#define XB_XGEN(j)  (2304 + 64 * (j))
#define XB_TOP      3328
#define XB_TOPGEN   3392
#define XCD_BAR_WORDS 3456
#define XB_SPIN_CAP (1u << 18)

__device__ __forceinline__ unsigned xb_ld(unsigned* p)              { return __hip_atomic_load(p, __ATOMIC_RELAXED, __HIP_MEMORY_SCOPE_AGENT); }
__device__ __forceinline__ unsigned xb_add(unsigned* p, unsigned v) { return __hip_atomic_fetch_add(p, v, __ATOMIC_RELAXED, __HIP_MEMORY_SCOPE_AGENT); }
__device__ __forceinline__ unsigned xb_xcc_id() { return (unsigned)__builtin_amdgcn_s_getreg((3 << 11) | 20) & 0xFu; }
#define XB_SPIN(cond, bar) do { unsigned _sp = 0; while (cond) { __builtin_amdgcn_s_sleep(1); \
    if ((++_sp & 255u) == 0u) { if (xb_ld(&(bar)[XB_TMO])) break; if (_sp > XB_SPIN_CAP) { atomicAdd(&(bar)[XB_TMO], 1u); break; } } } } while (0)

struct XcdBarrier {
    unsigned* bar; unsigned x;
    volatile LAS unsigned* st;
};

__device__ __forceinline__ XcdBarrier xcd_barrier_post(unsigned* bar, volatile LAS unsigned* st) {
    XcdBarrier b; b.bar = bar; b.x = xb_xcc_id(); b.st = st;
    if (threadIdx.x == 0) (void)xb_add(&bar[XB_XCNT(b.x)], 1u);
    return b;
}
__device__ __forceinline__ void xcd_barrier_complete(unsigned* bar, unsigned x, unsigned& nloc, unsigned& nx) {
    const unsigned G = gridDim.x * gridDim.y * gridDim.z;
    unsigned sum, cnt, mine, sp = 0u;
    for (;;) {
        sum = 0u; cnt = 0u; mine = 0u;
#pragma unroll
        for (unsigned j = 0; j < 16; ++j) { const unsigned c = xb_ld(&bar[XB_XCNT(j)]); sum += c; cnt += (c > 0u) ? 1u : 0u; mine = (j == x) ? c : mine; }
        if (sum == G) break;
        __builtin_amdgcn_s_sleep(1);
        if ((++sp & 255u) == 0u) { if (xb_ld(&bar[XB_TMO])) break; if (sp > XB_SPIN_CAP) { atomicAdd(&bar[XB_TMO], 1u); break; } }
    }
    nloc = mine > 0u ? mine : 1u; nx = cnt > 0u ? cnt : 1u;
}

__device__ __forceinline__ void xcd_barrier(const XcdBarrier& b) {
    asm volatile("s_waitcnt vmcnt(0)" ::: "memory");
    __syncthreads();
    if (threadIdx.x == 0) {
        unsigned* bar = b.bar;
        __builtin_amdgcn_s_waitcnt(0);
        unsigned nloc = b.st[0], nx = b.st[1];
        if (nloc == 0u) { xcd_barrier_complete(bar, b.x, nloc, nx); b.st[0] = nloc; b.st[1] = nx; }
        const unsigned old = xb_add(&bar[XB_XSUB(b.x)], 1u);
        const unsigned gen = old / nloc;
        if (old + 1u == (gen + 1u) * nloc) {
            __builtin_amdgcn_fence(__ATOMIC_RELEASE, "agent");
            asm volatile("s_waitcnt vmcnt(0)" ::: "memory");
            const unsigned og = xb_add(&bar[XB_TOP], 1u);
            const unsigned tg = og / nx;
            if (og + 1u == (tg + 1u) * nx) xb_add(&bar[XB_TOPGEN], 1u);
            else XB_SPIN(xb_ld(&bar[XB_TOPGEN]) == tg, bar);
            __builtin_amdgcn_fence(__ATOMIC_ACQUIRE, "agent");
            xb_add(&bar[XB_XGEN(b.x)], 1u);
            asm volatile("s_waitcnt vmcnt(0)" ::: "memory");
        } else {
            XB_SPIN(xb_ld(&bar[XB_XGEN(b.x)]) == gen, bar);
            __builtin_amdgcn_fence(__ATOMIC_ACQUIRE, "agent");
            asm volatile("s_waitcnt vmcnt(0)" ::: "memory");
        }
    }
    __syncthreads();
}
struct Frame {
    LAS unsigned char* lds;
    volatile LAS unsigned* MISC;
    gu32* ctl;
    int tid, lane, wave, vcu, G;
    const float *x, *g_mix, *g_ffn, *w_in_ab, *gq_a, *gk_a, *w_gate_up, *b_gate, *g_gla, *w_out_ab, *w_in_c, *gq_c, *gk_c, *w_out_c, *w_up, *w_down;
    float* out;
    bf16 *Wab, *Woab, *Wup0, *Wdn0, *Winc, *Woc, *Wup1, *Wdn1;
    bf16 *XB, *CAT, *R1;
    float* SSQ; unsigned* MASK;
};
__device__ __forceinline__ float bf2f(bf16 v) { return __builtin_bit_cast(float, (unsigned)v << 16); }
__device__ __forceinline__ float wave_sum(float v) {
#pragma unroll
    for (int o = 1; o < 64; o <<= 1) v += __shfl_xor(v, o);
    return v;
}
__device__ __forceinline__ float wave_max(float v) {
#pragma unroll
    for (int o = 1; o < 64; o <<= 1) v = fmaxf(v, __shfl_xor(v, o));
    return v;
}
__device__ __forceinline__ float log_sigmoid(float x) { return fminf(x, 0.f) - log1pf(expf(-fabsf(x))); }

__device__ __forceinline__ int oldcol_ab(int n) {
    if (n < 2048) return n;
    if (n < 2304) return 2120 + (n - 2048);
    if (n < 2560) return 2376 + (n - 2304);
    if (n < 3072) return 2632 + (n - 2560);
    if (n < 3584) return 3160 + (n - 3072);
    if (n < 3648) return 2048 + (n - 3584);
    if (n < 3656) return 2112 + (n - 3648);
    if (n < 3672) return 3144 + (n - 3656);
    return -1;
}
__device__ __forceinline__ void p0_transpose_item(const float* W, int ldw, int K, const float* gain, bf16* WT, bool map, LAS float* scr, int item, int nblk, int lane) {
    const int kb = item / nblk, nb = item % nblk, k0 = 64 * kb, n0 = 32 * nb;
    int oc = n0 + (lane & 31); if (map) oc = oldcol_ab(oc);
#pragma unroll 8
    for (int i = 0; i < 32; ++i) { const int kk = 2 * i + (lane >> 5); float v = 0.f;
        if (oc >= 0) { v = W[(size_t)(k0 + kk) * ldw + oc]; if (gain) v *= gain[k0 + kk]; }
        scr[kk * 33 + (lane & 31)] = v; }
    LDS_WAIT(); asm volatile("" ::: "memory");
    const int c = lane & 7;
#pragma unroll
    for (int j = 0; j < 4; ++j) { const int n = (lane >> 3) + 8 * j; const LAS float* s = scr + (8 * c) * 33 + n;
        v4u o; o.x = pk2(s[0 * 33], s[1 * 33]); o.y = pk2(s[2 * 33], s[3 * 33]); o.z = pk2(s[4 * 33], s[5 * 33]); o.w = pk2(s[6 * 33], s[7 * 33]);
        *(GAS v4u*)(WT + (size_t)(n0 + n) * K + k0 + 8 * c) = o; }
    LDS_WAIT(); asm volatile("" ::: "memory");
}
__device__ __forceinline__ void ph_prologue(Frame& F) {
    LAS float* scr = (LAS float*)(F.lds + F.wave * 16384);
    const int gw = F.vcu * NWAVES + F.wave, NGW = F.G * NWAVES;
    constexpr int I_AB = (D / 64) * (NAB / 32), I_O = (D / 64) * (D / 32), I_UP = (D / 64) * (FF / 32), I_DN = (FF / 64) * (D / 32), I_C = (D / 64) * (NC / 32);
    constexpr int NITEMS = I_AB + 2 * I_O + 2 * I_UP + 2 * I_DN + I_C;
    for (int it = gw; it < NITEMS; it += NGW) {
        int r = it;
        if (r < I_AB) { p0_transpose_item(F.w_in_ab, ABP_OLD, D, F.g_mix, F.Wab, true, scr, r, NAB / 32, F.lane); continue; } r -= I_AB;
        if (r < I_O) { p0_transpose_item(F.w_out_ab, D, D, nullptr, F.Woab, false, scr, r, D / 32, F.lane); continue; } r -= I_O;
        if (r < I_UP) { p0_transpose_item(F.w_up, FF, D, F.g_ffn, F.Wup0, false, scr, r, FF / 32, F.lane); continue; } r -= I_UP;
        if (r < I_DN) { p0_transpose_item(F.w_down, D, FF, nullptr, F.Wdn0, false, scr, r, D / 32, F.lane); continue; } r -= I_DN;
        if (r < I_C) { p0_transpose_item(F.w_in_c, NC, D, F.g_mix + D, F.Winc, false, scr, r, NC / 32, F.lane); continue; } r -= I_C;
        if (r < I_O) { p0_transpose_item(F.w_out_c, D, D, nullptr, F.Woc, false, scr, r, D / 32, F.lane); continue; } r -= I_O;
        if (r < I_UP) { p0_transpose_item(F.w_up + (size_t)D * FF, FF, D, F.g_ffn + D, F.Wup1, false, scr, r, FF / 32, F.lane); continue; } r -= I_UP;
        p0_transpose_item(F.w_down + (size_t)FF * D, D, FF, nullptr, F.Wdn1, false, scr, r, D / 32, F.lane);
    }
    for (int m = gw; m < M; m += NGW) {
        const GAS f32x4* xr = (const GAS f32x4*)(F.x + (size_t)m * D) + F.lane;
        f32x4 v[4]; float s = 0.f;
#pragma unroll
        for (int j = 0; j < 4; ++j) { v[j] = xr[64 * j]; s += (v[j].x * v[j].x + v[j].y * v[j].y) + (v[j].z * v[j].z + v[j].w * v[j].w); }
        s = wave_sum(s);
        GAS unsigned long long* o8 = (GAS unsigned long long*)(F.XB + (size_t)m * D) + F.lane;
#pragma unroll
        for (int j = 0; j < 4; ++j) o8[64 * j] = (unsigned long long)pk2(v[j].x, v[j].y) | ((unsigned long long)pk2(v[j].z, v[j].w) << 32);
        if (F.lane < 16) F.SSQ[(size_t)m * 16 + F.lane] = (F.lane == 0) ? s : 0.f;
    }
}
namespace att {
typedef short s16x4 __attribute__((ext_vector_type(4)));
typedef float f32x16 __attribute__((ext_vector_type(16)));
typedef _Float16 f16x8 __attribute__((ext_vector_type(8)));
typedef unsigned u32x4 __attribute__((ext_vector_type(4)));
typedef short v4i16_t __attribute__((ext_vector_type(4)));
constexpr float C2 = 0.08838834764831845f * 1.4426950408889634f;
__device__ __forceinline__ int crow(int r, int hi) { return (r & 3) + 8 * (r >> 2) + 4 * hi; }
__device__ __forceinline__ int img_off(int row, int ch) { return 256 * row + 16 * (ch ^ (((row & 3) << 2) | ((row >> 2) & 3))); }
__device__ __forceinline__ bf16x8 pack8(float a0, float a1, float a2, float a3, float a4, float a5, float a6, float a7) {
    u32x4 w; w.x = pg8::cvt_pk_bf16(a0, a1); w.y = pg8::cvt_pk_bf16(a2, a3); w.z = pg8::cvt_pk_bf16(a4, a5); w.w = pg8::cvt_pk_bf16(a6, a7);
    return __builtin_bit_cast(bf16x8, w);
}
__device__ __forceinline__ f16x8 pack8h(float a0, float a1, float a2, float a3, float a4, float a5, float a6, float a7) {
    f16x8 r; r[0] = (_Float16)a0; r[1] = (_Float16)a1; r[2] = (_Float16)a2; r[3] = (_Float16)a3; r[4] = (_Float16)a4; r[5] = (_Float16)a5; r[6] = (_Float16)a6; r[7] = (_Float16)a7; return r;
}
__device__ __forceinline__ void tile_dma(const bf16* g, int ld, LAS unsigned char* buf, int wave, int lane) {
#pragma unroll
    for (int i = 0; i < 2; ++i) { const int pi = 2 * wave + i, row = 4 * pi + (lane >> 4), pc = lane & 15, ch = pc ^ (((row & 3) << 2) | ((row >> 2) & 3));
        __builtin_amdgcn_global_load_lds((const unsigned*)(g + (size_t)row * ld + ch * 8), (LAS unsigned*)(buf + 1024 * pi), 16, 0, 0); }
}
struct FragOff { int k[8]; int va[4], vb[4]; };
__device__ __forceinline__ void frag_off_init(FragOff& fo, int lane) {
    const int hi = lane >> 5, r32 = lane & 31, i = lane & 15, q = i >> 2, p = i & 3, x = 2 * ((lane >> 4) & 1) + (p >> 1);
#pragma unroll
    for (int ks = 0; ks < 8; ++ks) fo.k[ks] = img_off(r32, 2 * ks + hi);
#pragma unroll
    for (int ct = 0; ct < 4; ++ct) { fo.va[ct] = img_off(4 * hi + q, 4 * ct + x) + 8 * (p & 1); fo.vb[ct] = img_off(4 * hi + q + 8, 4 * ct + x) + 8 * (p & 1); }
}
__device__ __forceinline__ bf16x8 k_frag(const LAS unsigned char* kbuf, const FragOff& fo, int rt, int ks) { return *(const LAS bf16x8*)(kbuf + fo.k[ks] + 8192 * rt); }
__device__ __forceinline__ s16x4 vtr(const LAS unsigned char* p) { return __builtin_bit_cast(s16x4, __builtin_amdgcn_ds_read_tr16_b64_v4i16((LAS v4i16_t*)p)); }
__device__ __forceinline__ bf16x8 v_frag(const LAS unsigned char* vbuf, const FragOff& fo, int ct, int kk) {
    const s16x4 lo = vtr(vbuf + fo.va[ct] + 4096 * kk), hh = vtr(vbuf + fo.vb[ct] + 4096 * kk);
    return (bf16x8){lo[0], lo[1], lo[2], lo[3], hh[0], hh[1], hh[2], hh[3]};
}
__device__ __forceinline__ void store_o(const f32x16 (&o)[4], const float (&rscale)[16], LAS unsigned char* stg, bf16* dst, int ld, int lane) {
    const int hi = lane >> 5, r32 = lane & 31;
#pragma unroll
    for (int r = 0; r < 16; ++r) { const int orow = crow(r, hi);
#pragma unroll
        for (int ct = 0; ct < 4; ++ct) *(LAS bf16*)(stg + orow * 256 + (32 * ct + r32) * 2) = (bf16)f2bf(o[ct][r] * rscale[r]); }
    asm volatile("s_waitcnt lgkmcnt(0)" ::: "memory");
#pragma unroll
    for (int i = 0; i < 8; ++i) { const int c = lane + 64 * i, row = c >> 4, ch = c & 15; const u32x4 v = *(const LAS u32x4*)(stg + row * 256 + ch * 16); *(u32x4*)(dst + (size_t)row * ld + ch * 8) = v; }
}
}
__device__ __forceinline__ void ph_prep_a(Frame& F) {
    const int gw = F.vcu * NWAVES + F.wave, NGW = F.G * NWAVES, lane = F.lane;
    for (int tok = gw; tok < M; tok += NGW) {
        const float pos = (float)(tok & (SEQ - 1));
        bf16* pr = F.R1 + (size_t)tok * NAB;
        float c128 = 1.f, s128 = 0.f;
        if (lane < 32) { const int i = lane & 15; const float inv = powf(500000.0f, -(float)i * 2.0f / 32.0f); const float ang = pos * inv; c128 = cosf(ang); s128 = sinf(ang); }
#pragma unroll
        for (int which = 0; which < 2; ++which) {
            const int base = which == 0 ? C_QA : C_KA;
            const float* gn = which == 0 ? F.gq_a : F.gk_a;
            for (int h = 0; h < 4; ++h) {
                float a = bf2f(pr[base + h * 128 + lane]), b = bf2f(pr[base + h * 128 + 64 + lane]);
                const float ss = wave_sum(a * a + b * b);
                const float rs = rsqrtf(ss * (1.f / 128.f) + EPS);
                a = a * rs * gn[lane]; b = b * rs * gn[64 + lane];
                const float other = __shfl_xor(a, 16);
                float o = a;
                if (lane < 16) o = a * c128 - other * s128;
                else if (lane < 32) o = a * c128 + other * s128;
                pr[base + h * 128 + lane] = (bf16)f2bf(o); pr[base + h * 128 + 64 + lane] = (bf16)f2bf(b);
            }
        }
        float c64 = 1.f, s64 = 0.f;
        if (lane < 16) { const int i = lane & 7; const float inv = powf(500000.0f, -(float)i * 2.0f / 16.0f); const float ang = pos * inv; c64 = cosf(ang); s64 = sinf(ang); }
        for (int h = 0; h < 9; ++h) {
            const int col = (h < 8) ? C_IQ + h * 64 : C_IK;
            const float a = bf2f(pr[col + lane]);
            const float other = __shfl_xor(a, 8);
            float o = a;
            if (lane < 8) o = a * c64 - other * s64;
            else if (lane < 16) o = a * c64 + other * s64;
            pr[col + lane] = (bf16)f2bf(o);
        }
    }
}
__device__ __forceinline__ void ph_indexer_naive(Frame& F) {
    LAS float* sc = (LAS float*)F.lds;
    LAS float* qv = sc + 2048;
    LAS float* wv = qv + 512;
    LAS unsigned* mw = (LAS unsigned*)(wv + 8);
    const int tid = F.tid;
    for (int tok = F.vcu; tok < M; tok += F.G) {
        const int pos = tok & (SEQ - 1), seq0 = tok - pos, limit = ((pos >> 6) + 1) << 6;
        const bf16* pr = F.R1 + (size_t)tok * NAB;
        qv[tid] = bf2f(pr[C_IQ + tid]);
        if (tid < 8) wv[tid] = bf2f(pr[C_IW + tid]) * 0.35355339059327373f;
        if (tid < 64) mw[tid] = 0u;
        __syncthreads();
        for (int s = tid; s < limit; s += NTHR) {
            const bf16* kp = F.R1 + (size_t)(seq0 + s) * NAB + C_IK;
            float acc[8];
#pragma unroll
            for (int h = 0; h < 8; ++h) acc[h] = 0.f;
            for (int d = 0; d < 64; ++d) { const float kd = bf2f(kp[d]);
#pragma unroll
                for (int h = 0; h < 8; ++h) acc[h] = fmaf(qv[h * 64 + d], kd, acc[h]); }
            float score = 0.f;
#pragma unroll
            for (int h = 0; h < 8; ++h) score += fmaxf(acc[h] * 0.125f, 0.f) * wv[h];
            sc[s] = score;
        }
        __syncthreads();
        if (limit <= 256) { if (tid < 64) mw[tid] = (tid * 32 < limit) ? 0xffffffffu : 0u; }
        else {
            for (int s = tid; s < limit; s += NTHR) {
                const float v = sc[s]; int cnt = 0;
                for (int j = 0; j < limit; ++j) { const float u = sc[j]; cnt += ((u > v) || (u == v && j < s)) ? 1 : 0; }
                if (cnt < 256) atomicOr((unsigned*)&mw[s >> 5], 1u << (s & 31));
            }
        }
        __syncthreads();
        if (tid < 64) F.MASK[(size_t)tok * 64 + tid] = mw[tid];
        __syncthreads();
    }
}
__device__ __forceinline__ float block_sum(float v, LAS float* red, int tid) {
    v = wave_sum(v);
    __syncthreads();
    if ((tid & 63) == 0) red[tid >> 6] = v;
    __syncthreads();
    float r = 0.f;
#pragma unroll
    for (int i = 0; i < NWAVES; ++i) r += red[i];
    return r;
}
__device__ __forceinline__ float block_max(float v, LAS float* red, int tid) {
    v = wave_max(v);
    __syncthreads();
    if ((tid & 63) == 0) red[tid >> 6] = v;
    __syncthreads();
    float r = red[0];
#pragma unroll
    for (int i = 1; i < NWAVES; ++i) r = fmaxf(r, red[i]);
    return r;
}
__device__ __forceinline__ void ph_dsa_naive(Frame& F) {
    LAS unsigned* mw = (LAS unsigned*)F.lds;
    LAS int* pre = (LAS int*)(mw + 64);
    LAS int* idx = pre + 128;
    LAS float* pp = (LAS float*)(idx + 256);
    LAS float* q = pp + 512;
    LAS float* red = q + 512;
    const int tid = F.tid;
    for (int tok = F.vcu; tok < M; tok += F.G) {
        const int pos = tok & (SEQ - 1), seq0 = tok - pos;
        if (tid < 64) mw[tid] = F.MASK[(size_t)tok * 64 + tid];
        q[tid] = bf2f(F.R1[(size_t)tok * NAB + C_QA + tid]);
        __syncthreads();
        if (tid == 0) { int a = 0; for (int w = 0; w < 64; ++w) { pre[w] = a; a += __popc(mw[w]); } pre[64] = a; }
        __syncthreads();
        const int n = pre[64];
        for (int s = tid; s < SEQ; s += NTHR) { const unsigned w = mw[s >> 5]; if ((w >> (s & 31)) & 1u) idx[pre[s >> 5] + __popc(w & ((1u << (s & 31)) - 1u))] = s; }
        __syncthreads();
        for (int h = 0; h < 4; ++h) {
            float sv = -INFINITY;
            if (tid < n) { const bf16* kp = F.R1 + (size_t)(seq0 + idx[tid]) * NAB + C_KA + h * 128; float a = 0.f;
                for (int d = 0; d < 128; ++d) a = fmaf(q[h * 128 + d], bf2f(kp[d]), a);
                sv = a * 0.08838834764831845f; }
            const float m = block_max(sv, red, tid);
            const float e = (tid < n) ? expf(sv - m) : 0.f;
            const float l = block_sum(e, red, tid);
            pp[tid] = e;
            __syncthreads();
            if (tid < 128) { float o = 0.f;
                for (int j = 0; j < n; ++j) o = fmaf(pp[j], bf2f(F.R1[(size_t)(seq0 + idx[j]) * NAB + C_VA + h * 128 + tid]), o);
                F.CAT[(size_t)tok * D + h * 128 + tid] = (bf16)f2bf(o / l); }
            __syncthreads();
        }
    }
}
__device__ __forceinline__ void ph_gla_naive(Frame& F) {
    LAS float* sq = (LAS float*)F.lds; LAS float* sk = sq + 1024; LAS float* sd = sk + 1024;
    LAS float* sg = sd + 1024;
    LAS float* red = sg + 256;
    const int tid = F.tid, lane = F.lane;
    for (int item = F.vcu; item < BATCH * 4; item += F.G) {
        const int b = item >> 2, h = item & 3, seq0 = b * SEQ;
        float S[64];
#pragma unroll
        for (int d = 0; d < 64; ++d) S[d] = 0.f;
        for (int t0 = 0; t0 < SEQ; t0 += 16) {
            if (tid < 256) { const int tt = tid >> 4, r = tid & 15; sg[tid] = bf2f(F.R1[(size_t)(seq0 + t0 + tt) * NAB + C_GL + r]); }
            __syncthreads();
            for (int i = tid; i < 1024; i += NTHR) { const int tt = i >> 6, d = i & 63; const bf16* pr = F.R1 + (size_t)(seq0 + t0 + tt) * NAB;
                sq[i] = bf2f(pr[C_QB + h * 64 + d]) * 0.125f; sk[i] = bf2f(pr[C_KB + h * 64 + d]);
                float g = F.b_gate[h * 64 + d];
#pragma unroll
                for (int r = 0; r < 16; ++r) g = fmaf(sg[tt * 16 + r], F.w_gate_up[r * 256 + h * 64 + d], g);
                sd[i] = expf(log_sigmoid(g) * (1.f / 16.f)); }
            __syncthreads();
            float o[16];
            if (tid < 128) {
#pragma unroll
                for (int tt = 0; tt < 16; ++tt) {
                    const float v = bf2f(F.R1[(size_t)(seq0 + t0 + tt) * NAB + C_VB + h * 128 + tid]); float a = 0.f;
#pragma unroll
                    for (int d = 0; d < 64; ++d) { S[d] = fmaf(sd[tt * 64 + d], S[d], sk[tt * 64 + d] * v); a = fmaf(sq[tt * 64 + d], S[d], a); }
                    o[tt] = a;
                    const float ws = wave_sum(a * a);
                    if (lane == 0) red[tt * 2 + (tid >> 6)] = ws;
                }
            }
            __syncthreads();
            if (tid < 128) {
#pragma unroll
                for (int tt = 0; tt < 16; ++tt) {
                    const size_t tok = seq0 + t0 + tt;
                    const float rs = rsqrtf((red[tt * 2] + red[tt * 2 + 1]) * (1.f / 128.f) + EPS);
                    const float og = bf2f(F.R1[tok * NAB + C_OG + h * 128 + tid]);
                    F.CAT[tok * D + 512 + h * 128 + tid] = (bf16)f2bf(o[tt] * rs * F.g_gla[tid] * (og / (1.f + expf(-og))));
                }
            }
            __syncthreads();
        }
    }
}
template <bool SCALEQ> __device__ __forceinline__ void ph_prep_c(Frame& F) {
    const int gw = F.vcu * NWAVES + F.wave, NGW = F.G * NWAVES, lane = F.lane;
    for (int it = gw; it < M * 16; it += NGW) {
        const int tok = it >> 4, hh = it & 15, isk = hh >> 3, h = hh & 7;
        bf16* p = F.R1 + (size_t)tok * NC + isk * 1024 + h * 128;
        const float* gn = isk ? F.gk_c : F.gq_c;
        const float a = bf2f(p[lane]), b = bf2f(p[64 + lane]);
        const float rs = rsqrtf(wave_sum(a * a + b * b) * (1.f / 128.f) + EPS);
        const float sc = (SCALEQ && !isk) ? att::C2 : 1.0f;
        p[lane] = (bf16)f2bf(a * rs * gn[lane] * sc); p[64 + lane] = (bf16)f2bf(b * rs * gn[64 + lane] * sc);
    }
}
__device__ __forceinline__ void ph_sb_naive(Frame& F) {
    const int gw = F.vcu * NWAVES + F.wave, NGW = F.G * NWAVES, lane = F.lane;
    for (int it = gw; it < M * 8; it += NGW) {
        const int tok = it >> 3, h = it & 7, pos = tok & (SEQ - 1), seq0 = tok - pos;
        const unsigned qq = *(const unsigned*)(F.R1 + (size_t)tok * NC + h * 128 + 2 * lane);
        const float q0 = __builtin_bit_cast(float, qq << 16), q1 = __builtin_bit_cast(float, qq & 0xffff0000u);
        float R = 0.f, o0 = 0.f, o1 = 0.f;
        for (int s = pos - 1; s >= 0; --s) {
            const bf16* pr = F.R1 + (size_t)(seq0 + s) * NC + h * 128 + 2 * lane;
            const unsigned kk = *(const unsigned*)(pr + 1024), vv = *(const unsigned*)(pr + 2048);
            const float k0 = __builtin_bit_cast(float, kk << 16), k1 = __builtin_bit_cast(float, kk & 0xffff0000u);
            const float z = wave_sum(q0 * k0 + q1 * k1) * 0.08838834764831845f;
            const float sp = log1pf(expf(-fabsf(z)));
            const float lsp = fminf(z, 0.f) - sp, lsn = fminf(-z, 0.f) - sp;
            const float a = expf(lsp + R);
            o0 = fmaf(a, __builtin_bit_cast(float, vv << 16), o0); o1 = fmaf(a, __builtin_bit_cast(float, vv & 0xffff0000u), o1);
            R += lsn;
        }
        *(unsigned*)(F.CAT + (size_t)tok * D + h * 128 + 2 * lane) = pk2(o0, o1);
    }
}
__device__ __forceinline__ void sb_unit(Frame& F, int b, int h, int qb) {
    using namespace att;
    const int tid = F.tid, lane = F.lane, w = F.wave, hi = lane >> 5, r32 = lane & 31;
    const bf16* Qg = F.R1 + (size_t)b * SEQ * NC + h * 128; const bf16* Kg = Qg + 1024; const bf16* Vg = Qg + 2048;
    const int T0 = qb * 256, t0w = T0 + 32 * w, jd = t0w >> 6, jtop = (T0 >> 6) + 3, tl = 32 * (w & 1) + r32;
    LAS unsigned char* lds = F.lds;
    FragOff fo; frag_off_init(fo, lane);
    bf16x8 qf[8];
#pragma unroll
    for (int ks = 0; ks < 8; ++ks) qf[ks] = *(const bf16x8*)(Qg + (size_t)(t0w + r32) * NC + 16 * ks + 8 * hi);
    f16x8 T0f, T1f, ONEf;
#pragma unroll
    for (int j = 0; j < 8; ++j) { const int kp = 8 * (j >> 2) + 4 * hi + (j & 3); T0f[j] = (kp >= r32) ? (_Float16)1.0f : (_Float16)0.0f; T1f[j] = (kp + 16 >= r32) ? (_Float16)1.0f : (_Float16)0.0f; ONEf[j] = (_Float16)1.0f; }
    f32x16 o[4];
#pragma unroll
    for (int ct = 0; ct < 4; ++ct)
#pragma unroll
        for (int r = 0; r < 16; ++r) o[ct][r] = 0.f;
    float R2 = 0.f; bool done = false;
    volatile LAS unsigned* flags = F.MISC + 16;
    tile_dma(Kg + (size_t)(64 * jtop) * NC, NC, lds, w, lane); tile_dma(Vg + (size_t)(64 * jtop) * NC, NC, lds + 16384, w, lane);
    asm volatile("s_waitcnt vmcnt(0)" ::: "memory");
    __syncthreads();
    for (int j = jtop; j >= 0; --j) {
        const int cur = (jtop - j) & 1;
        const LAS unsigned char* kb = lds + cur * 32768; const LAS unsigned char* vb = kb + 16384;
        if (j > 0) { tile_dma(Kg + (size_t)(64 * (j - 1)) * NC, NC, lds + (cur ^ 1) * 32768, w, lane); tile_dma(Vg + (size_t)(64 * (j - 1)) * NC, NC, lds + (cur ^ 1) * 32768 + 16384, w, lane); }
        if (j <= jd && !done) {
            f32x16 p0, p1;
#pragma unroll
            for (int r = 0; r < 16; ++r) { p0[r] = 0.f; p1[r] = 0.f; }
#pragma unroll
            for (int ks = 0; ks < 8; ++ks) { const bf16x8 a0 = k_frag(kb, fo, 0, ks), a1 = k_frag(kb, fo, 1, ks);
                p0 = __builtin_amdgcn_mfma_f32_32x32x16_bf16(a0, qf[ks], p0, 0, 0, 0); p1 = __builtin_amdgcn_mfma_f32_32x32x16_bf16(a1, qf[ks], p1, 0, 0, 0); }
            const bool diag = (j == jd);
            float x0[16], x1[16]; float rs = 0.f;
#pragma unroll
            for (int r = 0; r < 16; ++r) { const int key = crow(r, hi);
                float l0 = -__builtin_amdgcn_logf(1.0f + __builtin_amdgcn_exp2f(p0[r])), l1 = -__builtin_amdgcn_logf(1.0f + __builtin_amdgcn_exp2f(p1[r]));
                if (diag) { if (!(key < tl)) l0 = 0.f; if (!(key + 32 < tl)) l1 = 0.f; }
                x0[r] = l0; x1[r] = l1; rs += l0 + l1; p0[r] += R2; p1[r] += R2; }
            const f16x8 xb00 = pack8h(x0[0], x0[1], x0[2], x0[3], x0[4], x0[5], x0[6], x0[7]), xb01 = pack8h(x0[8], x0[9], x0[10], x0[11], x0[12], x0[13], x0[14], x0[15]);
            const f16x8 xb10 = pack8h(x1[0], x1[1], x1[2], x1[3], x1[4], x1[5], x1[6], x1[7]), xb11 = pack8h(x1[8], x1[9], x1[10], x1[11], x1[12], x1[13], x1[14], x1[15]);
            p0 = __builtin_amdgcn_mfma_f32_32x32x16_f16(T0f, xb00, p0, 0, 0, 0); p0 = __builtin_amdgcn_mfma_f32_32x32x16_f16(T1f, xb01, p0, 0, 0, 0);
            p0 = __builtin_amdgcn_mfma_f32_32x32x16_f16(ONEf, xb10, p0, 0, 0, 0); p0 = __builtin_amdgcn_mfma_f32_32x32x16_f16(ONEf, xb11, p0, 0, 0, 0);
            p1 = __builtin_amdgcn_mfma_f32_32x32x16_f16(T0f, xb10, p1, 0, 0, 0); p1 = __builtin_amdgcn_mfma_f32_32x32x16_f16(T1f, xb11, p1, 0, 0, 0);
#pragma unroll
            for (int r = 0; r < 16; ++r) { const int key = crow(r, hi);
                float a0 = __builtin_amdgcn_exp2f(p0[r]), a1 = __builtin_amdgcn_exp2f(p1[r]);
                if (diag) { if (!(key < tl)) a0 = 0.f; if (!(key + 32 < tl)) a1 = 0.f; }
                p0[r] = a0; p1[r] = a1; }
            const bf16x8 pa0 = pack8(p0[0], p0[1], p0[2], p0[3], p0[4], p0[5], p0[6], p0[7]), pa1 = pack8(p0[8], p0[9], p0[10], p0[11], p0[12], p0[13], p0[14], p0[15]);
            const bf16x8 pa2 = pack8(p1[0], p1[1], p1[2], p1[3], p1[4], p1[5], p1[6], p1[7]), pa3 = pack8(p1[8], p1[9], p1[10], p1[11], p1[12], p1[13], p1[14], p1[15]);
#pragma unroll
            for (int ct = 0; ct < 4; ++ct) {
                o[ct] = __builtin_amdgcn_mfma_f32_32x32x16_bf16(pa0, v_frag(vb, fo, ct, 0), o[ct], 0, 0, 0);
                o[ct] = __builtin_amdgcn_mfma_f32_32x32x16_bf16(pa1, v_frag(vb, fo, ct, 1), o[ct], 0, 0, 0);
                o[ct] = __builtin_amdgcn_mfma_f32_32x32x16_bf16(pa2, v_frag(vb, fo, ct, 2), o[ct], 0, 0, 0);
                o[ct] = __builtin_amdgcn_mfma_f32_32x32x16_bf16(pa3, v_frag(vb, fo, ct, 3), o[ct], 0, 0, 0);
            }
            rs += __shfl_xor(rs, 32);
            R2 += rs;
            done = __all(R2 < -152.0f);
        }
        if (lane == 0) flags[cur * 8 + w] = done ? 1u : 0u;
        asm volatile("s_waitcnt vmcnt(0) lgkmcnt(0)" ::: "memory");
        __syncthreads();
        unsigned alld = 1u;
#pragma unroll
        for (int i = 0; i < 8; ++i) alld &= flags[cur * 8 + i];
        if (alld) break;
    }
    float ones[16];
#pragma unroll
    for (int r = 0; r < 16; ++r) ones[r] = 1.0f;
    store_o(o, ones, lds + w * 8192, F.CAT + (size_t)(b * SEQ + t0w) * D + h * 128, D, lane);
    __syncthreads();
}
__device__ __forceinline__ void ph_sb(Frame& F) {
    for (int v = F.vcu; v < BATCH * 8 * 2; v += F.G) {
        const int bh = v >> 1, half = v & 1;
#pragma unroll 1
        for (int i = 0; i < 4; ++i) { const int qb = half ? (i == 0 ? 1 : i == 1 ? 6 : i == 2 ? 2 : 5) : (i == 0 ? 0 : i == 1 ? 7 : i == 2 ? 3 : 4); sb_unit(F, bh >> 3, bh & 7, qb); }
    }
}
#ifndef MK_PER_PHASE
#define MK_PER_PHASE 0
#endif
constexpr int NPH = 14;
struct Args { const float* in[16]; float* out; unsigned char* ws; int ph_lo, ph_hi; };
__global__ void __launch_bounds__(NTHR, 2) mk_fwd(Args args) {
    extern __shared__ __attribute__((aligned(16))) unsigned char lds[];
    Frame F;
    F.lds = (LAS unsigned char*)lds;
    F.MISC = (volatile LAS unsigned*)(F.lds + MISC_OFF);
    F.tid = threadIdx.x; F.lane = F.tid & 63; F.wave = __builtin_amdgcn_readfirstlane(F.tid >> 6);
    F.G = gridDim.x; { const int bx = blockIdx.x; F.vcu = (F.G % 8 == 0) ? (bx % 8) * (F.G / 8) + bx / 8 : bx; }
    unsigned char* ws = args.ws;
    F.ctl = (gu32*)(ws + WS_CTL);
    F.x = args.in[0]; F.g_mix = args.in[1]; F.g_ffn = args.in[2]; F.w_in_ab = args.in[3]; F.gq_a = args.in[4]; F.gk_a = args.in[5]; F.w_gate_up = args.in[6]; F.b_gate = args.in[7];
    F.g_gla = args.in[8]; F.w_out_ab = args.in[9]; F.w_in_c = args.in[10]; F.gq_c = args.in[11]; F.gk_c = args.in[12]; F.w_out_c = args.in[13]; F.w_up = args.in[14]; F.w_down = args.in[15];
    F.out = args.out;
    F.Wab = (bf16*)(ws + WS_WAB); F.Woab = (bf16*)(ws + WS_WOAB); F.Wup0 = (bf16*)(ws + WS_WUP0); F.Wdn0 = (bf16*)(ws + WS_WDN0);
    F.Winc = (bf16*)(ws + WS_WINC); F.Woc = (bf16*)(ws + WS_WOC); F.Wup1 = (bf16*)(ws + WS_WUP1); F.Wdn1 = (bf16*)(ws + WS_WDN1);
    F.XB = (bf16*)(ws + WS_XB); F.CAT = (bf16*)(ws + WS_CAT); F.R1 = (bf16*)(ws + WS_R1); F.SSQ = (float*)(ws + WS_SSQ); F.MASK = (unsigned*)(ws + WS_MASK);
    for (int u = F.tid; u < (LDS_BYTES - MISC_OFF) / 4; u += NTHR) ((LAS unsigned*)(F.lds + MISC_OFF))[u] = 0u;
    __syncthreads();
    XcdBarrier bar; bar.bar = (unsigned*)(F.ctl + CW_BAR); bar.x = 0; bar.st = nullptr;
    if (!MK_PER_PHASE) bar = xcd_barrier_post((unsigned*)(F.ctl + CW_BAR), F.MISC + 8);
    const int lo = args.ph_lo, hi = args.ph_hi;
#define IN(k) (lo <= (k) && (k) < hi)
#define SEAM(k) do { if (IN(k) && IN((k) + 1)) xcd_barrier(bar); } while (0)
    float* const SSQ0 = F.SSQ, *SSQ1 = F.SSQ + (size_t)M * 16, *SSQ2 = F.SSQ + (size_t)2 * M * 16, *SSQ3 = F.SSQ + (size_t)3 * M * 16;
    typedef pg8::StaticOrder SO;
    if (IN(0)) { ph_prologue(F); } SEAM(0);
    if (IN(1)) { pg8::Gemm g{F.XB, F.Wab, M, NAB, D}; SO S; S.init(M, NAB, F.G, (int)blockIdx.x); pg8::EpiScale<0> E{F.R1, NAB, SSQ0};
        pg8::gemm_phase<pg8::EpiScale<0>, SO, true, true>(F.lds, g, S, E); } SEAM(1);
    if (IN(2)) { ph_prep_a(F); } SEAM(2);
    if (IN(3)) { ph_indexer_naive(F); } SEAM(3);
    if (IN(4)) { ph_dsa_naive(F); __syncthreads(); ph_gla_naive(F); } SEAM(4);
    if (IN(5)) { pg8::Gemm g{F.CAT, F.Woab, M, D, D}; SO S; S.init(M, D, F.G, (int)blockIdx.x); pg8::EpiResid<1> E{F.x, F.out, F.XB, SSQ1};
        pg8::gemm_phase<pg8::EpiResid<1>, SO, true, true>(F.lds, g, S, E); } SEAM(5);
    if (IN(6)) { pg8::Gemm g{F.XB, F.Wup0, M, FF, D}; SO S; S.init(M, FF, F.G, (int)blockIdx.x); pg8::EpiScale<1> E{F.R1, FF, SSQ1};
        pg8::gemm_phase<pg8::EpiScale<1>, SO, true, true>(F.lds, g, S, E); } SEAM(6);
    if (IN(7)) { pg8::Gemm g{F.R1, F.Wdn0, M, D, FF}; SO S; S.init(M, D, F.G, (int)blockIdx.x); pg8::EpiResid<1> E{F.out, F.out, F.XB, SSQ2};
        pg8::gemm_phase<pg8::EpiResid<1>, SO, true, true>(F.lds, g, S, E); } SEAM(7);
    if (IN(8)) { pg8::Gemm g{F.XB, F.Winc, M, NC, D}; SO S; S.init(M, NC, F.G, (int)blockIdx.x); pg8::EpiScale<0> E{F.R1, NC, SSQ2};
        pg8::gemm_phase<pg8::EpiScale<0>, SO, true, true>(F.lds, g, S, E); } SEAM(8);
    if (IN(9)) { ph_prep_c<true>(F); } SEAM(9);
    if (IN(10)) { ph_sb(F); } SEAM(10);
    if (IN(11)) { pg8::Gemm g{F.CAT, F.Woc, M, D, D}; SO S; S.init(M, D, F.G, (int)blockIdx.x); pg8::EpiResid<1> E{F.out, F.out, F.XB, SSQ3};
        pg8::gemm_phase<pg8::EpiResid<1>, SO, true, true>(F.lds, g, S, E); } SEAM(11);
    if (IN(12)) { pg8::Gemm g{F.XB, F.Wup1, M, FF, D}; SO S; S.init(M, FF, F.G, (int)blockIdx.x); pg8::EpiScale<1> E{F.R1, FF, SSQ3};
        pg8::gemm_phase<pg8::EpiScale<1>, SO, true, true>(F.lds, g, S, E); } SEAM(12);
    if (IN(13)) { pg8::Gemm g{F.R1, F.Wdn1, M, D, FF}; SO S; S.init(M, D, F.G, (int)blockIdx.x); pg8::EpiResid<0> E{F.out, F.out, nullptr, nullptr};
        pg8::gemm_phase<pg8::EpiResid<0>, SO, true, true>(F.lds, g, S, E); }
#undef IN
#undef SEAM
}

extern "C" void kernel_launch(void* const* d_in, const int* in_sizes, int n_in, void* d_out, int out_size, void* d_ws, size_t ws_size, hipStream_t stream) {
    static int grid = 0;
    if (grid == 0) {
        if (n_in != 16 || in_sizes[0] != M * D || out_size != M * D || ws_size < WS_END) { fprintf(stderr, "kernel_launch: unexpected shapes / workspace (%d inputs, ws %zu)\n", n_in, ws_size); grid = -1; return; }
        int dev = 0, cus = 0;
        if (hipGetDevice(&dev) != hipSuccess || hipDeviceGetAttribute(&cus, hipDeviceAttributeMultiprocessorCount, dev) != hipSuccess) { grid = -1; return; }
        if (hipFuncSetAttribute((const void*)mk_fwd, hipFuncAttributeMaxDynamicSharedMemorySize, LDS_BYTES) != hipSuccess) { fprintf(stderr, "kernel_launch: hipFuncSetAttribute failed\n"); grid = -1; return; }
        (void)hipGetLastError();
        grid = cus;
    }
    if (grid < 0) return;
    if (hipMemsetAsync((char*)d_ws + WS_CTL, 0, CTL_ZERO_BYTES, stream) != hipSuccess) { fprintf(stderr, "kernel_launch: memset failed\n"); return; }
    Args a{};
    for (int i = 0; i < 16; ++i) a.in[i] = (const float*)d_in[i];
    a.out = (float*)d_out; a.ws = (unsigned char*)d_ws;
#if MK_PER_PHASE
    for (int ph = 0; ph < NPH; ++ph) { a.ph_lo = ph; a.ph_hi = ph + 1; hipLaunchKernelGGL(mk_fwd, dim3(grid), dim3(NTHR), LDS_BYTES, stream, a); }
#else
    a.ph_lo = 0; a.ph_hi = NPH;
    hipLaunchKernelGGL(mk_fwd, dim3(grid), dim3(NTHR), LDS_BYTES, stream, a);
#endif
    const hipError_t le = hipPeekAtLastError();
    if (le != hipSuccess) fprintf(stderr, "kernel_launch: launch failed: %s\n", hipGetErrorName(le));
}
```

```cpp
#include <hip/hip_runtime.h>
#include <cstdio>
#include <cstdint>
namespace pg8 {
#define PG8_LAS __attribute__((address_space(3)))
typedef unsigned short bf16_t;
typedef short bf16x8 __attribute__((ext_vector_type(8)));
typedef float f32x4 __attribute__((ext_vector_type(4)));
typedef unsigned u32x4 __attribute__((ext_vector_type(4)));
constexpr int BM = 256, BK = 64, HALF = 128, HTB = HALF * BK * 2  , STAGE_BYTES = 8 * HTB, NXCD = 8, WGM = 8;

__host__ __device__ __forceinline__ int lds_byte(int r, int c) { const int st = (r >> 4) * 2 + (c >> 5), rr = r & 15, cc = c & 31, ob = rr * 64 + cc * 2; return st * 1024 + (ob ^ (((ob >> 9) & 1) << 5)); }
__host__ __device__ __forceinline__ void stage_rc(int b, int& R, int& C) { const int st = b / 1024, sb = b % 1024, swz = sb ^ (((sb >> 9) & 1) << 5); R = (st >> 1) * 16 + swz / 64; C = (st & 1) * 32 + (swz % 64) / 2; }
__host__ __device__ __forceinline__ int perm32(int rho) { const int n = rho >> 4, i = rho & 15; return 8 * (i >> 2) + 4 * n + (i & 3); }

struct Unit { int pm, pn; };
struct Gemm { const bf16_t* A; const bf16_t* Bt; int M, N, K; };

struct StaticOrder {
    int nM, nN, nwg, G, c;
    __host__ __device__ void init(int M, int N, int G_, int c_) { nM = M / BM; nN = N / BM; nwg = nM * nN; G = G_; c = c_; }
    __host__ __device__ bool next(int i, Unit& u) const {
        const long L = (long)i * G + c; if (L >= nwg) return false;
        int wgid = (int)L; { const int q = nwg / NXCD, r = nwg % NXCD, xcd = wgid % NXCD, off = wgid / NXCD; wgid = (xcd < r ? xcd * (q + 1) : r * (q + 1) + (xcd - r) * q) + off; }
        const int nig = WGM * nN, gid = wgid / nig, fm = gid * WGM, gsz = (nM - fm) < WGM ? (nM - fm) : WGM;
        u.pm = fm + ((wgid % nig) % gsz); u.pn = (wgid % nig) / gsz; return true;
    }
    __device__ __forceinline__ void a_ready(const Unit&) const {}
    __device__ __forceinline__ void done(const Unit&) const {}
};

__device__ __forceinline__ unsigned cvt_pk_bf16(float lo, float hi) { unsigned r; asm volatile("v_cvt_pk_bf16_f32 %0, %1, %2" : "=v"(r) : "v"(lo), "v"(hi)); return r; }
__device__ __forceinline__ float row_rstd(const float* ssqp, int row) {
    const f32x4* p = (const f32x4*)(ssqp + (size_t)row * 16);
    const f32x4 a = p[0], b = p[1], c = p[2], d = p[3];
    const float s = (((a[0] + a[1]) + (a[2] + a[3])) + ((b[0] + b[1]) + (b[2] + b[3]))) + (((c[0] + c[1]) + (c[2] + c[3])) + ((d[0] + d[1]) + (d[2] + d[3])));
    return rsqrtf(s * (1.0f / 1024.0f) + 1e-6f);
}
template <int ACT  > struct EpiScale {
    static constexpr bool PERM = true, AFTER_DRAIN = false;
    bf16_t* O; int ldc; const float* ssqp;
    __device__ __forceinline__ void operator()(const f32x4 (&acc)[2][2][4][2], const Unit& u, int wr, int wc, int fr, int fq) const {
        const int row0 = u.pm * BM + wr * 64 + fr, col0 = u.pn * BM + wc * 32 + 8 * fq;
#pragma unroll
        for (int ai = 0; ai < 2; ++ai)
#pragma unroll
            for (int m = 0; m < 4; ++m) {
                const int row = row0 + ai * HALF + m * 16;
                const float rs = row_rstd(ssqp, row);
                bf16_t* rowp = O + (size_t)row * ldc + col0;
#pragma unroll
                for (int bj = 0; bj < 2; ++bj) {
                    f32x4 v0 = acc[ai][bj][m][0] * rs, v1 = acc[ai][bj][m][1] * rs;
                    if (ACT == 1) {
#pragma unroll
                        for (int e = 0; e < 4; ++e) { const float a0 = fmaxf(v0[e], 0.f), a1 = fmaxf(v1[e], 0.f); v0[e] = a0 * a0; v1[e] = a1 * a1; }
                    }
                    u32x4 w; w.x = cvt_pk_bf16(v0[0], v0[1]); w.y = cvt_pk_bf16(v0[2], v0[3]); w.z = cvt_pk_bf16(v1[0], v1[1]); w.w = cvt_pk_bf16(v1[2], v1[3]);
                    *(u32x4*)(rowp + bj * HALF) = w;
                }
            }
    }
};
template <int WRITE_HB> struct EpiResid {
    static constexpr bool PERM = true, AFTER_DRAIN = false;
    const float* R; float* out; bf16_t* hb; float* ssqp;
    __device__ __forceinline__ void operator()(const f32x4 (&acc)[2][2][4][2], const Unit& u, int wr, int wc, int fr, int fq) const {
        const int row0 = u.pm * BM + wr * 64 + fr, col0 = u.pn * BM + wc * 32 + 8 * fq;
#pragma unroll
        for (int ai = 0; ai < 2; ++ai)
#pragma unroll
            for (int m = 0; m < 4; ++m) {
                const int row = row0 + ai * HALF + m * 16;
                const size_t off = (size_t)row * 1024 + col0;
                float ss = 0.f;
#pragma unroll
                for (int bj = 0; bj < 2; ++bj) {
                    const f32x4 r0 = *(const f32x4*)(R + off + bj * HALF), r1 = *(const f32x4*)(R + off + bj * HALF + 4);
                    const f32x4 v0 = acc[ai][bj][m][0] + r0, v1 = acc[ai][bj][m][1] + r1;
                    *(f32x4*)(out + off + bj * HALF) = v0; *(f32x4*)(out + off + bj * HALF + 4) = v1;
                    if (WRITE_HB) {
                        u32x4 w; w.x = cvt_pk_bf16(v0[0], v0[1]); w.y = cvt_pk_bf16(v0[2], v0[3]); w.z = cvt_pk_bf16(v1[0], v1[1]); w.w = cvt_pk_bf16(v1[2], v1[3]);
                        *(u32x4*)(hb + off + bj * HALF) = w;
                        ss += ((v0[0] * v0[0] + v0[1] * v0[1]) + (v0[2] * v0[2] + v0[3] * v0[3])) + ((v1[0] * v1[0] + v1[1] * v1[1]) + (v1[2] * v1[2] + v1[3] * v1[3]));
                    }
                }
                if (WRITE_HB) { ss += __shfl_xor(ss, 16); ss += __shfl_xor(ss, 32); if (fq == 0) ssqp[(size_t)row * 16 + u.pn * 4 + wc] = ss; }
            }
    }
};
template <class Epi, class Sched, bool ALIGN_EPI = false, bool SP2 = false>
__device__ __forceinline__ void gemm_phase(PG8_LAS unsigned char* lds, const Gemm g, const Sched& S, const Epi& E, const int wave_in) {
    const int wid = wave_in, lane = (int)__builtin_amdgcn_mbcnt_hi(~0u, __builtin_amdgcn_mbcnt_lo(~0u, 0u)), tid = wid * 64 + lane, wr = wid >> 2, wc = wid & 3, fr = lane & 15, fq = lane >> 4;
    const int K = g.K, nt = K / BK;
    unsigned voffA[2], voffB[2];
#pragma unroll
    for (int i = 0; i < 2; ++i) { int R, C; stage_rc(tid * 16 + i * 8192, R, C); const int Rb = Epi::PERM ? ((R & ~31) + perm32(R & 31)) : R;
        voffA[i] = (unsigned)(R * K + C) * 2u; voffB[i] = (unsigned)(Rb * K + C) * 2u; }
    const size_t kstep = (size_t)(BK * 2);
    const size_t hstep = (size_t)HALF * K * 2;
    const size_t tstep = 2 * hstep;
    const unsigned ldsw = (unsigned)wid * 1024u;
    const int aoff = lds_byte(wr * 64 + fr, fq * 8), boff = lds_byte(wc * 32 + fr, fq * 8);
#define PG8_SA(b, h) (((b) * 2 + (h)) * HTB)
#define PG8_SB(b, h) ((4 + (b) * 2 + (h)) * HTB)
#define PG8_STAGE(bufoff, gbase, voff) do { _Pragma("unroll") for (int _i = 0; _i < 2; ++_i) \
        __builtin_amdgcn_global_load_lds((const unsigned*)((const char*)(gbase) + (voff)[_i]), (PG8_LAS unsigned*)(lds + (bufoff) + ldsw + _i * 8192), 16, 0, 0); } while (0)
#define PG8_LDA(dst, b, h) do { _Pragma("unroll") for (int m = 0; m < 4; ++m) _Pragma("unroll") for (int k = 0; k < 2; ++k) dst[m][k] = *(const PG8_LAS bf16x8*)(lds + PG8_SA(b, h) + aoff + m * 2048 + k * 1024); } while (0)
#define PG8_LDB(dst, b, h) do { _Pragma("unroll") for (int n = 0; n < 2; ++n) _Pragma("unroll") for (int k = 0; k < 2; ++k) dst[n][k] = *(const PG8_LAS bf16x8*)(lds + PG8_SB(b, h) + boff + n * 2048 + k * 1024); } while (0)
#define PG8_MMA(ai, bj, At, Bt) do { __builtin_amdgcn_s_setprio(1); _Pragma("unroll") for (int m = 0; m < 4; ++m) _Pragma("unroll") for (int n = 0; n < 2; ++n) _Pragma("unroll") for (int k = 0; k < 2; ++k) \
        acc[ai][bj][m][n] = __builtin_amdgcn_mfma_f32_16x16x32_bf16(Bt[n][k], At[m][k], acc[ai][bj][m][n], 0, 0, 0); __builtin_amdgcn_s_setprio(0); } while (0)
#define PG8_WAIT_V(n) asm volatile("s_waitcnt vmcnt(" #n ")" ::: "memory")
#define PG8_WAIT_L(n) asm volatile("s_waitcnt lgkmcnt(" #n ")" ::: "memory")
#define PG8_BAR __builtin_amdgcn_s_barrier()
#define PG8_SCHED __builtin_amdgcn_sched_barrier(0)
    Unit cur, nxt; int ui = 0;
    if (!S.next(0, cur)) return;
    f32x4 acc[2][2][4][2];
#pragma unroll
    for (int a = 0; a < 2; ++a)
#pragma unroll
        for (int b = 0; b < 2; ++b)
#pragma unroll
            for (int m = 0; m < 4; ++m)
#pragma unroll
                for (int n = 0; n < 2; ++n) acc[a][b][m][n] = (f32x4){0.f, 0.f, 0.f, 0.f};
    bf16x8 At[4][2], B0[2][2], B1[2][2];
    const char* cA = (const char*)g.A + (size_t)cur.pm * tstep; const char* cB = (const char*)g.Bt + (size_t)cur.pn * tstep;
    S.a_ready(cur);
    if constexpr (SP2) {
        PG8_STAGE(PG8_SB(0, 0), cB, voffB); PG8_STAGE(PG8_SB(0, 1), cB + hstep, voffB); PG8_STAGE(PG8_SA(0, 0), cA, voffA); PG8_STAGE(PG8_SA(0, 1), cA + hstep, voffA);
        if (wr == 1) PG8_BAR;
        PG8_WAIT_V(2); PG8_BAR;
        PG8_STAGE(PG8_SB(1, 0), cB + kstep, voffB); PG8_STAGE(PG8_SA(1, 0), cA + kstep, voffA); PG8_STAGE(PG8_SB(1, 1), cB + hstep + kstep, voffB);
        PG8_WAIT_V(6); PG8_BAR;
    } else {
        PG8_STAGE(PG8_SB(0, 0), cB, voffB); PG8_STAGE(PG8_SA(0, 0), cA, voffA); PG8_STAGE(PG8_SB(0, 1), cB + hstep, voffB); PG8_STAGE(PG8_SA(0, 1), cA + hstep, voffA);
        if (wr == 1) PG8_BAR;
        PG8_WAIT_V(4); PG8_BAR;
        PG8_STAGE(PG8_SB(1, 0), cB + kstep, voffB); PG8_STAGE(PG8_SA(1, 0), cA + kstep, voffA); PG8_STAGE(PG8_SB(1, 1), cB + hstep + kstep, voffB);
        PG8_WAIT_V(6); PG8_BAR;
    }
    for (;;) {
        const bool has_next = S.next(ui + 1, nxt);
        const char* nA = has_next ? (const char*)g.A + (size_t)nxt.pm * tstep : cA; const char* nB = has_next ? (const char*)g.Bt + (size_t)nxt.pn * tstep : cB;
        for (int t = 0; t < nt; t += 2) {
            const bool last = (t == nt - 2);
            const char* a1 = cA + (size_t)(t + 1) * kstep;
            const char* a2 = last ? nA : cA + (size_t)(t + 2) * kstep; const char* b2 = last ? nB : cB + (size_t)(t + 2) * kstep;
            const char* a3 = a2 + kstep; const char* b3 = b2 + kstep;
            if (last && has_next) S.a_ready(nxt);
            if constexpr (SP2) {
            PG8_LDB(B0, 0, 0); PG8_LDB(B1, 0, 1); PG8_SCHED; PG8_LDA(At, 0, 0); PG8_STAGE(PG8_SA(1, 1), a1 + hstep, voffA);
            PG8_WAIT_V(8); PG8_WAIT_L(0); PG8_BAR; PG8_MMA(0, 0, At, B0); PG8_MMA(0, 1, At, B1); PG8_BAR; PG8_SCHED;
            PG8_LDA(At, 0, 1); PG8_STAGE(PG8_SB(0, 0), b2, voffB); PG8_STAGE(PG8_SB(0, 1), b2 + hstep, voffB); PG8_STAGE(PG8_SA(0, 0), a2, voffA);
            PG8_WAIT_V(8); PG8_WAIT_L(0); PG8_BAR; PG8_MMA(1, 0, At, B0); PG8_MMA(1, 1, At, B1); PG8_BAR; PG8_SCHED;
            PG8_LDB(B0, 1, 0); PG8_LDB(B1, 1, 1); PG8_SCHED; PG8_LDA(At, 1, 0); PG8_STAGE(PG8_SA(0, 1), a2 + hstep, voffA);
            PG8_WAIT_V(8); PG8_WAIT_L(0); PG8_BAR; PG8_MMA(0, 0, At, B0); PG8_MMA(0, 1, At, B1); PG8_BAR; PG8_SCHED;
            PG8_LDA(At, 1, 1); PG8_STAGE(PG8_SB(1, 0), b3, voffB); PG8_STAGE(PG8_SB(1, 1), b3 + hstep, voffB); PG8_STAGE(PG8_SA(1, 0), a3, voffA);
            PG8_WAIT_V(8); PG8_WAIT_L(0); PG8_BAR; PG8_MMA(1, 0, At, B0); PG8_MMA(1, 1, At, B1); PG8_BAR; PG8_SCHED;
            } else {
            PG8_LDB(B0, 0, 0); PG8_SCHED; PG8_LDA(At, 0, 0); PG8_STAGE(PG8_SA(1, 1), a1 + hstep, voffA);
            PG8_WAIT_L(8); PG8_BAR; PG8_WAIT_L(0); PG8_MMA(0, 0, At, B0); PG8_BAR; PG8_SCHED;
            PG8_LDB(B1, 0, 1); PG8_STAGE(PG8_SB(0, 0), b2, voffB);
            PG8_BAR; PG8_WAIT_L(0); PG8_MMA(0, 1, At, B1); PG8_BAR;
            PG8_LDA(At, 0, 1); PG8_STAGE(PG8_SA(0, 0), a2, voffA);
            PG8_BAR; PG8_WAIT_L(0); PG8_MMA(1, 0, At, B0); PG8_BAR; PG8_SCHED;
            PG8_STAGE(PG8_SB(0, 1), b2 + hstep, voffB);
            PG8_WAIT_V(6); PG8_BAR; PG8_MMA(1, 1, At, B1); PG8_BAR;
            PG8_LDB(B0, 1, 0); PG8_SCHED; PG8_LDA(At, 1, 0); PG8_STAGE(PG8_SA(0, 1), a2 + hstep, voffA);
            PG8_WAIT_L(8); PG8_BAR; PG8_WAIT_L(0); PG8_MMA(0, 0, At, B0); PG8_BAR; PG8_SCHED;
            PG8_LDB(B1, 1, 1); PG8_STAGE(PG8_SB(1, 0), b3, voffB);
            PG8_BAR; PG8_WAIT_L(0); PG8_MMA(0, 1, At, B1); PG8_BAR;
            PG8_LDA(At, 1, 1); PG8_STAGE(PG8_SA(1, 0), a3, voffA);
            PG8_BAR; PG8_WAIT_L(0); PG8_MMA(1, 0, At, B0); PG8_BAR; PG8_SCHED;
            PG8_STAGE(PG8_SB(1, 1), b3 + hstep, voffB);
            PG8_WAIT_V(6); PG8_BAR; PG8_MMA(1, 1, At, B1); PG8_BAR;
            }
        }
        if constexpr (ALIGN_EPI) { if (wr == 0) PG8_BAR; }
        if constexpr (!Epi::AFTER_DRAIN) { E(acc, cur, wr, wc, fr, fq); S.done(cur); }
        if (!has_next) break;
#pragma unroll
        for (int a = 0; a < 2; ++a)
#pragma unroll
            for (int b = 0; b < 2; ++b)
#pragma unroll
                for (int m = 0; m < 4; ++m)
#pragma unroll
                    for (int n = 0; n < 2; ++n) acc[a][b][m][n] = (f32x4){0.f, 0.f, 0.f, 0.f};
        cur = nxt; cA = nA; cB = nB; ++ui;
        if constexpr (ALIGN_EPI) { if (wr == 1) PG8_BAR; }
    }
    PG8_WAIT_V(0);
    if constexpr (!ALIGN_EPI) { if (wr == 0) PG8_BAR; }
    PG8_BAR;
    if constexpr (Epi::AFTER_DRAIN) { E.fused(acc, cur, wr, wc, fr, fq, lds, wid, lane); S.done(cur); }
#undef PG8_SA
#undef PG8_SB
#undef PG8_STAGE
#undef PG8_LDA
#undef PG8_LDB
#undef PG8_MMA
#undef PG8_WAIT_V
#undef PG8_WAIT_L
#undef PG8_BAR
#undef PG8_SCHED
}
}
#include <cmath>
constexpr int NWAVES = 8, NTHR = 512;
constexpr int BATCH = 16, SEQ = 2048, M = BATCH * SEQ, D = 1024, FF = 4096, NAB = 3840, NC = 3072, ABP_OLD = 3672;
constexpr int C_QA = 0, C_KA = 512, C_VA = 1024, C_IQ = 1536, C_QB = 2048, C_KB = 2304, C_VB = 2560, C_OG = 3072, C_IK = 3584, C_IW = 3648, C_GL = 3656;
constexpr float EPS = 1e-6f;
constexpr size_t MiB = 1u << 20;
constexpr size_t WS_CTL = 0, CTL_ZERO_BYTES = 1 * MiB;
constexpr size_t WS_WAB = 1 * MiB, WS_WOAB = 9 * MiB, WS_WUP0 = 11 * MiB, WS_WDN0 = 19 * MiB, WS_WINC = 27 * MiB, WS_WOC = 33 * MiB, WS_WUP1 = 35 * MiB, WS_WDN1 = 43 * MiB;
constexpr size_t WS_SSQ = 51 * MiB, SSQ_BYTES = 2 * MiB;
constexpr size_t WS_XB = 60 * MiB;
constexpr size_t WS_CAT = 124 * MiB;
constexpr size_t WS_MASK = 188 * MiB;
constexpr size_t WS_R1 = 196 * MiB;
constexpr size_t WS_END = 452 * MiB;
constexpr int CW_BAR = 4096;
constexpr int RING_BYTES = 131072;
constexpr int LDS_BYTES = 163840;
constexpr int MISC_OFF = LDS_BYTES - 256;
#define GAS __attribute__((address_space(1)))
#define LAS __attribute__((address_space(3)))
typedef unsigned short bf16;
typedef unsigned v4u __attribute__((ext_vector_type(4)));
typedef float f32x4 __attribute__((ext_vector_type(4)));
typedef short bf16x8 __attribute__((ext_vector_type(8)));
typedef GAS unsigned gu32;
typedef GAS unsigned long long gu64;
#define RLX_AGENT __ATOMIC_RELAXED, __HIP_MEMORY_SCOPE_AGENT
#define LDS_WAIT() asm volatile("s_waitcnt lgkmcnt(0)" ::: "memory")
#define VM_WAIT() asm volatile("s_waitcnt vmcnt(0)" ::: "memory")
__device__ __forceinline__ unsigned long long rt() { return __builtin_amdgcn_s_memrealtime(); }
__device__ __forceinline__ unsigned f2bf(float f) { unsigned u = __builtin_bit_cast(unsigned, f); return (u + 0x7fffu + ((u >> 16) & 1u)) >> 16; }
__device__ __forceinline__ unsigned pk2(float lo, float hi) { return f2bf(lo) | (f2bf(hi) << 16); }
#define XB_TMO      128
#define XB_XCNT(j)  (256  + 64 * (j))
#define XB_XSUB(j)  (1280 + 64 * (j))
#define XB_XGEN(j)  (2304 + 64 * (j))
#define XB_TOP      3328
#define XB_TOPGEN   3392
#define XCD_BAR_WORDS 3456
#define XB_SPIN_CAP (1u << 18)

__device__ __forceinline__ unsigned xb_ld(unsigned* p)              { return __hip_atomic_load(p, __ATOMIC_RELAXED, __HIP_MEMORY_SCOPE_AGENT); }
__device__ __forceinline__ unsigned xb_add(unsigned* p, unsigned v) { return __hip_atomic_fetch_add(p, v, __ATOMIC_RELAXED, __HIP_MEMORY_SCOPE_AGENT); }
__device__ __forceinline__ unsigned xb_xcc_id() { return (unsigned)__builtin_amdgcn_s_getreg((3 << 11) | 20) & 0xFu; }
#define XB_SPIN(cond, bar) do { unsigned _sp = 0; while (cond) { __builtin_amdgcn_s_sleep(1); \
    if ((++_sp & 255u) == 0u) { if (xb_ld(&(bar)[XB_TMO])) break; if (_sp > XB_SPIN_CAP) { atomicAdd(&(bar)[XB_TMO], 1u); break; } } } } while (0)

struct XcdBarrier {
    unsigned* bar; unsigned x; int wave;
    volatile LAS unsigned* st;
};

__device__ __forceinline__ bool xb_t0(int wave) { return wave == 0 && __builtin_amdgcn_mbcnt_hi(~0u, __builtin_amdgcn_mbcnt_lo(~0u, 0u)) == 0u; }
__device__ __forceinline__ XcdBarrier xcd_barrier_post(unsigned* bar, volatile LAS unsigned* st, int wave) {
    XcdBarrier b; b.bar = bar; b.x = xb_xcc_id(); b.st = st; b.wave = wave;
    if (xb_t0(wave)) (void)xb_add(&bar[XB_XCNT(b.x)], 1u);
    return b;
}
__device__ __forceinline__ void xcd_barrier_complete(unsigned* bar, unsigned x, unsigned& nloc, unsigned& nx) {
    const unsigned G = gridDim.x * gridDim.y * gridDim.z;
    unsigned sum, cnt, mine, sp = 0u;
    for (;;) {
        sum = 0u; cnt = 0u; mine = 0u;
#pragma unroll
        for (unsigned j = 0; j < 16; ++j) { const unsigned c = xb_ld(&bar[XB_XCNT(j)]); sum += c; cnt += (c > 0u) ? 1u : 0u; mine = (j == x) ? c : mine; }
        if (sum == G) break;
        __builtin_amdgcn_s_sleep(1);
        if ((++sp & 255u) == 0u) { if (xb_ld(&bar[XB_TMO])) break; if (sp > XB_SPIN_CAP) { atomicAdd(&bar[XB_TMO], 1u); break; } }
    }
    nloc = mine > 0u ? mine : 1u; nx = cnt > 0u ? cnt : 1u;
}

__device__ __forceinline__ void xcd_barrier(const XcdBarrier& b) {
    asm volatile("s_waitcnt vmcnt(0)" ::: "memory");
    __syncthreads();
    if (xb_t0(b.wave)) {
        unsigned* bar = b.bar;
        __builtin_amdgcn_s_waitcnt(0);
        unsigned nloc = b.st[0], nx = b.st[1];
        if (nloc == 0u) { xcd_barrier_complete(bar, b.x, nloc, nx); b.st[0] = nloc; b.st[1] = nx; }
        const unsigned old = xb_add(&bar[XB_XSUB(b.x)], 1u);
        const unsigned gen = old / nloc;
        if (old + 1u == (gen + 1u) * nloc) {
            __builtin_amdgcn_fence(__ATOMIC_RELEASE, "agent");
            asm volatile("s_waitcnt vmcnt(0)" ::: "memory");
            const unsigned og = xb_add(&bar[XB_TOP], 1u);
            const unsigned tg = og / nx;
            if (og + 1u == (tg + 1u) * nx) xb_add(&bar[XB_TOPGEN], 1u);
            else XB_SPIN(xb_ld(&bar[XB_TOPGEN]) == tg, bar);
            __builtin_amdgcn_fence(__ATOMIC_ACQUIRE, "agent");
            xb_add(&bar[XB_XGEN(b.x)], 1u);
            asm volatile("s_waitcnt vmcnt(0)" ::: "memory");
        } else {
            XB_SPIN(xb_ld(&bar[XB_XGEN(b.x)]) == gen, bar);
            __builtin_amdgcn_fence(__ATOMIC_ACQUIRE, "agent");
            asm volatile("s_waitcnt vmcnt(0)" ::: "memory");
        }
    }
    __syncthreads();
}
struct Frame {
    LAS unsigned char* lds;
    volatile LAS unsigned* MISC;
    gu32* ctl;
    int tid, lane, wave, vcu, G;
    const float *x, *g_mix, *g_ffn, *w_in_ab, *gq_a, *gk_a, *w_gate_up, *b_gate, *g_gla, *w_out_ab, *w_in_c, *gq_c, *gk_c, *w_out_c, *w_up, *w_down;
    float* out;
    bf16 *Wab, *Woab, *Wup0, *Wdn0, *Winc, *Woc, *Wup1, *Wdn1;
    bf16 *XB, *CAT, *R1;
    float* SSQ; unsigned* MASK;
};
__device__ __forceinline__ float bf2f(bf16 v) { return __builtin_bit_cast(float, (unsigned)v << 16); }
__device__ __forceinline__ float wave_sum(float v) {
#pragma unroll
    for (int o = 1; o < 64; o <<= 1) v += __shfl_xor(v, o);
    return v;
}
__device__ __forceinline__ float wave_max(float v) {
#pragma unroll
    for (int o = 1; o < 64; o <<= 1) v = fmaxf(v, __shfl_xor(v, o));
    return v;
}
__device__ __forceinline__ float log_sigmoid(float x) { return fminf(x, 0.f) - log1pf(expf(-fabsf(x))); }

__device__ __forceinline__ int oldcol_ab(int n) {
    if (n < 2048) return n;
    if (n < 2304) return 2120 + (n - 2048);
    if (n < 2560) return 2376 + (n - 2304);
    if (n < 3072) return 2632 + (n - 2560);
    if (n < 3584) return 3160 + (n - 3072);
    if (n < 3648) return 2048 + (n - 3584);
    if (n < 3656) return 2112 + (n - 3648);
    if (n < 3672) return 3144 + (n - 3656);
    return -1;
}
__device__ __forceinline__ void p0_transpose_item(const float* W, int ldw, int K, const float* gain, bf16* WT, bool map, LAS float* scr, int item, int nblk, int lane) {
    const int kb = item / nblk, nb = item % nblk, k0 = 64 * kb, n0 = 32 * nb;
    int oc = n0 + (lane & 31); if (map) oc = oldcol_ab(oc);
#pragma unroll 8
    for (int i = 0; i < 32; ++i) { const int kk = 2 * i + (lane >> 5); float v = 0.f;
        if (oc >= 0) { v = W[(size_t)(k0 + kk) * ldw + oc]; if (gain) v *= gain[k0 + kk]; }
        scr[kk * 33 + (lane & 31)] = v; }
    LDS_WAIT(); asm volatile("" ::: "memory");
    const int c = lane & 7;
#pragma unroll
    for (int j = 0; j < 4; ++j) { const int n = (lane >> 3) + 8 * j; const LAS float* s = scr + (8 * c) * 33 + n;
        v4u o; o.x = pk2(s[0 * 33], s[1 * 33]); o.y = pk2(s[2 * 33], s[3 * 33]); o.z = pk2(s[4 * 33], s[5 * 33]); o.w = pk2(s[6 * 33], s[7 * 33]);
        *(GAS v4u*)(WT + (size_t)(n0 + n) * K + k0 + 8 * c) = o; }
    LDS_WAIT(); asm volatile("" ::: "memory");
}
__device__ __forceinline__ void ph_prologue(Frame& F) {
    LAS float* scr = (LAS float*)(F.lds + F.wave * 16384);
    const int gw = F.vcu * NWAVES + F.wave, NGW = F.G * NWAVES;
    constexpr int I_AB = (D / 64) * (NAB / 32), I_O = (D / 64) * (D / 32), I_UP = (D / 64) * (FF / 32), I_DN = (FF / 64) * (D / 32), I_C = (D / 64) * (NC / 32);
    constexpr int NITEMS = I_AB + 2 * I_O + 2 * I_UP + 2 * I_DN + I_C;
    for (int it = gw; it < NITEMS; it += NGW) {
        int r = it;
        if (r < I_AB) { p0_transpose_item(F.w_in_ab, ABP_OLD, D, F.g_mix, F.Wab, true, scr, r, NAB / 32, F.lane); continue; } r -= I_AB;
        if (r < I_O) { p0_transpose_item(F.w_out_ab, D, D, nullptr, F.Woab, false, scr, r, D / 32, F.lane); continue; } r -= I_O;
        if (r < I_UP) { p0_transpose_item(F.w_up, FF, D, F.g_ffn, F.Wup0, false, scr, r, FF / 32, F.lane); continue; } r -= I_UP;
        if (r < I_DN) { p0_transpose_item(F.w_down, D, FF, nullptr, F.Wdn0, false, scr, r, D / 32, F.lane); continue; } r -= I_DN;
        if (r < I_C) { p0_transpose_item(F.w_in_c, NC, D, F.g_mix + D, F.Winc, false, scr, r, NC / 32, F.lane); continue; } r -= I_C;
        if (r < I_O) { p0_transpose_item(F.w_out_c, D, D, nullptr, F.Woc, false, scr, r, D / 32, F.lane); continue; } r -= I_O;
        if (r < I_UP) { p0_transpose_item(F.w_up + (size_t)D * FF, FF, D, F.g_ffn + D, F.Wup1, false, scr, r, FF / 32, F.lane); continue; } r -= I_UP;
        p0_transpose_item(F.w_down + (size_t)FF * D, D, FF, nullptr, F.Wdn1, false, scr, r, D / 32, F.lane);
    }
    for (int m = gw; m < M; m += NGW) {
        const GAS f32x4* xr = (const GAS f32x4*)(F.x + (size_t)m * D) + F.lane;
        f32x4 v[4]; float s = 0.f;
#pragma unroll
        for (int j = 0; j < 4; ++j) { v[j] = xr[64 * j]; s += (v[j].x * v[j].x + v[j].y * v[j].y) + (v[j].z * v[j].z + v[j].w * v[j].w); }
        s = wave_sum(s);
        GAS unsigned long long* o8 = (GAS unsigned long long*)(F.XB + (size_t)m * D) + F.lane;
#pragma unroll
        for (int j = 0; j < 4; ++j) o8[64 * j] = (unsigned long long)pk2(v[j].x, v[j].y) | ((unsigned long long)pk2(v[j].z, v[j].w) << 32);
        if (F.lane < 16) F.SSQ[(size_t)m * 16 + F.lane] = (F.lane == 0) ? s : 0.f;
    }
}
namespace att {
typedef short s16x4 __attribute__((ext_vector_type(4)));
typedef float f32x16 __attribute__((ext_vector_type(16)));
typedef _Float16 f16x8 __attribute__((ext_vector_type(8)));
typedef unsigned u32x4 __attribute__((ext_vector_type(4)));
typedef short v4i16_t __attribute__((ext_vector_type(4)));
constexpr float C2 = 0.08838834764831845f * 1.4426950408889634f;
__device__ __forceinline__ int crow(int r, int hi) { return (r & 3) + 8 * (r >> 2) + 4 * hi; }
__device__ __forceinline__ int img_off(int row, int ch) { return 256 * row + 16 * (ch ^ (((row & 3) << 2) | ((row >> 2) & 3))); }
__device__ __forceinline__ bf16x8 pack8(float a0, float a1, float a2, float a3, float a4, float a5, float a6, float a7) {
    u32x4 w; w.x = pg8::cvt_pk_bf16(a0, a1); w.y = pg8::cvt_pk_bf16(a2, a3); w.z = pg8::cvt_pk_bf16(a4, a5); w.w = pg8::cvt_pk_bf16(a6, a7);
    return __builtin_bit_cast(bf16x8, w);
}
__device__ __forceinline__ f16x8 pack8h(float a0, float a1, float a2, float a3, float a4, float a5, float a6, float a7) {
    f16x8 r; r[0] = (_Float16)a0; r[1] = (_Float16)a1; r[2] = (_Float16)a2; r[3] = (_Float16)a3; r[4] = (_Float16)a4; r[5] = (_Float16)a5; r[6] = (_Float16)a6; r[7] = (_Float16)a7; return r;
}
__device__ __forceinline__ void dma_off_init(unsigned (&dvo)[2], int ld, int wave, int lane) {
#pragma unroll
    for (int i = 0; i < 2; ++i) { const int pi = 2 * wave + i, row = 4 * pi + (lane >> 4), pc = lane & 15, ch = pc ^ (((row & 3) << 2) | ((row >> 2) & 3)); dvo[i] = (unsigned)(row * ld + ch * 8) * 2u; }
}
__device__ __forceinline__ void tile_dma(const bf16* g, const unsigned (&dvo)[2], LAS unsigned char* buf, int wave) {
#pragma unroll
    for (int i = 0; i < 2; ++i) __builtin_amdgcn_global_load_lds((const unsigned*)((const char*)g + dvo[i]), (LAS unsigned*)(buf + 1024 * (2 * wave + i)), 16, 0, 0);
}
struct FragOff { int k[8]; int va[4]; int vd; };
__device__ __forceinline__ void frag_off_init(FragOff& fo, int lane) {
    const int hi = lane >> 5, r32 = lane & 31, i = lane & 15, q = i >> 2, p = i & 3, x = 2 * ((lane >> 4) & 1) + (p >> 1);
#pragma unroll
    for (int ks = 0; ks < 8; ++ks) fo.k[ks] = img_off(r32, 2 * ks + hi);
#pragma unroll
    for (int ct = 0; ct < 4; ++ct) fo.va[ct] = img_off(4 * hi + q, 4 * ct + x) + 8 * (p & 1);
    fo.vd = img_off(4 * hi + q + 8, x) - img_off(4 * hi + q, x);
}
__device__ __forceinline__ bf16x8 k_frag(const LAS unsigned char* kbuf, const FragOff& fo, int rt, int ks) { return *(const LAS bf16x8*)(kbuf + fo.k[ks] + 8192 * rt); }
__device__ __forceinline__ s16x4 vtr(const LAS unsigned char* p) { return __builtin_bit_cast(s16x4, __builtin_amdgcn_ds_read_tr16_b64_v4i16((LAS v4i16_t*)p)); }
__device__ __forceinline__ bf16x8 v_frag(const LAS unsigned char* vbuf, const FragOff& fo, int ct, int kk) {
    const s16x4 lo = vtr(vbuf + fo.va[ct] + 4096 * kk), hh = vtr(vbuf + fo.va[ct] + fo.vd + 4096 * kk);
    return (bf16x8){lo[0], lo[1], lo[2], lo[3], hh[0], hh[1], hh[2], hh[3]};
}
__device__ __forceinline__ void store_o(const f32x16 (&o)[4], const float (&rscale)[16], LAS unsigned char* stg, bf16* dst, int ld, int lane) {
    const int hi = lane >> 5, r32 = lane & 31;
#pragma unroll
    for (int r = 0; r < 16; ++r) { const int orow = crow(r, hi);
#pragma unroll
        for (int ct = 0; ct < 4; ++ct) *(LAS bf16*)(stg + orow * 256 + (32 * ct + r32) * 2) = (bf16)f2bf(o[ct][r] * rscale[r]); }
    asm volatile("s_waitcnt lgkmcnt(0)" ::: "memory");
#pragma unroll
    for (int i = 0; i < 8; ++i) { const int c = lane + 64 * i, row = c >> 4, ch = c & 15; const u32x4 v = *(const LAS u32x4*)(stg + row * 256 + ch * 16); *(u32x4*)(dst + (size_t)row * ld + ch * 8) = v; }
}
}
template <bool SCALEQ> __device__ __forceinline__ void ph_prep_a(Frame& F) {
    const int gw = F.vcu * NWAVES + F.wave, NGW = F.G * NWAVES, lane = F.lane;
    for (int tok = gw; tok < M; tok += NGW) {
        const float pos = (float)(tok & (SEQ - 1));
        bf16* pr = F.R1 + (size_t)tok * NAB;
        float c128 = 1.f, s128 = 0.f;
        if (lane < 32) { const int i = lane & 15; const float inv = powf(500000.0f, -(float)i * 2.0f / 32.0f); const float ang = pos * inv; c128 = cosf(ang); s128 = sinf(ang); }
#pragma unroll
        for (int which = 0; which < 2; ++which) {
            const int base = which == 0 ? C_QA : C_KA;
            const float* gn = which == 0 ? F.gq_a : F.gk_a;
            for (int h = 0; h < 4; ++h) {
                float a = bf2f(pr[base + h * 128 + lane]), b = bf2f(pr[base + h * 128 + 64 + lane]);
                const float ss = wave_sum(a * a + b * b);
                const float rs = rsqrtf(ss * (1.f / 128.f) + EPS);
                const float qs = (SCALEQ && which == 0) ? att::C2 : 1.0f;
                a = a * rs * gn[lane] * qs; b = b * rs * gn[64 + lane] * qs;
                const float other = __shfl_xor(a, 16);
                float o = a;
                if (lane < 16) o = a * c128 - other * s128;
                else if (lane < 32) o = a * c128 + other * s128;
                pr[base + h * 128 + lane] = (bf16)f2bf(o); pr[base + h * 128 + 64 + lane] = (bf16)f2bf(b);
            }
        }
        float c64 = 1.f, s64 = 0.f;
        if (lane < 16) { const int i = lane & 7; const float inv = powf(500000.0f, -(float)i * 2.0f / 16.0f); const float ang = pos * inv; c64 = cosf(ang); s64 = sinf(ang); }
        for (int h = 0; h < 9; ++h) {
            const int col = (h < 8) ? C_IQ + h * 64 : C_IK;
            const float a = bf2f(pr[col + lane]);
            const float other = __shfl_xor(a, 8);
            float o = a;
            if (lane < 8) o = a * c64 - other * s64;
            else if (lane < 16) o = a * c64 + other * s64;
            pr[col + lane] = (bf16)f2bf(o);
        }
    }
}
__device__ __forceinline__ void ph_indexer_naive(Frame& F) {
    LAS float* sc = (LAS float*)F.lds;
    LAS float* qv = sc + 2048;
    LAS float* wv = qv + 512;
    LAS unsigned* mw = (LAS unsigned*)(wv + 8);
    const int tid = F.tid;
    for (int tok = F.vcu; tok < M; tok += F.G) {
        const int pos = tok & (SEQ - 1), seq0 = tok - pos, limit = ((pos >> 6) + 1) << 6;
        const bf16* pr = F.R1 + (size_t)tok * NAB;
        qv[tid] = bf2f(pr[C_IQ + tid]);
        if (tid < 8) wv[tid] = bf2f(pr[C_IW + tid]) * 0.35355339059327373f;
        if (tid < 64) mw[tid] = 0u;
        __syncthreads();
        for (int s = tid; s < limit; s += NTHR) {
            const bf16* kp = F.R1 + (size_t)(seq0 + s) * NAB + C_IK;
            float acc[8];
#pragma unroll
            for (int h = 0; h < 8; ++h) acc[h] = 0.f;
            for (int d = 0; d < 64; ++d) { const float kd = bf2f(kp[d]);
#pragma unroll
                for (int h = 0; h < 8; ++h) acc[h] = fmaf(qv[h * 64 + d], kd, acc[h]); }
            float score = 0.f;
#pragma unroll
            for (int h = 0; h < 8; ++h) score += fmaxf(acc[h] * 0.125f, 0.f) * wv[h];
            sc[s] = score;
        }
        __syncthreads();
        if (limit <= 256) { if (tid < 64) mw[tid] = (tid * 32 < limit) ? 0xffffffffu : 0u; }
        else {
            for (int s = tid; s < limit; s += NTHR) {
                const float v = sc[s]; int cnt = 0;
                for (int j = 0; j < limit; ++j) { const float u = sc[j]; cnt += ((u > v) || (u == v && j < s)) ? 1 : 0; }
                if (cnt < 256) atomicOr((unsigned*)&mw[s >> 5], 1u << (s & 31));
            }
        }
        __syncthreads();
        if (tid < 64) F.MASK[(size_t)tok * 64 + tid] = mw[tid];
        __syncthreads();
    }
}
__device__ __forceinline__ float block_sum(float v, LAS float* red, int tid) {
    v = wave_sum(v);
    __syncthreads();
    if ((tid & 63) == 0) red[tid >> 6] = v;
    __syncthreads();
    float r = 0.f;
#pragma unroll
    for (int i = 0; i < NWAVES; ++i) r += red[i];
    return r;
}
__device__ __forceinline__ float block_max(float v, LAS float* red, int tid) {
    v = wave_max(v);
    __syncthreads();
    if ((tid & 63) == 0) red[tid >> 6] = v;
    __syncthreads();
    float r = red[0];
#pragma unroll
    for (int i = 1; i < NWAVES; ++i) r = fmaxf(r, red[i]);
    return r;
}
__device__ __forceinline__ void ph_dsa_naive(Frame& F) {
    LAS unsigned* mw = (LAS unsigned*)F.lds;
    LAS int* pre = (LAS int*)(mw + 64);
    LAS int* idx = pre + 128;
    LAS float* pp = (LAS float*)(idx + 256);
    LAS float* q = pp + 512;
    LAS float* red = q + 512;
    const int tid = F.tid;
    for (int tok = F.vcu; tok < M; tok += F.G) {
        const int pos = tok & (SEQ - 1), seq0 = tok - pos;
        if (tid < 64) mw[tid] = F.MASK[(size_t)tok * 64 + tid];
        q[tid] = bf2f(F.R1[(size_t)tok * NAB + C_QA + tid]);
        __syncthreads();
        if (tid == 0) { int a = 0; for (int w = 0; w < 64; ++w) { pre[w] = a; a += __popc(mw[w]); } pre[64] = a; }
        __syncthreads();
        const int n = pre[64];
        for (int s = tid; s < SEQ; s += NTHR) { const unsigned w = mw[s >> 5]; if ((w >> (s & 31)) & 1u) idx[pre[s >> 5] + __popc(w & ((1u << (s & 31)) - 1u))] = s; }
        __syncthreads();
        for (int h = 0; h < 4; ++h) {
            float sv = -INFINITY;
            if (tid < n) { const bf16* kp = F.R1 + (size_t)(seq0 + idx[tid]) * NAB + C_KA + h * 128; float a = 0.f;
                for (int d = 0; d < 128; ++d) a = fmaf(q[h * 128 + d], bf2f(kp[d]), a);
                sv = a * 0.08838834764831845f; }
            const float m = block_max(sv, red, tid);
            const float e = (tid < n) ? expf(sv - m) : 0.f;
            const float l = block_sum(e, red, tid);
            pp[tid] = e;
            __syncthreads();
            if (tid < 128) { float o = 0.f;
                for (int j = 0; j < n; ++j) o = fmaf(pp[j], bf2f(F.R1[(size_t)(seq0 + idx[j]) * NAB + C_VA + h * 128 + tid]), o);
                F.CAT[(size_t)tok * D + h * 128 + tid] = (bf16)f2bf(o / l); }
            __syncthreads();
        }
    }
}
__device__ __forceinline__ void ph_gla_naive(Frame& F) {
    LAS float* sq = (LAS float*)F.lds; LAS float* sk = sq + 1024; LAS float* sd = sk + 1024;
    LAS float* sg = sd + 1024;
    LAS float* red = sg + 256;
    const int tid = F.tid, lane = F.lane;
    for (int item = F.vcu; item < BATCH * 4; item += F.G) {
        const int b = item >> 2, h = item & 3, seq0 = b * SEQ;
        float S[64];
#pragma unroll
        for (int d = 0; d < 64; ++d) S[d] = 0.f;
        for (int t0 = 0; t0 < SEQ; t0 += 16) {
            if (tid < 256) { const int tt = tid >> 4, r = tid & 15; sg[tid] = bf2f(F.R1[(size_t)(seq0 + t0 + tt) * NAB + C_GL + r]); }
            __syncthreads();
            for (int i = tid; i < 1024; i += NTHR) { const int tt = i >> 6, d = i & 63; const bf16* pr = F.R1 + (size_t)(seq0 + t0 + tt) * NAB;
                sq[i] = bf2f(pr[C_QB + h * 64 + d]) * 0.125f; sk[i] = bf2f(pr[C_KB + h * 64 + d]);
                float g = F.b_gate[h * 64 + d];
#pragma unroll
                for (int r = 0; r < 16; ++r) g = fmaf(sg[tt * 16 + r], F.w_gate_up[r * 256 + h * 64 + d], g);
                sd[i] = expf(log_sigmoid(g) * (1.f / 16.f)); }
            __syncthreads();
            float o[16];
            if (tid < 128) {
#pragma unroll
                for (int tt = 0; tt < 16; ++tt) {
                    const float v = bf2f(F.R1[(size_t)(seq0 + t0 + tt) * NAB + C_VB + h * 128 + tid]); float a = 0.f;
#pragma unroll
                    for (int d = 0; d < 64; ++d) { S[d] = fmaf(sd[tt * 64 + d], S[d], sk[tt * 64 + d] * v); a = fmaf(sq[tt * 64 + d], S[d], a); }
                    o[tt] = a;
                    const float ws = wave_sum(a * a);
                    if (lane == 0) red[tt * 2 + (tid >> 6)] = ws;
                }
            }
            __syncthreads();
            if (tid < 128) {
#pragma unroll
                for (int tt = 0; tt < 16; ++tt) {
                    const size_t tok = seq0 + t0 + tt;
                    const float rs = rsqrtf((red[tt * 2] + red[tt * 2 + 1]) * (1.f / 128.f) + EPS);
                    const float og = bf2f(F.R1[tok * NAB + C_OG + h * 128 + tid]);
                    F.CAT[tok * D + 512 + h * 128 + tid] = (bf16)f2bf(o[tt] * rs * F.g_gla[tid] * (og / (1.f + expf(-og))));
                }
            }
            __syncthreads();
        }
    }
}
template <bool SCALEQ> __device__ __forceinline__ void ph_prep_c(Frame& F) {
    const int gw = F.vcu * NWAVES + F.wave, NGW = F.G * NWAVES, lane = F.lane;
    for (int it = gw; it < M * 16; it += NGW) {
        const int tok = it >> 4, hh = it & 15, isk = hh >> 3, h = hh & 7;
        bf16* p = F.R1 + (size_t)tok * NC + isk * 1024 + h * 128;
        const float* gn = isk ? F.gk_c : F.gq_c;
        const float a = bf2f(p[lane]), b = bf2f(p[64 + lane]);
        const float rs = rsqrtf(wave_sum(a * a + b * b) * (1.f / 128.f) + EPS);
        const float sc = (SCALEQ && !isk) ? att::C2 : 1.0f;
        p[lane] = (bf16)f2bf(a * rs * gn[lane] * sc); p[64 + lane] = (bf16)f2bf(b * rs * gn[64 + lane] * sc);
    }
}
__device__ __forceinline__ void ph_sb_naive(Frame& F) {
    const int gw = F.vcu * NWAVES + F.wave, NGW = F.G * NWAVES, lane = F.lane;
    for (int it = gw; it < M * 8; it += NGW) {
        const int tok = it >> 3, h = it & 7, pos = tok & (SEQ - 1), seq0 = tok - pos;
        const unsigned qq = *(const unsigned*)(F.R1 + (size_t)tok * NC + h * 128 + 2 * lane);
        const float q0 = __builtin_bit_cast(float, qq << 16), q1 = __builtin_bit_cast(float, qq & 0xffff0000u);
        float R = 0.f, o0 = 0.f, o1 = 0.f;
        for (int s = pos - 1; s >= 0; --s) {
            const bf16* pr = F.R1 + (size_t)(seq0 + s) * NC + h * 128 + 2 * lane;
            const unsigned kk = *(const unsigned*)(pr + 1024), vv = *(const unsigned*)(pr + 2048);
            const float k0 = __builtin_bit_cast(float, kk << 16), k1 = __builtin_bit_cast(float, kk & 0xffff0000u);
            const float z = wave_sum(q0 * k0 + q1 * k1) * 0.08838834764831845f;
            const float sp = log1pf(expf(-fabsf(z)));
            const float lsp = fminf(z, 0.f) - sp, lsn = fminf(-z, 0.f) - sp;
            const float a = expf(lsp + R);
            o0 = fmaf(a, __builtin_bit_cast(float, vv << 16), o0); o1 = fmaf(a, __builtin_bit_cast(float, vv & 0xffff0000u), o1);
            R += lsn;
        }
        *(unsigned*)(F.CAT + (size_t)tok * D + h * 128 + 2 * lane) = pk2(o0, o1);
    }
}
__device__ __forceinline__ void sb_unit(Frame& F, int b, int h, int qb) {
    using namespace att;
    const int tid = F.tid, lane = F.lane, w = F.wave, hi = lane >> 5, r32 = lane & 31;
    const bf16* Qg = F.R1 + (size_t)b * SEQ * NC + h * 128; const bf16* Kg = Qg + 1024; const bf16* Vg = Qg + 2048;
    const int T0 = qb * 256, t0w = T0 + 32 * w, jd = t0w >> 6, jtop = (T0 >> 6) + 3, tl = 32 * (w & 1) + r32;
    LAS unsigned char* lds = F.lds;
    FragOff fo; frag_off_init(fo, lane);
    unsigned dvo[2]; dma_off_init(dvo, NC, w, lane);
    bf16x8 qf[8];
#pragma unroll
    for (int ks = 0; ks < 8; ++ks) qf[ks] = *(const bf16x8*)(Qg + (size_t)(t0w + r32) * NC + 16 * ks + 8 * hi);
    f16x8 T0f, T1f, ONEf;
#pragma unroll
    for (int j = 0; j < 8; ++j) { const int kp = 8 * (j >> 2) + 4 * hi + (j & 3); T0f[j] = (kp >= r32) ? (_Float16)1.0f : (_Float16)0.0f; T1f[j] = (kp + 16 >= r32) ? (_Float16)1.0f : (_Float16)0.0f; ONEf[j] = (_Float16)1.0f; }
    f32x16 o[4];
#pragma unroll
    for (int ct = 0; ct < 4; ++ct)
#pragma unroll
        for (int r = 0; r < 16; ++r) o[ct][r] = 0.f;
    float R2 = 0.f; bool done = false;
    volatile LAS unsigned* flags = F.MISC + 16;
    tile_dma(Kg + (size_t)(64 * jtop) * NC, dvo, lds, w); tile_dma(Vg + (size_t)(64 * jtop) * NC, dvo, lds + 16384, w);
    asm volatile("s_waitcnt vmcnt(0)" ::: "memory");
    __syncthreads();
    for (int j = jtop; j >= 0; --j) {
        const int cur = (jtop - j) & 1;
        const LAS unsigned char* kb = lds + cur * 32768; const LAS unsigned char* vb = kb + 16384;
        if (j > 0) { tile_dma(Kg + (size_t)(64 * (j - 1)) * NC, dvo, lds + (cur ^ 1) * 32768, w); tile_dma(Vg + (size_t)(64 * (j - 1)) * NC, dvo, lds + (cur ^ 1) * 32768 + 16384, w); }
        if (j <= jd && !done) {
            f32x16 p0, p1;
#pragma unroll
            for (int r = 0; r < 16; ++r) { p0[r] = 0.f; p1[r] = 0.f; }
#pragma unroll
            for (int ks = 0; ks < 8; ++ks) { const bf16x8 a0 = k_frag(kb, fo, 0, ks), a1 = k_frag(kb, fo, 1, ks);
                p0 = __builtin_amdgcn_mfma_f32_32x32x16_bf16(a0, qf[ks], p0, 0, 0, 0); p1 = __builtin_amdgcn_mfma_f32_32x32x16_bf16(a1, qf[ks], p1, 0, 0, 0); }
            const bool diag = (j == jd);
            float x0[16], x1[16]; float rs = 0.f;
#pragma unroll
            for (int r = 0; r < 16; ++r) { const int key = crow(r, hi);
                float l0 = -__builtin_amdgcn_logf(1.0f + __builtin_amdgcn_exp2f(p0[r])), l1 = -__builtin_amdgcn_logf(1.0f + __builtin_amdgcn_exp2f(p1[r]));
                if (diag) { if (!(key < tl)) l0 = 0.f; if (!(key + 32 < tl)) l1 = 0.f; }
                x0[r] = l0; x1[r] = l1; rs += l0 + l1; p0[r] += R2; p1[r] += R2; }
            const f16x8 xb00 = pack8h(x0[0], x0[1], x0[2], x0[3], x0[4], x0[5], x0[6], x0[7]), xb01 = pack8h(x0[8], x0[9], x0[10], x0[11], x0[12], x0[13], x0[14], x0[15]);
            const f16x8 xb10 = pack8h(x1[0], x1[1], x1[2], x1[3], x1[4], x1[5], x1[6], x1[7]), xb11 = pack8h(x1[8], x1[9], x1[10], x1[11], x1[12], x1[13], x1[14], x1[15]);
            p0 = __builtin_amdgcn_mfma_f32_32x32x16_f16(T0f, xb00, p0, 0, 0, 0); p0 = __builtin_amdgcn_mfma_f32_32x32x16_f16(T1f, xb01, p0, 0, 0, 0);
            p0 = __builtin_amdgcn_mfma_f32_32x32x16_f16(ONEf, xb10, p0, 0, 0, 0); p0 = __builtin_amdgcn_mfma_f32_32x32x16_f16(ONEf, xb11, p0, 0, 0, 0);
            p1 = __builtin_amdgcn_mfma_f32_32x32x16_f16(T0f, xb10, p1, 0, 0, 0); p1 = __builtin_amdgcn_mfma_f32_32x32x16_f16(T1f, xb11, p1, 0, 0, 0);
#pragma unroll
            for (int r = 0; r < 16; ++r) { const int key = crow(r, hi);
                float a0 = __builtin_amdgcn_exp2f(p0[r]), a1 = __builtin_amdgcn_exp2f(p1[r]);
                if (diag) { if (!(key < tl)) a0 = 0.f; if (!(key + 32 < tl)) a1 = 0.f; }
                p0[r] = a0; p1[r] = a1; }
            const bf16x8 pa0 = pack8(p0[0], p0[1], p0[2], p0[3], p0[4], p0[5], p0[6], p0[7]), pa1 = pack8(p0[8], p0[9], p0[10], p0[11], p0[12], p0[13], p0[14], p0[15]);
            const bf16x8 pa2 = pack8(p1[0], p1[1], p1[2], p1[3], p1[4], p1[5], p1[6], p1[7]), pa3 = pack8(p1[8], p1[9], p1[10], p1[11], p1[12], p1[13], p1[14], p1[15]);
#pragma unroll
            for (int ct = 0; ct < 4; ++ct) {
                o[ct] = __builtin_amdgcn_mfma_f32_32x32x16_bf16(pa0, v_frag(vb, fo, ct, 0), o[ct], 0, 0, 0);
                o[ct] = __builtin_amdgcn_mfma_f32_32x32x16_bf16(pa1, v_frag(vb, fo, ct, 1), o[ct], 0, 0, 0);
                o[ct] = __builtin_amdgcn_mfma_f32_32x32x16_bf16(pa2, v_frag(vb, fo, ct, 2), o[ct], 0, 0, 0);
                o[ct] = __builtin_amdgcn_mfma_f32_32x32x16_bf16(pa3, v_frag(vb, fo, ct, 3), o[ct], 0, 0, 0);
            }
            rs += __shfl_xor(rs, 32);
            R2 += rs;
            done = __all(R2 < -152.0f);
        }
        if (lane == 0) flags[cur * 8 + w] = done ? 1u : 0u;
        asm volatile("s_waitcnt vmcnt(0) lgkmcnt(0)" ::: "memory");
        __syncthreads();
        unsigned alld = 1u;
#pragma unroll
        for (int i = 0; i < 8; ++i) alld &= flags[cur * 8 + i];
        if (alld) break;
    }
    float ones[16];
#pragma unroll
    for (int r = 0; r < 16; ++r) ones[r] = 1.0f;
    store_o(o, ones, lds + w * 8192, F.CAT + (size_t)(b * SEQ + t0w) * D + h * 128, D, lane);
    __syncthreads();
}
__device__ __forceinline__ void ph_sb(Frame& F) {
    for (int v = F.vcu; v < BATCH * 8 * 2; v += F.G) {
        const int bh = v >> 1, half = v & 1;
#pragma unroll 1
        for (int i = 0; i < 4; ++i) { const int qb = half ? (i == 0 ? 1 : i == 1 ? 6 : i == 2 ? 2 : 5) : (i == 0 ? 0 : i == 1 ? 7 : i == 2 ? 3 : 4); sb_unit(F, bh >> 3, bh & 7, qb); }
    }
}
__device__ __forceinline__ void dsa_unit(Frame& F, int b, int h, int ub, float mref) {
    using namespace att;
    const int lane = F.lane, w = F.wave, hi = lane >> 5, r32 = lane & 31;
    const bf16* Qg = F.R1 + (size_t)b * SEQ * NAB + C_QA + h * 128; const bf16* Kg = F.R1 + (size_t)b * SEQ * NAB + C_KA + h * 128; const bf16* Vg = F.R1 + (size_t)b * SEQ * NAB + C_VA + h * 128;
    const int t0w = 256 * ub + 32 * w, cw = t0w >> 6, jlast = 4 * ub + 3;
    LAS unsigned char* lds = F.lds;
    LAS unsigned char* mst = lds + 65536 + w * 8448;
    FragOff fo; frag_off_init(fo, lane);
    unsigned dvo[2]; dma_off_init(dvo, NAB, w, lane);
    tile_dma(Kg, dvo, lds, w); tile_dma(Vg, dvo, lds + 16384, w);
    bf16x8 qf[8];
#pragma unroll
    for (int ks = 0; ks < 8; ++ks) qf[ks] = *(const bf16x8*)(Qg + (size_t)(t0w + r32) * NAB + 16 * ks + 8 * hi);
    { const unsigned* mg = F.MASK + (size_t)(b * SEQ + t0w) * 64;
#pragma unroll 2
      for (int i = 0; i < 8; ++i) { const int c = lane + 64 * i, row = c >> 4, c4 = c & 15; const u32x4 v = *(const u32x4*)(mg + row * 64 + c4 * 4);
          *(LAS unsigned long long*)(mst + row * 264 + c4 * 16) = (unsigned long long)v.x | ((unsigned long long)v.y << 32);
          *(LAS unsigned long long*)(mst + row * 264 + c4 * 16 + 8) = (unsigned long long)v.z | ((unsigned long long)v.w << 32); } }
    f32x16 o[4];
#pragma unroll
    for (int ct = 0; ct < 4; ++ct)
#pragma unroll
        for (int r = 0; r < 16; ++r) o[ct][r] = 0.f;
    float lsum = 0.f;
    asm volatile("s_waitcnt vmcnt(0) lgkmcnt(0)" ::: "memory");
    __syncthreads();
    for (int j = 0; j <= jlast; ++j) {
        const int cur = j & 1;
        const LAS unsigned char* kb = lds + cur * 32768; const LAS unsigned char* vb = kb + 16384;
        if (j < jlast) { tile_dma(Kg + (size_t)(64 * (j + 1)) * NAB, dvo, lds + (cur ^ 1) * 32768, w); tile_dma(Vg + (size_t)(64 * (j + 1)) * NAB, dvo, lds + (cur ^ 1) * 32768 + 16384, w); }
        if (j <= cw) {
            const unsigned long long mw = *(const LAS unsigned long long*)(mst + r32 * 264 + j * 8);
            const unsigned mw0 = (unsigned)mw, mw1 = (unsigned)(mw >> 32);
#pragma unroll
            for (int half = 0; half < 2; ++half) {
                const unsigned mwh = half ? mw1 : mw0;
                f32x16 p;
#pragma unroll
                for (int r = 0; r < 16; ++r) p[r] = -mref;
#pragma unroll
                for (int ks = 0; ks < 8; ++ks) p = __builtin_amdgcn_mfma_f32_32x32x16_bf16(k_frag(kb, fo, half, ks), qf[ks], p, 0, 0, 0);
#pragma unroll
                for (int r = 0; r < 16; ++r) { const unsigned keep = (unsigned)(-(int)((mwh >> crow(r, hi)) & 1u));
                    const float e = __uint_as_float(__float_as_uint(__builtin_amdgcn_exp2f(p[r])) & keep); p[r] = e; lsum += e; }
                const bf16x8 pa0 = pack8(p[0], p[1], p[2], p[3], p[4], p[5], p[6], p[7]), pa1 = pack8(p[8], p[9], p[10], p[11], p[12], p[13], p[14], p[15]);
#pragma unroll
                for (int ct = 0; ct < 4; ++ct) {
                    o[ct] = __builtin_amdgcn_mfma_f32_32x32x16_bf16(pa0, v_frag(vb, fo, ct, 2 * half), o[ct], 0, 0, 0);
                    o[ct] = __builtin_amdgcn_mfma_f32_32x32x16_bf16(pa1, v_frag(vb, fo, ct, 2 * half + 1), o[ct], 0, 0, 0);
                }
            }
        }
        asm volatile("s_waitcnt vmcnt(0) lgkmcnt(0)" ::: "memory");
        __syncthreads();
    }
    lsum += __shfl_xor(lsum, 32);
    LAS float* lsc = (LAS float*)mst;
    if (hi == 0) lsc[r32] = 1.0f / lsum;
    asm volatile("s_waitcnt lgkmcnt(0)" ::: "memory");
    float rsc[16];
#pragma unroll
    for (int r = 0; r < 16; ++r) rsc[r] = lsc[crow(r, hi)];
    store_o(o, rsc, lds + w * 8192, F.CAT + (size_t)(b * SEQ + t0w) * D + h * 128, D, lane);
    __syncthreads();
}
__device__ __forceinline__ void ph_dsa(Frame& F) {
    float gm = fmaxf(fabsf(F.gq_a[F.lane]), fabsf(F.gq_a[64 + F.lane])), km = fmaxf(fabsf(F.gk_a[F.lane]), fabsf(F.gk_a[64 + F.lane]));
    gm = wave_max(gm); km = wave_max(km);
    const float mref = att::C2 * 128.0f * gm * km * 1.02f;
    for (int v = F.vcu; v < BATCH * 4 * 4; v += F.G) {
        const int bh = v >> 2, pi = v & 3;
        dsa_unit(F, bh >> 2, bh & 3, pi, mref);
        dsa_unit(F, bh >> 2, bh & 3, 7 - pi, mref);
    }
}
#ifndef MK_PER_PHASE
#define MK_PER_PHASE 0
#endif
constexpr int NPH = 14;
struct Args { const float* in[16]; float* out; unsigned char* ws; int ph_lo, ph_hi; };
__global__ void __launch_bounds__(NTHR, 2) mk_fwd(Args args) {
    extern __shared__ __attribute__((aligned(16))) unsigned char lds[];
    Frame F;
    F.lds = (LAS unsigned char*)lds;
    F.MISC = (volatile LAS unsigned*)(F.lds + MISC_OFF);
    F.wave = __builtin_amdgcn_readfirstlane((int)threadIdx.x >> 6);
#define RELANE() (F.lane = (int)__builtin_amdgcn_mbcnt_hi(~0u, __builtin_amdgcn_mbcnt_lo(~0u, 0u)), F.tid = F.wave * 64 + F.lane, true)
    RELANE();
    F.G = gridDim.x; { const int bx = blockIdx.x; F.vcu = (F.G % 8 == 0) ? (bx % 8) * (F.G / 8) + bx / 8 : bx; }
    unsigned char* ws = args.ws;
    F.ctl = (gu32*)(ws + WS_CTL);
    F.x = args.in[0]; F.g_mix = args.in[1]; F.g_ffn = args.in[2]; F.w_in_ab = args.in[3]; F.gq_a = args.in[4]; F.gk_a = args.in[5]; F.w_gate_up = args.in[6]; F.b_gate = args.in[7];
    F.g_gla = args.in[8]; F.w_out_ab = args.in[9]; F.w_in_c = args.in[10]; F.gq_c = args.in[11]; F.gk_c = args.in[12]; F.w_out_c = args.in[13]; F.w_up = args.in[14]; F.w_down = args.in[15];
    F.out = args.out;
    F.Wab = (bf16*)(ws + WS_WAB); F.Woab = (bf16*)(ws + WS_WOAB); F.Wup0 = (bf16*)(ws + WS_WUP0); F.Wdn0 = (bf16*)(ws + WS_WDN0);
    F.Winc = (bf16*)(ws + WS_WINC); F.Woc = (bf16*)(ws + WS_WOC); F.Wup1 = (bf16*)(ws + WS_WUP1); F.Wdn1 = (bf16*)(ws + WS_WDN1);
    F.XB = (bf16*)(ws + WS_XB); F.CAT = (bf16*)(ws + WS_CAT); F.R1 = (bf16*)(ws + WS_R1); F.SSQ = (float*)(ws + WS_SSQ); F.MASK = (unsigned*)(ws + WS_MASK);
    for (int u = F.tid; u < (LDS_BYTES - MISC_OFF) / 4; u += NTHR) ((LAS unsigned*)(F.lds + MISC_OFF))[u] = 0u;
    __syncthreads();
    XcdBarrier bar; bar.bar = (unsigned*)(F.ctl + CW_BAR); bar.x = 0; bar.st = nullptr; bar.wave = F.wave;
    if (!MK_PER_PHASE) bar = xcd_barrier_post((unsigned*)(F.ctl + CW_BAR), F.MISC + 8, F.wave);
    const int lo = args.ph_lo, hi = args.ph_hi;
#define IN(k) (lo <= (k) && (k) < hi && RELANE())
#define SEAM(k) do { if (lo <= (k) && (k) + 1 < hi) xcd_barrier(bar); } while (0)
    float* const SSQ0 = F.SSQ, *SSQ1 = F.SSQ + (size_t)M * 16, *SSQ2 = F.SSQ + (size_t)2 * M * 16, *SSQ3 = F.SSQ + (size_t)3 * M * 16;
    typedef pg8::StaticOrder SO;
    if (IN(0)) { ph_prologue(F); } SEAM(0);
    if (IN(1)) { pg8::Gemm g{F.XB, F.Wab, M, NAB, D}; SO S; S.init(M, NAB, F.G, (int)blockIdx.x); pg8::EpiScale<0> E{F.R1, NAB, SSQ0};
        pg8::gemm_phase<pg8::EpiScale<0>, SO, true, true>(F.lds, g, S, E, F.wave); } SEAM(1);
    if (IN(2)) { ph_prep_a<true>(F); } SEAM(2);
    if (IN(3)) { ph_indexer_naive(F); } SEAM(3);
    if (IN(4)) { ph_dsa(F); __syncthreads(); ph_gla_naive(F); } SEAM(4);
    if (IN(5)) { pg8::Gemm g{F.CAT, F.Woab, M, D, D}; SO S; S.init(M, D, F.G, (int)blockIdx.x); pg8::EpiResid<1> E{F.x, F.out, F.XB, SSQ1};
        pg8::gemm_phase<pg8::EpiResid<1>, SO, true, true>(F.lds, g, S, E, F.wave); } SEAM(5);
    if (IN(6)) { pg8::Gemm g{F.XB, F.Wup0, M, FF, D}; SO S; S.init(M, FF, F.G, (int)blockIdx.x); pg8::EpiScale<1> E{F.R1, FF, SSQ1};
        pg8::gemm_phase<pg8::EpiScale<1>, SO, true, true>(F.lds, g, S, E, F.wave); } SEAM(6);
    if (IN(7)) { pg8::Gemm g{F.R1, F.Wdn0, M, D, FF}; SO S; S.init(M, D, F.G, (int)blockIdx.x); pg8::EpiResid<1> E{F.out, F.out, F.XB, SSQ2};
        pg8::gemm_phase<pg8::EpiResid<1>, SO, true, true>(F.lds, g, S, E, F.wave); } SEAM(7);
    if (IN(8)) { pg8::Gemm g{F.XB, F.Winc, M, NC, D}; SO S; S.init(M, NC, F.G, (int)blockIdx.x); pg8::EpiScale<0> E{F.R1, NC, SSQ2};
        pg8::gemm_phase<pg8::EpiScale<0>, SO, true, true>(F.lds, g, S, E, F.wave); } SEAM(8);
    if (IN(9)) { ph_prep_c<true>(F); } SEAM(9);
    if (IN(10)) { ph_sb(F); } SEAM(10);
    if (IN(11)) { pg8::Gemm g{F.CAT, F.Woc, M, D, D}; SO S; S.init(M, D, F.G, (int)blockIdx.x); pg8::EpiResid<1> E{F.out, F.out, F.XB, SSQ3};
        pg8::gemm_phase<pg8::EpiResid<1>, SO, true, true>(F.lds, g, S, E, F.wave); } SEAM(11);
    if (IN(12)) { pg8::Gemm g{F.XB, F.Wup1, M, FF, D}; SO S; S.init(M, FF, F.G, (int)blockIdx.x); pg8::EpiScale<1> E{F.R1, FF, SSQ3};
        pg8::gemm_phase<pg8::EpiScale<1>, SO, true, true>(F.lds, g, S, E, F.wave); } SEAM(12);
    if (IN(13)) { pg8::Gemm g{F.R1, F.Wdn1, M, D, FF}; SO S; S.init(M, D, F.G, (int)blockIdx.x); pg8::EpiResid<0> E{F.out, F.out, nullptr, nullptr};
        pg8::gemm_phase<pg8::EpiResid<0>, SO, true, true>(F.lds, g, S, E, F.wave); }
#undef IN
#undef SEAM
}

extern "C" void kernel_launch(void* const* d_in, const int* in_sizes, int n_in, void* d_out, int out_size, void* d_ws, size_t ws_size, hipStream_t stream) {
    static int grid = 0;
    if (grid == 0) {
        if (n_in != 16 || in_sizes[0] != M * D || out_size != M * D || ws_size < WS_END) { fprintf(stderr, "kernel_launch: unexpected shapes / workspace (%d inputs, ws %zu)\n", n_in, ws_size); grid = -1; return; }
        int dev = 0, cus = 0;
        if (hipGetDevice(&dev) != hipSuccess || hipDeviceGetAttribute(&cus, hipDeviceAttributeMultiprocessorCount, dev) != hipSuccess) { grid = -1; return; }
        if (hipFuncSetAttribute((const void*)mk_fwd, hipFuncAttributeMaxDynamicSharedMemorySize, LDS_BYTES) != hipSuccess) { fprintf(stderr, "kernel_launch: hipFuncSetAttribute failed\n"); grid = -1; return; }
        (void)hipGetLastError();
        grid = cus;
    }
    if (grid < 0) return;
    if (hipMemsetAsync((char*)d_ws + WS_CTL, 0, CTL_ZERO_BYTES, stream) != hipSuccess) { fprintf(stderr, "kernel_launch: memset failed\n"); return; }
    Args a{};
    for (int i = 0; i < 16; ++i) a.in[i] = (const float*)d_in[i];
    a.out = (float*)d_out; a.ws = (unsigned char*)d_ws;
#if MK_PER_PHASE
    for (int ph = 0; ph < NPH; ++ph) { a.ph_lo = ph; a.ph_hi = ph + 1; hipLaunchKernelGGL(mk_fwd, dim3(grid), dim3(NTHR), LDS_BYTES, stream, a); }
#else
    a.ph_lo = 0; a.ph_hi = NPH;
    hipLaunchKernelGGL(mk_fwd, dim3(grid), dim3(NTHR), LDS_BYTES, stream, a);
#endif
    const hipError_t le = hipPeekAtLastError();
    if (le != hipSuccess) fprintf(stderr, "kernel_launch: launch failed: %s\n", hipGetErrorName(le));
}
```

```cpp
#include <hip/hip_runtime.h>
#include <cstdio>
#include <cstdint>
namespace pg8 {
#define PG8_LAS __attribute__((address_space(3)))
typedef unsigned short bf16_t;
typedef short bf16x8 __attribute__((ext_vector_type(8)));
typedef float f32x4 __attribute__((ext_vector_type(4)));
typedef unsigned u32x4 __attribute__((ext_vector_type(4)));
constexpr int BM = 256, BK = 64, HALF = 128, HTB = HALF * BK * 2  , STAGE_BYTES = 8 * HTB, NXCD = 8, WGM = 8;

__host__ __device__ __forceinline__ int lds_byte(int r, int c) { const int st = (r >> 4) * 2 + (c >> 5), rr = r & 15, cc = c & 31, ob = rr * 64 + cc * 2; return st * 1024 + (ob ^ (((ob >> 9) & 1) << 5)); }
__host__ __device__ __forceinline__ void stage_rc(int b, int& R, int& C) { const int st = b / 1024, sb = b % 1024, swz = sb ^ (((sb >> 9) & 1) << 5); R = (st >> 1) * 16 + swz / 64; C = (st & 1) * 32 + (swz % 64) / 2; }
__host__ __device__ __forceinline__ int perm32(int rho) { const int n = rho >> 4, i = rho & 15; return 8 * (i >> 2) + 4 * n + (i & 3); }

struct Unit { int pm, pn; };
struct Gemm { const bf16_t* A; const bf16_t* Bt; int M, N, K; };

struct StaticOrder {
    int nM, nN, nwg, G, c;
    __host__ __device__ void init(int M, int N, int G_, int c_) { nM = M / BM; nN = N / BM; nwg = nM * nN; G = G_; c = c_; }
    __host__ __device__ bool next(int i, Unit& u) const {
        const long L = (long)i * G + c; if (L >= nwg) return false;
        int wgid = (int)L; { const int q = nwg / NXCD, r = nwg % NXCD, xcd = wgid % NXCD, off = wgid / NXCD; wgid = (xcd < r ? xcd * (q + 1) : r * (q + 1) + (xcd - r) * q) + off; }
        const int nig = WGM * nN, gid = wgid / nig, fm = gid * WGM, gsz = (nM - fm) < WGM ? (nM - fm) : WGM;
        u.pm = fm + ((wgid % nig) % gsz); u.pn = (wgid % nig) / gsz; return true;
    }
    __device__ __forceinline__ void a_ready(const Unit&) const {}
    __device__ __forceinline__ void done(const Unit&) const {}
};

__device__ __forceinline__ unsigned cvt_pk_bf16(float lo, float hi) { unsigned r; asm volatile("v_cvt_pk_bf16_f32 %0, %1, %2" : "=v"(r) : "v"(lo), "v"(hi)); return r; }
__device__ __forceinline__ float row_rstd(const float* ssqp, int row) {
    const f32x4* p = (const f32x4*)(ssqp + (size_t)row * 16);
    const f32x4 a = p[0], b = p[1], c = p[2], d = p[3];
    const float s = (((a[0] + a[1]) + (a[2] + a[3])) + ((b[0] + b[1]) + (b[2] + b[3]))) + (((c[0] + c[1]) + (c[2] + c[3])) + ((d[0] + d[1]) + (d[2] + d[3])));
    return rsqrtf(s * (1.0f / 1024.0f) + 1e-6f);
}
template <int ACT  > struct EpiScale {
    static constexpr bool PERM = true, AFTER_DRAIN = false;
    bf16_t* O; int ldc; const float* ssqp;
    __device__ __forceinline__ void operator()(const f32x4 (&acc)[2][2][4][2], const Unit& u, int wr, int wc, int fr, int fq) const {
        const int row0 = u.pm * BM + wr * 64 + fr, col0 = u.pn * BM + wc * 32 + 8 * fq;
#pragma unroll
        for (int ai = 0; ai < 2; ++ai)
#pragma unroll
            for (int m = 0; m < 4; ++m) {
                const int row = row0 + ai * HALF + m * 16;
                const float rs = row_rstd(ssqp, row);
                bf16_t* rowp = O + (size_t)row * ldc + col0;
#pragma unroll
                for (int bj = 0; bj < 2; ++bj) {
                    f32x4 v0 = acc[ai][bj][m][0] * rs, v1 = acc[ai][bj][m][1] * rs;
                    if (ACT == 1) {
#pragma unroll
                        for (int e = 0; e < 4; ++e) { const float a0 = fmaxf(v0[e], 0.f), a1 = fmaxf(v1[e], 0.f); v0[e] = a0 * a0; v1[e] = a1 * a1; }
                    }
                    u32x4 w; w.x = cvt_pk_bf16(v0[0], v0[1]); w.y = cvt_pk_bf16(v0[2], v0[3]); w.z = cvt_pk_bf16(v1[0], v1[1]); w.w = cvt_pk_bf16(v1[2], v1[3]);
                    *(u32x4*)(rowp + bj * HALF) = w;
                }
            }
    }
};
template <int WRITE_HB> struct EpiResid {
    static constexpr bool PERM = true, AFTER_DRAIN = false;
    const float* R; float* out; bf16_t* hb; float* ssqp;
    __device__ __forceinline__ void operator()(const f32x4 (&acc)[2][2][4][2], const Unit& u, int wr, int wc, int fr, int fq) const {
        const int row0 = u.pm * BM + wr * 64 + fr, col0 = u.pn * BM + wc * 32 + 8 * fq;
#pragma unroll
        for (int ai = 0; ai < 2; ++ai)
#pragma unroll
            for (int m = 0; m < 4; ++m) {
                const int row = row0 + ai * HALF + m * 16;
                const size_t off = (size_t)row * 1024 + col0;
                float ss = 0.f;
#pragma unroll
                for (int bj = 0; bj < 2; ++bj) {
                    const f32x4 r0 = *(const f32x4*)(R + off + bj * HALF), r1 = *(const f32x4*)(R + off + bj * HALF + 4);
                    const f32x4 v0 = acc[ai][bj][m][0] + r0, v1 = acc[ai][bj][m][1] + r1;
                    *(f32x4*)(out + off + bj * HALF) = v0; *(f32x4*)(out + off + bj * HALF + 4) = v1;
                    if (WRITE_HB) {
                        u32x4 w; w.x = cvt_pk_bf16(v0[0], v0[1]); w.y = cvt_pk_bf16(v0[2], v0[3]); w.z = cvt_pk_bf16(v1[0], v1[1]); w.w = cvt_pk_bf16(v1[2], v1[3]);
                        *(u32x4*)(hb + off + bj * HALF) = w;
                        ss += ((v0[0] * v0[0] + v0[1] * v0[1]) + (v0[2] * v0[2] + v0[3] * v0[3])) + ((v1[0] * v1[0] + v1[1] * v1[1]) + (v1[2] * v1[2] + v1[3] * v1[3]));
                    }
                }
                if (WRITE_HB) { ss += __shfl_xor(ss, 16); ss += __shfl_xor(ss, 32); if (fq == 0) ssqp[(size_t)row * 16 + u.pn * 4 + wc] = ss; }
            }
    }
};
template <class Epi, class Sched, bool ALIGN_EPI = false, bool SP2 = false>
__device__ __forceinline__ void gemm_phase(PG8_LAS unsigned char* lds, const Gemm g, const Sched& S, const Epi& E, const int wave_in) {
    const int wid = wave_in, lane = (int)__builtin_amdgcn_mbcnt_hi(~0u, __builtin_amdgcn_mbcnt_lo(~0u, 0u)), tid = wid * 64 + lane, wr = wid >> 2, wc = wid & 3, fr = lane & 15, fq = lane >> 4;
    const int K = g.K, nt = K / BK;
    unsigned voffA[2], voffB[2];
#pragma unroll
    for (int i = 0; i < 2; ++i) { int R, C; stage_rc(tid * 16 + i * 8192, R, C); const int Rb = Epi::PERM ? ((R & ~31) + perm32(R & 31)) : R;
        voffA[i] = (unsigned)(R * K + C) * 2u; voffB[i] = (unsigned)(Rb * K + C) * 2u; }
    const size_t kstep = (size_t)(BK * 2);
    const size_t hstep = (size_t)HALF * K * 2;
    const size_t tstep = 2 * hstep;
    const unsigned ldsw = (unsigned)wid * 1024u;
    const int aoff = lds_byte(wr * 64 + fr, fq * 8), boff = lds_byte(wc * 32 + fr, fq * 8);
#define PG8_SA(b, h) (((b) * 2 + (h)) * HTB)
#define PG8_SB(b, h) ((4 + (b) * 2 + (h)) * HTB)
#define PG8_STAGE(bufoff, gbase, voff) do { _Pragma("unroll") for (int _i = 0; _i < 2; ++_i) \
        __builtin_amdgcn_global_load_lds((const unsigned*)((const char*)(gbase) + (voff)[_i]), (PG8_LAS unsigned*)(lds + (bufoff) + ldsw + _i * 8192), 16, 0, 0); } while (0)
#define PG8_LDA(dst, b, h) do { _Pragma("unroll") for (int m = 0; m < 4; ++m) _Pragma("unroll") for (int k = 0; k < 2; ++k) dst[m][k] = *(const PG8_LAS bf16x8*)(lds + PG8_SA(b, h) + aoff + m * 2048 + k * 1024); } while (0)
#define PG8_LDB(dst, b, h) do { _Pragma("unroll") for (int n = 0; n < 2; ++n) _Pragma("unroll") for (int k = 0; k < 2; ++k) dst[n][k] = *(const PG8_LAS bf16x8*)(lds + PG8_SB(b, h) + boff + n * 2048 + k * 1024); } while (0)
#define PG8_MMA(ai, bj, At, Bt) do { __builtin_amdgcn_s_setprio(1); _Pragma("unroll") for (int m = 0; m < 4; ++m) _Pragma("unroll") for (int n = 0; n < 2; ++n) _Pragma("unroll") for (int k = 0; k < 2; ++k) \
        acc[ai][bj][m][n] = __builtin_amdgcn_mfma_f32_16x16x32_bf16(Bt[n][k], At[m][k], acc[ai][bj][m][n], 0, 0, 0); __builtin_amdgcn_s_setprio(0); } while (0)
#define PG8_WAIT_V(n) asm volatile("s_waitcnt vmcnt(" #n ")" ::: "memory")
#define PG8_WAIT_L(n) asm volatile("s_waitcnt lgkmcnt(" #n ")" ::: "memory")
#define PG8_BAR __builtin_amdgcn_s_barrier()
#define PG8_SCHED __builtin_amdgcn_sched_barrier(0)
    Unit cur, nxt; int ui = 0;
    if (!S.next(0, cur)) return;
    f32x4 acc[2][2][4][2];
#pragma unroll
    for (int a = 0; a < 2; ++a)
#pragma unroll
        for (int b = 0; b < 2; ++b)
#pragma unroll
            for (int m = 0; m < 4; ++m)
#pragma unroll
                for (int n = 0; n < 2; ++n) acc[a][b][m][n] = (f32x4){0.f, 0.f, 0.f, 0.f};
    bf16x8 At[4][2], B0[2][2], B1[2][2];
    const char* cA = (const char*)g.A + (size_t)cur.pm * tstep; const char* cB = (const char*)g.Bt + (size_t)cur.pn * tstep;
    S.a_ready(cur);
    if constexpr (SP2) {
        PG8_STAGE(PG8_SB(0, 0), cB, voffB); PG8_STAGE(PG8_SB(0, 1), cB + hstep, voffB); PG8_STAGE(PG8_SA(0, 0), cA, voffA); PG8_STAGE(PG8_SA(0, 1), cA + hstep, voffA);
        if (wr == 1) PG8_BAR;
        PG8_WAIT_V(2); PG8_BAR;
        PG8_STAGE(PG8_SB(1, 0), cB + kstep, voffB); PG8_STAGE(PG8_SA(1, 0), cA + kstep, voffA); PG8_STAGE(PG8_SB(1, 1), cB + hstep + kstep, voffB);
        PG8_WAIT_V(6); PG8_BAR;
    } else {
        PG8_STAGE(PG8_SB(0, 0), cB, voffB); PG8_STAGE(PG8_SA(0, 0), cA, voffA); PG8_STAGE(PG8_SB(0, 1), cB + hstep, voffB); PG8_STAGE(PG8_SA(0, 1), cA + hstep, voffA);
        if (wr == 1) PG8_BAR;
        PG8_WAIT_V(4); PG8_BAR;
        PG8_STAGE(PG8_SB(1, 0), cB + kstep, voffB); PG8_STAGE(PG8_SA(1, 0), cA + kstep, voffA); PG8_STAGE(PG8_SB(1, 1), cB + hstep + kstep, voffB);
        PG8_WAIT_V(6); PG8_BAR;
    }
    for (;;) {
        const bool has_next = S.next(ui + 1, nxt);
        const char* nA = has_next ? (const char*)g.A + (size_t)nxt.pm * tstep : cA; const char* nB = has_next ? (const char*)g.Bt + (size_t)nxt.pn * tstep : cB;
        for (int t = 0; t < nt; t += 2) {
            const bool last = (t == nt - 2);
            const char* a1 = cA + (size_t)(t + 1) * kstep;
            const char* a2 = last ? nA : cA + (size_t)(t + 2) * kstep; const char* b2 = last ? nB : cB + (size_t)(t + 2) * kstep;
            const char* a3 = a2 + kstep; const char* b3 = b2 + kstep;
            if (last && has_next) S.a_ready(nxt);
            if constexpr (SP2) {
            PG8_LDB(B0, 0, 0); PG8_LDB(B1, 0, 1); PG8_SCHED; PG8_LDA(At, 0, 0); PG8_STAGE(PG8_SA(1, 1), a1 + hstep, voffA);
            PG8_WAIT_V(8); PG8_WAIT_L(0); PG8_BAR; PG8_MMA(0, 0, At, B0); PG8_MMA(0, 1, At, B1); PG8_BAR; PG8_SCHED;
            PG8_LDA(At, 0, 1); PG8_STAGE(PG8_SB(0, 0), b2, voffB); PG8_STAGE(PG8_SB(0, 1), b2 + hstep, voffB); PG8_STAGE(PG8_SA(0, 0), a2, voffA);
            PG8_WAIT_V(8); PG8_WAIT_L(0); PG8_BAR; PG8_MMA(1, 0, At, B0); PG8_MMA(1, 1, At, B1); PG8_BAR; PG8_SCHED;
            PG8_LDB(B0, 1, 0); PG8_LDB(B1, 1, 1); PG8_SCHED; PG8_LDA(At, 1, 0); PG8_STAGE(PG8_SA(0, 1), a2 + hstep, voffA);
            PG8_WAIT_V(8); PG8_WAIT_L(0); PG8_BAR; PG8_MMA(0, 0, At, B0); PG8_MMA(0, 1, At, B1); PG8_BAR; PG8_SCHED;
            PG8_LDA(At, 1, 1); PG8_STAGE(PG8_SB(1, 0), b3, voffB); PG8_STAGE(PG8_SB(1, 1), b3 + hstep, voffB); PG8_STAGE(PG8_SA(1, 0), a3, voffA);
            PG8_WAIT_V(8); PG8_WAIT_L(0); PG8_BAR; PG8_MMA(1, 0, At, B0); PG8_MMA(1, 1, At, B1); PG8_BAR; PG8_SCHED;
            } else {
            PG8_LDB(B0, 0, 0); PG8_SCHED; PG8_LDA(At, 0, 0); PG8_STAGE(PG8_SA(1, 1), a1 + hstep, voffA);
            PG8_WAIT_L(8); PG8_BAR; PG8_WAIT_L(0); PG8_MMA(0, 0, At, B0); PG8_BAR; PG8_SCHED;
            PG8_LDB(B1, 0, 1); PG8_STAGE(PG8_SB(0, 0), b2, voffB);
            PG8_BAR; PG8_WAIT_L(0); PG8_MMA(0, 1, At, B1); PG8_BAR;
            PG8_LDA(At, 0, 1); PG8_STAGE(PG8_SA(0, 0), a2, voffA);
            PG8_BAR; PG8_WAIT_L(0); PG8_MMA(1, 0, At, B0); PG8_BAR; PG8_SCHED;
            PG8_STAGE(PG8_SB(0, 1), b2 + hstep, voffB);
            PG8_WAIT_V(6); PG8_BAR; PG8_MMA(1, 1, At, B1); PG8_BAR;
            PG8_LDB(B0, 1, 0); PG8_SCHED; PG8_LDA(At, 1, 0); PG8_STAGE(PG8_SA(0, 1), a2 + hstep, voffA);
            PG8_WAIT_L(8); PG8_BAR; PG8_WAIT_L(0); PG8_MMA(0, 0, At, B0); PG8_BAR; PG8_SCHED;
            PG8_LDB(B1, 1, 1); PG8_STAGE(PG8_SB(1, 0), b3, voffB);
            PG8_BAR; PG8_WAIT_L(0); PG8_MMA(0, 1, At, B1); PG8_BAR;
            PG8_LDA(At, 1, 1); PG8_STAGE(PG8_SA(1, 0), a3, voffA);
            PG8_BAR; PG8_WAIT_L(0); PG8_MMA(1, 0, At, B0); PG8_BAR; PG8_SCHED;
            PG8_STAGE(PG8_SB(1, 1), b3 + hstep, voffB);
            PG8_WAIT_V(6); PG8_BAR; PG8_MMA(1, 1, At, B1); PG8_BAR;
            }
        }
        if constexpr (ALIGN_EPI) { if (wr == 0) PG8_BAR; }
        if constexpr (!Epi::AFTER_DRAIN) { E(acc, cur, wr, wc, fr, fq); S.done(cur); }
        if (!has_next) break;
#pragma unroll
        for (int a = 0; a < 2; ++a)
#pragma unroll
            for (int b = 0; b < 2; ++b)
#pragma unroll
                for (int m = 0; m < 4; ++m)
#pragma unroll
                    for (int n = 0; n < 2; ++n) acc[a][b][m][n] = (f32x4){0.f, 0.f, 0.f, 0.f};
        cur = nxt; cA = nA; cB = nB; ++ui;
        if constexpr (ALIGN_EPI) { if (wr == 1) PG8_BAR; }
    }
    PG8_WAIT_V(0);
    if constexpr (!ALIGN_EPI) { if (wr == 0) PG8_BAR; }
    PG8_BAR;
    if constexpr (Epi::AFTER_DRAIN) { E.fused(acc, cur, wr, wc, fr, fq, lds, wid, lane); S.done(cur); }
#undef PG8_SA
#undef PG8_SB
#undef PG8_STAGE
#undef PG8_LDA
#undef PG8_LDB
#undef PG8_MMA
#undef PG8_WAIT_V
#undef PG8_WAIT_L
#undef PG8_BAR
#undef PG8_SCHED
}
}
#include <cmath>
constexpr int NWAVES = 8, NTHR = 512;
constexpr int BATCH = 16, SEQ = 2048, M = BATCH * SEQ, D = 1024, FF = 4096, NAB = 3840, NC = 3072, ABP_OLD = 3672;
constexpr int C_QA = 0, C_KA = 512, C_VA = 1024, C_IQ = 1536, C_QB = 2048, C_KB = 2304, C_VB = 2560, C_OG = 3072, C_IK = 3584, C_IW = 3648, C_GL = 3656;
constexpr float EPS = 1e-6f;
constexpr size_t MiB = 1u << 20;
constexpr size_t WS_CTL = 0, CTL_ZERO_BYTES = 1 * MiB;
constexpr size_t WS_WAB = 1 * MiB, WS_WOAB = 9 * MiB, WS_WUP0 = 11 * MiB, WS_WDN0 = 19 * MiB, WS_WINC = 27 * MiB, WS_WOC = 33 * MiB, WS_WUP1 = 35 * MiB, WS_WDN1 = 43 * MiB;
constexpr size_t WS_SSQ = 51 * MiB, SSQ_BYTES = 2 * MiB;
constexpr size_t WS_XB = 60 * MiB;
constexpr size_t WS_CAT = 124 * MiB;
constexpr size_t WS_MASK = 188 * MiB;
constexpr size_t WS_R1 = 196 * MiB;
constexpr size_t WS_END = 452 * MiB;
constexpr int CW_BAR = 4096;
constexpr int RING_BYTES = 131072;
constexpr int LDS_BYTES = 163840;
constexpr int MISC_OFF = LDS_BYTES - 256;
#define GAS __attribute__((address_space(1)))
#define LAS __attribute__((address_space(3)))
typedef unsigned short bf16;
typedef unsigned v4u __attribute__((ext_vector_type(4)));
typedef float f32x4 __attribute__((ext_vector_type(4)));
typedef short bf16x8 __attribute__((ext_vector_type(8)));
typedef GAS unsigned gu32;
typedef GAS unsigned long long gu64;
#define RLX_AGENT __ATOMIC_RELAXED, __HIP_MEMORY_SCOPE_AGENT
#define LDS_WAIT() asm volatile("s_waitcnt lgkmcnt(0)" ::: "memory")
#define VM_WAIT() asm volatile("s_waitcnt vmcnt(0)" ::: "memory")
__device__ __forceinline__ unsigned long long rt() { return __builtin_amdgcn_s_memrealtime(); }
__device__ __forceinline__ unsigned f2bf(float f) { unsigned u = __builtin_bit_cast(unsigned, f); return (u + 0x7fffu + ((u >> 16) & 1u)) >> 16; }
__device__ __forceinline__ unsigned pk2(float lo, float hi) { return f2bf(lo) | (f2bf(hi) << 16); }
#define XB_TMO      128
#define XB_XCNT(j)  (256  + 64 * (j))
#define XB_XSUB(j)  (1280 + 64 * (j))
#define XB_XGEN(j)  (2304 + 64 * (j))
#define XB_TOP      3328
#define XB_TOPGEN   3392
#define XCD_BAR_WORDS 3456
#define XB_SPIN_CAP (1u << 18)

__device__ __forceinline__ unsigned xb_ld(unsigned* p)              { return __hip_atomic_load(p, __ATOMIC_RELAXED, __HIP_MEMORY_SCOPE_AGENT); }
__device__ __forceinline__ unsigned xb_add(unsigned* p, unsigned v) { return __hip_atomic_fetch_add(p, v, __ATOMIC_RELAXED, __HIP_MEMORY_SCOPE_AGENT); }
__device__ __forceinline__ unsigned xb_xcc_id() { return (unsigned)__builtin_amdgcn_s_getreg((3 << 11) | 20) & 0xFu; }
#define XB_SPIN(cond, bar) do { unsigned _sp = 0; while (cond) { __builtin_amdgcn_s_sleep(1); \
    if ((++_sp & 255u) == 0u) { if (xb_ld(&(bar)[XB_TMO])) break; if (_sp > XB_SPIN_CAP) { atomicAdd(&(bar)[XB_TMO], 1u); break; } } } } while (0)

struct XcdBarrier {
    unsigned* bar; unsigned x; int wave;
    volatile LAS unsigned* st;
};

__device__ __forceinline__ bool xb_t0(int wave) { return wave == 0 && __builtin_amdgcn_mbcnt_hi(~0u, __builtin_amdgcn_mbcnt_lo(~0u, 0u)) == 0u; }
__device__ __forceinline__ XcdBarrier xcd_barrier_post(unsigned* bar, volatile LAS unsigned* st, int wave) {
    XcdBarrier b; b.bar = bar; b.x = xb_xcc_id(); b.st = st; b.wave = wave;
    if (xb_t0(wave)) (void)xb_add(&bar[XB_XCNT(b.x)], 1u);
    return b;
}
__device__ __forceinline__ void xcd_barrier_complete(unsigned* bar, unsigned x, unsigned& nloc, unsigned& nx) {
    const unsigned G = gridDim.x * gridDim.y * gridDim.z;
    unsigned sum, cnt, mine, sp = 0u;
    for (;;) {
        sum = 0u; cnt = 0u; mine = 0u;
#pragma unroll
        for (unsigned j = 0; j < 16; ++j) { const unsigned c = xb_ld(&bar[XB_XCNT(j)]); sum += c; cnt += (c > 0u) ? 1u : 0u; mine = (j == x) ? c : mine; }
        if (sum == G) break;
        __builtin_amdgcn_s_sleep(1);
        if ((++sp & 255u) == 0u) { if (xb_ld(&bar[XB_TMO])) break; if (sp > XB_SPIN_CAP) { atomicAdd(&bar[XB_TMO], 1u); break; } }
    }
    nloc = mine > 0u ? mine : 1u; nx = cnt > 0u ? cnt : 1u;
}

__device__ __forceinline__ void xcd_barrier(const XcdBarrier& b) {
    asm volatile("s_waitcnt vmcnt(0)" ::: "memory");
    __syncthreads();
    if (xb_t0(b.wave)) {
        unsigned* bar = b.bar;
        __builtin_amdgcn_s_waitcnt(0);
        unsigned nloc = b.st[0], nx = b.st[1];
        if (nloc == 0u) { xcd_barrier_complete(bar, b.x, nloc, nx); b.st[0] = nloc; b.st[1] = nx; }
        const unsigned old = xb_add(&bar[XB_XSUB(b.x)], 1u);
        const unsigned gen = old / nloc;
        if (old + 1u == (gen + 1u) * nloc) {
            __builtin_amdgcn_fence(__ATOMIC_RELEASE, "agent");
            asm volatile("s_waitcnt vmcnt(0)" ::: "memory");
            const unsigned og = xb_add(&bar[XB_TOP], 1u);
            const unsigned tg = og / nx;
            if (og + 1u == (tg + 1u) * nx) xb_add(&bar[XB_TOPGEN], 1u);
            else XB_SPIN(xb_ld(&bar[XB_TOPGEN]) == tg, bar);
            __builtin_amdgcn_fence(__ATOMIC_ACQUIRE, "agent");
            xb_add(&bar[XB_XGEN(b.x)], 1u);
            asm volatile("s_waitcnt vmcnt(0)" ::: "memory");
        } else {
            XB_SPIN(xb_ld(&bar[XB_XGEN(b.x)]) == gen, bar);
            __builtin_amdgcn_fence(__ATOMIC_ACQUIRE, "agent");
            asm volatile("s_waitcnt vmcnt(0)" ::: "memory");
        }
    }
    __syncthreads();
}
struct Frame {
    LAS unsigned char* lds;
    volatile LAS unsigned* MISC;
    gu32* ctl;
    int tid, lane, wave, vcu, G;
    const float *x, *g_mix, *g_ffn, *w_in_ab, *gq_a, *gk_a, *w_gate_up, *b_gate, *g_gla, *w_out_ab, *w_in_c, *gq_c, *gk_c, *w_out_c, *w_up, *w_down;
    float* out;
    bf16 *Wab, *Woab, *Wup0, *Wdn0, *Winc, *Woc, *Wup1, *Wdn1;
    bf16 *XB, *CAT, *R1;
    float* SSQ; unsigned* MASK;
};
__device__ __forceinline__ float bf2f(bf16 v) { return __builtin_bit_cast(float, (unsigned)v << 16); }
__device__ __forceinline__ float wave_sum(float v) {
#pragma unroll
    for (int o = 1; o < 64; o <<= 1) v += __shfl_xor(v, o);
    return v;
}
__device__ __forceinline__ float wave_max(float v) {
#pragma unroll
    for (int o = 1; o < 64; o <<= 1) v = fmaxf(v, __shfl_xor(v, o));
    return v;
}
__device__ __forceinline__ float log_sigmoid(float x) { return fminf(x, 0.f) - log1pf(expf(-fabsf(x))); }

__device__ __forceinline__ int oldcol_ab(int n) {
    if (n < 2048) return n;
    if (n < 2304) return 2120 + (n - 2048);
    if (n < 2560) return 2376 + (n - 2304);
    if (n < 3072) return 2632 + (n - 2560);
    if (n < 3584) return 3160 + (n - 3072);
    if (n < 3648) return 2048 + (n - 3584);
    if (n < 3656) return 2112 + (n - 3648);
    if (n < 3672) return 3144 + (n - 3656);
    return -1;
}
__device__ __forceinline__ void p0_transpose_item(const float* W, int ldw, int K, const float* gain, bf16* WT, bool map, LAS float* scr, int item, int nblk, int lane) {
    const int kb = item / nblk, nb = item % nblk, k0 = 64 * kb, n0 = 32 * nb;
    int oc = n0 + (lane & 31); if (map) oc = oldcol_ab(oc);
#pragma unroll 8
    for (int i = 0; i < 32; ++i) { const int kk = 2 * i + (lane >> 5); float v = 0.f;
        if (oc >= 0) { v = W[(size_t)(k0 + kk) * ldw + oc]; if (gain) v *= gain[k0 + kk]; }
        scr[kk * 33 + (lane & 31)] = v; }
    LDS_WAIT(); asm volatile("" ::: "memory");
    const int c = lane & 7;
#pragma unroll
    for (int j = 0; j < 4; ++j) { const int n = (lane >> 3) + 8 * j; const LAS float* s = scr + (8 * c) * 33 + n;
        v4u o; o.x = pk2(s[0 * 33], s[1 * 33]); o.y = pk2(s[2 * 33], s[3 * 33]); o.z = pk2(s[4 * 33], s[5 * 33]); o.w = pk2(s[6 * 33], s[7 * 33]);
        *(GAS v4u*)(WT + (size_t)(n0 + n) * K + k0 + 8 * c) = o; }
    LDS_WAIT(); asm volatile("" ::: "memory");
}
__device__ __forceinline__ void ph_prologue(Frame& F) {
    LAS float* scr = (LAS float*)(F.lds + F.wave * 16384);
    const int gw = F.vcu * NWAVES + F.wave, NGW = F.G * NWAVES;
    constexpr int I_AB = (D / 64) * (NAB / 32), I_O = (D / 64) * (D / 32), I_UP = (D / 64) * (FF / 32), I_DN = (FF / 64) * (D / 32), I_C = (D / 64) * (NC / 32);
    constexpr int NITEMS = I_AB + 2 * I_O + 2 * I_UP + 2 * I_DN + I_C;
    for (int it = gw; it < NITEMS; it += NGW) {
        int r = it;
        if (r < I_AB) { p0_transpose_item(F.w_in_ab, ABP_OLD, D, F.g_mix, F.Wab, true, scr, r, NAB / 32, F.lane); continue; } r -= I_AB;
        if (r < I_O) { p0_transpose_item(F.w_out_ab, D, D, nullptr, F.Woab, false, scr, r, D / 32, F.lane); continue; } r -= I_O;
        if (r < I_UP) { p0_transpose_item(F.w_up, FF, D, F.g_ffn, F.Wup0, false, scr, r, FF / 32, F.lane); continue; } r -= I_UP;
        if (r < I_DN) { p0_transpose_item(F.w_down, D, FF, nullptr, F.Wdn0, false, scr, r, D / 32, F.lane); continue; } r -= I_DN;
        if (r < I_C) { p0_transpose_item(F.w_in_c, NC, D, F.g_mix + D, F.Winc, false, scr, r, NC / 32, F.lane); continue; } r -= I_C;
        if (r < I_O) { p0_transpose_item(F.w_out_c, D, D, nullptr, F.Woc, false, scr, r, D / 32, F.lane); continue; } r -= I_O;
        if (r < I_UP) { p0_transpose_item(F.w_up + (size_t)D * FF, FF, D, F.g_ffn + D, F.Wup1, false, scr, r, FF / 32, F.lane); continue; } r -= I_UP;
        p0_transpose_item(F.w_down + (size_t)FF * D, D, FF, nullptr, F.Wdn1, false, scr, r, D / 32, F.lane);
    }
    for (int m = gw; m < M; m += NGW) {
        const GAS f32x4* xr = (const GAS f32x4*)(F.x + (size_t)m * D) + F.lane;
        f32x4 v[4]; float s = 0.f;
#pragma unroll
        for (int j = 0; j < 4; ++j) { v[j] = xr[64 * j]; s += (v[j].x * v[j].x + v[j].y * v[j].y) + (v[j].z * v[j].z + v[j].w * v[j].w); }
        s = wave_sum(s);
        GAS unsigned long long* o8 = (GAS unsigned long long*)(F.XB + (size_t)m * D) + F.lane;
#pragma unroll
        for (int j = 0; j < 4; ++j) o8[64 * j] = (unsigned long long)pk2(v[j].x, v[j].y) | ((unsigned long long)pk2(v[j].z, v[j].w) << 32);
        if (F.lane < 16) F.SSQ[(size_t)m * 16 + F.lane] = (F.lane == 0) ? s : 0.f;
    }
}
namespace att {
typedef short s16x4 __attribute__((ext_vector_type(4)));
typedef float f32x16 __attribute__((ext_vector_type(16)));
typedef _Float16 f16x8 __attribute__((ext_vector_type(8)));
typedef unsigned u32x4 __attribute__((ext_vector_type(4)));
typedef short v4i16_t __attribute__((ext_vector_type(4)));
constexpr float C2 = 0.08838834764831845f * 1.4426950408889634f;
__device__ __forceinline__ int crow(int r, int hi) { return (r & 3) + 8 * (r >> 2) + 4 * hi; }
__device__ __forceinline__ int img_off(int row, int ch) { return 256 * row + 16 * (ch ^ (((row & 3) << 2) | ((row >> 2) & 3))); }
__device__ __forceinline__ bf16x8 pack8(float a0, float a1, float a2, float a3, float a4, float a5, float a6, float a7) {
    u32x4 w; w.x = pg8::cvt_pk_bf16(a0, a1); w.y = pg8::cvt_pk_bf16(a2, a3); w.z = pg8::cvt_pk_bf16(a4, a5); w.w = pg8::cvt_pk_bf16(a6, a7);
    return __builtin_bit_cast(bf16x8, w);
}
__device__ __forceinline__ f16x8 pack8h(float a0, float a1, float a2, float a3, float a4, float a5, float a6, float a7) {
    f16x8 r; r[0] = (_Float16)a0; r[1] = (_Float16)a1; r[2] = (_Float16)a2; r[3] = (_Float16)a3; r[4] = (_Float16)a4; r[5] = (_Float16)a5; r[6] = (_Float16)a6; r[7] = (_Float16)a7; return r;
}
__device__ __forceinline__ void dma_off_init(unsigned (&dvo)[2], int ld, int wave, int lane) {
#pragma unroll
    for (int i = 0; i < 2; ++i) { const int pi = 2 * wave + i, row = 4 * pi + (lane >> 4), pc = lane & 15, ch = pc ^ (((row & 3) << 2) | ((row >> 2) & 3)); dvo[i] = (unsigned)(row * ld + ch * 8) * 2u; }
}
__device__ __forceinline__ void tile_dma(const bf16* g, const unsigned (&dvo)[2], LAS unsigned char* buf, int wave) {
#pragma unroll
    for (int i = 0; i < 2; ++i) __builtin_amdgcn_global_load_lds((const unsigned*)((const char*)g + dvo[i]), (LAS unsigned*)(buf + 1024 * (2 * wave + i)), 16, 0, 0);
}
struct FragOff { int k[8]; int va[4]; int vd; };
__device__ __forceinline__ void frag_off_init(FragOff& fo, int lane) {
    const int hi = lane >> 5, r32 = lane & 31, i = lane & 15, q = i >> 2, p = i & 3, x = 2 * ((lane >> 4) & 1) + (p >> 1);
#pragma unroll
    for (int ks = 0; ks < 8; ++ks) fo.k[ks] = img_off(r32, 2 * ks + hi);
#pragma unroll
    for (int ct = 0; ct < 4; ++ct) fo.va[ct] = img_off(4 * hi + q, 4 * ct + x) + 8 * (p & 1);
    fo.vd = img_off(4 * hi + q + 8, x) - img_off(4 * hi + q, x);
}
__device__ __forceinline__ bf16x8 k_frag(const LAS unsigned char* kbuf, const FragOff& fo, int rt, int ks) { return *(const LAS bf16x8*)(kbuf + fo.k[ks] + 8192 * rt); }
__device__ __forceinline__ s16x4 vtr(const LAS unsigned char* p) { return __builtin_bit_cast(s16x4, __builtin_amdgcn_ds_read_tr16_b64_v4i16((LAS v4i16_t*)p)); }
__device__ __forceinline__ bf16x8 v_frag(const LAS unsigned char* vbuf, const FragOff& fo, int ct, int kk) {
    const s16x4 lo = vtr(vbuf + fo.va[ct] + 4096 * kk), hh = vtr(vbuf + fo.va[ct] + fo.vd + 4096 * kk);
    return (bf16x8){lo[0], lo[1], lo[2], lo[3], hh[0], hh[1], hh[2], hh[3]};
}
__device__ __forceinline__ void store_o(const f32x16 (&o)[4], const float (&rscale)[16], LAS unsigned char* stg, bf16* dst, int ld, int lane) {
    const int hi = lane >> 5, r32 = lane & 31;
#pragma unroll
    for (int r = 0; r < 16; ++r) { const int orow = crow(r, hi);
#pragma unroll
        for (int ct = 0; ct < 4; ++ct) *(LAS bf16*)(stg + orow * 256 + (32 * ct + r32) * 2) = (bf16)f2bf(o[ct][r] * rscale[r]); }
    asm volatile("s_waitcnt lgkmcnt(0)" ::: "memory");
#pragma unroll
    for (int i = 0; i < 8; ++i) { const int c = lane + 64 * i, row = c >> 4, ch = c & 15; const u32x4 v = *(const LAS u32x4*)(stg + row * 256 + ch * 16); *(u32x4*)(dst + (size_t)row * ld + ch * 8) = v; }
}
}
template <bool SCALEQ> __device__ __forceinline__ void ph_prep_a(Frame& F) {
    const int gw = F.vcu * NWAVES + F.wave, NGW = F.G * NWAVES, lane = F.lane;
    for (int tok = gw; tok < M; tok += NGW) {
        const float pos = (float)(tok & (SEQ - 1));
        bf16* pr = F.R1 + (size_t)tok * NAB;
        float c128 = 1.f, s128 = 0.f;
        if (lane < 32) { const int i = lane & 15; const float inv = powf(500000.0f, -(float)i * 2.0f / 32.0f); const float ang = pos * inv; c128 = cosf(ang); s128 = sinf(ang); }
#pragma unroll
        for (int which = 0; which < 2; ++which) {
            const int base = which == 0 ? C_QA : C_KA;
            const float* gn = which == 0 ? F.gq_a : F.gk_a;
            for (int h = 0; h < 4; ++h) {
                float a = bf2f(pr[base + h * 128 + lane]), b = bf2f(pr[base + h * 128 + 64 + lane]);
                const float ss = wave_sum(a * a + b * b);
                const float rs = rsqrtf(ss * (1.f / 128.f) + EPS);
                const float qs = (SCALEQ && which == 0) ? att::C2 : 1.0f;
                a = a * rs * gn[lane] * qs; b = b * rs * gn[64 + lane] * qs;
                const float other = __shfl_xor(a, 16);
                float o = a;
                if (lane < 16) o = a * c128 - other * s128;
                else if (lane < 32) o = a * c128 + other * s128;
                pr[base + h * 128 + lane] = (bf16)f2bf(o); pr[base + h * 128 + 64 + lane] = (bf16)f2bf(b);
            }
        }
        float c64 = 1.f, s64 = 0.f;
        if (lane < 16) { const int i = lane & 7; const float inv = powf(500000.0f, -(float)i * 2.0f / 16.0f); const float ang = pos * inv; c64 = cosf(ang); s64 = sinf(ang); }
        for (int h = 0; h < 9; ++h) {
            const int col = (h < 8) ? C_IQ + h * 64 : C_IK;
            const float a = bf2f(pr[col + lane]);
            const float other = __shfl_xor(a, 8);
            float o = a;
            if (lane < 8) o = a * c64 - other * s64;
            else if (lane < 16) o = a * c64 + other * s64;
            pr[col + lane] = (bf16)f2bf(o);
        }
    }
}
__device__ __forceinline__ void ph_indexer_naive(Frame& F) {
    LAS float* sc = (LAS float*)F.lds;
    LAS float* qv = sc + 2048;
    LAS float* wv = qv + 512;
    LAS unsigned* mw = (LAS unsigned*)(wv + 8);
    const int tid = F.tid;
    for (int tok = F.vcu; tok < M; tok += F.G) {
        const int pos = tok & (SEQ - 1), seq0 = tok - pos, limit = ((pos >> 6) + 1) << 6;
        const bf16* pr = F.R1 + (size_t)tok * NAB;
        qv[tid] = bf2f(pr[C_IQ + tid]);
        if (tid < 8) wv[tid] = bf2f(pr[C_IW + tid]) * 0.35355339059327373f;
        if (tid < 64) mw[tid] = 0u;
        __syncthreads();
        for (int s = tid; s < limit; s += NTHR) {
            const bf16* kp = F.R1 + (size_t)(seq0 + s) * NAB + C_IK;
            float acc[8];
#pragma unroll
            for (int h = 0; h < 8; ++h) acc[h] = 0.f;
            for (int d = 0; d < 64; ++d) { const float kd = bf2f(kp[d]);
#pragma unroll
                for (int h = 0; h < 8; ++h) acc[h] = fmaf(qv[h * 64 + d], kd, acc[h]); }
            float score = 0.f;
#pragma unroll
            for (int h = 0; h < 8; ++h) score += fmaxf(acc[h] * 0.125f, 0.f) * wv[h];
            sc[s] = score;
        }
        __syncthreads();
        if (limit <= 256) { if (tid < 64) mw[tid] = (tid * 32 < limit) ? 0xffffffffu : 0u; }
        else {
            for (int s = tid; s < limit; s += NTHR) {
                const float v = sc[s]; int cnt = 0;
                for (int j = 0; j < limit; ++j) { const float u = sc[j]; cnt += ((u > v) || (u == v && j < s)) ? 1 : 0; }
                if (cnt < 256) atomicOr((unsigned*)&mw[s >> 5], 1u << (s & 31));
            }
        }
        __syncthreads();
        if (tid < 64) F.MASK[(size_t)tok * 64 + tid] = mw[tid];
        __syncthreads();
    }
}
__device__ __forceinline__ float block_sum(float v, LAS float* red, int tid) {
    v = wave_sum(v);
    __syncthreads();
    if ((tid & 63) == 0) red[tid >> 6] = v;
    __syncthreads();
    float r = 0.f;
#pragma unroll
    for (int i = 0; i < NWAVES; ++i) r += red[i];
    return r;
}
__device__ __forceinline__ float block_max(float v, LAS float* red, int tid) {
    v = wave_max(v);
    __syncthreads();
    if ((tid & 63) == 0) red[tid >> 6] = v;
    __syncthreads();
    float r = red[0];
#pragma unroll
    for (int i = 1; i < NWAVES; ++i) r = fmaxf(r, red[i]);
    return r;
}
__device__ __forceinline__ void ph_dsa_naive(Frame& F) {
    LAS unsigned* mw = (LAS unsigned*)F.lds;
    LAS int* pre = (LAS int*)(mw + 64);
    LAS int* idx = pre + 128;
    LAS float* pp = (LAS float*)(idx + 256);
    LAS float* q = pp + 512;
    LAS float* red = q + 512;
    const int tid = F.tid;
    for (int tok = F.vcu; tok < M; tok += F.G) {
        const int pos = tok & (SEQ - 1), seq0 = tok - pos;
        if (tid < 64) mw[tid] = F.MASK[(size_t)tok * 64 + tid];
        q[tid] = bf2f(F.R1[(size_t)tok * NAB + C_QA + tid]);
        __syncthreads();
        if (tid == 0) { int a = 0; for (int w = 0; w < 64; ++w) { pre[w] = a; a += __popc(mw[w]); } pre[64] = a; }
        __syncthreads();
        const int n = pre[64];
        for (int s = tid; s < SEQ; s += NTHR) { const unsigned w = mw[s >> 5]; if ((w >> (s & 31)) & 1u) idx[pre[s >> 5] + __popc(w & ((1u << (s & 31)) - 1u))] = s; }
        __syncthreads();
        for (int h = 0; h < 4; ++h) {
            float sv = -INFINITY;
            if (tid < n) { const bf16* kp = F.R1 + (size_t)(seq0 + idx[tid]) * NAB + C_KA + h * 128; float a = 0.f;
                for (int d = 0; d < 128; ++d) a = fmaf(q[h * 128 + d], bf2f(kp[d]), a);
                sv = a * 0.08838834764831845f; }
            const float m = block_max(sv, red, tid);
            const float e = (tid < n) ? expf(sv - m) : 0.f;
            const float l = block_sum(e, red, tid);
            pp[tid] = e;
            __syncthreads();
            if (tid < 128) { float o = 0.f;
                for (int j = 0; j < n; ++j) o = fmaf(pp[j], bf2f(F.R1[(size_t)(seq0 + idx[j]) * NAB + C_VA + h * 128 + tid]), o);
                F.CAT[(size_t)tok * D + h * 128 + tid] = (bf16)f2bf(o / l); }
            __syncthreads();
        }
    }
}
__device__ __forceinline__ void ph_gla_naive(Frame& F) {
    LAS float* sq = (LAS float*)F.lds; LAS float* sk = sq + 1024; LAS float* sd = sk + 1024;
    LAS float* sg = sd + 1024;
    LAS float* red = sg + 256;
    const int tid = F.tid, lane = F.lane;
    for (int item = F.vcu; item < BATCH * 4; item += F.G) {
        const int b = item >> 2, h = item & 3, seq0 = b * SEQ;
        float S[64];
#pragma unroll
        for (int d = 0; d < 64; ++d) S[d] = 0.f;
        for (int t0 = 0; t0 < SEQ; t0 += 16) {
            if (tid < 256) { const int tt = tid >> 4, r = tid & 15; sg[tid] = bf2f(F.R1[(size_t)(seq0 + t0 + tt) * NAB + C_GL + r]); }
            __syncthreads();
            for (int i = tid; i < 1024; i += NTHR) { const int tt = i >> 6, d = i & 63; const bf16* pr = F.R1 + (size_t)(seq0 + t0 + tt) * NAB;
                sq[i] = bf2f(pr[C_QB + h * 64 + d]) * 0.125f; sk[i] = bf2f(pr[C_KB + h * 64 + d]);
                float g = F.b_gate[h * 64 + d];
#pragma unroll
                for (int r = 0; r < 16; ++r) g = fmaf(sg[tt * 16 + r], F.w_gate_up[r * 256 + h * 64 + d], g);
                sd[i] = expf(log_sigmoid(g) * (1.f / 16.f)); }
            __syncthreads();
            float o[16];
            if (tid < 128) {
#pragma unroll
                for (int tt = 0; tt < 16; ++tt) {
                    const float v = bf2f(F.R1[(size_t)(seq0 + t0 + tt) * NAB + C_VB + h * 128 + tid]); float a = 0.f;
#pragma unroll
                    for (int d = 0; d < 64; ++d) { S[d] = fmaf(sd[tt * 64 + d], S[d], sk[tt * 64 + d] * v); a = fmaf(sq[tt * 64 + d], S[d], a); }
                    o[tt] = a;
                    const float ws = wave_sum(a * a);
                    if (lane == 0) red[tt * 2 + (tid >> 6)] = ws;
                }
            }
            __syncthreads();
            if (tid < 128) {
#pragma unroll
                for (int tt = 0; tt < 16; ++tt) {
                    const size_t tok = seq0 + t0 + tt;
                    const float rs = rsqrtf((red[tt * 2] + red[tt * 2 + 1]) * (1.f / 128.f) + EPS);
                    const float og = bf2f(F.R1[tok * NAB + C_OG + h * 128 + tid]);
                    F.CAT[tok * D + 512 + h * 128 + tid] = (bf16)f2bf(o[tt] * rs * F.g_gla[tid] * (og / (1.f + expf(-og))));
                }
            }
            __syncthreads();
        }
    }
}
template <bool SCALEQ> __device__ __forceinline__ void ph_prep_c(Frame& F) {
    const int gw = F.vcu * NWAVES + F.wave, NGW = F.G * NWAVES, lane = F.lane;
    for (int it = gw; it < M * 16; it += NGW) {
        const int tok = it >> 4, hh = it & 15, isk = hh >> 3, h = hh & 7;
        bf16* p = F.R1 + (size_t)tok * NC + isk * 1024 + h * 128;
        const float* gn = isk ? F.gk_c : F.gq_c;
        const float a = bf2f(p[lane]), b = bf2f(p[64 + lane]);
        const float rs = rsqrtf(wave_sum(a * a + b * b) * (1.f / 128.f) + EPS);
        const float sc = (SCALEQ && !isk) ? att::C2 : 1.0f;
        p[lane] = (bf16)f2bf(a * rs * gn[lane] * sc); p[64 + lane] = (bf16)f2bf(b * rs * gn[64 + lane] * sc);
    }
}
__device__ __forceinline__ void ph_sb_naive(Frame& F) {
    const int gw = F.vcu * NWAVES + F.wave, NGW = F.G * NWAVES, lane = F.lane;
    for (int it = gw; it < M * 8; it += NGW) {
        const int tok = it >> 3, h = it & 7, pos = tok & (SEQ - 1), seq0 = tok - pos;
        const unsigned qq = *(const unsigned*)(F.R1 + (size_t)tok * NC + h * 128 + 2 * lane);
        const float q0 = __builtin_bit_cast(float, qq << 16), q1 = __builtin_bit_cast(float, qq & 0xffff0000u);
        float R = 0.f, o0 = 0.f, o1 = 0.f;
        for (int s = pos - 1; s >= 0; --s) {
            const bf16* pr = F.R1 + (size_t)(seq0 + s) * NC + h * 128 + 2 * lane;
            const unsigned kk = *(const unsigned*)(pr + 1024), vv = *(const unsigned*)(pr + 2048);
            const float k0 = __builtin_bit_cast(float, kk << 16), k1 = __builtin_bit_cast(float, kk & 0xffff0000u);
            const float z = wave_sum(q0 * k0 + q1 * k1) * 0.08838834764831845f;
            const float sp = log1pf(expf(-fabsf(z)));
            const float lsp = fminf(z, 0.f) - sp, lsn = fminf(-z, 0.f) - sp;
            const float a = expf(lsp + R);
            o0 = fmaf(a, __builtin_bit_cast(float, vv << 16), o0); o1 = fmaf(a, __builtin_bit_cast(float, vv & 0xffff0000u), o1);
            R += lsn;
        }
        *(unsigned*)(F.CAT + (size_t)tok * D + h * 128 + 2 * lane) = pk2(o0, o1);
    }
}
__device__ __forceinline__ void sb_unit(Frame& F, int b, int h, int qb) {
    using namespace att;
    const int tid = F.tid, lane = F.lane, w = F.wave, hi = lane >> 5, r32 = lane & 31;
    const bf16* Qg = F.R1 + (size_t)b * SEQ * NC + h * 128; const bf16* Kg = Qg + 1024; const bf16* Vg = Qg + 2048;
    const int T0 = qb * 256, t0w = T0 + 32 * w, jd = t0w >> 6, jtop = (T0 >> 6) + 3, tl = 32 * (w & 1) + r32;
    LAS unsigned char* lds = F.lds;
    FragOff fo; frag_off_init(fo, lane);
    unsigned dvo[2]; dma_off_init(dvo, NC, w, lane);
    bf16x8 qf[8];
#pragma unroll
    for (int ks = 0; ks < 8; ++ks) qf[ks] = *(const bf16x8*)(Qg + (size_t)(t0w + r32) * NC + 16 * ks + 8 * hi);
    f16x8 T0f, T1f, ONEf;
#pragma unroll
    for (int j = 0; j < 8; ++j) { const int kp = 8 * (j >> 2) + 4 * hi + (j & 3); T0f[j] = (kp >= r32) ? (_Float16)1.0f : (_Float16)0.0f; T1f[j] = (kp + 16 >= r32) ? (_Float16)1.0f : (_Float16)0.0f; ONEf[j] = (_Float16)1.0f; }
    f32x16 o[4];
#pragma unroll
    for (int ct = 0; ct < 4; ++ct)
#pragma unroll
        for (int r = 0; r < 16; ++r) o[ct][r] = 0.f;
    float R2 = 0.f; bool done = false;
    volatile LAS unsigned* flags = F.MISC + 16;
    tile_dma(Kg + (size_t)(64 * jtop) * NC, dvo, lds, w); tile_dma(Vg + (size_t)(64 * jtop) * NC, dvo, lds + 16384, w);
    asm volatile("s_waitcnt vmcnt(0)" ::: "memory");
    __syncthreads();
    for (int j = jtop; j >= 0; --j) {
        const int cur = (jtop - j) & 1;
        const LAS unsigned char* kb = lds + cur * 32768; const LAS unsigned char* vb = kb + 16384;
        if (j > 0) { tile_dma(Kg + (size_t)(64 * (j - 1)) * NC, dvo, lds + (cur ^ 1) * 32768, w); tile_dma(Vg + (size_t)(64 * (j - 1)) * NC, dvo, lds + (cur ^ 1) * 32768 + 16384, w); }
        if (j <= jd && !done) {
            f32x16 p0, p1;
#pragma unroll
            for (int r = 0; r < 16; ++r) { p0[r] = 0.f; p1[r] = 0.f; }
#pragma unroll
            for (int ks = 0; ks < 8; ++ks) { const bf16x8 a0 = k_frag(kb, fo, 0, ks), a1 = k_frag(kb, fo, 1, ks);
                p0 = __builtin_amdgcn_mfma_f32_32x32x16_bf16(a0, qf[ks], p0, 0, 0, 0); p1 = __builtin_amdgcn_mfma_f32_32x32x16_bf16(a1, qf[ks], p1, 0, 0, 0); }
            const bool diag = (j == jd);
            float x0[16], x1[16]; float rs = 0.f;
#pragma unroll
            for (int r = 0; r < 16; ++r) { const int key = crow(r, hi);
                float l0 = -__builtin_amdgcn_logf(1.0f + __builtin_amdgcn_exp2f(p0[r])), l1 = -__builtin_amdgcn_logf(1.0f + __builtin_amdgcn_exp2f(p1[r]));
                if (diag) { if (!(key < tl)) l0 = 0.f; if (!(key + 32 < tl)) l1 = 0.f; }
                x0[r] = l0; x1[r] = l1; rs += l0 + l1; p0[r] += R2; p1[r] += R2; }
            const f16x8 xb00 = pack8h(x0[0], x0[1], x0[2], x0[3], x0[4], x0[5], x0[6], x0[7]), xb01 = pack8h(x0[8], x0[9], x0[10], x0[11], x0[12], x0[13], x0[14], x0[15]);
            const f16x8 xb10 = pack8h(x1[0], x1[1], x1[2], x1[3], x1[4], x1[5], x1[6], x1[7]), xb11 = pack8h(x1[8], x1[9], x1[10], x1[11], x1[12], x1[13], x1[14], x1[15]);
            p0 = __builtin_amdgcn_mfma_f32_32x32x16_f16(T0f, xb00, p0, 0, 0, 0); p0 = __builtin_amdgcn_mfma_f32_32x32x16_f16(T1f, xb01, p0, 0, 0, 0);
            p0 = __builtin_amdgcn_mfma_f32_32x32x16_f16(ONEf, xb10, p0, 0, 0, 0); p0 = __builtin_amdgcn_mfma_f32_32x32x16_f16(ONEf, xb11, p0, 0, 0, 0);
            p1 = __builtin_amdgcn_mfma_f32_32x32x16_f16(T0f, xb10, p1, 0, 0, 0); p1 = __builtin_amdgcn_mfma_f32_32x32x16_f16(T1f, xb11, p1, 0, 0, 0);
#pragma unroll
            for (int r = 0; r < 16; ++r) { const int key = crow(r, hi);
                float a0 = __builtin_amdgcn_exp2f(p0[r]), a1 = __builtin_amdgcn_exp2f(p1[r]);
                if (diag) { if (!(key < tl)) a0 = 0.f; if (!(key + 32 < tl)) a1 = 0.f; }
                p0[r] = a0; p1[r] = a1; }
            const bf16x8 pa0 = pack8(p0[0], p0[1], p0[2], p0[3], p0[4], p0[5], p0[6], p0[7]), pa1 = pack8(p0[8], p0[9], p0[10], p0[11], p0[12], p0[13], p0[14], p0[15]);
            const bf16x8 pa2 = pack8(p1[0], p1[1], p1[2], p1[3], p1[4], p1[5], p1[6], p1[7]), pa3 = pack8(p1[8], p1[9], p1[10], p1[11], p1[12], p1[13], p1[14], p1[15]);
#pragma unroll
            for (int ct = 0; ct < 4; ++ct) {
                o[ct] = __builtin_amdgcn_mfma_f32_32x32x16_bf16(pa0, v_frag(vb, fo, ct, 0), o[ct], 0, 0, 0);
                o[ct] = __builtin_amdgcn_mfma_f32_32x32x16_bf16(pa1, v_frag(vb, fo, ct, 1), o[ct], 0, 0, 0);
                o[ct] = __builtin_amdgcn_mfma_f32_32x32x16_bf16(pa2, v_frag(vb, fo, ct, 2), o[ct], 0, 0, 0);
                o[ct] = __builtin_amdgcn_mfma_f32_32x32x16_bf16(pa3, v_frag(vb, fo, ct, 3), o[ct], 0, 0, 0);
            }
            rs += __shfl_xor(rs, 32);
            R2 += rs;
            done = __all(R2 < -152.0f);
        }
        if (lane == 0) flags[cur * 8 + w] = done ? 1u : 0u;
        asm volatile("s_waitcnt vmcnt(0) lgkmcnt(0)" ::: "memory");
        __syncthreads();
        unsigned alld = 1u;
#pragma unroll
        for (int i = 0; i < 8; ++i) alld &= flags[cur * 8 + i];
        if (alld) break;
    }
    float ones[16];
#pragma unroll
    for (int r = 0; r < 16; ++r) ones[r] = 1.0f;
    store_o(o, ones, lds + w * 8192, F.CAT + (size_t)(b * SEQ + t0w) * D + h * 128, D, lane);
    __syncthreads();
}
__device__ __forceinline__ void ph_sb(Frame& F) {
    for (int v = F.vcu; v < BATCH * 8 * 2; v += F.G) {
        const int bh = v >> 1, half = v & 1;
#pragma unroll 1
        for (int i = 0; i < 4; ++i) { const int qb = half ? (i == 0 ? 1 : i == 1 ? 6 : i == 2 ? 2 : 5) : (i == 0 ? 0 : i == 1 ? 7 : i == 2 ? 3 : 4); sb_unit(F, bh >> 3, bh & 7, qb); }
    }
}
__device__ __forceinline__ void dsa_unit(Frame& F, int b, int h, int ub, float mref) {
    using namespace att;
    const int lane = F.lane, w = F.wave, hi = lane >> 5, r32 = lane & 31;
    const bf16* Qg = F.R1 + (size_t)b * SEQ * NAB + C_QA + h * 128; const bf16* Kg = F.R1 + (size_t)b * SEQ * NAB + C_KA + h * 128; const bf16* Vg = F.R1 + (size_t)b * SEQ * NAB + C_VA + h * 128;
    const int t0w = 256 * ub + 32 * w, cw = t0w >> 6, jlast = 4 * ub + 3;
    LAS unsigned char* lds = F.lds;
    LAS unsigned char* mst = lds + 65536 + w * 8448;
    FragOff fo; frag_off_init(fo, lane);
    unsigned dvo[2]; dma_off_init(dvo, NAB, w, lane);
    tile_dma(Kg, dvo, lds, w); tile_dma(Vg, dvo, lds + 16384, w);
    bf16x8 qf[8];
#pragma unroll
    for (int ks = 0; ks < 8; ++ks) qf[ks] = *(const bf16x8*)(Qg + (size_t)(t0w + r32) * NAB + 16 * ks + 8 * hi);
    { const unsigned* mg = F.MASK + (size_t)(b * SEQ + t0w) * 64;
#pragma unroll 2
      for (int i = 0; i < 8; ++i) { const int c = lane + 64 * i, row = c >> 4, c4 = c & 15; const u32x4 v = *(const u32x4*)(mg + row * 64 + c4 * 4);
          *(LAS unsigned long long*)(mst + row * 264 + c4 * 16) = (unsigned long long)v.x | ((unsigned long long)v.y << 32);
          *(LAS unsigned long long*)(mst + row * 264 + c4 * 16 + 8) = (unsigned long long)v.z | ((unsigned long long)v.w << 32); } }
    f32x16 o[4];
#pragma unroll
    for (int ct = 0; ct < 4; ++ct)
#pragma unroll
        for (int r = 0; r < 16; ++r) o[ct][r] = 0.f;
    float lsum = 0.f;
    asm volatile("s_waitcnt vmcnt(0) lgkmcnt(0)" ::: "memory");
    __syncthreads();
    for (int j = 0; j <= jlast; ++j) {
        const int cur = j & 1;
        const LAS unsigned char* kb = lds + cur * 32768; const LAS unsigned char* vb = kb + 16384;
        if (j < jlast) { tile_dma(Kg + (size_t)(64 * (j + 1)) * NAB, dvo, lds + (cur ^ 1) * 32768, w); tile_dma(Vg + (size_t)(64 * (j + 1)) * NAB, dvo, lds + (cur ^ 1) * 32768 + 16384, w); }
        if (j <= cw) {
            const unsigned long long mw = *(const LAS unsigned long long*)(mst + r32 * 264 + j * 8);
            const unsigned mw0 = (unsigned)mw, mw1 = (unsigned)(mw >> 32);
#pragma unroll 1
            for (int half = 0; half < 2; ++half) {
                const unsigned mwh = half ? mw1 : mw0;
                f32x16 p;
#pragma unroll
                for (int r = 0; r < 16; ++r) p[r] = -mref;
#pragma unroll
                for (int ks = 0; ks < 8; ++ks) p = __builtin_amdgcn_mfma_f32_32x32x16_bf16(k_frag(kb, fo, half, ks), qf[ks], p, 0, 0, 0);
#pragma unroll
                for (int r = 0; r < 16; ++r) { const unsigned keep = (unsigned)(-(int)((mwh >> crow(r, hi)) & 1u));
                    const float e = __uint_as_float(__float_as_uint(__builtin_amdgcn_exp2f(p[r])) & keep); p[r] = e; lsum += e; }
                const bf16x8 pa0 = pack8(p[0], p[1], p[2], p[3], p[4], p[5], p[6], p[7]), pa1 = pack8(p[8], p[9], p[10], p[11], p[12], p[13], p[14], p[15]);
#pragma unroll
                for (int ct = 0; ct < 4; ++ct) {
                    o[ct] = __builtin_amdgcn_mfma_f32_32x32x16_bf16(pa0, v_frag(vb, fo, ct, 2 * half), o[ct], 0, 0, 0);
                    o[ct] = __builtin_amdgcn_mfma_f32_32x32x16_bf16(pa1, v_frag(vb, fo, ct, 2 * half + 1), o[ct], 0, 0, 0);
                }
            }
        }
        asm volatile("s_waitcnt vmcnt(0) lgkmcnt(0)" ::: "memory");
        __syncthreads();
    }
    lsum += __shfl_xor(lsum, 32);
    LAS float* lsc = (LAS float*)mst;
    if (hi == 0) lsc[r32] = 1.0f / lsum;
    asm volatile("s_waitcnt lgkmcnt(0)" ::: "memory");
    float rsc[16];
#pragma unroll
    for (int r = 0; r < 16; ++r) rsc[r] = lsc[crow(r, hi)];
    store_o(o, rsc, lds + w * 8192, F.CAT + (size_t)(b * SEQ + t0w) * D + h * 128, D, lane);
    __syncthreads();
}
__device__ __forceinline__ void ph_dsa(Frame& F) {
    float gm = fmaxf(fabsf(F.gq_a[F.lane]), fabsf(F.gq_a[64 + F.lane])), km = fmaxf(fabsf(F.gk_a[F.lane]), fabsf(F.gk_a[64 + F.lane]));
    gm = wave_max(gm); km = wave_max(km);
    const float mref = att::C2 * 128.0f * gm * km * 1.02f;
    for (int v = F.vcu; v < BATCH * 4 * 4; v += F.G) {
        const int bh = v >> 2, pi = v & 3;
#pragma unroll 1
        for (int k = 0; k < 2; ++k) dsa_unit(F, bh >> 2, bh & 3, k ? 7 - pi : pi, mref);
    }
}
namespace idx {
using att::f32x16;
constexpr int SCP = 2048;
__device__ __forceinline__ unsigned okey(float f) { const unsigned u = __float_as_uint(f); return (u & 0x80000000u) ? ~u : (u | 0x80000000u); }
template <int EP> __device__ __forceinline__ void select_row(const LAS float* sc, int E, unsigned* mrow, int lane) {
    unsigned key[EP];
#pragma unroll
    for (int j = 0; j < EP; ++j) key[j] = (j < E) ? okey(sc[64 * j + lane]) : 0u;
    unsigned T = 0u; bool exact = false;
    for (int bit = 31; bit >= 0; --bit) {
        const unsigned cand = T | (1u << bit); int cnt = 0;
#pragma unroll
        for (int j = 0; j < EP; ++j) cnt += __popcll(__ballot(key[j] >= cand));
        if (cnt >= 256) { T = cand; if (cnt == 256) { exact = true; break; } }
    }
    unsigned long long mine = 0ull;
    if (exact) {
#pragma unroll
        for (int j = 0; j < EP; ++j) { const unsigned long long m = __ballot(key[j] >= T); if (lane == j) mine = m; }
    } else {
        int cgt = 0;
#pragma unroll
        for (int j = 0; j < EP; ++j) cgt += __popcll(__ballot(key[j] > T));
        int need = 256 - cgt;
        const unsigned long long below = (1ull << lane) - 1ull;
#pragma unroll
        for (int j = 0; j < EP; ++j) {
            const unsigned long long eq = __ballot(key[j] == T), gt = __ballot(key[j] > T);
            const bool take = (key[j] == T) && (__popcll(eq & below) < need);
            const unsigned long long m = gt | __ballot(take);
            need -= __popcll(eq); if (need < 0) need = 0;
            if (lane == j) mine = m;
        }
    }
    if (lane < 32) *(unsigned long long*)(mrow + 2 * lane) = (lane < E) ? mine : 0ull;
}
__device__ __forceinline__ void unit(Frame& F, int b, int c, int sub) {
    const int lane = F.lane, w = F.wave, hi = lane >> 5, r32 = lane & 31, tid = F.tid;
    const int n = 64 * (c + 1), t0 = 64 * c + 16 * sub;
    const bf16* P = F.R1 + (size_t)b * SEQ * NAB;
    LAS float* sc = (LAS float*)F.lds;
    LAS float* wt = sc + 16 * SCP;
    if (tid < 128) wt[tid] = bf2f(P[(size_t)(t0 + (tid >> 3)) * NAB + C_IW + (tid & 7)]) * (0.125f * 0.35355339059327373f);
    bf16x8 af[4][4];
#pragma unroll
    for (int rt = 0; rt < 4; ++rt)
#pragma unroll
        for (int ks = 0; ks < 4; ++ks) af[rt][ks] = *(const bf16x8*)(P + (size_t)(t0 + 4 * rt + (r32 >> 3)) * NAB + C_IQ + (r32 & 7) * 64 + 16 * ks + 8 * hi);
    __syncthreads();
    const int nstrip = n >> 5;
    bf16x8 bfr[4], bnx[4];
    if (w < nstrip) {
#pragma unroll
        for (int ks = 0; ks < 4; ++ks) bfr[ks] = *(const bf16x8*)(P + (size_t)(32 * w + r32) * NAB + C_IK + 16 * ks + 8 * hi);
    }
    for (int s = w; s < nstrip; s += NWAVES) {
        const bool more = s + NWAVES < nstrip;
        if (more) {
#pragma unroll
            for (int ks = 0; ks < 4; ++ks) bnx[ks] = *(const bf16x8*)(P + (size_t)(32 * (s + NWAVES) + r32) * NAB + C_IK + 16 * ks + 8 * hi);
        }
#pragma unroll
        for (int rt = 0; rt < 4; ++rt) {
            f32x16 acc;
#pragma unroll
            for (int r = 0; r < 16; ++r) acc[r] = 0.f;
#pragma unroll
            for (int ks = 0; ks < 4; ++ks) acc = __builtin_amdgcn_mfma_f32_32x32x16_bf16(af[rt][ks], bfr[ks], acc, 0, 0, 0);
            float part[4];
#pragma unroll
            for (int qi = 0; qi < 4; ++qi) { const f32x4 wv = *(const LAS f32x4*)(wt + (4 * rt + qi) * 8 + 4 * hi);
                part[qi] = fmaxf(acc[4 * qi], 0.f) * wv[0] + fmaxf(acc[4 * qi + 1], 0.f) * wv[1] + fmaxf(acc[4 * qi + 2], 0.f) * wv[2] + fmaxf(acc[4 * qi + 3], 0.f) * wv[3]; }
            const float send0 = hi ? part[0] : part[2], send1 = hi ? part[1] : part[3];
            const float got0 = __shfl_xor(send0, 32), got1 = __shfl_xor(send1, 32);
            const float f0 = (hi ? part[2] : part[0]) + got0, f1 = (hi ? part[3] : part[1]) + got1;
            const int q0 = 4 * rt + 2 * hi;
            sc[q0 * SCP + 32 * s + r32] = f0; sc[(q0 + 1) * SCP + 32 * s + r32] = f1;
        }
        if (more) {
#pragma unroll
            for (int ks = 0; ks < 4; ++ks) bfr[ks] = bnx[ks];
        }
    }
    __syncthreads();
    const int E = n >> 6;
#pragma unroll 1
    for (int rr = 0; rr < 2; ++rr) {
        const int q = 2 * w + rr;
        unsigned* mrow = F.MASK + (size_t)(b * SEQ + t0 + q) * 64;
        const LAS float* row = sc + q * SCP;
        if (E <= 8) select_row<8>(row, E, mrow, lane);
        else if (E <= 16) select_row<16>(row, E, mrow, lane);
        else if (E <= 24) select_row<24>(row, E, mrow, lane);
        else select_row<32>(row, E, mrow, lane);
    }
    __syncthreads();
}
}
__device__ __forceinline__ void ph_indexer(Frame& F) {
    { const int gw = F.vcu * NWAVES + F.wave, NGW = F.G * NWAVES;
      for (int i = gw; i < BATCH * 256; i += NGW) { const int b = i >> 8, pos = i & 255, n = ((pos >> 6) + 1) << 6;
          if (F.lane < 32) { unsigned long long v = 0ull; if (64 * F.lane < n) v = ~0ull; *(unsigned long long*)(F.MASK + (size_t)(b * SEQ + pos) * 64 + 2 * F.lane) = v; } } }
    for (int u = F.vcu; u < BATCH * 28 * 4; u += F.G) { const int c = 4 + u % 28, rest = u / 28; idx::unit(F, rest >> 2, c, rest & 3); }
}
#ifndef MK_PER_PHASE
#define MK_PER_PHASE 0
#endif
constexpr int NPH = 14;
struct Args { const float* in[16]; float* out; unsigned char* ws; int ph_lo, ph_hi; };
__global__ void __launch_bounds__(NTHR, 2) mk_fwd(Args args) {
    extern __shared__ __attribute__((aligned(16))) unsigned char lds[];
    Frame F;
    F.lds = (LAS unsigned char*)lds;
    F.MISC = (volatile LAS unsigned*)(F.lds + MISC_OFF);
    F.wave = __builtin_amdgcn_readfirstlane((int)threadIdx.x >> 6);
#define RELANE() (F.lane = (int)__builtin_amdgcn_mbcnt_hi(~0u, __builtin_amdgcn_mbcnt_lo(~0u, 0u)), F.tid = F.wave * 64 + F.lane, true)
    RELANE();
    F.G = gridDim.x; { const int bx = blockIdx.x; F.vcu = (F.G % 8 == 0) ? (bx % 8) * (F.G / 8) + bx / 8 : bx; }
    unsigned char* ws = args.ws;
    F.ctl = (gu32*)(ws + WS_CTL);
    F.x = args.in[0]; F.g_mix = args.in[1]; F.g_ffn = args.in[2]; F.w_in_ab = args.in[3]; F.gq_a = args.in[4]; F.gk_a = args.in[5]; F.w_gate_up = args.in[6]; F.b_gate = args.in[7];
    F.g_gla = args.in[8]; F.w_out_ab = args.in[9]; F.w_in_c = args.in[10]; F.gq_c = args.in[11]; F.gk_c = args.in[12]; F.w_out_c = args.in[13]; F.w_up = args.in[14]; F.w_down = args.in[15];
    F.out = args.out;
    F.Wab = (bf16*)(ws + WS_WAB); F.Woab = (bf16*)(ws + WS_WOAB); F.Wup0 = (bf16*)(ws + WS_WUP0); F.Wdn0 = (bf16*)(ws + WS_WDN0);
    F.Winc = (bf16*)(ws + WS_WINC); F.Woc = (bf16*)(ws + WS_WOC); F.Wup1 = (bf16*)(ws + WS_WUP1); F.Wdn1 = (bf16*)(ws + WS_WDN1);
    F.XB = (bf16*)(ws + WS_XB); F.CAT = (bf16*)(ws + WS_CAT); F.R1 = (bf16*)(ws + WS_R1); F.SSQ = (float*)(ws + WS_SSQ); F.MASK = (unsigned*)(ws + WS_MASK);
    for (int u = F.tid; u < (LDS_BYTES - MISC_OFF) / 4; u += NTHR) ((LAS unsigned*)(F.lds + MISC_OFF))[u] = 0u;
    __syncthreads();
    XcdBarrier bar; bar.bar = (unsigned*)(F.ctl + CW_BAR); bar.x = 0; bar.st = nullptr; bar.wave = F.wave;
    if (!MK_PER_PHASE) bar = xcd_barrier_post((unsigned*)(F.ctl + CW_BAR), F.MISC + 8, F.wave);
    const int lo = args.ph_lo, hi = args.ph_hi;
#define IN(k) (lo <= (k) && (k) < hi && RELANE())
#define SEAM(k) do { if (lo <= (k) && (k) + 1 < hi) xcd_barrier(bar); } while (0)
    float* const SSQ0 = F.SSQ, *SSQ1 = F.SSQ + (size_t)M * 16, *SSQ2 = F.SSQ + (size_t)2 * M * 16, *SSQ3 = F.SSQ + (size_t)3 * M * 16;
    typedef pg8::StaticOrder SO;
    if (IN(0)) { ph_prologue(F); } SEAM(0);
    if (IN(1)) { pg8::Gemm g{F.XB, F.Wab, M, NAB, D}; SO S; S.init(M, NAB, F.G, (int)blockIdx.x); pg8::EpiScale<0> E{F.R1, NAB, SSQ0};
        pg8::gemm_phase<pg8::EpiScale<0>, SO, true, true>(F.lds, g, S, E, F.wave); } SEAM(1);
    if (IN(2)) { ph_prep_a<true>(F); } SEAM(2);
    if (IN(3)) { ph_indexer(F); } SEAM(3);
    if (IN(4)) { ph_dsa(F); __syncthreads(); ph_gla_naive(F); } SEAM(4);
    if (IN(5)) { pg8::Gemm g{F.CAT, F.Woab, M, D, D}; SO S; S.init(M, D, F.G, (int)blockIdx.x); pg8::EpiResid<1> E{F.x, F.out, F.XB, SSQ1};
        pg8::gemm_phase<pg8::EpiResid<1>, SO, true, true>(F.lds, g, S, E, F.wave); } SEAM(5);
    if (IN(6)) { pg8::Gemm g{F.XB, F.Wup0, M, FF, D}; SO S; S.init(M, FF, F.G, (int)blockIdx.x); pg8::EpiScale<1> E{F.R1, FF, SSQ1};
        pg8::gemm_phase<pg8::EpiScale<1>, SO, true, true>(F.lds, g, S, E, F.wave); } SEAM(6);
    if (IN(7)) { pg8::Gemm g{F.R1, F.Wdn0, M, D, FF}; SO S; S.init(M, D, F.G, (int)blockIdx.x); pg8::EpiResid<1> E{F.out, F.out, F.XB, SSQ2};
        pg8::gemm_phase<pg8::EpiResid<1>, SO, true, true>(F.lds, g, S, E, F.wave); } SEAM(7);
    if (IN(8)) { pg8::Gemm g{F.XB, F.Winc, M, NC, D}; SO S; S.init(M, NC, F.G, (int)blockIdx.x); pg8::EpiScale<0> E{F.R1, NC, SSQ2};
        pg8::gemm_phase<pg8::EpiScale<0>, SO, true, true>(F.lds, g, S, E, F.wave); } SEAM(8);
    if (IN(9)) { ph_prep_c<true>(F); } SEAM(9);
    if (IN(10)) { ph_sb(F); } SEAM(10);
    if (IN(11)) { pg8::Gemm g{F.CAT, F.Woc, M, D, D}; SO S; S.init(M, D, F.G, (int)blockIdx.x); pg8::EpiResid<1> E{F.out, F.out, F.XB, SSQ3};
        pg8::gemm_phase<pg8::EpiResid<1>, SO, true, true>(F.lds, g, S, E, F.wave); } SEAM(11);
    if (IN(12)) { pg8::Gemm g{F.XB, F.Wup1, M, FF, D}; SO S; S.init(M, FF, F.G, (int)blockIdx.x); pg8::EpiScale<1> E{F.R1, FF, SSQ3};
        pg8::gemm_phase<pg8::EpiScale<1>, SO, true, true>(F.lds, g, S, E, F.wave); } SEAM(12);
    if (IN(13)) { pg8::Gemm g{F.R1, F.Wdn1, M, D, FF}; SO S; S.init(M, D, F.G, (int)blockIdx.x); pg8::EpiResid<0> E{F.out, F.out, nullptr, nullptr};
        pg8::gemm_phase<pg8::EpiResid<0>, SO, true, true>(F.lds, g, S, E, F.wave); }
#undef IN
#undef SEAM
}

extern "C" void kernel_launch(void* const* d_in, const int* in_sizes, int n_in, void* d_out, int out_size, void* d_ws, size_t ws_size, hipStream_t stream) {
    static int grid = 0;
    if (grid == 0) {
        if (n_in != 16 || in_sizes[0] != M * D || out_size != M * D || ws_size < WS_END) { fprintf(stderr, "kernel_launch: unexpected shapes / workspace (%d inputs, ws %zu)\n", n_in, ws_size); grid = -1; return; }
        int dev = 0, cus = 0;
        if (hipGetDevice(&dev) != hipSuccess || hipDeviceGetAttribute(&cus, hipDeviceAttributeMultiprocessorCount, dev) != hipSuccess) { grid = -1; return; }
        if (hipFuncSetAttribute((const void*)mk_fwd, hipFuncAttributeMaxDynamicSharedMemorySize, LDS_BYTES) != hipSuccess) { fprintf(stderr, "kernel_launch: hipFuncSetAttribute failed\n"); grid = -1; return; }
        (void)hipGetLastError();
        grid = cus;
    }
    if (grid < 0) return;
    if (hipMemsetAsync((char*)d_ws + WS_CTL, 0, CTL_ZERO_BYTES, stream) != hipSuccess) { fprintf(stderr, "kernel_launch: memset failed\n"); return; }
    Args a{};
    for (int i = 0; i < 16; ++i) a.in[i] = (const float*)d_in[i];
    a.out = (float*)d_out; a.ws = (unsigned char*)d_ws;
#if MK_PER_PHASE
    for (int ph = 0; ph < NPH; ++ph) { a.ph_lo = ph; a.ph_hi = ph + 1; hipLaunchKernelGGL(mk_fwd, dim3(grid), dim3(NTHR), LDS_BYTES, stream, a); }
#else
    a.ph_lo = 0; a.ph_hi = NPH;
    hipLaunchKernelGGL(mk_fwd, dim3(grid), dim3(NTHR), LDS_BYTES, stream, a);
#endif
    const hipError_t le = hipPeekAtLastError();
    if (le != hipSuccess) fprintf(stderr, "kernel_launch: launch failed: %s\n", hipGetErrorName(le));
}
```

```cpp
#include <hip/hip_runtime.h>
#include <cstdio>
#include <cstdint>
namespace pg8 {
#define PG8_LAS __attribute__((address_space(3)))
typedef unsigned short bf16_t;
typedef short bf16x8 __attribute__((ext_vector_type(8)));
typedef float f32x4 __attribute__((ext_vector_type(4)));
typedef unsigned u32x4 __attribute__((ext_vector_type(4)));
constexpr int BM = 256, BK = 64, HALF = 128, HTB = HALF * BK * 2  , STAGE_BYTES = 8 * HTB, NXCD = 8, WGM = 8;

__host__ __device__ __forceinline__ int lds_byte(int r, int c) { const int st = (r >> 4) * 2 + (c >> 5), rr = r & 15, cc = c & 31, ob = rr * 64 + cc * 2; return st * 1024 + (ob ^ (((ob >> 9) & 1) << 5)); }
__host__ __device__ __forceinline__ void stage_rc(int b, int& R, int& C) { const int st = b / 1024, sb = b % 1024, swz = sb ^ (((sb >> 9) & 1) << 5); R = (st >> 1) * 16 + swz / 64; C = (st & 1) * 32 + (swz % 64) / 2; }
__host__ __device__ __forceinline__ int perm32(int rho) { const int n = rho >> 4, i = rho & 15; return 8 * (i >> 2) + 4 * n + (i & 3); }

struct Unit { int pm, pn; };
struct Gemm { const bf16_t* A; const bf16_t* Bt; int M, N, K; };

struct StaticOrder {
    int nM, nN, nwg, G, c;
    __host__ __device__ void init(int M, int N, int G_, int c_) { nM = M / BM; nN = N / BM; nwg = nM * nN; G = G_; c = c_; }
    __host__ __device__ bool next(int i, Unit& u) const {
        const long L = (long)i * G + c; if (L >= nwg) return false;
        int wgid = (int)L; { const int q = nwg / NXCD, r = nwg % NXCD, xcd = wgid % NXCD, off = wgid / NXCD; wgid = (xcd < r ? xcd * (q + 1) : r * (q + 1) + (xcd - r) * q) + off; }
        const int nig = WGM * nN, gid = wgid / nig, fm = gid * WGM, gsz = (nM - fm) < WGM ? (nM - fm) : WGM;
        u.pm = fm + ((wgid % nig) % gsz); u.pn = (wgid % nig) / gsz; return true;
    }
    __device__ __forceinline__ void a_ready(const Unit&) const {}
    __device__ __forceinline__ void done(const Unit&) const {}
};

__device__ __forceinline__ unsigned cvt_pk_bf16(float lo, float hi) { unsigned r; asm volatile("v_cvt_pk_bf16_f32 %0, %1, %2" : "=v"(r) : "v"(lo), "v"(hi)); return r; }
__device__ __forceinline__ float row_rstd(const float* ssqp, int row) {
    const f32x4* p = (const f32x4*)(ssqp + (size_t)row * 16);
    const f32x4 a = p[0], b = p[1], c = p[2], d = p[3];
    const float s = (((a[0] + a[1]) + (a[2] + a[3])) + ((b[0] + b[1]) + (b[2] + b[3]))) + (((c[0] + c[1]) + (c[2] + c[3])) + ((d[0] + d[1]) + (d[2] + d[3])));
    return rsqrtf(s * (1.0f / 1024.0f) + 1e-6f);
}
template <int ACT  > struct EpiScale {
    static constexpr bool PERM = true, AFTER_DRAIN = false;
    bf16_t* O; int ldc; const float* ssqp;
    __device__ __forceinline__ void operator()(const f32x4 (&acc)[2][2][4][2], const Unit& u, int wr, int wc, int fr, int fq) const {
        const int row0 = u.pm * BM + wr * 64 + fr, col0 = u.pn * BM + wc * 32 + 8 * fq;
#pragma unroll
        for (int ai = 0; ai < 2; ++ai)
#pragma unroll
            for (int m = 0; m < 4; ++m) {
                const int row = row0 + ai * HALF + m * 16;
                const float rs = row_rstd(ssqp, row);
                bf16_t* rowp = O + (size_t)row * ldc + col0;
#pragma unroll
                for (int bj = 0; bj < 2; ++bj) {
                    f32x4 v0 = acc[ai][bj][m][0] * rs, v1 = acc[ai][bj][m][1] * rs;
                    if (ACT == 1) {
#pragma unroll
                        for (int e = 0; e < 4; ++e) { const float a0 = fmaxf(v0[e], 0.f), a1 = fmaxf(v1[e], 0.f); v0[e] = a0 * a0; v1[e] = a1 * a1; }
                    }
                    u32x4 w; w.x = cvt_pk_bf16(v0[0], v0[1]); w.y = cvt_pk_bf16(v0[2], v0[3]); w.z = cvt_pk_bf16(v1[0], v1[1]); w.w = cvt_pk_bf16(v1[2], v1[3]);
                    *(u32x4*)(rowp + bj * HALF) = w;
                }
            }
    }
};
template <int WRITE_HB> struct EpiResid {
    static constexpr bool PERM = true, AFTER_DRAIN = false;
    const float* R; float* out; bf16_t* hb; float* ssqp;
    __device__ __forceinline__ void operator()(const f32x4 (&acc)[2][2][4][2], const Unit& u, int wr, int wc, int fr, int fq) const {
        const int row0 = u.pm * BM + wr * 64 + fr, col0 = u.pn * BM + wc * 32 + 8 * fq;
#pragma unroll
        for (int ai = 0; ai < 2; ++ai)
#pragma unroll
            for (int m = 0; m < 4; ++m) {
                const int row = row0 + ai * HALF + m * 16;
                const size_t off = (size_t)row * 1024 + col0;
                float ss = 0.f;
#pragma unroll
                for (int bj = 0; bj < 2; ++bj) {
                    const f32x4 r0 = *(const f32x4*)(R + off + bj * HALF), r1 = *(const f32x4*)(R + off + bj * HALF + 4);
                    const f32x4 v0 = acc[ai][bj][m][0] + r0, v1 = acc[ai][bj][m][1] + r1;
                    *(f32x4*)(out + off + bj * HALF) = v0; *(f32x4*)(out + off + bj * HALF + 4) = v1;
                    if (WRITE_HB) {
                        u32x4 w; w.x = cvt_pk_bf16(v0[0], v0[1]); w.y = cvt_pk_bf16(v0[2], v0[3]); w.z = cvt_pk_bf16(v1[0], v1[1]); w.w = cvt_pk_bf16(v1[2], v1[3]);
                        *(u32x4*)(hb + off + bj * HALF) = w;
                        ss += ((v0[0] * v0[0] + v0[1] * v0[1]) + (v0[2] * v0[2] + v0[3] * v0[3])) + ((v1[0] * v1[0] + v1[1] * v1[1]) + (v1[2] * v1[2] + v1[3] * v1[3]));
                    }
                }
                if (WRITE_HB) { ss += __shfl_xor(ss, 16); ss += __shfl_xor(ss, 32); if (fq == 0) ssqp[(size_t)row * 16 + u.pn * 4 + wc] = ss; }
            }
    }
};
template <class Epi, class Sched, bool ALIGN_EPI = false, bool SP2 = false>
__device__ __forceinline__ void gemm_phase(PG8_LAS unsigned char* lds, const Gemm g, const Sched& S, const Epi& E, const int wave_in) {
    const int wid = wave_in, lane = (int)__builtin_amdgcn_mbcnt_hi(~0u, __builtin_amdgcn_mbcnt_lo(~0u, 0u)), tid = wid * 64 + lane, wr = wid >> 2, wc = wid & 3, fr = lane & 15, fq = lane >> 4;
    const int K = g.K, nt = K / BK;
    unsigned voffA[2], voffB[2];
#pragma unroll
    for (int i = 0; i < 2; ++i) { int R, C; stage_rc(tid * 16 + i * 8192, R, C); const int Rb = Epi::PERM ? ((R & ~31) + perm32(R & 31)) : R;
        voffA[i] = (unsigned)(R * K + C) * 2u; voffB[i] = (unsigned)(Rb * K + C) * 2u; }
    const size_t kstep = (size_t)(BK * 2);
    const size_t hstep = (size_t)HALF * K * 2;
    const size_t tstep = 2 * hstep;
    const unsigned ldsw = (unsigned)wid * 1024u;
    const int aoff = lds_byte(wr * 64 + fr, fq * 8), boff = lds_byte(wc * 32 + fr, fq * 8);
#define PG8_SA(b, h) (((b) * 2 + (h)) * HTB)
#define PG8_SB(b, h) ((4 + (b) * 2 + (h)) * HTB)
#define PG8_STAGE(bufoff, gbase, voff) do { _Pragma("unroll") for (int _i = 0; _i < 2; ++_i) \
        __builtin_amdgcn_global_load_lds((const unsigned*)((const char*)(gbase) + (voff)[_i]), (PG8_LAS unsigned*)(lds + (bufoff) + ldsw + _i * 8192), 16, 0, 0); } while (0)
#define PG8_LDA(dst, b, h) do { _Pragma("unroll") for (int m = 0; m < 4; ++m) _Pragma("unroll") for (int k = 0; k < 2; ++k) dst[m][k] = *(const PG8_LAS bf16x8*)(lds + PG8_SA(b, h) + aoff + m * 2048 + k * 1024); } while (0)
#define PG8_LDB(dst, b, h) do { _Pragma("unroll") for (int n = 0; n < 2; ++n) _Pragma("unroll") for (int k = 0; k < 2; ++k) dst[n][k] = *(const PG8_LAS bf16x8*)(lds + PG8_SB(b, h) + boff + n * 2048 + k * 1024); } while (0)
#define PG8_MMA(ai, bj, At, Bt) do { __builtin_amdgcn_s_setprio(1); _Pragma("unroll") for (int m = 0; m < 4; ++m) _Pragma("unroll") for (int n = 0; n < 2; ++n) _Pragma("unroll") for (int k = 0; k < 2; ++k) \
        acc[ai][bj][m][n] = __builtin_amdgcn_mfma_f32_16x16x32_bf16(Bt[n][k], At[m][k], acc[ai][bj][m][n], 0, 0, 0); __builtin_amdgcn_s_setprio(0); } while (0)
#define PG8_WAIT_V(n) asm volatile("s_waitcnt vmcnt(" #n ")" ::: "memory")
#define PG8_WAIT_L(n) asm volatile("s_waitcnt lgkmcnt(" #n ")" ::: "memory")
#define PG8_BAR __builtin_amdgcn_s_barrier()
#define PG8_SCHED __builtin_amdgcn_sched_barrier(0)
    Unit cur, nxt; int ui = 0;
    if (!S.next(0, cur)) return;
    f32x4 acc[2][2][4][2];
#pragma unroll
    for (int a = 0; a < 2; ++a)
#pragma unroll
        for (int b = 0; b < 2; ++b)
#pragma unroll
            for (int m = 0; m < 4; ++m)
#pragma unroll
                for (int n = 0; n < 2; ++n) acc[a][b][m][n] = (f32x4){0.f, 0.f, 0.f, 0.f};
    bf16x8 At[4][2], B0[2][2], B1[2][2];
    const char* cA = (const char*)g.A + (size_t)cur.pm * tstep; const char* cB = (const char*)g.Bt + (size_t)cur.pn * tstep;
    S.a_ready(cur);
    if constexpr (SP2) {
        PG8_STAGE(PG8_SB(0, 0), cB, voffB); PG8_STAGE(PG8_SB(0, 1), cB + hstep, voffB); PG8_STAGE(PG8_SA(0, 0), cA, voffA); PG8_STAGE(PG8_SA(0, 1), cA + hstep, voffA);
        if (wr == 1) PG8_BAR;
        PG8_WAIT_V(2); PG8_BAR;
        PG8_STAGE(PG8_SB(1, 0), cB + kstep, voffB); PG8_STAGE(PG8_SA(1, 0), cA + kstep, voffA); PG8_STAGE(PG8_SB(1, 1), cB + hstep + kstep, voffB);
        PG8_WAIT_V(6); PG8_BAR;
    } else {
        PG8_STAGE(PG8_SB(0, 0), cB, voffB); PG8_STAGE(PG8_SA(0, 0), cA, voffA); PG8_STAGE(PG8_SB(0, 1), cB + hstep, voffB); PG8_STAGE(PG8_SA(0, 1), cA + hstep, voffA);
        if (wr == 1) PG8_BAR;
        PG8_WAIT_V(4); PG8_BAR;
        PG8_STAGE(PG8_SB(1, 0), cB + kstep, voffB); PG8_STAGE(PG8_SA(1, 0), cA + kstep, voffA); PG8_STAGE(PG8_SB(1, 1), cB + hstep + kstep, voffB);
        PG8_WAIT_V(6); PG8_BAR;
    }
    for (;;) {
        const bool has_next = S.next(ui + 1, nxt);
        const char* nA = has_next ? (const char*)g.A + (size_t)nxt.pm * tstep : cA; const char* nB = has_next ? (const char*)g.Bt + (size_t)nxt.pn * tstep : cB;
        for (int t = 0; t < nt; t += 2) {
            const bool last = (t == nt - 2);
            const char* a1 = cA + (size_t)(t + 1) * kstep;
            const char* a2 = last ? nA : cA + (size_t)(t + 2) * kstep; const char* b2 = last ? nB : cB + (size_t)(t + 2) * kstep;
            const char* a3 = a2 + kstep; const char* b3 = b2 + kstep;
            if (last && has_next) S.a_ready(nxt);
            if constexpr (SP2) {
            PG8_LDB(B0, 0, 0); PG8_LDB(B1, 0, 1); PG8_SCHED; PG8_LDA(At, 0, 0); PG8_STAGE(PG8_SA(1, 1), a1 + hstep, voffA);
            PG8_WAIT_V(8); PG8_WAIT_L(0); PG8_BAR; PG8_MMA(0, 0, At, B0); PG8_MMA(0, 1, At, B1); PG8_BAR; PG8_SCHED;
            PG8_LDA(At, 0, 1); PG8_STAGE(PG8_SB(0, 0), b2, voffB); PG8_STAGE(PG8_SB(0, 1), b2 + hstep, voffB); PG8_STAGE(PG8_SA(0, 0), a2, voffA);
            PG8_WAIT_V(8); PG8_WAIT_L(0); PG8_BAR; PG8_MMA(1, 0, At, B0); PG8_MMA(1, 1, At, B1); PG8_BAR; PG8_SCHED;
            PG8_LDB(B0, 1, 0); PG8_LDB(B1, 1, 1); PG8_SCHED; PG8_LDA(At, 1, 0); PG8_STAGE(PG8_SA(0, 1), a2 + hstep, voffA);
            PG8_WAIT_V(8); PG8_WAIT_L(0); PG8_BAR; PG8_MMA(0, 0, At, B0); PG8_MMA(0, 1, At, B1); PG8_BAR; PG8_SCHED;
            PG8_LDA(At, 1, 1); PG8_STAGE(PG8_SB(1, 0), b3, voffB); PG8_STAGE(PG8_SB(1, 1), b3 + hstep, voffB); PG8_STAGE(PG8_SA(1, 0), a3, voffA);
            PG8_WAIT_V(8); PG8_WAIT_L(0); PG8_BAR; PG8_MMA(1, 0, At, B0); PG8_MMA(1, 1, At, B1); PG8_BAR; PG8_SCHED;
            } else {
            PG8_LDB(B0, 0, 0); PG8_SCHED; PG8_LDA(At, 0, 0); PG8_STAGE(PG8_SA(1, 1), a1 + hstep, voffA);
            PG8_WAIT_L(8); PG8_BAR; PG8_WAIT_L(0); PG8_MMA(0, 0, At, B0); PG8_BAR; PG8_SCHED;
            PG8_LDB(B1, 0, 1); PG8_STAGE(PG8_SB(0, 0), b2, voffB);
            PG8_BAR; PG8_WAIT_L(0); PG8_MMA(0, 1, At, B1); PG8_BAR;
            PG8_LDA(At, 0, 1); PG8_STAGE(PG8_SA(0, 0), a2, voffA);
            PG8_BAR; PG8_WAIT_L(0); PG8_MMA(1, 0, At, B0); PG8_BAR; PG8_SCHED;
            PG8_STAGE(PG8_SB(0, 1), b2 + hstep, voffB);
            PG8_WAIT_V(6); PG8_BAR; PG8_MMA(1, 1, At, B1); PG8_BAR;
            PG8_LDB(B0, 1, 0); PG8_SCHED; PG8_LDA(At, 1, 0); PG8_STAGE(PG8_SA(0, 1), a2 + hstep, voffA);
            PG8_WAIT_L(8); PG8_BAR; PG8_WAIT_L(0); PG8_MMA(0, 0, At, B0); PG8_BAR; PG8_SCHED;
            PG8_LDB(B1, 1, 1); PG8_STAGE(PG8_SB(1, 0), b3, voffB);
            PG8_BAR; PG8_WAIT_L(0); PG8_MMA(0, 1, At, B1); PG8_BAR;
            PG8_LDA(At, 1, 1); PG8_STAGE(PG8_SA(1, 0), a3, voffA);
            PG8_BAR; PG8_WAIT_L(0); PG8_MMA(1, 0, At, B0); PG8_BAR; PG8_SCHED;
            PG8_STAGE(PG8_SB(1, 1), b3 + hstep, voffB);
            PG8_WAIT_V(6); PG8_BAR; PG8_MMA(1, 1, At, B1); PG8_BAR;
            }
        }
        if constexpr (ALIGN_EPI) { if (wr == 0) PG8_BAR; }
        if constexpr (!Epi::AFTER_DRAIN) { E(acc, cur, wr, wc, fr, fq); S.done(cur); }
        if (!has_next) break;
#pragma unroll
        for (int a = 0; a < 2; ++a)
#pragma unroll
            for (int b = 0; b < 2; ++b)
#pragma unroll
                for (int m = 0; m < 4; ++m)
#pragma unroll
                    for (int n = 0; n < 2; ++n) acc[a][b][m][n] = (f32x4){0.f, 0.f, 0.f, 0.f};
        cur = nxt; cA = nA; cB = nB; ++ui;
        if constexpr (ALIGN_EPI) { if (wr == 1) PG8_BAR; }
    }
    PG8_WAIT_V(0);
    if constexpr (!ALIGN_EPI) { if (wr == 0) PG8_BAR; }
    PG8_BAR;
    if constexpr (Epi::AFTER_DRAIN) { E.fused(acc, cur, wr, wc, fr, fq, lds, wid, lane); S.done(cur); }
#undef PG8_SA
#undef PG8_SB
#undef PG8_STAGE
#undef PG8_LDA
#undef PG8_LDB
#undef PG8_MMA
#undef PG8_WAIT_V
#undef PG8_WAIT_L
#undef PG8_BAR
#undef PG8_SCHED
}
}
#include <cmath>
constexpr int NWAVES = 8, NTHR = 512;
constexpr int BATCH = 16, SEQ = 2048, M = BATCH * SEQ, D = 1024, FF = 4096, NAB = 3840, NC = 3072, ABP_OLD = 3672;
constexpr int C_QA = 0, C_KA = 512, C_VA = 1024, C_IQ = 1536, C_QB = 2048, C_KB = 2304, C_VB = 2560, C_OG = 3072, C_IK = 3584, C_IW = 3648, C_GL = 3656;
constexpr float EPS = 1e-6f;
constexpr size_t MiB = 1u << 20;
constexpr size_t WS_CTL = 0, CTL_ZERO_BYTES = 1 * MiB;
constexpr size_t WS_WAB = 1 * MiB, WS_WOAB = 9 * MiB, WS_WUP0 = 11 * MiB, WS_WDN0 = 19 * MiB, WS_WINC = 27 * MiB, WS_WOC = 33 * MiB, WS_WUP1 = 35 * MiB, WS_WDN1 = 43 * MiB;
constexpr size_t WS_SSQ = 51 * MiB, SSQ_BYTES = 2 * MiB;
constexpr size_t WS_DEC = 59 * MiB;
constexpr size_t WS_XB = 60 * MiB;
constexpr size_t WS_CAT = 124 * MiB;
constexpr size_t WS_MASK = 188 * MiB;
constexpr size_t WS_R1 = 196 * MiB;
constexpr size_t WS_END = 452 * MiB;
constexpr int CW_BAR = 4096;
constexpr int RING_BYTES = 131072;
constexpr int LDS_BYTES = 163840;
constexpr int MISC_OFF = LDS_BYTES - 256;
#define GAS __attribute__((address_space(1)))
#define LAS __attribute__((address_space(3)))
typedef unsigned short bf16;
typedef unsigned v4u __attribute__((ext_vector_type(4)));
typedef float f32x4 __attribute__((ext_vector_type(4)));
typedef short bf16x8 __attribute__((ext_vector_type(8)));
typedef GAS unsigned gu32;
typedef GAS unsigned long long gu64;
#define RLX_AGENT __ATOMIC_RELAXED, __HIP_MEMORY_SCOPE_AGENT
#define LDS_WAIT() asm volatile("s_waitcnt lgkmcnt(0)" ::: "memory")
#define VM_WAIT() asm volatile("s_waitcnt vmcnt(0)" ::: "memory")
__device__ __forceinline__ unsigned long long rt() { return __builtin_amdgcn_s_memrealtime(); }
__device__ __forceinline__ unsigned f2bf(float f) { unsigned u = __builtin_bit_cast(unsigned, f); return (u + 0x7fffu + ((u >> 16) & 1u)) >> 16; }
__device__ __forceinline__ unsigned pk2(float lo, float hi) { return f2bf(lo) | (f2bf(hi) << 16); }
#define XB_TMO      128
#define XB_XCNT(j)  (256  + 64 * (j))
#define XB_XSUB(j)  (1280 + 64 * (j))
#define XB_XGEN(j)  (2304 + 64 * (j))
#define XB_TOP      3328
#define XB_TOPGEN   3392
#define XCD_BAR_WORDS 3456
#define XB_SPIN_CAP (1u << 18)

__device__ __forceinline__ unsigned xb_ld(unsigned* p)              { return __hip_atomic_load(p, __ATOMIC_RELAXED, __HIP_MEMORY_SCOPE_AGENT); }
__device__ __forceinline__ unsigned xb_add(unsigned* p, unsigned v) { return __hip_atomic_fetch_add(p, v, __ATOMIC_RELAXED, __HIP_MEMORY_SCOPE_AGENT); }
__device__ __forceinline__ unsigned xb_xcc_id() { return (unsigned)__builtin_amdgcn_s_getreg((3 << 11) | 20) & 0xFu; }
#define XB_SPIN(cond, bar) do { unsigned _sp = 0; while (cond) { __builtin_amdgcn_s_sleep(1); \
    if ((++_sp & 255u) == 0u) { if (xb_ld(&(bar)[XB_TMO])) break; if (_sp > XB_SPIN_CAP) { atomicAdd(&(bar)[XB_TMO], 1u); break; } } } } while (0)

struct XcdBarrier {
    unsigned* bar; unsigned x; int wave;
    volatile LAS unsigned* st;
};

__device__ __forceinline__ bool xb_t0(int wave) { return wave == 0 && __builtin_amdgcn_mbcnt_hi(~0u, __builtin_amdgcn_mbcnt_lo(~0u, 0u)) == 0u; }
__device__ __forceinline__ XcdBarrier xcd_barrier_post(unsigned* bar, volatile LAS unsigned* st, int wave) {
    XcdBarrier b; b.bar = bar; b.x = xb_xcc_id(); b.st = st; b.wave = wave;
    if (xb_t0(wave)) (void)xb_add(&bar[XB_XCNT(b.x)], 1u);
    return b;
}
__device__ __forceinline__ void xcd_barrier_complete(unsigned* bar, unsigned x, unsigned& nloc, unsigned& nx) {
    const unsigned G = gridDim.x * gridDim.y * gridDim.z;
    unsigned sum, cnt, mine, sp = 0u;
    for (;;) {
        sum = 0u; cnt = 0u; mine = 0u;
#pragma unroll
        for (unsigned j = 0; j < 16; ++j) { const unsigned c = xb_ld(&bar[XB_XCNT(j)]); sum += c; cnt += (c > 0u) ? 1u : 0u; mine = (j == x) ? c : mine; }
        if (sum == G) break;
        __builtin_amdgcn_s_sleep(1);
        if ((++sp & 255u) == 0u) { if (xb_ld(&bar[XB_TMO])) break; if (sp > XB_SPIN_CAP) { atomicAdd(&bar[XB_TMO], 1u); break; } }
    }
    nloc = mine > 0u ? mine : 1u; nx = cnt > 0u ? cnt : 1u;
}

__device__ __forceinline__ void xcd_barrier(const XcdBarrier& b) {
    asm volatile("s_waitcnt vmcnt(0)" ::: "memory");
    __syncthreads();
    if (xb_t0(b.wave)) {
        unsigned* bar = b.bar;
        __builtin_amdgcn_s_waitcnt(0);
        unsigned nloc = b.st[0], nx = b.st[1];
        if (nloc == 0u) { xcd_barrier_complete(bar, b.x, nloc, nx); b.st[0] = nloc; b.st[1] = nx; }
        const unsigned old = xb_add(&bar[XB_XSUB(b.x)], 1u);
        const unsigned gen = old / nloc;
        if (old + 1u == (gen + 1u) * nloc) {
            __builtin_amdgcn_fence(__ATOMIC_RELEASE, "agent");
            asm volatile("s_waitcnt vmcnt(0)" ::: "memory");
            const unsigned og = xb_add(&bar[XB_TOP], 1u);
            const unsigned tg = og / nx;
            if (og + 1u == (tg + 1u) * nx) xb_add(&bar[XB_TOPGEN], 1u);
            else XB_SPIN(xb_ld(&bar[XB_TOPGEN]) == tg, bar);
            __builtin_amdgcn_fence(__ATOMIC_ACQUIRE, "agent");
            xb_add(&bar[XB_XGEN(b.x)], 1u);
            asm volatile("s_waitcnt vmcnt(0)" ::: "memory");
        } else {
            XB_SPIN(xb_ld(&bar[XB_XGEN(b.x)]) == gen, bar);
            __builtin_amdgcn_fence(__ATOMIC_ACQUIRE, "agent");
            asm volatile("s_waitcnt vmcnt(0)" ::: "memory");
        }
    }
    __syncthreads();
}
struct Frame {
    LAS unsigned char* lds;
    volatile LAS unsigned* MISC;
    gu32* ctl;
    int tid, lane, wave, vcu, G;
    const float *x, *g_mix, *g_ffn, *w_in_ab, *gq_a, *gk_a, *w_gate_up, *b_gate, *g_gla, *w_out_ab, *w_in_c, *gq_c, *gk_c, *w_out_c, *w_up, *w_down;
    float* out;
    bf16 *Wab, *Woab, *Wup0, *Wdn0, *Winc, *Woc, *Wup1, *Wdn1;
    bf16 *XB, *CAT, *R1;
    float* SSQ; unsigned* MASK;
};
__device__ __forceinline__ float bf2f(bf16 v) { return __builtin_bit_cast(float, (unsigned)v << 16); }
__device__ __forceinline__ float wave_sum(float v) {
#pragma unroll
    for (int o = 1; o < 64; o <<= 1) v += __shfl_xor(v, o);
    return v;
}
__device__ __forceinline__ float wave_max(float v) {
#pragma unroll
    for (int o = 1; o < 64; o <<= 1) v = fmaxf(v, __shfl_xor(v, o));
    return v;
}
__device__ __forceinline__ float log_sigmoid(float x) { return fminf(x, 0.f) - log1pf(expf(-fabsf(x))); }

__device__ __forceinline__ int oldcol_ab(int n) {
    if (n < 2048) return n;
    if (n < 2304) return 2120 + (n - 2048);
    if (n < 2560) return 2376 + (n - 2304);
    if (n < 3072) return 2632 + (n - 2560);
    if (n < 3584) return 3160 + (n - 3072);
    if (n < 3648) return 2048 + (n - 3584);
    if (n < 3656) return 2112 + (n - 3648);
    if (n < 3672) return 3144 + (n - 3656);
    return -1;
}
__device__ __forceinline__ void p0_transpose_item(const float* W, int ldw, int K, const float* gain, bf16* WT, bool map, LAS float* scr, int item, int nblk, int lane) {
    const int kb = item / nblk, nb = item % nblk, k0 = 64 * kb, n0 = 32 * nb;
    int oc = n0 + (lane & 31); if (map) oc = oldcol_ab(oc);
#pragma unroll 8
    for (int i = 0; i < 32; ++i) { const int kk = 2 * i + (lane >> 5); float v = 0.f;
        if (oc >= 0) { v = W[(size_t)(k0 + kk) * ldw + oc]; if (gain) v *= gain[k0 + kk]; }
        scr[kk * 33 + (lane & 31)] = v; }
    LDS_WAIT(); asm volatile("" ::: "memory");
    const int c = lane & 7;
#pragma unroll
    for (int j = 0; j < 4; ++j) { const int n = (lane >> 3) + 8 * j; const LAS float* s = scr + (8 * c) * 33 + n;
        v4u o; o.x = pk2(s[0 * 33], s[1 * 33]); o.y = pk2(s[2 * 33], s[3 * 33]); o.z = pk2(s[4 * 33], s[5 * 33]); o.w = pk2(s[6 * 33], s[7 * 33]);
        *(GAS v4u*)(WT + (size_t)(n0 + n) * K + k0 + 8 * c) = o; }
    LDS_WAIT(); asm volatile("" ::: "memory");
}
__device__ __forceinline__ void ph_prologue(Frame& F) {
    LAS float* scr = (LAS float*)(F.lds + F.wave * 16384);
    const int gw = F.vcu * NWAVES + F.wave, NGW = F.G * NWAVES;
    constexpr int I_AB = (D / 64) * (NAB / 32), I_O = (D / 64) * (D / 32), I_UP = (D / 64) * (FF / 32), I_DN = (FF / 64) * (D / 32), I_C = (D / 64) * (NC / 32);
    constexpr int NITEMS = I_AB + 2 * I_O + 2 * I_UP + 2 * I_DN + I_C;
    for (int it = gw; it < NITEMS; it += NGW) {
        int r = it;
        if (r < I_AB) { p0_transpose_item(F.w_in_ab, ABP_OLD, D, F.g_mix, F.Wab, true, scr, r, NAB / 32, F.lane); continue; } r -= I_AB;
        if (r < I_O) { p0_transpose_item(F.w_out_ab, D, D, nullptr, F.Woab, false, scr, r, D / 32, F.lane); continue; } r -= I_O;
        if (r < I_UP) { p0_transpose_item(F.w_up, FF, D, F.g_ffn, F.Wup0, false, scr, r, FF / 32, F.lane); continue; } r -= I_UP;
        if (r < I_DN) { p0_transpose_item(F.w_down, D, FF, nullptr, F.Wdn0, false, scr, r, D / 32, F.lane); continue; } r -= I_DN;
        if (r < I_C) { p0_transpose_item(F.w_in_c, NC, D, F.g_mix + D, F.Winc, false, scr, r, NC / 32, F.lane); continue; } r -= I_C;
        if (r < I_O) { p0_transpose_item(F.w_out_c, D, D, nullptr, F.Woc, false, scr, r, D / 32, F.lane); continue; } r -= I_O;
        if (r < I_UP) { p0_transpose_item(F.w_up + (size_t)D * FF, FF, D, F.g_ffn + D, F.Wup1, false, scr, r, FF / 32, F.lane); continue; } r -= I_UP;
        p0_transpose_item(F.w_down + (size_t)FF * D, D, FF, nullptr, F.Wdn1, false, scr, r, D / 32, F.lane);
    }
    for (int m = gw; m < M; m += NGW) {
        const GAS f32x4* xr = (const GAS f32x4*)(F.x + (size_t)m * D) + F.lane;
        f32x4 v[4]; float s = 0.f;
#pragma unroll
        for (int j = 0; j < 4; ++j) { v[j] = xr[64 * j]; s += (v[j].x * v[j].x + v[j].y * v[j].y) + (v[j].z * v[j].z + v[j].w * v[j].w); }
        s = wave_sum(s);
        GAS unsigned long long* o8 = (GAS unsigned long long*)(F.XB + (size_t)m * D) + F.lane;
#pragma unroll
        for (int j = 0; j < 4; ++j) o8[64 * j] = (unsigned long long)pk2(v[j].x, v[j].y) | ((unsigned long long)pk2(v[j].z, v[j].w) << 32);
        if (F.lane < 16) F.SSQ[(size_t)m * 16 + F.lane] = (F.lane == 0) ? s : 0.f;
    }
}
namespace att {
typedef short s16x4 __attribute__((ext_vector_type(4)));
typedef float f32x16 __attribute__((ext_vector_type(16)));
typedef _Float16 f16x8 __attribute__((ext_vector_type(8)));
typedef unsigned u32x4 __attribute__((ext_vector_type(4)));
typedef short v4i16_t __attribute__((ext_vector_type(4)));
constexpr float C2 = 0.08838834764831845f * 1.4426950408889634f;
__device__ __forceinline__ int crow(int r, int hi) { return (r & 3) + 8 * (r >> 2) + 4 * hi; }
__device__ __forceinline__ int img_off(int row, int ch) { return 256 * row + 16 * (ch ^ (((row & 3) << 2) | ((row >> 2) & 3))); }
__device__ __forceinline__ bf16x8 pack8(float a0, float a1, float a2, float a3, float a4, float a5, float a6, float a7) {
    u32x4 w; w.x = pg8::cvt_pk_bf16(a0, a1); w.y = pg8::cvt_pk_bf16(a2, a3); w.z = pg8::cvt_pk_bf16(a4, a5); w.w = pg8::cvt_pk_bf16(a6, a7);
    return __builtin_bit_cast(bf16x8, w);
}
__device__ __forceinline__ f16x8 pack8h(float a0, float a1, float a2, float a3, float a4, float a5, float a6, float a7) {
    f16x8 r; r[0] = (_Float16)a0; r[1] = (_Float16)a1; r[2] = (_Float16)a2; r[3] = (_Float16)a3; r[4] = (_Float16)a4; r[5] = (_Float16)a5; r[6] = (_Float16)a6; r[7] = (_Float16)a7; return r;
}
__device__ __forceinline__ void dma_off_init(unsigned (&dvo)[2], int ld, int wave, int lane) {
#pragma unroll
    for (int i = 0; i < 2; ++i) { const int pi = 2 * wave + i, row = 4 * pi + (lane >> 4), pc = lane & 15, ch = pc ^ (((row & 3) << 2) | ((row >> 2) & 3)); dvo[i] = (unsigned)(row * ld + ch * 8) * 2u; }
}
__device__ __forceinline__ void tile_dma(const bf16* g, const unsigned (&dvo)[2], LAS unsigned char* buf, int wave) {
#pragma unroll
    for (int i = 0; i < 2; ++i) __builtin_amdgcn_global_load_lds((const unsigned*)((const char*)g + dvo[i]), (LAS unsigned*)(buf + 1024 * (2 * wave + i)), 16, 0, 0);
}
struct FragOff { int k[8]; int va[4]; int vd; };
__device__ __forceinline__ void frag_off_init(FragOff& fo, int lane) {
    const int hi = lane >> 5, r32 = lane & 31, i = lane & 15, q = i >> 2, p = i & 3, x = 2 * ((lane >> 4) & 1) + (p >> 1);
#pragma unroll
    for (int ks = 0; ks < 8; ++ks) fo.k[ks] = img_off(r32, 2 * ks + hi);
#pragma unroll
    for (int ct = 0; ct < 4; ++ct) fo.va[ct] = img_off(4 * hi + q, 4 * ct + x) + 8 * (p & 1);
    fo.vd = img_off(4 * hi + q + 8, x) - img_off(4 * hi + q, x);
}
__device__ __forceinline__ bf16x8 k_frag(const LAS unsigned char* kbuf, const FragOff& fo, int rt, int ks) { return *(const LAS bf16x8*)(kbuf + fo.k[ks] + 8192 * rt); }
__device__ __forceinline__ s16x4 vtr(const LAS unsigned char* p) { return __builtin_bit_cast(s16x4, __builtin_amdgcn_ds_read_tr16_b64_v4i16((LAS v4i16_t*)p)); }
__device__ __forceinline__ bf16x8 v_frag(const LAS unsigned char* vbuf, const FragOff& fo, int ct, int kk) {
    const s16x4 lo = vtr(vbuf + fo.va[ct] + 4096 * kk), hh = vtr(vbuf + fo.va[ct] + fo.vd + 4096 * kk);
    return (bf16x8){lo[0], lo[1], lo[2], lo[3], hh[0], hh[1], hh[2], hh[3]};
}
__device__ __forceinline__ int frag_va(int lane, int ct) { const int hi = lane >> 5, i = lane & 15, q = i >> 2, p = i & 3, x = 2 * ((lane >> 4) & 1) + (p >> 1); return img_off(4 * hi + q, 4 * ct + x) + 8 * (p & 1); }
__device__ __forceinline__ bf16x8 v_frag_rt(const LAS unsigned char* vbuf, int va, int vd, int kk) {
    const s16x4 lo = vtr(vbuf + va + 4096 * kk), hh = vtr(vbuf + va + vd + 4096 * kk);
    return (bf16x8){lo[0], lo[1], lo[2], lo[3], hh[0], hh[1], hh[2], hh[3]};
}
__device__ __forceinline__ void store_o(const f32x16 (&o)[4], const float (&rscale)[16], LAS unsigned char* stg, bf16* dst, int ld, int lane) {
    const int hi = lane >> 5, r32 = lane & 31;
#pragma unroll
    for (int r = 0; r < 16; ++r) { const int orow = crow(r, hi);
#pragma unroll
        for (int ct = 0; ct < 4; ++ct) *(LAS bf16*)(stg + orow * 256 + (32 * ct + r32) * 2) = (bf16)f2bf(o[ct][r] * rscale[r]); }
    asm volatile("s_waitcnt lgkmcnt(0)" ::: "memory");
#pragma unroll
    for (int i = 0; i < 8; ++i) { const int c = lane + 64 * i, row = c >> 4, ch = c & 15; const u32x4 v = *(const LAS u32x4*)(stg + row * 256 + ch * 16); *(u32x4*)(dst + (size_t)row * ld + ch * 8) = v; }
}
}
template <bool SCALEQ> __device__ __forceinline__ void ph_prep_a(Frame& F) {
    const int gw = F.vcu * NWAVES + F.wave, NGW = F.G * NWAVES, lane = F.lane;
    for (int tok = gw; tok < M; tok += NGW) {
        const float pos = (float)(tok & (SEQ - 1));
        bf16* pr = F.R1 + (size_t)tok * NAB;
        float c128 = 1.f, s128 = 0.f;
        if (lane < 32) { const int i = lane & 15; const float inv = powf(500000.0f, -(float)i * 2.0f / 32.0f); const float ang = pos * inv; c128 = cosf(ang); s128 = sinf(ang); }
#pragma unroll
        for (int which = 0; which < 2; ++which) {
            const int base = which == 0 ? C_QA : C_KA;
            const float* gn = which == 0 ? F.gq_a : F.gk_a;
            for (int h = 0; h < 4; ++h) {
                float a = bf2f(pr[base + h * 128 + lane]), b = bf2f(pr[base + h * 128 + 64 + lane]);
                const float ss = wave_sum(a * a + b * b);
                const float rs = rsqrtf(ss * (1.f / 128.f) + EPS);
                const float qs = (SCALEQ && which == 0) ? att::C2 : 1.0f;
                a = a * rs * gn[lane] * qs; b = b * rs * gn[64 + lane] * qs;
                const float other = __shfl_xor(a, 16);
                float o = a;
                if (lane < 16) o = a * c128 - other * s128;
                else if (lane < 32) o = a * c128 + other * s128;
                pr[base + h * 128 + lane] = (bf16)f2bf(o); pr[base + h * 128 + 64 + lane] = (bf16)f2bf(b);
            }
        }
        float c64 = 1.f, s64 = 0.f;
        if (lane < 16) { const int i = lane & 7; const float inv = powf(500000.0f, -(float)i * 2.0f / 16.0f); const float ang = pos * inv; c64 = cosf(ang); s64 = sinf(ang); }
        for (int h = 0; h < 9; ++h) {
            const int col = (h < 8) ? C_IQ + h * 64 : C_IK;
            const float a = bf2f(pr[col + lane]);
            const float other = __shfl_xor(a, 8);
            float o = a;
            if (lane < 8) o = a * c64 - other * s64;
            else if (lane < 16) o = a * c64 + other * s64;
            pr[col + lane] = (bf16)f2bf(o);
        }
    }
}
__device__ __forceinline__ void ph_indexer_naive(Frame& F) {
    LAS float* sc = (LAS float*)F.lds;
    LAS float* qv = sc + 2048;
    LAS float* wv = qv + 512;
    LAS unsigned* mw = (LAS unsigned*)(wv + 8);
    const int tid = F.tid;
    for (int tok = F.vcu; tok < M; tok += F.G) {
        const int pos = tok & (SEQ - 1), seq0 = tok - pos, limit = ((pos >> 6) + 1) << 6;
        const bf16* pr = F.R1 + (size_t)tok * NAB;
        qv[tid] = bf2f(pr[C_IQ + tid]);
        if (tid < 8) wv[tid] = bf2f(pr[C_IW + tid]) * 0.35355339059327373f;
        if (tid < 64) mw[tid] = 0u;
        __syncthreads();
        for (int s = tid; s < limit; s += NTHR) {
            const bf16* kp = F.R1 + (size_t)(seq0 + s) * NAB + C_IK;
            float acc[8];
#pragma unroll
            for (int h = 0; h < 8; ++h) acc[h] = 0.f;
            for (int d = 0; d < 64; ++d) { const float kd = bf2f(kp[d]);
#pragma unroll
                for (int h = 0; h < 8; ++h) acc[h] = fmaf(qv[h * 64 + d], kd, acc[h]); }
            float score = 0.f;
#pragma unroll
            for (int h = 0; h < 8; ++h) score += fmaxf(acc[h] * 0.125f, 0.f) * wv[h];
            sc[s] = score;
        }
        __syncthreads();
        if (limit <= 256) { if (tid < 64) mw[tid] = (tid * 32 < limit) ? 0xffffffffu : 0u; }
        else {
            for (int s = tid; s < limit; s += NTHR) {
                const float v = sc[s]; int cnt = 0;
                for (int j = 0; j < limit; ++j) { const float u = sc[j]; cnt += ((u > v) || (u == v && j < s)) ? 1 : 0; }
                if (cnt < 256) atomicOr((unsigned*)&mw[s >> 5], 1u << (s & 31));
            }
        }
        __syncthreads();
        if (tid < 64) F.MASK[(size_t)tok * 64 + tid] = mw[tid];
        __syncthreads();
    }
}
__device__ __forceinline__ float block_sum(float v, LAS float* red, int tid) {
    v = wave_sum(v);
    __syncthreads();
    if ((tid & 63) == 0) red[tid >> 6] = v;
    __syncthreads();
    float r = 0.f;
#pragma unroll
    for (int i = 0; i < NWAVES; ++i) r += red[i];
    return r;
}
__device__ __forceinline__ float block_max(float v, LAS float* red, int tid) {
    v = wave_max(v);
    __syncthreads();
    if ((tid & 63) == 0) red[tid >> 6] = v;
    __syncthreads();
    float r = red[0];
#pragma unroll
    for (int i = 1; i < NWAVES; ++i) r = fmaxf(r, red[i]);
    return r;
}
__device__ __forceinline__ void ph_dsa_naive(Frame& F) {
    LAS unsigned* mw = (LAS unsigned*)F.lds;
    LAS int* pre = (LAS int*)(mw + 64);
    LAS int* idx = pre + 128;
    LAS float* pp = (LAS float*)(idx + 256);
    LAS float* q = pp + 512;
    LAS float* red = q + 512;
    const int tid = F.tid;
    for (int tok = F.vcu; tok < M; tok += F.G) {
        const int pos = tok & (SEQ - 1), seq0 = tok - pos;
        if (tid < 64) mw[tid] = F.MASK[(size_t)tok * 64 + tid];
        q[tid] = bf2f(F.R1[(size_t)tok * NAB + C_QA + tid]);
        __syncthreads();
        if (tid == 0) { int a = 0; for (int w = 0; w < 64; ++w) { pre[w] = a; a += __popc(mw[w]); } pre[64] = a; }
        __syncthreads();
        const int n = pre[64];
        for (int s = tid; s < SEQ; s += NTHR) { const unsigned w = mw[s >> 5]; if ((w >> (s & 31)) & 1u) idx[pre[s >> 5] + __popc(w & ((1u << (s & 31)) - 1u))] = s; }
        __syncthreads();
        for (int h = 0; h < 4; ++h) {
            float sv = -INFINITY;
            if (tid < n) { const bf16* kp = F.R1 + (size_t)(seq0 + idx[tid]) * NAB + C_KA + h * 128; float a = 0.f;
                for (int d = 0; d < 128; ++d) a = fmaf(q[h * 128 + d], bf2f(kp[d]), a);
                sv = a * 0.08838834764831845f; }
            const float m = block_max(sv, red, tid);
            const float e = (tid < n) ? expf(sv - m) : 0.f;
            const float l = block_sum(e, red, tid);
            pp[tid] = e;
            __syncthreads();
            if (tid < 128) { float o = 0.f;
                for (int j = 0; j < n; ++j) o = fmaf(pp[j], bf2f(F.R1[(size_t)(seq0 + idx[j]) * NAB + C_VA + h * 128 + tid]), o);
                F.CAT[(size_t)tok * D + h * 128 + tid] = (bf16)f2bf(o / l); }
            __syncthreads();
        }
    }
}
__device__ __forceinline__ void ph_gla_naive(Frame& F) {
    LAS float* sq = (LAS float*)F.lds; LAS float* sk = sq + 1024; LAS float* sd = sk + 1024;
    LAS float* sg = sd + 1024;
    LAS float* red = sg + 256;
    const int tid = F.tid, lane = F.lane;
    for (int item = F.vcu; item < BATCH * 4; item += F.G) {
        const int b = item >> 2, h = item & 3, seq0 = b * SEQ;
        float S[64];
#pragma unroll
        for (int d = 0; d < 64; ++d) S[d] = 0.f;
        for (int t0 = 0; t0 < SEQ; t0 += 16) {
            if (tid < 256) { const int tt = tid >> 4, r = tid & 15; sg[tid] = bf2f(F.R1[(size_t)(seq0 + t0 + tt) * NAB + C_GL + r]); }
            __syncthreads();
            for (int i = tid; i < 1024; i += NTHR) { const int tt = i >> 6, d = i & 63; const bf16* pr = F.R1 + (size_t)(seq0 + t0 + tt) * NAB;
                sq[i] = bf2f(pr[C_QB + h * 64 + d]) * 0.125f; sk[i] = bf2f(pr[C_KB + h * 64 + d]);
                float g = F.b_gate[h * 64 + d];
#pragma unroll
                for (int r = 0; r < 16; ++r) g = fmaf(sg[tt * 16 + r], F.w_gate_up[r * 256 + h * 64 + d], g);
                sd[i] = expf(log_sigmoid(g) * (1.f / 16.f)); }
            __syncthreads();
            float o[16];
            if (tid < 128) {
#pragma unroll
                for (int tt = 0; tt < 16; ++tt) {
                    const float v = bf2f(F.R1[(size_t)(seq0 + t0 + tt) * NAB + C_VB + h * 128 + tid]); float a = 0.f;
#pragma unroll
                    for (int d = 0; d < 64; ++d) { S[d] = fmaf(sd[tt * 64 + d], S[d], sk[tt * 64 + d] * v); a = fmaf(sq[tt * 64 + d], S[d], a); }
                    o[tt] = a;
                    const float ws = wave_sum(a * a);
                    if (lane == 0) red[tt * 2 + (tid >> 6)] = ws;
                }
            }
            __syncthreads();
            if (tid < 128) {
#pragma unroll
                for (int tt = 0; tt < 16; ++tt) {
                    const size_t tok = seq0 + t0 + tt;
                    const float rs = rsqrtf((red[tt * 2] + red[tt * 2 + 1]) * (1.f / 128.f) + EPS);
                    const float og = bf2f(F.R1[tok * NAB + C_OG + h * 128 + tid]);
                    F.CAT[tok * D + 512 + h * 128 + tid] = (bf16)f2bf(o[tt] * rs * F.g_gla[tid] * (og / (1.f + expf(-og))));
                }
            }
            __syncthreads();
        }
    }
}
template <bool SCALEQ> __device__ __forceinline__ void ph_prep_c(Frame& F) {
    const int gw = F.vcu * NWAVES + F.wave, NGW = F.G * NWAVES, lane = F.lane;
    for (int it = gw; it < M * 16; it += NGW) {
        const int tok = it >> 4, hh = it & 15, isk = hh >> 3, h = hh & 7;
        bf16* p = F.R1 + (size_t)tok * NC + isk * 1024 + h * 128;
        const float* gn = isk ? F.gk_c : F.gq_c;
        const float a = bf2f(p[lane]), b = bf2f(p[64 + lane]);
        const float rs = rsqrtf(wave_sum(a * a + b * b) * (1.f / 128.f) + EPS);
        const float sc = (SCALEQ && !isk) ? att::C2 : 1.0f;
        p[lane] = (bf16)f2bf(a * rs * gn[lane] * sc); p[64 + lane] = (bf16)f2bf(b * rs * gn[64 + lane] * sc);
    }
}
__device__ __forceinline__ void ph_sb_naive(Frame& F) {
    const int gw = F.vcu * NWAVES + F.wave, NGW = F.G * NWAVES, lane = F.lane;
    for (int it = gw; it < M * 8; it += NGW) {
        const int tok = it >> 3, h = it & 7, pos = tok & (SEQ - 1), seq0 = tok - pos;
        const unsigned qq = *(const unsigned*)(F.R1 + (size_t)tok * NC + h * 128 + 2 * lane);
        const float q0 = __builtin_bit_cast(float, qq << 16), q1 = __builtin_bit_cast(float, qq & 0xffff0000u);
        float R = 0.f, o0 = 0.f, o1 = 0.f;
        for (int s = pos - 1; s >= 0; --s) {
            const bf16* pr = F.R1 + (size_t)(seq0 + s) * NC + h * 128 + 2 * lane;
            const unsigned kk = *(const unsigned*)(pr + 1024), vv = *(const unsigned*)(pr + 2048);
            const float k0 = __builtin_bit_cast(float, kk << 16), k1 = __builtin_bit_cast(float, kk & 0xffff0000u);
            const float z = wave_sum(q0 * k0 + q1 * k1) * 0.08838834764831845f;
            const float sp = log1pf(expf(-fabsf(z)));
            const float lsp = fminf(z, 0.f) - sp, lsn = fminf(-z, 0.f) - sp;
            const float a = expf(lsp + R);
            o0 = fmaf(a, __builtin_bit_cast(float, vv << 16), o0); o1 = fmaf(a, __builtin_bit_cast(float, vv & 0xffff0000u), o1);
            R += lsn;
        }
        *(unsigned*)(F.CAT + (size_t)tok * D + h * 128 + 2 * lane) = pk2(o0, o1);
    }
}
__device__ __forceinline__ void sb_unit(Frame& F, int b, int h, int qb) {
    using namespace att;
    const int tid = F.tid, lane = F.lane, w = F.wave, hi = lane >> 5, r32 = lane & 31;
    const bf16* Qg = F.R1 + (size_t)b * SEQ * NC + h * 128; const bf16* Kg = Qg + 1024; const bf16* Vg = Qg + 2048;
    const int T0 = qb * 256, t0w = T0 + 32 * w, jd = t0w >> 6, jtop = (T0 >> 6) + 3, tl = 32 * (w & 1) + r32;
    LAS unsigned char* lds = F.lds;
    FragOff fo; frag_off_init(fo, lane);
    unsigned dvo[2]; dma_off_init(dvo, NC, w, lane);
    bf16x8 qf[8];
#pragma unroll
    for (int ks = 0; ks < 8; ++ks) qf[ks] = *(const bf16x8*)(Qg + (size_t)(t0w + r32) * NC + 16 * ks + 8 * hi);
    f16x8 T0f, T1f, ONEf;
#pragma unroll
    for (int j = 0; j < 8; ++j) { const int kp = 8 * (j >> 2) + 4 * hi + (j & 3); T0f[j] = (kp >= r32) ? (_Float16)1.0f : (_Float16)0.0f; T1f[j] = (kp + 16 >= r32) ? (_Float16)1.0f : (_Float16)0.0f; ONEf[j] = (_Float16)1.0f; }
    f32x16 o[4];
#pragma unroll
    for (int ct = 0; ct < 4; ++ct)
#pragma unroll
        for (int r = 0; r < 16; ++r) o[ct][r] = 0.f;
    float R2 = 0.f; bool done = false;
    volatile LAS unsigned* flags = F.MISC + 16;
    tile_dma(Kg + (size_t)(64 * jtop) * NC, dvo, lds, w); tile_dma(Vg + (size_t)(64 * jtop) * NC, dvo, lds + 16384, w);
    asm volatile("s_waitcnt vmcnt(0)" ::: "memory");
    __syncthreads();
    for (int j = jtop; j >= 0; --j) {
        const int cur = (jtop - j) & 1;
        const LAS unsigned char* kb = lds + cur * 32768; const LAS unsigned char* vb = kb + 16384;
        if (j > 0) { tile_dma(Kg + (size_t)(64 * (j - 1)) * NC, dvo, lds + (cur ^ 1) * 32768, w); tile_dma(Vg + (size_t)(64 * (j - 1)) * NC, dvo, lds + (cur ^ 1) * 32768 + 16384, w); }
        if (j <= jd && !done) {
            f32x16 p0, p1;
#pragma unroll
            for (int r = 0; r < 16; ++r) { p0[r] = 0.f; p1[r] = 0.f; }
#pragma unroll
            for (int ks = 0; ks < 8; ++ks) { const bf16x8 a0 = k_frag(kb, fo, 0, ks), a1 = k_frag(kb, fo, 1, ks);
                p0 = __builtin_amdgcn_mfma_f32_32x32x16_bf16(a0, qf[ks], p0, 0, 0, 0); p1 = __builtin_amdgcn_mfma_f32_32x32x16_bf16(a1, qf[ks], p1, 0, 0, 0); }
            const bool diag = (j == jd);
            float x0[16], x1[16]; float rs = 0.f;
#pragma unroll
            for (int r = 0; r < 16; ++r) { const int key = crow(r, hi);
                float l0 = -__builtin_amdgcn_logf(1.0f + __builtin_amdgcn_exp2f(p0[r])), l1 = -__builtin_amdgcn_logf(1.0f + __builtin_amdgcn_exp2f(p1[r]));
                if (diag) { if (!(key < tl)) l0 = 0.f; if (!(key + 32 < tl)) l1 = 0.f; }
                x0[r] = l0; x1[r] = l1; rs += l0 + l1; p0[r] += R2; p1[r] += R2; }
            const f16x8 xb00 = pack8h(x0[0], x0[1], x0[2], x0[3], x0[4], x0[5], x0[6], x0[7]), xb01 = pack8h(x0[8], x0[9], x0[10], x0[11], x0[12], x0[13], x0[14], x0[15]);
            const f16x8 xb10 = pack8h(x1[0], x1[1], x1[2], x1[3], x1[4], x1[5], x1[6], x1[7]), xb11 = pack8h(x1[8], x1[9], x1[10], x1[11], x1[12], x1[13], x1[14], x1[15]);
            p0 = __builtin_amdgcn_mfma_f32_32x32x16_f16(T0f, xb00, p0, 0, 0, 0); p0 = __builtin_amdgcn_mfma_f32_32x32x16_f16(T1f, xb01, p0, 0, 0, 0);
            p0 = __builtin_amdgcn_mfma_f32_32x32x16_f16(ONEf, xb10, p0, 0, 0, 0); p0 = __builtin_amdgcn_mfma_f32_32x32x16_f16(ONEf, xb11, p0, 0, 0, 0);
            p1 = __builtin_amdgcn_mfma_f32_32x32x16_f16(T0f, xb10, p1, 0, 0, 0); p1 = __builtin_amdgcn_mfma_f32_32x32x16_f16(T1f, xb11, p1, 0, 0, 0);
#pragma unroll
            for (int r = 0; r < 16; ++r) { const int key = crow(r, hi);
                float a0 = __builtin_amdgcn_exp2f(p0[r]), a1 = __builtin_amdgcn_exp2f(p1[r]);
                if (diag) { if (!(key < tl)) a0 = 0.f; if (!(key + 32 < tl)) a1 = 0.f; }
                p0[r] = a0; p1[r] = a1; }
            const bf16x8 pa0 = pack8(p0[0], p0[1], p0[2], p0[3], p0[4], p0[5], p0[6], p0[7]), pa1 = pack8(p0[8], p0[9], p0[10], p0[11], p0[12], p0[13], p0[14], p0[15]);
            const bf16x8 pa2 = pack8(p1[0], p1[1], p1[2], p1[3], p1[4], p1[5], p1[6], p1[7]), pa3 = pack8(p1[8], p1[9], p1[10], p1[11], p1[12], p1[13], p1[14], p1[15]);
#pragma unroll
            for (int ct = 0; ct < 4; ++ct) {
                o[ct] = __builtin_amdgcn_mfma_f32_32x32x16_bf16(pa0, v_frag(vb, fo, ct, 0), o[ct], 0, 0, 0);
                o[ct] = __builtin_amdgcn_mfma_f32_32x32x16_bf16(pa1, v_frag(vb, fo, ct, 1), o[ct], 0, 0, 0);
                o[ct] = __builtin_amdgcn_mfma_f32_32x32x16_bf16(pa2, v_frag(vb, fo, ct, 2), o[ct], 0, 0, 0);
                o[ct] = __builtin_amdgcn_mfma_f32_32x32x16_bf16(pa3, v_frag(vb, fo, ct, 3), o[ct], 0, 0, 0);
            }
            rs += __shfl_xor(rs, 32);
            R2 += rs;
            done = __all(R2 < -152.0f);
        }
        if (lane == 0) flags[cur * 8 + w] = done ? 1u : 0u;
        asm volatile("s_waitcnt vmcnt(0) lgkmcnt(0)" ::: "memory");
        __syncthreads();
        unsigned alld = 1u;
#pragma unroll
        for (int i = 0; i < 8; ++i) alld &= flags[cur * 8 + i];
        if (alld) break;
    }
    float ones[16];
#pragma unroll
    for (int r = 0; r < 16; ++r) ones[r] = 1.0f;
    store_o(o, ones, lds + w * 8192, F.CAT + (size_t)(b * SEQ + t0w) * D + h * 128, D, lane);
    __syncthreads();
}
__device__ __forceinline__ void ph_sb(Frame& F) {
    for (int v = F.vcu; v < BATCH * 8 * 2; v += F.G) {
        const int bh = v >> 1, half = v & 1;
#pragma unroll 1
        for (int i = 0; i < 4; ++i) { const int qb = half ? (i == 0 ? 1 : i == 1 ? 6 : i == 2 ? 2 : 5) : (i == 0 ? 0 : i == 1 ? 7 : i == 2 ? 3 : 4); sb_unit(F, bh >> 3, bh & 7, qb); }
    }
}
__device__ __forceinline__ void dsa_unit(Frame& F, int b, int h, int ub, float mref) {
    using namespace att;
    const int lane = F.lane, w = F.wave, hi = lane >> 5, r32 = lane & 31;
    const bf16* Qg = F.R1 + (size_t)b * SEQ * NAB + C_QA + h * 128; const bf16* Kg = F.R1 + (size_t)b * SEQ * NAB + C_KA + h * 128; const bf16* Vg = F.R1 + (size_t)b * SEQ * NAB + C_VA + h * 128;
    const int t0w = 256 * ub + 32 * w, cw = t0w >> 6, jlast = 4 * ub + 3;
    LAS unsigned char* lds = F.lds;
    LAS unsigned char* mst = lds + 65536 + w * 8448;
    FragOff fo; frag_off_init(fo, lane);
    unsigned dvo[2]; dma_off_init(dvo, NAB, w, lane);
    tile_dma(Kg, dvo, lds, w); tile_dma(Vg, dvo, lds + 16384, w);
    bf16x8 qf[8];
#pragma unroll
    for (int ks = 0; ks < 8; ++ks) qf[ks] = *(const bf16x8*)(Qg + (size_t)(t0w + r32) * NAB + 16 * ks + 8 * hi);
    { const unsigned* mg = F.MASK + (size_t)(b * SEQ + t0w) * 64;
#pragma unroll 2
      for (int i = 0; i < 8; ++i) { const int c = lane + 64 * i, row = c >> 4, c4 = c & 15; const u32x4 v = *(const u32x4*)(mg + row * 64 + c4 * 4);
          *(LAS unsigned long long*)(mst + row * 264 + c4 * 16) = (unsigned long long)v.x | ((unsigned long long)v.y << 32);
          *(LAS unsigned long long*)(mst + row * 264 + c4 * 16 + 8) = (unsigned long long)v.z | ((unsigned long long)v.w << 32); } }
    f32x16 o[4];
#pragma unroll
    for (int ct = 0; ct < 4; ++ct)
#pragma unroll
        for (int r = 0; r < 16; ++r) o[ct][r] = 0.f;
    float lsum = 0.f;
    asm volatile("s_waitcnt vmcnt(0) lgkmcnt(0)" ::: "memory");
    __syncthreads();
    for (int j = 0; j <= jlast; ++j) {
        const int cur = j & 1;
        const LAS unsigned char* kb = lds + cur * 32768; const LAS unsigned char* vb = kb + 16384;
        if (j < jlast) { tile_dma(Kg + (size_t)(64 * (j + 1)) * NAB, dvo, lds + (cur ^ 1) * 32768, w); tile_dma(Vg + (size_t)(64 * (j + 1)) * NAB, dvo, lds + (cur ^ 1) * 32768 + 16384, w); }
        if (j <= cw) {
            const unsigned long long mw = *(const LAS unsigned long long*)(mst + r32 * 264 + j * 8);
            const unsigned mw0 = (unsigned)mw, mw1 = (unsigned)(mw >> 32);
#pragma unroll 1
            for (int half = 0; half < 2; ++half) {
                const unsigned mwh = half ? mw1 : mw0;
                f32x16 p;
#pragma unroll
                for (int r = 0; r < 16; ++r) p[r] = -mref;
#pragma unroll
                for (int ks = 0; ks < 8; ++ks) p = __builtin_amdgcn_mfma_f32_32x32x16_bf16(k_frag(kb, fo, half, ks), qf[ks], p, 0, 0, 0);
#pragma unroll
                for (int r = 0; r < 16; ++r) { const unsigned keep = (unsigned)(-(int)((mwh >> crow(r, hi)) & 1u));
                    const float e = __uint_as_float(__float_as_uint(__builtin_amdgcn_exp2f(p[r])) & keep); p[r] = e; lsum += e; }
                const bf16x8 pa0 = pack8(p[0], p[1], p[2], p[3], p[4], p[5], p[6], p[7]), pa1 = pack8(p[8], p[9], p[10], p[11], p[12], p[13], p[14], p[15]);
#pragma unroll
                for (int ct = 0; ct < 4; ++ct) {
                    o[ct] = __builtin_amdgcn_mfma_f32_32x32x16_bf16(pa0, v_frag(vb, fo, ct, 2 * half), o[ct], 0, 0, 0);
                    o[ct] = __builtin_amdgcn_mfma_f32_32x32x16_bf16(pa1, v_frag(vb, fo, ct, 2 * half + 1), o[ct], 0, 0, 0);
                }
            }
        }
        asm volatile("s_waitcnt vmcnt(0) lgkmcnt(0)" ::: "memory");
        __syncthreads();
    }
    lsum += __shfl_xor(lsum, 32);
    LAS float* lsc = (LAS float*)mst;
    if (hi == 0) lsc[r32] = 1.0f / lsum;
    asm volatile("s_waitcnt lgkmcnt(0)" ::: "memory");
    float rsc[16];
#pragma unroll
    for (int r = 0; r < 16; ++r) rsc[r] = lsc[crow(r, hi)];
    store_o(o, rsc, lds + w * 8192, F.CAT + (size_t)(b * SEQ + t0w) * D + h * 128, D, lane);
    __syncthreads();
}
__device__ __forceinline__ void ph_dsa(Frame& F) {
    float gm = fmaxf(fabsf(F.gq_a[F.lane]), fabsf(F.gq_a[64 + F.lane])), km = fmaxf(fabsf(F.gk_a[F.lane]), fabsf(F.gk_a[64 + F.lane]));
    gm = wave_max(gm); km = wave_max(km);
    const float mref = att::C2 * 128.0f * gm * km * 1.02f;
    for (int v = F.vcu; v < BATCH * 4 * 4; v += F.G) {
        const int bh = v >> 2, pi = v & 3;
#pragma unroll 1
        for (int k = 0; k < 2; ++k) dsa_unit(F, bh >> 2, bh & 3, k ? 7 - pi : pi, mref);
    }
}
namespace idx {
using att::f32x16;
constexpr int SCP = 2048;
__device__ __forceinline__ unsigned okey(float f) { const unsigned u = __float_as_uint(f); return (u & 0x80000000u) ? ~u : (u | 0x80000000u); }
template <int EP> __device__ __forceinline__ void select_row(const LAS float* sc, int E, unsigned* mrow, int lane) {
    unsigned key[EP];
#pragma unroll
    for (int j = 0; j < EP; ++j) key[j] = (j < E) ? okey(sc[64 * j + lane]) : 0u;
    unsigned T = 0u; bool exact = false;
    for (int bit = 31; bit >= 0; --bit) {
        const unsigned cand = T | (1u << bit); int cnt = 0;
#pragma unroll
        for (int j = 0; j < EP; ++j) cnt += __popcll(__ballot(key[j] >= cand));
        if (cnt >= 256) { T = cand; if (cnt == 256) { exact = true; break; } }
    }
    unsigned long long mine = 0ull;
    if (exact) {
#pragma unroll
        for (int j = 0; j < EP; ++j) { const unsigned long long m = __ballot(key[j] >= T); if (lane == j) mine = m; }
    } else {
        int cgt = 0;
#pragma unroll
        for (int j = 0; j < EP; ++j) cgt += __popcll(__ballot(key[j] > T));
        int need = 256 - cgt;
        const unsigned long long below = (1ull << lane) - 1ull;
#pragma unroll
        for (int j = 0; j < EP; ++j) {
            const unsigned long long eq = __ballot(key[j] == T), gt = __ballot(key[j] > T);
            const bool take = (key[j] == T) && (__popcll(eq & below) < need);
            const unsigned long long m = gt | __ballot(take);
            need -= __popcll(eq); if (need < 0) need = 0;
            if (lane == j) mine = m;
        }
    }
    if (lane < 32) *(unsigned long long*)(mrow + 2 * lane) = (lane < E) ? mine : 0ull;
}
__device__ __forceinline__ void unit(Frame& F, int b, int c, int sub) {
    const int lane = F.lane, w = F.wave, hi = lane >> 5, r32 = lane & 31, tid = F.tid;
    const int n = 64 * (c + 1), t0 = 64 * c + 16 * sub;
    const bf16* P = F.R1 + (size_t)b * SEQ * NAB;
    LAS float* sc = (LAS float*)F.lds;
    LAS float* wt = sc + 16 * SCP;
    if (tid < 128) wt[tid] = bf2f(P[(size_t)(t0 + (tid >> 3)) * NAB + C_IW + (tid & 7)]) * (0.125f * 0.35355339059327373f);
    bf16x8 af[4][4];
#pragma unroll
    for (int rt = 0; rt < 4; ++rt)
#pragma unroll
        for (int ks = 0; ks < 4; ++ks) af[rt][ks] = *(const bf16x8*)(P + (size_t)(t0 + 4 * rt + (r32 >> 3)) * NAB + C_IQ + (r32 & 7) * 64 + 16 * ks + 8 * hi);
    __syncthreads();
    const int nstrip = n >> 5;
    bf16x8 bfr[4], bnx[4];
    if (w < nstrip) {
#pragma unroll
        for (int ks = 0; ks < 4; ++ks) bfr[ks] = *(const bf16x8*)(P + (size_t)(32 * w + r32) * NAB + C_IK + 16 * ks + 8 * hi);
    }
    for (int s = w; s < nstrip; s += NWAVES) {
        const bool more = s + NWAVES < nstrip;
        if (more) {
#pragma unroll
            for (int ks = 0; ks < 4; ++ks) bnx[ks] = *(const bf16x8*)(P + (size_t)(32 * (s + NWAVES) + r32) * NAB + C_IK + 16 * ks + 8 * hi);
        }
#pragma unroll
        for (int rt = 0; rt < 4; ++rt) {
            f32x16 acc;
#pragma unroll
            for (int r = 0; r < 16; ++r) acc[r] = 0.f;
#pragma unroll
            for (int ks = 0; ks < 4; ++ks) acc = __builtin_amdgcn_mfma_f32_32x32x16_bf16(af[rt][ks], bfr[ks], acc, 0, 0, 0);
            float part[4];
#pragma unroll
            for (int qi = 0; qi < 4; ++qi) { const f32x4 wv = *(const LAS f32x4*)(wt + (4 * rt + qi) * 8 + 4 * hi);
                part[qi] = fmaxf(acc[4 * qi], 0.f) * wv[0] + fmaxf(acc[4 * qi + 1], 0.f) * wv[1] + fmaxf(acc[4 * qi + 2], 0.f) * wv[2] + fmaxf(acc[4 * qi + 3], 0.f) * wv[3]; }
            const float send0 = hi ? part[0] : part[2], send1 = hi ? part[1] : part[3];
            const float got0 = __shfl_xor(send0, 32), got1 = __shfl_xor(send1, 32);
            const float f0 = (hi ? part[2] : part[0]) + got0, f1 = (hi ? part[3] : part[1]) + got1;
            const int q0 = 4 * rt + 2 * hi;
            sc[q0 * SCP + 32 * s + r32] = f0; sc[(q0 + 1) * SCP + 32 * s + r32] = f1;
        }
        if (more) {
#pragma unroll
            for (int ks = 0; ks < 4; ++ks) bfr[ks] = bnx[ks];
        }
    }
    __syncthreads();
    const int E = n >> 6;
#pragma unroll 1
    for (int rr = 0; rr < 2; ++rr) {
        const int q = 2 * w + rr;
        unsigned* mrow = F.MASK + (size_t)(b * SEQ + t0 + q) * 64;
        const LAS float* row = sc + q * SCP;
        if (E <= 8) select_row<8>(row, E, mrow, lane);
        else if (E <= 16) select_row<16>(row, E, mrow, lane);
        else if (E <= 24) select_row<24>(row, E, mrow, lane);
        else select_row<32>(row, E, mrow, lane);
    }
    __syncthreads();
}
}
__device__ __forceinline__ void ph_indexer(Frame& F) {
    { const int gw = F.vcu * NWAVES + F.wave, NGW = F.G * NWAVES;
      for (int i = gw; i < BATCH * 256; i += NGW) { const int b = i >> 8, pos = i & 255, n = ((pos >> 6) + 1) << 6;
          if (F.lane < 32) { unsigned long long v = 0ull; if (64 * F.lane < n) v = ~0ull; *(unsigned long long*)(F.MASK + (size_t)(b * SEQ + pos) * 64 + 2 * F.lane) = v; } } }
    for (int u = F.vcu; u < BATCH * 28 * 4; u += F.G) { const int c = 4 + u % 28, rest = u / 28; idx::unit(F, rest >> 2, c, rest & 3); }
}
namespace gla {
using att::f32x16; using att::u32x4;
constexpr int L_WL = 0, L_V = 4096, L_K = 20480, L_Q = 29696, L_OG = 38912, L_PART = 55296, L_STG = 56320, KP = 144, SP = 272;
__device__ __forceinline__ void stage_wl(Frame& F, int h) {
    LAS float* wl = (LAS float*)(F.lds + L_WL);
#pragma unroll
    for (int i = 0; i < 2; ++i) { const int e = F.tid + 512 * i, r = e >> 6, d = e & 63; wl[e] = F.w_gate_up[r * 256 + h * 64 + d]; }
}
__device__ __forceinline__ void gate_scan(Frame& F, int b, int h, int c, float (&bc)[8], float (&blast)[8]) {
    const int lane = F.lane, d0 = 8 * F.wave;
    const bf16* pr = F.R1 + (size_t)(b * SEQ + 64 * c + lane) * NAB + C_GL;
    const u32x4 g0 = *(const u32x4*)pr, g1 = *(const u32x4*)(pr + 8);
    float gl[16];
#pragma unroll
    for (int i = 0; i < 4; ++i) { gl[2 * i] = __uint_as_float(g0[i] << 16); gl[2 * i + 1] = __uint_as_float(g0[i] & 0xffff0000u); gl[8 + 2 * i] = __uint_as_float(g1[i] << 16); gl[8 + 2 * i + 1] = __uint_as_float(g1[i] & 0xffff0000u); }
    const LAS float* wl = (const LAS float*)(F.lds + L_WL);
    float acc[8];
#pragma unroll
    for (int i = 0; i < 8; ++i) acc[i] = F.b_gate[h * 64 + d0 + i];
#pragma unroll
    for (int r = 0; r < 16; ++r) { const f32x4 w0 = *(const LAS f32x4*)(wl + r * 64 + d0), w1 = *(const LAS f32x4*)(wl + r * 64 + d0 + 4);
#pragma unroll
        for (int i = 0; i < 4; ++i) { acc[i] = fmaf(gl[r], w0[i], acc[i]); acc[4 + i] = fmaf(gl[r], w1[i], acc[4 + i]); } }
#pragma unroll
    for (int i = 0; i < 8; ++i) { float v = log_sigmoid(acc[i]) * (1.0f / 16.0f);
#pragma unroll
        for (int off = 1; off < 64; off <<= 1) { const float u = __shfl_up(v, off); if (lane >= off) v += u; }
        bc[i] = v; blast[i] = __shfl(v, 63); }
}
__device__ __forceinline__ void unpack8(const u32x4 v, float (&f)[8]) {
#pragma unroll
    for (int i = 0; i < 4; ++i) { f[2 * i] = __uint_as_float(v[i] << 16); f[2 * i + 1] = __uint_as_float(v[i] & 0xffff0000u); }
}
__device__ __forceinline__ void unit_a(Frame& F, int b, int h, int c, float* GU, float* DEC) {
    const int lane = F.lane, w = F.wave, hi = lane >> 5, r32 = lane & 31, uid = (4 * b + h) * 32 + c;
    const bf16* P = F.R1 + (size_t)(b * SEQ + 64 * c) * NAB;
    att::FragOff fo; att::frag_off_init(fo, lane);
    unsigned dvo[2]; att::dma_off_init(dvo, NAB, w, lane);
    att::tile_dma(P + C_VB + h * 128, dvo, F.lds + L_V, w);
    stage_wl(F, h);
    __syncthreads();
    float bc[8], blast[8];
    gate_scan(F, b, h, c, bc, blast);
    float kf[8]; unpack8(*(const u32x4*)(P + (size_t)lane * NAB + C_KB + h * 64 + 8 * w), kf);
#pragma unroll
    for (int i = 0; i < 8; ++i) *(LAS bf16*)(F.lds + L_K + (8 * w + i) * KP + lane * 2) = (bf16)f2bf(kf[i] * __expf(blast[i] - bc[i]));
    if (lane == 0) {
#pragma unroll
        for (int i = 0; i < 8; ++i) DEC[(size_t)uid * 64 + 8 * w + i] = __expf(blast[i]); }
    asm volatile("s_waitcnt vmcnt(0) lgkmcnt(0)" ::: "memory");
    __syncthreads();
    const int et = w >> 1, dt = w & 1, va_et = att::frag_va(lane, et);
    f32x16 acc;
#pragma unroll
    for (int r = 0; r < 16; ++r) acc[r] = 0.f;
#pragma unroll
    for (int kk = 0; kk < 4; ++kk) {
        const LAS unsigned char* kp = F.lds + L_K + (32 * dt + r32) * KP + (16 * kk + 4 * hi) * 2;
        const unsigned long long lo = *(const LAS unsigned long long*)kp, hh = *(const LAS unsigned long long*)(kp + 16);
        u32x4 bw; bw.x = (unsigned)lo; bw.y = (unsigned)(lo >> 32); bw.z = (unsigned)hh; bw.w = (unsigned)(hh >> 32);
        acc = __builtin_amdgcn_mfma_f32_32x32x16_bf16(att::v_frag_rt(F.lds + L_V, va_et, fo.vd, kk), __builtin_bit_cast(bf16x8, bw), acc, 0, 0, 0);
    }
    float* gu = GU + (size_t)uid * 8192;
#pragma unroll
    for (int r = 0; r < 16; ++r) gu[(32 * et + att::crow(r, hi)) * 64 + 32 * dt + r32] = acc[r];
    __syncthreads();
}
__device__ __forceinline__ void pass_b(Frame& F, float* GU, const float* DEC) {
    for (int idx = F.vcu * NTHR + F.tid; idx < 64 * 128 * 16; idx += F.G * NTHR) {
        const int bh = idx >> 11, e = (idx >> 4) & 127, dq = idx & 15;
        f32x4 S = (f32x4){0.f, 0.f, 0.f, 0.f};
        for (int c = 0; c < 32; ++c) { const size_t uid = (size_t)bh * 32 + c; f32x4* p = (f32x4*)(GU + (uid * 128 + e) * 64 + 4 * dq);
            const f32x4 U = *p, dec = *(const f32x4*)(DEC + uid * 64 + 4 * dq);
            *p = S; S = dec * S + U; }
    }
}
__device__ __forceinline__ void unit_c(Frame& F, int b, int h, int c, const float* GU) {
    const int lane = F.lane, w = F.wave, hi = lane >> 5, r32 = lane & 31, tid = F.tid, uid = (4 * b + h) * 32 + c;
    const bf16* P = F.R1 + (size_t)(b * SEQ + 64 * c) * NAB;
    LAS unsigned char* lds = F.lds;
    att::FragOff fo; att::frag_off_init(fo, lane);
    unsigned dvo[2]; att::dma_off_init(dvo, NAB, w, lane);
    att::tile_dma(P + C_VB + h * 128, dvo, lds + L_V, w);
    att::tile_dma(P + C_OG + h * 128, dvo, lds + L_OG, w);
    stage_wl(F, h);
    __syncthreads();
    float bc[8], blast[8];
    gate_scan(F, b, h, c, bc, blast);
    { float qf[8], kf[8]; unpack8(*(const u32x4*)(P + (size_t)lane * NAB + C_QB + h * 64 + 8 * w), qf); unpack8(*(const u32x4*)(P + (size_t)lane * NAB + C_KB + h * 64 + 8 * w), kf);
      float eq[8], ek[8];
#pragma unroll
      for (int i = 0; i < 8; ++i) { eq[i] = qf[i] * 0.125f * __expf(bc[i]); ek[i] = kf[i] * __expf(-bc[i]); }
      *(LAS bf16x8*)(lds + L_Q + lane * KP + 16 * w) = att::pack8(eq[0], eq[1], eq[2], eq[3], eq[4], eq[5], eq[6], eq[7]);
      *(LAS bf16x8*)(lds + L_K + lane * KP + 16 * w) = att::pack8(ek[0], ek[1], ek[2], ek[3], ek[4], ek[5], ek[6], ek[7]); }
    asm volatile("s_waitcnt vmcnt(0) lgkmcnt(0)" ::: "memory");
    __syncthreads();
    const int et = w >> 1, tt = w & 1, tl = 32 * tt + r32, va_et = att::frag_va(lane, et);
    bf16x8 qfr[4];
#pragma unroll
    for (int ks = 0; ks < 4; ++ks) qfr[ks] = *(const LAS bf16x8*)(lds + L_Q + tl * KP + (16 * ks + 8 * hi) * 2);
    f32x16 p0, p1;
#pragma unroll
    for (int r = 0; r < 16; ++r) { p0[r] = 0.f; p1[r] = 0.f; }
#pragma unroll
    for (int ks = 0; ks < 4; ++ks) {
        const bf16x8 a0 = *(const LAS bf16x8*)(lds + L_K + r32 * KP + (16 * ks + 8 * hi) * 2), a1 = *(const LAS bf16x8*)(lds + L_K + (32 + r32) * KP + (16 * ks + 8 * hi) * 2);
        p0 = __builtin_amdgcn_mfma_f32_32x32x16_bf16(a0, qfr[ks], p0, 0, 0, 0); p1 = __builtin_amdgcn_mfma_f32_32x32x16_bf16(a1, qfr[ks], p1, 0, 0, 0);
    }
#pragma unroll
    for (int r = 0; r < 16; ++r) { const int s = att::crow(r, hi); if (s > tl) p0[r] = 0.f; if (s + 32 > tl) p1[r] = 0.f; }
    const bf16x8 pa0 = att::pack8(p0[0], p0[1], p0[2], p0[3], p0[4], p0[5], p0[6], p0[7]), pa1 = att::pack8(p0[8], p0[9], p0[10], p0[11], p0[12], p0[13], p0[14], p0[15]);
    const bf16x8 pa2 = att::pack8(p1[0], p1[1], p1[2], p1[3], p1[4], p1[5], p1[6], p1[7]), pa3 = att::pack8(p1[8], p1[9], p1[10], p1[11], p1[12], p1[13], p1[14], p1[15]);
    f32x16 acc;
#pragma unroll
    for (int r = 0; r < 16; ++r) acc[r] = 0.f;
    acc = __builtin_amdgcn_mfma_f32_32x32x16_bf16(att::v_frag_rt(lds + L_V, va_et, fo.vd, 0), pa0, acc, 0, 0, 0);
    acc = __builtin_amdgcn_mfma_f32_32x32x16_bf16(att::v_frag_rt(lds + L_V, va_et, fo.vd, 1), pa1, acc, 0, 0, 0);
    acc = __builtin_amdgcn_mfma_f32_32x32x16_bf16(att::v_frag_rt(lds + L_V, va_et, fo.vd, 2), pa2, acc, 0, 0, 0);
    acc = __builtin_amdgcn_mfma_f32_32x32x16_bf16(att::v_frag_rt(lds + L_V, va_et, fo.vd, 3), pa3, acc, 0, 0, 0);
    { const float* gs = GU + ((size_t)uid * 128 + 32 * et + r32) * 64;
#pragma unroll
      for (int ks = 0; ks < 4; ++ks) { const f32x4 s0 = *(const f32x4*)(gs + 16 * ks + 8 * hi), s1 = *(const f32x4*)(gs + 16 * ks + 8 * hi + 4);
          acc = __builtin_amdgcn_mfma_f32_32x32x16_bf16(att::pack8(s0[0], s0[1], s0[2], s0[3], s1[0], s1[1], s1[2], s1[3]), qfr[ks], acc, 0, 0, 0); } }
    float ss = 0.f;
#pragma unroll
    for (int r = 0; r < 16; ++r) ss = fmaf(acc[r], acc[r], ss);
    ss += __shfl_xor(ss, 32);
    LAS float* part = (LAS float*)(lds + L_PART);
    if (hi == 0) part[et * 64 + tl] = ss;
    asm volatile("s_waitcnt lgkmcnt(0)" ::: "memory");
    __syncthreads();
    const float rs = rsqrtf(((part[tl] + part[64 + tl]) + (part[128 + tl] + part[192 + tl])) * (1.0f / 128.0f) + EPS);
#pragma unroll
    for (int g = 0; g < 4; ++g) {
        const int e0 = 32 * et + 8 * g + 4 * hi;
        const unsigned long long ow = *(const LAS unsigned long long*)(lds + L_OG + att::img_off(tl, 4 * et + g) + 8 * hi);
        const f32x4 gg = *(const f32x4*)(F.g_gla + e0);
        float y[4];
#pragma unroll
        for (int i = 0; i < 4; ++i) { const float og = __uint_as_float(((unsigned)(ow >> (16 * i)) & 0xffffu) << 16); y[i] = acc[4 * g + i] * rs * gg[i] * (og / (1.0f + __expf(-og))); }
        *(LAS unsigned long long*)(lds + L_STG + tl * SP + e0 * 2) = (unsigned long long)pg8::cvt_pk_bf16(y[0], y[1]) | ((unsigned long long)pg8::cvt_pk_bf16(y[2], y[3]) << 32);
    }
    asm volatile("s_waitcnt lgkmcnt(0)" ::: "memory");
    __syncthreads();
#pragma unroll
    for (int i = 0; i < 2; ++i) { const int cidx = tid + 512 * i, row = cidx >> 4, ch = cidx & 15;
        *(u32x4*)(F.CAT + (size_t)(b * SEQ + 64 * c + row) * D + 512 + h * 128 + ch * 8) = *(const LAS u32x4*)(lds + L_STG + row * SP + ch * 16); }
    __syncthreads();
}
}
__device__ __forceinline__ void ph_gla_a(Frame& F, float* GU, float* DEC) { for (int u = F.vcu; u < BATCH * 4 * 32; u += F.G) gla::unit_a(F, u >> 7, (u >> 5) & 3, u & 31, GU, DEC); }
__device__ __forceinline__ void ph_gla_c(Frame& F, const float* GU) { for (int u = F.vcu; u < BATCH * 4 * 32; u += F.G) gla::unit_c(F, u >> 7, (u >> 5) & 3, u & 31, GU); }
#ifndef MK_PER_PHASE
#define MK_PER_PHASE 0
#endif
constexpr int NPH = 14;
struct Args { const float* in[16]; float* out; unsigned char* ws; int ph_lo, ph_hi; };
__global__ void __launch_bounds__(NTHR, 2) mk_fwd(Args args) {
    extern __shared__ __attribute__((aligned(16))) unsigned char lds[];
    Frame F;
    F.lds = (LAS unsigned char*)lds;
    F.MISC = (volatile LAS unsigned*)(F.lds + MISC_OFF);
    F.wave = __builtin_amdgcn_readfirstlane((int)threadIdx.x >> 6);
#define RELANE() (F.lane = (int)__builtin_amdgcn_mbcnt_hi(~0u, __builtin_amdgcn_mbcnt_lo(~0u, 0u)), F.tid = F.wave * 64 + F.lane, true)
    RELANE();
    F.G = gridDim.x; { const int bx = blockIdx.x; F.vcu = (F.G % 8 == 0) ? (bx % 8) * (F.G / 8) + bx / 8 : bx; }
    unsigned char* ws = args.ws;
    F.ctl = (gu32*)(ws + WS_CTL);
    F.x = args.in[0]; F.g_mix = args.in[1]; F.g_ffn = args.in[2]; F.w_in_ab = args.in[3]; F.gq_a = args.in[4]; F.gk_a = args.in[5]; F.w_gate_up = args.in[6]; F.b_gate = args.in[7];
    F.g_gla = args.in[8]; F.w_out_ab = args.in[9]; F.w_in_c = args.in[10]; F.gq_c = args.in[11]; F.gk_c = args.in[12]; F.w_out_c = args.in[13]; F.w_up = args.in[14]; F.w_down = args.in[15];
    F.out = args.out;
    F.Wab = (bf16*)(ws + WS_WAB); F.Woab = (bf16*)(ws + WS_WOAB); F.Wup0 = (bf16*)(ws + WS_WUP0); F.Wdn0 = (bf16*)(ws + WS_WDN0);
    F.Winc = (bf16*)(ws + WS_WINC); F.Woc = (bf16*)(ws + WS_WOC); F.Wup1 = (bf16*)(ws + WS_WUP1); F.Wdn1 = (bf16*)(ws + WS_WDN1);
    F.XB = (bf16*)(ws + WS_XB); F.CAT = (bf16*)(ws + WS_CAT); F.R1 = (bf16*)(ws + WS_R1); F.SSQ = (float*)(ws + WS_SSQ); F.MASK = (unsigned*)(ws + WS_MASK);
    for (int u = F.tid; u < (LDS_BYTES - MISC_OFF) / 4; u += NTHR) ((LAS unsigned*)(F.lds + MISC_OFF))[u] = 0u;
    __syncthreads();
    XcdBarrier bar; bar.bar = (unsigned*)(F.ctl + CW_BAR); bar.x = 0; bar.st = nullptr; bar.wave = F.wave;
    if (!MK_PER_PHASE) bar = xcd_barrier_post((unsigned*)(F.ctl + CW_BAR), F.MISC + 8, F.wave);
    const int lo = args.ph_lo, hi = args.ph_hi;
#define IN(k) (lo <= (k) && (k) < hi && RELANE())
#define SEAM(k) do { if (lo <= (k) && (k) + 1 < hi) xcd_barrier(bar); } while (0)
    float* const SSQ0 = F.SSQ, *SSQ1 = F.SSQ + (size_t)M * 16, *SSQ2 = F.SSQ + (size_t)2 * M * 16, *SSQ3 = F.SSQ + (size_t)3 * M * 16;
    typedef pg8::StaticOrder SO;
    if (IN(0)) { ph_prologue(F); } SEAM(0);
    if (IN(1)) { pg8::Gemm g{F.XB, F.Wab, M, NAB, D}; SO S; S.init(M, NAB, F.G, (int)blockIdx.x); pg8::EpiScale<0> E{F.R1, NAB, SSQ0};
        pg8::gemm_phase<pg8::EpiScale<0>, SO, true, true>(F.lds, g, S, E, F.wave); } SEAM(1);
    float* const GU = (float*)(ws + WS_XB); float* const DEC = (float*)(ws + WS_DEC);
    if (IN(2)) { ph_prep_a<true>(F); ph_gla_a(F, GU, DEC); } SEAM(2);
    if (IN(3)) { gla::pass_b(F, GU, DEC); ph_indexer(F); } SEAM(3);
    if (IN(4)) { ph_dsa(F); ph_gla_c(F, GU); } SEAM(4);
    if (IN(5)) { pg8::Gemm g{F.CAT, F.Woab, M, D, D}; SO S; S.init(M, D, F.G, (int)blockIdx.x); pg8::EpiResid<1> E{F.x, F.out, F.XB, SSQ1};
        pg8::gemm_phase<pg8::EpiResid<1>, SO, true, true>(F.lds, g, S, E, F.wave); } SEAM(5);
    if (IN(6)) { pg8::Gemm g{F.XB, F.Wup0, M, FF, D}; SO S; S.init(M, FF, F.G, (int)blockIdx.x); pg8::EpiScale<1> E{F.R1, FF, SSQ1};
        pg8::gemm_phase<pg8::EpiScale<1>, SO, true, true>(F.lds, g, S, E, F.wave); } SEAM(6);
    if (IN(7)) { pg8::Gemm g{F.R1, F.Wdn0, M, D, FF}; SO S; S.init(M, D, F.G, (int)blockIdx.x); pg8::EpiResid<1> E{F.out, F.out, F.XB, SSQ2};
        pg8::gemm_phase<pg8::EpiResid<1>, SO, true, true>(F.lds, g, S, E, F.wave); } SEAM(7);
    if (IN(8)) { pg8::Gemm g{F.XB, F.Winc, M, NC, D}; SO S; S.init(M, NC, F.G, (int)blockIdx.x); pg8::EpiScale<0> E{F.R1, NC, SSQ2};
        pg8::gemm_phase<pg8::EpiScale<0>, SO, true, true>(F.lds, g, S, E, F.wave); } SEAM(8);
    if (IN(9)) { ph_prep_c<true>(F); } SEAM(9);
    if (IN(10)) { ph_sb(F); } SEAM(10);
    if (IN(11)) { pg8::Gemm g{F.CAT, F.Woc, M, D, D}; SO S; S.init(M, D, F.G, (int)blockIdx.x); pg8::EpiResid<1> E{F.out, F.out, F.XB, SSQ3};
        pg8::gemm_phase<pg8::EpiResid<1>, SO, true, true>(F.lds, g, S, E, F.wave); } SEAM(11);
    if (IN(12)) { pg8::Gemm g{F.XB, F.Wup1, M, FF, D}; SO S; S.init(M, FF, F.G, (int)blockIdx.x); pg8::EpiScale<1> E{F.R1, FF, SSQ3};
        pg8::gemm_phase<pg8::EpiScale<1>, SO, true, true>(F.lds, g, S, E, F.wave); } SEAM(12);
    if (IN(13)) { pg8::Gemm g{F.R1, F.Wdn1, M, D, FF}; SO S; S.init(M, D, F.G, (int)blockIdx.x); pg8::EpiResid<0> E{F.out, F.out, nullptr, nullptr};
        pg8::gemm_phase<pg8::EpiResid<0>, SO, true, true>(F.lds, g, S, E, F.wave); }
#undef IN
#undef SEAM
}

extern "C" void kernel_launch(void* const* d_in, const int* in_sizes, int n_in, void* d_out, int out_size, void* d_ws, size_t ws_size, hipStream_t stream) {
    static int grid = 0;
    if (grid == 0) {
        if (n_in != 16 || in_sizes[0] != M * D || out_size != M * D || ws_size < WS_END) { fprintf(stderr, "kernel_launch: unexpected shapes / workspace (%d inputs, ws %zu)\n", n_in, ws_size); grid = -1; return; }
        int dev = 0, cus = 0;
        if (hipGetDevice(&dev) != hipSuccess || hipDeviceGetAttribute(&cus, hipDeviceAttributeMultiprocessorCount, dev) != hipSuccess) { grid = -1; return; }
        if (hipFuncSetAttribute((const void*)mk_fwd, hipFuncAttributeMaxDynamicSharedMemorySize, LDS_BYTES) != hipSuccess) { fprintf(stderr, "kernel_launch: hipFuncSetAttribute failed\n"); grid = -1; return; }
        (void)hipGetLastError();
        grid = cus;
    }
    if (grid < 0) return;
    if (hipMemsetAsync((char*)d_ws + WS_CTL, 0, CTL_ZERO_BYTES, stream) != hipSuccess) { fprintf(stderr, "kernel_launch: memset failed\n"); return; }
    Args a{};
    for (int i = 0; i < 16; ++i) a.in[i] = (const float*)d_in[i];
    a.out = (float*)d_out; a.ws = (unsigned char*)d_ws;
#if MK_PER_PHASE
    for (int ph = 0; ph < NPH; ++ph) { a.ph_lo = ph; a.ph_hi = ph + 1; hipLaunchKernelGGL(mk_fwd, dim3(grid), dim3(NTHR), LDS_BYTES, stream, a); }
#else
    a.ph_lo = 0; a.ph_hi = NPH;
    hipLaunchKernelGGL(mk_fwd, dim3(grid), dim3(NTHR), LDS_BYTES, stream, a);
#endif
    const hipError_t le = hipPeekAtLastError();
    if (le != hipSuccess) fprintf(stderr, "kernel_launch: launch failed: %s\n", hipGetErrorName(le));
}
```

```cpp
#include <hip/hip_runtime.h>
#include <cstdio>
#include <cstdint>
namespace pg8 {
#define PG8_LAS __attribute__((address_space(3)))
typedef unsigned short bf16_t;
typedef short bf16x8 __attribute__((ext_vector_type(8)));
typedef float f32x4 __attribute__((ext_vector_type(4)));
typedef unsigned u32x4 __attribute__((ext_vector_type(4)));
constexpr int BM = 256, BK = 64, HALF = 128, HTB = HALF * BK * 2  , STAGE_BYTES = 8 * HTB, NXCD = 8, WGM = 8;

__host__ __device__ __forceinline__ int lds_byte(int r, int c) { const int st = (r >> 4) * 2 + (c >> 5), rr = r & 15, cc = c & 31, ob = rr * 64 + cc * 2; return st * 1024 + (ob ^ (((ob >> 9) & 1) << 5)); }
__host__ __device__ __forceinline__ void stage_rc(int b, int& R, int& C) { const int st = b / 1024, sb = b % 1024, swz = sb ^ (((sb >> 9) & 1) << 5); R = (st >> 1) * 16 + swz / 64; C = (st & 1) * 32 + (swz % 64) / 2; }
__host__ __device__ __forceinline__ int perm32(int rho) { const int n = rho >> 4, i = rho & 15; return 8 * (i >> 2) + 4 * n + (i & 3); }

struct Unit { int pm, pn; };
struct Gemm { const bf16_t* A; const bf16_t* Bt; int M, N, K; };

struct StaticOrder {
    int nM, nN, nwg, G, c;
    __host__ __device__ void init(int M, int N, int G_, int c_) { nM = M / BM; nN = N / BM; nwg = nM * nN; G = G_; c = c_; }
    __host__ __device__ bool next(int i, Unit& u) const {
        const long L = (long)i * G + c; if (L >= nwg) return false;
        int wgid = (int)L; { const int q = nwg / NXCD, r = nwg % NXCD, xcd = wgid % NXCD, off = wgid / NXCD; wgid = (xcd < r ? xcd * (q + 1) : r * (q + 1) + (xcd - r) * q) + off; }
        const int nig = WGM * nN, gid = wgid / nig, fm = gid * WGM, gsz = (nM - fm) < WGM ? (nM - fm) : WGM;
        u.pm = fm + ((wgid % nig) % gsz); u.pn = (wgid % nig) / gsz; return true;
    }
    __device__ __forceinline__ void a_ready(const Unit&) const {}
    __device__ __forceinline__ void done(const Unit&) const {}
};

__device__ __forceinline__ unsigned cvt_pk_bf16(float lo, float hi) { unsigned r; asm volatile("v_cvt_pk_bf16_f32 %0, %1, %2" : "=v"(r) : "v"(lo), "v"(hi)); return r; }
__device__ __forceinline__ float row_rstd(const float* ssqp, int row) {
    const f32x4* p = (const f32x4*)(ssqp + (size_t)row * 16);
    const f32x4 a = p[0], b = p[1], c = p[2], d = p[3];
    const float s = (((a[0] + a[1]) + (a[2] + a[3])) + ((b[0] + b[1]) + (b[2] + b[3]))) + (((c[0] + c[1]) + (c[2] + c[3])) + ((d[0] + d[1]) + (d[2] + d[3])));
    return rsqrtf(s * (1.0f / 1024.0f) + 1e-6f);
}
template <int ACT  > struct EpiScale {
    static constexpr bool PERM = true, AFTER_DRAIN = false;
    bf16_t* O; int ldc; const float* ssqp;
    __device__ __forceinline__ void operator()(const f32x4 (&acc)[2][2][4][2], const Unit& u, int wr, int wc, int fr, int fq) const {
        const int row0 = u.pm * BM + wr * 64 + fr, col0 = u.pn * BM + wc * 32 + 8 * fq;
#pragma unroll
        for (int ai = 0; ai < 2; ++ai)
#pragma unroll
            for (int m = 0; m < 4; ++m) {
                const int row = row0 + ai * HALF + m * 16;
                const float rs = row_rstd(ssqp, row);
                bf16_t* rowp = O + (size_t)row * ldc + col0;
#pragma unroll
                for (int bj = 0; bj < 2; ++bj) {
                    f32x4 v0 = acc[ai][bj][m][0] * rs, v1 = acc[ai][bj][m][1] * rs;
                    if (ACT == 1) {
#pragma unroll
                        for (int e = 0; e < 4; ++e) { const float a0 = fmaxf(v0[e], 0.f), a1 = fmaxf(v1[e], 0.f); v0[e] = a0 * a0; v1[e] = a1 * a1; }
                    }
                    u32x4 w; w.x = cvt_pk_bf16(v0[0], v0[1]); w.y = cvt_pk_bf16(v0[2], v0[3]); w.z = cvt_pk_bf16(v1[0], v1[1]); w.w = cvt_pk_bf16(v1[2], v1[3]);
                    *(u32x4*)(rowp + bj * HALF) = w;
                }
            }
    }
};
template <int RIN, int OUT> struct EpiResid {
    static constexpr bool PERM = true, AFTER_DRAIN = false;
    const void* R; float* out; bf16_t* hb; float* ssqp;
    __device__ __forceinline__ void operator()(const f32x4 (&acc)[2][2][4][2], const Unit& u, int wr, int wc, int fr, int fq) const {
        const int row0 = u.pm * BM + wr * 64 + fr, col0 = u.pn * BM + wc * 32 + 8 * fq;
#pragma unroll
        for (int ai = 0; ai < 2; ++ai)
#pragma unroll
            for (int m = 0; m < 4; ++m) {
                const int row = row0 + ai * HALF + m * 16;
                const size_t off = (size_t)row * 1024 + col0;
                float ss = 0.f;
#pragma unroll
                for (int bj = 0; bj < 2; ++bj) {
                    f32x4 r0, r1;
                    if (RIN == 0) { r0 = *(const f32x4*)((const float*)R + off + bj * HALF); r1 = *(const f32x4*)((const float*)R + off + bj * HALF + 4); }
                    else { const u32x4 rw = *(const u32x4*)((const bf16_t*)R + off + bj * HALF);
                        r0 = (f32x4){__uint_as_float(rw.x << 16), __uint_as_float(rw.x & 0xffff0000u), __uint_as_float(rw.y << 16), __uint_as_float(rw.y & 0xffff0000u)};
                        r1 = (f32x4){__uint_as_float(rw.z << 16), __uint_as_float(rw.z & 0xffff0000u), __uint_as_float(rw.w << 16), __uint_as_float(rw.w & 0xffff0000u)}; }
                    const f32x4 v0 = acc[ai][bj][m][0] + r0, v1 = acc[ai][bj][m][1] + r1;
                    if (OUT == 1) { *(f32x4*)(out + off + bj * HALF) = v0; *(f32x4*)(out + off + bj * HALF + 4) = v1; }
                    else {
                        u32x4 w; w.x = cvt_pk_bf16(v0[0], v0[1]); w.y = cvt_pk_bf16(v0[2], v0[3]); w.z = cvt_pk_bf16(v1[0], v1[1]); w.w = cvt_pk_bf16(v1[2], v1[3]);
                        *(u32x4*)(hb + off + bj * HALF) = w;
                        ss += ((v0[0] * v0[0] + v0[1] * v0[1]) + (v0[2] * v0[2] + v0[3] * v0[3])) + ((v1[0] * v1[0] + v1[1] * v1[1]) + (v1[2] * v1[2] + v1[3] * v1[3]));
                    }
                }
                if (OUT == 0) { ss += __shfl_xor(ss, 16); ss += __shfl_xor(ss, 32); if (fq == 0) ssqp[(size_t)row * 16 + u.pn * 4 + wc] = ss; }
            }
    }
};
template <class Epi, class Sched, bool ALIGN_EPI = false, bool SP2 = false>
__device__ __forceinline__ void gemm_phase(PG8_LAS unsigned char* lds, const Gemm g, const Sched& S, const Epi& E, const int wave_in) {
    const int wid = wave_in, lane = (int)__builtin_amdgcn_mbcnt_hi(~0u, __builtin_amdgcn_mbcnt_lo(~0u, 0u)), tid = wid * 64 + lane, wr = wid >> 2, wc = wid & 3, fr = lane & 15, fq = lane >> 4;
    const int K = g.K, nt = K / BK;
    unsigned voffA[2], voffB[2];
#pragma unroll
    for (int i = 0; i < 2; ++i) { int R, C; stage_rc(tid * 16 + i * 8192, R, C); const int Rb = Epi::PERM ? ((R & ~31) + perm32(R & 31)) : R;
        voffA[i] = (unsigned)(R * K + C) * 2u; voffB[i] = (unsigned)(Rb * K + C) * 2u; }
    const size_t kstep = (size_t)(BK * 2);
    const size_t hstep = (size_t)HALF * K * 2;
    const size_t tstep = 2 * hstep;
    const unsigned ldsw = (unsigned)wid * 1024u;
    const int aoff = lds_byte(wr * 64 + fr, fq * 8), boff = lds_byte(wc * 32 + fr, fq * 8);
#define PG8_SA(b, h) (((b) * 2 + (h)) * HTB)
#define PG8_SB(b, h) ((4 + (b) * 2 + (h)) * HTB)
#define PG8_STAGE(bufoff, gbase, voff) do { _Pragma("unroll") for (int _i = 0; _i < 2; ++_i) \
        __builtin_amdgcn_global_load_lds((const unsigned*)((const char*)(gbase) + (voff)[_i]), (PG8_LAS unsigned*)(lds + (bufoff) + ldsw + _i * 8192), 16, 0, 0); } while (0)
#define PG8_LDA(dst, b, h) do { _Pragma("unroll") for (int m = 0; m < 4; ++m) _Pragma("unroll") for (int k = 0; k < 2; ++k) dst[m][k] = *(const PG8_LAS bf16x8*)(lds + PG8_SA(b, h) + aoff + m * 2048 + k * 1024); } while (0)
#define PG8_LDB(dst, b, h) do { _Pragma("unroll") for (int n = 0; n < 2; ++n) _Pragma("unroll") for (int k = 0; k < 2; ++k) dst[n][k] = *(const PG8_LAS bf16x8*)(lds + PG8_SB(b, h) + boff + n * 2048 + k * 1024); } while (0)
#define PG8_MMA(ai, bj, At, Bt) do { __builtin_amdgcn_s_setprio(1); _Pragma("unroll") for (int m = 0; m < 4; ++m) _Pragma("unroll") for (int n = 0; n < 2; ++n) _Pragma("unroll") for (int k = 0; k < 2; ++k) \
        acc[ai][bj][m][n] = __builtin_amdgcn_mfma_f32_16x16x32_bf16(Bt[n][k], At[m][k], acc[ai][bj][m][n], 0, 0, 0); __builtin_amdgcn_s_setprio(0); } while (0)
#define PG8_WAIT_V(n) asm volatile("s_waitcnt vmcnt(" #n ")" ::: "memory")
#define PG8_WAIT_L(n) asm volatile("s_waitcnt lgkmcnt(" #n ")" ::: "memory")
#define PG8_BAR __builtin_amdgcn_s_barrier()
#define PG8_SCHED __builtin_amdgcn_sched_barrier(0)
    Unit cur, nxt; int ui = 0;
    if (!S.next(0, cur)) return;
    f32x4 acc[2][2][4][2];
#pragma unroll
    for (int a = 0; a < 2; ++a)
#pragma unroll
        for (int b = 0; b < 2; ++b)
#pragma unroll
            for (int m = 0; m < 4; ++m)
#pragma unroll
                for (int n = 0; n < 2; ++n) acc[a][b][m][n] = (f32x4){0.f, 0.f, 0.f, 0.f};
    bf16x8 At[4][2], B0[2][2], B1[2][2];
    const char* cA = (const char*)g.A + (size_t)cur.pm * tstep; const char* cB = (const char*)g.Bt + (size_t)cur.pn * tstep;
    S.a_ready(cur);
    if constexpr (SP2) {
        PG8_STAGE(PG8_SB(0, 0), cB, voffB); PG8_STAGE(PG8_SB(0, 1), cB + hstep, voffB); PG8_STAGE(PG8_SA(0, 0), cA, voffA); PG8_STAGE(PG8_SA(0, 1), cA + hstep, voffA);
        if (wr == 1) PG8_BAR;
        PG8_WAIT_V(2); PG8_BAR;
        PG8_STAGE(PG8_SB(1, 0), cB + kstep, voffB); PG8_STAGE(PG8_SA(1, 0), cA + kstep, voffA); PG8_STAGE(PG8_SB(1, 1), cB + hstep + kstep, voffB);
        PG8_WAIT_V(6); PG8_BAR;
    } else {
        PG8_STAGE(PG8_SB(0, 0), cB, voffB); PG8_STAGE(PG8_SA(0, 0), cA, voffA); PG8_STAGE(PG8_SB(0, 1), cB + hstep, voffB); PG8_STAGE(PG8_SA(0, 1), cA + hstep, voffA);
        if (wr == 1) PG8_BAR;
        PG8_WAIT_V(4); PG8_BAR;
        PG8_STAGE(PG8_SB(1, 0), cB + kstep, voffB); PG8_STAGE(PG8_SA(1, 0), cA + kstep, voffA); PG8_STAGE(PG8_SB(1, 1), cB + hstep + kstep, voffB);
        PG8_WAIT_V(6); PG8_BAR;
    }
    for (;;) {
        const bool has_next = S.next(ui + 1, nxt);
        const char* nA = has_next ? (const char*)g.A + (size_t)nxt.pm * tstep : cA; const char* nB = has_next ? (const char*)g.Bt + (size_t)nxt.pn * tstep : cB;
        for (int t = 0; t < nt; t += 2) {
            const bool last = (t == nt - 2);
            const char* a1 = cA + (size_t)(t + 1) * kstep;
            const char* a2 = last ? nA : cA + (size_t)(t + 2) * kstep; const char* b2 = last ? nB : cB + (size_t)(t + 2) * kstep;
            const char* a3 = a2 + kstep; const char* b3 = b2 + kstep;
            if (last && has_next) S.a_ready(nxt);
            if constexpr (SP2) {
            PG8_LDB(B0, 0, 0); PG8_LDB(B1, 0, 1); PG8_SCHED; PG8_LDA(At, 0, 0); PG8_STAGE(PG8_SA(1, 1), a1 + hstep, voffA);
            PG8_WAIT_V(8); PG8_WAIT_L(0); PG8_BAR; PG8_MMA(0, 0, At, B0); PG8_MMA(0, 1, At, B1); PG8_BAR; PG8_SCHED;
            PG8_LDA(At, 0, 1); PG8_STAGE(PG8_SB(0, 0), b2, voffB); PG8_STAGE(PG8_SB(0, 1), b2 + hstep, voffB); PG8_STAGE(PG8_SA(0, 0), a2, voffA);
            PG8_WAIT_V(8); PG8_WAIT_L(0); PG8_BAR; PG8_MMA(1, 0, At, B0); PG8_MMA(1, 1, At, B1); PG8_BAR; PG8_SCHED;
            PG8_LDB(B0, 1, 0); PG8_LDB(B1, 1, 1); PG8_SCHED; PG8_LDA(At, 1, 0); PG8_STAGE(PG8_SA(0, 1), a2 + hstep, voffA);
            PG8_WAIT_V(8); PG8_WAIT_L(0); PG8_BAR; PG8_MMA(0, 0, At, B0); PG8_MMA(0, 1, At, B1); PG8_BAR; PG8_SCHED;
            PG8_LDA(At, 1, 1); PG8_STAGE(PG8_SB(1, 0), b3, voffB); PG8_STAGE(PG8_SB(1, 1), b3 + hstep, voffB); PG8_STAGE(PG8_SA(1, 0), a3, voffA);
            PG8_WAIT_V(8); PG8_WAIT_L(0); PG8_BAR; PG8_MMA(1, 0, At, B0); PG8_MMA(1, 1, At, B1); PG8_BAR; PG8_SCHED;
            } else {
            PG8_LDB(B0, 0, 0); PG8_SCHED; PG8_LDA(At, 0, 0); PG8_STAGE(PG8_SA(1, 1), a1 + hstep, voffA);
            PG8_WAIT_L(8); PG8_BAR; PG8_WAIT_L(0); PG8_MMA(0, 0, At, B0); PG8_BAR; PG8_SCHED;
            PG8_LDB(B1, 0, 1); PG8_STAGE(PG8_SB(0, 0), b2, voffB);
            PG8_BAR; PG8_WAIT_L(0); PG8_MMA(0, 1, At, B1); PG8_BAR;
            PG8_LDA(At, 0, 1); PG8_STAGE(PG8_SA(0, 0), a2, voffA);
            PG8_BAR; PG8_WAIT_L(0); PG8_MMA(1, 0, At, B0); PG8_BAR; PG8_SCHED;
            PG8_STAGE(PG8_SB(0, 1), b2 + hstep, voffB);
            PG8_WAIT_V(6); PG8_BAR; PG8_MMA(1, 1, At, B1); PG8_BAR;
            PG8_LDB(B0, 1, 0); PG8_SCHED; PG8_LDA(At, 1, 0); PG8_STAGE(PG8_SA(0, 1), a2 + hstep, voffA);
            PG8_WAIT_L(8); PG8_BAR; PG8_WAIT_L(0); PG8_MMA(0, 0, At, B0); PG8_BAR; PG8_SCHED;
            PG8_LDB(B1, 1, 1); PG8_STAGE(PG8_SB(1, 0), b3, voffB);
            PG8_BAR; PG8_WAIT_L(0); PG8_MMA(0, 1, At, B1); PG8_BAR;
            PG8_LDA(At, 1, 1); PG8_STAGE(PG8_SA(1, 0), a3, voffA);
            PG8_BAR; PG8_WAIT_L(0); PG8_MMA(1, 0, At, B0); PG8_BAR; PG8_SCHED;
            PG8_STAGE(PG8_SB(1, 1), b3 + hstep, voffB);
            PG8_WAIT_V(6); PG8_BAR; PG8_MMA(1, 1, At, B1); PG8_BAR;
            }
        }
        if constexpr (ALIGN_EPI) { if (wr == 0) PG8_BAR; }
        if constexpr (!Epi::AFTER_DRAIN) { E(acc, cur, wr, wc, fr, fq); S.done(cur); }
        if (!has_next) break;
#pragma unroll
        for (int a = 0; a < 2; ++a)
#pragma unroll
            for (int b = 0; b < 2; ++b)
#pragma unroll
                for (int m = 0; m < 4; ++m)
#pragma unroll
                    for (int n = 0; n < 2; ++n) acc[a][b][m][n] = (f32x4){0.f, 0.f, 0.f, 0.f};
        cur = nxt; cA = nA; cB = nB; ++ui;
        if constexpr (ALIGN_EPI) { if (wr == 1) PG8_BAR; }
    }
    PG8_WAIT_V(0);
    if constexpr (!ALIGN_EPI) { if (wr == 0) PG8_BAR; }
    PG8_BAR;
    if constexpr (Epi::AFTER_DRAIN) { E.fused(acc, cur, wr, wc, fr, fq, lds, wid, lane); S.done(cur); }
#undef PG8_SA
#undef PG8_SB
#undef PG8_STAGE
#undef PG8_LDA
#undef PG8_LDB
#undef PG8_MMA
#undef PG8_WAIT_V
#undef PG8_WAIT_L
#undef PG8_BAR
#undef PG8_SCHED
}
}
#include <cmath>
constexpr int NWAVES = 8, NTHR = 512;
constexpr int BATCH = 16, SEQ = 2048, M = BATCH * SEQ, D = 1024, FF = 4096, NAB = 3840, NC = 3072, ABP_OLD = 3672;
constexpr int C_QA = 0, C_KA = 512, C_VA = 1024, C_IQ = 1536, C_QB = 2048, C_KB = 2304, C_VB = 2560, C_OG = 3072, C_IK = 3584, C_IW = 3648, C_GL = 3656;
constexpr float EPS = 1e-6f;
constexpr size_t MiB = 1u << 20;
constexpr size_t WS_CTL = 0, CTL_ZERO_BYTES = 1 * MiB;
constexpr size_t WS_WAB = 1 * MiB, WS_WOAB = 9 * MiB, WS_WUP0 = 11 * MiB, WS_WDN0 = 19 * MiB, WS_WINC = 27 * MiB, WS_WOC = 33 * MiB, WS_WUP1 = 35 * MiB, WS_WDN1 = 43 * MiB;
constexpr size_t WS_SSQ = 51 * MiB, SSQ_BYTES = 2 * MiB;
constexpr size_t WS_DEC = 59 * MiB;
constexpr size_t WS_ROPE = 59 * MiB + 512 * 1024;
constexpr size_t WS_XB = 60 * MiB;
constexpr size_t WS_CAT = 124 * MiB;
constexpr size_t WS_MASK = 188 * MiB;
constexpr size_t WS_R1 = 196 * MiB;
constexpr size_t WS_END = 452 * MiB;
constexpr int CW_BAR = 4096;
constexpr int RING_BYTES = 131072;
constexpr int LDS_BYTES = 163840;
constexpr int MISC_OFF = LDS_BYTES - 256;
#define GAS __attribute__((address_space(1)))
#define LAS __attribute__((address_space(3)))
typedef unsigned short bf16;
typedef unsigned v4u __attribute__((ext_vector_type(4)));
typedef float f32x4 __attribute__((ext_vector_type(4)));
typedef short bf16x8 __attribute__((ext_vector_type(8)));
typedef GAS unsigned gu32;
typedef GAS unsigned long long gu64;
#define RLX_AGENT __ATOMIC_RELAXED, __HIP_MEMORY_SCOPE_AGENT
#define LDS_WAIT() asm volatile("s_waitcnt lgkmcnt(0)" ::: "memory")
#define VM_WAIT() asm volatile("s_waitcnt vmcnt(0)" ::: "memory")
__device__ __forceinline__ unsigned long long rt() { return __builtin_amdgcn_s_memrealtime(); }
__device__ __forceinline__ unsigned f2bf(float f) { unsigned u = __builtin_bit_cast(unsigned, f); return (u + 0x7fffu + ((u >> 16) & 1u)) >> 16; }
__device__ __forceinline__ unsigned pk2(float lo, float hi) { return f2bf(lo) | (f2bf(hi) << 16); }
#define XB_TMO      128
#define XB_XCNT(j)  (256  + 64 * (j))
#define XB_XSUB(j)  (1280 + 64 * (j))
#define XB_XGEN(j)  (2304 + 64 * (j))
#define XB_TOP      3328
#define XB_TOPGEN   3392
#define XCD_BAR_WORDS 3456
#define XB_SPIN_CAP (1u << 18)

__device__ __forceinline__ unsigned xb_ld(unsigned* p)              { return __hip_atomic_load(p, __ATOMIC_RELAXED, __HIP_MEMORY_SCOPE_AGENT); }
__device__ __forceinline__ unsigned xb_add(unsigned* p, unsigned v) { return __hip_atomic_fetch_add(p, v, __ATOMIC_RELAXED, __HIP_MEMORY_SCOPE_AGENT); }
__device__ __forceinline__ unsigned xb_xcc_id() { return (unsigned)__builtin_amdgcn_s_getreg((3 << 11) | 20) & 0xFu; }
#define XB_SPIN(cond, bar) do { unsigned _sp = 0; while (cond) { __builtin_amdgcn_s_sleep(1); \
    if ((++_sp & 255u) == 0u) { if (xb_ld(&(bar)[XB_TMO])) break; if (_sp > XB_SPIN_CAP) { atomicAdd(&(bar)[XB_TMO], 1u); break; } } } } while (0)

struct XcdBarrier {
    unsigned* bar; unsigned x; int wave;
    volatile LAS unsigned* st;
};

__device__ __forceinline__ bool xb_t0(int wave) { return wave == 0 && __builtin_amdgcn_mbcnt_hi(~0u, __builtin_amdgcn_mbcnt_lo(~0u, 0u)) == 0u; }
__device__ __forceinline__ XcdBarrier xcd_barrier_post(unsigned* bar, volatile LAS unsigned* st, int wave) {
    XcdBarrier b; b.bar = bar; b.x = xb_xcc_id(); b.st = st; b.wave = wave;
    if (xb_t0(wave)) (void)xb_add(&bar[XB_XCNT(b.x)], 1u);
    return b;
}
__device__ __forceinline__ void xcd_barrier_complete(unsigned* bar, unsigned x, unsigned& nloc, unsigned& nx) {
    const unsigned G = gridDim.x * gridDim.y * gridDim.z;
    unsigned sum, cnt, mine, sp = 0u;
    for (;;) {
        sum = 0u; cnt = 0u; mine = 0u;
#pragma unroll
        for (unsigned j = 0; j < 16; ++j) { const unsigned c = xb_ld(&bar[XB_XCNT(j)]); sum += c; cnt += (c > 0u) ? 1u : 0u; mine = (j == x) ? c : mine; }
        if (sum == G) break;
        __builtin_amdgcn_s_sleep(1);
        if ((++sp & 255u) == 0u) { if (xb_ld(&bar[XB_TMO])) break; if (sp > XB_SPIN_CAP) { atomicAdd(&bar[XB_TMO], 1u); break; } }
    }
    nloc = mine > 0u ? mine : 1u; nx = cnt > 0u ? cnt : 1u;
}

__device__ __forceinline__ void xcd_barrier(const XcdBarrier& b) {
    asm volatile("s_waitcnt vmcnt(0)" ::: "memory");
    __syncthreads();
    if (xb_t0(b.wave)) {
        unsigned* bar = b.bar;
        __builtin_amdgcn_s_waitcnt(0);
        unsigned nloc = b.st[0], nx = b.st[1];
        if (nloc == 0u) { xcd_barrier_complete(bar, b.x, nloc, nx); b.st[0] = nloc; b.st[1] = nx; }
        const unsigned old = xb_add(&bar[XB_XSUB(b.x)], 1u);
        const unsigned gen = old / nloc;
        if (old + 1u == (gen + 1u) * nloc) {
            __builtin_amdgcn_fence(__ATOMIC_RELEASE, "agent");
            asm volatile("s_waitcnt vmcnt(0)" ::: "memory");
            const unsigned og = xb_add(&bar[XB_TOP], 1u);
            const unsigned tg = og / nx;
            if (og + 1u == (tg + 1u) * nx) xb_add(&bar[XB_TOPGEN], 1u);
            else XB_SPIN(xb_ld(&bar[XB_TOPGEN]) == tg, bar);
            __builtin_amdgcn_fence(__ATOMIC_ACQUIRE, "agent");
            xb_add(&bar[XB_XGEN(b.x)], 1u);
            asm volatile("s_waitcnt vmcnt(0)" ::: "memory");
        } else {
            XB_SPIN(xb_ld(&bar[XB_XGEN(b.x)]) == gen, bar);
            __builtin_amdgcn_fence(__ATOMIC_ACQUIRE, "agent");
            asm volatile("s_waitcnt vmcnt(0)" ::: "memory");
        }
    }
    __syncthreads();
}
struct Frame {
    LAS unsigned char* lds;
    volatile LAS unsigned* MISC;
    gu32* ctl;
    int tid, lane, wave, vcu, G;
    const float *x, *g_mix, *g_ffn, *w_in_ab, *gq_a, *gk_a, *w_gate_up, *b_gate, *g_gla, *w_out_ab, *w_in_c, *gq_c, *gk_c, *w_out_c, *w_up, *w_down;
    float* out;
    bf16 *Wab, *Woab, *Wup0, *Wdn0, *Winc, *Woc, *Wup1, *Wdn1;
    bf16 *XB, *CAT, *R1;
    float* SSQ; unsigned* MASK;
};
__device__ __forceinline__ float bf2f(bf16 v) { return __builtin_bit_cast(float, (unsigned)v << 16); }
__device__ __forceinline__ float wave_sum(float v) {
#pragma unroll
    for (int o = 1; o < 64; o <<= 1) v += __shfl_xor(v, o);
    return v;
}
__device__ __forceinline__ float wave_max(float v) {
#pragma unroll
    for (int o = 1; o < 64; o <<= 1) v = fmaxf(v, __shfl_xor(v, o));
    return v;
}
__device__ __forceinline__ float log_sigmoid(float x) { return fminf(x, 0.f) - log1pf(expf(-fabsf(x))); }

__device__ __forceinline__ int oldcol_ab(int n) {
    if (n < 2048) return n;
    if (n < 2304) return 2120 + (n - 2048);
    if (n < 2560) return 2376 + (n - 2304);
    if (n < 3072) return 2632 + (n - 2560);
    if (n < 3584) return 3160 + (n - 3072);
    if (n < 3648) return 2048 + (n - 3584);
    if (n < 3656) return 2112 + (n - 3648);
    if (n < 3672) return 3144 + (n - 3656);
    return -1;
}
__device__ __forceinline__ void p0_transpose_item(const float* W, int ldw, int K, const float* gain, bf16* WT, bool map, LAS float* scr, int item, int nblk, int lane) {
    const int kb = item / nblk, nb = item % nblk, k0 = 64 * kb, n0 = 32 * nb;
    int oc = n0 + (lane & 31); if (map) oc = oldcol_ab(oc);
#pragma unroll 8
    for (int i = 0; i < 32; ++i) { const int kk = 2 * i + (lane >> 5); float v = 0.f;
        if (oc >= 0) { v = W[(size_t)(k0 + kk) * ldw + oc]; if (gain) v *= gain[k0 + kk]; }
        scr[kk * 33 + (lane & 31)] = v; }
    LDS_WAIT(); asm volatile("" ::: "memory");
    const int c = lane & 7;
#pragma unroll
    for (int j = 0; j < 4; ++j) { const int n = (lane >> 3) + 8 * j; const LAS float* s = scr + (8 * c) * 33 + n;
        v4u o; o.x = pk2(s[0 * 33], s[1 * 33]); o.y = pk2(s[2 * 33], s[3 * 33]); o.z = pk2(s[4 * 33], s[5 * 33]); o.w = pk2(s[6 * 33], s[7 * 33]);
        *(GAS v4u*)(WT + (size_t)(n0 + n) * K + k0 + 8 * c) = o; }
    LDS_WAIT(); asm volatile("" ::: "memory");
}
__device__ __forceinline__ void ph_prologue(Frame& F) {
    LAS float* scr = (LAS float*)(F.lds + F.wave * 16384);
    const int gw = F.vcu * NWAVES + F.wave, NGW = F.G * NWAVES;
    constexpr int I_AB = (D / 64) * (NAB / 32), I_O = (D / 64) * (D / 32), I_UP = (D / 64) * (FF / 32), I_DN = (FF / 64) * (D / 32), I_C = (D / 64) * (NC / 32);
    constexpr int NITEMS = I_AB + 2 * I_O + 2 * I_UP + 2 * I_DN + I_C;
    for (int it = gw; it < NITEMS; it += NGW) {
        int r = it;
        if (r < I_AB) { p0_transpose_item(F.w_in_ab, ABP_OLD, D, F.g_mix, F.Wab, true, scr, r, NAB / 32, F.lane); continue; } r -= I_AB;
        if (r < I_O) { p0_transpose_item(F.w_out_ab, D, D, nullptr, F.Woab, false, scr, r, D / 32, F.lane); continue; } r -= I_O;
        if (r < I_UP) { p0_transpose_item(F.w_up, FF, D, F.g_ffn, F.Wup0, false, scr, r, FF / 32, F.lane); continue; } r -= I_UP;
        if (r < I_DN) { p0_transpose_item(F.w_down, D, FF, nullptr, F.Wdn0, false, scr, r, D / 32, F.lane); continue; } r -= I_DN;
        if (r < I_C) { p0_transpose_item(F.w_in_c, NC, D, F.g_mix + D, F.Winc, false, scr, r, NC / 32, F.lane); continue; } r -= I_C;
        if (r < I_O) { p0_transpose_item(F.w_out_c, D, D, nullptr, F.Woc, false, scr, r, D / 32, F.lane); continue; } r -= I_O;
        if (r < I_UP) { p0_transpose_item(F.w_up + (size_t)D * FF, FF, D, F.g_ffn + D, F.Wup1, false, scr, r, FF / 32, F.lane); continue; } r -= I_UP;
        p0_transpose_item(F.w_down + (size_t)FF * D, D, FF, nullptr, F.Wdn1, false, scr, r, D / 32, F.lane);
    }
    for (int m = gw; m < M; m += NGW) {
        const GAS f32x4* xr = (const GAS f32x4*)(F.x + (size_t)m * D) + F.lane;
        f32x4 v[4]; float s = 0.f;
#pragma unroll
        for (int j = 0; j < 4; ++j) { v[j] = xr[64 * j]; s += (v[j].x * v[j].x + v[j].y * v[j].y) + (v[j].z * v[j].z + v[j].w * v[j].w); }
        s = wave_sum(s);
        GAS unsigned long long* o8 = (GAS unsigned long long*)(F.XB + (size_t)m * D) + F.lane;
#pragma unroll
        for (int j = 0; j < 4; ++j) o8[64 * j] = (unsigned long long)pk2(v[j].x, v[j].y) | ((unsigned long long)pk2(v[j].z, v[j].w) << 32);
        if (F.lane < 16) F.SSQ[(size_t)m * 16 + F.lane] = (F.lane == 0) ? s : 0.f;
    }
}
namespace att {
typedef short s16x4 __attribute__((ext_vector_type(4)));
typedef float f32x16 __attribute__((ext_vector_type(16)));
typedef _Float16 f16x8 __attribute__((ext_vector_type(8)));
typedef unsigned u32x4 __attribute__((ext_vector_type(4)));
typedef short v4i16_t __attribute__((ext_vector_type(4)));
constexpr float C2 = 0.08838834764831845f * 1.4426950408889634f;
__device__ __forceinline__ int crow(int r, int hi) { return (r & 3) + 8 * (r >> 2) + 4 * hi; }
__device__ __forceinline__ int img_off(int row, int ch) { return 256 * row + 16 * (ch ^ (((row & 3) << 2) | ((row >> 2) & 3))); }
__device__ __forceinline__ bf16x8 pack8(float a0, float a1, float a2, float a3, float a4, float a5, float a6, float a7) {
    u32x4 w; w.x = pg8::cvt_pk_bf16(a0, a1); w.y = pg8::cvt_pk_bf16(a2, a3); w.z = pg8::cvt_pk_bf16(a4, a5); w.w = pg8::cvt_pk_bf16(a6, a7);
    return __builtin_bit_cast(bf16x8, w);
}
__device__ __forceinline__ f16x8 pack8h(float a0, float a1, float a2, float a3, float a4, float a5, float a6, float a7) {
    f16x8 r; r[0] = (_Float16)a0; r[1] = (_Float16)a1; r[2] = (_Float16)a2; r[3] = (_Float16)a3; r[4] = (_Float16)a4; r[5] = (_Float16)a5; r[6] = (_Float16)a6; r[7] = (_Float16)a7; return r;
}
__device__ __forceinline__ void dma_off_init(unsigned (&dvo)[2], int ld, int wave, int lane) {
#pragma unroll
    for (int i = 0; i < 2; ++i) { const int pi = 2 * wave + i, row = 4 * pi + (lane >> 4), pc = lane & 15, ch = pc ^ (((row & 3) << 2) | ((row >> 2) & 3)); dvo[i] = (unsigned)(row * ld + ch * 8) * 2u; }
}
__device__ __forceinline__ void tile_dma(const bf16* g, const unsigned (&dvo)[2], LAS unsigned char* buf, int wave) {
#pragma unroll
    for (int i = 0; i < 2; ++i) __builtin_amdgcn_global_load_lds((const unsigned*)((const char*)g + dvo[i]), (LAS unsigned*)(buf + 1024 * (2 * wave + i)), 16, 0, 0);
}
struct FragOff { int k[8]; int va[4]; int vd; };
__device__ __forceinline__ void frag_off_init(FragOff& fo, int lane) {
    const int hi = lane >> 5, r32 = lane & 31, i = lane & 15, q = i >> 2, p = i & 3, x = 2 * ((lane >> 4) & 1) + (p >> 1);
#pragma unroll
    for (int ks = 0; ks < 8; ++ks) fo.k[ks] = img_off(r32, 2 * ks + hi);
#pragma unroll
    for (int ct = 0; ct < 4; ++ct) fo.va[ct] = img_off(4 * hi + q, 4 * ct + x) + 8 * (p & 1);
    fo.vd = img_off(4 * hi + q + 8, x) - img_off(4 * hi + q, x);
}
__device__ __forceinline__ bf16x8 k_frag(const LAS unsigned char* kbuf, const FragOff& fo, int rt, int ks) { return *(const LAS bf16x8*)(kbuf + fo.k[ks] + 8192 * rt); }
__device__ __forceinline__ s16x4 vtr(const LAS unsigned char* p) { return __builtin_bit_cast(s16x4, __builtin_amdgcn_ds_read_tr16_b64_v4i16((LAS v4i16_t*)p)); }
__device__ __forceinline__ bf16x8 v_frag(const LAS unsigned char* vbuf, const FragOff& fo, int ct, int kk) {
    const s16x4 lo = vtr(vbuf + fo.va[ct] + 4096 * kk), hh = vtr(vbuf + fo.va[ct] + fo.vd + 4096 * kk);
    return (bf16x8){lo[0], lo[1], lo[2], lo[3], hh[0], hh[1], hh[2], hh[3]};
}
__device__ __forceinline__ int frag_va(int lane, int ct) { const int hi = lane >> 5, i = lane & 15, q = i >> 2, p = i & 3, x = 2 * ((lane >> 4) & 1) + (p >> 1); return img_off(4 * hi + q, 4 * ct + x) + 8 * (p & 1); }
__device__ __forceinline__ bf16x8 v_frag_rt(const LAS unsigned char* vbuf, int va, int vd, int kk) {
    const s16x4 lo = vtr(vbuf + va + 4096 * kk), hh = vtr(vbuf + va + vd + 4096 * kk);
    return (bf16x8){lo[0], lo[1], lo[2], lo[3], hh[0], hh[1], hh[2], hh[3]};
}
__device__ __forceinline__ void store_o(const f32x16 (&o)[4], const float (&rscale)[16], LAS unsigned char* stg, bf16* dst, int ld, int lane) {
    const int hi = lane >> 5, r32 = lane & 31;
#pragma unroll
    for (int r = 0; r < 16; ++r) { const int orow = crow(r, hi);
#pragma unroll
        for (int ct = 0; ct < 4; ++ct) *(LAS bf16*)(stg + orow * 256 + (32 * ct + r32) * 2) = (bf16)f2bf(o[ct][r] * rscale[r]); }
    asm volatile("s_waitcnt lgkmcnt(0)" ::: "memory");
#pragma unroll
    for (int i = 0; i < 8; ++i) { const int c = lane + 64 * i, row = c >> 4, ch = c & 15; const u32x4 v = *(const LAS u32x4*)(stg + row * 256 + ch * 16); *(u32x4*)(dst + (size_t)row * ld + ch * 8) = v; }
}
}
template <bool SCALEQ> __device__ __forceinline__ void ph_prep_a(Frame& F) {
    const int gw = F.vcu * NWAVES + F.wave, NGW = F.G * NWAVES, lane = F.lane;
    for (int tok = gw; tok < M; tok += NGW) {
        const float pos = (float)(tok & (SEQ - 1));
        bf16* pr = F.R1 + (size_t)tok * NAB;
        float c128 = 1.f, s128 = 0.f;
        if (lane < 32) { const int i = lane & 15; const float inv = powf(500000.0f, -(float)i * 2.0f / 32.0f); const float ang = pos * inv; c128 = cosf(ang); s128 = sinf(ang); }
#pragma unroll
        for (int which = 0; which < 2; ++which) {
            const int base = which == 0 ? C_QA : C_KA;
            const float* gn = which == 0 ? F.gq_a : F.gk_a;
            for (int h = 0; h < 4; ++h) {
                float a = bf2f(pr[base + h * 128 + lane]), b = bf2f(pr[base + h * 128 + 64 + lane]);
                const float ss = wave_sum(a * a + b * b);
                const float rs = rsqrtf(ss * (1.f / 128.f) + EPS);
                const float qs = (SCALEQ && which == 0) ? att::C2 : 1.0f;
                a = a * rs * gn[lane] * qs; b = b * rs * gn[64 + lane] * qs;
                const float other = __shfl_xor(a, 16);
                float o = a;
                if (lane < 16) o = a * c128 - other * s128;
                else if (lane < 32) o = a * c128 + other * s128;
                pr[base + h * 128 + lane] = (bf16)f2bf(o); pr[base + h * 128 + 64 + lane] = (bf16)f2bf(b);
            }
        }
        float c64 = 1.f, s64 = 0.f;
        if (lane < 16) { const int i = lane & 7; const float inv = powf(500000.0f, -(float)i * 2.0f / 16.0f); const float ang = pos * inv; c64 = cosf(ang); s64 = sinf(ang); }
        for (int h = 0; h < 9; ++h) {
            const int col = (h < 8) ? C_IQ + h * 64 : C_IK;
            const float a = bf2f(pr[col + lane]);
            const float other = __shfl_xor(a, 8);
            float o = a;
            if (lane < 8) o = a * c64 - other * s64;
            else if (lane < 16) o = a * c64 + other * s64;
            pr[col + lane] = (bf16)f2bf(o);
        }
    }
}
__device__ __forceinline__ void ph_indexer_naive(Frame& F) {
    LAS float* sc = (LAS float*)F.lds;
    LAS float* qv = sc + 2048;
    LAS float* wv = qv + 512;
    LAS unsigned* mw = (LAS unsigned*)(wv + 8);
    const int tid = F.tid;
    for (int tok = F.vcu; tok < M; tok += F.G) {
        const int pos = tok & (SEQ - 1), seq0 = tok - pos, limit = ((pos >> 6) + 1) << 6;
        const bf16* pr = F.R1 + (size_t)tok * NAB;
        qv[tid] = bf2f(pr[C_IQ + tid]);
        if (tid < 8) wv[tid] = bf2f(pr[C_IW + tid]) * 0.35355339059327373f;
        if (tid < 64) mw[tid] = 0u;
        __syncthreads();
        for (int s = tid; s < limit; s += NTHR) {
            const bf16* kp = F.R1 + (size_t)(seq0 + s) * NAB + C_IK;
            float acc[8];
#pragma unroll
            for (int h = 0; h < 8; ++h) acc[h] = 0.f;
            for (int d = 0; d < 64; ++d) { const float kd = bf2f(kp[d]);
#pragma unroll
                for (int h = 0; h < 8; ++h) acc[h] = fmaf(qv[h * 64 + d], kd, acc[h]); }
            float score = 0.f;
#pragma unroll
            for (int h = 0; h < 8; ++h) score += fmaxf(acc[h] * 0.125f, 0.f) * wv[h];
            sc[s] = score;
        }
        __syncthreads();
        if (limit <= 256) { if (tid < 64) mw[tid] = (tid * 32 < limit) ? 0xffffffffu : 0u; }
        else {
            for (int s = tid; s < limit; s += NTHR) {
                const float v = sc[s]; int cnt = 0;
                for (int j = 0; j < limit; ++j) { const float u = sc[j]; cnt += ((u > v) || (u == v && j < s)) ? 1 : 0; }
                if (cnt < 256) atomicOr((unsigned*)&mw[s >> 5], 1u << (s & 31));
            }
        }
        __syncthreads();
        if (tid < 64) F.MASK[(size_t)tok * 64 + tid] = mw[tid];
        __syncthreads();
    }
}
__device__ __forceinline__ float block_sum(float v, LAS float* red, int tid) {
    v = wave_sum(v);
    __syncthreads();
    if ((tid & 63) == 0) red[tid >> 6] = v;
    __syncthreads();
    float r = 0.f;
#pragma unroll
    for (int i = 0; i < NWAVES; ++i) r += red[i];
    return r;
}
__device__ __forceinline__ float block_max(float v, LAS float* red, int tid) {
    v = wave_max(v);
    __syncthreads();
    if ((tid & 63) == 0) red[tid >> 6] = v;
    __syncthreads();
    float r = red[0];
#pragma unroll
    for (int i = 1; i < NWAVES; ++i) r = fmaxf(r, red[i]);
    return r;
}
__device__ __forceinline__ void ph_dsa_naive(Frame& F) {
    LAS unsigned* mw = (LAS unsigned*)F.lds;
    LAS int* pre = (LAS int*)(mw + 64);
    LAS int* idx = pre + 128;
    LAS float* pp = (LAS float*)(idx + 256);
    LAS float* q = pp + 512;
    LAS float* red = q + 512;
    const int tid = F.tid;
    for (int tok = F.vcu; tok < M; tok += F.G) {
        const int pos = tok & (SEQ - 1), seq0 = tok - pos;
        if (tid < 64) mw[tid] = F.MASK[(size_t)tok * 64 + tid];
        q[tid] = bf2f(F.R1[(size_t)tok * NAB + C_QA + tid]);
        __syncthreads();
        if (tid == 0) { int a = 0; for (int w = 0; w < 64; ++w) { pre[w] = a; a += __popc(mw[w]); } pre[64] = a; }
        __syncthreads();
        const int n = pre[64];
        for (int s = tid; s < SEQ; s += NTHR) { const unsigned w = mw[s >> 5]; if ((w >> (s & 31)) & 1u) idx[pre[s >> 5] + __popc(w & ((1u << (s & 31)) - 1u))] = s; }
        __syncthreads();
        for (int h = 0; h < 4; ++h) {
            float sv = -INFINITY;
            if (tid < n) { const bf16* kp = F.R1 + (size_t)(seq0 + idx[tid]) * NAB + C_KA + h * 128; float a = 0.f;
                for (int d = 0; d < 128; ++d) a = fmaf(q[h * 128 + d], bf2f(kp[d]), a);
                sv = a * 0.08838834764831845f; }
            const float m = block_max(sv, red, tid);
            const float e = (tid < n) ? expf(sv - m) : 0.f;
            const float l = block_sum(e, red, tid);
            pp[tid] = e;
            __syncthreads();
            if (tid < 128) { float o = 0.f;
                for (int j = 0; j < n; ++j) o = fmaf(pp[j], bf2f(F.R1[(size_t)(seq0 + idx[j]) * NAB + C_VA + h * 128 + tid]), o);
                F.CAT[(size_t)tok * D + h * 128 + tid] = (bf16)f2bf(o / l); }
            __syncthreads();
        }
    }
}
__device__ __forceinline__ void ph_gla_naive(Frame& F) {
    LAS float* sq = (LAS float*)F.lds; LAS float* sk = sq + 1024; LAS float* sd = sk + 1024;
    LAS float* sg = sd + 1024;
    LAS float* red = sg + 256;
    const int tid = F.tid, lane = F.lane;
    for (int item = F.vcu; item < BATCH * 4; item += F.G) {
        const int b = item >> 2, h = item & 3, seq0 = b * SEQ;
        float S[64];
#pragma unroll
        for (int d = 0; d < 64; ++d) S[d] = 0.f;
        for (int t0 = 0; t0 < SEQ; t0 += 16) {
            if (tid < 256) { const int tt = tid >> 4, r = tid & 15; sg[tid] = bf2f(F.R1[(size_t)(seq0 + t0 + tt) * NAB + C_GL + r]); }
            __syncthreads();
            for (int i = tid; i < 1024; i += NTHR) { const int tt = i >> 6, d = i & 63; const bf16* pr = F.R1 + (size_t)(seq0 + t0 + tt) * NAB;
                sq[i] = bf2f(pr[C_QB + h * 64 + d]) * 0.125f; sk[i] = bf2f(pr[C_KB + h * 64 + d]);
                float g = F.b_gate[h * 64 + d];
#pragma unroll
                for (int r = 0; r < 16; ++r) g = fmaf(sg[tt * 16 + r], F.w_gate_up[r * 256 + h * 64 + d], g);
                sd[i] = expf(log_sigmoid(g) * (1.f / 16.f)); }
            __syncthreads();
            float o[16];
            if (tid < 128) {
#pragma unroll
                for (int tt = 0; tt < 16; ++tt) {
                    const float v = bf2f(F.R1[(size_t)(seq0 + t0 + tt) * NAB + C_VB + h * 128 + tid]); float a = 0.f;
#pragma unroll
                    for (int d = 0; d < 64; ++d) { S[d] = fmaf(sd[tt * 64 + d], S[d], sk[tt * 64 + d] * v); a = fmaf(sq[tt * 64 + d], S[d], a); }
                    o[tt] = a;
                    const float ws = wave_sum(a * a);
                    if (lane == 0) red[tt * 2 + (tid >> 6)] = ws;
                }
            }
            __syncthreads();
            if (tid < 128) {
#pragma unroll
                for (int tt = 0; tt < 16; ++tt) {
                    const size_t tok = seq0 + t0 + tt;
                    const float rs = rsqrtf((red[tt * 2] + red[tt * 2 + 1]) * (1.f / 128.f) + EPS);
                    const float og = bf2f(F.R1[tok * NAB + C_OG + h * 128 + tid]);
                    F.CAT[tok * D + 512 + h * 128 + tid] = (bf16)f2bf(o[tt] * rs * F.g_gla[tid] * (og / (1.f + expf(-og))));
                }
            }
            __syncthreads();
        }
    }
}
template <bool SCALEQ> __device__ __forceinline__ void ph_prep_c(Frame& F) {
    const int gw = F.vcu * NWAVES + F.wave, NGW = F.G * NWAVES, lane = F.lane;
    for (int it = gw; it < M * 16; it += NGW) {
        const int tok = it >> 4, hh = it & 15, isk = hh >> 3, h = hh & 7;
        bf16* p = F.R1 + (size_t)tok * NC + isk * 1024 + h * 128;
        const float* gn = isk ? F.gk_c : F.gq_c;
        const float a = bf2f(p[lane]), b = bf2f(p[64 + lane]);
        const float rs = rsqrtf(wave_sum(a * a + b * b) * (1.f / 128.f) + EPS);
        const float sc = (SCALEQ && !isk) ? att::C2 : 1.0f;
        p[lane] = (bf16)f2bf(a * rs * gn[lane] * sc); p[64 + lane] = (bf16)f2bf(b * rs * gn[64 + lane] * sc);
    }
}
__device__ __forceinline__ void ph_sb_naive(Frame& F) {
    const int gw = F.vcu * NWAVES + F.wave, NGW = F.G * NWAVES, lane = F.lane;
    for (int it = gw; it < M * 8; it += NGW) {
        const int tok = it >> 3, h = it & 7, pos = tok & (SEQ - 1), seq0 = tok - pos;
        const unsigned qq = *(const unsigned*)(F.R1 + (size_t)tok * NC + h * 128 + 2 * lane);
        const float q0 = __builtin_bit_cast(float, qq << 16), q1 = __builtin_bit_cast(float, qq & 0xffff0000u);
        float R = 0.f, o0 = 0.f, o1 = 0.f;
        for (int s = pos - 1; s >= 0; --s) {
            const bf16* pr = F.R1 + (size_t)(seq0 + s) * NC + h * 128 + 2 * lane;
            const unsigned kk = *(const unsigned*)(pr + 1024), vv = *(const unsigned*)(pr + 2048);
            const float k0 = __builtin_bit_cast(float, kk << 16), k1 = __builtin_bit_cast(float, kk & 0xffff0000u);
            const float z = wave_sum(q0 * k0 + q1 * k1) * 0.08838834764831845f;
            const float sp = log1pf(expf(-fabsf(z)));
            const float lsp = fminf(z, 0.f) - sp, lsn = fminf(-z, 0.f) - sp;
            const float a = expf(lsp + R);
            o0 = fmaf(a, __builtin_bit_cast(float, vv << 16), o0); o1 = fmaf(a, __builtin_bit_cast(float, vv & 0xffff0000u), o1);
            R += lsn;
        }
        *(unsigned*)(F.CAT + (size_t)tok * D + h * 128 + 2 * lane) = pk2(o0, o1);
    }
}
__device__ __forceinline__ void sb_unit(Frame& F, int b, int h, int qb) {
    using namespace att;
    const int tid = F.tid, lane = F.lane, w = F.wave, hi = lane >> 5, r32 = lane & 31;
    const bf16* Qg = F.R1 + (size_t)b * SEQ * NC + h * 128; const bf16* Kg = Qg + 1024; const bf16* Vg = Qg + 2048;
    const int T0 = qb * 256, t0w = T0 + 32 * w, jd = t0w >> 6, jtop = (T0 >> 6) + 3, tl = 32 * (w & 1) + r32;
    LAS unsigned char* lds = F.lds;
    FragOff fo; frag_off_init(fo, lane);
    unsigned dvo[2]; dma_off_init(dvo, NC, w, lane);
    bf16x8 qf[8];
#pragma unroll
    for (int ks = 0; ks < 8; ++ks) qf[ks] = *(const bf16x8*)(Qg + (size_t)(t0w + r32) * NC + 16 * ks + 8 * hi);
    f16x8 T0f, T1f, ONEf;
#pragma unroll
    for (int j = 0; j < 8; ++j) { const int kp = 8 * (j >> 2) + 4 * hi + (j & 3); T0f[j] = (kp >= r32) ? (_Float16)1.0f : (_Float16)0.0f; T1f[j] = (kp + 16 >= r32) ? (_Float16)1.0f : (_Float16)0.0f; ONEf[j] = (_Float16)1.0f; }
    f32x16 o[4];
#pragma unroll
    for (int ct = 0; ct < 4; ++ct)
#pragma unroll
        for (int r = 0; r < 16; ++r) o[ct][r] = 0.f;
    float R2 = 0.f; bool done = false;
    volatile LAS unsigned* flags = F.MISC + 16;
    tile_dma(Kg + (size_t)(64 * jtop) * NC, dvo, lds, w); tile_dma(Vg + (size_t)(64 * jtop) * NC, dvo, lds + 16384, w);
    asm volatile("s_waitcnt vmcnt(0)" ::: "memory");
    __syncthreads();
    for (int j = jtop; j >= 0; --j) {
        const int cur = (jtop - j) & 1;
        const LAS unsigned char* kb = lds + cur * 32768; const LAS unsigned char* vb = kb + 16384;
        if (j > 0) { tile_dma(Kg + (size_t)(64 * (j - 1)) * NC, dvo, lds + (cur ^ 1) * 32768, w); tile_dma(Vg + (size_t)(64 * (j - 1)) * NC, dvo, lds + (cur ^ 1) * 32768 + 16384, w); }
        if (j <= jd && !done) {
            f32x16 p0, p1;
#pragma unroll
            for (int r = 0; r < 16; ++r) { p0[r] = 0.f; p1[r] = 0.f; }
#pragma unroll
            for (int ks = 0; ks < 8; ++ks) { const bf16x8 a0 = k_frag(kb, fo, 0, ks), a1 = k_frag(kb, fo, 1, ks);
                p0 = __builtin_amdgcn_mfma_f32_32x32x16_bf16(a0, qf[ks], p0, 0, 0, 0); p1 = __builtin_amdgcn_mfma_f32_32x32x16_bf16(a1, qf[ks], p1, 0, 0, 0); }
            const bool diag = (j == jd);
            float x0[16], x1[16]; float rs = 0.f;
#pragma unroll
            for (int r = 0; r < 16; ++r) { const int key = crow(r, hi);
                float l0 = -__builtin_amdgcn_logf(1.0f + __builtin_amdgcn_exp2f(p0[r])), l1 = -__builtin_amdgcn_logf(1.0f + __builtin_amdgcn_exp2f(p1[r]));
                if (diag) { if (!(key < tl)) l0 = 0.f; if (!(key + 32 < tl)) l1 = 0.f; }
                x0[r] = l0; x1[r] = l1; rs += l0 + l1; p0[r] += R2; p1[r] += R2; }
            const f16x8 xb00 = pack8h(x0[0], x0[1], x0[2], x0[3], x0[4], x0[5], x0[6], x0[7]), xb01 = pack8h(x0[8], x0[9], x0[10], x0[11], x0[12], x0[13], x0[14], x0[15]);
            const f16x8 xb10 = pack8h(x1[0], x1[1], x1[2], x1[3], x1[4], x1[5], x1[6], x1[7]), xb11 = pack8h(x1[8], x1[9], x1[10], x1[11], x1[12], x1[13], x1[14], x1[15]);
            p0 = __builtin_amdgcn_mfma_f32_32x32x16_f16(T0f, xb00, p0, 0, 0, 0); p0 = __builtin_amdgcn_mfma_f32_32x32x16_f16(T1f, xb01, p0, 0, 0, 0);
            p0 = __builtin_amdgcn_mfma_f32_32x32x16_f16(ONEf, xb10, p0, 0, 0, 0); p0 = __builtin_amdgcn_mfma_f32_32x32x16_f16(ONEf, xb11, p0, 0, 0, 0);
            p1 = __builtin_amdgcn_mfma_f32_32x32x16_f16(T0f, xb10, p1, 0, 0, 0); p1 = __builtin_amdgcn_mfma_f32_32x32x16_f16(T1f, xb11, p1, 0, 0, 0);
#pragma unroll
            for (int r = 0; r < 16; ++r) { const int key = crow(r, hi);
                float a0 = __builtin_amdgcn_exp2f(p0[r]), a1 = __builtin_amdgcn_exp2f(p1[r]);
                if (diag) { if (!(key < tl)) a0 = 0.f; if (!(key + 32 < tl)) a1 = 0.f; }
                p0[r] = a0; p1[r] = a1; }
            const bf16x8 pa0 = pack8(p0[0], p0[1], p0[2], p0[3], p0[4], p0[5], p0[6], p0[7]), pa1 = pack8(p0[8], p0[9], p0[10], p0[11], p0[12], p0[13], p0[14], p0[15]);
            const bf16x8 pa2 = pack8(p1[0], p1[1], p1[2], p1[3], p1[4], p1[5], p1[6], p1[7]), pa3 = pack8(p1[8], p1[9], p1[10], p1[11], p1[12], p1[13], p1[14], p1[15]);
#pragma unroll
            for (int ct = 0; ct < 4; ++ct) {
                o[ct] = __builtin_amdgcn_mfma_f32_32x32x16_bf16(pa0, v_frag(vb, fo, ct, 0), o[ct], 0, 0, 0);
                o[ct] = __builtin_amdgcn_mfma_f32_32x32x16_bf16(pa1, v_frag(vb, fo, ct, 1), o[ct], 0, 0, 0);
                o[ct] = __builtin_amdgcn_mfma_f32_32x32x16_bf16(pa2, v_frag(vb, fo, ct, 2), o[ct], 0, 0, 0);
                o[ct] = __builtin_amdgcn_mfma_f32_32x32x16_bf16(pa3, v_frag(vb, fo, ct, 3), o[ct], 0, 0, 0);
            }
            rs += __shfl_xor(rs, 32);
            R2 += rs;
            done = __all(R2 < -152.0f);
        }
        if (lane == 0) flags[cur * 8 + w] = done ? 1u : 0u;
        asm volatile("s_waitcnt vmcnt(0) lgkmcnt(0)" ::: "memory");
        __syncthreads();
        unsigned alld = 1u;
#pragma unroll
        for (int i = 0; i < 8; ++i) alld &= flags[cur * 8 + i];
        if (alld) break;
    }
    float ones[16];
#pragma unroll
    for (int r = 0; r < 16; ++r) ones[r] = 1.0f;
    store_o(o, ones, lds + w * 8192, F.CAT + (size_t)(b * SEQ + t0w) * D + h * 128, D, lane);
    __syncthreads();
}
__device__ __forceinline__ void ph_sb(Frame& F) {
    for (int v = F.vcu; v < BATCH * 8 * 2; v += F.G) {
        const int bh = v >> 1, half = v & 1;
#pragma unroll 1
        for (int i = 0; i < 4; ++i) { const int qb = half ? (i == 0 ? 1 : i == 1 ? 6 : i == 2 ? 2 : 5) : (i == 0 ? 0 : i == 1 ? 7 : i == 2 ? 3 : 4); sb_unit(F, bh >> 3, bh & 7, qb); }
    }
}
__device__ __forceinline__ void dsa_unit(Frame& F, int b, int h, int ub, float mref) {
    using namespace att;
    const int lane = F.lane, w = F.wave, hi = lane >> 5, r32 = lane & 31;
    const bf16* Qg = F.R1 + (size_t)b * SEQ * NAB + C_QA + h * 128; const bf16* Kg = F.R1 + (size_t)b * SEQ * NAB + C_KA + h * 128; const bf16* Vg = F.R1 + (size_t)b * SEQ * NAB + C_VA + h * 128;
    const int t0w = 256 * ub + 32 * w, cw = t0w >> 6, jlast = 4 * ub + 3;
    LAS unsigned char* lds = F.lds;
    LAS unsigned char* mst = lds + 65536 + w * 8448;
    FragOff fo; frag_off_init(fo, lane);
    unsigned dvo[2]; dma_off_init(dvo, NAB, w, lane);
    tile_dma(Kg, dvo, lds, w); tile_dma(Vg, dvo, lds + 16384, w);
    bf16x8 qf[8];
#pragma unroll
    for (int ks = 0; ks < 8; ++ks) qf[ks] = *(const bf16x8*)(Qg + (size_t)(t0w + r32) * NAB + 16 * ks + 8 * hi);
    { const unsigned* mg = F.MASK + (size_t)(b * SEQ + t0w) * 64;
#pragma unroll 2
      for (int i = 0; i < 8; ++i) { const int c = lane + 64 * i, row = c >> 4, c4 = c & 15; const u32x4 v = *(const u32x4*)(mg + row * 64 + c4 * 4);
          *(LAS unsigned long long*)(mst + row * 264 + c4 * 16) = (unsigned long long)v.x | ((unsigned long long)v.y << 32);
          *(LAS unsigned long long*)(mst + row * 264 + c4 * 16 + 8) = (unsigned long long)v.z | ((unsigned long long)v.w << 32); } }
    f32x16 o[4];
#pragma unroll
    for (int ct = 0; ct < 4; ++ct)
#pragma unroll
        for (int r = 0; r < 16; ++r) o[ct][r] = 0.f;
    float lsum = 0.f;
    asm volatile("s_waitcnt vmcnt(0) lgkmcnt(0)" ::: "memory");
    __syncthreads();
    for (int j = 0; j <= jlast; ++j) {
        const int cur = j & 1;
        const LAS unsigned char* kb = lds + cur * 32768; const LAS unsigned char* vb = kb + 16384;
        if (j < jlast) { tile_dma(Kg + (size_t)(64 * (j + 1)) * NAB, dvo, lds + (cur ^ 1) * 32768, w); tile_dma(Vg + (size_t)(64 * (j + 1)) * NAB, dvo, lds + (cur ^ 1) * 32768 + 16384, w); }
        if (j <= cw) {
            const unsigned long long mw = *(const LAS unsigned long long*)(mst + r32 * 264 + j * 8);
            const unsigned mw0 = (unsigned)mw, mw1 = (unsigned)(mw >> 32);
#pragma unroll 1
            for (int half = 0; half < 2; ++half) {
                const unsigned mwh = half ? mw1 : mw0;
                f32x16 p;
#pragma unroll
                for (int r = 0; r < 16; ++r) p[r] = -mref;
#pragma unroll
                for (int ks = 0; ks < 8; ++ks) p = __builtin_amdgcn_mfma_f32_32x32x16_bf16(k_frag(kb, fo, half, ks), qf[ks], p, 0, 0, 0);
#pragma unroll
                for (int r = 0; r < 16; ++r) { const unsigned keep = (unsigned)(-(int)((mwh >> crow(r, hi)) & 1u));
                    const float e = __uint_as_float(__float_as_uint(__builtin_amdgcn_exp2f(p[r])) & keep); p[r] = e; lsum += e; }
                const bf16x8 pa0 = pack8(p[0], p[1], p[2], p[3], p[4], p[5], p[6], p[7]), pa1 = pack8(p[8], p[9], p[10], p[11], p[12], p[13], p[14], p[15]);
#pragma unroll
                for (int ct = 0; ct < 4; ++ct) {
                    o[ct] = __builtin_amdgcn_mfma_f32_32x32x16_bf16(pa0, v_frag(vb, fo, ct, 2 * half), o[ct], 0, 0, 0);
                    o[ct] = __builtin_amdgcn_mfma_f32_32x32x16_bf16(pa1, v_frag(vb, fo, ct, 2 * half + 1), o[ct], 0, 0, 0);
                }
            }
        }
        asm volatile("s_waitcnt vmcnt(0) lgkmcnt(0)" ::: "memory");
        __syncthreads();
    }
    lsum += __shfl_xor(lsum, 32);
    LAS float* lsc = (LAS float*)mst;
    if (hi == 0) lsc[r32] = 1.0f / lsum;
    asm volatile("s_waitcnt lgkmcnt(0)" ::: "memory");
    float rsc[16];
#pragma unroll
    for (int r = 0; r < 16; ++r) rsc[r] = lsc[crow(r, hi)];
    store_o(o, rsc, lds + w * 8192, F.CAT + (size_t)(b * SEQ + t0w) * D + h * 128, D, lane);
    __syncthreads();
}
__device__ __forceinline__ void ph_dsa(Frame& F) {
    float gm = fmaxf(fabsf(F.gq_a[F.lane]), fabsf(F.gq_a[64 + F.lane])), km = fmaxf(fabsf(F.gk_a[F.lane]), fabsf(F.gk_a[64 + F.lane]));
    gm = wave_max(gm); km = wave_max(km);
    const float mref = att::C2 * 128.0f * gm * km * 1.02f;
    for (int v = F.vcu; v < BATCH * 4 * 4; v += F.G) {
        const int bh = v >> 2, pi = v & 3;
#pragma unroll 1
        for (int k = 0; k < 2; ++k) dsa_unit(F, bh >> 2, bh & 3, k ? 7 - pi : pi, mref);
    }
}
namespace idx {
using att::f32x16;
constexpr int SCP = 2048;
__device__ __forceinline__ unsigned okey(float f) { const unsigned u = __float_as_uint(f); return (u & 0x80000000u) ? ~u : (u | 0x80000000u); }
template <int EP> __device__ __forceinline__ void select_row(const LAS float* sc, int E, unsigned* mrow, int lane) {
    unsigned key[EP];
#pragma unroll
    for (int j = 0; j < EP; ++j) key[j] = (j < E) ? okey(sc[64 * j + lane]) : 0u;
    unsigned T = 0u; bool exact = false;
    for (int bit = 31; bit >= 0; --bit) {
        const unsigned cand = T | (1u << bit); int cnt = 0;
#pragma unroll
        for (int j = 0; j < EP; ++j) cnt += __popcll(__ballot(key[j] >= cand));
        if (cnt >= 256) { T = cand; if (cnt == 256) { exact = true; break; } }
    }
    unsigned long long mine = 0ull;
    if (exact) {
#pragma unroll
        for (int j = 0; j < EP; ++j) { const unsigned long long m = __ballot(key[j] >= T); if (lane == j) mine = m; }
    } else {
        int cgt = 0;
#pragma unroll
        for (int j = 0; j < EP; ++j) cgt += __popcll(__ballot(key[j] > T));
        int need = 256 - cgt;
        const unsigned long long below = (1ull << lane) - 1ull;
#pragma unroll
        for (int j = 0; j < EP; ++j) {
            const unsigned long long eq = __ballot(key[j] == T), gt = __ballot(key[j] > T);
            const bool take = (key[j] == T) && (__popcll(eq & below) < need);
            const unsigned long long m = gt | __ballot(take);
            need -= __popcll(eq); if (need < 0) need = 0;
            if (lane == j) mine = m;
        }
    }
    if (lane < 32) *(unsigned long long*)(mrow + 2 * lane) = (lane < E) ? mine : 0ull;
}
__device__ __forceinline__ void unit(Frame& F, int b, int c, int sub) {
    const int lane = F.lane, w = F.wave, hi = lane >> 5, r32 = lane & 31, tid = F.tid;
    const int n = 64 * (c + 1), t0 = 64 * c + 16 * sub;
    const bf16* P = F.R1 + (size_t)b * SEQ * NAB;
    LAS float* sc = (LAS float*)F.lds;
    LAS float* wt = sc + 16 * SCP;
    if (tid < 128) wt[tid] = bf2f(P[(size_t)(t0 + (tid >> 3)) * NAB + C_IW + (tid & 7)]) * (0.125f * 0.35355339059327373f);
    bf16x8 af[4][4];
#pragma unroll
    for (int rt = 0; rt < 4; ++rt)
#pragma unroll
        for (int ks = 0; ks < 4; ++ks) af[rt][ks] = *(const bf16x8*)(P + (size_t)(t0 + 4 * rt + (r32 >> 3)) * NAB + C_IQ + (r32 & 7) * 64 + 16 * ks + 8 * hi);
    __syncthreads();
    const int nstrip = n >> 5;
    bf16x8 bfr[4], bnx[4];
    if (w < nstrip) {
#pragma unroll
        for (int ks = 0; ks < 4; ++ks) bfr[ks] = *(const bf16x8*)(P + (size_t)(32 * w + r32) * NAB + C_IK + 16 * ks + 8 * hi);
    }
    for (int s = w; s < nstrip; s += NWAVES) {
        const bool more = s + NWAVES < nstrip;
        if (more) {
#pragma unroll
            for (int ks = 0; ks < 4; ++ks) bnx[ks] = *(const bf16x8*)(P + (size_t)(32 * (s + NWAVES) + r32) * NAB + C_IK + 16 * ks + 8 * hi);
        }
#pragma unroll
        for (int rt = 0; rt < 4; ++rt) {
            f32x16 acc;
#pragma unroll
            for (int r = 0; r < 16; ++r) acc[r] = 0.f;
#pragma unroll
            for (int ks = 0; ks < 4; ++ks) acc = __builtin_amdgcn_mfma_f32_32x32x16_bf16(af[rt][ks], bfr[ks], acc, 0, 0, 0);
            float part[4];
#pragma unroll
            for (int qi = 0; qi < 4; ++qi) { const f32x4 wv = *(const LAS f32x4*)(wt + (4 * rt + qi) * 8 + 4 * hi);
                part[qi] = fmaxf(acc[4 * qi], 0.f) * wv[0] + fmaxf(acc[4 * qi + 1], 0.f) * wv[1] + fmaxf(acc[4 * qi + 2], 0.f) * wv[2] + fmaxf(acc[4 * qi + 3], 0.f) * wv[3]; }
            const float send0 = hi ? part[0] : part[2], send1 = hi ? part[1] : part[3];
            const float got0 = __shfl_xor(send0, 32), got1 = __shfl_xor(send1, 32);
            const float f0 = (hi ? part[2] : part[0]) + got0, f1 = (hi ? part[3] : part[1]) + got1;
            const int q0 = 4 * rt + 2 * hi;
            sc[q0 * SCP + 32 * s + r32] = f0; sc[(q0 + 1) * SCP + 32 * s + r32] = f1;
        }
        if (more) {
#pragma unroll
            for (int ks = 0; ks < 4; ++ks) bfr[ks] = bnx[ks];
        }
    }
    __syncthreads();
    const int E = n >> 6;
#pragma unroll 1
    for (int rr = 0; rr < 2; ++rr) {
        const int q = 2 * w + rr;
        unsigned* mrow = F.MASK + (size_t)(b * SEQ + t0 + q) * 64;
        const LAS float* row = sc + q * SCP;
        if (E <= 8) select_row<8>(row, E, mrow, lane);
        else if (E <= 16) select_row<16>(row, E, mrow, lane);
        else if (E <= 24) select_row<24>(row, E, mrow, lane);
        else select_row<32>(row, E, mrow, lane);
    }
    __syncthreads();
}
}
__device__ __forceinline__ void ph_indexer(Frame& F) {
    { const int gw = F.vcu * NWAVES + F.wave, NGW = F.G * NWAVES;
      for (int i = gw; i < BATCH * 256; i += NGW) { const int b = i >> 8, pos = i & 255, n = ((pos >> 6) + 1) << 6;
          if (F.lane < 32) { unsigned long long v = 0ull; if (64 * F.lane < n) v = ~0ull; *(unsigned long long*)(F.MASK + (size_t)(b * SEQ + pos) * 64 + 2 * F.lane) = v; } } }
    for (int u = F.vcu; u < BATCH * 28 * 4; u += F.G) { const int c = 4 + u % 28, rest = u / 28; idx::unit(F, rest >> 2, c, rest & 3); }
}
namespace gla {
using att::f32x16; using att::u32x4;
constexpr int L_WL = 0, L_V = 4096, L_K = 20480, L_Q = 29696, L_OG = 38912, L_PART = 55296, L_STG = 56320, KP = 144, SP = 272;
__device__ __forceinline__ void stage_wl(Frame& F, int h) {
    LAS float* wl = (LAS float*)(F.lds + L_WL);
#pragma unroll
    for (int i = 0; i < 2; ++i) { const int e = F.tid + 512 * i, r = e >> 6, d = e & 63; wl[e] = F.w_gate_up[r * 256 + h * 64 + d]; }
}
__device__ __forceinline__ void gate_scan(Frame& F, int b, int h, int c, float (&bc)[8], float (&blast)[8]) {
    const int lane = F.lane, d0 = 8 * F.wave;
    const bf16* pr = F.R1 + (size_t)(b * SEQ + 64 * c + lane) * NAB + C_GL;
    const u32x4 g0 = *(const u32x4*)pr, g1 = *(const u32x4*)(pr + 8);
    float gl[16];
#pragma unroll
    for (int i = 0; i < 4; ++i) { gl[2 * i] = __uint_as_float(g0[i] << 16); gl[2 * i + 1] = __uint_as_float(g0[i] & 0xffff0000u); gl[8 + 2 * i] = __uint_as_float(g1[i] << 16); gl[8 + 2 * i + 1] = __uint_as_float(g1[i] & 0xffff0000u); }
    const LAS float* wl = (const LAS float*)(F.lds + L_WL);
    float acc[8];
#pragma unroll
    for (int i = 0; i < 8; ++i) acc[i] = F.b_gate[h * 64 + d0 + i];
#pragma unroll
    for (int r = 0; r < 16; ++r) { const f32x4 w0 = *(const LAS f32x4*)(wl + r * 64 + d0), w1 = *(const LAS f32x4*)(wl + r * 64 + d0 + 4);
#pragma unroll
        for (int i = 0; i < 4; ++i) { acc[i] = fmaf(gl[r], w0[i], acc[i]); acc[4 + i] = fmaf(gl[r], w1[i], acc[4 + i]); } }
#pragma unroll
    for (int i = 0; i < 8; ++i) { float v = log_sigmoid(acc[i]) * (1.0f / 16.0f);
#pragma unroll
        for (int off = 1; off < 64; off <<= 1) { const float u = __shfl_up(v, off); if (lane >= off) v += u; }
        bc[i] = v; blast[i] = __shfl(v, 63); }
}
__device__ __forceinline__ void unpack8(const u32x4 v, float (&f)[8]) {
#pragma unroll
    for (int i = 0; i < 4; ++i) { f[2 * i] = __uint_as_float(v[i] << 16); f[2 * i + 1] = __uint_as_float(v[i] & 0xffff0000u); }
}
__device__ __forceinline__ void unit_a(Frame& F, int b, int h, int c, float* GU, float* DEC) {
    const int lane = F.lane, w = F.wave, hi = lane >> 5, r32 = lane & 31, uid = (4 * b + h) * 32 + c;
    const bf16* P = F.R1 + (size_t)(b * SEQ + 64 * c) * NAB;
    att::FragOff fo; att::frag_off_init(fo, lane);
    unsigned dvo[2]; att::dma_off_init(dvo, NAB, w, lane);
    att::tile_dma(P + C_VB + h * 128, dvo, F.lds + L_V, w);
    stage_wl(F, h);
    __syncthreads();
    float bc[8], blast[8];
    gate_scan(F, b, h, c, bc, blast);
    float kf[8]; unpack8(*(const u32x4*)(P + (size_t)lane * NAB + C_KB + h * 64 + 8 * w), kf);
#pragma unroll
    for (int i = 0; i < 8; ++i) *(LAS bf16*)(F.lds + L_K + (8 * w + i) * KP + lane * 2) = (bf16)f2bf(kf[i] * __expf(blast[i] - bc[i]));
    if (lane == 0) {
#pragma unroll
        for (int i = 0; i < 8; ++i) DEC[(size_t)uid * 64 + 8 * w + i] = __expf(blast[i]); }
    asm volatile("s_waitcnt vmcnt(0) lgkmcnt(0)" ::: "memory");
    __syncthreads();
    const int et = w >> 1, dt = w & 1, va_et = att::frag_va(lane, et);
    f32x16 acc;
#pragma unroll
    for (int r = 0; r < 16; ++r) acc[r] = 0.f;
#pragma unroll
    for (int kk = 0; kk < 4; ++kk) {
        const LAS unsigned char* kp = F.lds + L_K + (32 * dt + r32) * KP + (16 * kk + 4 * hi) * 2;
        const unsigned long long lo = *(const LAS unsigned long long*)kp, hh = *(const LAS unsigned long long*)(kp + 16);
        u32x4 bw; bw.x = (unsigned)lo; bw.y = (unsigned)(lo >> 32); bw.z = (unsigned)hh; bw.w = (unsigned)(hh >> 32);
        acc = __builtin_amdgcn_mfma_f32_32x32x16_bf16(att::v_frag_rt(F.lds + L_V, va_et, fo.vd, kk), __builtin_bit_cast(bf16x8, bw), acc, 0, 0, 0);
    }
    float* gu = GU + (size_t)uid * 8192;
#pragma unroll
    for (int r = 0; r < 16; ++r) gu[(32 * et + att::crow(r, hi)) * 64 + 32 * dt + r32] = acc[r];
    __syncthreads();
}
__device__ __forceinline__ void pass_b(Frame& F, float* GU, const float* DEC) {
    for (int idx = F.vcu * NTHR + F.tid; idx < 64 * 128 * 16; idx += F.G * NTHR) {
        const int bh = idx >> 11, e = (idx >> 4) & 127, dq = idx & 15;
        f32x4 S = (f32x4){0.f, 0.f, 0.f, 0.f};
        for (int c = 0; c < 32; ++c) { const size_t uid = (size_t)bh * 32 + c; f32x4* p = (f32x4*)(GU + (uid * 128 + e) * 64 + 4 * dq);
            const f32x4 U = *p, dec = *(const f32x4*)(DEC + uid * 64 + 4 * dq);
            *p = S; S = dec * S + U; }
    }
}
__device__ __forceinline__ void unit_c(Frame& F, int b, int h, int c, const float* GU) {
    const int lane = F.lane, w = F.wave, hi = lane >> 5, r32 = lane & 31, tid = F.tid, uid = (4 * b + h) * 32 + c;
    const bf16* P = F.R1 + (size_t)(b * SEQ + 64 * c) * NAB;
    LAS unsigned char* lds = F.lds;
    att::FragOff fo; att::frag_off_init(fo, lane);
    unsigned dvo[2]; att::dma_off_init(dvo, NAB, w, lane);
    att::tile_dma(P + C_VB + h * 128, dvo, lds + L_V, w);
    att::tile_dma(P + C_OG + h * 128, dvo, lds + L_OG, w);
    stage_wl(F, h);
    __syncthreads();
    float bc[8], blast[8];
    gate_scan(F, b, h, c, bc, blast);
    { float qf[8], kf[8]; unpack8(*(const u32x4*)(P + (size_t)lane * NAB + C_QB + h * 64 + 8 * w), qf); unpack8(*(const u32x4*)(P + (size_t)lane * NAB + C_KB + h * 64 + 8 * w), kf);
      float eq[8], ek[8];
#pragma unroll
      for (int i = 0; i < 8; ++i) { eq[i] = qf[i] * 0.125f * __expf(bc[i]); ek[i] = kf[i] * __expf(-bc[i]); }
      *(LAS bf16x8*)(lds + L_Q + lane * KP + 16 * w) = att::pack8(eq[0], eq[1], eq[2], eq[3], eq[4], eq[5], eq[6], eq[7]);
      *(LAS bf16x8*)(lds + L_K + lane * KP + 16 * w) = att::pack8(ek[0], ek[1], ek[2], ek[3], ek[4], ek[5], ek[6], ek[7]); }
    asm volatile("s_waitcnt vmcnt(0) lgkmcnt(0)" ::: "memory");
    __syncthreads();
    const int et = w >> 1, tt = w & 1, tl = 32 * tt + r32, va_et = att::frag_va(lane, et);
    bf16x8 qfr[4];
#pragma unroll
    for (int ks = 0; ks < 4; ++ks) qfr[ks] = *(const LAS bf16x8*)(lds + L_Q + tl * KP + (16 * ks + 8 * hi) * 2);
    f32x16 p0, p1;
#pragma unroll
    for (int r = 0; r < 16; ++r) { p0[r] = 0.f; p1[r] = 0.f; }
#pragma unroll
    for (int ks = 0; ks < 4; ++ks) {
        const bf16x8 a0 = *(const LAS bf16x8*)(lds + L_K + r32 * KP + (16 * ks + 8 * hi) * 2), a1 = *(const LAS bf16x8*)(lds + L_K + (32 + r32) * KP + (16 * ks + 8 * hi) * 2);
        p0 = __builtin_amdgcn_mfma_f32_32x32x16_bf16(a0, qfr[ks], p0, 0, 0, 0); p1 = __builtin_amdgcn_mfma_f32_32x32x16_bf16(a1, qfr[ks], p1, 0, 0, 0);
    }
#pragma unroll
    for (int r = 0; r < 16; ++r) { const int s = att::crow(r, hi); if (s > tl) p0[r] = 0.f; if (s + 32 > tl) p1[r] = 0.f; }
    const bf16x8 pa0 = att::pack8(p0[0], p0[1], p0[2], p0[3], p0[4], p0[5], p0[6], p0[7]), pa1 = att::pack8(p0[8], p0[9], p0[10], p0[11], p0[12], p0[13], p0[14], p0[15]);
    const bf16x8 pa2 = att::pack8(p1[0], p1[1], p1[2], p1[3], p1[4], p1[5], p1[6], p1[7]), pa3 = att::pack8(p1[8], p1[9], p1[10], p1[11], p1[12], p1[13], p1[14], p1[15]);
    f32x16 acc;
#pragma unroll
    for (int r = 0; r < 16; ++r) acc[r] = 0.f;
    acc = __builtin_amdgcn_mfma_f32_32x32x16_bf16(att::v_frag_rt(lds + L_V, va_et, fo.vd, 0), pa0, acc, 0, 0, 0);
    acc = __builtin_amdgcn_mfma_f32_32x32x16_bf16(att::v_frag_rt(lds + L_V, va_et, fo.vd, 1), pa1, acc, 0, 0, 0);
    acc = __builtin_amdgcn_mfma_f32_32x32x16_bf16(att::v_frag_rt(lds + L_V, va_et, fo.vd, 2), pa2, acc, 0, 0, 0);
    acc = __builtin_amdgcn_mfma_f32_32x32x16_bf16(att::v_frag_rt(lds + L_V, va_et, fo.vd, 3), pa3, acc, 0, 0, 0);
    { const float* gs = GU + ((size_t)uid * 128 + 32 * et + r32) * 64;
#pragma unroll
      for (int ks = 0; ks < 4; ++ks) { const f32x4 s0 = *(const f32x4*)(gs + 16 * ks + 8 * hi), s1 = *(const f32x4*)(gs + 16 * ks + 8 * hi + 4);
          acc = __builtin_amdgcn_mfma_f32_32x32x16_bf16(att::pack8(s0[0], s0[1], s0[2], s0[3], s1[0], s1[1], s1[2], s1[3]), qfr[ks], acc, 0, 0, 0); } }
    float ss = 0.f;
#pragma unroll
    for (int r = 0; r < 16; ++r) ss = fmaf(acc[r], acc[r], ss);
    ss += __shfl_xor(ss, 32);
    LAS float* part = (LAS float*)(lds + L_PART);
    if (hi == 0) part[et * 64 + tl] = ss;
    asm volatile("s_waitcnt lgkmcnt(0)" ::: "memory");
    __syncthreads();
    const float rs = rsqrtf(((part[tl] + part[64 + tl]) + (part[128 + tl] + part[192 + tl])) * (1.0f / 128.0f) + EPS);
#pragma unroll
    for (int g = 0; g < 4; ++g) {
        const int e0 = 32 * et + 8 * g + 4 * hi;
        const unsigned long long ow = *(const LAS unsigned long long*)(lds + L_OG + att::img_off(tl, 4 * et + g) + 8 * hi);
        const f32x4 gg = *(const f32x4*)(F.g_gla + e0);
        float y[4];
#pragma unroll
        for (int i = 0; i < 4; ++i) { const float og = __uint_as_float(((unsigned)(ow >> (16 * i)) & 0xffffu) << 16); y[i] = acc[4 * g + i] * rs * gg[i] * (og / (1.0f + __expf(-og))); }
        *(LAS unsigned long long*)(lds + L_STG + tl * SP + e0 * 2) = (unsigned long long)pg8::cvt_pk_bf16(y[0], y[1]) | ((unsigned long long)pg8::cvt_pk_bf16(y[2], y[3]) << 32);
    }
    asm volatile("s_waitcnt lgkmcnt(0)" ::: "memory");
    __syncthreads();
#pragma unroll
    for (int i = 0; i < 2; ++i) { const int cidx = tid + 512 * i, row = cidx >> 4, ch = cidx & 15;
        *(u32x4*)(F.CAT + (size_t)(b * SEQ + 64 * c + row) * D + 512 + h * 128 + ch * 8) = *(const LAS u32x4*)(lds + L_STG + row * SP + ch * 16); }
    __syncthreads();
}
}
__device__ __forceinline__ void ph_gla_a(Frame& F, float* GU, float* DEC) { for (int u = F.vcu; u < BATCH * 4 * 32; u += F.G) gla::unit_a(F, u >> 7, (u >> 5) & 3, u & 31, GU, DEC); }
__device__ __forceinline__ void ph_gla_c(Frame& F, const float* GU) { for (int u = F.vcu; u < BATCH * 4 * 32; u += F.G) gla::unit_c(F, u >> 7, (u >> 5) & 3, u & 31, GU); }
__device__ __forceinline__ void ph_rope_tables(Frame& F, float* R128, float* R64) {
    for (int i = F.vcu * NTHR + F.tid; i < SEQ * 24; i += F.G * NTHR) {
        const int pos = i / 24, k = i % 24;
        if (k < 16) { const float inv = powf(500000.0f, -(float)k * 2.0f / 32.0f), ang = (float)pos * inv; R128[pos * 32 + k] = cosf(ang); R128[pos * 32 + 16 + k] = sinf(ang); }
        else { const int j = k - 16; const float inv = powf(500000.0f, -(float)j * 2.0f / 16.0f), ang = (float)pos * inv; R64[pos * 16 + j] = cosf(ang); R64[pos * 16 + 8 + j] = sinf(ang); }
    }
}
__device__ __forceinline__ float dpp_xor1(float v) { return __builtin_bit_cast(float, __builtin_amdgcn_mov_dpp(__builtin_bit_cast(int, v), 0xB1, 0xF, 0xF, true)); }
__device__ __forceinline__ float dpp_xor2(float v) { return __builtin_bit_cast(float, __builtin_amdgcn_mov_dpp(__builtin_bit_cast(int, v), 0x4E, 0xF, 0xF, true)); }
__device__ __forceinline__ void ph_prep_c_fast(Frame& F) {
    const int gw = F.vcu * NWAVES + F.wave, NGW = F.G * NWAVES, lane = F.lane;
    const float* gn = (lane < 32 ? F.gq_c : F.gk_c) + (lane & 3) * 32;
    const float sc = lane < 32 ? att::C2 : 1.0f;
    float g[32];
#pragma unroll
    for (int i = 0; i < 8; ++i) { const f32x4 v = *(const f32x4*)(gn + 4 * i); g[4 * i] = v[0] * sc; g[4 * i + 1] = v[1] * sc; g[4 * i + 2] = v[2] * sc; g[4 * i + 3] = v[3] * sc; }
    for (int tok = gw; tok < M; tok += NGW) {
        att::u32x4* p = (att::u32x4*)(F.R1 + (size_t)tok * NC + lane * 32);
        att::u32x4 v[4]; float f[32]; float ss = 0.f;
#pragma unroll
        for (int i = 0; i < 4; ++i) v[i] = p[i];
#pragma unroll
        for (int i = 0; i < 4; ++i)
#pragma unroll
            for (int j = 0; j < 4; ++j) { const float a = __uint_as_float(v[i][j] << 16), b = __uint_as_float(v[i][j] & 0xffff0000u); f[8 * i + 2 * j] = a; f[8 * i + 2 * j + 1] = b; ss = fmaf(a, a, fmaf(b, b, ss)); }
        ss += dpp_xor1(ss); ss += dpp_xor2(ss);
        const float rs = rsqrtf(ss * (1.f / 128.f) + EPS);
#pragma unroll
        for (int i = 0; i < 4; ++i) { att::u32x4 o;
#pragma unroll
            for (int j = 0; j < 4; ++j) o[j] = pg8::cvt_pk_bf16(f[8 * i + 2 * j] * rs * g[8 * i + 2 * j], f[8 * i + 2 * j + 1] * rs * g[8 * i + 2 * j + 1]);
            p[i] = o; }
    }
}
__device__ __forceinline__ void ph_prep_a_fast(Frame& F, const float* R128, const float* R64) {
    const int gw = F.vcu * NWAVES + F.wave, NGW = F.G * NWAVES, lane = F.lane, l8 = lane & 7;
    const float* gn = (lane < 32 ? F.gq_a : F.gk_a) + l8 * 16;
    const float sc = lane < 32 ? att::C2 : 1.0f;
    float g[16];
#pragma unroll
    for (int i = 0; i < 4; ++i) { const f32x4 v = *(const f32x4*)(gn + 4 * i); g[4 * i] = v[0] * sc; g[4 * i + 1] = v[1] * sc; g[4 * i + 2] = v[2] * sc; g[4 * i + 3] = v[3] * sc; }
    for (int tok = gw; tok < M; tok += NGW) {
        const int pos = tok & (SEQ - 1);
        bf16* pr = F.R1 + (size_t)tok * NAB;
        {   att::u32x4* p = (att::u32x4*)(pr + lane * 16);
            const att::u32x4 v0 = p[0], v1 = p[1]; float f[16]; float ss = 0.f;
#pragma unroll
            for (int j = 0; j < 4; ++j) { f[2 * j] = __uint_as_float(v0[j] << 16); f[2 * j + 1] = __uint_as_float(v0[j] & 0xffff0000u); f[8 + 2 * j] = __uint_as_float(v1[j] << 16); f[8 + 2 * j + 1] = __uint_as_float(v1[j] & 0xffff0000u); }
#pragma unroll
            for (int i = 0; i < 16; ++i) ss = fmaf(f[i], f[i], ss);
            ss += dpp_xor1(ss); ss += dpp_xor2(ss); ss += __shfl_xor(ss, 4);
            const float rs = rsqrtf(ss * (1.f / 128.f) + EPS);
#pragma unroll
            for (int i = 0; i < 16; ++i) f[i] = f[i] * rs * g[i];
            const float* cs = R128 + pos * 32;
#pragma unroll
            for (int i = 0; i < 16; ++i) { const float other = dpp_xor1(f[i]);
                if (l8 < 2) { const float c = cs[i], s = cs[16 + i]; f[i] = (l8 == 0) ? f[i] * c - other * s : f[i] * c + other * s; } }
            att::u32x4 o0, o1;
#pragma unroll
            for (int j = 0; j < 4; ++j) { o0[j] = pg8::cvt_pk_bf16(f[2 * j], f[2 * j + 1]); o1[j] = pg8::cvt_pk_bf16(f[8 + 2 * j], f[8 + 2 * j + 1]); }
            p[0] = o0; p[1] = o1;
        }
        {
#pragma unroll
            for (int part = 0; part < 2; ++part) {
                if (part == 1 && lane >= 8) break;
                att::u32x4* p = (att::u32x4*)(pr + (part == 0 ? C_IQ + lane * 8 : C_IK + lane * 8));
                const att::u32x4 v0 = p[0]; float f[8];
#pragma unroll
                for (int j = 0; j < 4; ++j) { f[2 * j] = __uint_as_float(v0[j] << 16); f[2 * j + 1] = __uint_as_float(v0[j] & 0xffff0000u); }
                const float* cs = R64 + pos * 16;
#pragma unroll
                for (int i = 0; i < 8; ++i) { const float other = dpp_xor1(f[i]);
                    if (l8 < 2) { const float c = cs[i], s = cs[8 + i]; f[i] = (l8 == 0) ? f[i] * c - other * s : f[i] * c + other * s; } }
                att::u32x4 o0;
#pragma unroll
                for (int j = 0; j < 4; ++j) o0[j] = pg8::cvt_pk_bf16(f[2 * j], f[2 * j + 1]);
                p[0] = o0;
            }
        }
    }
}
#ifndef MK_PER_PHASE
#define MK_PER_PHASE 0
#endif
constexpr int NPH = 14;
struct Args { const float* in[16]; float* out; unsigned char* ws; int ph_lo, ph_hi; };
__global__ void __launch_bounds__(NTHR, 2) mk_fwd(Args args) {
    extern __shared__ __attribute__((aligned(16))) unsigned char lds[];
    Frame F;
    F.lds = (LAS unsigned char*)lds;
    F.MISC = (volatile LAS unsigned*)(F.lds + MISC_OFF);
    F.wave = __builtin_amdgcn_readfirstlane((int)threadIdx.x >> 6);
#define RELANE() (F.lane = (int)__builtin_amdgcn_mbcnt_hi(~0u, __builtin_amdgcn_mbcnt_lo(~0u, 0u)), F.tid = F.wave * 64 + F.lane, true)
    RELANE();
    F.G = gridDim.x; { const int bx = blockIdx.x; F.vcu = (F.G % 8 == 0) ? (bx % 8) * (F.G / 8) + bx / 8 : bx; }
    unsigned char* ws = args.ws;
    F.ctl = (gu32*)(ws + WS_CTL);
    F.x = args.in[0]; F.g_mix = args.in[1]; F.g_ffn = args.in[2]; F.w_in_ab = args.in[3]; F.gq_a = args.in[4]; F.gk_a = args.in[5]; F.w_gate_up = args.in[6]; F.b_gate = args.in[7];
    F.g_gla = args.in[8]; F.w_out_ab = args.in[9]; F.w_in_c = args.in[10]; F.gq_c = args.in[11]; F.gk_c = args.in[12]; F.w_out_c = args.in[13]; F.w_up = args.in[14]; F.w_down = args.in[15];
    F.out = args.out;
    F.Wab = (bf16*)(ws + WS_WAB); F.Woab = (bf16*)(ws + WS_WOAB); F.Wup0 = (bf16*)(ws + WS_WUP0); F.Wdn0 = (bf16*)(ws + WS_WDN0);
    F.Winc = (bf16*)(ws + WS_WINC); F.Woc = (bf16*)(ws + WS_WOC); F.Wup1 = (bf16*)(ws + WS_WUP1); F.Wdn1 = (bf16*)(ws + WS_WDN1);
    F.XB = (bf16*)(ws + WS_XB); F.CAT = (bf16*)(ws + WS_CAT); F.R1 = (bf16*)(ws + WS_R1); F.SSQ = (float*)(ws + WS_SSQ); F.MASK = (unsigned*)(ws + WS_MASK);
    for (int u = F.tid; u < (LDS_BYTES - MISC_OFF) / 4; u += NTHR) ((LAS unsigned*)(F.lds + MISC_OFF))[u] = 0u;
    __syncthreads();
    XcdBarrier bar; bar.bar = (unsigned*)(F.ctl + CW_BAR); bar.x = 0; bar.st = nullptr; bar.wave = F.wave;
    if (!MK_PER_PHASE) bar = xcd_barrier_post((unsigned*)(F.ctl + CW_BAR), F.MISC + 8, F.wave);
    const int lo = args.ph_lo, hi = args.ph_hi;
#ifdef PROBE_PH
    unsigned long long pt0 = 0ull, pt1 = 0ull;
#define STAMP(k) do { if ((k) == PROBE_PH) pt0 = __builtin_amdgcn_s_memrealtime(); if ((k) == PROBE_PH + 1) pt1 = __builtin_amdgcn_s_memrealtime(); } while (0)
#else
#define STAMP(k) do { } while (0)
#endif
#define IN(k) (lo <= (k) && (k) < hi && RELANE())
#define SEAM(k) do { if (lo <= (k) && (k) + 1 < hi) xcd_barrier(bar); } while (0)
    float* const SSQ0 = F.SSQ, *SSQ1 = F.SSQ + (size_t)M * 16, *SSQ2 = F.SSQ + (size_t)2 * M * 16, *SSQ3 = F.SSQ + (size_t)3 * M * 16;
    typedef pg8::StaticOrder SO;
    STAMP(0); float* const R128 = (float*)(ws + WS_ROPE); float* const R64 = R128 + SEQ * 32;
    if (IN(0)) { ph_prologue(F); ph_rope_tables(F, R128, R64); } SEAM(0);
    STAMP(1); if (IN(1)) { pg8::Gemm g{F.XB, F.Wab, M, NAB, D}; SO S; S.init(M, NAB, F.G, (int)blockIdx.x); pg8::EpiScale<0> E{F.R1, NAB, SSQ0};
        pg8::gemm_phase<pg8::EpiScale<0>, SO, true, true>(F.lds, g, S, E, F.wave); } SEAM(1);
    float* const GU = (float*)(ws + WS_XB); float* const DEC = (float*)(ws + WS_DEC);
    STAMP(2); if (IN(2)) { ph_prep_a_fast(F, R128, R64); ph_gla_a(F, GU, DEC); } SEAM(2);
    STAMP(3); if (IN(3)) { gla::pass_b(F, GU, DEC); ph_indexer(F); } SEAM(3);
    STAMP(4); if (IN(4)) { ph_dsa(F); ph_gla_c(F, GU); } SEAM(4);
    STAMP(5); if (IN(5)) { pg8::Gemm g{F.CAT, F.Woab, M, D, D}; SO S; S.init(M, D, F.G, (int)blockIdx.x); pg8::EpiResid<0, 0> E{F.x, nullptr, F.XB, SSQ1};
        pg8::gemm_phase<pg8::EpiResid<0, 0>, SO, true, true>(F.lds, g, S, E, F.wave); } SEAM(5);
    STAMP(6); if (IN(6)) { pg8::Gemm g{F.XB, F.Wup0, M, FF, D}; SO S; S.init(M, FF, F.G, (int)blockIdx.x); pg8::EpiScale<1> E{F.R1, FF, SSQ1};
        pg8::gemm_phase<pg8::EpiScale<1>, SO, true, true>(F.lds, g, S, E, F.wave); } SEAM(6);
    STAMP(7); if (IN(7)) { pg8::Gemm g{F.R1, F.Wdn0, M, D, FF}; SO S; S.init(M, D, F.G, (int)blockIdx.x); pg8::EpiResid<1, 0> E{F.XB, nullptr, F.XB, SSQ2};
        pg8::gemm_phase<pg8::EpiResid<1, 0>, SO, true, true>(F.lds, g, S, E, F.wave); } SEAM(7);
    STAMP(8); if (IN(8)) { pg8::Gemm g{F.XB, F.Winc, M, NC, D}; SO S; S.init(M, NC, F.G, (int)blockIdx.x); pg8::EpiScale<0> E{F.R1, NC, SSQ2};
        pg8::gemm_phase<pg8::EpiScale<0>, SO, true, true>(F.lds, g, S, E, F.wave); } SEAM(8);
    STAMP(9); if (IN(9)) { ph_prep_c_fast(F); } SEAM(9);
    STAMP(10); if (IN(10)) { ph_sb(F); } SEAM(10);
    STAMP(11); if (IN(11)) { pg8::Gemm g{F.CAT, F.Woc, M, D, D}; SO S; S.init(M, D, F.G, (int)blockIdx.x); pg8::EpiResid<1, 0> E{F.XB, nullptr, F.XB, SSQ3};
        pg8::gemm_phase<pg8::EpiResid<1, 0>, SO, true, true>(F.lds, g, S, E, F.wave); } SEAM(11);
    STAMP(12); if (IN(12)) { pg8::Gemm g{F.XB, F.Wup1, M, FF, D}; SO S; S.init(M, FF, F.G, (int)blockIdx.x); pg8::EpiScale<1> E{F.R1, FF, SSQ3};
        pg8::gemm_phase<pg8::EpiScale<1>, SO, true, true>(F.lds, g, S, E, F.wave); } SEAM(12);
    STAMP(13); if (IN(13)) { pg8::Gemm g{F.R1, F.Wdn1, M, D, FF}; SO S; S.init(M, D, F.G, (int)blockIdx.x); pg8::EpiResid<1, 1> E{F.XB, F.out, nullptr, nullptr};
        pg8::gemm_phase<pg8::EpiResid<1, 1>, SO, true, true>(F.lds, g, S, E, F.wave); }
    STAMP(NPH);
#ifdef PROBE_PH
    if (blockIdx.x == 0) { const unsigned long long t1 = __builtin_amdgcn_s_memrealtime(), dt = (pt1 - pt0) * PROBE_MULT; while (__builtin_amdgcn_s_memrealtime() - t1 < dt) __builtin_amdgcn_s_sleep(8); }
#endif
#undef IN
#undef SEAM
}

extern "C" void kernel_launch(void* const* d_in, const int* in_sizes, int n_in, void* d_out, int out_size, void* d_ws, size_t ws_size, hipStream_t stream) {
    static int grid = 0;
    if (grid == 0) {
        if (n_in != 16 || in_sizes[0] != M * D || out_size != M * D || ws_size < WS_END) { fprintf(stderr, "kernel_launch: unexpected shapes / workspace (%d inputs, ws %zu)\n", n_in, ws_size); grid = -1; return; }
        int dev = 0, cus = 0;
        if (hipGetDevice(&dev) != hipSuccess || hipDeviceGetAttribute(&cus, hipDeviceAttributeMultiprocessorCount, dev) != hipSuccess) { grid = -1; return; }
        if (hipFuncSetAttribute((const void*)mk_fwd, hipFuncAttributeMaxDynamicSharedMemorySize, LDS_BYTES) != hipSuccess) { fprintf(stderr, "kernel_launch: hipFuncSetAttribute failed\n"); grid = -1; return; }
        (void)hipGetLastError();
        grid = cus;
    }
    if (grid < 0) return;
    if (hipMemsetAsync((char*)d_ws + WS_CTL, 0, CTL_ZERO_BYTES, stream) != hipSuccess) { fprintf(stderr, "kernel_launch: memset failed\n"); return; }
    Args a{};
    for (int i = 0; i < 16; ++i) a.in[i] = (const float*)d_in[i];
    a.out = (float*)d_out; a.ws = (unsigned char*)d_ws;
#if MK_PER_PHASE
    for (int ph = 0; ph < NPH; ++ph) { a.ph_lo = ph; a.ph_hi = ph + 1; hipLaunchKernelGGL(mk_fwd, dim3(grid), dim3(NTHR), LDS_BYTES, stream, a); }
#else
    a.ph_lo = 0; a.ph_hi = NPH;
    hipLaunchKernelGGL(mk_fwd, dim3(grid), dim3(NTHR), LDS_BYTES, stream, a);
#endif
    const hipError_t le = hipPeekAtLastError();
    if (le != hipSuccess) fprintf(stderr, "kernel_launch: launch failed: %s\n", hipGetErrorName(le));
}
```

```cpp
#include <hip/hip_runtime.h>
#include <cstdio>
#include <cstdint>
namespace pg8 {
#define PG8_LAS __attribute__((address_space(3)))
typedef unsigned short bf16_t;
typedef short bf16x8 __attribute__((ext_vector_type(8)));
typedef float f32x4 __attribute__((ext_vector_type(4)));
typedef unsigned u32x4 __attribute__((ext_vector_type(4)));
constexpr int BM = 256, BK = 64, HALF = 128, HTB = HALF * BK * 2  , STAGE_BYTES = 8 * HTB, NXCD = 8, WGM = 8;

__host__ __device__ __forceinline__ int lds_byte(int r, int c) { const int st = (r >> 4) * 2 + (c >> 5), rr = r & 15, cc = c & 31, ob = rr * 64 + cc * 2; return st * 1024 + (ob ^ (((ob >> 9) & 1) << 5)); }
__host__ __device__ __forceinline__ void stage_rc(int b, int& R, int& C) { const int st = b / 1024, sb = b % 1024, swz = sb ^ (((sb >> 9) & 1) << 5); R = (st >> 1) * 16 + swz / 64; C = (st & 1) * 32 + (swz % 64) / 2; }
__host__ __device__ __forceinline__ int perm32(int rho) { const int n = rho >> 4, i = rho & 15; return 8 * (i >> 2) + 4 * n + (i & 3); }

struct Unit { int pm, pn; };
struct Gemm { const bf16_t* A; const bf16_t* Bt; int M, N, K; };

struct StaticOrder {
    int nM, nN, nwg, G, c;
    __host__ __device__ void init(int M, int N, int G_, int c_) { nM = M / BM; nN = N / BM; nwg = nM * nN; G = G_; c = c_; }
    __host__ __device__ bool next(int i, Unit& u) const {
        const long L = (long)i * G + c; if (L >= nwg) return false;
        int wgid = (int)L; { const int q = nwg / NXCD, r = nwg % NXCD, xcd = wgid % NXCD, off = wgid / NXCD; wgid = (xcd < r ? xcd * (q + 1) : r * (q + 1) + (xcd - r) * q) + off; }
        const int nig = WGM * nN, gid = wgid / nig, fm = gid * WGM, gsz = (nM - fm) < WGM ? (nM - fm) : WGM;
        u.pm = fm + ((wgid % nig) % gsz); u.pn = (wgid % nig) / gsz; return true;
    }
    __device__ __forceinline__ void a_ready(const Unit&) const {}
    __device__ __forceinline__ void done(const Unit&) const {}
};

__device__ __forceinline__ unsigned cvt_pk_bf16(float lo, float hi) { unsigned r; asm volatile("v_cvt_pk_bf16_f32 %0, %1, %2" : "=v"(r) : "v"(lo), "v"(hi)); return r; }
__device__ __forceinline__ float row_rstd(const float* ssqp, int row) {
    const f32x4* p = (const f32x4*)(ssqp + (size_t)row * 16);
    const f32x4 a = p[0], b = p[1], c = p[2], d = p[3];
    const float s = (((a[0] + a[1]) + (a[2] + a[3])) + ((b[0] + b[1]) + (b[2] + b[3]))) + (((c[0] + c[1]) + (c[2] + c[3])) + ((d[0] + d[1]) + (d[2] + d[3])));
    return rsqrtf(s * (1.0f / 1024.0f) + 1e-6f);
}
template <int ACT  > struct EpiScale {
    static constexpr bool PERM = true, AFTER_DRAIN = false;
    bf16_t* O; int ldc; const float* ssqp;
    __device__ __forceinline__ void operator()(const f32x4 (&acc)[2][2][4][2], const Unit& u, int wr, int wc, int fr, int fq) const {
        const int row0 = u.pm * BM + wr * 64 + fr, col0 = u.pn * BM + wc * 32 + 8 * fq;
#pragma unroll
        for (int ai = 0; ai < 2; ++ai)
#pragma unroll
            for (int m = 0; m < 4; ++m) {
                const int row = row0 + ai * HALF + m * 16;
                const float rs = row_rstd(ssqp, row);
                bf16_t* rowp = O + (size_t)row * ldc + col0;
#pragma unroll
                for (int bj = 0; bj < 2; ++bj) {
                    f32x4 v0 = acc[ai][bj][m][0] * rs, v1 = acc[ai][bj][m][1] * rs;
                    if (ACT == 1) {
#pragma unroll
                        for (int e = 0; e < 4; ++e) { const float a0 = fmaxf(v0[e], 0.f), a1 = fmaxf(v1[e], 0.f); v0[e] = a0 * a0; v1[e] = a1 * a1; }
                    }
                    u32x4 w; w.x = cvt_pk_bf16(v0[0], v0[1]); w.y = cvt_pk_bf16(v0[2], v0[3]); w.z = cvt_pk_bf16(v1[0], v1[1]); w.w = cvt_pk_bf16(v1[2], v1[3]);
                    *(u32x4*)(rowp + bj * HALF) = w;
                }
            }
    }
};
template <int RIN, int OUT> struct EpiResid {
    static constexpr bool PERM = true, AFTER_DRAIN = false;
    const void* R; float* out; bf16_t* hb; float* ssqp;
    __device__ __forceinline__ void operator()(const f32x4 (&acc)[2][2][4][2], const Unit& u, int wr, int wc, int fr, int fq) const {
        const int row0 = u.pm * BM + wr * 64 + fr, col0 = u.pn * BM + wc * 32 + 8 * fq;
#pragma unroll
        for (int ai = 0; ai < 2; ++ai)
#pragma unroll
            for (int m = 0; m < 4; ++m) {
                const int row = row0 + ai * HALF + m * 16;
                const size_t off = (size_t)row * 1024 + col0;
                float ss = 0.f;
#pragma unroll
                for (int bj = 0; bj < 2; ++bj) {
                    f32x4 r0, r1;
                    if (RIN == 0) { r0 = *(const f32x4*)((const float*)R + off + bj * HALF); r1 = *(const f32x4*)((const float*)R + off + bj * HALF + 4); }
                    else { const u32x4 rw = *(const u32x4*)((const bf16_t*)R + off + bj * HALF);
                        r0 = (f32x4){__uint_as_float(rw.x << 16), __uint_as_float(rw.x & 0xffff0000u), __uint_as_float(rw.y << 16), __uint_as_float(rw.y & 0xffff0000u)};
                        r1 = (f32x4){__uint_as_float(rw.z << 16), __uint_as_float(rw.z & 0xffff0000u), __uint_as_float(rw.w << 16), __uint_as_float(rw.w & 0xffff0000u)}; }
                    const f32x4 v0 = acc[ai][bj][m][0] + r0, v1 = acc[ai][bj][m][1] + r1;
                    if (OUT == 1) { *(f32x4*)(out + off + bj * HALF) = v0; *(f32x4*)(out + off + bj * HALF + 4) = v1; }
                    else {
                        u32x4 w; w.x = cvt_pk_bf16(v0[0], v0[1]); w.y = cvt_pk_bf16(v0[2], v0[3]); w.z = cvt_pk_bf16(v1[0], v1[1]); w.w = cvt_pk_bf16(v1[2], v1[3]);
                        *(u32x4*)(hb + off + bj * HALF) = w;
                        ss += ((v0[0] * v0[0] + v0[1] * v0[1]) + (v0[2] * v0[2] + v0[3] * v0[3])) + ((v1[0] * v1[0] + v1[1] * v1[1]) + (v1[2] * v1[2] + v1[3] * v1[3]));
                    }
                }
                if (OUT == 0) { ss += __shfl_xor(ss, 16); ss += __shfl_xor(ss, 32); if (fq == 0) ssqp[(size_t)row * 16 + u.pn * 4 + wc] = ss; }
            }
    }
};
template <class Epi, class Sched, bool ALIGN_EPI = false, bool SP2 = false>
__device__ __forceinline__ void gemm_phase(PG8_LAS unsigned char* lds, const Gemm g, const Sched& S, const Epi& E, const int wave_in) {
    const int wid = wave_in, lane = (int)__builtin_amdgcn_mbcnt_hi(~0u, __builtin_amdgcn_mbcnt_lo(~0u, 0u)), tid = wid * 64 + lane, wr = wid >> 2, wc = wid & 3, fr = lane & 15, fq = lane >> 4;
    const int K = g.K, nt = K / BK;
    unsigned voffA[2], voffB[2];
#pragma unroll
    for (int i = 0; i < 2; ++i) { int R, C; stage_rc(tid * 16 + i * 8192, R, C); const int Rb = Epi::PERM ? ((R & ~31) + perm32(R & 31)) : R;
        voffA[i] = (unsigned)(R * K + C) * 2u; voffB[i] = (unsigned)(Rb * K + C) * 2u; }
    const size_t kstep = (size_t)(BK * 2);
    const size_t hstep = (size_t)HALF * K * 2;
    const size_t tstep = 2 * hstep;
    const unsigned ldsw = (unsigned)wid * 1024u;
    const int aoff = lds_byte(wr * 64 + fr, fq * 8), boff = lds_byte(wc * 32 + fr, fq * 8);
#define PG8_SA(b, h) (((b) * 2 + (h)) * HTB)
#define PG8_SB(b, h) ((4 + (b) * 2 + (h)) * HTB)
#define PG8_STAGE(bufoff, gbase, voff) do { _Pragma("unroll") for (int _i = 0; _i < 2; ++_i) \
        __builtin_amdgcn_global_load_lds((const unsigned*)((const char*)(gbase) + (voff)[_i]), (PG8_LAS unsigned*)(lds + (bufoff) + ldsw + _i * 8192), 16, 0, 0); } while (0)
#define PG8_LDA(dst, b, h) do { _Pragma("unroll") for (int m = 0; m < 4; ++m) _Pragma("unroll") for (int k = 0; k < 2; ++k) dst[m][k] = *(const PG8_LAS bf16x8*)(lds + PG8_SA(b, h) + aoff + m * 2048 + k * 1024); } while (0)
#define PG8_LDB(dst, b, h) do { _Pragma("unroll") for (int n = 0; n < 2; ++n) _Pragma("unroll") for (int k = 0; k < 2; ++k) dst[n][k] = *(const PG8_LAS bf16x8*)(lds + PG8_SB(b, h) + boff + n * 2048 + k * 1024); } while (0)
#define PG8_MMA(ai, bj, At, Bt) do { __builtin_amdgcn_s_setprio(1); _Pragma("unroll") for (int m = 0; m < 4; ++m) _Pragma("unroll") for (int n = 0; n < 2; ++n) _Pragma("unroll") for (int k = 0; k < 2; ++k) \
        acc[ai][bj][m][n] = __builtin_amdgcn_mfma_f32_16x16x32_bf16(Bt[n][k], At[m][k], acc[ai][bj][m][n], 0, 0, 0); __builtin_amdgcn_s_setprio(0); } while (0)
#define PG8_WAIT_V(n) asm volatile("s_waitcnt vmcnt(" #n ")" ::: "memory")
#define PG8_WAIT_L(n) asm volatile("s_waitcnt lgkmcnt(" #n ")" ::: "memory")
#define PG8_BAR __builtin_amdgcn_s_barrier()
#define PG8_SCHED __builtin_amdgcn_sched_barrier(0)
    Unit cur, nxt; int ui = 0;
    if (!S.next(0, cur)) return;
    f32x4 acc[2][2][4][2];
#pragma unroll
    for (int a = 0; a < 2; ++a)
#pragma unroll
        for (int b = 0; b < 2; ++b)
#pragma unroll
            for (int m = 0; m < 4; ++m)
#pragma unroll
                for (int n = 0; n < 2; ++n) acc[a][b][m][n] = (f32x4){0.f, 0.f, 0.f, 0.f};
    bf16x8 At[4][2], B0[2][2], B1[2][2];
    const char* cA = (const char*)g.A + (size_t)cur.pm * tstep; const char* cB = (const char*)g.Bt + (size_t)cur.pn * tstep;
    S.a_ready(cur);
    if constexpr (SP2) {
        PG8_STAGE(PG8_SB(0, 0), cB, voffB); PG8_STAGE(PG8_SB(0, 1), cB + hstep, voffB); PG8_STAGE(PG8_SA(0, 0), cA, voffA); PG8_STAGE(PG8_SA(0, 1), cA + hstep, voffA);
        if (wr == 1) PG8_BAR;
        PG8_WAIT_V(2); PG8_BAR;
        PG8_STAGE(PG8_SB(1, 0), cB + kstep, voffB); PG8_STAGE(PG8_SA(1, 0), cA + kstep, voffA); PG8_STAGE(PG8_SB(1, 1), cB + hstep + kstep, voffB);
        PG8_WAIT_V(6); PG8_BAR;
    } else {
        PG8_STAGE(PG8_SB(0, 0), cB, voffB); PG8_STAGE(PG8_SA(0, 0), cA, voffA); PG8_STAGE(PG8_SB(0, 1), cB + hstep, voffB); PG8_STAGE(PG8_SA(0, 1), cA + hstep, voffA);
        if (wr == 1) PG8_BAR;
        PG8_WAIT_V(4); PG8_BAR;
        PG8_STAGE(PG8_SB(1, 0), cB + kstep, voffB); PG8_STAGE(PG8_SA(1, 0), cA + kstep, voffA); PG8_STAGE(PG8_SB(1, 1), cB + hstep + kstep, voffB);
        PG8_WAIT_V(6); PG8_BAR;
    }
    for (;;) {
        const bool has_next = S.next(ui + 1, nxt);
        const char* nA = has_next ? (const char*)g.A + (size_t)nxt.pm * tstep : cA; const char* nB = has_next ? (const char*)g.Bt + (size_t)nxt.pn * tstep : cB;
        for (int t = 0; t < nt; t += 2) {
            const bool last = (t == nt - 2);
            const char* a1 = cA + (size_t)(t + 1) * kstep;
            const char* a2 = last ? nA : cA + (size_t)(t + 2) * kstep; const char* b2 = last ? nB : cB + (size_t)(t + 2) * kstep;
            const char* a3 = a2 + kstep; const char* b3 = b2 + kstep;
            if (last && has_next) S.a_ready(nxt);
            if constexpr (SP2) {
            PG8_LDB(B0, 0, 0); PG8_LDB(B1, 0, 1); PG8_SCHED; PG8_LDA(At, 0, 0); PG8_STAGE(PG8_SA(1, 1), a1 + hstep, voffA);
            PG8_WAIT_V(8); PG8_WAIT_L(0); PG8_BAR; PG8_MMA(0, 0, At, B0); PG8_MMA(0, 1, At, B1); PG8_BAR; PG8_SCHED;
            PG8_LDA(At, 0, 1); PG8_STAGE(PG8_SB(0, 0), b2, voffB); PG8_STAGE(PG8_SB(0, 1), b2 + hstep, voffB); PG8_STAGE(PG8_SA(0, 0), a2, voffA);
            PG8_WAIT_V(8); PG8_WAIT_L(0); PG8_BAR; PG8_MMA(1, 0, At, B0); PG8_MMA(1, 1, At, B1); PG8_BAR; PG8_SCHED;
            PG8_LDB(B0, 1, 0); PG8_LDB(B1, 1, 1); PG8_SCHED; PG8_LDA(At, 1, 0); PG8_STAGE(PG8_SA(0, 1), a2 + hstep, voffA);
            PG8_WAIT_V(8); PG8_WAIT_L(0); PG8_BAR; PG8_MMA(0, 0, At, B0); PG8_MMA(0, 1, At, B1); PG8_BAR; PG8_SCHED;
            PG8_LDA(At, 1, 1); PG8_STAGE(PG8_SB(1, 0), b3, voffB); PG8_STAGE(PG8_SB(1, 1), b3 + hstep, voffB); PG8_STAGE(PG8_SA(1, 0), a3, voffA);
            PG8_WAIT_V(8); PG8_WAIT_L(0); PG8_BAR; PG8_MMA(1, 0, At, B0); PG8_MMA(1, 1, At, B1); PG8_BAR; PG8_SCHED;
            } else {
            PG8_LDB(B0, 0, 0); PG8_SCHED; PG8_LDA(At, 0, 0); PG8_STAGE(PG8_SA(1, 1), a1 + hstep, voffA);
            PG8_WAIT_L(8); PG8_BAR; PG8_WAIT_L(0); PG8_MMA(0, 0, At, B0); PG8_BAR; PG8_SCHED;
            PG8_LDB(B1, 0, 1); PG8_STAGE(PG8_SB(0, 0), b2, voffB);
            PG8_BAR; PG8_WAIT_L(0); PG8_MMA(0, 1, At, B1); PG8_BAR;
            PG8_LDA(At, 0, 1); PG8_STAGE(PG8_SA(0, 0), a2, voffA);
            PG8_BAR; PG8_WAIT_L(0); PG8_MMA(1, 0, At, B0); PG8_BAR; PG8_SCHED;
            PG8_STAGE(PG8_SB(0, 1), b2 + hstep, voffB);
            PG8_WAIT_V(6); PG8_BAR; PG8_MMA(1, 1, At, B1); PG8_BAR;
            PG8_LDB(B0, 1, 0); PG8_SCHED; PG8_LDA(At, 1, 0); PG8_STAGE(PG8_SA(0, 1), a2 + hstep, voffA);
            PG8_WAIT_L(8); PG8_BAR; PG8_WAIT_L(0); PG8_MMA(0, 0, At, B0); PG8_BAR; PG8_SCHED;
            PG8_LDB(B1, 1, 1); PG8_STAGE(PG8_SB(1, 0), b3, voffB);
            PG8_BAR; PG8_WAIT_L(0); PG8_MMA(0, 1, At, B1); PG8_BAR;
            PG8_LDA(At, 1, 1); PG8_STAGE(PG8_SA(1, 0), a3, voffA);
            PG8_BAR; PG8_WAIT_L(0); PG8_MMA(1, 0, At, B0); PG8_BAR; PG8_SCHED;
            PG8_STAGE(PG8_SB(1, 1), b3 + hstep, voffB);
            PG8_WAIT_V(6); PG8_BAR; PG8_MMA(1, 1, At, B1); PG8_BAR;
            }
        }
        if constexpr (ALIGN_EPI) { if (wr == 0) PG8_BAR; }
        if constexpr (!Epi::AFTER_DRAIN) { E(acc, cur, wr, wc, fr, fq); S.done(cur); }
        if (!has_next) break;
#pragma unroll
        for (int a = 0; a < 2; ++a)
#pragma unroll
            for (int b = 0; b < 2; ++b)
#pragma unroll
                for (int m = 0; m < 4; ++m)
#pragma unroll
                    for (int n = 0; n < 2; ++n) acc[a][b][m][n] = (f32x4){0.f, 0.f, 0.f, 0.f};
        cur = nxt; cA = nA; cB = nB; ++ui;
        if constexpr (ALIGN_EPI) { if (wr == 1) PG8_BAR; }
    }
    PG8_WAIT_V(0);
    if constexpr (!ALIGN_EPI) { if (wr == 0) PG8_BAR; }
    PG8_BAR;
    if constexpr (Epi::AFTER_DRAIN) { E.fused(acc, cur, wr, wc, fr, fq, lds, wid, lane); S.done(cur); }
#undef PG8_SA
#undef PG8_SB
#undef PG8_STAGE
#undef PG8_LDA
#undef PG8_LDB
#undef PG8_MMA
#undef PG8_WAIT_V
#undef PG8_WAIT_L
#undef PG8_BAR
#undef PG8_SCHED
}
}
#include <cmath>
constexpr int NWAVES = 8, NTHR = 512;
constexpr int BATCH = 16, SEQ = 2048, M = BATCH * SEQ, D = 1024, FF = 4096, NAB = 3840, NC = 3072, ABP_OLD = 3672;
constexpr int C_QA = 0, C_KA = 512, C_VA = 1024, C_IQ = 1536, C_QB = 2048, C_KB = 2304, C_VB = 2560, C_OG = 3072, C_IK = 3584, C_IW = 3648, C_GL = 3656;
constexpr float EPS = 1e-6f;
constexpr size_t MiB = 1u << 20;
constexpr size_t WS_CTL = 0, CTL_ZERO_BYTES = 1 * MiB;
constexpr size_t WS_WAB = 1 * MiB, WS_WOAB = 9 * MiB, WS_WUP0 = 11 * MiB, WS_WDN0 = 19 * MiB, WS_WINC = 27 * MiB, WS_WOC = 33 * MiB, WS_WUP1 = 35 * MiB, WS_WDN1 = 43 * MiB;
constexpr size_t WS_SSQ = 51 * MiB, SSQ_BYTES = 2 * MiB;
constexpr size_t WS_DEC = 59 * MiB;
constexpr size_t WS_ROPE = 59 * MiB + 512 * 1024;
constexpr size_t WS_XB = 60 * MiB;
constexpr size_t WS_CAT = 124 * MiB;
constexpr size_t WS_MASK = 188 * MiB;
constexpr size_t WS_R1 = 196 * MiB;
constexpr size_t WS_END = 452 * MiB;
constexpr int CW_BAR = 4096;
constexpr int RING_BYTES = 131072;
constexpr int LDS_BYTES = 163840;
constexpr int MISC_OFF = LDS_BYTES - 256;
#define GAS __attribute__((address_space(1)))
#define LAS __attribute__((address_space(3)))
typedef unsigned short bf16;
typedef unsigned v4u __attribute__((ext_vector_type(4)));
typedef float f32x4 __attribute__((ext_vector_type(4)));
typedef short bf16x8 __attribute__((ext_vector_type(8)));
typedef GAS unsigned gu32;
typedef GAS unsigned long long gu64;
#define RLX_AGENT __ATOMIC_RELAXED, __HIP_MEMORY_SCOPE_AGENT
#define LDS_WAIT() asm volatile("s_waitcnt lgkmcnt(0)" ::: "memory")
#define VM_WAIT() asm volatile("s_waitcnt vmcnt(0)" ::: "memory")
__device__ __forceinline__ unsigned long long rt() { return __builtin_amdgcn_s_memrealtime(); }
__device__ __forceinline__ unsigned f2bf(float f) { unsigned u = __builtin_bit_cast(unsigned, f); return (u + 0x7fffu + ((u >> 16) & 1u)) >> 16; }
__device__ __forceinline__ unsigned pk2(float lo, float hi) { return f2bf(lo) | (f2bf(hi) << 16); }
#define XB_TMO      128
#define XB_XCNT(j)  (256  + 64 * (j))
#define XB_XSUB(j)  (1280 + 64 * (j))
#define XB_XGEN(j)  (2304 + 64 * (j))
#define XB_TOP      3328
#define XB_TOPGEN   3392
#define XCD_BAR_WORDS 3456
#define XB_SPIN_CAP (1u << 18)

__device__ __forceinline__ unsigned xb_ld(unsigned* p)              { return __hip_atomic_load(p, __ATOMIC_RELAXED, __HIP_MEMORY_SCOPE_AGENT); }
__device__ __forceinline__ unsigned xb_add(unsigned* p, unsigned v) { return __hip_atomic_fetch_add(p, v, __ATOMIC_RELAXED, __HIP_MEMORY_SCOPE_AGENT); }
__device__ __forceinline__ unsigned xb_xcc_id() { return (unsigned)__builtin_amdgcn_s_getreg((3 << 11) | 20) & 0xFu; }
#define XB_SPIN(cond, bar) do { unsigned _sp = 0; while (cond) { __builtin_amdgcn_s_sleep(1); \
    if ((++_sp & 255u) == 0u) { if (xb_ld(&(bar)[XB_TMO])) break; if (_sp > XB_SPIN_CAP) { atomicAdd(&(bar)[XB_TMO], 1u); break; } } } } while (0)

struct XcdBarrier {
    unsigned* bar; unsigned x; int wave;
    volatile LAS unsigned* st;
};

__device__ __forceinline__ bool xb_t0(int wave) { return wave == 0 && __builtin_amdgcn_mbcnt_hi(~0u, __builtin_amdgcn_mbcnt_lo(~0u, 0u)) == 0u; }
__device__ __forceinline__ XcdBarrier xcd_barrier_post(unsigned* bar, volatile LAS unsigned* st, int wave) {
    XcdBarrier b; b.bar = bar; b.x = xb_xcc_id(); b.st = st; b.wave = wave;
    if (xb_t0(wave)) (void)xb_add(&bar[XB_XCNT(b.x)], 1u);
    return b;
}
__device__ __forceinline__ void xcd_barrier_complete(unsigned* bar, unsigned x, unsigned& nloc, unsigned& nx) {
    const unsigned G = gridDim.x * gridDim.y * gridDim.z;
    unsigned sum, cnt, mine, sp = 0u;
    for (;;) {
        sum = 0u; cnt = 0u; mine = 0u;
#pragma unroll
        for (unsigned j = 0; j < 16; ++j) { const unsigned c = xb_ld(&bar[XB_XCNT(j)]); sum += c; cnt += (c > 0u) ? 1u : 0u; mine = (j == x) ? c : mine; }
        if (sum == G) break;
        __builtin_amdgcn_s_sleep(1);
        if ((++sp & 255u) == 0u) { if (xb_ld(&bar[XB_TMO])) break; if (sp > XB_SPIN_CAP) { atomicAdd(&bar[XB_TMO], 1u); break; } }
    }
    nloc = mine > 0u ? mine : 1u; nx = cnt > 0u ? cnt : 1u;
}

__device__ __forceinline__ void xcd_barrier(const XcdBarrier& b) {
    asm volatile("s_waitcnt vmcnt(0)" ::: "memory");
    __syncthreads();
    if (xb_t0(b.wave)) {
        unsigned* bar = b.bar;
        __builtin_amdgcn_s_waitcnt(0);
        unsigned nloc = b.st[0], nx = b.st[1];
        if (nloc == 0u) { xcd_barrier_complete(bar, b.x, nloc, nx); b.st[0] = nloc; b.st[1] = nx; }
        const unsigned old = xb_add(&bar[XB_XSUB(b.x)], 1u);
        const unsigned gen = old / nloc;
        if (old + 1u == (gen + 1u) * nloc) {
            __builtin_amdgcn_fence(__ATOMIC_RELEASE, "agent");
            asm volatile("s_waitcnt vmcnt(0)" ::: "memory");
            const unsigned og = xb_add(&bar[XB_TOP], 1u);
            const unsigned tg = og / nx;
            if (og + 1u == (tg + 1u) * nx) xb_add(&bar[XB_TOPGEN], 1u);
            else XB_SPIN(xb_ld(&bar[XB_TOPGEN]) == tg, bar);
            __builtin_amdgcn_fence(__ATOMIC_ACQUIRE, "agent");
            xb_add(&bar[XB_XGEN(b.x)], 1u);
            asm volatile("s_waitcnt vmcnt(0)" ::: "memory");
        } else {
            XB_SPIN(xb_ld(&bar[XB_XGEN(b.x)]) == gen, bar);
            __builtin_amdgcn_fence(__ATOMIC_ACQUIRE, "agent");
            asm volatile("s_waitcnt vmcnt(0)" ::: "memory");
        }
    }
    __syncthreads();
}
struct Frame {
    LAS unsigned char* lds;
    volatile LAS unsigned* MISC;
    gu32* ctl;
    int tid, lane, wave, vcu, G;
    const float *x, *g_mix, *g_ffn, *w_in_ab, *gq_a, *gk_a, *w_gate_up, *b_gate, *g_gla, *w_out_ab, *w_in_c, *gq_c, *gk_c, *w_out_c, *w_up, *w_down;
    float* out;
    bf16 *Wab, *Woab, *Wup0, *Wdn0, *Winc, *Woc, *Wup1, *Wdn1;
    bf16 *XB, *CAT, *R1;
    float* SSQ; unsigned* MASK;
};
__device__ __forceinline__ float bf2f(bf16 v) { return __builtin_bit_cast(float, (unsigned)v << 16); }
__device__ __forceinline__ float wave_sum(float v) {
#pragma unroll
    for (int o = 1; o < 64; o <<= 1) v += __shfl_xor(v, o);
    return v;
}
__device__ __forceinline__ float wave_max(float v) {
#pragma unroll
    for (int o = 1; o < 64; o <<= 1) v = fmaxf(v, __shfl_xor(v, o));
    return v;
}
__device__ __forceinline__ float log_sigmoid(float x) { return fminf(x, 0.f) - log1pf(expf(-fabsf(x))); }

__device__ __forceinline__ int oldcol_ab(int n) {
    if (n < 2048) return n;
    if (n < 2304) return 2120 + (n - 2048);
    if (n < 2560) return 2376 + (n - 2304);
    if (n < 3072) return 2632 + (n - 2560);
    if (n < 3584) return 3160 + (n - 3072);
    if (n < 3648) return 2048 + (n - 3584);
    if (n < 3656) return 2112 + (n - 3648);
    if (n < 3672) return 3144 + (n - 3656);
    return -1;
}
__device__ __forceinline__ void p0_transpose_item(const float* W, int ldw, int K, const float* gain, bf16* WT, bool map, int item, int nblk, int lane) {
    const int kb = item / nblk, nb = item % nblk, ng = lane & 7, ko = lane >> 3, k0 = 64 * kb + 8 * ko, n = 32 * nb + 4 * ng;
    const int oc = map ? oldcol_ab(n) : n;
    f32x4 v[8];
#pragma unroll
    for (int i = 0; i < 8; ++i) { v[i] = (f32x4){0.f, 0.f, 0.f, 0.f}; if (oc >= 0) v[i] = *(const GAS f32x4*)(W + (size_t)(k0 + i) * ldw + oc); }
    if (gain) { const f32x4 g0 = *(const GAS f32x4*)(gain + k0), g1 = *(const GAS f32x4*)(gain + k0 + 4);
#pragma unroll
        for (int i = 0; i < 4; ++i) { v[i] = v[i] * g0[i]; v[4 + i] = v[4 + i] * g1[i]; } }
#pragma unroll
    for (int e = 0; e < 4; ++e) { v4u o; o.x = pk2(v[0][e], v[1][e]); o.y = pk2(v[2][e], v[3][e]); o.z = pk2(v[4][e], v[5][e]); o.w = pk2(v[6][e], v[7][e]);
        *(GAS v4u*)(WT + (size_t)(n + e) * K + k0) = o; }
}
__device__ __forceinline__ void ph_prologue(Frame& F) {
    const int gw = F.vcu * NWAVES + F.wave, NGW = F.G * NWAVES;
    constexpr int I_AB = (D / 64) * (NAB / 32), I_O = (D / 64) * (D / 32), I_UP = (D / 64) * (FF / 32), I_DN = (FF / 64) * (D / 32), I_C = (D / 64) * (NC / 32);
    constexpr int NITEMS = I_AB + 2 * I_O + 2 * I_UP + 2 * I_DN + I_C;
    for (int it = gw; it < NITEMS; it += NGW) {
        int r = it;
        if (r < I_AB) { p0_transpose_item(F.w_in_ab, ABP_OLD, D, F.g_mix, F.Wab, true, r, NAB / 32, F.lane); continue; } r -= I_AB;
        if (r < I_O) { p0_transpose_item(F.w_out_ab, D, D, nullptr, F.Woab, false, r, D / 32, F.lane); continue; } r -= I_O;
        if (r < I_UP) { p0_transpose_item(F.w_up, FF, D, F.g_ffn, F.Wup0, false, r, FF / 32, F.lane); continue; } r -= I_UP;
        if (r < I_DN) { p0_transpose_item(F.w_down, D, FF, nullptr, F.Wdn0, false, r, D / 32, F.lane); continue; } r -= I_DN;
        if (r < I_C) { p0_transpose_item(F.w_in_c, NC, D, F.g_mix + D, F.Winc, false, r, NC / 32, F.lane); continue; } r -= I_C;
        if (r < I_O) { p0_transpose_item(F.w_out_c, D, D, nullptr, F.Woc, false, r, D / 32, F.lane); continue; } r -= I_O;
        if (r < I_UP) { p0_transpose_item(F.w_up + (size_t)D * FF, FF, D, F.g_ffn + D, F.Wup1, false, r, FF / 32, F.lane); continue; } r -= I_UP;
        p0_transpose_item(F.w_down + (size_t)FF * D, D, FF, nullptr, F.Wdn1, false, r, D / 32, F.lane);
    }
    for (int m = gw; m < M; m += NGW) {
        const GAS f32x4* xr = (const GAS f32x4*)(F.x + (size_t)m * D) + F.lane;
        f32x4 v[4]; float s = 0.f;
#pragma unroll
        for (int j = 0; j < 4; ++j) { v[j] = xr[64 * j]; s += (v[j].x * v[j].x + v[j].y * v[j].y) + (v[j].z * v[j].z + v[j].w * v[j].w); }
        s = wave_sum(s);
        GAS unsigned long long* o8 = (GAS unsigned long long*)(F.XB + (size_t)m * D) + F.lane;
#pragma unroll
        for (int j = 0; j < 4; ++j) o8[64 * j] = (unsigned long long)pk2(v[j].x, v[j].y) | ((unsigned long long)pk2(v[j].z, v[j].w) << 32);
        if (F.lane < 16) F.SSQ[(size_t)m * 16 + F.lane] = (F.lane == 0) ? s : 0.f;
    }
}
namespace att {
typedef short s16x4 __attribute__((ext_vector_type(4)));
typedef float f32x16 __attribute__((ext_vector_type(16)));
typedef _Float16 f16x8 __attribute__((ext_vector_type(8)));
typedef unsigned u32x4 __attribute__((ext_vector_type(4)));
typedef short v4i16_t __attribute__((ext_vector_type(4)));
constexpr float C2 = 0.08838834764831845f * 1.4426950408889634f;
__device__ __forceinline__ int crow(int r, int hi) { return (r & 3) + 8 * (r >> 2) + 4 * hi; }
__device__ __forceinline__ int img_off(int row, int ch) { return 256 * row + 16 * (ch ^ (((row & 3) << 2) | ((row >> 2) & 3))); }
__device__ __forceinline__ bf16x8 pack8(float a0, float a1, float a2, float a3, float a4, float a5, float a6, float a7) {
    u32x4 w; w.x = pg8::cvt_pk_bf16(a0, a1); w.y = pg8::cvt_pk_bf16(a2, a3); w.z = pg8::cvt_pk_bf16(a4, a5); w.w = pg8::cvt_pk_bf16(a6, a7);
    return __builtin_bit_cast(bf16x8, w);
}
__device__ __forceinline__ f16x8 pack8h(float a0, float a1, float a2, float a3, float a4, float a5, float a6, float a7) {
    f16x8 r; r[0] = (_Float16)a0; r[1] = (_Float16)a1; r[2] = (_Float16)a2; r[3] = (_Float16)a3; r[4] = (_Float16)a4; r[5] = (_Float16)a5; r[6] = (_Float16)a6; r[7] = (_Float16)a7; return r;
}
__device__ __forceinline__ void dma_off_init(unsigned (&dvo)[2], int ld, int wave, int lane) {
#pragma unroll
    for (int i = 0; i < 2; ++i) { const int pi = 2 * wave + i, row = 4 * pi + (lane >> 4), pc = lane & 15, ch = pc ^ (((row & 3) << 2) | ((row >> 2) & 3)); dvo[i] = (unsigned)(row * ld + ch * 8) * 2u; }
}
__device__ __forceinline__ void tile_dma(const bf16* g, const unsigned (&dvo)[2], LAS unsigned char* buf, int wave) {
#pragma unroll
    for (int i = 0; i < 2; ++i) __builtin_amdgcn_global_load_lds((const unsigned*)((const char*)g + dvo[i]), (LAS unsigned*)(buf + 1024 * (2 * wave + i)), 16, 0, 0);
}
struct FragOff { int k[8]; int va[4]; int vd; };
__device__ __forceinline__ void frag_off_init(FragOff& fo, int lane) {
    const int hi = lane >> 5, r32 = lane & 31, i = lane & 15, q = i >> 2, p = i & 3, x = 2 * ((lane >> 4) & 1) + (p >> 1);
#pragma unroll
    for (int ks = 0; ks < 8; ++ks) fo.k[ks] = img_off(r32, 2 * ks + hi);
#pragma unroll
    for (int ct = 0; ct < 4; ++ct) fo.va[ct] = img_off(4 * hi + q, 4 * ct + x) + 8 * (p & 1);
    fo.vd = img_off(4 * hi + q + 8, x) - img_off(4 * hi + q, x);
}
__device__ __forceinline__ bf16x8 k_frag(const LAS unsigned char* kbuf, const FragOff& fo, int rt, int ks) { return *(const LAS bf16x8*)(kbuf + fo.k[ks] + 8192 * rt); }
__device__ __forceinline__ s16x4 vtr(const LAS unsigned char* p) { return __builtin_bit_cast(s16x4, __builtin_amdgcn_ds_read_tr16_b64_v4i16((LAS v4i16_t*)p)); }
__device__ __forceinline__ bf16x8 v_frag(const LAS unsigned char* vbuf, const FragOff& fo, int ct, int kk) {
    const s16x4 lo = vtr(vbuf + fo.va[ct] + 4096 * kk), hh = vtr(vbuf + fo.va[ct] + fo.vd + 4096 * kk);
    return (bf16x8){lo[0], lo[1], lo[2], lo[3], hh[0], hh[1], hh[2], hh[3]};
}
__device__ __forceinline__ int frag_va(int lane, int ct) { const int hi = lane >> 5, i = lane & 15, q = i >> 2, p = i & 3, x = 2 * ((lane >> 4) & 1) + (p >> 1); return img_off(4 * hi + q, 4 * ct + x) + 8 * (p & 1); }
__device__ __forceinline__ bf16x8 v_frag_rt(const LAS unsigned char* vbuf, int va, int vd, int kk) {
    const s16x4 lo = vtr(vbuf + va + 4096 * kk), hh = vtr(vbuf + va + vd + 4096 * kk);
    return (bf16x8){lo[0], lo[1], lo[2], lo[3], hh[0], hh[1], hh[2], hh[3]};
}
__device__ __forceinline__ void store_o(const f32x16 (&o)[4], const float (&rscale)[16], LAS unsigned char* stg, bf16* dst, int ld, int lane) {
    const int hi = lane >> 5, r32 = lane & 31;
#pragma unroll
    for (int r = 0; r < 16; ++r) { const int orow = crow(r, hi);
#pragma unroll
        for (int ct = 0; ct < 4; ++ct) *(LAS bf16*)(stg + orow * 256 + (32 * ct + r32) * 2) = (bf16)f2bf(o[ct][r] * rscale[r]); }
    asm volatile("s_waitcnt lgkmcnt(0)" ::: "memory");
#pragma unroll
    for (int i = 0; i < 8; ++i) { const int c = lane + 64 * i, row = c >> 4, ch = c & 15; const u32x4 v = *(const LAS u32x4*)(stg + row * 256 + ch * 16); *(u32x4*)(dst + (size_t)row * ld + ch * 8) = v; }
}
}
template <bool SCALEQ> __device__ __forceinline__ void ph_prep_a(Frame& F) {
    const int gw = F.vcu * NWAVES + F.wave, NGW = F.G * NWAVES, lane = F.lane;
    for (int tok = gw; tok < M; tok += NGW) {
        const float pos = (float)(tok & (SEQ - 1));
        bf16* pr = F.R1 + (size_t)tok * NAB;
        float c128 = 1.f, s128 = 0.f;
        if (lane < 32) { const int i = lane & 15; const float inv = powf(500000.0f, -(float)i * 2.0f / 32.0f); const float ang = pos * inv; c128 = cosf(ang); s128 = sinf(ang); }
#pragma unroll
        for (int which = 0; which < 2; ++which) {
            const int base = which == 0 ? C_QA : C_KA;
            const float* gn = which == 0 ? F.gq_a : F.gk_a;
            for (int h = 0; h < 4; ++h) {
                float a = bf2f(pr[base + h * 128 + lane]), b = bf2f(pr[base + h * 128 + 64 + lane]);
                const float ss = wave_sum(a * a + b * b);
                const float rs = rsqrtf(ss * (1.f / 128.f) + EPS);
                const float qs = (SCALEQ && which == 0) ? att::C2 : 1.0f;
                a = a * rs * gn[lane] * qs; b = b * rs * gn[64 + lane] * qs;
                const float other = __shfl_xor(a, 16);
                float o = a;
                if (lane < 16) o = a * c128 - other * s128;
                else if (lane < 32) o = a * c128 + other * s128;
                pr[base + h * 128 + lane] = (bf16)f2bf(o); pr[base + h * 128 + 64 + lane] = (bf16)f2bf(b);
            }
        }
        float c64 = 1.f, s64 = 0.f;
        if (lane < 16) { const int i = lane & 7; const float inv = powf(500000.0f, -(float)i * 2.0f / 16.0f); const float ang = pos * inv; c64 = cosf(ang); s64 = sinf(ang); }
        for (int h = 0; h < 9; ++h) {
            const int col = (h < 8) ? C_IQ + h * 64 : C_IK;
            const float a = bf2f(pr[col + lane]);
            const float other = __shfl_xor(a, 8);
            float o = a;
            if (lane < 8) o = a * c64 - other * s64;
            else if (lane < 16) o = a * c64 + other * s64;
            pr[col + lane] = (bf16)f2bf(o);
        }
    }
}
__device__ __forceinline__ void ph_indexer_naive(Frame& F) {
    LAS float* sc = (LAS float*)F.lds;
    LAS float* qv = sc + 2048;
    LAS float* wv = qv + 512;
    LAS unsigned* mw = (LAS unsigned*)(wv + 8);
    const int tid = F.tid;
    for (int tok = F.vcu; tok < M; tok += F.G) {
        const int pos = tok & (SEQ - 1), seq0 = tok - pos, limit = ((pos >> 6) + 1) << 6;
        const bf16* pr = F.R1 + (size_t)tok * NAB;
        qv[tid] = bf2f(pr[C_IQ + tid]);
        if (tid < 8) wv[tid] = bf2f(pr[C_IW + tid]) * 0.35355339059327373f;
        if (tid < 64) mw[tid] = 0u;
        __syncthreads();
        for (int s = tid; s < limit; s += NTHR) {
            const bf16* kp = F.R1 + (size_t)(seq0 + s) * NAB + C_IK;
            float acc[8];
#pragma unroll
            for (int h = 0; h < 8; ++h) acc[h] = 0.f;
            for (int d = 0; d < 64; ++d) { const float kd = bf2f(kp[d]);
#pragma unroll
                for (int h = 0; h < 8; ++h) acc[h] = fmaf(qv[h * 64 + d], kd, acc[h]); }
            float score = 0.f;
#pragma unroll
            for (int h = 0; h < 8; ++h) score += fmaxf(acc[h] * 0.125f, 0.f) * wv[h];
            sc[s] = score;
        }
        __syncthreads();
        if (limit <= 256) { if (tid < 64) mw[tid] = (tid * 32 < limit) ? 0xffffffffu : 0u; }
        else {
            for (int s = tid; s < limit; s += NTHR) {
                const float v = sc[s]; int cnt = 0;
                for (int j = 0; j < limit; ++j) { const float u = sc[j]; cnt += ((u > v) || (u == v && j < s)) ? 1 : 0; }
                if (cnt < 256) atomicOr((unsigned*)&mw[s >> 5], 1u << (s & 31));
            }
        }
        __syncthreads();
        if (tid < 64) F.MASK[(size_t)tok * 64 + tid] = mw[tid];
        __syncthreads();
    }
}
__device__ __forceinline__ float block_sum(float v, LAS float* red, int tid) {
    v = wave_sum(v);
    __syncthreads();
    if ((tid & 63) == 0) red[tid >> 6] = v;
    __syncthreads();
    float r = 0.f;
#pragma unroll
    for (int i = 0; i < NWAVES; ++i) r += red[i];
    return r;
}
__device__ __forceinline__ float block_max(float v, LAS float* red, int tid) {
    v = wave_max(v);
    __syncthreads();
    if ((tid & 63) == 0) red[tid >> 6] = v;
    __syncthreads();
    float r = red[0];
#pragma unroll
    for (int i = 1; i < NWAVES; ++i) r = fmaxf(r, red[i]);
    return r;
}
__device__ __forceinline__ void ph_dsa_naive(Frame& F) {
    LAS unsigned* mw = (LAS unsigned*)F.lds;
    LAS int* pre = (LAS int*)(mw + 64);
    LAS int* idx = pre + 128;
    LAS float* pp = (LAS float*)(idx + 256);
    LAS float* q = pp + 512;
    LAS float* red = q + 512;
    const int tid = F.tid;
    for (int tok = F.vcu; tok < M; tok += F.G) {
        const int pos = tok & (SEQ - 1), seq0 = tok - pos;
        if (tid < 64) mw[tid] = F.MASK[(size_t)tok * 64 + tid];
        q[tid] = bf2f(F.R1[(size_t)tok * NAB + C_QA + tid]);
        __syncthreads();
        if (tid == 0) { int a = 0; for (int w = 0; w < 64; ++w) { pre[w] = a; a += __popc(mw[w]); } pre[64] = a; }
        __syncthreads();
        const int n = pre[64];
        for (int s = tid; s < SEQ; s += NTHR) { const unsigned w = mw[s >> 5]; if ((w >> (s & 31)) & 1u) idx[pre[s >> 5] + __popc(w & ((1u << (s & 31)) - 1u))] = s; }
        __syncthreads();
        for (int h = 0; h < 4; ++h) {
            float sv = -INFINITY;
            if (tid < n) { const bf16* kp = F.R1 + (size_t)(seq0 + idx[tid]) * NAB + C_KA + h * 128; float a = 0.f;
                for (int d = 0; d < 128; ++d) a = fmaf(q[h * 128 + d], bf2f(kp[d]), a);
                sv = a * 0.08838834764831845f; }
            const float m = block_max(sv, red, tid);
            const float e = (tid < n) ? expf(sv - m) : 0.f;
            const float l = block_sum(e, red, tid);
            pp[tid] = e;
            __syncthreads();
            if (tid < 128) { float o = 0.f;
                for (int j = 0; j < n; ++j) o = fmaf(pp[j], bf2f(F.R1[(size_t)(seq0 + idx[j]) * NAB + C_VA + h * 128 + tid]), o);
                F.CAT[(size_t)tok * D + h * 128 + tid] = (bf16)f2bf(o / l); }
            __syncthreads();
        }
    }
}
__device__ __forceinline__ void ph_gla_naive(Frame& F) {
    LAS float* sq = (LAS float*)F.lds; LAS float* sk = sq + 1024; LAS float* sd = sk + 1024;
    LAS float* sg = sd + 1024;
    LAS float* red = sg + 256;
    const int tid = F.tid, lane = F.lane;
    for (int item = F.vcu; item < BATCH * 4; item += F.G) {
        const int b = item >> 2, h = item & 3, seq0 = b * SEQ;
        float S[64];
#pragma unroll
        for (int d = 0; d < 64; ++d) S[d] = 0.f;
        for (int t0 = 0; t0 < SEQ; t0 += 16) {
            if (tid < 256) { const int tt = tid >> 4, r = tid & 15; sg[tid] = bf2f(F.R1[(size_t)(seq0 + t0 + tt) * NAB + C_GL + r]); }
            __syncthreads();
            for (int i = tid; i < 1024; i += NTHR) { const int tt = i >> 6, d = i & 63; const bf16* pr = F.R1 + (size_t)(seq0 + t0 + tt) * NAB;
                sq[i] = bf2f(pr[C_QB + h * 64 + d]) * 0.125f; sk[i] = bf2f(pr[C_KB + h * 64 + d]);
                float g = F.b_gate[h * 64 + d];
#pragma unroll
                for (int r = 0; r < 16; ++r) g = fmaf(sg[tt * 16 + r], F.w_gate_up[r * 256 + h * 64 + d], g);
                sd[i] = expf(log_sigmoid(g) * (1.f / 16.f)); }
            __syncthreads();
            float o[16];
            if (tid < 128) {
#pragma unroll
                for (int tt = 0; tt < 16; ++tt) {
                    const float v = bf2f(F.R1[(size_t)(seq0 + t0 + tt) * NAB + C_VB + h * 128 + tid]); float a = 0.f;
#pragma unroll
                    for (int d = 0; d < 64; ++d) { S[d] = fmaf(sd[tt * 64 + d], S[d], sk[tt * 64 + d] * v); a = fmaf(sq[tt * 64 + d], S[d], a); }
                    o[tt] = a;
                    const float ws = wave_sum(a * a);
                    if (lane == 0) red[tt * 2 + (tid >> 6)] = ws;
                }
            }
            __syncthreads();
            if (tid < 128) {
#pragma unroll
                for (int tt = 0; tt < 16; ++tt) {
                    const size_t tok = seq0 + t0 + tt;
                    const float rs = rsqrtf((red[tt * 2] + red[tt * 2 + 1]) * (1.f / 128.f) + EPS);
                    const float og = bf2f(F.R1[tok * NAB + C_OG + h * 128 + tid]);
                    F.CAT[tok * D + 512 + h * 128 + tid] = (bf16)f2bf(o[tt] * rs * F.g_gla[tid] * (og / (1.f + expf(-og))));
                }
            }
            __syncthreads();
        }
    }
}
template <bool SCALEQ> __device__ __forceinline__ void ph_prep_c(Frame& F) {
    const int gw = F.vcu * NWAVES + F.wave, NGW = F.G * NWAVES, lane = F.lane;
    for (int it = gw; it < M * 16; it += NGW) {
        const int tok = it >> 4, hh = it & 15, isk = hh >> 3, h = hh & 7;
        bf16* p = F.R1 + (size_t)tok * NC + isk * 1024 + h * 128;
        const float* gn = isk ? F.gk_c : F.gq_c;
        const float a = bf2f(p[lane]), b = bf2f(p[64 + lane]);
        const float rs = rsqrtf(wave_sum(a * a + b * b) * (1.f / 128.f) + EPS);
        const float sc = (SCALEQ && !isk) ? att::C2 : 1.0f;
        p[lane] = (bf16)f2bf(a * rs * gn[lane] * sc); p[64 + lane] = (bf16)f2bf(b * rs * gn[64 + lane] * sc);
    }
}
__device__ __forceinline__ void ph_sb_naive(Frame& F) {
    const int gw = F.vcu * NWAVES + F.wave, NGW = F.G * NWAVES, lane = F.lane;
    for (int it = gw; it < M * 8; it += NGW) {
        const int tok = it >> 3, h = it & 7, pos = tok & (SEQ - 1), seq0 = tok - pos;
        const unsigned qq = *(const unsigned*)(F.R1 + (size_t)tok * NC + h * 128 + 2 * lane);
        const float q0 = __builtin_bit_cast(float, qq << 16), q1 = __builtin_bit_cast(float, qq & 0xffff0000u);
        float R = 0.f, o0 = 0.f, o1 = 0.f;
        for (int s = pos - 1; s >= 0; --s) {
            const bf16* pr = F.R1 + (size_t)(seq0 + s) * NC + h * 128 + 2 * lane;
            const unsigned kk = *(const unsigned*)(pr + 1024), vv = *(const unsigned*)(pr + 2048);
            const float k0 = __builtin_bit_cast(float, kk << 16), k1 = __builtin_bit_cast(float, kk & 0xffff0000u);
            const float z = wave_sum(q0 * k0 + q1 * k1) * 0.08838834764831845f;
            const float sp = log1pf(expf(-fabsf(z)));
            const float lsp = fminf(z, 0.f) - sp, lsn = fminf(-z, 0.f) - sp;
            const float a = expf(lsp + R);
            o0 = fmaf(a, __builtin_bit_cast(float, vv << 16), o0); o1 = fmaf(a, __builtin_bit_cast(float, vv & 0xffff0000u), o1);
            R += lsn;
        }
        *(unsigned*)(F.CAT + (size_t)tok * D + h * 128 + 2 * lane) = pk2(o0, o1);
    }
}
__device__ __forceinline__ void sb_unit(Frame& F, int b, int h, int qb) {
    using namespace att;
    const int tid = F.tid, lane = F.lane, w = F.wave, hi = lane >> 5, r32 = lane & 31;
    const bf16* Qg = F.R1 + (size_t)b * SEQ * NC + h * 128; const bf16* Kg = Qg + 1024; const bf16* Vg = Qg + 2048;
    const int T0 = qb * 256, t0w = T0 + 32 * w, jd = t0w >> 6, jtop = (T0 >> 6) + 3, tl = 32 * (w & 1) + r32;
    LAS unsigned char* lds = F.lds;
    FragOff fo; frag_off_init(fo, lane);
    unsigned dvo[2]; dma_off_init(dvo, NC, w, lane);
    bf16x8 qf[8];
#pragma unroll
    for (int ks = 0; ks < 8; ++ks) qf[ks] = *(const bf16x8*)(Qg + (size_t)(t0w + r32) * NC + 16 * ks + 8 * hi);
    f16x8 T0f, T1f, ONEf;
#pragma unroll
    for (int j = 0; j < 8; ++j) { const int kp = 8 * (j >> 2) + 4 * hi + (j & 3); T0f[j] = (kp >= r32) ? (_Float16)1.0f : (_Float16)0.0f; T1f[j] = (kp + 16 >= r32) ? (_Float16)1.0f : (_Float16)0.0f; ONEf[j] = (_Float16)1.0f; }
    f32x16 o[4];
#pragma unroll
    for (int ct = 0; ct < 4; ++ct)
#pragma unroll
        for (int r = 0; r < 16; ++r) o[ct][r] = 0.f;
    float R2 = 0.f; bool done = false;
    volatile LAS unsigned* flags = F.MISC + 16;
    tile_dma(Kg + (size_t)(64 * jtop) * NC, dvo, lds, w); tile_dma(Vg + (size_t)(64 * jtop) * NC, dvo, lds + 16384, w);
    asm volatile("s_waitcnt vmcnt(0)" ::: "memory");
    __syncthreads();
    for (int j = jtop; j >= 0; --j) {
        const int cur = (jtop - j) & 1;
        const LAS unsigned char* kb = lds + cur * 32768; const LAS unsigned char* vb = kb + 16384;
        if (j > 0) { tile_dma(Kg + (size_t)(64 * (j - 1)) * NC, dvo, lds + (cur ^ 1) * 32768, w); tile_dma(Vg + (size_t)(64 * (j - 1)) * NC, dvo, lds + (cur ^ 1) * 32768 + 16384, w); }
        if (j <= jd && !done) {
            f32x16 p0, p1;
#pragma unroll
            for (int r = 0; r < 16; ++r) { p0[r] = 0.f; p1[r] = 0.f; }
#pragma unroll
            for (int ks = 0; ks < 8; ++ks) { const bf16x8 a0 = k_frag(kb, fo, 0, ks), a1 = k_frag(kb, fo, 1, ks);
                p0 = __builtin_amdgcn_mfma_f32_32x32x16_bf16(a0, qf[ks], p0, 0, 0, 0); p1 = __builtin_amdgcn_mfma_f32_32x32x16_bf16(a1, qf[ks], p1, 0, 0, 0); }
            const bool diag = (j == jd);
            float x0[16], x1[16]; float rs = 0.f;
#pragma unroll
            for (int r = 0; r < 16; ++r) { const int key = crow(r, hi);
                float l0 = -__builtin_amdgcn_logf(1.0f + __builtin_amdgcn_exp2f(p0[r])), l1 = -__builtin_amdgcn_logf(1.0f + __builtin_amdgcn_exp2f(p1[r]));
                if (diag) { if (!(key < tl)) l0 = 0.f; if (!(key + 32 < tl)) l1 = 0.f; }
                x0[r] = l0; x1[r] = l1; rs += l0 + l1; p0[r] += R2; p1[r] += R2; }
            const f16x8 xb00 = pack8h(x0[0], x0[1], x0[2], x0[3], x0[4], x0[5], x0[6], x0[7]), xb01 = pack8h(x0[8], x0[9], x0[10], x0[11], x0[12], x0[13], x0[14], x0[15]);
            const f16x8 xb10 = pack8h(x1[0], x1[1], x1[2], x1[3], x1[4], x1[5], x1[6], x1[7]), xb11 = pack8h(x1[8], x1[9], x1[10], x1[11], x1[12], x1[13], x1[14], x1[15]);
            p0 = __builtin_amdgcn_mfma_f32_32x32x16_f16(T0f, xb00, p0, 0, 0, 0); p0 = __builtin_amdgcn_mfma_f32_32x32x16_f16(T1f, xb01, p0, 0, 0, 0);
            p0 = __builtin_amdgcn_mfma_f32_32x32x16_f16(ONEf, xb10, p0, 0, 0, 0); p0 = __builtin_amdgcn_mfma_f32_32x32x16_f16(ONEf, xb11, p0, 0, 0, 0);
            p1 = __builtin_amdgcn_mfma_f32_32x32x16_f16(T0f, xb10, p1, 0, 0, 0); p1 = __builtin_amdgcn_mfma_f32_32x32x16_f16(T1f, xb11, p1, 0, 0, 0);
#pragma unroll
            for (int r = 0; r < 16; ++r) { const int key = crow(r, hi);
                float a0 = __builtin_amdgcn_exp2f(p0[r]), a1 = __builtin_amdgcn_exp2f(p1[r]);
                if (diag) { if (!(key < tl)) a0 = 0.f; if (!(key + 32 < tl)) a1 = 0.f; }
                p0[r] = a0; p1[r] = a1; }
            const bf16x8 pa0 = pack8(p0[0], p0[1], p0[2], p0[3], p0[4], p0[5], p0[6], p0[7]), pa1 = pack8(p0[8], p0[9], p0[10], p0[11], p0[12], p0[13], p0[14], p0[15]);
            const bf16x8 pa2 = pack8(p1[0], p1[1], p1[2], p1[3], p1[4], p1[5], p1[6], p1[7]), pa3 = pack8(p1[8], p1[9], p1[10], p1[11], p1[12], p1[13], p1[14], p1[15]);
#pragma unroll
            for (int ct = 0; ct < 4; ++ct) {
                o[ct] = __builtin_amdgcn_mfma_f32_32x32x16_bf16(pa0, v_frag(vb, fo, ct, 0), o[ct], 0, 0, 0);
                o[ct] = __builtin_amdgcn_mfma_f32_32x32x16_bf16(pa1, v_frag(vb, fo, ct, 1), o[ct], 0, 0, 0);
                o[ct] = __builtin_amdgcn_mfma_f32_32x32x16_bf16(pa2, v_frag(vb, fo, ct, 2), o[ct], 0, 0, 0);
                o[ct] = __builtin_amdgcn_mfma_f32_32x32x16_bf16(pa3, v_frag(vb, fo, ct, 3), o[ct], 0, 0, 0);
            }
            rs += __shfl_xor(rs, 32);
            R2 += rs;
            done = __all(R2 < -152.0f);
        }
        if (lane == 0) flags[cur * 8 + w] = done ? 1u : 0u;
        asm volatile("s_waitcnt vmcnt(0) lgkmcnt(0)" ::: "memory");
        __syncthreads();
        unsigned alld = 1u;
#pragma unroll
        for (int i = 0; i < 8; ++i) alld &= flags[cur * 8 + i];
        if (alld) break;
    }
    float ones[16];
#pragma unroll
    for (int r = 0; r < 16; ++r) ones[r] = 1.0f;
    store_o(o, ones, lds + w * 8192, F.CAT + (size_t)(b * SEQ + t0w) * D + h * 128, D, lane);
    __syncthreads();
}
__device__ __forceinline__ void ph_sb(Frame& F) {
    for (int v = F.vcu; v < BATCH * 8 * 2; v += F.G) {
        const int bh = v >> 1, half = v & 1;
#pragma unroll 1
        for (int i = 0; i < 4; ++i) { const int qb = half ? (i == 0 ? 1 : i == 1 ? 6 : i == 2 ? 2 : 5) : (i == 0 ? 0 : i == 1 ? 7 : i == 2 ? 3 : 4); sb_unit(F, bh >> 3, bh & 7, qb); }
    }
}
__device__ __forceinline__ void dsa_unit(Frame& F, int b, int h, int ub, float mref) {
    using namespace att;
    const int lane = F.lane, w = F.wave, hi = lane >> 5, r32 = lane & 31;
    const bf16* Qg = F.R1 + (size_t)b * SEQ * NAB + C_QA + h * 128; const bf16* Kg = F.R1 + (size_t)b * SEQ * NAB + C_KA + h * 128; const bf16* Vg = F.R1 + (size_t)b * SEQ * NAB + C_VA + h * 128;
    const int t0w = 256 * ub + 32 * w, cw = t0w >> 6, jlast = 4 * ub + 3;
    LAS unsigned char* lds = F.lds;
    LAS unsigned char* mst = lds + 65536 + w * 8448;
    FragOff fo; frag_off_init(fo, lane);
    unsigned dvo[2]; dma_off_init(dvo, NAB, w, lane);
    tile_dma(Kg, dvo, lds, w); tile_dma(Vg, dvo, lds + 16384, w);
    bf16x8 qf[8];
#pragma unroll
    for (int ks = 0; ks < 8; ++ks) qf[ks] = *(const bf16x8*)(Qg + (size_t)(t0w + r32) * NAB + 16 * ks + 8 * hi);
    { const unsigned* mg = F.MASK + (size_t)(b * SEQ + t0w) * 64;
#pragma unroll 2
      for (int i = 0; i < 8; ++i) { const int c = lane + 64 * i, row = c >> 4, c4 = c & 15; const u32x4 v = *(const u32x4*)(mg + row * 64 + c4 * 4);
          *(LAS unsigned long long*)(mst + row * 264 + c4 * 16) = (unsigned long long)v.x | ((unsigned long long)v.y << 32);
          *(LAS unsigned long long*)(mst + row * 264 + c4 * 16 + 8) = (unsigned long long)v.z | ((unsigned long long)v.w << 32); } }
    f32x16 o[4];
#pragma unroll
    for (int ct = 0; ct < 4; ++ct)
#pragma unroll
        for (int r = 0; r < 16; ++r) o[ct][r] = 0.f;
    float lsum = 0.f;
    asm volatile("s_waitcnt vmcnt(0) lgkmcnt(0)" ::: "memory");
    __syncthreads();
    for (int j = 0; j <= jlast; ++j) {
        const int cur = j & 1;
        const LAS unsigned char* kb = lds + cur * 32768; const LAS unsigned char* vb = kb + 16384;
        if (j < jlast) { tile_dma(Kg + (size_t)(64 * (j + 1)) * NAB, dvo, lds + (cur ^ 1) * 32768, w); tile_dma(Vg + (size_t)(64 * (j + 1)) * NAB, dvo, lds + (cur ^ 1) * 32768 + 16384, w); }
        if (j <= cw) {
            const unsigned long long mw = *(const LAS unsigned long long*)(mst + r32 * 264 + j * 8);
            const unsigned mw0 = (unsigned)mw, mw1 = (unsigned)(mw >> 32);
#pragma unroll 1
            for (int half = 0; half < 2; ++half) {
                const unsigned mwh = half ? mw1 : mw0;
                f32x16 p;
#pragma unroll
                for (int r = 0; r < 16; ++r) p[r] = -mref;
#pragma unroll
                for (int ks = 0; ks < 8; ++ks) p = __builtin_amdgcn_mfma_f32_32x32x16_bf16(k_frag(kb, fo, half, ks), qf[ks], p, 0, 0, 0);
#pragma unroll
                for (int r = 0; r < 16; ++r) { const unsigned keep = (unsigned)(-(int)((mwh >> crow(r, hi)) & 1u));
                    const float e = __uint_as_float(__float_as_uint(__builtin_amdgcn_exp2f(p[r])) & keep); p[r] = e; lsum += e; }
                const bf16x8 pa0 = pack8(p[0], p[1], p[2], p[3], p[4], p[5], p[6], p[7]), pa1 = pack8(p[8], p[9], p[10], p[11], p[12], p[13], p[14], p[15]);
#pragma unroll
                for (int ct = 0; ct < 4; ++ct) {
                    o[ct] = __builtin_amdgcn_mfma_f32_32x32x16_bf16(pa0, v_frag(vb, fo, ct, 2 * half), o[ct], 0, 0, 0);
                    o[ct] = __builtin_amdgcn_mfma_f32_32x32x16_bf16(pa1, v_frag(vb, fo, ct, 2 * half + 1), o[ct], 0, 0, 0);
                }
            }
        }
        asm volatile("s_waitcnt vmcnt(0) lgkmcnt(0)" ::: "memory");
        __syncthreads();
    }
    lsum += __shfl_xor(lsum, 32);
    LAS float* lsc = (LAS float*)mst;
    if (hi == 0) lsc[r32] = 1.0f / lsum;
    asm volatile("s_waitcnt lgkmcnt(0)" ::: "memory");
    float rsc[16];
#pragma unroll
    for (int r = 0; r < 16; ++r) rsc[r] = lsc[crow(r, hi)];
    store_o(o, rsc, lds + w * 8192, F.CAT + (size_t)(b * SEQ + t0w) * D + h * 128, D, lane);
    __syncthreads();
}
__device__ __forceinline__ void ph_dsa(Frame& F) {
    float gm = fmaxf(fabsf(F.gq_a[F.lane]), fabsf(F.gq_a[64 + F.lane])), km = fmaxf(fabsf(F.gk_a[F.lane]), fabsf(F.gk_a[64 + F.lane]));
    gm = wave_max(gm); km = wave_max(km);
    const float mref = att::C2 * 128.0f * gm * km * 1.02f;
    for (int v = F.vcu; v < BATCH * 4 * 4; v += F.G) {
        const int bh = v >> 2, pi = v & 3;
#pragma unroll 1
        for (int k = 0; k < 2; ++k) dsa_unit(F, bh >> 2, bh & 3, k ? 7 - pi : pi, mref);
    }
}
namespace idx {
using att::f32x16;
constexpr int SCP = 2048;
__device__ __forceinline__ unsigned okey(float f) { const unsigned u = __float_as_uint(f); return (u & 0x80000000u) ? ~u : (u | 0x80000000u); }
__device__ __forceinline__ int wave_isum(int c) {
    c += __builtin_amdgcn_mov_dpp(c, 0xB1, 0xF, 0xF, true);
    c += __builtin_amdgcn_mov_dpp(c, 0x4E, 0xF, 0xF, true);
    c += __builtin_amdgcn_mov_dpp(c, 0x141, 0xF, 0xF, true);
    c += __builtin_amdgcn_mov_dpp(c, 0x140, 0xF, 0xF, true);
    return (__builtin_amdgcn_readlane(c, 0) + __builtin_amdgcn_readlane(c, 16)) + (__builtin_amdgcn_readlane(c, 32) + __builtin_amdgcn_readlane(c, 48));
}
template <int EP> __device__ __forceinline__ void select_row(const LAS float* sc, int E, unsigned* mrow, int lane) {
    unsigned key[EP];
#pragma unroll
    for (int j = 0; j < EP; ++j) key[j] = (j < E) ? okey(sc[64 * j + lane]) : 0u;
    unsigned T = 0u; bool exact = false;
    for (int bit = 31; bit >= 0; --bit) {
        const unsigned cand = T | (1u << bit); int c = 0;
#pragma unroll
        for (int j = 0; j < EP; ++j) c += (key[j] >= cand) ? 1 : 0;
        const int cnt = wave_isum(c);
        if (cnt >= 256) { T = cand; if (cnt == 256) { exact = true; break; } }
    }
    unsigned long long mine = 0ull;
    if (exact) {
#pragma unroll
        for (int j = 0; j < EP; ++j) { const unsigned long long m = __ballot(key[j] >= T); if (lane == j) mine = m; }
    } else {
        int cgt = 0;
#pragma unroll
        for (int j = 0; j < EP; ++j) cgt += __popcll(__ballot(key[j] > T));
        int need = 256 - cgt;
        const unsigned long long below = (1ull << lane) - 1ull;
#pragma unroll
        for (int j = 0; j < EP; ++j) {
            const unsigned long long eq = __ballot(key[j] == T), gt = __ballot(key[j] > T);
            const bool take = (key[j] == T) && (__popcll(eq & below) < need);
            const unsigned long long m = gt | __ballot(take);
            need -= __popcll(eq); if (need < 0) need = 0;
            if (lane == j) mine = m;
        }
    }
    if (lane < 32) *(unsigned long long*)(mrow + 2 * lane) = (lane < E) ? mine : 0ull;
}
__device__ __forceinline__ void unit(Frame& F, int b, int c, int sub) {
    const int lane = F.lane, w = F.wave, hi = lane >> 5, r32 = lane & 31, tid = F.tid;
    const int n = 64 * (c + 1), t0 = 64 * c + 16 * sub;
    const bf16* P = F.R1 + (size_t)b * SEQ * NAB;
    LAS float* sc = (LAS float*)F.lds;
    LAS float* wt = sc + 16 * SCP;
    if (tid < 128) wt[tid] = bf2f(P[(size_t)(t0 + (tid >> 3)) * NAB + C_IW + (tid & 7)]) * (0.125f * 0.35355339059327373f);
    bf16x8 af[4][4];
#pragma unroll
    for (int rt = 0; rt < 4; ++rt)
#pragma unroll
        for (int ks = 0; ks < 4; ++ks) af[rt][ks] = *(const bf16x8*)(P + (size_t)(t0 + 4 * rt + (r32 >> 3)) * NAB + C_IQ + (r32 & 7) * 64 + 16 * ks + 8 * hi);
    __syncthreads();
    const int nstrip = n >> 5;
    bf16x8 bfr[4], bnx[4];
    if (w < nstrip) {
#pragma unroll
        for (int ks = 0; ks < 4; ++ks) bfr[ks] = *(const bf16x8*)(P + (size_t)(32 * w + r32) * NAB + C_IK + 16 * ks + 8 * hi);
    }
    for (int s = w; s < nstrip; s += NWAVES) {
        const bool more = s + NWAVES < nstrip;
        if (more) {
#pragma unroll
            for (int ks = 0; ks < 4; ++ks) bnx[ks] = *(const bf16x8*)(P + (size_t)(32 * (s + NWAVES) + r32) * NAB + C_IK + 16 * ks + 8 * hi);
        }
#pragma unroll
        for (int rt = 0; rt < 4; ++rt) {
            f32x16 acc;
#pragma unroll
            for (int r = 0; r < 16; ++r) acc[r] = 0.f;
#pragma unroll
            for (int ks = 0; ks < 4; ++ks) acc = __builtin_amdgcn_mfma_f32_32x32x16_bf16(af[rt][ks], bfr[ks], acc, 0, 0, 0);
            float part[4];
#pragma unroll
            for (int qi = 0; qi < 4; ++qi) { const f32x4 wv = *(const LAS f32x4*)(wt + (4 * rt + qi) * 8 + 4 * hi);
                part[qi] = fmaxf(acc[4 * qi], 0.f) * wv[0] + fmaxf(acc[4 * qi + 1], 0.f) * wv[1] + fmaxf(acc[4 * qi + 2], 0.f) * wv[2] + fmaxf(acc[4 * qi + 3], 0.f) * wv[3]; }
            const float send0 = hi ? part[0] : part[2], send1 = hi ? part[1] : part[3];
            const float got0 = __shfl_xor(send0, 32), got1 = __shfl_xor(send1, 32);
            const float f0 = (hi ? part[2] : part[0]) + got0, f1 = (hi ? part[3] : part[1]) + got1;
            const int q0 = 4 * rt + 2 * hi;
            sc[q0 * SCP + 32 * s + r32] = f0; sc[(q0 + 1) * SCP + 32 * s + r32] = f1;
        }
        if (more) {
#pragma unroll
            for (int ks = 0; ks < 4; ++ks) bfr[ks] = bnx[ks];
        }
    }
    __syncthreads();
    const int E = n >> 6;
#pragma unroll 1
    for (int rr = 0; rr < 2; ++rr) {
        const int q = 2 * w + rr;
        unsigned* mrow = F.MASK + (size_t)(b * SEQ + t0 + q) * 64;
        const LAS float* row = sc + q * SCP;
        if (E <= 8) select_row<8>(row, E, mrow, lane);
        else if (E <= 16) select_row<16>(row, E, mrow, lane);
        else if (E <= 24) select_row<24>(row, E, mrow, lane);
        else select_row<32>(row, E, mrow, lane);
    }
    __syncthreads();
}
}
__device__ __forceinline__ void ph_indexer(Frame& F) {
    { const int gw = F.vcu * NWAVES + F.wave, NGW = F.G * NWAVES;
      for (int i = gw; i < BATCH * 256; i += NGW) { const int b = i >> 8, pos = i & 255, n = ((pos >> 6) + 1) << 6;
          if (F.lane < 32) { unsigned long long v = 0ull; if (64 * F.lane < n) v = ~0ull; *(unsigned long long*)(F.MASK + (size_t)(b * SEQ + pos) * 64 + 2 * F.lane) = v; } } }
    for (int u = F.vcu; u < BATCH * 28 * 4; u += F.G) { const int c = 4 + u % 28, rest = u / 28; idx::unit(F, rest >> 2, c, rest & 3); }
}
namespace gla {
using att::f32x16; using att::u32x4;
constexpr int L_WL = 0, L_V = 4096, L_K = 20480, L_Q = 29696, L_OG = 38912, L_PART = 55296, L_STG = 56320, KP = 144, SP = 272;
__device__ __forceinline__ void stage_wl(Frame& F, int h) {
    LAS float* wl = (LAS float*)(F.lds + L_WL);
#pragma unroll
    for (int i = 0; i < 2; ++i) { const int e = F.tid + 512 * i, r = e >> 6, d = e & 63; wl[e] = F.w_gate_up[r * 256 + h * 64 + d]; }
}
__device__ __forceinline__ void gate_scan(Frame& F, int b, int h, int c, float (&bc)[8], float (&blast)[8]) {
    const int lane = F.lane, d0 = 8 * F.wave;
    const bf16* pr = F.R1 + (size_t)(b * SEQ + 64 * c + lane) * NAB + C_GL;
    const u32x4 g0 = *(const u32x4*)pr, g1 = *(const u32x4*)(pr + 8);
    float gl[16];
#pragma unroll
    for (int i = 0; i < 4; ++i) { gl[2 * i] = __uint_as_float(g0[i] << 16); gl[2 * i + 1] = __uint_as_float(g0[i] & 0xffff0000u); gl[8 + 2 * i] = __uint_as_float(g1[i] << 16); gl[8 + 2 * i + 1] = __uint_as_float(g1[i] & 0xffff0000u); }
    const LAS float* wl = (const LAS float*)(F.lds + L_WL);
    float acc[8];
#pragma unroll
    for (int i = 0; i < 8; ++i) acc[i] = F.b_gate[h * 64 + d0 + i];
#pragma unroll
    for (int r = 0; r < 16; ++r) { const f32x4 w0 = *(const LAS f32x4*)(wl + r * 64 + d0), w1 = *(const LAS f32x4*)(wl + r * 64 + d0 + 4);
#pragma unroll
        for (int i = 0; i < 4; ++i) { acc[i] = fmaf(gl[r], w0[i], acc[i]); acc[4 + i] = fmaf(gl[r], w1[i], acc[4 + i]); } }
#pragma unroll
    for (int i = 0; i < 8; ++i) { float v = log_sigmoid(acc[i]) * (1.0f / 16.0f);
#pragma unroll
        for (int off = 1; off < 64; off <<= 1) { const float u = __shfl_up(v, off); if (lane >= off) v += u; }
        bc[i] = v; blast[i] = __shfl(v, 63); }
}
__device__ __forceinline__ void unpack8(const u32x4 v, float (&f)[8]) {
#pragma unroll
    for (int i = 0; i < 4; ++i) { f[2 * i] = __uint_as_float(v[i] << 16); f[2 * i + 1] = __uint_as_float(v[i] & 0xffff0000u); }
}
__device__ __forceinline__ void unit_a(Frame& F, int b, int h, int c, float* GU, float* DEC) {
    const int lane = F.lane, w = F.wave, hi = lane >> 5, r32 = lane & 31, uid = (4 * b + h) * 32 + c;
    const bf16* P = F.R1 + (size_t)(b * SEQ + 64 * c) * NAB;
    att::FragOff fo; att::frag_off_init(fo, lane);
    unsigned dvo[2]; att::dma_off_init(dvo, NAB, w, lane);
    att::tile_dma(P + C_VB + h * 128, dvo, F.lds + L_V, w);
    stage_wl(F, h);
    __syncthreads();
    float bc[8], blast[8];
    gate_scan(F, b, h, c, bc, blast);
    float kf[8]; unpack8(*(const u32x4*)(P + (size_t)lane * NAB + C_KB + h * 64 + 8 * w), kf);
#pragma unroll
    for (int i = 0; i < 8; ++i) *(LAS bf16*)(F.lds + L_K + (8 * w + i) * KP + lane * 2) = (bf16)f2bf(kf[i] * __expf(blast[i] - bc[i]));
    if (lane == 0) {
#pragma unroll
        for (int i = 0; i < 8; ++i) DEC[(size_t)uid * 64 + 8 * w + i] = __expf(blast[i]); }
    asm volatile("s_waitcnt vmcnt(0) lgkmcnt(0)" ::: "memory");
    __syncthreads();
    const int et = w >> 1, dt = w & 1, va_et = att::frag_va(lane, et);
    f32x16 acc;
#pragma unroll
    for (int r = 0; r < 16; ++r) acc[r] = 0.f;
#pragma unroll
    for (int kk = 0; kk < 4; ++kk) {
        const LAS unsigned char* kp = F.lds + L_K + (32 * dt + r32) * KP + (16 * kk + 4 * hi) * 2;
        const unsigned long long lo = *(const LAS unsigned long long*)kp, hh = *(const LAS unsigned long long*)(kp + 16);
        u32x4 bw; bw.x = (unsigned)lo; bw.y = (unsigned)(lo >> 32); bw.z = (unsigned)hh; bw.w = (unsigned)(hh >> 32);
        acc = __builtin_amdgcn_mfma_f32_32x32x16_bf16(att::v_frag_rt(F.lds + L_V, va_et, fo.vd, kk), __builtin_bit_cast(bf16x8, bw), acc, 0, 0, 0);
    }
    float* gu = GU + (size_t)uid * 8192;
#pragma unroll
    for (int r = 0; r < 16; ++r) gu[(32 * et + att::crow(r, hi)) * 64 + 32 * dt + r32] = acc[r];
    __syncthreads();
}
__device__ __forceinline__ void pass_b(Frame& F, float* GU, const float* DEC) {
    for (int idx = F.vcu * NTHR + F.tid; idx < 64 * 128 * 16; idx += F.G * NTHR) {
        const int bh = idx >> 11, e = (idx >> 4) & 127, dq = idx & 15;
        f32x4 S = (f32x4){0.f, 0.f, 0.f, 0.f};
        for (int c = 0; c < 32; ++c) { const size_t uid = (size_t)bh * 32 + c; f32x4* p = (f32x4*)(GU + (uid * 128 + e) * 64 + 4 * dq);
            const f32x4 U = *p, dec = *(const f32x4*)(DEC + uid * 64 + 4 * dq);
            *p = S; S = dec * S + U; }
    }
}
__device__ __forceinline__ void unit_c(Frame& F, int b, int h, int c, const float* GU) {
    const int lane = F.lane, w = F.wave, hi = lane >> 5, r32 = lane & 31, tid = F.tid, uid = (4 * b + h) * 32 + c;
    const bf16* P = F.R1 + (size_t)(b * SEQ + 64 * c) * NAB;
    LAS unsigned char* lds = F.lds;
    att::FragOff fo; att::frag_off_init(fo, lane);
    unsigned dvo[2]; att::dma_off_init(dvo, NAB, w, lane);
    att::tile_dma(P + C_VB + h * 128, dvo, lds + L_V, w);
    att::tile_dma(P + C_OG + h * 128, dvo, lds + L_OG, w);
    stage_wl(F, h);
    __syncthreads();
    float bc[8], blast[8];
    gate_scan(F, b, h, c, bc, blast);
    { float qf[8], kf[8]; unpack8(*(const u32x4*)(P + (size_t)lane * NAB + C_QB + h * 64 + 8 * w), qf); unpack8(*(const u32x4*)(P + (size_t)lane * NAB + C_KB + h * 64 + 8 * w), kf);
      float eq[8], ek[8];
#pragma unroll
      for (int i = 0; i < 8; ++i) { eq[i] = qf[i] * 0.125f * __expf(bc[i]); ek[i] = kf[i] * __expf(-bc[i]); }
      *(LAS bf16x8*)(lds + L_Q + lane * KP + 16 * w) = att::pack8(eq[0], eq[1], eq[2], eq[3], eq[4], eq[5], eq[6], eq[7]);
      *(LAS bf16x8*)(lds + L_K + lane * KP + 16 * w) = att::pack8(ek[0], ek[1], ek[2], ek[3], ek[4], ek[5], ek[6], ek[7]); }
    asm volatile("s_waitcnt vmcnt(0) lgkmcnt(0)" ::: "memory");
    __syncthreads();
    const int et = w >> 1, tt = w & 1, tl = 32 * tt + r32, va_et = att::frag_va(lane, et);
    bf16x8 qfr[4];
#pragma unroll
    for (int ks = 0; ks < 4; ++ks) qfr[ks] = *(const LAS bf16x8*)(lds + L_Q + tl * KP + (16 * ks + 8 * hi) * 2);
    f32x16 p0, p1;
#pragma unroll
    for (int r = 0; r < 16; ++r) { p0[r] = 0.f; p1[r] = 0.f; }
#pragma unroll
    for (int ks = 0; ks < 4; ++ks) {
        const bf16x8 a0 = *(const LAS bf16x8*)(lds + L_K + r32 * KP + (16 * ks + 8 * hi) * 2), a1 = *(const LAS bf16x8*)(lds + L_K + (32 + r32) * KP + (16 * ks + 8 * hi) * 2);
        p0 = __builtin_amdgcn_mfma_f32_32x32x16_bf16(a0, qfr[ks], p0, 0, 0, 0); p1 = __builtin_amdgcn_mfma_f32_32x32x16_bf16(a1, qfr[ks], p1, 0, 0, 0);
    }
#pragma unroll
    for (int r = 0; r < 16; ++r) { const int s = att::crow(r, hi); if (s > tl) p0[r] = 0.f; if (s + 32 > tl) p1[r] = 0.f; }
    const bf16x8 pa0 = att::pack8(p0[0], p0[1], p0[2], p0[3], p0[4], p0[5], p0[6], p0[7]), pa1 = att::pack8(p0[8], p0[9], p0[10], p0[11], p0[12], p0[13], p0[14], p0[15]);
    const bf16x8 pa2 = att::pack8(p1[0], p1[1], p1[2], p1[3], p1[4], p1[5], p1[6], p1[7]), pa3 = att::pack8(p1[8], p1[9], p1[10], p1[11], p1[12], p1[13], p1[14], p1[15]);
    f32x16 acc;
#pragma unroll
    for (int r = 0; r < 16; ++r) acc[r] = 0.f;
    acc = __builtin_amdgcn_mfma_f32_32x32x16_bf16(att::v_frag_rt(lds + L_V, va_et, fo.vd, 0), pa0, acc, 0, 0, 0);
    acc = __builtin_amdgcn_mfma_f32_32x32x16_bf16(att::v_frag_rt(lds + L_V, va_et, fo.vd, 1), pa1, acc, 0, 0, 0);
    acc = __builtin_amdgcn_mfma_f32_32x32x16_bf16(att::v_frag_rt(lds + L_V, va_et, fo.vd, 2), pa2, acc, 0, 0, 0);
    acc = __builtin_amdgcn_mfma_f32_32x32x16_bf16(att::v_frag_rt(lds + L_V, va_et, fo.vd, 3), pa3, acc, 0, 0, 0);
    { const float* gs = GU + ((size_t)uid * 128 + 32 * et + r32) * 64;
#pragma unroll
      for (int ks = 0; ks < 4; ++ks) { const f32x4 s0 = *(const f32x4*)(gs + 16 * ks + 8 * hi), s1 = *(const f32x4*)(gs + 16 * ks + 8 * hi + 4);
          acc = __builtin_amdgcn_mfma_f32_32x32x16_bf16(att::pack8(s0[0], s0[1], s0[2], s0[3], s1[0], s1[1], s1[2], s1[3]), qfr[ks], acc, 0, 0, 0); } }
    float ss = 0.f;
#pragma unroll
    for (int r = 0; r < 16; ++r) ss = fmaf(acc[r], acc[r], ss);
    ss += __shfl_xor(ss, 32);
    LAS float* part = (LAS float*)(lds + L_PART);
    if (hi == 0) part[et * 64 + tl] = ss;
    asm volatile("s_waitcnt lgkmcnt(0)" ::: "memory");
    __syncthreads();
    const float rs = rsqrtf(((part[tl] + part[64 + tl]) + (part[128 + tl] + part[192 + tl])) * (1.0f / 128.0f) + EPS);
#pragma unroll
    for (int g = 0; g < 4; ++g) {
        const int e0 = 32 * et + 8 * g + 4 * hi;
        const unsigned long long ow = *(const LAS unsigned long long*)(lds + L_OG + att::img_off(tl, 4 * et + g) + 8 * hi);
        const f32x4 gg = *(const f32x4*)(F.g_gla + e0);
        float y[4];
#pragma unroll
        for (int i = 0; i < 4; ++i) { const float og = __uint_as_float(((unsigned)(ow >> (16 * i)) & 0xffffu) << 16); y[i] = acc[4 * g + i] * rs * gg[i] * (og / (1.0f + __expf(-og))); }
        *(LAS unsigned long long*)(lds + L_STG + tl * SP + e0 * 2) = (unsigned long long)pg8::cvt_pk_bf16(y[0], y[1]) | ((unsigned long long)pg8::cvt_pk_bf16(y[2], y[3]) << 32);
    }
    asm volatile("s_waitcnt lgkmcnt(0)" ::: "memory");
    __syncthreads();
#pragma unroll
    for (int i = 0; i < 2; ++i) { const int cidx = tid + 512 * i, row = cidx >> 4, ch = cidx & 15;
        *(u32x4*)(F.CAT + (size_t)(b * SEQ + 64 * c + row) * D + 512 + h * 128 + ch * 8) = *(const LAS u32x4*)(lds + L_STG + row * SP + ch * 16); }
    __syncthreads();
}
}
__device__ __forceinline__ void ph_gla_a(Frame& F, float* GU, float* DEC) { for (int u = F.vcu; u < BATCH * 4 * 32; u += F.G) gla::unit_a(F, u >> 7, (u >> 5) & 3, u & 31, GU, DEC); }
__device__ __forceinline__ void ph_gla_c(Frame& F, const float* GU) { for (int u = F.vcu; u < BATCH * 4 * 32; u += F.G) gla::unit_c(F, u >> 7, (u >> 5) & 3, u & 31, GU); }
__device__ __forceinline__ void ph_rope_tables(Frame& F, float* R128, float* R64) {
    for (int i = F.vcu * NTHR + F.tid; i < SEQ * 24; i += F.G * NTHR) {
        const int pos = i / 24, k = i % 24;
        if (k < 16) { const float inv = powf(500000.0f, -(float)k * 2.0f / 32.0f), ang = (float)pos * inv; R128[pos * 32 + k] = cosf(ang); R128[pos * 32 + 16 + k] = sinf(ang); }
        else { const int j = k - 16; const float inv = powf(500000.0f, -(float)j * 2.0f / 16.0f), ang = (float)pos * inv; R64[pos * 16 + j] = cosf(ang); R64[pos * 16 + 8 + j] = sinf(ang); }
    }
}
__device__ __forceinline__ float dpp_xor1(float v) { return __builtin_bit_cast(float, __builtin_amdgcn_mov_dpp(__builtin_bit_cast(int, v), 0xB1, 0xF, 0xF, true)); }
__device__ __forceinline__ float dpp_xor2(float v) { return __builtin_bit_cast(float, __builtin_amdgcn_mov_dpp(__builtin_bit_cast(int, v), 0x4E, 0xF, 0xF, true)); }
__device__ __forceinline__ void ph_prep_c_fast(Frame& F) {
    const int gw = F.vcu * NWAVES + F.wave, NGW = F.G * NWAVES, lane = F.lane;
    const float* gn = (lane < 32 ? F.gq_c : F.gk_c) + (lane & 3) * 32;
    const float sc = lane < 32 ? att::C2 : 1.0f;
    float g[32];
#pragma unroll
    for (int i = 0; i < 8; ++i) { const f32x4 v = *(const f32x4*)(gn + 4 * i); g[4 * i] = v[0] * sc; g[4 * i + 1] = v[1] * sc; g[4 * i + 2] = v[2] * sc; g[4 * i + 3] = v[3] * sc; }
    for (int tok = gw; tok < M; tok += NGW) {
        att::u32x4* p = (att::u32x4*)(F.R1 + (size_t)tok * NC + lane * 32);
        att::u32x4 v[4]; float f[32]; float ss = 0.f;
#pragma unroll
        for (int i = 0; i < 4; ++i) v[i] = p[i];
#pragma unroll
        for (int i = 0; i < 4; ++i)
#pragma unroll
            for (int j = 0; j < 4; ++j) { const float a = __uint_as_float(v[i][j] << 16), b = __uint_as_float(v[i][j] & 0xffff0000u); f[8 * i + 2 * j] = a; f[8 * i + 2 * j + 1] = b; ss = fmaf(a, a, fmaf(b, b, ss)); }
        ss += dpp_xor1(ss); ss += dpp_xor2(ss);
        const float rs = rsqrtf(ss * (1.f / 128.f) + EPS);
#pragma unroll
        for (int i = 0; i < 4; ++i) { att::u32x4 o;
#pragma unroll
            for (int j = 0; j < 4; ++j) o[j] = pg8::cvt_pk_bf16(f[8 * i + 2 * j] * rs * g[8 * i + 2 * j], f[8 * i + 2 * j + 1] * rs * g[8 * i + 2 * j + 1]);
            p[i] = o; }
    }
}
__device__ __forceinline__ void ph_prep_a_fast(Frame& F, const float* R128, const float* R64) {
    const int gw = F.vcu * NWAVES + F.wave, NGW = F.G * NWAVES, lane = F.lane, l8 = lane & 7;
    const float* gn = (lane < 32 ? F.gq_a : F.gk_a) + l8 * 16;
    const float sc = lane < 32 ? att::C2 : 1.0f;
    float g[16];
#pragma unroll
    for (int i = 0; i < 4; ++i) { const f32x4 v = *(const f32x4*)(gn + 4 * i); g[4 * i] = v[0] * sc; g[4 * i + 1] = v[1] * sc; g[4 * i + 2] = v[2] * sc; g[4 * i + 3] = v[3] * sc; }
    for (int tok = gw; tok < M; tok += NGW) {
        const int pos = tok & (SEQ - 1);
        bf16* pr = F.R1 + (size_t)tok * NAB;
        {   att::u32x4* p = (att::u32x4*)(pr + lane * 16);
            const att::u32x4 v0 = p[0], v1 = p[1]; float f[16]; float ss = 0.f;
#pragma unroll
            for (int j = 0; j < 4; ++j) { f[2 * j] = __uint_as_float(v0[j] << 16); f[2 * j + 1] = __uint_as_float(v0[j] & 0xffff0000u); f[8 + 2 * j] = __uint_as_float(v1[j] << 16); f[8 + 2 * j + 1] = __uint_as_float(v1[j] & 0xffff0000u); }
#pragma unroll
            for (int i = 0; i < 16; ++i) ss = fmaf(f[i], f[i], ss);
            ss += dpp_xor1(ss); ss += dpp_xor2(ss); ss += __shfl_xor(ss, 4);
            const float rs = rsqrtf(ss * (1.f / 128.f) + EPS);
#pragma unroll
            for (int i = 0; i < 16; ++i) f[i] = f[i] * rs * g[i];
            const float* cs = R128 + pos * 32;
#pragma unroll
            for (int i = 0; i < 16; ++i) { const float other = dpp_xor1(f[i]);
                if (l8 < 2) { const float c = cs[i], s = cs[16 + i]; f[i] = (l8 == 0) ? f[i] * c - other * s : f[i] * c + other * s; } }
            att::u32x4 o0, o1;
#pragma unroll
            for (int j = 0; j < 4; ++j) { o0[j] = pg8::cvt_pk_bf16(f[2 * j], f[2 * j + 1]); o1[j] = pg8::cvt_pk_bf16(f[8 + 2 * j], f[8 + 2 * j + 1]); }
            p[0] = o0; p[1] = o1;
        }
        {
#pragma unroll
            for (int part = 0; part < 2; ++part) {
                if (part == 1 && lane >= 8) break;
                att::u32x4* p = (att::u32x4*)(pr + (part == 0 ? C_IQ + lane * 8 : C_IK + lane * 8));
                const att::u32x4 v0 = p[0]; float f[8];
#pragma unroll
                for (int j = 0; j < 4; ++j) { f[2 * j] = __uint_as_float(v0[j] << 16); f[2 * j + 1] = __uint_as_float(v0[j] & 0xffff0000u); }
                const float* cs = R64 + pos * 16;
#pragma unroll
                for (int i = 0; i < 8; ++i) { const float other = dpp_xor1(f[i]);
                    if (l8 < 2) { const float c = cs[i], s = cs[8 + i]; f[i] = (l8 == 0) ? f[i] * c - other * s : f[i] * c + other * s; } }
                att::u32x4 o0;
#pragma unroll
                for (int j = 0; j < 4; ++j) o0[j] = pg8::cvt_pk_bf16(f[2 * j], f[2 * j + 1]);
                p[0] = o0;
            }
        }
    }
}
#ifndef MK_PER_PHASE
#define MK_PER_PHASE 0
#endif
constexpr int NPH = 14;
struct Args { const float* in[16]; float* out; unsigned char* ws; int ph_lo, ph_hi; };
__global__ void __launch_bounds__(NTHR, 2) mk_fwd(Args args) {
    extern __shared__ __attribute__((aligned(16))) unsigned char lds[];
    Frame F;
    F.lds = (LAS unsigned char*)lds;
    F.MISC = (volatile LAS unsigned*)(F.lds + MISC_OFF);
    F.wave = __builtin_amdgcn_readfirstlane((int)threadIdx.x >> 6);
#define RELANE() (F.lane = (int)__builtin_amdgcn_mbcnt_hi(~0u, __builtin_amdgcn_mbcnt_lo(~0u, 0u)), F.tid = F.wave * 64 + F.lane, true)
    RELANE();
    F.G = gridDim.x; { const int bx = blockIdx.x; F.vcu = (F.G % 8 == 0) ? (bx % 8) * (F.G / 8) + bx / 8 : bx; }
    unsigned char* ws = args.ws;
    F.ctl = (gu32*)(ws + WS_CTL);
    F.x = args.in[0]; F.g_mix = args.in[1]; F.g_ffn = args.in[2]; F.w_in_ab = args.in[3]; F.gq_a = args.in[4]; F.gk_a = args.in[5]; F.w_gate_up = args.in[6]; F.b_gate = args.in[7];
    F.g_gla = args.in[8]; F.w_out_ab = args.in[9]; F.w_in_c = args.in[10]; F.gq_c = args.in[11]; F.gk_c = args.in[12]; F.w_out_c = args.in[13]; F.w_up = args.in[14]; F.w_down = args.in[15];
    F.out = args.out;
    F.Wab = (bf16*)(ws + WS_WAB); F.Woab = (bf16*)(ws + WS_WOAB); F.Wup0 = (bf16*)(ws + WS_WUP0); F.Wdn0 = (bf16*)(ws + WS_WDN0);
    F.Winc = (bf16*)(ws + WS_WINC); F.Woc = (bf16*)(ws + WS_WOC); F.Wup1 = (bf16*)(ws + WS_WUP1); F.Wdn1 = (bf16*)(ws + WS_WDN1);
    F.XB = (bf16*)(ws + WS_XB); F.CAT = (bf16*)(ws + WS_CAT); F.R1 = (bf16*)(ws + WS_R1); F.SSQ = (float*)(ws + WS_SSQ); F.MASK = (unsigned*)(ws + WS_MASK);
    for (int u = F.tid; u < (LDS_BYTES - MISC_OFF) / 4; u += NTHR) ((LAS unsigned*)(F.lds + MISC_OFF))[u] = 0u;
    __syncthreads();
    XcdBarrier bar; bar.bar = (unsigned*)(F.ctl + CW_BAR); bar.x = 0; bar.st = nullptr; bar.wave = F.wave;
    if (!MK_PER_PHASE) bar = xcd_barrier_post((unsigned*)(F.ctl + CW_BAR), F.MISC + 8, F.wave);
    const int lo = args.ph_lo, hi = args.ph_hi;
#ifdef PROBE_PH
    unsigned long long pt0 = 0ull, pt1 = 0ull;
#define STAMP(k) do { if ((k) == PROBE_PH) pt0 = __builtin_amdgcn_s_memrealtime(); if ((k) == PROBE_PH + 1) pt1 = __builtin_amdgcn_s_memrealtime(); } while (0)
#else
#define STAMP(k) do { } while (0)
#endif
#define IN(k) (lo <= (k) && (k) < hi && RELANE())
#define SEAM(k) do { if (lo <= (k) && (k) + 1 < hi) xcd_barrier(bar); } while (0)
    float* const SSQ0 = F.SSQ, *SSQ1 = F.SSQ + (size_t)M * 16, *SSQ2 = F.SSQ + (size_t)2 * M * 16, *SSQ3 = F.SSQ + (size_t)3 * M * 16;
    typedef pg8::StaticOrder SO;
    STAMP(0); float* const R128 = (float*)(ws + WS_ROPE); float* const R64 = R128 + SEQ * 32;
    if (IN(0)) { ph_prologue(F); ph_rope_tables(F, R128, R64); } SEAM(0);
    STAMP(1); if (IN(1)) { pg8::Gemm g{F.XB, F.Wab, M, NAB, D}; SO S; S.init(M, NAB, F.G, (int)blockIdx.x); pg8::EpiScale<0> E{F.R1, NAB, SSQ0};
        pg8::gemm_phase<pg8::EpiScale<0>, SO, true, true>(F.lds, g, S, E, F.wave); } SEAM(1);
    float* const GU = (float*)(ws + WS_XB); float* const DEC = (float*)(ws + WS_DEC);
    STAMP(2); if (IN(2)) { ph_prep_a_fast(F, R128, R64); ph_gla_a(F, GU, DEC); } SEAM(2);
    STAMP(3); if (IN(3)) { gla::pass_b(F, GU, DEC); ph_indexer(F); } SEAM(3);
    STAMP(4); if (IN(4)) { ph_dsa(F); ph_gla_c(F, GU); } SEAM(4);
    STAMP(5); if (IN(5)) { pg8::Gemm g{F.CAT, F.Woab, M, D, D}; SO S; S.init(M, D, F.G, (int)blockIdx.x); pg8::EpiResid<0, 0> E{F.x, nullptr, F.XB, SSQ1};
        pg8::gemm_phase<pg8::EpiResid<0, 0>, SO, true, true>(F.lds, g, S, E, F.wave); } SEAM(5);
    STAMP(6); if (IN(6)) { pg8::Gemm g{F.XB, F.Wup0, M, FF, D}; SO S; S.init(M, FF, F.G, (int)blockIdx.x); pg8::EpiScale<1> E{F.R1, FF, SSQ1};
        pg8::gemm_phase<pg8::EpiScale<1>, SO, true, true>(F.lds, g, S, E, F.wave); } SEAM(6);
    STAMP(7); if (IN(7)) { pg8::Gemm g{F.R1, F.Wdn0, M, D, FF}; SO S; S.init(M, D, F.G, (int)blockIdx.x); pg8::EpiResid<1, 0> E{F.XB, nullptr, F.XB, SSQ2};
        pg8::gemm_phase<pg8::EpiResid<1, 0>, SO, true, true>(F.lds, g, S, E, F.wave); } SEAM(7);
    STAMP(8); if (IN(8)) { pg8::Gemm g{F.XB, F.Winc, M, NC, D}; SO S; S.init(M, NC, F.G, (int)blockIdx.x); pg8::EpiScale<0> E{F.R1, NC, SSQ2};
        pg8::gemm_phase<pg8::EpiScale<0>, SO, true, true>(F.lds, g, S, E, F.wave); } SEAM(8);
    STAMP(9); if (IN(9)) { ph_prep_c_fast(F); } SEAM(9);
    STAMP(10); if (IN(10)) { ph_sb(F); } SEAM(10);
    STAMP(11); if (IN(11)) { pg8::Gemm g{F.CAT, F.Woc, M, D, D}; SO S; S.init(M, D, F.G, (int)blockIdx.x); pg8::EpiResid<1, 0> E{F.XB, nullptr, F.XB, SSQ3};
        pg8::gemm_phase<pg8::EpiResid<1, 0>, SO, true, true>(F.lds, g, S, E, F.wave); } SEAM(11);
    STAMP(12); if (IN(12)) { pg8::Gemm g{F.XB, F.Wup1, M, FF, D}; SO S; S.init(M, FF, F.G, (int)blockIdx.x); pg8::EpiScale<1> E{F.R1, FF, SSQ3};
        pg8::gemm_phase<pg8::EpiScale<1>, SO, true, true>(F.lds, g, S, E, F.wave); } SEAM(12);
    STAMP(13); if (IN(13)) { pg8::Gemm g{F.R1, F.Wdn1, M, D, FF}; SO S; S.init(M, D, F.G, (int)blockIdx.x); pg8::EpiResid<1, 1> E{F.XB, F.out, nullptr, nullptr};
        pg8::gemm_phase<pg8::EpiResid<1, 1>, SO, true, true>(F.lds, g, S, E, F.wave); }
    STAMP(NPH);
#ifdef PROBE_PH
    if (blockIdx.x == 0) { const unsigned long long t1 = __builtin_amdgcn_s_memrealtime(), dt = (pt1 - pt0) * PROBE_MULT; while (__builtin_amdgcn_s_memrealtime() - t1 < dt) __builtin_amdgcn_s_sleep(8); }
#endif
#undef IN
#undef SEAM
}

extern "C" void kernel_launch(void* const* d_in, const int* in_sizes, int n_in, void* d_out, int out_size, void* d_ws, size_t ws_size, hipStream_t stream) {
    static int grid = 0;
    if (grid == 0) {
        if (n_in != 16 || in_sizes[0] != M * D || out_size != M * D || ws_size < WS_END) { fprintf(stderr, "kernel_launch: unexpected shapes / workspace (%d inputs, ws %zu)\n", n_in, ws_size); grid = -1; return; }
        int dev = 0, cus = 0;
        if (hipGetDevice(&dev) != hipSuccess || hipDeviceGetAttribute(&cus, hipDeviceAttributeMultiprocessorCount, dev) != hipSuccess) { grid = -1; return; }
        if (hipFuncSetAttribute((const void*)mk_fwd, hipFuncAttributeMaxDynamicSharedMemorySize, LDS_BYTES) != hipSuccess) { fprintf(stderr, "kernel_launch: hipFuncSetAttribute failed\n"); grid = -1; return; }
        (void)hipGetLastError();
        grid = cus;
    }
    if (grid < 0) return;
    if (hipMemsetAsync((char*)d_ws + WS_CTL, 0, CTL_ZERO_BYTES, stream) != hipSuccess) { fprintf(stderr, "kernel_launch: memset failed\n"); return; }
    Args a{};
    for (int i = 0; i < 16; ++i) a.in[i] = (const float*)d_in[i];
    a.out = (float*)d_out; a.ws = (unsigned char*)d_ws;
#if MK_PER_PHASE
    for (int ph = 0; ph < NPH; ++ph) { a.ph_lo = ph; a.ph_hi = ph + 1; hipLaunchKernelGGL(mk_fwd, dim3(grid), dim3(NTHR), LDS_BYTES, stream, a); }
#else
    a.ph_lo = 0; a.ph_hi = NPH;
    hipLaunchKernelGGL(mk_fwd, dim3(grid), dim3(NTHR), LDS_BYTES, stream, a);
#endif
    const hipError_t le = hipPeekAtLastError();
    if (le != hipSuccess) fprintf(stderr, "kernel_launch: launch failed: %s\n", hipGetErrorName(le));
}
```

```cpp
#include <hip/hip_runtime.h>
#include <cstdio>
#include <cstdint>
namespace pg8 {
#define PG8_LAS __attribute__((address_space(3)))
typedef unsigned short bf16_t;
typedef short bf16x8 __attribute__((ext_vector_type(8)));
typedef float f32x4 __attribute__((ext_vector_type(4)));
typedef unsigned u32x4 __attribute__((ext_vector_type(4)));
constexpr int BM = 256, BK = 64, HALF = 128, HTB = HALF * BK * 2  , STAGE_BYTES = 8 * HTB, NXCD = 8, WGM = 8;

__host__ __device__ __forceinline__ int lds_byte(int r, int c) { const int st = (r >> 4) * 2 + (c >> 5), rr = r & 15, cc = c & 31, ob = rr * 64 + cc * 2; return st * 1024 + (ob ^ (((ob >> 9) & 1) << 5)); }
__host__ __device__ __forceinline__ void stage_rc(int b, int& R, int& C) { const int st = b / 1024, sb = b % 1024, swz = sb ^ (((sb >> 9) & 1) << 5); R = (st >> 1) * 16 + swz / 64; C = (st & 1) * 32 + (swz % 64) / 2; }
__host__ __device__ __forceinline__ int perm32(int rho) { const int n = rho >> 4, i = rho & 15; return 8 * (i >> 2) + 4 * n + (i & 3); }

struct Unit { int pm, pn; };
struct Gemm { const bf16_t* A; const bf16_t* Bt; int M, N, K; };

struct StaticOrder {
    int nM, nN, nwg, G, c;
    __host__ __device__ void init(int M, int N, int G_, int c_) { nM = M / BM; nN = N / BM; nwg = nM * nN; G = G_; c = c_; }
    __host__ __device__ bool next(int i, Unit& u) const {
        const long L = (long)i * G + c; if (L >= nwg) return false;
        int wgid = (int)L; { const int q = nwg / NXCD, r = nwg % NXCD, xcd = wgid % NXCD, off = wgid / NXCD; wgid = (xcd < r ? xcd * (q + 1) : r * (q + 1) + (xcd - r) * q) + off; }
        const int nig = WGM * nN, gid = wgid / nig, fm = gid * WGM, gsz = (nM - fm) < WGM ? (nM - fm) : WGM;
        u.pm = fm + ((wgid % nig) % gsz); u.pn = (wgid % nig) / gsz; return true;
    }
    __device__ __forceinline__ void a_ready(const Unit&) const {}
    __device__ __forceinline__ void done(const Unit&) const {}
};

__device__ __forceinline__ unsigned cvt_pk_bf16(float lo, float hi) { unsigned r; asm volatile("v_cvt_pk_bf16_f32 %0, %1, %2" : "=v"(r) : "v"(lo), "v"(hi)); return r; }
__device__ __forceinline__ float row_rstd(const float* ssqp, int row) {
    const f32x4* p = (const f32x4*)(ssqp + (size_t)row * 16);
    const f32x4 a = p[0], b = p[1], c = p[2], d = p[3];
    const float s = (((a[0] + a[1]) + (a[2] + a[3])) + ((b[0] + b[1]) + (b[2] + b[3]))) + (((c[0] + c[1]) + (c[2] + c[3])) + ((d[0] + d[1]) + (d[2] + d[3])));
    return rsqrtf(s * (1.0f / 1024.0f) + 1e-6f);
}
template <int ACT  > struct EpiScale {
    static constexpr bool PERM = true, AFTER_DRAIN = false;
    bf16_t* O; int ldc; const float* ssqp;
    __device__ __forceinline__ void operator()(const f32x4 (&acc)[2][2][4][2], const Unit& u, int wr, int wc, int fr, int fq) const {
        const int row0 = u.pm * BM + wr * 64 + fr, col0 = u.pn * BM + wc * 32 + 8 * fq;
#pragma unroll
        for (int ai = 0; ai < 2; ++ai)
#pragma unroll
            for (int m = 0; m < 4; ++m) {
                const int row = row0 + ai * HALF + m * 16;
                const float rs = row_rstd(ssqp, row);
                bf16_t* rowp = O + (size_t)row * ldc + col0;
#pragma unroll
                for (int bj = 0; bj < 2; ++bj) {
                    f32x4 v0 = acc[ai][bj][m][0] * rs, v1 = acc[ai][bj][m][1] * rs;
                    if (ACT == 1) {
#pragma unroll
                        for (int e = 0; e < 4; ++e) { const float a0 = fmaxf(v0[e], 0.f), a1 = fmaxf(v1[e], 0.f); v0[e] = a0 * a0; v1[e] = a1 * a1; }
                    }
                    u32x4 w; w.x = cvt_pk_bf16(v0[0], v0[1]); w.y = cvt_pk_bf16(v0[2], v0[3]); w.z = cvt_pk_bf16(v1[0], v1[1]); w.w = cvt_pk_bf16(v1[2], v1[3]);
                    *(u32x4*)(rowp + bj * HALF) = w;
                }
            }
    }
};
template <int RIN, int OUT> struct EpiResid {
    static constexpr bool PERM = true, AFTER_DRAIN = false;
    const void* R; float* out; bf16_t* hb; float* ssqp;
    __device__ __forceinline__ void operator()(const f32x4 (&acc)[2][2][4][2], const Unit& u, int wr, int wc, int fr, int fq) const {
        const int row0 = u.pm * BM + wr * 64 + fr, col0 = u.pn * BM + wc * 32 + 8 * fq;
#pragma unroll
        for (int ai = 0; ai < 2; ++ai)
#pragma unroll
            for (int m = 0; m < 4; ++m) {
                const int row = row0 + ai * HALF + m * 16;
                const size_t off = (size_t)row * 1024 + col0;
                float ss = 0.f;
#pragma unroll
                for (int bj = 0; bj < 2; ++bj) {
                    f32x4 r0, r1;
                    if (RIN == 0) { r0 = *(const f32x4*)((const float*)R + off + bj * HALF); r1 = *(const f32x4*)((const float*)R + off + bj * HALF + 4); }
                    else { const u32x4 rw = *(const u32x4*)((const bf16_t*)R + off + bj * HALF);
                        r0 = (f32x4){__uint_as_float(rw.x << 16), __uint_as_float(rw.x & 0xffff0000u), __uint_as_float(rw.y << 16), __uint_as_float(rw.y & 0xffff0000u)};
                        r1 = (f32x4){__uint_as_float(rw.z << 16), __uint_as_float(rw.z & 0xffff0000u), __uint_as_float(rw.w << 16), __uint_as_float(rw.w & 0xffff0000u)}; }
                    const f32x4 v0 = acc[ai][bj][m][0] + r0, v1 = acc[ai][bj][m][1] + r1;
                    if (OUT == 1) { *(f32x4*)(out + off + bj * HALF) = v0; *(f32x4*)(out + off + bj * HALF + 4) = v1; }
                    else {
                        u32x4 w; w.x = cvt_pk_bf16(v0[0], v0[1]); w.y = cvt_pk_bf16(v0[2], v0[3]); w.z = cvt_pk_bf16(v1[0], v1[1]); w.w = cvt_pk_bf16(v1[2], v1[3]);
                        *(u32x4*)(hb + off + bj * HALF) = w;
                        ss += ((v0[0] * v0[0] + v0[1] * v0[1]) + (v0[2] * v0[2] + v0[3] * v0[3])) + ((v1[0] * v1[0] + v1[1] * v1[1]) + (v1[2] * v1[2] + v1[3] * v1[3]));
                    }
                }
                if (OUT == 0) { ss += __shfl_xor(ss, 16); ss += __shfl_xor(ss, 32); if (fq == 0) ssqp[(size_t)row * 16 + u.pn * 4 + wc] = ss; }
            }
    }
};
template <class Epi, class Sched, bool ALIGN_EPI = false, bool SP2 = false>
__device__ __forceinline__ void gemm_phase(PG8_LAS unsigned char* lds, const Gemm g, const Sched& S, const Epi& E, const int wave_in) {
    const int wid = wave_in, lane = (int)__builtin_amdgcn_mbcnt_hi(~0u, __builtin_amdgcn_mbcnt_lo(~0u, 0u)), tid = wid * 64 + lane, wr = wid >> 2, wc = wid & 3, fr = lane & 15, fq = lane >> 4;
    const int K = g.K, nt = K / BK;
    unsigned voffA[2], voffB[2];
#pragma unroll
    for (int i = 0; i < 2; ++i) { int R, C; stage_rc(tid * 16 + i * 8192, R, C); const int Rb = Epi::PERM ? ((R & ~31) + perm32(R & 31)) : R;
        voffA[i] = (unsigned)(R * K + C) * 2u; voffB[i] = (unsigned)(Rb * K + C) * 2u; }
    const size_t kstep = (size_t)(BK * 2);
    const size_t hstep = (size_t)HALF * K * 2;
    const size_t tstep = 2 * hstep;
    const unsigned ldsw = (unsigned)wid * 1024u;
    const int aoff = lds_byte(wr * 64 + fr, fq * 8), boff = lds_byte(wc * 32 + fr, fq * 8);
#define PG8_SA(b, h) (((b) * 2 + (h)) * HTB)
#define PG8_SB(b, h) ((4 + (b) * 2 + (h)) * HTB)
#define PG8_STAGE(bufoff, gbase, voff) do { _Pragma("unroll") for (int _i = 0; _i < 2; ++_i) \
        __builtin_amdgcn_global_load_lds((const unsigned*)((const char*)(gbase) + (voff)[_i]), (PG8_LAS unsigned*)(lds + (bufoff) + ldsw + _i * 8192), 16, 0, 0); } while (0)
#define PG8_LDA(dst, b, h) do { _Pragma("unroll") for (int m = 0; m < 4; ++m) _Pragma("unroll") for (int k = 0; k < 2; ++k) dst[m][k] = *(const PG8_LAS bf16x8*)(lds + PG8_SA(b, h) + aoff + m * 2048 + k * 1024); } while (0)
#define PG8_LDB(dst, b, h) do { _Pragma("unroll") for (int n = 0; n < 2; ++n) _Pragma("unroll") for (int k = 0; k < 2; ++k) dst[n][k] = *(const PG8_LAS bf16x8*)(lds + PG8_SB(b, h) + boff + n * 2048 + k * 1024); } while (0)
#define PG8_MMA(ai, bj, At, Bt) do { __builtin_amdgcn_s_setprio(1); _Pragma("unroll") for (int m = 0; m < 4; ++m) _Pragma("unroll") for (int n = 0; n < 2; ++n) _Pragma("unroll") for (int k = 0; k < 2; ++k) \
        acc[ai][bj][m][n] = __builtin_amdgcn_mfma_f32_16x16x32_bf16(Bt[n][k], At[m][k], acc[ai][bj][m][n], 0, 0, 0); __builtin_amdgcn_s_setprio(0); } while (0)
#define PG8_WAIT_V(n) asm volatile("s_waitcnt vmcnt(" #n ")" ::: "memory")
#define PG8_WAIT_L(n) asm volatile("s_waitcnt lgkmcnt(" #n ")" ::: "memory")
#define PG8_BAR __builtin_amdgcn_s_barrier()
#define PG8_SCHED __builtin_amdgcn_sched_barrier(0)
    Unit cur, nxt; int ui = 0;
    if (!S.next(0, cur)) return;
    f32x4 acc[2][2][4][2];
#pragma unroll
    for (int a = 0; a < 2; ++a)
#pragma unroll
        for (int b = 0; b < 2; ++b)
#pragma unroll
            for (int m = 0; m < 4; ++m)
#pragma unroll
                for (int n = 0; n < 2; ++n) acc[a][b][m][n] = (f32x4){0.f, 0.f, 0.f, 0.f};
    bf16x8 At[4][2], B0[2][2], B1[2][2];
    const char* cA = (const char*)g.A + (size_t)cur.pm * tstep; const char* cB = (const char*)g.Bt + (size_t)cur.pn * tstep;
    S.a_ready(cur);
    if constexpr (SP2) {
        PG8_STAGE(PG8_SB(0, 0), cB, voffB); PG8_STAGE(PG8_SB(0, 1), cB + hstep, voffB); PG8_STAGE(PG8_SA(0, 0), cA, voffA); PG8_STAGE(PG8_SA(0, 1), cA + hstep, voffA);
        if (wr == 1) PG8_BAR;
        PG8_WAIT_V(2); PG8_BAR;
        PG8_STAGE(PG8_SB(1, 0), cB + kstep, voffB); PG8_STAGE(PG8_SA(1, 0), cA + kstep, voffA); PG8_STAGE(PG8_SB(1, 1), cB + hstep + kstep, voffB);
        PG8_WAIT_V(6); PG8_BAR;
    } else {
        PG8_STAGE(PG8_SB(0, 0), cB, voffB); PG8_STAGE(PG8_SA(0, 0), cA, voffA); PG8_STAGE(PG8_SB(0, 1), cB + hstep, voffB); PG8_STAGE(PG8_SA(0, 1), cA + hstep, voffA);
        if (wr == 1) PG8_BAR;
        PG8_WAIT_V(4); PG8_BAR;
        PG8_STAGE(PG8_SB(1, 0), cB + kstep, voffB); PG8_STAGE(PG8_SA(1, 0), cA + kstep, voffA); PG8_STAGE(PG8_SB(1, 1), cB + hstep + kstep, voffB);
        PG8_WAIT_V(6); PG8_BAR;
    }
    for (;;) {
        const bool has_next = S.next(ui + 1, nxt);
        const char* nA = has_next ? (const char*)g.A + (size_t)nxt.pm * tstep : cA; const char* nB = has_next ? (const char*)g.Bt + (size_t)nxt.pn * tstep : cB;
        for (int t = 0; t < nt; t += 2) {
            const bool last = (t == nt - 2);
            const char* a1 = cA + (size_t)(t + 1) * kstep;
            const char* a2 = last ? nA : cA + (size_t)(t + 2) * kstep; const char* b2 = last ? nB : cB + (size_t)(t + 2) * kstep;
            const char* a3 = a2 + kstep; const char* b3 = b2 + kstep;
            if (last && has_next) S.a_ready(nxt);
            if constexpr (SP2) {
            PG8_LDB(B0, 0, 0); PG8_LDB(B1, 0, 1); PG8_SCHED; PG8_LDA(At, 0, 0); PG8_STAGE(PG8_SA(1, 1), a1 + hstep, voffA);
            PG8_WAIT_V(8); PG8_WAIT_L(0); PG8_BAR; PG8_MMA(0, 0, At, B0); PG8_MMA(0, 1, At, B1); PG8_BAR; PG8_SCHED;
            PG8_LDA(At, 0, 1); PG8_STAGE(PG8_SB(0, 0), b2, voffB); PG8_STAGE(PG8_SB(0, 1), b2 + hstep, voffB); PG8_STAGE(PG8_SA(0, 0), a2, voffA);
            PG8_WAIT_V(8); PG8_WAIT_L(0); PG8_BAR; PG8_MMA(1, 0, At, B0); PG8_MMA(1, 1, At, B1); PG8_BAR; PG8_SCHED;
            PG8_LDB(B0, 1, 0); PG8_LDB(B1, 1, 1); PG8_SCHED; PG8_LDA(At, 1, 0); PG8_STAGE(PG8_SA(0, 1), a2 + hstep, voffA);
            PG8_WAIT_V(8); PG8_WAIT_L(0); PG8_BAR; PG8_MMA(0, 0, At, B0); PG8_MMA(0, 1, At, B1); PG8_BAR; PG8_SCHED;
            PG8_LDA(At, 1, 1); PG8_STAGE(PG8_SB(1, 0), b3, voffB); PG8_STAGE(PG8_SB(1, 1), b3 + hstep, voffB); PG8_STAGE(PG8_SA(1, 0), a3, voffA);
            PG8_WAIT_V(8); PG8_WAIT_L(0); PG8_BAR; PG8_MMA(1, 0, At, B0); PG8_MMA(1, 1, At, B1); PG8_BAR; PG8_SCHED;
            } else {
            PG8_LDB(B0, 0, 0); PG8_SCHED; PG8_LDA(At, 0, 0); PG8_STAGE(PG8_SA(1, 1), a1 + hstep, voffA);
            PG8_WAIT_L(8); PG8_BAR; PG8_WAIT_L(0); PG8_MMA(0, 0, At, B0); PG8_BAR; PG8_SCHED;
            PG8_LDB(B1, 0, 1); PG8_STAGE(PG8_SB(0, 0), b2, voffB);
            PG8_BAR; PG8_WAIT_L(0); PG8_MMA(0, 1, At, B1); PG8_BAR;
            PG8_LDA(At, 0, 1); PG8_STAGE(PG8_SA(0, 0), a2, voffA);
            PG8_BAR; PG8_WAIT_L(0); PG8_MMA(1, 0, At, B0); PG8_BAR; PG8_SCHED;
            PG8_STAGE(PG8_SB(0, 1), b2 + hstep, voffB);
            PG8_WAIT_V(6); PG8_BAR; PG8_MMA(1, 1, At, B1); PG8_BAR;
            PG8_LDB(B0, 1, 0); PG8_SCHED; PG8_LDA(At, 1, 0); PG8_STAGE(PG8_SA(0, 1), a2 + hstep, voffA);
            PG8_WAIT_L(8); PG8_BAR; PG8_WAIT_L(0); PG8_MMA(0, 0, At, B0); PG8_BAR; PG8_SCHED;
            PG8_LDB(B1, 1, 1); PG8_STAGE(PG8_SB(1, 0), b3, voffB);
            PG8_BAR; PG8_WAIT_L(0); PG8_MMA(0, 1, At, B1); PG8_BAR;
            PG8_LDA(At, 1, 1); PG8_STAGE(PG8_SA(1, 0), a3, voffA);
            PG8_BAR; PG8_WAIT_L(0); PG8_MMA(1, 0, At, B0); PG8_BAR; PG8_SCHED;
            PG8_STAGE(PG8_SB(1, 1), b3 + hstep, voffB);
            PG8_WAIT_V(6); PG8_BAR; PG8_MMA(1, 1, At, B1); PG8_BAR;
            }
        }
        if constexpr (ALIGN_EPI) { if (wr == 0) PG8_BAR; }
        if constexpr (!Epi::AFTER_DRAIN) { E(acc, cur, wr, wc, fr, fq); S.done(cur); }
        if (!has_next) break;
#pragma unroll
        for (int a = 0; a < 2; ++a)
#pragma unroll
            for (int b = 0; b < 2; ++b)
#pragma unroll
                for (int m = 0; m < 4; ++m)
#pragma unroll
                    for (int n = 0; n < 2; ++n) acc[a][b][m][n] = (f32x4){0.f, 0.f, 0.f, 0.f};
        cur = nxt; cA = nA; cB = nB; ++ui;
        if constexpr (ALIGN_EPI) { if (wr == 1) PG8_BAR; }
    }
    PG8_WAIT_V(0);
    if constexpr (!ALIGN_EPI) { if (wr == 0) PG8_BAR; }
    PG8_BAR;
    if constexpr (Epi::AFTER_DRAIN) { E.fused(acc, cur, wr, wc, fr, fq, lds, wid, lane); S.done(cur); }
#undef PG8_SA
#undef PG8_SB
#undef PG8_STAGE
#undef PG8_LDA
#undef PG8_LDB
#undef PG8_MMA
#undef PG8_WAIT_V
#undef PG8_WAIT_L
#undef PG8_BAR
#undef PG8_SCHED
}
}
#include <cmath>
constexpr int NWAVES = 8, NTHR = 512;
constexpr int BATCH = 16, SEQ = 2048, M = BATCH * SEQ, D = 1024, FF = 4096, NAB = 3840, NC = 3072, ABP_OLD = 3672;
constexpr int C_QA = 0, C_KA = 512, C_VA = 1024, C_IQ = 1536, C_QB = 2048, C_KB = 2304, C_VB = 2560, C_OG = 3072, C_IK = 3584, C_IW = 3648, C_GL = 3656;
constexpr float EPS = 1e-6f;
constexpr size_t MiB = 1u << 20;
constexpr size_t WS_CTL = 0, CTL_ZERO_BYTES = 1 * MiB;
constexpr size_t WS_WAB = 1 * MiB, WS_WOAB = 9 * MiB, WS_WUP0 = 11 * MiB, WS_WDN0 = 19 * MiB, WS_WINC = 27 * MiB, WS_WOC = 33 * MiB, WS_WUP1 = 35 * MiB, WS_WDN1 = 43 * MiB;
constexpr size_t WS_SSQ = 51 * MiB, SSQ_BYTES = 2 * MiB;
constexpr size_t WS_DEC = 59 * MiB;
constexpr size_t WS_ROPE = 59 * MiB + 512 * 1024;
constexpr size_t WS_XB = 60 * MiB;
constexpr size_t WS_CAT = 124 * MiB;
constexpr size_t WS_MASK = 188 * MiB;
constexpr size_t WS_R1 = 196 * MiB;
constexpr size_t WS_END = 452 * MiB;
constexpr int CW_BAR = 4096;
constexpr int RING_BYTES = 131072;
constexpr int LDS_BYTES = 163840;
constexpr int MISC_OFF = LDS_BYTES - 256;
#define GAS __attribute__((address_space(1)))
#define LAS __attribute__((address_space(3)))
typedef unsigned short bf16;
typedef unsigned v4u __attribute__((ext_vector_type(4)));
typedef float f32x4 __attribute__((ext_vector_type(4)));
typedef short bf16x8 __attribute__((ext_vector_type(8)));
typedef GAS unsigned gu32;
typedef GAS unsigned long long gu64;
#define RLX_AGENT __ATOMIC_RELAXED, __HIP_MEMORY_SCOPE_AGENT
#define LDS_WAIT() asm volatile("s_waitcnt lgkmcnt(0)" ::: "memory")
#define VM_WAIT() asm volatile("s_waitcnt vmcnt(0)" ::: "memory")
__device__ __forceinline__ unsigned long long rt() { return __builtin_amdgcn_s_memrealtime(); }
__device__ __forceinline__ unsigned f2bf(float f) { unsigned u = __builtin_bit_cast(unsigned, f); return (u + 0x7fffu + ((u >> 16) & 1u)) >> 16; }
__device__ __forceinline__ unsigned pk2(float lo, float hi) { return f2bf(lo) | (f2bf(hi) << 16); }
#define XB_TMO      128
#define XB_XCNT(j)  (256  + 64 * (j))
#define XB_XSUB(j)  (1280 + 64 * (j))
#define XB_XGEN(j)  (2304 + 64 * (j))
#define XB_TOP      3328
#define XB_TOPGEN   3392
#define XCD_BAR_WORDS 3456
#define XB_SPIN_CAP (1u << 18)

__device__ __forceinline__ unsigned xb_ld(unsigned* p)              { return __hip_atomic_load(p, __ATOMIC_RELAXED, __HIP_MEMORY_SCOPE_AGENT); }
__device__ __forceinline__ unsigned xb_add(unsigned* p, unsigned v) { return __hip_atomic_fetch_add(p, v, __ATOMIC_RELAXED, __HIP_MEMORY_SCOPE_AGENT); }
__device__ __forceinline__ unsigned xb_xcc_id() { return (unsigned)__builtin_amdgcn_s_getreg((3 << 11) | 20) & 0xFu; }
#define XB_SPIN(cond, bar) do { unsigned _sp = 0; while (cond) { __builtin_amdgcn_s_sleep(1); \
    if ((++_sp & 255u) == 0u) { if (xb_ld(&(bar)[XB_TMO])) break; if (_sp > XB_SPIN_CAP) { atomicAdd(&(bar)[XB_TMO], 1u); break; } } } } while (0)

struct XcdBarrier {
    unsigned* bar; unsigned x; int wave;
    volatile LAS unsigned* st;
};

__device__ __forceinline__ bool xb_t0(int wave) { return wave == 0 && __builtin_amdgcn_mbcnt_hi(~0u, __builtin_amdgcn_mbcnt_lo(~0u, 0u)) == 0u; }
__device__ __forceinline__ XcdBarrier xcd_barrier_post(unsigned* bar, volatile LAS unsigned* st, int wave) {
    XcdBarrier b; b.bar = bar; b.x = xb_xcc_id(); b.st = st; b.wave = wave;
    if (xb_t0(wave)) (void)xb_add(&bar[XB_XCNT(b.x)], 1u);
    return b;
}
__device__ __forceinline__ void xcd_barrier_complete(unsigned* bar, unsigned x, unsigned& nloc, unsigned& nx) {
    const unsigned G = gridDim.x * gridDim.y * gridDim.z;
    unsigned sum, cnt, mine, sp = 0u;
    for (;;) {
        sum = 0u; cnt = 0u; mine = 0u;
#pragma unroll
        for (unsigned j = 0; j < 16; ++j) { const unsigned c = xb_ld(&bar[XB_XCNT(j)]); sum += c; cnt += (c > 0u) ? 1u : 0u; mine = (j == x) ? c : mine; }
        if (sum == G) break;
        __builtin_amdgcn_s_sleep(1);
        if ((++sp & 255u) == 0u) { if (xb_ld(&bar[XB_TMO])) break; if (sp > XB_SPIN_CAP) { atomicAdd(&bar[XB_TMO], 1u); break; } }
    }
    nloc = mine > 0u ? mine : 1u; nx = cnt > 0u ? cnt : 1u;
}

__device__ __forceinline__ void xcd_barrier(const XcdBarrier& b) {
    asm volatile("s_waitcnt vmcnt(0)" ::: "memory");
    __syncthreads();
    if (xb_t0(b.wave)) {
        unsigned* bar = b.bar;
        __builtin_amdgcn_s_waitcnt(0);
        unsigned nloc = b.st[0], nx = b.st[1];
        if (nloc == 0u) { xcd_barrier_complete(bar, b.x, nloc, nx); b.st[0] = nloc; b.st[1] = nx; }
        const unsigned old = xb_add(&bar[XB_XSUB(b.x)], 1u);
        const unsigned gen = old / nloc;
        if (old + 1u == (gen + 1u) * nloc) {
            __builtin_amdgcn_fence(__ATOMIC_RELEASE, "agent");
            asm volatile("s_waitcnt vmcnt(0)" ::: "memory");
            const unsigned og = xb_add(&bar[XB_TOP], 1u);
            const unsigned tg = og / nx;
            if (og + 1u == (tg + 1u) * nx) xb_add(&bar[XB_TOPGEN], 1u);
            else XB_SPIN(xb_ld(&bar[XB_TOPGEN]) == tg, bar);
            __builtin_amdgcn_fence(__ATOMIC_ACQUIRE, "agent");
            xb_add(&bar[XB_XGEN(b.x)], 1u);
            asm volatile("s_waitcnt vmcnt(0)" ::: "memory");
        } else {
            XB_SPIN(xb_ld(&bar[XB_XGEN(b.x)]) == gen, bar);
            __builtin_amdgcn_fence(__ATOMIC_ACQUIRE, "agent");
            asm volatile("s_waitcnt vmcnt(0)" ::: "memory");
        }
    }
    __syncthreads();
}
#ifdef PROBE_ACC
#define ACC_BEGIN(F, id) do { if ((id) == PROBE_ACC) { __syncthreads(); (F).acc_t0 = __builtin_amdgcn_s_memrealtime(); } } while (0)
#define ACC_END(F, id) do { if ((id) == PROBE_ACC) { __syncthreads(); (F).acc_sum += __builtin_amdgcn_s_memrealtime() - (F).acc_t0; } } while (0)
#else
#define ACC_BEGIN(F, id) do { } while (0)
#define ACC_END(F, id) do { } while (0)
#endif
struct Frame {
#ifdef PROBE_ACC
    unsigned long long acc_t0, acc_sum;
#endif
    LAS unsigned char* lds;
    volatile LAS unsigned* MISC;
    gu32* ctl;
    int tid, lane, wave, vcu, G;
    const float *x, *g_mix, *g_ffn, *w_in_ab, *gq_a, *gk_a, *w_gate_up, *b_gate, *g_gla, *w_out_ab, *w_in_c, *gq_c, *gk_c, *w_out_c, *w_up, *w_down;
    float* out;
    bf16 *Wab, *Woab, *Wup0, *Wdn0, *Winc, *Woc, *Wup1, *Wdn1;
    bf16 *XB, *CAT, *R1;
    float* SSQ; unsigned* MASK;
};
__device__ __forceinline__ int lane_id_opaque() { int l; asm volatile("v_mbcnt_lo_u32_b32 %0, -1, 0\n\tv_mbcnt_hi_u32_b32 %0, -1, %0" : "=v"(l)); return l; }
__device__ __forceinline__ float bf2f(bf16 v) { return __builtin_bit_cast(float, (unsigned)v << 16); }
__device__ __forceinline__ float wave_sum(float v) {
#pragma unroll
    for (int o = 1; o < 64; o <<= 1) v += __shfl_xor(v, o);
    return v;
}
__device__ __forceinline__ float wave_max(float v) {
#pragma unroll
    for (int o = 1; o < 64; o <<= 1) v = fmaxf(v, __shfl_xor(v, o));
    return v;
}
__device__ __forceinline__ float log_sigmoid(float x) { return fminf(x, 0.f) - log1pf(expf(-fabsf(x))); }

__device__ __forceinline__ int oldcol_ab(int n) {
    if (n < 2048) return n;
    if (n < 2304) return 2120 + (n - 2048);
    if (n < 2560) return 2376 + (n - 2304);
    if (n < 3072) return 2632 + (n - 2560);
    if (n < 3584) return 3160 + (n - 3072);
    if (n < 3648) return 2048 + (n - 3584);
    if (n < 3656) return 2112 + (n - 3648);
    if (n < 3672) return 3144 + (n - 3656);
    return -1;
}
__device__ __forceinline__ void p0_transpose_item(const float* W, int ldw, int K, const float* gain, bf16* WT, bool map, int item, int nblk, int lane) {
    const int kb = item / nblk, nb = item % nblk, ng = lane & 7, ko = lane >> 3, k0 = 64 * kb + 8 * ko, n = 32 * nb + 4 * ng;
    const int oc = map ? oldcol_ab(n) : n;
    f32x4 v[8];
#pragma unroll
    for (int i = 0; i < 8; ++i) { v[i] = (f32x4){0.f, 0.f, 0.f, 0.f}; if (oc >= 0) v[i] = *(const GAS f32x4*)(W + (size_t)(k0 + i) * ldw + oc); }
    if (gain) { const f32x4 g0 = *(const GAS f32x4*)(gain + k0), g1 = *(const GAS f32x4*)(gain + k0 + 4);
#pragma unroll
        for (int i = 0; i < 4; ++i) { v[i] = v[i] * g0[i]; v[4 + i] = v[4 + i] * g1[i]; } }
#pragma unroll
    for (int e = 0; e < 4; ++e) { v4u o; o.x = pk2(v[0][e], v[1][e]); o.y = pk2(v[2][e], v[3][e]); o.z = pk2(v[4][e], v[5][e]); o.w = pk2(v[6][e], v[7][e]);
        *(GAS v4u*)(WT + (size_t)(n + e) * K + k0) = o; }
}
__device__ __forceinline__ void ph_prologue(Frame& F) {
    const int gw = F.vcu * NWAVES + F.wave, NGW = F.G * NWAVES;
    constexpr int I_AB = (D / 64) * (NAB / 32), I_O = (D / 64) * (D / 32), I_UP = (D / 64) * (FF / 32), I_DN = (FF / 64) * (D / 32), I_C = (D / 64) * (NC / 32);
    constexpr int NITEMS = I_AB + 2 * I_O + 2 * I_UP + 2 * I_DN + I_C;
    for (int it = gw; it < NITEMS; it += NGW) {
        int r = it;
        if (r < I_AB) { p0_transpose_item(F.w_in_ab, ABP_OLD, D, F.g_mix, F.Wab, true, r, NAB / 32, F.lane); continue; } r -= I_AB;
        if (r < I_O) { p0_transpose_item(F.w_out_ab, D, D, nullptr, F.Woab, false, r, D / 32, F.lane); continue; } r -= I_O;
        if (r < I_UP) { p0_transpose_item(F.w_up, FF, D, F.g_ffn, F.Wup0, false, r, FF / 32, F.lane); continue; } r -= I_UP;
        if (r < I_DN) { p0_transpose_item(F.w_down, D, FF, nullptr, F.Wdn0, false, r, D / 32, F.lane); continue; } r -= I_DN;
        if (r < I_C) { p0_transpose_item(F.w_in_c, NC, D, F.g_mix + D, F.Winc, false, r, NC / 32, F.lane); continue; } r -= I_C;
        if (r < I_O) { p0_transpose_item(F.w_out_c, D, D, nullptr, F.Woc, false, r, D / 32, F.lane); continue; } r -= I_O;
        if (r < I_UP) { p0_transpose_item(F.w_up + (size_t)D * FF, FF, D, F.g_ffn + D, F.Wup1, false, r, FF / 32, F.lane); continue; } r -= I_UP;
        p0_transpose_item(F.w_down + (size_t)FF * D, D, FF, nullptr, F.Wdn1, false, r, D / 32, F.lane);
    }
    for (int m = gw; m < M; m += NGW) {
        const GAS f32x4* xr = (const GAS f32x4*)(F.x + (size_t)m * D) + F.lane;
        f32x4 v[4]; float s = 0.f;
#pragma unroll
        for (int j = 0; j < 4; ++j) { v[j] = xr[64 * j]; s += (v[j].x * v[j].x + v[j].y * v[j].y) + (v[j].z * v[j].z + v[j].w * v[j].w); }
        s = wave_sum(s);
        GAS unsigned long long* o8 = (GAS unsigned long long*)(F.XB + (size_t)m * D) + F.lane;
#pragma unroll
        for (int j = 0; j < 4; ++j) o8[64 * j] = (unsigned long long)pk2(v[j].x, v[j].y) | ((unsigned long long)pk2(v[j].z, v[j].w) << 32);
        if (F.lane < 16) F.SSQ[(size_t)m * 16 + F.lane] = (F.lane == 0) ? s : 0.f;
    }
}
namespace att {
typedef short s16x4 __attribute__((ext_vector_type(4)));
typedef float f32x16 __attribute__((ext_vector_type(16)));
typedef _Float16 f16x8 __attribute__((ext_vector_type(8)));
typedef unsigned u32x4 __attribute__((ext_vector_type(4)));
typedef short v4i16_t __attribute__((ext_vector_type(4)));
constexpr float C2 = 0.08838834764831845f * 1.4426950408889634f;
__device__ __forceinline__ int crow(int r, int hi) { return (r & 3) + 8 * (r >> 2) + 4 * hi; }
__device__ __forceinline__ int img_off(int row, int ch) { return 256 * row + 16 * (ch ^ (((row & 3) << 2) | ((row >> 2) & 3))); }
__device__ __forceinline__ bf16x8 pack8(float a0, float a1, float a2, float a3, float a4, float a5, float a6, float a7) {
    u32x4 w; w.x = pg8::cvt_pk_bf16(a0, a1); w.y = pg8::cvt_pk_bf16(a2, a3); w.z = pg8::cvt_pk_bf16(a4, a5); w.w = pg8::cvt_pk_bf16(a6, a7);
    return __builtin_bit_cast(bf16x8, w);
}
__device__ __forceinline__ f16x8 pack8h(float a0, float a1, float a2, float a3, float a4, float a5, float a6, float a7) {
    f16x8 r; r[0] = (_Float16)a0; r[1] = (_Float16)a1; r[2] = (_Float16)a2; r[3] = (_Float16)a3; r[4] = (_Float16)a4; r[5] = (_Float16)a5; r[6] = (_Float16)a6; r[7] = (_Float16)a7; return r;
}
__device__ __forceinline__ void dma_off_init(unsigned (&dvo)[2], int ld, int wave, int lane) {
#pragma unroll
    for (int i = 0; i < 2; ++i) { const int pi = 2 * wave + i, row = 4 * pi + (lane >> 4), pc = lane & 15, ch = pc ^ (((row & 3) << 2) | ((row >> 2) & 3)); dvo[i] = (unsigned)(row * ld + ch * 8) * 2u; }
}
__device__ __forceinline__ void tile_dma(const bf16* g, const unsigned (&dvo)[2], LAS unsigned char* buf, int wave) {
#pragma unroll
    for (int i = 0; i < 2; ++i) __builtin_amdgcn_global_load_lds((const unsigned*)((const char*)g + dvo[i]), (LAS unsigned*)(buf + 1024 * (2 * wave + i)), 16, 0, 0);
}
struct FragOff { int k[8]; int va[4]; int vd; };
__device__ __forceinline__ void frag_off_init(FragOff& fo, int lane) {
    const int hi = lane >> 5, r32 = lane & 31, i = lane & 15, q = i >> 2, p = i & 3, x = 2 * ((lane >> 4) & 1) + (p >> 1);
#pragma unroll
    for (int ks = 0; ks < 8; ++ks) fo.k[ks] = img_off(r32, 2 * ks + hi);
#pragma unroll
    for (int ct = 0; ct < 4; ++ct) fo.va[ct] = img_off(4 * hi + q, 4 * ct + x) + 8 * (p & 1);
    fo.vd = img_off(4 * hi + q + 8, x) - img_off(4 * hi + q, x);
}
__device__ __forceinline__ bf16x8 k_frag(const LAS unsigned char* kbuf, const FragOff& fo, int rt, int ks) { return *(const LAS bf16x8*)(kbuf + fo.k[ks] + 8192 * rt); }
__device__ __forceinline__ s16x4 vtr(const LAS unsigned char* p) { return __builtin_bit_cast(s16x4, __builtin_amdgcn_ds_read_tr16_b64_v4i16((LAS v4i16_t*)p)); }
__device__ __forceinline__ bf16x8 v_frag(const LAS unsigned char* vbuf, const FragOff& fo, int ct, int kk) {
    const s16x4 lo = vtr(vbuf + fo.va[ct] + 4096 * kk), hh = vtr(vbuf + fo.va[ct] + fo.vd + 4096 * kk);
    return (bf16x8){lo[0], lo[1], lo[2], lo[3], hh[0], hh[1], hh[2], hh[3]};
}
#define TR_READ(dst, addr, OFF) asm volatile("ds_read_b64_tr_b16 %0, %1 offset:%c2" : "=&v"(dst) : "v"(addr), "i"(OFF) : "memory")
#define LGKM_WAIT0() do { asm volatile("s_waitcnt lgkmcnt(0)" ::: "memory"); __builtin_amdgcn_sched_barrier(0); } while (0)
__device__ __forceinline__ bf16x8 mk_frag(s16x4 lo, s16x4 hh) { return (bf16x8){lo[0], lo[1], lo[2], lo[3], hh[0], hh[1], hh[2], hh[3]}; }
__device__ __forceinline__ int frag_va(int lane, int ct) { const int hi = lane >> 5, i = lane & 15, q = i >> 2, p = i & 3, x = 2 * ((lane >> 4) & 1) + (p >> 1); return img_off(4 * hi + q, 4 * ct + x) + 8 * (p & 1); }
__device__ __forceinline__ bf16x8 v_frag_rt(const LAS unsigned char* vbuf, int va, int vd, int kk) {
    const s16x4 lo = vtr(vbuf + va + 4096 * kk), hh = vtr(vbuf + va + vd + 4096 * kk);
    return (bf16x8){lo[0], lo[1], lo[2], lo[3], hh[0], hh[1], hh[2], hh[3]};
}
__device__ __forceinline__ void store_o(const f32x16 (&o)[4], const float (&rscale)[16], LAS unsigned char* stg, bf16* dst, int ld, int lane) {
    const int hi = lane >> 5, r32 = lane & 31;
#pragma unroll
    for (int r = 0; r < 16; ++r) { const int orow = crow(r, hi);
#pragma unroll
        for (int ct = 0; ct < 4; ++ct) *(LAS bf16*)(stg + orow * 256 + (32 * ct + r32) * 2) = (bf16)f2bf(o[ct][r] * rscale[r]); }
    asm volatile("s_waitcnt lgkmcnt(0)" ::: "memory");
#pragma unroll
    for (int i = 0; i < 8; ++i) { const int c = lane + 64 * i, row = c >> 4, ch = c & 15; const u32x4 v = *(const LAS u32x4*)(stg + row * 256 + ch * 16); *(u32x4*)(dst + (size_t)row * ld + ch * 8) = v; }
}
}
template <bool SCALEQ> __device__ __forceinline__ void ph_prep_a(Frame& F) {
    const int gw = F.vcu * NWAVES + F.wave, NGW = F.G * NWAVES, lane = F.lane;
    for (int tok = gw; tok < M; tok += NGW) {
        const float pos = (float)(tok & (SEQ - 1));
        bf16* pr = F.R1 + (size_t)tok * NAB;
        float c128 = 1.f, s128 = 0.f;
        if (lane < 32) { const int i = lane & 15; const float inv = powf(500000.0f, -(float)i * 2.0f / 32.0f); const float ang = pos * inv; c128 = cosf(ang); s128 = sinf(ang); }
#pragma unroll
        for (int which = 0; which < 2; ++which) {
            const int base = which == 0 ? C_QA : C_KA;
            const float* gn = which == 0 ? F.gq_a : F.gk_a;
            for (int h = 0; h < 4; ++h) {
                float a = bf2f(pr[base + h * 128 + lane]), b = bf2f(pr[base + h * 128 + 64 + lane]);
                const float ss = wave_sum(a * a + b * b);
                const float rs = rsqrtf(ss * (1.f / 128.f) + EPS);
                const float qs = (SCALEQ && which == 0) ? att::C2 : 1.0f;
                a = a * rs * gn[lane] * qs; b = b * rs * gn[64 + lane] * qs;
                const float other = __shfl_xor(a, 16);
                float o = a;
                if (lane < 16) o = a * c128 - other * s128;
                else if (lane < 32) o = a * c128 + other * s128;
                pr[base + h * 128 + lane] = (bf16)f2bf(o); pr[base + h * 128 + 64 + lane] = (bf16)f2bf(b);
            }
        }
        float c64 = 1.f, s64 = 0.f;
        if (lane < 16) { const int i = lane & 7; const float inv = powf(500000.0f, -(float)i * 2.0f / 16.0f); const float ang = pos * inv; c64 = cosf(ang); s64 = sinf(ang); }
        for (int h = 0; h < 9; ++h) {
            const int col = (h < 8) ? C_IQ + h * 64 : C_IK;
            const float a = bf2f(pr[col + lane]);
            const float other = __shfl_xor(a, 8);
            float o = a;
            if (lane < 8) o = a * c64 - other * s64;
            else if (lane < 16) o = a * c64 + other * s64;
            pr[col + lane] = (bf16)f2bf(o);
        }
    }
}
__device__ __forceinline__ void ph_indexer_naive(Frame& F) {
    LAS float* sc = (LAS float*)F.lds;
    LAS float* qv = sc + 2048;
    LAS float* wv = qv + 512;
    LAS unsigned* mw = (LAS unsigned*)(wv + 8);
    const int tid = F.tid;
    for (int tok = F.vcu; tok < M; tok += F.G) {
        const int pos = tok & (SEQ - 1), seq0 = tok - pos, limit = ((pos >> 6) + 1) << 6;
        const bf16* pr = F.R1 + (size_t)tok * NAB;
        qv[tid] = bf2f(pr[C_IQ + tid]);
        if (tid < 8) wv[tid] = bf2f(pr[C_IW + tid]) * 0.35355339059327373f;
        if (tid < 64) mw[tid] = 0u;
        __syncthreads();
        for (int s = tid; s < limit; s += NTHR) {
            const bf16* kp = F.R1 + (size_t)(seq0 + s) * NAB + C_IK;
            float acc[8];
#pragma unroll
            for (int h = 0; h < 8; ++h) acc[h] = 0.f;
            for (int d = 0; d < 64; ++d) { const float kd = bf2f(kp[d]);
#pragma unroll
                for (int h = 0; h < 8; ++h) acc[h] = fmaf(qv[h * 64 + d], kd, acc[h]); }
            float score = 0.f;
#pragma unroll
            for (int h = 0; h < 8; ++h) score += fmaxf(acc[h] * 0.125f, 0.f) * wv[h];
            sc[s] = score;
        }
        __syncthreads();
        if (limit <= 256) { if (tid < 64) mw[tid] = (tid * 32 < limit) ? 0xffffffffu : 0u; }
        else {
            for (int s = tid; s < limit; s += NTHR) {
                const float v = sc[s]; int cnt = 0;
                for (int j = 0; j < limit; ++j) { const float u = sc[j]; cnt += ((u > v) || (u == v && j < s)) ? 1 : 0; }
                if (cnt < 256) atomicOr((unsigned*)&mw[s >> 5], 1u << (s & 31));
            }
        }
        __syncthreads();
        if (tid < 64) F.MASK[(size_t)tok * 64 + tid] = mw[tid];
        __syncthreads();
    }
}
__device__ __forceinline__ float block_sum(float v, LAS float* red, int tid) {
    v = wave_sum(v);
    __syncthreads();
    if ((tid & 63) == 0) red[tid >> 6] = v;
    __syncthreads();
    float r = 0.f;
#pragma unroll
    for (int i = 0; i < NWAVES; ++i) r += red[i];
    return r;
}
__device__ __forceinline__ float block_max(float v, LAS float* red, int tid) {
    v = wave_max(v);
    __syncthreads();
    if ((tid & 63) == 0) red[tid >> 6] = v;
    __syncthreads();
    float r = red[0];
#pragma unroll
    for (int i = 1; i < NWAVES; ++i) r = fmaxf(r, red[i]);
    return r;
}
__device__ __forceinline__ void ph_dsa_naive(Frame& F) {
    LAS unsigned* mw = (LAS unsigned*)F.lds;
    LAS int* pre = (LAS int*)(mw + 64);
    LAS int* idx = pre + 128;
    LAS float* pp = (LAS float*)(idx + 256);
    LAS float* q = pp + 512;
    LAS float* red = q + 512;
    const int tid = F.tid;
    for (int tok = F.vcu; tok < M; tok += F.G) {
        const int pos = tok & (SEQ - 1), seq0 = tok - pos;
        if (tid < 64) mw[tid] = F.MASK[(size_t)tok * 64 + tid];
        q[tid] = bf2f(F.R1[(size_t)tok * NAB + C_QA + tid]);
        __syncthreads();
        if (tid == 0) { int a = 0; for (int w = 0; w < 64; ++w) { pre[w] = a; a += __popc(mw[w]); } pre[64] = a; }
        __syncthreads();
        const int n = pre[64];
        for (int s = tid; s < SEQ; s += NTHR) { const unsigned w = mw[s >> 5]; if ((w >> (s & 31)) & 1u) idx[pre[s >> 5] + __popc(w & ((1u << (s & 31)) - 1u))] = s; }
        __syncthreads();
        for (int h = 0; h < 4; ++h) {
            float sv = -INFINITY;
            if (tid < n) { const bf16* kp = F.R1 + (size_t)(seq0 + idx[tid]) * NAB + C_KA + h * 128; float a = 0.f;
                for (int d = 0; d < 128; ++d) a = fmaf(q[h * 128 + d], bf2f(kp[d]), a);
                sv = a * 0.08838834764831845f; }
            const float m = block_max(sv, red, tid);
            const float e = (tid < n) ? expf(sv - m) : 0.f;
            const float l = block_sum(e, red, tid);
            pp[tid] = e;
            __syncthreads();
            if (tid < 128) { float o = 0.f;
                for (int j = 0; j < n; ++j) o = fmaf(pp[j], bf2f(F.R1[(size_t)(seq0 + idx[j]) * NAB + C_VA + h * 128 + tid]), o);
                F.CAT[(size_t)tok * D + h * 128 + tid] = (bf16)f2bf(o / l); }
            __syncthreads();
        }
    }
}
__device__ __forceinline__ void ph_gla_naive(Frame& F) {
    LAS float* sq = (LAS float*)F.lds; LAS float* sk = sq + 1024; LAS float* sd = sk + 1024;
    LAS float* sg = sd + 1024;
    LAS float* red = sg + 256;
    const int tid = F.tid, lane = F.lane;
    for (int item = F.vcu; item < BATCH * 4; item += F.G) {
        const int b = item >> 2, h = item & 3, seq0 = b * SEQ;
        float S[64];
#pragma unroll
        for (int d = 0; d < 64; ++d) S[d] = 0.f;
        for (int t0 = 0; t0 < SEQ; t0 += 16) {
            if (tid < 256) { const int tt = tid >> 4, r = tid & 15; sg[tid] = bf2f(F.R1[(size_t)(seq0 + t0 + tt) * NAB + C_GL + r]); }
            __syncthreads();
            for (int i = tid; i < 1024; i += NTHR) { const int tt = i >> 6, d = i & 63; const bf16* pr = F.R1 + (size_t)(seq0 + t0 + tt) * NAB;
                sq[i] = bf2f(pr[C_QB + h * 64 + d]) * 0.125f; sk[i] = bf2f(pr[C_KB + h * 64 + d]);
                float g = F.b_gate[h * 64 + d];
#pragma unroll
                for (int r = 0; r < 16; ++r) g = fmaf(sg[tt * 16 + r], F.w_gate_up[r * 256 + h * 64 + d], g);
                sd[i] = expf(log_sigmoid(g) * (1.f / 16.f)); }
            __syncthreads();
            float o[16];
            if (tid < 128) {
#pragma unroll
                for (int tt = 0; tt < 16; ++tt) {
                    const float v = bf2f(F.R1[(size_t)(seq0 + t0 + tt) * NAB + C_VB + h * 128 + tid]); float a = 0.f;
#pragma unroll
                    for (int d = 0; d < 64; ++d) { S[d] = fmaf(sd[tt * 64 + d], S[d], sk[tt * 64 + d] * v); a = fmaf(sq[tt * 64 + d], S[d], a); }
                    o[tt] = a;
                    const float ws = wave_sum(a * a);
                    if (lane == 0) red[tt * 2 + (tid >> 6)] = ws;
                }
            }
            __syncthreads();
            if (tid < 128) {
#pragma unroll
                for (int tt = 0; tt < 16; ++tt) {
                    const size_t tok = seq0 + t0 + tt;
                    const float rs = rsqrtf((red[tt * 2] + red[tt * 2 + 1]) * (1.f / 128.f) + EPS);
                    const float og = bf2f(F.R1[tok * NAB + C_OG + h * 128 + tid]);
                    F.CAT[tok * D + 512 + h * 128 + tid] = (bf16)f2bf(o[tt] * rs * F.g_gla[tid] * (og / (1.f + expf(-og))));
                }
            }
            __syncthreads();
        }
    }
}
template <bool SCALEQ> __device__ __forceinline__ void ph_prep_c(Frame& F) {
    const int gw = F.vcu * NWAVES + F.wave, NGW = F.G * NWAVES, lane = F.lane;
    for (int it = gw; it < M * 16; it += NGW) {
        const int tok = it >> 4, hh = it & 15, isk = hh >> 3, h = hh & 7;
        bf16* p = F.R1 + (size_t)tok * NC + isk * 1024 + h * 128;
        const float* gn = isk ? F.gk_c : F.gq_c;
        const float a = bf2f(p[lane]), b = bf2f(p[64 + lane]);
        const float rs = rsqrtf(wave_sum(a * a + b * b) * (1.f / 128.f) + EPS);
        const float sc = (SCALEQ && !isk) ? att::C2 : 1.0f;
        p[lane] = (bf16)f2bf(a * rs * gn[lane] * sc); p[64 + lane] = (bf16)f2bf(b * rs * gn[64 + lane] * sc);
    }
}
__device__ __forceinline__ void ph_sb_naive(Frame& F) {
    const int gw = F.vcu * NWAVES + F.wave, NGW = F.G * NWAVES, lane = F.lane;
    for (int it = gw; it < M * 8; it += NGW) {
        const int tok = it >> 3, h = it & 7, pos = tok & (SEQ - 1), seq0 = tok - pos;
        const unsigned qq = *(const unsigned*)(F.R1 + (size_t)tok * NC + h * 128 + 2 * lane);
        const float q0 = __builtin_bit_cast(float, qq << 16), q1 = __builtin_bit_cast(float, qq & 0xffff0000u);
        float R = 0.f, o0 = 0.f, o1 = 0.f;
        for (int s = pos - 1; s >= 0; --s) {
            const bf16* pr = F.R1 + (size_t)(seq0 + s) * NC + h * 128 + 2 * lane;
            const unsigned kk = *(const unsigned*)(pr + 1024), vv = *(const unsigned*)(pr + 2048);
            const float k0 = __builtin_bit_cast(float, kk << 16), k1 = __builtin_bit_cast(float, kk & 0xffff0000u);
            const float z = wave_sum(q0 * k0 + q1 * k1) * 0.08838834764831845f;
            const float sp = log1pf(expf(-fabsf(z)));
            const float lsp = fminf(z, 0.f) - sp, lsn = fminf(-z, 0.f) - sp;
            const float a = expf(lsp + R);
            o0 = fmaf(a, __builtin_bit_cast(float, vv << 16), o0); o1 = fmaf(a, __builtin_bit_cast(float, vv & 0xffff0000u), o1);
            R += lsn;
        }
        *(unsigned*)(F.CAT + (size_t)tok * D + h * 128 + 2 * lane) = pk2(o0, o1);
    }
}
__device__ __forceinline__ void sb_unit(Frame& F, int b, int h, int qb) {
    using namespace att;
    const int tid = F.tid, lane = F.lane, w = F.wave, hi = lane >> 5, r32 = lane & 31;
    const bf16* Qg = F.R1 + (size_t)b * SEQ * NC + h * 128; const bf16* Kg = Qg + 1024; const bf16* Vg = Qg + 2048;
    const int T0 = qb * 256, t0w = T0 + 32 * w, jd = t0w >> 6, jtop = (T0 >> 6) + 3, tl = 32 * (w & 1) + r32, tl4 = tl - 4 * hi;
    LAS unsigned char* lds = F.lds;
    FragOff fo; frag_off_init(fo, lane);
    unsigned dvo[2]; dma_off_init(dvo, NC, w, lane);
    bf16x8 qf[8];
#pragma unroll
    for (int ks = 0; ks < 8; ++ks) qf[ks] = *(const bf16x8*)(Qg + (size_t)(t0w + r32) * NC + 16 * ks + 8 * hi);
    f16x8 T0f, T1f, ONEf;
#pragma unroll
    for (int j = 0; j < 8; ++j) { const int kp = 8 * (j >> 2) + 4 * hi + (j & 3); T0f[j] = (kp >= r32) ? (_Float16)1.0f : (_Float16)0.0f; T1f[j] = (kp + 16 >= r32) ? (_Float16)1.0f : (_Float16)0.0f; ONEf[j] = (_Float16)1.0f; }
    f32x16 o[4];
#pragma unroll
    for (int ct = 0; ct < 4; ++ct)
#pragma unroll
        for (int r = 0; r < 16; ++r) o[ct][r] = 0.f;
    float R2 = 0.f; bool done = false;
    volatile LAS unsigned* flags = F.MISC + 16;
    tile_dma(Kg + (size_t)(64 * jtop) * NC, dvo, lds, w); tile_dma(Vg + (size_t)(64 * jtop) * NC, dvo, lds + 16384, w);
    asm volatile("s_waitcnt vmcnt(0)" ::: "memory");
    __syncthreads();
    for (int j = jtop; j >= 0; --j) {
        const int cur = (jtop - j) & 1;
        const LAS unsigned char* kb = lds + cur * 32768; const LAS unsigned char* vb = kb + 16384;
        if (j > 0) { tile_dma(Kg + (size_t)(64 * (j - 1)) * NC, dvo, lds + (cur ^ 1) * 32768, w); tile_dma(Vg + (size_t)(64 * (j - 1)) * NC, dvo, lds + (cur ^ 1) * 32768 + 16384, w); }
        if (j <= jd && !done) {
            f32x16 p0, p1;
#pragma unroll
            for (int r = 0; r < 16; ++r) { p0[r] = 0.f; p1[r] = 0.f; }
            { bf16x8 kf[8];
#pragma unroll
              for (int ks = 0; ks < 8; ++ks) kf[ks] = k_frag(kb, fo, 0, ks);
#pragma unroll
              for (int ks = 0; ks < 8; ++ks) p0 = __builtin_amdgcn_mfma_f32_32x32x16_bf16(kf[ks], qf[ks], p0, 0, 0, 0);
#pragma unroll
              for (int ks = 0; ks < 8; ++ks) kf[ks] = k_frag(kb, fo, 1, ks);
#pragma unroll
              for (int ks = 0; ks < 8; ++ks) p1 = __builtin_amdgcn_mfma_f32_32x32x16_bf16(kf[ks], qf[ks], p1, 0, 0, 0); }
            s16x4 vl[4], vh[4], wl[4], wh[4];
            unsigned va0[4], va1[4];
#pragma unroll
            for (int ct = 0; ct < 4; ++ct) { va0[ct] = (unsigned)(size_t)vb + (unsigned)fo.va[ct]; va1[ct] = va0[ct] + (unsigned)fo.vd; }
            const bool diag = (j == jd);
            float x0[16], x1[16]; float rs = 0.f;
#pragma unroll
            for (int r = 0; r < 16; ++r) { const int key = (r & 3) + 8 * (r >> 2);
                float l0 = -__builtin_amdgcn_logf(1.0f + __builtin_amdgcn_exp2f(p0[r])), l1 = -__builtin_amdgcn_logf(1.0f + __builtin_amdgcn_exp2f(p1[r]));
                if (diag) { if (!(key < tl4)) l0 = 0.f; if (!(key + 32 < tl4)) l1 = 0.f; }
                x0[r] = l0; x1[r] = l1; rs += l0 + l1; p0[r] += R2; p1[r] += R2; }
            const f16x8 xb00 = pack8h(x0[0], x0[1], x0[2], x0[3], x0[4], x0[5], x0[6], x0[7]), xb01 = pack8h(x0[8], x0[9], x0[10], x0[11], x0[12], x0[13], x0[14], x0[15]);
            const f16x8 xb10 = pack8h(x1[0], x1[1], x1[2], x1[3], x1[4], x1[5], x1[6], x1[7]), xb11 = pack8h(x1[8], x1[9], x1[10], x1[11], x1[12], x1[13], x1[14], x1[15]);
            p0 = __builtin_amdgcn_mfma_f32_32x32x16_f16(T0f, xb00, p0, 0, 0, 0); p0 = __builtin_amdgcn_mfma_f32_32x32x16_f16(T1f, xb01, p0, 0, 0, 0);
            p0 = __builtin_amdgcn_mfma_f32_32x32x16_f16(ONEf, xb10, p0, 0, 0, 0); p0 = __builtin_amdgcn_mfma_f32_32x32x16_f16(ONEf, xb11, p0, 0, 0, 0);
            p1 = __builtin_amdgcn_mfma_f32_32x32x16_f16(T0f, xb10, p1, 0, 0, 0); p1 = __builtin_amdgcn_mfma_f32_32x32x16_f16(T1f, xb11, p1, 0, 0, 0);
#pragma unroll
            for (int r = 0; r < 16; ++r) { const int key = (r & 3) + 8 * (r >> 2);
                float a0 = __builtin_amdgcn_exp2f(p0[r]), a1 = __builtin_amdgcn_exp2f(p1[r]);
                if (diag) { if (!(key < tl4)) a0 = 0.f; if (!(key + 32 < tl4)) a1 = 0.f; }
                p0[r] = a0; p1[r] = a1; }
            const bf16x8 pa0 = pack8(p0[0], p0[1], p0[2], p0[3], p0[4], p0[5], p0[6], p0[7]), pa1 = pack8(p0[8], p0[9], p0[10], p0[11], p0[12], p0[13], p0[14], p0[15]);
            const bf16x8 pa2 = pack8(p1[0], p1[1], p1[2], p1[3], p1[4], p1[5], p1[6], p1[7]), pa3 = pack8(p1[8], p1[9], p1[10], p1[11], p1[12], p1[13], p1[14], p1[15]);
#pragma unroll
            for (int ct = 0; ct < 4; ++ct) { TR_READ(vl[ct], va0[ct], 0); TR_READ(vh[ct], va1[ct], 0); }
            LGKM_WAIT0();
#pragma unroll
            for (int ct = 0; ct < 4; ++ct) { TR_READ(wl[ct], va0[ct], 4096); TR_READ(wh[ct], va1[ct], 4096); }
#pragma unroll
            for (int ct = 0; ct < 4; ++ct) o[ct] = __builtin_amdgcn_mfma_f32_32x32x16_bf16(pa0, mk_frag(vl[ct], vh[ct]), o[ct], 0, 0, 0);
            LGKM_WAIT0();
#pragma unroll
            for (int ct = 0; ct < 4; ++ct) { TR_READ(vl[ct], va0[ct], 8192); TR_READ(vh[ct], va1[ct], 8192); }
#pragma unroll
            for (int ct = 0; ct < 4; ++ct) o[ct] = __builtin_amdgcn_mfma_f32_32x32x16_bf16(pa1, mk_frag(wl[ct], wh[ct]), o[ct], 0, 0, 0);
            LGKM_WAIT0();
#pragma unroll
            for (int ct = 0; ct < 4; ++ct) { TR_READ(wl[ct], va0[ct], 12288); TR_READ(wh[ct], va1[ct], 12288); }
#pragma unroll
            for (int ct = 0; ct < 4; ++ct) o[ct] = __builtin_amdgcn_mfma_f32_32x32x16_bf16(pa2, mk_frag(vl[ct], vh[ct]), o[ct], 0, 0, 0);
            LGKM_WAIT0();
#pragma unroll
            for (int ct = 0; ct < 4; ++ct) o[ct] = __builtin_amdgcn_mfma_f32_32x32x16_bf16(pa3, mk_frag(wl[ct], wh[ct]), o[ct], 0, 0, 0);
            rs += __shfl_xor(rs, 32);
            R2 += rs;
            done = __all(R2 < -152.0f);
        }
        if (lane == 0) flags[cur * 8 + w] = done ? 1u : 0u;
        asm volatile("s_waitcnt vmcnt(0) lgkmcnt(0)" ::: "memory");
        __syncthreads();
        unsigned alld = 1u;
#pragma unroll
        for (int i = 0; i < 8; ++i) alld &= flags[cur * 8 + i];
        if (alld) break;
    }
    float ones[16];
#pragma unroll
    for (int r = 0; r < 16; ++r) ones[r] = 1.0f;
    store_o(o, ones, lds + w * 8192, F.CAT + (size_t)(b * SEQ + t0w) * D + h * 128, D, lane);
    __syncthreads();
}
__device__ __forceinline__ void ph_sb(Frame& F) {
    for (int v = F.vcu; v < BATCH * 8 * 2; v += F.G) {
        const int bh = v >> 1, half = v & 1;
#pragma unroll 1
        for (int i = 0; i < 4; ++i) { const int qb = half ? (i == 0 ? 1 : i == 1 ? 6 : i == 2 ? 2 : 5) : (i == 0 ? 0 : i == 1 ? 7 : i == 2 ? 3 : 4); sb_unit(F, bh >> 3, bh & 7, qb); }
    }
}
__device__ __forceinline__ void dsa_unit(Frame& F, int b, int h, int ub, float mref) {
    using namespace att;
    const int lane = F.lane, w = F.wave, hi = lane >> 5, r32 = lane & 31;
    const bf16* Qg = F.R1 + (size_t)b * SEQ * NAB + C_QA + h * 128; const bf16* Kg = F.R1 + (size_t)b * SEQ * NAB + C_KA + h * 128; const bf16* Vg = F.R1 + (size_t)b * SEQ * NAB + C_VA + h * 128;
    const int t0w = 256 * ub + 32 * w, cw = t0w >> 6, jlast = 4 * ub + 3;
    LAS unsigned char* lds = F.lds;
    LAS unsigned char* mst = lds + 65536 + w * 8448;
    FragOff fo; frag_off_init(fo, lane);
    unsigned dvo[2]; dma_off_init(dvo, NAB, w, lane);
    tile_dma(Kg, dvo, lds, w); tile_dma(Vg, dvo, lds + 16384, w);
    bf16x8 qf[8];
#pragma unroll
    for (int ks = 0; ks < 8; ++ks) qf[ks] = *(const bf16x8*)(Qg + (size_t)(t0w + r32) * NAB + 16 * ks + 8 * hi);
    { const unsigned* mg = F.MASK + (size_t)(b * SEQ + t0w) * 64;
#pragma unroll 2
      for (int i = 0; i < 8; ++i) { const int c = lane + 64 * i, row = c >> 4, c4 = c & 15; const u32x4 v = *(const u32x4*)(mg + row * 64 + c4 * 4);
          *(LAS unsigned long long*)(mst + row * 264 + c4 * 16) = (unsigned long long)v.x | ((unsigned long long)v.y << 32);
          *(LAS unsigned long long*)(mst + row * 264 + c4 * 16 + 8) = (unsigned long long)v.z | ((unsigned long long)v.w << 32); } }
    f32x16 o[4];
#pragma unroll
    for (int ct = 0; ct < 4; ++ct)
#pragma unroll
        for (int r = 0; r < 16; ++r) o[ct][r] = 0.f;
    float lsum = 0.f;
    asm volatile("s_waitcnt vmcnt(0) lgkmcnt(0)" ::: "memory");
    __syncthreads();
    for (int j = 0; j <= jlast; ++j) {
        const int cur = j & 1;
        const LAS unsigned char* kb = lds + cur * 32768; const LAS unsigned char* vb = kb + 16384;
        if (j < jlast) { tile_dma(Kg + (size_t)(64 * (j + 1)) * NAB, dvo, lds + (cur ^ 1) * 32768, w); tile_dma(Vg + (size_t)(64 * (j + 1)) * NAB, dvo, lds + (cur ^ 1) * 32768 + 16384, w); }
        if (j <= cw) {
            const unsigned long long mw = *(const LAS unsigned long long*)(mst + r32 * 264 + j * 8);
            const unsigned mw0 = (unsigned)mw, mw1 = (unsigned)(mw >> 32);
#pragma unroll 1
            for (int half = 0; half < 2; ++half) {
                const unsigned mwh = (half ? mw1 : mw0) >> (4 * hi);
                bf16x8 kf[8];
#pragma unroll
                for (int ks = 0; ks < 8; ++ks) kf[ks] = k_frag(kb, fo, half, ks);
                f32x16 p;
#pragma unroll
                for (int r = 0; r < 16; ++r) p[r] = 0.f;
#pragma unroll
                for (int ks = 0; ks < 8; ++ks) p = __builtin_amdgcn_mfma_f32_32x32x16_bf16(kf[ks], qf[ks], p, 0, 0, 0);
#pragma unroll
                for (int r = 0; r < 16; ++r) { const unsigned keep = (unsigned)(-(int)((mwh >> ((r & 3) + 8 * (r >> 2))) & 1u));
                    const float e = __uint_as_float(__float_as_uint(__builtin_amdgcn_exp2f(p[r] - mref)) & keep); p[r] = e; lsum += e; }
                const bf16x8 pa0 = pack8(p[0], p[1], p[2], p[3], p[4], p[5], p[6], p[7]), pa1 = pack8(p[8], p[9], p[10], p[11], p[12], p[13], p[14], p[15]);
                s16x4 vl[8], vh[8];
                const unsigned vbase = (unsigned)(size_t)vb + 8192u * (unsigned)half;
#pragma unroll
                for (int ct = 0; ct < 4; ++ct) { const unsigned a0 = vbase + (unsigned)fo.va[ct], a1 = a0 + (unsigned)fo.vd;
                    TR_READ(vl[2 * ct], a0, 0); TR_READ(vh[2 * ct], a1, 0); TR_READ(vl[2 * ct + 1], a0, 4096); TR_READ(vh[2 * ct + 1], a1, 4096); }
                LGKM_WAIT0();
#pragma unroll
                for (int ct = 0; ct < 4; ++ct) {
                    o[ct] = __builtin_amdgcn_mfma_f32_32x32x16_bf16(pa0, mk_frag(vl[2 * ct], vh[2 * ct]), o[ct], 0, 0, 0);
                    o[ct] = __builtin_amdgcn_mfma_f32_32x32x16_bf16(pa1, mk_frag(vl[2 * ct + 1], vh[2 * ct + 1]), o[ct], 0, 0, 0);
                }
            }
        }
        asm volatile("s_waitcnt vmcnt(0) lgkmcnt(0)" ::: "memory");
        __syncthreads();
    }
    lsum += __shfl_xor(lsum, 32);
    LAS float* lsc = (LAS float*)mst;
    if (hi == 0) lsc[r32] = 1.0f / lsum;
    asm volatile("s_waitcnt lgkmcnt(0)" ::: "memory");
    float rsc[16];
#pragma unroll
    for (int r = 0; r < 16; ++r) rsc[r] = lsc[crow(r, hi)];
    store_o(o, rsc, lds + w * 8192, F.CAT + (size_t)(b * SEQ + t0w) * D + h * 128, D, lane);
    __syncthreads();
}
__device__ __forceinline__ void ph_dsa(Frame& F) {
    float gm = fmaxf(fabsf(F.gq_a[F.lane]), fabsf(F.gq_a[64 + F.lane])), km = fmaxf(fabsf(F.gk_a[F.lane]), fabsf(F.gk_a[64 + F.lane]));
    gm = wave_max(gm); km = wave_max(km);
    const float mref = att::C2 * 128.0f * gm * km * 1.02f;
    for (int v = F.vcu; v < BATCH * 4 * 4; v += F.G) {
        const int bh = v >> 2, pi = v & 3;
#pragma unroll 1
        for (int k = 0; k < 2; ++k) dsa_unit(F, bh >> 2, bh & 3, k ? 7 - pi : pi, mref);
    }
}
namespace idx {
using att::f32x16;
constexpr int SCP = 2048;
__device__ __forceinline__ unsigned okey(float f) { const unsigned u = __float_as_uint(f); return (u & 0x80000000u) ? ~u : (u | 0x80000000u); }
__device__ __forceinline__ int wave_isum(int c) {
    c += __builtin_amdgcn_mov_dpp(c, 0xB1, 0xF, 0xF, true);
    c += __builtin_amdgcn_mov_dpp(c, 0x4E, 0xF, 0xF, true);
    c += __builtin_amdgcn_mov_dpp(c, 0x141, 0xF, 0xF, true);
    c += __builtin_amdgcn_mov_dpp(c, 0x140, 0xF, 0xF, true);
    return (__builtin_amdgcn_readlane(c, 0) + __builtin_amdgcn_readlane(c, 16)) + (__builtin_amdgcn_readlane(c, 32) + __builtin_amdgcn_readlane(c, 48));
}
template <int EP> __device__ __forceinline__ void select_row(const LAS float* sc, int E, unsigned* mrow, int lane) {
    unsigned key[EP];
#pragma unroll
    for (int j = 0; j < EP; ++j) key[j] = (j < E) ? okey(sc[64 * j + lane]) : 0u;
    unsigned T = 0u; bool exact = false;
    for (int bit = 31; bit >= 0; --bit) {
        const unsigned cand = T | (1u << bit); int c = 0;
#pragma unroll
        for (int j = 0; j < EP; ++j) c += (key[j] >= cand) ? 1 : 0;
        const int cnt = wave_isum(c);
        if (cnt >= 256) { T = cand; if (cnt == 256) { exact = true; break; } }
    }
    unsigned long long mine = 0ull;
    if (exact) {
#pragma unroll
        for (int j = 0; j < EP; ++j) { const unsigned long long m = __ballot(key[j] >= T); if (lane == j) mine = m; }
    } else {
        int cgt = 0;
#pragma unroll
        for (int j = 0; j < EP; ++j) cgt += __popcll(__ballot(key[j] > T));
        int need = 256 - cgt;
        const unsigned long long below = (1ull << lane) - 1ull;
#pragma unroll
        for (int j = 0; j < EP; ++j) {
            const unsigned long long eq = __ballot(key[j] == T), gt = __ballot(key[j] > T);
            const bool take = (key[j] == T) && (__popcll(eq & below) < need);
            const unsigned long long m = gt | __ballot(take);
            need -= __popcll(eq); if (need < 0) need = 0;
            if (lane == j) mine = m;
        }
    }
    if (lane < 32) *(unsigned long long*)(mrow + 2 * lane) = (lane < E) ? mine : 0ull;
}
__device__ __forceinline__ void unit(Frame& F, int b, int c, int sub) {
    const int lane = F.lane, w = F.wave, hi = lane >> 5, r32 = lane & 31, tid = F.tid;
    const int n = 64 * (c + 1), t0 = 64 * c + 16 * sub;
    const bf16* P = F.R1 + (size_t)b * SEQ * NAB;
    LAS float* sc = (LAS float*)F.lds;
    LAS float* wt = sc + 16 * SCP;
    ACC_BEGIN(F, 1);
    if (tid < 128) wt[tid] = bf2f(P[(size_t)(t0 + (tid >> 3)) * NAB + C_IW + (tid & 7)]) * (0.125f * 0.35355339059327373f);
    bf16x8 af[4][4];
#pragma unroll
    for (int rt = 0; rt < 4; ++rt)
#pragma unroll
        for (int ks = 0; ks < 4; ++ks) af[rt][ks] = *(const bf16x8*)(P + (size_t)(t0 + 4 * rt + (r32 >> 3)) * NAB + C_IQ + (r32 & 7) * 64 + 16 * ks + 8 * hi);
    __syncthreads();
    const int nstrip = n >> 5;
    bf16x8 bfr[4], bnx[4];
    if (w < nstrip) {
#pragma unroll
        for (int ks = 0; ks < 4; ++ks) bfr[ks] = *(const bf16x8*)(P + (size_t)(32 * w + r32) * NAB + C_IK + 16 * ks + 8 * hi);
    }
    for (int s = w; s < nstrip; s += NWAVES) {
        const bool more = s + NWAVES < nstrip;
        if (more) {
#pragma unroll
            for (int ks = 0; ks < 4; ++ks) bnx[ks] = *(const bf16x8*)(P + (size_t)(32 * (s + NWAVES) + r32) * NAB + C_IK + 16 * ks + 8 * hi);
        }
#pragma unroll
        for (int rt = 0; rt < 4; ++rt) {
            f32x16 acc;
#pragma unroll
            for (int r = 0; r < 16; ++r) acc[r] = 0.f;
#pragma unroll
            for (int ks = 0; ks < 4; ++ks) acc = __builtin_amdgcn_mfma_f32_32x32x16_bf16(af[rt][ks], bfr[ks], acc, 0, 0, 0);
            float part[4];
#pragma unroll
            for (int qi = 0; qi < 4; ++qi) { const f32x4 wv = *(const LAS f32x4*)(wt + (4 * rt + qi) * 8 + 4 * hi);
                part[qi] = fmaxf(acc[4 * qi], 0.f) * wv[0] + fmaxf(acc[4 * qi + 1], 0.f) * wv[1] + fmaxf(acc[4 * qi + 2], 0.f) * wv[2] + fmaxf(acc[4 * qi + 3], 0.f) * wv[3]; }
            const float send0 = hi ? part[0] : part[2], send1 = hi ? part[1] : part[3];
            const float got0 = __shfl_xor(send0, 32), got1 = __shfl_xor(send1, 32);
            const float f0 = (hi ? part[2] : part[0]) + got0, f1 = (hi ? part[3] : part[1]) + got1;
            const int q0 = 4 * rt + 2 * hi;
            sc[q0 * SCP + 32 * s + r32] = f0; sc[(q0 + 1) * SCP + 32 * s + r32] = f1;
        }
        if (more) {
#pragma unroll
            for (int ks = 0; ks < 4; ++ks) bfr[ks] = bnx[ks];
        }
    }
    __syncthreads();
    ACC_END(F, 1);
    ACC_BEGIN(F, 2);
    const int E = n >> 6;
#pragma unroll 1
    for (int rr = 0; rr < 2; ++rr) {
        const int q = 2 * w + rr;
        unsigned* mrow = F.MASK + (size_t)(b * SEQ + t0 + q) * 64;
        const LAS float* row = sc + q * SCP;
        if (E <= 8) select_row<8>(row, E, mrow, lane);
        else if (E <= 16) select_row<16>(row, E, mrow, lane);
        else if (E <= 24) select_row<24>(row, E, mrow, lane);
        else select_row<32>(row, E, mrow, lane);
    }
    __syncthreads();
    ACC_END(F, 2);
}
}
__device__ __forceinline__ void ph_indexer(Frame& F) {
    { const int gw = F.vcu * NWAVES + F.wave, NGW = F.G * NWAVES;
      for (int i = gw; i < BATCH * 256; i += NGW) { const int b = i >> 8, pos = i & 255, n = ((pos >> 6) + 1) << 6;
          if (F.lane < 32) { unsigned long long v = 0ull; if (64 * F.lane < n) v = ~0ull; *(unsigned long long*)(F.MASK + (size_t)(b * SEQ + pos) * 64 + 2 * F.lane) = v; } } }
    for (int u = F.vcu; u < BATCH * 28 * 4; u += F.G) { const int c = 4 + u % 28, rest = u / 28; idx::unit(F, rest >> 2, c, rest & 3); }
}
namespace gla {
using att::f32x16; using att::u32x4;
constexpr int L_WL = 0, L_V = 4096, L_OG = 36864, L_K = 69632, L_Q = 78848, L_PART = 88064, L_STG = 89088, KP = 144, SP = 272;
struct In { u32x4 g0, g1, kk, qq; };
__device__ __forceinline__ void decode(int u, int& b, int& h, int& c) { b = u >> 7; h = (u >> 5) & 3; c = u & 31; }
template <bool NEEDQ> __device__ __forceinline__ void load_in(Frame& F, int u, In& in) {
    int b, h, c; decode(u, b, h, c);
    const bf16* pr = F.R1 + (size_t)(b * SEQ + 64 * c + F.lane) * NAB;
    in.g0 = *(const u32x4*)(pr + C_GL); in.g1 = *(const u32x4*)(pr + C_GL + 8);
    in.kk = *(const u32x4*)(pr + C_KB + h * 64 + 8 * F.wave);
    if (NEEDQ) in.qq = *(const u32x4*)(pr + C_QB + h * 64 + 8 * F.wave);
}
template <bool NEEDOG> __device__ __forceinline__ void dma_in(Frame& F, int u, int buf, const unsigned (&dvo)[2]) {
    int b, h, c; decode(u, b, h, c);
    const bf16* P = F.R1 + (size_t)(b * SEQ + 64 * c) * NAB;
    att::tile_dma(P + C_VB + h * 128, dvo, F.lds + L_V + buf * 16384, F.wave);
    if (NEEDOG) att::tile_dma(P + C_OG + h * 128, dvo, F.lds + L_OG + buf * 16384, F.wave);
}
__device__ __forceinline__ void stage_wl(Frame& F, int h) {
    LAS float* wl = (LAS float*)(F.lds + L_WL);
#pragma unroll
    for (int i = 0; i < 2; ++i) { const int e = F.tid + 512 * i, r = e >> 6, d = e & 63; wl[e] = F.w_gate_up[r * 256 + h * 64 + d]; }
}
__device__ __forceinline__ void unpack8(const u32x4 v, float (&f)[8]) {
#pragma unroll
    for (int i = 0; i < 4; ++i) { f[2 * i] = __uint_as_float(v[i] << 16); f[2 * i + 1] = __uint_as_float(v[i] & 0xffff0000u); }
}
__device__ __forceinline__ void gate_scan(Frame& F, int h, const float (&gl)[16], float (&bc)[8], float (&blast)[8]) {
    const int lane = F.lane, d0 = 8 * F.wave;
    const LAS float* wl = (const LAS float*)(F.lds + L_WL);
    float acc[8];
#pragma unroll
    for (int i = 0; i < 8; ++i) acc[i] = F.b_gate[h * 64 + d0 + i];
#pragma unroll
    for (int r = 0; r < 16; ++r) { const f32x4 w0 = *(const LAS f32x4*)(wl + r * 64 + d0), w1 = *(const LAS f32x4*)(wl + r * 64 + d0 + 4);
#pragma unroll
        for (int i = 0; i < 4; ++i) { acc[i] = fmaf(gl[r], w0[i], acc[i]); acc[4 + i] = fmaf(gl[r], w1[i], acc[4 + i]); } }
#pragma unroll
    for (int i = 0; i < 8; ++i) { float v = (fminf(acc[i], 0.f) - __logf(1.0f + __expf(-fabsf(acc[i])))) * (1.0f / 16.0f);
#pragma unroll
        for (int off = 1; off < 64; off <<= 1) { const float u = __shfl_up(v, off); if (lane >= off) v += u; }
        bc[i] = v; blast[i] = __shfl(v, 63); }
}
__device__ __forceinline__ void pass_a(Frame& F, float* GU, float* DEC) {
    const int lane = F.lane, w = F.wave, hi = lane >> 5, r32 = lane & 31;
    att::FragOff fo; att::frag_off_init(fo, lane);
    unsigned dvo[2]; att::dma_off_init(dvo, NAB, w, lane);
    const int et = w >> 1, dt = w & 1, va_et = att::frag_va(lane, et);
    int u = F.vcu; if (u >= BATCH * 4 * 32) return;
    In cur, nxt; int hprev = -1;
    dma_in<false>(F, u, 0, dvo); load_in<false>(F, u, cur);
    for (int it = 0; u < BATCH * 4 * 32; ++it, u += F.G) {
        int b, h, c; decode(u, b, h, c);
        const int un = u + F.G; const bool more = un < BATCH * 4 * 32;
        if (h != hprev) { stage_wl(F, h); hprev = h; }
        asm volatile("s_waitcnt vmcnt(0) lgkmcnt(0)" ::: "memory");
        __syncthreads();
        float gl[16], kf[8];
        unpack8(cur.g0, (float(&)[8])gl[0]); unpack8(cur.g1, (float(&)[8])gl[8]); unpack8(cur.kk, kf);
        asm volatile("" ::: "memory");
        if (more) { dma_in<false>(F, un, (it + 1) & 1, dvo); load_in<false>(F, un, nxt); }
        float bc[8], blast[8];
        gate_scan(F, h, gl, bc, blast);
        const int uid = u;
#pragma unroll
        for (int i = 0; i < 8; ++i) *(LAS bf16*)(F.lds + L_K + (8 * w + i) * KP + lane * 2) = (bf16)f2bf(kf[i] * __expf(blast[i] - bc[i]));
        if (lane == 0) {
#pragma unroll
            for (int i = 0; i < 8; ++i) DEC[(size_t)uid * 64 + 8 * w + i] = __expf(blast[i]); }
        asm volatile("s_waitcnt lgkmcnt(0)" ::: "memory");
        __syncthreads();
        const LAS unsigned char* vbuf = F.lds + L_V + (it & 1) * 16384;
        f32x16 acc;
#pragma unroll
        for (int r = 0; r < 16; ++r) acc[r] = 0.f;
#pragma unroll
        for (int kk = 0; kk < 4; ++kk) {
            const LAS unsigned char* kp = F.lds + L_K + (32 * dt + r32) * KP + (16 * kk + 4 * hi) * 2;
            const unsigned long long lo = *(const LAS unsigned long long*)kp, hh = *(const LAS unsigned long long*)(kp + 16);
            u32x4 bw; bw.x = (unsigned)lo; bw.y = (unsigned)(lo >> 32); bw.z = (unsigned)hh; bw.w = (unsigned)(hh >> 32);
            acc = __builtin_amdgcn_mfma_f32_32x32x16_bf16(att::v_frag_rt(vbuf, va_et, fo.vd, kk), __builtin_bit_cast(bf16x8, bw), acc, 0, 0, 0);
        }
        float* gu = GU + (size_t)uid * 8192;
#pragma unroll
        for (int r = 0; r < 16; ++r) gu[(32 * et + att::crow(r, hi)) * 64 + 32 * dt + r32] = acc[r];
        cur = nxt;
    }
    __syncthreads();
}
__device__ __forceinline__ void pass_b(Frame& F, float* GU, const float* DEC) {
    for (int idx = F.vcu * NTHR + F.tid; idx < 64 * 128 * 16; idx += F.G * NTHR) {
        const int bh = idx >> 11, e = (idx >> 4) & 127, dq = idx & 15;
        f32x4 S = (f32x4){0.f, 0.f, 0.f, 0.f};
        for (int c0 = 0; c0 < 32; c0 += 8) {
            f32x4 U[8], dec[8];
#pragma unroll
            for (int i = 0; i < 8; ++i) { const size_t uid = (size_t)bh * 32 + c0 + i; U[i] = *(const f32x4*)(GU + (uid * 128 + e) * 64 + 4 * dq); dec[i] = *(const f32x4*)(DEC + uid * 64 + 4 * dq); }
#pragma unroll
            for (int i = 0; i < 8; ++i) { const size_t uid = (size_t)bh * 32 + c0 + i; *(f32x4*)(GU + (uid * 128 + e) * 64 + 4 * dq) = S; S = dec[i] * S + U[i]; }
        }
    }
}
__device__ __forceinline__ void pass_c(Frame& F, const float* GU) {
    const int lane = F.lane, w = F.wave, hi = lane >> 5, r32 = lane & 31, tid = F.tid;
    LAS unsigned char* lds = F.lds;
    att::FragOff fo; att::frag_off_init(fo, lane);
    unsigned dvo[2]; att::dma_off_init(dvo, NAB, w, lane);
    const int et = w >> 1, tt = w & 1, tl = 32 * tt + r32, va_et = att::frag_va(lane, et);
    int u = F.vcu; if (u >= BATCH * 4 * 32) return;
    In cur, nxt; int hprev = -1;
    dma_in<true>(F, u, 0, dvo); load_in<true>(F, u, cur);
    for (int it = 0; u < BATCH * 4 * 32; ++it, u += F.G) {
        int b, h, c; decode(u, b, h, c);
        const int un = u + F.G; const bool more = un < BATCH * 4 * 32;
        if (h != hprev) { stage_wl(F, h); hprev = h; }
        asm volatile("s_waitcnt vmcnt(0) lgkmcnt(0)" ::: "memory");
        __syncthreads();
        float gl[16], kf[8], qf[8];
        unpack8(cur.g0, (float(&)[8])gl[0]); unpack8(cur.g1, (float(&)[8])gl[8]); unpack8(cur.kk, kf); unpack8(cur.qq, qf);
        asm volatile("" ::: "memory");
        if (more) { dma_in<true>(F, un, (it + 1) & 1, dvo); load_in<true>(F, un, nxt); }
        f32x4 sf[8];
        { const float* gs = GU + ((size_t)u * 128 + 32 * et + r32) * 64;
#pragma unroll
          for (int ks = 0; ks < 4; ++ks) { sf[2 * ks] = *(const f32x4*)(gs + 16 * ks + 8 * hi); sf[2 * ks + 1] = *(const f32x4*)(gs + 16 * ks + 8 * hi + 4); } }
        float bc[8], blast[8];
        gate_scan(F, h, gl, bc, blast);
        { float eq[8], ek[8];
#pragma unroll
          for (int i = 0; i < 8; ++i) { eq[i] = qf[i] * 0.125f * __expf(bc[i]); ek[i] = kf[i] * __expf(-bc[i]); }
          *(LAS bf16x8*)(lds + L_Q + lane * KP + 16 * w) = att::pack8(eq[0], eq[1], eq[2], eq[3], eq[4], eq[5], eq[6], eq[7]);
          *(LAS bf16x8*)(lds + L_K + lane * KP + 16 * w) = att::pack8(ek[0], ek[1], ek[2], ek[3], ek[4], ek[5], ek[6], ek[7]); }
        asm volatile("s_waitcnt lgkmcnt(0)" ::: "memory");
        __syncthreads();
        const LAS unsigned char* vbuf = lds + L_V + (it & 1) * 16384; const LAS unsigned char* ogbuf = lds + L_OG + (it & 1) * 16384;
        bf16x8 qfr[4];
#pragma unroll
        for (int ks = 0; ks < 4; ++ks) qfr[ks] = *(const LAS bf16x8*)(lds + L_Q + tl * KP + (16 * ks + 8 * hi) * 2);
        f32x16 p0, p1;
#pragma unroll
        for (int r = 0; r < 16; ++r) { p0[r] = 0.f; p1[r] = 0.f; }
#pragma unroll
        for (int ks = 0; ks < 4; ++ks) {
            const bf16x8 a0 = *(const LAS bf16x8*)(lds + L_K + r32 * KP + (16 * ks + 8 * hi) * 2), a1 = *(const LAS bf16x8*)(lds + L_K + (32 + r32) * KP + (16 * ks + 8 * hi) * 2);
            p0 = __builtin_amdgcn_mfma_f32_32x32x16_bf16(a0, qfr[ks], p0, 0, 0, 0); p1 = __builtin_amdgcn_mfma_f32_32x32x16_bf16(a1, qfr[ks], p1, 0, 0, 0);
        }
        { const int tl4 = tl - 4 * hi;
#pragma unroll
          for (int r = 0; r < 16; ++r) { const int s = (r & 3) + 8 * (r >> 2); if (s > tl4) p0[r] = 0.f; if (s + 32 > tl4) p1[r] = 0.f; } }
        const bf16x8 pa0 = att::pack8(p0[0], p0[1], p0[2], p0[3], p0[4], p0[5], p0[6], p0[7]), pa1 = att::pack8(p0[8], p0[9], p0[10], p0[11], p0[12], p0[13], p0[14], p0[15]);
        const bf16x8 pa2 = att::pack8(p1[0], p1[1], p1[2], p1[3], p1[4], p1[5], p1[6], p1[7]), pa3 = att::pack8(p1[8], p1[9], p1[10], p1[11], p1[12], p1[13], p1[14], p1[15]);
        f32x16 acc;
#pragma unroll
        for (int r = 0; r < 16; ++r) acc[r] = 0.f;
        acc = __builtin_amdgcn_mfma_f32_32x32x16_bf16(att::v_frag_rt(vbuf, va_et, fo.vd, 0), pa0, acc, 0, 0, 0);
        acc = __builtin_amdgcn_mfma_f32_32x32x16_bf16(att::v_frag_rt(vbuf, va_et, fo.vd, 1), pa1, acc, 0, 0, 0);
        acc = __builtin_amdgcn_mfma_f32_32x32x16_bf16(att::v_frag_rt(vbuf, va_et, fo.vd, 2), pa2, acc, 0, 0, 0);
        acc = __builtin_amdgcn_mfma_f32_32x32x16_bf16(att::v_frag_rt(vbuf, va_et, fo.vd, 3), pa3, acc, 0, 0, 0);
#pragma unroll
        for (int ks = 0; ks < 4; ++ks) { const f32x4 s0 = sf[2 * ks], s1 = sf[2 * ks + 1];
            acc = __builtin_amdgcn_mfma_f32_32x32x16_bf16(att::pack8(s0[0], s0[1], s0[2], s0[3], s1[0], s1[1], s1[2], s1[3]), qfr[ks], acc, 0, 0, 0); }
        float ss = 0.f;
#pragma unroll
        for (int r = 0; r < 16; ++r) ss = fmaf(acc[r], acc[r], ss);
        ss += __shfl_xor(ss, 32);
        LAS float* part = (LAS float*)(lds + L_PART);
        if (hi == 0) part[et * 64 + tl] = ss;
        asm volatile("s_waitcnt lgkmcnt(0)" ::: "memory");
        __syncthreads();
        const float rs = rsqrtf(((part[tl] + part[64 + tl]) + (part[128 + tl] + part[192 + tl])) * (1.0f / 128.0f) + EPS);
#pragma unroll
        for (int g = 0; g < 4; ++g) {
            const int e0 = 32 * et + 8 * g + 4 * hi;
            const unsigned long long ow = *(const LAS unsigned long long*)(ogbuf + att::img_off(tl, 4 * et + g) + 8 * hi);
            const f32x4 gg = *(const f32x4*)(F.g_gla + e0);
            float y[4];
#pragma unroll
            for (int i = 0; i < 4; ++i) { const float og = __uint_as_float(((unsigned)(ow >> (16 * i)) & 0xffffu) << 16); y[i] = acc[4 * g + i] * rs * gg[i] * (og * __builtin_amdgcn_rcpf(1.0f + __expf(-og))); }
            *(LAS unsigned long long*)(lds + L_STG + tl * SP + e0 * 2) = (unsigned long long)pg8::cvt_pk_bf16(y[0], y[1]) | ((unsigned long long)pg8::cvt_pk_bf16(y[2], y[3]) << 32);
        }
        asm volatile("s_waitcnt lgkmcnt(0)" ::: "memory");
        __syncthreads();
#pragma unroll
        for (int i = 0; i < 2; ++i) { const int cidx = tid + 512 * i, row = cidx >> 4, ch = cidx & 15;
            *(u32x4*)(F.CAT + (size_t)(b * SEQ + 64 * c + row) * D + 512 + h * 128 + ch * 8) = *(const LAS u32x4*)(lds + L_STG + row * SP + ch * 16); }
        cur = nxt;
    }
    __syncthreads();
}
}
__device__ __forceinline__ void ph_rope_tables(Frame& F, float* R128, float* R64) {
    for (int i = F.vcu * NTHR + F.tid; i < SEQ * 24; i += F.G * NTHR) {
        const int pos = i / 24, k = i % 24;
        if (k < 16) { const float inv = powf(500000.0f, -(float)k * 2.0f / 32.0f), ang = (float)pos * inv; R128[pos * 32 + k] = cosf(ang); R128[pos * 32 + 16 + k] = sinf(ang); }
        else { const int j = k - 16; const float inv = powf(500000.0f, -(float)j * 2.0f / 16.0f), ang = (float)pos * inv; R64[pos * 16 + j] = cosf(ang); R64[pos * 16 + 8 + j] = sinf(ang); }
    }
}
__device__ __forceinline__ float dpp_xor1(float v) { return __builtin_bit_cast(float, __builtin_amdgcn_mov_dpp(__builtin_bit_cast(int, v), 0xB1, 0xF, 0xF, true)); }
__device__ __forceinline__ float dpp_xor2(float v) { return __builtin_bit_cast(float, __builtin_amdgcn_mov_dpp(__builtin_bit_cast(int, v), 0x4E, 0xF, 0xF, true)); }
__device__ __forceinline__ void ph_prep_c_fast(Frame& F) {
    const int gw = F.vcu * NWAVES + F.wave, NGW = F.G * NWAVES, lane = F.lane;
    const float* gn = (lane < 32 ? F.gq_c : F.gk_c) + (lane & 3) * 32;
    const float sc = lane < 32 ? att::C2 : 1.0f;
    float g[32];
#pragma unroll
    for (int i = 0; i < 8; ++i) { const f32x4 v = *(const f32x4*)(gn + 4 * i); g[4 * i] = v[0] * sc; g[4 * i + 1] = v[1] * sc; g[4 * i + 2] = v[2] * sc; g[4 * i + 3] = v[3] * sc; }
    for (int tok = gw; tok < M; tok += NGW) {
        att::u32x4* p = (att::u32x4*)(F.R1 + (size_t)tok * NC + lane * 32);
        att::u32x4 v[4]; float f[32]; float ss = 0.f;
#pragma unroll
        for (int i = 0; i < 4; ++i) v[i] = p[i];
#pragma unroll
        for (int i = 0; i < 4; ++i)
#pragma unroll
            for (int j = 0; j < 4; ++j) { const float a = __uint_as_float(v[i][j] << 16), b = __uint_as_float(v[i][j] & 0xffff0000u); f[8 * i + 2 * j] = a; f[8 * i + 2 * j + 1] = b; ss = fmaf(a, a, fmaf(b, b, ss)); }
        ss += dpp_xor1(ss); ss += dpp_xor2(ss);
        const float rs = rsqrtf(ss * (1.f / 128.f) + EPS);
#pragma unroll
        for (int i = 0; i < 4; ++i) { att::u32x4 o;
#pragma unroll
            for (int j = 0; j < 4; ++j) o[j] = pg8::cvt_pk_bf16(f[8 * i + 2 * j] * rs * g[8 * i + 2 * j], f[8 * i + 2 * j + 1] * rs * g[8 * i + 2 * j + 1]);
            p[i] = o; }
    }
}
__device__ __forceinline__ void ph_prep_a_fast(Frame& F, const float* R128, const float* R64) {
    const int gw = F.vcu * NWAVES + F.wave, NGW = F.G * NWAVES, lane = F.lane, l8 = lane & 7;
    const float* gn = (lane < 32 ? F.gq_a : F.gk_a) + l8 * 16;
    const float sc = lane < 32 ? att::C2 : 1.0f;
    float g[16];
#pragma unroll
    for (int i = 0; i < 4; ++i) { const f32x4 v = *(const f32x4*)(gn + 4 * i); g[4 * i] = v[0] * sc; g[4 * i + 1] = v[1] * sc; g[4 * i + 2] = v[2] * sc; g[4 * i + 3] = v[3] * sc; }
    for (int tok = gw; tok < M; tok += NGW) {
        const int pos = tok & (SEQ - 1);
        bf16* pr = F.R1 + (size_t)tok * NAB;
        {   att::u32x4* p = (att::u32x4*)(pr + lane * 16);
            const att::u32x4 v0 = p[0], v1 = p[1]; float f[16]; float ss = 0.f;
#pragma unroll
            for (int j = 0; j < 4; ++j) { f[2 * j] = __uint_as_float(v0[j] << 16); f[2 * j + 1] = __uint_as_float(v0[j] & 0xffff0000u); f[8 + 2 * j] = __uint_as_float(v1[j] << 16); f[8 + 2 * j + 1] = __uint_as_float(v1[j] & 0xffff0000u); }
#pragma unroll
            for (int i = 0; i < 16; ++i) ss = fmaf(f[i], f[i], ss);
            ss += dpp_xor1(ss); ss += dpp_xor2(ss); ss += __shfl_xor(ss, 4);
            const float rs = rsqrtf(ss * (1.f / 128.f) + EPS);
#pragma unroll
            for (int i = 0; i < 16; ++i) f[i] = f[i] * rs * g[i];
            const float* cs = R128 + pos * 32;
#pragma unroll
            for (int i = 0; i < 16; ++i) { const float other = dpp_xor1(f[i]);
                if (l8 < 2) { const float c = cs[i], s = cs[16 + i]; f[i] = (l8 == 0) ? f[i] * c - other * s : f[i] * c + other * s; } }
            att::u32x4 o0, o1;
#pragma unroll
            for (int j = 0; j < 4; ++j) { o0[j] = pg8::cvt_pk_bf16(f[2 * j], f[2 * j + 1]); o1[j] = pg8::cvt_pk_bf16(f[8 + 2 * j], f[8 + 2 * j + 1]); }
            p[0] = o0; p[1] = o1;
        }
        {
#pragma unroll
            for (int part = 0; part < 2; ++part) {
                if (part == 1 && lane >= 8) break;
                att::u32x4* p = (att::u32x4*)(pr + (part == 0 ? C_IQ + lane * 8 : C_IK + lane * 8));
                const att::u32x4 v0 = p[0]; float f[8];
#pragma unroll
                for (int j = 0; j < 4; ++j) { f[2 * j] = __uint_as_float(v0[j] << 16); f[2 * j + 1] = __uint_as_float(v0[j] & 0xffff0000u); }
                const float* cs = R64 + pos * 16;
#pragma unroll
                for (int i = 0; i < 8; ++i) { const float other = dpp_xor1(f[i]);
                    if (l8 < 2) { const float c = cs[i], s = cs[8 + i]; f[i] = (l8 == 0) ? f[i] * c - other * s : f[i] * c + other * s; } }
                att::u32x4 o0;
#pragma unroll
                for (int j = 0; j < 4; ++j) o0[j] = pg8::cvt_pk_bf16(f[2 * j], f[2 * j + 1]);
                p[0] = o0;
            }
        }
    }
}
#ifndef MK_PER_PHASE
#define MK_PER_PHASE 0
#endif
constexpr int NPH = 14;
struct Args { const float* in[16]; float* out; unsigned char* ws; int ph_lo, ph_hi; };
__global__ void __launch_bounds__(NTHR, 2) mk_fwd(Args args) {
    extern __shared__ __attribute__((aligned(16))) unsigned char lds[];
    Frame F;
    F.lds = (LAS unsigned char*)lds;
    F.MISC = (volatile LAS unsigned*)(F.lds + MISC_OFF);
    F.wave = __builtin_amdgcn_readfirstlane((int)threadIdx.x >> 6);
#define RELANE() (F.lane = lane_id_opaque(), F.tid = F.wave * 64 + F.lane, true)
    RELANE();
#ifdef PROBE_ACC
    F.acc_t0 = 0ull; F.acc_sum = 0ull;
#endif
    F.G = gridDim.x; { const int bx = blockIdx.x; F.vcu = (F.G % 8 == 0) ? (bx % 8) * (F.G / 8) + bx / 8 : bx; }
    unsigned char* ws = args.ws;
    F.ctl = (gu32*)(ws + WS_CTL);
    F.x = args.in[0]; F.g_mix = args.in[1]; F.g_ffn = args.in[2]; F.w_in_ab = args.in[3]; F.gq_a = args.in[4]; F.gk_a = args.in[5]; F.w_gate_up = args.in[6]; F.b_gate = args.in[7];
    F.g_gla = args.in[8]; F.w_out_ab = args.in[9]; F.w_in_c = args.in[10]; F.gq_c = args.in[11]; F.gk_c = args.in[12]; F.w_out_c = args.in[13]; F.w_up = args.in[14]; F.w_down = args.in[15];
    F.out = args.out;
    F.Wab = (bf16*)(ws + WS_WAB); F.Woab = (bf16*)(ws + WS_WOAB); F.Wup0 = (bf16*)(ws + WS_WUP0); F.Wdn0 = (bf16*)(ws + WS_WDN0);
    F.Winc = (bf16*)(ws + WS_WINC); F.Woc = (bf16*)(ws + WS_WOC); F.Wup1 = (bf16*)(ws + WS_WUP1); F.Wdn1 = (bf16*)(ws + WS_WDN1);
    F.XB = (bf16*)(ws + WS_XB); F.CAT = (bf16*)(ws + WS_CAT); F.R1 = (bf16*)(ws + WS_R1); F.SSQ = (float*)(ws + WS_SSQ); F.MASK = (unsigned*)(ws + WS_MASK);
    for (int u = F.tid; u < (LDS_BYTES - MISC_OFF) / 4; u += NTHR) ((LAS unsigned*)(F.lds + MISC_OFF))[u] = 0u;
    __syncthreads();
    XcdBarrier bar; bar.bar = (unsigned*)(F.ctl + CW_BAR); bar.x = 0; bar.st = nullptr; bar.wave = F.wave;
    if (!MK_PER_PHASE) bar = xcd_barrier_post((unsigned*)(F.ctl + CW_BAR), F.MISC + 8, F.wave);
    const int lo = args.ph_lo, hi = args.ph_hi;
#ifdef PROBE_PH
    unsigned long long pt0 = 0ull, pt1 = 0ull;
#define STAMP(k) do { if ((k) == PROBE_PH) pt0 = __builtin_amdgcn_s_memrealtime(); if ((k) == PROBE_PH + 1) pt1 = __builtin_amdgcn_s_memrealtime(); } while (0)
#ifdef PROBE_SUB
#define SUBSTAMP(k) do { if ((k) == PROBE_PH) { __syncthreads(); pt0 = __builtin_amdgcn_s_memrealtime(); } } while (0)
#else
#define SUBSTAMP(k) do { } while (0)
#endif
#else
#define STAMP(k) do { } while (0)
#define SUBSTAMP(k) do { } while (0)
#endif
#define IN(k) (lo <= (k) && (k) < hi && RELANE())
#define SEAM(k) do { if (lo <= (k) && (k) + 1 < hi) xcd_barrier(bar); } while (0)
    float* const SSQ0 = F.SSQ, *SSQ1 = F.SSQ + (size_t)M * 16, *SSQ2 = F.SSQ + (size_t)2 * M * 16, *SSQ3 = F.SSQ + (size_t)3 * M * 16;
    typedef pg8::StaticOrder SO;
    STAMP(0); float* const R128 = (float*)(ws + WS_ROPE); float* const R64 = R128 + SEQ * 32;
    if (IN(0)) { ph_prologue(F); ph_rope_tables(F, R128, R64); } SEAM(0);
    STAMP(1); if (IN(1)) { pg8::Gemm g{F.XB, F.Wab, M, NAB, D}; SO S; S.init(M, NAB, F.G, (int)blockIdx.x); pg8::EpiScale<0> E{F.R1, NAB, SSQ0};
        pg8::gemm_phase<pg8::EpiScale<0>, SO, true, true>(F.lds, g, S, E, F.wave); } SEAM(1);
    float* const GU = (float*)(ws + WS_XB); float* const DEC = (float*)(ws + WS_DEC);
    STAMP(2); if (IN(2)) { ph_prep_a_fast(F, R128, R64); SUBSTAMP(2); gla::pass_a(F, GU, DEC); } SEAM(2);
    STAMP(3); if (IN(3)) { gla::pass_b(F, GU, DEC); SUBSTAMP(3); ph_indexer(F); } SEAM(3);
    STAMP(4); if (IN(4)) { ph_dsa(F); SUBSTAMP(4); gla::pass_c(F, GU); } SEAM(4);
    STAMP(5); if (IN(5)) { pg8::Gemm g{F.CAT, F.Woab, M, D, D}; SO S; S.init(M, D, F.G, (int)blockIdx.x); pg8::EpiResid<0, 0> E{F.x, nullptr, F.XB, SSQ1};
        pg8::gemm_phase<pg8::EpiResid<0, 0>, SO, true, true>(F.lds, g, S, E, F.wave); } SEAM(5);
    STAMP(6); if (IN(6)) { pg8::Gemm g{F.XB, F.Wup0, M, FF, D}; SO S; S.init(M, FF, F.G, (int)blockIdx.x); pg8::EpiScale<1> E{F.R1, FF, SSQ1};
        pg8::gemm_phase<pg8::EpiScale<1>, SO, true, true>(F.lds, g, S, E, F.wave); } SEAM(6);
    STAMP(7); if (IN(7)) { pg8::Gemm g{F.R1, F.Wdn0, M, D, FF}; SO S; S.init(M, D, F.G, (int)blockIdx.x); pg8::EpiResid<1, 0> E{F.XB, nullptr, F.XB, SSQ2};
        pg8::gemm_phase<pg8::EpiResid<1, 0>, SO, true, true>(F.lds, g, S, E, F.wave); } SEAM(7);
    STAMP(8); if (IN(8)) { pg8::Gemm g{F.XB, F.Winc, M, NC, D}; SO S; S.init(M, NC, F.G, (int)blockIdx.x); pg8::EpiScale<0> E{F.R1, NC, SSQ2};
        pg8::gemm_phase<pg8::EpiScale<0>, SO, true, true>(F.lds, g, S, E, F.wave); } SEAM(8);
    STAMP(9); if (IN(9)) { ph_prep_c_fast(F); } SEAM(9);
    STAMP(10); if (IN(10)) { ph_sb(F); } SEAM(10);
    STAMP(11); if (IN(11)) { pg8::Gemm g{F.CAT, F.Woc, M, D, D}; SO S; S.init(M, D, F.G, (int)blockIdx.x); pg8::EpiResid<1, 0> E{F.XB, nullptr, F.XB, SSQ3};
        pg8::gemm_phase<pg8::EpiResid<1, 0>, SO, true, true>(F.lds, g, S, E, F.wave); } SEAM(11);
    STAMP(12); if (IN(12)) { pg8::Gemm g{F.XB, F.Wup1, M, FF, D}; SO S; S.init(M, FF, F.G, (int)blockIdx.x); pg8::EpiScale<1> E{F.R1, FF, SSQ3};
        pg8::gemm_phase<pg8::EpiScale<1>, SO, true, true>(F.lds, g, S, E, F.wave); } SEAM(12);
    STAMP(13); if (IN(13)) { pg8::Gemm g{F.R1, F.Wdn1, M, D, FF}; SO S; S.init(M, D, F.G, (int)blockIdx.x); pg8::EpiResid<1, 1> E{F.XB, F.out, nullptr, nullptr};
        pg8::gemm_phase<pg8::EpiResid<1, 1>, SO, true, true>(F.lds, g, S, E, F.wave); }
    STAMP(NPH);
#ifdef PROBE_ACC
    if (blockIdx.x == 0) { const unsigned long long t1 = __builtin_amdgcn_s_memrealtime(), dt = F.acc_sum * PROBE_MULT; while (__builtin_amdgcn_s_memrealtime() - t1 < dt) __builtin_amdgcn_s_sleep(8); }
#endif
#ifdef PROBE_PH
    if (blockIdx.x == 0) { const unsigned long long t1 = __builtin_amdgcn_s_memrealtime(), dt = (pt1 - pt0) * PROBE_MULT; while (__builtin_amdgcn_s_memrealtime() - t1 < dt) __builtin_amdgcn_s_sleep(8); }
#endif
#undef IN
#undef SEAM
}

extern "C" void kernel_launch(void* const* d_in, const int* in_sizes, int n_in, void* d_out, int out_size, void* d_ws, size_t ws_size, hipStream_t stream) {
    static int grid = 0;
    if (grid == 0) {
        if (n_in != 16 || in_sizes[0] != M * D || out_size != M * D || ws_size < WS_END) { fprintf(stderr, "kernel_launch: unexpected shapes / workspace (%d inputs, ws %zu)\n", n_in, ws_size); grid = -1; return; }
        int dev = 0, cus = 0;
        if (hipGetDevice(&dev) != hipSuccess || hipDeviceGetAttribute(&cus, hipDeviceAttributeMultiprocessorCount, dev) != hipSuccess) { grid = -1; return; }
        if (hipFuncSetAttribute((const void*)mk_fwd, hipFuncAttributeMaxDynamicSharedMemorySize, LDS_BYTES) != hipSuccess) { fprintf(stderr, "kernel_launch: hipFuncSetAttribute failed\n"); grid = -1; return; }
        (void)hipGetLastError();
        grid = cus;
    }
    if (grid < 0) return;
    if (hipMemsetAsync((char*)d_ws + WS_CTL, 0, CTL_ZERO_BYTES, stream) != hipSuccess) { fprintf(stderr, "kernel_launch: memset failed\n"); return; }
    Args a{};
    for (int i = 0; i < 16; ++i) a.in[i] = (const float*)d_in[i];
    a.out = (float*)d_out; a.ws = (unsigned char*)d_ws;
#if MK_PER_PHASE
    for (int ph = 0; ph < NPH; ++ph) { a.ph_lo = ph; a.ph_hi = ph + 1; hipLaunchKernelGGL(mk_fwd, dim3(grid), dim3(NTHR), LDS_BYTES, stream, a); }
#else
    a.ph_lo = 0; a.ph_hi = NPH;
    hipLaunchKernelGGL(mk_fwd, dim3(grid), dim3(NTHR), LDS_BYTES, stream, a);
#endif
    const hipError_t le = hipPeekAtLastError();
    if (le != hipSuccess) fprintf(stderr, "kernel_launch: launch failed: %s\n", hipGetErrorName(le));
}
```

```cpp
#include <hip/hip_runtime.h>
#include <cstdio>
#include <cstdint>
namespace pg8 {
#define PG8_LAS __attribute__((address_space(3)))
typedef unsigned short bf16_t;
typedef short bf16x8 __attribute__((ext_vector_type(8)));
typedef float f32x4 __attribute__((ext_vector_type(4)));
typedef unsigned u32x4 __attribute__((ext_vector_type(4)));
constexpr int BM = 256, BK = 64, HALF = 128, HTB = HALF * BK * 2  , STAGE_BYTES = 8 * HTB, NXCD = 8, WGM = 8;

__host__ __device__ __forceinline__ int lds_byte(int r, int c) { const int st = (r >> 4) * 2 + (c >> 5), rr = r & 15, cc = c & 31, ob = rr * 64 + cc * 2; return st * 1024 + (ob ^ (((ob >> 9) & 1) << 5)); }
__host__ __device__ __forceinline__ void stage_rc(int b, int& R, int& C) { const int st = b / 1024, sb = b % 1024, swz = sb ^ (((sb >> 9) & 1) << 5); R = (st >> 1) * 16 + swz / 64; C = (st & 1) * 32 + (swz % 64) / 2; }
__host__ __device__ __forceinline__ int perm32(int rho) { const int n = rho >> 4, i = rho & 15; return 8 * (i >> 2) + 4 * n + (i & 3); }

struct Unit { int pm, pn; };
struct Gemm { const bf16_t* A; const bf16_t* Bt; int M, N, K; };

struct StaticOrder {
    int nM, nN, nwg, G, c;
    __host__ __device__ void init(int M, int N, int G_, int c_) { nM = M / BM; nN = N / BM; nwg = nM * nN; G = G_; c = c_; }
    __host__ __device__ bool next(int i, Unit& u) const {
        const long L = (long)i * G + c; if (L >= nwg) return false;
        int wgid = (int)L; { const int q = nwg / NXCD, r = nwg % NXCD, xcd = wgid % NXCD, off = wgid / NXCD; wgid = (xcd < r ? xcd * (q + 1) : r * (q + 1) + (xcd - r) * q) + off; }
        const int nig = WGM * nN, gid = wgid / nig, fm = gid * WGM, gsz = (nM - fm) < WGM ? (nM - fm) : WGM;
        u.pm = fm + ((wgid % nig) % gsz); u.pn = (wgid % nig) / gsz; return true;
    }
    __device__ __forceinline__ void a_ready(const Unit&) const {}
    __device__ __forceinline__ void done(const Unit&) const {}
};

__device__ __forceinline__ unsigned cvt_pk_bf16(float lo, float hi) { unsigned r; asm volatile("v_cvt_pk_bf16_f32 %0, %1, %2" : "=v"(r) : "v"(lo), "v"(hi)); return r; }
__device__ __forceinline__ float row_rstd(const float* ssqp, int row) {
    const f32x4* p = (const f32x4*)(ssqp + (size_t)row * 16);
    const f32x4 a = p[0], b = p[1], c = p[2], d = p[3];
    const float s = (((a[0] + a[1]) + (a[2] + a[3])) + ((b[0] + b[1]) + (b[2] + b[3]))) + (((c[0] + c[1]) + (c[2] + c[3])) + ((d[0] + d[1]) + (d[2] + d[3])));
    return rsqrtf(s * (1.0f / 1024.0f) + 1e-6f);
}
template <int ACT  > struct EpiScale {
    static constexpr bool PERM = true, AFTER_DRAIN = false;
    bf16_t* O; int ldc; const float* ssqp;
    __device__ __forceinline__ void operator()(const f32x4 (&acc)[2][2][4][2], const Unit& u, int wr, int wc, int fr, int fq) const {
        const int row0 = u.pm * BM + wr * 64 + fr, col0 = u.pn * BM + wc * 32 + 8 * fq;
#pragma unroll
        for (int ai = 0; ai < 2; ++ai)
#pragma unroll
            for (int m = 0; m < 4; ++m) {
                const int row = row0 + ai * HALF + m * 16;
                const float rs = row_rstd(ssqp, row);
                bf16_t* rowp = O + (size_t)row * ldc + col0;
#pragma unroll
                for (int bj = 0; bj < 2; ++bj) {
                    f32x4 v0 = acc[ai][bj][m][0] * rs, v1 = acc[ai][bj][m][1] * rs;
                    if (ACT == 1) {
#pragma unroll
                        for (int e = 0; e < 4; ++e) { const float a0 = fmaxf(v0[e], 0.f), a1 = fmaxf(v1[e], 0.f); v0[e] = a0 * a0; v1[e] = a1 * a1; }
                    }
                    u32x4 w; w.x = cvt_pk_bf16(v0[0], v0[1]); w.y = cvt_pk_bf16(v0[2], v0[3]); w.z = cvt_pk_bf16(v1[0], v1[1]); w.w = cvt_pk_bf16(v1[2], v1[3]);
                    *(u32x4*)(rowp + bj * HALF) = w;
                }
            }
    }
};
template <int RIN, int OUT> struct EpiResid {
    static constexpr bool PERM = true, AFTER_DRAIN = false;
    const void* R; float* out; bf16_t* hb; float* ssqp;
    __device__ __forceinline__ void operator()(const f32x4 (&acc)[2][2][4][2], const Unit& u, int wr, int wc, int fr, int fq) const {
        const int row0 = u.pm * BM + wr * 64 + fr, col0 = u.pn * BM + wc * 32 + 8 * fq;
#pragma unroll
        for (int ai = 0; ai < 2; ++ai)
#pragma unroll
            for (int m = 0; m < 4; ++m) {
                const int row = row0 + ai * HALF + m * 16;
                const size_t off = (size_t)row * 1024 + col0;
                float ss = 0.f;
#pragma unroll
                for (int bj = 0; bj < 2; ++bj) {
                    f32x4 r0, r1;
                    if (RIN == 0) { r0 = *(const f32x4*)((const float*)R + off + bj * HALF); r1 = *(const f32x4*)((const float*)R + off + bj * HALF + 4); }
                    else { const u32x4 rw = *(const u32x4*)((const bf16_t*)R + off + bj * HALF);
                        r0 = (f32x4){__uint_as_float(rw.x << 16), __uint_as_float(rw.x & 0xffff0000u), __uint_as_float(rw.y << 16), __uint_as_float(rw.y & 0xffff0000u)};
                        r1 = (f32x4){__uint_as_float(rw.z << 16), __uint_as_float(rw.z & 0xffff0000u), __uint_as_float(rw.w << 16), __uint_as_float(rw.w & 0xffff0000u)}; }
                    const f32x4 v0 = acc[ai][bj][m][0] + r0, v1 = acc[ai][bj][m][1] + r1;
                    if (OUT == 1) { *(f32x4*)(out + off + bj * HALF) = v0; *(f32x4*)(out + off + bj * HALF + 4) = v1; }
                    else {
                        u32x4 w; w.x = cvt_pk_bf16(v0[0], v0[1]); w.y = cvt_pk_bf16(v0[2], v0[3]); w.z = cvt_pk_bf16(v1[0], v1[1]); w.w = cvt_pk_bf16(v1[2], v1[3]);
                        *(u32x4*)(hb + off + bj * HALF) = w;
                        ss += ((v0[0] * v0[0] + v0[1] * v0[1]) + (v0[2] * v0[2] + v0[3] * v0[3])) + ((v1[0] * v1[0] + v1[1] * v1[1]) + (v1[2] * v1[2] + v1[3] * v1[3]));
                    }
                }
                if (OUT == 0) { ss += __shfl_xor(ss, 16); ss += __shfl_xor(ss, 32); if (fq == 0) ssqp[(size_t)row * 16 + u.pn * 4 + wc] = ss; }
            }
    }
};
template <class Epi, class Sched, bool ALIGN_EPI = false, bool SP2 = false>
__device__ __forceinline__ void gemm_phase(PG8_LAS unsigned char* lds, const Gemm g, const Sched& S, const Epi& E, const int wave_in) {
    const int wid = wave_in, lane = (int)__builtin_amdgcn_mbcnt_hi(~0u, __builtin_amdgcn_mbcnt_lo(~0u, 0u)), tid = wid * 64 + lane, wr = wid >> 2, wc = wid & 3, fr = lane & 15, fq = lane >> 4;
    const int K = g.K, nt = K / BK;
    unsigned voffA[2], voffB[2];
#pragma unroll
    for (int i = 0; i < 2; ++i) { int R, C; stage_rc(tid * 16 + i * 8192, R, C); const int Rb = Epi::PERM ? ((R & ~31) + perm32(R & 31)) : R;
        voffA[i] = (unsigned)(R * K + C) * 2u; voffB[i] = (unsigned)(Rb * K + C) * 2u; }
    const size_t kstep = (size_t)(BK * 2);
    const size_t hstep = (size_t)HALF * K * 2;
    const size_t tstep = 2 * hstep;
    const unsigned ldsw = (unsigned)wid * 1024u;
    const int aoff = lds_byte(wr * 64 + fr, fq * 8), boff = lds_byte(wc * 32 + fr, fq * 8);
#define PG8_SA(b, h) (((b) * 2 + (h)) * HTB)
#define PG8_SB(b, h) ((4 + (b) * 2 + (h)) * HTB)
#define PG8_STAGE(bufoff, gbase, voff) do { _Pragma("unroll") for (int _i = 0; _i < 2; ++_i) \
        __builtin_amdgcn_global_load_lds((const unsigned*)((const char*)(gbase) + (voff)[_i]), (PG8_LAS unsigned*)(lds + (bufoff) + ldsw + _i * 8192), 16, 0, 0); } while (0)
#define PG8_LDA(dst, b, h) do { _Pragma("unroll") for (int m = 0; m < 4; ++m) _Pragma("unroll") for (int k = 0; k < 2; ++k) dst[m][k] = *(const PG8_LAS bf16x8*)(lds + PG8_SA(b, h) + aoff + m * 2048 + k * 1024); } while (0)
#define PG8_LDB(dst, b, h) do { _Pragma("unroll") for (int n = 0; n < 2; ++n) _Pragma("unroll") for (int k = 0; k < 2; ++k) dst[n][k] = *(const PG8_LAS bf16x8*)(lds + PG8_SB(b, h) + boff + n * 2048 + k * 1024); } while (0)
#define PG8_MMA(ai, bj, At, Bt) do { __builtin_amdgcn_s_setprio(1); _Pragma("unroll") for (int m = 0; m < 4; ++m) _Pragma("unroll") for (int n = 0; n < 2; ++n) _Pragma("unroll") for (int k = 0; k < 2; ++k) \
        acc[ai][bj][m][n] = __builtin_amdgcn_mfma_f32_16x16x32_bf16(Bt[n][k], At[m][k], acc[ai][bj][m][n], 0, 0, 0); __builtin_amdgcn_s_setprio(0); } while (0)
#define PG8_WAIT_V(n) asm volatile("s_waitcnt vmcnt(" #n ")" ::: "memory")
#define PG8_WAIT_L(n) asm volatile("s_waitcnt lgkmcnt(" #n ")" ::: "memory")
#define PG8_BAR __builtin_amdgcn_s_barrier()
#define PG8_SCHED __builtin_amdgcn_sched_barrier(0)
    Unit cur, nxt; int ui = 0;
    if (!S.next(0, cur)) return;
    f32x4 acc[2][2][4][2];
#pragma unroll
    for (int a = 0; a < 2; ++a)
#pragma unroll
        for (int b = 0; b < 2; ++b)
#pragma unroll
            for (int m = 0; m < 4; ++m)
#pragma unroll
                for (int n = 0; n < 2; ++n) acc[a][b][m][n] = (f32x4){0.f, 0.f, 0.f, 0.f};
    bf16x8 At[4][2], B0[2][2], B1[2][2];
    const char* cA = (const char*)g.A + (size_t)cur.pm * tstep; const char* cB = (const char*)g.Bt + (size_t)cur.pn * tstep;
    S.a_ready(cur);
    if constexpr (SP2) {
        PG8_STAGE(PG8_SB(0, 0), cB, voffB); PG8_STAGE(PG8_SB(0, 1), cB + hstep, voffB); PG8_STAGE(PG8_SA(0, 0), cA, voffA); PG8_STAGE(PG8_SA(0, 1), cA + hstep, voffA);
        if (wr == 1) PG8_BAR;
        PG8_WAIT_V(2); PG8_BAR;
        PG8_STAGE(PG8_SB(1, 0), cB + kstep, voffB); PG8_STAGE(PG8_SA(1, 0), cA + kstep, voffA); PG8_STAGE(PG8_SB(1, 1), cB + hstep + kstep, voffB);
        PG8_WAIT_V(6); PG8_BAR;
    } else {
        PG8_STAGE(PG8_SB(0, 0), cB, voffB); PG8_STAGE(PG8_SA(0, 0), cA, voffA); PG8_STAGE(PG8_SB(0, 1), cB + hstep, voffB); PG8_STAGE(PG8_SA(0, 1), cA + hstep, voffA);
        if (wr == 1) PG8_BAR;
        PG8_WAIT_V(4); PG8_BAR;
        PG8_STAGE(PG8_SB(1, 0), cB + kstep, voffB); PG8_STAGE(PG8_SA(1, 0), cA + kstep, voffA); PG8_STAGE(PG8_SB(1, 1), cB + hstep + kstep, voffB);
        PG8_WAIT_V(6); PG8_BAR;
    }
    for (;;) {
        const bool has_next = S.next(ui + 1, nxt);
        const char* nA = has_next ? (const char*)g.A + (size_t)nxt.pm * tstep : cA; const char* nB = has_next ? (const char*)g.Bt + (size_t)nxt.pn * tstep : cB;
        for (int t = 0; t < nt; t += 2) {
            const bool last = (t == nt - 2);
            const char* a1 = cA + (size_t)(t + 1) * kstep;
            const char* a2 = last ? nA : cA + (size_t)(t + 2) * kstep; const char* b2 = last ? nB : cB + (size_t)(t + 2) * kstep;
            const char* a3 = a2 + kstep; const char* b3 = b2 + kstep;
            if (last && has_next) S.a_ready(nxt);
            if constexpr (SP2) {
            PG8_LDB(B0, 0, 0); PG8_LDB(B1, 0, 1); PG8_SCHED; PG8_LDA(At, 0, 0); PG8_STAGE(PG8_SA(1, 1), a1 + hstep, voffA);
            PG8_WAIT_V(8); PG8_WAIT_L(0); PG8_BAR; PG8_MMA(0, 0, At, B0); PG8_MMA(0, 1, At, B1); PG8_BAR; PG8_SCHED;
            PG8_LDA(At, 0, 1); PG8_STAGE(PG8_SB(0, 0), b2, voffB); PG8_STAGE(PG8_SB(0, 1), b2 + hstep, voffB); PG8_STAGE(PG8_SA(0, 0), a2, voffA);
            PG8_WAIT_V(8); PG8_WAIT_L(0); PG8_BAR; PG8_MMA(1, 0, At, B0); PG8_MMA(1, 1, At, B1); PG8_BAR; PG8_SCHED;
            PG8_LDB(B0, 1, 0); PG8_LDB(B1, 1, 1); PG8_SCHED; PG8_LDA(At, 1, 0); PG8_STAGE(PG8_SA(0, 1), a2 + hstep, voffA);
            PG8_WAIT_V(8); PG8_WAIT_L(0); PG8_BAR; PG8_MMA(0, 0, At, B0); PG8_MMA(0, 1, At, B1); PG8_BAR; PG8_SCHED;
            PG8_LDA(At, 1, 1); PG8_STAGE(PG8_SB(1, 0), b3, voffB); PG8_STAGE(PG8_SB(1, 1), b3 + hstep, voffB); PG8_STAGE(PG8_SA(1, 0), a3, voffA);
            PG8_WAIT_V(8); PG8_WAIT_L(0); PG8_BAR; PG8_MMA(1, 0, At, B0); PG8_MMA(1, 1, At, B1); PG8_BAR; PG8_SCHED;
            } else {
            PG8_LDB(B0, 0, 0); PG8_SCHED; PG8_LDA(At, 0, 0); PG8_STAGE(PG8_SA(1, 1), a1 + hstep, voffA);
            PG8_WAIT_L(8); PG8_BAR; PG8_WAIT_L(0); PG8_MMA(0, 0, At, B0); PG8_BAR; PG8_SCHED;
            PG8_LDB(B1, 0, 1); PG8_STAGE(PG8_SB(0, 0), b2, voffB);
            PG8_BAR; PG8_WAIT_L(0); PG8_MMA(0, 1, At, B1); PG8_BAR;
            PG8_LDA(At, 0, 1); PG8_STAGE(PG8_SA(0, 0), a2, voffA);
            PG8_BAR; PG8_WAIT_L(0); PG8_MMA(1, 0, At, B0); PG8_BAR; PG8_SCHED;
            PG8_STAGE(PG8_SB(0, 1), b2 + hstep, voffB);
            PG8_WAIT_V(6); PG8_BAR; PG8_MMA(1, 1, At, B1); PG8_BAR;
            PG8_LDB(B0, 1, 0); PG8_SCHED; PG8_LDA(At, 1, 0); PG8_STAGE(PG8_SA(0, 1), a2 + hstep, voffA);
            PG8_WAIT_L(8); PG8_BAR; PG8_WAIT_L(0); PG8_MMA(0, 0, At, B0); PG8_BAR; PG8_SCHED;
            PG8_LDB(B1, 1, 1); PG8_STAGE(PG8_SB(1, 0), b3, voffB);
            PG8_BAR; PG8_WAIT_L(0); PG8_MMA(0, 1, At, B1); PG8_BAR;
            PG8_LDA(At, 1, 1); PG8_STAGE(PG8_SA(1, 0), a3, voffA);
            PG8_BAR; PG8_WAIT_L(0); PG8_MMA(1, 0, At, B0); PG8_BAR; PG8_SCHED;
            PG8_STAGE(PG8_SB(1, 1), b3 + hstep, voffB);
            PG8_WAIT_V(6); PG8_BAR; PG8_MMA(1, 1, At, B1); PG8_BAR;
            }
        }
        if constexpr (ALIGN_EPI) { if (wr == 0) PG8_BAR; }
        if constexpr (!Epi::AFTER_DRAIN) { E(acc, cur, wr, wc, fr, fq); S.done(cur); }
        if (!has_next) break;
#pragma unroll
        for (int a = 0; a < 2; ++a)
#pragma unroll
            for (int b = 0; b < 2; ++b)
#pragma unroll
                for (int m = 0; m < 4; ++m)
#pragma unroll
                    for (int n = 0; n < 2; ++n) acc[a][b][m][n] = (f32x4){0.f, 0.f, 0.f, 0.f};
        cur = nxt; cA = nA; cB = nB; ++ui;
        if constexpr (ALIGN_EPI) { if (wr == 1) PG8_BAR; }
    }
    PG8_WAIT_V(0);
    if constexpr (!ALIGN_EPI) { if (wr == 0) PG8_BAR; }
    PG8_BAR;
    if constexpr (Epi::AFTER_DRAIN) { E.fused(acc, cur, wr, wc, fr, fq, lds, wid, lane); S.done(cur); }
#undef PG8_SA
#undef PG8_SB
#undef PG8_STAGE
#undef PG8_LDA
#undef PG8_LDB
#undef PG8_MMA
#undef PG8_WAIT_V
#undef PG8_WAIT_L
#undef PG8_BAR
#undef PG8_SCHED
}
}
#include <cmath>
constexpr int NWAVES = 8, NTHR = 512;
constexpr int BATCH = 16, SEQ = 2048, M = BATCH * SEQ, D = 1024, FF = 4096, NAB = 3840, NC = 3072, ABP_OLD = 3672;
constexpr int C_QA = 0, C_KA = 512, C_VA = 1024, C_IQ = 1536, C_QB = 2048, C_KB = 2304, C_VB = 2560, C_OG = 3072, C_IK = 3584, C_IW = 3648, C_GL = 3656;
constexpr float EPS = 1e-6f;
constexpr size_t MiB = 1u << 20;
constexpr size_t WS_CTL = 0, CTL_ZERO_BYTES = 1 * MiB;
constexpr size_t WS_WAB = 1 * MiB, WS_WOAB = 9 * MiB, WS_WUP0 = 11 * MiB, WS_WDN0 = 19 * MiB, WS_WINC = 27 * MiB, WS_WOC = 33 * MiB, WS_WUP1 = 35 * MiB, WS_WDN1 = 43 * MiB;
constexpr size_t WS_SSQ = 51 * MiB, SSQ_BYTES = 2 * MiB;
constexpr size_t WS_DEC = 59 * MiB;
constexpr size_t WS_ROPE = 59 * MiB + 512 * 1024;
constexpr size_t WS_XB = 60 * MiB;
constexpr size_t WS_CAT = 124 * MiB;
constexpr size_t WS_MASK = 188 * MiB;
constexpr size_t WS_R1 = 196 * MiB;
constexpr size_t WS_END = 452 * MiB;
constexpr int CW_BAR = 4096;
constexpr int RING_BYTES = 131072;
constexpr int LDS_BYTES = 163840;
constexpr int MISC_OFF = LDS_BYTES - 256;
#define GAS __attribute__((address_space(1)))
#define LAS __attribute__((address_space(3)))
typedef unsigned short bf16;
typedef unsigned v4u __attribute__((ext_vector_type(4)));
typedef float f32x4 __attribute__((ext_vector_type(4)));
typedef short bf16x8 __attribute__((ext_vector_type(8)));
typedef GAS unsigned gu32;
typedef GAS unsigned long long gu64;
#define RLX_AGENT __ATOMIC_RELAXED, __HIP_MEMORY_SCOPE_AGENT
#define LDS_WAIT() asm volatile("s_waitcnt lgkmcnt(0)" ::: "memory")
#define VM_WAIT() asm volatile("s_waitcnt vmcnt(0)" ::: "memory")
__device__ __forceinline__ unsigned long long rt() { return __builtin_amdgcn_s_memrealtime(); }
__device__ __forceinline__ unsigned f2bf(float f) { unsigned u = __builtin_bit_cast(unsigned, f); return (u + 0x7fffu + ((u >> 16) & 1u)) >> 16; }
__device__ __forceinline__ unsigned pk2(float lo, float hi) { return f2bf(lo) | (f2bf(hi) << 16); }
#define XB_TMO      128
#define XB_XCNT(j)  (256  + 64 * (j))
#define XB_XSUB(j)  (1280 + 64 * (j))
#define XB_XGEN(j)  (2304 + 64 * (j))
#define XB_TOP      3328
#define XB_TOPGEN   3392
#define XCD_BAR_WORDS 3456
#define XB_SPIN_CAP (1u << 18)

__device__ __forceinline__ unsigned xb_ld(unsigned* p)              { return __hip_atomic_load(p, __ATOMIC_RELAXED, __HIP_MEMORY_SCOPE_AGENT); }
__device__ __forceinline__ unsigned xb_add(unsigned* p, unsigned v) { return __hip_atomic_fetch_add(p, v, __ATOMIC_RELAXED, __HIP_MEMORY_SCOPE_AGENT); }
__device__ __forceinline__ unsigned xb_xcc_id() { return (unsigned)__builtin_amdgcn_s_getreg((3 << 11) | 20) & 0xFu; }
#define XB_SPIN(cond, bar) do { unsigned _sp = 0; while (cond) { __builtin_amdgcn_s_sleep(1); \
    if ((++_sp & 255u) == 0u) { if (xb_ld(&(bar)[XB_TMO])) break; if (_sp > XB_SPIN_CAP) { atomicAdd(&(bar)[XB_TMO], 1u); break; } } } } while (0)

struct XcdBarrier {
    unsigned* bar; unsigned x; int wave;
    volatile LAS unsigned* st;
};

__device__ __forceinline__ bool xb_t0(int wave) { return wave == 0 && __builtin_amdgcn_mbcnt_hi(~0u, __builtin_amdgcn_mbcnt_lo(~0u, 0u)) == 0u; }
__device__ __forceinline__ XcdBarrier xcd_barrier_post(unsigned* bar, volatile LAS unsigned* st, int wave) {
    XcdBarrier b; b.bar = bar; b.x = xb_xcc_id(); b.st = st; b.wave = wave;
    if (xb_t0(wave)) (void)xb_add(&bar[XB_XCNT(b.x)], 1u);
    return b;
}
__device__ __forceinline__ void xcd_barrier_complete(unsigned* bar, unsigned x, unsigned& nloc, unsigned& nx) {
    const unsigned G = gridDim.x * gridDim.y * gridDim.z;
    unsigned sum, cnt, mine, sp = 0u;
    for (;;) {
        sum = 0u; cnt = 0u; mine = 0u;
#pragma unroll
        for (unsigned j = 0; j < 16; ++j) { const unsigned c = xb_ld(&bar[XB_XCNT(j)]); sum += c; cnt += (c > 0u) ? 1u : 0u; mine = (j == x) ? c : mine; }
        if (sum == G) break;
        __builtin_amdgcn_s_sleep(1);
        if ((++sp & 255u) == 0u) { if (xb_ld(&bar[XB_TMO])) break; if (sp > XB_SPIN_CAP) { atomicAdd(&bar[XB_TMO], 1u); break; } }
    }
    nloc = mine > 0u ? mine : 1u; nx = cnt > 0u ? cnt : 1u;
}

__device__ __forceinline__ void xcd_barrier(const XcdBarrier& b) {
    asm volatile("s_waitcnt vmcnt(0)" ::: "memory");
    __syncthreads();
    if (xb_t0(b.wave)) {
        unsigned* bar = b.bar;
        __builtin_amdgcn_s_waitcnt(0);
        unsigned nloc = b.st[0], nx = b.st[1];
        if (nloc == 0u) { xcd_barrier_complete(bar, b.x, nloc, nx); b.st[0] = nloc; b.st[1] = nx; }
        const unsigned old = xb_add(&bar[XB_XSUB(b.x)], 1u);
        const unsigned gen = old / nloc;
        if (old + 1u == (gen + 1u) * nloc) {
            __builtin_amdgcn_fence(__ATOMIC_RELEASE, "agent");
            asm volatile("s_waitcnt vmcnt(0)" ::: "memory");
            const unsigned og = xb_add(&bar[XB_TOP], 1u);
            const unsigned tg = og / nx;
            if (og + 1u == (tg + 1u) * nx) xb_add(&bar[XB_TOPGEN], 1u);
            else XB_SPIN(xb_ld(&bar[XB_TOPGEN]) == tg, bar);
            __builtin_amdgcn_fence(__ATOMIC_ACQUIRE, "agent");
            xb_add(&bar[XB_XGEN(b.x)], 1u);
            asm volatile("s_waitcnt vmcnt(0)" ::: "memory");
        } else {
            XB_SPIN(xb_ld(&bar[XB_XGEN(b.x)]) == gen, bar);
            __builtin_amdgcn_fence(__ATOMIC_ACQUIRE, "agent");
            asm volatile("s_waitcnt vmcnt(0)" ::: "memory");
        }
    }
    __syncthreads();
}
#ifdef PROBE_ACC
#define ACC_BEGIN(F, id) do { if ((id) == PROBE_ACC) { __syncthreads(); (F).acc_t0 = __builtin_amdgcn_s_memrealtime(); } } while (0)
#define ACC_END(F, id) do { if ((id) == PROBE_ACC) { __syncthreads(); (F).acc_sum += __builtin_amdgcn_s_memrealtime() - (F).acc_t0; } } while (0)
#else
#define ACC_BEGIN(F, id) do { } while (0)
#define ACC_END(F, id) do { } while (0)
#endif
struct Frame {
#ifdef PROBE_ACC
    unsigned long long acc_t0, acc_sum;
#endif
    LAS unsigned char* lds;
    volatile LAS unsigned* MISC;
    gu32* ctl;
    int tid, lane, wave, vcu, G;
    const float *x, *g_mix, *g_ffn, *w_in_ab, *gq_a, *gk_a, *w_gate_up, *b_gate, *g_gla, *w_out_ab, *w_in_c, *gq_c, *gk_c, *w_out_c, *w_up, *w_down;
    float* out;
    bf16 *Wab, *Woab, *Wup0, *Wdn0, *Winc, *Woc, *Wup1, *Wdn1;
    bf16 *XB, *CAT, *R1;
    float* SSQ; unsigned* MASK;
};
__device__ __forceinline__ int lane_id_opaque() { int l; asm volatile("v_mbcnt_lo_u32_b32 %0, -1, 0\n\tv_mbcnt_hi_u32_b32 %0, -1, %0" : "=v"(l)); return l; }
__device__ __forceinline__ float bf2f(bf16 v) { return __builtin_bit_cast(float, (unsigned)v << 16); }
__device__ __forceinline__ float wave_sum(float v) {
#pragma unroll
    for (int o = 1; o < 64; o <<= 1) v += __shfl_xor(v, o);
    return v;
}
__device__ __forceinline__ float wave_max(float v) {
#pragma unroll
    for (int o = 1; o < 64; o <<= 1) v = fmaxf(v, __shfl_xor(v, o));
    return v;
}
__device__ __forceinline__ float log_sigmoid(float x) { return fminf(x, 0.f) - log1pf(expf(-fabsf(x))); }

__device__ __forceinline__ int oldcol_ab(int n) {
    if (n < 2048) return n;
    if (n < 2304) return 2120 + (n - 2048);
    if (n < 2560) return 2376 + (n - 2304);
    if (n < 3072) return 2632 + (n - 2560);
    if (n < 3584) return 3160 + (n - 3072);
    if (n < 3648) return 2048 + (n - 3584);
    if (n < 3656) return 2112 + (n - 3648);
    if (n < 3672) return 3144 + (n - 3656);
    return -1;
}
__device__ __forceinline__ void p0_transpose_item(const float* W, int ldw, int K, const float* gain, bf16* WT, bool map, int item, int nblk, int lane) {
    const int kb = item / nblk, nb = item % nblk, ng = lane & 7, ko = lane >> 3, k0 = 64 * kb + 8 * ko, n = 32 * nb + 4 * ng;
    const int oc = map ? oldcol_ab(n) : n;
    f32x4 v[8];
#pragma unroll
    for (int i = 0; i < 8; ++i) { v[i] = (f32x4){0.f, 0.f, 0.f, 0.f}; if (oc >= 0) v[i] = *(const GAS f32x4*)(W + (size_t)(k0 + i) * ldw + oc); }
    if (gain) { const f32x4 g0 = *(const GAS f32x4*)(gain + k0), g1 = *(const GAS f32x4*)(gain + k0 + 4);
#pragma unroll
        for (int i = 0; i < 4; ++i) { v[i] = v[i] * g0[i]; v[4 + i] = v[4 + i] * g1[i]; } }
#pragma unroll
    for (int e = 0; e < 4; ++e) { v4u o; o.x = pk2(v[0][e], v[1][e]); o.y = pk2(v[2][e], v[3][e]); o.z = pk2(v[4][e], v[5][e]); o.w = pk2(v[6][e], v[7][e]);
        *(GAS v4u*)(WT + (size_t)(n + e) * K + k0) = o; }
}
__device__ __forceinline__ void ph_prologue(Frame& F) {
    const int gw = F.vcu * NWAVES + F.wave, NGW = F.G * NWAVES;
    constexpr int I_AB = (D / 64) * (NAB / 32), I_O = (D / 64) * (D / 32), I_UP = (D / 64) * (FF / 32), I_DN = (FF / 64) * (D / 32), I_C = (D / 64) * (NC / 32);
    constexpr int NITEMS = I_AB + 2 * I_O + 2 * I_UP + 2 * I_DN + I_C;
    for (int it = gw; it < NITEMS; it += NGW) {
        int r = it;
        if (r < I_AB) { p0_transpose_item(F.w_in_ab, ABP_OLD, D, F.g_mix, F.Wab, true, r, NAB / 32, F.lane); continue; } r -= I_AB;
        if (r < I_O) { p0_transpose_item(F.w_out_ab, D, D, nullptr, F.Woab, false, r, D / 32, F.lane); continue; } r -= I_O;
        if (r < I_UP) { p0_transpose_item(F.w_up, FF, D, F.g_ffn, F.Wup0, false, r, FF / 32, F.lane); continue; } r -= I_UP;
        if (r < I_DN) { p0_transpose_item(F.w_down, D, FF, nullptr, F.Wdn0, false, r, D / 32, F.lane); continue; } r -= I_DN;
        if (r < I_C) { p0_transpose_item(F.w_in_c, NC, D, F.g_mix + D, F.Winc, false, r, NC / 32, F.lane); continue; } r -= I_C;
        if (r < I_O) { p0_transpose_item(F.w_out_c, D, D, nullptr, F.Woc, false, r, D / 32, F.lane); continue; } r -= I_O;
        if (r < I_UP) { p0_transpose_item(F.w_up + (size_t)D * FF, FF, D, F.g_ffn + D, F.Wup1, false, r, FF / 32, F.lane); continue; } r -= I_UP;
        p0_transpose_item(F.w_down + (size_t)FF * D, D, FF, nullptr, F.Wdn1, false, r, D / 32, F.lane);
    }
    for (int m = gw; m < M; m += NGW) {
        const GAS f32x4* xr = (const GAS f32x4*)(F.x + (size_t)m * D) + F.lane;
        f32x4 v[4]; float s = 0.f;
#pragma unroll
        for (int j = 0; j < 4; ++j) { v[j] = xr[64 * j]; s += (v[j].x * v[j].x + v[j].y * v[j].y) + (v[j].z * v[j].z + v[j].w * v[j].w); }
        s = wave_sum(s);
        GAS unsigned long long* o8 = (GAS unsigned long long*)(F.XB + (size_t)m * D) + F.lane;
#pragma unroll
        for (int j = 0; j < 4; ++j) o8[64 * j] = (unsigned long long)pk2(v[j].x, v[j].y) | ((unsigned long long)pk2(v[j].z, v[j].w) << 32);
        if (F.lane < 16) F.SSQ[(size_t)m * 16 + F.lane] = (F.lane == 0) ? s : 0.f;
    }
}
namespace att {
typedef short s16x4 __attribute__((ext_vector_type(4)));
typedef float f32x16 __attribute__((ext_vector_type(16)));
typedef _Float16 f16x8 __attribute__((ext_vector_type(8)));
typedef unsigned u32x4 __attribute__((ext_vector_type(4)));
typedef short v4i16_t __attribute__((ext_vector_type(4)));
constexpr float C2 = 0.08838834764831845f * 1.4426950408889634f;
__device__ __forceinline__ int crow(int r, int hi) { return (r & 3) + 8 * (r >> 2) + 4 * hi; }
__device__ __forceinline__ int img_off(int row, int ch) { return 256 * row + 16 * (ch ^ (((row & 3) << 2) | ((row >> 2) & 3))); }
__device__ __forceinline__ bf16x8 pack8(float a0, float a1, float a2, float a3, float a4, float a5, float a6, float a7) {
    u32x4 w; w.x = pg8::cvt_pk_bf16(a0, a1); w.y = pg8::cvt_pk_bf16(a2, a3); w.z = pg8::cvt_pk_bf16(a4, a5); w.w = pg8::cvt_pk_bf16(a6, a7);
    return __builtin_bit_cast(bf16x8, w);
}
__device__ __forceinline__ f16x8 pack8h(float a0, float a1, float a2, float a3, float a4, float a5, float a6, float a7) {
    f16x8 r; r[0] = (_Float16)a0; r[1] = (_Float16)a1; r[2] = (_Float16)a2; r[3] = (_Float16)a3; r[4] = (_Float16)a4; r[5] = (_Float16)a5; r[6] = (_Float16)a6; r[7] = (_Float16)a7; return r;
}
__device__ __forceinline__ void dma_off_init(unsigned (&dvo)[2], int ld, int wave, int lane) {
#pragma unroll
    for (int i = 0; i < 2; ++i) { const int pi = 2 * wave + i, row = 4 * pi + (lane >> 4), pc = lane & 15, ch = pc ^ (((row & 3) << 2) | ((row >> 2) & 3)); dvo[i] = (unsigned)(row * ld + ch * 8) * 2u; }
}
__device__ __forceinline__ void tile_dma(const bf16* g, const unsigned (&dvo)[2], LAS unsigned char* buf, int wave) {
#pragma unroll
    for (int i = 0; i < 2; ++i) __builtin_amdgcn_global_load_lds((const unsigned*)((const char*)g + dvo[i]), (LAS unsigned*)(buf + 1024 * (2 * wave + i)), 16, 0, 0);
}
struct FragOff { int k[8]; int va[4]; int vd; };
__device__ __forceinline__ void frag_off_init(FragOff& fo, int lane) {
    const int hi = lane >> 5, r32 = lane & 31, i = lane & 15, q = i >> 2, p = i & 3, x = 2 * ((lane >> 4) & 1) + (p >> 1);
#pragma unroll
    for (int ks = 0; ks < 8; ++ks) fo.k[ks] = img_off(r32, 2 * ks + hi);
#pragma unroll
    for (int ct = 0; ct < 4; ++ct) fo.va[ct] = img_off(4 * hi + q, 4 * ct + x) + 8 * (p & 1);
    fo.vd = img_off(4 * hi + q + 8, x) - img_off(4 * hi + q, x);
}
__device__ __forceinline__ bf16x8 k_frag(const LAS unsigned char* kbuf, const FragOff& fo, int rt, int ks) { return *(const LAS bf16x8*)(kbuf + fo.k[ks] + 8192 * rt); }
__device__ __forceinline__ s16x4 vtr(const LAS unsigned char* p) { return __builtin_bit_cast(s16x4, __builtin_amdgcn_ds_read_tr16_b64_v4i16((LAS v4i16_t*)p)); }
__device__ __forceinline__ bf16x8 v_frag(const LAS unsigned char* vbuf, const FragOff& fo, int ct, int kk) {
    const s16x4 lo = vtr(vbuf + fo.va[ct] + 4096 * kk), hh = vtr(vbuf + fo.va[ct] + fo.vd + 4096 * kk);
    return (bf16x8){lo[0], lo[1], lo[2], lo[3], hh[0], hh[1], hh[2], hh[3]};
}
#define TR_READ(dst, addr, OFF) asm volatile("ds_read_b64_tr_b16 %0, %1 offset:%c2" : "=&v"(dst) : "v"(addr), "i"(OFF) : "memory")
#define LGKM_WAIT0() do { asm volatile("s_waitcnt lgkmcnt(0)" ::: "memory"); __builtin_amdgcn_sched_barrier(0); } while (0)
__device__ __forceinline__ bf16x8 mk_frag(s16x4 lo, s16x4 hh) { return (bf16x8){lo[0], lo[1], lo[2], lo[3], hh[0], hh[1], hh[2], hh[3]}; }
__device__ __forceinline__ int frag_va(int lane, int ct) { const int hi = lane >> 5, i = lane & 15, q = i >> 2, p = i & 3, x = 2 * ((lane >> 4) & 1) + (p >> 1); return img_off(4 * hi + q, 4 * ct + x) + 8 * (p & 1); }
__device__ __forceinline__ bf16x8 v_frag_rt(const LAS unsigned char* vbuf, int va, int vd, int kk) {
    const s16x4 lo = vtr(vbuf + va + 4096 * kk), hh = vtr(vbuf + va + vd + 4096 * kk);
    return (bf16x8){lo[0], lo[1], lo[2], lo[3], hh[0], hh[1], hh[2], hh[3]};
}
__device__ __forceinline__ void store_o(const f32x16 (&o)[4], const float (&rscale)[16], LAS unsigned char* stg, bf16* dst, int ld, int lane) {
    const int hi = lane >> 5, r32 = lane & 31;
#pragma unroll
    for (int r = 0; r < 16; ++r) { const int orow = crow(r, hi);
#pragma unroll
        for (int ct = 0; ct < 4; ++ct) *(LAS bf16*)(stg + orow * 256 + (32 * ct + r32) * 2) = (bf16)f2bf(o[ct][r] * rscale[r]); }
    asm volatile("s_waitcnt lgkmcnt(0)" ::: "memory");
#pragma unroll
    for (int i = 0; i < 8; ++i) { const int c = lane + 64 * i, row = c >> 4, ch = c & 15; const u32x4 v = *(const LAS u32x4*)(stg + row * 256 + ch * 16); *(u32x4*)(dst + (size_t)row * ld + ch * 8) = v; }
}
}
template <bool SCALEQ> __device__ __forceinline__ void ph_prep_a(Frame& F) {
    const int gw = F.vcu * NWAVES + F.wave, NGW = F.G * NWAVES, lane = F.lane;
    for (int tok = gw; tok < M; tok += NGW) {
        const float pos = (float)(tok & (SEQ - 1));
        bf16* pr = F.R1 + (size_t)tok * NAB;
        float c128 = 1.f, s128 = 0.f;
        if (lane < 32) { const int i = lane & 15; const float inv = powf(500000.0f, -(float)i * 2.0f / 32.0f); const float ang = pos * inv; c128 = cosf(ang); s128 = sinf(ang); }
#pragma unroll
        for (int which = 0; which < 2; ++which) {
            const int base = which == 0 ? C_QA : C_KA;
            const float* gn = which == 0 ? F.gq_a : F.gk_a;
            for (int h = 0; h < 4; ++h) {
                float a = bf2f(pr[base + h * 128 + lane]), b = bf2f(pr[base + h * 128 + 64 + lane]);
                const float ss = wave_sum(a * a + b * b);
                const float rs = rsqrtf(ss * (1.f / 128.f) + EPS);
                const float qs = (SCALEQ && which == 0) ? att::C2 : 1.0f;
                a = a * rs * gn[lane] * qs; b = b * rs * gn[64 + lane] * qs;
                const float other = __shfl_xor(a, 16);
                float o = a;
                if (lane < 16) o = a * c128 - other * s128;
                else if (lane < 32) o = a * c128 + other * s128;
                pr[base + h * 128 + lane] = (bf16)f2bf(o); pr[base + h * 128 + 64 + lane] = (bf16)f2bf(b);
            }
        }
        float c64 = 1.f, s64 = 0.f;
        if (lane < 16) { const int i = lane & 7; const float inv = powf(500000.0f, -(float)i * 2.0f / 16.0f); const float ang = pos * inv; c64 = cosf(ang); s64 = sinf(ang); }
        for (int h = 0; h < 9; ++h) {
            const int col = (h < 8) ? C_IQ + h * 64 : C_IK;
            const float a = bf2f(pr[col + lane]);
            const float other = __shfl_xor(a, 8);
            float o = a;
            if (lane < 8) o = a * c64 - other * s64;
            else if (lane < 16) o = a * c64 + other * s64;
            pr[col + lane] = (bf16)f2bf(o);
        }
    }
}
__device__ __forceinline__ void ph_indexer_naive(Frame& F) {
    LAS float* sc = (LAS float*)F.lds;
    LAS float* qv = sc + 2048;
    LAS float* wv = qv + 512;
    LAS unsigned* mw = (LAS unsigned*)(wv + 8);
    const int tid = F.tid;
    for (int tok = F.vcu; tok < M; tok += F.G) {
        const int pos = tok & (SEQ - 1), seq0 = tok - pos, limit = ((pos >> 6) + 1) << 6;
        const bf16* pr = F.R1 + (size_t)tok * NAB;
        qv[tid] = bf2f(pr[C_IQ + tid]);
        if (tid < 8) wv[tid] = bf2f(pr[C_IW + tid]) * 0.35355339059327373f;
        if (tid < 64) mw[tid] = 0u;
        __syncthreads();
        for (int s = tid; s < limit; s += NTHR) {
            const bf16* kp = F.R1 + (size_t)(seq0 + s) * NAB + C_IK;
            float acc[8];
#pragma unroll
            for (int h = 0; h < 8; ++h) acc[h] = 0.f;
            for (int d = 0; d < 64; ++d) { const float kd = bf2f(kp[d]);
#pragma unroll
                for (int h = 0; h < 8; ++h) acc[h] = fmaf(qv[h * 64 + d], kd, acc[h]); }
            float score = 0.f;
#pragma unroll
            for (int h = 0; h < 8; ++h) score += fmaxf(acc[h] * 0.125f, 0.f) * wv[h];
            sc[s] = score;
        }
        __syncthreads();
        if (limit <= 256) { if (tid < 64) mw[tid] = (tid * 32 < limit) ? 0xffffffffu : 0u; }
        else {
            for (int s = tid; s < limit; s += NTHR) {
                const float v = sc[s]; int cnt = 0;
                for (int j = 0; j < limit; ++j) { const float u = sc[j]; cnt += ((u > v) || (u == v && j < s)) ? 1 : 0; }
                if (cnt < 256) atomicOr((unsigned*)&mw[s >> 5], 1u << (s & 31));
            }
        }
        __syncthreads();
        if (tid < 64) F.MASK[(size_t)tok * 64 + tid] = mw[tid];
        __syncthreads();
    }
}
__device__ __forceinline__ float block_sum(float v, LAS float* red, int tid) {
    v = wave_sum(v);
    __syncthreads();
    if ((tid & 63) == 0) red[tid >> 6] = v;
    __syncthreads();
    float r = 0.f;
#pragma unroll
    for (int i = 0; i < NWAVES; ++i) r += red[i];
    return r;
}
__device__ __forceinline__ float block_max(float v, LAS float* red, int tid) {
    v = wave_max(v);
    __syncthreads();
    if ((tid & 63) == 0) red[tid >> 6] = v;
    __syncthreads();
    float r = red[0];
#pragma unroll
    for (int i = 1; i < NWAVES; ++i) r = fmaxf(r, red[i]);
    return r;
}
__device__ __forceinline__ void ph_dsa_naive(Frame& F) {
    LAS unsigned* mw = (LAS unsigned*)F.lds;
    LAS int* pre = (LAS int*)(mw + 64);
    LAS int* idx = pre + 128;
    LAS float* pp = (LAS float*)(idx + 256);
    LAS float* q = pp + 512;
    LAS float* red = q + 512;
    const int tid = F.tid;
    for (int tok = F.vcu; tok < M; tok += F.G) {
        const int pos = tok & (SEQ - 1), seq0 = tok - pos;
        if (tid < 64) mw[tid] = F.MASK[(size_t)tok * 64 + tid];
        q[tid] = bf2f(F.R1[(size_t)tok * NAB + C_QA + tid]);
        __syncthreads();
        if (tid == 0) { int a = 0; for (int w = 0; w < 64; ++w) { pre[w] = a; a += __popc(mw[w]); } pre[64] = a; }
        __syncthreads();
        const int n = pre[64];
        for (int s = tid; s < SEQ; s += NTHR) { const unsigned w = mw[s >> 5]; if ((w >> (s & 31)) & 1u) idx[pre[s >> 5] + __popc(w & ((1u << (s & 31)) - 1u))] = s; }
        __syncthreads();
        for (int h = 0; h < 4; ++h) {
            float sv = -INFINITY;
            if (tid < n) { const bf16* kp = F.R1 + (size_t)(seq0 + idx[tid]) * NAB + C_KA + h * 128; float a = 0.f;
                for (int d = 0; d < 128; ++d) a = fmaf(q[h * 128 + d], bf2f(kp[d]), a);
                sv = a * 0.08838834764831845f; }
            const float m = block_max(sv, red, tid);
            const float e = (tid < n) ? expf(sv - m) : 0.f;
            const float l = block_sum(e, red, tid);
            pp[tid] = e;
            __syncthreads();
            if (tid < 128) { float o = 0.f;
                for (int j = 0; j < n; ++j) o = fmaf(pp[j], bf2f(F.R1[(size_t)(seq0 + idx[j]) * NAB + C_VA + h * 128 + tid]), o);
                F.CAT[(size_t)tok * D + h * 128 + tid] = (bf16)f2bf(o / l); }
            __syncthreads();
        }
    }
}
__device__ __forceinline__ void ph_gla_naive(Frame& F) {
    LAS float* sq = (LAS float*)F.lds; LAS float* sk = sq + 1024; LAS float* sd = sk + 1024;
    LAS float* sg = sd + 1024;
    LAS float* red = sg + 256;
    const int tid = F.tid, lane = F.lane;
    for (int item = F.vcu; item < BATCH * 4; item += F.G) {
        const int b = item >> 2, h = item & 3, seq0 = b * SEQ;
        float S[64];
#pragma unroll
        for (int d = 0; d < 64; ++d) S[d] = 0.f;
        for (int t0 = 0; t0 < SEQ; t0 += 16) {
            if (tid < 256) { const int tt = tid >> 4, r = tid & 15; sg[tid] = bf2f(F.R1[(size_t)(seq0 + t0 + tt) * NAB + C_GL + r]); }
            __syncthreads();
            for (int i = tid; i < 1024; i += NTHR) { const int tt = i >> 6, d = i & 63; const bf16* pr = F.R1 + (size_t)(seq0 + t0 + tt) * NAB;
                sq[i] = bf2f(pr[C_QB + h * 64 + d]) * 0.125f; sk[i] = bf2f(pr[C_KB + h * 64 + d]);
                float g = F.b_gate[h * 64 + d];
#pragma unroll
                for (int r = 0; r < 16; ++r) g = fmaf(sg[tt * 16 + r], F.w_gate_up[r * 256 + h * 64 + d], g);
                sd[i] = expf(log_sigmoid(g) * (1.f / 16.f)); }
            __syncthreads();
            float o[16];
            if (tid < 128) {
#pragma unroll
                for (int tt = 0; tt < 16; ++tt) {
                    const float v = bf2f(F.R1[(size_t)(seq0 + t0 + tt) * NAB + C_VB + h * 128 + tid]); float a = 0.f;
#pragma unroll
                    for (int d = 0; d < 64; ++d) { S[d] = fmaf(sd[tt * 64 + d], S[d], sk[tt * 64 + d] * v); a = fmaf(sq[tt * 64 + d], S[d], a); }
                    o[tt] = a;
                    const float ws = wave_sum(a * a);
                    if (lane == 0) red[tt * 2 + (tid >> 6)] = ws;
                }
            }
            __syncthreads();
            if (tid < 128) {
#pragma unroll
                for (int tt = 0; tt < 16; ++tt) {
                    const size_t tok = seq0 + t0 + tt;
                    const float rs = rsqrtf((red[tt * 2] + red[tt * 2 + 1]) * (1.f / 128.f) + EPS);
                    const float og = bf2f(F.R1[tok * NAB + C_OG + h * 128 + tid]);
                    F.CAT[tok * D + 512 + h * 128 + tid] = (bf16)f2bf(o[tt] * rs * F.g_gla[tid] * (og / (1.f + expf(-og))));
                }
            }
            __syncthreads();
        }
    }
}
template <bool SCALEQ> __device__ __forceinline__ void ph_prep_c(Frame& F) {
    const int gw = F.vcu * NWAVES + F.wave, NGW = F.G * NWAVES, lane = F.lane;
    for (int it = gw; it < M * 16; it += NGW) {
        const int tok = it >> 4, hh = it & 15, isk = hh >> 3, h = hh & 7;
        bf16* p = F.R1 + (size_t)tok * NC + isk * 1024 + h * 128;
        const float* gn = isk ? F.gk_c : F.gq_c;
        const float a = bf2f(p[lane]), b = bf2f(p[64 + lane]);
        const float rs = rsqrtf(wave_sum(a * a + b * b) * (1.f / 128.f) + EPS);
        const float sc = (SCALEQ && !isk) ? att::C2 : 1.0f;
        p[lane] = (bf16)f2bf(a * rs * gn[lane] * sc); p[64 + lane] = (bf16)f2bf(b * rs * gn[64 + lane] * sc);
    }
}
__device__ __forceinline__ void ph_sb_naive(Frame& F) {
    const int gw = F.vcu * NWAVES + F.wave, NGW = F.G * NWAVES, lane = F.lane;
    for (int it = gw; it < M * 8; it += NGW) {
        const int tok = it >> 3, h = it & 7, pos = tok & (SEQ - 1), seq0 = tok - pos;
        const unsigned qq = *(const unsigned*)(F.R1 + (size_t)tok * NC + h * 128 + 2 * lane);
        const float q0 = __builtin_bit_cast(float, qq << 16), q1 = __builtin_bit_cast(float, qq & 0xffff0000u);
        float R = 0.f, o0 = 0.f, o1 = 0.f;
        for (int s = pos - 1; s >= 0; --s) {
            const bf16* pr = F.R1 + (size_t)(seq0 + s) * NC + h * 128 + 2 * lane;
            const unsigned kk = *(const unsigned*)(pr + 1024), vv = *(const unsigned*)(pr + 2048);
            const float k0 = __builtin_bit_cast(float, kk << 16), k1 = __builtin_bit_cast(float, kk & 0xffff0000u);
            const float z = wave_sum(q0 * k0 + q1 * k1) * 0.08838834764831845f;
            const float sp = log1pf(expf(-fabsf(z)));
            const float lsp = fminf(z, 0.f) - sp, lsn = fminf(-z, 0.f) - sp;
            const float a = expf(lsp + R);
            o0 = fmaf(a, __builtin_bit_cast(float, vv << 16), o0); o1 = fmaf(a, __builtin_bit_cast(float, vv & 0xffff0000u), o1);
            R += lsn;
        }
        *(unsigned*)(F.CAT + (size_t)tok * D + h * 128 + 2 * lane) = pk2(o0, o1);
    }
}
__device__ __forceinline__ void sb_unit(Frame& F, int b, int h, int qb) {
    using namespace att;
    const int tid = F.tid, lane = F.lane, w = F.wave, hi = lane >> 5, r32 = lane & 31;
    const bf16* Qg = F.R1 + (size_t)b * SEQ * NC + h * 128; const bf16* Kg = Qg + 1024; const bf16* Vg = Qg + 2048;
    const int T0 = qb * 256, t0w = T0 + 32 * w, jd = t0w >> 6, jtop = (T0 >> 6) + 3, tl = 32 * (w & 1) + r32, tl4 = tl - 4 * hi;
    LAS unsigned char* lds = F.lds;
    FragOff fo; frag_off_init(fo, lane);
    unsigned dvo[2]; dma_off_init(dvo, NC, w, lane);
    bf16x8 qf[8];
#pragma unroll
    for (int ks = 0; ks < 8; ++ks) qf[ks] = *(const bf16x8*)(Qg + (size_t)(t0w + r32) * NC + 16 * ks + 8 * hi);
    f16x8 T0f, T1f, ONEf;
#pragma unroll
    for (int j = 0; j < 8; ++j) { const int kp = 8 * (j >> 2) + 4 * hi + (j & 3); T0f[j] = (kp >= r32) ? (_Float16)1.0f : (_Float16)0.0f; T1f[j] = (kp + 16 >= r32) ? (_Float16)1.0f : (_Float16)0.0f; ONEf[j] = (_Float16)1.0f; }
    f32x16 o[4];
#pragma unroll
    for (int ct = 0; ct < 4; ++ct)
#pragma unroll
        for (int r = 0; r < 16; ++r) o[ct][r] = 0.f;
    float R2 = 0.f; bool done = false;
    volatile LAS unsigned* flags = F.MISC + 16;
    tile_dma(Kg + (size_t)(64 * jtop) * NC, dvo, lds, w); tile_dma(Vg + (size_t)(64 * jtop) * NC, dvo, lds + 16384, w);
    asm volatile("s_waitcnt vmcnt(0)" ::: "memory");
    __syncthreads();
    for (int j = jtop; j >= 0; --j) {
        const int cur = (jtop - j) & 1;
        const LAS unsigned char* kb = lds + cur * 32768; const LAS unsigned char* vb = kb + 16384;
        if (j > 0) { tile_dma(Kg + (size_t)(64 * (j - 1)) * NC, dvo, lds + (cur ^ 1) * 32768, w); tile_dma(Vg + (size_t)(64 * (j - 1)) * NC, dvo, lds + (cur ^ 1) * 32768 + 16384, w); }
        if (j <= jd && !done) {
            f32x16 p0, p1;
#pragma unroll
            for (int r = 0; r < 16; ++r) { p0[r] = 0.f; p1[r] = 0.f; }
            { bf16x8 kf[8];
#pragma unroll
              for (int ks = 0; ks < 8; ++ks) kf[ks] = k_frag(kb, fo, 0, ks);
#pragma unroll
              for (int ks = 0; ks < 8; ++ks) p0 = __builtin_amdgcn_mfma_f32_32x32x16_bf16(kf[ks], qf[ks], p0, 0, 0, 0);
#pragma unroll
              for (int ks = 0; ks < 8; ++ks) kf[ks] = k_frag(kb, fo, 1, ks);
#pragma unroll
              for (int ks = 0; ks < 8; ++ks) p1 = __builtin_amdgcn_mfma_f32_32x32x16_bf16(kf[ks], qf[ks], p1, 0, 0, 0); }
            s16x4 vl[4], vh[4], wl[4], wh[4];
            unsigned va0[4], va1[4];
#pragma unroll
            for (int ct = 0; ct < 4; ++ct) { va0[ct] = (unsigned)(size_t)vb + (unsigned)fo.va[ct]; va1[ct] = va0[ct] + (unsigned)fo.vd; }
            const bool diag = (j == jd);
            float x0[16], x1[16]; float rs = 0.f;
#pragma unroll
            for (int r = 0; r < 16; ++r) { const int key = (r & 3) + 8 * (r >> 2);
                float l0 = -__builtin_amdgcn_logf(1.0f + __builtin_amdgcn_exp2f(p0[r])), l1 = -__builtin_amdgcn_logf(1.0f + __builtin_amdgcn_exp2f(p1[r]));
                if (diag) { if (!(key < tl4)) l0 = 0.f; if (!(key + 32 < tl4)) l1 = 0.f; }
                x0[r] = l0; x1[r] = l1; rs += l0 + l1; p0[r] += R2; p1[r] += R2; }
            const f16x8 xb00 = pack8h(x0[0], x0[1], x0[2], x0[3], x0[4], x0[5], x0[6], x0[7]), xb01 = pack8h(x0[8], x0[9], x0[10], x0[11], x0[12], x0[13], x0[14], x0[15]);
            const f16x8 xb10 = pack8h(x1[0], x1[1], x1[2], x1[3], x1[4], x1[5], x1[6], x1[7]), xb11 = pack8h(x1[8], x1[9], x1[10], x1[11], x1[12], x1[13], x1[14], x1[15]);
            p0 = __builtin_amdgcn_mfma_f32_32x32x16_f16(T0f, xb00, p0, 0, 0, 0); p0 = __builtin_amdgcn_mfma_f32_32x32x16_f16(T1f, xb01, p0, 0, 0, 0);
            p0 = __builtin_amdgcn_mfma_f32_32x32x16_f16(ONEf, xb10, p0, 0, 0, 0); p0 = __builtin_amdgcn_mfma_f32_32x32x16_f16(ONEf, xb11, p0, 0, 0, 0);
            p1 = __builtin_amdgcn_mfma_f32_32x32x16_f16(T0f, xb10, p1, 0, 0, 0); p1 = __builtin_amdgcn_mfma_f32_32x32x16_f16(T1f, xb11, p1, 0, 0, 0);
#pragma unroll
            for (int r = 0; r < 16; ++r) { const int key = (r & 3) + 8 * (r >> 2);
                float a0 = __builtin_amdgcn_exp2f(p0[r]), a1 = __builtin_amdgcn_exp2f(p1[r]);
                if (diag) { if (!(key < tl4)) a0 = 0.f; if (!(key + 32 < tl4)) a1 = 0.f; }
                p0[r] = a0; p1[r] = a1; }
            const bf16x8 pa0 = pack8(p0[0], p0[1], p0[2], p0[3], p0[4], p0[5], p0[6], p0[7]), pa1 = pack8(p0[8], p0[9], p0[10], p0[11], p0[12], p0[13], p0[14], p0[15]);
            const bf16x8 pa2 = pack8(p1[0], p1[1], p1[2], p1[3], p1[4], p1[5], p1[6], p1[7]), pa3 = pack8(p1[8], p1[9], p1[10], p1[11], p1[12], p1[13], p1[14], p1[15]);
#pragma unroll
            for (int ct = 0; ct < 4; ++ct) { TR_READ(vl[ct], va0[ct], 0); TR_READ(vh[ct], va1[ct], 0); }
            LGKM_WAIT0();
#pragma unroll
            for (int ct = 0; ct < 4; ++ct) { TR_READ(wl[ct], va0[ct], 4096); TR_READ(wh[ct], va1[ct], 4096); }
#pragma unroll
            for (int ct = 0; ct < 4; ++ct) o[ct] = __builtin_amdgcn_mfma_f32_32x32x16_bf16(pa0, mk_frag(vl[ct], vh[ct]), o[ct], 0, 0, 0);
            LGKM_WAIT0();
#pragma unroll
            for (int ct = 0; ct < 4; ++ct) { TR_READ(vl[ct], va0[ct], 8192); TR_READ(vh[ct], va1[ct], 8192); }
#pragma unroll
            for (int ct = 0; ct < 4; ++ct) o[ct] = __builtin_amdgcn_mfma_f32_32x32x16_bf16(pa1, mk_frag(wl[ct], wh[ct]), o[ct], 0, 0, 0);
            LGKM_WAIT0();
#pragma unroll
            for (int ct = 0; ct < 4; ++ct) { TR_READ(wl[ct], va0[ct], 12288); TR_READ(wh[ct], va1[ct], 12288); }
#pragma unroll
            for (int ct = 0; ct < 4; ++ct) o[ct] = __builtin_amdgcn_mfma_f32_32x32x16_bf16(pa2, mk_frag(vl[ct], vh[ct]), o[ct], 0, 0, 0);
            LGKM_WAIT0();
#pragma unroll
            for (int ct = 0; ct < 4; ++ct) o[ct] = __builtin_amdgcn_mfma_f32_32x32x16_bf16(pa3, mk_frag(wl[ct], wh[ct]), o[ct], 0, 0, 0);
            rs += __shfl_xor(rs, 32);
            R2 += rs;
            done = __all(R2 < -152.0f);
        }
        if (lane == 0) flags[cur * 8 + w] = done ? 1u : 0u;
        asm volatile("s_waitcnt vmcnt(0) lgkmcnt(0)" ::: "memory");
        __syncthreads();
        unsigned alld = 1u;
#pragma unroll
        for (int i = 0; i < 8; ++i) alld &= flags[cur * 8 + i];
        if (alld) break;
    }
    float ones[16];
#pragma unroll
    for (int r = 0; r < 16; ++r) ones[r] = 1.0f;
    store_o(o, ones, lds + w * 8192, F.CAT + (size_t)(b * SEQ + t0w) * D + h * 128, D, lane);
    __syncthreads();
}
__device__ __forceinline__ void ph_sb(Frame& F) {
    for (int v = F.vcu; v < BATCH * 8 * 2; v += F.G) {
        const int bh = v >> 1, half = v & 1;
#pragma unroll 1
        for (int i = 0; i < 4; ++i) { const int qb = half ? (i == 0 ? 1 : i == 1 ? 6 : i == 2 ? 2 : 5) : (i == 0 ? 0 : i == 1 ? 7 : i == 2 ? 3 : 4); sb_unit(F, bh >> 3, bh & 7, qb); }
    }
}
__device__ __forceinline__ void dsa_unit(Frame& F, int b, int h, int ub, float mref) {
    using namespace att;
    const int lane = F.lane, w = F.wave, hi = lane >> 5, r32 = lane & 31;
    const bf16* Qg = F.R1 + (size_t)b * SEQ * NAB + C_QA + h * 128; const bf16* Kg = F.R1 + (size_t)b * SEQ * NAB + C_KA + h * 128; const bf16* Vg = F.R1 + (size_t)b * SEQ * NAB + C_VA + h * 128;
    const int t0w = 256 * ub + 32 * w, cw = t0w >> 6, jlast = 4 * ub + 3;
    LAS unsigned char* lds = F.lds;
    LAS unsigned char* mst = lds + 65536 + w * 8448;
    FragOff fo; frag_off_init(fo, lane);
    unsigned dvo[2]; dma_off_init(dvo, NAB, w, lane);
    tile_dma(Kg, dvo, lds, w); tile_dma(Vg, dvo, lds + 16384, w);
    bf16x8 qf[8];
#pragma unroll
    for (int ks = 0; ks < 8; ++ks) qf[ks] = *(const bf16x8*)(Qg + (size_t)(t0w + r32) * NAB + 16 * ks + 8 * hi);
    { const unsigned* mg = F.MASK + (size_t)(b * SEQ + t0w) * 64;
#pragma unroll 2
      for (int i = 0; i < 8; ++i) { const int c = lane + 64 * i, row = c >> 4, c4 = c & 15; const u32x4 v = *(const u32x4*)(mg + row * 64 + c4 * 4);
          *(LAS unsigned long long*)(mst + row * 264 + c4 * 16) = (unsigned long long)v.x | ((unsigned long long)v.y << 32);
          *(LAS unsigned long long*)(mst + row * 264 + c4 * 16 + 8) = (unsigned long long)v.z | ((unsigned long long)v.w << 32); } }
    f32x16 o[4];
#pragma unroll
    for (int ct = 0; ct < 4; ++ct)
#pragma unroll
        for (int r = 0; r < 16; ++r) o[ct][r] = 0.f;
    float lsum = 0.f;
    asm volatile("s_waitcnt vmcnt(0) lgkmcnt(0)" ::: "memory");
    __syncthreads();
    for (int j = 0; j <= jlast; ++j) {
        const int cur = j & 1;
        const LAS unsigned char* kb = lds + cur * 32768; const LAS unsigned char* vb = kb + 16384;
        if (j < jlast) { tile_dma(Kg + (size_t)(64 * (j + 1)) * NAB, dvo, lds + (cur ^ 1) * 32768, w); tile_dma(Vg + (size_t)(64 * (j + 1)) * NAB, dvo, lds + (cur ^ 1) * 32768 + 16384, w); }
        if (j <= cw) {
            const unsigned long long mw = *(const LAS unsigned long long*)(mst + r32 * 264 + j * 8);
            const unsigned mw0 = (unsigned)mw, mw1 = (unsigned)(mw >> 32);
#pragma unroll 1
            for (int half = 0; half < 2; ++half) {
                const unsigned mwh = (half ? mw1 : mw0) >> (4 * hi);
                bf16x8 kf[8];
#pragma unroll
                for (int ks = 0; ks < 8; ++ks) kf[ks] = k_frag(kb, fo, half, ks);
                f32x16 p;
#pragma unroll
                for (int r = 0; r < 16; ++r) p[r] = 0.f;
#pragma unroll
                for (int ks = 0; ks < 8; ++ks) p = __builtin_amdgcn_mfma_f32_32x32x16_bf16(kf[ks], qf[ks], p, 0, 0, 0);
#pragma unroll
                for (int r = 0; r < 16; ++r) { const unsigned keep = (unsigned)(-(int)((mwh >> ((r & 3) + 8 * (r >> 2))) & 1u));
                    const float e = __uint_as_float(__float_as_uint(__builtin_amdgcn_exp2f(p[r] - mref)) & keep); p[r] = e; lsum += e; }
                const bf16x8 pa0 = pack8(p[0], p[1], p[2], p[3], p[4], p[5], p[6], p[7]), pa1 = pack8(p[8], p[9], p[10], p[11], p[12], p[13], p[14], p[15]);
                s16x4 vl[8], vh[8];
                const unsigned vbase = (unsigned)(size_t)vb + 8192u * (unsigned)half;
#pragma unroll
                for (int ct = 0; ct < 4; ++ct) { const unsigned a0 = vbase + (unsigned)fo.va[ct], a1 = a0 + (unsigned)fo.vd;
                    TR_READ(vl[2 * ct], a0, 0); TR_READ(vh[2 * ct], a1, 0); TR_READ(vl[2 * ct + 1], a0, 4096); TR_READ(vh[2 * ct + 1], a1, 4096); }
                LGKM_WAIT0();
#pragma unroll
                for (int ct = 0; ct < 4; ++ct) {
                    o[ct] = __builtin_amdgcn_mfma_f32_32x32x16_bf16(pa0, mk_frag(vl[2 * ct], vh[2 * ct]), o[ct], 0, 0, 0);
                    o[ct] = __builtin_amdgcn_mfma_f32_32x32x16_bf16(pa1, mk_frag(vl[2 * ct + 1], vh[2 * ct + 1]), o[ct], 0, 0, 0);
                }
            }
        }
        asm volatile("s_waitcnt vmcnt(0) lgkmcnt(0)" ::: "memory");
        __syncthreads();
    }
    lsum += __shfl_xor(lsum, 32);
    LAS float* lsc = (LAS float*)mst;
    if (hi == 0) lsc[r32] = 1.0f / lsum;
    asm volatile("s_waitcnt lgkmcnt(0)" ::: "memory");
    float rsc[16];
#pragma unroll
    for (int r = 0; r < 16; ++r) rsc[r] = lsc[crow(r, hi)];
    store_o(o, rsc, lds + w * 8192, F.CAT + (size_t)(b * SEQ + t0w) * D + h * 128, D, lane);
    __syncthreads();
}
__device__ __forceinline__ void ph_dsa(Frame& F) {
    float gm = fmaxf(fabsf(F.gq_a[F.lane]), fabsf(F.gq_a[64 + F.lane])), km = fmaxf(fabsf(F.gk_a[F.lane]), fabsf(F.gk_a[64 + F.lane]));
    gm = wave_max(gm); km = wave_max(km);
    const float mref = att::C2 * 128.0f * gm * km * 1.02f;
    for (int v = F.vcu; v < BATCH * 4 * 4; v += F.G) {
        const int bh = v >> 2, pi = v & 3;
#pragma unroll 1
        for (int k = 0; k < 2; ++k) dsa_unit(F, bh >> 2, bh & 3, k ? 7 - pi : pi, mref);
    }
}
namespace idx {
using att::f32x16;
constexpr int SCP = 2048;
__device__ __forceinline__ unsigned okey(float f) { const unsigned u = __float_as_uint(f); return (u & 0x80000000u) ? ~u : (u | 0x80000000u); }
__device__ __forceinline__ int wave_isum(int c) {
    c += __builtin_amdgcn_mov_dpp(c, 0xB1, 0xF, 0xF, true);
    c += __builtin_amdgcn_mov_dpp(c, 0x4E, 0xF, 0xF, true);
    c += __builtin_amdgcn_mov_dpp(c, 0x141, 0xF, 0xF, true);
    c += __builtin_amdgcn_mov_dpp(c, 0x140, 0xF, 0xF, true);
    return (__builtin_amdgcn_readlane(c, 0) + __builtin_amdgcn_readlane(c, 16)) + (__builtin_amdgcn_readlane(c, 32) + __builtin_amdgcn_readlane(c, 48));
}
__device__ __forceinline__ void bit_transpose32x2(unsigned (&A)[32], unsigned (&B)[32]) {
    unsigned mask = 0x0000FFFFu;
#pragma unroll
    for (int s = 16; s; s >>= 1) {
        unsigned ta[16], tb[16];
#pragma unroll
        for (int k = 0, i = 0; k < 32; ++k) if (!(k & s)) { ta[i] = A[k + s] >> s; tb[i] = B[k + s] >> s; ++i; }
#pragma unroll
        for (int k = 0, i = 0; k < 32; ++k) if (!(k & s)) { ta[i] ^= A[k]; tb[i] ^= B[k]; ++i; }
#pragma unroll
        for (int i = 0; i < 16; ++i) { ta[i] &= mask; tb[i] &= mask; }
#pragma unroll
        for (int k = 0, i = 0; k < 32; ++k) if (!(k & s)) { A[k] ^= ta[i]; B[k] ^= tb[i]; ++i; }
#pragma unroll
        for (int k = 0, i = 0; k < 32; ++k) if (!(k & s)) { A[k + s] ^= ta[i] << s; B[k + s] ^= tb[i] << s; ++i; }
        mask ^= mask << (s >> 1);
    }
}
__device__ __forceinline__ void select_rows2(Frame& F, const LAS float* scA, const LAS float* scB, int E, unsigned* mrowA, unsigned* mrowB, int lane) {
    ACC_BEGIN(F, 3);
    unsigned Wa[32], Wb[32];
#pragma unroll
    for (int j = 0; j < 32; ++j) { Wa[31 - j] = __float_as_uint(scA[64 * j + lane]); Wb[31 - j] = __float_as_uint(scB[64 * j + lane]); }
#pragma unroll
    for (int j = 0; j < 32; ++j) { const unsigned ua = Wa[31 - j], ub = Wb[31 - j];
        const unsigned ka = (ua & 0x80000000u) ? ~ua : (ua | 0x80000000u), kb = (ub & 0x80000000u) ? ~ub : (ub | 0x80000000u);
        Wa[31 - j] = (j < E) ? ka : 0u; Wb[31 - j] = (j < E) ? kb : 0u; }
    bit_transpose32x2(Wa, Wb);
    ACC_END(F, 3);
    ACC_BEGIN(F, 4);
    const unsigned valid = (E >= 32) ? 0xFFFFFFFFu : ((1u << E) - 1u);
    unsigned alA = valid, alB = valid, gtA = 0u, gtB = 0u;
    int GA = 0, GB = 0, AA = 64 * E, AB = 64 * E; bool dA = false, dB = false;
#pragma unroll
    for (int b = 0; b < 32; ++b) {
        if (dA && dB) break;
        const unsigned m1a = alA & Wa[b], m1b = alB & Wb[b];
        const int ca = wave_isum(__popc(m1a)), cb = wave_isum(__popc(m1b));
        if (!dA) { if (GA + ca >= 256) { alA = m1a; AA = ca; } else { GA += ca; gtA |= m1a; alA &= ~Wa[b]; AA -= ca; } dA = (GA + AA == 256); }
        if (!dB) { if (GB + cb >= 256) { alB = m1b; AB = cb; } else { GB += cb; gtB |= m1b; alB &= ~Wb[b]; AB -= cb; } dB = (GB + AB == 256); }
    }
    ACC_END(F, 4);
    ACC_BEGIN(F, 5);
#pragma unroll 1
    for (int rr = 0; rr < 2; ++rr) {
        const unsigned al = rr ? alB : alA, gt = rr ? gtB : gtA; const bool done = rr ? dB : dA; unsigned* mrow = rr ? mrowB : mrowA;
        unsigned sel = gt | al;
        if (!done) {
            int need = 256 - (rr ? GB : GA); sel = gt;
            const unsigned long long below = (1ull << lane) - 1ull;
            for (int j = 0; j < E; ++j) { const bool e = (al >> j) & 1u; const unsigned long long eq = __ballot(e);
                if (e && __popcll(eq & below) < need) sel |= 1u << j;
                need -= __popcll(eq); if (need <= 0) break; }
        }
        unsigned long long mine = 0ull;
#pragma unroll
        for (int j = 0; j < 32; ++j) { if (j < E) { const unsigned long long m = __ballot((sel >> j) & 1u); if (lane == j) mine = m; } }
        if (lane < 32) *(unsigned long long*)(mrow + 2 * lane) = mine;
    }
    ACC_END(F, 5);
}
__device__ __forceinline__ void unit(Frame& F, int b, int c, int sub) {
    const int lane = F.lane, w = F.wave, hi = lane >> 5, r32 = lane & 31, tid = F.tid;
    const int n = 64 * (c + 1), t0 = 64 * c + 16 * sub;
    const bf16* P = F.R1 + (size_t)b * SEQ * NAB;
    LAS float* sc = (LAS float*)F.lds;
    LAS float* wt = sc + 16 * SCP;
    ACC_BEGIN(F, 1);
    if (tid < 128) wt[tid] = bf2f(P[(size_t)(t0 + (tid >> 3)) * NAB + C_IW + (tid & 7)]) * (0.125f * 0.35355339059327373f);
    bf16x8 af[4][4];
#pragma unroll
    for (int rt = 0; rt < 4; ++rt)
#pragma unroll
        for (int ks = 0; ks < 4; ++ks) af[rt][ks] = *(const bf16x8*)(P + (size_t)(t0 + 4 * rt + (r32 >> 3)) * NAB + C_IQ + (r32 & 7) * 64 + 16 * ks + 8 * hi);
    __syncthreads();
    const int nstrip = n >> 5;
    bf16x8 bfr[4], bnx[4];
    if (w < nstrip) {
#pragma unroll
        for (int ks = 0; ks < 4; ++ks) bfr[ks] = *(const bf16x8*)(P + (size_t)(32 * w + r32) * NAB + C_IK + 16 * ks + 8 * hi);
    }
    for (int s = w; s < nstrip; s += NWAVES) {
        const bool more = s + NWAVES < nstrip;
        if (more) {
#pragma unroll
            for (int ks = 0; ks < 4; ++ks) bnx[ks] = *(const bf16x8*)(P + (size_t)(32 * (s + NWAVES) + r32) * NAB + C_IK + 16 * ks + 8 * hi);
        }
#pragma unroll
        for (int rt = 0; rt < 4; ++rt) {
            f32x16 acc;
#pragma unroll
            for (int r = 0; r < 16; ++r) acc[r] = 0.f;
#pragma unroll
            for (int ks = 0; ks < 4; ++ks) acc = __builtin_amdgcn_mfma_f32_32x32x16_bf16(af[rt][ks], bfr[ks], acc, 0, 0, 0);
            float part[4];
#pragma unroll
            for (int qi = 0; qi < 4; ++qi) { const f32x4 wv = *(const LAS f32x4*)(wt + (4 * rt + qi) * 8 + 4 * hi);
                part[qi] = fmaxf(acc[4 * qi], 0.f) * wv[0] + fmaxf(acc[4 * qi + 1], 0.f) * wv[1] + fmaxf(acc[4 * qi + 2], 0.f) * wv[2] + fmaxf(acc[4 * qi + 3], 0.f) * wv[3]; }
            const float send0 = hi ? part[0] : part[2], send1 = hi ? part[1] : part[3];
            const float got0 = __shfl_xor(send0, 32), got1 = __shfl_xor(send1, 32);
            const float f0 = (hi ? part[2] : part[0]) + got0, f1 = (hi ? part[3] : part[1]) + got1;
            const int q0 = 4 * rt + 2 * hi;
            sc[q0 * SCP + 32 * s + r32] = f0; sc[(q0 + 1) * SCP + 32 * s + r32] = f1;
        }
        if (more) {
#pragma unroll
            for (int ks = 0; ks < 4; ++ks) bfr[ks] = bnx[ks];
        }
    }
    __syncthreads();
    ACC_END(F, 1);
    ACC_BEGIN(F, 2);
    const int E = n >> 6;
    { const int q = 2 * w;
      unsigned* mrowA = F.MASK + (size_t)(b * SEQ + t0 + q) * 64; unsigned* mrowB = mrowA + 64;
      const LAS float* rowA = sc + q * SCP; const LAS float* rowB = rowA + SCP;
      select_rows2(F, rowA, rowB, E, mrowA, mrowB, lane); }
    __syncthreads();
    ACC_END(F, 2);
}
}
__device__ __forceinline__ void ph_indexer(Frame& F) {
    { const int gw = F.vcu * NWAVES + F.wave, NGW = F.G * NWAVES;
      for (int i = gw; i < BATCH * 256; i += NGW) { const int b = i >> 8, pos = i & 255, n = ((pos >> 6) + 1) << 6;
          if (F.lane < 32) { unsigned long long v = 0ull; if (64 * F.lane < n) v = ~0ull; *(unsigned long long*)(F.MASK + (size_t)(b * SEQ + pos) * 64 + 2 * F.lane) = v; } } }
    for (int u = F.vcu; u < BATCH * 28 * 4; u += F.G) { const int c = 4 + u % 28, rest = u / 28; idx::unit(F, rest >> 2, c, rest & 3); }
}
namespace gla {
using att::f32x16; using att::u32x4;
constexpr int L_WL = 0, L_V = 4096, L_OG = 36864, L_K = 69632, L_Q = 78848, L_PART = 88064, L_STG = 89088, KP = 144, SP = 272;
struct In { u32x4 g0, g1, kk, qq; };
__device__ __forceinline__ void decode(int u, int& b, int& h, int& c) { b = u >> 7; h = (u >> 5) & 3; c = u & 31; }
template <bool NEEDQ> __device__ __forceinline__ void load_in(Frame& F, int u, In& in) {
    int b, h, c; decode(u, b, h, c);
    const bf16* pr = F.R1 + (size_t)(b * SEQ + 64 * c + F.lane) * NAB;
    in.g0 = *(const u32x4*)(pr + C_GL); in.g1 = *(const u32x4*)(pr + C_GL + 8);
    in.kk = *(const u32x4*)(pr + C_KB + h * 64 + 8 * F.wave);
    if (NEEDQ) in.qq = *(const u32x4*)(pr + C_QB + h * 64 + 8 * F.wave);
}
template <bool NEEDOG> __device__ __forceinline__ void dma_in(Frame& F, int u, int buf, const unsigned (&dvo)[2]) {
    int b, h, c; decode(u, b, h, c);
    const bf16* P = F.R1 + (size_t)(b * SEQ + 64 * c) * NAB;
    att::tile_dma(P + C_VB + h * 128, dvo, F.lds + L_V + buf * 16384, F.wave);
    if (NEEDOG) att::tile_dma(P + C_OG + h * 128, dvo, F.lds + L_OG + buf * 16384, F.wave);
}
__device__ __forceinline__ void stage_wl(Frame& F, int h) {
    LAS float* wl = (LAS float*)(F.lds + L_WL);
#pragma unroll
    for (int i = 0; i < 2; ++i) { const int e = F.tid + 512 * i, r = e >> 6, d = e & 63; wl[e] = F.w_gate_up[r * 256 + h * 64 + d]; }
}
__device__ __forceinline__ void unpack8(const u32x4 v, float (&f)[8]) {
#pragma unroll
    for (int i = 0; i < 4; ++i) { f[2 * i] = __uint_as_float(v[i] << 16); f[2 * i + 1] = __uint_as_float(v[i] & 0xffff0000u); }
}
__device__ __forceinline__ void gate_scan(Frame& F, int h, const float (&gl)[16], float (&bc)[8], float (&blast)[8]) {
    const int lane = F.lane, d0 = 8 * F.wave;
    const LAS float* wl = (const LAS float*)(F.lds + L_WL);
    float acc[8];
#pragma unroll
    for (int i = 0; i < 8; ++i) acc[i] = F.b_gate[h * 64 + d0 + i];
#pragma unroll
    for (int r = 0; r < 16; ++r) { const f32x4 w0 = *(const LAS f32x4*)(wl + r * 64 + d0), w1 = *(const LAS f32x4*)(wl + r * 64 + d0 + 4);
#pragma unroll
        for (int i = 0; i < 4; ++i) { acc[i] = fmaf(gl[r], w0[i], acc[i]); acc[4 + i] = fmaf(gl[r], w1[i], acc[4 + i]); } }
#pragma unroll
    for (int i = 0; i < 8; ++i) { float v = (fminf(acc[i], 0.f) - __logf(1.0f + __expf(-fabsf(acc[i])))) * (1.0f / 16.0f);
#pragma unroll
        for (int off = 1; off < 64; off <<= 1) { const float u = __shfl_up(v, off); if (lane >= off) v += u; }
        bc[i] = v; blast[i] = __shfl(v, 63); }
}
__device__ __forceinline__ void pass_a(Frame& F, float* GU, float* DEC) {
    const int lane = F.lane, w = F.wave, hi = lane >> 5, r32 = lane & 31;
    att::FragOff fo; att::frag_off_init(fo, lane);
    unsigned dvo[2]; att::dma_off_init(dvo, NAB, w, lane);
    const int et = w >> 1, dt = w & 1, va_et = att::frag_va(lane, et);
    int u = F.vcu; if (u >= BATCH * 4 * 32) return;
    In cur, nxt; int hprev = -1;
    dma_in<false>(F, u, 0, dvo); load_in<false>(F, u, cur);
    for (int it = 0; u < BATCH * 4 * 32; ++it, u += F.G) {
        int b, h, c; decode(u, b, h, c);
        const int un = u + F.G; const bool more = un < BATCH * 4 * 32;
        if (h != hprev) { stage_wl(F, h); hprev = h; }
        asm volatile("s_waitcnt vmcnt(0) lgkmcnt(0)" ::: "memory");
        __syncthreads();
        float gl[16], kf[8];
        unpack8(cur.g0, (float(&)[8])gl[0]); unpack8(cur.g1, (float(&)[8])gl[8]); unpack8(cur.kk, kf);
        asm volatile("" ::: "memory");
        if (more) { dma_in<false>(F, un, (it + 1) & 1, dvo); load_in<false>(F, un, nxt); }
        float bc[8], blast[8];
        gate_scan(F, h, gl, bc, blast);
        const int uid = u;
#pragma unroll
        for (int i = 0; i < 8; ++i) *(LAS bf16*)(F.lds + L_K + (8 * w + i) * KP + lane * 2) = (bf16)f2bf(kf[i] * __expf(blast[i] - bc[i]));
        if (lane == 0) {
#pragma unroll
            for (int i = 0; i < 8; ++i) DEC[(size_t)uid * 64 + 8 * w + i] = __expf(blast[i]); }
        asm volatile("s_waitcnt lgkmcnt(0)" ::: "memory");
        __syncthreads();
        const LAS unsigned char* vbuf = F.lds + L_V + (it & 1) * 16384;
        f32x16 acc;
#pragma unroll
        for (int r = 0; r < 16; ++r) acc[r] = 0.f;
#pragma unroll
        for (int kk = 0; kk < 4; ++kk) {
            const LAS unsigned char* kp = F.lds + L_K + (32 * dt + r32) * KP + (16 * kk + 4 * hi) * 2;
            const unsigned long long lo = *(const LAS unsigned long long*)kp, hh = *(const LAS unsigned long long*)(kp + 16);
            u32x4 bw; bw.x = (unsigned)lo; bw.y = (unsigned)(lo >> 32); bw.z = (unsigned)hh; bw.w = (unsigned)(hh >> 32);
            acc = __builtin_amdgcn_mfma_f32_32x32x16_bf16(att::v_frag_rt(vbuf, va_et, fo.vd, kk), __builtin_bit_cast(bf16x8, bw), acc, 0, 0, 0);
        }
        float* gu = GU + (size_t)uid * 8192;
#pragma unroll
        for (int r = 0; r < 16; ++r) gu[(32 * et + att::crow(r, hi)) * 64 + 32 * dt + r32] = acc[r];
        cur = nxt;
    }
    __syncthreads();
}
__device__ __forceinline__ void pass_b(Frame& F, float* GU, const float* DEC) {
    for (int idx = F.vcu * NTHR + F.tid; idx < 64 * 128 * 16; idx += F.G * NTHR) {
        const int bh = idx >> 11, e = (idx >> 4) & 127, dq = idx & 15;
        f32x4 S = (f32x4){0.f, 0.f, 0.f, 0.f};
        for (int c0 = 0; c0 < 32; c0 += 8) {
            f32x4 U[8], dec[8];
#pragma unroll
            for (int i = 0; i < 8; ++i) { const size_t uid = (size_t)bh * 32 + c0 + i; U[i] = *(const f32x4*)(GU + (uid * 128 + e) * 64 + 4 * dq); dec[i] = *(const f32x4*)(DEC + uid * 64 + 4 * dq); }
#pragma unroll
            for (int i = 0; i < 8; ++i) { const size_t uid = (size_t)bh * 32 + c0 + i; *(f32x4*)(GU + (uid * 128 + e) * 64 + 4 * dq) = S; S = dec[i] * S + U[i]; }
        }
    }
}
__device__ __forceinline__ void pass_c(Frame& F, const float* GU) {
    const int lane = F.lane, w = F.wave, hi = lane >> 5, r32 = lane & 31, tid = F.tid;
    LAS unsigned char* lds = F.lds;
    att::FragOff fo; att::frag_off_init(fo, lane);
    unsigned dvo[2]; att::dma_off_init(dvo, NAB, w, lane);
    const int et = w >> 1, tt = w & 1, tl = 32 * tt + r32, va_et = att::frag_va(lane, et);
    int u = F.vcu; if (u >= BATCH * 4 * 32) return;
    In cur, nxt; int hprev = -1;
    dma_in<true>(F, u, 0, dvo); load_in<true>(F, u, cur);
    for (int it = 0; u < BATCH * 4 * 32; ++it, u += F.G) {
        int b, h, c; decode(u, b, h, c);
        const int un = u + F.G; const bool more = un < BATCH * 4 * 32;
        if (h != hprev) { stage_wl(F, h); hprev = h; }
        asm volatile("s_waitcnt vmcnt(0) lgkmcnt(0)" ::: "memory");
        __syncthreads();
        float gl[16], kf[8], qf[8];
        unpack8(cur.g0, (float(&)[8])gl[0]); unpack8(cur.g1, (float(&)[8])gl[8]); unpack8(cur.kk, kf); unpack8(cur.qq, qf);
        asm volatile("" ::: "memory");
        if (more) { dma_in<true>(F, un, (it + 1) & 1, dvo); load_in<true>(F, un, nxt); }
        f32x4 sf[8];
        { const float* gs = GU + ((size_t)u * 128 + 32 * et + r32) * 64;
#pragma unroll
          for (int ks = 0; ks < 4; ++ks) { sf[2 * ks] = *(const f32x4*)(gs + 16 * ks + 8 * hi); sf[2 * ks + 1] = *(const f32x4*)(gs + 16 * ks + 8 * hi + 4); } }
        float bc[8], blast[8];
        gate_scan(F, h, gl, bc, blast);
        { float eq[8], ek[8];
#pragma unroll
          for (int i = 0; i < 8; ++i) { eq[i] = qf[i] * 0.125f * __expf(bc[i]); ek[i] = kf[i] * __expf(-bc[i]); }
          *(LAS bf16x8*)(lds + L_Q + lane * KP + 16 * w) = att::pack8(eq[0], eq[1], eq[2], eq[3], eq[4], eq[5], eq[6], eq[7]);
          *(LAS bf16x8*)(lds + L_K + lane * KP + 16 * w) = att::pack8(ek[0], ek[1], ek[2], ek[3], ek[4], ek[5], ek[6], ek[7]); }
        asm volatile("s_waitcnt lgkmcnt(0)" ::: "memory");
        __syncthreads();
        const LAS unsigned char* vbuf = lds + L_V + (it & 1) * 16384; const LAS unsigned char* ogbuf = lds + L_OG + (it & 1) * 16384;
        bf16x8 qfr[4];
#pragma unroll
        for (int ks = 0; ks < 4; ++ks) qfr[ks] = *(const LAS bf16x8*)(lds + L_Q + tl * KP + (16 * ks + 8 * hi) * 2);
        f32x16 p0, p1;
#pragma unroll
        for (int r = 0; r < 16; ++r) { p0[r] = 0.f; p1[r] = 0.f; }
#pragma unroll
        for (int ks = 0; ks < 4; ++ks) {
            const bf16x8 a0 = *(const LAS bf16x8*)(lds + L_K + r32 * KP + (16 * ks + 8 * hi) * 2), a1 = *(const LAS bf16x8*)(lds + L_K + (32 + r32) * KP + (16 * ks + 8 * hi) * 2);
            p0 = __builtin_amdgcn_mfma_f32_32x32x16_bf16(a0, qfr[ks], p0, 0, 0, 0); p1 = __builtin_amdgcn_mfma_f32_32x32x16_bf16(a1, qfr[ks], p1, 0, 0, 0);
        }
        { const int tl4 = tl - 4 * hi;
#pragma unroll
          for (int r = 0; r < 16; ++r) { const int s = (r & 3) + 8 * (r >> 2); if (s > tl4) p0[r] = 0.f; if (s + 32 > tl4) p1[r] = 0.f; } }
        const bf16x8 pa0 = att::pack8(p0[0], p0[1], p0[2], p0[3], p0[4], p0[5], p0[6], p0[7]), pa1 = att::pack8(p0[8], p0[9], p0[10], p0[11], p0[12], p0[13], p0[14], p0[15]);
        const bf16x8 pa2 = att::pack8(p1[0], p1[1], p1[2], p1[3], p1[4], p1[5], p1[6], p1[7]), pa3 = att::pack8(p1[8], p1[9], p1[10], p1[11], p1[12], p1[13], p1[14], p1[15]);
        f32x16 acc;
#pragma unroll
        for (int r = 0; r < 16; ++r) acc[r] = 0.f;
        acc = __builtin_amdgcn_mfma_f32_32x32x16_bf16(att::v_frag_rt(vbuf, va_et, fo.vd, 0), pa0, acc, 0, 0, 0);
        acc = __builtin_amdgcn_mfma_f32_32x32x16_bf16(att::v_frag_rt(vbuf, va_et, fo.vd, 1), pa1, acc, 0, 0, 0);
        acc = __builtin_amdgcn_mfma_f32_32x32x16_bf16(att::v_frag_rt(vbuf, va_et, fo.vd, 2), pa2, acc, 0, 0, 0);
        acc = __builtin_amdgcn_mfma_f32_32x32x16_bf16(att::v_frag_rt(vbuf, va_et, fo.vd, 3), pa3, acc, 0, 0, 0);
#pragma unroll
        for (int ks = 0; ks < 4; ++ks) { const f32x4 s0 = sf[2 * ks], s1 = sf[2 * ks + 1];
            acc = __builtin_amdgcn_mfma_f32_32x32x16_bf16(att::pack8(s0[0], s0[1], s0[2], s0[3], s1[0], s1[1], s1[2], s1[3]), qfr[ks], acc, 0, 0, 0); }
        float ss = 0.f;
#pragma unroll
        for (int r = 0; r < 16; ++r) ss = fmaf(acc[r], acc[r], ss);
        ss += __shfl_xor(ss, 32);
        LAS float* part = (LAS float*)(lds + L_PART);
        if (hi == 0) part[et * 64 + tl] = ss;
        asm volatile("s_waitcnt lgkmcnt(0)" ::: "memory");
        __syncthreads();
        const float rs = rsqrtf(((part[tl] + part[64 + tl]) + (part[128 + tl] + part[192 + tl])) * (1.0f / 128.0f) + EPS);
#pragma unroll
        for (int g = 0; g < 4; ++g) {
            const int e0 = 32 * et + 8 * g + 4 * hi;
            const unsigned long long ow = *(const LAS unsigned long long*)(ogbuf + att::img_off(tl, 4 * et + g) + 8 * hi);
            const f32x4 gg = *(const f32x4*)(F.g_gla + e0);
            float y[4];
#pragma unroll
            for (int i = 0; i < 4; ++i) { const float og = __uint_as_float(((unsigned)(ow >> (16 * i)) & 0xffffu) << 16); y[i] = acc[4 * g + i] * rs * gg[i] * (og * __builtin_amdgcn_rcpf(1.0f + __expf(-og))); }
            *(LAS unsigned long long*)(lds + L_STG + tl * SP + e0 * 2) = (unsigned long long)pg8::cvt_pk_bf16(y[0], y[1]) | ((unsigned long long)pg8::cvt_pk_bf16(y[2], y[3]) << 32);
        }
        asm volatile("s_waitcnt lgkmcnt(0)" ::: "memory");
        __syncthreads();
#pragma unroll
        for (int i = 0; i < 2; ++i) { const int cidx = tid + 512 * i, row = cidx >> 4, ch = cidx & 15;
            *(u32x4*)(F.CAT + (size_t)(b * SEQ + 64 * c + row) * D + 512 + h * 128 + ch * 8) = *(const LAS u32x4*)(lds + L_STG + row * SP + ch * 16); }
        cur = nxt;
    }
    __syncthreads();
}
}
__device__ __forceinline__ void ph_rope_tables(Frame& F, float* R128, float* R64) {
    for (int i = F.vcu * NTHR + F.tid; i < SEQ * 24; i += F.G * NTHR) {
        const int pos = i / 24, k = i % 24;
        if (k < 16) { const float inv = powf(500000.0f, -(float)k * 2.0f / 32.0f), ang = (float)pos * inv; R128[pos * 32 + k] = cosf(ang); R128[pos * 32 + 16 + k] = sinf(ang); }
        else { const int j = k - 16; const float inv = powf(500000.0f, -(float)j * 2.0f / 16.0f), ang = (float)pos * inv; R64[pos * 16 + j] = cosf(ang); R64[pos * 16 + 8 + j] = sinf(ang); }
    }
}
__device__ __forceinline__ float dpp_xor1(float v) { return __builtin_bit_cast(float, __builtin_amdgcn_mov_dpp(__builtin_bit_cast(int, v), 0xB1, 0xF, 0xF, true)); }
__device__ __forceinline__ float dpp_xor2(float v) { return __builtin_bit_cast(float, __builtin_amdgcn_mov_dpp(__builtin_bit_cast(int, v), 0x4E, 0xF, 0xF, true)); }
__device__ __forceinline__ void ph_prep_c_fast(Frame& F) {
    const int gw = F.vcu * NWAVES + F.wave, NGW = F.G * NWAVES, lane = F.lane;
    const float* gn = (lane < 32 ? F.gq_c : F.gk_c) + (lane & 3) * 32;
    const float sc = lane < 32 ? att::C2 : 1.0f;
    float g[32];
#pragma unroll
    for (int i = 0; i < 8; ++i) { const f32x4 v = *(const f32x4*)(gn + 4 * i); g[4 * i] = v[0] * sc; g[4 * i + 1] = v[1] * sc; g[4 * i + 2] = v[2] * sc; g[4 * i + 3] = v[3] * sc; }
    for (int tok = gw; tok < M; tok += NGW) {
        att::u32x4* p = (att::u32x4*)(F.R1 + (size_t)tok * NC + lane * 32);
        att::u32x4 v[4]; float f[32]; float ss = 0.f;
#pragma unroll
        for (int i = 0; i < 4; ++i) v[i] = p[i];
#pragma unroll
        for (int i = 0; i < 4; ++i)
#pragma unroll
            for (int j = 0; j < 4; ++j) { const float a = __uint_as_float(v[i][j] << 16), b = __uint_as_float(v[i][j] & 0xffff0000u); f[8 * i + 2 * j] = a; f[8 * i + 2 * j + 1] = b; ss = fmaf(a, a, fmaf(b, b, ss)); }
        ss += dpp_xor1(ss); ss += dpp_xor2(ss);
        const float rs = rsqrtf(ss * (1.f / 128.f) + EPS);
#pragma unroll
        for (int i = 0; i < 4; ++i) { att::u32x4 o;
#pragma unroll
            for (int j = 0; j < 4; ++j) o[j] = pg8::cvt_pk_bf16(f[8 * i + 2 * j] * rs * g[8 * i + 2 * j], f[8 * i + 2 * j + 1] * rs * g[8 * i + 2 * j + 1]);
            p[i] = o; }
    }
}
__device__ __forceinline__ void ph_prep_a_fast(Frame& F, const float* R128, const float* R64) {
    const int gw = F.vcu * NWAVES + F.wave, NGW = F.G * NWAVES, lane = F.lane, l8 = lane & 7;
    const float* gn = (lane < 32 ? F.gq_a : F.gk_a) + l8 * 16;
    const float sc = lane < 32 ? att::C2 : 1.0f;
    float g[16];
#pragma unroll
    for (int i = 0; i < 4; ++i) { const f32x4 v = *(const f32x4*)(gn + 4 * i); g[4 * i] = v[0] * sc; g[4 * i + 1] = v[1] * sc; g[4 * i + 2] = v[2] * sc; g[4 * i + 3] = v[3] * sc; }
    for (int tok = gw; tok < M; tok += NGW) {
        const int pos = tok & (SEQ - 1);
        bf16* pr = F.R1 + (size_t)tok * NAB;
        {   att::u32x4* p = (att::u32x4*)(pr + lane * 16);
            const att::u32x4 v0 = p[0], v1 = p[1]; float f[16]; float ss = 0.f;
#pragma unroll
            for (int j = 0; j < 4; ++j) { f[2 * j] = __uint_as_float(v0[j] << 16); f[2 * j + 1] = __uint_as_float(v0[j] & 0xffff0000u); f[8 + 2 * j] = __uint_as_float(v1[j] << 16); f[8 + 2 * j + 1] = __uint_as_float(v1[j] & 0xffff0000u); }
#pragma unroll
            for (int i = 0; i < 16; ++i) ss = fmaf(f[i], f[i], ss);
            ss += dpp_xor1(ss); ss += dpp_xor2(ss); ss += __shfl_xor(ss, 4);
            const float rs = rsqrtf(ss * (1.f / 128.f) + EPS);
#pragma unroll
            for (int i = 0; i < 16; ++i) f[i] = f[i] * rs * g[i];
            const float* cs = R128 + pos * 32;
#pragma unroll
            for (int i = 0; i < 16; ++i) { const float other = dpp_xor1(f[i]);
                if (l8 < 2) { const float c = cs[i], s = cs[16 + i]; f[i] = (l8 == 0) ? f[i] * c - other * s : f[i] * c + other * s; } }
            att::u32x4 o0, o1;
#pragma unroll
            for (int j = 0; j < 4; ++j) { o0[j] = pg8::cvt_pk_bf16(f[2 * j], f[2 * j + 1]); o1[j] = pg8::cvt_pk_bf16(f[8 + 2 * j], f[8 + 2 * j + 1]); }
            p[0] = o0; p[1] = o1;
        }
        {
#pragma unroll
            for (int part = 0; part < 2; ++part) {
                if (part == 1 && lane >= 8) break;
                att::u32x4* p = (att::u32x4*)(pr + (part == 0 ? C_IQ + lane * 8 : C_IK + lane * 8));
                const att::u32x4 v0 = p[0]; float f[8];
#pragma unroll
                for (int j = 0; j < 4; ++j) { f[2 * j] = __uint_as_float(v0[j] << 16); f[2 * j + 1] = __uint_as_float(v0[j] & 0xffff0000u); }
                const float* cs = R64 + pos * 16;
#pragma unroll
                for (int i = 0; i < 8; ++i) { const float other = dpp_xor1(f[i]);
                    if (l8 < 2) { const float c = cs[i], s = cs[8 + i]; f[i] = (l8 == 0) ? f[i] * c - other * s : f[i] * c + other * s; } }
                att::u32x4 o0;
#pragma unroll
                for (int j = 0; j < 4; ++j) o0[j] = pg8::cvt_pk_bf16(f[2 * j], f[2 * j + 1]);
                p[0] = o0;
            }
        }
    }
}
#ifndef MK_PER_PHASE
#define MK_PER_PHASE 0
#endif
constexpr int NPH = 14;
struct Args { const float* in[16]; float* out; unsigned char* ws; int ph_lo, ph_hi; };
__global__ void __launch_bounds__(NTHR, 2) mk_fwd(Args args) {
    extern __shared__ __attribute__((aligned(16))) unsigned char lds[];
    Frame F;
    F.lds = (LAS unsigned char*)lds;
    F.MISC = (volatile LAS unsigned*)(F.lds + MISC_OFF);
    F.wave = __builtin_amdgcn_readfirstlane((int)threadIdx.x >> 6);
#define RELANE() (F.lane = lane_id_opaque(), F.tid = F.wave * 64 + F.lane, true)
    RELANE();
#ifdef PROBE_ACC
    F.acc_t0 = 0ull; F.acc_sum = 0ull;
#endif
    F.G = gridDim.x; { const int bx = blockIdx.x; F.vcu = (F.G % 8 == 0) ? (bx % 8) * (F.G / 8) + bx / 8 : bx; }
    unsigned char* ws = args.ws;
    F.ctl = (gu32*)(ws + WS_CTL);
    F.x = args.in[0]; F.g_mix = args.in[1]; F.g_ffn = args.in[2]; F.w_in_ab = args.in[3]; F.gq_a = args.in[4]; F.gk_a = args.in[5]; F.w_gate_up = args.in[6]; F.b_gate = args.in[7];
    F.g_gla = args.in[8]; F.w_out_ab = args.in[9]; F.w_in_c = args.in[10]; F.gq_c = args.in[11]; F.gk_c = args.in[12]; F.w_out_c = args.in[13]; F.w_up = args.in[14]; F.w_down = args.in[15];
    F.out = args.out;
    F.Wab = (bf16*)(ws + WS_WAB); F.Woab = (bf16*)(ws + WS_WOAB); F.Wup0 = (bf16*)(ws + WS_WUP0); F.Wdn0 = (bf16*)(ws + WS_WDN0);
    F.Winc = (bf16*)(ws + WS_WINC); F.Woc = (bf16*)(ws + WS_WOC); F.Wup1 = (bf16*)(ws + WS_WUP1); F.Wdn1 = (bf16*)(ws + WS_WDN1);
    F.XB = (bf16*)(ws + WS_XB); F.CAT = (bf16*)(ws + WS_CAT); F.R1 = (bf16*)(ws + WS_R1); F.SSQ = (float*)(ws + WS_SSQ); F.MASK = (unsigned*)(ws + WS_MASK);
    for (int u = F.tid; u < (LDS_BYTES - MISC_OFF) / 4; u += NTHR) ((LAS unsigned*)(F.lds + MISC_OFF))[u] = 0u;
    __syncthreads();
    XcdBarrier bar; bar.bar = (unsigned*)(F.ctl + CW_BAR); bar.x = 0; bar.st = nullptr; bar.wave = F.wave;
    if (!MK_PER_PHASE) bar = xcd_barrier_post((unsigned*)(F.ctl + CW_BAR), F.MISC + 8, F.wave);
    const int lo = args.ph_lo, hi = args.ph_hi;
#ifdef PROBE_PH
    unsigned long long pt0 = 0ull, pt1 = 0ull;
#define STAMP(k) do { if ((k) == PROBE_PH) pt0 = __builtin_amdgcn_s_memrealtime(); if ((k) == PROBE_PH + 1) pt1 = __builtin_amdgcn_s_memrealtime(); } while (0)
#ifdef PROBE_SUB
#define SUBSTAMP(k) do { if ((k) == PROBE_PH) { __syncthreads(); pt0 = __builtin_amdgcn_s_memrealtime(); } } while (0)
#else
#define SUBSTAMP(k) do { } while (0)
#endif
#else
#define STAMP(k) do { } while (0)
#define SUBSTAMP(k) do { } while (0)
#endif
#define IN(k) (lo <= (k) && (k) < hi && RELANE())
#define SEAM(k) do { if (lo <= (k) && (k) + 1 < hi) xcd_barrier(bar); } while (0)
    float* const SSQ0 = F.SSQ, *SSQ1 = F.SSQ + (size_t)M * 16, *SSQ2 = F.SSQ + (size_t)2 * M * 16, *SSQ3 = F.SSQ + (size_t)3 * M * 16;
    typedef pg8::StaticOrder SO;
    STAMP(0); float* const R128 = (float*)(ws + WS_ROPE); float* const R64 = R128 + SEQ * 32;
    if (IN(0)) { ph_prologue(F); ph_rope_tables(F, R128, R64); } SEAM(0);
    STAMP(1); if (IN(1)) { pg8::Gemm g{F.XB, F.Wab, M, NAB, D}; SO S; S.init(M, NAB, F.G, (int)blockIdx.x); pg8::EpiScale<0> E{F.R1, NAB, SSQ0};
        pg8::gemm_phase<pg8::EpiScale<0>, SO, true, true>(F.lds, g, S, E, F.wave); } SEAM(1);
    float* const GU = (float*)(ws + WS_XB); float* const DEC = (float*)(ws + WS_DEC);
    STAMP(2); if (IN(2)) { ph_prep_a_fast(F, R128, R64); SUBSTAMP(2); gla::pass_a(F, GU, DEC); } SEAM(2);
    STAMP(3); if (IN(3)) { gla::pass_b(F, GU, DEC); SUBSTAMP(3); ph_indexer(F); } SEAM(3);
    STAMP(4); if (IN(4)) { ph_dsa(F); SUBSTAMP(4); gla::pass_c(F, GU); } SEAM(4);
    STAMP(5); if (IN(5)) { pg8::Gemm g{F.CAT, F.Woab, M, D, D}; SO S; S.init(M, D, F.G, (int)blockIdx.x); pg8::EpiResid<0, 0> E{F.x, nullptr, F.XB, SSQ1};
        pg8::gemm_phase<pg8::EpiResid<0, 0>, SO, true, true>(F.lds, g, S, E, F.wave); } SEAM(5);
    STAMP(6); if (IN(6)) { pg8::Gemm g{F.XB, F.Wup0, M, FF, D}; SO S; S.init(M, FF, F.G, (int)blockIdx.x); pg8::EpiScale<1> E{F.R1, FF, SSQ1};
        pg8::gemm_phase<pg8::EpiScale<1>, SO, true, true>(F.lds, g, S, E, F.wave); } SEAM(6);
    STAMP(7); if (IN(7)) { pg8::Gemm g{F.R1, F.Wdn0, M, D, FF}; SO S; S.init(M, D, F.G, (int)blockIdx.x); pg8::EpiResid<1, 0> E{F.XB, nullptr, F.XB, SSQ2};
        pg8::gemm_phase<pg8::EpiResid<1, 0>, SO, true, true>(F.lds, g, S, E, F.wave); } SEAM(7);
    STAMP(8); if (IN(8)) { pg8::Gemm g{F.XB, F.Winc, M, NC, D}; SO S; S.init(M, NC, F.G, (int)blockIdx.x); pg8::EpiScale<0> E{F.R1, NC, SSQ2};
        pg8::gemm_phase<pg8::EpiScale<0>, SO, true, true>(F.lds, g, S, E, F.wave); } SEAM(8);
    STAMP(9); if (IN(9)) { ph_prep_c_fast(F); } SEAM(9);
    STAMP(10); if (IN(10)) { ph_sb(F); } SEAM(10);
    STAMP(11); if (IN(11)) { pg8::Gemm g{F.CAT, F.Woc, M, D, D}; SO S; S.init(M, D, F.G, (int)blockIdx.x); pg8::EpiResid<1, 0> E{F.XB, nullptr, F.XB, SSQ3};
        pg8::gemm_phase<pg8::EpiResid<1, 0>, SO, true, true>(F.lds, g, S, E, F.wave); } SEAM(11);
    STAMP(12); if (IN(12)) { pg8::Gemm g{F.XB, F.Wup1, M, FF, D}; SO S; S.init(M, FF, F.G, (int)blockIdx.x); pg8::EpiScale<1> E{F.R1, FF, SSQ3};
        pg8::gemm_phase<pg8::EpiScale<1>, SO, true, true>(F.lds, g, S, E, F.wave); } SEAM(12);
    STAMP(13); if (IN(13)) { pg8::Gemm g{F.R1, F.Wdn1, M, D, FF}; SO S; S.init(M, D, F.G, (int)blockIdx.x); pg8::EpiResid<1, 1> E{F.XB, F.out, nullptr, nullptr};
        pg8::gemm_phase<pg8::EpiResid<1, 1>, SO, true, true>(F.lds, g, S, E, F.wave); }
    STAMP(NPH);
#ifdef PROBE_ACC
    if (blockIdx.x == 0) { const unsigned long long t1 = __builtin_amdgcn_s_memrealtime(), dt = F.acc_sum * PROBE_MULT; while (__builtin_amdgcn_s_memrealtime() - t1 < dt) __builtin_amdgcn_s_sleep(8); }
#endif
#ifdef PROBE_PH
    if (blockIdx.x == 0) { const unsigned long long t1 = __builtin_amdgcn_s_memrealtime(), dt = (pt1 - pt0) * PROBE_MULT; while (__builtin_amdgcn_s_memrealtime() - t1 < dt) __builtin_amdgcn_s_sleep(8); }
#endif
#undef IN
#undef SEAM
}

extern "C" void kernel_launch(void* const* d_in, const int* in_sizes, int n_in, void* d_out, int out_size, void* d_ws, size_t ws_size, hipStream_t stream) {
    static int grid = 0;
    if (grid == 0) {
        if (n_in != 16 || in_sizes[0] != M * D || out_size != M * D || ws_size < WS_END) { fprintf(stderr, "kernel_launch: unexpected shapes / workspace (%d inputs, ws %zu)\n", n_in, ws_size); grid = -1; return; }
        int dev = 0, cus = 0;
        if (hipGetDevice(&dev) != hipSuccess || hipDeviceGetAttribute(&cus, hipDeviceAttributeMultiprocessorCount, dev) != hipSuccess) { grid = -1; return; }
        if (hipFuncSetAttribute((const void*)mk_fwd, hipFuncAttributeMaxDynamicSharedMemorySize, LDS_BYTES) != hipSuccess) { fprintf(stderr, "kernel_launch: hipFuncSetAttribute failed\n"); grid = -1; return; }
        (void)hipGetLastError();
        grid = cus;
    }
    if (grid < 0) return;
    if (hipMemsetAsync((char*)d_ws + WS_CTL, 0, CTL_ZERO_BYTES, stream) != hipSuccess) { fprintf(stderr, "kernel_launch: memset failed\n"); return; }
    Args a{};
    for (int i = 0; i < 16; ++i) a.in[i] = (const float*)d_in[i];
    a.out = (float*)d_out; a.ws = (unsigned char*)d_ws;
#if MK_PER_PHASE
    for (int ph = 0; ph < NPH; ++ph) { a.ph_lo = ph; a.ph_hi = ph + 1; hipLaunchKernelGGL(mk_fwd, dim3(grid), dim3(NTHR), LDS_BYTES, stream, a); }
#else
    a.ph_lo = 0; a.ph_hi = NPH;
    hipLaunchKernelGGL(mk_fwd, dim3(grid), dim3(NTHR), LDS_BYTES, stream, a);
#endif
    const hipError_t le = hipPeekAtLastError();
    if (le != hipSuccess) fprintf(stderr, "kernel_launch: launch failed: %s\n", hipGetErrorName(le));
}
```

```cpp
#include <hip/hip_runtime.h>
#include <cstdio>
#include <cstdint>
namespace pg8 {
#define PG8_LAS __attribute__((address_space(3)))
typedef unsigned short bf16_t;
typedef short bf16x8 __attribute__((ext_vector_type(8)));
typedef float f32x4 __attribute__((ext_vector_type(4)));
typedef unsigned u32x4 __attribute__((ext_vector_type(4)));
constexpr int BM = 256, BK = 64, HALF = 128, HTB = HALF * BK * 2  , STAGE_BYTES = 8 * HTB, NXCD = 8, WGM = 8;

__host__ __device__ __forceinline__ int lds_byte(int r, int c) { const int st = (r >> 4) * 2 + (c >> 5), rr = r & 15, cc = c & 31, ob = rr * 64 + cc * 2; return st * 1024 + (ob ^ (((ob >> 9) & 1) << 5)); }
__host__ __device__ __forceinline__ void stage_rc(int b, int& R, int& C) { const int st = b / 1024, sb = b % 1024, swz = sb ^ (((sb >> 9) & 1) << 5); R = (st >> 1) * 16 + swz / 64; C = (st & 1) * 32 + (swz % 64) / 2; }
__host__ __device__ __forceinline__ int perm32(int rho) { const int n = rho >> 4, i = rho & 15; return 8 * (i >> 2) + 4 * n + (i & 3); }

struct Unit { int pm, pn; };
struct Gemm { const bf16_t* A; const bf16_t* Bt; int M, N, K; };

struct StaticOrder {
    int nM, nN, nwg, G, c;
    __host__ __device__ void init(int M, int N, int G_, int c_) { nM = M / BM; nN = N / BM; nwg = nM * nN; G = G_; c = c_; }
    __host__ __device__ bool next(int i, Unit& u) const {
        const long L = (long)i * G + c; if (L >= nwg) return false;
        int wgid = (int)L; { const int q = nwg / NXCD, r = nwg % NXCD, xcd = wgid % NXCD, off = wgid / NXCD; wgid = (xcd < r ? xcd * (q + 1) : r * (q + 1) + (xcd - r) * q) + off; }
        const int nig = WGM * nN, gid = wgid / nig, fm = gid * WGM, gsz = (nM - fm) < WGM ? (nM - fm) : WGM;
        u.pm = fm + ((wgid % nig) % gsz); u.pn = (wgid % nig) / gsz; return true;
    }
    __device__ __forceinline__ void a_ready(const Unit&) const {}
    __device__ __forceinline__ void done(const Unit&) const {}
};

__device__ __forceinline__ unsigned cvt_pk_bf16(float lo, float hi) { unsigned r; asm volatile("v_cvt_pk_bf16_f32 %0, %1, %2" : "=v"(r) : "v"(lo), "v"(hi)); return r; }
__device__ __forceinline__ float row_rstd(const float* ssqp, int row) {
    const f32x4* p = (const f32x4*)(ssqp + (size_t)row * 16);
    const f32x4 a = p[0], b = p[1], c = p[2], d = p[3];
    const float s = (((a[0] + a[1]) + (a[2] + a[3])) + ((b[0] + b[1]) + (b[2] + b[3]))) + (((c[0] + c[1]) + (c[2] + c[3])) + ((d[0] + d[1]) + (d[2] + d[3])));
    return rsqrtf(s * (1.0f / 1024.0f) + 1e-6f);
}
template <int ACT  > struct EpiScale {
    static constexpr bool PERM = true, AFTER_DRAIN = false;
    bf16_t* O; int ldc; const float* ssqp;
    __device__ __forceinline__ void operator()(const f32x4 (&acc)[2][2][4][2], const Unit& u, int wr, int wc, int fr, int fq) const {
        const int row0 = u.pm * BM + wr * 64 + fr, col0 = u.pn * BM + wc * 32 + 8 * fq;
#pragma unroll
        for (int ai = 0; ai < 2; ++ai)
#pragma unroll
            for (int m = 0; m < 4; ++m) {
                const int row = row0 + ai * HALF + m * 16;
                const float rs = row_rstd(ssqp, row);
                bf16_t* rowp = O + (size_t)row * ldc + col0;
#pragma unroll
                for (int bj = 0; bj < 2; ++bj) {
                    f32x4 v0 = acc[ai][bj][m][0] * rs, v1 = acc[ai][bj][m][1] * rs;
                    if (ACT == 1) {
#pragma unroll
                        for (int e = 0; e < 4; ++e) { const float a0 = fmaxf(v0[e], 0.f), a1 = fmaxf(v1[e], 0.f); v0[e] = a0 * a0; v1[e] = a1 * a1; }
                    }
                    u32x4 w; w.x = cvt_pk_bf16(v0[0], v0[1]); w.y = cvt_pk_bf16(v0[2], v0[3]); w.z = cvt_pk_bf16(v1[0], v1[1]); w.w = cvt_pk_bf16(v1[2], v1[3]);
                    *(u32x4*)(rowp + bj * HALF) = w;
                }
            }
    }
};
template <int RIN, int OUT> struct EpiResid {
    static constexpr bool PERM = true, AFTER_DRAIN = false;
    const void* R; float* out; bf16_t* hb; float* ssqp;
    __device__ __forceinline__ void operator()(const f32x4 (&acc)[2][2][4][2], const Unit& u, int wr, int wc, int fr, int fq) const {
        const int row0 = u.pm * BM + wr * 64 + fr, col0 = u.pn * BM + wc * 32 + 8 * fq;
#pragma unroll
        for (int ai = 0; ai < 2; ++ai)
#pragma unroll
            for (int m = 0; m < 4; ++m) {
                const int row = row0 + ai * HALF + m * 16;
                const size_t off = (size_t)row * 1024 + col0;
                float ss = 0.f;
#pragma unroll
                for (int bj = 0; bj < 2; ++bj) {
                    f32x4 r0, r1;
                    if (RIN == 0) { r0 = *(const f32x4*)((const float*)R + off + bj * HALF); r1 = *(const f32x4*)((const float*)R + off + bj * HALF + 4); }
                    else { const u32x4 rw = *(const u32x4*)((const bf16_t*)R + off + bj * HALF);
                        r0 = (f32x4){__uint_as_float(rw.x << 16), __uint_as_float(rw.x & 0xffff0000u), __uint_as_float(rw.y << 16), __uint_as_float(rw.y & 0xffff0000u)};
                        r1 = (f32x4){__uint_as_float(rw.z << 16), __uint_as_float(rw.z & 0xffff0000u), __uint_as_float(rw.w << 16), __uint_as_float(rw.w & 0xffff0000u)}; }
                    const f32x4 v0 = acc[ai][bj][m][0] + r0, v1 = acc[ai][bj][m][1] + r1;
                    if (OUT == 1) { *(f32x4*)(out + off + bj * HALF) = v0; *(f32x4*)(out + off + bj * HALF + 4) = v1; }
                    else {
                        u32x4 w; w.x = cvt_pk_bf16(v0[0], v0[1]); w.y = cvt_pk_bf16(v0[2], v0[3]); w.z = cvt_pk_bf16(v1[0], v1[1]); w.w = cvt_pk_bf16(v1[2], v1[3]);
                        *(u32x4*)(hb + off + bj * HALF) = w;
                        ss += ((v0[0] * v0[0] + v0[1] * v0[1]) + (v0[2] * v0[2] + v0[3] * v0[3])) + ((v1[0] * v1[0] + v1[1] * v1[1]) + (v1[2] * v1[2] + v1[3] * v1[3]));
                    }
                }
                if (OUT == 0) { ss += __shfl_xor(ss, 16); ss += __shfl_xor(ss, 32); if (fq == 0) ssqp[(size_t)row * 16 + u.pn * 4 + wc] = ss; }
            }
    }
};
template <class Epi, class Sched, bool ALIGN_EPI = false, bool SP2 = false>
__device__ __forceinline__ void gemm_phase(PG8_LAS unsigned char* lds, const Gemm g, const Sched& S, const Epi& E, const int wave_in) {
    const int wid = wave_in, lane = (int)__builtin_amdgcn_mbcnt_hi(~0u, __builtin_amdgcn_mbcnt_lo(~0u, 0u)), tid = wid * 64 + lane, wr = wid >> 2, wc = wid & 3, fr = lane & 15, fq = lane >> 4;
    const int K = g.K, nt = K / BK;
    unsigned voffA[2], voffB[2];
#pragma unroll
    for (int i = 0; i < 2; ++i) { int R, C; stage_rc(tid * 16 + i * 8192, R, C); const int Rb = Epi::PERM ? ((R & ~31) + perm32(R & 31)) : R;
        voffA[i] = (unsigned)(R * K + C) * 2u; voffB[i] = (unsigned)(Rb * K + C) * 2u; }
    const size_t kstep = (size_t)(BK * 2);
    const size_t hstep = (size_t)HALF * K * 2;
    const size_t tstep = 2 * hstep;
    const unsigned ldsw = (unsigned)wid * 1024u;
    const int aoff = lds_byte(wr * 64 + fr, fq * 8), boff = lds_byte(wc * 32 + fr, fq * 8);
#define PG8_SA(b, h) (((b) * 2 + (h)) * HTB)
#define PG8_SB(b, h) ((4 + (b) * 2 + (h)) * HTB)
#define PG8_STAGE(bufoff, gbase, voff) do { _Pragma("unroll") for (int _i = 0; _i < 2; ++_i) \
        __builtin_amdgcn_global_load_lds((const unsigned*)((const char*)(gbase) + (voff)[_i]), (PG8_LAS unsigned*)(lds + (bufoff) + ldsw + _i * 8192), 16, 0, 0); } while (0)
#define PG8_LDA(dst, b, h) do { _Pragma("unroll") for (int m = 0; m < 4; ++m) _Pragma("unroll") for (int k = 0; k < 2; ++k) dst[m][k] = *(const PG8_LAS bf16x8*)(lds + PG8_SA(b, h) + aoff + m * 2048 + k * 1024); } while (0)
#define PG8_LDB(dst, b, h) do { _Pragma("unroll") for (int n = 0; n < 2; ++n) _Pragma("unroll") for (int k = 0; k < 2; ++k) dst[n][k] = *(const PG8_LAS bf16x8*)(lds + PG8_SB(b, h) + boff + n * 2048 + k * 1024); } while (0)
#define PG8_MMA(ai, bj, At, Bt) do { __builtin_amdgcn_s_setprio(1); _Pragma("unroll") for (int m = 0; m < 4; ++m) _Pragma("unroll") for (int n = 0; n < 2; ++n) _Pragma("unroll") for (int k = 0; k < 2; ++k) \
        acc[ai][bj][m][n] = __builtin_amdgcn_mfma_f32_16x16x32_bf16(Bt[n][k], At[m][k], acc[ai][bj][m][n], 0, 0, 0); __builtin_amdgcn_s_setprio(0); } while (0)
#define PG8_WAIT_V(n) asm volatile("s_waitcnt vmcnt(" #n ")" ::: "memory")
#define PG8_WAIT_L(n) asm volatile("s_waitcnt lgkmcnt(" #n ")" ::: "memory")
#define PG8_BAR __builtin_amdgcn_s_barrier()
#define PG8_SCHED __builtin_amdgcn_sched_barrier(0)
    Unit cur, nxt; int ui = 0;
    if (!S.next(0, cur)) return;
    f32x4 acc[2][2][4][2];
#pragma unroll
    for (int a = 0; a < 2; ++a)
#pragma unroll
        for (int b = 0; b < 2; ++b)
#pragma unroll
            for (int m = 0; m < 4; ++m)
#pragma unroll
                for (int n = 0; n < 2; ++n) acc[a][b][m][n] = (f32x4){0.f, 0.f, 0.f, 0.f};
    bf16x8 At[4][2], B0[2][2], B1[2][2];
    const char* cA = (const char*)g.A + (size_t)cur.pm * tstep; const char* cB = (const char*)g.Bt + (size_t)cur.pn * tstep;
    S.a_ready(cur);
    if constexpr (SP2) {
        PG8_STAGE(PG8_SB(0, 0), cB, voffB); PG8_STAGE(PG8_SB(0, 1), cB + hstep, voffB); PG8_STAGE(PG8_SA(0, 0), cA, voffA); PG8_STAGE(PG8_SA(0, 1), cA + hstep, voffA);
        if (wr == 1) PG8_BAR;
        PG8_WAIT_V(2); PG8_BAR;
        PG8_STAGE(PG8_SB(1, 0), cB + kstep, voffB); PG8_STAGE(PG8_SA(1, 0), cA + kstep, voffA); PG8_STAGE(PG8_SB(1, 1), cB + hstep + kstep, voffB);
        PG8_WAIT_V(6); PG8_BAR;
    } else {
        PG8_STAGE(PG8_SB(0, 0), cB, voffB); PG8_STAGE(PG8_SA(0, 0), cA, voffA); PG8_STAGE(PG8_SB(0, 1), cB + hstep, voffB); PG8_STAGE(PG8_SA(0, 1), cA + hstep, voffA);
        if (wr == 1) PG8_BAR;
        PG8_WAIT_V(4); PG8_BAR;
        PG8_STAGE(PG8_SB(1, 0), cB + kstep, voffB); PG8_STAGE(PG8_SA(1, 0), cA + kstep, voffA); PG8_STAGE(PG8_SB(1, 1), cB + hstep + kstep, voffB);
        PG8_WAIT_V(6); PG8_BAR;
    }
    for (;;) {
        const bool has_next = S.next(ui + 1, nxt);
        const char* nA = has_next ? (const char*)g.A + (size_t)nxt.pm * tstep : cA; const char* nB = has_next ? (const char*)g.Bt + (size_t)nxt.pn * tstep : cB;
        for (int t = 0; t < nt; t += 2) {
            const bool last = (t == nt - 2);
            const char* a1 = cA + (size_t)(t + 1) * kstep;
            const char* a2 = last ? nA : cA + (size_t)(t + 2) * kstep; const char* b2 = last ? nB : cB + (size_t)(t + 2) * kstep;
            const char* a3 = a2 + kstep; const char* b3 = b2 + kstep;
            if (last && has_next) S.a_ready(nxt);
            if constexpr (SP2) {
            PG8_LDB(B0, 0, 0); PG8_LDB(B1, 0, 1); PG8_SCHED; PG8_LDA(At, 0, 0); PG8_STAGE(PG8_SA(1, 1), a1 + hstep, voffA);
            PG8_WAIT_V(8); PG8_WAIT_L(0); PG8_BAR; PG8_MMA(0, 0, At, B0); PG8_MMA(0, 1, At, B1); PG8_BAR; PG8_SCHED;
            PG8_LDA(At, 0, 1); PG8_STAGE(PG8_SB(0, 0), b2, voffB); PG8_STAGE(PG8_SB(0, 1), b2 + hstep, voffB); PG8_STAGE(PG8_SA(0, 0), a2, voffA);
            PG8_WAIT_V(8); PG8_WAIT_L(0); PG8_BAR; PG8_MMA(1, 0, At, B0); PG8_MMA(1, 1, At, B1); PG8_BAR; PG8_SCHED;
            PG8_LDB(B0, 1, 0); PG8_LDB(B1, 1, 1); PG8_SCHED; PG8_LDA(At, 1, 0); PG8_STAGE(PG8_SA(0, 1), a2 + hstep, voffA);
            PG8_WAIT_V(8); PG8_WAIT_L(0); PG8_BAR; PG8_MMA(0, 0, At, B0); PG8_MMA(0, 1, At, B1); PG8_BAR; PG8_SCHED;
            PG8_LDA(At, 1, 1); PG8_STAGE(PG8_SB(1, 0), b3, voffB); PG8_STAGE(PG8_SB(1, 1), b3 + hstep, voffB); PG8_STAGE(PG8_SA(1, 0), a3, voffA);
            PG8_WAIT_V(8); PG8_WAIT_L(0); PG8_BAR; PG8_MMA(1, 0, At, B0); PG8_MMA(1, 1, At, B1); PG8_BAR; PG8_SCHED;
            } else {
            PG8_LDB(B0, 0, 0); PG8_SCHED; PG8_LDA(At, 0, 0); PG8_STAGE(PG8_SA(1, 1), a1 + hstep, voffA);
            PG8_WAIT_L(8); PG8_BAR; PG8_WAIT_L(0); PG8_MMA(0, 0, At, B0); PG8_BAR; PG8_SCHED;
            PG8_LDB(B1, 0, 1); PG8_STAGE(PG8_SB(0, 0), b2, voffB);
            PG8_BAR; PG8_WAIT_L(0); PG8_MMA(0, 1, At, B1); PG8_BAR;
            PG8_LDA(At, 0, 1); PG8_STAGE(PG8_SA(0, 0), a2, voffA);
            PG8_BAR; PG8_WAIT_L(0); PG8_MMA(1, 0, At, B0); PG8_BAR; PG8_SCHED;
            PG8_STAGE(PG8_SB(0, 1), b2 + hstep, voffB);
            PG8_WAIT_V(6); PG8_BAR; PG8_MMA(1, 1, At, B1); PG8_BAR;
            PG8_LDB(B0, 1, 0); PG8_SCHED; PG8_LDA(At, 1, 0); PG8_STAGE(PG8_SA(0, 1), a2 + hstep, voffA);
            PG8_WAIT_L(8); PG8_BAR; PG8_WAIT_L(0); PG8_MMA(0, 0, At, B0); PG8_BAR; PG8_SCHED;
            PG8_LDB(B1, 1, 1); PG8_STAGE(PG8_SB(1, 0), b3, voffB);
            PG8_BAR; PG8_WAIT_L(0); PG8_MMA(0, 1, At, B1); PG8_BAR;
            PG8_LDA(At, 1, 1); PG8_STAGE(PG8_SA(1, 0), a3, voffA);
            PG8_BAR; PG8_WAIT_L(0); PG8_MMA(1, 0, At, B0); PG8_BAR; PG8_SCHED;
            PG8_STAGE(PG8_SB(1, 1), b3 + hstep, voffB);
            PG8_WAIT_V(6); PG8_BAR; PG8_MMA(1, 1, At, B1); PG8_BAR;
            }
        }
        if constexpr (ALIGN_EPI) { if (wr == 0) PG8_BAR; }
        if constexpr (!Epi::AFTER_DRAIN) { E(acc, cur, wr, wc, fr, fq); S.done(cur); }
        if (!has_next) break;
#pragma unroll
        for (int a = 0; a < 2; ++a)
#pragma unroll
            for (int b = 0; b < 2; ++b)
#pragma unroll
                for (int m = 0; m < 4; ++m)
#pragma unroll
                    for (int n = 0; n < 2; ++n) acc[a][b][m][n] = (f32x4){0.f, 0.f, 0.f, 0.f};
        cur = nxt; cA = nA; cB = nB; ++ui;
        if constexpr (ALIGN_EPI) { if (wr == 1) PG8_BAR; }
    }
    PG8_WAIT_V(0);
    if constexpr (!ALIGN_EPI) { if (wr == 0) PG8_BAR; }
    PG8_BAR;
    if constexpr (Epi::AFTER_DRAIN) { E.fused(acc, cur, wr, wc, fr, fq, lds, wid, lane); S.done(cur); }
#undef PG8_SA
#undef PG8_SB
#undef PG8_STAGE
#undef PG8_LDA
#undef PG8_LDB
#undef PG8_MMA
#undef PG8_WAIT_V
#undef PG8_WAIT_L
#undef PG8_BAR
#undef PG8_SCHED
}
}
#include <cmath>
constexpr int NWAVES = 8, NTHR = 512;
constexpr int BATCH = 16, SEQ = 2048, M = BATCH * SEQ, D = 1024, FF = 4096, NAB = 3840, NC = 3072, ABP_OLD = 3672;
constexpr int C_QA = 0, C_KA = 512, C_VA = 1024, C_IQ = 1536, C_QB = 2048, C_KB = 2304, C_VB = 2560, C_OG = 3072, C_IK = 3584, C_IW = 3648, C_GL = 3656;
constexpr float EPS = 1e-6f;
constexpr size_t MiB = 1u << 20;
constexpr size_t WS_CTL = 0, CTL_ZERO_BYTES = 1 * MiB;
constexpr size_t WS_WAB = 1 * MiB, WS_WOAB = 9 * MiB, WS_WUP0 = 11 * MiB, WS_WDN0 = 19 * MiB, WS_WINC = 27 * MiB, WS_WOC = 33 * MiB, WS_WUP1 = 35 * MiB, WS_WDN1 = 43 * MiB;
constexpr size_t WS_SSQ = 51 * MiB, SSQ_BYTES = 2 * MiB;
constexpr size_t WS_DEC = 59 * MiB;
constexpr size_t WS_ROPE = 59 * MiB + 512 * 1024;
constexpr size_t WS_XB = 60 * MiB;
constexpr size_t WS_CAT = 124 * MiB;
constexpr size_t WS_MASK = 188 * MiB;
constexpr size_t WS_R1 = 196 * MiB;
constexpr size_t WS_END = 452 * MiB;
constexpr int CW_BAR = 4096;
constexpr int RING_BYTES = 131072;
constexpr int LDS_BYTES = 163840;
constexpr int MISC_OFF = LDS_BYTES - 256;
#define GAS __attribute__((address_space(1)))
#define LAS __attribute__((address_space(3)))
typedef unsigned short bf16;
typedef unsigned v4u __attribute__((ext_vector_type(4)));
typedef float f32x4 __attribute__((ext_vector_type(4)));
typedef short bf16x8 __attribute__((ext_vector_type(8)));
typedef GAS unsigned gu32;
typedef GAS unsigned long long gu64;
#define RLX_AGENT __ATOMIC_RELAXED, __HIP_MEMORY_SCOPE_AGENT
#define LDS_WAIT() asm volatile("s_waitcnt lgkmcnt(0)" ::: "memory")
#define VM_WAIT() asm volatile("s_waitcnt vmcnt(0)" ::: "memory")
__device__ __forceinline__ unsigned long long rt() { return __builtin_amdgcn_s_memrealtime(); }
__device__ __forceinline__ unsigned f2bf(float f) { unsigned u = __builtin_bit_cast(unsigned, f); return (u + 0x7fffu + ((u >> 16) & 1u)) >> 16; }
__device__ __forceinline__ unsigned pk2(float lo, float hi) { return f2bf(lo) | (f2bf(hi) << 16); }
#define XB_TMO      128
#define XB_XCNT(j)  (256  + 64 * (j))
#define XB_XSUB(j)  (1280 + 64 * (j))
#define XB_XGEN(j)  (2304 + 64 * (j))
#define XB_TOP      3328
#define XB_TOPGEN   3392
#define XCD_BAR_WORDS 3456
#define XB_SPIN_CAP (1u << 18)

__device__ __forceinline__ unsigned xb_ld(unsigned* p)              { return __hip_atomic_load(p, __ATOMIC_RELAXED, __HIP_MEMORY_SCOPE_AGENT); }
__device__ __forceinline__ unsigned xb_add(unsigned* p, unsigned v) { return __hip_atomic_fetch_add(p, v, __ATOMIC_RELAXED, __HIP_MEMORY_SCOPE_AGENT); }
__device__ __forceinline__ unsigned xb_xcc_id() { return (unsigned)__builtin_amdgcn_s_getreg((3 << 11) | 20) & 0xFu; }
#define XB_SPIN(cond, bar) do { unsigned _sp = 0; while (cond) { __builtin_amdgcn_s_sleep(1); \
    if ((++_sp & 255u) == 0u) { if (xb_ld(&(bar)[XB_TMO])) break; if (_sp > XB_SPIN_CAP) { atomicAdd(&(bar)[XB_TMO], 1u); break; } } } } while (0)

struct XcdBarrier {
    unsigned* bar; unsigned x; int wave;
    volatile LAS unsigned* st;
};

__device__ __forceinline__ bool xb_t0(int wave) { return wave == 0 && __builtin_amdgcn_mbcnt_hi(~0u, __builtin_amdgcn_mbcnt_lo(~0u, 0u)) == 0u; }
__device__ __forceinline__ XcdBarrier xcd_barrier_post(unsigned* bar, volatile LAS unsigned* st, int wave) {
    XcdBarrier b; b.bar = bar; b.x = xb_xcc_id(); b.st = st; b.wave = wave;
    if (xb_t0(wave)) (void)xb_add(&bar[XB_XCNT(b.x)], 1u);
    return b;
}
__device__ __forceinline__ void xcd_barrier_complete(unsigned* bar, unsigned x, unsigned& nloc, unsigned& nx) {
    const unsigned G = gridDim.x * gridDim.y * gridDim.z;
    unsigned sum, cnt, mine, sp = 0u;
    for (;;) {
        sum = 0u; cnt = 0u; mine = 0u;
#pragma unroll
        for (unsigned j = 0; j < 16; ++j) { const unsigned c = xb_ld(&bar[XB_XCNT(j)]); sum += c; cnt += (c > 0u) ? 1u : 0u; mine = (j == x) ? c : mine; }
        if (sum == G) break;
        __builtin_amdgcn_s_sleep(1);
        if ((++sp & 255u) == 0u) { if (xb_ld(&bar[XB_TMO])) break; if (sp > XB_SPIN_CAP) { atomicAdd(&bar[XB_TMO], 1u); break; } }
    }
    nloc = mine > 0u ? mine : 1u; nx = cnt > 0u ? cnt : 1u;
}

__device__ __forceinline__ void xcd_barrier(const XcdBarrier& b) {
    asm volatile("s_waitcnt vmcnt(0)" ::: "memory");
    __syncthreads();
    if (xb_t0(b.wave)) {
        unsigned* bar = b.bar;
        __builtin_amdgcn_s_waitcnt(0);
        unsigned nloc = b.st[0], nx = b.st[1];
        if (nloc == 0u) { xcd_barrier_complete(bar, b.x, nloc, nx); b.st[0] = nloc; b.st[1] = nx; }
        const unsigned old = xb_add(&bar[XB_XSUB(b.x)], 1u);
        const unsigned gen = old / nloc;
        if (old + 1u == (gen + 1u) * nloc) {
            __builtin_amdgcn_fence(__ATOMIC_RELEASE, "agent");
            asm volatile("s_waitcnt vmcnt(0)" ::: "memory");
            const unsigned og = xb_add(&bar[XB_TOP], 1u);
            const unsigned tg = og / nx;
            if (og + 1u == (tg + 1u) * nx) xb_add(&bar[XB_TOPGEN], 1u);
            else XB_SPIN(xb_ld(&bar[XB_TOPGEN]) == tg, bar);
            __builtin_amdgcn_fence(__ATOMIC_ACQUIRE, "agent");
            xb_add(&bar[XB_XGEN(b.x)], 1u);
            asm volatile("s_waitcnt vmcnt(0)" ::: "memory");
        } else {
            XB_SPIN(xb_ld(&bar[XB_XGEN(b.x)]) == gen, bar);
            __builtin_amdgcn_fence(__ATOMIC_ACQUIRE, "agent");
            asm volatile("s_waitcnt vmcnt(0)" ::: "memory");
        }
    }
    __syncthreads();
}
#ifdef PROBE_ACC
#define ACC_BEGIN(F, id) do { if ((id) == PROBE_ACC) { __syncthreads(); (F).acc_t0 = __builtin_amdgcn_s_memrealtime(); } } while (0)
#define ACC_END(F, id) do { if ((id) == PROBE_ACC) { __syncthreads(); (F).acc_sum += __builtin_amdgcn_s_memrealtime() - (F).acc_t0; } } while (0)
#else
#define ACC_BEGIN(F, id) do { } while (0)
#define ACC_END(F, id) do { } while (0)
#endif
struct Frame {
#ifdef PROBE_ACC
    unsigned long long acc_t0, acc_sum;
#endif
    LAS unsigned char* lds;
    volatile LAS unsigned* MISC;
    gu32* ctl;
    int tid, lane, wave, vcu, G;
    const float *x, *g_mix, *g_ffn, *w_in_ab, *gq_a, *gk_a, *w_gate_up, *b_gate, *g_gla, *w_out_ab, *w_in_c, *gq_c, *gk_c, *w_out_c, *w_up, *w_down;
    float* out;
    bf16 *Wab, *Woab, *Wup0, *Wdn0, *Winc, *Woc, *Wup1, *Wdn1;
    bf16 *XB, *CAT, *R1;
    float* SSQ; unsigned* MASK;
};
__device__ __forceinline__ int lane_id_opaque() { int l; asm volatile("v_mbcnt_lo_u32_b32 %0, -1, 0\n\tv_mbcnt_hi_u32_b32 %0, -1, %0" : "=v"(l)); return l; }
__device__ __forceinline__ float bf2f(bf16 v) { return __builtin_bit_cast(float, (unsigned)v << 16); }
__device__ __forceinline__ float wave_sum(float v) {
#pragma unroll
    for (int o = 1; o < 64; o <<= 1) v += __shfl_xor(v, o);
    return v;
}
__device__ __forceinline__ float wave_max(float v) {
#pragma unroll
    for (int o = 1; o < 64; o <<= 1) v = fmaxf(v, __shfl_xor(v, o));
    return v;
}
__device__ __forceinline__ float log_sigmoid(float x) { return fminf(x, 0.f) - log1pf(expf(-fabsf(x))); }

__device__ __forceinline__ int oldcol_ab(int n) {
    if (n < 2048) return n;
    if (n < 2304) return 2120 + (n - 2048);
    if (n < 2560) return 2376 + (n - 2304);
    if (n < 3072) return 2632 + (n - 2560);
    if (n < 3584) return 3160 + (n - 3072);
    if (n < 3648) return 2048 + (n - 3584);
    if (n < 3656) return 2112 + (n - 3648);
    if (n < 3672) return 3144 + (n - 3656);
    return -1;
}
__device__ __forceinline__ void p0_transpose_item(const float* W, int ldw, int K, const float* gain, bf16* WT, bool map, int item, int nblk, int lane) {
    const int kb = item / nblk, nb = item % nblk, ng = lane & 7, ko = lane >> 3, k0 = 64 * kb + 8 * ko, n = 32 * nb + 4 * ng;
    const int oc = map ? oldcol_ab(n) : n;
    f32x4 v[8];
#pragma unroll
    for (int i = 0; i < 8; ++i) { v[i] = (f32x4){0.f, 0.f, 0.f, 0.f}; if (oc >= 0) v[i] = *(const GAS f32x4*)(W + (size_t)(k0 + i) * ldw + oc); }
    if (gain) { const f32x4 g0 = *(const GAS f32x4*)(gain + k0), g1 = *(const GAS f32x4*)(gain + k0 + 4);
#pragma unroll
        for (int i = 0; i < 4; ++i) { v[i] = v[i] * g0[i]; v[4 + i] = v[4 + i] * g1[i]; } }
#pragma unroll
    for (int e = 0; e < 4; ++e) { v4u o; o.x = pk2(v[0][e], v[1][e]); o.y = pk2(v[2][e], v[3][e]); o.z = pk2(v[4][e], v[5][e]); o.w = pk2(v[6][e], v[7][e]);
        *(GAS v4u*)(WT + (size_t)(n + e) * K + k0) = o; }
}
__device__ __forceinline__ void ph_prologue(Frame& F) {
    const int gw = F.vcu * NWAVES + F.wave, NGW = F.G * NWAVES;
    constexpr int I_AB = (D / 64) * (NAB / 32), I_O = (D / 64) * (D / 32), I_UP = (D / 64) * (FF / 32), I_DN = (FF / 64) * (D / 32), I_C = (D / 64) * (NC / 32);
    constexpr int NITEMS = I_AB + 2 * I_O + 2 * I_UP + 2 * I_DN + I_C;
    for (int it = gw; it < NITEMS; it += NGW) {
        int r = it;
        if (r < I_AB) { p0_transpose_item(F.w_in_ab, ABP_OLD, D, F.g_mix, F.Wab, true, r, NAB / 32, F.lane); continue; } r -= I_AB;
        if (r < I_O) { p0_transpose_item(F.w_out_ab, D, D, nullptr, F.Woab, false, r, D / 32, F.lane); continue; } r -= I_O;
        if (r < I_UP) { p0_transpose_item(F.w_up, FF, D, F.g_ffn, F.Wup0, false, r, FF / 32, F.lane); continue; } r -= I_UP;
        if (r < I_DN) { p0_transpose_item(F.w_down, D, FF, nullptr, F.Wdn0, false, r, D / 32, F.lane); continue; } r -= I_DN;
        if (r < I_C) { p0_transpose_item(F.w_in_c, NC, D, F.g_mix + D, F.Winc, false, r, NC / 32, F.lane); continue; } r -= I_C;
        if (r < I_O) { p0_transpose_item(F.w_out_c, D, D, nullptr, F.Woc, false, r, D / 32, F.lane); continue; } r -= I_O;
        if (r < I_UP) { p0_transpose_item(F.w_up + (size_t)D * FF, FF, D, F.g_ffn + D, F.Wup1, false, r, FF / 32, F.lane); continue; } r -= I_UP;
        p0_transpose_item(F.w_down + (size_t)FF * D, D, FF, nullptr, F.Wdn1, false, r, D / 32, F.lane);
    }
    for (int m = gw; m < M; m += NGW) {
        const GAS f32x4* xr = (const GAS f32x4*)(F.x + (size_t)m * D) + F.lane;
        f32x4 v[4]; float s = 0.f;
#pragma unroll
        for (int j = 0; j < 4; ++j) { v[j] = xr[64 * j]; s += (v[j].x * v[j].x + v[j].y * v[j].y) + (v[j].z * v[j].z + v[j].w * v[j].w); }
        s = wave_sum(s);
        GAS unsigned long long* o8 = (GAS unsigned long long*)(F.XB + (size_t)m * D) + F.lane;
#pragma unroll
        for (int j = 0; j < 4; ++j) o8[64 * j] = (unsigned long long)pk2(v[j].x, v[j].y) | ((unsigned long long)pk2(v[j].z, v[j].w) << 32);
        if (F.lane < 16) F.SSQ[(size_t)m * 16 + F.lane] = (F.lane == 0) ? s : 0.f;
    }
}
namespace att {
typedef short s16x4 __attribute__((ext_vector_type(4)));
typedef float f32x16 __attribute__((ext_vector_type(16)));
typedef _Float16 f16x8 __attribute__((ext_vector_type(8)));
typedef unsigned u32x4 __attribute__((ext_vector_type(4)));
typedef short v4i16_t __attribute__((ext_vector_type(4)));
constexpr float C2 = 0.08838834764831845f * 1.4426950408889634f;
__device__ __forceinline__ int crow(int r, int hi) { return (r & 3) + 8 * (r >> 2) + 4 * hi; }
__device__ __forceinline__ int img_off(int row, int ch) { return 256 * row + 16 * (ch ^ (((row & 3) << 2) | ((row >> 2) & 3))); }
__device__ __forceinline__ bf16x8 pack8(float a0, float a1, float a2, float a3, float a4, float a5, float a6, float a7) {
    u32x4 w; w.x = pg8::cvt_pk_bf16(a0, a1); w.y = pg8::cvt_pk_bf16(a2, a3); w.z = pg8::cvt_pk_bf16(a4, a5); w.w = pg8::cvt_pk_bf16(a6, a7);
    return __builtin_bit_cast(bf16x8, w);
}
__device__ __forceinline__ f16x8 pack8h(float a0, float a1, float a2, float a3, float a4, float a5, float a6, float a7) {
    f16x8 r; r[0] = (_Float16)a0; r[1] = (_Float16)a1; r[2] = (_Float16)a2; r[3] = (_Float16)a3; r[4] = (_Float16)a4; r[5] = (_Float16)a5; r[6] = (_Float16)a6; r[7] = (_Float16)a7; return r;
}
__device__ __forceinline__ void dma_off_init(unsigned (&dvo)[2], int ld, int wave, int lane) {
#pragma unroll
    for (int i = 0; i < 2; ++i) { const int pi = 2 * wave + i, row = 4 * pi + (lane >> 4), pc = lane & 15, ch = pc ^ (((row & 3) << 2) | ((row >> 2) & 3)); dvo[i] = (unsigned)(row * ld + ch * 8) * 2u; }
}
__device__ __forceinline__ void tile_dma(const bf16* g, const unsigned (&dvo)[2], LAS unsigned char* buf, int wave) {
#pragma unroll
    for (int i = 0; i < 2; ++i) __builtin_amdgcn_global_load_lds((const unsigned*)((const char*)g + dvo[i]), (LAS unsigned*)(buf + 1024 * (2 * wave + i)), 16, 0, 0);
}
struct FragOff { int k[8]; int va[4]; int vd; };
__device__ __forceinline__ void frag_off_init(FragOff& fo, int lane) {
    const int hi = lane >> 5, r32 = lane & 31, i = lane & 15, q = i >> 2, p = i & 3, x = 2 * ((lane >> 4) & 1) + (p >> 1);
#pragma unroll
    for (int ks = 0; ks < 8; ++ks) fo.k[ks] = img_off(r32, 2 * ks + hi);
#pragma unroll
    for (int ct = 0; ct < 4; ++ct) fo.va[ct] = img_off(4 * hi + q, 4 * ct + x) + 8 * (p & 1);
    fo.vd = img_off(4 * hi + q + 8, x) - img_off(4 * hi + q, x);
}
__device__ __forceinline__ bf16x8 k_frag(const LAS unsigned char* kbuf, const FragOff& fo, int rt, int ks) { return *(const LAS bf16x8*)(kbuf + fo.k[ks] + 8192 * rt); }
__device__ __forceinline__ s16x4 vtr(const LAS unsigned char* p) { return __builtin_bit_cast(s16x4, __builtin_amdgcn_ds_read_tr16_b64_v4i16((LAS v4i16_t*)p)); }
__device__ __forceinline__ bf16x8 v_frag(const LAS unsigned char* vbuf, const FragOff& fo, int ct, int kk) {
    const s16x4 lo = vtr(vbuf + fo.va[ct] + 4096 * kk), hh = vtr(vbuf + fo.va[ct] + fo.vd + 4096 * kk);
    return (bf16x8){lo[0], lo[1], lo[2], lo[3], hh[0], hh[1], hh[2], hh[3]};
}
#define TR_READ(dst, addr, OFF) asm volatile("ds_read_b64_tr_b16 %0, %1 offset:%c2" : "=&v"(dst) : "v"(addr), "i"(OFF) : "memory")
#define LGKM_WAIT0() do { asm volatile("s_waitcnt lgkmcnt(0)" ::: "memory"); __builtin_amdgcn_sched_barrier(0); } while (0)
__device__ __forceinline__ bf16x8 mk_frag(s16x4 lo, s16x4 hh) { return (bf16x8){lo[0], lo[1], lo[2], lo[3], hh[0], hh[1], hh[2], hh[3]}; }
__device__ __forceinline__ int frag_va(int lane, int ct) { const int hi = lane >> 5, i = lane & 15, q = i >> 2, p = i & 3, x = 2 * ((lane >> 4) & 1) + (p >> 1); return img_off(4 * hi + q, 4 * ct + x) + 8 * (p & 1); }
__device__ __forceinline__ bf16x8 v_frag_rt(const LAS unsigned char* vbuf, int va, int vd, int kk) {
    const s16x4 lo = vtr(vbuf + va + 4096 * kk), hh = vtr(vbuf + va + vd + 4096 * kk);
    return (bf16x8){lo[0], lo[1], lo[2], lo[3], hh[0], hh[1], hh[2], hh[3]};
}
__device__ __forceinline__ void store_o(const f32x16 (&o)[4], const float (&rscale)[16], LAS unsigned char* stg, bf16* dst, int ld, int lane) {
    const int hi = lane >> 5, r32 = lane & 31;
#pragma unroll
    for (int r = 0; r < 16; ++r) { const int orow = crow(r, hi);
#pragma unroll
        for (int ct = 0; ct < 4; ++ct) *(LAS bf16*)(stg + orow * 256 + (32 * ct + r32) * 2) = (bf16)f2bf(o[ct][r] * rscale[r]); }
    asm volatile("s_waitcnt lgkmcnt(0)" ::: "memory");
#pragma unroll
    for (int i = 0; i < 8; ++i) { const int c = lane + 64 * i, row = c >> 4, ch = c & 15; const u32x4 v = *(const LAS u32x4*)(stg + row * 256 + ch * 16); *(u32x4*)(dst + (size_t)row * ld + ch * 8) = v; }
}
}
template <bool SCALEQ> __device__ __forceinline__ void ph_prep_a(Frame& F) {
    const int gw = F.vcu * NWAVES + F.wave, NGW = F.G * NWAVES, lane = F.lane;
    for (int tok = gw; tok < M; tok += NGW) {
        const float pos = (float)(tok & (SEQ - 1));
        bf16* pr = F.R1 + (size_t)tok * NAB;
        float c128 = 1.f, s128 = 0.f;
        if (lane < 32) { const int i = lane & 15; const float inv = powf(500000.0f, -(float)i * 2.0f / 32.0f); const float ang = pos * inv; c128 = cosf(ang); s128 = sinf(ang); }
#pragma unroll
        for (int which = 0; which < 2; ++which) {
            const int base = which == 0 ? C_QA : C_KA;
            const float* gn = which == 0 ? F.gq_a : F.gk_a;
            for (int h = 0; h < 4; ++h) {
                float a = bf2f(pr[base + h * 128 + lane]), b = bf2f(pr[base + h * 128 + 64 + lane]);
                const float ss = wave_sum(a * a + b * b);
                const float rs = rsqrtf(ss * (1.f / 128.f) + EPS);
                const float qs = (SCALEQ && which == 0) ? att::C2 : 1.0f;
                a = a * rs * gn[lane] * qs; b = b * rs * gn[64 + lane] * qs;
                const float other = __shfl_xor(a, 16);
                float o = a;
                if (lane < 16) o = a * c128 - other * s128;
                else if (lane < 32) o = a * c128 + other * s128;
                pr[base + h * 128 + lane] = (bf16)f2bf(o); pr[base + h * 128 + 64 + lane] = (bf16)f2bf(b);
            }
        }
        float c64 = 1.f, s64 = 0.f;
        if (lane < 16) { const int i = lane & 7; const float inv = powf(500000.0f, -(float)i * 2.0f / 16.0f); const float ang = pos * inv; c64 = cosf(ang); s64 = sinf(ang); }
        for (int h = 0; h < 9; ++h) {
            const int col = (h < 8) ? C_IQ + h * 64 : C_IK;
            const float a = bf2f(pr[col + lane]);
            const float other = __shfl_xor(a, 8);
            float o = a;
            if (lane < 8) o = a * c64 - other * s64;
            else if (lane < 16) o = a * c64 + other * s64;
            pr[col + lane] = (bf16)f2bf(o);
        }
    }
}
__device__ __forceinline__ void ph_indexer_naive(Frame& F) {
    LAS float* sc = (LAS float*)F.lds;
    LAS float* qv = sc + 2048;
    LAS float* wv = qv + 512;
    LAS unsigned* mw = (LAS unsigned*)(wv + 8);
    const int tid = F.tid;
    for (int tok = F.vcu; tok < M; tok += F.G) {
        const int pos = tok & (SEQ - 1), seq0 = tok - pos, limit = ((pos >> 6) + 1) << 6;
        const bf16* pr = F.R1 + (size_t)tok * NAB;
        qv[tid] = bf2f(pr[C_IQ + tid]);
        if (tid < 8) wv[tid] = bf2f(pr[C_IW + tid]) * 0.35355339059327373f;
        if (tid < 64) mw[tid] = 0u;
        __syncthreads();
        for (int s = tid; s < limit; s += NTHR) {
            const bf16* kp = F.R1 + (size_t)(seq0 + s) * NAB + C_IK;
            float acc[8];
#pragma unroll
            for (int h = 0; h < 8; ++h) acc[h] = 0.f;
            for (int d = 0; d < 64; ++d) { const float kd = bf2f(kp[d]);
#pragma unroll
                for (int h = 0; h < 8; ++h) acc[h] = fmaf(qv[h * 64 + d], kd, acc[h]); }
            float score = 0.f;
#pragma unroll
            for (int h = 0; h < 8; ++h) score += fmaxf(acc[h] * 0.125f, 0.f) * wv[h];
            sc[s] = score;
        }
        __syncthreads();
        if (limit <= 256) { if (tid < 64) mw[tid] = (tid * 32 < limit) ? 0xffffffffu : 0u; }
        else {
            for (int s = tid; s < limit; s += NTHR) {
                const float v = sc[s]; int cnt = 0;
                for (int j = 0; j < limit; ++j) { const float u = sc[j]; cnt += ((u > v) || (u == v && j < s)) ? 1 : 0; }
                if (cnt < 256) atomicOr((unsigned*)&mw[s >> 5], 1u << (s & 31));
            }
        }
        __syncthreads();
        if (tid < 64) F.MASK[(size_t)tok * 64 + tid] = mw[tid];
        __syncthreads();
    }
}
__device__ __forceinline__ float block_sum(float v, LAS float* red, int tid) {
    v = wave_sum(v);
    __syncthreads();
    if ((tid & 63) == 0) red[tid >> 6] = v;
    __syncthreads();
    float r = 0.f;
#pragma unroll
    for (int i = 0; i < NWAVES; ++i) r += red[i];
    return r;
}
__device__ __forceinline__ float block_max(float v, LAS float* red, int tid) {
    v = wave_max(v);
    __syncthreads();
    if ((tid & 63) == 0) red[tid >> 6] = v;
    __syncthreads();
    float r = red[0];
#pragma unroll
    for (int i = 1; i < NWAVES; ++i) r = fmaxf(r, red[i]);
    return r;
}
__device__ __forceinline__ void ph_dsa_naive(Frame& F) {
    LAS unsigned* mw = (LAS unsigned*)F.lds;
    LAS int* pre = (LAS int*)(mw + 64);
    LAS int* idx = pre + 128;
    LAS float* pp = (LAS float*)(idx + 256);
    LAS float* q = pp + 512;
    LAS float* red = q + 512;
    const int tid = F.tid;
    for (int tok = F.vcu; tok < M; tok += F.G) {
        const int pos = tok & (SEQ - 1), seq0 = tok - pos;
        if (tid < 64) mw[tid] = F.MASK[(size_t)tok * 64 + tid];
        q[tid] = bf2f(F.R1[(size_t)tok * NAB + C_QA + tid]);
        __syncthreads();
        if (tid == 0) { int a = 0; for (int w = 0; w < 64; ++w) { pre[w] = a; a += __popc(mw[w]); } pre[64] = a; }
        __syncthreads();
        const int n = pre[64];
        for (int s = tid; s < SEQ; s += NTHR) { const unsigned w = mw[s >> 5]; if ((w >> (s & 31)) & 1u) idx[pre[s >> 5] + __popc(w & ((1u << (s & 31)) - 1u))] = s; }
        __syncthreads();
        for (int h = 0; h < 4; ++h) {
            float sv = -INFINITY;
            if (tid < n) { const bf16* kp = F.R1 + (size_t)(seq0 + idx[tid]) * NAB + C_KA + h * 128; float a = 0.f;
                for (int d = 0; d < 128; ++d) a = fmaf(q[h * 128 + d], bf2f(kp[d]), a);
                sv = a * 0.08838834764831845f; }
            const float m = block_max(sv, red, tid);
            const float e = (tid < n) ? expf(sv - m) : 0.f;
            const float l = block_sum(e, red, tid);
            pp[tid] = e;
            __syncthreads();
            if (tid < 128) { float o = 0.f;
                for (int j = 0; j < n; ++j) o = fmaf(pp[j], bf2f(F.R1[(size_t)(seq0 + idx[j]) * NAB + C_VA + h * 128 + tid]), o);
                F.CAT[(size_t)tok * D + h * 128 + tid] = (bf16)f2bf(o / l); }
            __syncthreads();
        }
    }
}
__device__ __forceinline__ void ph_gla_naive(Frame& F) {
    LAS float* sq = (LAS float*)F.lds; LAS float* sk = sq + 1024; LAS float* sd = sk + 1024;
    LAS float* sg = sd + 1024;
    LAS float* red = sg + 256;
    const int tid = F.tid, lane = F.lane;
    for (int item = F.vcu; item < BATCH * 4; item += F.G) {
        const int b = item >> 2, h = item & 3, seq0 = b * SEQ;
        float S[64];
#pragma unroll
        for (int d = 0; d < 64; ++d) S[d] = 0.f;
        for (int t0 = 0; t0 < SEQ; t0 += 16) {
            if (tid < 256) { const int tt = tid >> 4, r = tid & 15; sg[tid] = bf2f(F.R1[(size_t)(seq0 + t0 + tt) * NAB + C_GL + r]); }
            __syncthreads();
            for (int i = tid; i < 1024; i += NTHR) { const int tt = i >> 6, d = i & 63; const bf16* pr = F.R1 + (size_t)(seq0 + t0 + tt) * NAB;
                sq[i] = bf2f(pr[C_QB + h * 64 + d]) * 0.125f; sk[i] = bf2f(pr[C_KB + h * 64 + d]);
                float g = F.b_gate[h * 64 + d];
#pragma unroll
                for (int r = 0; r < 16; ++r) g = fmaf(sg[tt * 16 + r], F.w_gate_up[r * 256 + h * 64 + d], g);
                sd[i] = expf(log_sigmoid(g) * (1.f / 16.f)); }
            __syncthreads();
            float o[16];
            if (tid < 128) {
#pragma unroll
                for (int tt = 0; tt < 16; ++tt) {
                    const float v = bf2f(F.R1[(size_t)(seq0 + t0 + tt) * NAB + C_VB + h * 128 + tid]); float a = 0.f;
#pragma unroll
                    for (int d = 0; d < 64; ++d) { S[d] = fmaf(sd[tt * 64 + d], S[d], sk[tt * 64 + d] * v); a = fmaf(sq[tt * 64 + d], S[d], a); }
                    o[tt] = a;
                    const float ws = wave_sum(a * a);
                    if (lane == 0) red[tt * 2 + (tid >> 6)] = ws;
                }
            }
            __syncthreads();
            if (tid < 128) {
#pragma unroll
                for (int tt = 0; tt < 16; ++tt) {
                    const size_t tok = seq0 + t0 + tt;
                    const float rs = rsqrtf((red[tt * 2] + red[tt * 2 + 1]) * (1.f / 128.f) + EPS);
                    const float og = bf2f(F.R1[tok * NAB + C_OG + h * 128 + tid]);
                    F.CAT[tok * D + 512 + h * 128 + tid] = (bf16)f2bf(o[tt] * rs * F.g_gla[tid] * (og / (1.f + expf(-og))));
                }
            }
            __syncthreads();
        }
    }
}
template <bool SCALEQ> __device__ __forceinline__ void ph_prep_c(Frame& F) {
    const int gw = F.vcu * NWAVES + F.wave, NGW = F.G * NWAVES, lane = F.lane;
    for (int it = gw; it < M * 16; it += NGW) {
        const int tok = it >> 4, hh = it & 15, isk = hh >> 3, h = hh & 7;
        bf16* p = F.R1 + (size_t)tok * NC + isk * 1024 + h * 128;
        const float* gn = isk ? F.gk_c : F.gq_c;
        const float a = bf2f(p[lane]), b = bf2f(p[64 + lane]);
        const float rs = rsqrtf(wave_sum(a * a + b * b) * (1.f / 128.f) + EPS);
        const float sc = (SCALEQ && !isk) ? att::C2 : 1.0f;
        p[lane] = (bf16)f2bf(a * rs * gn[lane] * sc); p[64 + lane] = (bf16)f2bf(b * rs * gn[64 + lane] * sc);
    }
}
__device__ __forceinline__ void ph_sb_naive(Frame& F) {
    const int gw = F.vcu * NWAVES + F.wave, NGW = F.G * NWAVES, lane = F.lane;
    for (int it = gw; it < M * 8; it += NGW) {
        const int tok = it >> 3, h = it & 7, pos = tok & (SEQ - 1), seq0 = tok - pos;
        const unsigned qq = *(const unsigned*)(F.R1 + (size_t)tok * NC + h * 128 + 2 * lane);
        const float q0 = __builtin_bit_cast(float, qq << 16), q1 = __builtin_bit_cast(float, qq & 0xffff0000u);
        float R = 0.f, o0 = 0.f, o1 = 0.f;
        for (int s = pos - 1; s >= 0; --s) {
            const bf16* pr = F.R1 + (size_t)(seq0 + s) * NC + h * 128 + 2 * lane;
            const unsigned kk = *(const unsigned*)(pr + 1024), vv = *(const unsigned*)(pr + 2048);
            const float k0 = __builtin_bit_cast(float, kk << 16), k1 = __builtin_bit_cast(float, kk & 0xffff0000u);
            const float z = wave_sum(q0 * k0 + q1 * k1) * 0.08838834764831845f;
            const float sp = log1pf(expf(-fabsf(z)));
            const float lsp = fminf(z, 0.f) - sp, lsn = fminf(-z, 0.f) - sp;
            const float a = expf(lsp + R);
            o0 = fmaf(a, __builtin_bit_cast(float, vv << 16), o0); o1 = fmaf(a, __builtin_bit_cast(float, vv & 0xffff0000u), o1);
            R += lsn;
        }
        *(unsigned*)(F.CAT + (size_t)tok * D + h * 128 + 2 * lane) = pk2(o0, o1);
    }
}
__device__ __forceinline__ void sb_unit(Frame& F, int b, int h, int qb) {
    using namespace att;
    const int tid = F.tid, lane = F.lane, w = F.wave, hi = lane >> 5, r32 = lane & 31;
    const bf16* Qg = F.R1 + (size_t)b * SEQ * NC + h * 128; const bf16* Kg = Qg + 1024; const bf16* Vg = Qg + 2048;
    const int T0 = qb * 256, t0w = T0 + 32 * w, jd = t0w >> 6, jtop = (T0 >> 6) + 3, tl = 32 * (w & 1) + r32, tl4 = tl - 4 * hi;
    LAS unsigned char* lds = F.lds;
    FragOff fo; frag_off_init(fo, lane);
    unsigned dvo[2]; dma_off_init(dvo, NC, w, lane);
    bf16x8 qf[8];
#pragma unroll
    for (int ks = 0; ks < 8; ++ks) qf[ks] = *(const bf16x8*)(Qg + (size_t)(t0w + r32) * NC + 16 * ks + 8 * hi);
    f16x8 T0f, T1f, ONEf;
#pragma unroll
    for (int j = 0; j < 8; ++j) { const int kp = 8 * (j >> 2) + 4 * hi + (j & 3); T0f[j] = (kp >= r32) ? (_Float16)1.0f : (_Float16)0.0f; T1f[j] = (kp + 16 >= r32) ? (_Float16)1.0f : (_Float16)0.0f; ONEf[j] = (_Float16)1.0f; }
    f32x16 o[4];
#pragma unroll
    for (int ct = 0; ct < 4; ++ct)
#pragma unroll
        for (int r = 0; r < 16; ++r) o[ct][r] = 0.f;
    float R2 = 0.f; bool done = false;
    volatile LAS unsigned* flags = F.MISC + 16;
    tile_dma(Kg + (size_t)(64 * jtop) * NC, dvo, lds, w); tile_dma(Vg + (size_t)(64 * jtop) * NC, dvo, lds + 16384, w);
    asm volatile("s_waitcnt vmcnt(0)" ::: "memory");
    __syncthreads();
    for (int j = jtop; j >= 0; --j) {
        const int cur = (jtop - j) & 1;
        const LAS unsigned char* kb = lds + cur * 32768; const LAS unsigned char* vb = kb + 16384;
        if (j > 0) { tile_dma(Kg + (size_t)(64 * (j - 1)) * NC, dvo, lds + (cur ^ 1) * 32768, w); tile_dma(Vg + (size_t)(64 * (j - 1)) * NC, dvo, lds + (cur ^ 1) * 32768 + 16384, w); }
        if (j <= jd && !done) {
            f32x16 p0, p1;
#pragma unroll
            for (int r = 0; r < 16; ++r) { p0[r] = 0.f; p1[r] = 0.f; }
            { bf16x8 kf[8];
#pragma unroll
              for (int ks = 0; ks < 8; ++ks) kf[ks] = k_frag(kb, fo, 0, ks);
#pragma unroll
              for (int ks = 0; ks < 8; ++ks) p0 = __builtin_amdgcn_mfma_f32_32x32x16_bf16(kf[ks], qf[ks], p0, 0, 0, 0);
#pragma unroll
              for (int ks = 0; ks < 8; ++ks) kf[ks] = k_frag(kb, fo, 1, ks);
#pragma unroll
              for (int ks = 0; ks < 8; ++ks) p1 = __builtin_amdgcn_mfma_f32_32x32x16_bf16(kf[ks], qf[ks], p1, 0, 0, 0); }
            s16x4 vl[4], vh[4], wl[4], wh[4];
            unsigned va0[4], va1[4];
#pragma unroll
            for (int ct = 0; ct < 4; ++ct) { va0[ct] = (unsigned)(size_t)vb + (unsigned)fo.va[ct]; va1[ct] = va0[ct] + (unsigned)fo.vd; }
            const bool diag = (j == jd);
            float x0[16], x1[16]; float rs = 0.f;
#pragma unroll
            for (int r = 0; r < 16; ++r) { const int key = (r & 3) + 8 * (r >> 2);
                float l0 = -__builtin_amdgcn_logf(1.0f + __builtin_amdgcn_exp2f(p0[r])), l1 = -__builtin_amdgcn_logf(1.0f + __builtin_amdgcn_exp2f(p1[r]));
                if (diag) { if (!(key < tl4)) l0 = 0.f; if (!(key + 32 < tl4)) l1 = 0.f; }
                x0[r] = l0; x1[r] = l1; rs += l0 + l1; p0[r] += R2; p1[r] += R2; }
            const f16x8 xb00 = pack8h(x0[0], x0[1], x0[2], x0[3], x0[4], x0[5], x0[6], x0[7]), xb01 = pack8h(x0[8], x0[9], x0[10], x0[11], x0[12], x0[13], x0[14], x0[15]);
            const f16x8 xb10 = pack8h(x1[0], x1[1], x1[2], x1[3], x1[4], x1[5], x1[6], x1[7]), xb11 = pack8h(x1[8], x1[9], x1[10], x1[11], x1[12], x1[13], x1[14], x1[15]);
            p0 = __builtin_amdgcn_mfma_f32_32x32x16_f16(T0f, xb00, p0, 0, 0, 0); p0 = __builtin_amdgcn_mfma_f32_32x32x16_f16(T1f, xb01, p0, 0, 0, 0);
            p0 = __builtin_amdgcn_mfma_f32_32x32x16_f16(ONEf, xb10, p0, 0, 0, 0); p0 = __builtin_amdgcn_mfma_f32_32x32x16_f16(ONEf, xb11, p0, 0, 0, 0);
            p1 = __builtin_amdgcn_mfma_f32_32x32x16_f16(T0f, xb10, p1, 0, 0, 0); p1 = __builtin_amdgcn_mfma_f32_32x32x16_f16(T1f, xb11, p1, 0, 0, 0);
#pragma unroll
            for (int r = 0; r < 16; ++r) { const int key = (r & 3) + 8 * (r >> 2);
                float a0 = __builtin_amdgcn_exp2f(p0[r]), a1 = __builtin_amdgcn_exp2f(p1[r]);
                if (diag) { if (!(key < tl4)) a0 = 0.f; if (!(key + 32 < tl4)) a1 = 0.f; }
                p0[r] = a0; p1[r] = a1; }
            const bf16x8 pa0 = pack8(p0[0], p0[1], p0[2], p0[3], p0[4], p0[5], p0[6], p0[7]), pa1 = pack8(p0[8], p0[9], p0[10], p0[11], p0[12], p0[13], p0[14], p0[15]);
            const bf16x8 pa2 = pack8(p1[0], p1[1], p1[2], p1[3], p1[4], p1[5], p1[6], p1[7]), pa3 = pack8(p1[8], p1[9], p1[10], p1[11], p1[12], p1[13], p1[14], p1[15]);
#pragma unroll
            for (int ct = 0; ct < 4; ++ct) { TR_READ(vl[ct], va0[ct], 0); TR_READ(vh[ct], va1[ct], 0); }
            LGKM_WAIT0();
#pragma unroll
            for (int ct = 0; ct < 4; ++ct) { TR_READ(wl[ct], va0[ct], 4096); TR_READ(wh[ct], va1[ct], 4096); }
#pragma unroll
            for (int ct = 0; ct < 4; ++ct) o[ct] = __builtin_amdgcn_mfma_f32_32x32x16_bf16(pa0, mk_frag(vl[ct], vh[ct]), o[ct], 0, 0, 0);
            LGKM_WAIT0();
#pragma unroll
            for (int ct = 0; ct < 4; ++ct) { TR_READ(vl[ct], va0[ct], 8192); TR_READ(vh[ct], va1[ct], 8192); }
#pragma unroll
            for (int ct = 0; ct < 4; ++ct) o[ct] = __builtin_amdgcn_mfma_f32_32x32x16_bf16(pa1, mk_frag(wl[ct], wh[ct]), o[ct], 0, 0, 0);
            LGKM_WAIT0();
#pragma unroll
            for (int ct = 0; ct < 4; ++ct) { TR_READ(wl[ct], va0[ct], 12288); TR_READ(wh[ct], va1[ct], 12288); }
#pragma unroll
            for (int ct = 0; ct < 4; ++ct) o[ct] = __builtin_amdgcn_mfma_f32_32x32x16_bf16(pa2, mk_frag(vl[ct], vh[ct]), o[ct], 0, 0, 0);
            LGKM_WAIT0();
#pragma unroll
            for (int ct = 0; ct < 4; ++ct) o[ct] = __builtin_amdgcn_mfma_f32_32x32x16_bf16(pa3, mk_frag(wl[ct], wh[ct]), o[ct], 0, 0, 0);
            rs += __shfl_xor(rs, 32);
            R2 += rs;
            done = __all(R2 < -152.0f);
        }
        if (lane == 0) flags[cur * 8 + w] = done ? 1u : 0u;
        asm volatile("s_waitcnt vmcnt(0) lgkmcnt(0)" ::: "memory");
        __syncthreads();
        unsigned alld = 1u;
#pragma unroll
        for (int i = 0; i < 8; ++i) alld &= flags[cur * 8 + i];
        if (alld) break;
    }
    float ones[16];
#pragma unroll
    for (int r = 0; r < 16; ++r) ones[r] = 1.0f;
    store_o(o, ones, lds + w * 8192, F.CAT + (size_t)(b * SEQ + t0w) * D + h * 128, D, lane);
    __syncthreads();
}
__device__ __forceinline__ void ph_sb(Frame& F) {
    for (int v = F.vcu; v < BATCH * 8 * 2; v += F.G) {
        const int bh = v >> 1, half = v & 1;
#pragma unroll 1
        for (int i = 0; i < 4; ++i) { const int qb = half ? (i == 0 ? 1 : i == 1 ? 6 : i == 2 ? 2 : 5) : (i == 0 ? 0 : i == 1 ? 7 : i == 2 ? 3 : 4); sb_unit(F, bh >> 3, bh & 7, qb); }
    }
}
__device__ __forceinline__ void dsa_unit(Frame& F, int b, int h, int ub, float mref) {
    using namespace att;
    const int lane = F.lane, w = F.wave, hi = lane >> 5, r32 = lane & 31;
    const bf16* Qg = F.R1 + (size_t)b * SEQ * NAB + C_QA + h * 128; const bf16* Kg = F.R1 + (size_t)b * SEQ * NAB + C_KA + h * 128; const bf16* Vg = F.R1 + (size_t)b * SEQ * NAB + C_VA + h * 128;
    const int t0w = 256 * ub + 32 * w, cw = t0w >> 6, jlast = 4 * ub + 3;
    LAS unsigned char* lds = F.lds;
    LAS unsigned char* mst = lds + 65536 + w * 8448;
    FragOff fo; frag_off_init(fo, lane);
    unsigned dvo[2]; dma_off_init(dvo, NAB, w, lane);
    tile_dma(Kg, dvo, lds, w); tile_dma(Vg, dvo, lds + 16384, w);
    bf16x8 qf[8];
#pragma unroll
    for (int ks = 0; ks < 8; ++ks) qf[ks] = *(const bf16x8*)(Qg + (size_t)(t0w + r32) * NAB + 16 * ks + 8 * hi);
    { const unsigned* mg = F.MASK + (size_t)(b * SEQ + t0w) * 64;
#pragma unroll 2
      for (int i = 0; i < 8; ++i) { const int c = lane + 64 * i, row = c >> 4, c4 = c & 15; const u32x4 v = *(const u32x4*)(mg + row * 64 + c4 * 4);
          *(LAS unsigned long long*)(mst + row * 264 + c4 * 16) = (unsigned long long)v.x | ((unsigned long long)v.y << 32);
          *(LAS unsigned long long*)(mst + row * 264 + c4 * 16 + 8) = (unsigned long long)v.z | ((unsigned long long)v.w << 32); } }
    f32x16 o[4];
#pragma unroll
    for (int ct = 0; ct < 4; ++ct)
#pragma unroll
        for (int r = 0; r < 16; ++r) o[ct][r] = 0.f;
    float lsum = 0.f;
    asm volatile("s_waitcnt vmcnt(0) lgkmcnt(0)" ::: "memory");
    __syncthreads();
    for (int j = 0; j <= jlast; ++j) {
        const int cur = j & 1;
        const LAS unsigned char* kb = lds + cur * 32768; const LAS unsigned char* vb = kb + 16384;
        if (j < jlast) { tile_dma(Kg + (size_t)(64 * (j + 1)) * NAB, dvo, lds + (cur ^ 1) * 32768, w); tile_dma(Vg + (size_t)(64 * (j + 1)) * NAB, dvo, lds + (cur ^ 1) * 32768 + 16384, w); }
        if (j <= cw) {
            const unsigned long long mw = *(const LAS unsigned long long*)(mst + r32 * 264 + j * 8);
            const unsigned mw0 = (unsigned)mw, mw1 = (unsigned)(mw >> 32);
#pragma unroll 1
            for (int half = 0; half < 2; ++half) {
                const unsigned mwh = (half ? mw1 : mw0) >> (4 * hi);
                bf16x8 kf[8];
#pragma unroll
                for (int ks = 0; ks < 8; ++ks) kf[ks] = k_frag(kb, fo, half, ks);
                f32x16 p;
#pragma unroll
                for (int r = 0; r < 16; ++r) p[r] = 0.f;
#pragma unroll
                for (int ks = 0; ks < 8; ++ks) p = __builtin_amdgcn_mfma_f32_32x32x16_bf16(kf[ks], qf[ks], p, 0, 0, 0);
#pragma unroll
                for (int r = 0; r < 16; ++r) { const unsigned keep = (unsigned)(-(int)((mwh >> ((r & 3) + 8 * (r >> 2))) & 1u));
                    const float e = __uint_as_float(__float_as_uint(__builtin_amdgcn_exp2f(p[r] - mref)) & keep); p[r] = e; lsum += e; }
                const bf16x8 pa0 = pack8(p[0], p[1], p[2], p[3], p[4], p[5], p[6], p[7]), pa1 = pack8(p[8], p[9], p[10], p[11], p[12], p[13], p[14], p[15]);
                s16x4 vl[8], vh[8];
                const unsigned vbase = (unsigned)(size_t)vb + 8192u * (unsigned)half;
#pragma unroll
                for (int ct = 0; ct < 4; ++ct) { const unsigned a0 = vbase + (unsigned)fo.va[ct], a1 = a0 + (unsigned)fo.vd;
                    TR_READ(vl[2 * ct], a0, 0); TR_READ(vh[2 * ct], a1, 0); TR_READ(vl[2 * ct + 1], a0, 4096); TR_READ(vh[2 * ct + 1], a1, 4096); }
                LGKM_WAIT0();
#pragma unroll
                for (int ct = 0; ct < 4; ++ct) {
                    o[ct] = __builtin_amdgcn_mfma_f32_32x32x16_bf16(pa0, mk_frag(vl[2 * ct], vh[2 * ct]), o[ct], 0, 0, 0);
                    o[ct] = __builtin_amdgcn_mfma_f32_32x32x16_bf16(pa1, mk_frag(vl[2 * ct + 1], vh[2 * ct + 1]), o[ct], 0, 0, 0);
                }
            }
        }
        asm volatile("s_waitcnt vmcnt(0) lgkmcnt(0)" ::: "memory");
        __syncthreads();
    }
    lsum += __shfl_xor(lsum, 32);
    LAS float* lsc = (LAS float*)mst;
    if (hi == 0) lsc[r32] = 1.0f / lsum;
    asm volatile("s_waitcnt lgkmcnt(0)" ::: "memory");
    float rsc[16];
#pragma unroll
    for (int r = 0; r < 16; ++r) rsc[r] = lsc[crow(r, hi)];
    store_o(o, rsc, lds + w * 8192, F.CAT + (size_t)(b * SEQ + t0w) * D + h * 128, D, lane);
    __syncthreads();
}
__device__ __forceinline__ void ph_dsa(Frame& F) {
    float gm = fmaxf(fabsf(F.gq_a[F.lane]), fabsf(F.gq_a[64 + F.lane])), km = fmaxf(fabsf(F.gk_a[F.lane]), fabsf(F.gk_a[64 + F.lane]));
    gm = wave_max(gm); km = wave_max(km);
    const float mref = att::C2 * 128.0f * gm * km * 1.02f;
    for (int v = F.vcu; v < BATCH * 4 * 4; v += F.G) {
        const int bh = v >> 2, pi = v & 3;
#pragma unroll 1
        for (int k = 0; k < 2; ++k) dsa_unit(F, bh >> 2, bh & 3, k ? 7 - pi : pi, mref);
    }
}
namespace idx {
using att::f32x16;
constexpr int SCP = 2048;
__device__ __forceinline__ unsigned okey(float f) { const unsigned u = __float_as_uint(f); return (u & 0x80000000u) ? ~u : (u | 0x80000000u); }
__device__ __forceinline__ int wave_isum(int c) {
    c += __builtin_amdgcn_mov_dpp(c, 0xB1, 0xF, 0xF, true);
    c += __builtin_amdgcn_mov_dpp(c, 0x4E, 0xF, 0xF, true);
    c += __builtin_amdgcn_mov_dpp(c, 0x141, 0xF, 0xF, true);
    c += __builtin_amdgcn_mov_dpp(c, 0x140, 0xF, 0xF, true);
    return (__builtin_amdgcn_readlane(c, 0) + __builtin_amdgcn_readlane(c, 16)) + (__builtin_amdgcn_readlane(c, 32) + __builtin_amdgcn_readlane(c, 48));
}
__device__ __forceinline__ void bit_transpose32x2(unsigned (&A)[32], unsigned (&B)[32]) {
    unsigned mask = 0x0000FFFFu;
#pragma unroll
    for (int s = 16; s; s >>= 1) {
        unsigned ta[16], tb[16];
#pragma unroll
        for (int k = 0, i = 0; k < 32; ++k) if (!(k & s)) { ta[i] = A[k + s] >> s; tb[i] = B[k + s] >> s; ++i; }
#pragma unroll
        for (int k = 0, i = 0; k < 32; ++k) if (!(k & s)) { ta[i] ^= A[k]; tb[i] ^= B[k]; ++i; }
#pragma unroll
        for (int i = 0; i < 16; ++i) { ta[i] &= mask; tb[i] &= mask; }
#pragma unroll
        for (int k = 0, i = 0; k < 32; ++k) if (!(k & s)) { A[k] ^= ta[i]; B[k] ^= tb[i]; ++i; }
#pragma unroll
        for (int k = 0, i = 0; k < 32; ++k) if (!(k & s)) { A[k + s] ^= ta[i] << s; B[k + s] ^= tb[i] << s; ++i; }
        mask ^= mask << (s >> 1);
    }
}
__device__ __forceinline__ void select_prepare(const LAS float* scA, const LAS float* scB, int E, unsigned (&Wa)[32], unsigned (&Wb)[32], int lane) {
#pragma unroll
    for (int j = 0; j < 32; ++j) { Wa[31 - j] = __float_as_uint(scA[64 * j + lane]); Wb[31 - j] = __float_as_uint(scB[64 * j + lane]); }
#pragma unroll
    for (int j = 0; j < 32; ++j) { const unsigned ua = Wa[31 - j], ub = Wb[31 - j];
        const unsigned ka = (ua & 0x80000000u) ? ~ua : (ua | 0x80000000u), kb = (ub & 0x80000000u) ? ~ub : (ub | 0x80000000u);
        Wa[31 - j] = (j < E) ? ka : 0u; Wb[31 - j] = (j < E) ? kb : 0u; }
    bit_transpose32x2(Wa, Wb);
}
__device__ __forceinline__ void select_finish(const unsigned (&Wa)[32], const unsigned (&Wb)[32], int E, unsigned* mrowA, unsigned* mrowB, int lane) {
    const unsigned valid = (E >= 32) ? 0xFFFFFFFFu : ((1u << E) - 1u);
    unsigned alA = valid, alB = valid, gtA = 0u, gtB = 0u;
    int GA = 0, GB = 0, AA = 64 * E, AB = 64 * E; bool dA = false, dB = false;
#pragma unroll
    for (int b = 0; b < 32; ++b) {
        if (dA && dB) break;
        const unsigned m1a = alA & Wa[b], m1b = alB & Wb[b];
        const int ca = wave_isum(__popc(m1a)), cb = wave_isum(__popc(m1b));
        if (!dA) { if (GA + ca >= 256) { alA = m1a; AA = ca; } else { GA += ca; gtA |= m1a; alA &= ~Wa[b]; AA -= ca; } dA = (GA + AA == 256); }
        if (!dB) { if (GB + cb >= 256) { alB = m1b; AB = cb; } else { GB += cb; gtB |= m1b; alB &= ~Wb[b]; AB -= cb; } dB = (GB + AB == 256); }
    }
#pragma unroll 1
    for (int rr = 0; rr < 2; ++rr) {
        const unsigned al = rr ? alB : alA, gt = rr ? gtB : gtA; const bool done = rr ? dB : dA; unsigned* mrow = rr ? mrowB : mrowA;
        unsigned sel = gt | al;
        if (!done) {
            int need = 256 - (rr ? GB : GA); sel = gt;
            const unsigned long long below = (1ull << lane) - 1ull;
            for (int j = 0; j < E; ++j) { const bool e = (al >> j) & 1u; const unsigned long long eq = __ballot(e);
                if (e && __popcll(eq & below) < need) sel |= 1u << j;
                need -= __popcll(eq); if (need <= 0) break; }
        }
        unsigned long long mine = 0ull;
#pragma unroll
        for (int j = 0; j < 32; ++j) { if (j < E) { const unsigned long long m = __ballot((sel >> j) & 1u); if (lane == j) mine = m; } }
        if (lane < 32) *(unsigned long long*)(mrow + 2 * lane) = mine;
    }
}
__device__ __forceinline__ void decode(int u, int& b, int& c, int& sub) { c = 4 + u % 28; const int rest = u / 28; b = rest >> 2; sub = rest & 3; }
__device__ __forceinline__ void load_af(Frame& F, int u, bf16x8 (&af)[4][4]) {
    int b, c, sub; decode(u, b, c, sub);
    const int r32 = F.lane & 31, hi = F.lane >> 5, t0 = 64 * c + 16 * sub;
    const bf16* P = F.R1 + (size_t)b * SEQ * NAB;
#pragma unroll
    for (int rt = 0; rt < 4; ++rt)
#pragma unroll
        for (int ks = 0; ks < 4; ++ks) af[rt][ks] = *(const bf16x8*)(P + (size_t)(t0 + 4 * rt + (r32 >> 3)) * NAB + C_IQ + (r32 & 7) * 64 + 16 * ks + 8 * hi);
}
__device__ __forceinline__ float load_w(Frame& F, int u) {
    int b, c, sub; decode(u, b, c, sub);
    const int t0 = 64 * c + 16 * sub;
    return (F.tid < 128) ? bf2f(F.R1[(size_t)(b * SEQ + t0 + (F.tid >> 3)) * NAB + C_IW + (F.tid & 7)]) * (0.125f * 0.35355339059327373f) : 0.f;
}
__device__ __forceinline__ void load_bf(Frame& F, int b, int strip, bf16x8 (&bfr)[4]) {
    const bf16* P = F.R1 + (size_t)b * SEQ * NAB;
#pragma unroll
    for (int ks = 0; ks < 4; ++ks) bfr[ks] = *(const bf16x8*)(P + (size_t)(32 * strip + (F.lane & 31)) * NAB + C_IK + 16 * ks + 8 * (F.lane >> 5));
}
__device__ __forceinline__ void run(Frame& F) {
    const int lane = F.lane, w = F.wave, hi = lane >> 5, r32 = lane & 31, tid = F.tid, NU = BATCH * 28 * 4;
    int u = F.vcu; if (u >= NU) return;
    LAS float* sc = (LAS float*)F.lds;
    LAS float* wtb = sc + 16 * SCP;
    bf16x8 af[4][4], bfr[4], bnx[4];
    load_af(F, u, af);
    { const float wv = load_w(F, u); if (tid < 128) wtb[tid] = wv; }
    { int b, c, sub; decode(u, b, c, sub); if (w < 2 * (c + 1)) load_bf(F, b, w, bfr); }
    for (int it = 0; u < NU; ++it, u += F.G) {
        int b, c, sub; decode(u, b, c, sub);
        const int n = 64 * (c + 1), t0 = 64 * c + 16 * sub, nstrip = n >> 5;
        const int un = u + F.G; const bool more = un < NU;
        const LAS float* wt = wtb + (it & 1) * 128;
        __syncthreads();
        const float wnext = more ? load_w(F, un) : 0.f;
        for (int s = w; s < nstrip; s += NWAVES) {
            const bool mstrip = s + NWAVES < nstrip;
            if (mstrip) load_bf(F, b, s + NWAVES, bnx);
#pragma unroll
            for (int rt = 0; rt < 4; ++rt) {
                f32x16 acc;
#pragma unroll
                for (int r = 0; r < 16; ++r) acc[r] = 0.f;
#pragma unroll
                for (int ks = 0; ks < 4; ++ks) acc = __builtin_amdgcn_mfma_f32_32x32x16_bf16(af[rt][ks], bfr[ks], acc, 0, 0, 0);
                float part[4];
#pragma unroll
                for (int qi = 0; qi < 4; ++qi) { const f32x4 wv = *(const LAS f32x4*)(wt + (4 * rt + qi) * 8 + 4 * hi);
                    part[qi] = fmaxf(acc[4 * qi], 0.f) * wv[0] + fmaxf(acc[4 * qi + 1], 0.f) * wv[1] + fmaxf(acc[4 * qi + 2], 0.f) * wv[2] + fmaxf(acc[4 * qi + 3], 0.f) * wv[3]; }
                const float send0 = hi ? part[0] : part[2], send1 = hi ? part[1] : part[3];
                const float got0 = __shfl_xor(send0, 32), got1 = __shfl_xor(send1, 32);
                const float f0 = (hi ? part[2] : part[0]) + got0, f1 = (hi ? part[3] : part[1]) + got1;
                const int q0 = 4 * rt + 2 * hi;
                sc[q0 * SCP + 32 * s + r32] = f0; sc[(q0 + 1) * SCP + 32 * s + r32] = f1;
            }
            if (mstrip) {
#pragma unroll
                for (int ks = 0; ks < 4; ++ks) bfr[ks] = bnx[ks];
            }
        }
        if (more && tid < 128) wtb[((it + 1) & 1) * 128 + tid] = wnext;
        __syncthreads();
        { const int q = 2 * w;
          unsigned* mrowA = F.MASK + (size_t)(b * SEQ + t0 + q) * 64; unsigned* mrowB = mrowA + 64;
          const LAS float* rowA = sc + q * SCP; const LAS float* rowB = rowA + SCP;
          unsigned Wa[32], Wb[32];
          select_prepare(rowA, rowB, n >> 6, Wa, Wb, lane);
          asm volatile("" ::: "memory");
          if (more) load_af(F, un, af);
          select_finish(Wa, Wb, n >> 6, mrowA, mrowB, lane); }
        if (more) { int bn, cn, sn; decode(un, bn, cn, sn); if (w < 2 * (cn + 1)) load_bf(F, bn, w, bfr); }
    }
    __syncthreads();
}
}
__device__ __forceinline__ void ph_indexer(Frame& F) {
    { const int gw = F.vcu * NWAVES + F.wave, NGW = F.G * NWAVES;
      for (int i = gw; i < BATCH * 256; i += NGW) { const int b = i >> 8, pos = i & 255, n = ((pos >> 6) + 1) << 6;
          if (F.lane < 32) { unsigned long long v = 0ull; if (64 * F.lane < n) v = ~0ull; *(unsigned long long*)(F.MASK + (size_t)(b * SEQ + pos) * 64 + 2 * F.lane) = v; } } }
    idx::run(F);
}
namespace gla {
using att::f32x16; using att::u32x4;
constexpr int L_WL = 0, L_V = 4096, L_OG = 36864, L_K = 69632, L_Q = 78848, L_PART = 88064, L_STG = 89088, KP = 144, SP = 272;
struct In { u32x4 g0, g1, kk, qq; };
__device__ __forceinline__ void decode(int u, int& b, int& h, int& c) { b = u >> 7; h = (u >> 5) & 3; c = u & 31; }
template <bool NEEDQ> __device__ __forceinline__ void load_in(Frame& F, int u, In& in) {
    int b, h, c; decode(u, b, h, c);
    const bf16* pr = F.R1 + (size_t)(b * SEQ + 64 * c + F.lane) * NAB;
    in.g0 = *(const u32x4*)(pr + C_GL); in.g1 = *(const u32x4*)(pr + C_GL + 8);
    in.kk = *(const u32x4*)(pr + C_KB + h * 64 + 8 * F.wave);
    if (NEEDQ) in.qq = *(const u32x4*)(pr + C_QB + h * 64 + 8 * F.wave);
}
template <bool NEEDOG> __device__ __forceinline__ void dma_in(Frame& F, int u, int buf, const unsigned (&dvo)[2]) {
    int b, h, c; decode(u, b, h, c);
    const bf16* P = F.R1 + (size_t)(b * SEQ + 64 * c) * NAB;
    att::tile_dma(P + C_VB + h * 128, dvo, F.lds + L_V + buf * 16384, F.wave);
    if (NEEDOG) att::tile_dma(P + C_OG + h * 128, dvo, F.lds + L_OG + buf * 16384, F.wave);
}
__device__ __forceinline__ void stage_wl(Frame& F, int h) {
    LAS float* wl = (LAS float*)(F.lds + L_WL);
#pragma unroll
    for (int i = 0; i < 2; ++i) { const int e = F.tid + 512 * i, r = e >> 6, d = e & 63; wl[e] = F.w_gate_up[r * 256 + h * 64 + d]; }
}
__device__ __forceinline__ void unpack8(const u32x4 v, float (&f)[8]) {
#pragma unroll
    for (int i = 0; i < 4; ++i) { f[2 * i] = __uint_as_float(v[i] << 16); f[2 * i + 1] = __uint_as_float(v[i] & 0xffff0000u); }
}
__device__ __forceinline__ void gate_scan(Frame& F, int h, const float (&gl)[16], float (&bc)[8], float (&blast)[8]) {
    const int lane = F.lane, d0 = 8 * F.wave;
    const LAS float* wl = (const LAS float*)(F.lds + L_WL);
    float acc[8];
#pragma unroll
    for (int i = 0; i < 8; ++i) acc[i] = F.b_gate[h * 64 + d0 + i];
#pragma unroll
    for (int r = 0; r < 16; ++r) { const f32x4 w0 = *(const LAS f32x4*)(wl + r * 64 + d0), w1 = *(const LAS f32x4*)(wl + r * 64 + d0 + 4);
#pragma unroll
        for (int i = 0; i < 4; ++i) { acc[i] = fmaf(gl[r], w0[i], acc[i]); acc[4 + i] = fmaf(gl[r], w1[i], acc[4 + i]); } }
#pragma unroll
    for (int i = 0; i < 8; ++i) { float v = (fminf(acc[i], 0.f) - __logf(1.0f + __expf(-fabsf(acc[i])))) * (1.0f / 16.0f);
#pragma unroll
        for (int off = 1; off < 64; off <<= 1) { const float u = __shfl_up(v, off); if (lane >= off) v += u; }
        bc[i] = v; blast[i] = __shfl(v, 63); }
}
__device__ __forceinline__ void pass_a(Frame& F, float* GU, float* DEC) {
    const int lane = F.lane, w = F.wave, hi = lane >> 5, r32 = lane & 31;
    att::FragOff fo; att::frag_off_init(fo, lane);
    unsigned dvo[2]; att::dma_off_init(dvo, NAB, w, lane);
    const int et = w >> 1, dt = w & 1, va_et = att::frag_va(lane, et);
    int u = F.vcu; if (u >= BATCH * 4 * 32) return;
    In cur, nxt; int hprev = -1;
    dma_in<false>(F, u, 0, dvo); load_in<false>(F, u, cur);
    for (int it = 0; u < BATCH * 4 * 32; ++it, u += F.G) {
        int b, h, c; decode(u, b, h, c);
        const int un = u + F.G; const bool more = un < BATCH * 4 * 32;
        if (h != hprev) { stage_wl(F, h); hprev = h; }
        asm volatile("s_waitcnt vmcnt(0) lgkmcnt(0)" ::: "memory");
        __syncthreads();
        float gl[16], kf[8];
        unpack8(cur.g0, (float(&)[8])gl[0]); unpack8(cur.g1, (float(&)[8])gl[8]); unpack8(cur.kk, kf);
        asm volatile("" ::: "memory");
        if (more) { dma_in<false>(F, un, (it + 1) & 1, dvo); load_in<false>(F, un, nxt); }
        float bc[8], blast[8];
        gate_scan(F, h, gl, bc, blast);
        const int uid = u;
#pragma unroll
        for (int i = 0; i < 8; ++i) *(LAS bf16*)(F.lds + L_K + (8 * w + i) * KP + lane * 2) = (bf16)f2bf(kf[i] * __expf(blast[i] - bc[i]));
        if (lane == 0) {
#pragma unroll
            for (int i = 0; i < 8; ++i) DEC[(size_t)uid * 64 + 8 * w + i] = __expf(blast[i]); }
        asm volatile("s_waitcnt lgkmcnt(0)" ::: "memory");
        __syncthreads();
        const LAS unsigned char* vbuf = F.lds + L_V + (it & 1) * 16384;
        f32x16 acc;
#pragma unroll
        for (int r = 0; r < 16; ++r) acc[r] = 0.f;
#pragma unroll
        for (int kk = 0; kk < 4; ++kk) {
            const LAS unsigned char* kp = F.lds + L_K + (32 * dt + r32) * KP + (16 * kk + 4 * hi) * 2;
            const unsigned long long lo = *(const LAS unsigned long long*)kp, hh = *(const LAS unsigned long long*)(kp + 16);
            u32x4 bw; bw.x = (unsigned)lo; bw.y = (unsigned)(lo >> 32); bw.z = (unsigned)hh; bw.w = (unsigned)(hh >> 32);
            acc = __builtin_amdgcn_mfma_f32_32x32x16_bf16(att::v_frag_rt(vbuf, va_et, fo.vd, kk), __builtin_bit_cast(bf16x8, bw), acc, 0, 0, 0);
        }
        float* gu = GU + (size_t)uid * 8192;
#pragma unroll
        for (int r = 0; r < 16; ++r) gu[(32 * et + att::crow(r, hi)) * 64 + 32 * dt + r32] = acc[r];
        cur = nxt;
    }
    __syncthreads();
}
__device__ __forceinline__ void pass_b(Frame& F, float* GU, const float* DEC) {
    for (int idx = F.vcu * NTHR + F.tid; idx < 64 * 128 * 16; idx += F.G * NTHR) {
        const int bh = idx >> 11, e = (idx >> 4) & 127, dq = idx & 15;
        f32x4 S = (f32x4){0.f, 0.f, 0.f, 0.f};
        for (int c0 = 0; c0 < 32; c0 += 8) {
            f32x4 U[8], dec[8];
#pragma unroll
            for (int i = 0; i < 8; ++i) { const size_t uid = (size_t)bh * 32 + c0 + i; U[i] = *(const f32x4*)(GU + (uid * 128 + e) * 64 + 4 * dq); dec[i] = *(const f32x4*)(DEC + uid * 64 + 4 * dq); }
#pragma unroll
            for (int i = 0; i < 8; ++i) { const size_t uid = (size_t)bh * 32 + c0 + i; *(f32x4*)(GU + (uid * 128 + e) * 64 + 4 * dq) = S; S = dec[i] * S + U[i]; }
        }
    }
}
__device__ __forceinline__ void pass_c(Frame& F, const float* GU) {
    const int lane = F.lane, w = F.wave, hi = lane >> 5, r32 = lane & 31, tid = F.tid;
    LAS unsigned char* lds = F.lds;
    att::FragOff fo; att::frag_off_init(fo, lane);
    unsigned dvo[2]; att::dma_off_init(dvo, NAB, w, lane);
    const int et = w >> 1, tt = w & 1, tl = 32 * tt + r32, va_et = att::frag_va(lane, et);
    int u = F.vcu; if (u >= BATCH * 4 * 32) return;
    In cur, nxt; int hprev = -1;
    dma_in<true>(F, u, 0, dvo); load_in<true>(F, u, cur);
    for (int it = 0; u < BATCH * 4 * 32; ++it, u += F.G) {
        int b, h, c; decode(u, b, h, c);
        const int un = u + F.G; const bool more = un < BATCH * 4 * 32;
        if (h != hprev) { stage_wl(F, h); hprev = h; }
        asm volatile("s_waitcnt vmcnt(0) lgkmcnt(0)" ::: "memory");
        __syncthreads();
        float gl[16], kf[8], qf[8];
        unpack8(cur.g0, (float(&)[8])gl[0]); unpack8(cur.g1, (float(&)[8])gl[8]); unpack8(cur.kk, kf); unpack8(cur.qq, qf);
        asm volatile("" ::: "memory");
        if (more) { dma_in<true>(F, un, (it + 1) & 1, dvo); load_in<true>(F, un, nxt); }
        f32x4 sf[8];
        { const float* gs = GU + ((size_t)u * 128 + 32 * et + r32) * 64;
#pragma unroll
          for (int ks = 0; ks < 4; ++ks) { sf[2 * ks] = *(const f32x4*)(gs + 16 * ks + 8 * hi); sf[2 * ks + 1] = *(const f32x4*)(gs + 16 * ks + 8 * hi + 4); } }
        float bc[8], blast[8];
        gate_scan(F, h, gl, bc, blast);
        { float eq[8], ek[8];
#pragma unroll
          for (int i = 0; i < 8; ++i) { eq[i] = qf[i] * 0.125f * __expf(bc[i]); ek[i] = kf[i] * __expf(-bc[i]); }
          *(LAS bf16x8*)(lds + L_Q + lane * KP + 16 * w) = att::pack8(eq[0], eq[1], eq[2], eq[3], eq[4], eq[5], eq[6], eq[7]);
          *(LAS bf16x8*)(lds + L_K + lane * KP + 16 * w) = att::pack8(ek[0], ek[1], ek[2], ek[3], ek[4], ek[5], ek[6], ek[7]); }
        asm volatile("s_waitcnt lgkmcnt(0)" ::: "memory");
        __syncthreads();
        const LAS unsigned char* vbuf = lds + L_V + (it & 1) * 16384; const LAS unsigned char* ogbuf = lds + L_OG + (it & 1) * 16384;
        bf16x8 qfr[4];
#pragma unroll
        for (int ks = 0; ks < 4; ++ks) qfr[ks] = *(const LAS bf16x8*)(lds + L_Q + tl * KP + (16 * ks + 8 * hi) * 2);
        f32x16 p0, p1;
#pragma unroll
        for (int r = 0; r < 16; ++r) { p0[r] = 0.f; p1[r] = 0.f; }
#pragma unroll
        for (int ks = 0; ks < 4; ++ks) {
            const bf16x8 a0 = *(const LAS bf16x8*)(lds + L_K + r32 * KP + (16 * ks + 8 * hi) * 2), a1 = *(const LAS bf16x8*)(lds + L_K + (32 + r32) * KP + (16 * ks + 8 * hi) * 2);
            p0 = __builtin_amdgcn_mfma_f32_32x32x16_bf16(a0, qfr[ks], p0, 0, 0, 0); p1 = __builtin_amdgcn_mfma_f32_32x32x16_bf16(a1, qfr[ks], p1, 0, 0, 0);
        }
        { const int tl4 = tl - 4 * hi;
#pragma unroll
          for (int r = 0; r < 16; ++r) { const int s = (r & 3) + 8 * (r >> 2); if (s > tl4) p0[r] = 0.f; if (s + 32 > tl4) p1[r] = 0.f; } }
        const bf16x8 pa0 = att::pack8(p0[0], p0[1], p0[2], p0[3], p0[4], p0[5], p0[6], p0[7]), pa1 = att::pack8(p0[8], p0[9], p0[10], p0[11], p0[12], p0[13], p0[14], p0[15]);
        const bf16x8 pa2 = att::pack8(p1[0], p1[1], p1[2], p1[3], p1[4], p1[5], p1[6], p1[7]), pa3 = att::pack8(p1[8], p1[9], p1[10], p1[11], p1[12], p1[13], p1[14], p1[15]);
        f32x16 acc;
#pragma unroll
        for (int r = 0; r < 16; ++r) acc[r] = 0.f;
        acc = __builtin_amdgcn_mfma_f32_32x32x16_bf16(att::v_frag_rt(vbuf, va_et, fo.vd, 0), pa0, acc, 0, 0, 0);
        acc = __builtin_amdgcn_mfma_f32_32x32x16_bf16(att::v_frag_rt(vbuf, va_et, fo.vd, 1), pa1, acc, 0, 0, 0);
        acc = __builtin_amdgcn_mfma_f32_32x32x16_bf16(att::v_frag_rt(vbuf, va_et, fo.vd, 2), pa2, acc, 0, 0, 0);
        acc = __builtin_amdgcn_mfma_f32_32x32x16_bf16(att::v_frag_rt(vbuf, va_et, fo.vd, 3), pa3, acc, 0, 0, 0);
#pragma unroll
        for (int ks = 0; ks < 4; ++ks) { const f32x4 s0 = sf[2 * ks], s1 = sf[2 * ks + 1];
            acc = __builtin_amdgcn_mfma_f32_32x32x16_bf16(att::pack8(s0[0], s0[1], s0[2], s0[3], s1[0], s1[1], s1[2], s1[3]), qfr[ks], acc, 0, 0, 0); }
        float ss = 0.f;
#pragma unroll
        for (int r = 0; r < 16; ++r) ss = fmaf(acc[r], acc[r], ss);
        ss += __shfl_xor(ss, 32);
        LAS float* part = (LAS float*)(lds + L_PART);
        if (hi == 0) part[et * 64 + tl] = ss;
        asm volatile("s_waitcnt lgkmcnt(0)" ::: "memory");
        __syncthreads();
        const float rs = rsqrtf(((part[tl] + part[64 + tl]) + (part[128 + tl] + part[192 + tl])) * (1.0f / 128.0f) + EPS);
#pragma unroll
        for (int g = 0; g < 4; ++g) {
            const int e0 = 32 * et + 8 * g + 4 * hi;
            const unsigned long long ow = *(const LAS unsigned long long*)(ogbuf + att::img_off(tl, 4 * et + g) + 8 * hi);
            const f32x4 gg = *(const f32x4*)(F.g_gla + e0);
            float y[4];
#pragma unroll
            for (int i = 0; i < 4; ++i) { const float og = __uint_as_float(((unsigned)(ow >> (16 * i)) & 0xffffu) << 16); y[i] = acc[4 * g + i] * rs * gg[i] * (og * __builtin_amdgcn_rcpf(1.0f + __expf(-og))); }
            *(LAS unsigned long long*)(lds + L_STG + tl * SP + e0 * 2) = (unsigned long long)pg8::cvt_pk_bf16(y[0], y[1]) | ((unsigned long long)pg8::cvt_pk_bf16(y[2], y[3]) << 32);
        }
        asm volatile("s_waitcnt lgkmcnt(0)" ::: "memory");
        __syncthreads();
#pragma unroll
        for (int i = 0; i < 2; ++i) { const int cidx = tid + 512 * i, row = cidx >> 4, ch = cidx & 15;
            *(u32x4*)(F.CAT + (size_t)(b * SEQ + 64 * c + row) * D + 512 + h * 128 + ch * 8) = *(const LAS u32x4*)(lds + L_STG + row * SP + ch * 16); }
        cur = nxt;
    }
    __syncthreads();
}
}
__device__ __forceinline__ void ph_rope_tables(Frame& F, float* R128, float* R64) {
    for (int i = F.vcu * NTHR + F.tid; i < SEQ * 24; i += F.G * NTHR) {
        const int pos = i / 24, k = i % 24;
        if (k < 16) { const float inv = powf(500000.0f, -(float)k * 2.0f / 32.0f), ang = (float)pos * inv; R128[pos * 32 + k] = cosf(ang); R128[pos * 32 + 16 + k] = sinf(ang); }
        else { const int j = k - 16; const float inv = powf(500000.0f, -(float)j * 2.0f / 16.0f), ang = (float)pos * inv; R64[pos * 16 + j] = cosf(ang); R64[pos * 16 + 8 + j] = sinf(ang); }
    }
}
__device__ __forceinline__ float dpp_xor1(float v) { return __builtin_bit_cast(float, __builtin_amdgcn_mov_dpp(__builtin_bit_cast(int, v), 0xB1, 0xF, 0xF, true)); }
__device__ __forceinline__ float dpp_xor2(float v) { return __builtin_bit_cast(float, __builtin_amdgcn_mov_dpp(__builtin_bit_cast(int, v), 0x4E, 0xF, 0xF, true)); }
__device__ __forceinline__ void ph_prep_c_fast(Frame& F) {
    const int gw = F.vcu * NWAVES + F.wave, NGW = F.G * NWAVES, lane = F.lane;
    const float* gn = (lane < 32 ? F.gq_c : F.gk_c) + (lane & 3) * 32;
    const float sc = lane < 32 ? att::C2 : 1.0f;
    float g[32];
#pragma unroll
    for (int i = 0; i < 8; ++i) { const f32x4 v = *(const f32x4*)(gn + 4 * i); g[4 * i] = v[0] * sc; g[4 * i + 1] = v[1] * sc; g[4 * i + 2] = v[2] * sc; g[4 * i + 3] = v[3] * sc; }
    for (int tok = gw; tok < M; tok += NGW) {
        att::u32x4* p = (att::u32x4*)(F.R1 + (size_t)tok * NC + lane * 32);
        att::u32x4 v[4]; float f[32]; float ss = 0.f;
#pragma unroll
        for (int i = 0; i < 4; ++i) v[i] = p[i];
#pragma unroll
        for (int i = 0; i < 4; ++i)
#pragma unroll
            for (int j = 0; j < 4; ++j) { const float a = __uint_as_float(v[i][j] << 16), b = __uint_as_float(v[i][j] & 0xffff0000u); f[8 * i + 2 * j] = a; f[8 * i + 2 * j + 1] = b; ss = fmaf(a, a, fmaf(b, b, ss)); }
        ss += dpp_xor1(ss); ss += dpp_xor2(ss);
        const float rs = rsqrtf(ss * (1.f / 128.f) + EPS);
#pragma unroll
        for (int i = 0; i < 4; ++i) { att::u32x4 o;
#pragma unroll
            for (int j = 0; j < 4; ++j) o[j] = pg8::cvt_pk_bf16(f[8 * i + 2 * j] * rs * g[8 * i + 2 * j], f[8 * i + 2 * j + 1] * rs * g[8 * i + 2 * j + 1]);
            p[i] = o; }
    }
}
__device__ __forceinline__ void ph_prep_a_fast(Frame& F, const float* R128, const float* R64) {
    const int gw = F.vcu * NWAVES + F.wave, NGW = F.G * NWAVES, lane = F.lane, l8 = lane & 7;
    const float* gn = (lane < 32 ? F.gq_a : F.gk_a) + l8 * 16;
    const float sc = lane < 32 ? att::C2 : 1.0f;
    float g[16];
#pragma unroll
    for (int i = 0; i < 4; ++i) { const f32x4 v = *(const f32x4*)(gn + 4 * i); g[4 * i] = v[0] * sc; g[4 * i + 1] = v[1] * sc; g[4 * i + 2] = v[2] * sc; g[4 * i + 3] = v[3] * sc; }
    for (int tok = gw; tok < M; tok += NGW) {
        const int pos = tok & (SEQ - 1);
        bf16* pr = F.R1 + (size_t)tok * NAB;
        {   att::u32x4* p = (att::u32x4*)(pr + lane * 16);
            const att::u32x4 v0 = p[0], v1 = p[1]; float f[16]; float ss = 0.f;
#pragma unroll
            for (int j = 0; j < 4; ++j) { f[2 * j] = __uint_as_float(v0[j] << 16); f[2 * j + 1] = __uint_as_float(v0[j] & 0xffff0000u); f[8 + 2 * j] = __uint_as_float(v1[j] << 16); f[8 + 2 * j + 1] = __uint_as_float(v1[j] & 0xffff0000u); }
#pragma unroll
            for (int i = 0; i < 16; ++i) ss = fmaf(f[i], f[i], ss);
            ss += dpp_xor1(ss); ss += dpp_xor2(ss); ss += __shfl_xor(ss, 4);
            const float rs = rsqrtf(ss * (1.f / 128.f) + EPS);
#pragma unroll
            for (int i = 0; i < 16; ++i) f[i] = f[i] * rs * g[i];
            const float* cs = R128 + pos * 32;
#pragma unroll
            for (int i = 0; i < 16; ++i) { const float other = dpp_xor1(f[i]);
                if (l8 < 2) { const float c = cs[i], s = cs[16 + i]; f[i] = (l8 == 0) ? f[i] * c - other * s : f[i] * c + other * s; } }
            att::u32x4 o0, o1;
#pragma unroll
            for (int j = 0; j < 4; ++j) { o0[j] = pg8::cvt_pk_bf16(f[2 * j], f[2 * j + 1]); o1[j] = pg8::cvt_pk_bf16(f[8 + 2 * j], f[8 + 2 * j + 1]); }
            p[0] = o0; p[1] = o1;
        }
        {
#pragma unroll
            for (int part = 0; part < 2; ++part) {
                if (part == 1 && lane >= 8) break;
                att::u32x4* p = (att::u32x4*)(pr + (part == 0 ? C_IQ + lane * 8 : C_IK + lane * 8));
                const att::u32x4 v0 = p[0]; float f[8];
#pragma unroll
                for (int j = 0; j < 4; ++j) { f[2 * j] = __uint_as_float(v0[j] << 16); f[2 * j + 1] = __uint_as_float(v0[j] & 0xffff0000u); }
                const float* cs = R64 + pos * 16;
#pragma unroll
                for (int i = 0; i < 8; ++i) { const float other = dpp_xor1(f[i]);
                    if (l8 < 2) { const float c = cs[i], s = cs[8 + i]; f[i] = (l8 == 0) ? f[i] * c - other * s : f[i] * c + other * s; } }
                att::u32x4 o0;
#pragma unroll
                for (int j = 0; j < 4; ++j) o0[j] = pg8::cvt_pk_bf16(f[2 * j], f[2 * j + 1]);
                p[0] = o0;
            }
        }
    }
}
#ifndef MK_PER_PHASE
#define MK_PER_PHASE 0
#endif
constexpr int NPH = 14;
struct Args { const float* in[16]; float* out; unsigned char* ws; int ph_lo, ph_hi; };
__global__ void __launch_bounds__(NTHR, 2) mk_fwd(Args args) {
    extern __shared__ __attribute__((aligned(16))) unsigned char lds[];
    Frame F;
    F.lds = (LAS unsigned char*)lds;
    F.MISC = (volatile LAS unsigned*)(F.lds + MISC_OFF);
    F.wave = __builtin_amdgcn_readfirstlane((int)threadIdx.x >> 6);
#define RELANE() (F.lane = lane_id_opaque(), F.tid = F.wave * 64 + F.lane, true)
    RELANE();
#ifdef PROBE_ACC
    F.acc_t0 = 0ull; F.acc_sum = 0ull;
#endif
    F.G = gridDim.x; { const int bx = blockIdx.x; F.vcu = (F.G % 8 == 0) ? (bx % 8) * (F.G / 8) + bx / 8 : bx; }
    unsigned char* ws = args.ws;
    F.ctl = (gu32*)(ws + WS_CTL);
    F.x = args.in[0]; F.g_mix = args.in[1]; F.g_ffn = args.in[2]; F.w_in_ab = args.in[3]; F.gq_a = args.in[4]; F.gk_a = args.in[5]; F.w_gate_up = args.in[6]; F.b_gate = args.in[7];
    F.g_gla = args.in[8]; F.w_out_ab = args.in[9]; F.w_in_c = args.in[10]; F.gq_c = args.in[11]; F.gk_c = args.in[12]; F.w_out_c = args.in[13]; F.w_up = args.in[14]; F.w_down = args.in[15];
    F.out = args.out;
    F.Wab = (bf16*)(ws + WS_WAB); F.Woab = (bf16*)(ws + WS_WOAB); F.Wup0 = (bf16*)(ws + WS_WUP0); F.Wdn0 = (bf16*)(ws + WS_WDN0);
    F.Winc = (bf16*)(ws + WS_WINC); F.Woc = (bf16*)(ws + WS_WOC); F.Wup1 = (bf16*)(ws + WS_WUP1); F.Wdn1 = (bf16*)(ws + WS_WDN1);
    F.XB = (bf16*)(ws + WS_XB); F.CAT = (bf16*)(ws + WS_CAT); F.R1 = (bf16*)(ws + WS_R1); F.SSQ = (float*)(ws + WS_SSQ); F.MASK = (unsigned*)(ws + WS_MASK);
    for (int u = F.tid; u < (LDS_BYTES - MISC_OFF) / 4; u += NTHR) ((LAS unsigned*)(F.lds + MISC_OFF))[u] = 0u;
    __syncthreads();
    XcdBarrier bar; bar.bar = (unsigned*)(F.ctl + CW_BAR); bar.x = 0; bar.st = nullptr; bar.wave = F.wave;
    if (!MK_PER_PHASE) bar = xcd_barrier_post((unsigned*)(F.ctl + CW_BAR), F.MISC + 8, F.wave);
    const int lo = args.ph_lo, hi = args.ph_hi;
#ifdef PROBE_PH
    unsigned long long pt0 = 0ull, pt1 = 0ull;
#define STAMP(k) do { if ((k) == PROBE_PH) pt0 = __builtin_amdgcn_s_memrealtime(); if ((k) == PROBE_PH + 1) pt1 = __builtin_amdgcn_s_memrealtime(); } while (0)
#ifdef PROBE_SUB
#define SUBSTAMP(k) do { if ((k) == PROBE_PH) { __syncthreads(); pt0 = __builtin_amdgcn_s_memrealtime(); } } while (0)
#else
#define SUBSTAMP(k) do { } while (0)
#endif
#else
#define STAMP(k) do { } while (0)
#define SUBSTAMP(k) do { } while (0)
#endif
#define IN(k) (lo <= (k) && (k) < hi && RELANE())
#define SEAM(k) do { if (lo <= (k) && (k) + 1 < hi) xcd_barrier(bar); } while (0)
    float* const SSQ0 = F.SSQ, *SSQ1 = F.SSQ + (size_t)M * 16, *SSQ2 = F.SSQ + (size_t)2 * M * 16, *SSQ3 = F.SSQ + (size_t)3 * M * 16;
    typedef pg8::StaticOrder SO;
    STAMP(0); float* const R128 = (float*)(ws + WS_ROPE); float* const R64 = R128 + SEQ * 32;
    if (IN(0)) { ph_prologue(F); ph_rope_tables(F, R128, R64); } SEAM(0);
    STAMP(1); if (IN(1)) { pg8::Gemm g{F.XB, F.Wab, M, NAB, D}; SO S; S.init(M, NAB, F.G, (int)blockIdx.x); pg8::EpiScale<0> E{F.R1, NAB, SSQ0};
        pg8::gemm_phase<pg8::EpiScale<0>, SO, true, true>(F.lds, g, S, E, F.wave); } SEAM(1);
    float* const GU = (float*)(ws + WS_XB); float* const DEC = (float*)(ws + WS_DEC);
    STAMP(2); if (IN(2)) { ph_prep_a_fast(F, R128, R64); SUBSTAMP(2); gla::pass_a(F, GU, DEC); } SEAM(2);
    STAMP(3); if (IN(3)) { gla::pass_b(F, GU, DEC); SUBSTAMP(3); ph_indexer(F); } SEAM(3);
    STAMP(4); if (IN(4)) { ph_dsa(F); SUBSTAMP(4); gla::pass_c(F, GU); } SEAM(4);
    STAMP(5); if (IN(5)) { pg8::Gemm g{F.CAT, F.Woab, M, D, D}; SO S; S.init(M, D, F.G, (int)blockIdx.x); pg8::EpiResid<0, 0> E{F.x, nullptr, F.XB, SSQ1};
        pg8::gemm_phase<pg8::EpiResid<0, 0>, SO, true, true>(F.lds, g, S, E, F.wave); } SEAM(5);
    STAMP(6); if (IN(6)) { pg8::Gemm g{F.XB, F.Wup0, M, FF, D}; SO S; S.init(M, FF, F.G, (int)blockIdx.x); pg8::EpiScale<1> E{F.R1, FF, SSQ1};
        pg8::gemm_phase<pg8::EpiScale<1>, SO, true, true>(F.lds, g, S, E, F.wave); } SEAM(6);
    STAMP(7); if (IN(7)) { pg8::Gemm g{F.R1, F.Wdn0, M, D, FF}; SO S; S.init(M, D, F.G, (int)blockIdx.x); pg8::EpiResid<1, 0> E{F.XB, nullptr, F.XB, SSQ2};
        pg8::gemm_phase<pg8::EpiResid<1, 0>, SO, true, true>(F.lds, g, S, E, F.wave); } SEAM(7);
    STAMP(8); if (IN(8)) { pg8::Gemm g{F.XB, F.Winc, M, NC, D}; SO S; S.init(M, NC, F.G, (int)blockIdx.x); pg8::EpiScale<0> E{F.R1, NC, SSQ2};
        pg8::gemm_phase<pg8::EpiScale<0>, SO, true, true>(F.lds, g, S, E, F.wave); } SEAM(8);
    STAMP(9); if (IN(9)) { ph_prep_c_fast(F); } SEAM(9);
    STAMP(10); if (IN(10)) { ph_sb(F); } SEAM(10);
    STAMP(11); if (IN(11)) { pg8::Gemm g{F.CAT, F.Woc, M, D, D}; SO S; S.init(M, D, F.G, (int)blockIdx.x); pg8::EpiResid<1, 0> E{F.XB, nullptr, F.XB, SSQ3};
        pg8::gemm_phase<pg8::EpiResid<1, 0>, SO, true, true>(F.lds, g, S, E, F.wave); } SEAM(11);
    STAMP(12); if (IN(12)) { pg8::Gemm g{F.XB, F.Wup1, M, FF, D}; SO S; S.init(M, FF, F.G, (int)blockIdx.x); pg8::EpiScale<1> E{F.R1, FF, SSQ3};
        pg8::gemm_phase<pg8::EpiScale<1>, SO, true, true>(F.lds, g, S, E, F.wave); } SEAM(12);
    STAMP(13); if (IN(13)) { pg8::Gemm g{F.R1, F.Wdn1, M, D, FF}; SO S; S.init(M, D, F.G, (int)blockIdx.x); pg8::EpiResid<1, 1> E{F.XB, F.out, nullptr, nullptr};
        pg8::gemm_phase<pg8::EpiResid<1, 1>, SO, true, true>(F.lds, g, S, E, F.wave); }
    STAMP(NPH);
#ifdef PROBE_ACC
    if (blockIdx.x == 0) { const unsigned long long t1 = __builtin_amdgcn_s_memrealtime(), dt = F.acc_sum * PROBE_MULT; while (__builtin_amdgcn_s_memrealtime() - t1 < dt) __builtin_amdgcn_s_sleep(8); }
#endif
#ifdef PROBE_PH
    if (blockIdx.x == 0) { const unsigned long long t1 = __builtin_amdgcn_s_memrealtime(), dt = (pt1 - pt0) * PROBE_MULT; while (__builtin_amdgcn_s_memrealtime() - t1 < dt) __builtin_amdgcn_s_sleep(8); }
#endif
#undef IN
#undef SEAM
}

extern "C" void kernel_launch(void* const* d_in, const int* in_sizes, int n_in, void* d_out, int out_size, void* d_ws, size_t ws_size, hipStream_t stream) {
    static int grid = 0;
    if (grid == 0) {
        if (n_in != 16 || in_sizes[0] != M * D || out_size != M * D || ws_size < WS_END) { fprintf(stderr, "kernel_launch: unexpected shapes / workspace (%d inputs, ws %zu)\n", n_in, ws_size); grid = -1; return; }
        int dev = 0, cus = 0;
        if (hipGetDevice(&dev) != hipSuccess || hipDeviceGetAttribute(&cus, hipDeviceAttributeMultiprocessorCount, dev) != hipSuccess) { grid = -1; return; }
        if (hipFuncSetAttribute((const void*)mk_fwd, hipFuncAttributeMaxDynamicSharedMemorySize, LDS_BYTES) != hipSuccess) { fprintf(stderr, "kernel_launch: hipFuncSetAttribute failed\n"); grid = -1; return; }
        (void)hipGetLastError();
        grid = cus;
    }
    if (grid < 0) return;
    if (hipMemsetAsync((char*)d_ws + WS_CTL, 0, CTL_ZERO_BYTES, stream) != hipSuccess) { fprintf(stderr, "kernel_launch: memset failed\n"); return; }
    Args a{};
    for (int i = 0; i < 16; ++i) a.in[i] = (const float*)d_in[i];
    a.out = (float*)d_out; a.ws = (unsigned char*)d_ws;
#if MK_PER_PHASE
    for (int ph = 0; ph < NPH; ++ph) { a.ph_lo = ph; a.ph_hi = ph + 1; hipLaunchKernelGGL(mk_fwd, dim3(grid), dim3(NTHR), LDS_BYTES, stream, a); }
#else
    a.ph_lo = 0; a.ph_hi = NPH;
    hipLaunchKernelGGL(mk_fwd, dim3(grid), dim3(NTHR), LDS_BYTES, stream, a);
#endif
    const hipError_t le = hipPeekAtLastError();
    if (le != hipSuccess) fprintf(stderr, "kernel_launch: launch failed: %s\n", hipGetErrorName(le));
}
```

```cpp
#include <hip/hip_runtime.h>
#include <cstdio>
#include <cstdint>
namespace pg8 {
#define PG8_LAS __attribute__((address_space(3)))
typedef unsigned short bf16_t;
typedef short bf16x8 __attribute__((ext_vector_type(8)));
typedef float f32x4 __attribute__((ext_vector_type(4)));
typedef unsigned u32x4 __attribute__((ext_vector_type(4)));
constexpr int BM = 256, BK = 64, HALF = 128, HTB = HALF * BK * 2  , STAGE_BYTES = 8 * HTB, NXCD = 8, WGM = 8;

__host__ __device__ __forceinline__ int lds_byte(int r, int c) { const int st = (r >> 4) * 2 + (c >> 5), rr = r & 15, cc = c & 31, ob = rr * 64 + cc * 2; return st * 1024 + (ob ^ (((ob >> 9) & 1) << 5)); }
__host__ __device__ __forceinline__ void stage_rc(int b, int& R, int& C) { const int st = b / 1024, sb = b % 1024, swz = sb ^ (((sb >> 9) & 1) << 5); R = (st >> 1) * 16 + swz / 64; C = (st & 1) * 32 + (swz % 64) / 2; }
__host__ __device__ __forceinline__ int perm32(int rho) { const int n = rho >> 4, i = rho & 15; return 8 * (i >> 2) + 4 * n + (i & 3); }

struct Unit { int pm, pn; };
struct Gemm { const bf16_t* A; const bf16_t* Bt; int M, N, K; };

struct StaticOrder {
    int nM, nN, nwg, G, c;
    __host__ __device__ void init(int M, int N, int G_, int c_) { nM = M / BM; nN = N / BM; nwg = nM * nN; G = G_; c = c_; }
    __host__ __device__ bool next(int i, Unit& u) const {
        const long L = (long)i * G + c; if (L >= nwg) return false;
        int wgid = (int)L; { const int q = nwg / NXCD, r = nwg % NXCD, xcd = wgid % NXCD, off = wgid / NXCD; wgid = (xcd < r ? xcd * (q + 1) : r * (q + 1) + (xcd - r) * q) + off; }
        const int nig = WGM * nN, gid = wgid / nig, fm = gid * WGM, gsz = (nM - fm) < WGM ? (nM - fm) : WGM;
        u.pm = fm + ((wgid % nig) % gsz); u.pn = (wgid % nig) / gsz; return true;
    }
    __device__ __forceinline__ void a_ready(const Unit&) const {}
    __device__ __forceinline__ void done(const Unit&) const {}
};

__device__ __forceinline__ unsigned cvt_pk_bf16(float lo, float hi) { unsigned r; asm volatile("v_cvt_pk_bf16_f32 %0, %1, %2" : "=v"(r) : "v"(lo), "v"(hi)); return r; }
__device__ __forceinline__ float row_rstd(const float* ssqp, int row) {
    const f32x4* p = (const f32x4*)(ssqp + (size_t)row * 16);
    const f32x4 a = p[0], b = p[1], c = p[2], d = p[3];
    const float s = (((a[0] + a[1]) + (a[2] + a[3])) + ((b[0] + b[1]) + (b[2] + b[3]))) + (((c[0] + c[1]) + (c[2] + c[3])) + ((d[0] + d[1]) + (d[2] + d[3])));
    return rsqrtf(s * (1.0f / 1024.0f) + 1e-6f);
}
template <int ACT  > struct EpiScale {
    static constexpr bool PERM = true, AFTER_DRAIN = false;
    bf16_t* O; int ldc; const float* ssqp;
    __device__ __forceinline__ void operator()(const f32x4 (&acc)[2][2][4][2], const Unit& u, int wr, int wc, int fr, int fq) const {
        const int row0 = u.pm * BM + wr * 64 + fr, col0 = u.pn * BM + wc * 32 + 8 * fq;
#pragma unroll
        for (int ai = 0; ai < 2; ++ai)
#pragma unroll
            for (int m = 0; m < 4; ++m) {
                const int row = row0 + ai * HALF + m * 16;
                const float rs = (ACT == 0) ? row_rstd(ssqp, row) : 1.0f;
                bf16_t* rowp = O + (size_t)row * ldc + col0;
#pragma unroll
                for (int bj = 0; bj < 2; ++bj) {
                    f32x4 v0 = acc[ai][bj][m][0] * rs, v1 = acc[ai][bj][m][1] * rs;
                    if (ACT == 1) {
#pragma unroll
                        for (int e = 0; e < 4; ++e) { const float a0 = fmaxf(v0[e], 0.f), a1 = fmaxf(v1[e], 0.f); v0[e] = a0 * a0; v1[e] = a1 * a1; }
                    }
                    u32x4 w; w.x = cvt_pk_bf16(v0[0], v0[1]); w.y = cvt_pk_bf16(v0[2], v0[3]); w.z = cvt_pk_bf16(v1[0], v1[1]); w.w = cvt_pk_bf16(v1[2], v1[3]);
                    *(u32x4*)(rowp + bj * HALF) = w;
                }
            }
    }
};
template <int RIN, int OUT> struct EpiResid {
    static constexpr bool PERM = true, AFTER_DRAIN = false;
    const void* R; float* out; bf16_t* hb; float* ssqp; const float* ssq_in;
    __device__ __forceinline__ void operator()(const f32x4 (&acc)[2][2][4][2], const Unit& u, int wr, int wc, int fr, int fq) const {
        const int row0 = u.pm * BM + wr * 64 + fr, col0 = u.pn * BM + wc * 32 + 8 * fq;
#pragma unroll
        for (int ai = 0; ai < 2; ++ai)
#pragma unroll
            for (int m = 0; m < 4; ++m) {
                const int row = row0 + ai * HALF + m * 16;
                const size_t off = (size_t)row * 1024 + col0;
                float sc2 = 1.0f; if (ssq_in) { const float rs = row_rstd(ssq_in, row); sc2 = rs * rs; }
                float ss = 0.f;
#pragma unroll
                for (int bj = 0; bj < 2; ++bj) {
                    f32x4 r0, r1;
                    if (RIN == 0) { r0 = *(const f32x4*)((const float*)R + off + bj * HALF); r1 = *(const f32x4*)((const float*)R + off + bj * HALF + 4); }
                    else { const u32x4 rw = *(const u32x4*)((const bf16_t*)R + off + bj * HALF);
                        r0 = (f32x4){__uint_as_float(rw.x << 16), __uint_as_float(rw.x & 0xffff0000u), __uint_as_float(rw.y << 16), __uint_as_float(rw.y & 0xffff0000u)};
                        r1 = (f32x4){__uint_as_float(rw.z << 16), __uint_as_float(rw.z & 0xffff0000u), __uint_as_float(rw.w << 16), __uint_as_float(rw.w & 0xffff0000u)}; }
                    const f32x4 v0 = acc[ai][bj][m][0] * sc2 + r0, v1 = acc[ai][bj][m][1] * sc2 + r1;
                    if (OUT == 1) { *(f32x4*)(out + off + bj * HALF) = v0; *(f32x4*)(out + off + bj * HALF + 4) = v1; }
                    else {
                        u32x4 w; w.x = cvt_pk_bf16(v0[0], v0[1]); w.y = cvt_pk_bf16(v0[2], v0[3]); w.z = cvt_pk_bf16(v1[0], v1[1]); w.w = cvt_pk_bf16(v1[2], v1[3]);
                        *(u32x4*)(hb + off + bj * HALF) = w;
                        ss += ((v0[0] * v0[0] + v0[1] * v0[1]) + (v0[2] * v0[2] + v0[3] * v0[3])) + ((v1[0] * v1[0] + v1[1] * v1[1]) + (v1[2] * v1[2] + v1[3] * v1[3]));
                    }
                }
                if (OUT == 0) { ss += __shfl_xor(ss, 16); ss += __shfl_xor(ss, 32); if (fq == 0) ssqp[(size_t)row * 16 + u.pn * 4 + wc] = ss; }
            }
    }
};
template <class Epi, class Sched, bool ALIGN_EPI = false, bool SP2 = false>
__device__ __forceinline__ void gemm_phase(PG8_LAS unsigned char* lds, const Gemm g, const Sched& S, const Epi& E, const int wave_in) {
    const int wid = wave_in, lane = (int)__builtin_amdgcn_mbcnt_hi(~0u, __builtin_amdgcn_mbcnt_lo(~0u, 0u)), tid = wid * 64 + lane, wr = wid >> 2, wc = wid & 3, fr = lane & 15, fq = lane >> 4;
    const int K = g.K, nt = K / BK;
    unsigned voffA[2], voffB[2];
#pragma unroll
    for (int i = 0; i < 2; ++i) { int R, C; stage_rc(tid * 16 + i * 8192, R, C); const int Rb = Epi::PERM ? ((R & ~31) + perm32(R & 31)) : R;
        voffA[i] = (unsigned)(R * K + C) * 2u; voffB[i] = (unsigned)(Rb * K + C) * 2u; }
    const size_t kstep = (size_t)(BK * 2);
    const size_t hstep = (size_t)HALF * K * 2;
    const size_t tstep = 2 * hstep;
    const unsigned ldsw = (unsigned)wid * 1024u;
    const int aoff = lds_byte(wr * 64 + fr, fq * 8), boff = lds_byte(wc * 32 + fr, fq * 8);
#define PG8_SA(b, h) (((b) * 2 + (h)) * HTB)
#define PG8_SB(b, h) ((4 + (b) * 2 + (h)) * HTB)
#define PG8_STAGE(bufoff, gbase, voff) do { _Pragma("unroll") for (int _i = 0; _i < 2; ++_i) \
        __builtin_amdgcn_global_load_lds((const unsigned*)((const char*)(gbase) + (voff)[_i]), (PG8_LAS unsigned*)(lds + (bufoff) + ldsw + _i * 8192), 16, 0, 0); } while (0)
#define PG8_LDA(dst, b, h) do { _Pragma("unroll") for (int m = 0; m < 4; ++m) _Pragma("unroll") for (int k = 0; k < 2; ++k) dst[m][k] = *(const PG8_LAS bf16x8*)(lds + PG8_SA(b, h) + aoff + m * 2048 + k * 1024); } while (0)
#define PG8_LDB(dst, b, h) do { _Pragma("unroll") for (int n = 0; n < 2; ++n) _Pragma("unroll") for (int k = 0; k < 2; ++k) dst[n][k] = *(const PG8_LAS bf16x8*)(lds + PG8_SB(b, h) + boff + n * 2048 + k * 1024); } while (0)
#define PG8_MMA(ai, bj, At, Bt) do { __builtin_amdgcn_s_setprio(1); _Pragma("unroll") for (int m = 0; m < 4; ++m) _Pragma("unroll") for (int n = 0; n < 2; ++n) _Pragma("unroll") for (int k = 0; k < 2; ++k) \
        acc[ai][bj][m][n] = __builtin_amdgcn_mfma_f32_16x16x32_bf16(Bt[n][k], At[m][k], acc[ai][bj][m][n], 0, 0, 0); __builtin_amdgcn_s_setprio(0); } while (0)
#define PG8_WAIT_V(n) asm volatile("s_waitcnt vmcnt(" #n ")" ::: "memory")
#define PG8_WAIT_L(n) asm volatile("s_waitcnt lgkmcnt(" #n ")" ::: "memory")
#define PG8_BAR __builtin_amdgcn_s_barrier()
#define PG8_SCHED __builtin_amdgcn_sched_barrier(0)
    Unit cur, nxt; int ui = 0;
    if (!S.next(0, cur)) return;
    f32x4 acc[2][2][4][2];
#pragma unroll
    for (int a = 0; a < 2; ++a)
#pragma unroll
        for (int b = 0; b < 2; ++b)
#pragma unroll
            for (int m = 0; m < 4; ++m)
#pragma unroll
                for (int n = 0; n < 2; ++n) acc[a][b][m][n] = (f32x4){0.f, 0.f, 0.f, 0.f};
    bf16x8 At[4][2], B0[2][2], B1[2][2];
    const char* cA = (const char*)g.A + (size_t)cur.pm * tstep; const char* cB = (const char*)g.Bt + (size_t)cur.pn * tstep;
    S.a_ready(cur);
    if constexpr (SP2) {
        PG8_STAGE(PG8_SB(0, 0), cB, voffB); PG8_STAGE(PG8_SB(0, 1), cB + hstep, voffB); PG8_STAGE(PG8_SA(0, 0), cA, voffA); PG8_STAGE(PG8_SA(0, 1), cA + hstep, voffA);
        if (wr == 1) PG8_BAR;
        PG8_WAIT_V(2); PG8_BAR;
        PG8_STAGE(PG8_SB(1, 0), cB + kstep, voffB); PG8_STAGE(PG8_SA(1, 0), cA + kstep, voffA); PG8_STAGE(PG8_SB(1, 1), cB + hstep + kstep, voffB);
        PG8_WAIT_V(6); PG8_BAR;
    } else {
        PG8_STAGE(PG8_SB(0, 0), cB, voffB); PG8_STAGE(PG8_SA(0, 0), cA, voffA); PG8_STAGE(PG8_SB(0, 1), cB + hstep, voffB); PG8_STAGE(PG8_SA(0, 1), cA + hstep, voffA);
        if (wr == 1) PG8_BAR;
        PG8_WAIT_V(4); PG8_BAR;
        PG8_STAGE(PG8_SB(1, 0), cB + kstep, voffB); PG8_STAGE(PG8_SA(1, 0), cA + kstep, voffA); PG8_STAGE(PG8_SB(1, 1), cB + hstep + kstep, voffB);
        PG8_WAIT_V(6); PG8_BAR;
    }
    for (;;) {
        const bool has_next = S.next(ui + 1, nxt);
        const char* nA = has_next ? (const char*)g.A + (size_t)nxt.pm * tstep : cA; const char* nB = has_next ? (const char*)g.Bt + (size_t)nxt.pn * tstep : cB;
        for (int t = 0; t < nt; t += 2) {
            const bool last = (t == nt - 2);
            const char* a1 = cA + (size_t)(t + 1) * kstep;
            const char* a2 = last ? nA : cA + (size_t)(t + 2) * kstep; const char* b2 = last ? nB : cB + (size_t)(t + 2) * kstep;
            const char* a3 = a2 + kstep; const char* b3 = b2 + kstep;
            if (last && has_next) S.a_ready(nxt);
            if constexpr (SP2) {
            PG8_LDB(B0, 0, 0); PG8_LDB(B1, 0, 1); PG8_SCHED; PG8_LDA(At, 0, 0); PG8_STAGE(PG8_SA(1, 1), a1 + hstep, voffA);
            PG8_WAIT_V(8); PG8_WAIT_L(0); PG8_BAR; PG8_MMA(0, 0, At, B0); PG8_MMA(0, 1, At, B1); PG8_BAR; PG8_SCHED;
            PG8_LDA(At, 0, 1); PG8_STAGE(PG8_SB(0, 0), b2, voffB); PG8_STAGE(PG8_SB(0, 1), b2 + hstep, voffB); PG8_STAGE(PG8_SA(0, 0), a2, voffA);
            PG8_WAIT_V(8); PG8_WAIT_L(0); PG8_BAR; PG8_MMA(1, 0, At, B0); PG8_MMA(1, 1, At, B1); PG8_BAR; PG8_SCHED;
            PG8_LDB(B0, 1, 0); PG8_LDB(B1, 1, 1); PG8_SCHED; PG8_LDA(At, 1, 0); PG8_STAGE(PG8_SA(0, 1), a2 + hstep, voffA);
            PG8_WAIT_V(8); PG8_WAIT_L(0); PG8_BAR; PG8_MMA(0, 0, At, B0); PG8_MMA(0, 1, At, B1); PG8_BAR; PG8_SCHED;
            PG8_LDA(At, 1, 1); PG8_STAGE(PG8_SB(1, 0), b3, voffB); PG8_STAGE(PG8_SB(1, 1), b3 + hstep, voffB); PG8_STAGE(PG8_SA(1, 0), a3, voffA);
            PG8_WAIT_V(8); PG8_WAIT_L(0); PG8_BAR; PG8_MMA(1, 0, At, B0); PG8_MMA(1, 1, At, B1); PG8_BAR; PG8_SCHED;
            } else {
            PG8_LDB(B0, 0, 0); PG8_SCHED; PG8_LDA(At, 0, 0); PG8_STAGE(PG8_SA(1, 1), a1 + hstep, voffA);
            PG8_WAIT_L(8); PG8_BAR; PG8_WAIT_L(0); PG8_MMA(0, 0, At, B0); PG8_BAR; PG8_SCHED;
            PG8_LDB(B1, 0, 1); PG8_STAGE(PG8_SB(0, 0), b2, voffB);
            PG8_BAR; PG8_WAIT_L(0); PG8_MMA(0, 1, At, B1); PG8_BAR;
            PG8_LDA(At, 0, 1); PG8_STAGE(PG8_SA(0, 0), a2, voffA);
            PG8_BAR; PG8_WAIT_L(0); PG8_MMA(1, 0, At, B0); PG8_BAR; PG8_SCHED;
            PG8_STAGE(PG8_SB(0, 1), b2 + hstep, voffB);
            PG8_WAIT_V(6); PG8_BAR; PG8_MMA(1, 1, At, B1); PG8_BAR;
            PG8_LDB(B0, 1, 0); PG8_SCHED; PG8_LDA(At, 1, 0); PG8_STAGE(PG8_SA(0, 1), a2 + hstep, voffA);
            PG8_WAIT_L(8); PG8_BAR; PG8_WAIT_L(0); PG8_MMA(0, 0, At, B0); PG8_BAR; PG8_SCHED;
            PG8_LDB(B1, 1, 1); PG8_STAGE(PG8_SB(1, 0), b3, voffB);
            PG8_BAR; PG8_WAIT_L(0); PG8_MMA(0, 1, At, B1); PG8_BAR;
            PG8_LDA(At, 1, 1); PG8_STAGE(PG8_SA(1, 0), a3, voffA);
            PG8_BAR; PG8_WAIT_L(0); PG8_MMA(1, 0, At, B0); PG8_BAR; PG8_SCHED;
            PG8_STAGE(PG8_SB(1, 1), b3 + hstep, voffB);
            PG8_WAIT_V(6); PG8_BAR; PG8_MMA(1, 1, At, B1); PG8_BAR;
            }
        }
        if constexpr (ALIGN_EPI) { if (wr == 0) PG8_BAR; }
        if constexpr (!Epi::AFTER_DRAIN) { E(acc, cur, wr, wc, fr, fq); S.done(cur); }
        if (!has_next) break;
#pragma unroll
        for (int a = 0; a < 2; ++a)
#pragma unroll
            for (int b = 0; b < 2; ++b)
#pragma unroll
                for (int m = 0; m < 4; ++m)
#pragma unroll
                    for (int n = 0; n < 2; ++n) acc[a][b][m][n] = (f32x4){0.f, 0.f, 0.f, 0.f};
        cur = nxt; cA = nA; cB = nB; ++ui;
        if constexpr (ALIGN_EPI) { if (wr == 1) PG8_BAR; }
    }
    PG8_WAIT_V(0);
    if constexpr (!ALIGN_EPI) { if (wr == 0) PG8_BAR; }
    PG8_BAR;
    if constexpr (Epi::AFTER_DRAIN) { E.fused(acc, cur, wr, wc, fr, fq, lds, wid, lane); S.done(cur); }
#undef PG8_SA
#undef PG8_SB
#undef PG8_STAGE
#undef PG8_LDA
#undef PG8_LDB
#undef PG8_MMA
#undef PG8_WAIT_V
#undef PG8_WAIT_L
#undef PG8_BAR
#undef PG8_SCHED
}
}
#include <cmath>
constexpr int NWAVES = 8, NTHR = 512;
constexpr int BATCH = 16, SEQ = 2048, M = BATCH * SEQ, D = 1024, FF = 4096, NAB = 3840, NC = 3072, ABP_OLD = 3672;
constexpr int C_QA = 0, C_KA = 512, C_VA = 1024, C_IQ = 1536, C_QB = 2048, C_KB = 2304, C_VB = 2560, C_OG = 3072, C_IK = 3584, C_IW = 3648, C_GL = 3656;
constexpr float EPS = 1e-6f;
constexpr size_t MiB = 1u << 20;
constexpr size_t WS_CTL = 0, CTL_ZERO_BYTES = 64 * 1024;
constexpr size_t WS_WAB = 1 * MiB, WS_WOAB = 9 * MiB, WS_WUP0 = 11 * MiB, WS_WDN0 = 19 * MiB, WS_WINC = 27 * MiB, WS_WOC = 33 * MiB, WS_WUP1 = 35 * MiB, WS_WDN1 = 43 * MiB;
constexpr size_t WS_SSQ = 51 * MiB, SSQ_BYTES = 2 * MiB;
constexpr size_t WS_DEC = 59 * MiB;
constexpr size_t WS_ROPE = 59 * MiB + 512 * 1024;
constexpr size_t WS_XB = 60 * MiB;
constexpr size_t WS_CAT = 124 * MiB;
constexpr size_t WS_MASK = 188 * MiB;
constexpr size_t WS_R1 = 196 * MiB;
constexpr size_t WS_BC = 452 * MiB;
constexpr size_t WS_END = 484 * MiB;
constexpr int CW_BAR = 4096;
constexpr int RING_BYTES = 131072;
constexpr int LDS_BYTES = 163840;
constexpr int MISC_OFF = LDS_BYTES - 256;
#define GAS __attribute__((address_space(1)))
#define LAS __attribute__((address_space(3)))
typedef unsigned short bf16;
typedef unsigned v4u __attribute__((ext_vector_type(4)));
typedef float f32x4 __attribute__((ext_vector_type(4)));
typedef short bf16x8 __attribute__((ext_vector_type(8)));
typedef GAS unsigned gu32;
typedef GAS unsigned long long gu64;
#define RLX_AGENT __ATOMIC_RELAXED, __HIP_MEMORY_SCOPE_AGENT
#define LDS_WAIT() asm volatile("s_waitcnt lgkmcnt(0)" ::: "memory")
#define VM_WAIT() asm volatile("s_waitcnt vmcnt(0)" ::: "memory")
__device__ __forceinline__ unsigned long long rt() { return __builtin_amdgcn_s_memrealtime(); }
__device__ __forceinline__ unsigned f2bf(float f) { unsigned u = __builtin_bit_cast(unsigned, f); return (u + 0x7fffu + ((u >> 16) & 1u)) >> 16; }
__device__ __forceinline__ unsigned pk2(float lo, float hi) { return f2bf(lo) | (f2bf(hi) << 16); }
#define XB_TMO      128
#define XB_XCNT(j)  (256  + 64 * (j))
#define XB_XSUB(j)  (1280 + 64 * (j))
#define XB_XGEN(j)  (2304 + 64 * (j))
#define XB_TOP      3328
#define XB_TOPGEN   3392
#define XCD_BAR_WORDS 3456
#define XB_SPIN_CAP (1u << 18)

__device__ __forceinline__ unsigned xb_ld(unsigned* p)              { return __hip_atomic_load(p, __ATOMIC_RELAXED, __HIP_MEMORY_SCOPE_AGENT); }
__device__ __forceinline__ unsigned xb_add(unsigned* p, unsigned v) { return __hip_atomic_fetch_add(p, v, __ATOMIC_RELAXED, __HIP_MEMORY_SCOPE_AGENT); }
__device__ __forceinline__ unsigned xb_xcc_id() { return (unsigned)__builtin_amdgcn_s_getreg((3 << 11) | 20) & 0xFu; }
#define XB_SPIN(cond, bar) do { unsigned _sp = 0; while (cond) { __builtin_amdgcn_s_sleep(1); \
    if ((++_sp & 255u) == 0u) { if (xb_ld(&(bar)[XB_TMO])) break; if (_sp > XB_SPIN_CAP) { atomicAdd(&(bar)[XB_TMO], 1u); break; } } } } while (0)

struct XcdBarrier {
    unsigned* bar; unsigned x; int wave;
    volatile LAS unsigned* st;
};

__device__ __forceinline__ bool xb_t0(int wave) { return wave == 0 && __builtin_amdgcn_mbcnt_hi(~0u, __builtin_amdgcn_mbcnt_lo(~0u, 0u)) == 0u; }
__device__ __forceinline__ XcdBarrier xcd_barrier_post(unsigned* bar, volatile LAS unsigned* st, int wave) {
    XcdBarrier b; b.bar = bar; b.x = xb_xcc_id(); b.st = st; b.wave = wave;
    if (xb_t0(wave)) (void)xb_add(&bar[XB_XCNT(b.x)], 1u);
    return b;
}
__device__ __forceinline__ void xcd_barrier_complete(unsigned* bar, unsigned x, unsigned& nloc, unsigned& nx) {
    const unsigned G = gridDim.x * gridDim.y * gridDim.z;
    unsigned sum, cnt, mine, sp = 0u;
    for (;;) {
        sum = 0u; cnt = 0u; mine = 0u;
#pragma unroll
        for (unsigned j = 0; j < 16; ++j) { const unsigned c = xb_ld(&bar[XB_XCNT(j)]); sum += c; cnt += (c > 0u) ? 1u : 0u; mine = (j == x) ? c : mine; }
        if (sum == G) break;
        __builtin_amdgcn_s_sleep(1);
        if ((++sp & 255u) == 0u) { if (xb_ld(&bar[XB_TMO])) break; if (sp > XB_SPIN_CAP) { atomicAdd(&bar[XB_TMO], 1u); break; } }
    }
    nloc = mine > 0u ? mine : 1u; nx = cnt > 0u ? cnt : 1u;
}

__device__ __forceinline__ void xcd_barrier(const XcdBarrier& b) {
    asm volatile("s_waitcnt vmcnt(0)" ::: "memory");
    __syncthreads();
    if (xb_t0(b.wave)) {
        unsigned* bar = b.bar;
        __builtin_amdgcn_s_waitcnt(0);
        unsigned nloc = b.st[0], nx = b.st[1];
        if (nloc == 0u) { xcd_barrier_complete(bar, b.x, nloc, nx); b.st[0] = nloc; b.st[1] = nx; }
        const unsigned old = xb_add(&bar[XB_XSUB(b.x)], 1u);
        const unsigned gen = old / nloc;
        if (old + 1u == (gen + 1u) * nloc) {
            __builtin_amdgcn_fence(__ATOMIC_RELEASE, "agent");
            asm volatile("s_waitcnt vmcnt(0)" ::: "memory");
            const unsigned og = xb_add(&bar[XB_TOP], 1u);
            const unsigned tg = og / nx;
            if (og + 1u == (tg + 1u) * nx) xb_add(&bar[XB_TOPGEN], 1u);
            else XB_SPIN(xb_ld(&bar[XB_TOPGEN]) == tg, bar);
            __builtin_amdgcn_fence(__ATOMIC_ACQUIRE, "agent");
            xb_add(&bar[XB_XGEN(b.x)], 1u);
            asm volatile("s_waitcnt vmcnt(0)" ::: "memory");
        } else {
            XB_SPIN(xb_ld(&bar[XB_XGEN(b.x)]) == gen, bar);
            __builtin_amdgcn_fence(__ATOMIC_ACQUIRE, "agent");
            asm volatile("s_waitcnt vmcnt(0)" ::: "memory");
        }
    }
    __syncthreads();
}
#ifdef PROBE_ACC
#define ACC_BEGIN(F, id) do { if ((id) == PROBE_ACC) { __syncthreads(); (F).acc_t0 = __builtin_amdgcn_s_memrealtime(); } } while (0)
#define ACC_END(F, id) do { if ((id) == PROBE_ACC) { __syncthreads(); (F).acc_sum += __builtin_amdgcn_s_memrealtime() - (F).acc_t0; } } while (0)
#else
#define ACC_BEGIN(F, id) do { } while (0)
#define ACC_END(F, id) do { } while (0)
#endif
struct Frame {
#ifdef PROBE_ACC
    unsigned long long acc_t0, acc_sum;
#endif
    LAS unsigned char* lds;
    volatile LAS unsigned* MISC;
    gu32* ctl;
    int tid, lane, wave, vcu, G;
    const float *x, *g_mix, *g_ffn, *w_in_ab, *gq_a, *gk_a, *w_gate_up, *b_gate, *g_gla, *w_out_ab, *w_in_c, *gq_c, *gk_c, *w_out_c, *w_up, *w_down;
    float* out;
    bf16 *Wab, *Woab, *Wup0, *Wdn0, *Winc, *Woc, *Wup1, *Wdn1;
    bf16 *XB, *CAT, *R1;
    float* SSQ; unsigned* MASK;
};
__device__ __forceinline__ int lane_id_opaque() { int l; asm volatile("v_mbcnt_lo_u32_b32 %0, -1, 0\n\tv_mbcnt_hi_u32_b32 %0, -1, %0" : "=v"(l)); return l; }
__device__ __forceinline__ float bf2f(bf16 v) { return __builtin_bit_cast(float, (unsigned)v << 16); }
__device__ __forceinline__ float wave_sum(float v) {
#pragma unroll
    for (int o = 1; o < 64; o <<= 1) v += __shfl_xor(v, o);
    return v;
}
__device__ __forceinline__ float wave_max(float v) {
#pragma unroll
    for (int o = 1; o < 64; o <<= 1) v = fmaxf(v, __shfl_xor(v, o));
    return v;
}
__device__ __forceinline__ float log_sigmoid(float x) { return fminf(x, 0.f) - log1pf(expf(-fabsf(x))); }

__device__ __forceinline__ int oldcol_ab(int n) {
    if (n < 2048) return n;
    if (n < 2304) return 2120 + (n - 2048);
    if (n < 2560) return 2376 + (n - 2304);
    if (n < 3072) return 2632 + (n - 2560);
    if (n < 3584) return 3160 + (n - 3072);
    if (n < 3648) return 2048 + (n - 3584);
    if (n < 3656) return 2112 + (n - 3648);
    if (n < 3672) return 3144 + (n - 3656);
    return -1;
}
__device__ __forceinline__ void p0_transpose_item(const float* W, int ldw, int K, const float* gain, bf16* WT, bool map, int item, int nblk, int lane) {
    const int kb = item / nblk, nb = item % nblk, ng = lane & 7, ko = lane >> 3, k0 = 64 * kb + 8 * ko, n = 32 * nb + 4 * ng;
    const int oc = map ? oldcol_ab(n) : n;
    f32x4 v[8];
#pragma unroll
    for (int i = 0; i < 8; ++i) { v[i] = (f32x4){0.f, 0.f, 0.f, 0.f}; if (oc >= 0) v[i] = *(const GAS f32x4*)(W + (size_t)(k0 + i) * ldw + oc); }
    if (gain) { const f32x4 g0 = *(const GAS f32x4*)(gain + k0), g1 = *(const GAS f32x4*)(gain + k0 + 4);
#pragma unroll
        for (int i = 0; i < 4; ++i) { v[i] = v[i] * g0[i]; v[4 + i] = v[4 + i] * g1[i]; } }
#pragma unroll
    for (int e = 0; e < 4; ++e) { v4u o; o.x = pk2(v[0][e], v[1][e]); o.y = pk2(v[2][e], v[3][e]); o.z = pk2(v[4][e], v[5][e]); o.w = pk2(v[6][e], v[7][e]);
        *(GAS v4u*)(WT + (size_t)(n + e) * K + k0) = o; }
}
__device__ __forceinline__ void ph_prologue(Frame& F) {
    const int gw = F.vcu * NWAVES + F.wave, NGW = F.G * NWAVES;
    constexpr int I_AB = (D / 64) * (NAB / 32), I_O = (D / 64) * (D / 32), I_UP = (D / 64) * (FF / 32), I_DN = (FF / 64) * (D / 32), I_C = (D / 64) * (NC / 32);
    constexpr int NITEMS = I_AB + 2 * I_O + 2 * I_UP + 2 * I_DN + I_C;
    for (int it = gw; it < NITEMS; it += NGW) {
        int r = it;
        if (r < I_AB) { p0_transpose_item(F.w_in_ab, ABP_OLD, D, F.g_mix, F.Wab, true, r, NAB / 32, F.lane); continue; } r -= I_AB;
        if (r < I_O) { p0_transpose_item(F.w_out_ab, D, D, nullptr, F.Woab, false, r, D / 32, F.lane); continue; } r -= I_O;
        if (r < I_UP) { p0_transpose_item(F.w_up, FF, D, F.g_ffn, F.Wup0, false, r, FF / 32, F.lane); continue; } r -= I_UP;
        if (r < I_DN) { p0_transpose_item(F.w_down, D, FF, nullptr, F.Wdn0, false, r, D / 32, F.lane); continue; } r -= I_DN;
        if (r < I_C) { p0_transpose_item(F.w_in_c, NC, D, F.g_mix + D, F.Winc, false, r, NC / 32, F.lane); continue; } r -= I_C;
        if (r < I_O) { p0_transpose_item(F.w_out_c, D, D, nullptr, F.Woc, false, r, D / 32, F.lane); continue; } r -= I_O;
        if (r < I_UP) { p0_transpose_item(F.w_up + (size_t)D * FF, FF, D, F.g_ffn + D, F.Wup1, false, r, FF / 32, F.lane); continue; } r -= I_UP;
        p0_transpose_item(F.w_down + (size_t)FF * D, D, FF, nullptr, F.Wdn1, false, r, D / 32, F.lane);
    }
    for (int m = gw; m < M; m += NGW) {
        const GAS f32x4* xr = (const GAS f32x4*)(F.x + (size_t)m * D) + F.lane;
        f32x4 v[4]; float s = 0.f;
#pragma unroll
        for (int j = 0; j < 4; ++j) { v[j] = xr[64 * j]; s += (v[j].x * v[j].x + v[j].y * v[j].y) + (v[j].z * v[j].z + v[j].w * v[j].w); }
        s = wave_sum(s);
        GAS unsigned long long* o8 = (GAS unsigned long long*)(F.XB + (size_t)m * D) + F.lane;
#pragma unroll
        for (int j = 0; j < 4; ++j) o8[64 * j] = (unsigned long long)pk2(v[j].x, v[j].y) | ((unsigned long long)pk2(v[j].z, v[j].w) << 32);
        if (F.lane < 16) F.SSQ[(size_t)m * 16 + F.lane] = (F.lane == 0) ? s : 0.f;
    }
}
namespace att {
typedef short s16x4 __attribute__((ext_vector_type(4)));
typedef float f32x16 __attribute__((ext_vector_type(16)));
typedef _Float16 f16x8 __attribute__((ext_vector_type(8)));
typedef unsigned u32x4 __attribute__((ext_vector_type(4)));
typedef short v4i16_t __attribute__((ext_vector_type(4)));
constexpr float C2 = 0.08838834764831845f * 1.4426950408889634f;
__device__ __forceinline__ int crow(int r, int hi) { return (r & 3) + 8 * (r >> 2) + 4 * hi; }
__device__ __forceinline__ int img_off(int row, int ch) { return 256 * row + 16 * (ch ^ (((row & 3) << 2) | ((row >> 2) & 3))); }
__device__ __forceinline__ bf16x8 pack8(float a0, float a1, float a2, float a3, float a4, float a5, float a6, float a7) {
    u32x4 w; w.x = pg8::cvt_pk_bf16(a0, a1); w.y = pg8::cvt_pk_bf16(a2, a3); w.z = pg8::cvt_pk_bf16(a4, a5); w.w = pg8::cvt_pk_bf16(a6, a7);
    return __builtin_bit_cast(bf16x8, w);
}
__device__ __forceinline__ f16x8 pack8h(float a0, float a1, float a2, float a3, float a4, float a5, float a6, float a7) {
    f16x8 r; r[0] = (_Float16)a0; r[1] = (_Float16)a1; r[2] = (_Float16)a2; r[3] = (_Float16)a3; r[4] = (_Float16)a4; r[5] = (_Float16)a5; r[6] = (_Float16)a6; r[7] = (_Float16)a7; return r;
}
__device__ __forceinline__ void dma_off_init(unsigned (&dvo)[2], int ld, int wave, int lane) {
#pragma unroll
    for (int i = 0; i < 2; ++i) { const int pi = 2 * wave + i, row = 4 * pi + (lane >> 4), pc = lane & 15, ch = pc ^ (((row & 3) << 2) | ((row >> 2) & 3)); dvo[i] = (unsigned)(row * ld + ch * 8) * 2u; }
}
__device__ __forceinline__ void tile_dma(const bf16* g, const unsigned (&dvo)[2], LAS unsigned char* buf, int wave) {
#pragma unroll
    for (int i = 0; i < 2; ++i) __builtin_amdgcn_global_load_lds((const unsigned*)((const char*)g + dvo[i]), (LAS unsigned*)(buf + 1024 * (2 * wave + i)), 16, 0, 0);
}
struct FragOff { int k[8]; int va[4]; int vd; };
__device__ __forceinline__ void frag_off_init(FragOff& fo, int lane) {
    const int hi = lane >> 5, r32 = lane & 31, i = lane & 15, q = i >> 2, p = i & 3, x = 2 * ((lane >> 4) & 1) + (p >> 1);
#pragma unroll
    for (int ks = 0; ks < 8; ++ks) fo.k[ks] = img_off(r32, 2 * ks + hi);
#pragma unroll
    for (int ct = 0; ct < 4; ++ct) fo.va[ct] = img_off(4 * hi + q, 4 * ct + x) + 8 * (p & 1);
    fo.vd = img_off(4 * hi + q + 8, x) - img_off(4 * hi + q, x);
}
__device__ __forceinline__ bf16x8 k_frag(const LAS unsigned char* kbuf, const FragOff& fo, int rt, int ks) { return *(const LAS bf16x8*)(kbuf + fo.k[ks] + 8192 * rt); }
__device__ __forceinline__ s16x4 vtr(const LAS unsigned char* p) { return __builtin_bit_cast(s16x4, __builtin_amdgcn_ds_read_tr16_b64_v4i16((LAS v4i16_t*)p)); }
__device__ __forceinline__ bf16x8 v_frag(const LAS unsigned char* vbuf, const FragOff& fo, int ct, int kk) {
    const s16x4 lo = vtr(vbuf + fo.va[ct] + 4096 * kk), hh = vtr(vbuf + fo.va[ct] + fo.vd + 4096 * kk);
    return (bf16x8){lo[0], lo[1], lo[2], lo[3], hh[0], hh[1], hh[2], hh[3]};
}
#define TR_READ(dst, addr, OFF) asm volatile("ds_read_b64_tr_b16 %0, %1 offset:%c2" : "=&v"(dst) : "v"(addr), "i"(OFF) : "memory")
#define LGKM_WAIT0() do { asm volatile("s_waitcnt lgkmcnt(0)" ::: "memory"); __builtin_amdgcn_sched_barrier(0); } while (0)
__device__ __forceinline__ bf16x8 mk_frag(s16x4 lo, s16x4 hh) { return (bf16x8){lo[0], lo[1], lo[2], lo[3], hh[0], hh[1], hh[2], hh[3]}; }
__device__ __forceinline__ int frag_va(int lane, int ct) { const int hi = lane >> 5, i = lane & 15, q = i >> 2, p = i & 3, x = 2 * ((lane >> 4) & 1) + (p >> 1); return img_off(4 * hi + q, 4 * ct + x) + 8 * (p & 1); }
__device__ __forceinline__ bf16x8 v_frag_rt(const LAS unsigned char* vbuf, int va, int vd, int kk) {
    const s16x4 lo = vtr(vbuf + va + 4096 * kk), hh = vtr(vbuf + va + vd + 4096 * kk);
    return (bf16x8){lo[0], lo[1], lo[2], lo[3], hh[0], hh[1], hh[2], hh[3]};
}
__device__ __forceinline__ void store_o(const f32x16 (&o)[4], const float (&rscale)[16], LAS unsigned char* stg, bf16* dst, int ld, int lane) {
    const int hi = lane >> 5, r32 = lane & 31;
#pragma unroll
    for (int r = 0; r < 16; ++r) { const int orow = crow(r, hi);
#pragma unroll
        for (int ct = 0; ct < 4; ++ct) *(LAS bf16*)(stg + orow * 256 + (32 * ct + r32) * 2) = (bf16)f2bf(o[ct][r] * rscale[r]); }
    asm volatile("s_waitcnt lgkmcnt(0)" ::: "memory");
#pragma unroll
    for (int i = 0; i < 8; ++i) { const int c = lane + 64 * i, row = c >> 4, ch = c & 15; const u32x4 v = *(const LAS u32x4*)(stg + row * 256 + ch * 16); *(u32x4*)(dst + (size_t)row * ld + ch * 8) = v; }
}
}
template <bool SCALEQ> __device__ __forceinline__ void ph_prep_a(Frame& F) {
    const int gw = F.vcu * NWAVES + F.wave, NGW = F.G * NWAVES, lane = F.lane;
    for (int tok = gw; tok < M; tok += NGW) {
        const float pos = (float)(tok & (SEQ - 1));
        bf16* pr = F.R1 + (size_t)tok * NAB;
        float c128 = 1.f, s128 = 0.f;
        if (lane < 32) { const int i = lane & 15; const float inv = powf(500000.0f, -(float)i * 2.0f / 32.0f); const float ang = pos * inv; c128 = cosf(ang); s128 = sinf(ang); }
#pragma unroll
        for (int which = 0; which < 2; ++which) {
            const int base = which == 0 ? C_QA : C_KA;
            const float* gn = which == 0 ? F.gq_a : F.gk_a;
            for (int h = 0; h < 4; ++h) {
                float a = bf2f(pr[base + h * 128 + lane]), b = bf2f(pr[base + h * 128 + 64 + lane]);
                const float ss = wave_sum(a * a + b * b);
                const float rs = rsqrtf(ss * (1.f / 128.f) + EPS);
                const float qs = (SCALEQ && which == 0) ? att::C2 : 1.0f;
                a = a * rs * gn[lane] * qs; b = b * rs * gn[64 + lane] * qs;
                const float other = __shfl_xor(a, 16);
                float o = a;
                if (lane < 16) o = a * c128 - other * s128;
                else if (lane < 32) o = a * c128 + other * s128;
                pr[base + h * 128 + lane] = (bf16)f2bf(o); pr[base + h * 128 + 64 + lane] = (bf16)f2bf(b);
            }
        }
        float c64 = 1.f, s64 = 0.f;
        if (lane < 16) { const int i = lane & 7; const float inv = powf(500000.0f, -(float)i * 2.0f / 16.0f); const float ang = pos * inv; c64 = cosf(ang); s64 = sinf(ang); }
        for (int h = 0; h < 9; ++h) {
            const int col = (h < 8) ? C_IQ + h * 64 : C_IK;
            const float a = bf2f(pr[col + lane]);
            const float other = __shfl_xor(a, 8);
            float o = a;
            if (lane < 8) o = a * c64 - other * s64;
            else if (lane < 16) o = a * c64 + other * s64;
            pr[col + lane] = (bf16)f2bf(o);
        }
    }
}
__device__ __forceinline__ void ph_indexer_naive(Frame& F) {
    LAS float* sc = (LAS float*)F.lds;
    LAS float* qv = sc + 2048;
    LAS float* wv = qv + 512;
    LAS unsigned* mw = (LAS unsigned*)(wv + 8);
    const int tid = F.tid;
    for (int tok = F.vcu; tok < M; tok += F.G) {
        const int pos = tok & (SEQ - 1), seq0 = tok - pos, limit = ((pos >> 6) + 1) << 6;
        const bf16* pr = F.R1 + (size_t)tok * NAB;
        qv[tid] = bf2f(pr[C_IQ + tid]);
        if (tid < 8) wv[tid] = bf2f(pr[C_IW + tid]) * 0.35355339059327373f;
        if (tid < 64) mw[tid] = 0u;
        __syncthreads();
        for (int s = tid; s < limit; s += NTHR) {
            const bf16* kp = F.R1 + (size_t)(seq0 + s) * NAB + C_IK;
            float acc[8];
#pragma unroll
            for (int h = 0; h < 8; ++h) acc[h] = 0.f;
            for (int d = 0; d < 64; ++d) { const float kd = bf2f(kp[d]);
#pragma unroll
                for (int h = 0; h < 8; ++h) acc[h] = fmaf(qv[h * 64 + d], kd, acc[h]); }
            float score = 0.f;
#pragma unroll
            for (int h = 0; h < 8; ++h) score += fmaxf(acc[h] * 0.125f, 0.f) * wv[h];
            sc[s] = score;
        }
        __syncthreads();
        if (limit <= 256) { if (tid < 64) mw[tid] = (tid * 32 < limit) ? 0xffffffffu : 0u; }
        else {
            for (int s = tid; s < limit; s += NTHR) {
                const float v = sc[s]; int cnt = 0;
                for (int j = 0; j < limit; ++j) { const float u = sc[j]; cnt += ((u > v) || (u == v && j < s)) ? 1 : 0; }
                if (cnt < 256) atomicOr((unsigned*)&mw[s >> 5], 1u << (s & 31));
            }
        }
        __syncthreads();
        if (tid < 64) F.MASK[(size_t)tok * 64 + tid] = mw[tid];
        __syncthreads();
    }
}
__device__ __forceinline__ float block_sum(float v, LAS float* red, int tid) {
    v = wave_sum(v);
    __syncthreads();
    if ((tid & 63) == 0) red[tid >> 6] = v;
    __syncthreads();
    float r = 0.f;
#pragma unroll
    for (int i = 0; i < NWAVES; ++i) r += red[i];
    return r;
}
__device__ __forceinline__ float block_max(float v, LAS float* red, int tid) {
    v = wave_max(v);
    __syncthreads();
    if ((tid & 63) == 0) red[tid >> 6] = v;
    __syncthreads();
    float r = red[0];
#pragma unroll
    for (int i = 1; i < NWAVES; ++i) r = fmaxf(r, red[i]);
    return r;
}
__device__ __forceinline__ void ph_dsa_naive(Frame& F) {
    LAS unsigned* mw = (LAS unsigned*)F.lds;
    LAS int* pre = (LAS int*)(mw + 64);
    LAS int* idx = pre + 128;
    LAS float* pp = (LAS float*)(idx + 256);
    LAS float* q = pp + 512;
    LAS float* red = q + 512;
    const int tid = F.tid;
    for (int tok = F.vcu; tok < M; tok += F.G) {
        const int pos = tok & (SEQ - 1), seq0 = tok - pos;
        if (tid < 64) mw[tid] = F.MASK[(size_t)tok * 64 + tid];
        q[tid] = bf2f(F.R1[(size_t)tok * NAB + C_QA + tid]);
        __syncthreads();
        if (tid == 0) { int a = 0; for (int w = 0; w < 64; ++w) { pre[w] = a; a += __popc(mw[w]); } pre[64] = a; }
        __syncthreads();
        const int n = pre[64];
        for (int s = tid; s < SEQ; s += NTHR) { const unsigned w = mw[s >> 5]; if ((w >> (s & 31)) & 1u) idx[pre[s >> 5] + __popc(w & ((1u << (s & 31)) - 1u))] = s; }
        __syncthreads();
        for (int h = 0; h < 4; ++h) {
            float sv = -INFINITY;
            if (tid < n) { const bf16* kp = F.R1 + (size_t)(seq0 + idx[tid]) * NAB + C_KA + h * 128; float a = 0.f;
                for (int d = 0; d < 128; ++d) a = fmaf(q[h * 128 + d], bf2f(kp[d]), a);
                sv = a * 0.08838834764831845f; }
            const float m = block_max(sv, red, tid);
            const float e = (tid < n) ? expf(sv - m) : 0.f;
            const float l = block_sum(e, red, tid);
            pp[tid] = e;
            __syncthreads();
            if (tid < 128) { float o = 0.f;
                for (int j = 0; j < n; ++j) o = fmaf(pp[j], bf2f(F.R1[(size_t)(seq0 + idx[j]) * NAB + C_VA + h * 128 + tid]), o);
                F.CAT[(size_t)tok * D + h * 128 + tid] = (bf16)f2bf(o / l); }
            __syncthreads();
        }
    }
}
__device__ __forceinline__ void ph_gla_naive(Frame& F) {
    LAS float* sq = (LAS float*)F.lds; LAS float* sk = sq + 1024; LAS float* sd = sk + 1024;
    LAS float* sg = sd + 1024;
    LAS float* red = sg + 256;
    const int tid = F.tid, lane = F.lane;
    for (int item = F.vcu; item < BATCH * 4; item += F.G) {
        const int b = item >> 2, h = item & 3, seq0 = b * SEQ;
        float S[64];
#pragma unroll
        for (int d = 0; d < 64; ++d) S[d] = 0.f;
        for (int t0 = 0; t0 < SEQ; t0 += 16) {
            if (tid < 256) { const int tt = tid >> 4, r = tid & 15; sg[tid] = bf2f(F.R1[(size_t)(seq0 + t0 + tt) * NAB + C_GL + r]); }
            __syncthreads();
            for (int i = tid; i < 1024; i += NTHR) { const int tt = i >> 6, d = i & 63; const bf16* pr = F.R1 + (size_t)(seq0 + t0 + tt) * NAB;
                sq[i] = bf2f(pr[C_QB + h * 64 + d]) * 0.125f; sk[i] = bf2f(pr[C_KB + h * 64 + d]);
                float g = F.b_gate[h * 64 + d];
#pragma unroll
                for (int r = 0; r < 16; ++r) g = fmaf(sg[tt * 16 + r], F.w_gate_up[r * 256 + h * 64 + d], g);
                sd[i] = expf(log_sigmoid(g) * (1.f / 16.f)); }
            __syncthreads();
            float o[16];
            if (tid < 128) {
#pragma unroll
                for (int tt = 0; tt < 16; ++tt) {
                    const float v = bf2f(F.R1[(size_t)(seq0 + t0 + tt) * NAB + C_VB + h * 128 + tid]); float a = 0.f;
#pragma unroll
                    for (int d = 0; d < 64; ++d) { S[d] = fmaf(sd[tt * 64 + d], S[d], sk[tt * 64 + d] * v); a = fmaf(sq[tt * 64 + d], S[d], a); }
                    o[tt] = a;
                    const float ws = wave_sum(a * a);
                    if (lane == 0) red[tt * 2 + (tid >> 6)] = ws;
                }
            }
            __syncthreads();
            if (tid < 128) {
#pragma unroll
                for (int tt = 0; tt < 16; ++tt) {
                    const size_t tok = seq0 + t0 + tt;
                    const float rs = rsqrtf((red[tt * 2] + red[tt * 2 + 1]) * (1.f / 128.f) + EPS);
                    const float og = bf2f(F.R1[tok * NAB + C_OG + h * 128 + tid]);
                    F.CAT[tok * D + 512 + h * 128 + tid] = (bf16)f2bf(o[tt] * rs * F.g_gla[tid] * (og / (1.f + expf(-og))));
                }
            }
            __syncthreads();
        }
    }
}
template <bool SCALEQ> __device__ __forceinline__ void ph_prep_c(Frame& F) {
    const int gw = F.vcu * NWAVES + F.wave, NGW = F.G * NWAVES, lane = F.lane;
    for (int it = gw; it < M * 16; it += NGW) {
        const int tok = it >> 4, hh = it & 15, isk = hh >> 3, h = hh & 7;
        bf16* p = F.R1 + (size_t)tok * NC + isk * 1024 + h * 128;
        const float* gn = isk ? F.gk_c : F.gq_c;
        const float a = bf2f(p[lane]), b = bf2f(p[64 + lane]);
        const float rs = rsqrtf(wave_sum(a * a + b * b) * (1.f / 128.f) + EPS);
        const float sc = (SCALEQ && !isk) ? att::C2 : 1.0f;
        p[lane] = (bf16)f2bf(a * rs * gn[lane] * sc); p[64 + lane] = (bf16)f2bf(b * rs * gn[64 + lane] * sc);
    }
}
__device__ __forceinline__ void ph_sb_naive(Frame& F) {
    const int gw = F.vcu * NWAVES + F.wave, NGW = F.G * NWAVES, lane = F.lane;
    for (int it = gw; it < M * 8; it += NGW) {
        const int tok = it >> 3, h = it & 7, pos = tok & (SEQ - 1), seq0 = tok - pos;
        const unsigned qq = *(const unsigned*)(F.R1 + (size_t)tok * NC + h * 128 + 2 * lane);
        const float q0 = __builtin_bit_cast(float, qq << 16), q1 = __builtin_bit_cast(float, qq & 0xffff0000u);
        float R = 0.f, o0 = 0.f, o1 = 0.f;
        for (int s = pos - 1; s >= 0; --s) {
            const bf16* pr = F.R1 + (size_t)(seq0 + s) * NC + h * 128 + 2 * lane;
            const unsigned kk = *(const unsigned*)(pr + 1024), vv = *(const unsigned*)(pr + 2048);
            const float k0 = __builtin_bit_cast(float, kk << 16), k1 = __builtin_bit_cast(float, kk & 0xffff0000u);
            const float z = wave_sum(q0 * k0 + q1 * k1) * 0.08838834764831845f;
            const float sp = log1pf(expf(-fabsf(z)));
            const float lsp = fminf(z, 0.f) - sp, lsn = fminf(-z, 0.f) - sp;
            const float a = expf(lsp + R);
            o0 = fmaf(a, __builtin_bit_cast(float, vv << 16), o0); o1 = fmaf(a, __builtin_bit_cast(float, vv & 0xffff0000u), o1);
            R += lsn;
        }
        *(unsigned*)(F.CAT + (size_t)tok * D + h * 128 + 2 * lane) = pk2(o0, o1);
    }
}
__device__ __forceinline__ void sb_unit(Frame& F, int b, int h, int qb) {
    using namespace att;
    const int tid = F.tid, lane = F.lane, w = F.wave, hi = lane >> 5, r32 = lane & 31;
    const bf16* Qg = F.R1 + (size_t)b * SEQ * NC + h * 128; const bf16* Kg = Qg + 1024; const bf16* Vg = Qg + 2048;
    const int T0 = qb * 256, t0w = T0 + 32 * w, jd = t0w >> 6, jtop = (T0 >> 6) + 3, tl = 32 * (w & 1) + r32, tl4 = tl - 4 * hi;
    LAS unsigned char* lds = F.lds;
    FragOff fo; frag_off_init(fo, lane);
    unsigned dvo[2]; dma_off_init(dvo, NC, w, lane);
    bf16x8 qf[8];
#pragma unroll
    for (int ks = 0; ks < 8; ++ks) qf[ks] = *(const bf16x8*)(Qg + (size_t)(t0w + r32) * NC + 16 * ks + 8 * hi);
    f16x8 T0f, T1f, ONEf;
#pragma unroll
    for (int j = 0; j < 8; ++j) { const int kp = 8 * (j >> 2) + 4 * hi + (j & 3); T0f[j] = (kp >= r32) ? (_Float16)1.0f : (_Float16)0.0f; T1f[j] = (kp + 16 >= r32) ? (_Float16)1.0f : (_Float16)0.0f; ONEf[j] = (_Float16)1.0f; }
    f32x16 o[4];
#pragma unroll
    for (int ct = 0; ct < 4; ++ct)
#pragma unroll
        for (int r = 0; r < 16; ++r) o[ct][r] = 0.f;
    float R2 = 0.f; bool done = false;
    volatile LAS unsigned* flags = F.MISC + 16;
    tile_dma(Kg + (size_t)(64 * jtop) * NC, dvo, lds, w); tile_dma(Vg + (size_t)(64 * jtop) * NC, dvo, lds + 16384, w);
    asm volatile("s_waitcnt vmcnt(0)" ::: "memory");
    __syncthreads();
    for (int j = jtop; j >= 0; --j) {
        const int cur = (jtop - j) & 1;
        const LAS unsigned char* kb = lds + cur * 32768; const LAS unsigned char* vb = kb + 16384;
        if (j > 0) { tile_dma(Kg + (size_t)(64 * (j - 1)) * NC, dvo, lds + (cur ^ 1) * 32768, w); tile_dma(Vg + (size_t)(64 * (j - 1)) * NC, dvo, lds + (cur ^ 1) * 32768 + 16384, w); }
        if (j <= jd && !done) {
            f32x16 p0, p1;
#pragma unroll
            for (int r = 0; r < 16; ++r) { p0[r] = 0.f; p1[r] = 0.f; }
            { bf16x8 kf[8];
#pragma unroll
              for (int ks = 0; ks < 8; ++ks) kf[ks] = k_frag(kb, fo, 0, ks);
#pragma unroll
              for (int ks = 0; ks < 8; ++ks) p0 = __builtin_amdgcn_mfma_f32_32x32x16_bf16(kf[ks], qf[ks], p0, 0, 0, 0);
#pragma unroll
              for (int ks = 0; ks < 8; ++ks) kf[ks] = k_frag(kb, fo, 1, ks);
#pragma unroll
              for (int ks = 0; ks < 8; ++ks) p1 = __builtin_amdgcn_mfma_f32_32x32x16_bf16(kf[ks], qf[ks], p1, 0, 0, 0); }
            s16x4 vl[4], vh[4], wl[4], wh[4];
            unsigned va0[4], va1[4];
#pragma unroll
            for (int ct = 0; ct < 4; ++ct) { va0[ct] = (unsigned)(size_t)vb + (unsigned)fo.va[ct]; va1[ct] = va0[ct] + (unsigned)fo.vd; }
            const bool diag = (j == jd);
            float x0[16], x1[16]; float rs = 0.f;
#pragma unroll
            for (int r = 0; r < 16; ++r) { const int key = (r & 3) + 8 * (r >> 2);
                float l0 = -__builtin_amdgcn_logf(1.0f + __builtin_amdgcn_exp2f(p0[r])), l1 = -__builtin_amdgcn_logf(1.0f + __builtin_amdgcn_exp2f(p1[r]));
                if (diag) { if (!(key < tl4)) l0 = 0.f; if (!(key + 32 < tl4)) l1 = 0.f; }
                x0[r] = l0; x1[r] = l1; rs += l0 + l1; p0[r] += R2; p1[r] += R2; }
            const f16x8 xb00 = pack8h(x0[0], x0[1], x0[2], x0[3], x0[4], x0[5], x0[6], x0[7]), xb01 = pack8h(x0[8], x0[9], x0[10], x0[11], x0[12], x0[13], x0[14], x0[15]);
            const f16x8 xb10 = pack8h(x1[0], x1[1], x1[2], x1[3], x1[4], x1[5], x1[6], x1[7]), xb11 = pack8h(x1[8], x1[9], x1[10], x1[11], x1[12], x1[13], x1[14], x1[15]);
            p0 = __builtin_amdgcn_mfma_f32_32x32x16_f16(T0f, xb00, p0, 0, 0, 0); p0 = __builtin_amdgcn_mfma_f32_32x32x16_f16(T1f, xb01, p0, 0, 0, 0);
            p0 = __builtin_amdgcn_mfma_f32_32x32x16_f16(ONEf, xb10, p0, 0, 0, 0); p0 = __builtin_amdgcn_mfma_f32_32x32x16_f16(ONEf, xb11, p0, 0, 0, 0);
            p1 = __builtin_amdgcn_mfma_f32_32x32x16_f16(T0f, xb10, p1, 0, 0, 0); p1 = __builtin_amdgcn_mfma_f32_32x32x16_f16(T1f, xb11, p1, 0, 0, 0);
#pragma unroll
            for (int r = 0; r < 16; ++r) { const int key = (r & 3) + 8 * (r >> 2);
                float a0 = __builtin_amdgcn_exp2f(p0[r]), a1 = __builtin_amdgcn_exp2f(p1[r]);
                if (diag) { if (!(key < tl4)) a0 = 0.f; if (!(key + 32 < tl4)) a1 = 0.f; }
                p0[r] = a0; p1[r] = a1; }
            const bf16x8 pa0 = pack8(p0[0], p0[1], p0[2], p0[3], p0[4], p0[5], p0[6], p0[7]), pa1 = pack8(p0[8], p0[9], p0[10], p0[11], p0[12], p0[13], p0[14], p0[15]);
            const bf16x8 pa2 = pack8(p1[0], p1[1], p1[2], p1[3], p1[4], p1[5], p1[6], p1[7]), pa3 = pack8(p1[8], p1[9], p1[10], p1[11], p1[12], p1[13], p1[14], p1[15]);
#pragma unroll
            for (int ct = 0; ct < 4; ++ct) { TR_READ(vl[ct], va0[ct], 0); TR_READ(vh[ct], va1[ct], 0); }
            LGKM_WAIT0();
#pragma unroll
            for (int ct = 0; ct < 4; ++ct) { TR_READ(wl[ct], va0[ct], 4096); TR_READ(wh[ct], va1[ct], 4096); }
#pragma unroll
            for (int ct = 0; ct < 4; ++ct) o[ct] = __builtin_amdgcn_mfma_f32_32x32x16_bf16(pa0, mk_frag(vl[ct], vh[ct]), o[ct], 0, 0, 0);
            LGKM_WAIT0();
#pragma unroll
            for (int ct = 0; ct < 4; ++ct) { TR_READ(vl[ct], va0[ct], 8192); TR_READ(vh[ct], va1[ct], 8192); }
#pragma unroll
            for (int ct = 0; ct < 4; ++ct) o[ct] = __builtin_amdgcn_mfma_f32_32x32x16_bf16(pa1, mk_frag(wl[ct], wh[ct]), o[ct], 0, 0, 0);
            LGKM_WAIT0();
#pragma unroll
            for (int ct = 0; ct < 4; ++ct) { TR_READ(wl[ct], va0[ct], 12288); TR_READ(wh[ct], va1[ct], 12288); }
#pragma unroll
            for (int ct = 0; ct < 4; ++ct) o[ct] = __builtin_amdgcn_mfma_f32_32x32x16_bf16(pa2, mk_frag(vl[ct], vh[ct]), o[ct], 0, 0, 0);
            LGKM_WAIT0();
#pragma unroll
            for (int ct = 0; ct < 4; ++ct) o[ct] = __builtin_amdgcn_mfma_f32_32x32x16_bf16(pa3, mk_frag(wl[ct], wh[ct]), o[ct], 0, 0, 0);
            rs += __shfl_xor(rs, 32);
            R2 += rs;
            done = __all(R2 < -152.0f);
        }
        if (lane == 0) flags[cur * 8 + w] = done ? 1u : 0u;
        asm volatile("s_waitcnt vmcnt(0) lgkmcnt(0)" ::: "memory");
        __syncthreads();
        unsigned alld = 1u;
#pragma unroll
        for (int i = 0; i < 8; ++i) alld &= flags[cur * 8 + i];
        if (alld) break;
    }
    float ones[16];
#pragma unroll
    for (int r = 0; r < 16; ++r) ones[r] = 1.0f;
    store_o(o, ones, lds + w * 8192, F.CAT + (size_t)(b * SEQ + t0w) * D + h * 128, D, lane);
    __syncthreads();
}
__device__ __forceinline__ void ph_sb(Frame& F) {
    for (int v = F.vcu; v < BATCH * 8 * 2; v += F.G) {
        const int bh = v >> 1, half = v & 1;
#pragma unroll 1
        for (int i = 0; i < 4; ++i) { const int qb = half ? (i == 0 ? 1 : i == 1 ? 6 : i == 2 ? 2 : 5) : (i == 0 ? 0 : i == 1 ? 7 : i == 2 ? 3 : 4); sb_unit(F, bh >> 3, bh & 7, qb); }
    }
}
__device__ __forceinline__ void dsa_unit(Frame& F, int b, int h, int ub, float mref) {
    using namespace att;
    const int lane = F.lane, w = F.wave, hi = lane >> 5, r32 = lane & 31;
    const bf16* Qg = F.R1 + (size_t)b * SEQ * NAB + C_QA + h * 128; const bf16* Kg = F.R1 + (size_t)b * SEQ * NAB + C_KA + h * 128; const bf16* Vg = F.R1 + (size_t)b * SEQ * NAB + C_VA + h * 128;
    const int t0w = 256 * ub + 32 * w, cw = t0w >> 6, jlast = 4 * ub + 3;
    LAS unsigned char* lds = F.lds;
    LAS unsigned char* mst = lds + 65536 + w * 8448;
    FragOff fo; frag_off_init(fo, lane);
    unsigned dvo[2]; dma_off_init(dvo, NAB, w, lane);
    tile_dma(Kg, dvo, lds, w); tile_dma(Vg, dvo, lds + 16384, w);
    bf16x8 qf[8];
#pragma unroll
    for (int ks = 0; ks < 8; ++ks) qf[ks] = *(const bf16x8*)(Qg + (size_t)(t0w + r32) * NAB + 16 * ks + 8 * hi);
    { const unsigned* mg = F.MASK + (size_t)(b * SEQ + t0w) * 64;
#pragma unroll 2
      for (int i = 0; i < 8; ++i) { const int c = lane + 64 * i, row = c >> 4, c4 = c & 15; const u32x4 v = *(const u32x4*)(mg + row * 64 + c4 * 4);
          *(LAS unsigned long long*)(mst + row * 264 + c4 * 16) = (unsigned long long)v.x | ((unsigned long long)v.y << 32);
          *(LAS unsigned long long*)(mst + row * 264 + c4 * 16 + 8) = (unsigned long long)v.z | ((unsigned long long)v.w << 32); } }
    f32x16 o[4];
#pragma unroll
    for (int ct = 0; ct < 4; ++ct)
#pragma unroll
        for (int r = 0; r < 16; ++r) o[ct][r] = 0.f;
    float lsum = 0.f;
    asm volatile("s_waitcnt vmcnt(0) lgkmcnt(0)" ::: "memory");
    __syncthreads();
    for (int j = 0; j <= jlast; ++j) {
        const int cur = j & 1;
        const LAS unsigned char* kb = lds + cur * 32768; const LAS unsigned char* vb = kb + 16384;
        if (j < jlast) { tile_dma(Kg + (size_t)(64 * (j + 1)) * NAB, dvo, lds + (cur ^ 1) * 32768, w); tile_dma(Vg + (size_t)(64 * (j + 1)) * NAB, dvo, lds + (cur ^ 1) * 32768 + 16384, w); }
        if (j <= cw) {
            const unsigned long long mw = *(const LAS unsigned long long*)(mst + r32 * 264 + j * 8);
            const unsigned mw0 = (unsigned)mw, mw1 = (unsigned)(mw >> 32);
#pragma unroll 1
            for (int half = 0; half < 2; ++half) {
                const unsigned mwh = (half ? mw1 : mw0) >> (4 * hi);
                bf16x8 kf[8];
#pragma unroll
                for (int ks = 0; ks < 8; ++ks) kf[ks] = k_frag(kb, fo, half, ks);
                f32x16 p;
#pragma unroll
                for (int r = 0; r < 16; ++r) p[r] = 0.f;
#pragma unroll
                for (int ks = 0; ks < 8; ++ks) p = __builtin_amdgcn_mfma_f32_32x32x16_bf16(kf[ks], qf[ks], p, 0, 0, 0);
#pragma unroll
                for (int r = 0; r < 16; ++r) { const unsigned keep = (unsigned)(-(int)((mwh >> ((r & 3) + 8 * (r >> 2))) & 1u));
                    const float e = __uint_as_float(__float_as_uint(__builtin_amdgcn_exp2f(p[r] - mref)) & keep); p[r] = e; lsum += e; }
                const bf16x8 pa0 = pack8(p[0], p[1], p[2], p[3], p[4], p[5], p[6], p[7]), pa1 = pack8(p[8], p[9], p[10], p[11], p[12], p[13], p[14], p[15]);
                s16x4 vl[8], vh[8];
                const unsigned vbase = (unsigned)(size_t)vb + 8192u * (unsigned)half;
#pragma unroll
                for (int ct = 0; ct < 4; ++ct) { const unsigned a0 = vbase + (unsigned)fo.va[ct], a1 = a0 + (unsigned)fo.vd;
                    TR_READ(vl[2 * ct], a0, 0); TR_READ(vh[2 * ct], a1, 0); TR_READ(vl[2 * ct + 1], a0, 4096); TR_READ(vh[2 * ct + 1], a1, 4096); }
                LGKM_WAIT0();
#pragma unroll
                for (int ct = 0; ct < 4; ++ct) {
                    o[ct] = __builtin_amdgcn_mfma_f32_32x32x16_bf16(pa0, mk_frag(vl[2 * ct], vh[2 * ct]), o[ct], 0, 0, 0);
                    o[ct] = __builtin_amdgcn_mfma_f32_32x32x16_bf16(pa1, mk_frag(vl[2 * ct + 1], vh[2 * ct + 1]), o[ct], 0, 0, 0);
                }
            }
        }
        asm volatile("s_waitcnt vmcnt(0) lgkmcnt(0)" ::: "memory");
        __syncthreads();
    }
    lsum += __shfl_xor(lsum, 32);
    LAS float* lsc = (LAS float*)mst;
    if (hi == 0) lsc[r32] = 1.0f / lsum;
    asm volatile("s_waitcnt lgkmcnt(0)" ::: "memory");
    float rsc[16];
#pragma unroll
    for (int r = 0; r < 16; ++r) rsc[r] = lsc[crow(r, hi)];
    store_o(o, rsc, lds + w * 8192, F.CAT + (size_t)(b * SEQ + t0w) * D + h * 128, D, lane);
    __syncthreads();
}
__device__ __forceinline__ void ph_dsa(Frame& F) {
    float gm = fmaxf(fabsf(F.gq_a[F.lane]), fabsf(F.gq_a[64 + F.lane])), km = fmaxf(fabsf(F.gk_a[F.lane]), fabsf(F.gk_a[64 + F.lane]));
    gm = wave_max(gm); km = wave_max(km);
    const float mref = att::C2 * 128.0f * gm * km * 1.02f;
    for (int v = F.vcu; v < BATCH * 4 * 4; v += F.G) {
        const int bh = v >> 2, pi = v & 3;
#pragma unroll 1
        for (int k = 0; k < 2; ++k) dsa_unit(F, bh >> 2, bh & 3, k ? 7 - pi : pi, mref);
    }
}
namespace idx {
using att::f32x16;
constexpr int SCP = 2048;
__device__ __forceinline__ unsigned okey(float f) { const unsigned u = __float_as_uint(f); return (u & 0x80000000u) ? ~u : (u | 0x80000000u); }
__device__ __forceinline__ int wave_isum(int c) {
    c += __builtin_amdgcn_mov_dpp(c, 0xB1, 0xF, 0xF, true);
    c += __builtin_amdgcn_mov_dpp(c, 0x4E, 0xF, 0xF, true);
    c += __builtin_amdgcn_mov_dpp(c, 0x141, 0xF, 0xF, true);
    c += __builtin_amdgcn_mov_dpp(c, 0x140, 0xF, 0xF, true);
    return (__builtin_amdgcn_readlane(c, 0) + __builtin_amdgcn_readlane(c, 16)) + (__builtin_amdgcn_readlane(c, 32) + __builtin_amdgcn_readlane(c, 48));
}
__device__ __forceinline__ void bit_transpose32x2(unsigned (&A)[32], unsigned (&B)[32]) {
    unsigned mask = 0x0000FFFFu;
#pragma unroll
    for (int s = 16; s; s >>= 1) {
        unsigned ta[16], tb[16];
#pragma unroll
        for (int k = 0, i = 0; k < 32; ++k) if (!(k & s)) { ta[i] = A[k + s] >> s; tb[i] = B[k + s] >> s; ++i; }
#pragma unroll
        for (int k = 0, i = 0; k < 32; ++k) if (!(k & s)) { ta[i] ^= A[k]; tb[i] ^= B[k]; ++i; }
#pragma unroll
        for (int i = 0; i < 16; ++i) { ta[i] &= mask; tb[i] &= mask; }
#pragma unroll
        for (int k = 0, i = 0; k < 32; ++k) if (!(k & s)) { A[k] ^= ta[i]; B[k] ^= tb[i]; ++i; }
#pragma unroll
        for (int k = 0, i = 0; k < 32; ++k) if (!(k & s)) { A[k + s] ^= ta[i] << s; B[k + s] ^= tb[i] << s; ++i; }
        mask ^= mask << (s >> 1);
    }
}
__device__ __forceinline__ void select_prepare(const LAS float* scA, const LAS float* scB, int E, unsigned (&Wa)[32], unsigned (&Wb)[32], int lane) {
#pragma unroll
    for (int j = 0; j < 32; ++j) { Wa[31 - j] = __float_as_uint(scA[64 * j + lane]); Wb[31 - j] = __float_as_uint(scB[64 * j + lane]); }
#pragma unroll
    for (int j = 0; j < 32; ++j) { const unsigned ua = Wa[31 - j], ub = Wb[31 - j];
        const unsigned ka = (ua & 0x80000000u) ? ~ua : (ua | 0x80000000u), kb = (ub & 0x80000000u) ? ~ub : (ub | 0x80000000u);
        Wa[31 - j] = (j < E) ? ka : 0u; Wb[31 - j] = (j < E) ? kb : 0u; }
    bit_transpose32x2(Wa, Wb);
}
__device__ __forceinline__ void select_finish(const unsigned (&Wa)[32], const unsigned (&Wb)[32], int E, unsigned* mrowA, unsigned* mrowB, int lane) {
    const unsigned valid = (E >= 32) ? 0xFFFFFFFFu : ((1u << E) - 1u);
    unsigned alA = valid, alB = valid, gtA = 0u, gtB = 0u;
    int GA = 0, GB = 0, AA = 64 * E, AB = 64 * E; bool dA = false, dB = false;
#pragma unroll
    for (int b = 0; b < 32; ++b) {
        if (dA && dB) break;
        const unsigned m1a = alA & Wa[b], m1b = alB & Wb[b];
        const int ca = wave_isum(__popc(m1a)), cb = wave_isum(__popc(m1b));
        if (!dA) { if (GA + ca >= 256) { alA = m1a; AA = ca; } else { GA += ca; gtA |= m1a; alA &= ~Wa[b]; AA -= ca; } dA = (GA + AA == 256); }
        if (!dB) { if (GB + cb >= 256) { alB = m1b; AB = cb; } else { GB += cb; gtB |= m1b; alB &= ~Wb[b]; AB -= cb; } dB = (GB + AB == 256); }
    }
#pragma unroll 1
    for (int rr = 0; rr < 2; ++rr) {
        const unsigned al = rr ? alB : alA, gt = rr ? gtB : gtA; const bool done = rr ? dB : dA; unsigned* mrow = rr ? mrowB : mrowA;
        unsigned sel = gt | al;
        if (!done) {
            int need = 256 - (rr ? GB : GA); sel = gt;
            const unsigned long long below = (1ull << lane) - 1ull;
            for (int j = 0; j < E; ++j) { const bool e = (al >> j) & 1u; const unsigned long long eq = __ballot(e);
                if (e && __popcll(eq & below) < need) sel |= 1u << j;
                need -= __popcll(eq); if (need <= 0) break; }
        }
        unsigned long long mine = 0ull;
#pragma unroll
        for (int j = 0; j < 32; ++j) { if (j < E) { const unsigned long long m = __ballot((sel >> j) & 1u); if (lane == j) mine = m; } }
        if (lane < 32) *(unsigned long long*)(mrow + 2 * lane) = mine;
    }
}
__device__ __forceinline__ void decode(int u, int& b, int& c, int& sub) { c = 4 + u % 28; const int rest = u / 28; b = rest >> 2; sub = rest & 3; }
__device__ __forceinline__ void load_af(Frame& F, int u, bf16x8 (&af)[4][4]) {
    int b, c, sub; decode(u, b, c, sub);
    const int r32 = F.lane & 31, hi = F.lane >> 5, t0 = 64 * c + 16 * sub;
    const bf16* P = F.R1 + (size_t)b * SEQ * NAB;
#pragma unroll
    for (int rt = 0; rt < 4; ++rt)
#pragma unroll
        for (int ks = 0; ks < 4; ++ks) af[rt][ks] = *(const bf16x8*)(P + (size_t)(t0 + 4 * rt + (r32 >> 3)) * NAB + C_IQ + (r32 & 7) * 64 + 16 * ks + 8 * hi);
}
__device__ __forceinline__ float load_w(Frame& F, int u) {
    int b, c, sub; decode(u, b, c, sub);
    const int t0 = 64 * c + 16 * sub;
    return (F.tid < 128) ? bf2f(F.R1[(size_t)(b * SEQ + t0 + (F.tid >> 3)) * NAB + C_IW + (F.tid & 7)]) * (0.125f * 0.35355339059327373f) : 0.f;
}
__device__ __forceinline__ void load_bf(Frame& F, int b, int strip, bf16x8 (&bfr)[4]) {
    const bf16* P = F.R1 + (size_t)b * SEQ * NAB;
#pragma unroll
    for (int ks = 0; ks < 4; ++ks) bfr[ks] = *(const bf16x8*)(P + (size_t)(32 * strip + (F.lane & 31)) * NAB + C_IK + 16 * ks + 8 * (F.lane >> 5));
}
__device__ __forceinline__ void run(Frame& F) {
    const int lane = F.lane, w = F.wave, hi = lane >> 5, r32 = lane & 31, tid = F.tid, NU = BATCH * 28 * 4;
    int u = F.vcu; if (u >= NU) return;
    LAS float* sc = (LAS float*)F.lds;
    LAS float* wtb = sc + 16 * SCP;
    bf16x8 af[4][4], bfr[4], bnx[4];
    load_af(F, u, af);
    { const float wv = load_w(F, u); if (tid < 128) wtb[tid] = wv; }
    { int b, c, sub; decode(u, b, c, sub); if (w < 2 * (c + 1)) load_bf(F, b, w, bfr); }
    for (int it = 0; u < NU; ++it, u += F.G) {
        int b, c, sub; decode(u, b, c, sub);
        const int n = 64 * (c + 1), t0 = 64 * c + 16 * sub, nstrip = n >> 5;
        const int un = u + F.G; const bool more = un < NU;
        const LAS float* wt = wtb + (it & 1) * 128;
        __syncthreads();
        const float wnext = more ? load_w(F, un) : 0.f;
        for (int s = w; s < nstrip; s += NWAVES) {
            const bool mstrip = s + NWAVES < nstrip;
            if (mstrip) load_bf(F, b, s + NWAVES, bnx);
#pragma unroll
            for (int rt = 0; rt < 4; ++rt) {
                f32x16 acc;
#pragma unroll
                for (int r = 0; r < 16; ++r) acc[r] = 0.f;
#pragma unroll
                for (int ks = 0; ks < 4; ++ks) acc = __builtin_amdgcn_mfma_f32_32x32x16_bf16(af[rt][ks], bfr[ks], acc, 0, 0, 0);
                float part[4];
#pragma unroll
                for (int qi = 0; qi < 4; ++qi) { const f32x4 wv = *(const LAS f32x4*)(wt + (4 * rt + qi) * 8 + 4 * hi);
                    part[qi] = fmaxf(acc[4 * qi], 0.f) * wv[0] + fmaxf(acc[4 * qi + 1], 0.f) * wv[1] + fmaxf(acc[4 * qi + 2], 0.f) * wv[2] + fmaxf(acc[4 * qi + 3], 0.f) * wv[3]; }
                const float send0 = hi ? part[0] : part[2], send1 = hi ? part[1] : part[3];
                const float got0 = __shfl_xor(send0, 32), got1 = __shfl_xor(send1, 32);
                const float f0 = (hi ? part[2] : part[0]) + got0, f1 = (hi ? part[3] : part[1]) + got1;
                const int q0 = 4 * rt + 2 * hi;
                sc[q0 * SCP + 32 * s + r32] = f0; sc[(q0 + 1) * SCP + 32 * s + r32] = f1;
            }
            if (mstrip) {
#pragma unroll
                for (int ks = 0; ks < 4; ++ks) bfr[ks] = bnx[ks];
            }
        }
        if (more && tid < 128) wtb[((it + 1) & 1) * 128 + tid] = wnext;
        __syncthreads();
        { const int q = 2 * w;
          unsigned* mrowA = F.MASK + (size_t)(b * SEQ + t0 + q) * 64; unsigned* mrowB = mrowA + 64;
          const LAS float* rowA = sc + q * SCP; const LAS float* rowB = rowA + SCP;
          unsigned Wa[32], Wb[32];
          select_prepare(rowA, rowB, n >> 6, Wa, Wb, lane);
          asm volatile("" ::: "memory");
          if (more) load_af(F, un, af);
          select_finish(Wa, Wb, n >> 6, mrowA, mrowB, lane); }
        if (more) { int bn, cn, sn; decode(un, bn, cn, sn); if (w < 2 * (cn + 1)) load_bf(F, bn, w, bfr); }
    }
    __syncthreads();
}
}
__device__ __forceinline__ void ph_indexer(Frame& F) {
    { const int gw = F.vcu * NWAVES + F.wave, NGW = F.G * NWAVES;
      for (int i = gw; i < BATCH * 256; i += NGW) { const int b = i >> 8, pos = i & 255, n = ((pos >> 6) + 1) << 6;
          if (F.lane < 32) { unsigned long long v = 0ull; if (64 * F.lane < n) v = ~0ull; *(unsigned long long*)(F.MASK + (size_t)(b * SEQ + pos) * 64 + 2 * F.lane) = v; } } }
    idx::run(F);
}
namespace gla {
using att::f32x16; using att::u32x4;
constexpr int L_WL = 0, L_V = 4096, L_OG = 36864, L_K = 69632, L_Q = 78848, L_PART = 88064, L_STG = 89088, KP = 144, SP = 272;
struct In { u32x4 g0, g1, kk, qq; f32x4 b0, b1; };
__device__ __forceinline__ void decode(int u, int& b, int& h, int& c) { b = u >> 7; h = (u >> 5) & 3; c = u & 31; }
template <bool PASSC> __device__ __forceinline__ void load_in(Frame& F, int u, In& in, const float* BC) {
    int b, h, c; decode(u, b, h, c);
    const bf16* pr = F.R1 + (size_t)(b * SEQ + 64 * c + F.lane) * NAB;
    in.kk = *(const u32x4*)(pr + C_KB + h * 64 + 8 * F.wave);
    if (PASSC) { in.qq = *(const u32x4*)(pr + C_QB + h * 64 + 8 * F.wave);
        const float* bp = BC + ((size_t)u * 64 + F.lane) * 64 + 8 * F.wave; in.b0 = *(const f32x4*)bp; in.b1 = *(const f32x4*)(bp + 4); }
    else { in.g0 = *(const u32x4*)(pr + C_GL); in.g1 = *(const u32x4*)(pr + C_GL + 8); }
}
template <bool NEEDOG> __device__ __forceinline__ void dma_in(Frame& F, int u, int buf, const unsigned (&dvo)[2]) {
    int b, h, c; decode(u, b, h, c);
    const bf16* P = F.R1 + (size_t)(b * SEQ + 64 * c) * NAB;
    att::tile_dma(P + C_VB + h * 128, dvo, F.lds + L_V + buf * 16384, F.wave);
    if (NEEDOG) att::tile_dma(P + C_OG + h * 128, dvo, F.lds + L_OG + buf * 16384, F.wave);
}
__device__ __forceinline__ void stage_wl(Frame& F, int h) {
    LAS float* wl = (LAS float*)(F.lds + L_WL);
#pragma unroll
    for (int i = 0; i < 2; ++i) { const int e = F.tid + 512 * i, r = e >> 6, d = e & 63; wl[e] = F.w_gate_up[r * 256 + h * 64 + d]; }
}
__device__ __forceinline__ void unpack8(const u32x4 v, float (&f)[8]) {
#pragma unroll
    for (int i = 0; i < 4; ++i) { f[2 * i] = __uint_as_float(v[i] << 16); f[2 * i + 1] = __uint_as_float(v[i] & 0xffff0000u); }
}
__device__ __forceinline__ void gate_scan(Frame& F, int h, const float (&gl)[16], float (&bc)[8], float (&blast)[8]) {
    const int lane = F.lane, d0 = 8 * F.wave;
    const LAS float* wl = (const LAS float*)(F.lds + L_WL);
    float acc[8];
#pragma unroll
    for (int i = 0; i < 8; ++i) acc[i] = F.b_gate[h * 64 + d0 + i];
#pragma unroll
    for (int r = 0; r < 16; ++r) { const f32x4 w0 = *(const LAS f32x4*)(wl + r * 64 + d0), w1 = *(const LAS f32x4*)(wl + r * 64 + d0 + 4);
#pragma unroll
        for (int i = 0; i < 4; ++i) { acc[i] = fmaf(gl[r], w0[i], acc[i]); acc[4 + i] = fmaf(gl[r], w1[i], acc[4 + i]); } }
#pragma unroll
    for (int i = 0; i < 8; ++i) { float v = (fminf(acc[i], 0.f) - __logf(1.0f + __expf(-fabsf(acc[i])))) * (1.0f / 16.0f);
#pragma unroll
        for (int off = 1; off < 64; off <<= 1) { const float u = __shfl_up(v, off); if (lane >= off) v += u; }
        bc[i] = v; blast[i] = __shfl(v, 63); }
}
__device__ __forceinline__ void pass_a(Frame& F, float* GU, float* DEC, float* BC) {
    const int lane = F.lane, w = F.wave, hi = lane >> 5, r32 = lane & 31;
    att::FragOff fo; att::frag_off_init(fo, lane);
    unsigned dvo[2]; att::dma_off_init(dvo, NAB, w, lane);
    const int et = w >> 1, dt = w & 1, va_et = att::frag_va(lane, et);
    int u = F.vcu; if (u >= BATCH * 4 * 32) return;
    In cur, nxt; int hprev = -1;
    dma_in<false>(F, u, 0, dvo); load_in<false>(F, u, cur, BC);
    for (int it = 0; u < BATCH * 4 * 32; ++it, u += F.G) {
        int b, h, c; decode(u, b, h, c);
        const int un = u + F.G; const bool more = un < BATCH * 4 * 32;
        if (h != hprev) { stage_wl(F, h); hprev = h; }
        asm volatile("s_waitcnt vmcnt(0) lgkmcnt(0)" ::: "memory");
        __syncthreads();
        float gl[16], kf[8];
        unpack8(cur.g0, (float(&)[8])gl[0]); unpack8(cur.g1, (float(&)[8])gl[8]); unpack8(cur.kk, kf);
        asm volatile("" ::: "memory");
        if (more) { dma_in<false>(F, un, (it + 1) & 1, dvo); load_in<false>(F, un, nxt, BC); }
        float bc[8], blast[8];
        gate_scan(F, h, gl, bc, blast);
        const int uid = u;
        { float* bp = BC + ((size_t)uid * 64 + lane) * 64 + 8 * w; *(f32x4*)bp = (f32x4){bc[0], bc[1], bc[2], bc[3]}; *(f32x4*)(bp + 4) = (f32x4){bc[4], bc[5], bc[6], bc[7]}; }
#pragma unroll
        for (int i = 0; i < 8; ++i) *(LAS bf16*)(F.lds + L_K + (8 * w + i) * KP + lane * 2) = (bf16)f2bf(kf[i] * __expf(blast[i] - bc[i]));
        if (lane == 0) {
#pragma unroll
            for (int i = 0; i < 8; ++i) DEC[(size_t)uid * 64 + 8 * w + i] = __expf(blast[i]); }
        asm volatile("s_waitcnt lgkmcnt(0)" ::: "memory");
        __syncthreads();
        const LAS unsigned char* vbuf = F.lds + L_V + (it & 1) * 16384;
        f32x16 acc;
#pragma unroll
        for (int r = 0; r < 16; ++r) acc[r] = 0.f;
#pragma unroll
        for (int kk = 0; kk < 4; ++kk) {
            const LAS unsigned char* kp = F.lds + L_K + (32 * dt + r32) * KP + (16 * kk + 4 * hi) * 2;
            const unsigned long long lo = *(const LAS unsigned long long*)kp, hh = *(const LAS unsigned long long*)(kp + 16);
            u32x4 bw; bw.x = (unsigned)lo; bw.y = (unsigned)(lo >> 32); bw.z = (unsigned)hh; bw.w = (unsigned)(hh >> 32);
            acc = __builtin_amdgcn_mfma_f32_32x32x16_bf16(att::v_frag_rt(vbuf, va_et, fo.vd, kk), __builtin_bit_cast(bf16x8, bw), acc, 0, 0, 0);
        }
        float* gu = GU + (size_t)uid * 8192;
#pragma unroll
        for (int r = 0; r < 16; ++r) gu[(32 * et + att::crow(r, hi)) * 64 + 32 * dt + r32] = acc[r];
        cur = nxt;
    }
    __syncthreads();
}
__device__ __forceinline__ void pass_b(Frame& F, float* GU, const float* DEC) {
    for (int idx = F.vcu * NTHR + F.tid; idx < 64 * 128 * 16; idx += F.G * NTHR) {
        const int bh = idx >> 11, e = (idx >> 4) & 127, dq = idx & 15;
        f32x4 S = (f32x4){0.f, 0.f, 0.f, 0.f};
        for (int c0 = 0; c0 < 32; c0 += 8) {
            f32x4 U[8], dec[8];
#pragma unroll
            for (int i = 0; i < 8; ++i) { const size_t uid = (size_t)bh * 32 + c0 + i; U[i] = *(const f32x4*)(GU + (uid * 128 + e) * 64 + 4 * dq); dec[i] = *(const f32x4*)(DEC + uid * 64 + 4 * dq); }
#pragma unroll
            for (int i = 0; i < 8; ++i) { const size_t uid = (size_t)bh * 32 + c0 + i; *(f32x4*)(GU + (uid * 128 + e) * 64 + 4 * dq) = S; S = dec[i] * S + U[i]; }
        }
    }
}
__device__ __forceinline__ void pass_c(Frame& F, const float* GU, const float* BC) {
    const int lane = F.lane, w = F.wave, hi = lane >> 5, r32 = lane & 31, tid = F.tid;
    LAS unsigned char* lds = F.lds;
    att::FragOff fo; att::frag_off_init(fo, lane);
    unsigned dvo[2]; att::dma_off_init(dvo, NAB, w, lane);
    const int et = w >> 1, tt = w & 1, tl = 32 * tt + r32, va_et = att::frag_va(lane, et);
    int u = F.vcu; if (u >= BATCH * 4 * 32) return;
    In cur, nxt;
    dma_in<true>(F, u, 0, dvo); load_in<true>(F, u, cur, BC);
    for (int it = 0; u < BATCH * 4 * 32; ++it, u += F.G) {
        int b, h, c; decode(u, b, h, c);
        const int un = u + F.G; const bool more = un < BATCH * 4 * 32;
        asm volatile("s_waitcnt vmcnt(0) lgkmcnt(0)" ::: "memory");
        __syncthreads();
        float kf[8], qf[8], bc[8];
        unpack8(cur.kk, kf); unpack8(cur.qq, qf);
#pragma unroll
        for (int i = 0; i < 4; ++i) { bc[i] = cur.b0[i]; bc[4 + i] = cur.b1[i]; }
        asm volatile("" ::: "memory");
        if (more) { dma_in<true>(F, un, (it + 1) & 1, dvo); load_in<true>(F, un, nxt, BC); }
        f32x4 sf[8];
        { const float* gs = GU + ((size_t)u * 128 + 32 * et + r32) * 64;
#pragma unroll
          for (int ks = 0; ks < 4; ++ks) { sf[2 * ks] = *(const f32x4*)(gs + 16 * ks + 8 * hi); sf[2 * ks + 1] = *(const f32x4*)(gs + 16 * ks + 8 * hi + 4); } }
        { float eq[8], ek[8];
#pragma unroll
          for (int i = 0; i < 8; ++i) { eq[i] = qf[i] * 0.125f * __expf(bc[i]); ek[i] = kf[i] * __expf(-bc[i]); }
          *(LAS bf16x8*)(lds + L_Q + lane * KP + 16 * w) = att::pack8(eq[0], eq[1], eq[2], eq[3], eq[4], eq[5], eq[6], eq[7]);
          *(LAS bf16x8*)(lds + L_K + lane * KP + 16 * w) = att::pack8(ek[0], ek[1], ek[2], ek[3], ek[4], ek[5], ek[6], ek[7]); }
        asm volatile("s_waitcnt lgkmcnt(0)" ::: "memory");
        __syncthreads();
        const LAS unsigned char* vbuf = lds + L_V + (it & 1) * 16384; const LAS unsigned char* ogbuf = lds + L_OG + (it & 1) * 16384;
        bf16x8 qfr[4];
#pragma unroll
        for (int ks = 0; ks < 4; ++ks) qfr[ks] = *(const LAS bf16x8*)(lds + L_Q + tl * KP + (16 * ks + 8 * hi) * 2);
        f32x16 p0, p1;
#pragma unroll
        for (int r = 0; r < 16; ++r) { p0[r] = 0.f; p1[r] = 0.f; }
#pragma unroll
        for (int ks = 0; ks < 4; ++ks) {
            const bf16x8 a0 = *(const LAS bf16x8*)(lds + L_K + r32 * KP + (16 * ks + 8 * hi) * 2), a1 = *(const LAS bf16x8*)(lds + L_K + (32 + r32) * KP + (16 * ks + 8 * hi) * 2);
            p0 = __builtin_amdgcn_mfma_f32_32x32x16_bf16(a0, qfr[ks], p0, 0, 0, 0); p1 = __builtin_amdgcn_mfma_f32_32x32x16_bf16(a1, qfr[ks], p1, 0, 0, 0);
        }
        { const int tl4 = tl - 4 * hi;
#pragma unroll
          for (int r = 0; r < 16; ++r) { const int s = (r & 3) + 8 * (r >> 2); if (s > tl4) p0[r] = 0.f; if (s + 32 > tl4) p1[r] = 0.f; } }
        const bf16x8 pa0 = att::pack8(p0[0], p0[1], p0[2], p0[3], p0[4], p0[5], p0[6], p0[7]), pa1 = att::pack8(p0[8], p0[9], p0[10], p0[11], p0[12], p0[13], p0[14], p0[15]);
        const bf16x8 pa2 = att::pack8(p1[0], p1[1], p1[2], p1[3], p1[4], p1[5], p1[6], p1[7]), pa3 = att::pack8(p1[8], p1[9], p1[10], p1[11], p1[12], p1[13], p1[14], p1[15]);
        f32x16 acc;
#pragma unroll
        for (int r = 0; r < 16; ++r) acc[r] = 0.f;
        acc = __builtin_amdgcn_mfma_f32_32x32x16_bf16(att::v_frag_rt(vbuf, va_et, fo.vd, 0), pa0, acc, 0, 0, 0);
        acc = __builtin_amdgcn_mfma_f32_32x32x16_bf16(att::v_frag_rt(vbuf, va_et, fo.vd, 1), pa1, acc, 0, 0, 0);
        acc = __builtin_amdgcn_mfma_f32_32x32x16_bf16(att::v_frag_rt(vbuf, va_et, fo.vd, 2), pa2, acc, 0, 0, 0);
        acc = __builtin_amdgcn_mfma_f32_32x32x16_bf16(att::v_frag_rt(vbuf, va_et, fo.vd, 3), pa3, acc, 0, 0, 0);
#pragma unroll
        for (int ks = 0; ks < 4; ++ks) { const f32x4 s0 = sf[2 * ks], s1 = sf[2 * ks + 1];
            acc = __builtin_amdgcn_mfma_f32_32x32x16_bf16(att::pack8(s0[0], s0[1], s0[2], s0[3], s1[0], s1[1], s1[2], s1[3]), qfr[ks], acc, 0, 0, 0); }
        float ss = 0.f;
#pragma unroll
        for (int r = 0; r < 16; ++r) ss = fmaf(acc[r], acc[r], ss);
        ss += __shfl_xor(ss, 32);
        LAS float* part = (LAS float*)(lds + L_PART);
        if (hi == 0) part[et * 64 + tl] = ss;
        asm volatile("s_waitcnt lgkmcnt(0)" ::: "memory");
        __syncthreads();
        const float rs = rsqrtf(((part[tl] + part[64 + tl]) + (part[128 + tl] + part[192 + tl])) * (1.0f / 128.0f) + EPS);
#pragma unroll
        for (int g = 0; g < 4; ++g) {
            const int e0 = 32 * et + 8 * g + 4 * hi;
            const unsigned long long ow = *(const LAS unsigned long long*)(ogbuf + att::img_off(tl, 4 * et + g) + 8 * hi);
            const f32x4 gg = *(const f32x4*)(F.g_gla + e0);
            float y[4];
#pragma unroll
            for (int i = 0; i < 4; ++i) { const float og = __uint_as_float(((unsigned)(ow >> (16 * i)) & 0xffffu) << 16); y[i] = acc[4 * g + i] * rs * gg[i] * (og * __builtin_amdgcn_rcpf(1.0f + __expf(-og))); }
            *(LAS unsigned long long*)(lds + L_STG + tl * SP + e0 * 2) = (unsigned long long)pg8::cvt_pk_bf16(y[0], y[1]) | ((unsigned long long)pg8::cvt_pk_bf16(y[2], y[3]) << 32);
        }
        asm volatile("s_waitcnt lgkmcnt(0)" ::: "memory");
        __syncthreads();
#pragma unroll
        for (int i = 0; i < 2; ++i) { const int cidx = tid + 512 * i, row = cidx >> 4, ch = cidx & 15;
            *(u32x4*)(F.CAT + (size_t)(b * SEQ + 64 * c + row) * D + 512 + h * 128 + ch * 8) = *(const LAS u32x4*)(lds + L_STG + row * SP + ch * 16); }
        cur = nxt;
    }
    __syncthreads();
}
}
__device__ __forceinline__ void ph_rope_tables(Frame& F, float* R128, float* R64) {
    for (int i = F.vcu * NTHR + F.tid; i < SEQ * 24; i += F.G * NTHR) {
        const int pos = i / 24, k = i % 24;
        if (k < 16) { const float inv = powf(500000.0f, -(float)k * 2.0f / 32.0f), ang = (float)pos * inv; R128[pos * 32 + k] = cosf(ang); R128[pos * 32 + 16 + k] = sinf(ang); }
        else { const int j = k - 16; const float inv = powf(500000.0f, -(float)j * 2.0f / 16.0f), ang = (float)pos * inv; R64[pos * 16 + j] = cosf(ang); R64[pos * 16 + 8 + j] = sinf(ang); }
    }
}
__device__ __forceinline__ float dpp_xor1(float v) { return __builtin_bit_cast(float, __builtin_amdgcn_mov_dpp(__builtin_bit_cast(int, v), 0xB1, 0xF, 0xF, true)); }
__device__ __forceinline__ float dpp_xor2(float v) { return __builtin_bit_cast(float, __builtin_amdgcn_mov_dpp(__builtin_bit_cast(int, v), 0x4E, 0xF, 0xF, true)); }
__device__ __forceinline__ void ph_prep_c_fast(Frame& F) {
    const int gw = F.vcu * NWAVES + F.wave, NGW = F.G * NWAVES, lane = F.lane;
    const float* gn = (lane < 32 ? F.gq_c : F.gk_c) + (lane & 3) * 32;
    const float sc = lane < 32 ? att::C2 : 1.0f;
    float g[32];
#pragma unroll
    for (int i = 0; i < 8; ++i) { const f32x4 v = *(const f32x4*)(gn + 4 * i); g[4 * i] = v[0] * sc; g[4 * i + 1] = v[1] * sc; g[4 * i + 2] = v[2] * sc; g[4 * i + 3] = v[3] * sc; }
    for (int tok = gw; tok < M; tok += NGW) {
        att::u32x4* p = (att::u32x4*)(F.R1 + (size_t)tok * NC + lane * 32);
        att::u32x4 v[4]; float f[32]; float ss = 0.f;
#pragma unroll
        for (int i = 0; i < 4; ++i) v[i] = p[i];
#pragma unroll
        for (int i = 0; i < 4; ++i)
#pragma unroll
            for (int j = 0; j < 4; ++j) { const float a = __uint_as_float(v[i][j] << 16), b = __uint_as_float(v[i][j] & 0xffff0000u); f[8 * i + 2 * j] = a; f[8 * i + 2 * j + 1] = b; ss = fmaf(a, a, fmaf(b, b, ss)); }
        ss += dpp_xor1(ss); ss += dpp_xor2(ss);
        const float rs = rsqrtf(ss * (1.f / 128.f) + EPS);
#pragma unroll
        for (int i = 0; i < 4; ++i) { att::u32x4 o;
#pragma unroll
            for (int j = 0; j < 4; ++j) o[j] = pg8::cvt_pk_bf16(f[8 * i + 2 * j] * rs * g[8 * i + 2 * j], f[8 * i + 2 * j + 1] * rs * g[8 * i + 2 * j + 1]);
            p[i] = o; }
    }
}
__device__ __forceinline__ void ph_prep_a_fast(Frame& F, const float* R128, const float* R64) {
    const int gw = F.vcu * NWAVES + F.wave, NGW = F.G * NWAVES, lane = F.lane, l8 = lane & 7;
    const float* gn = (lane < 32 ? F.gq_a : F.gk_a) + l8 * 16;
    const float sc = lane < 32 ? att::C2 : 1.0f;
    float g[16];
#pragma unroll
    for (int i = 0; i < 4; ++i) { const f32x4 v = *(const f32x4*)(gn + 4 * i); g[4 * i] = v[0] * sc; g[4 * i + 1] = v[1] * sc; g[4 * i + 2] = v[2] * sc; g[4 * i + 3] = v[3] * sc; }
    for (int tok = gw; tok < M; tok += NGW) {
        const int pos = tok & (SEQ - 1);
        bf16* pr = F.R1 + (size_t)tok * NAB;
        {   att::u32x4* p = (att::u32x4*)(pr + lane * 16);
            const att::u32x4 v0 = p[0], v1 = p[1]; float f[16]; float ss = 0.f;
#pragma unroll
            for (int j = 0; j < 4; ++j) { f[2 * j] = __uint_as_float(v0[j] << 16); f[2 * j + 1] = __uint_as_float(v0[j] & 0xffff0000u); f[8 + 2 * j] = __uint_as_float(v1[j] << 16); f[8 + 2 * j + 1] = __uint_as_float(v1[j] & 0xffff0000u); }
#pragma unroll
            for (int i = 0; i < 16; ++i) ss = fmaf(f[i], f[i], ss);
            ss += dpp_xor1(ss); ss += dpp_xor2(ss); ss += __shfl_xor(ss, 4);
            const float rs = rsqrtf(ss * (1.f / 128.f) + EPS);
#pragma unroll
            for (int i = 0; i < 16; ++i) f[i] = f[i] * rs * g[i];
            const float* cs = R128 + pos * 32;
#pragma unroll
            for (int i = 0; i < 16; ++i) { const float other = dpp_xor1(f[i]);
                if (l8 < 2) { const float c = cs[i], s = cs[16 + i]; f[i] = (l8 == 0) ? f[i] * c - other * s : f[i] * c + other * s; } }
            att::u32x4 o0, o1;
#pragma unroll
            for (int j = 0; j < 4; ++j) { o0[j] = pg8::cvt_pk_bf16(f[2 * j], f[2 * j + 1]); o1[j] = pg8::cvt_pk_bf16(f[8 + 2 * j], f[8 + 2 * j + 1]); }
            p[0] = o0; p[1] = o1;
        }
        {
#pragma unroll
            for (int part = 0; part < 2; ++part) {
                if (part == 1 && lane >= 8) break;
                att::u32x4* p = (att::u32x4*)(pr + (part == 0 ? C_IQ + lane * 8 : C_IK + lane * 8));
                const att::u32x4 v0 = p[0]; float f[8];
#pragma unroll
                for (int j = 0; j < 4; ++j) { f[2 * j] = __uint_as_float(v0[j] << 16); f[2 * j + 1] = __uint_as_float(v0[j] & 0xffff0000u); }
                const float* cs = R64 + pos * 16;
#pragma unroll
                for (int i = 0; i < 8; ++i) { const float other = dpp_xor1(f[i]);
                    if (l8 < 2) { const float c = cs[i], s = cs[8 + i]; f[i] = (l8 == 0) ? f[i] * c - other * s : f[i] * c + other * s; } }
                att::u32x4 o0;
#pragma unroll
                for (int j = 0; j < 4; ++j) o0[j] = pg8::cvt_pk_bf16(f[2 * j], f[2 * j + 1]);
                p[0] = o0;
            }
        }
    }
}
#ifndef MK_PER_PHASE
#define MK_PER_PHASE 0
#endif
constexpr int NPH = 14;
struct Args { const float* in[16]; float* out; unsigned char* ws; int ph_lo, ph_hi; };
__global__ void __launch_bounds__(NTHR, 2) mk_fwd(Args args) {
    extern __shared__ __attribute__((aligned(16))) unsigned char lds[];
    Frame F;
    F.lds = (LAS unsigned char*)lds;
    F.MISC = (volatile LAS unsigned*)(F.lds + MISC_OFF);
    F.wave = __builtin_amdgcn_readfirstlane((int)threadIdx.x >> 6);
#define RELANE() (F.lane = lane_id_opaque(), F.tid = F.wave * 64 + F.lane, true)
    RELANE();
#ifdef PROBE_ACC
    F.acc_t0 = 0ull; F.acc_sum = 0ull;
#endif
    F.G = gridDim.x; { const int bx = blockIdx.x; F.vcu = (F.G % 8 == 0) ? (bx % 8) * (F.G / 8) + bx / 8 : bx; }
    unsigned char* ws = args.ws;
    F.ctl = (gu32*)(ws + WS_CTL);
    F.x = args.in[0]; F.g_mix = args.in[1]; F.g_ffn = args.in[2]; F.w_in_ab = args.in[3]; F.gq_a = args.in[4]; F.gk_a = args.in[5]; F.w_gate_up = args.in[6]; F.b_gate = args.in[7];
    F.g_gla = args.in[8]; F.w_out_ab = args.in[9]; F.w_in_c = args.in[10]; F.gq_c = args.in[11]; F.gk_c = args.in[12]; F.w_out_c = args.in[13]; F.w_up = args.in[14]; F.w_down = args.in[15];
    F.out = args.out;
    F.Wab = (bf16*)(ws + WS_WAB); F.Woab = (bf16*)(ws + WS_WOAB); F.Wup0 = (bf16*)(ws + WS_WUP0); F.Wdn0 = (bf16*)(ws + WS_WDN0);
    F.Winc = (bf16*)(ws + WS_WINC); F.Woc = (bf16*)(ws + WS_WOC); F.Wup1 = (bf16*)(ws + WS_WUP1); F.Wdn1 = (bf16*)(ws + WS_WDN1);
    F.XB = (bf16*)(ws + WS_XB); F.CAT = (bf16*)(ws + WS_CAT); F.R1 = (bf16*)(ws + WS_R1); F.SSQ = (float*)(ws + WS_SSQ); F.MASK = (unsigned*)(ws + WS_MASK);
    for (int u = F.tid; u < (LDS_BYTES - MISC_OFF) / 4; u += NTHR) ((LAS unsigned*)(F.lds + MISC_OFF))[u] = 0u;
    __syncthreads();
    XcdBarrier bar; bar.bar = (unsigned*)(F.ctl + CW_BAR); bar.x = 0; bar.st = nullptr; bar.wave = F.wave;
    if (!MK_PER_PHASE) bar = xcd_barrier_post((unsigned*)(F.ctl + CW_BAR), F.MISC + 8, F.wave);
    const int lo = args.ph_lo, hi = args.ph_hi;
#ifdef PROBE_PH
    unsigned long long pt0 = 0ull, pt1 = 0ull;
#define STAMP(k) do { if ((k) == PROBE_PH) pt0 = __builtin_amdgcn_s_memrealtime(); if ((k) == PROBE_PH + 1) pt1 = __builtin_amdgcn_s_memrealtime(); } while (0)
#ifdef PROBE_SUB
#define SUBSTAMP(k) do { if ((k) == PROBE_PH) { __syncthreads(); pt0 = __builtin_amdgcn_s_memrealtime(); } } while (0)
#else
#define SUBSTAMP(k) do { } while (0)
#endif
#else
#define STAMP(k) do { } while (0)
#define SUBSTAMP(k) do { } while (0)
#endif
#define IN(k) (lo <= (k) && (k) < hi && RELANE())
#define SEAM(k) do { if (lo <= (k) && (k) + 1 < hi) xcd_barrier(bar); } while (0)
    float* const SSQ0 = F.SSQ, *SSQ1 = F.SSQ + (size_t)M * 16, *SSQ2 = F.SSQ + (size_t)2 * M * 16, *SSQ3 = F.SSQ + (size_t)3 * M * 16;
    typedef pg8::StaticOrder SO;
    STAMP(0); float* const R128 = (float*)(ws + WS_ROPE); float* const R64 = R128 + SEQ * 32;
    if (IN(0)) { ph_prologue(F); ph_rope_tables(F, R128, R64); } SEAM(0);
    STAMP(1); if (IN(1)) { pg8::Gemm g{F.XB, F.Wab, M, NAB, D}; SO S; S.init(M, NAB, F.G, (int)blockIdx.x); pg8::EpiScale<0> E{F.R1, NAB, SSQ0};
        pg8::gemm_phase<pg8::EpiScale<0>, SO, true, true>(F.lds, g, S, E, F.wave); } SEAM(1);
    float* const GU = (float*)(ws + WS_XB); float* const DEC = (float*)(ws + WS_DEC);
    STAMP(2); if (IN(2)) { ph_prep_a_fast(F, R128, R64); SUBSTAMP(2); gla::pass_a(F, GU, DEC, (float*)(ws + WS_BC)); } SEAM(2);
    STAMP(3); if (IN(3)) { gla::pass_b(F, GU, DEC); SUBSTAMP(3); ph_indexer(F); } SEAM(3);
    STAMP(4); if (IN(4)) { ph_dsa(F); SUBSTAMP(4); gla::pass_c(F, GU, (const float*)(ws + WS_BC)); } SEAM(4);
    STAMP(5); if (IN(5)) { pg8::Gemm g{F.CAT, F.Woab, M, D, D}; SO S; S.init(M, D, F.G, (int)blockIdx.x); pg8::EpiResid<0, 0> E{F.x, nullptr, F.XB, SSQ1, nullptr};
        pg8::gemm_phase<pg8::EpiResid<0, 0>, SO, true, true>(F.lds, g, S, E, F.wave); } SEAM(5);
    STAMP(6); if (IN(6)) { pg8::Gemm g{F.XB, F.Wup0, M, FF, D}; SO S; S.init(M, FF, F.G, (int)blockIdx.x); pg8::EpiScale<1> E{F.R1, FF, SSQ1};
        pg8::gemm_phase<pg8::EpiScale<1>, SO, true, true>(F.lds, g, S, E, F.wave); } SEAM(6);
    STAMP(7); if (IN(7)) { pg8::Gemm g{F.R1, F.Wdn0, M, D, FF}; SO S; S.init(M, D, F.G, (int)blockIdx.x); pg8::EpiResid<1, 0> E{F.XB, nullptr, F.XB, SSQ2, SSQ1};
        pg8::gemm_phase<pg8::EpiResid<1, 0>, SO, true, true>(F.lds, g, S, E, F.wave); } SEAM(7);
    STAMP(8); if (IN(8)) { pg8::Gemm g{F.XB, F.Winc, M, NC, D}; SO S; S.init(M, NC, F.G, (int)blockIdx.x); pg8::EpiScale<0> E{F.R1, NC, SSQ2};
        pg8::gemm_phase<pg8::EpiScale<0>, SO, true, true>(F.lds, g, S, E, F.wave); } SEAM(8);
    STAMP(9); if (IN(9)) { ph_prep_c_fast(F); } SEAM(9);
    STAMP(10); if (IN(10)) { ph_sb(F); } SEAM(10);
    STAMP(11); if (IN(11)) { pg8::Gemm g{F.CAT, F.Woc, M, D, D}; SO S; S.init(M, D, F.G, (int)blockIdx.x); pg8::EpiResid<1, 0> E{F.XB, nullptr, F.XB, SSQ3, nullptr};
        pg8::gemm_phase<pg8::EpiResid<1, 0>, SO, true, true>(F.lds, g, S, E, F.wave); } SEAM(11);
    STAMP(12); if (IN(12)) { pg8::Gemm g{F.XB, F.Wup1, M, FF, D}; SO S; S.init(M, FF, F.G, (int)blockIdx.x); pg8::EpiScale<1> E{F.R1, FF, SSQ3};
        pg8::gemm_phase<pg8::EpiScale<1>, SO, true, true>(F.lds, g, S, E, F.wave); } SEAM(12);
    STAMP(13); if (IN(13)) { pg8::Gemm g{F.R1, F.Wdn1, M, D, FF}; SO S; S.init(M, D, F.G, (int)blockIdx.x); pg8::EpiResid<1, 1> E{F.XB, F.out, nullptr, nullptr, SSQ3};
        pg8::gemm_phase<pg8::EpiResid<1, 1>, SO, true, true>(F.lds, g, S, E, F.wave); }
    STAMP(NPH);
#ifdef PROBE_ACC
    if (blockIdx.x == 0) { const unsigned long long t1 = __builtin_amdgcn_s_memrealtime(), dt = F.acc_sum * PROBE_MULT; while (__builtin_amdgcn_s_memrealtime() - t1 < dt) __builtin_amdgcn_s_sleep(8); }
#endif
#ifdef PROBE_PH
    if (blockIdx.x == 0) { const unsigned long long t1 = __builtin_amdgcn_s_memrealtime(), dt = (pt1 - pt0) * PROBE_MULT; while (__builtin_amdgcn_s_memrealtime() - t1 < dt) __builtin_amdgcn_s_sleep(8); }
#endif
#undef IN
#undef SEAM
}

extern "C" void kernel_launch(void* const* d_in, const int* in_sizes, int n_in, void* d_out, int out_size, void* d_ws, size_t ws_size, hipStream_t stream) {
    static int grid = 0;
    if (grid == 0) {
        if (n_in != 16 || in_sizes[0] != M * D || out_size != M * D || ws_size < WS_END) { fprintf(stderr, "kernel_launch: unexpected shapes / workspace (%d inputs, ws %zu)\n", n_in, ws_size); grid = -1; return; }
        int dev = 0, cus = 0;
        if (hipGetDevice(&dev) != hipSuccess || hipDeviceGetAttribute(&cus, hipDeviceAttributeMultiprocessorCount, dev) != hipSuccess) { grid = -1; return; }
        if (hipFuncSetAttribute((const void*)mk_fwd, hipFuncAttributeMaxDynamicSharedMemorySize, LDS_BYTES) != hipSuccess) { fprintf(stderr, "kernel_launch: hipFuncSetAttribute failed\n"); grid = -1; return; }
        (void)hipGetLastError();
        grid = cus;
    }
    if (grid < 0) return;
    if (hipMemsetAsync((char*)d_ws + WS_CTL, 0, CTL_ZERO_BYTES, stream) != hipSuccess) { fprintf(stderr, "kernel_launch: memset failed\n"); return; }
    Args a{};
    for (int i = 0; i < 16; ++i) a.in[i] = (const float*)d_in[i];
    a.out = (float*)d_out; a.ws = (unsigned char*)d_ws;
#if MK_PER_PHASE
    for (int ph = 0; ph < NPH; ++ph) { a.ph_lo = ph; a.ph_hi = ph + 1; hipLaunchKernelGGL(mk_fwd, dim3(grid), dim3(NTHR), LDS_BYTES, stream, a); }
#else
    a.ph_lo = 0; a.ph_hi = NPH;
    hipLaunchKernelGGL(mk_fwd, dim3(grid), dim3(NTHR), LDS_BYTES, stream, a);
#endif
    const hipError_t le = hipPeekAtLastError();
    if (le != hipSuccess) fprintf(stderr, "kernel_launch: launch failed: %s\n", hipGetErrorName(le));
}
```

```cpp
#include <hip/hip_runtime.h>
#include <cstdio>
#include <cstdint>
namespace pg8 {
#define PG8_LAS __attribute__((address_space(3)))
typedef unsigned short bf16_t;
typedef short bf16x8 __attribute__((ext_vector_type(8)));
typedef float f32x4 __attribute__((ext_vector_type(4)));
typedef unsigned u32x4 __attribute__((ext_vector_type(4)));
constexpr int BM = 256, BK = 64, HALF = 128, HTB = HALF * BK * 2  , STAGE_BYTES = 8 * HTB, NXCD = 8, WGM = 8;

__host__ __device__ __forceinline__ int lds_byte(int r, int c) { const int st = (r >> 4) * 2 + (c >> 5), rr = r & 15, cc = c & 31, ob = rr * 64 + cc * 2; return st * 1024 + (ob ^ (((ob >> 9) & 1) << 5)); }
__host__ __device__ __forceinline__ void stage_rc(int b, int& R, int& C) { const int st = b / 1024, sb = b % 1024, swz = sb ^ (((sb >> 9) & 1) << 5); R = (st >> 1) * 16 + swz / 64; C = (st & 1) * 32 + (swz % 64) / 2; }
__host__ __device__ __forceinline__ int perm32(int rho) { const int n = rho >> 4, i = rho & 15; return 8 * (i >> 2) + 4 * n + (i & 3); }

struct Unit { int pm, pn; };
struct Gemm { const bf16_t* A; const bf16_t* Bt; int M, N, K; };

struct StaticOrder {
    int nM, nN, nwg, G, c;
    __host__ __device__ void init(int M, int N, int G_, int c_) { nM = M / BM; nN = N / BM; nwg = nM * nN; G = G_; c = c_; }
    __host__ __device__ bool next(int i, Unit& u) const {
        const long L = (long)i * G + c; if (L >= nwg) return false;
        int wgid = (int)L; { const int q = nwg / NXCD, r = nwg % NXCD, xcd = wgid % NXCD, off = wgid / NXCD; wgid = (xcd < r ? xcd * (q + 1) : r * (q + 1) + (xcd - r) * q) + off; }
        const int nig = WGM * nN, gid = wgid / nig, fm = gid * WGM, gsz = (nM - fm) < WGM ? (nM - fm) : WGM;
        u.pm = fm + ((wgid % nig) % gsz); u.pn = (wgid % nig) / gsz; return true;
    }
    __device__ __forceinline__ void a_ready(const Unit&) const {}
    __device__ __forceinline__ void done(const Unit&) const {}
};

__device__ __forceinline__ unsigned cvt_pk_bf16(float lo, float hi) { unsigned r; asm volatile("v_cvt_pk_bf16_f32 %0, %1, %2" : "=v"(r) : "v"(lo), "v"(hi)); return r; }
__device__ __forceinline__ float row_rstd(const float* ssqp, int row) {
    const f32x4* p = (const f32x4*)(ssqp + (size_t)row * 16);
    const f32x4 a = p[0], b = p[1], c = p[2], d = p[3];
    const float s = (((a[0] + a[1]) + (a[2] + a[3])) + ((b[0] + b[1]) + (b[2] + b[3]))) + (((c[0] + c[1]) + (c[2] + c[3])) + ((d[0] + d[1]) + (d[2] + d[3])));
    return rsqrtf(s * (1.0f / 1024.0f) + 1e-6f);
}
template <int ACT  > struct EpiScale {
    static constexpr bool PERM = true, AFTER_DRAIN = false;
    bf16_t* O; int ldc; const float* ssqp;
    __device__ __forceinline__ void operator()(const f32x4 (&acc)[2][2][4][2], const Unit& u, int wr, int wc, int fr, int fq) const {
        const int row0 = u.pm * BM + wr * 64 + fr, col0 = u.pn * BM + wc * 32 + 8 * fq;
#pragma unroll
        for (int ai = 0; ai < 2; ++ai)
#pragma unroll
            for (int m = 0; m < 4; ++m) {
                const int row = row0 + ai * HALF + m * 16;
                const float rs = (ACT == 0) ? row_rstd(ssqp, row) : 1.0f;
                bf16_t* rowp = O + (size_t)row * ldc + col0;
#pragma unroll
                for (int bj = 0; bj < 2; ++bj) {
                    f32x4 v0 = acc[ai][bj][m][0] * rs, v1 = acc[ai][bj][m][1] * rs;
                    if (ACT == 1) {
#pragma unroll
                        for (int e = 0; e < 4; ++e) { const float a0 = fmaxf(v0[e], 0.f), a1 = fmaxf(v1[e], 0.f); v0[e] = a0 * a0; v1[e] = a1 * a1; }
                    }
                    u32x4 w; w.x = cvt_pk_bf16(v0[0], v0[1]); w.y = cvt_pk_bf16(v0[2], v0[3]); w.z = cvt_pk_bf16(v1[0], v1[1]); w.w = cvt_pk_bf16(v1[2], v1[3]);
                    *(u32x4*)(rowp + bj * HALF) = w;
                }
            }
    }
};
template <int RIN, int OUT> struct EpiResid {
    static constexpr bool PERM = true, AFTER_DRAIN = false;
    const void* R; float* out; bf16_t* hb; float* ssqp; const float* ssq_in;
    __device__ __forceinline__ void operator()(const f32x4 (&acc)[2][2][4][2], const Unit& u, int wr, int wc, int fr, int fq) const {
        const int row0 = u.pm * BM + wr * 64 + fr, col0 = u.pn * BM + wc * 32 + 8 * fq;
#pragma unroll
        for (int ai = 0; ai < 2; ++ai)
#pragma unroll
            for (int m = 0; m < 4; ++m) {
                const int row = row0 + ai * HALF + m * 16;
                const size_t off = (size_t)row * 1024 + col0;
                float sc2 = 1.0f; if (ssq_in) { const float rs = row_rstd(ssq_in, row); sc2 = rs * rs; }
                float ss = 0.f;
#pragma unroll
                for (int bj = 0; bj < 2; ++bj) {
                    f32x4 r0, r1;
                    if (RIN == 0) { r0 = *(const f32x4*)((const float*)R + off + bj * HALF); r1 = *(const f32x4*)((const float*)R + off + bj * HALF + 4); }
                    else { const u32x4 rw = *(const u32x4*)((const bf16_t*)R + off + bj * HALF);
                        r0 = (f32x4){__uint_as_float(rw.x << 16), __uint_as_float(rw.x & 0xffff0000u), __uint_as_float(rw.y << 16), __uint_as_float(rw.y & 0xffff0000u)};
                        r1 = (f32x4){__uint_as_float(rw.z << 16), __uint_as_float(rw.z & 0xffff0000u), __uint_as_float(rw.w << 16), __uint_as_float(rw.w & 0xffff0000u)}; }
                    const f32x4 v0 = acc[ai][bj][m][0] * sc2 + r0, v1 = acc[ai][bj][m][1] * sc2 + r1;
                    if (OUT == 1) { *(f32x4*)(out + off + bj * HALF) = v0; *(f32x4*)(out + off + bj * HALF + 4) = v1; }
                    else {
                        u32x4 w; w.x = cvt_pk_bf16(v0[0], v0[1]); w.y = cvt_pk_bf16(v0[2], v0[3]); w.z = cvt_pk_bf16(v1[0], v1[1]); w.w = cvt_pk_bf16(v1[2], v1[3]);
                        *(u32x4*)(hb + off + bj * HALF) = w;
                        ss += ((v0[0] * v0[0] + v0[1] * v0[1]) + (v0[2] * v0[2] + v0[3] * v0[3])) + ((v1[0] * v1[0] + v1[1] * v1[1]) + (v1[2] * v1[2] + v1[3] * v1[3]));
                    }
                }
                if (OUT == 0) { ss += __shfl_xor(ss, 16); ss += __shfl_xor(ss, 32); if (fq == 0) ssqp[(size_t)row * 16 + u.pn * 4 + wc] = ss; }
            }
    }
};
template <class Epi, class Sched, bool ALIGN_EPI = false, bool SP2 = false>
__device__ __forceinline__ void gemm_phase(PG8_LAS unsigned char* lds, const Gemm g, const Sched& S, const Epi& E, const int wave_in) {
    const int wid = wave_in, lane = (int)__builtin_amdgcn_mbcnt_hi(~0u, __builtin_amdgcn_mbcnt_lo(~0u, 0u)), tid = wid * 64 + lane, wr = wid >> 2, wc = wid & 3, fr = lane & 15, fq = lane >> 4;
    const int K = g.K, nt = K / BK;
    unsigned voffA[2], voffB[2];
#pragma unroll
    for (int i = 0; i < 2; ++i) { int R, C; stage_rc(tid * 16 + i * 8192, R, C); const int Rb = Epi::PERM ? ((R & ~31) + perm32(R & 31)) : R;
        voffA[i] = (unsigned)(R * K + C) * 2u; voffB[i] = (unsigned)(Rb * K + C) * 2u; }
    const size_t kstep = (size_t)(BK * 2);
    const size_t hstep = (size_t)HALF * K * 2;
    const size_t tstep = 2 * hstep;
    const unsigned ldsw = (unsigned)wid * 1024u;
    const int aoff = lds_byte(wr * 64 + fr, fq * 8), boff = lds_byte(wc * 32 + fr, fq * 8);
#define PG8_SA(b, h) (((b) * 2 + (h)) * HTB)
#define PG8_SB(b, h) ((4 + (b) * 2 + (h)) * HTB)
#define PG8_STAGE(bufoff, gbase, voff) do { _Pragma("unroll") for (int _i = 0; _i < 2; ++_i) \
        __builtin_amdgcn_global_load_lds((const unsigned*)((const char*)(gbase) + (voff)[_i]), (PG8_LAS unsigned*)(lds + (bufoff) + ldsw + _i * 8192), 16, 0, 0); } while (0)
#define PG8_LDA(dst, b, h) do { _Pragma("unroll") for (int m = 0; m < 4; ++m) _Pragma("unroll") for (int k = 0; k < 2; ++k) dst[m][k] = *(const PG8_LAS bf16x8*)(lds + PG8_SA(b, h) + aoff + m * 2048 + k * 1024); } while (0)
#define PG8_LDB(dst, b, h) do { _Pragma("unroll") for (int n = 0; n < 2; ++n) _Pragma("unroll") for (int k = 0; k < 2; ++k) dst[n][k] = *(const PG8_LAS bf16x8*)(lds + PG8_SB(b, h) + boff + n * 2048 + k * 1024); } while (0)
#define PG8_MMA(ai, bj, At, Bt) do { __builtin_amdgcn_s_setprio(1); _Pragma("unroll") for (int m = 0; m < 4; ++m) _Pragma("unroll") for (int n = 0; n < 2; ++n) _Pragma("unroll") for (int k = 0; k < 2; ++k) \
        acc[ai][bj][m][n] = __builtin_amdgcn_mfma_f32_16x16x32_bf16(Bt[n][k], At[m][k], acc[ai][bj][m][n], 0, 0, 0); __builtin_amdgcn_s_setprio(0); } while (0)
#define PG8_WAIT_V(n) asm volatile("s_waitcnt vmcnt(" #n ")" ::: "memory")
#define PG8_WAIT_L(n) asm volatile("s_waitcnt lgkmcnt(" #n ")" ::: "memory")
#define PG8_BAR __builtin_amdgcn_s_barrier()
#define PG8_SCHED __builtin_amdgcn_sched_barrier(0)
    Unit cur, nxt; int ui = 0;
    if (!S.next(0, cur)) return;
    f32x4 acc[2][2][4][2];
#pragma unroll
    for (int a = 0; a < 2; ++a)
#pragma unroll
        for (int b = 0; b < 2; ++b)
#pragma unroll
            for (int m = 0; m < 4; ++m)
#pragma unroll
                for (int n = 0; n < 2; ++n) acc[a][b][m][n] = (f32x4){0.f, 0.f, 0.f, 0.f};
    bf16x8 At[4][2], B0[2][2], B1[2][2];
    const char* cA = (const char*)g.A + (size_t)cur.pm * tstep; const char* cB = (const char*)g.Bt + (size_t)cur.pn * tstep;
    S.a_ready(cur);
    if constexpr (SP2) {
        PG8_STAGE(PG8_SB(0, 0), cB, voffB); PG8_STAGE(PG8_SB(0, 1), cB + hstep, voffB); PG8_STAGE(PG8_SA(0, 0), cA, voffA); PG8_STAGE(PG8_SA(0, 1), cA + hstep, voffA);
        if (wr == 1) PG8_BAR;
        PG8_WAIT_V(2); PG8_BAR;
        PG8_STAGE(PG8_SB(1, 0), cB + kstep, voffB); PG8_STAGE(PG8_SA(1, 0), cA + kstep, voffA); PG8_STAGE(PG8_SB(1, 1), cB + hstep + kstep, voffB);
        PG8_WAIT_V(6); PG8_BAR;
    } else {
        PG8_STAGE(PG8_SB(0, 0), cB, voffB); PG8_STAGE(PG8_SA(0, 0), cA, voffA); PG8_STAGE(PG8_SB(0, 1), cB + hstep, voffB); PG8_STAGE(PG8_SA(0, 1), cA + hstep, voffA);
        if (wr == 1) PG8_BAR;
        PG8_WAIT_V(4); PG8_BAR;
        PG8_STAGE(PG8_SB(1, 0), cB + kstep, voffB); PG8_STAGE(PG8_SA(1, 0), cA + kstep, voffA); PG8_STAGE(PG8_SB(1, 1), cB + hstep + kstep, voffB);
        PG8_WAIT_V(6); PG8_BAR;
    }
    for (;;) {
        const bool has_next = S.next(ui + 1, nxt);
        const char* nA = has_next ? (const char*)g.A + (size_t)nxt.pm * tstep : cA; const char* nB = has_next ? (const char*)g.Bt + (size_t)nxt.pn * tstep : cB;
        for (int t = 0; t < nt; t += 2) {
            const bool last = (t == nt - 2);
            const char* a1 = cA + (size_t)(t + 1) * kstep;
            const char* a2 = last ? nA : cA + (size_t)(t + 2) * kstep; const char* b2 = last ? nB : cB + (size_t)(t + 2) * kstep;
            const char* a3 = a2 + kstep; const char* b3 = b2 + kstep;
            if (last && has_next) S.a_ready(nxt);
            if constexpr (SP2) {
            PG8_LDB(B0, 0, 0); PG8_LDB(B1, 0, 1); PG8_SCHED; PG8_LDA(At, 0, 0); PG8_STAGE(PG8_SA(1, 1), a1 + hstep, voffA);
            PG8_WAIT_V(8); PG8_WAIT_L(0); PG8_BAR; PG8_MMA(0, 0, At, B0); PG8_MMA(0, 1, At, B1); PG8_BAR; PG8_SCHED;
            PG8_LDA(At, 0, 1); PG8_STAGE(PG8_SB(0, 0), b2, voffB); PG8_STAGE(PG8_SB(0, 1), b2 + hstep, voffB); PG8_STAGE(PG8_SA(0, 0), a2, voffA);
            PG8_WAIT_V(8); PG8_WAIT_L(0); PG8_BAR; PG8_MMA(1, 0, At, B0); PG8_MMA(1, 1, At, B1); PG8_BAR; PG8_SCHED;
            PG8_LDB(B0, 1, 0); PG8_LDB(B1, 1, 1); PG8_SCHED; PG8_LDA(At, 1, 0); PG8_STAGE(PG8_SA(0, 1), a2 + hstep, voffA);
            PG8_WAIT_V(8); PG8_WAIT_L(0); PG8_BAR; PG8_MMA(0, 0, At, B0); PG8_MMA(0, 1, At, B1); PG8_BAR; PG8_SCHED;
            PG8_LDA(At, 1, 1); PG8_STAGE(PG8_SB(1, 0), b3, voffB); PG8_STAGE(PG8_SB(1, 1), b3 + hstep, voffB); PG8_STAGE(PG8_SA(1, 0), a3, voffA);
            PG8_WAIT_V(8); PG8_WAIT_L(0); PG8_BAR; PG8_MMA(1, 0, At, B0); PG8_MMA(1, 1, At, B1); PG8_BAR; PG8_SCHED;
            } else {
            PG8_LDB(B0, 0, 0); PG8_SCHED; PG8_LDA(At, 0, 0); PG8_STAGE(PG8_SA(1, 1), a1 + hstep, voffA);
            PG8_WAIT_L(8); PG8_BAR; PG8_WAIT_L(0); PG8_MMA(0, 0, At, B0); PG8_BAR; PG8_SCHED;
            PG8_LDB(B1, 0, 1); PG8_STAGE(PG8_SB(0, 0), b2, voffB);
            PG8_BAR; PG8_WAIT_L(0); PG8_MMA(0, 1, At, B1); PG8_BAR;
            PG8_LDA(At, 0, 1); PG8_STAGE(PG8_SA(0, 0), a2, voffA);
            PG8_BAR; PG8_WAIT_L(0); PG8_MMA(1, 0, At, B0); PG8_BAR; PG8_SCHED;
            PG8_STAGE(PG8_SB(0, 1), b2 + hstep, voffB);
            PG8_WAIT_V(6); PG8_BAR; PG8_MMA(1, 1, At, B1); PG8_BAR;
            PG8_LDB(B0, 1, 0); PG8_SCHED; PG8_LDA(At, 1, 0); PG8_STAGE(PG8_SA(0, 1), a2 + hstep, voffA);
            PG8_WAIT_L(8); PG8_BAR; PG8_WAIT_L(0); PG8_MMA(0, 0, At, B0); PG8_BAR; PG8_SCHED;
            PG8_LDB(B1, 1, 1); PG8_STAGE(PG8_SB(1, 0), b3, voffB);
            PG8_BAR; PG8_WAIT_L(0); PG8_MMA(0, 1, At, B1); PG8_BAR;
            PG8_LDA(At, 1, 1); PG8_STAGE(PG8_SA(1, 0), a3, voffA);
            PG8_BAR; PG8_WAIT_L(0); PG8_MMA(1, 0, At, B0); PG8_BAR; PG8_SCHED;
            PG8_STAGE(PG8_SB(1, 1), b3 + hstep, voffB);
            PG8_WAIT_V(6); PG8_BAR; PG8_MMA(1, 1, At, B1); PG8_BAR;
            }
        }
        if constexpr (ALIGN_EPI) { if (wr == 0) PG8_BAR; }
        if constexpr (!Epi::AFTER_DRAIN) { E(acc, cur, wr, wc, fr, fq); S.done(cur); }
        if (!has_next) break;
#pragma unroll
        for (int a = 0; a < 2; ++a)
#pragma unroll
            for (int b = 0; b < 2; ++b)
#pragma unroll
                for (int m = 0; m < 4; ++m)
#pragma unroll
                    for (int n = 0; n < 2; ++n) acc[a][b][m][n] = (f32x4){0.f, 0.f, 0.f, 0.f};
        cur = nxt; cA = nA; cB = nB; ++ui;
        if constexpr (ALIGN_EPI) { if (wr == 1) PG8_BAR; }
    }
    PG8_WAIT_V(0);
    if constexpr (!ALIGN_EPI) { if (wr == 0) PG8_BAR; }
    PG8_BAR;
    if constexpr (Epi::AFTER_DRAIN) { E.fused(acc, cur, wr, wc, fr, fq, lds, wid, lane); S.done(cur); }
#undef PG8_SA
#undef PG8_SB
#undef PG8_STAGE
#undef PG8_LDA
#undef PG8_LDB
#undef PG8_MMA
#undef PG8_WAIT_V
#undef PG8_WAIT_L
#undef PG8_BAR
#undef PG8_SCHED
}
}
#include <cmath>
constexpr int NWAVES = 8, NTHR = 512;
constexpr int BATCH = 16, SEQ = 2048, M = BATCH * SEQ, D = 1024, FF = 4096, NAB = 3840, NC = 3072, ABP_OLD = 3672;
constexpr int C_QA = 0, C_KA = 512, C_VA = 1024, C_IQ = 1536, C_QB = 2048, C_KB = 2304, C_VB = 2560, C_OG = 3072, C_IK = 3584, C_IW = 3648, C_GL = 3656;
constexpr float EPS = 1e-6f;
constexpr size_t MiB = 1u << 20;
constexpr size_t WS_CTL = 0, CTL_ZERO_BYTES = 64 * 1024;
constexpr size_t WS_WAB = 1 * MiB, WS_WOAB = 9 * MiB, WS_WUP0 = 11 * MiB, WS_WDN0 = 19 * MiB, WS_WINC = 27 * MiB, WS_WOC = 33 * MiB, WS_WUP1 = 35 * MiB, WS_WDN1 = 43 * MiB;
constexpr size_t WS_SSQ = 51 * MiB, SSQ_BYTES = 2 * MiB;
constexpr size_t WS_DEC = 59 * MiB;
constexpr size_t WS_ROPE = 59 * MiB + 512 * 1024;
constexpr size_t WS_XB = 60 * MiB;
constexpr size_t WS_CAT = 124 * MiB;
constexpr size_t WS_MASK = 188 * MiB;
constexpr size_t WS_R1 = 196 * MiB;
constexpr size_t WS_BC = 452 * MiB;
constexpr size_t WS_END = 484 * MiB;
constexpr int CW_BAR = 4096;
constexpr int RING_BYTES = 131072;
constexpr int LDS_BYTES = 163840;
constexpr int MISC_OFF = LDS_BYTES - 256;
#define GAS __attribute__((address_space(1)))
#define LAS __attribute__((address_space(3)))
typedef unsigned short bf16;
typedef unsigned v4u __attribute__((ext_vector_type(4)));
typedef float f32x4 __attribute__((ext_vector_type(4)));
typedef short bf16x8 __attribute__((ext_vector_type(8)));
typedef GAS unsigned gu32;
typedef GAS unsigned long long gu64;
#define RLX_AGENT __ATOMIC_RELAXED, __HIP_MEMORY_SCOPE_AGENT
#define LDS_WAIT() asm volatile("s_waitcnt lgkmcnt(0)" ::: "memory")
#define VM_WAIT() asm volatile("s_waitcnt vmcnt(0)" ::: "memory")
__device__ __forceinline__ unsigned long long rt() { return __builtin_amdgcn_s_memrealtime(); }
__device__ __forceinline__ unsigned f2bf(float f) { unsigned u = __builtin_bit_cast(unsigned, f); return (u + 0x7fffu + ((u >> 16) & 1u)) >> 16; }
__device__ __forceinline__ unsigned pk2(float lo, float hi) { return f2bf(lo) | (f2bf(hi) << 16); }
#define XB_TMO      128
#define XB_XCNT(j)  (256  + 64 * (j))
#define XB_XSUB(j)  (1280 + 64 * (j))
#define XB_XGEN(j)  (2304 + 64 * (j))
#define XB_TOP      3328
#define XB_TOPGEN   3392
#define XCD_BAR_WORDS 3456
#define XB_SPIN_CAP (1u << 18)

__device__ __forceinline__ unsigned xb_ld(unsigned* p)              { return __hip_atomic_load(p, __ATOMIC_RELAXED, __HIP_MEMORY_SCOPE_AGENT); }
__device__ __forceinline__ unsigned xb_add(unsigned* p, unsigned v) { return __hip_atomic_fetch_add(p, v, __ATOMIC_RELAXED, __HIP_MEMORY_SCOPE_AGENT); }
__device__ __forceinline__ unsigned xb_xcc_id() { return (unsigned)__builtin_amdgcn_s_getreg((3 << 11) | 20) & 0xFu; }
#define XB_SPIN(cond, bar) do { unsigned _sp = 0; while (cond) { __builtin_amdgcn_s_sleep(1); \
    if ((++_sp & 255u) == 0u) { if (xb_ld(&(bar)[XB_TMO])) break; if (_sp > XB_SPIN_CAP) { atomicAdd(&(bar)[XB_TMO], 1u); break; } } } } while (0)

struct XcdBarrier {
    unsigned* bar; unsigned x; int wave;
    volatile LAS unsigned* st;
};

__device__ __forceinline__ bool xb_t0(int wave) { return wave == 0 && __builtin_amdgcn_mbcnt_hi(~0u, __builtin_amdgcn_mbcnt_lo(~0u, 0u)) == 0u; }
__device__ __forceinline__ XcdBarrier xcd_barrier_post(unsigned* bar, volatile LAS unsigned* st, int wave) {
    XcdBarrier b; b.bar = bar; b.x = xb_xcc_id(); b.st = st; b.wave = wave;
    if (xb_t0(wave)) (void)xb_add(&bar[XB_XCNT(b.x)], 1u);
    return b;
}
__device__ __forceinline__ void xcd_barrier_complete(unsigned* bar, unsigned x, unsigned& nloc, unsigned& nx) {
    const unsigned G = gridDim.x * gridDim.y * gridDim.z;
    unsigned sum, cnt, mine, sp = 0u;
    for (;;) {
        sum = 0u; cnt = 0u; mine = 0u;
#pragma unroll
        for (unsigned j = 0; j < 16; ++j) { const unsigned c = xb_ld(&bar[XB_XCNT(j)]); sum += c; cnt += (c > 0u) ? 1u : 0u; mine = (j == x) ? c : mine; }
        if (sum == G) break;
        __builtin_amdgcn_s_sleep(1);
        if ((++sp & 255u) == 0u) { if (xb_ld(&bar[XB_TMO])) break; if (sp > XB_SPIN_CAP) { atomicAdd(&bar[XB_TMO], 1u); break; } }
    }
    nloc = mine > 0u ? mine : 1u; nx = cnt > 0u ? cnt : 1u;
}

__device__ __forceinline__ void xcd_barrier(const XcdBarrier& b) {
    asm volatile("s_waitcnt vmcnt(0)" ::: "memory");
    __syncthreads();
    if (xb_t0(b.wave)) {
        unsigned* bar = b.bar;
        __builtin_amdgcn_s_waitcnt(0);
        unsigned nloc = b.st[0], nx = b.st[1];
        if (nloc == 0u) { xcd_barrier_complete(bar, b.x, nloc, nx); b.st[0] = nloc; b.st[1] = nx; }
        const unsigned old = xb_add(&bar[XB_XSUB(b.x)], 1u);
        const unsigned gen = old / nloc;
        if (old + 1u == (gen + 1u) * nloc) {
            __builtin_amdgcn_fence(__ATOMIC_RELEASE, "agent");
            asm volatile("s_waitcnt vmcnt(0)" ::: "memory");
            const unsigned og = xb_add(&bar[XB_TOP], 1u);
            const unsigned tg = og / nx;
            if (og + 1u == (tg + 1u) * nx) xb_add(&bar[XB_TOPGEN], 1u);
            else XB_SPIN(xb_ld(&bar[XB_TOPGEN]) == tg, bar);
            __builtin_amdgcn_fence(__ATOMIC_ACQUIRE, "agent");
            xb_add(&bar[XB_XGEN(b.x)], 1u);
            asm volatile("s_waitcnt vmcnt(0)" ::: "memory");
        } else {
            XB_SPIN(xb_ld(&bar[XB_XGEN(b.x)]) == gen, bar);
            __builtin_amdgcn_fence(__ATOMIC_ACQUIRE, "agent");
            asm volatile("s_waitcnt vmcnt(0)" ::: "memory");
        }
    }
    __syncthreads();
}
#ifdef PROBE_ACC
#define ACC_BEGIN(F, id) do { if ((id) == PROBE_ACC) { __syncthreads(); (F).acc_t0 = __builtin_amdgcn_s_memrealtime(); } } while (0)
#define ACC_END(F, id) do { if ((id) == PROBE_ACC) { __syncthreads(); (F).acc_sum += __builtin_amdgcn_s_memrealtime() - (F).acc_t0; } } while (0)
#else
#define ACC_BEGIN(F, id) do { } while (0)
#define ACC_END(F, id) do { } while (0)
#endif
struct Frame {
#ifdef PROBE_ACC
    unsigned long long acc_t0, acc_sum;
#endif
    LAS unsigned char* lds;
    volatile LAS unsigned* MISC;
    gu32* ctl;
    int tid, lane, wave, vcu, G;
    const float *x, *g_mix, *g_ffn, *w_in_ab, *gq_a, *gk_a, *w_gate_up, *b_gate, *g_gla, *w_out_ab, *w_in_c, *gq_c, *gk_c, *w_out_c, *w_up, *w_down;
    float* out;
    bf16 *Wab, *Woab, *Wup0, *Wdn0, *Winc, *Woc, *Wup1, *Wdn1;
    bf16 *XB, *CAT, *R1;
    float* SSQ; unsigned* MASK;
};
__device__ __forceinline__ int lane_id_opaque() { int l; asm volatile("v_mbcnt_lo_u32_b32 %0, -1, 0\n\tv_mbcnt_hi_u32_b32 %0, -1, %0" : "=v"(l)); return l; }
__device__ __forceinline__ float bf2f(bf16 v) { return __builtin_bit_cast(float, (unsigned)v << 16); }
__device__ __forceinline__ float wave_sum(float v) {
#pragma unroll
    for (int o = 1; o < 64; o <<= 1) v += __shfl_xor(v, o);
    return v;
}
__device__ __forceinline__ float wave_max(float v) {
#pragma unroll
    for (int o = 1; o < 64; o <<= 1) v = fmaxf(v, __shfl_xor(v, o));
    return v;
}
__device__ __forceinline__ float log_sigmoid(float x) { return fminf(x, 0.f) - log1pf(expf(-fabsf(x))); }

__device__ __forceinline__ int oldcol_ab(int n) {
    if (n < 2048) return n;
    if (n < 2304) return 2120 + (n - 2048);
    if (n < 2560) return 2376 + (n - 2304);
    if (n < 3072) return 2632 + (n - 2560);
    if (n < 3584) return 3160 + (n - 3072);
    if (n < 3648) return 2048 + (n - 3584);
    if (n < 3656) return 2112 + (n - 3648);
    if (n < 3672) return 3144 + (n - 3656);
    return -1;
}
__device__ __forceinline__ void p0_transpose_item(const float* W, int ldw, int K, const float* gain, bf16* WT, bool map, int item, int nblk, int lane) {
    const int kb = item / nblk, nb = item % nblk, ng = lane & 7, ko = lane >> 3, k0 = 64 * kb + 8 * ko, n = 32 * nb + 4 * ng;
    const int oc = map ? oldcol_ab(n) : n;
    f32x4 v[8];
#pragma unroll
    for (int i = 0; i < 8; ++i) { v[i] = (f32x4){0.f, 0.f, 0.f, 0.f}; if (oc >= 0) v[i] = *(const GAS f32x4*)(W + (size_t)(k0 + i) * ldw + oc); }
    if (gain) { const f32x4 g0 = *(const GAS f32x4*)(gain + k0), g1 = *(const GAS f32x4*)(gain + k0 + 4);
#pragma unroll
        for (int i = 0; i < 4; ++i) { v[i] = v[i] * g0[i]; v[4 + i] = v[4 + i] * g1[i]; } }
#pragma unroll
    for (int e = 0; e < 4; ++e) { v4u o; o.x = pk2(v[0][e], v[1][e]); o.y = pk2(v[2][e], v[3][e]); o.z = pk2(v[4][e], v[5][e]); o.w = pk2(v[6][e], v[7][e]);
        *(GAS v4u*)(WT + (size_t)(n + e) * K + k0) = o; }
}
template <int PART> __device__ __forceinline__ void prologue_weights(Frame& F, int gw, int NGW) {
    constexpr int I_AB = (D / 64) * (NAB / 32), I_O = (D / 64) * (D / 32), I_UP = (D / 64) * (FF / 32), I_DN = (FF / 64) * (D / 32), I_C = (D / 64) * (NC / 32);
    if (PART == 0) { for (int it = gw; it < I_AB; it += NGW) p0_transpose_item(F.w_in_ab, ABP_OLD, D, F.g_mix, F.Wab, true, it, NAB / 32, F.lane); return; }
    constexpr int NITEMS = 2 * I_O + 2 * I_UP + 2 * I_DN + I_C;
    for (int it = gw; it < NITEMS; it += NGW) {
        int r = it;
        if (r < I_O) { p0_transpose_item(F.w_out_ab, D, D, nullptr, F.Woab, false, r, D / 32, F.lane); continue; } r -= I_O;
        if (r < I_UP) { p0_transpose_item(F.w_up, FF, D, F.g_ffn, F.Wup0, false, r, FF / 32, F.lane); continue; } r -= I_UP;
        if (r < I_DN) { p0_transpose_item(F.w_down, D, FF, nullptr, F.Wdn0, false, r, D / 32, F.lane); continue; } r -= I_DN;
        if (r < I_C) { p0_transpose_item(F.w_in_c, NC, D, F.g_mix + D, F.Winc, false, r, NC / 32, F.lane); continue; } r -= I_C;
        if (r < I_O) { p0_transpose_item(F.w_out_c, D, D, nullptr, F.Woc, false, r, D / 32, F.lane); continue; } r -= I_O;
        if (r < I_UP) { p0_transpose_item(F.w_up + (size_t)D * FF, FF, D, F.g_ffn + D, F.Wup1, false, r, FF / 32, F.lane); continue; } r -= I_UP;
        p0_transpose_item(F.w_down + (size_t)FF * D, D, FF, nullptr, F.Wdn1, false, r, D / 32, F.lane);
    }
}
__device__ __forceinline__ void ph_prologue(Frame& F) {
    const int gw = F.vcu * NWAVES + F.wave, NGW = F.G * NWAVES;
    prologue_weights<0>(F, gw, NGW);
    if (F.G != 256) prologue_weights<1>(F, gw, NGW);
    for (int m0 = gw; m0 < M; m0 += 4 * NGW) {
        f32x4 v[4][4]; float s[4];
#pragma unroll
        for (int r = 0; r < 4; ++r) { const int m = m0 + r * NGW; const GAS f32x4* xr = (const GAS f32x4*)(F.x + (size_t)(m < M ? m : m0) * D) + F.lane;
#pragma unroll
            for (int j = 0; j < 4; ++j) v[r][j] = xr[64 * j]; }
#pragma unroll
        for (int r = 0; r < 4; ++r) { float t = 0.f;
#pragma unroll
            for (int j = 0; j < 4; ++j) t += (v[r][j].x * v[r][j].x + v[r][j].y * v[r][j].y) + (v[r][j].z * v[r][j].z + v[r][j].w * v[r][j].w);
            s[r] = t; }
#pragma unroll
        for (int o = 1; o < 64; o <<= 1) {
#pragma unroll
            for (int r = 0; r < 4; ++r) s[r] += __shfl_xor(s[r], o); }
#pragma unroll
        for (int r = 0; r < 4; ++r) { const int m = m0 + r * NGW; if (m < M) {
            GAS unsigned long long* o8 = (GAS unsigned long long*)(F.XB + (size_t)m * D) + F.lane;
#pragma unroll
            for (int j = 0; j < 4; ++j) o8[64 * j] = (unsigned long long)pk2(v[r][j].x, v[r][j].y) | ((unsigned long long)pk2(v[r][j].z, v[r][j].w) << 32);
            if (F.lane < 16) F.SSQ[(size_t)m * 16 + F.lane] = (F.lane == 0) ? s[r] : 0.f; } }
    }
}
namespace att {
typedef short s16x4 __attribute__((ext_vector_type(4)));
typedef float f32x16 __attribute__((ext_vector_type(16)));
typedef _Float16 f16x8 __attribute__((ext_vector_type(8)));
typedef unsigned u32x4 __attribute__((ext_vector_type(4)));
typedef short v4i16_t __attribute__((ext_vector_type(4)));
constexpr float C2 = 0.08838834764831845f * 1.4426950408889634f;
__device__ __forceinline__ int crow(int r, int hi) { return (r & 3) + 8 * (r >> 2) + 4 * hi; }
__device__ __forceinline__ int img_off(int row, int ch) { return 256 * row + 16 * (ch ^ (((row & 3) << 2) | ((row >> 2) & 3))); }
__device__ __forceinline__ bf16x8 pack8(float a0, float a1, float a2, float a3, float a4, float a5, float a6, float a7) {
    u32x4 w; w.x = pg8::cvt_pk_bf16(a0, a1); w.y = pg8::cvt_pk_bf16(a2, a3); w.z = pg8::cvt_pk_bf16(a4, a5); w.w = pg8::cvt_pk_bf16(a6, a7);
    return __builtin_bit_cast(bf16x8, w);
}
__device__ __forceinline__ f16x8 pack8h(float a0, float a1, float a2, float a3, float a4, float a5, float a6, float a7) {
    f16x8 r; r[0] = (_Float16)a0; r[1] = (_Float16)a1; r[2] = (_Float16)a2; r[3] = (_Float16)a3; r[4] = (_Float16)a4; r[5] = (_Float16)a5; r[6] = (_Float16)a6; r[7] = (_Float16)a7; return r;
}
__device__ __forceinline__ void dma_off_init(unsigned (&dvo)[2], int ld, int wave, int lane) {
#pragma unroll
    for (int i = 0; i < 2; ++i) { const int pi = 2 * wave + i, row = 4 * pi + (lane >> 4), pc = lane & 15, ch = pc ^ (((row & 3) << 2) | ((row >> 2) & 3)); dvo[i] = (unsigned)(row * ld + ch * 8) * 2u; }
}
__device__ __forceinline__ void tile_dma(const bf16* g, const unsigned (&dvo)[2], LAS unsigned char* buf, int wave) {
#pragma unroll
    for (int i = 0; i < 2; ++i) __builtin_amdgcn_global_load_lds((const unsigned*)((const char*)g + dvo[i]), (LAS unsigned*)(buf + 1024 * (2 * wave + i)), 16, 0, 0);
}
struct FragOff { int k[8]; int va[4]; int vd; };
__device__ __forceinline__ void frag_off_init(FragOff& fo, int lane) {
    const int hi = lane >> 5, r32 = lane & 31, i = lane & 15, q = i >> 2, p = i & 3, x = 2 * ((lane >> 4) & 1) + (p >> 1);
#pragma unroll
    for (int ks = 0; ks < 8; ++ks) fo.k[ks] = img_off(r32, 2 * ks + hi);
#pragma unroll
    for (int ct = 0; ct < 4; ++ct) fo.va[ct] = img_off(4 * hi + q, 4 * ct + x) + 8 * (p & 1);
    fo.vd = img_off(4 * hi + q + 8, x) - img_off(4 * hi + q, x);
}
__device__ __forceinline__ bf16x8 k_frag(const LAS unsigned char* kbuf, const FragOff& fo, int rt, int ks) { return *(const LAS bf16x8*)(kbuf + fo.k[ks] + 8192 * rt); }
__device__ __forceinline__ s16x4 vtr(const LAS unsigned char* p) { return __builtin_bit_cast(s16x4, __builtin_amdgcn_ds_read_tr16_b64_v4i16((LAS v4i16_t*)p)); }
__device__ __forceinline__ bf16x8 v_frag(const LAS unsigned char* vbuf, const FragOff& fo, int ct, int kk) {
    const s16x4 lo = vtr(vbuf + fo.va[ct] + 4096 * kk), hh = vtr(vbuf + fo.va[ct] + fo.vd + 4096 * kk);
    return (bf16x8){lo[0], lo[1], lo[2], lo[3], hh[0], hh[1], hh[2], hh[3]};
}
#define TR_READ(dst, addr, OFF) asm volatile("ds_read_b64_tr_b16 %0, %1 offset:%c2" : "=&v"(dst) : "v"(addr), "i"(OFF) : "memory")
#define LGKM_WAIT0() do { asm volatile("s_waitcnt lgkmcnt(0)" ::: "memory"); __builtin_amdgcn_sched_barrier(0); } while (0)
__device__ __forceinline__ bf16x8 mk_frag(s16x4 lo, s16x4 hh) { return (bf16x8){lo[0], lo[1], lo[2], lo[3], hh[0], hh[1], hh[2], hh[3]}; }
__device__ __forceinline__ int frag_va(int lane, int ct) { const int hi = lane >> 5, i = lane & 15, q = i >> 2, p = i & 3, x = 2 * ((lane >> 4) & 1) + (p >> 1); return img_off(4 * hi + q, 4 * ct + x) + 8 * (p & 1); }
__device__ __forceinline__ bf16x8 v_frag_rt(const LAS unsigned char* vbuf, int va, int vd, int kk) {
    const s16x4 lo = vtr(vbuf + va + 4096 * kk), hh = vtr(vbuf + va + vd + 4096 * kk);
    return (bf16x8){lo[0], lo[1], lo[2], lo[3], hh[0], hh[1], hh[2], hh[3]};
}
__device__ __forceinline__ void store_o(const f32x16 (&o)[4], const float (&rscale)[16], LAS unsigned char* stg, bf16* dst, int ld, int lane) {
    const int hi = lane >> 5, r32 = lane & 31;
#pragma unroll
    for (int r = 0; r < 16; ++r) { const int orow = crow(r, hi);
#pragma unroll
        for (int ct = 0; ct < 4; ++ct) *(LAS bf16*)(stg + orow * 256 + (32 * ct + r32) * 2) = (bf16)f2bf(o[ct][r] * rscale[r]); }
    asm volatile("s_waitcnt lgkmcnt(0)" ::: "memory");
#pragma unroll
    for (int i = 0; i < 8; ++i) { const int c = lane + 64 * i, row = c >> 4, ch = c & 15; const u32x4 v = *(const LAS u32x4*)(stg + row * 256 + ch * 16); *(u32x4*)(dst + (size_t)row * ld + ch * 8) = v; }
}
}
__device__ __forceinline__ void sb_unit(Frame& F, int b, int h, int qb) {
    using namespace att;
    const int tid = F.tid, lane = F.lane, w = F.wave, hi = lane >> 5, r32 = lane & 31;
    const bf16* Qg = F.R1 + (size_t)b * SEQ * NC + h * 128; const bf16* Kg = Qg + 1024; const bf16* Vg = Qg + 2048;
    const int T0 = qb * 256, t0w = T0 + 32 * w, jd = t0w >> 6, jtop = (T0 >> 6) + 3, tl = 32 * (w & 1) + r32, tl4 = tl - 4 * hi;
    LAS unsigned char* lds = F.lds;
    FragOff fo; frag_off_init(fo, lane);
    unsigned dvo[2]; dma_off_init(dvo, NC, w, lane);
    bf16x8 qf[8];
#pragma unroll
    for (int ks = 0; ks < 8; ++ks) qf[ks] = *(const bf16x8*)(Qg + (size_t)(t0w + r32) * NC + 16 * ks + 8 * hi);
    f16x8 T0f, T1f, ONEf;
#pragma unroll
    for (int j = 0; j < 8; ++j) { const int kp = 8 * (j >> 2) + 4 * hi + (j & 3); T0f[j] = (kp >= r32) ? (_Float16)1.0f : (_Float16)0.0f; T1f[j] = (kp + 16 >= r32) ? (_Float16)1.0f : (_Float16)0.0f; ONEf[j] = (_Float16)1.0f; }
    f32x16 o[4];
#pragma unroll
    for (int ct = 0; ct < 4; ++ct)
#pragma unroll
        for (int r = 0; r < 16; ++r) o[ct][r] = 0.f;
    float R2 = 0.f; bool done = false;
    volatile LAS unsigned* flags = F.MISC + 16;
    tile_dma(Kg + (size_t)(64 * jtop) * NC, dvo, lds, w); tile_dma(Vg + (size_t)(64 * jtop) * NC, dvo, lds + 16384, w);
    asm volatile("s_waitcnt vmcnt(0)" ::: "memory");
    __syncthreads();
    for (int j = jtop; j >= 0; --j) {
        const int cur = (jtop - j) & 1;
        const LAS unsigned char* kb = lds + cur * 32768; const LAS unsigned char* vb = kb + 16384;
        if (j > 0) { tile_dma(Kg + (size_t)(64 * (j - 1)) * NC, dvo, lds + (cur ^ 1) * 32768, w); tile_dma(Vg + (size_t)(64 * (j - 1)) * NC, dvo, lds + (cur ^ 1) * 32768 + 16384, w); }
        if (j <= jd && !done) {
            f32x16 p0, p1;
#pragma unroll
            for (int r = 0; r < 16; ++r) { p0[r] = 0.f; p1[r] = 0.f; }
            { bf16x8 kf[8];
#pragma unroll
              for (int ks = 0; ks < 8; ++ks) kf[ks] = k_frag(kb, fo, 0, ks);
#pragma unroll
              for (int ks = 0; ks < 8; ++ks) p0 = __builtin_amdgcn_mfma_f32_32x32x16_bf16(kf[ks], qf[ks], p0, 0, 0, 0);
#pragma unroll
              for (int ks = 0; ks < 8; ++ks) kf[ks] = k_frag(kb, fo, 1, ks);
#pragma unroll
              for (int ks = 0; ks < 8; ++ks) p1 = __builtin_amdgcn_mfma_f32_32x32x16_bf16(kf[ks], qf[ks], p1, 0, 0, 0); }
            s16x4 vl[4], vh[4], wl[4], wh[4];
            unsigned va0[4], va1[4];
#pragma unroll
            for (int ct = 0; ct < 4; ++ct) { va0[ct] = (unsigned)(size_t)vb + (unsigned)fo.va[ct]; va1[ct] = va0[ct] + (unsigned)fo.vd; }
            const bool diag = (j == jd);
            float x0[16], x1[16]; float rs = 0.f;
#pragma unroll
            for (int r = 0; r < 16; ++r) { const int key = (r & 3) + 8 * (r >> 2);
                float l0 = -__builtin_amdgcn_logf(1.0f + __builtin_amdgcn_exp2f(p0[r])), l1 = -__builtin_amdgcn_logf(1.0f + __builtin_amdgcn_exp2f(p1[r]));
                if (diag) { if (!(key < tl4)) l0 = 0.f; if (!(key + 32 < tl4)) l1 = 0.f; }
                x0[r] = l0; x1[r] = l1; rs += l0 + l1; p0[r] += R2; p1[r] += R2; }
            const f16x8 xb00 = pack8h(x0[0], x0[1], x0[2], x0[3], x0[4], x0[5], x0[6], x0[7]), xb01 = pack8h(x0[8], x0[9], x0[10], x0[11], x0[12], x0[13], x0[14], x0[15]);
            const f16x8 xb10 = pack8h(x1[0], x1[1], x1[2], x1[3], x1[4], x1[5], x1[6], x1[7]), xb11 = pack8h(x1[8], x1[9], x1[10], x1[11], x1[12], x1[13], x1[14], x1[15]);
            p0 = __builtin_amdgcn_mfma_f32_32x32x16_f16(T0f, xb00, p0, 0, 0, 0); p0 = __builtin_amdgcn_mfma_f32_32x32x16_f16(T1f, xb01, p0, 0, 0, 0);
            p0 = __builtin_amdgcn_mfma_f32_32x32x16_f16(ONEf, xb10, p0, 0, 0, 0); p0 = __builtin_amdgcn_mfma_f32_32x32x16_f16(ONEf, xb11, p0, 0, 0, 0);
            p1 = __builtin_amdgcn_mfma_f32_32x32x16_f16(T0f, xb10, p1, 0, 0, 0); p1 = __builtin_amdgcn_mfma_f32_32x32x16_f16(T1f, xb11, p1, 0, 0, 0);
#pragma unroll
            for (int r = 0; r < 16; ++r) { const int key = (r & 3) + 8 * (r >> 2);
                float a0 = __builtin_amdgcn_exp2f(p0[r]), a1 = __builtin_amdgcn_exp2f(p1[r]);
                if (diag) { if (!(key < tl4)) a0 = 0.f; if (!(key + 32 < tl4)) a1 = 0.f; }
                p0[r] = a0; p1[r] = a1; }
            const bf16x8 pa0 = pack8(p0[0], p0[1], p0[2], p0[3], p0[4], p0[5], p0[6], p0[7]), pa1 = pack8(p0[8], p0[9], p0[10], p0[11], p0[12], p0[13], p0[14], p0[15]);
            const bf16x8 pa2 = pack8(p1[0], p1[1], p1[2], p1[3], p1[4], p1[5], p1[6], p1[7]), pa3 = pack8(p1[8], p1[9], p1[10], p1[11], p1[12], p1[13], p1[14], p1[15]);
#pragma unroll
            for (int ct = 0; ct < 4; ++ct) { TR_READ(vl[ct], va0[ct], 0); TR_READ(vh[ct], va1[ct], 0); }
            LGKM_WAIT0();
#pragma unroll
            for (int ct = 0; ct < 4; ++ct) { TR_READ(wl[ct], va0[ct], 4096); TR_READ(wh[ct], va1[ct], 4096); }
#pragma unroll
            for (int ct = 0; ct < 4; ++ct) o[ct] = __builtin_amdgcn_mfma_f32_32x32x16_bf16(pa0, mk_frag(vl[ct], vh[ct]), o[ct], 0, 0, 0);
            LGKM_WAIT0();
#pragma unroll
            for (int ct = 0; ct < 4; ++ct) { TR_READ(vl[ct], va0[ct], 8192); TR_READ(vh[ct], va1[ct], 8192); }
#pragma unroll
            for (int ct = 0; ct < 4; ++ct) o[ct] = __builtin_amdgcn_mfma_f32_32x32x16_bf16(pa1, mk_frag(wl[ct], wh[ct]), o[ct], 0, 0, 0);
            LGKM_WAIT0();
#pragma unroll
            for (int ct = 0; ct < 4; ++ct) { TR_READ(wl[ct], va0[ct], 12288); TR_READ(wh[ct], va1[ct], 12288); }
#pragma unroll
            for (int ct = 0; ct < 4; ++ct) o[ct] = __builtin_amdgcn_mfma_f32_32x32x16_bf16(pa2, mk_frag(vl[ct], vh[ct]), o[ct], 0, 0, 0);
            LGKM_WAIT0();
#pragma unroll
            for (int ct = 0; ct < 4; ++ct) o[ct] = __builtin_amdgcn_mfma_f32_32x32x16_bf16(pa3, mk_frag(wl[ct], wh[ct]), o[ct], 0, 0, 0);
            rs += __shfl_xor(rs, 32);
            R2 += rs;
            done = __all(R2 < -152.0f);
        }
        if (lane == 0) flags[cur * 8 + w] = done ? 1u : 0u;
        asm volatile("s_waitcnt vmcnt(0) lgkmcnt(0)" ::: "memory");
        __syncthreads();
        unsigned alld = 1u;
#pragma unroll
        for (int i = 0; i < 8; ++i) alld &= flags[cur * 8 + i];
        if (alld) break;
    }
    float ones[16];
#pragma unroll
    for (int r = 0; r < 16; ++r) ones[r] = 1.0f;
    store_o(o, ones, lds + w * 8192, F.CAT + (size_t)(b * SEQ + t0w) * D + h * 128, D, lane);
    __syncthreads();
}
__device__ __forceinline__ void ph_sb(Frame& F) {
    for (int v = F.vcu; v < BATCH * 8 * 2; v += F.G) {
        const int bh = v >> 1, half = v & 1;
#pragma unroll 1
        for (int i = 0; i < 4; ++i) { const int qb = half ? (i == 0 ? 1 : i == 1 ? 6 : i == 2 ? 2 : 5) : (i == 0 ? 0 : i == 1 ? 7 : i == 2 ? 3 : 4); sb_unit(F, bh >> 3, bh & 7, qb); }
    }
}
__device__ __forceinline__ void dsa_unit(Frame& F, int b, int h, int ub, float mref) {
    using namespace att;
    const int lane = F.lane, w = F.wave, hi = lane >> 5, r32 = lane & 31;
    const bf16* Qg = F.R1 + (size_t)b * SEQ * NAB + C_QA + h * 128; const bf16* Kg = F.R1 + (size_t)b * SEQ * NAB + C_KA + h * 128; const bf16* Vg = F.R1 + (size_t)b * SEQ * NAB + C_VA + h * 128;
    const int t0w = 256 * ub + 32 * w, cw = t0w >> 6, jlast = 4 * ub + 3;
    LAS unsigned char* lds = F.lds;
    LAS unsigned char* mst = lds + 65536 + w * 8448;
    FragOff fo; frag_off_init(fo, lane);
    unsigned dvo[2]; dma_off_init(dvo, NAB, w, lane);
    tile_dma(Kg, dvo, lds, w); tile_dma(Vg, dvo, lds + 16384, w);
    bf16x8 qf[8];
#pragma unroll
    for (int ks = 0; ks < 8; ++ks) qf[ks] = *(const bf16x8*)(Qg + (size_t)(t0w + r32) * NAB + 16 * ks + 8 * hi);
    { const unsigned* mg = F.MASK + (size_t)(b * SEQ + t0w) * 64;
#pragma unroll 2
      for (int i = 0; i < 8; ++i) { const int c = lane + 64 * i, row = c >> 4, c4 = c & 15; const u32x4 v = *(const u32x4*)(mg + row * 64 + c4 * 4);
          *(LAS unsigned long long*)(mst + row * 264 + c4 * 16) = (unsigned long long)v.x | ((unsigned long long)v.y << 32);
          *(LAS unsigned long long*)(mst + row * 264 + c4 * 16 + 8) = (unsigned long long)v.z | ((unsigned long long)v.w << 32); } }
    f32x16 o[4];
#pragma unroll
    for (int ct = 0; ct < 4; ++ct)
#pragma unroll
        for (int r = 0; r < 16; ++r) o[ct][r] = 0.f;
    float lsum = 0.f;
    asm volatile("s_waitcnt vmcnt(0) lgkmcnt(0)" ::: "memory");
    __syncthreads();
    for (int j = 0; j <= jlast; ++j) {
        const int cur = j & 1;
        const LAS unsigned char* kb = lds + cur * 32768; const LAS unsigned char* vb = kb + 16384;
        if (j < jlast) { tile_dma(Kg + (size_t)(64 * (j + 1)) * NAB, dvo, lds + (cur ^ 1) * 32768, w); tile_dma(Vg + (size_t)(64 * (j + 1)) * NAB, dvo, lds + (cur ^ 1) * 32768 + 16384, w); }
        if (j <= cw) {
            const unsigned long long mw = *(const LAS unsigned long long*)(mst + r32 * 264 + j * 8);
            const unsigned mw0 = (unsigned)mw, mw1 = (unsigned)(mw >> 32);
#pragma unroll 1
            for (int half = 0; half < 2; ++half) {
                const unsigned mwh = (half ? mw1 : mw0) >> (4 * hi);
                bf16x8 kf[8];
#pragma unroll
                for (int ks = 0; ks < 8; ++ks) kf[ks] = k_frag(kb, fo, half, ks);
                f32x16 p;
#pragma unroll
                for (int r = 0; r < 16; ++r) p[r] = 0.f;
#pragma unroll
                for (int ks = 0; ks < 8; ++ks) p = __builtin_amdgcn_mfma_f32_32x32x16_bf16(kf[ks], qf[ks], p, 0, 0, 0);
#pragma unroll
                for (int r = 0; r < 16; ++r) { const unsigned keep = (unsigned)(-(int)((mwh >> ((r & 3) + 8 * (r >> 2))) & 1u));
                    const float e = __uint_as_float(__float_as_uint(__builtin_amdgcn_exp2f(p[r] - mref)) & keep); p[r] = e; lsum += e; }
                const bf16x8 pa0 = pack8(p[0], p[1], p[2], p[3], p[4], p[5], p[6], p[7]), pa1 = pack8(p[8], p[9], p[10], p[11], p[12], p[13], p[14], p[15]);
                s16x4 vl[8], vh[8];
                const unsigned vbase = (unsigned)(size_t)vb + 8192u * (unsigned)half;
#pragma unroll
                for (int ct = 0; ct < 4; ++ct) { const unsigned a0 = vbase + (unsigned)fo.va[ct], a1 = a0 + (unsigned)fo.vd;
                    TR_READ(vl[2 * ct], a0, 0); TR_READ(vh[2 * ct], a1, 0); TR_READ(vl[2 * ct + 1], a0, 4096); TR_READ(vh[2 * ct + 1], a1, 4096); }
                LGKM_WAIT0();
#pragma unroll
                for (int ct = 0; ct < 4; ++ct) {
                    o[ct] = __builtin_amdgcn_mfma_f32_32x32x16_bf16(pa0, mk_frag(vl[2 * ct], vh[2 * ct]), o[ct], 0, 0, 0);
                    o[ct] = __builtin_amdgcn_mfma_f32_32x32x16_bf16(pa1, mk_frag(vl[2 * ct + 1], vh[2 * ct + 1]), o[ct], 0, 0, 0);
                }
            }
        }
        asm volatile("s_waitcnt vmcnt(0) lgkmcnt(0)" ::: "memory");
        __syncthreads();
    }
    lsum += __shfl_xor(lsum, 32);
    LAS float* lsc = (LAS float*)mst;
    if (hi == 0) lsc[r32] = 1.0f / lsum;
    asm volatile("s_waitcnt lgkmcnt(0)" ::: "memory");
    float rsc[16];
#pragma unroll
    for (int r = 0; r < 16; ++r) rsc[r] = lsc[crow(r, hi)];
    store_o(o, rsc, lds + w * 8192, F.CAT + (size_t)(b * SEQ + t0w) * D + h * 128, D, lane);
    __syncthreads();
}
__device__ __forceinline__ void ph_dsa(Frame& F) {
    float gm = fmaxf(fabsf(F.gq_a[F.lane]), fabsf(F.gq_a[64 + F.lane])), km = fmaxf(fabsf(F.gk_a[F.lane]), fabsf(F.gk_a[64 + F.lane]));
    gm = wave_max(gm); km = wave_max(km);
    const float mref = att::C2 * 128.0f * gm * km * 1.02f;
    for (int v = F.vcu; v < BATCH * 4 * 4; v += F.G) {
        const int bh = v >> 2, pi = v & 3;
#pragma unroll 1
        for (int k = 0; k < 2; ++k) dsa_unit(F, bh >> 2, bh & 3, k ? 7 - pi : pi, mref);
    }
}
namespace idx {
using att::f32x16;
constexpr int SCP = 2048;
__device__ __forceinline__ unsigned okey(float f) { const unsigned u = __float_as_uint(f); return (u & 0x80000000u) ? ~u : (u | 0x80000000u); }
__device__ __forceinline__ int wave_isum(int c) {
    c += __builtin_amdgcn_mov_dpp(c, 0xB1, 0xF, 0xF, true);
    c += __builtin_amdgcn_mov_dpp(c, 0x4E, 0xF, 0xF, true);
    c += __builtin_amdgcn_mov_dpp(c, 0x141, 0xF, 0xF, true);
    c += __builtin_amdgcn_mov_dpp(c, 0x140, 0xF, 0xF, true);
    return (__builtin_amdgcn_readlane(c, 0) + __builtin_amdgcn_readlane(c, 16)) + (__builtin_amdgcn_readlane(c, 32) + __builtin_amdgcn_readlane(c, 48));
}
__device__ __forceinline__ void bit_transpose32x2(unsigned (&A)[32], unsigned (&B)[32]) {
    unsigned mask = 0x0000FFFFu;
#pragma unroll
    for (int s = 16; s; s >>= 1) {
        unsigned ta[16], tb[16];
#pragma unroll
        for (int k = 0, i = 0; k < 32; ++k) if (!(k & s)) { ta[i] = A[k + s] >> s; tb[i] = B[k + s] >> s; ++i; }
#pragma unroll
        for (int k = 0, i = 0; k < 32; ++k) if (!(k & s)) { ta[i] ^= A[k]; tb[i] ^= B[k]; ++i; }
#pragma unroll
        for (int i = 0; i < 16; ++i) { ta[i] &= mask; tb[i] &= mask; }
#pragma unroll
        for (int k = 0, i = 0; k < 32; ++k) if (!(k & s)) { A[k] ^= ta[i]; B[k] ^= tb[i]; ++i; }
#pragma unroll
        for (int k = 0, i = 0; k < 32; ++k) if (!(k & s)) { A[k + s] ^= ta[i] << s; B[k + s] ^= tb[i] << s; ++i; }
        mask ^= mask << (s >> 1);
    }
}
__device__ __forceinline__ void select_prepare(const LAS float* scA, const LAS float* scB, int E, unsigned (&Wa)[32], unsigned (&Wb)[32], int lane) {
#pragma unroll
    for (int j = 0; j < 32; ++j) { Wa[31 - j] = __float_as_uint(scA[64 * j + lane]); Wb[31 - j] = __float_as_uint(scB[64 * j + lane]); }
#pragma unroll
    for (int j = 0; j < 32; ++j) { const unsigned ua = Wa[31 - j], ub = Wb[31 - j];
        const unsigned ka = (ua & 0x80000000u) ? ~ua : (ua | 0x80000000u), kb = (ub & 0x80000000u) ? ~ub : (ub | 0x80000000u);
        Wa[31 - j] = (j < E) ? ka : 0u; Wb[31 - j] = (j < E) ? kb : 0u; }
    bit_transpose32x2(Wa, Wb);
}
__device__ __forceinline__ void select_finish(const unsigned (&Wa)[32], const unsigned (&Wb)[32], int E, unsigned* mrowA, unsigned* mrowB, int lane) {
    const unsigned valid = (E >= 32) ? 0xFFFFFFFFu : ((1u << E) - 1u);
    unsigned alA = valid, alB = valid, gtA = 0u, gtB = 0u;
    int GA = 0, GB = 0, AA = 64 * E, AB = 64 * E; bool dA = false, dB = false;
#pragma unroll
    for (int b = 0; b < 32; ++b) {
        if (dA && dB) break;
        const unsigned m1a = alA & Wa[b], m1b = alB & Wb[b];
        const int ca = wave_isum(__popc(m1a)), cb = wave_isum(__popc(m1b));
        if (!dA) { if (GA + ca >= 256) { alA = m1a; AA = ca; } else { GA += ca; gtA |= m1a; alA &= ~Wa[b]; AA -= ca; } dA = (GA + AA == 256); }
        if (!dB) { if (GB + cb >= 256) { alB = m1b; AB = cb; } else { GB += cb; gtB |= m1b; alB &= ~Wb[b]; AB -= cb; } dB = (GB + AB == 256); }
    }
#pragma unroll 1
    for (int rr = 0; rr < 2; ++rr) {
        const unsigned al = rr ? alB : alA, gt = rr ? gtB : gtA; const bool done = rr ? dB : dA; unsigned* mrow = rr ? mrowB : mrowA;
        unsigned sel = gt | al;
        if (!done) {
            int need = 256 - (rr ? GB : GA); sel = gt;
            const unsigned long long below = (1ull << lane) - 1ull;
            for (int j = 0; j < E; ++j) { const bool e = (al >> j) & 1u; const unsigned long long eq = __ballot(e);
                if (e && __popcll(eq & below) < need) sel |= 1u << j;
                need -= __popcll(eq); if (need <= 0) break; }
        }
        unsigned long long mine = 0ull;
#pragma unroll
        for (int j = 0; j < 32; ++j) { if (j < E) { const unsigned long long m = __ballot((sel >> j) & 1u); if (lane == j) mine = m; } }
        if (lane < 32) *(unsigned long long*)(mrow + 2 * lane) = mine;
    }
}
__device__ __forceinline__ void decode(int u, int& b, int& c, int& sub) { c = 4 + u % 28; const int rest = u / 28; b = rest >> 2; sub = rest & 3; }
__device__ __forceinline__ void load_af(Frame& F, int u, bf16x8 (&af)[4][4]) {
    int b, c, sub; decode(u, b, c, sub);
    const int r32 = F.lane & 31, hi = F.lane >> 5, t0 = 64 * c + 16 * sub;
    const bf16* P = F.R1 + (size_t)b * SEQ * NAB;
#pragma unroll
    for (int rt = 0; rt < 4; ++rt)
#pragma unroll
        for (int ks = 0; ks < 4; ++ks) af[rt][ks] = *(const bf16x8*)(P + (size_t)(t0 + 4 * rt + (r32 >> 3)) * NAB + C_IQ + (r32 & 7) * 64 + 16 * ks + 8 * hi);
}
__device__ __forceinline__ float load_w(Frame& F, int u) {
    int b, c, sub; decode(u, b, c, sub);
    const int t0 = 64 * c + 16 * sub;
    return (F.tid < 128) ? bf2f(F.R1[(size_t)(b * SEQ + t0 + (F.tid >> 3)) * NAB + C_IW + (F.tid & 7)]) * (0.125f * 0.35355339059327373f) : 0.f;
}
__device__ __forceinline__ void load_bf(Frame& F, int b, int strip, bf16x8 (&bfr)[4]) {
    const bf16* P = F.R1 + (size_t)b * SEQ * NAB;
#pragma unroll
    for (int ks = 0; ks < 4; ++ks) bfr[ks] = *(const bf16x8*)(P + (size_t)(32 * strip + (F.lane & 31)) * NAB + C_IK + 16 * ks + 8 * (F.lane >> 5));
}
__device__ __forceinline__ void run(Frame& F) {
    const int lane = F.lane, w = F.wave, hi = lane >> 5, r32 = lane & 31, tid = F.tid, NU = BATCH * 28 * 4;
    int u = F.vcu; if (u >= NU) return;
    LAS float* sc = (LAS float*)F.lds;
    LAS float* wtb = sc + 16 * SCP;
    bf16x8 af[4][4], bfr[4], bnx[4];
    load_af(F, u, af);
    { const float wv = load_w(F, u); if (tid < 128) wtb[tid] = wv; }
    { int b, c, sub; decode(u, b, c, sub); if (w < 2 * (c + 1)) load_bf(F, b, w, bfr); }
    for (int it = 0; u < NU; ++it, u += F.G) {
        int b, c, sub; decode(u, b, c, sub);
        const int n = 64 * (c + 1), t0 = 64 * c + 16 * sub, nstrip = n >> 5;
        const int un = u + F.G; const bool more = un < NU;
        const LAS float* wt = wtb + (it & 1) * 128;
        __syncthreads();
        const float wnext = more ? load_w(F, un) : 0.f;
        for (int s = w; s < nstrip; s += NWAVES) {
            const bool mstrip = s + NWAVES < nstrip;
            if (mstrip) load_bf(F, b, s + NWAVES, bnx);
#pragma unroll
            for (int rt = 0; rt < 4; ++rt) {
                f32x16 acc;
#pragma unroll
                for (int r = 0; r < 16; ++r) acc[r] = 0.f;
#pragma unroll
                for (int ks = 0; ks < 4; ++ks) acc = __builtin_amdgcn_mfma_f32_32x32x16_bf16(af[rt][ks], bfr[ks], acc, 0, 0, 0);
                float part[4];
#pragma unroll
                for (int qi = 0; qi < 4; ++qi) { const f32x4 wv = *(const LAS f32x4*)(wt + (4 * rt + qi) * 8 + 4 * hi);
                    part[qi] = fmaxf(acc[4 * qi], 0.f) * wv[0] + fmaxf(acc[4 * qi + 1], 0.f) * wv[1] + fmaxf(acc[4 * qi + 2], 0.f) * wv[2] + fmaxf(acc[4 * qi + 3], 0.f) * wv[3]; }
                const float send0 = hi ? part[0] : part[2], send1 = hi ? part[1] : part[3];
                const float got0 = __shfl_xor(send0, 32), got1 = __shfl_xor(send1, 32);
                const float f0 = (hi ? part[2] : part[0]) + got0, f1 = (hi ? part[3] : part[1]) + got1;
                const int q0 = 4 * rt + 2 * hi;
                sc[q0 * SCP + 32 * s + r32] = f0; sc[(q0 + 1) * SCP + 32 * s + r32] = f1;
            }
            if (mstrip) {
#pragma unroll
                for (int ks = 0; ks < 4; ++ks) bfr[ks] = bnx[ks];
            }
        }
        if (more && tid < 128) wtb[((it + 1) & 1) * 128 + tid] = wnext;
        __syncthreads();
        { const int q = 2 * w;
          unsigned* mrowA = F.MASK + (size_t)(b * SEQ + t0 + q) * 64; unsigned* mrowB = mrowA + 64;
          const LAS float* rowA = sc + q * SCP; const LAS float* rowB = rowA + SCP;
          unsigned Wa[32], Wb[32];
          select_prepare(rowA, rowB, n >> 6, Wa, Wb, lane);
          asm volatile("" ::: "memory");
          if (more) load_af(F, un, af);
          select_finish(Wa, Wb, n >> 6, mrowA, mrowB, lane); }
        if (more) { int bn, cn, sn; decode(un, bn, cn, sn); if (w < 2 * (cn + 1)) load_bf(F, bn, w, bfr); }
    }
    __syncthreads();
}
}
__device__ __forceinline__ void ph_indexer(Frame& F) {
    { const int gw = F.vcu * NWAVES + F.wave, NGW = F.G * NWAVES;
      for (int i = gw; i < BATCH * 256; i += NGW) { const int b = i >> 8, pos = i & 255, n = ((pos >> 6) + 1) << 6;
          if (F.lane < 32) { unsigned long long v = 0ull; if (64 * F.lane < n) v = ~0ull; *(unsigned long long*)(F.MASK + (size_t)(b * SEQ + pos) * 64 + 2 * F.lane) = v; } } }
    idx::run(F);
}
namespace gla {
using att::f32x16; using att::u32x4;
constexpr int L_WL = 0, L_V = 4096, L_OG = 36864, L_K = 69632, L_Q = 78848, L_PART = 88064, L_STG = 89088, KP = 144, SP = 272;
struct In { u32x4 g0, g1, kk, qq; f32x4 b0, b1; };
__device__ __forceinline__ void decode(int u, int& b, int& h, int& c) { b = u >> 7; h = (u >> 5) & 3; c = u & 31; }
template <bool PASSC> __device__ __forceinline__ void load_in(Frame& F, int u, In& in, const float* BC) {
    int b, h, c; decode(u, b, h, c);
    const bf16* pr = F.R1 + (size_t)(b * SEQ + 64 * c + F.lane) * NAB;
    in.kk = *(const u32x4*)(pr + C_KB + h * 64 + 8 * F.wave);
    if (PASSC) { in.qq = *(const u32x4*)(pr + C_QB + h * 64 + 8 * F.wave);
        const float* bp = BC + ((size_t)u * 64 + F.lane) * 64 + 8 * F.wave; in.b0 = *(const f32x4*)bp; in.b1 = *(const f32x4*)(bp + 4); }
    else { in.g0 = *(const u32x4*)(pr + C_GL); in.g1 = *(const u32x4*)(pr + C_GL + 8); }
}
template <bool NEEDOG> __device__ __forceinline__ void dma_in(Frame& F, int u, int buf, const unsigned (&dvo)[2]) {
    int b, h, c; decode(u, b, h, c);
    const bf16* P = F.R1 + (size_t)(b * SEQ + 64 * c) * NAB;
    att::tile_dma(P + C_VB + h * 128, dvo, F.lds + L_V + buf * 16384, F.wave);
    if (NEEDOG) att::tile_dma(P + C_OG + h * 128, dvo, F.lds + L_OG + buf * 16384, F.wave);
}
__device__ __forceinline__ void stage_wl(Frame& F, int h) {
    LAS float* wl = (LAS float*)(F.lds + L_WL);
#pragma unroll
    for (int i = 0; i < 2; ++i) { const int e = F.tid + 512 * i, r = e >> 6, d = e & 63; wl[e] = F.w_gate_up[r * 256 + h * 64 + d]; }
}
__device__ __forceinline__ void unpack8(const u32x4 v, float (&f)[8]) {
#pragma unroll
    for (int i = 0; i < 4; ++i) { f[2 * i] = __uint_as_float(v[i] << 16); f[2 * i + 1] = __uint_as_float(v[i] & 0xffff0000u); }
}
__device__ __forceinline__ void gate_scan(Frame& F, int h, const float (&gl)[16], float (&bc)[8], float (&blast)[8]) {
    const int lane = F.lane, d0 = 8 * F.wave;
    const LAS float* wl = (const LAS float*)(F.lds + L_WL);
    float acc[8];
#pragma unroll
    for (int i = 0; i < 8; ++i) acc[i] = F.b_gate[h * 64 + d0 + i];
#pragma unroll
    for (int r = 0; r < 16; ++r) { const f32x4 w0 = *(const LAS f32x4*)(wl + r * 64 + d0), w1 = *(const LAS f32x4*)(wl + r * 64 + d0 + 4);
#pragma unroll
        for (int i = 0; i < 4; ++i) { acc[i] = fmaf(gl[r], w0[i], acc[i]); acc[4 + i] = fmaf(gl[r], w1[i], acc[4 + i]); } }
#pragma unroll
    for (int i = 0; i < 8; ++i) { float v = (fminf(acc[i], 0.f) - __logf(1.0f + __expf(-fabsf(acc[i])))) * (1.0f / 16.0f);
#pragma unroll
        for (int off = 1; off < 64; off <<= 1) { const float u = __shfl_up(v, off); if (lane >= off) v += u; }
        bc[i] = v; blast[i] = __shfl(v, 63); }
}
__device__ __forceinline__ void pass_a(Frame& F, float* GU, float* DEC, float* BC) {
    const int lane = F.lane, w = F.wave, hi = lane >> 5, r32 = lane & 31;
    att::FragOff fo; att::frag_off_init(fo, lane);
    unsigned dvo[2]; att::dma_off_init(dvo, NAB, w, lane);
    const int et = w >> 1, dt = w & 1, va_et = att::frag_va(lane, et);
    int u = F.vcu; if (u >= BATCH * 4 * 32) return;
    In cur, nxt; int hprev = -1;
    dma_in<false>(F, u, 0, dvo); load_in<false>(F, u, cur, BC);
    for (int it = 0; u < BATCH * 4 * 32; ++it, u += F.G) {
        int b, h, c; decode(u, b, h, c);
        const int un = u + F.G; const bool more = un < BATCH * 4 * 32;
        if (h != hprev) { stage_wl(F, h); hprev = h; }
        asm volatile("s_waitcnt vmcnt(0) lgkmcnt(0)" ::: "memory");
        __syncthreads();
        float gl[16], kf[8];
        unpack8(cur.g0, (float(&)[8])gl[0]); unpack8(cur.g1, (float(&)[8])gl[8]); unpack8(cur.kk, kf);
        asm volatile("" ::: "memory");
        if (more) { dma_in<false>(F, un, (it + 1) & 1, dvo); load_in<false>(F, un, nxt, BC); }
        float bc[8], blast[8];
        gate_scan(F, h, gl, bc, blast);
        const int uid = u;
        { float* bp = BC + ((size_t)uid * 64 + lane) * 64 + 8 * w; *(f32x4*)bp = (f32x4){bc[0], bc[1], bc[2], bc[3]}; *(f32x4*)(bp + 4) = (f32x4){bc[4], bc[5], bc[6], bc[7]}; }
#pragma unroll
        for (int i = 0; i < 8; ++i) *(LAS bf16*)(F.lds + L_K + (8 * w + i) * KP + lane * 2) = (bf16)f2bf(kf[i] * __expf(blast[i] - bc[i]));
        if (lane == 0) {
#pragma unroll
            for (int i = 0; i < 8; ++i) DEC[(size_t)uid * 64 + 8 * w + i] = __expf(blast[i]); }
        asm volatile("s_waitcnt lgkmcnt(0)" ::: "memory");
        __syncthreads();
        const LAS unsigned char* vbuf = F.lds + L_V + (it & 1) * 16384;
        f32x16 acc;
#pragma unroll
        for (int r = 0; r < 16; ++r) acc[r] = 0.f;
#pragma unroll
        for (int kk = 0; kk < 4; ++kk) {
            const LAS unsigned char* kp = F.lds + L_K + (32 * dt + r32) * KP + (16 * kk + 4 * hi) * 2;
            const unsigned long long lo = *(const LAS unsigned long long*)kp, hh = *(const LAS unsigned long long*)(kp + 16);
            u32x4 bw; bw.x = (unsigned)lo; bw.y = (unsigned)(lo >> 32); bw.z = (unsigned)hh; bw.w = (unsigned)(hh >> 32);
            acc = __builtin_amdgcn_mfma_f32_32x32x16_bf16(att::v_frag_rt(vbuf, va_et, fo.vd, kk), __builtin_bit_cast(bf16x8, bw), acc, 0, 0, 0);
        }
        float* gu = GU + (size_t)uid * 8192;
#pragma unroll
        for (int r = 0; r < 16; ++r) gu[(32 * et + att::crow(r, hi)) * 64 + 32 * dt + r32] = acc[r];
        cur = nxt;
    }
    __syncthreads();
}
__device__ __forceinline__ void pass_b(Frame& F, float* GU, const float* DEC) {
    for (int idx = F.vcu * NTHR + F.tid; idx < 64 * 128 * 16; idx += F.G * NTHR) {
        const int bh = idx >> 11, e = (idx >> 4) & 127, dq = idx & 15;
        f32x4 S = (f32x4){0.f, 0.f, 0.f, 0.f};
        for (int c0 = 0; c0 < 32; c0 += 8) {
            f32x4 U[8], dec[8];
#pragma unroll
            for (int i = 0; i < 8; ++i) { const size_t uid = (size_t)bh * 32 + c0 + i; U[i] = *(const f32x4*)(GU + (uid * 128 + e) * 64 + 4 * dq); dec[i] = *(const f32x4*)(DEC + uid * 64 + 4 * dq); }
#pragma unroll
            for (int i = 0; i < 8; ++i) { const size_t uid = (size_t)bh * 32 + c0 + i; *(f32x4*)(GU + (uid * 128 + e) * 64 + 4 * dq) = S; S = dec[i] * S + U[i]; }
        }
    }
}
__device__ __forceinline__ void pass_c(Frame& F, const float* GU, const float* BC) {
    const int lane = F.lane, w = F.wave, hi = lane >> 5, r32 = lane & 31, tid = F.tid;
    LAS unsigned char* lds = F.lds;
    att::FragOff fo; att::frag_off_init(fo, lane);
    unsigned dvo[2]; att::dma_off_init(dvo, NAB, w, lane);
    const int et = w >> 1, tt = w & 1, tl = 32 * tt + r32, va_et = att::frag_va(lane, et);
    int u = F.vcu; if (u >= BATCH * 4 * 32) return;
    In cur, nxt;
    dma_in<true>(F, u, 0, dvo); load_in<true>(F, u, cur, BC);
    for (int it = 0; u < BATCH * 4 * 32; ++it, u += F.G) {
        int b, h, c; decode(u, b, h, c);
        const int un = u + F.G; const bool more = un < BATCH * 4 * 32;
        asm volatile("s_waitcnt vmcnt(0) lgkmcnt(0)" ::: "memory");
        __syncthreads();
        float kf[8], qf[8], bc[8];
        unpack8(cur.kk, kf); unpack8(cur.qq, qf);
#pragma unroll
        for (int i = 0; i < 4; ++i) { bc[i] = cur.b0[i]; bc[4 + i] = cur.b1[i]; }
        asm volatile("" ::: "memory");
        if (more) { dma_in<true>(F, un, (it + 1) & 1, dvo); load_in<true>(F, un, nxt, BC); }
        f32x4 sf[8];
        { const float* gs = GU + ((size_t)u * 128 + 32 * et + r32) * 64;
#pragma unroll
          for (int ks = 0; ks < 4; ++ks) { sf[2 * ks] = *(const f32x4*)(gs + 16 * ks + 8 * hi); sf[2 * ks + 1] = *(const f32x4*)(gs + 16 * ks + 8 * hi + 4); } }
        { float eq[8], ek[8];
#pragma unroll
          for (int i = 0; i < 8; ++i) { eq[i] = qf[i] * 0.125f * __expf(bc[i]); ek[i] = kf[i] * __expf(-bc[i]); }
          *(LAS bf16x8*)(lds + L_Q + lane * KP + 16 * w) = att::pack8(eq[0], eq[1], eq[2], eq[3], eq[4], eq[5], eq[6], eq[7]);
          *(LAS bf16x8*)(lds + L_K + lane * KP + 16 * w) = att::pack8(ek[0], ek[1], ek[2], ek[3], ek[4], ek[5], ek[6], ek[7]); }
        asm volatile("s_waitcnt lgkmcnt(0)" ::: "memory");
        __syncthreads();
        const LAS unsigned char* vbuf = lds + L_V + (it & 1) * 16384; const LAS unsigned char* ogbuf = lds + L_OG + (it & 1) * 16384;
        bf16x8 qfr[4];
#pragma unroll
        for (int ks = 0; ks < 4; ++ks) qfr[ks] = *(const LAS bf16x8*)(lds + L_Q + tl * KP + (16 * ks + 8 * hi) * 2);
        f32x16 p0, p1;
#pragma unroll
        for (int r = 0; r < 16; ++r) { p0[r] = 0.f; p1[r] = 0.f; }
#pragma unroll
        for (int ks = 0; ks < 4; ++ks) {
            const bf16x8 a0 = *(const LAS bf16x8*)(lds + L_K + r32 * KP + (16 * ks + 8 * hi) * 2), a1 = *(const LAS bf16x8*)(lds + L_K + (32 + r32) * KP + (16 * ks + 8 * hi) * 2);
            p0 = __builtin_amdgcn_mfma_f32_32x32x16_bf16(a0, qfr[ks], p0, 0, 0, 0); p1 = __builtin_amdgcn_mfma_f32_32x32x16_bf16(a1, qfr[ks], p1, 0, 0, 0);
        }
        { const int tl4 = tl - 4 * hi;
#pragma unroll
          for (int r = 0; r < 16; ++r) { const int s = (r & 3) + 8 * (r >> 2); if (s > tl4) p0[r] = 0.f; if (s + 32 > tl4) p1[r] = 0.f; } }
        const bf16x8 pa0 = att::pack8(p0[0], p0[1], p0[2], p0[3], p0[4], p0[5], p0[6], p0[7]), pa1 = att::pack8(p0[8], p0[9], p0[10], p0[11], p0[12], p0[13], p0[14], p0[15]);
        const bf16x8 pa2 = att::pack8(p1[0], p1[1], p1[2], p1[3], p1[4], p1[5], p1[6], p1[7]), pa3 = att::pack8(p1[8], p1[9], p1[10], p1[11], p1[12], p1[13], p1[14], p1[15]);
        f32x16 acc;
#pragma unroll
        for (int r = 0; r < 16; ++r) acc[r] = 0.f;
        acc = __builtin_amdgcn_mfma_f32_32x32x16_bf16(att::v_frag_rt(vbuf, va_et, fo.vd, 0), pa0, acc, 0, 0, 0);
        acc = __builtin_amdgcn_mfma_f32_32x32x16_bf16(att::v_frag_rt(vbuf, va_et, fo.vd, 1), pa1, acc, 0, 0, 0);
        acc = __builtin_amdgcn_mfma_f32_32x32x16_bf16(att::v_frag_rt(vbuf, va_et, fo.vd, 2), pa2, acc, 0, 0, 0);
        acc = __builtin_amdgcn_mfma_f32_32x32x16_bf16(att::v_frag_rt(vbuf, va_et, fo.vd, 3), pa3, acc, 0, 0, 0);
#pragma unroll
        for (int ks = 0; ks < 4; ++ks) { const f32x4 s0 = sf[2 * ks], s1 = sf[2 * ks + 1];
            acc = __builtin_amdgcn_mfma_f32_32x32x16_bf16(att::pack8(s0[0], s0[1], s0[2], s0[3], s1[0], s1[1], s1[2], s1[3]), qfr[ks], acc, 0, 0, 0); }
        float ss = 0.f;
#pragma unroll
        for (int r = 0; r < 16; ++r) ss = fmaf(acc[r], acc[r], ss);
        ss += __shfl_xor(ss, 32);
        LAS float* part = (LAS float*)(lds + L_PART);
        if (hi == 0) part[et * 64 + tl] = ss;
        asm volatile("s_waitcnt lgkmcnt(0)" ::: "memory");
        __syncthreads();
        const float rs = rsqrtf(((part[tl] + part[64 + tl]) + (part[128 + tl] + part[192 + tl])) * (1.0f / 128.0f) + EPS);
#pragma unroll
        for (int g = 0; g < 4; ++g) {
            const int e0 = 32 * et + 8 * g + 4 * hi;
            const unsigned long long ow = *(const LAS unsigned long long*)(ogbuf + att::img_off(tl, 4 * et + g) + 8 * hi);
            const f32x4 gg = *(const f32x4*)(F.g_gla + e0);
            float y[4];
#pragma unroll
            for (int i = 0; i < 4; ++i) { const float og = __uint_as_float(((unsigned)(ow >> (16 * i)) & 0xffffu) << 16); y[i] = acc[4 * g + i] * rs * gg[i] * (og * __builtin_amdgcn_rcpf(1.0f + __expf(-og))); }
            *(LAS unsigned long long*)(lds + L_STG + tl * SP + e0 * 2) = (unsigned long long)pg8::cvt_pk_bf16(y[0], y[1]) | ((unsigned long long)pg8::cvt_pk_bf16(y[2], y[3]) << 32);
        }
        asm volatile("s_waitcnt lgkmcnt(0)" ::: "memory");
        __syncthreads();
#pragma unroll
        for (int i = 0; i < 2; ++i) { const int cidx = tid + 512 * i, row = cidx >> 4, ch = cidx & 15;
            *(u32x4*)(F.CAT + (size_t)(b * SEQ + 64 * c + row) * D + 512 + h * 128 + ch * 8) = *(const LAS u32x4*)(lds + L_STG + row * SP + ch * 16); }
        cur = nxt;
    }
    __syncthreads();
}
}
__device__ __forceinline__ void ph_rope_tables(Frame& F, float* R128, float* R64) {
    for (int i = F.vcu * NTHR + F.tid; i < SEQ * 24; i += F.G * NTHR) {
        const int pos = i / 24, k = i % 24;
        if (k < 16) { const float inv = powf(500000.0f, -(float)k * 2.0f / 32.0f), ang = (float)pos * inv; R128[pos * 32 + k] = cosf(ang); R128[pos * 32 + 16 + k] = sinf(ang); }
        else { const int j = k - 16; const float inv = powf(500000.0f, -(float)j * 2.0f / 16.0f), ang = (float)pos * inv; R64[pos * 16 + j] = cosf(ang); R64[pos * 16 + 8 + j] = sinf(ang); }
    }
}
__device__ __forceinline__ float dpp_xor1(float v) { return __builtin_bit_cast(float, __builtin_amdgcn_mov_dpp(__builtin_bit_cast(int, v), 0xB1, 0xF, 0xF, true)); }
__device__ __forceinline__ float dpp_xor2(float v) { return __builtin_bit_cast(float, __builtin_amdgcn_mov_dpp(__builtin_bit_cast(int, v), 0x4E, 0xF, 0xF, true)); }
__device__ __forceinline__ void ph_prep_c_fast(Frame& F) {
    const int gw = F.vcu * NWAVES + F.wave, NGW = F.G * NWAVES, lane = F.lane;
    const float* gn = (lane < 32 ? F.gq_c : F.gk_c) + (lane & 3) * 32;
    const float sc = lane < 32 ? att::C2 : 1.0f;
    float g[32];
#pragma unroll
    for (int i = 0; i < 8; ++i) { const f32x4 v = *(const f32x4*)(gn + 4 * i); g[4 * i] = v[0] * sc; g[4 * i + 1] = v[1] * sc; g[4 * i + 2] = v[2] * sc; g[4 * i + 3] = v[3] * sc; }
    for (int tok = gw; tok < M; tok += NGW) {
        att::u32x4* p = (att::u32x4*)(F.R1 + (size_t)tok * NC + lane * 32);
        att::u32x4 v[4]; float f[32]; float ss = 0.f;
#pragma unroll
        for (int i = 0; i < 4; ++i) v[i] = p[i];
#pragma unroll
        for (int i = 0; i < 4; ++i)
#pragma unroll
            for (int j = 0; j < 4; ++j) { const float a = __uint_as_float(v[i][j] << 16), b = __uint_as_float(v[i][j] & 0xffff0000u); f[8 * i + 2 * j] = a; f[8 * i + 2 * j + 1] = b; ss = fmaf(a, a, fmaf(b, b, ss)); }
        ss += dpp_xor1(ss); ss += dpp_xor2(ss);
        const float rs = rsqrtf(ss * (1.f / 128.f) + EPS);
#pragma unroll
        for (int i = 0; i < 4; ++i) { att::u32x4 o;
#pragma unroll
            for (int j = 0; j < 4; ++j) o[j] = pg8::cvt_pk_bf16(f[8 * i + 2 * j] * rs * g[8 * i + 2 * j], f[8 * i + 2 * j + 1] * rs * g[8 * i + 2 * j + 1]);
            p[i] = o; }
    }
}
__device__ __forceinline__ void ph_prep_a_fast(Frame& F, const float* R128, const float* R64) {
    const int gw = F.vcu * NWAVES + F.wave, NGW = F.G * NWAVES, lane = F.lane, l8 = lane & 7;
    const float* gn = (lane < 32 ? F.gq_a : F.gk_a) + l8 * 16;
    const float sc = lane < 32 ? att::C2 : 1.0f;
    float g[16];
#pragma unroll
    for (int i = 0; i < 4; ++i) { const f32x4 v = *(const f32x4*)(gn + 4 * i); g[4 * i] = v[0] * sc; g[4 * i + 1] = v[1] * sc; g[4 * i + 2] = v[2] * sc; g[4 * i + 3] = v[3] * sc; }
    for (int tok = gw; tok < M; tok += NGW) {
        const int pos = tok & (SEQ - 1);
        bf16* pr = F.R1 + (size_t)tok * NAB;
        {   att::u32x4* p = (att::u32x4*)(pr + lane * 16);
            const att::u32x4 v0 = p[0], v1 = p[1]; float f[16]; float ss = 0.f;
#pragma unroll
            for (int j = 0; j < 4; ++j) { f[2 * j] = __uint_as_float(v0[j] << 16); f[2 * j + 1] = __uint_as_float(v0[j] & 0xffff0000u); f[8 + 2 * j] = __uint_as_float(v1[j] << 16); f[8 + 2 * j + 1] = __uint_as_float(v1[j] & 0xffff0000u); }
#pragma unroll
            for (int i = 0; i < 16; ++i) ss = fmaf(f[i], f[i], ss);
            ss += dpp_xor1(ss); ss += dpp_xor2(ss); ss += __shfl_xor(ss, 4);
            const float rs = rsqrtf(ss * (1.f / 128.f) + EPS);
#pragma unroll
            for (int i = 0; i < 16; ++i) f[i] = f[i] * rs * g[i];
            const float* cs = R128 + pos * 32;
#pragma unroll
            for (int i = 0; i < 16; ++i) { const float other = dpp_xor1(f[i]);
                if (l8 < 2) { const float c = cs[i], s = cs[16 + i]; f[i] = (l8 == 0) ? f[i] * c - other * s : f[i] * c + other * s; } }
            att::u32x4 o0, o1;
#pragma unroll
            for (int j = 0; j < 4; ++j) { o0[j] = pg8::cvt_pk_bf16(f[2 * j], f[2 * j + 1]); o1[j] = pg8::cvt_pk_bf16(f[8 + 2 * j], f[8 + 2 * j + 1]); }
            p[0] = o0; p[1] = o1;
        }
        {
#pragma unroll
            for (int part = 0; part < 2; ++part) {
                if (part == 1 && lane >= 8) break;
                att::u32x4* p = (att::u32x4*)(pr + (part == 0 ? C_IQ + lane * 8 : C_IK + lane * 8));
                const att::u32x4 v0 = p[0]; float f[8];
#pragma unroll
                for (int j = 0; j < 4; ++j) { f[2 * j] = __uint_as_float(v0[j] << 16); f[2 * j + 1] = __uint_as_float(v0[j] & 0xffff0000u); }
                const float* cs = R64 + pos * 16;
#pragma unroll
                for (int i = 0; i < 8; ++i) { const float other = dpp_xor1(f[i]);
                    if (l8 < 2) { const float c = cs[i], s = cs[8 + i]; f[i] = (l8 == 0) ? f[i] * c - other * s : f[i] * c + other * s; } }
                att::u32x4 o0;
#pragma unroll
                for (int j = 0; j < 4; ++j) o0[j] = pg8::cvt_pk_bf16(f[2 * j], f[2 * j + 1]);
                p[0] = o0;
            }
        }
    }
}
#ifndef MK_PER_PHASE
#define MK_PER_PHASE 0
#endif
constexpr int NPH = 14;
struct Args { const float* in[16]; float* out; unsigned char* ws; int ph_lo, ph_hi; };
__global__ void __launch_bounds__(NTHR, 2) mk_fwd(Args args) {
    extern __shared__ __attribute__((aligned(16))) unsigned char lds[];
    Frame F;
    F.lds = (LAS unsigned char*)lds;
    F.MISC = (volatile LAS unsigned*)(F.lds + MISC_OFF);
    F.wave = __builtin_amdgcn_readfirstlane((int)threadIdx.x >> 6);
#define RELANE() (F.lane = lane_id_opaque(), F.tid = F.wave * 64 + F.lane, true)
    RELANE();
#ifdef PROBE_ACC
    F.acc_t0 = 0ull; F.acc_sum = 0ull;
#endif
    F.G = gridDim.x; { const int bx = blockIdx.x; F.vcu = (F.G % 8 == 0) ? (bx % 8) * (F.G / 8) + bx / 8 : bx; }
    unsigned char* ws = args.ws;
    F.ctl = (gu32*)(ws + WS_CTL);
    F.x = args.in[0]; F.g_mix = args.in[1]; F.g_ffn = args.in[2]; F.w_in_ab = args.in[3]; F.gq_a = args.in[4]; F.gk_a = args.in[5]; F.w_gate_up = args.in[6]; F.b_gate = args.in[7];
    F.g_gla = args.in[8]; F.w_out_ab = args.in[9]; F.w_in_c = args.in[10]; F.gq_c = args.in[11]; F.gk_c = args.in[12]; F.w_out_c = args.in[13]; F.w_up = args.in[14]; F.w_down = args.in[15];
    F.out = args.out;
    F.Wab = (bf16*)(ws + WS_WAB); F.Woab = (bf16*)(ws + WS_WOAB); F.Wup0 = (bf16*)(ws + WS_WUP0); F.Wdn0 = (bf16*)(ws + WS_WDN0);
    F.Winc = (bf16*)(ws + WS_WINC); F.Woc = (bf16*)(ws + WS_WOC); F.Wup1 = (bf16*)(ws + WS_WUP1); F.Wdn1 = (bf16*)(ws + WS_WDN1);
    F.XB = (bf16*)(ws + WS_XB); F.CAT = (bf16*)(ws + WS_CAT); F.R1 = (bf16*)(ws + WS_R1); F.SSQ = (float*)(ws + WS_SSQ); F.MASK = (unsigned*)(ws + WS_MASK);
    for (int u = F.tid; u < (LDS_BYTES - MISC_OFF) / 4; u += NTHR) ((LAS unsigned*)(F.lds + MISC_OFF))[u] = 0u;
    __syncthreads();
    XcdBarrier bar; bar.bar = (unsigned*)(F.ctl + CW_BAR); bar.x = 0; bar.st = nullptr; bar.wave = F.wave;
    if (!MK_PER_PHASE) bar = xcd_barrier_post((unsigned*)(F.ctl + CW_BAR), F.MISC + 8, F.wave);
    const int lo = args.ph_lo, hi = args.ph_hi;
#ifdef PROBE_PH
    unsigned long long pt0 = 0ull, pt1 = 0ull;
#define STAMP(k) do { if ((k) == PROBE_PH) pt0 = __builtin_amdgcn_s_memrealtime(); if ((k) == PROBE_PH + 1) pt1 = __builtin_amdgcn_s_memrealtime(); } while (0)
#ifdef PROBE_SUB
#define SUBSTAMP(k) do { if ((k) == PROBE_PH) { __syncthreads(); pt0 = __builtin_amdgcn_s_memrealtime(); } } while (0)
#else
#define SUBSTAMP(k) do { } while (0)
#endif
#else
#define STAMP(k) do { } while (0)
#define SUBSTAMP(k) do { } while (0)
#endif
#define IN(k) (lo <= (k) && (k) < hi && RELANE())
#define SEAM(k) do { if (lo <= (k) && (k) + 1 < hi) xcd_barrier(bar); } while (0)
    float* const SSQ0 = F.SSQ, *SSQ1 = F.SSQ + (size_t)M * 16, *SSQ2 = F.SSQ + (size_t)2 * M * 16, *SSQ3 = F.SSQ + (size_t)3 * M * 16;
    typedef pg8::StaticOrder SO;
    STAMP(0); float* const R128 = (float*)(ws + WS_ROPE); float* const R64 = R128 + SEQ * 32;
    if (IN(0)) { ph_prologue(F); ph_rope_tables(F, R128, R64); } SEAM(0);
    STAMP(1); if (IN(1)) { pg8::Gemm g{F.XB, F.Wab, M, NAB, D}; SO S; S.init(M, NAB, F.G, (int)blockIdx.x); pg8::EpiScale<0> E{F.R1, NAB, SSQ0};
        pg8::gemm_phase<pg8::EpiScale<0>, SO, true, true>(F.lds, g, S, E, F.wave);
        if (F.G == 256 && blockIdx.x >= 128) { RELANE(); prologue_weights<1>(F, ((int)blockIdx.x - 128) * NWAVES + F.wave, 128 * NWAVES); } } SEAM(1);
    float* const GU = (float*)(ws + WS_XB); float* const DEC = (float*)(ws + WS_DEC);
    STAMP(2); if (IN(2)) { ph_prep_a_fast(F, R128, R64); SUBSTAMP(2); gla::pass_a(F, GU, DEC, (float*)(ws + WS_BC)); } SEAM(2);
    STAMP(3); if (IN(3)) { gla::pass_b(F, GU, DEC); SUBSTAMP(3); ph_indexer(F); } SEAM(3);
    STAMP(4); if (IN(4)) { ph_dsa(F); SUBSTAMP(4); gla::pass_c(F, GU, (const float*)(ws + WS_BC)); } SEAM(4);
    STAMP(5); if (IN(5)) { pg8::Gemm g{F.CAT, F.Woab, M, D, D}; SO S; S.init(M, D, F.G, (int)blockIdx.x); pg8::EpiResid<0, 0> E{F.x, nullptr, F.XB, SSQ1, nullptr};
        pg8::gemm_phase<pg8::EpiResid<0, 0>, SO, true, true>(F.lds, g, S, E, F.wave); } SEAM(5);
    STAMP(6); if (IN(6)) { pg8::Gemm g{F.XB, F.Wup0, M, FF, D}; SO S; S.init(M, FF, F.G, (int)blockIdx.x); pg8::EpiScale<1> E{F.R1, FF, SSQ1};
        pg8::gemm_phase<pg8::EpiScale<1>, SO, true, true>(F.lds, g, S, E, F.wave); } SEAM(6);
    STAMP(7); if (IN(7)) { pg8::Gemm g{F.R1, F.Wdn0, M, D, FF}; SO S; S.init(M, D, F.G, (int)blockIdx.x); pg8::EpiResid<1, 0> E{F.XB, nullptr, F.XB, SSQ2, SSQ1};
        pg8::gemm_phase<pg8::EpiResid<1, 0>, SO, true, true>(F.lds, g, S, E, F.wave); } SEAM(7);
    STAMP(8); if (IN(8)) { pg8::Gemm g{F.XB, F.Winc, M, NC, D}; SO S; S.init(M, NC, F.G, (int)blockIdx.x); pg8::EpiScale<0> E{F.R1, NC, SSQ2};
        pg8::gemm_phase<pg8::EpiScale<0>, SO, true, true>(F.lds, g, S, E, F.wave); } SEAM(8);
    STAMP(9); if (IN(9)) { ph_prep_c_fast(F); } SEAM(9);
    STAMP(10); if (IN(10)) { ph_sb(F); } SEAM(10);
    STAMP(11); if (IN(11)) { pg8::Gemm g{F.CAT, F.Woc, M, D, D}; SO S; S.init(M, D, F.G, (int)blockIdx.x); pg8::EpiResid<1, 0> E{F.XB, nullptr, F.XB, SSQ3, nullptr};
        pg8::gemm_phase<pg8::EpiResid<1, 0>, SO, true, true>(F.lds, g, S, E, F.wave); } SEAM(11);
    STAMP(12); if (IN(12)) { pg8::Gemm g{F.XB, F.Wup1, M, FF, D}; SO S; S.init(M, FF, F.G, (int)blockIdx.x); pg8::EpiScale<1> E{F.R1, FF, SSQ3};
        pg8::gemm_phase<pg8::EpiScale<1>, SO, true, true>(F.lds, g, S, E, F.wave); } SEAM(12);
    STAMP(13); if (IN(13)) { pg8::Gemm g{F.R1, F.Wdn1, M, D, FF}; SO S; S.init(M, D, F.G, (int)blockIdx.x); pg8::EpiResid<1, 1> E{F.XB, F.out, nullptr, nullptr, SSQ3};
        pg8::gemm_phase<pg8::EpiResid<1, 1>, SO, true, true>(F.lds, g, S, E, F.wave); }
    STAMP(NPH);
#ifdef PROBE_ACC
    if (blockIdx.x == 0) { const unsigned long long t1 = __builtin_amdgcn_s_memrealtime(), dt = F.acc_sum * PROBE_MULT; while (__builtin_amdgcn_s_memrealtime() - t1 < dt) __builtin_amdgcn_s_sleep(8); }
#endif
#ifdef PROBE_PH
    if (blockIdx.x == 0) { const unsigned long long t1 = __builtin_amdgcn_s_memrealtime(), dt = (pt1 - pt0) * PROBE_MULT; while (__builtin_amdgcn_s_memrealtime() - t1 < dt) __builtin_amdgcn_s_sleep(8); }
#endif
#undef IN
#undef SEAM
}

extern "C" void kernel_launch(void* const* d_in, const int* in_sizes, int n_in, void* d_out, int out_size, void* d_ws, size_t ws_size, hipStream_t stream) {
    static int grid = 0;
    if (grid == 0) {
        if (n_in != 16 || in_sizes[0] != M * D || out_size != M * D || ws_size < WS_END) { fprintf(stderr, "kernel_launch: unexpected shapes / workspace (%d inputs, ws %zu)\n", n_in, ws_size); grid = -1; return; }
        int dev = 0, cus = 0;
        if (hipGetDevice(&dev) != hipSuccess || hipDeviceGetAttribute(&cus, hipDeviceAttributeMultiprocessorCount, dev) != hipSuccess) { grid = -1; return; }
        if (hipFuncSetAttribute((const void*)mk_fwd, hipFuncAttributeMaxDynamicSharedMemorySize, LDS_BYTES) != hipSuccess) { fprintf(stderr, "kernel_launch: hipFuncSetAttribute failed\n"); grid = -1; return; }
        (void)hipGetLastError();
        grid = cus;
    }
    if (grid < 0) return;
    if (hipMemsetAsync((char*)d_ws + WS_CTL, 0, CTL_ZERO_BYTES, stream) != hipSuccess) { fprintf(stderr, "kernel_launch: memset failed\n"); return; }
    Args a{};
    for (int i = 0; i < 16; ++i) a.in[i] = (const float*)d_in[i];
    a.out = (float*)d_out; a.ws = (unsigned char*)d_ws;
#if MK_PER_PHASE
    for (int ph = 0; ph < NPH; ++ph) { a.ph_lo = ph; a.ph_hi = ph + 1; hipLaunchKernelGGL(mk_fwd, dim3(grid), dim3(NTHR), LDS_BYTES, stream, a); }
#else
    a.ph_lo = 0; a.ph_hi = NPH;
    hipLaunchKernelGGL(mk_fwd, dim3(grid), dim3(NTHR), LDS_BYTES, stream, a);
#endif
    const hipError_t le = hipPeekAtLastError();
    if (le != hipSuccess) fprintf(stderr, "kernel_launch: launch failed: %s\n", hipGetErrorName(le));
}
```

```cpp
#include <hip/hip_runtime.h>
#include <cstdio>
#include <cstdint>
namespace pg8 {
#define PG8_LAS __attribute__((address_space(3)))
typedef unsigned short bf16_t;
typedef short bf16x8 __attribute__((ext_vector_type(8)));
typedef float f32x4 __attribute__((ext_vector_type(4)));
typedef unsigned u32x4 __attribute__((ext_vector_type(4)));
constexpr int BM = 256, BK = 64, HALF = 128, HTB = HALF * BK * 2  , STAGE_BYTES = 8 * HTB, NXCD = 8, WGM = 8;

__host__ __device__ __forceinline__ int lds_byte(int r, int c) { const int st = (r >> 4) * 2 + (c >> 5), rr = r & 15, cc = c & 31, ob = rr * 64 + cc * 2; return st * 1024 + (ob ^ (((ob >> 9) & 1) << 5)); }
__host__ __device__ __forceinline__ void stage_rc(int b, int& R, int& C) { const int st = b / 1024, sb = b % 1024, swz = sb ^ (((sb >> 9) & 1) << 5); R = (st >> 1) * 16 + swz / 64; C = (st & 1) * 32 + (swz % 64) / 2; }
__host__ __device__ __forceinline__ int perm32(int rho) { const int n = rho >> 4, i = rho & 15; return 8 * (i >> 2) + 4 * n + (i & 3); }

struct Unit { int pm, pn; };
struct Gemm { const bf16_t* A; const bf16_t* Bt; int M, N, K; };

struct StaticOrder {
    int nM, nN, nwg, G, c;
    __host__ __device__ void init(int M, int N, int G_, int c_) { nM = M / BM; nN = N / BM; nwg = nM * nN; G = G_; c = c_; }
    __host__ __device__ bool next(int i, Unit& u) const {
        const long L = (long)i * G + c; if (L >= nwg) return false;
        int wgid = (int)L; { const int q = nwg / NXCD, r = nwg % NXCD, xcd = wgid % NXCD, off = wgid / NXCD; wgid = (xcd < r ? xcd * (q + 1) : r * (q + 1) + (xcd - r) * q) + off; }
        const int nig = WGM * nN, gid = wgid / nig, fm = gid * WGM, gsz = (nM - fm) < WGM ? (nM - fm) : WGM;
        u.pm = fm + ((wgid % nig) % gsz); u.pn = (wgid % nig) / gsz; return true;
    }
    __device__ __forceinline__ void a_ready(const Unit&) const {}
    __device__ __forceinline__ void done(const Unit&) const {}
};

__device__ __forceinline__ unsigned cvt_pk_bf16(float lo, float hi) { unsigned r; asm volatile("v_cvt_pk_bf16_f32 %0, %1, %2" : "=v"(r) : "v"(lo), "v"(hi)); return r; }
__device__ __forceinline__ float row_rstd(const float* ssqp, int row) {
    const f32x4* p = (const f32x4*)(ssqp + (size_t)row * 16);
    const f32x4 a = p[0], b = p[1], c = p[2], d = p[3];
    const float s = (((a[0] + a[1]) + (a[2] + a[3])) + ((b[0] + b[1]) + (b[2] + b[3]))) + (((c[0] + c[1]) + (c[2] + c[3])) + ((d[0] + d[1]) + (d[2] + d[3])));
    return rsqrtf(s * (1.0f / 1024.0f) + 1e-6f);
}
template <int ACT  > struct EpiScale {
    static constexpr bool PERM = true, AFTER_DRAIN = false;
    bf16_t* O; int ldc; const float* ssqp;
    __device__ __forceinline__ void operator()(const f32x4 (&acc)[2][2][4][2], const Unit& u, int wr, int wc, int fr, int fq) const {
        const int row0 = u.pm * BM + wr * 64 + fr, col0 = u.pn * BM + wc * 32 + 8 * fq;
#pragma unroll
        for (int ai = 0; ai < 2; ++ai)
#pragma unroll
            for (int m = 0; m < 4; ++m) {
                const int row = row0 + ai * HALF + m * 16;
                const float rs = (ACT == 0) ? row_rstd(ssqp, row) : 1.0f;
                bf16_t* rowp = O + (size_t)row * ldc + col0;
#pragma unroll
                for (int bj = 0; bj < 2; ++bj) {
                    f32x4 v0 = acc[ai][bj][m][0] * rs, v1 = acc[ai][bj][m][1] * rs;
                    if (ACT == 1) {
#pragma unroll
                        for (int e = 0; e < 4; ++e) { const float a0 = fmaxf(v0[e], 0.f), a1 = fmaxf(v1[e], 0.f); v0[e] = a0 * a0; v1[e] = a1 * a1; }
                    }
                    u32x4 w; w.x = cvt_pk_bf16(v0[0], v0[1]); w.y = cvt_pk_bf16(v0[2], v0[3]); w.z = cvt_pk_bf16(v1[0], v1[1]); w.w = cvt_pk_bf16(v1[2], v1[3]);
                    *(u32x4*)(rowp + bj * HALF) = w;
                }
            }
    }
};
template <int RIN, int OUT> struct EpiResid {
    static constexpr bool PERM = true, AFTER_DRAIN = false;
    const void* R; float* out; bf16_t* hb; float* ssqp; const float* ssq_in;
    __device__ __forceinline__ void operator()(const f32x4 (&acc)[2][2][4][2], const Unit& u, int wr, int wc, int fr, int fq) const {
        const int row0 = u.pm * BM + wr * 64 + fr, col0 = u.pn * BM + wc * 32 + 8 * fq;
#pragma unroll
        for (int ai = 0; ai < 2; ++ai)
#pragma unroll
            for (int m = 0; m < 4; ++m) {
                const int row = row0 + ai * HALF + m * 16;
                const size_t off = (size_t)row * 1024 + col0;
                float sc2 = 1.0f; if (ssq_in) { const float rs = row_rstd(ssq_in, row); sc2 = rs * rs; }
                float ss = 0.f;
#pragma unroll
                for (int bj = 0; bj < 2; ++bj) {
                    f32x4 r0, r1;
                    if (RIN == 0) { r0 = *(const f32x4*)((const float*)R + off + bj * HALF); r1 = *(const f32x4*)((const float*)R + off + bj * HALF + 4); }
                    else { const u32x4 rw = *(const u32x4*)((const bf16_t*)R + off + bj * HALF);
                        r0 = (f32x4){__uint_as_float(rw.x << 16), __uint_as_float(rw.x & 0xffff0000u), __uint_as_float(rw.y << 16), __uint_as_float(rw.y & 0xffff0000u)};
                        r1 = (f32x4){__uint_as_float(rw.z << 16), __uint_as_float(rw.z & 0xffff0000u), __uint_as_float(rw.w << 16), __uint_as_float(rw.w & 0xffff0000u)}; }
                    const f32x4 v0 = acc[ai][bj][m][0] * sc2 + r0, v1 = acc[ai][bj][m][1] * sc2 + r1;
                    if (OUT == 1) { *(f32x4*)(out + off + bj * HALF) = v0; *(f32x4*)(out + off + bj * HALF + 4) = v1; }
                    else {
                        u32x4 w; w.x = cvt_pk_bf16(v0[0], v0[1]); w.y = cvt_pk_bf16(v0[2], v0[3]); w.z = cvt_pk_bf16(v1[0], v1[1]); w.w = cvt_pk_bf16(v1[2], v1[3]);
                        *(u32x4*)(hb + off + bj * HALF) = w;
                        ss += ((v0[0] * v0[0] + v0[1] * v0[1]) + (v0[2] * v0[2] + v0[3] * v0[3])) + ((v1[0] * v1[0] + v1[1] * v1[1]) + (v1[2] * v1[2] + v1[3] * v1[3]));
                    }
                }
                if (OUT == 0) { ss += __shfl_xor(ss, 16); ss += __shfl_xor(ss, 32); if (fq == 0) ssqp[(size_t)row * 16 + u.pn * 4 + wc] = ss; }
            }
    }
};
struct EpiQKNorm {
    static constexpr bool PERM = true, AFTER_DRAIN = false;
    bf16_t* O; int ldc; const float* ssqp; const float* gq; const float* gk; PG8_LAS float* part; float qscale;
    __device__ __forceinline__ void operator()(const f32x4 (&acc)[2][2][4][2], const Unit& u, int wr, int wc, int fr, int fq) const {
        const int row0 = u.pm * BM + wr * 64 + fr, col0 = u.pn * BM + wc * 32 + 8 * fq;
        const bool nrm = u.pn < 8;
        f32x4 g0 = (f32x4){1.f, 1.f, 1.f, 1.f}, g1 = g0;
        if (nrm) {
#pragma unroll
            for (int ai = 0; ai < 2; ++ai)
#pragma unroll
                for (int m = 0; m < 4; ++m)
#pragma unroll
                    for (int bj = 0; bj < 2; ++bj) { const f32x4 v0 = acc[ai][bj][m][0], v1 = acc[ai][bj][m][1];
                        float ss = ((v0[0] * v0[0] + v0[1] * v0[1]) + (v0[2] * v0[2] + v0[3] * v0[3])) + ((v1[0] * v1[0] + v1[1] * v1[1]) + (v1[2] * v1[2] + v1[3] * v1[3]));
                        ss += __shfl_xor(ss, 16); ss += __shfl_xor(ss, 32);
                        if (fq == 0) part[((ai * HALF + wr * 64 + m * 16 + fr) * 2 + bj) * 4 + wc] = ss; }
            asm volatile("s_waitcnt lgkmcnt(0)" ::: "memory"); __builtin_amdgcn_s_barrier(); asm volatile("" ::: "memory");
            const float* gp = (u.pn < 4 ? gq : gk) + wc * 32 + 8 * fq; const float sc = (u.pn < 4) ? qscale : 1.0f;
            g0 = *(const f32x4*)gp * sc; g1 = *(const f32x4*)(gp + 4) * sc;
        }
#pragma unroll
        for (int ai = 0; ai < 2; ++ai)
#pragma unroll
            for (int m = 0; m < 4; ++m) {
                const int row = row0 + ai * HALF + m * 16;
                const float rsr = row_rstd(ssqp, row);
                bf16_t* rowp = O + (size_t)row * ldc + col0;
#pragma unroll
                for (int bj = 0; bj < 2; ++bj) {
                    float hs = rsr;
                    if (nrm) { const f32x4 pp = *(const PG8_LAS f32x4*)(part + ((ai * HALF + wr * 64 + m * 16 + fr) * 2 + bj) * 4);
                        hs *= rsqrtf(((pp[0] + pp[1]) + (pp[2] + pp[3])) * (rsr * rsr * (1.0f / 128.0f)) + 1e-6f); }
                    const f32x4 v0 = acc[ai][bj][m][0] * hs * g0, v1 = acc[ai][bj][m][1] * hs * g1;
                    u32x4 w; w.x = cvt_pk_bf16(v0[0], v0[1]); w.y = cvt_pk_bf16(v0[2], v0[3]); w.z = cvt_pk_bf16(v1[0], v1[1]); w.w = cvt_pk_bf16(v1[2], v1[3]);
                    *(u32x4*)(rowp + bj * HALF) = w;
                }
            }
    }
};
template <class Epi, class Sched, bool ALIGN_EPI = false, bool SP2 = false>
__device__ __forceinline__ void gemm_phase(PG8_LAS unsigned char* lds, const Gemm g, const Sched& S, const Epi& E, const int wave_in) {
    const int wid = wave_in, lane = (int)__builtin_amdgcn_mbcnt_hi(~0u, __builtin_amdgcn_mbcnt_lo(~0u, 0u)), tid = wid * 64 + lane, wr = wid >> 2, wc = wid & 3, fr = lane & 15, fq = lane >> 4;
    const int K = g.K, nt = K / BK;
    unsigned voffA[2], voffB[2];
#pragma unroll
    for (int i = 0; i < 2; ++i) { int R, C; stage_rc(tid * 16 + i * 8192, R, C); const int Rb = Epi::PERM ? ((R & ~31) + perm32(R & 31)) : R;
        voffA[i] = (unsigned)(R * K + C) * 2u; voffB[i] = (unsigned)(Rb * K + C) * 2u; }
    const size_t kstep = (size_t)(BK * 2);
    const size_t hstep = (size_t)HALF * K * 2;
    const size_t tstep = 2 * hstep;
    const unsigned ldsw = (unsigned)wid * 1024u;
    const int aoff = lds_byte(wr * 64 + fr, fq * 8), boff = lds_byte(wc * 32 + fr, fq * 8);
#define PG8_SA(b, h) (((b) * 2 + (h)) * HTB)
#define PG8_SB(b, h) ((4 + (b) * 2 + (h)) * HTB)
#define PG8_STAGE(bufoff, gbase, voff) do { _Pragma("unroll") for (int _i = 0; _i < 2; ++_i) \
        __builtin_amdgcn_global_load_lds((const unsigned*)((const char*)(gbase) + (voff)[_i]), (PG8_LAS unsigned*)(lds + (bufoff) + ldsw + _i * 8192), 16, 0, 0); } while (0)
#define PG8_LDA(dst, b, h) do { _Pragma("unroll") for (int m = 0; m < 4; ++m) _Pragma("unroll") for (int k = 0; k < 2; ++k) dst[m][k] = *(const PG8_LAS bf16x8*)(lds + PG8_SA(b, h) + aoff + m * 2048 + k * 1024); } while (0)
#define PG8_LDB(dst, b, h) do { _Pragma("unroll") for (int n = 0; n < 2; ++n) _Pragma("unroll") for (int k = 0; k < 2; ++k) dst[n][k] = *(const PG8_LAS bf16x8*)(lds + PG8_SB(b, h) + boff + n * 2048 + k * 1024); } while (0)
#define PG8_MMA(ai, bj, At, Bt) do { __builtin_amdgcn_s_setprio(1); _Pragma("unroll") for (int m = 0; m < 4; ++m) _Pragma("unroll") for (int n = 0; n < 2; ++n) _Pragma("unroll") for (int k = 0; k < 2; ++k) \
        acc[ai][bj][m][n] = __builtin_amdgcn_mfma_f32_16x16x32_bf16(Bt[n][k], At[m][k], acc[ai][bj][m][n], 0, 0, 0); __builtin_amdgcn_s_setprio(0); } while (0)
#define PG8_WAIT_V(n) asm volatile("s_waitcnt vmcnt(" #n ")" ::: "memory")
#define PG8_WAIT_L(n) asm volatile("s_waitcnt lgkmcnt(" #n ")" ::: "memory")
#define PG8_BAR __builtin_amdgcn_s_barrier()
#define PG8_SCHED __builtin_amdgcn_sched_barrier(0)
    Unit cur, nxt; int ui = 0;
    if (!S.next(0, cur)) return;
    f32x4 acc[2][2][4][2];
#pragma unroll
    for (int a = 0; a < 2; ++a)
#pragma unroll
        for (int b = 0; b < 2; ++b)
#pragma unroll
            for (int m = 0; m < 4; ++m)
#pragma unroll
                for (int n = 0; n < 2; ++n) acc[a][b][m][n] = (f32x4){0.f, 0.f, 0.f, 0.f};
    bf16x8 At[4][2], B0[2][2], B1[2][2];
    const char* cA = (const char*)g.A + (size_t)cur.pm * tstep; const char* cB = (const char*)g.Bt + (size_t)cur.pn * tstep;
    S.a_ready(cur);
    if constexpr (SP2) {
        PG8_STAGE(PG8_SB(0, 0), cB, voffB); PG8_STAGE(PG8_SB(0, 1), cB + hstep, voffB); PG8_STAGE(PG8_SA(0, 0), cA, voffA); PG8_STAGE(PG8_SA(0, 1), cA + hstep, voffA);
        if (wr == 1) PG8_BAR;
        PG8_WAIT_V(2); PG8_BAR;
        PG8_STAGE(PG8_SB(1, 0), cB + kstep, voffB); PG8_STAGE(PG8_SA(1, 0), cA + kstep, voffA); PG8_STAGE(PG8_SB(1, 1), cB + hstep + kstep, voffB);
        PG8_WAIT_V(6); PG8_BAR;
    } else {
        PG8_STAGE(PG8_SB(0, 0), cB, voffB); PG8_STAGE(PG8_SA(0, 0), cA, voffA); PG8_STAGE(PG8_SB(0, 1), cB + hstep, voffB); PG8_STAGE(PG8_SA(0, 1), cA + hstep, voffA);
        if (wr == 1) PG8_BAR;
        PG8_WAIT_V(4); PG8_BAR;
        PG8_STAGE(PG8_SB(1, 0), cB + kstep, voffB); PG8_STAGE(PG8_SA(1, 0), cA + kstep, voffA); PG8_STAGE(PG8_SB(1, 1), cB + hstep + kstep, voffB);
        PG8_WAIT_V(6); PG8_BAR;
    }
    for (;;) {
        const bool has_next = S.next(ui + 1, nxt);
        const char* nA = has_next ? (const char*)g.A + (size_t)nxt.pm * tstep : cA; const char* nB = has_next ? (const char*)g.Bt + (size_t)nxt.pn * tstep : cB;
        for (int t = 0; t < nt; t += 2) {
            const bool last = (t == nt - 2);
            const char* a1 = cA + (size_t)(t + 1) * kstep;
            const char* a2 = last ? nA : cA + (size_t)(t + 2) * kstep; const char* b2 = last ? nB : cB + (size_t)(t + 2) * kstep;
            const char* a3 = a2 + kstep; const char* b3 = b2 + kstep;
            if (last && has_next) S.a_ready(nxt);
            if constexpr (SP2) {
            PG8_LDB(B0, 0, 0); PG8_LDB(B1, 0, 1); PG8_SCHED; PG8_LDA(At, 0, 0); PG8_STAGE(PG8_SA(1, 1), a1 + hstep, voffA);
            PG8_WAIT_V(8); PG8_WAIT_L(0); PG8_BAR; PG8_MMA(0, 0, At, B0); PG8_MMA(0, 1, At, B1); PG8_BAR; PG8_SCHED;
            PG8_LDA(At, 0, 1); PG8_STAGE(PG8_SB(0, 0), b2, voffB); PG8_STAGE(PG8_SB(0, 1), b2 + hstep, voffB); PG8_STAGE(PG8_SA(0, 0), a2, voffA);
            PG8_WAIT_V(8); PG8_WAIT_L(0); PG8_BAR; PG8_MMA(1, 0, At, B0); PG8_MMA(1, 1, At, B1); PG8_BAR; PG8_SCHED;
            PG8_LDB(B0, 1, 0); PG8_LDB(B1, 1, 1); PG8_SCHED; PG8_LDA(At, 1, 0); PG8_STAGE(PG8_SA(0, 1), a2 + hstep, voffA);
            PG8_WAIT_V(8); PG8_WAIT_L(0); PG8_BAR; PG8_MMA(0, 0, At, B0); PG8_MMA(0, 1, At, B1); PG8_BAR; PG8_SCHED;
            PG8_LDA(At, 1, 1); PG8_STAGE(PG8_SB(1, 0), b3, voffB); PG8_STAGE(PG8_SB(1, 1), b3 + hstep, voffB); PG8_STAGE(PG8_SA(1, 0), a3, voffA);
            PG8_WAIT_V(8); PG8_WAIT_L(0); PG8_BAR; PG8_MMA(1, 0, At, B0); PG8_MMA(1, 1, At, B1); PG8_BAR; PG8_SCHED;
            } else {
            PG8_LDB(B0, 0, 0); PG8_SCHED; PG8_LDA(At, 0, 0); PG8_STAGE(PG8_SA(1, 1), a1 + hstep, voffA);
            PG8_WAIT_L(8); PG8_BAR; PG8_WAIT_L(0); PG8_MMA(0, 0, At, B0); PG8_BAR; PG8_SCHED;
            PG8_LDB(B1, 0, 1); PG8_STAGE(PG8_SB(0, 0), b2, voffB);
            PG8_BAR; PG8_WAIT_L(0); PG8_MMA(0, 1, At, B1); PG8_BAR;
            PG8_LDA(At, 0, 1); PG8_STAGE(PG8_SA(0, 0), a2, voffA);
            PG8_BAR; PG8_WAIT_L(0); PG8_MMA(1, 0, At, B0); PG8_BAR; PG8_SCHED;
            PG8_STAGE(PG8_SB(0, 1), b2 + hstep, voffB);
            PG8_WAIT_V(6); PG8_BAR; PG8_MMA(1, 1, At, B1); PG8_BAR;
            PG8_LDB(B0, 1, 0); PG8_SCHED; PG8_LDA(At, 1, 0); PG8_STAGE(PG8_SA(0, 1), a2 + hstep, voffA);
            PG8_WAIT_L(8); PG8_BAR; PG8_WAIT_L(0); PG8_MMA(0, 0, At, B0); PG8_BAR; PG8_SCHED;
            PG8_LDB(B1, 1, 1); PG8_STAGE(PG8_SB(1, 0), b3, voffB);
            PG8_BAR; PG8_WAIT_L(0); PG8_MMA(0, 1, At, B1); PG8_BAR;
            PG8_LDA(At, 1, 1); PG8_STAGE(PG8_SA(1, 0), a3, voffA);
            PG8_BAR; PG8_WAIT_L(0); PG8_MMA(1, 0, At, B0); PG8_BAR; PG8_SCHED;
            PG8_STAGE(PG8_SB(1, 1), b3 + hstep, voffB);
            PG8_WAIT_V(6); PG8_BAR; PG8_MMA(1, 1, At, B1); PG8_BAR;
            }
        }
        if constexpr (ALIGN_EPI) { if (wr == 0) PG8_BAR; }
        if constexpr (!Epi::AFTER_DRAIN) { E(acc, cur, wr, wc, fr, fq); S.done(cur); }
        if (!has_next) break;
#pragma unroll
        for (int a = 0; a < 2; ++a)
#pragma unroll
            for (int b = 0; b < 2; ++b)
#pragma unroll
                for (int m = 0; m < 4; ++m)
#pragma unroll
                    for (int n = 0; n < 2; ++n) acc[a][b][m][n] = (f32x4){0.f, 0.f, 0.f, 0.f};
        cur = nxt; cA = nA; cB = nB; ++ui;
        if constexpr (ALIGN_EPI) { if (wr == 1) PG8_BAR; }
    }
    PG8_WAIT_V(0);
    if constexpr (!ALIGN_EPI) { if (wr == 0) PG8_BAR; }
    PG8_BAR;
    if constexpr (Epi::AFTER_DRAIN) { E.fused(acc, cur, wr, wc, fr, fq, lds, wid, lane); S.done(cur); }
#undef PG8_SA
#undef PG8_SB
#undef PG8_STAGE
#undef PG8_LDA
#undef PG8_LDB
#undef PG8_MMA
#undef PG8_WAIT_V
#undef PG8_WAIT_L
#undef PG8_BAR
#undef PG8_SCHED
}
}
#include <cmath>
constexpr int NWAVES = 8, NTHR = 512;
constexpr int BATCH = 16, SEQ = 2048, M = BATCH * SEQ, D = 1024, FF = 4096, NAB = 3840, NC = 3072, ABP_OLD = 3672;
constexpr int C_QA = 0, C_KA = 512, C_VA = 1024, C_IQ = 1536, C_QB = 2048, C_KB = 2304, C_VB = 2560, C_OG = 3072, C_IK = 3584, C_IW = 3648, C_GL = 3656;
constexpr float EPS = 1e-6f;
constexpr size_t MiB = 1u << 20;
constexpr size_t WS_CTL = 0, CTL_ZERO_BYTES = 64 * 1024;
constexpr size_t WS_WAB = 1 * MiB, WS_WOAB = 9 * MiB, WS_WUP0 = 11 * MiB, WS_WDN0 = 19 * MiB, WS_WINC = 27 * MiB, WS_WOC = 33 * MiB, WS_WUP1 = 35 * MiB, WS_WDN1 = 43 * MiB;
constexpr size_t WS_SSQ = 51 * MiB, SSQ_BYTES = 2 * MiB;
constexpr size_t WS_DEC = 59 * MiB;
constexpr size_t WS_ROPE = 59 * MiB + 512 * 1024;
constexpr size_t WS_XB = 60 * MiB;
constexpr size_t WS_CAT = 124 * MiB;
constexpr size_t WS_MASK = 188 * MiB;
constexpr size_t WS_R1 = 196 * MiB;
constexpr size_t WS_BC = 452 * MiB;
constexpr size_t WS_END = 484 * MiB;
constexpr int CW_BAR = 4096;
constexpr int RING_BYTES = 131072;
constexpr int LDS_BYTES = 163840;
constexpr int MISC_OFF = LDS_BYTES - 256;
#define GAS __attribute__((address_space(1)))
#define LAS __attribute__((address_space(3)))
typedef unsigned short bf16;
typedef unsigned v4u __attribute__((ext_vector_type(4)));
typedef float f32x4 __attribute__((ext_vector_type(4)));
typedef short bf16x8 __attribute__((ext_vector_type(8)));
typedef GAS unsigned gu32;
typedef GAS unsigned long long gu64;
#define RLX_AGENT __ATOMIC_RELAXED, __HIP_MEMORY_SCOPE_AGENT
#define LDS_WAIT() asm volatile("s_waitcnt lgkmcnt(0)" ::: "memory")
#define VM_WAIT() asm volatile("s_waitcnt vmcnt(0)" ::: "memory")
__device__ __forceinline__ unsigned long long rt() { return __builtin_amdgcn_s_memrealtime(); }
__device__ __forceinline__ unsigned f2bf(float f) { unsigned u = __builtin_bit_cast(unsigned, f); return (u + 0x7fffu + ((u >> 16) & 1u)) >> 16; }
__device__ __forceinline__ unsigned pk2(float lo, float hi) { return f2bf(lo) | (f2bf(hi) << 16); }
#define XB_TMO      128
#define XB_XCNT(j)  (256  + 64 * (j))
#define XB_XSUB(j)  (1280 + 64 * (j))
#define XB_XGEN(j)  (2304 + 64 * (j))
#define XB_TOP      3328
#define XB_TOPGEN   3392
#define XCD_BAR_WORDS 3456
#define XB_SPIN_CAP (1u << 18)

__device__ __forceinline__ unsigned xb_ld(unsigned* p)              { return __hip_atomic_load(p, __ATOMIC_RELAXED, __HIP_MEMORY_SCOPE_AGENT); }
__device__ __forceinline__ unsigned xb_add(unsigned* p, unsigned v) { return __hip_atomic_fetch_add(p, v, __ATOMIC_RELAXED, __HIP_MEMORY_SCOPE_AGENT); }
__device__ __forceinline__ unsigned xb_xcc_id() { return (unsigned)__builtin_amdgcn_s_getreg((3 << 11) | 20) & 0xFu; }
#define XB_SPIN(cond, bar) do { unsigned _sp = 0; while (cond) { __builtin_amdgcn_s_sleep(1); \
    if ((++_sp & 255u) == 0u) { if (xb_ld(&(bar)[XB_TMO])) break; if (_sp > XB_SPIN_CAP) { atomicAdd(&(bar)[XB_TMO], 1u); break; } } } } while (0)

struct XcdBarrier {
    unsigned* bar; unsigned x; int wave;
    volatile LAS unsigned* st;
};

__device__ __forceinline__ bool xb_t0(int wave) { return wave == 0 && __builtin_amdgcn_mbcnt_hi(~0u, __builtin_amdgcn_mbcnt_lo(~0u, 0u)) == 0u; }
__device__ __forceinline__ XcdBarrier xcd_barrier_post(unsigned* bar, volatile LAS unsigned* st, int wave) {
    XcdBarrier b; b.bar = bar; b.x = xb_xcc_id(); b.st = st; b.wave = wave;
    if (xb_t0(wave)) (void)xb_add(&bar[XB_XCNT(b.x)], 1u);
    return b;
}
__device__ __forceinline__ void xcd_barrier_complete(unsigned* bar, unsigned x, unsigned& nloc, unsigned& nx) {
    const unsigned G = gridDim.x * gridDim.y * gridDim.z;
    unsigned sum, cnt, mine, sp = 0u;
    for (;;) {
        sum = 0u; cnt = 0u; mine = 0u;
#pragma unroll
        for (unsigned j = 0; j < 16; ++j) { const unsigned c = xb_ld(&bar[XB_XCNT(j)]); sum += c; cnt += (c > 0u) ? 1u : 0u; mine = (j == x) ? c : mine; }
        if (sum == G) break;
        __builtin_amdgcn_s_sleep(1);
        if ((++sp & 255u) == 0u) { if (xb_ld(&bar[XB_TMO])) break; if (sp > XB_SPIN_CAP) { atomicAdd(&bar[XB_TMO], 1u); break; } }
    }
    nloc = mine > 0u ? mine : 1u; nx = cnt > 0u ? cnt : 1u;
}

__device__ __forceinline__ void xcd_barrier(const XcdBarrier& b) {
    asm volatile("s_waitcnt vmcnt(0)" ::: "memory");
    __syncthreads();
    if (xb_t0(b.wave)) {
        unsigned* bar = b.bar;
        __builtin_amdgcn_s_waitcnt(0);
        unsigned nloc = b.st[0], nx = b.st[1];
        if (nloc == 0u) { xcd_barrier_complete(bar, b.x, nloc, nx); b.st[0] = nloc; b.st[1] = nx; }
        const unsigned old = xb_add(&bar[XB_XSUB(b.x)], 1u);
        const unsigned gen = old / nloc;
        if (old + 1u == (gen + 1u) * nloc) {
            __builtin_amdgcn_fence(__ATOMIC_RELEASE, "agent");
            asm volatile("s_waitcnt vmcnt(0)" ::: "memory");
            const unsigned og = xb_add(&bar[XB_TOP], 1u);
            const unsigned tg = og / nx;
            if (og + 1u == (tg + 1u) * nx) xb_add(&bar[XB_TOPGEN], 1u);
            else XB_SPIN(xb_ld(&bar[XB_TOPGEN]) == tg, bar);
            __builtin_amdgcn_fence(__ATOMIC_ACQUIRE, "agent");
            xb_add(&bar[XB_XGEN(b.x)], 1u);
            asm volatile("s_waitcnt vmcnt(0)" ::: "memory");
        } else {
            XB_SPIN(xb_ld(&bar[XB_XGEN(b.x)]) == gen, bar);
            __builtin_amdgcn_fence(__ATOMIC_ACQUIRE, "agent");
            asm volatile("s_waitcnt vmcnt(0)" ::: "memory");
        }
    }
    __syncthreads();
}
#ifdef PROBE_ACC
#define ACC_BEGIN(F, id) do { if ((id) == PROBE_ACC) { __syncthreads(); (F).acc_t0 = __builtin_amdgcn_s_memrealtime(); } } while (0)
#define ACC_END(F, id) do { if ((id) == PROBE_ACC) { __syncthreads(); (F).acc_sum += __builtin_amdgcn_s_memrealtime() - (F).acc_t0; } } while (0)
#else
#define ACC_BEGIN(F, id) do { } while (0)
#define ACC_END(F, id) do { } while (0)
#endif
struct Frame {
#ifdef PROBE_ACC
    unsigned long long acc_t0, acc_sum;
#endif
    LAS unsigned char* lds;
    volatile LAS unsigned* MISC;
    gu32* ctl;
    int tid, lane, wave, vcu, G;
    const float *x, *g_mix, *g_ffn, *w_in_ab, *gq_a, *gk_a, *w_gate_up, *b_gate, *g_gla, *w_out_ab, *w_in_c, *gq_c, *gk_c, *w_out_c, *w_up, *w_down;
    float* out;
    bf16 *Wab, *Woab, *Wup0, *Wdn0, *Winc, *Woc, *Wup1, *Wdn1;
    bf16 *XB, *CAT, *R1;
    float* SSQ; unsigned* MASK;
};
__device__ __forceinline__ int lane_id_opaque() { int l; asm volatile("v_mbcnt_lo_u32_b32 %0, -1, 0\n\tv_mbcnt_hi_u32_b32 %0, -1, %0" : "=v"(l)); return l; }
__device__ __forceinline__ float bf2f(bf16 v) { return __builtin_bit_cast(float, (unsigned)v << 16); }
__device__ __forceinline__ float wave_sum(float v) {
#pragma unroll
    for (int o = 1; o < 64; o <<= 1) v += __shfl_xor(v, o);
    return v;
}
__device__ __forceinline__ float wave_max(float v) {
#pragma unroll
    for (int o = 1; o < 64; o <<= 1) v = fmaxf(v, __shfl_xor(v, o));
    return v;
}
__device__ __forceinline__ float log_sigmoid(float x) { return fminf(x, 0.f) - log1pf(expf(-fabsf(x))); }

__device__ __forceinline__ int oldcol_ab(int n) {
    if (n < 2048) return n;
    if (n < 2304) return 2120 + (n - 2048);
    if (n < 2560) return 2376 + (n - 2304);
    if (n < 3072) return 2632 + (n - 2560);
    if (n < 3584) return 3160 + (n - 3072);
    if (n < 3648) return 2048 + (n - 3584);
    if (n < 3656) return 2112 + (n - 3648);
    if (n < 3672) return 3144 + (n - 3656);
    return -1;
}
__device__ __forceinline__ void p0_transpose_item(const float* W, int ldw, int K, const float* gain, bf16* WT, bool map, int item, int nblk, int lane) {
    const int kb = item / nblk, nb = item % nblk, ng = lane & 7, ko = lane >> 3, k0 = 64 * kb + 8 * ko, n = 32 * nb + 4 * ng;
    const int oc = map ? oldcol_ab(n) : n;
    f32x4 v[8];
#pragma unroll
    for (int i = 0; i < 8; ++i) { v[i] = (f32x4){0.f, 0.f, 0.f, 0.f}; if (oc >= 0) v[i] = *(const GAS f32x4*)(W + (size_t)(k0 + i) * ldw + oc); }
    if (gain) { const f32x4 g0 = *(const GAS f32x4*)(gain + k0), g1 = *(const GAS f32x4*)(gain + k0 + 4);
#pragma unroll
        for (int i = 0; i < 4; ++i) { v[i] = v[i] * g0[i]; v[4 + i] = v[4 + i] * g1[i]; } }
#pragma unroll
    for (int e = 0; e < 4; ++e) { v4u o; o.x = pk2(v[0][e], v[1][e]); o.y = pk2(v[2][e], v[3][e]); o.z = pk2(v[4][e], v[5][e]); o.w = pk2(v[6][e], v[7][e]);
        *(GAS v4u*)(WT + (size_t)(n + e) * K + k0) = o; }
}
template <int PART> __device__ __forceinline__ void prologue_weights(Frame& F, int gw, int NGW) {
    constexpr int I_AB = (D / 64) * (NAB / 32), I_O = (D / 64) * (D / 32), I_UP = (D / 64) * (FF / 32), I_DN = (FF / 64) * (D / 32), I_C = (D / 64) * (NC / 32);
    if (PART == 0) { for (int it = gw; it < I_AB; it += NGW) p0_transpose_item(F.w_in_ab, ABP_OLD, D, F.g_mix, F.Wab, true, it, NAB / 32, F.lane); return; }
    constexpr int NITEMS = 2 * I_O + 2 * I_UP + 2 * I_DN + I_C;
    for (int it = gw; it < NITEMS; it += NGW) {
        int r = it;
        if (r < I_O) { p0_transpose_item(F.w_out_ab, D, D, nullptr, F.Woab, false, r, D / 32, F.lane); continue; } r -= I_O;
        if (r < I_UP) { p0_transpose_item(F.w_up, FF, D, F.g_ffn, F.Wup0, false, r, FF / 32, F.lane); continue; } r -= I_UP;
        if (r < I_DN) { p0_transpose_item(F.w_down, D, FF, nullptr, F.Wdn0, false, r, D / 32, F.lane); continue; } r -= I_DN;
        if (r < I_C) { p0_transpose_item(F.w_in_c, NC, D, F.g_mix + D, F.Winc, false, r, NC / 32, F.lane); continue; } r -= I_C;
        if (r < I_O) { p0_transpose_item(F.w_out_c, D, D, nullptr, F.Woc, false, r, D / 32, F.lane); continue; } r -= I_O;
        if (r < I_UP) { p0_transpose_item(F.w_up + (size_t)D * FF, FF, D, F.g_ffn + D, F.Wup1, false, r, FF / 32, F.lane); continue; } r -= I_UP;
        p0_transpose_item(F.w_down + (size_t)FF * D, D, FF, nullptr, F.Wdn1, false, r, D / 32, F.lane);
    }
}
__device__ __forceinline__ void ph_prologue(Frame& F) {
    const int gw = F.vcu * NWAVES + F.wave, NGW = F.G * NWAVES;
    prologue_weights<0>(F, gw, NGW);
    if (F.G != 256) prologue_weights<1>(F, gw, NGW);
    for (int m0 = gw; m0 < M; m0 += 4 * NGW) {
        f32x4 v[4][4]; float s[4];
#pragma unroll
        for (int r = 0; r < 4; ++r) { const int m = m0 + r * NGW; const GAS f32x4* xr = (const GAS f32x4*)(F.x + (size_t)(m < M ? m : m0) * D) + F.lane;
#pragma unroll
            for (int j = 0; j < 4; ++j) v[r][j] = xr[64 * j]; }
#pragma unroll
        for (int r = 0; r < 4; ++r) { float t = 0.f;
#pragma unroll
            for (int j = 0; j < 4; ++j) t += (v[r][j].x * v[r][j].x + v[r][j].y * v[r][j].y) + (v[r][j].z * v[r][j].z + v[r][j].w * v[r][j].w);
            s[r] = t; }
#pragma unroll
        for (int o = 1; o < 64; o <<= 1) {
#pragma unroll
            for (int r = 0; r < 4; ++r) s[r] += __shfl_xor(s[r], o); }
#pragma unroll
        for (int r = 0; r < 4; ++r) { const int m = m0 + r * NGW; if (m < M) {
            GAS unsigned long long* o8 = (GAS unsigned long long*)(F.XB + (size_t)m * D) + F.lane;
#pragma unroll
            for (int j = 0; j < 4; ++j) o8[64 * j] = (unsigned long long)pk2(v[r][j].x, v[r][j].y) | ((unsigned long long)pk2(v[r][j].z, v[r][j].w) << 32);
            if (F.lane < 16) F.SSQ[(size_t)m * 16 + F.lane] = (F.lane == 0) ? s[r] : 0.f; } }
    }
}
namespace att {
typedef short s16x4 __attribute__((ext_vector_type(4)));
typedef float f32x16 __attribute__((ext_vector_type(16)));
typedef _Float16 f16x8 __attribute__((ext_vector_type(8)));
typedef unsigned u32x4 __attribute__((ext_vector_type(4)));
typedef short v4i16_t __attribute__((ext_vector_type(4)));
constexpr float C2 = 0.08838834764831845f * 1.4426950408889634f;
__device__ __forceinline__ int crow(int r, int hi) { return (r & 3) + 8 * (r >> 2) + 4 * hi; }
__device__ __forceinline__ int img_off(int row, int ch) { return 256 * row + 16 * (ch ^ (((row & 3) << 2) | ((row >> 2) & 3))); }
__device__ __forceinline__ bf16x8 pack8(float a0, float a1, float a2, float a3, float a4, float a5, float a6, float a7) {
    u32x4 w; w.x = pg8::cvt_pk_bf16(a0, a1); w.y = pg8::cvt_pk_bf16(a2, a3); w.z = pg8::cvt_pk_bf16(a4, a5); w.w = pg8::cvt_pk_bf16(a6, a7);
    return __builtin_bit_cast(bf16x8, w);
}
__device__ __forceinline__ f16x8 pack8h(float a0, float a1, float a2, float a3, float a4, float a5, float a6, float a7) {
    f16x8 r; r[0] = (_Float16)a0; r[1] = (_Float16)a1; r[2] = (_Float16)a2; r[3] = (_Float16)a3; r[4] = (_Float16)a4; r[5] = (_Float16)a5; r[6] = (_Float16)a6; r[7] = (_Float16)a7; return r;
}
__device__ __forceinline__ void dma_off_init(unsigned (&dvo)[2], int ld, int wave, int lane) {
#pragma unroll
    for (int i = 0; i < 2; ++i) { const int pi = 2 * wave + i, row = 4 * pi + (lane >> 4), pc = lane & 15, ch = pc ^ (((row & 3) << 2) | ((row >> 2) & 3)); dvo[i] = (unsigned)(row * ld + ch * 8) * 2u; }
}
__device__ __forceinline__ void tile_dma(const bf16* g, const unsigned (&dvo)[2], LAS unsigned char* buf, int wave) {
#pragma unroll
    for (int i = 0; i < 2; ++i) __builtin_amdgcn_global_load_lds((const unsigned*)((const char*)g + dvo[i]), (LAS unsigned*)(buf + 1024 * (2 * wave + i)), 16, 0, 0);
}
struct FragOff { int k[8]; int va[4]; int vd; };
__device__ __forceinline__ void frag_off_init(FragOff& fo, int lane) {
    const int hi = lane >> 5, r32 = lane & 31, i = lane & 15, q = i >> 2, p = i & 3, x = 2 * ((lane >> 4) & 1) + (p >> 1);
#pragma unroll
    for (int ks = 0; ks < 8; ++ks) fo.k[ks] = img_off(r32, 2 * ks + hi);
#pragma unroll
    for (int ct = 0; ct < 4; ++ct) fo.va[ct] = img_off(4 * hi + q, 4 * ct + x) + 8 * (p & 1);
    fo.vd = img_off(4 * hi + q + 8, x) - img_off(4 * hi + q, x);
}
__device__ __forceinline__ bf16x8 k_frag(const LAS unsigned char* kbuf, const FragOff& fo, int rt, int ks) { return *(const LAS bf16x8*)(kbuf + fo.k[ks] + 8192 * rt); }
__device__ __forceinline__ s16x4 vtr(const LAS unsigned char* p) { return __builtin_bit_cast(s16x4, __builtin_amdgcn_ds_read_tr16_b64_v4i16((LAS v4i16_t*)p)); }
__device__ __forceinline__ bf16x8 v_frag(const LAS unsigned char* vbuf, const FragOff& fo, int ct, int kk) {
    const s16x4 lo = vtr(vbuf + fo.va[ct] + 4096 * kk), hh = vtr(vbuf + fo.va[ct] + fo.vd + 4096 * kk);
    return (bf16x8){lo[0], lo[1], lo[2], lo[3], hh[0], hh[1], hh[2], hh[3]};
}
#define TR_READ(dst, addr, OFF) asm volatile("ds_read_b64_tr_b16 %0, %1 offset:%c2" : "=&v"(dst) : "v"(addr), "i"(OFF) : "memory")
#define LGKM_WAIT0() do { asm volatile("s_waitcnt lgkmcnt(0)" ::: "memory"); __builtin_amdgcn_sched_barrier(0); } while (0)
__device__ __forceinline__ bf16x8 mk_frag(s16x4 lo, s16x4 hh) { return (bf16x8){lo[0], lo[1], lo[2], lo[3], hh[0], hh[1], hh[2], hh[3]}; }
__device__ __forceinline__ int frag_va(int lane, int ct) { const int hi = lane >> 5, i = lane & 15, q = i >> 2, p = i & 3, x = 2 * ((lane >> 4) & 1) + (p >> 1); return img_off(4 * hi + q, 4 * ct + x) + 8 * (p & 1); }
__device__ __forceinline__ bf16x8 v_frag_rt(const LAS unsigned char* vbuf, int va, int vd, int kk) {
    const s16x4 lo = vtr(vbuf + va + 4096 * kk), hh = vtr(vbuf + va + vd + 4096 * kk);
    return (bf16x8){lo[0], lo[1], lo[2], lo[3], hh[0], hh[1], hh[2], hh[3]};
}
__device__ __forceinline__ void store_o(const f32x16 (&o)[4], const float (&rscale)[16], LAS unsigned char* stg, bf16* dst, int ld, int lane) {
    const int hi = lane >> 5, r32 = lane & 31;
#pragma unroll
    for (int r = 0; r < 16; ++r) { const int orow = crow(r, hi);
#pragma unroll
        for (int ct = 0; ct < 4; ++ct) *(LAS bf16*)(stg + orow * 256 + (32 * ct + r32) * 2) = (bf16)f2bf(o[ct][r] * rscale[r]); }
    asm volatile("s_waitcnt lgkmcnt(0)" ::: "memory");
#pragma unroll
    for (int i = 0; i < 8; ++i) { const int c = lane + 64 * i, row = c >> 4, ch = c & 15; const u32x4 v = *(const LAS u32x4*)(stg + row * 256 + ch * 16); *(u32x4*)(dst + (size_t)row * ld + ch * 8) = v; }
}
}
__device__ __forceinline__ void sb_unit(Frame& F, int b, int h, int qb) {
    using namespace att;
    const int tid = F.tid, lane = F.lane, w = F.wave, hi = lane >> 5, r32 = lane & 31;
    const bf16* Qg = F.R1 + (size_t)b * SEQ * NC + h * 128; const bf16* Kg = Qg + 1024; const bf16* Vg = Qg + 2048;
    const int T0 = qb * 256, t0w = T0 + 32 * w, jd = t0w >> 6, jtop = (T0 >> 6) + 3, tl = 32 * (w & 1) + r32, tl4 = tl - 4 * hi;
    LAS unsigned char* lds = F.lds;
    FragOff fo; frag_off_init(fo, lane);
    unsigned dvo[2]; dma_off_init(dvo, NC, w, lane);
    bf16x8 qf[8];
#pragma unroll
    for (int ks = 0; ks < 8; ++ks) qf[ks] = *(const bf16x8*)(Qg + (size_t)(t0w + r32) * NC + 16 * ks + 8 * hi);
    f16x8 T0f, T1f, ONEf;
#pragma unroll
    for (int j = 0; j < 8; ++j) { const int kp = 8 * (j >> 2) + 4 * hi + (j & 3); T0f[j] = (kp >= r32) ? (_Float16)1.0f : (_Float16)0.0f; T1f[j] = (kp + 16 >= r32) ? (_Float16)1.0f : (_Float16)0.0f; ONEf[j] = (_Float16)1.0f; }
    f32x16 o[4];
#pragma unroll
    for (int ct = 0; ct < 4; ++ct)
#pragma unroll
        for (int r = 0; r < 16; ++r) o[ct][r] = 0.f;
    float R2 = 0.f; bool done = false;
    volatile LAS unsigned* flags = F.MISC + 16;
    tile_dma(Kg + (size_t)(64 * jtop) * NC, dvo, lds, w); tile_dma(Vg + (size_t)(64 * jtop) * NC, dvo, lds + 16384, w);
    asm volatile("s_waitcnt vmcnt(0)" ::: "memory");
    __syncthreads();
    for (int j = jtop; j >= 0; --j) {
        const int cur = (jtop - j) & 1;
        const LAS unsigned char* kb = lds + cur * 32768; const LAS unsigned char* vb = kb + 16384;
        if (j > 0) { tile_dma(Kg + (size_t)(64 * (j - 1)) * NC, dvo, lds + (cur ^ 1) * 32768, w); tile_dma(Vg + (size_t)(64 * (j - 1)) * NC, dvo, lds + (cur ^ 1) * 32768 + 16384, w); }
        if (j <= jd && !done) {
            f32x16 p0, p1;
#pragma unroll
            for (int r = 0; r < 16; ++r) { p0[r] = 0.f; p1[r] = 0.f; }
            { bf16x8 kf[8];
#pragma unroll
              for (int ks = 0; ks < 8; ++ks) kf[ks] = k_frag(kb, fo, 0, ks);
#pragma unroll
              for (int ks = 0; ks < 8; ++ks) p0 = __builtin_amdgcn_mfma_f32_32x32x16_bf16(kf[ks], qf[ks], p0, 0, 0, 0);
#pragma unroll
              for (int ks = 0; ks < 8; ++ks) kf[ks] = k_frag(kb, fo, 1, ks);
#pragma unroll
              for (int ks = 0; ks < 8; ++ks) p1 = __builtin_amdgcn_mfma_f32_32x32x16_bf16(kf[ks], qf[ks], p1, 0, 0, 0); }
            s16x4 vl[4], vh[4], wl[4], wh[4];
            unsigned va0[4], va1[4];
#pragma unroll
            for (int ct = 0; ct < 4; ++ct) { va0[ct] = (unsigned)(size_t)vb + (unsigned)fo.va[ct]; va1[ct] = va0[ct] + (unsigned)fo.vd; }
            const bool diag = (j == jd);
            float x0[16], x1[16]; float rs = 0.f;
#pragma unroll
            for (int r = 0; r < 16; ++r) { const int key = (r & 3) + 8 * (r >> 2);
                float l0 = -__builtin_amdgcn_logf(1.0f + __builtin_amdgcn_exp2f(p0[r])), l1 = -__builtin_amdgcn_logf(1.0f + __builtin_amdgcn_exp2f(p1[r]));
                if (diag) { if (!(key < tl4)) l0 = 0.f; if (!(key + 32 < tl4)) l1 = 0.f; }
                x0[r] = l0; x1[r] = l1; rs += l0 + l1; p0[r] += R2; p1[r] += R2; }
            const f16x8 xb00 = pack8h(x0[0], x0[1], x0[2], x0[3], x0[4], x0[5], x0[6], x0[7]), xb01 = pack8h(x0[8], x0[9], x0[10], x0[11], x0[12], x0[13], x0[14], x0[15]);
            const f16x8 xb10 = pack8h(x1[0], x1[1], x1[2], x1[3], x1[4], x1[5], x1[6], x1[7]), xb11 = pack8h(x1[8], x1[9], x1[10], x1[11], x1[12], x1[13], x1[14], x1[15]);
            p0 = __builtin_amdgcn_mfma_f32_32x32x16_f16(T0f, xb00, p0, 0, 0, 0); p0 = __builtin_amdgcn_mfma_f32_32x32x16_f16(T1f, xb01, p0, 0, 0, 0);
            p0 = __builtin_amdgcn_mfma_f32_32x32x16_f16(ONEf, xb10, p0, 0, 0, 0); p0 = __builtin_amdgcn_mfma_f32_32x32x16_f16(ONEf, xb11, p0, 0, 0, 0);
            p1 = __builtin_amdgcn_mfma_f32_32x32x16_f16(T0f, xb10, p1, 0, 0, 0); p1 = __builtin_amdgcn_mfma_f32_32x32x16_f16(T1f, xb11, p1, 0, 0, 0);
#pragma unroll
            for (int r = 0; r < 16; ++r) { const int key = (r & 3) + 8 * (r >> 2);
                float a0 = __builtin_amdgcn_exp2f(p0[r]), a1 = __builtin_amdgcn_exp2f(p1[r]);
                if (diag) { if (!(key < tl4)) a0 = 0.f; if (!(key + 32 < tl4)) a1 = 0.f; }
                p0[r] = a0; p1[r] = a1; }
            const bf16x8 pa0 = pack8(p0[0], p0[1], p0[2], p0[3], p0[4], p0[5], p0[6], p0[7]), pa1 = pack8(p0[8], p0[9], p0[10], p0[11], p0[12], p0[13], p0[14], p0[15]);
            const bf16x8 pa2 = pack8(p1[0], p1[1], p1[2], p1[3], p1[4], p1[5], p1[6], p1[7]), pa3 = pack8(p1[8], p1[9], p1[10], p1[11], p1[12], p1[13], p1[14], p1[15]);
#pragma unroll
            for (int ct = 0; ct < 4; ++ct) { TR_READ(vl[ct], va0[ct], 0); TR_READ(vh[ct], va1[ct], 0); }
            LGKM_WAIT0();
#pragma unroll
            for (int ct = 0; ct < 4; ++ct) { TR_READ(wl[ct], va0[ct], 4096); TR_READ(wh[ct], va1[ct], 4096); }
#pragma unroll
            for (int ct = 0; ct < 4; ++ct) o[ct] = __builtin_amdgcn_mfma_f32_32x32x16_bf16(pa0, mk_frag(vl[ct], vh[ct]), o[ct], 0, 0, 0);
            LGKM_WAIT0();
#pragma unroll
            for (int ct = 0; ct < 4; ++ct) { TR_READ(vl[ct], va0[ct], 8192); TR_READ(vh[ct], va1[ct], 8192); }
#pragma unroll
            for (int ct = 0; ct < 4; ++ct) o[ct] = __builtin_amdgcn_mfma_f32_32x32x16_bf16(pa1, mk_frag(wl[ct], wh[ct]), o[ct], 0, 0, 0);
            LGKM_WAIT0();
#pragma unroll
            for (int ct = 0; ct < 4; ++ct) { TR_READ(wl[ct], va0[ct], 12288); TR_READ(wh[ct], va1[ct], 12288); }
#pragma unroll
            for (int ct = 0; ct < 4; ++ct) o[ct] = __builtin_amdgcn_mfma_f32_32x32x16_bf16(pa2, mk_frag(vl[ct], vh[ct]), o[ct], 0, 0, 0);
            LGKM_WAIT0();
#pragma unroll
            for (int ct = 0; ct < 4; ++ct) o[ct] = __builtin_amdgcn_mfma_f32_32x32x16_bf16(pa3, mk_frag(wl[ct], wh[ct]), o[ct], 0, 0, 0);
            rs += __shfl_xor(rs, 32);
            R2 += rs;
            done = __all(R2 < -152.0f);
        }
        if (lane == 0) flags[cur * 8 + w] = done ? 1u : 0u;
        asm volatile("s_waitcnt vmcnt(0) lgkmcnt(0)" ::: "memory");
        __syncthreads();
        unsigned alld = 1u;
#pragma unroll
        for (int i = 0; i < 8; ++i) alld &= flags[cur * 8 + i];
        if (alld) break;
    }
    float ones[16];
#pragma unroll
    for (int r = 0; r < 16; ++r) ones[r] = 1.0f;
    store_o(o, ones, lds + w * 8192, F.CAT + (size_t)(b * SEQ + t0w) * D + h * 128, D, lane);
    __syncthreads();
}
__device__ __forceinline__ void ph_sb(Frame& F) {
    for (int v = F.vcu; v < BATCH * 8 * 2; v += F.G) {
        const int bh = v >> 1, half = v & 1;
#pragma unroll 1
        for (int i = 0; i < 4; ++i) { const int qb = half ? (i == 0 ? 1 : i == 1 ? 6 : i == 2 ? 2 : 5) : (i == 0 ? 0 : i == 1 ? 7 : i == 2 ? 3 : 4); sb_unit(F, bh >> 3, bh & 7, qb); }
    }
}
__device__ __forceinline__ void dsa_unit(Frame& F, int b, int h, int ub, float mref) {
    using namespace att;
    const int lane = F.lane, w = F.wave, hi = lane >> 5, r32 = lane & 31;
    const bf16* Qg = F.R1 + (size_t)b * SEQ * NAB + C_QA + h * 128; const bf16* Kg = F.R1 + (size_t)b * SEQ * NAB + C_KA + h * 128; const bf16* Vg = F.R1 + (size_t)b * SEQ * NAB + C_VA + h * 128;
    const int t0w = 256 * ub + 32 * w, cw = t0w >> 6, jlast = 4 * ub + 3;
    LAS unsigned char* lds = F.lds;
    LAS unsigned char* mst = lds + 65536 + w * 8448;
    FragOff fo; frag_off_init(fo, lane);
    unsigned dvo[2]; dma_off_init(dvo, NAB, w, lane);
    tile_dma(Kg, dvo, lds, w); tile_dma(Vg, dvo, lds + 16384, w);
    bf16x8 qf[8];
#pragma unroll
    for (int ks = 0; ks < 8; ++ks) qf[ks] = *(const bf16x8*)(Qg + (size_t)(t0w + r32) * NAB + 16 * ks + 8 * hi);
    { const unsigned* mg = F.MASK + (size_t)(b * SEQ + t0w) * 64;
#pragma unroll 2
      for (int i = 0; i < 8; ++i) { const int c = lane + 64 * i, row = c >> 4, c4 = c & 15; const u32x4 v = *(const u32x4*)(mg + row * 64 + c4 * 4);
          *(LAS unsigned long long*)(mst + row * 264 + c4 * 16) = (unsigned long long)v.x | ((unsigned long long)v.y << 32);
          *(LAS unsigned long long*)(mst + row * 264 + c4 * 16 + 8) = (unsigned long long)v.z | ((unsigned long long)v.w << 32); } }
    f32x16 o[4];
#pragma unroll
    for (int ct = 0; ct < 4; ++ct)
#pragma unroll
        for (int r = 0; r < 16; ++r) o[ct][r] = 0.f;
    float lsum = 0.f;
    asm volatile("s_waitcnt vmcnt(0) lgkmcnt(0)" ::: "memory");
    __syncthreads();
    for (int j = 0; j <= jlast; ++j) {
        const int cur = j & 1;
        const LAS unsigned char* kb = lds + cur * 32768; const LAS unsigned char* vb = kb + 16384;
        if (j < jlast) { tile_dma(Kg + (size_t)(64 * (j + 1)) * NAB, dvo, lds + (cur ^ 1) * 32768, w); tile_dma(Vg + (size_t)(64 * (j + 1)) * NAB, dvo, lds + (cur ^ 1) * 32768 + 16384, w); }
        if (j <= cw) {
            const unsigned long long mw = *(const LAS unsigned long long*)(mst + r32 * 264 + j * 8);
            const unsigned mw0 = (unsigned)mw, mw1 = (unsigned)(mw >> 32);
#pragma unroll 1
            for (int half = 0; half < 2; ++half) {
                const unsigned mwh = (half ? mw1 : mw0) >> (4 * hi);
                bf16x8 kf[8];
#pragma unroll
                for (int ks = 0; ks < 8; ++ks) kf[ks] = k_frag(kb, fo, half, ks);
                f32x16 p;
#pragma unroll
                for (int r = 0; r < 16; ++r) p[r] = 0.f;
#pragma unroll
                for (int ks = 0; ks < 8; ++ks) p = __builtin_amdgcn_mfma_f32_32x32x16_bf16(kf[ks], qf[ks], p, 0, 0, 0);
#pragma unroll
                for (int r = 0; r < 16; ++r) { const unsigned keep = (unsigned)(-(int)((mwh >> ((r & 3) + 8 * (r >> 2))) & 1u));
                    const float e = __uint_as_float(__float_as_uint(__builtin_amdgcn_exp2f(p[r] - mref)) & keep); p[r] = e; lsum += e; }
                const bf16x8 pa0 = pack8(p[0], p[1], p[2], p[3], p[4], p[5], p[6], p[7]), pa1 = pack8(p[8], p[9], p[10], p[11], p[12], p[13], p[14], p[15]);
                s16x4 vl[8], vh[8];
                const unsigned vbase = (unsigned)(size_t)vb + 8192u * (unsigned)half;
#pragma unroll
                for (int ct = 0; ct < 4; ++ct) { const unsigned a0 = vbase + (unsigned)fo.va[ct], a1 = a0 + (unsigned)fo.vd;
                    TR_READ(vl[2 * ct], a0, 0); TR_READ(vh[2 * ct], a1, 0); TR_READ(vl[2 * ct + 1], a0, 4096); TR_READ(vh[2 * ct + 1], a1, 4096); }
                LGKM_WAIT0();
#pragma unroll
                for (int ct = 0; ct < 4; ++ct) {
                    o[ct] = __builtin_amdgcn_mfma_f32_32x32x16_bf16(pa0, mk_frag(vl[2 * ct], vh[2 * ct]), o[ct], 0, 0, 0);
                    o[ct] = __builtin_amdgcn_mfma_f32_32x32x16_bf16(pa1, mk_frag(vl[2 * ct + 1], vh[2 * ct + 1]), o[ct], 0, 0, 0);
                }
            }
        }
        asm volatile("s_waitcnt vmcnt(0) lgkmcnt(0)" ::: "memory");
        __syncthreads();
    }
    lsum += __shfl_xor(lsum, 32);
    LAS float* lsc = (LAS float*)mst;
    if (hi == 0) lsc[r32] = 1.0f / lsum;
    asm volatile("s_waitcnt lgkmcnt(0)" ::: "memory");
    float rsc[16];
#pragma unroll
    for (int r = 0; r < 16; ++r) rsc[r] = lsc[crow(r, hi)];
    store_o(o, rsc, lds + w * 8192, F.CAT + (size_t)(b * SEQ + t0w) * D + h * 128, D, lane);
    __syncthreads();
}
__device__ __forceinline__ void ph_dsa(Frame& F) {
    float gm = fmaxf(fabsf(F.gq_a[F.lane]), fabsf(F.gq_a[64 + F.lane])), km = fmaxf(fabsf(F.gk_a[F.lane]), fabsf(F.gk_a[64 + F.lane]));
    gm = wave_max(gm); km = wave_max(km);
    const float mref = att::C2 * 128.0f * gm * km * 1.02f;
    for (int v = F.vcu; v < BATCH * 4 * 4; v += F.G) {
        const int bh = v >> 2, pi = v & 3;
#pragma unroll 1
        for (int k = 0; k < 2; ++k) dsa_unit(F, bh >> 2, bh & 3, k ? 7 - pi : pi, mref);
    }
}
namespace idx {
using att::f32x16;
constexpr int SCP = 2048;
__device__ __forceinline__ unsigned okey(float f) { const unsigned u = __float_as_uint(f); return (u & 0x80000000u) ? ~u : (u | 0x80000000u); }
__device__ __forceinline__ int wave_isum(int c) {
    c += __builtin_amdgcn_mov_dpp(c, 0xB1, 0xF, 0xF, true);
    c += __builtin_amdgcn_mov_dpp(c, 0x4E, 0xF, 0xF, true);
    c += __builtin_amdgcn_mov_dpp(c, 0x141, 0xF, 0xF, true);
    c += __builtin_amdgcn_mov_dpp(c, 0x140, 0xF, 0xF, true);
    return (__builtin_amdgcn_readlane(c, 0) + __builtin_amdgcn_readlane(c, 16)) + (__builtin_amdgcn_readlane(c, 32) + __builtin_amdgcn_readlane(c, 48));
}
__device__ __forceinline__ void bit_transpose32x2(unsigned (&A)[32], unsigned (&B)[32]) {
    unsigned mask = 0x0000FFFFu;
#pragma unroll
    for (int s = 16; s; s >>= 1) {
        unsigned ta[16], tb[16];
#pragma unroll
        for (int k = 0, i = 0; k < 32; ++k) if (!(k & s)) { ta[i] = A[k + s] >> s; tb[i] = B[k + s] >> s; ++i; }
#pragma unroll
        for (int k = 0, i = 0; k < 32; ++k) if (!(k & s)) { ta[i] ^= A[k]; tb[i] ^= B[k]; ++i; }
#pragma unroll
        for (int i = 0; i < 16; ++i) { ta[i] &= mask; tb[i] &= mask; }
#pragma unroll
        for (int k = 0, i = 0; k < 32; ++k) if (!(k & s)) { A[k] ^= ta[i]; B[k] ^= tb[i]; ++i; }
#pragma unroll
        for (int k = 0, i = 0; k < 32; ++k) if (!(k & s)) { A[k + s] ^= ta[i] << s; B[k + s] ^= tb[i] << s; ++i; }
        mask ^= mask << (s >> 1);
    }
}
__device__ __forceinline__ void select_prepare(const LAS float* scA, const LAS float* scB, int E, unsigned (&Wa)[32], unsigned (&Wb)[32], int lane) {
#pragma unroll
    for (int j = 0; j < 32; ++j) { Wa[31 - j] = __float_as_uint(scA[64 * j + lane]); Wb[31 - j] = __float_as_uint(scB[64 * j + lane]); }
#pragma unroll
    for (int j = 0; j < 32; ++j) { const unsigned ua = Wa[31 - j], ub = Wb[31 - j];
        const unsigned ka = (ua & 0x80000000u) ? ~ua : (ua | 0x80000000u), kb = (ub & 0x80000000u) ? ~ub : (ub | 0x80000000u);
        Wa[31 - j] = (j < E) ? ka : 0u; Wb[31 - j] = (j < E) ? kb : 0u; }
    bit_transpose32x2(Wa, Wb);
}
__device__ __forceinline__ void select_finish(const unsigned (&Wa)[32], const unsigned (&Wb)[32], int E, unsigned* mrowA, unsigned* mrowB, int lane) {
    const unsigned valid = (E >= 32) ? 0xFFFFFFFFu : ((1u << E) - 1u);
    unsigned alA = valid, alB = valid, gtA = 0u, gtB = 0u;
    int GA = 0, GB = 0, AA = 64 * E, AB = 64 * E; bool dA = false, dB = false;
#pragma unroll
    for (int b = 0; b < 32; ++b) {
        if (dA && dB) break;
        const unsigned m1a = alA & Wa[b], m1b = alB & Wb[b];
        const int ca = wave_isum(__popc(m1a)), cb = wave_isum(__popc(m1b));
        if (!dA) { if (GA + ca >= 256) { alA = m1a; AA = ca; } else { GA += ca; gtA |= m1a; alA &= ~Wa[b]; AA -= ca; } dA = (GA + AA == 256); }
        if (!dB) { if (GB + cb >= 256) { alB = m1b; AB = cb; } else { GB += cb; gtB |= m1b; alB &= ~Wb[b]; AB -= cb; } dB = (GB + AB == 256); }
    }
#pragma unroll 1
    for (int rr = 0; rr < 2; ++rr) {
        const unsigned al = rr ? alB : alA, gt = rr ? gtB : gtA; const bool done = rr ? dB : dA; unsigned* mrow = rr ? mrowB : mrowA;
        unsigned sel = gt | al;
        if (!done) {
            int need = 256 - (rr ? GB : GA); sel = gt;
            const unsigned long long below = (1ull << lane) - 1ull;
            for (int j = 0; j < E; ++j) { const bool e = (al >> j) & 1u; const unsigned long long eq = __ballot(e);
                if (e && __popcll(eq & below) < need) sel |= 1u << j;
                need -= __popcll(eq); if (need <= 0) break; }
        }
        unsigned long long mine = 0ull;
#pragma unroll
        for (int j = 0; j < 32; ++j) { if (j < E) { const unsigned long long m = __ballot((sel >> j) & 1u); if (lane == j) mine = m; } }
        if (lane < 32) *(unsigned long long*)(mrow + 2 * lane) = mine;
    }
}
__device__ __forceinline__ void decode(int u, int& b, int& c, int& sub) { c = 4 + u % 28; const int rest = u / 28; b = rest >> 2; sub = rest & 3; }
__device__ __forceinline__ void load_af(Frame& F, int u, bf16x8 (&af)[4][4]) {
    int b, c, sub; decode(u, b, c, sub);
    const int r32 = F.lane & 31, hi = F.lane >> 5, t0 = 64 * c + 16 * sub;
    const bf16* P = F.R1 + (size_t)b * SEQ * NAB;
#pragma unroll
    for (int rt = 0; rt < 4; ++rt)
#pragma unroll
        for (int ks = 0; ks < 4; ++ks) af[rt][ks] = *(const bf16x8*)(P + (size_t)(t0 + 4 * rt + (r32 >> 3)) * NAB + C_IQ + (r32 & 7) * 64 + 16 * ks + 8 * hi);
}
__device__ __forceinline__ float load_w(Frame& F, int u) {
    int b, c, sub; decode(u, b, c, sub);
    const int t0 = 64 * c + 16 * sub;
    return (F.tid < 128) ? bf2f(F.R1[(size_t)(b * SEQ + t0 + (F.tid >> 3)) * NAB + C_IW + (F.tid & 7)]) * (0.125f * 0.35355339059327373f) : 0.f;
}
__device__ __forceinline__ void load_bf(Frame& F, int b, int strip, bf16x8 (&bfr)[4]) {
    const bf16* P = F.R1 + (size_t)b * SEQ * NAB;
#pragma unroll
    for (int ks = 0; ks < 4; ++ks) bfr[ks] = *(const bf16x8*)(P + (size_t)(32 * strip + (F.lane & 31)) * NAB + C_IK + 16 * ks + 8 * (F.lane >> 5));
}
__device__ __forceinline__ void run(Frame& F) {
    const int lane = F.lane, w = F.wave, hi = lane >> 5, r32 = lane & 31, tid = F.tid, NU = BATCH * 28 * 4;
    int u = F.vcu; if (u >= NU) return;
    LAS float* sc = (LAS float*)F.lds;
    LAS float* wtb = sc + 16 * SCP;
    bf16x8 af[4][4], bfr[4], bnx[4];
    load_af(F, u, af);
    { const float wv = load_w(F, u); if (tid < 128) wtb[tid] = wv; }
    { int b, c, sub; decode(u, b, c, sub); if (w < 2 * (c + 1)) load_bf(F, b, w, bfr); }
    for (int it = 0; u < NU; ++it, u += F.G) {
        int b, c, sub; decode(u, b, c, sub);
        const int n = 64 * (c + 1), t0 = 64 * c + 16 * sub, nstrip = n >> 5;
        const int un = u + F.G; const bool more = un < NU;
        const LAS float* wt = wtb + (it & 1) * 128;
        __syncthreads();
        const float wnext = more ? load_w(F, un) : 0.f;
        for (int s = w; s < nstrip; s += NWAVES) {
            const bool mstrip = s + NWAVES < nstrip;
            if (mstrip) load_bf(F, b, s + NWAVES, bnx);
#pragma unroll
            for (int rt = 0; rt < 4; ++rt) {
                f32x16 acc;
#pragma unroll
                for (int r = 0; r < 16; ++r) acc[r] = 0.f;
#pragma unroll
                for (int ks = 0; ks < 4; ++ks) acc = __builtin_amdgcn_mfma_f32_32x32x16_bf16(af[rt][ks], bfr[ks], acc, 0, 0, 0);
                float part[4];
#pragma unroll
                for (int qi = 0; qi < 4; ++qi) { const f32x4 wv = *(const LAS f32x4*)(wt + (4 * rt + qi) * 8 + 4 * hi);
                    part[qi] = fmaxf(acc[4 * qi], 0.f) * wv[0] + fmaxf(acc[4 * qi + 1], 0.f) * wv[1] + fmaxf(acc[4 * qi + 2], 0.f) * wv[2] + fmaxf(acc[4 * qi + 3], 0.f) * wv[3]; }
                const float send0 = hi ? part[0] : part[2], send1 = hi ? part[1] : part[3];
                const float got0 = __shfl_xor(send0, 32), got1 = __shfl_xor(send1, 32);
                const float f0 = (hi ? part[2] : part[0]) + got0, f1 = (hi ? part[3] : part[1]) + got1;
                const int q0 = 4 * rt + 2 * hi;
                sc[q0 * SCP + 32 * s + r32] = f0; sc[(q0 + 1) * SCP + 32 * s + r32] = f1;
            }
            if (mstrip) {
#pragma unroll
                for (int ks = 0; ks < 4; ++ks) bfr[ks] = bnx[ks];
            }
        }
        if (more && tid < 128) wtb[((it + 1) & 1) * 128 + tid] = wnext;
        __syncthreads();
        { const int q = 2 * w;
          unsigned* mrowA = F.MASK + (size_t)(b * SEQ + t0 + q) * 64; unsigned* mrowB = mrowA + 64;
          const LAS float* rowA = sc + q * SCP; const LAS float* rowB = rowA + SCP;
          unsigned Wa[32], Wb[32];
          select_prepare(rowA, rowB, n >> 6, Wa, Wb, lane);
          asm volatile("" ::: "memory");
          if (more) load_af(F, un, af);
          select_finish(Wa, Wb, n >> 6, mrowA, mrowB, lane); }
        if (more) { int bn, cn, sn; decode(un, bn, cn, sn); if (w < 2 * (cn + 1)) load_bf(F, bn, w, bfr); }
    }
    __syncthreads();
}
}
__device__ __forceinline__ void ph_indexer(Frame& F) {
    { const int gw = F.vcu * NWAVES + F.wave, NGW = F.G * NWAVES;
      for (int i = gw; i < BATCH * 256; i += NGW) { const int b = i >> 8, pos = i & 255, n = ((pos >> 6) + 1) << 6;
          if (F.lane < 32) { unsigned long long v = 0ull; if (64 * F.lane < n) v = ~0ull; *(unsigned long long*)(F.MASK + (size_t)(b * SEQ + pos) * 64 + 2 * F.lane) = v; } } }
    idx::run(F);
}
namespace gla {
using att::f32x16; using att::u32x4;
constexpr int L_WL = 0, L_V = 4096, L_OG = 36864, L_K = 69632, L_Q = 78848, L_PART = 88064, L_STG = 89088, KP = 144, SP = 272;
struct In { u32x4 g0, g1, kk, qq; f32x4 b0, b1; };
__device__ __forceinline__ void decode(int u, int& b, int& h, int& c) { b = u >> 7; h = (u >> 5) & 3; c = u & 31; }
template <bool PASSC> __device__ __forceinline__ void load_in(Frame& F, int u, In& in, const float* BC) {
    int b, h, c; decode(u, b, h, c);
    const bf16* pr = F.R1 + (size_t)(b * SEQ + 64 * c + F.lane) * NAB;
    in.kk = *(const u32x4*)(pr + C_KB + h * 64 + 8 * F.wave);
    if (PASSC) { in.qq = *(const u32x4*)(pr + C_QB + h * 64 + 8 * F.wave);
        const float* bp = BC + ((size_t)u * 64 + F.lane) * 64 + 8 * F.wave; in.b0 = *(const f32x4*)bp; in.b1 = *(const f32x4*)(bp + 4); }
    else { in.g0 = *(const u32x4*)(pr + C_GL); in.g1 = *(const u32x4*)(pr + C_GL + 8); }
}
template <bool NEEDOG> __device__ __forceinline__ void dma_in(Frame& F, int u, int buf, const unsigned (&dvo)[2]) {
    int b, h, c; decode(u, b, h, c);
    const bf16* P = F.R1 + (size_t)(b * SEQ + 64 * c) * NAB;
    att::tile_dma(P + C_VB + h * 128, dvo, F.lds + L_V + buf * 16384, F.wave);
    if (NEEDOG) att::tile_dma(P + C_OG + h * 128, dvo, F.lds + L_OG + buf * 16384, F.wave);
}
__device__ __forceinline__ void stage_wl(Frame& F, int h) {
    LAS float* wl = (LAS float*)(F.lds + L_WL);
#pragma unroll
    for (int i = 0; i < 2; ++i) { const int e = F.tid + 512 * i, r = e >> 6, d = e & 63; wl[e] = F.w_gate_up[r * 256 + h * 64 + d]; }
}
__device__ __forceinline__ void unpack8(const u32x4 v, float (&f)[8]) {
#pragma unroll
    for (int i = 0; i < 4; ++i) { f[2 * i] = __uint_as_float(v[i] << 16); f[2 * i + 1] = __uint_as_float(v[i] & 0xffff0000u); }
}
__device__ __forceinline__ void gate_scan(Frame& F, int h, const float (&gl)[16], float (&bc)[8], float (&blast)[8]) {
    const int lane = F.lane, d0 = 8 * F.wave;
    const LAS float* wl = (const LAS float*)(F.lds + L_WL);
    float acc[8];
#pragma unroll
    for (int i = 0; i < 8; ++i) acc[i] = F.b_gate[h * 64 + d0 + i];
#pragma unroll
    for (int r = 0; r < 16; ++r) { const f32x4 w0 = *(const LAS f32x4*)(wl + r * 64 + d0), w1 = *(const LAS f32x4*)(wl + r * 64 + d0 + 4);
#pragma unroll
        for (int i = 0; i < 4; ++i) { acc[i] = fmaf(gl[r], w0[i], acc[i]); acc[4 + i] = fmaf(gl[r], w1[i], acc[4 + i]); } }
#pragma unroll
    for (int i = 0; i < 8; ++i) { float v = (fminf(acc[i], 0.f) - __logf(1.0f + __expf(-fabsf(acc[i])))) * (1.0f / 16.0f);
#pragma unroll
        for (int off = 1; off < 64; off <<= 1) { const float u = __shfl_up(v, off); if (lane >= off) v += u; }
        bc[i] = v; blast[i] = __shfl(v, 63); }
}
__device__ __forceinline__ void pass_a(Frame& F, float* GU, float* DEC, float* BC) {
    const int lane = F.lane, w = F.wave, hi = lane >> 5, r32 = lane & 31;
    att::FragOff fo; att::frag_off_init(fo, lane);
    unsigned dvo[2]; att::dma_off_init(dvo, NAB, w, lane);
    const int et = w >> 1, dt = w & 1, va_et = att::frag_va(lane, et);
    int u = F.vcu; if (u >= BATCH * 4 * 32) return;
    In cur, nxt; int hprev = -1;
    dma_in<false>(F, u, 0, dvo); load_in<false>(F, u, cur, BC);
    for (int it = 0; u < BATCH * 4 * 32; ++it, u += F.G) {
        int b, h, c; decode(u, b, h, c);
        const int un = u + F.G; const bool more = un < BATCH * 4 * 32;
        if (h != hprev) { stage_wl(F, h); hprev = h; }
        asm volatile("s_waitcnt vmcnt(0) lgkmcnt(0)" ::: "memory");
        __syncthreads();
        float gl[16], kf[8];
        unpack8(cur.g0, (float(&)[8])gl[0]); unpack8(cur.g1, (float(&)[8])gl[8]); unpack8(cur.kk, kf);
        asm volatile("" ::: "memory");
        if (more) { dma_in<false>(F, un, (it + 1) & 1, dvo); load_in<false>(F, un, nxt, BC); }
        float bc[8], blast[8];
        gate_scan(F, h, gl, bc, blast);
        const int uid = u;
        { float* bp = BC + ((size_t)uid * 64 + lane) * 64 + 8 * w; *(f32x4*)bp = (f32x4){bc[0], bc[1], bc[2], bc[3]}; *(f32x4*)(bp + 4) = (f32x4){bc[4], bc[5], bc[6], bc[7]}; }
#pragma unroll
        for (int i = 0; i < 8; ++i) *(LAS bf16*)(F.lds + L_K + (8 * w + i) * KP + lane * 2) = (bf16)f2bf(kf[i] * __expf(blast[i] - bc[i]));
        if (lane == 0) {
#pragma unroll
            for (int i = 0; i < 8; ++i) DEC[(size_t)uid * 64 + 8 * w + i] = __expf(blast[i]); }
        asm volatile("s_waitcnt lgkmcnt(0)" ::: "memory");
        __syncthreads();
        const LAS unsigned char* vbuf = F.lds + L_V + (it & 1) * 16384;
        f32x16 acc;
#pragma unroll
        for (int r = 0; r < 16; ++r) acc[r] = 0.f;
#pragma unroll
        for (int kk = 0; kk < 4; ++kk) {
            const LAS unsigned char* kp = F.lds + L_K + (32 * dt + r32) * KP + (16 * kk + 4 * hi) * 2;
            const unsigned long long lo = *(const LAS unsigned long long*)kp, hh = *(const LAS unsigned long long*)(kp + 16);
            u32x4 bw; bw.x = (unsigned)lo; bw.y = (unsigned)(lo >> 32); bw.z = (unsigned)hh; bw.w = (unsigned)(hh >> 32);
            acc = __builtin_amdgcn_mfma_f32_32x32x16_bf16(att::v_frag_rt(vbuf, va_et, fo.vd, kk), __builtin_bit_cast(bf16x8, bw), acc, 0, 0, 0);
        }
        float* gu = GU + (size_t)uid * 8192;
#pragma unroll
        for (int r = 0; r < 16; ++r) gu[(32 * et + att::crow(r, hi)) * 64 + 32 * dt + r32] = acc[r];
        cur = nxt;
    }
    __syncthreads();
}
__device__ __forceinline__ void pass_b(Frame& F, float* GU, const float* DEC) {
    for (int idx = F.vcu * NTHR + F.tid; idx < 64 * 128 * 16; idx += F.G * NTHR) {
        const int bh = idx >> 11, e = (idx >> 4) & 127, dq = idx & 15;
        f32x4 S = (f32x4){0.f, 0.f, 0.f, 0.f};
        for (int c0 = 0; c0 < 32; c0 += 8) {
            f32x4 U[8], dec[8];
#pragma unroll
            for (int i = 0; i < 8; ++i) { const size_t uid = (size_t)bh * 32 + c0 + i; U[i] = *(const f32x4*)(GU + (uid * 128 + e) * 64 + 4 * dq); dec[i] = *(const f32x4*)(DEC + uid * 64 + 4 * dq); }
#pragma unroll
            for (int i = 0; i < 8; ++i) { const size_t uid = (size_t)bh * 32 + c0 + i; *(f32x4*)(GU + (uid * 128 + e) * 64 + 4 * dq) = S; S = dec[i] * S + U[i]; }
        }
    }
}
__device__ __forceinline__ void pass_c(Frame& F, const float* GU, const float* BC) {
    const int lane = F.lane, w = F.wave, hi = lane >> 5, r32 = lane & 31, tid = F.tid;
    LAS unsigned char* lds = F.lds;
    att::FragOff fo; att::frag_off_init(fo, lane);
    unsigned dvo[2]; att::dma_off_init(dvo, NAB, w, lane);
    const int et = w >> 1, tt = w & 1, tl = 32 * tt + r32, va_et = att::frag_va(lane, et);
    int u = F.vcu; if (u >= BATCH * 4 * 32) return;
    In cur, nxt;
    dma_in<true>(F, u, 0, dvo); load_in<true>(F, u, cur, BC);
    for (int it = 0; u < BATCH * 4 * 32; ++it, u += F.G) {
        int b, h, c; decode(u, b, h, c);
        const int un = u + F.G; const bool more = un < BATCH * 4 * 32;
        asm volatile("s_waitcnt vmcnt(0) lgkmcnt(0)" ::: "memory");
        __syncthreads();
        float kf[8], qf[8], bc[8];
        unpack8(cur.kk, kf); unpack8(cur.qq, qf);
#pragma unroll
        for (int i = 0; i < 4; ++i) { bc[i] = cur.b0[i]; bc[4 + i] = cur.b1[i]; }
        asm volatile("" ::: "memory");
        if (more) { dma_in<true>(F, un, (it + 1) & 1, dvo); load_in<true>(F, un, nxt, BC); }
        f32x4 sf[8];
        { const float* gs = GU + ((size_t)u * 128 + 32 * et + r32) * 64;
#pragma unroll
          for (int ks = 0; ks < 4; ++ks) { sf[2 * ks] = *(const f32x4*)(gs + 16 * ks + 8 * hi); sf[2 * ks + 1] = *(const f32x4*)(gs + 16 * ks + 8 * hi + 4); } }
        { float eq[8], ek[8];
#pragma unroll
          for (int i = 0; i < 8; ++i) { eq[i] = qf[i] * 0.125f * __expf(bc[i]); ek[i] = kf[i] * __expf(-bc[i]); }
          *(LAS bf16x8*)(lds + L_Q + lane * KP + 16 * w) = att::pack8(eq[0], eq[1], eq[2], eq[3], eq[4], eq[5], eq[6], eq[7]);
          *(LAS bf16x8*)(lds + L_K + lane * KP + 16 * w) = att::pack8(ek[0], ek[1], ek[2], ek[3], ek[4], ek[5], ek[6], ek[7]); }
        asm volatile("s_waitcnt lgkmcnt(0)" ::: "memory");
        __syncthreads();
        const LAS unsigned char* vbuf = lds + L_V + (it & 1) * 16384; const LAS unsigned char* ogbuf = lds + L_OG + (it & 1) * 16384;
        bf16x8 qfr[4];
#pragma unroll
        for (int ks = 0; ks < 4; ++ks) qfr[ks] = *(const LAS bf16x8*)(lds + L_Q + tl * KP + (16 * ks + 8 * hi) * 2);
        f32x16 p0, p1;
#pragma unroll
        for (int r = 0; r < 16; ++r) { p0[r] = 0.f; p1[r] = 0.f; }
#pragma unroll
        for (int ks = 0; ks < 4; ++ks) {
            const bf16x8 a0 = *(const LAS bf16x8*)(lds + L_K + r32 * KP + (16 * ks + 8 * hi) * 2), a1 = *(const LAS bf16x8*)(lds + L_K + (32 + r32) * KP + (16 * ks + 8 * hi) * 2);
            p0 = __builtin_amdgcn_mfma_f32_32x32x16_bf16(a0, qfr[ks], p0, 0, 0, 0); p1 = __builtin_amdgcn_mfma_f32_32x32x16_bf16(a1, qfr[ks], p1, 0, 0, 0);
        }
        { const int tl4 = tl - 4 * hi;
#pragma unroll
          for (int r = 0; r < 16; ++r) { const int s = (r & 3) + 8 * (r >> 2); if (s > tl4) p0[r] = 0.f; if (s + 32 > tl4) p1[r] = 0.f; } }
        const bf16x8 pa0 = att::pack8(p0[0], p0[1], p0[2], p0[3], p0[4], p0[5], p0[6], p0[7]), pa1 = att::pack8(p0[8], p0[9], p0[10], p0[11], p0[12], p0[13], p0[14], p0[15]);
        const bf16x8 pa2 = att::pack8(p1[0], p1[1], p1[2], p1[3], p1[4], p1[5], p1[6], p1[7]), pa3 = att::pack8(p1[8], p1[9], p1[10], p1[11], p1[12], p1[13], p1[14], p1[15]);
        f32x16 acc;
#pragma unroll
        for (int r = 0; r < 16; ++r) acc[r] = 0.f;
        acc = __builtin_amdgcn_mfma_f32_32x32x16_bf16(att::v_frag_rt(vbuf, va_et, fo.vd, 0), pa0, acc, 0, 0, 0);
        acc = __builtin_amdgcn_mfma_f32_32x32x16_bf16(att::v_frag_rt(vbuf, va_et, fo.vd, 1), pa1, acc, 0, 0, 0);
        acc = __builtin_amdgcn_mfma_f32_32x32x16_bf16(att::v_frag_rt(vbuf, va_et, fo.vd, 2), pa2, acc, 0, 0, 0);
        acc = __builtin_amdgcn_mfma_f32_32x32x16_bf16(att::v_frag_rt(vbuf, va_et, fo.vd, 3), pa3, acc, 0, 0, 0);
#pragma unroll
        for (int ks = 0; ks < 4; ++ks) { const f32x4 s0 = sf[2 * ks], s1 = sf[2 * ks + 1];
            acc = __builtin_amdgcn_mfma_f32_32x32x16_bf16(att::pack8(s0[0], s0[1], s0[2], s0[3], s1[0], s1[1], s1[2], s1[3]), qfr[ks], acc, 0, 0, 0); }
        float ss = 0.f;
#pragma unroll
        for (int r = 0; r < 16; ++r) ss = fmaf(acc[r], acc[r], ss);
        ss += __shfl_xor(ss, 32);
        LAS float* part = (LAS float*)(lds + L_PART);
        if (hi == 0) part[et * 64 + tl] = ss;
        asm volatile("s_waitcnt lgkmcnt(0)" ::: "memory");
        __syncthreads();
        const float rs = rsqrtf(((part[tl] + part[64 + tl]) + (part[128 + tl] + part[192 + tl])) * (1.0f / 128.0f) + EPS);
#pragma unroll
        for (int g = 0; g < 4; ++g) {
            const int e0 = 32 * et + 8 * g + 4 * hi;
            const unsigned long long ow = *(const LAS unsigned long long*)(ogbuf + att::img_off(tl, 4 * et + g) + 8 * hi);
            const f32x4 gg = *(const f32x4*)(F.g_gla + e0);
            float y[4];
#pragma unroll
            for (int i = 0; i < 4; ++i) { const float og = __uint_as_float(((unsigned)(ow >> (16 * i)) & 0xffffu) << 16); y[i] = acc[4 * g + i] * rs * gg[i] * (og * __builtin_amdgcn_rcpf(1.0f + __expf(-og))); }
            *(LAS unsigned long long*)(lds + L_STG + tl * SP + e0 * 2) = (unsigned long long)pg8::cvt_pk_bf16(y[0], y[1]) | ((unsigned long long)pg8::cvt_pk_bf16(y[2], y[3]) << 32);
        }
        asm volatile("s_waitcnt lgkmcnt(0)" ::: "memory");
        __syncthreads();
#pragma unroll
        for (int i = 0; i < 2; ++i) { const int cidx = tid + 512 * i, row = cidx >> 4, ch = cidx & 15;
            *(u32x4*)(F.CAT + (size_t)(b * SEQ + 64 * c + row) * D + 512 + h * 128 + ch * 8) = *(const LAS u32x4*)(lds + L_STG + row * SP + ch * 16); }
        cur = nxt;
    }
    __syncthreads();
}
}
__device__ __forceinline__ void ph_rope_tables(Frame& F, float* R128, float* R64) {
    for (int i = F.vcu * NTHR + F.tid; i < SEQ * 24; i += F.G * NTHR) {
        const int pos = i / 24, k = i % 24;
        if (k < 16) { const float inv = powf(500000.0f, -(float)k * 2.0f / 32.0f), ang = (float)pos * inv; R128[pos * 32 + k] = cosf(ang); R128[pos * 32 + 16 + k] = sinf(ang); }
        else { const int j = k - 16; const float inv = powf(500000.0f, -(float)j * 2.0f / 16.0f), ang = (float)pos * inv; R64[pos * 16 + j] = cosf(ang); R64[pos * 16 + 8 + j] = sinf(ang); }
    }
}
__device__ __forceinline__ float dpp_xor1(float v) { return __builtin_bit_cast(float, __builtin_amdgcn_mov_dpp(__builtin_bit_cast(int, v), 0xB1, 0xF, 0xF, true)); }
__device__ __forceinline__ float dpp_xor2(float v) { return __builtin_bit_cast(float, __builtin_amdgcn_mov_dpp(__builtin_bit_cast(int, v), 0x4E, 0xF, 0xF, true)); }
__device__ __forceinline__ void ph_prep_c_fast(Frame& F) {
    const int gw = F.vcu * NWAVES + F.wave, NGW = F.G * NWAVES, lane = F.lane;
    const float* gn = (lane < 32 ? F.gq_c : F.gk_c) + (lane & 3) * 32;
    const float sc = lane < 32 ? att::C2 : 1.0f;
    float g[32];
#pragma unroll
    for (int i = 0; i < 8; ++i) { const f32x4 v = *(const f32x4*)(gn + 4 * i); g[4 * i] = v[0] * sc; g[4 * i + 1] = v[1] * sc; g[4 * i + 2] = v[2] * sc; g[4 * i + 3] = v[3] * sc; }
    for (int tok = gw; tok < M; tok += NGW) {
        att::u32x4* p = (att::u32x4*)(F.R1 + (size_t)tok * NC + lane * 32);
        att::u32x4 v[4]; float f[32]; float ss = 0.f;
#pragma unroll
        for (int i = 0; i < 4; ++i) v[i] = p[i];
#pragma unroll
        for (int i = 0; i < 4; ++i)
#pragma unroll
            for (int j = 0; j < 4; ++j) { const float a = __uint_as_float(v[i][j] << 16), b = __uint_as_float(v[i][j] & 0xffff0000u); f[8 * i + 2 * j] = a; f[8 * i + 2 * j + 1] = b; ss = fmaf(a, a, fmaf(b, b, ss)); }
        ss += dpp_xor1(ss); ss += dpp_xor2(ss);
        const float rs = rsqrtf(ss * (1.f / 128.f) + EPS);
#pragma unroll
        for (int i = 0; i < 4; ++i) { att::u32x4 o;
#pragma unroll
            for (int j = 0; j < 4; ++j) o[j] = pg8::cvt_pk_bf16(f[8 * i + 2 * j] * rs * g[8 * i + 2 * j], f[8 * i + 2 * j + 1] * rs * g[8 * i + 2 * j + 1]);
            p[i] = o; }
    }
}
__device__ __forceinline__ void ph_prep_a_fast(Frame& F, const float* R128, const float* R64) {
    const int gw = F.vcu * NWAVES + F.wave, NGW = F.G * NWAVES, lane = F.lane, l8 = lane & 7;
    const float* gn = (lane < 32 ? F.gq_a : F.gk_a) + l8 * 16;
    const float sc = lane < 32 ? att::C2 : 1.0f;
    float g[16];
#pragma unroll
    for (int i = 0; i < 4; ++i) { const f32x4 v = *(const f32x4*)(gn + 4 * i); g[4 * i] = v[0] * sc; g[4 * i + 1] = v[1] * sc; g[4 * i + 2] = v[2] * sc; g[4 * i + 3] = v[3] * sc; }
    for (int tok = gw; tok < M; tok += NGW) {
        const int pos = tok & (SEQ - 1);
        bf16* pr = F.R1 + (size_t)tok * NAB;
        {   att::u32x4* p = (att::u32x4*)(pr + lane * 16);
            const att::u32x4 v0 = p[0], v1 = p[1]; float f[16]; float ss = 0.f;
#pragma unroll
            for (int j = 0; j < 4; ++j) { f[2 * j] = __uint_as_float(v0[j] << 16); f[2 * j + 1] = __uint_as_float(v0[j] & 0xffff0000u); f[8 + 2 * j] = __uint_as_float(v1[j] << 16); f[8 + 2 * j + 1] = __uint_as_float(v1[j] & 0xffff0000u); }
#pragma unroll
            for (int i = 0; i < 16; ++i) ss = fmaf(f[i], f[i], ss);
            ss += dpp_xor1(ss); ss += dpp_xor2(ss); ss += __shfl_xor(ss, 4);
            const float rs = rsqrtf(ss * (1.f / 128.f) + EPS);
#pragma unroll
            for (int i = 0; i < 16; ++i) f[i] = f[i] * rs * g[i];
            const float* cs = R128 + pos * 32;
#pragma unroll
            for (int i = 0; i < 16; ++i) { const float other = dpp_xor1(f[i]);
                if (l8 < 2) { const float c = cs[i], s = cs[16 + i]; f[i] = (l8 == 0) ? f[i] * c - other * s : f[i] * c + other * s; } }
            att::u32x4 o0, o1;
#pragma unroll
            for (int j = 0; j < 4; ++j) { o0[j] = pg8::cvt_pk_bf16(f[2 * j], f[2 * j + 1]); o1[j] = pg8::cvt_pk_bf16(f[8 + 2 * j], f[8 + 2 * j + 1]); }
            p[0] = o0; p[1] = o1;
        }
        {
#pragma unroll
            for (int part = 0; part < 2; ++part) {
                if (part == 1 && lane >= 8) break;
                att::u32x4* p = (att::u32x4*)(pr + (part == 0 ? C_IQ + lane * 8 : C_IK + lane * 8));
                const att::u32x4 v0 = p[0]; float f[8];
#pragma unroll
                for (int j = 0; j < 4; ++j) { f[2 * j] = __uint_as_float(v0[j] << 16); f[2 * j + 1] = __uint_as_float(v0[j] & 0xffff0000u); }
                const float* cs = R64 + pos * 16;
#pragma unroll
                for (int i = 0; i < 8; ++i) { const float other = dpp_xor1(f[i]);
                    if (l8 < 2) { const float c = cs[i], s = cs[8 + i]; f[i] = (l8 == 0) ? f[i] * c - other * s : f[i] * c + other * s; } }
                att::u32x4 o0;
#pragma unroll
                for (int j = 0; j < 4; ++j) o0[j] = pg8::cvt_pk_bf16(f[2 * j], f[2 * j + 1]);
                p[0] = o0;
            }
        }
    }
}
#ifndef MK_PER_PHASE
#define MK_PER_PHASE 0
#endif
constexpr int NPH = 14;
struct Args { const float* in[16]; float* out; unsigned char* ws; int ph_lo, ph_hi; };
__global__ void __launch_bounds__(NTHR, 2) mk_fwd(Args args) {
    extern __shared__ __attribute__((aligned(16))) unsigned char lds[];
    Frame F;
    F.lds = (LAS unsigned char*)lds;
    F.MISC = (volatile LAS unsigned*)(F.lds + MISC_OFF);
    F.wave = __builtin_amdgcn_readfirstlane((int)threadIdx.x >> 6);
#define RELANE() (F.lane = lane_id_opaque(), F.tid = F.wave * 64 + F.lane, true)
    RELANE();
#ifdef PROBE_ACC
    F.acc_t0 = 0ull; F.acc_sum = 0ull;
#endif
    F.G = gridDim.x; { const int bx = blockIdx.x; F.vcu = (F.G % 8 == 0) ? (bx % 8) * (F.G / 8) + bx / 8 : bx; }
    unsigned char* ws = args.ws;
    F.ctl = (gu32*)(ws + WS_CTL);
    F.x = args.in[0]; F.g_mix = args.in[1]; F.g_ffn = args.in[2]; F.w_in_ab = args.in[3]; F.gq_a = args.in[4]; F.gk_a = args.in[5]; F.w_gate_up = args.in[6]; F.b_gate = args.in[7];
    F.g_gla = args.in[8]; F.w_out_ab = args.in[9]; F.w_in_c = args.in[10]; F.gq_c = args.in[11]; F.gk_c = args.in[12]; F.w_out_c = args.in[13]; F.w_up = args.in[14]; F.w_down = args.in[15];
    F.out = args.out;
    F.Wab = (bf16*)(ws + WS_WAB); F.Woab = (bf16*)(ws + WS_WOAB); F.Wup0 = (bf16*)(ws + WS_WUP0); F.Wdn0 = (bf16*)(ws + WS_WDN0);
    F.Winc = (bf16*)(ws + WS_WINC); F.Woc = (bf16*)(ws + WS_WOC); F.Wup1 = (bf16*)(ws + WS_WUP1); F.Wdn1 = (bf16*)(ws + WS_WDN1);
    F.XB = (bf16*)(ws + WS_XB); F.CAT = (bf16*)(ws + WS_CAT); F.R1 = (bf16*)(ws + WS_R1); F.SSQ = (float*)(ws + WS_SSQ); F.MASK = (unsigned*)(ws + WS_MASK);
    for (int u = F.tid; u < (LDS_BYTES - MISC_OFF) / 4; u += NTHR) ((LAS unsigned*)(F.lds + MISC_OFF))[u] = 0u;
    __syncthreads();
    XcdBarrier bar; bar.bar = (unsigned*)(F.ctl + CW_BAR); bar.x = 0; bar.st = nullptr; bar.wave = F.wave;
    if (!MK_PER_PHASE) bar = xcd_barrier_post((unsigned*)(F.ctl + CW_BAR), F.MISC + 8, F.wave);
    const int lo = args.ph_lo, hi = args.ph_hi;
#ifdef PROBE_PH
    unsigned long long pt0 = 0ull, pt1 = 0ull;
#define STAMP(k) do { if ((k) == PROBE_PH) pt0 = __builtin_amdgcn_s_memrealtime(); if ((k) == PROBE_PH + 1) pt1 = __builtin_amdgcn_s_memrealtime(); } while (0)
#ifdef PROBE_SUB
#define SUBSTAMP(k) do { if ((k) == PROBE_PH) { __syncthreads(); pt0 = __builtin_amdgcn_s_memrealtime(); } } while (0)
#else
#define SUBSTAMP(k) do { } while (0)
#endif
#else
#define STAMP(k) do { } while (0)
#define SUBSTAMP(k) do { } while (0)
#endif
#define IN(k) (lo <= (k) && (k) < hi && RELANE())
#define SEAM(k) do { if (lo <= (k) && (k) + 1 < hi) xcd_barrier(bar); } while (0)
    float* const SSQ0 = F.SSQ, *SSQ1 = F.SSQ + (size_t)M * 16, *SSQ2 = F.SSQ + (size_t)2 * M * 16, *SSQ3 = F.SSQ + (size_t)3 * M * 16;
    typedef pg8::StaticOrder SO;
    STAMP(0); float* const R128 = (float*)(ws + WS_ROPE); float* const R64 = R128 + SEQ * 32;
    if (IN(0)) { ph_prologue(F); ph_rope_tables(F, R128, R64); } SEAM(0);
    STAMP(1); if (IN(1)) { pg8::Gemm g{F.XB, F.Wab, M, NAB, D}; SO S; S.init(M, NAB, F.G, (int)blockIdx.x); pg8::EpiScale<0> E{F.R1, NAB, SSQ0};
        pg8::gemm_phase<pg8::EpiScale<0>, SO, true, true>(F.lds, g, S, E, F.wave);
        if (F.G == 256 && blockIdx.x >= 128) { RELANE(); prologue_weights<1>(F, ((int)blockIdx.x - 128) * NWAVES + F.wave, 128 * NWAVES); } } SEAM(1);
    float* const GU = (float*)(ws + WS_XB); float* const DEC = (float*)(ws + WS_DEC);
    STAMP(2); if (IN(2)) { ph_prep_a_fast(F, R128, R64); SUBSTAMP(2); gla::pass_a(F, GU, DEC, (float*)(ws + WS_BC)); } SEAM(2);
    STAMP(3); if (IN(3)) { gla::pass_b(F, GU, DEC); SUBSTAMP(3); ph_indexer(F); } SEAM(3);
    STAMP(4); if (IN(4)) { ph_dsa(F); SUBSTAMP(4); gla::pass_c(F, GU, (const float*)(ws + WS_BC)); } SEAM(4);
    STAMP(5); if (IN(5)) { pg8::Gemm g{F.CAT, F.Woab, M, D, D}; SO S; S.init(M, D, F.G, (int)blockIdx.x); pg8::EpiResid<0, 0> E{F.x, nullptr, F.XB, SSQ1, nullptr};
        pg8::gemm_phase<pg8::EpiResid<0, 0>, SO, true, true>(F.lds, g, S, E, F.wave); } SEAM(5);
    STAMP(6); if (IN(6)) { pg8::Gemm g{F.XB, F.Wup0, M, FF, D}; SO S; S.init(M, FF, F.G, (int)blockIdx.x); pg8::EpiScale<1> E{F.R1, FF, SSQ1};
        pg8::gemm_phase<pg8::EpiScale<1>, SO, true, true>(F.lds, g, S, E, F.wave); } SEAM(6);
    STAMP(7); if (IN(7)) { pg8::Gemm g{F.R1, F.Wdn0, M, D, FF}; SO S; S.init(M, D, F.G, (int)blockIdx.x); pg8::EpiResid<1, 0> E{F.XB, nullptr, F.XB, SSQ2, SSQ1};
        pg8::gemm_phase<pg8::EpiResid<1, 0>, SO, true, true>(F.lds, g, S, E, F.wave); } SEAM(7);
    STAMP(8); if (IN(8)) { pg8::Gemm g{F.XB, F.Winc, M, NC, D}; SO S; S.init(M, NC, F.G, (int)blockIdx.x); pg8::EpiQKNorm E{F.R1, NC, SSQ2, F.gq_c, F.gk_c, (LAS float*)(F.lds + RING_BYTES), att::C2};
        pg8::gemm_phase<pg8::EpiQKNorm, SO, true, true>(F.lds, g, S, E, F.wave); } SEAM(8);
    STAMP(9);
    STAMP(10); if (IN(10)) { ph_sb(F); } SEAM(10);
    STAMP(11); if (IN(11)) { pg8::Gemm g{F.CAT, F.Woc, M, D, D}; SO S; S.init(M, D, F.G, (int)blockIdx.x); pg8::EpiResid<1, 0> E{F.XB, nullptr, F.XB, SSQ3, nullptr};
        pg8::gemm_phase<pg8::EpiResid<1, 0>, SO, true, true>(F.lds, g, S, E, F.wave); } SEAM(11);
    STAMP(12); if (IN(12)) { pg8::Gemm g{F.XB, F.Wup1, M, FF, D}; SO S; S.init(M, FF, F.G, (int)blockIdx.x); pg8::EpiScale<1> E{F.R1, FF, SSQ3};
        pg8::gemm_phase<pg8::EpiScale<1>, SO, true, true>(F.lds, g, S, E, F.wave); } SEAM(12);
    STAMP(13); if (IN(13)) { pg8::Gemm g{F.R1, F.Wdn1, M, D, FF}; SO S; S.init(M, D, F.G, (int)blockIdx.x); pg8::EpiResid<1, 1> E{F.XB, F.out, nullptr, nullptr, SSQ3};
        pg8::gemm_phase<pg8::EpiResid<1, 1>, SO, true, true>(F.lds, g, S, E, F.wave); }
    STAMP(NPH);
#ifdef PROBE_ACC
    if (blockIdx.x == 0) { const unsigned long long t1 = __builtin_amdgcn_s_memrealtime(), dt = F.acc_sum * PROBE_MULT; while (__builtin_amdgcn_s_memrealtime() - t1 < dt) __builtin_amdgcn_s_sleep(8); }
#endif
#ifdef PROBE_PH
    if (blockIdx.x == 0) { const unsigned long long t1 = __builtin_amdgcn_s_memrealtime(), dt = (pt1 - pt0) * PROBE_MULT; while (__builtin_amdgcn_s_memrealtime() - t1 < dt) __builtin_amdgcn_s_sleep(8); }
#endif
#undef IN
#undef SEAM
}

extern "C" void kernel_launch(void* const* d_in, const int* in_sizes, int n_in, void* d_out, int out_size, void* d_ws, size_t ws_size, hipStream_t stream) {
    static int grid = 0;
    if (grid == 0) {
        if (n_in != 16 || in_sizes[0] != M * D || out_size != M * D || ws_size < WS_END) { fprintf(stderr, "kernel_launch: unexpected shapes / workspace (%d inputs, ws %zu)\n", n_in, ws_size); grid = -1; return; }
        int dev = 0, cus = 0;
        if (hipGetDevice(&dev) != hipSuccess || hipDeviceGetAttribute(&cus, hipDeviceAttributeMultiprocessorCount, dev) != hipSuccess) { grid = -1; return; }
        if (hipFuncSetAttribute((const void*)mk_fwd, hipFuncAttributeMaxDynamicSharedMemorySize, LDS_BYTES) != hipSuccess) { fprintf(stderr, "kernel_launch: hipFuncSetAttribute failed\n"); grid = -1; return; }
        (void)hipGetLastError();
        grid = cus;
    }
    if (grid < 0) return;
    if (hipMemsetAsync((char*)d_ws + WS_CTL, 0, CTL_ZERO_BYTES, stream) != hipSuccess) { fprintf(stderr, "kernel_launch: memset failed\n"); return; }
    Args a{};
    for (int i = 0; i < 16; ++i) a.in[i] = (const float*)d_in[i];
    a.out = (float*)d_out; a.ws = (unsigned char*)d_ws;
#if MK_PER_PHASE
    for (int ph = 0; ph < NPH; ++ph) { a.ph_lo = ph; a.ph_hi = ph + 1; hipLaunchKernelGGL(mk_fwd, dim3(grid), dim3(NTHR), LDS_BYTES, stream, a); }
#else
    a.ph_lo = 0; a.ph_hi = NPH;
    hipLaunchKernelGGL(mk_fwd, dim3(grid), dim3(NTHR), LDS_BYTES, stream, a);
#endif
    const hipError_t le = hipPeekAtLastError();
    if (le != hipSuccess) fprintf(stderr, "kernel_launch: launch failed: %s\n", hipGetErrorName(le));
}
```

```cpp
#include <hip/hip_runtime.h>
#include <cstdio>
#include <cstdint>
namespace pg8 {
#define PG8_LAS __attribute__((address_space(3)))
typedef unsigned short bf16_t;
typedef short bf16x8 __attribute__((ext_vector_type(8)));
typedef float f32x4 __attribute__((ext_vector_type(4)));
typedef unsigned u32x4 __attribute__((ext_vector_type(4)));
constexpr int BM = 256, BK = 64, HALF = 128, HTB = HALF * BK * 2  , STAGE_BYTES = 8 * HTB, NXCD = 8, WGM = 8;

__host__ __device__ __forceinline__ int lds_byte(int r, int c) { const int st = (r >> 4) * 2 + (c >> 5), rr = r & 15, cc = c & 31, ob = rr * 64 + cc * 2; return st * 1024 + (ob ^ (((ob >> 9) & 1) << 5)); }
__host__ __device__ __forceinline__ void stage_rc(int b, int& R, int& C) { const int st = b / 1024, sb = b % 1024, swz = sb ^ (((sb >> 9) & 1) << 5); R = (st >> 1) * 16 + swz / 64; C = (st & 1) * 32 + (swz % 64) / 2; }
__host__ __device__ __forceinline__ int perm32(int rho) { const int n = rho >> 4, i = rho & 15; return 8 * (i >> 2) + 4 * n + (i & 3); }

struct Unit { int pm, pn; };
struct Gemm { const bf16_t* A; const bf16_t* Bt; int M, N, K; };

struct StaticOrder {
    int nM, nN, nwg, G, c;
    __host__ __device__ void init(int M, int N, int G_, int c_) { nM = M / BM; nN = N / BM; nwg = nM * nN; G = G_; c = c_; }
    __host__ __device__ bool next(int i, Unit& u) const {
        const long L = (long)i * G + c; if (L >= nwg) return false;
        int wgid = (int)L; { const int q = nwg / NXCD, r = nwg % NXCD, xcd = wgid % NXCD, off = wgid / NXCD; wgid = (xcd < r ? xcd * (q + 1) : r * (q + 1) + (xcd - r) * q) + off; }
        const int nig = WGM * nN, gid = wgid / nig, fm = gid * WGM, gsz = (nM - fm) < WGM ? (nM - fm) : WGM;
        u.pm = fm + ((wgid % nig) % gsz); u.pn = (wgid % nig) / gsz; return true;
    }
    __device__ __forceinline__ void a_ready(const Unit&) const {}
    __device__ __forceinline__ void done(const Unit&) const {}
};

__device__ __forceinline__ unsigned cvt_pk_bf16(float lo, float hi) { unsigned r; asm volatile("v_cvt_pk_bf16_f32 %0, %1, %2" : "=v"(r) : "v"(lo), "v"(hi)); return r; }
__device__ __forceinline__ float row_rstd(const float* ssqp, int row) {
    const f32x4* p = (const f32x4*)(ssqp + (size_t)row * 16);
    const f32x4 a = p[0], b = p[1], c = p[2], d = p[3];
    const float s = (((a[0] + a[1]) + (a[2] + a[3])) + ((b[0] + b[1]) + (b[2] + b[3]))) + (((c[0] + c[1]) + (c[2] + c[3])) + ((d[0] + d[1]) + (d[2] + d[3])));
    return rsqrtf(s * (1.0f / 1024.0f) + 1e-6f);
}
template <int ACT  > struct EpiScale {
    static constexpr bool PERM = true, AFTER_DRAIN = false;
    bf16_t* O; int ldc; const float* ssqp;
    __device__ __forceinline__ void operator()(const f32x4 (&acc)[2][2][4][2], const Unit& u, int wr, int wc, int fr, int fq) const {
        const int row0 = u.pm * BM + wr * 64 + fr, col0 = u.pn * BM + wc * 32 + 8 * fq;
#pragma unroll
        for (int ai = 0; ai < 2; ++ai)
#pragma unroll
            for (int m = 0; m < 4; ++m) {
                const int row = row0 + ai * HALF + m * 16;
                const float rs = (ACT == 0) ? row_rstd(ssqp, row) : 1.0f;
                bf16_t* rowp = O + (size_t)row * ldc + col0;
#pragma unroll
                for (int bj = 0; bj < 2; ++bj) {
                    f32x4 v0 = acc[ai][bj][m][0] * rs, v1 = acc[ai][bj][m][1] * rs;
                    if (ACT == 1) {
#pragma unroll
                        for (int e = 0; e < 4; ++e) { const float a0 = fmaxf(v0[e], 0.f), a1 = fmaxf(v1[e], 0.f); v0[e] = a0 * a0; v1[e] = a1 * a1; }
                    }
                    u32x4 w; w.x = cvt_pk_bf16(v0[0], v0[1]); w.y = cvt_pk_bf16(v0[2], v0[3]); w.z = cvt_pk_bf16(v1[0], v1[1]); w.w = cvt_pk_bf16(v1[2], v1[3]);
                    *(u32x4*)(rowp + bj * HALF) = w;
                }
            }
    }
};
template <int RIN, int OUT> struct EpiResid {
    static constexpr bool PERM = true, AFTER_DRAIN = false;
    const void* R; float* out; bf16_t* hb; float* ssqp; const float* ssq_in;
    __device__ __forceinline__ void operator()(const f32x4 (&acc)[2][2][4][2], const Unit& u, int wr, int wc, int fr, int fq) const {
        const int row0 = u.pm * BM + wr * 64 + fr, col0 = u.pn * BM + wc * 32 + 8 * fq;
#pragma unroll
        for (int ai = 0; ai < 2; ++ai)
#pragma unroll
            for (int m = 0; m < 4; ++m) {
                const int row = row0 + ai * HALF + m * 16;
                const size_t off = (size_t)row * 1024 + col0;
                float sc2 = 1.0f; if (ssq_in) { const float rs = row_rstd(ssq_in, row); sc2 = rs * rs; }
                float ss = 0.f;
#pragma unroll
                for (int bj = 0; bj < 2; ++bj) {
                    f32x4 r0, r1;
                    if (RIN == 0) { r0 = *(const f32x4*)((const float*)R + off + bj * HALF); r1 = *(const f32x4*)((const float*)R + off + bj * HALF + 4); }
                    else { const u32x4 rw = *(const u32x4*)((const bf16_t*)R + off + bj * HALF);
                        r0 = (f32x4){__uint_as_float(rw.x << 16), __uint_as_float(rw.x & 0xffff0000u), __uint_as_float(rw.y << 16), __uint_as_float(rw.y & 0xffff0000u)};
                        r1 = (f32x4){__uint_as_float(rw.z << 16), __uint_as_float(rw.z & 0xffff0000u), __uint_as_float(rw.w << 16), __uint_as_float(rw.w & 0xffff0000u)}; }
                    const f32x4 v0 = acc[ai][bj][m][0] * sc2 + r0, v1 = acc[ai][bj][m][1] * sc2 + r1;
                    if (OUT == 1) { *(f32x4*)(out + off + bj * HALF) = v0; *(f32x4*)(out + off + bj * HALF + 4) = v1; }
                    else {
                        u32x4 w; w.x = cvt_pk_bf16(v0[0], v0[1]); w.y = cvt_pk_bf16(v0[2], v0[3]); w.z = cvt_pk_bf16(v1[0], v1[1]); w.w = cvt_pk_bf16(v1[2], v1[3]);
                        *(u32x4*)(hb + off + bj * HALF) = w;
                        ss += ((v0[0] * v0[0] + v0[1] * v0[1]) + (v0[2] * v0[2] + v0[3] * v0[3])) + ((v1[0] * v1[0] + v1[1] * v1[1]) + (v1[2] * v1[2] + v1[3] * v1[3]));
                    }
                }
                if (OUT == 0) { ss += __shfl_xor(ss, 16); ss += __shfl_xor(ss, 32); if (fq == 0) ssqp[(size_t)row * 16 + u.pn * 4 + wc] = ss; }
            }
    }
};
struct EpiQKNorm {
    static constexpr bool PERM = true, AFTER_DRAIN = false;
    bf16_t* O; int ldc; const float* ssqp; const float* gq; const float* gk; PG8_LAS float* part; float qscale;
    __device__ __forceinline__ void operator()(const f32x4 (&acc)[2][2][4][2], const Unit& u, int wr, int wc, int fr, int fq) const {
        const int row0 = u.pm * BM + wr * 64 + fr, col0 = u.pn * BM + wc * 32 + 8 * fq;
        const bool nrm = u.pn < 8;
        f32x4 g0 = (f32x4){1.f, 1.f, 1.f, 1.f}, g1 = g0;
        if (nrm) {
#pragma unroll
            for (int ai = 0; ai < 2; ++ai)
#pragma unroll
                for (int m = 0; m < 4; ++m)
#pragma unroll
                    for (int bj = 0; bj < 2; ++bj) { const f32x4 v0 = acc[ai][bj][m][0], v1 = acc[ai][bj][m][1];
                        float ss = ((v0[0] * v0[0] + v0[1] * v0[1]) + (v0[2] * v0[2] + v0[3] * v0[3])) + ((v1[0] * v1[0] + v1[1] * v1[1]) + (v1[2] * v1[2] + v1[3] * v1[3]));
                        ss += __shfl_xor(ss, 16); ss += __shfl_xor(ss, 32);
                        if (fq == 0) part[((ai * HALF + wr * 64 + m * 16 + fr) * 2 + bj) * 4 + wc] = ss; }
            asm volatile("s_waitcnt lgkmcnt(0)" ::: "memory"); __builtin_amdgcn_s_barrier(); asm volatile("" ::: "memory");
            const float* gp = (u.pn < 4 ? gq : gk) + wc * 32 + 8 * fq; const float sc = (u.pn < 4) ? qscale : 1.0f;
            g0 = *(const f32x4*)gp * sc; g1 = *(const f32x4*)(gp + 4) * sc;
        }
#pragma unroll
        for (int ai = 0; ai < 2; ++ai)
#pragma unroll
            for (int m = 0; m < 4; ++m) {
                const int row = row0 + ai * HALF + m * 16;
                const float rsr = row_rstd(ssqp, row);
                bf16_t* rowp = O + (size_t)row * ldc + col0;
#pragma unroll
                for (int bj = 0; bj < 2; ++bj) {
                    float hs = rsr;
                    if (nrm) { const f32x4 pp = *(const PG8_LAS f32x4*)(part + ((ai * HALF + wr * 64 + m * 16 + fr) * 2 + bj) * 4);
                        hs *= rsqrtf(((pp[0] + pp[1]) + (pp[2] + pp[3])) * (rsr * rsr * (1.0f / 128.0f)) + 1e-6f); }
                    const f32x4 v0 = acc[ai][bj][m][0] * hs * g0, v1 = acc[ai][bj][m][1] * hs * g1;
                    u32x4 w; w.x = cvt_pk_bf16(v0[0], v0[1]); w.y = cvt_pk_bf16(v0[2], v0[3]); w.z = cvt_pk_bf16(v1[0], v1[1]); w.w = cvt_pk_bf16(v1[2], v1[3]);
                    *(u32x4*)(rowp + bj * HALF) = w;
                }
            }
    }
};
struct EpiProjAB {
    static constexpr bool PERM = true, AFTER_DRAIN = false;
    bf16_t* O; int ldc; const float* ssqp; const float* gq; const float* gk; const float* r128; const float* r64; PG8_LAS float* part; float qscale;
    __device__ __forceinline__ void operator()(const f32x4 (&acc)[2][2][4][2], const Unit& u, int wr, int wc, int fr, int fq) const {
        const int row0 = u.pm * BM + wr * 64 + fr, col0 = u.pn * BM + wc * 32 + 8 * fq, pn = u.pn;
        const bool qk = pn < 4, iq = (pn == 6) || (pn == 7) || (pn == 14);
        const bool rope_qk = qk && (wc == 0), rope_iq = iq && !(wc & 1) && (pn != 14 || wc == 0);
        f32x4 g0 = (f32x4){1.f, 1.f, 1.f, 1.f}, g1 = g0;
        if (qk) {
#pragma unroll
            for (int ai = 0; ai < 2; ++ai)
#pragma unroll
                for (int m = 0; m < 4; ++m)
#pragma unroll
                    for (int bj = 0; bj < 2; ++bj) { const f32x4 v0 = acc[ai][bj][m][0], v1 = acc[ai][bj][m][1];
                        float ss = ((v0[0] * v0[0] + v0[1] * v0[1]) + (v0[2] * v0[2] + v0[3] * v0[3])) + ((v1[0] * v1[0] + v1[1] * v1[1]) + (v1[2] * v1[2] + v1[3] * v1[3]));
                        ss += __shfl_xor(ss, 16); ss += __shfl_xor(ss, 32);
                        if (fq == 0) part[((ai * HALF + wr * 64 + m * 16 + fr) * 2 + bj) * 4 + wc] = ss; }
            asm volatile("s_waitcnt lgkmcnt(0)" ::: "memory"); __builtin_amdgcn_s_barrier(); asm volatile("" ::: "memory");
            const float* gp = (pn < 2 ? gq : gk) + wc * 32 + 8 * fq; const float sc = (pn < 2) ? qscale : 1.0f;
            g0 = *(const f32x4*)gp * sc; g1 = *(const f32x4*)(gp + 4) * sc;
        }
#pragma unroll
        for (int ai = 0; ai < 2; ++ai)
#pragma unroll
            for (int m = 0; m < 4; ++m) {
                const int row = row0 + ai * HALF + m * 16, pos = row & 2047;
                const float rsr = row_rstd(ssqp, row);
                bf16_t* rowp = O + (size_t)row * ldc + col0;
                f32x4 c0 = (f32x4){1.f, 1.f, 1.f, 1.f}, c1 = c0, s0 = (f32x4){0.f, 0.f, 0.f, 0.f}, s1 = s0;
                if (rope_qk) { const float* t = r128 + pos * 32 + 8 * (fq & 1); c0 = *(const f32x4*)t; c1 = *(const f32x4*)(t + 4); s0 = *(const f32x4*)(t + 16); s1 = *(const f32x4*)(t + 20); }
                else if (rope_iq) { const float* t = r64 + pos * 16; c0 = *(const f32x4*)t; c1 = *(const f32x4*)(t + 4); s0 = *(const f32x4*)(t + 8); s1 = *(const f32x4*)(t + 12); }
#pragma unroll
                for (int bj = 0; bj < 2; ++bj) {
                    float hs = rsr;
                    if (qk) { const f32x4 pp = *(const PG8_LAS f32x4*)(part + ((ai * HALF + wr * 64 + m * 16 + fr) * 2 + bj) * 4);
                        hs *= rsqrtf(((pp[0] + pp[1]) + (pp[2] + pp[3])) * (rsr * rsr * (1.0f / 128.0f)) + 1e-6f); }
                    f32x4 v0 = acc[ai][bj][m][0] * hs * g0, v1 = acc[ai][bj][m][1] * hs * g1;
                    if (rope_qk) {
                        f32x4 p0, p1;
#pragma unroll
                        for (int e = 0; e < 4; ++e) { p0[e] = __shfl_xor(v0[e], 32); p1[e] = __shfl_xor(v1[e], 32); }
                        if (fq < 2) { v0 = v0 * c0 - p0 * s0; v1 = v1 * c1 - p1 * s1; } else { v0 = v0 * c0 + p0 * s0; v1 = v1 * c1 + p1 * s1; }
                    } else if (rope_iq && (pn != 14 || bj == 0)) {
                        f32x4 p0, p1;
#pragma unroll
                        for (int e = 0; e < 4; ++e) { p0[e] = __shfl_xor(v0[e], 16); p1[e] = __shfl_xor(v1[e], 16); }
                        if (fq == 0) { v0 = v0 * c0 - p0 * s0; v1 = v1 * c1 - p1 * s1; } else if (fq == 1) { v0 = v0 * c0 + p0 * s0; v1 = v1 * c1 + p1 * s1; }
                    }
                    u32x4 w; w.x = cvt_pk_bf16(v0[0], v0[1]); w.y = cvt_pk_bf16(v0[2], v0[3]); w.z = cvt_pk_bf16(v1[0], v1[1]); w.w = cvt_pk_bf16(v1[2], v1[3]);
                    *(u32x4*)(rowp + bj * HALF) = w;
                }
            }
    }
};
template <class Epi, class Sched, bool ALIGN_EPI = false, bool SP2 = false>
__device__ __forceinline__ void gemm_phase(PG8_LAS unsigned char* lds, const Gemm g, const Sched& S, const Epi& E, const int wave_in) {
    const int wid = wave_in, lane = (int)__builtin_amdgcn_mbcnt_hi(~0u, __builtin_amdgcn_mbcnt_lo(~0u, 0u)), tid = wid * 64 + lane, wr = wid >> 2, wc = wid & 3, fr = lane & 15, fq = lane >> 4;
    const int K = g.K, nt = K / BK;
    unsigned voffA[2], voffB[2];
#pragma unroll
    for (int i = 0; i < 2; ++i) { int R, C; stage_rc(tid * 16 + i * 8192, R, C); const int Rb = Epi::PERM ? ((R & ~31) + perm32(R & 31)) : R;
        voffA[i] = (unsigned)(R * K + C) * 2u; voffB[i] = (unsigned)(Rb * K + C) * 2u; }
    const size_t kstep = (size_t)(BK * 2);
    const size_t hstep = (size_t)HALF * K * 2;
    const size_t tstep = 2 * hstep;
    const unsigned ldsw = (unsigned)wid * 1024u;
    const int aoff = lds_byte(wr * 64 + fr, fq * 8), boff = lds_byte(wc * 32 + fr, fq * 8);
#define PG8_SA(b, h) (((b) * 2 + (h)) * HTB)
#define PG8_SB(b, h) ((4 + (b) * 2 + (h)) * HTB)
#define PG8_STAGE(bufoff, gbase, voff) do { _Pragma("unroll") for (int _i = 0; _i < 2; ++_i) \
        __builtin_amdgcn_global_load_lds((const unsigned*)((const char*)(gbase) + (voff)[_i]), (PG8_LAS unsigned*)(lds + (bufoff) + ldsw + _i * 8192), 16, 0, 0); } while (0)
#define PG8_LDA(dst, b, h) do { _Pragma("unroll") for (int m = 0; m < 4; ++m) _Pragma("unroll") for (int k = 0; k < 2; ++k) dst[m][k] = *(const PG8_LAS bf16x8*)(lds + PG8_SA(b, h) + aoff + m * 2048 + k * 1024); } while (0)
#define PG8_LDB(dst, b, h) do { _Pragma("unroll") for (int n = 0; n < 2; ++n) _Pragma("unroll") for (int k = 0; k < 2; ++k) dst[n][k] = *(const PG8_LAS bf16x8*)(lds + PG8_SB(b, h) + boff + n * 2048 + k * 1024); } while (0)
#define PG8_MMA(ai, bj, At, Bt) do { __builtin_amdgcn_s_setprio(1); _Pragma("unroll") for (int m = 0; m < 4; ++m) _Pragma("unroll") for (int n = 0; n < 2; ++n) _Pragma("unroll") for (int k = 0; k < 2; ++k) \
        acc[ai][bj][m][n] = __builtin_amdgcn_mfma_f32_16x16x32_bf16(Bt[n][k], At[m][k], acc[ai][bj][m][n], 0, 0, 0); __builtin_amdgcn_s_setprio(0); } while (0)
#define PG8_WAIT_V(n) asm volatile("s_waitcnt vmcnt(" #n ")" ::: "memory")
#define PG8_WAIT_L(n) asm volatile("s_waitcnt lgkmcnt(" #n ")" ::: "memory")
#define PG8_BAR __builtin_amdgcn_s_barrier()
#define PG8_SCHED __builtin_amdgcn_sched_barrier(0)
    Unit cur, nxt; int ui = 0;
    if (!S.next(0, cur)) return;
    f32x4 acc[2][2][4][2];
#pragma unroll
    for (int a = 0; a < 2; ++a)
#pragma unroll
        for (int b = 0; b < 2; ++b)
#pragma unroll
            for (int m = 0; m < 4; ++m)
#pragma unroll
                for (int n = 0; n < 2; ++n) acc[a][b][m][n] = (f32x4){0.f, 0.f, 0.f, 0.f};
    bf16x8 At[4][2], B0[2][2], B1[2][2];
    const char* cA = (const char*)g.A + (size_t)cur.pm * tstep; const char* cB = (const char*)g.Bt + (size_t)cur.pn * tstep;
    S.a_ready(cur);
    if constexpr (SP2) {
        PG8_STAGE(PG8_SB(0, 0), cB, voffB); PG8_STAGE(PG8_SB(0, 1), cB + hstep, voffB); PG8_STAGE(PG8_SA(0, 0), cA, voffA); PG8_STAGE(PG8_SA(0, 1), cA + hstep, voffA);
        if (wr == 1) PG8_BAR;
        PG8_WAIT_V(2); PG8_BAR;
        PG8_STAGE(PG8_SB(1, 0), cB + kstep, voffB); PG8_STAGE(PG8_SA(1, 0), cA + kstep, voffA); PG8_STAGE(PG8_SB(1, 1), cB + hstep + kstep, voffB);
        PG8_WAIT_V(6); PG8_BAR;
    } else {
        PG8_STAGE(PG8_SB(0, 0), cB, voffB); PG8_STAGE(PG8_SA(0, 0), cA, voffA); PG8_STAGE(PG8_SB(0, 1), cB + hstep, voffB); PG8_STAGE(PG8_SA(0, 1), cA + hstep, voffA);
        if (wr == 1) PG8_BAR;
        PG8_WAIT_V(4); PG8_BAR;
        PG8_STAGE(PG8_SB(1, 0), cB + kstep, voffB); PG8_STAGE(PG8_SA(1, 0), cA + kstep, voffA); PG8_STAGE(PG8_SB(1, 1), cB + hstep + kstep, voffB);
        PG8_WAIT_V(6); PG8_BAR;
    }
    for (;;) {
        const bool has_next = S.next(ui + 1, nxt);
        const char* nA = has_next ? (const char*)g.A + (size_t)nxt.pm * tstep : cA; const char* nB = has_next ? (const char*)g.Bt + (size_t)nxt.pn * tstep : cB;
        for (int t = 0; t < nt; t += 2) {
            const bool last = (t == nt - 2);
            const char* a1 = cA + (size_t)(t + 1) * kstep;
            const char* a2 = last ? nA : cA + (size_t)(t + 2) * kstep; const char* b2 = last ? nB : cB + (size_t)(t + 2) * kstep;
            const char* a3 = a2 + kstep; const char* b3 = b2 + kstep;
            if (last && has_next) S.a_ready(nxt);
            if constexpr (SP2) {
            PG8_LDB(B0, 0, 0); PG8_LDB(B1, 0, 1); PG8_SCHED; PG8_LDA(At, 0, 0); PG8_STAGE(PG8_SA(1, 1), a1 + hstep, voffA);
            PG8_WAIT_V(8); PG8_WAIT_L(0); PG8_BAR; PG8_MMA(0, 0, At, B0); PG8_MMA(0, 1, At, B1); PG8_BAR; PG8_SCHED;
            PG8_LDA(At, 0, 1); PG8_STAGE(PG8_SB(0, 0), b2, voffB); PG8_STAGE(PG8_SB(0, 1), b2 + hstep, voffB); PG8_STAGE(PG8_SA(0, 0), a2, voffA);
            PG8_WAIT_V(8); PG8_WAIT_L(0); PG8_BAR; PG8_MMA(1, 0, At, B0); PG8_MMA(1, 1, At, B1); PG8_BAR; PG8_SCHED;
            PG8_LDB(B0, 1, 0); PG8_LDB(B1, 1, 1); PG8_SCHED; PG8_LDA(At, 1, 0); PG8_STAGE(PG8_SA(0, 1), a2 + hstep, voffA);
            PG8_WAIT_V(8); PG8_WAIT_L(0); PG8_BAR; PG8_MMA(0, 0, At, B0); PG8_MMA(0, 1, At, B1); PG8_BAR; PG8_SCHED;
            PG8_LDA(At, 1, 1); PG8_STAGE(PG8_SB(1, 0), b3, voffB); PG8_STAGE(PG8_SB(1, 1), b3 + hstep, voffB); PG8_STAGE(PG8_SA(1, 0), a3, voffA);
            PG8_WAIT_V(8); PG8_WAIT_L(0); PG8_BAR; PG8_MMA(1, 0, At, B0); PG8_MMA(1, 1, At, B1); PG8_BAR; PG8_SCHED;
            } else {
            PG8_LDB(B0, 0, 0); PG8_SCHED; PG8_LDA(At, 0, 0); PG8_STAGE(PG8_SA(1, 1), a1 + hstep, voffA);
            PG8_WAIT_L(8); PG8_BAR; PG8_WAIT_L(0); PG8_MMA(0, 0, At, B0); PG8_BAR; PG8_SCHED;
            PG8_LDB(B1, 0, 1); PG8_STAGE(PG8_SB(0, 0), b2, voffB);
            PG8_BAR; PG8_WAIT_L(0); PG8_MMA(0, 1, At, B1); PG8_BAR;
            PG8_LDA(At, 0, 1); PG8_STAGE(PG8_SA(0, 0), a2, voffA);
            PG8_BAR; PG8_WAIT_L(0); PG8_MMA(1, 0, At, B0); PG8_BAR; PG8_SCHED;
            PG8_STAGE(PG8_SB(0, 1), b2 + hstep, voffB);
            PG8_WAIT_V(6); PG8_BAR; PG8_MMA(1, 1, At, B1); PG8_BAR;
            PG8_LDB(B0, 1, 0); PG8_SCHED; PG8_LDA(At, 1, 0); PG8_STAGE(PG8_SA(0, 1), a2 + hstep, voffA);
            PG8_WAIT_L(8); PG8_BAR; PG8_WAIT_L(0); PG8_MMA(0, 0, At, B0); PG8_BAR; PG8_SCHED;
            PG8_LDB(B1, 1, 1); PG8_STAGE(PG8_SB(1, 0), b3, voffB);
            PG8_BAR; PG8_WAIT_L(0); PG8_MMA(0, 1, At, B1); PG8_BAR;
            PG8_LDA(At, 1, 1); PG8_STAGE(PG8_SA(1, 0), a3, voffA);
            PG8_BAR; PG8_WAIT_L(0); PG8_MMA(1, 0, At, B0); PG8_BAR; PG8_SCHED;
            PG8_STAGE(PG8_SB(1, 1), b3 + hstep, voffB);
            PG8_WAIT_V(6); PG8_BAR; PG8_MMA(1, 1, At, B1); PG8_BAR;
            }
        }
        if constexpr (ALIGN_EPI) { if (wr == 0) PG8_BAR; }
        if constexpr (!Epi::AFTER_DRAIN) { E(acc, cur, wr, wc, fr, fq); S.done(cur); }
        if (!has_next) break;
#pragma unroll
        for (int a = 0; a < 2; ++a)
#pragma unroll
            for (int b = 0; b < 2; ++b)
#pragma unroll
                for (int m = 0; m < 4; ++m)
#pragma unroll
                    for (int n = 0; n < 2; ++n) acc[a][b][m][n] = (f32x4){0.f, 0.f, 0.f, 0.f};
        cur = nxt; cA = nA; cB = nB; ++ui;
        if constexpr (ALIGN_EPI) { if (wr == 1) PG8_BAR; }
    }
    PG8_WAIT_V(0);
    if constexpr (!ALIGN_EPI) { if (wr == 0) PG8_BAR; }
    PG8_BAR;
    if constexpr (Epi::AFTER_DRAIN) { E.fused(acc, cur, wr, wc, fr, fq, lds, wid, lane); S.done(cur); }
#undef PG8_SA
#undef PG8_SB
#undef PG8_STAGE
#undef PG8_LDA
#undef PG8_LDB
#undef PG8_MMA
#undef PG8_WAIT_V
#undef PG8_WAIT_L
#undef PG8_BAR
#undef PG8_SCHED
}
}
#include <cmath>
constexpr int NWAVES = 8, NTHR = 512;
constexpr int BATCH = 16, SEQ = 2048, M = BATCH * SEQ, D = 1024, FF = 4096, NAB = 3840, NC = 3072, ABP_OLD = 3672;
constexpr int C_QA = 0, C_KA = 512, C_VA = 1024, C_IQ = 1536, C_QB = 2048, C_KB = 2304, C_VB = 2560, C_OG = 3072, C_IK = 3584, C_IW = 3648, C_GL = 3656;
constexpr float EPS = 1e-6f;
constexpr size_t MiB = 1u << 20;
constexpr size_t WS_CTL = 0, CTL_ZERO_BYTES = 64 * 1024;
constexpr size_t WS_WAB = 1 * MiB, WS_WOAB = 9 * MiB, WS_WUP0 = 11 * MiB, WS_WDN0 = 19 * MiB, WS_WINC = 27 * MiB, WS_WOC = 33 * MiB, WS_WUP1 = 35 * MiB, WS_WDN1 = 43 * MiB;
constexpr size_t WS_SSQ = 51 * MiB, SSQ_BYTES = 2 * MiB;
constexpr size_t WS_DEC = 59 * MiB;
constexpr size_t WS_ROPE = 59 * MiB + 512 * 1024;
constexpr size_t WS_XB = 60 * MiB;
constexpr size_t WS_CAT = 124 * MiB;
constexpr size_t WS_MASK = 188 * MiB;
constexpr size_t WS_R1 = 196 * MiB;
constexpr size_t WS_BC = 452 * MiB;
constexpr size_t WS_END = 484 * MiB;
constexpr int CW_BAR = 4096;
constexpr int RING_BYTES = 131072;
constexpr int LDS_BYTES = 163840;
constexpr int MISC_OFF = LDS_BYTES - 256;
#define GAS __attribute__((address_space(1)))
#define LAS __attribute__((address_space(3)))
typedef unsigned short bf16;
typedef unsigned v4u __attribute__((ext_vector_type(4)));
typedef float f32x4 __attribute__((ext_vector_type(4)));
typedef short bf16x8 __attribute__((ext_vector_type(8)));
typedef GAS unsigned gu32;
typedef GAS unsigned long long gu64;
#define RLX_AGENT __ATOMIC_RELAXED, __HIP_MEMORY_SCOPE_AGENT
#define LDS_WAIT() asm volatile("s_waitcnt lgkmcnt(0)" ::: "memory")
#define VM_WAIT() asm volatile("s_waitcnt vmcnt(0)" ::: "memory")
__device__ __forceinline__ unsigned long long rt() { return __builtin_amdgcn_s_memrealtime(); }
__device__ __forceinline__ unsigned f2bf(float f) { unsigned u = __builtin_bit_cast(unsigned, f); return (u + 0x7fffu + ((u >> 16) & 1u)) >> 16; }
__device__ __forceinline__ unsigned pk2(float lo, float hi) { return f2bf(lo) | (f2bf(hi) << 16); }
#define XB_TMO      128
#define XB_XCNT(j)  (256  + 64 * (j))
#define XB_XSUB(j)  (1280 + 64 * (j))
#define XB_XGEN(j)  (2304 + 64 * (j))
#define XB_TOP      3328
#define XB_TOPGEN   3392
#define XCD_BAR_WORDS 3456
#define XB_SPIN_CAP (1u << 18)

__device__ __forceinline__ unsigned xb_ld(unsigned* p)              { return __hip_atomic_load(p, __ATOMIC_RELAXED, __HIP_MEMORY_SCOPE_AGENT); }
__device__ __forceinline__ unsigned xb_add(unsigned* p, unsigned v) { return __hip_atomic_fetch_add(p, v, __ATOMIC_RELAXED, __HIP_MEMORY_SCOPE_AGENT); }
__device__ __forceinline__ unsigned xb_xcc_id() { return (unsigned)__builtin_amdgcn_s_getreg((3 << 11) | 20) & 0xFu; }
#define XB_SPIN(cond, bar) do { unsigned _sp = 0; while (cond) { __builtin_amdgcn_s_sleep(1); \
    if ((++_sp & 255u) == 0u) { if (xb_ld(&(bar)[XB_TMO])) break; if (_sp > XB_SPIN_CAP) { atomicAdd(&(bar)[XB_TMO], 1u); break; } } } } while (0)

struct XcdBarrier {
    unsigned* bar; unsigned x; int wave;
    volatile LAS unsigned* st;
};

__device__ __forceinline__ bool xb_t0(int wave) { return wave == 0 && __builtin_amdgcn_mbcnt_hi(~0u, __builtin_amdgcn_mbcnt_lo(~0u, 0u)) == 0u; }
__device__ __forceinline__ XcdBarrier xcd_barrier_post(unsigned* bar, volatile LAS unsigned* st, int wave) {
    XcdBarrier b; b.bar = bar; b.x = xb_xcc_id(); b.st = st; b.wave = wave;
    if (xb_t0(wave)) (void)xb_add(&bar[XB_XCNT(b.x)], 1u);
    return b;
}
__device__ __forceinline__ void xcd_barrier_complete(unsigned* bar, unsigned x, unsigned& nloc, unsigned& nx) {
    const unsigned G = gridDim.x * gridDim.y * gridDim.z;
    unsigned sum, cnt, mine, sp = 0u;
    for (;;) {
        sum = 0u; cnt = 0u; mine = 0u;
#pragma unroll
        for (unsigned j = 0; j < 16; ++j) { const unsigned c = xb_ld(&bar[XB_XCNT(j)]); sum += c; cnt += (c > 0u) ? 1u : 0u; mine = (j == x) ? c : mine; }
        if (sum == G) break;
        __builtin_amdgcn_s_sleep(1);
        if ((++sp & 255u) == 0u) { if (xb_ld(&bar[XB_TMO])) break; if (sp > XB_SPIN_CAP) { atomicAdd(&bar[XB_TMO], 1u); break; } }
    }
    nloc = mine > 0u ? mine : 1u; nx = cnt > 0u ? cnt : 1u;
}

__device__ __forceinline__ void xcd_barrier(const XcdBarrier& b) {
    asm volatile("s_waitcnt vmcnt(0)" ::: "memory");
    __syncthreads();
    if (xb_t0(b.wave)) {
        unsigned* bar = b.bar;
        __builtin_amdgcn_s_waitcnt(0);
        unsigned nloc = b.st[0], nx = b.st[1];
        if (nloc == 0u) { xcd_barrier_complete(bar, b.x, nloc, nx); b.st[0] = nloc; b.st[1] = nx; }
        const unsigned old = xb_add(&bar[XB_XSUB(b.x)], 1u);
        const unsigned gen = old / nloc;
        if (old + 1u == (gen + 1u) * nloc) {
            __builtin_amdgcn_fence(__ATOMIC_RELEASE, "agent");
            asm volatile("s_waitcnt vmcnt(0)" ::: "memory");
            const unsigned og = xb_add(&bar[XB_TOP], 1u);
            const unsigned tg = og / nx;
            if (og + 1u == (tg + 1u) * nx) xb_add(&bar[XB_TOPGEN], 1u);
            else XB_SPIN(xb_ld(&bar[XB_TOPGEN]) == tg, bar);
            __builtin_amdgcn_fence(__ATOMIC_ACQUIRE, "agent");
            xb_add(&bar[XB_XGEN(b.x)], 1u);
            asm volatile("s_waitcnt vmcnt(0)" ::: "memory");
        } else {
            XB_SPIN(xb_ld(&bar[XB_XGEN(b.x)]) == gen, bar);
            __builtin_amdgcn_fence(__ATOMIC_ACQUIRE, "agent");
            asm volatile("s_waitcnt vmcnt(0)" ::: "memory");
        }
    }
    __syncthreads();
}
#ifdef PROBE_ACC
#define ACC_BEGIN(F, id) do { if ((id) == PROBE_ACC) { __syncthreads(); (F).acc_t0 = __builtin_amdgcn_s_memrealtime(); } } while (0)
#define ACC_END(F, id) do { if ((id) == PROBE_ACC) { __syncthreads(); (F).acc_sum += __builtin_amdgcn_s_memrealtime() - (F).acc_t0; } } while (0)
#else
#define ACC_BEGIN(F, id) do { } while (0)
#define ACC_END(F, id) do { } while (0)
#endif
struct Frame {
#ifdef PROBE_ACC
    unsigned long long acc_t0, acc_sum;
#endif
    LAS unsigned char* lds;
    volatile LAS unsigned* MISC;
    gu32* ctl;
    int tid, lane, wave, vcu, G;
    const float *x, *g_mix, *g_ffn, *w_in_ab, *gq_a, *gk_a, *w_gate_up, *b_gate, *g_gla, *w_out_ab, *w_in_c, *gq_c, *gk_c, *w_out_c, *w_up, *w_down;
    float* out;
    bf16 *Wab, *Woab, *Wup0, *Wdn0, *Winc, *Woc, *Wup1, *Wdn1;
    bf16 *XB, *CAT, *R1;
    float* SSQ; unsigned* MASK;
};
__device__ __forceinline__ int lane_id_opaque() { int l; asm volatile("v_mbcnt_lo_u32_b32 %0, -1, 0\n\tv_mbcnt_hi_u32_b32 %0, -1, %0" : "=v"(l)); return l; }
__device__ __forceinline__ float bf2f(bf16 v) { return __builtin_bit_cast(float, (unsigned)v << 16); }
__device__ __forceinline__ float wave_sum(float v) {
#pragma unroll
    for (int o = 1; o < 64; o <<= 1) v += __shfl_xor(v, o);
    return v;
}
__device__ __forceinline__ float wave_max(float v) {
#pragma unroll
    for (int o = 1; o < 64; o <<= 1) v = fmaxf(v, __shfl_xor(v, o));
    return v;
}
__device__ __forceinline__ float log_sigmoid(float x) { return fminf(x, 0.f) - log1pf(expf(-fabsf(x))); }

__device__ __forceinline__ int oldcol_ab(int n) {
    if (n < 2048) return n;
    if (n < 2304) return 2120 + (n - 2048);
    if (n < 2560) return 2376 + (n - 2304);
    if (n < 3072) return 2632 + (n - 2560);
    if (n < 3584) return 3160 + (n - 3072);
    if (n < 3648) return 2048 + (n - 3584);
    if (n < 3656) return 2112 + (n - 3648);
    if (n < 3672) return 3144 + (n - 3656);
    return -1;
}
__device__ __forceinline__ void p0_transpose_item(const float* W, int ldw, int K, const float* gain, bf16* WT, bool map, int item, int nblk, int lane) {
    const int kb = item / nblk, nb = item % nblk, ng = lane & 7, ko = lane >> 3, k0 = 64 * kb + 8 * ko, n = 32 * nb + 4 * ng;
    const int oc = map ? oldcol_ab(n) : n;
    f32x4 v[8];
#pragma unroll
    for (int i = 0; i < 8; ++i) { v[i] = (f32x4){0.f, 0.f, 0.f, 0.f}; if (oc >= 0) v[i] = *(const GAS f32x4*)(W + (size_t)(k0 + i) * ldw + oc); }
    if (gain) { const f32x4 g0 = *(const GAS f32x4*)(gain + k0), g1 = *(const GAS f32x4*)(gain + k0 + 4);
#pragma unroll
        for (int i = 0; i < 4; ++i) { v[i] = v[i] * g0[i]; v[4 + i] = v[4 + i] * g1[i]; } }
#pragma unroll
    for (int e = 0; e < 4; ++e) { v4u o; o.x = pk2(v[0][e], v[1][e]); o.y = pk2(v[2][e], v[3][e]); o.z = pk2(v[4][e], v[5][e]); o.w = pk2(v[6][e], v[7][e]);
        *(GAS v4u*)(WT + (size_t)(n + e) * K + k0) = o; }
}
template <int PART> __device__ __forceinline__ void prologue_weights(Frame& F, int gw, int NGW) {
    constexpr int I_AB = (D / 64) * (NAB / 32), I_O = (D / 64) * (D / 32), I_UP = (D / 64) * (FF / 32), I_DN = (FF / 64) * (D / 32), I_C = (D / 64) * (NC / 32);
    if (PART == 0) { for (int it = gw; it < I_AB; it += NGW) p0_transpose_item(F.w_in_ab, ABP_OLD, D, F.g_mix, F.Wab, true, it, NAB / 32, F.lane); return; }
    constexpr int NITEMS = 2 * I_O + 2 * I_UP + 2 * I_DN + I_C;
    for (int it = gw; it < NITEMS; it += NGW) {
        int r = it;
        if (r < I_O) { p0_transpose_item(F.w_out_ab, D, D, nullptr, F.Woab, false, r, D / 32, F.lane); continue; } r -= I_O;
        if (r < I_UP) { p0_transpose_item(F.w_up, FF, D, F.g_ffn, F.Wup0, false, r, FF / 32, F.lane); continue; } r -= I_UP;
        if (r < I_DN) { p0_transpose_item(F.w_down, D, FF, nullptr, F.Wdn0, false, r, D / 32, F.lane); continue; } r -= I_DN;
        if (r < I_C) { p0_transpose_item(F.w_in_c, NC, D, F.g_mix + D, F.Winc, false, r, NC / 32, F.lane); continue; } r -= I_C;
        if (r < I_O) { p0_transpose_item(F.w_out_c, D, D, nullptr, F.Woc, false, r, D / 32, F.lane); continue; } r -= I_O;
        if (r < I_UP) { p0_transpose_item(F.w_up + (size_t)D * FF, FF, D, F.g_ffn + D, F.Wup1, false, r, FF / 32, F.lane); continue; } r -= I_UP;
        p0_transpose_item(F.w_down + (size_t)FF * D, D, FF, nullptr, F.Wdn1, false, r, D / 32, F.lane);
    }
}
__device__ __forceinline__ void ph_prologue(Frame& F) {
    const int gw = F.vcu * NWAVES + F.wave, NGW = F.G * NWAVES;
    prologue_weights<0>(F, gw, NGW);
    if (F.G != 256) prologue_weights<1>(F, gw, NGW);
    for (int m0 = gw; m0 < M; m0 += 4 * NGW) {
        f32x4 v[4][4]; float s[4];
#pragma unroll
        for (int r = 0; r < 4; ++r) { const int m = m0 + r * NGW; const GAS f32x4* xr = (const GAS f32x4*)(F.x + (size_t)(m < M ? m : m0) * D) + F.lane;
#pragma unroll
            for (int j = 0; j < 4; ++j) v[r][j] = xr[64 * j]; }
#pragma unroll
        for (int r = 0; r < 4; ++r) { float t = 0.f;
#pragma unroll
            for (int j = 0; j < 4; ++j) t += (v[r][j].x * v[r][j].x + v[r][j].y * v[r][j].y) + (v[r][j].z * v[r][j].z + v[r][j].w * v[r][j].w);
            s[r] = t; }
#pragma unroll
        for (int o = 1; o < 64; o <<= 1) {
#pragma unroll
            for (int r = 0; r < 4; ++r) s[r] += __shfl_xor(s[r], o); }
#pragma unroll
        for (int r = 0; r < 4; ++r) { const int m = m0 + r * NGW; if (m < M) {
            GAS unsigned long long* o8 = (GAS unsigned long long*)(F.XB + (size_t)m * D) + F.lane;
#pragma unroll
            for (int j = 0; j < 4; ++j) o8[64 * j] = (unsigned long long)pk2(v[r][j].x, v[r][j].y) | ((unsigned long long)pk2(v[r][j].z, v[r][j].w) << 32);
            if (F.lane < 16) F.SSQ[(size_t)m * 16 + F.lane] = (F.lane == 0) ? s[r] : 0.f; } }
    }
}
namespace att {
typedef short s16x4 __attribute__((ext_vector_type(4)));
typedef float f32x16 __attribute__((ext_vector_type(16)));
typedef _Float16 f16x8 __attribute__((ext_vector_type(8)));
typedef unsigned u32x4 __attribute__((ext_vector_type(4)));
typedef short v4i16_t __attribute__((ext_vector_type(4)));
constexpr float C2 = 0.08838834764831845f * 1.4426950408889634f;
__device__ __forceinline__ int crow(int r, int hi) { return (r & 3) + 8 * (r >> 2) + 4 * hi; }
__device__ __forceinline__ int img_off(int row, int ch) { return 256 * row + 16 * (ch ^ (((row & 3) << 2) | ((row >> 2) & 3))); }
__device__ __forceinline__ bf16x8 pack8(float a0, float a1, float a2, float a3, float a4, float a5, float a6, float a7) {
    u32x4 w; w.x = pg8::cvt_pk_bf16(a0, a1); w.y = pg8::cvt_pk_bf16(a2, a3); w.z = pg8::cvt_pk_bf16(a4, a5); w.w = pg8::cvt_pk_bf16(a6, a7);
    return __builtin_bit_cast(bf16x8, w);
}
__device__ __forceinline__ f16x8 pack8h(float a0, float a1, float a2, float a3, float a4, float a5, float a6, float a7) {
    f16x8 r; r[0] = (_Float16)a0; r[1] = (_Float16)a1; r[2] = (_Float16)a2; r[3] = (_Float16)a3; r[4] = (_Float16)a4; r[5] = (_Float16)a5; r[6] = (_Float16)a6; r[7] = (_Float16)a7; return r;
}
__device__ __forceinline__ void dma_off_init(unsigned (&dvo)[2], int ld, int wave, int lane) {
#pragma unroll
    for (int i = 0; i < 2; ++i) { const int pi = 2 * wave + i, row = 4 * pi + (lane >> 4), pc = lane & 15, ch = pc ^ (((row & 3) << 2) | ((row >> 2) & 3)); dvo[i] = (unsigned)(row * ld + ch * 8) * 2u; }
}
__device__ __forceinline__ void tile_dma(const bf16* g, const unsigned (&dvo)[2], LAS unsigned char* buf, int wave) {
#pragma unroll
    for (int i = 0; i < 2; ++i) __builtin_amdgcn_global_load_lds((const unsigned*)((const char*)g + dvo[i]), (LAS unsigned*)(buf + 1024 * (2 * wave + i)), 16, 0, 0);
}
struct FragOff { int k[8]; int va[4]; int vd; };
__device__ __forceinline__ void frag_off_init(FragOff& fo, int lane) {
    const int hi = lane >> 5, r32 = lane & 31, i = lane & 15, q = i >> 2, p = i & 3, x = 2 * ((lane >> 4) & 1) + (p >> 1);
#pragma unroll
    for (int ks = 0; ks < 8; ++ks) fo.k[ks] = img_off(r32, 2 * ks + hi);
#pragma unroll
    for (int ct = 0; ct < 4; ++ct) fo.va[ct] = img_off(4 * hi + q, 4 * ct + x) + 8 * (p & 1);
    fo.vd = img_off(4 * hi + q + 8, x) - img_off(4 * hi + q, x);
}
__device__ __forceinline__ bf16x8 k_frag(const LAS unsigned char* kbuf, const FragOff& fo, int rt, int ks) { return *(const LAS bf16x8*)(kbuf + fo.k[ks] + 8192 * rt); }
__device__ __forceinline__ s16x4 vtr(const LAS unsigned char* p) { return __builtin_bit_cast(s16x4, __builtin_amdgcn_ds_read_tr16_b64_v4i16((LAS v4i16_t*)p)); }
__device__ __forceinline__ bf16x8 v_frag(const LAS unsigned char* vbuf, const FragOff& fo, int ct, int kk) {
    const s16x4 lo = vtr(vbuf + fo.va[ct] + 4096 * kk), hh = vtr(vbuf + fo.va[ct] + fo.vd + 4096 * kk);
    return (bf16x8){lo[0], lo[1], lo[2], lo[3], hh[0], hh[1], hh[2], hh[3]};
}
#define TR_READ(dst, addr, OFF) asm volatile("ds_read_b64_tr_b16 %0, %1 offset:%c2" : "=&v"(dst) : "v"(addr), "i"(OFF) : "memory")
#define LGKM_WAIT0() do { asm volatile("s_waitcnt lgkmcnt(0)" ::: "memory"); __builtin_amdgcn_sched_barrier(0); } while (0)
__device__ __forceinline__ bf16x8 mk_frag(s16x4 lo, s16x4 hh) { return (bf16x8){lo[0], lo[1], lo[2], lo[3], hh[0], hh[1], hh[2], hh[3]}; }
__device__ __forceinline__ int frag_va(int lane, int ct) { const int hi = lane >> 5, i = lane & 15, q = i >> 2, p = i & 3, x = 2 * ((lane >> 4) & 1) + (p >> 1); return img_off(4 * hi + q, 4 * ct + x) + 8 * (p & 1); }
__device__ __forceinline__ bf16x8 v_frag_rt(const LAS unsigned char* vbuf, int va, int vd, int kk) {
    const s16x4 lo = vtr(vbuf + va + 4096 * kk), hh = vtr(vbuf + va + vd + 4096 * kk);
    return (bf16x8){lo[0], lo[1], lo[2], lo[3], hh[0], hh[1], hh[2], hh[3]};
}
__device__ __forceinline__ void store_o(const f32x16 (&o)[4], const float (&rscale)[16], LAS unsigned char* stg, bf16* dst, int ld, int lane) {
    const int hi = lane >> 5, r32 = lane & 31;
#pragma unroll
    for (int r = 0; r < 16; ++r) { const int orow = crow(r, hi);
#pragma unroll
        for (int ct = 0; ct < 4; ++ct) *(LAS bf16*)(stg + orow * 256 + (32 * ct + r32) * 2) = (bf16)f2bf(o[ct][r] * rscale[r]); }
    asm volatile("s_waitcnt lgkmcnt(0)" ::: "memory");
#pragma unroll
    for (int i = 0; i < 8; ++i) { const int c = lane + 64 * i, row = c >> 4, ch = c & 15; const u32x4 v = *(const LAS u32x4*)(stg + row * 256 + ch * 16); *(u32x4*)(dst + (size_t)row * ld + ch * 8) = v; }
}
}
__device__ __forceinline__ void sb_unit(Frame& F, int b, int h, int qb) {
    using namespace att;
    const int tid = F.tid, lane = F.lane, w = F.wave, hi = lane >> 5, r32 = lane & 31;
    const bf16* Qg = F.R1 + (size_t)b * SEQ * NC + h * 128; const bf16* Kg = Qg + 1024; const bf16* Vg = Qg + 2048;
    const int T0 = qb * 256, t0w = T0 + 32 * w, jd = t0w >> 6, jtop = (T0 >> 6) + 3, tl = 32 * (w & 1) + r32, tl4 = tl - 4 * hi;
    LAS unsigned char* lds = F.lds;
    FragOff fo; frag_off_init(fo, lane);
    unsigned dvo[2]; dma_off_init(dvo, NC, w, lane);
    bf16x8 qf[8];
#pragma unroll
    for (int ks = 0; ks < 8; ++ks) qf[ks] = *(const bf16x8*)(Qg + (size_t)(t0w + r32) * NC + 16 * ks + 8 * hi);
    f16x8 T0f, T1f, ONEf;
#pragma unroll
    for (int j = 0; j < 8; ++j) { const int kp = 8 * (j >> 2) + 4 * hi + (j & 3); T0f[j] = (kp >= r32) ? (_Float16)1.0f : (_Float16)0.0f; T1f[j] = (kp + 16 >= r32) ? (_Float16)1.0f : (_Float16)0.0f; ONEf[j] = (_Float16)1.0f; }
    f32x16 o[4];
#pragma unroll
    for (int ct = 0; ct < 4; ++ct)
#pragma unroll
        for (int r = 0; r < 16; ++r) o[ct][r] = 0.f;
    float R2 = 0.f; bool done = false;
    volatile LAS unsigned* flags = F.MISC + 16;
    tile_dma(Kg + (size_t)(64 * jtop) * NC, dvo, lds, w); tile_dma(Vg + (size_t)(64 * jtop) * NC, dvo, lds + 16384, w);
    asm volatile("s_waitcnt vmcnt(0)" ::: "memory");
    __syncthreads();
    for (int j = jtop; j >= 0; --j) {
        const int cur = (jtop - j) & 1;
        const LAS unsigned char* kb = lds + cur * 32768; const LAS unsigned char* vb = kb + 16384;
        if (j > 0) { tile_dma(Kg + (size_t)(64 * (j - 1)) * NC, dvo, lds + (cur ^ 1) * 32768, w); tile_dma(Vg + (size_t)(64 * (j - 1)) * NC, dvo, lds + (cur ^ 1) * 32768 + 16384, w); }
        if (j <= jd && !done) {
            f32x16 p0, p1;
#pragma unroll
            for (int r = 0; r < 16; ++r) { p0[r] = 0.f; p1[r] = 0.f; }
            { bf16x8 kf[8];
#pragma unroll
              for (int ks = 0; ks < 8; ++ks) kf[ks] = k_frag(kb, fo, 0, ks);
#pragma unroll
              for (int ks = 0; ks < 8; ++ks) p0 = __builtin_amdgcn_mfma_f32_32x32x16_bf16(kf[ks], qf[ks], p0, 0, 0, 0);
#pragma unroll
              for (int ks = 0; ks < 8; ++ks) kf[ks] = k_frag(kb, fo, 1, ks);
#pragma unroll
              for (int ks = 0; ks < 8; ++ks) p1 = __builtin_amdgcn_mfma_f32_32x32x16_bf16(kf[ks], qf[ks], p1, 0, 0, 0); }
            s16x4 vl[4], vh[4], wl[4], wh[4];
            unsigned va0[4], va1[4];
#pragma unroll
            for (int ct = 0; ct < 4; ++ct) { va0[ct] = (unsigned)(size_t)vb + (unsigned)fo.va[ct]; va1[ct] = va0[ct] + (unsigned)fo.vd; }
            const bool diag = (j == jd);
            float x0[16], x1[16]; float rs = 0.f;
#pragma unroll
            for (int r = 0; r < 16; ++r) { const int key = (r & 3) + 8 * (r >> 2);
                float l0 = -__builtin_amdgcn_logf(1.0f + __builtin_amdgcn_exp2f(p0[r])), l1 = -__builtin_amdgcn_logf(1.0f + __builtin_amdgcn_exp2f(p1[r]));
                if (diag) { if (!(key < tl4)) l0 = 0.f; if (!(key + 32 < tl4)) l1 = 0.f; }
                x0[r] = l0; x1[r] = l1; rs += l0 + l1; p0[r] += R2; p1[r] += R2; }
            const f16x8 xb00 = pack8h(x0[0], x0[1], x0[2], x0[3], x0[4], x0[5], x0[6], x0[7]), xb01 = pack8h(x0[8], x0[9], x0[10], x0[11], x0[12], x0[13], x0[14], x0[15]);
            const f16x8 xb10 = pack8h(x1[0], x1[1], x1[2], x1[3], x1[4], x1[5], x1[6], x1[7]), xb11 = pack8h(x1[8], x1[9], x1[10], x1[11], x1[12], x1[13], x1[14], x1[15]);
            p0 = __builtin_amdgcn_mfma_f32_32x32x16_f16(T0f, xb00, p0, 0, 0, 0); p0 = __builtin_amdgcn_mfma_f32_32x32x16_f16(T1f, xb01, p0, 0, 0, 0);
            p0 = __builtin_amdgcn_mfma_f32_32x32x16_f16(ONEf, xb10, p0, 0, 0, 0); p0 = __builtin_amdgcn_mfma_f32_32x32x16_f16(ONEf, xb11, p0, 0, 0, 0);
            p1 = __builtin_amdgcn_mfma_f32_32x32x16_f16(T0f, xb10, p1, 0, 0, 0); p1 = __builtin_amdgcn_mfma_f32_32x32x16_f16(T1f, xb11, p1, 0, 0, 0);
#pragma unroll
            for (int r = 0; r < 16; ++r) { const int key = (r & 3) + 8 * (r >> 2);
                float a0 = __builtin_amdgcn_exp2f(p0[r]), a1 = __builtin_amdgcn_exp2f(p1[r]);
                if (diag) { if (!(key < tl4)) a0 = 0.f; if (!(key + 32 < tl4)) a1 = 0.f; }
                p0[r] = a0; p1[r] = a1; }
            const bf16x8 pa0 = pack8(p0[0], p0[1], p0[2], p0[3], p0[4], p0[5], p0[6], p0[7]), pa1 = pack8(p0[8], p0[9], p0[10], p0[11], p0[12], p0[13], p0[14], p0[15]);
            const bf16x8 pa2 = pack8(p1[0], p1[1], p1[2], p1[3], p1[4], p1[5], p1[6], p1[7]), pa3 = pack8(p1[8], p1[9], p1[10], p1[11], p1[12], p1[13], p1[14], p1[15]);
#pragma unroll
            for (int ct = 0; ct < 4; ++ct) { TR_READ(vl[ct], va0[ct], 0); TR_READ(vh[ct], va1[ct], 0); }
            LGKM_WAIT0();
#pragma unroll
            for (int ct = 0; ct < 4; ++ct) { TR_READ(wl[ct], va0[ct], 4096); TR_READ(wh[ct], va1[ct], 4096); }
#pragma unroll
            for (int ct = 0; ct < 4; ++ct) o[ct] = __builtin_amdgcn_mfma_f32_32x32x16_bf16(pa0, mk_frag(vl[ct], vh[ct]), o[ct], 0, 0, 0);
            LGKM_WAIT0();
#pragma unroll
            for (int ct = 0; ct < 4; ++ct) { TR_READ(vl[ct], va0[ct], 8192); TR_READ(vh[ct], va1[ct], 8192); }
#pragma unroll
            for (int ct = 0; ct < 4; ++ct) o[ct] = __builtin_amdgcn_mfma_f32_32x32x16_bf16(pa1, mk_frag(wl[ct], wh[ct]), o[ct], 0, 0, 0);
            LGKM_WAIT0();
#pragma unroll
            for (int ct = 0; ct < 4; ++ct) { TR_READ(wl[ct], va0[ct], 12288); TR_READ(wh[ct], va1[ct], 12288); }
#pragma unroll
            for (int ct = 0; ct < 4; ++ct) o[ct] = __builtin_amdgcn_mfma_f32_32x32x16_bf16(pa2, mk_frag(vl[ct], vh[ct]), o[ct], 0, 0, 0);
            LGKM_WAIT0();
#pragma unroll
            for (int ct = 0; ct < 4; ++ct) o[ct] = __builtin_amdgcn_mfma_f32_32x32x16_bf16(pa3, mk_frag(wl[ct], wh[ct]), o[ct], 0, 0, 0);
            rs += __shfl_xor(rs, 32);
            R2 += rs;
            done = __all(R2 < -152.0f);
        }
        if (lane == 0) flags[cur * 8 + w] = done ? 1u : 0u;
        asm volatile("s_waitcnt vmcnt(0) lgkmcnt(0)" ::: "memory");
        __syncthreads();
        unsigned alld = 1u;
#pragma unroll
        for (int i = 0; i < 8; ++i) alld &= flags[cur * 8 + i];
        if (alld) break;
    }
    float ones[16];
#pragma unroll
    for (int r = 0; r < 16; ++r) ones[r] = 1.0f;
    store_o(o, ones, lds + w * 8192, F.CAT + (size_t)(b * SEQ + t0w) * D + h * 128, D, lane);
    __syncthreads();
}
__device__ __forceinline__ void ph_sb(Frame& F) {
    for (int v = F.vcu; v < BATCH * 8 * 2; v += F.G) {
        const int bh = v >> 1, half = v & 1;
#pragma unroll 1
        for (int i = 0; i < 4; ++i) { const int qb = half ? (i == 0 ? 1 : i == 1 ? 6 : i == 2 ? 2 : 5) : (i == 0 ? 0 : i == 1 ? 7 : i == 2 ? 3 : 4); sb_unit(F, bh >> 3, bh & 7, qb); }
    }
}
__device__ __forceinline__ void dsa_unit(Frame& F, int b, int h, int ub, float mref) {
    using namespace att;
    const int lane = F.lane, w = F.wave, hi = lane >> 5, r32 = lane & 31;
    const bf16* Qg = F.R1 + (size_t)b * SEQ * NAB + C_QA + h * 128; const bf16* Kg = F.R1 + (size_t)b * SEQ * NAB + C_KA + h * 128; const bf16* Vg = F.R1 + (size_t)b * SEQ * NAB + C_VA + h * 128;
    const int t0w = 256 * ub + 32 * w, cw = t0w >> 6, jlast = 4 * ub + 3;
    LAS unsigned char* lds = F.lds;
    LAS unsigned char* mst = lds + 65536 + w * 8448;
    FragOff fo; frag_off_init(fo, lane);
    unsigned dvo[2]; dma_off_init(dvo, NAB, w, lane);
    tile_dma(Kg, dvo, lds, w); tile_dma(Vg, dvo, lds + 16384, w);
    bf16x8 qf[8];
#pragma unroll
    for (int ks = 0; ks < 8; ++ks) qf[ks] = *(const bf16x8*)(Qg + (size_t)(t0w + r32) * NAB + 16 * ks + 8 * hi);
    { const unsigned* mg = F.MASK + (size_t)(b * SEQ + t0w) * 64;
#pragma unroll 2
      for (int i = 0; i < 8; ++i) { const int c = lane + 64 * i, row = c >> 4, c4 = c & 15; const u32x4 v = *(const u32x4*)(mg + row * 64 + c4 * 4);
          *(LAS unsigned long long*)(mst + row * 264 + c4 * 16) = (unsigned long long)v.x | ((unsigned long long)v.y << 32);
          *(LAS unsigned long long*)(mst + row * 264 + c4 * 16 + 8) = (unsigned long long)v.z | ((unsigned long long)v.w << 32); } }
    f32x16 o[4];
#pragma unroll
    for (int ct = 0; ct < 4; ++ct)
#pragma unroll
        for (int r = 0; r < 16; ++r) o[ct][r] = 0.f;
    float lsum = 0.f;
    asm volatile("s_waitcnt vmcnt(0) lgkmcnt(0)" ::: "memory");
    __syncthreads();
    for (int j = 0; j <= jlast; ++j) {
        const int cur = j & 1;
        const LAS unsigned char* kb = lds + cur * 32768; const LAS unsigned char* vb = kb + 16384;
        if (j < jlast) { tile_dma(Kg + (size_t)(64 * (j + 1)) * NAB, dvo, lds + (cur ^ 1) * 32768, w); tile_dma(Vg + (size_t)(64 * (j + 1)) * NAB, dvo, lds + (cur ^ 1) * 32768 + 16384, w); }
        if (j <= cw) {
            const unsigned long long mw = *(const LAS unsigned long long*)(mst + r32 * 264 + j * 8);
            const unsigned mw0 = (unsigned)mw, mw1 = (unsigned)(mw >> 32);
#pragma unroll 1
            for (int half = 0; half < 2; ++half) {
                const unsigned mwh = (half ? mw1 : mw0) >> (4 * hi);
                bf16x8 kf[8];
#pragma unroll
                for (int ks = 0; ks < 8; ++ks) kf[ks] = k_frag(kb, fo, half, ks);
                f32x16 p;
#pragma unroll
                for (int r = 0; r < 16; ++r) p[r] = 0.f;
#pragma unroll
                for (int ks = 0; ks < 8; ++ks) p = __builtin_amdgcn_mfma_f32_32x32x16_bf16(kf[ks], qf[ks], p, 0, 0, 0);
#pragma unroll
                for (int r = 0; r < 16; ++r) { const unsigned keep = (unsigned)(-(int)((mwh >> ((r & 3) + 8 * (r >> 2))) & 1u));
                    const float e = __uint_as_float(__float_as_uint(__builtin_amdgcn_exp2f(p[r] - mref)) & keep); p[r] = e; lsum += e; }
                const bf16x8 pa0 = pack8(p[0], p[1], p[2], p[3], p[4], p[5], p[6], p[7]), pa1 = pack8(p[8], p[9], p[10], p[11], p[12], p[13], p[14], p[15]);
                s16x4 vl[8], vh[8];
                const unsigned vbase = (unsigned)(size_t)vb + 8192u * (unsigned)half;
#pragma unroll
                for (int ct = 0; ct < 4; ++ct) { const unsigned a0 = vbase + (unsigned)fo.va[ct], a1 = a0 + (unsigned)fo.vd;
                    TR_READ(vl[2 * ct], a0, 0); TR_READ(vh[2 * ct], a1, 0); TR_READ(vl[2 * ct + 1], a0, 4096); TR_READ(vh[2 * ct + 1], a1, 4096); }
                LGKM_WAIT0();
#pragma unroll
                for (int ct = 0; ct < 4; ++ct) {
                    o[ct] = __builtin_amdgcn_mfma_f32_32x32x16_bf16(pa0, mk_frag(vl[2 * ct], vh[2 * ct]), o[ct], 0, 0, 0);
                    o[ct] = __builtin_amdgcn_mfma_f32_32x32x16_bf16(pa1, mk_frag(vl[2 * ct + 1], vh[2 * ct + 1]), o[ct], 0, 0, 0);
                }
            }
        }
        asm volatile("s_waitcnt vmcnt(0) lgkmcnt(0)" ::: "memory");
        __syncthreads();
    }
    lsum += __shfl_xor(lsum, 32);
    LAS float* lsc = (LAS float*)mst;
    if (hi == 0) lsc[r32] = 1.0f / lsum;
    asm volatile("s_waitcnt lgkmcnt(0)" ::: "memory");
    float rsc[16];
#pragma unroll
    for (int r = 0; r < 16; ++r) rsc[r] = lsc[crow(r, hi)];
    store_o(o, rsc, lds + w * 8192, F.CAT + (size_t)(b * SEQ + t0w) * D + h * 128, D, lane);
    __syncthreads();
}
__device__ __forceinline__ void ph_dsa(Frame& F) {
    float gm = fmaxf(fabsf(F.gq_a[F.lane]), fabsf(F.gq_a[64 + F.lane])), km = fmaxf(fabsf(F.gk_a[F.lane]), fabsf(F.gk_a[64 + F.lane]));
    gm = wave_max(gm); km = wave_max(km);
    const float mref = att::C2 * 128.0f * gm * km * 1.02f;
    for (int v = F.vcu; v < BATCH * 4 * 4; v += F.G) {
        const int bh = v >> 2, pi = v & 3;
#pragma unroll 1
        for (int k = 0; k < 2; ++k) dsa_unit(F, bh >> 2, bh & 3, k ? 7 - pi : pi, mref);
    }
}
namespace idx {
using att::f32x16;
constexpr int SCP = 2048;
__device__ __forceinline__ unsigned okey(float f) { const unsigned u = __float_as_uint(f); return (u & 0x80000000u) ? ~u : (u | 0x80000000u); }
__device__ __forceinline__ int wave_isum(int c) {
    c += __builtin_amdgcn_mov_dpp(c, 0xB1, 0xF, 0xF, true);
    c += __builtin_amdgcn_mov_dpp(c, 0x4E, 0xF, 0xF, true);
    c += __builtin_amdgcn_mov_dpp(c, 0x141, 0xF, 0xF, true);
    c += __builtin_amdgcn_mov_dpp(c, 0x140, 0xF, 0xF, true);
    return (__builtin_amdgcn_readlane(c, 0) + __builtin_amdgcn_readlane(c, 16)) + (__builtin_amdgcn_readlane(c, 32) + __builtin_amdgcn_readlane(c, 48));
}
__device__ __forceinline__ void bit_transpose32x2(unsigned (&A)[32], unsigned (&B)[32]) {
    unsigned mask = 0x0000FFFFu;
#pragma unroll
    for (int s = 16; s; s >>= 1) {
        unsigned ta[16], tb[16];
#pragma unroll
        for (int k = 0, i = 0; k < 32; ++k) if (!(k & s)) { ta[i] = A[k + s] >> s; tb[i] = B[k + s] >> s; ++i; }
#pragma unroll
        for (int k = 0, i = 0; k < 32; ++k) if (!(k & s)) { ta[i] ^= A[k]; tb[i] ^= B[k]; ++i; }
#pragma unroll
        for (int i = 0; i < 16; ++i) { ta[i] &= mask; tb[i] &= mask; }
#pragma unroll
        for (int k = 0, i = 0; k < 32; ++k) if (!(k & s)) { A[k] ^= ta[i]; B[k] ^= tb[i]; ++i; }
#pragma unroll
        for (int k = 0, i = 0; k < 32; ++k) if (!(k & s)) { A[k + s] ^= ta[i] << s; B[k + s] ^= tb[i] << s; ++i; }
        mask ^= mask << (s >> 1);
    }
}
__device__ __forceinline__ void select_prepare(const LAS float* scA, const LAS float* scB, int E, unsigned (&Wa)[32], unsigned (&Wb)[32], int lane) {
#pragma unroll
    for (int j = 0; j < 32; ++j) { Wa[31 - j] = __float_as_uint(scA[64 * j + lane]); Wb[31 - j] = __float_as_uint(scB[64 * j + lane]); }
#pragma unroll
    for (int j = 0; j < 32; ++j) { const unsigned ua = Wa[31 - j], ub = Wb[31 - j];
        const unsigned ka = (ua & 0x80000000u) ? ~ua : (ua | 0x80000000u), kb = (ub & 0x80000000u) ? ~ub : (ub | 0x80000000u);
        Wa[31 - j] = (j < E) ? ka : 0u; Wb[31 - j] = (j < E) ? kb : 0u; }
    bit_transpose32x2(Wa, Wb);
}
__device__ __forceinline__ void select_finish(const unsigned (&Wa)[32], const unsigned (&Wb)[32], int E, unsigned* mrowA, unsigned* mrowB, int lane) {
    const unsigned valid = (E >= 32) ? 0xFFFFFFFFu : ((1u << E) - 1u);
    unsigned alA = valid, alB = valid, gtA = 0u, gtB = 0u;
    int GA = 0, GB = 0, AA = 64 * E, AB = 64 * E; bool dA = false, dB = false;
#pragma unroll
    for (int b = 0; b < 32; ++b) {
        if (dA && dB) break;
        const unsigned m1a = alA & Wa[b], m1b = alB & Wb[b];
        const int ca = wave_isum(__popc(m1a)), cb = wave_isum(__popc(m1b));
        if (!dA) { if (GA + ca >= 256) { alA = m1a; AA = ca; } else { GA += ca; gtA |= m1a; alA &= ~Wa[b]; AA -= ca; } dA = (GA + AA == 256); }
        if (!dB) { if (GB + cb >= 256) { alB = m1b; AB = cb; } else { GB += cb; gtB |= m1b; alB &= ~Wb[b]; AB -= cb; } dB = (GB + AB == 256); }
    }
#pragma unroll 1
    for (int rr = 0; rr < 2; ++rr) {
        const unsigned al = rr ? alB : alA, gt = rr ? gtB : gtA; const bool done = rr ? dB : dA; unsigned* mrow = rr ? mrowB : mrowA;
        unsigned sel = gt | al;
        if (!done) {
            int need = 256 - (rr ? GB : GA); sel = gt;
            const unsigned long long below = (1ull << lane) - 1ull;
            for (int j = 0; j < E; ++j) { const bool e = (al >> j) & 1u; const unsigned long long eq = __ballot(e);
                if (e && __popcll(eq & below) < need) sel |= 1u << j;
                need -= __popcll(eq); if (need <= 0) break; }
        }
        unsigned long long mine = 0ull;
#pragma unroll
        for (int j = 0; j < 32; ++j) { if (j < E) { const unsigned long long m = __ballot((sel >> j) & 1u); if (lane == j) mine = m; } }
        if (lane < 32) *(unsigned long long*)(mrow + 2 * lane) = mine;
    }
}
__device__ __forceinline__ void decode(int u, int& b, int& c, int& sub) { c = 4 + u % 28; const int rest = u / 28; b = rest >> 2; sub = rest & 3; }
__device__ __forceinline__ void load_af(Frame& F, int u, bf16x8 (&af)[4][4]) {
    int b, c, sub; decode(u, b, c, sub);
    const int r32 = F.lane & 31, hi = F.lane >> 5, t0 = 64 * c + 16 * sub;
    const bf16* P = F.R1 + (size_t)b * SEQ * NAB;
#pragma unroll
    for (int rt = 0; rt < 4; ++rt)
#pragma unroll
        for (int ks = 0; ks < 4; ++ks) af[rt][ks] = *(const bf16x8*)(P + (size_t)(t0 + 4 * rt + (r32 >> 3)) * NAB + C_IQ + (r32 & 7) * 64 + 16 * ks + 8 * hi);
}
__device__ __forceinline__ float load_w(Frame& F, int u) {
    int b, c, sub; decode(u, b, c, sub);
    const int t0 = 64 * c + 16 * sub;
    return (F.tid < 128) ? bf2f(F.R1[(size_t)(b * SEQ + t0 + (F.tid >> 3)) * NAB + C_IW + (F.tid & 7)]) * (0.125f * 0.35355339059327373f) : 0.f;
}
__device__ __forceinline__ void load_bf(Frame& F, int b, int strip, bf16x8 (&bfr)[4]) {
    const bf16* P = F.R1 + (size_t)b * SEQ * NAB;
#pragma unroll
    for (int ks = 0; ks < 4; ++ks) bfr[ks] = *(const bf16x8*)(P + (size_t)(32 * strip + (F.lane & 31)) * NAB + C_IK + 16 * ks + 8 * (F.lane >> 5));
}
__device__ __forceinline__ void run(Frame& F) {
    const int lane = F.lane, w = F.wave, hi = lane >> 5, r32 = lane & 31, tid = F.tid, NU = BATCH * 28 * 4;
    int u = F.vcu; if (u >= NU) return;
    LAS float* sc = (LAS float*)F.lds;
    LAS float* wtb = sc + 16 * SCP;
    bf16x8 af[4][4], bfr[4], bnx[4];
    load_af(F, u, af);
    { const float wv = load_w(F, u); if (tid < 128) wtb[tid] = wv; }
    { int b, c, sub; decode(u, b, c, sub); if (w < 2 * (c + 1)) load_bf(F, b, w, bfr); }
    for (int it = 0; u < NU; ++it, u += F.G) {
        int b, c, sub; decode(u, b, c, sub);
        const int n = 64 * (c + 1), t0 = 64 * c + 16 * sub, nstrip = n >> 5;
        const int un = u + F.G; const bool more = un < NU;
        const LAS float* wt = wtb + (it & 1) * 128;
        __syncthreads();
        const float wnext = more ? load_w(F, un) : 0.f;
        for (int s = w; s < nstrip; s += NWAVES) {
            const bool mstrip = s + NWAVES < nstrip;
            if (mstrip) load_bf(F, b, s + NWAVES, bnx);
#pragma unroll
            for (int rt = 0; rt < 4; ++rt) {
                f32x16 acc;
#pragma unroll
                for (int r = 0; r < 16; ++r) acc[r] = 0.f;
#pragma unroll
                for (int ks = 0; ks < 4; ++ks) acc = __builtin_amdgcn_mfma_f32_32x32x16_bf16(af[rt][ks], bfr[ks], acc, 0, 0, 0);
                float part[4];
#pragma unroll
                for (int qi = 0; qi < 4; ++qi) { const f32x4 wv = *(const LAS f32x4*)(wt + (4 * rt + qi) * 8 + 4 * hi);
                    part[qi] = fmaxf(acc[4 * qi], 0.f) * wv[0] + fmaxf(acc[4 * qi + 1], 0.f) * wv[1] + fmaxf(acc[4 * qi + 2], 0.f) * wv[2] + fmaxf(acc[4 * qi + 3], 0.f) * wv[3]; }
                const float send0 = hi ? part[0] : part[2], send1 = hi ? part[1] : part[3];
                const float got0 = __shfl_xor(send0, 32), got1 = __shfl_xor(send1, 32);
                const float f0 = (hi ? part[2] : part[0]) + got0, f1 = (hi ? part[3] : part[1]) + got1;
                const int q0 = 4 * rt + 2 * hi;
                sc[q0 * SCP + 32 * s + r32] = f0; sc[(q0 + 1) * SCP + 32 * s + r32] = f1;
            }
            if (mstrip) {
#pragma unroll
                for (int ks = 0; ks < 4; ++ks) bfr[ks] = bnx[ks];
            }
        }
        if (more && tid < 128) wtb[((it + 1) & 1) * 128 + tid] = wnext;
        __syncthreads();
        { const int q = 2 * w;
          unsigned* mrowA = F.MASK + (size_t)(b * SEQ + t0 + q) * 64; unsigned* mrowB = mrowA + 64;
          const LAS float* rowA = sc + q * SCP; const LAS float* rowB = rowA + SCP;
          unsigned Wa[32], Wb[32];
          select_prepare(rowA, rowB, n >> 6, Wa, Wb, lane);
          asm volatile("" ::: "memory");
          if (more) load_af(F, un, af);
          select_finish(Wa, Wb, n >> 6, mrowA, mrowB, lane); }
        if (more) { int bn, cn, sn; decode(un, bn, cn, sn); if (w < 2 * (cn + 1)) load_bf(F, bn, w, bfr); }
    }
    __syncthreads();
}
}
__device__ __forceinline__ void ph_indexer(Frame& F) {
    { const int gw = F.vcu * NWAVES + F.wave, NGW = F.G * NWAVES;
      for (int i = gw; i < BATCH * 256; i += NGW) { const int b = i >> 8, pos = i & 255, n = ((pos >> 6) + 1) << 6;
          if (F.lane < 32) { unsigned long long v = 0ull; if (64 * F.lane < n) v = ~0ull; *(unsigned long long*)(F.MASK + (size_t)(b * SEQ + pos) * 64 + 2 * F.lane) = v; } } }
    idx::run(F);
}
namespace gla {
using att::f32x16; using att::u32x4;
constexpr int L_WL = 0, L_V = 4096, L_OG = 36864, L_K = 69632, L_Q = 78848, L_PART = 88064, L_STG = 89088, KP = 144, SP = 272;
struct In { u32x4 g0, g1, kk, qq; f32x4 b0, b1; };
__device__ __forceinline__ void decode(int u, int& b, int& h, int& c) { b = u >> 7; h = (u >> 5) & 3; c = u & 31; }
template <bool PASSC> __device__ __forceinline__ void load_in(Frame& F, int u, In& in, const float* BC) {
    int b, h, c; decode(u, b, h, c);
    const bf16* pr = F.R1 + (size_t)(b * SEQ + 64 * c + F.lane) * NAB;
    in.kk = *(const u32x4*)(pr + C_KB + h * 64 + 8 * F.wave);
    if (PASSC) { in.qq = *(const u32x4*)(pr + C_QB + h * 64 + 8 * F.wave);
        const float* bp = BC + ((size_t)u * 64 + F.lane) * 64 + 8 * F.wave; in.b0 = *(const f32x4*)bp; in.b1 = *(const f32x4*)(bp + 4); }
    else { in.g0 = *(const u32x4*)(pr + C_GL); in.g1 = *(const u32x4*)(pr + C_GL + 8); }
}
template <bool NEEDOG> __device__ __forceinline__ void dma_in(Frame& F, int u, int buf, const unsigned (&dvo)[2]) {
    int b, h, c; decode(u, b, h, c);
    const bf16* P = F.R1 + (size_t)(b * SEQ + 64 * c) * NAB;
    att::tile_dma(P + C_VB + h * 128, dvo, F.lds + L_V + buf * 16384, F.wave);
    if (NEEDOG) att::tile_dma(P + C_OG + h * 128, dvo, F.lds + L_OG + buf * 16384, F.wave);
}
__device__ __forceinline__ void stage_wl(Frame& F, int h) {
    LAS float* wl = (LAS float*)(F.lds + L_WL);
#pragma unroll
    for (int i = 0; i < 2; ++i) { const int e = F.tid + 512 * i, r = e >> 6, d = e & 63; wl[e] = F.w_gate_up[r * 256 + h * 64 + d]; }
}
__device__ __forceinline__ void unpack8(const u32x4 v, float (&f)[8]) {
#pragma unroll
    for (int i = 0; i < 4; ++i) { f[2 * i] = __uint_as_float(v[i] << 16); f[2 * i + 1] = __uint_as_float(v[i] & 0xffff0000u); }
}
__device__ __forceinline__ void gate_scan(Frame& F, int h, const float (&gl)[16], float (&bc)[8], float (&blast)[8]) {
    const int lane = F.lane, d0 = 8 * F.wave;
    const LAS float* wl = (const LAS float*)(F.lds + L_WL);
    float acc[8];
#pragma unroll
    for (int i = 0; i < 8; ++i) acc[i] = F.b_gate[h * 64 + d0 + i];
#pragma unroll
    for (int r = 0; r < 16; ++r) { const f32x4 w0 = *(const LAS f32x4*)(wl + r * 64 + d0), w1 = *(const LAS f32x4*)(wl + r * 64 + d0 + 4);
#pragma unroll
        for (int i = 0; i < 4; ++i) { acc[i] = fmaf(gl[r], w0[i], acc[i]); acc[4 + i] = fmaf(gl[r], w1[i], acc[4 + i]); } }
#pragma unroll
    for (int i = 0; i < 8; ++i) { float v = (fminf(acc[i], 0.f) - __logf(1.0f + __expf(-fabsf(acc[i])))) * (1.0f / 16.0f);
#pragma unroll
        for (int off = 1; off < 64; off <<= 1) { const float u = __shfl_up(v, off); if (lane >= off) v += u; }
        bc[i] = v; blast[i] = __shfl(v, 63); }
}
__device__ __forceinline__ void pass_a(Frame& F, float* GU, float* DEC, float* BC) {
    const int lane = F.lane, w = F.wave, hi = lane >> 5, r32 = lane & 31;
    att::FragOff fo; att::frag_off_init(fo, lane);
    unsigned dvo[2]; att::dma_off_init(dvo, NAB, w, lane);
    const int et = w >> 1, dt = w & 1, va_et = att::frag_va(lane, et);
    int u = F.vcu; if (u >= BATCH * 4 * 32) return;
    In cur, nxt; int hprev = -1;
    dma_in<false>(F, u, 0, dvo); load_in<false>(F, u, cur, BC);
    for (int it = 0; u < BATCH * 4 * 32; ++it, u += F.G) {
        int b, h, c; decode(u, b, h, c);
        const int un = u + F.G; const bool more = un < BATCH * 4 * 32;
        if (h != hprev) { stage_wl(F, h); hprev = h; }
        asm volatile("s_waitcnt vmcnt(0) lgkmcnt(0)" ::: "memory");
        __syncthreads();
        float gl[16], kf[8];
        unpack8(cur.g0, (float(&)[8])gl[0]); unpack8(cur.g1, (float(&)[8])gl[8]); unpack8(cur.kk, kf);
        asm volatile("" ::: "memory");
        if (more) { dma_in<false>(F, un, (it + 1) & 1, dvo); load_in<false>(F, un, nxt, BC); }
        float bc[8], blast[8];
        gate_scan(F, h, gl, bc, blast);
        const int uid = u;
        { float* bp = BC + ((size_t)uid * 64 + lane) * 64 + 8 * w; *(f32x4*)bp = (f32x4){bc[0], bc[1], bc[2], bc[3]}; *(f32x4*)(bp + 4) = (f32x4){bc[4], bc[5], bc[6], bc[7]}; }
#pragma unroll
        for (int i = 0; i < 8; ++i) *(LAS bf16*)(F.lds + L_K + (8 * w + i) * KP + lane * 2) = (bf16)f2bf(kf[i] * __expf(blast[i] - bc[i]));
        if (lane == 0) {
#pragma unroll
            for (int i = 0; i < 8; ++i) DEC[(size_t)uid * 64 + 8 * w + i] = __expf(blast[i]); }
        asm volatile("s_waitcnt lgkmcnt(0)" ::: "memory");
        __syncthreads();
        const LAS unsigned char* vbuf = F.lds + L_V + (it & 1) * 16384;
        f32x16 acc;
#pragma unroll
        for (int r = 0; r < 16; ++r) acc[r] = 0.f;
#pragma unroll
        for (int kk = 0; kk < 4; ++kk) {
            const LAS unsigned char* kp = F.lds + L_K + (32 * dt + r32) * KP + (16 * kk + 4 * hi) * 2;
            const unsigned long long lo = *(const LAS unsigned long long*)kp, hh = *(const LAS unsigned long long*)(kp + 16);
            u32x4 bw; bw.x = (unsigned)lo; bw.y = (unsigned)(lo >> 32); bw.z = (unsigned)hh; bw.w = (unsigned)(hh >> 32);
            acc = __builtin_amdgcn_mfma_f32_32x32x16_bf16(att::v_frag_rt(vbuf, va_et, fo.vd, kk), __builtin_bit_cast(bf16x8, bw), acc, 0, 0, 0);
        }
        float* gu = GU + (size_t)uid * 8192;
#pragma unroll
        for (int r = 0; r < 16; ++r) gu[(32 * et + att::crow(r, hi)) * 64 + 32 * dt + r32] = acc[r];
        cur = nxt;
    }
    __syncthreads();
}
__device__ __forceinline__ void pass_b(Frame& F, float* GU, const float* DEC) {
    for (int idx = F.vcu * NTHR + F.tid; idx < 64 * 128 * 16; idx += F.G * NTHR) {
        const int bh = idx >> 11, e = (idx >> 4) & 127, dq = idx & 15;
        f32x4 S = (f32x4){0.f, 0.f, 0.f, 0.f};
        for (int c0 = 0; c0 < 32; c0 += 8) {
            f32x4 U[8], dec[8];
#pragma unroll
            for (int i = 0; i < 8; ++i) { const size_t uid = (size_t)bh * 32 + c0 + i; U[i] = *(const f32x4*)(GU + (uid * 128 + e) * 64 + 4 * dq); dec[i] = *(const f32x4*)(DEC + uid * 64 + 4 * dq); }
#pragma unroll
            for (int i = 0; i < 8; ++i) { const size_t uid = (size_t)bh * 32 + c0 + i; *(f32x4*)(GU + (uid * 128 + e) * 64 + 4 * dq) = S; S = dec[i] * S + U[i]; }
        }
    }
}
__device__ __forceinline__ void pass_c(Frame& F, const float* GU, const float* BC) {
    const int lane = F.lane, w = F.wave, hi = lane >> 5, r32 = lane & 31, tid = F.tid;
    LAS unsigned char* lds = F.lds;
    att::FragOff fo; att::frag_off_init(fo, lane);
    unsigned dvo[2]; att::dma_off_init(dvo, NAB, w, lane);
    const int et = w >> 1, tt = w & 1, tl = 32 * tt + r32, va_et = att::frag_va(lane, et);
    int u = F.vcu; if (u >= BATCH * 4 * 32) return;
    In cur, nxt;
    dma_in<true>(F, u, 0, dvo); load_in<true>(F, u, cur, BC);
    for (int it = 0; u < BATCH * 4 * 32; ++it, u += F.G) {
        int b, h, c; decode(u, b, h, c);
        const int un = u + F.G; const bool more = un < BATCH * 4 * 32;
        asm volatile("s_waitcnt vmcnt(0) lgkmcnt(0)" ::: "memory");
        __syncthreads();
        float kf[8], qf[8], bc[8];
        unpack8(cur.kk, kf); unpack8(cur.qq, qf);
#pragma unroll
        for (int i = 0; i < 4; ++i) { bc[i] = cur.b0[i]; bc[4 + i] = cur.b1[i]; }
        asm volatile("" ::: "memory");
        if (more) { dma_in<true>(F, un, (it + 1) & 1, dvo); load_in<true>(F, un, nxt, BC); }
        f32x4 sf[8];
        { const float* gs = GU + ((size_t)u * 128 + 32 * et + r32) * 64;
#pragma unroll
          for (int ks = 0; ks < 4; ++ks) { sf[2 * ks] = *(const f32x4*)(gs + 16 * ks + 8 * hi); sf[2 * ks + 1] = *(const f32x4*)(gs + 16 * ks + 8 * hi + 4); } }
        { float eq[8], ek[8];
#pragma unroll
          for (int i = 0; i < 8; ++i) { eq[i] = qf[i] * 0.125f * __expf(bc[i]); ek[i] = kf[i] * __expf(-bc[i]); }
          *(LAS bf16x8*)(lds + L_Q + lane * KP + 16 * w) = att::pack8(eq[0], eq[1], eq[2], eq[3], eq[4], eq[5], eq[6], eq[7]);
          *(LAS bf16x8*)(lds + L_K + lane * KP + 16 * w) = att::pack8(ek[0], ek[1], ek[2], ek[3], ek[4], ek[5], ek[6], ek[7]); }
        asm volatile("s_waitcnt lgkmcnt(0)" ::: "memory");
        __syncthreads();
        const LAS unsigned char* vbuf = lds + L_V + (it & 1) * 16384; const LAS unsigned char* ogbuf = lds + L_OG + (it & 1) * 16384;
        bf16x8 qfr[4];
#pragma unroll
        for (int ks = 0; ks < 4; ++ks) qfr[ks] = *(const LAS bf16x8*)(lds + L_Q + tl * KP + (16 * ks + 8 * hi) * 2);
        f32x16 p0, p1;
#pragma unroll
        for (int r = 0; r < 16; ++r) { p0[r] = 0.f; p1[r] = 0.f; }
#pragma unroll
        for (int ks = 0; ks < 4; ++ks) {
            const bf16x8 a0 = *(const LAS bf16x8*)(lds + L_K + r32 * KP + (16 * ks + 8 * hi) * 2), a1 = *(const LAS bf16x8*)(lds + L_K + (32 + r32) * KP + (16 * ks + 8 * hi) * 2);
            p0 = __builtin_amdgcn_mfma_f32_32x32x16_bf16(a0, qfr[ks], p0, 0, 0, 0); p1 = __builtin_amdgcn_mfma_f32_32x32x16_bf16(a1, qfr[ks], p1, 0, 0, 0);
        }
        { const int tl4 = tl - 4 * hi;
#pragma unroll
          for (int r = 0; r < 16; ++r) { const int s = (r & 3) + 8 * (r >> 2); if (s > tl4) p0[r] = 0.f; if (s + 32 > tl4) p1[r] = 0.f; } }
        const bf16x8 pa0 = att::pack8(p0[0], p0[1], p0[2], p0[3], p0[4], p0[5], p0[6], p0[7]), pa1 = att::pack8(p0[8], p0[9], p0[10], p0[11], p0[12], p0[13], p0[14], p0[15]);
        const bf16x8 pa2 = att::pack8(p1[0], p1[1], p1[2], p1[3], p1[4], p1[5], p1[6], p1[7]), pa3 = att::pack8(p1[8], p1[9], p1[10], p1[11], p1[12], p1[13], p1[14], p1[15]);
        f32x16 acc;
#pragma unroll
        for (int r = 0; r < 16; ++r) acc[r] = 0.f;
        acc = __builtin_amdgcn_mfma_f32_32x32x16_bf16(att::v_frag_rt(vbuf, va_et, fo.vd, 0), pa0, acc, 0, 0, 0);
        acc = __builtin_amdgcn_mfma_f32_32x32x16_bf16(att::v_frag_rt(vbuf, va_et, fo.vd, 1), pa1, acc, 0, 0, 0);
        acc = __builtin_amdgcn_mfma_f32_32x32x16_bf16(att::v_frag_rt(vbuf, va_et, fo.vd, 2), pa2, acc, 0, 0, 0);
        acc = __builtin_amdgcn_mfma_f32_32x32x16_bf16(att::v_frag_rt(vbuf, va_et, fo.vd, 3), pa3, acc, 0, 0, 0);
#pragma unroll
        for (int ks = 0; ks < 4; ++ks) { const f32x4 s0 = sf[2 * ks], s1 = sf[2 * ks + 1];
            acc = __builtin_amdgcn_mfma_f32_32x32x16_bf16(att::pack8(s0[0], s0[1], s0[2], s0[3], s1[0], s1[1], s1[2], s1[3]), qfr[ks], acc, 0, 0, 0); }
        float ss = 0.f;
#pragma unroll
        for (int r = 0; r < 16; ++r) ss = fmaf(acc[r], acc[r], ss);
        ss += __shfl_xor(ss, 32);
        LAS float* part = (LAS float*)(lds + L_PART);
        if (hi == 0) part[et * 64 + tl] = ss;
        asm volatile("s_waitcnt lgkmcnt(0)" ::: "memory");
        __syncthreads();
        const float rs = rsqrtf(((part[tl] + part[64 + tl]) + (part[128 + tl] + part[192 + tl])) * (1.0f / 128.0f) + EPS);
#pragma unroll
        for (int g = 0; g < 4; ++g) {
            const int e0 = 32 * et + 8 * g + 4 * hi;
            const unsigned long long ow = *(const LAS unsigned long long*)(ogbuf + att::img_off(tl, 4 * et + g) + 8 * hi);
            const f32x4 gg = *(const f32x4*)(F.g_gla + e0);
            float y[4];
#pragma unroll
            for (int i = 0; i < 4; ++i) { const float og = __uint_as_float(((unsigned)(ow >> (16 * i)) & 0xffffu) << 16); y[i] = acc[4 * g + i] * rs * gg[i] * (og * __builtin_amdgcn_rcpf(1.0f + __expf(-og))); }
            *(LAS unsigned long long*)(lds + L_STG + tl * SP + e0 * 2) = (unsigned long long)pg8::cvt_pk_bf16(y[0], y[1]) | ((unsigned long long)pg8::cvt_pk_bf16(y[2], y[3]) << 32);
        }
        asm volatile("s_waitcnt lgkmcnt(0)" ::: "memory");
        __syncthreads();
#pragma unroll
        for (int i = 0; i < 2; ++i) { const int cidx = tid + 512 * i, row = cidx >> 4, ch = cidx & 15;
            *(u32x4*)(F.CAT + (size_t)(b * SEQ + 64 * c + row) * D + 512 + h * 128 + ch * 8) = *(const LAS u32x4*)(lds + L_STG + row * SP + ch * 16); }
        cur = nxt;
    }
    __syncthreads();
}
}
__device__ __forceinline__ void ph_rope_tables(Frame& F, float* R128, float* R64) {
    for (int i = F.vcu * NTHR + F.tid; i < SEQ * 24; i += F.G * NTHR) {
        const int pos = i / 24, k = i % 24;
        if (k < 16) { const float inv = powf(500000.0f, -(float)k * 2.0f / 32.0f), ang = (float)pos * inv; R128[pos * 32 + k] = cosf(ang); R128[pos * 32 + 16 + k] = sinf(ang); }
        else { const int j = k - 16; const float inv = powf(500000.0f, -(float)j * 2.0f / 16.0f), ang = (float)pos * inv; R64[pos * 16 + j] = cosf(ang); R64[pos * 16 + 8 + j] = sinf(ang); }
    }
}
__device__ __forceinline__ float dpp_xor1(float v) { return __builtin_bit_cast(float, __builtin_amdgcn_mov_dpp(__builtin_bit_cast(int, v), 0xB1, 0xF, 0xF, true)); }
__device__ __forceinline__ float dpp_xor2(float v) { return __builtin_bit_cast(float, __builtin_amdgcn_mov_dpp(__builtin_bit_cast(int, v), 0x4E, 0xF, 0xF, true)); }
__device__ __forceinline__ void ph_prep_c_fast(Frame& F) {
    const int gw = F.vcu * NWAVES + F.wave, NGW = F.G * NWAVES, lane = F.lane;
    const float* gn = (lane < 32 ? F.gq_c : F.gk_c) + (lane & 3) * 32;
    const float sc = lane < 32 ? att::C2 : 1.0f;
    float g[32];
#pragma unroll
    for (int i = 0; i < 8; ++i) { const f32x4 v = *(const f32x4*)(gn + 4 * i); g[4 * i] = v[0] * sc; g[4 * i + 1] = v[1] * sc; g[4 * i + 2] = v[2] * sc; g[4 * i + 3] = v[3] * sc; }
    for (int tok = gw; tok < M; tok += NGW) {
        att::u32x4* p = (att::u32x4*)(F.R1 + (size_t)tok * NC + lane * 32);
        att::u32x4 v[4]; float f[32]; float ss = 0.f;
#pragma unroll
        for (int i = 0; i < 4; ++i) v[i] = p[i];
#pragma unroll
        for (int i = 0; i < 4; ++i)
#pragma unroll
            for (int j = 0; j < 4; ++j) { const float a = __uint_as_float(v[i][j] << 16), b = __uint_as_float(v[i][j] & 0xffff0000u); f[8 * i + 2 * j] = a; f[8 * i + 2 * j + 1] = b; ss = fmaf(a, a, fmaf(b, b, ss)); }
        ss += dpp_xor1(ss); ss += dpp_xor2(ss);
        const float rs = rsqrtf(ss * (1.f / 128.f) + EPS);
#pragma unroll
        for (int i = 0; i < 4; ++i) { att::u32x4 o;
#pragma unroll
            for (int j = 0; j < 4; ++j) o[j] = pg8::cvt_pk_bf16(f[8 * i + 2 * j] * rs * g[8 * i + 2 * j], f[8 * i + 2 * j + 1] * rs * g[8 * i + 2 * j + 1]);
            p[i] = o; }
    }
}
__device__ __forceinline__ void ph_prep_a_fast(Frame& F, const float* R128, const float* R64) {
    const int gw = F.vcu * NWAVES + F.wave, NGW = F.G * NWAVES, lane = F.lane, l8 = lane & 7;
    const float* gn = (lane < 32 ? F.gq_a : F.gk_a) + l8 * 16;
    const float sc = lane < 32 ? att::C2 : 1.0f;
    float g[16];
#pragma unroll
    for (int i = 0; i < 4; ++i) { const f32x4 v = *(const f32x4*)(gn + 4 * i); g[4 * i] = v[0] * sc; g[4 * i + 1] = v[1] * sc; g[4 * i + 2] = v[2] * sc; g[4 * i + 3] = v[3] * sc; }
    for (int tok = gw; tok < M; tok += NGW) {
        const int pos = tok & (SEQ - 1);
        bf16* pr = F.R1 + (size_t)tok * NAB;
        {   att::u32x4* p = (att::u32x4*)(pr + lane * 16);
            const att::u32x4 v0 = p[0], v1 = p[1]; float f[16]; float ss = 0.f;
#pragma unroll
            for (int j = 0; j < 4; ++j) { f[2 * j] = __uint_as_float(v0[j] << 16); f[2 * j + 1] = __uint_as_float(v0[j] & 0xffff0000u); f[8 + 2 * j] = __uint_as_float(v1[j] << 16); f[8 + 2 * j + 1] = __uint_as_float(v1[j] & 0xffff0000u); }
#pragma unroll
            for (int i = 0; i < 16; ++i) ss = fmaf(f[i], f[i], ss);
            ss += dpp_xor1(ss); ss += dpp_xor2(ss); ss += __shfl_xor(ss, 4);
            const float rs = rsqrtf(ss * (1.f / 128.f) + EPS);
#pragma unroll
            for (int i = 0; i < 16; ++i) f[i] = f[i] * rs * g[i];
            const float* cs = R128 + pos * 32;
#pragma unroll
            for (int i = 0; i < 16; ++i) { const float other = dpp_xor1(f[i]);
                if (l8 < 2) { const float c = cs[i], s = cs[16 + i]; f[i] = (l8 == 0) ? f[i] * c - other * s : f[i] * c + other * s; } }
            att::u32x4 o0, o1;
#pragma unroll
            for (int j = 0; j < 4; ++j) { o0[j] = pg8::cvt_pk_bf16(f[2 * j], f[2 * j + 1]); o1[j] = pg8::cvt_pk_bf16(f[8 + 2 * j], f[8 + 2 * j + 1]); }
            p[0] = o0; p[1] = o1;
        }
        {
#pragma unroll
            for (int part = 0; part < 2; ++part) {
                if (part == 1 && lane >= 8) break;
                att::u32x4* p = (att::u32x4*)(pr + (part == 0 ? C_IQ + lane * 8 : C_IK + lane * 8));
                const att::u32x4 v0 = p[0]; float f[8];
#pragma unroll
                for (int j = 0; j < 4; ++j) { f[2 * j] = __uint_as_float(v0[j] << 16); f[2 * j + 1] = __uint_as_float(v0[j] & 0xffff0000u); }
                const float* cs = R64 + pos * 16;
#pragma unroll
                for (int i = 0; i < 8; ++i) { const float other = dpp_xor1(f[i]);
                    if (l8 < 2) { const float c = cs[i], s = cs[8 + i]; f[i] = (l8 == 0) ? f[i] * c - other * s : f[i] * c + other * s; } }
                att::u32x4 o0;
#pragma unroll
                for (int j = 0; j < 4; ++j) o0[j] = pg8::cvt_pk_bf16(f[2 * j], f[2 * j + 1]);
                p[0] = o0;
            }
        }
    }
}
#ifndef MK_PER_PHASE
#define MK_PER_PHASE 0
#endif
constexpr int NPH = 14;
struct Args { const float* in[16]; float* out; unsigned char* ws; int ph_lo, ph_hi; };
__global__ void __launch_bounds__(NTHR, 2) mk_fwd(Args args) {
    extern __shared__ __attribute__((aligned(16))) unsigned char lds[];
    Frame F;
    F.lds = (LAS unsigned char*)lds;
    F.MISC = (volatile LAS unsigned*)(F.lds + MISC_OFF);
#ifdef PROBE_TOTAL
    const unsigned long long pt_start = __builtin_amdgcn_s_memrealtime();
#endif
    F.wave = __builtin_amdgcn_readfirstlane((int)threadIdx.x >> 6);
#define RELANE() (F.lane = lane_id_opaque(), F.tid = F.wave * 64 + F.lane, true)
    RELANE();
#ifdef PROBE_ACC
    F.acc_t0 = 0ull; F.acc_sum = 0ull;
#endif
    F.G = gridDim.x; { const int bx = blockIdx.x; F.vcu = (F.G % 8 == 0) ? (bx % 8) * (F.G / 8) + bx / 8 : bx; }
    unsigned char* ws = args.ws;
    F.ctl = (gu32*)(ws + WS_CTL);
    F.x = args.in[0]; F.g_mix = args.in[1]; F.g_ffn = args.in[2]; F.w_in_ab = args.in[3]; F.gq_a = args.in[4]; F.gk_a = args.in[5]; F.w_gate_up = args.in[6]; F.b_gate = args.in[7];
    F.g_gla = args.in[8]; F.w_out_ab = args.in[9]; F.w_in_c = args.in[10]; F.gq_c = args.in[11]; F.gk_c = args.in[12]; F.w_out_c = args.in[13]; F.w_up = args.in[14]; F.w_down = args.in[15];
    F.out = args.out;
    F.Wab = (bf16*)(ws + WS_WAB); F.Woab = (bf16*)(ws + WS_WOAB); F.Wup0 = (bf16*)(ws + WS_WUP0); F.Wdn0 = (bf16*)(ws + WS_WDN0);
    F.Winc = (bf16*)(ws + WS_WINC); F.Woc = (bf16*)(ws + WS_WOC); F.Wup1 = (bf16*)(ws + WS_WUP1); F.Wdn1 = (bf16*)(ws + WS_WDN1);
    F.XB = (bf16*)(ws + WS_XB); F.CAT = (bf16*)(ws + WS_CAT); F.R1 = (bf16*)(ws + WS_R1); F.SSQ = (float*)(ws + WS_SSQ); F.MASK = (unsigned*)(ws + WS_MASK);
    for (int u = F.tid; u < (LDS_BYTES - MISC_OFF) / 4; u += NTHR) ((LAS unsigned*)(F.lds + MISC_OFF))[u] = 0u;
    __syncthreads();
    XcdBarrier bar; bar.bar = (unsigned*)(F.ctl + CW_BAR); bar.x = 0; bar.st = nullptr; bar.wave = F.wave;
    if (!MK_PER_PHASE) bar = xcd_barrier_post((unsigned*)(F.ctl + CW_BAR), F.MISC + 8, F.wave);
    const int lo = args.ph_lo, hi = args.ph_hi;
#ifdef PROBE_PH
    unsigned long long pt0 = 0ull, pt1 = 0ull;
#define STAMP(k) do { if ((k) == PROBE_PH) pt0 = __builtin_amdgcn_s_memrealtime(); if ((k) == PROBE_PH + 1) pt1 = __builtin_amdgcn_s_memrealtime(); } while (0)
#ifdef PROBE_SUB
#define SUBSTAMP(k) do { if ((k) == PROBE_PH) { __syncthreads(); pt0 = __builtin_amdgcn_s_memrealtime(); } } while (0)
#else
#define SUBSTAMP(k) do { } while (0)
#endif
#else
#define STAMP(k) do { } while (0)
#define SUBSTAMP(k) do { } while (0)
#endif
#define IN(k) (lo <= (k) && (k) < hi && RELANE())
#ifdef PROBE_DBLBAR
#define SEAM(k) do { if (lo <= (k) && (k) + 1 < hi) { xcd_barrier(bar); xcd_barrier(bar); } } while (0)
#else
#define SEAM(k) do { if (lo <= (k) && (k) + 1 < hi) xcd_barrier(bar); } while (0)
#endif
    float* const SSQ0 = F.SSQ, *SSQ1 = F.SSQ + (size_t)M * 16, *SSQ2 = F.SSQ + (size_t)2 * M * 16, *SSQ3 = F.SSQ + (size_t)3 * M * 16;
    typedef pg8::StaticOrder SO;
    STAMP(0); float* const R128 = (float*)(ws + WS_ROPE); float* const R64 = R128 + SEQ * 32;
    if (IN(0)) { ph_prologue(F); ph_rope_tables(F, R128, R64); } SEAM(0);
    STAMP(1); if (IN(1)) { pg8::Gemm g{F.XB, F.Wab, M, NAB, D}; SO S; S.init(M, NAB, F.G, (int)blockIdx.x); pg8::EpiProjAB E{F.R1, NAB, SSQ0, F.gq_a, F.gk_a, R128, R64, (LAS float*)(F.lds + RING_BYTES), att::C2};
        pg8::gemm_phase<pg8::EpiProjAB, SO, true, true>(F.lds, g, S, E, F.wave);
        if (F.G == 256 && blockIdx.x >= 128) { RELANE(); prologue_weights<1>(F, ((int)blockIdx.x - 128) * NWAVES + F.wave, 128 * NWAVES); } } SEAM(1);
    float* const GU = (float*)(ws + WS_XB); float* const DEC = (float*)(ws + WS_DEC);
    STAMP(2); if (IN(2)) { SUBSTAMP(2); gla::pass_a(F, GU, DEC, (float*)(ws + WS_BC)); } SEAM(2);
    STAMP(3); if (IN(3)) { gla::pass_b(F, GU, DEC); SUBSTAMP(3); ph_indexer(F); } SEAM(3);
    STAMP(4); if (IN(4)) { ph_dsa(F); SUBSTAMP(4); gla::pass_c(F, GU, (const float*)(ws + WS_BC)); } SEAM(4);
    STAMP(5); if (IN(5)) { pg8::Gemm g{F.CAT, F.Woab, M, D, D}; SO S; S.init(M, D, F.G, (int)blockIdx.x); pg8::EpiResid<0, 0> E{F.x, nullptr, F.XB, SSQ1, nullptr};
        pg8::gemm_phase<pg8::EpiResid<0, 0>, SO, true, true>(F.lds, g, S, E, F.wave); } SEAM(5);
    STAMP(6); if (IN(6)) { pg8::Gemm g{F.XB, F.Wup0, M, FF, D}; SO S; S.init(M, FF, F.G, (int)blockIdx.x); pg8::EpiScale<1> E{F.R1, FF, SSQ1};
        pg8::gemm_phase<pg8::EpiScale<1>, SO, true, true>(F.lds, g, S, E, F.wave); } SEAM(6);
    STAMP(7); if (IN(7)) { pg8::Gemm g{F.R1, F.Wdn0, M, D, FF}; SO S; S.init(M, D, F.G, (int)blockIdx.x); pg8::EpiResid<1, 0> E{F.XB, nullptr, F.XB, SSQ2, SSQ1};
        pg8::gemm_phase<pg8::EpiResid<1, 0>, SO, true, true>(F.lds, g, S, E, F.wave); } SEAM(7);
    STAMP(8); if (IN(8)) { pg8::Gemm g{F.XB, F.Winc, M, NC, D}; SO S; S.init(M, NC, F.G, (int)blockIdx.x); pg8::EpiQKNorm E{F.R1, NC, SSQ2, F.gq_c, F.gk_c, (LAS float*)(F.lds + RING_BYTES), att::C2};
        pg8::gemm_phase<pg8::EpiQKNorm, SO, true, true>(F.lds, g, S, E, F.wave); } SEAM(8);
    STAMP(9);
    STAMP(10); if (IN(10)) { ph_sb(F); } SEAM(10);
    STAMP(11); if (IN(11)) { pg8::Gemm g{F.CAT, F.Woc, M, D, D}; SO S; S.init(M, D, F.G, (int)blockIdx.x); pg8::EpiResid<1, 0> E{F.XB, nullptr, F.XB, SSQ3, nullptr};
        pg8::gemm_phase<pg8::EpiResid<1, 0>, SO, true, true>(F.lds, g, S, E, F.wave); } SEAM(11);
    STAMP(12); if (IN(12)) { pg8::Gemm g{F.XB, F.Wup1, M, FF, D}; SO S; S.init(M, FF, F.G, (int)blockIdx.x); pg8::EpiScale<1> E{F.R1, FF, SSQ3};
        pg8::gemm_phase<pg8::EpiScale<1>, SO, true, true>(F.lds, g, S, E, F.wave); } SEAM(12);
    STAMP(13); if (IN(13)) { pg8::Gemm g{F.R1, F.Wdn1, M, D, FF}; SO S; S.init(M, D, F.G, (int)blockIdx.x); pg8::EpiResid<1, 1> E{F.XB, F.out, nullptr, nullptr, SSQ3};
        pg8::gemm_phase<pg8::EpiResid<1, 1>, SO, true, true>(F.lds, g, S, E, F.wave); }
    STAMP(NPH);
#ifdef PROBE_TOTAL
    if (blockIdx.x == 0) { const unsigned long long t1 = __builtin_amdgcn_s_memrealtime(), dt = (t1 - pt_start); while (__builtin_amdgcn_s_memrealtime() - t1 < dt) __builtin_amdgcn_s_sleep(8); }
#endif
#ifdef PROBE_ACC
    if (blockIdx.x == 0) { const unsigned long long t1 = __builtin_amdgcn_s_memrealtime(), dt = F.acc_sum * PROBE_MULT; while (__builtin_amdgcn_s_memrealtime() - t1 < dt) __builtin_amdgcn_s_sleep(8); }
#endif
#ifdef PROBE_PH
    if (blockIdx.x == 0) { const unsigned long long t1 = __builtin_amdgcn_s_memrealtime(), dt = (pt1 - pt0) * PROBE_MULT; while (__builtin_amdgcn_s_memrealtime() - t1 < dt) __builtin_amdgcn_s_sleep(8); }
#endif
#undef IN
#undef SEAM
}

extern "C" void kernel_launch(void* const* d_in, const int* in_sizes, int n_in, void* d_out, int out_size, void* d_ws, size_t ws_size, hipStream_t stream) {
    static int grid = 0;
    if (grid == 0) {
        if (n_in != 16 || in_sizes[0] != M * D || out_size != M * D || ws_size < WS_END) { fprintf(stderr, "kernel_launch: unexpected shapes / workspace (%d inputs, ws %zu)\n", n_in, ws_size); grid = -1; return; }
        int dev = 0, cus = 0;
        if (hipGetDevice(&dev) != hipSuccess || hipDeviceGetAttribute(&cus, hipDeviceAttributeMultiprocessorCount, dev) != hipSuccess) { grid = -1; return; }
        if (hipFuncSetAttribute((const void*)mk_fwd, hipFuncAttributeMaxDynamicSharedMemorySize, LDS_BYTES) != hipSuccess) { fprintf(stderr, "kernel_launch: hipFuncSetAttribute failed\n"); grid = -1; return; }
        (void)hipGetLastError();
        grid = cus;
    }
    if (grid < 0) return;
    if (hipMemsetAsync((char*)d_ws + WS_CTL, 0, CTL_ZERO_BYTES, stream) != hipSuccess) { fprintf(stderr, "kernel_launch: memset failed\n"); return; }
    Args a{};
    for (int i = 0; i < 16; ++i) a.in[i] = (const float*)d_in[i];
    a.out = (float*)d_out; a.ws = (unsigned char*)d_ws;
#if MK_PER_PHASE
    for (int ph = 0; ph < NPH; ++ph) { a.ph_lo = ph; a.ph_hi = ph + 1; hipLaunchKernelGGL(mk_fwd, dim3(grid), dim3(NTHR), LDS_BYTES, stream, a); }
#else
    a.ph_lo = 0; a.ph_hi = NPH;
    hipLaunchKernelGGL(mk_fwd, dim3(grid), dim3(NTHR), LDS_BYTES, stream, a);
#endif
    const hipError_t le = hipPeekAtLastError();
    if (le != hipSuccess) fprintf(stderr, "kernel_launch: launch failed: %s\n", hipGetErrorName(le));
}
```

```cpp
#include <hip/hip_runtime.h>
#include <cstdio>
#include <cstdint>
namespace pg8 {
#define PG8_LAS __attribute__((address_space(3)))
typedef unsigned short bf16_t;
typedef short bf16x8 __attribute__((ext_vector_type(8)));
typedef float f32x4 __attribute__((ext_vector_type(4)));
typedef unsigned u32x4 __attribute__((ext_vector_type(4)));
constexpr int BM = 256, BK = 64, HALF = 128, HTB = HALF * BK * 2  , STAGE_BYTES = 8 * HTB, NXCD = 8, WGM = 8;

__host__ __device__ __forceinline__ int lds_byte(int r, int c) { const int st = (r >> 4) * 2 + (c >> 5), rr = r & 15, cc = c & 31, ob = rr * 64 + cc * 2; return st * 1024 + (ob ^ (((ob >> 9) & 1) << 5)); }
__host__ __device__ __forceinline__ void stage_rc(int b, int& R, int& C) { const int st = b / 1024, sb = b % 1024, swz = sb ^ (((sb >> 9) & 1) << 5); R = (st >> 1) * 16 + swz / 64; C = (st & 1) * 32 + (swz % 64) / 2; }
__host__ __device__ __forceinline__ int perm32(int rho) { const int n = rho >> 4, i = rho & 15; return 8 * (i >> 2) + 4 * n + (i & 3); }

struct Unit { int pm, pn; };
struct Gemm { const bf16_t* A; const bf16_t* Bt; int M, N, K; };

struct StaticOrder {
    int nM, nN, nwg, G, c;
    __host__ __device__ void init(int M, int N, int G_, int c_) { nM = M / BM; nN = N / BM; nwg = nM * nN; G = G_; c = c_; }
    __host__ __device__ bool next(int i, Unit& u) const {
        const long L = (long)i * G + c; if (L >= nwg) return false;
        int wgid = (int)L; { const int q = nwg / NXCD, r = nwg % NXCD, xcd = wgid % NXCD, off = wgid / NXCD; wgid = (xcd < r ? xcd * (q + 1) : r * (q + 1) + (xcd - r) * q) + off; }
        const int nig = WGM * nN, gid = wgid / nig, fm = gid * WGM, gsz = (nM - fm) < WGM ? (nM - fm) : WGM;
        u.pm = fm + ((wgid % nig) % gsz); u.pn = (wgid % nig) / gsz; return true;
    }
    __device__ __forceinline__ void a_ready(const Unit&) const {}
    __device__ __forceinline__ void done(const Unit&) const {}
};

__device__ __forceinline__ unsigned cvt_pk_bf16(float lo, float hi) { unsigned r; asm volatile("v_cvt_pk_bf16_f32 %0, %1, %2" : "=v"(r) : "v"(lo), "v"(hi)); return r; }
__device__ __forceinline__ float row_rstd(const float* ssqp, int row) {
    const f32x4* p = (const f32x4*)(ssqp + (size_t)row * 16);
    const f32x4 a = p[0], b = p[1], c = p[2], d = p[3];
    const float s = (((a[0] + a[1]) + (a[2] + a[3])) + ((b[0] + b[1]) + (b[2] + b[3]))) + (((c[0] + c[1]) + (c[2] + c[3])) + ((d[0] + d[1]) + (d[2] + d[3])));
    return rsqrtf(s * (1.0f / 1024.0f) + 1e-6f);
}
template <int ACT  > struct EpiScale {
    static constexpr bool PERM = true, AFTER_DRAIN = false;
    bf16_t* O; int ldc; const float* ssqp;
    __device__ __forceinline__ void operator()(const f32x4 (&acc)[2][2][4][2], const Unit& u, int wr, int wc, int fr, int fq) const {
        const int row0 = u.pm * BM + wr * 64 + fr, col0 = u.pn * BM + wc * 32 + 8 * fq;
#pragma unroll
        for (int ai = 0; ai < 2; ++ai)
#pragma unroll
            for (int m = 0; m < 4; ++m) {
                const int row = row0 + ai * HALF + m * 16;
                const float rs = (ACT == 0) ? row_rstd(ssqp, row) : 1.0f;
                bf16_t* rowp = O + (size_t)row * ldc + col0;
#pragma unroll
                for (int bj = 0; bj < 2; ++bj) {
                    f32x4 v0 = acc[ai][bj][m][0] * rs, v1 = acc[ai][bj][m][1] * rs;
                    if (ACT == 1) {
#pragma unroll
                        for (int e = 0; e < 4; ++e) { const float a0 = fmaxf(v0[e], 0.f), a1 = fmaxf(v1[e], 0.f); v0[e] = a0 * a0; v1[e] = a1 * a1; }
                    }
                    u32x4 w; w.x = cvt_pk_bf16(v0[0], v0[1]); w.y = cvt_pk_bf16(v0[2], v0[3]); w.z = cvt_pk_bf16(v1[0], v1[1]); w.w = cvt_pk_bf16(v1[2], v1[3]);
                    *(u32x4*)(rowp + bj * HALF) = w;
                }
            }
    }
};
template <int RIN, int OUT> struct EpiResid {
    static constexpr bool PERM = true, AFTER_DRAIN = false;
    const void* R; float* out; bf16_t* hb; float* ssqp; const float* ssq_in;
    __device__ __forceinline__ void operator()(const f32x4 (&acc)[2][2][4][2], const Unit& u, int wr, int wc, int fr, int fq) const {
        const int row0 = u.pm * BM + wr * 64 + fr, col0 = u.pn * BM + wc * 32 + 8 * fq;
        constexpr int MB = 2;
        constexpr int NW = (RIN == 0) ? 2 : 1;
#pragma unroll
        for (int ai = 0; ai < 2; ++ai)
#pragma unroll
            for (int m0 = 0; m0 < 4; m0 += MB) {
                u32x4 rw[MB][2][NW]; f32x4 pp[MB][4];
#pragma unroll
                for (int mm = 0; mm < MB; ++mm)
#pragma unroll
                    for (int bj = 0; bj < 2; ++bj) { const unsigned off = (unsigned)((row0 + ai * HALF + (m0 + mm) * 16) * 1024 + col0 + bj * HALF);
                        if (RIN == 0) { rw[mm][bj][0] = *(const u32x4*)((const char*)R + off * 4u); rw[mm][bj][NW - 1] = *(const u32x4*)((const char*)R + off * 4u + 16u); }
                        else rw[mm][bj][0] = *(const u32x4*)((const char*)R + off * 2u); }
                if (ssq_in) {
#pragma unroll
                    for (int mm = 0; mm < MB; ++mm) { const f32x4* p = (const f32x4*)((const char*)ssq_in + (unsigned)(row0 + ai * HALF + (m0 + mm) * 16) * 64u);
#pragma unroll
                        for (int k = 0; k < 4; ++k) pp[mm][k] = p[k]; } }
                asm volatile("" ::: "memory");
#pragma unroll
                for (int mm = 0; mm < MB; ++mm) {
                    const int m = m0 + mm, row = row0 + ai * HALF + m * 16;
                    const unsigned off = (unsigned)(row * 1024 + col0);
                    float sc2 = 1.0f;
                    if (ssq_in) { const f32x4 a = pp[mm][0], b = pp[mm][1], c = pp[mm][2], d = pp[mm][3];
                        const float sum = (((a[0] + a[1]) + (a[2] + a[3])) + ((b[0] + b[1]) + (b[2] + b[3]))) + (((c[0] + c[1]) + (c[2] + c[3])) + ((d[0] + d[1]) + (d[2] + d[3])));
                        const float rs = rsqrtf(sum * (1.0f / 1024.0f) + 1e-6f); sc2 = rs * rs; }
                    float ss = 0.f;
#pragma unroll
                    for (int bj = 0; bj < 2; ++bj) {
                        f32x4 r0, r1;
                        if (RIN == 0) { r0 = __builtin_bit_cast(f32x4, rw[mm][bj][0]); r1 = __builtin_bit_cast(f32x4, rw[mm][bj][NW - 1]); }
                        else { const u32x4 w = rw[mm][bj][0];
                            r0 = (f32x4){__uint_as_float(w.x << 16), __uint_as_float(w.x & 0xffff0000u), __uint_as_float(w.y << 16), __uint_as_float(w.y & 0xffff0000u)};
                            r1 = (f32x4){__uint_as_float(w.z << 16), __uint_as_float(w.z & 0xffff0000u), __uint_as_float(w.w << 16), __uint_as_float(w.w & 0xffff0000u)}; }
                        const f32x4 v0 = acc[ai][bj][m][0] * sc2 + r0, v1 = acc[ai][bj][m][1] * sc2 + r1;
                        if (OUT == 1) { *(f32x4*)((char*)out + (off + bj * HALF) * 4u) = v0; *(f32x4*)((char*)out + (off + bj * HALF) * 4u + 16u) = v1; }
                        else {
                            u32x4 w; w.x = cvt_pk_bf16(v0[0], v0[1]); w.y = cvt_pk_bf16(v0[2], v0[3]); w.z = cvt_pk_bf16(v1[0], v1[1]); w.w = cvt_pk_bf16(v1[2], v1[3]);
                            *(u32x4*)((char*)hb + (off + bj * HALF) * 2u) = w;
                            ss += ((v0[0] * v0[0] + v0[1] * v0[1]) + (v0[2] * v0[2] + v0[3] * v0[3])) + ((v1[0] * v1[0] + v1[1] * v1[1]) + (v1[2] * v1[2] + v1[3] * v1[3]));
                        }
                    }
                    if (OUT == 0) { ss += __shfl_xor(ss, 16); ss += __shfl_xor(ss, 32); if (fq == 0) *(float*)((char*)ssqp + (unsigned)(row * 16 + u.pn * 4 + wc) * 4u) = ss; }
                }
            }
    }
};
struct EpiQKNorm {
    static constexpr bool PERM = true, AFTER_DRAIN = false;
    bf16_t* O; int ldc; const float* ssqp; const float* gq; const float* gk; PG8_LAS float* part; float qscale;
    __device__ __forceinline__ void operator()(const f32x4 (&acc)[2][2][4][2], const Unit& u, int wr, int wc, int fr, int fq) const {
        const int row0 = u.pm * BM + wr * 64 + fr, col0 = u.pn * BM + wc * 32 + 8 * fq;
        const bool nrm = u.pn < 8;
        f32x4 g0 = (f32x4){1.f, 1.f, 1.f, 1.f}, g1 = g0;
        if (nrm) {
#pragma unroll
            for (int ai = 0; ai < 2; ++ai)
#pragma unroll
                for (int m = 0; m < 4; ++m)
#pragma unroll
                    for (int bj = 0; bj < 2; ++bj) { const f32x4 v0 = acc[ai][bj][m][0], v1 = acc[ai][bj][m][1];
                        float ss = ((v0[0] * v0[0] + v0[1] * v0[1]) + (v0[2] * v0[2] + v0[3] * v0[3])) + ((v1[0] * v1[0] + v1[1] * v1[1]) + (v1[2] * v1[2] + v1[3] * v1[3]));
                        ss += __shfl_xor(ss, 16); ss += __shfl_xor(ss, 32);
                        if (fq == 0) part[((ai * HALF + wr * 64 + m * 16 + fr) * 2 + bj) * 4 + wc] = ss; }
            asm volatile("s_waitcnt lgkmcnt(0)" ::: "memory"); __builtin_amdgcn_s_barrier(); asm volatile("" ::: "memory");
            const float* gp = (u.pn < 4 ? gq : gk) + wc * 32 + 8 * fq; const float sc = (u.pn < 4) ? qscale : 1.0f;
            g0 = *(const f32x4*)gp * sc; g1 = *(const f32x4*)(gp + 4) * sc;
        }
#pragma unroll
        for (int ai = 0; ai < 2; ++ai)
#pragma unroll
            for (int m = 0; m < 4; ++m) {
                const int row = row0 + ai * HALF + m * 16;
                const float rsr = row_rstd(ssqp, row);
                bf16_t* rowp = O + (size_t)row * ldc + col0;
#pragma unroll
                for (int bj = 0; bj < 2; ++bj) {
                    float hs = rsr;
                    if (nrm) { const f32x4 pp = *(const PG8_LAS f32x4*)(part + ((ai * HALF + wr * 64 + m * 16 + fr) * 2 + bj) * 4);
                        hs *= rsqrtf(((pp[0] + pp[1]) + (pp[2] + pp[3])) * (rsr * rsr * (1.0f / 128.0f)) + 1e-6f); }
                    const f32x4 v0 = acc[ai][bj][m][0] * hs * g0, v1 = acc[ai][bj][m][1] * hs * g1;
                    u32x4 w; w.x = cvt_pk_bf16(v0[0], v0[1]); w.y = cvt_pk_bf16(v0[2], v0[3]); w.z = cvt_pk_bf16(v1[0], v1[1]); w.w = cvt_pk_bf16(v1[2], v1[3]);
                    *(u32x4*)(rowp + bj * HALF) = w;
                }
            }
    }
};
struct EpiProjAB {
    static constexpr bool PERM = true, AFTER_DRAIN = false;
    bf16_t* O; int ldc; const float* ssqp; const float* gq; const float* gk; const float* r128; const float* r64; PG8_LAS float* part; float qscale;
    __device__ __forceinline__ void operator()(const f32x4 (&acc)[2][2][4][2], const Unit& u, int wr, int wc, int fr, int fq) const {
        const int row0 = u.pm * BM + wr * 64 + fr, col0 = u.pn * BM + wc * 32 + 8 * fq, pn = u.pn;
        const bool qk = pn < 4, iq = (pn == 6) || (pn == 7) || (pn == 14);
        const bool rope_qk = qk && (wc == 0), rope_iq = iq && !(wc & 1) && (pn != 14 || wc == 0);
        f32x4 g0 = (f32x4){1.f, 1.f, 1.f, 1.f}, g1 = g0;
        if (qk) {
#pragma unroll
            for (int ai = 0; ai < 2; ++ai)
#pragma unroll
                for (int m = 0; m < 4; ++m)
#pragma unroll
                    for (int bj = 0; bj < 2; ++bj) { const f32x4 v0 = acc[ai][bj][m][0], v1 = acc[ai][bj][m][1];
                        float ss = ((v0[0] * v0[0] + v0[1] * v0[1]) + (v0[2] * v0[2] + v0[3] * v0[3])) + ((v1[0] * v1[0] + v1[1] * v1[1]) + (v1[2] * v1[2] + v1[3] * v1[3]));
                        ss += __shfl_xor(ss, 16); ss += __shfl_xor(ss, 32);
                        if (fq == 0) part[((ai * HALF + wr * 64 + m * 16 + fr) * 2 + bj) * 4 + wc] = ss; }
            asm volatile("s_waitcnt lgkmcnt(0)" ::: "memory"); __builtin_amdgcn_s_barrier(); asm volatile("" ::: "memory");
            const float* gp = (pn < 2 ? gq : gk) + wc * 32 + 8 * fq; const float sc = (pn < 2) ? qscale : 1.0f;
            g0 = *(const f32x4*)gp * sc; g1 = *(const f32x4*)(gp + 4) * sc;
        }
#pragma unroll
        for (int ai = 0; ai < 2; ++ai)
#pragma unroll
            for (int m = 0; m < 4; ++m) {
                const int row = row0 + ai * HALF + m * 16, pos = row & 2047;
                const float rsr = row_rstd(ssqp, row);
                bf16_t* rowp = O + (size_t)row * ldc + col0;
                f32x4 c0 = (f32x4){1.f, 1.f, 1.f, 1.f}, c1 = c0, s0 = (f32x4){0.f, 0.f, 0.f, 0.f}, s1 = s0;
                if (rope_qk) { const float* t = r128 + pos * 32 + 8 * (fq & 1); c0 = *(const f32x4*)t; c1 = *(const f32x4*)(t + 4); s0 = *(const f32x4*)(t + 16); s1 = *(const f32x4*)(t + 20); }
                else if (rope_iq) { const float* t = r64 + pos * 16; c0 = *(const f32x4*)t; c1 = *(const f32x4*)(t + 4); s0 = *(const f32x4*)(t + 8); s1 = *(const f32x4*)(t + 12); }
#pragma unroll
                for (int bj = 0; bj < 2; ++bj) {
                    float hs = rsr;
                    if (qk) { const f32x4 pp = *(const PG8_LAS f32x4*)(part + ((ai * HALF + wr * 64 + m * 16 + fr) * 2 + bj) * 4);
                        hs *= rsqrtf(((pp[0] + pp[1]) + (pp[2] + pp[3])) * (rsr * rsr * (1.0f / 128.0f)) + 1e-6f); }
                    f32x4 v0 = acc[ai][bj][m][0] * hs * g0, v1 = acc[ai][bj][m][1] * hs * g1;
                    if (rope_qk) {
                        f32x4 p0, p1;
#pragma unroll
                        for (int e = 0; e < 4; ++e) { p0[e] = __shfl_xor(v0[e], 32); p1[e] = __shfl_xor(v1[e], 32); }
                        if (fq < 2) { v0 = v0 * c0 - p0 * s0; v1 = v1 * c1 - p1 * s1; } else { v0 = v0 * c0 + p0 * s0; v1 = v1 * c1 + p1 * s1; }
                    } else if (rope_iq && (pn != 14 || bj == 0)) {
                        f32x4 p0, p1;
#pragma unroll
                        for (int e = 0; e < 4; ++e) { p0[e] = __shfl_xor(v0[e], 16); p1[e] = __shfl_xor(v1[e], 16); }
                        if (fq == 0) { v0 = v0 * c0 - p0 * s0; v1 = v1 * c1 - p1 * s1; } else if (fq == 1) { v0 = v0 * c0 + p0 * s0; v1 = v1 * c1 + p1 * s1; }
                    }
                    u32x4 w; w.x = cvt_pk_bf16(v0[0], v0[1]); w.y = cvt_pk_bf16(v0[2], v0[3]); w.z = cvt_pk_bf16(v1[0], v1[1]); w.w = cvt_pk_bf16(v1[2], v1[3]);
                    *(u32x4*)(rowp + bj * HALF) = w;
                }
            }
    }
};
template <class Epi, class Sched, bool ALIGN_EPI = false, bool SP2 = false>
__device__ __forceinline__ void gemm_phase(PG8_LAS unsigned char* lds, const Gemm g, const Sched& S, const Epi& E, const int wave_in) {
    const int wid = wave_in, lane = (int)__builtin_amdgcn_mbcnt_hi(~0u, __builtin_amdgcn_mbcnt_lo(~0u, 0u)), tid = wid * 64 + lane, wr = wid >> 2, wc = wid & 3, fr = lane & 15, fq = lane >> 4;
    const int K = g.K, nt = K / BK;
    unsigned voffA[2], voffB[2];
#pragma unroll
    for (int i = 0; i < 2; ++i) { int R, C; stage_rc(tid * 16 + i * 8192, R, C); const int Rb = Epi::PERM ? ((R & ~31) + perm32(R & 31)) : R;
        voffA[i] = (unsigned)(R * K + C) * 2u; voffB[i] = (unsigned)(Rb * K + C) * 2u; }
    const size_t kstep = (size_t)(BK * 2);
    const size_t hstep = (size_t)HALF * K * 2;
    const size_t tstep = 2 * hstep;
    const unsigned ldsw = (unsigned)wid * 1024u;
    const int aoff = lds_byte(wr * 64 + fr, fq * 8), boff = lds_byte(wc * 32 + fr, fq * 8);
#define PG8_SA(b, h) (((b) * 2 + (h)) * HTB)
#define PG8_SB(b, h) ((4 + (b) * 2 + (h)) * HTB)
#define PG8_STAGE(bufoff, gbase, voff) do { _Pragma("unroll") for (int _i = 0; _i < 2; ++_i) \
        __builtin_amdgcn_global_load_lds((const unsigned*)((const char*)(gbase) + (voff)[_i]), (PG8_LAS unsigned*)(lds + (bufoff) + ldsw + _i * 8192), 16, 0, 0); } while (0)
#define PG8_LDA(dst, b, h) do { _Pragma("unroll") for (int m = 0; m < 4; ++m) _Pragma("unroll") for (int k = 0; k < 2; ++k) dst[m][k] = *(const PG8_LAS bf16x8*)(lds + PG8_SA(b, h) + aoff + m * 2048 + k * 1024); } while (0)
#define PG8_LDB(dst, b, h) do { _Pragma("unroll") for (int n = 0; n < 2; ++n) _Pragma("unroll") for (int k = 0; k < 2; ++k) dst[n][k] = *(const PG8_LAS bf16x8*)(lds + PG8_SB(b, h) + boff + n * 2048 + k * 1024); } while (0)
#define PG8_MMA(ai, bj, At, Bt) do { __builtin_amdgcn_s_setprio(1); _Pragma("unroll") for (int m = 0; m < 4; ++m) _Pragma("unroll") for (int n = 0; n < 2; ++n) _Pragma("unroll") for (int k = 0; k < 2; ++k) \
        acc[ai][bj][m][n] = __builtin_amdgcn_mfma_f32_16x16x32_bf16(Bt[n][k], At[m][k], acc[ai][bj][m][n], 0, 0, 0); __builtin_amdgcn_s_setprio(0); } while (0)
#define PG8_WAIT_V(n) asm volatile("s_waitcnt vmcnt(" #n ")" ::: "memory")
#define PG8_WAIT_L(n) asm volatile("s_waitcnt lgkmcnt(" #n ")" ::: "memory")
#define PG8_BAR __builtin_amdgcn_s_barrier()
#define PG8_SCHED __builtin_amdgcn_sched_barrier(0)
    Unit cur, nxt; int ui = 0;
    if (!S.next(0, cur)) return;
    f32x4 acc[2][2][4][2];
#pragma unroll
    for (int a = 0; a < 2; ++a)
#pragma unroll
        for (int b = 0; b < 2; ++b)
#pragma unroll
            for (int m = 0; m < 4; ++m)
#pragma unroll
                for (int n = 0; n < 2; ++n) acc[a][b][m][n] = (f32x4){0.f, 0.f, 0.f, 0.f};
    bf16x8 At[4][2], B0[2][2], B1[2][2];
    const char* cA = (const char*)g.A + (size_t)cur.pm * tstep; const char* cB = (const char*)g.Bt + (size_t)cur.pn * tstep;
    S.a_ready(cur);
    if constexpr (SP2) {
        PG8_STAGE(PG8_SB(0, 0), cB, voffB); PG8_STAGE(PG8_SB(0, 1), cB + hstep, voffB); PG8_STAGE(PG8_SA(0, 0), cA, voffA); PG8_STAGE(PG8_SA(0, 1), cA + hstep, voffA);
        if (wr == 1) PG8_BAR;
        PG8_WAIT_V(2); PG8_BAR;
        PG8_STAGE(PG8_SB(1, 0), cB + kstep, voffB); PG8_STAGE(PG8_SA(1, 0), cA + kstep, voffA); PG8_STAGE(PG8_SB(1, 1), cB + hstep + kstep, voffB);
        PG8_WAIT_V(6); PG8_BAR;
    } else {
        PG8_STAGE(PG8_SB(0, 0), cB, voffB); PG8_STAGE(PG8_SA(0, 0), cA, voffA); PG8_STAGE(PG8_SB(0, 1), cB + hstep, voffB); PG8_STAGE(PG8_SA(0, 1), cA + hstep, voffA);
        if (wr == 1) PG8_BAR;
        PG8_WAIT_V(4); PG8_BAR;
        PG8_STAGE(PG8_SB(1, 0), cB + kstep, voffB); PG8_STAGE(PG8_SA(1, 0), cA + kstep, voffA); PG8_STAGE(PG8_SB(1, 1), cB + hstep + kstep, voffB);
        PG8_WAIT_V(6); PG8_BAR;
    }
    for (;;) {
        const bool has_next = S.next(ui + 1, nxt);
        const char* nA = has_next ? (const char*)g.A + (size_t)nxt.pm * tstep : cA; const char* nB = has_next ? (const char*)g.Bt + (size_t)nxt.pn * tstep : cB;
        for (int t = 0; t < nt; t += 2) {
            const bool last = (t == nt - 2);
            const char* a1 = cA + (size_t)(t + 1) * kstep;
            const char* a2 = last ? nA : cA + (size_t)(t + 2) * kstep; const char* b2 = last ? nB : cB + (size_t)(t + 2) * kstep;
            const char* a3 = a2 + kstep; const char* b3 = b2 + kstep;
            if (last && has_next) S.a_ready(nxt);
            if constexpr (SP2) {
            PG8_LDB(B0, 0, 0); PG8_LDB(B1, 0, 1); PG8_SCHED; PG8_LDA(At, 0, 0); PG8_STAGE(PG8_SA(1, 1), a1 + hstep, voffA);
            PG8_WAIT_V(8); PG8_WAIT_L(0); PG8_BAR; PG8_MMA(0, 0, At, B0); PG8_MMA(0, 1, At, B1); PG8_BAR; PG8_SCHED;
            PG8_LDA(At, 0, 1); PG8_STAGE(PG8_SB(0, 0), b2, voffB); PG8_STAGE(PG8_SB(0, 1), b2 + hstep, voffB); PG8_STAGE(PG8_SA(0, 0), a2, voffA);
            PG8_WAIT_V(8); PG8_WAIT_L(0); PG8_BAR; PG8_MMA(1, 0, At, B0); PG8_MMA(1, 1, At, B1); PG8_BAR; PG8_SCHED;
            PG8_LDB(B0, 1, 0); PG8_LDB(B1, 1, 1); PG8_SCHED; PG8_LDA(At, 1, 0); PG8_STAGE(PG8_SA(0, 1), a2 + hstep, voffA);
            PG8_WAIT_V(8); PG8_WAIT_L(0); PG8_BAR; PG8_MMA(0, 0, At, B0); PG8_MMA(0, 1, At, B1); PG8_BAR; PG8_SCHED;
            PG8_LDA(At, 1, 1); PG8_STAGE(PG8_SB(1, 0), b3, voffB); PG8_STAGE(PG8_SB(1, 1), b3 + hstep, voffB); PG8_STAGE(PG8_SA(1, 0), a3, voffA);
            PG8_WAIT_V(8); PG8_WAIT_L(0); PG8_BAR; PG8_MMA(1, 0, At, B0); PG8_MMA(1, 1, At, B1); PG8_BAR; PG8_SCHED;
            } else {
            PG8_LDB(B0, 0, 0); PG8_SCHED; PG8_LDA(At, 0, 0); PG8_STAGE(PG8_SA(1, 1), a1 + hstep, voffA);
            PG8_WAIT_L(8); PG8_BAR; PG8_WAIT_L(0); PG8_MMA(0, 0, At, B0); PG8_BAR; PG8_SCHED;
            PG8_LDB(B1, 0, 1); PG8_STAGE(PG8_SB(0, 0), b2, voffB);
            PG8_BAR; PG8_WAIT_L(0); PG8_MMA(0, 1, At, B1); PG8_BAR;
            PG8_LDA(At, 0, 1); PG8_STAGE(PG8_SA(0, 0), a2, voffA);
            PG8_BAR; PG8_WAIT_L(0); PG8_MMA(1, 0, At, B0); PG8_BAR; PG8_SCHED;
            PG8_STAGE(PG8_SB(0, 1), b2 + hstep, voffB);
            PG8_WAIT_V(6); PG8_BAR; PG8_MMA(1, 1, At, B1); PG8_BAR;
            PG8_LDB(B0, 1, 0); PG8_SCHED; PG8_LDA(At, 1, 0); PG8_STAGE(PG8_SA(0, 1), a2 + hstep, voffA);
            PG8_WAIT_L(8); PG8_BAR; PG8_WAIT_L(0); PG8_MMA(0, 0, At, B0); PG8_BAR; PG8_SCHED;
            PG8_LDB(B1, 1, 1); PG8_STAGE(PG8_SB(1, 0), b3, voffB);
            PG8_BAR; PG8_WAIT_L(0); PG8_MMA(0, 1, At, B1); PG8_BAR;
            PG8_LDA(At, 1, 1); PG8_STAGE(PG8_SA(1, 0), a3, voffA);
            PG8_BAR; PG8_WAIT_L(0); PG8_MMA(1, 0, At, B0); PG8_BAR; PG8_SCHED;
            PG8_STAGE(PG8_SB(1, 1), b3 + hstep, voffB);
            PG8_WAIT_V(6); PG8_BAR; PG8_MMA(1, 1, At, B1); PG8_BAR;
            }
        }
        if constexpr (ALIGN_EPI) { if (wr == 0) PG8_BAR; }
        if constexpr (!Epi::AFTER_DRAIN) { E(acc, cur, wr, wc, fr, fq); S.done(cur); }
        if (!has_next) break;
#pragma unroll
        for (int a = 0; a < 2; ++a)
#pragma unroll
            for (int b = 0; b < 2; ++b)
#pragma unroll
                for (int m = 0; m < 4; ++m)
#pragma unroll
                    for (int n = 0; n < 2; ++n) acc[a][b][m][n] = (f32x4){0.f, 0.f, 0.f, 0.f};
        cur = nxt; cA = nA; cB = nB; ++ui;
        if constexpr (ALIGN_EPI) { if (wr == 1) PG8_BAR; }
    }
    PG8_WAIT_V(0);
    if constexpr (!ALIGN_EPI) { if (wr == 0) PG8_BAR; }
    PG8_BAR;
    if constexpr (Epi::AFTER_DRAIN) { E.fused(acc, cur, wr, wc, fr, fq, lds, wid, lane); S.done(cur); }
#undef PG8_SA
#undef PG8_SB
#undef PG8_STAGE
#undef PG8_LDA
#undef PG8_LDB
#undef PG8_MMA
#undef PG8_WAIT_V
#undef PG8_WAIT_L
#undef PG8_BAR
#undef PG8_SCHED
}
}
#include <cmath>
constexpr int NWAVES = 8, NTHR = 512;
constexpr int BATCH = 16, SEQ = 2048, M = BATCH * SEQ, D = 1024, FF = 4096, NAB = 3840, NC = 3072, ABP_OLD = 3672;
constexpr int C_QA = 0, C_KA = 512, C_VA = 1024, C_IQ = 1536, C_QB = 2048, C_KB = 2304, C_VB = 2560, C_OG = 3072, C_IK = 3584, C_IW = 3648, C_GL = 3656;
constexpr float EPS = 1e-6f;
constexpr size_t MiB = 1u << 20;
constexpr size_t WS_CTL = 0, CTL_ZERO_BYTES = 64 * 1024;
constexpr size_t WS_WAB = 1 * MiB, WS_WOAB = 9 * MiB, WS_WUP0 = 11 * MiB, WS_WDN0 = 19 * MiB, WS_WINC = 27 * MiB, WS_WOC = 33 * MiB, WS_WUP1 = 35 * MiB, WS_WDN1 = 43 * MiB;
constexpr size_t WS_SSQ = 51 * MiB, SSQ_BYTES = 2 * MiB;
constexpr size_t WS_DEC = 59 * MiB;
constexpr size_t WS_ROPE = 59 * MiB + 512 * 1024;
constexpr size_t WS_XB = 60 * MiB;
constexpr size_t WS_CAT = 124 * MiB;
constexpr size_t WS_MASK = 188 * MiB;
constexpr size_t WS_R1 = 196 * MiB;
constexpr size_t WS_BC = 452 * MiB;
constexpr size_t WS_END = 484 * MiB;
constexpr int CW_BAR = 4096;
constexpr int RING_BYTES = 131072;
constexpr int LDS_BYTES = 163840;
constexpr int MISC_OFF = LDS_BYTES - 256;
#define GAS __attribute__((address_space(1)))
#define LAS __attribute__((address_space(3)))
typedef unsigned short bf16;
typedef unsigned v4u __attribute__((ext_vector_type(4)));
typedef float f32x4 __attribute__((ext_vector_type(4)));
typedef short bf16x8 __attribute__((ext_vector_type(8)));
typedef GAS unsigned gu32;
typedef GAS unsigned long long gu64;
#define RLX_AGENT __ATOMIC_RELAXED, __HIP_MEMORY_SCOPE_AGENT
#define LDS_WAIT() asm volatile("s_waitcnt lgkmcnt(0)" ::: "memory")
#define VM_WAIT() asm volatile("s_waitcnt vmcnt(0)" ::: "memory")
__device__ __forceinline__ unsigned long long rt() { return __builtin_amdgcn_s_memrealtime(); }
__device__ __forceinline__ unsigned f2bf(float f) { unsigned u = __builtin_bit_cast(unsigned, f); return (u + 0x7fffu + ((u >> 16) & 1u)) >> 16; }
__device__ __forceinline__ unsigned pk2(float lo, float hi) { return f2bf(lo) | (f2bf(hi) << 16); }
#define XB_TMO      128
#define XB_XCNT(j)  (256  + 64 * (j))
#define XB_XSUB(j)  (1280 + 64 * (j))
#define XB_XGEN(j)  (2304 + 64 * (j))
#define XB_TOP      3328
#define XB_TOPGEN   3392
#define XCD_BAR_WORDS 3456
#define XB_SPIN_CAP (1u << 18)

__device__ __forceinline__ unsigned xb_ld(unsigned* p)              { return __hip_atomic_load(p, __ATOMIC_RELAXED, __HIP_MEMORY_SCOPE_AGENT); }
__device__ __forceinline__ unsigned xb_add(unsigned* p, unsigned v) { return __hip_atomic_fetch_add(p, v, __ATOMIC_RELAXED, __HIP_MEMORY_SCOPE_AGENT); }
__device__ __forceinline__ unsigned xb_xcc_id() { return (unsigned)__builtin_amdgcn_s_getreg((3 << 11) | 20) & 0xFu; }
#define XB_SPIN(cond, bar) do { unsigned _sp = 0; while (cond) { __builtin_amdgcn_s_sleep(1); \
    if ((++_sp & 255u) == 0u) { if (xb_ld(&(bar)[XB_TMO])) break; if (_sp > XB_SPIN_CAP) { atomicAdd(&(bar)[XB_TMO], 1u); break; } } } } while (0)

struct XcdBarrier {
    unsigned* bar; unsigned x; int wave;
    volatile LAS unsigned* st;
};

__device__ __forceinline__ bool xb_t0(int wave) { return wave == 0 && __builtin_amdgcn_mbcnt_hi(~0u, __builtin_amdgcn_mbcnt_lo(~0u, 0u)) == 0u; }
__device__ __forceinline__ XcdBarrier xcd_barrier_post(unsigned* bar, volatile LAS unsigned* st, int wave) {
    XcdBarrier b; b.bar = bar; b.x = xb_xcc_id(); b.st = st; b.wave = wave;
    if (xb_t0(wave)) (void)xb_add(&bar[XB_XCNT(b.x)], 1u);
    return b;
}
__device__ __forceinline__ void xcd_barrier_complete(unsigned* bar, unsigned x, unsigned& nloc, unsigned& nx) {
    const unsigned G = gridDim.x * gridDim.y * gridDim.z;
    unsigned sum, cnt, mine, sp = 0u;
    for (;;) {
        sum = 0u; cnt = 0u; mine = 0u;
#pragma unroll
        for (unsigned j = 0; j < 16; ++j) { const unsigned c = xb_ld(&bar[XB_XCNT(j)]); sum += c; cnt += (c > 0u) ? 1u : 0u; mine = (j == x) ? c : mine; }
        if (sum == G) break;
        __builtin_amdgcn_s_sleep(1);
        if ((++sp & 255u) == 0u) { if (xb_ld(&bar[XB_TMO])) break; if (sp > XB_SPIN_CAP) { atomicAdd(&bar[XB_TMO], 1u); break; } }
    }
    nloc = mine > 0u ? mine : 1u; nx = cnt > 0u ? cnt : 1u;
}

__device__ __forceinline__ void xcd_barrier(const XcdBarrier& b) {
    asm volatile("s_waitcnt vmcnt(0)" ::: "memory");
    __syncthreads();
    if (xb_t0(b.wave)) {
        unsigned* bar = b.bar;
        __builtin_amdgcn_s_waitcnt(0);
        unsigned nloc = b.st[0], nx = b.st[1];
        if (nloc == 0u) { xcd_barrier_complete(bar, b.x, nloc, nx); b.st[0] = nloc; b.st[1] = nx; }
        const unsigned old = xb_add(&bar[XB_XSUB(b.x)], 1u);
        const unsigned gen = old / nloc;
        if (old + 1u == (gen + 1u) * nloc) {
            __builtin_amdgcn_fence(__ATOMIC_RELEASE, "agent");
            asm volatile("s_waitcnt vmcnt(0)" ::: "memory");
            const unsigned og = xb_add(&bar[XB_TOP], 1u);
            const unsigned tg = og / nx;
            if (og + 1u == (tg + 1u) * nx) xb_add(&bar[XB_TOPGEN], 1u);
            else XB_SPIN(xb_ld(&bar[XB_TOPGEN]) == tg, bar);
            __builtin_amdgcn_fence(__ATOMIC_ACQUIRE, "agent");
            xb_add(&bar[XB_XGEN(b.x)], 1u);
            asm volatile("s_waitcnt vmcnt(0)" ::: "memory");
        } else {
            XB_SPIN(xb_ld(&bar[XB_XGEN(b.x)]) == gen, bar);
            __builtin_amdgcn_fence(__ATOMIC_ACQUIRE, "agent");
            asm volatile("s_waitcnt vmcnt(0)" ::: "memory");
        }
    }
    __syncthreads();
}
#ifdef PROBE_ACC
#define ACC_BEGIN(F, id) do { if ((id) == PROBE_ACC) { __syncthreads(); (F).acc_t0 = __builtin_amdgcn_s_memrealtime(); } } while (0)
#define ACC_END(F, id) do { if ((id) == PROBE_ACC) { __syncthreads(); (F).acc_sum += __builtin_amdgcn_s_memrealtime() - (F).acc_t0; } } while (0)
#else
#define ACC_BEGIN(F, id) do { } while (0)
#define ACC_END(F, id) do { } while (0)
#endif
struct Frame {
#ifdef PROBE_ACC
    unsigned long long acc_t0, acc_sum;
#endif
    LAS unsigned char* lds;
    volatile LAS unsigned* MISC;
    gu32* ctl;
    int tid, lane, wave, vcu, G;
    const float *x, *g_mix, *g_ffn, *w_in_ab, *gq_a, *gk_a, *w_gate_up, *b_gate, *g_gla, *w_out_ab, *w_in_c, *gq_c, *gk_c, *w_out_c, *w_up, *w_down;
    float* out;
    bf16 *Wab, *Woab, *Wup0, *Wdn0, *Winc, *Woc, *Wup1, *Wdn1;
    bf16 *XB, *CAT, *R1;
    float* SSQ; unsigned* MASK;
};
__device__ __forceinline__ int lane_id_opaque() { int l; asm volatile("v_mbcnt_lo_u32_b32 %0, -1, 0\n\tv_mbcnt_hi_u32_b32 %0, -1, %0" : "=v"(l)); return l; }
__device__ __forceinline__ float bf2f(bf16 v) { return __builtin_bit_cast(float, (unsigned)v << 16); }
__device__ __forceinline__ float wave_sum(float v) {
#pragma unroll
    for (int o = 1; o < 64; o <<= 1) v += __shfl_xor(v, o);
    return v;
}
__device__ __forceinline__ float wave_max(float v) {
#pragma unroll
    for (int o = 1; o < 64; o <<= 1) v = fmaxf(v, __shfl_xor(v, o));
    return v;
}
__device__ __forceinline__ float log_sigmoid(float x) { return fminf(x, 0.f) - log1pf(expf(-fabsf(x))); }

__device__ __forceinline__ int oldcol_ab(int n) {
    if (n < 2048) return n;
    if (n < 2304) return 2120 + (n - 2048);
    if (n < 2560) return 2376 + (n - 2304);
    if (n < 3072) return 2632 + (n - 2560);
    if (n < 3584) return 3160 + (n - 3072);
    if (n < 3648) return 2048 + (n - 3584);
    if (n < 3656) return 2112 + (n - 3648);
    if (n < 3672) return 3144 + (n - 3656);
    return -1;
}
__device__ __forceinline__ void p0_transpose_item(const float* W, int ldw, int K, const float* gain, bf16* WT, bool map, int item, int nblk, int lane) {
    const int kb = item / nblk, nb = item % nblk, ng = lane & 7, ko = lane >> 3, k0 = 64 * kb + 8 * ko, n = 32 * nb + 4 * ng;
    const int oc = map ? oldcol_ab(n) : n;
    f32x4 v[8];
#pragma unroll
    for (int i = 0; i < 8; ++i) { v[i] = (f32x4){0.f, 0.f, 0.f, 0.f}; if (oc >= 0) v[i] = *(const GAS f32x4*)(W + (size_t)(k0 + i) * ldw + oc); }
    if (gain) { const f32x4 g0 = *(const GAS f32x4*)(gain + k0), g1 = *(const GAS f32x4*)(gain + k0 + 4);
#pragma unroll
        for (int i = 0; i < 4; ++i) { v[i] = v[i] * g0[i]; v[4 + i] = v[4 + i] * g1[i]; } }
#pragma unroll
    for (int e = 0; e < 4; ++e) { v4u o; o.x = pk2(v[0][e], v[1][e]); o.y = pk2(v[2][e], v[3][e]); o.z = pk2(v[4][e], v[5][e]); o.w = pk2(v[6][e], v[7][e]);
        *(GAS v4u*)(WT + (size_t)(n + e) * K + k0) = o; }
}
template <int PART> __device__ __forceinline__ void prologue_weights(Frame& F, int gw, int NGW) {
    constexpr int I_AB = (D / 64) * (NAB / 32), I_O = (D / 64) * (D / 32), I_UP = (D / 64) * (FF / 32), I_DN = (FF / 64) * (D / 32), I_C = (D / 64) * (NC / 32);
    if (PART == 0) { for (int it = gw; it < I_AB; it += NGW) p0_transpose_item(F.w_in_ab, ABP_OLD, D, F.g_mix, F.Wab, true, it, NAB / 32, F.lane); return; }
    constexpr int NITEMS = 2 * I_O + 2 * I_UP + 2 * I_DN + I_C;
    for (int it = gw; it < NITEMS; it += NGW) {
        int r = it;
        if (r < I_O) { p0_transpose_item(F.w_out_ab, D, D, nullptr, F.Woab, false, r, D / 32, F.lane); continue; } r -= I_O;
        if (r < I_UP) { p0_transpose_item(F.w_up, FF, D, F.g_ffn, F.Wup0, false, r, FF / 32, F.lane); continue; } r -= I_UP;
        if (r < I_DN) { p0_transpose_item(F.w_down, D, FF, nullptr, F.Wdn0, false, r, D / 32, F.lane); continue; } r -= I_DN;
        if (r < I_C) { p0_transpose_item(F.w_in_c, NC, D, F.g_mix + D, F.Winc, false, r, NC / 32, F.lane); continue; } r -= I_C;
        if (r < I_O) { p0_transpose_item(F.w_out_c, D, D, nullptr, F.Woc, false, r, D / 32, F.lane); continue; } r -= I_O;
        if (r < I_UP) { p0_transpose_item(F.w_up + (size_t)D * FF, FF, D, F.g_ffn + D, F.Wup1, false, r, FF / 32, F.lane); continue; } r -= I_UP;
        p0_transpose_item(F.w_down + (size_t)FF * D, D, FF, nullptr, F.Wdn1, false, r, D / 32, F.lane);
    }
}
__device__ __forceinline__ void ph_prologue(Frame& F) {
    const int gw = F.vcu * NWAVES + F.wave, NGW = F.G * NWAVES;
    prologue_weights<0>(F, gw, NGW);
    if (F.G != 256) prologue_weights<1>(F, gw, NGW);
    for (int m0 = gw; m0 < M; m0 += 4 * NGW) {
        f32x4 v[4][4]; float s[4];
#pragma unroll
        for (int r = 0; r < 4; ++r) { const int m = m0 + r * NGW; const GAS f32x4* xr = (const GAS f32x4*)(F.x + (size_t)(m < M ? m : m0) * D) + F.lane;
#pragma unroll
            for (int j = 0; j < 4; ++j) v[r][j] = xr[64 * j]; }
#pragma unroll
        for (int r = 0; r < 4; ++r) { float t = 0.f;
#pragma unroll
            for (int j = 0; j < 4; ++j) t += (v[r][j].x * v[r][j].x + v[r][j].y * v[r][j].y) + (v[r][j].z * v[r][j].z + v[r][j].w * v[r][j].w);
            s[r] = t; }
#pragma unroll
        for (int o = 1; o < 64; o <<= 1) {
#pragma unroll
            for (int r = 0; r < 4; ++r) s[r] += __shfl_xor(s[r], o); }
#pragma unroll
        for (int r = 0; r < 4; ++r) { const int m = m0 + r * NGW; if (m < M) {
            GAS unsigned long long* o8 = (GAS unsigned long long*)(F.XB + (size_t)m * D) + F.lane;
#pragma unroll
            for (int j = 0; j < 4; ++j) o8[64 * j] = (unsigned long long)pk2(v[r][j].x, v[r][j].y) | ((unsigned long long)pk2(v[r][j].z, v[r][j].w) << 32);
            if (F.lane < 16) F.SSQ[(size_t)m * 16 + F.lane] = (F.lane == 0) ? s[r] : 0.f; } }
    }
}
namespace att {
typedef short s16x4 __attribute__((ext_vector_type(4)));
typedef float f32x16 __attribute__((ext_vector_type(16)));
typedef _Float16 f16x8 __attribute__((ext_vector_type(8)));
typedef unsigned u32x4 __attribute__((ext_vector_type(4)));
typedef short v4i16_t __attribute__((ext_vector_type(4)));
constexpr float C2 = 0.08838834764831845f * 1.4426950408889634f;
__device__ __forceinline__ int crow(int r, int hi) { return (r & 3) + 8 * (r >> 2) + 4 * hi; }
__device__ __forceinline__ int img_off(int row, int ch) { return 256 * row + 16 * (ch ^ (((row & 3) << 2) | ((row >> 2) & 3))); }
__device__ __forceinline__ bf16x8 pack8(float a0, float a1, float a2, float a3, float a4, float a5, float a6, float a7) {
    u32x4 w; w.x = pg8::cvt_pk_bf16(a0, a1); w.y = pg8::cvt_pk_bf16(a2, a3); w.z = pg8::cvt_pk_bf16(a4, a5); w.w = pg8::cvt_pk_bf16(a6, a7);
    return __builtin_bit_cast(bf16x8, w);
}
__device__ __forceinline__ f16x8 pack8h(float a0, float a1, float a2, float a3, float a4, float a5, float a6, float a7) {
    f16x8 r; r[0] = (_Float16)a0; r[1] = (_Float16)a1; r[2] = (_Float16)a2; r[3] = (_Float16)a3; r[4] = (_Float16)a4; r[5] = (_Float16)a5; r[6] = (_Float16)a6; r[7] = (_Float16)a7; return r;
}
__device__ __forceinline__ void dma_off_init(unsigned (&dvo)[2], int ld, int wave, int lane) {
#pragma unroll
    for (int i = 0; i < 2; ++i) { const int pi = 2 * wave + i, row = 4 * pi + (lane >> 4), pc = lane & 15, ch = pc ^ (((row & 3) << 2) | ((row >> 2) & 3)); dvo[i] = (unsigned)(row * ld + ch * 8) * 2u; }
}
__device__ __forceinline__ void tile_dma(const bf16* g, const unsigned (&dvo)[2], LAS unsigned char* buf, int wave) {
#pragma unroll
    for (int i = 0; i < 2; ++i) __builtin_amdgcn_global_load_lds((const unsigned*)((const char*)g + dvo[i]), (LAS unsigned*)(buf + 1024 * (2 * wave + i)), 16, 0, 0);
}
struct FragOff { int k[8]; int va[4]; int vd; };
__device__ __forceinline__ void frag_off_init(FragOff& fo, int lane) {
    const int hi = lane >> 5, r32 = lane & 31, i = lane & 15, q = i >> 2, p = i & 3, x = 2 * ((lane >> 4) & 1) + (p >> 1);
#pragma unroll
    for (int ks = 0; ks < 8; ++ks) fo.k[ks] = img_off(r32, 2 * ks + hi);
#pragma unroll
    for (int ct = 0; ct < 4; ++ct) fo.va[ct] = img_off(4 * hi + q, 4 * ct + x) + 8 * (p & 1);
    fo.vd = img_off(4 * hi + q + 8, x) - img_off(4 * hi + q, x);
}
__device__ __forceinline__ bf16x8 k_frag(const LAS unsigned char* kbuf, const FragOff& fo, int rt, int ks) { return *(const LAS bf16x8*)(kbuf + fo.k[ks] + 8192 * rt); }
__device__ __forceinline__ s16x4 vtr(const LAS unsigned char* p) { return __builtin_bit_cast(s16x4, __builtin_amdgcn_ds_read_tr16_b64_v4i16((LAS v4i16_t*)p)); }
__device__ __forceinline__ bf16x8 v_frag(const LAS unsigned char* vbuf, const FragOff& fo, int ct, int kk) {
    const s16x4 lo = vtr(vbuf + fo.va[ct] + 4096 * kk), hh = vtr(vbuf + fo.va[ct] + fo.vd + 4096 * kk);
    return (bf16x8){lo[0], lo[1], lo[2], lo[3], hh[0], hh[1], hh[2], hh[3]};
}
#define TR_READ(dst, addr, OFF) asm volatile("ds_read_b64_tr_b16 %0, %1 offset:%c2" : "=&v"(dst) : "v"(addr), "i"(OFF) : "memory")
#define LGKM_WAIT0() do { asm volatile("s_waitcnt lgkmcnt(0)" ::: "memory"); __builtin_amdgcn_sched_barrier(0); } while (0)
__device__ __forceinline__ bf16x8 mk_frag(s16x4 lo, s16x4 hh) { return (bf16x8){lo[0], lo[1], lo[2], lo[3], hh[0], hh[1], hh[2], hh[3]}; }
__device__ __forceinline__ int frag_va(int lane, int ct) { const int hi = lane >> 5, i = lane & 15, q = i >> 2, p = i & 3, x = 2 * ((lane >> 4) & 1) + (p >> 1); return img_off(4 * hi + q, 4 * ct + x) + 8 * (p & 1); }
__device__ __forceinline__ bf16x8 v_frag_rt(const LAS unsigned char* vbuf, int va, int vd, int kk) {
    const s16x4 lo = vtr(vbuf + va + 4096 * kk), hh = vtr(vbuf + va + vd + 4096 * kk);
    return (bf16x8){lo[0], lo[1], lo[2], lo[3], hh[0], hh[1], hh[2], hh[3]};
}
__device__ __forceinline__ void store_o(const f32x16 (&o)[4], const float (&rscale)[16], LAS unsigned char* stg, bf16* dst, int ld, int lane) {
    const int hi = lane >> 5, r32 = lane & 31;
#pragma unroll
    for (int r = 0; r < 16; ++r) { const int orow = crow(r, hi);
#pragma unroll
        for (int ct = 0; ct < 4; ++ct) *(LAS bf16*)(stg + orow * 256 + (32 * ct + r32) * 2) = (bf16)f2bf(o[ct][r] * rscale[r]); }
    asm volatile("s_waitcnt lgkmcnt(0)" ::: "memory");
#pragma unroll
    for (int i = 0; i < 8; ++i) { const int c = lane + 64 * i, row = c >> 4, ch = c & 15; const u32x4 v = *(const LAS u32x4*)(stg + row * 256 + ch * 16); *(u32x4*)(dst + (size_t)row * ld + ch * 8) = v; }
}
}
__device__ __forceinline__ void sb_unit(Frame& F, int b, int h, int qb) {
    using namespace att;
    const int tid = F.tid, lane = F.lane, w = F.wave, hi = lane >> 5, r32 = lane & 31;
    const bf16* Qg = F.R1 + (size_t)b * SEQ * NC + h * 128; const bf16* Kg = Qg + 1024; const bf16* Vg = Qg + 2048;
    const int T0 = qb * 256, t0w = T0 + 32 * w, jd = t0w >> 6, jtop = (T0 >> 6) + 3, tl = 32 * (w & 1) + r32, tl4 = tl - 4 * hi;
    LAS unsigned char* lds = F.lds;
    FragOff fo; frag_off_init(fo, lane);
    unsigned dvo[2]; dma_off_init(dvo, NC, w, lane);
    bf16x8 qf[8];
#pragma unroll
    for (int ks = 0; ks < 8; ++ks) qf[ks] = *(const bf16x8*)(Qg + (size_t)(t0w + r32) * NC + 16 * ks + 8 * hi);
    f16x8 T0f, T1f, ONEf;
#pragma unroll
    for (int j = 0; j < 8; ++j) { const int kp = 8 * (j >> 2) + 4 * hi + (j & 3); T0f[j] = (kp >= r32) ? (_Float16)1.0f : (_Float16)0.0f; T1f[j] = (kp + 16 >= r32) ? (_Float16)1.0f : (_Float16)0.0f; ONEf[j] = (_Float16)1.0f; }
    f32x16 o[4];
#pragma unroll
    for (int ct = 0; ct < 4; ++ct)
#pragma unroll
        for (int r = 0; r < 16; ++r) o[ct][r] = 0.f;
    float R2 = 0.f; bool done = false;
    volatile LAS unsigned* flags = F.MISC + 16;
    tile_dma(Kg + (size_t)(64 * jtop) * NC, dvo, lds, w); tile_dma(Vg + (size_t)(64 * jtop) * NC, dvo, lds + 16384, w);
    asm volatile("s_waitcnt vmcnt(0)" ::: "memory");
    __syncthreads();
    for (int j = jtop; j >= 0; --j) {
        const int cur = (jtop - j) & 1;
        const LAS unsigned char* kb = lds + cur * 32768; const LAS unsigned char* vb = kb + 16384;
        if (j > 0) { tile_dma(Kg + (size_t)(64 * (j - 1)) * NC, dvo, lds + (cur ^ 1) * 32768, w); tile_dma(Vg + (size_t)(64 * (j - 1)) * NC, dvo, lds + (cur ^ 1) * 32768 + 16384, w); }
        if (j <= jd && !done) {
            f32x16 p0, p1;
#pragma unroll
            for (int r = 0; r < 16; ++r) { p0[r] = 0.f; p1[r] = 0.f; }
            { bf16x8 kf[8];
#pragma unroll
              for (int ks = 0; ks < 8; ++ks) kf[ks] = k_frag(kb, fo, 0, ks);
#pragma unroll
              for (int ks = 0; ks < 8; ++ks) p0 = __builtin_amdgcn_mfma_f32_32x32x16_bf16(kf[ks], qf[ks], p0, 0, 0, 0);
#pragma unroll
              for (int ks = 0; ks < 8; ++ks) kf[ks] = k_frag(kb, fo, 1, ks);
#pragma unroll
              for (int ks = 0; ks < 8; ++ks) p1 = __builtin_amdgcn_mfma_f32_32x32x16_bf16(kf[ks], qf[ks], p1, 0, 0, 0); }
            s16x4 vl[4], vh[4], wl[4], wh[4];
            unsigned va0[4], va1[4];
#pragma unroll
            for (int ct = 0; ct < 4; ++ct) { va0[ct] = (unsigned)(size_t)vb + (unsigned)fo.va[ct]; va1[ct] = va0[ct] + (unsigned)fo.vd; }
            const bool diag = (j == jd);
            float x0[16], x1[16]; float rs = 0.f;
#pragma unroll
            for (int r = 0; r < 16; ++r) { const int key = (r & 3) + 8 * (r >> 2);
                float l0 = -__builtin_amdgcn_logf(1.0f + __builtin_amdgcn_exp2f(p0[r])), l1 = -__builtin_amdgcn_logf(1.0f + __builtin_amdgcn_exp2f(p1[r]));
                if (diag) { if (!(key < tl4)) l0 = 0.f; if (!(key + 32 < tl4)) l1 = 0.f; }
                x0[r] = l0; x1[r] = l1; rs += l0 + l1; p0[r] += R2; p1[r] += R2; }
            const f16x8 xb00 = pack8h(x0[0], x0[1], x0[2], x0[3], x0[4], x0[5], x0[6], x0[7]), xb01 = pack8h(x0[8], x0[9], x0[10], x0[11], x0[12], x0[13], x0[14], x0[15]);
            const f16x8 xb10 = pack8h(x1[0], x1[1], x1[2], x1[3], x1[4], x1[5], x1[6], x1[7]), xb11 = pack8h(x1[8], x1[9], x1[10], x1[11], x1[12], x1[13], x1[14], x1[15]);
            p0 = __builtin_amdgcn_mfma_f32_32x32x16_f16(T0f, xb00, p0, 0, 0, 0); p0 = __builtin_amdgcn_mfma_f32_32x32x16_f16(T1f, xb01, p0, 0, 0, 0);
            p0 = __builtin_amdgcn_mfma_f32_32x32x16_f16(ONEf, xb10, p0, 0, 0, 0); p0 = __builtin_amdgcn_mfma_f32_32x32x16_f16(ONEf, xb11, p0, 0, 0, 0);
            p1 = __builtin_amdgcn_mfma_f32_32x32x16_f16(T0f, xb10, p1, 0, 0, 0); p1 = __builtin_amdgcn_mfma_f32_32x32x16_f16(T1f, xb11, p1, 0, 0, 0);
#pragma unroll
            for (int r = 0; r < 16; ++r) { const int key = (r & 3) + 8 * (r >> 2);
                float a0 = __builtin_amdgcn_exp2f(p0[r]), a1 = __builtin_amdgcn_exp2f(p1[r]);
                if (diag) { if (!(key < tl4)) a0 = 0.f; if (!(key + 32 < tl4)) a1 = 0.f; }
                p0[r] = a0; p1[r] = a1; }
            const bf16x8 pa0 = pack8(p0[0], p0[1], p0[2], p0[3], p0[4], p0[5], p0[6], p0[7]), pa1 = pack8(p0[8], p0[9], p0[10], p0[11], p0[12], p0[13], p0[14], p0[15]);
            const bf16x8 pa2 = pack8(p1[0], p1[1], p1[2], p1[3], p1[4], p1[5], p1[6], p1[7]), pa3 = pack8(p1[8], p1[9], p1[10], p1[11], p1[12], p1[13], p1[14], p1[15]);
#pragma unroll
            for (int ct = 0; ct < 4; ++ct) { TR_READ(vl[ct], va0[ct], 0); TR_READ(vh[ct], va1[ct], 0); }
            LGKM_WAIT0();
#pragma unroll
            for (int ct = 0; ct < 4; ++ct) { TR_READ(wl[ct], va0[ct], 4096); TR_READ(wh[ct], va1[ct], 4096); }
#pragma unroll
            for (int ct = 0; ct < 4; ++ct) o[ct] = __builtin_amdgcn_mfma_f32_32x32x16_bf16(pa0, mk_frag(vl[ct], vh[ct]), o[ct], 0, 0, 0);
            LGKM_WAIT0();
#pragma unroll
            for (int ct = 0; ct < 4; ++ct) { TR_READ(vl[ct], va0[ct], 8192); TR_READ(vh[ct], va1[ct], 8192); }
#pragma unroll
            for (int ct = 0; ct < 4; ++ct) o[ct] = __builtin_amdgcn_mfma_f32_32x32x16_bf16(pa1, mk_frag(wl[ct], wh[ct]), o[ct], 0, 0, 0);
            LGKM_WAIT0();
#pragma unroll
            for (int ct = 0; ct < 4; ++ct) { TR_READ(wl[ct], va0[ct], 12288); TR_READ(wh[ct], va1[ct], 12288); }
#pragma unroll
            for (int ct = 0; ct < 4; ++ct) o[ct] = __builtin_amdgcn_mfma_f32_32x32x16_bf16(pa2, mk_frag(vl[ct], vh[ct]), o[ct], 0, 0, 0);
            LGKM_WAIT0();
#pragma unroll
            for (int ct = 0; ct < 4; ++ct) o[ct] = __builtin_amdgcn_mfma_f32_32x32x16_bf16(pa3, mk_frag(wl[ct], wh[ct]), o[ct], 0, 0, 0);
            rs += __shfl_xor(rs, 32);
            R2 += rs;
            done = __all(R2 < -152.0f);
        }
        if (lane == 0) flags[cur * 8 + w] = done ? 1u : 0u;
        asm volatile("s_waitcnt vmcnt(0) lgkmcnt(0)" ::: "memory");
        __syncthreads();
        unsigned alld = 1u;
#pragma unroll
        for (int i = 0; i < 8; ++i) alld &= flags[cur * 8 + i];
        if (alld) break;
    }
    float ones[16];
#pragma unroll
    for (int r = 0; r < 16; ++r) ones[r] = 1.0f;
    store_o(o, ones, lds + w * 8192, F.CAT + (size_t)(b * SEQ + t0w) * D + h * 128, D, lane);
    __syncthreads();
}
__device__ __forceinline__ void ph_sb(Frame& F) {
    for (int v = F.vcu; v < BATCH * 8 * 2; v += F.G) {
        const int bh = v >> 1, half = v & 1;
#pragma unroll 1
        for (int i = 0; i < 4; ++i) { const int qb = half ? (i == 0 ? 1 : i == 1 ? 6 : i == 2 ? 2 : 5) : (i == 0 ? 0 : i == 1 ? 7 : i == 2 ? 3 : 4); sb_unit(F, bh >> 3, bh & 7, qb); }
    }
}
__device__ __forceinline__ void dsa_unit(Frame& F, int b, int h, int ub, float mref) {
    using namespace att;
    const int lane = F.lane, w = F.wave, hi = lane >> 5, r32 = lane & 31;
    const bf16* Qg = F.R1 + (size_t)b * SEQ * NAB + C_QA + h * 128; const bf16* Kg = F.R1 + (size_t)b * SEQ * NAB + C_KA + h * 128; const bf16* Vg = F.R1 + (size_t)b * SEQ * NAB + C_VA + h * 128;
    const int t0w = 256 * ub + 32 * w, cw = t0w >> 6, jlast = 4 * ub + 3;
    LAS unsigned char* lds = F.lds;
    LAS unsigned char* mst = lds + 65536 + w * 8448;
    FragOff fo; frag_off_init(fo, lane);
    unsigned dvo[2]; dma_off_init(dvo, NAB, w, lane);
    tile_dma(Kg, dvo, lds, w); tile_dma(Vg, dvo, lds + 16384, w);
    bf16x8 qf[8];
#pragma unroll
    for (int ks = 0; ks < 8; ++ks) qf[ks] = *(const bf16x8*)(Qg + (size_t)(t0w + r32) * NAB + 16 * ks + 8 * hi);
    { const unsigned* mg = F.MASK + (size_t)(b * SEQ + t0w) * 64;
#pragma unroll 2
      for (int i = 0; i < 8; ++i) { const int c = lane + 64 * i, row = c >> 4, c4 = c & 15; const u32x4 v = *(const u32x4*)(mg + row * 64 + c4 * 4);
          *(LAS unsigned long long*)(mst + row * 264 + c4 * 16) = (unsigned long long)v.x | ((unsigned long long)v.y << 32);
          *(LAS unsigned long long*)(mst + row * 264 + c4 * 16 + 8) = (unsigned long long)v.z | ((unsigned long long)v.w << 32); } }
    f32x16 o[4];
#pragma unroll
    for (int ct = 0; ct < 4; ++ct)
#pragma unroll
        for (int r = 0; r < 16; ++r) o[ct][r] = 0.f;
    float lsum = 0.f;
    asm volatile("s_waitcnt vmcnt(0) lgkmcnt(0)" ::: "memory");
    __syncthreads();
    for (int j = 0; j <= jlast; ++j) {
        const int cur = j & 1;
        const LAS unsigned char* kb = lds + cur * 32768; const LAS unsigned char* vb = kb + 16384;
        if (j < jlast) { tile_dma(Kg + (size_t)(64 * (j + 1)) * NAB, dvo, lds + (cur ^ 1) * 32768, w); tile_dma(Vg + (size_t)(64 * (j + 1)) * NAB, dvo, lds + (cur ^ 1) * 32768 + 16384, w); }
        if (j <= cw) {
            const unsigned long long mw = *(const LAS unsigned long long*)(mst + r32 * 264 + j * 8);
            const unsigned mw0 = (unsigned)mw, mw1 = (unsigned)(mw >> 32);
#pragma unroll 1
            for (int half = 0; half < 2; ++half) {
                const unsigned mwh = (half ? mw1 : mw0) >> (4 * hi);
                bf16x8 kf[8];
#pragma unroll
                for (int ks = 0; ks < 8; ++ks) kf[ks] = k_frag(kb, fo, half, ks);
                f32x16 p;
#pragma unroll
                for (int r = 0; r < 16; ++r) p[r] = 0.f;
#pragma unroll
                for (int ks = 0; ks < 8; ++ks) p = __builtin_amdgcn_mfma_f32_32x32x16_bf16(kf[ks], qf[ks], p, 0, 0, 0);
#pragma unroll
                for (int r = 0; r < 16; ++r) { const unsigned keep = (unsigned)(-(int)((mwh >> ((r & 3) + 8 * (r >> 2))) & 1u));
                    const float e = __uint_as_float(__float_as_uint(__builtin_amdgcn_exp2f(p[r] - mref)) & keep); p[r] = e; lsum += e; }
                const bf16x8 pa0 = pack8(p[0], p[1], p[2], p[3], p[4], p[5], p[6], p[7]), pa1 = pack8(p[8], p[9], p[10], p[11], p[12], p[13], p[14], p[15]);
                s16x4 vl[8], vh[8];
                const unsigned vbase = (unsigned)(size_t)vb + 8192u * (unsigned)half;
#pragma unroll
                for (int ct = 0; ct < 4; ++ct) { const unsigned a0 = vbase + (unsigned)fo.va[ct], a1 = a0 + (unsigned)fo.vd;
                    TR_READ(vl[2 * ct], a0, 0); TR_READ(vh[2 * ct], a1, 0); TR_READ(vl[2 * ct + 1], a0, 4096); TR_READ(vh[2 * ct + 1], a1, 4096); }
                LGKM_WAIT0();
#pragma unroll
                for (int ct = 0; ct < 4; ++ct) {
                    o[ct] = __builtin_amdgcn_mfma_f32_32x32x16_bf16(pa0, mk_frag(vl[2 * ct], vh[2 * ct]), o[ct], 0, 0, 0);
                    o[ct] = __builtin_amdgcn_mfma_f32_32x32x16_bf16(pa1, mk_frag(vl[2 * ct + 1], vh[2 * ct + 1]), o[ct], 0, 0, 0);
                }
            }
        }
        asm volatile("s_waitcnt vmcnt(0) lgkmcnt(0)" ::: "memory");
        __syncthreads();
    }
    lsum += __shfl_xor(lsum, 32);
    LAS float* lsc = (LAS float*)mst;
    if (hi == 0) lsc[r32] = 1.0f / lsum;
    asm volatile("s_waitcnt lgkmcnt(0)" ::: "memory");
    float rsc[16];
#pragma unroll
    for (int r = 0; r < 16; ++r) rsc[r] = lsc[crow(r, hi)];
    store_o(o, rsc, lds + w * 8192, F.CAT + (size_t)(b * SEQ + t0w) * D + h * 128, D, lane);
    __syncthreads();
}
__device__ __forceinline__ void ph_dsa(Frame& F) {
    float gm = fmaxf(fabsf(F.gq_a[F.lane]), fabsf(F.gq_a[64 + F.lane])), km = fmaxf(fabsf(F.gk_a[F.lane]), fabsf(F.gk_a[64 + F.lane]));
    gm = wave_max(gm); km = wave_max(km);
    const float mref = att::C2 * 128.0f * gm * km * 1.02f;
    for (int v = F.vcu; v < BATCH * 4 * 4; v += F.G) {
        const int bh = v >> 2, pi = v & 3;
#pragma unroll 1
        for (int k = 0; k < 2; ++k) dsa_unit(F, bh >> 2, bh & 3, k ? 7 - pi : pi, mref);
    }
}
namespace idx {
using att::f32x16;
constexpr int SCP = 2048;
__device__ __forceinline__ unsigned okey(float f) { const unsigned u = __float_as_uint(f); return (u & 0x80000000u) ? ~u : (u | 0x80000000u); }
__device__ __forceinline__ int wave_isum(int c) {
    c += __builtin_amdgcn_mov_dpp(c, 0xB1, 0xF, 0xF, true);
    c += __builtin_amdgcn_mov_dpp(c, 0x4E, 0xF, 0xF, true);
    c += __builtin_amdgcn_mov_dpp(c, 0x141, 0xF, 0xF, true);
    c += __builtin_amdgcn_mov_dpp(c, 0x140, 0xF, 0xF, true);
    return (__builtin_amdgcn_readlane(c, 0) + __builtin_amdgcn_readlane(c, 16)) + (__builtin_amdgcn_readlane(c, 32) + __builtin_amdgcn_readlane(c, 48));
}
__device__ __forceinline__ void bit_transpose32x2(unsigned (&A)[32], unsigned (&B)[32]) {
    unsigned mask = 0x0000FFFFu;
#pragma unroll
    for (int s = 16; s; s >>= 1) {
        unsigned ta[16], tb[16];
#pragma unroll
        for (int k = 0, i = 0; k < 32; ++k) if (!(k & s)) { ta[i] = A[k + s] >> s; tb[i] = B[k + s] >> s; ++i; }
#pragma unroll
        for (int k = 0, i = 0; k < 32; ++k) if (!(k & s)) { ta[i] ^= A[k]; tb[i] ^= B[k]; ++i; }
#pragma unroll
        for (int i = 0; i < 16; ++i) { ta[i] &= mask; tb[i] &= mask; }
#pragma unroll
        for (int k = 0, i = 0; k < 32; ++k) if (!(k & s)) { A[k] ^= ta[i]; B[k] ^= tb[i]; ++i; }
#pragma unroll
        for (int k = 0, i = 0; k < 32; ++k) if (!(k & s)) { A[k + s] ^= ta[i] << s; B[k + s] ^= tb[i] << s; ++i; }
        mask ^= mask << (s >> 1);
    }
}
__device__ __forceinline__ void select_prepare(const LAS float* scA, const LAS float* scB, int E, unsigned (&Wa)[32], unsigned (&Wb)[32], int lane) {
#pragma unroll
    for (int j = 0; j < 32; ++j) { Wa[31 - j] = __float_as_uint(scA[64 * j + lane]); Wb[31 - j] = __float_as_uint(scB[64 * j + lane]); }
#pragma unroll
    for (int j = 0; j < 32; ++j) { const unsigned ua = Wa[31 - j], ub = Wb[31 - j];
        const unsigned ka = (ua & 0x80000000u) ? ~ua : (ua | 0x80000000u), kb = (ub & 0x80000000u) ? ~ub : (ub | 0x80000000u);
        Wa[31 - j] = (j < E) ? ka : 0u; Wb[31 - j] = (j < E) ? kb : 0u; }
    bit_transpose32x2(Wa, Wb);
}
__device__ __forceinline__ void select_finish(const unsigned (&Wa)[32], const unsigned (&Wb)[32], int E, unsigned* mrowA, unsigned* mrowB, int lane) {
    const unsigned valid = (E >= 32) ? 0xFFFFFFFFu : ((1u << E) - 1u);
    unsigned alA = valid, alB = valid, gtA = 0u, gtB = 0u;
    int GA = 0, GB = 0, AA = 64 * E, AB = 64 * E; bool dA = false, dB = false;
#pragma unroll
    for (int b = 0; b < 32; ++b) {
        if (dA && dB) break;
        const unsigned m1a = alA & Wa[b], m1b = alB & Wb[b];
        const int ca = wave_isum(__popc(m1a)), cb = wave_isum(__popc(m1b));
        if (!dA) { if (GA + ca >= 256) { alA = m1a; AA = ca; } else { GA += ca; gtA |= m1a; alA &= ~Wa[b]; AA -= ca; } dA = (GA + AA == 256); }
        if (!dB) { if (GB + cb >= 256) { alB = m1b; AB = cb; } else { GB += cb; gtB |= m1b; alB &= ~Wb[b]; AB -= cb; } dB = (GB + AB == 256); }
    }
#pragma unroll 1
    for (int rr = 0; rr < 2; ++rr) {
        const unsigned al = rr ? alB : alA, gt = rr ? gtB : gtA; const bool done = rr ? dB : dA; unsigned* mrow = rr ? mrowB : mrowA;
        unsigned sel = gt | al;
        if (!done) {
            int need = 256 - (rr ? GB : GA); sel = gt;
            const unsigned long long below = (1ull << lane) - 1ull;
            for (int j = 0; j < E; ++j) { const bool e = (al >> j) & 1u; const unsigned long long eq = __ballot(e);
                if (e && __popcll(eq & below) < need) sel |= 1u << j;
                need -= __popcll(eq); if (need <= 0) break; }
        }
        unsigned long long mine = 0ull;
#pragma unroll
        for (int j = 0; j < 32; ++j) { if (j < E) { const unsigned long long m = __ballot((sel >> j) & 1u); if (lane == j) mine = m; } }
        if (lane < 32) *(unsigned long long*)(mrow + 2 * lane) = mine;
    }
}
__device__ __forceinline__ void decode(int u, int& b, int& c, int& sub) { c = 4 + u % 28; const int rest = u / 28; b = rest >> 2; sub = rest & 3; }
__device__ __forceinline__ void load_af(Frame& F, int u, bf16x8 (&af)[4][4]) {
    int b, c, sub; decode(u, b, c, sub);
    const int r32 = F.lane & 31, hi = F.lane >> 5, t0 = 64 * c + 16 * sub;
    const bf16* P = F.R1 + (size_t)b * SEQ * NAB;
#pragma unroll
    for (int rt = 0; rt < 4; ++rt)
#pragma unroll
        for (int ks = 0; ks < 4; ++ks) af[rt][ks] = *(const bf16x8*)(P + (size_t)(t0 + 4 * rt + (r32 >> 3)) * NAB + C_IQ + (r32 & 7) * 64 + 16 * ks + 8 * hi);
}
__device__ __forceinline__ float load_w(Frame& F, int u) {
    int b, c, sub; decode(u, b, c, sub);
    const int t0 = 64 * c + 16 * sub;
    return (F.tid < 128) ? bf2f(F.R1[(size_t)(b * SEQ + t0 + (F.tid >> 3)) * NAB + C_IW + (F.tid & 7)]) * (0.125f * 0.35355339059327373f) : 0.f;
}
__device__ __forceinline__ void load_bf(Frame& F, int b, int strip, bf16x8 (&bfr)[4]) {
    const bf16* P = F.R1 + (size_t)b * SEQ * NAB;
#pragma unroll
    for (int ks = 0; ks < 4; ++ks) bfr[ks] = *(const bf16x8*)(P + (size_t)(32 * strip + (F.lane & 31)) * NAB + C_IK + 16 * ks + 8 * (F.lane >> 5));
}
__device__ __forceinline__ void run(Frame& F) {
    const int lane = F.lane, w = F.wave, hi = lane >> 5, r32 = lane & 31, tid = F.tid, NU = BATCH * 28 * 4;
    int u = F.vcu; if (u >= NU) return;
    LAS float* sc = (LAS float*)F.lds;
    LAS float* wtb = sc + 16 * SCP;
    bf16x8 af[4][4], bfr[4], bnx[4];
    load_af(F, u, af);
    { const float wv = load_w(F, u); if (tid < 128) wtb[tid] = wv; }
    { int b, c, sub; decode(u, b, c, sub); if (w < 2 * (c + 1)) load_bf(F, b, w, bfr); }
    for (int it = 0; u < NU; ++it, u += F.G) {
        int b, c, sub; decode(u, b, c, sub);
        const int n = 64 * (c + 1), t0 = 64 * c + 16 * sub, nstrip = n >> 5;
        const int un = u + F.G; const bool more = un < NU;
        const LAS float* wt = wtb + (it & 1) * 128;
        __syncthreads();
        const float wnext = more ? load_w(F, un) : 0.f;
        for (int s = w; s < nstrip; s += NWAVES) {
            const bool mstrip = s + NWAVES < nstrip;
            if (mstrip) load_bf(F, b, s + NWAVES, bnx);
#pragma unroll
            for (int rt = 0; rt < 4; ++rt) {
                f32x16 acc;
#pragma unroll
                for (int r = 0; r < 16; ++r) acc[r] = 0.f;
#pragma unroll
                for (int ks = 0; ks < 4; ++ks) acc = __builtin_amdgcn_mfma_f32_32x32x16_bf16(af[rt][ks], bfr[ks], acc, 0, 0, 0);
                float part[4];
#pragma unroll
                for (int qi = 0; qi < 4; ++qi) { const f32x4 wv = *(const LAS f32x4*)(wt + (4 * rt + qi) * 8 + 4 * hi);
                    part[qi] = fmaxf(acc[4 * qi], 0.f) * wv[0] + fmaxf(acc[4 * qi + 1], 0.f) * wv[1] + fmaxf(acc[4 * qi + 2], 0.f) * wv[2] + fmaxf(acc[4 * qi + 3], 0.f) * wv[3]; }
                const float send0 = hi ? part[0] : part[2], send1 = hi ? part[1] : part[3];
                const float got0 = __shfl_xor(send0, 32), got1 = __shfl_xor(send1, 32);
                const float f0 = (hi ? part[2] : part[0]) + got0, f1 = (hi ? part[3] : part[1]) + got1;
                const int q0 = 4 * rt + 2 * hi;
                sc[q0 * SCP + 32 * s + r32] = f0; sc[(q0 + 1) * SCP + 32 * s + r32] = f1;
            }
            if (mstrip) {
#pragma unroll
                for (int ks = 0; ks < 4; ++ks) bfr[ks] = bnx[ks];
            }
        }
        if (more && tid < 128) wtb[((it + 1) & 1) * 128 + tid] = wnext;
        __syncthreads();
        { const int q = 2 * w;
          unsigned* mrowA = F.MASK + (size_t)(b * SEQ + t0 + q) * 64; unsigned* mrowB = mrowA + 64;
          const LAS float* rowA = sc + q * SCP; const LAS float* rowB = rowA + SCP;
          unsigned Wa[32], Wb[32];
          select_prepare(rowA, rowB, n >> 6, Wa, Wb, lane);
          asm volatile("" ::: "memory");
          if (more) load_af(F, un, af);
          select_finish(Wa, Wb, n >> 6, mrowA, mrowB, lane); }
        if (more) { int bn, cn, sn; decode(un, bn, cn, sn); if (w < 2 * (cn + 1)) load_bf(F, bn, w, bfr); }
    }
    __syncthreads();
}
}
__device__ __forceinline__ void ph_indexer(Frame& F) {
    { const int gw = F.vcu * NWAVES + F.wave, NGW = F.G * NWAVES;
      for (int i = gw; i < BATCH * 256; i += NGW) { const int b = i >> 8, pos = i & 255, n = ((pos >> 6) + 1) << 6;
          if (F.lane < 32) { unsigned long long v = 0ull; if (64 * F.lane < n) v = ~0ull; *(unsigned long long*)(F.MASK + (size_t)(b * SEQ + pos) * 64 + 2 * F.lane) = v; } } }
    idx::run(F);
}
namespace gla {
using att::f32x16; using att::u32x4;
constexpr int L_WL = 0, L_V = 4096, L_OG = 36864, L_K = 69632, L_Q = 78848, L_PART = 88064, L_STG = 89088, KP = 144, SP = 272;
struct In { u32x4 g0, g1, kk, qq; f32x4 b0, b1; };
__device__ __forceinline__ void decode(int u, int& b, int& h, int& c) { b = u >> 7; h = (u >> 5) & 3; c = u & 31; }
template <bool PASSC> __device__ __forceinline__ void load_in(Frame& F, int u, In& in, const float* BC) {
    int b, h, c; decode(u, b, h, c);
    const bf16* pr = F.R1 + (size_t)(b * SEQ + 64 * c + F.lane) * NAB;
    in.kk = *(const u32x4*)(pr + C_KB + h * 64 + 8 * F.wave);
    if (PASSC) { in.qq = *(const u32x4*)(pr + C_QB + h * 64 + 8 * F.wave);
        const float* bp = BC + ((size_t)u * 64 + F.lane) * 64 + 8 * F.wave; in.b0 = *(const f32x4*)bp; in.b1 = *(const f32x4*)(bp + 4); }
    else { in.g0 = *(const u32x4*)(pr + C_GL); in.g1 = *(const u32x4*)(pr + C_GL + 8); }
}
template <bool NEEDOG> __device__ __forceinline__ void dma_in(Frame& F, int u, int buf, const unsigned (&dvo)[2]) {
    int b, h, c; decode(u, b, h, c);
    const bf16* P = F.R1 + (size_t)(b * SEQ + 64 * c) * NAB;
    att::tile_dma(P + C_VB + h * 128, dvo, F.lds + L_V + buf * 16384, F.wave);
    if (NEEDOG) att::tile_dma(P + C_OG + h * 128, dvo, F.lds + L_OG + buf * 16384, F.wave);
}
__device__ __forceinline__ void stage_wl(Frame& F, int h) {
    LAS float* wl = (LAS float*)(F.lds + L_WL);
#pragma unroll
    for (int i = 0; i < 2; ++i) { const int e = F.tid + 512 * i, r = e >> 6, d = e & 63; wl[e] = F.w_gate_up[r * 256 + h * 64 + d]; }
}
__device__ __forceinline__ void unpack8(const u32x4 v, float (&f)[8]) {
#pragma unroll
    for (int i = 0; i < 4; ++i) { f[2 * i] = __uint_as_float(v[i] << 16); f[2 * i + 1] = __uint_as_float(v[i] & 0xffff0000u); }
}
__device__ __forceinline__ void gate_scan(Frame& F, int h, const float (&gl)[16], float (&bc)[8], float (&blast)[8]) {
    const int lane = F.lane, d0 = 8 * F.wave;
    const LAS float* wl = (const LAS float*)(F.lds + L_WL);
    float acc[8];
#pragma unroll
    for (int i = 0; i < 8; ++i) acc[i] = F.b_gate[h * 64 + d0 + i];
#pragma unroll
    for (int r = 0; r < 16; ++r) { const f32x4 w0 = *(const LAS f32x4*)(wl + r * 64 + d0), w1 = *(const LAS f32x4*)(wl + r * 64 + d0 + 4);
#pragma unroll
        for (int i = 0; i < 4; ++i) { acc[i] = fmaf(gl[r], w0[i], acc[i]); acc[4 + i] = fmaf(gl[r], w1[i], acc[4 + i]); } }
#pragma unroll
    for (int i = 0; i < 8; ++i) { float v = (fminf(acc[i], 0.f) - __logf(1.0f + __expf(-fabsf(acc[i])))) * (1.0f / 16.0f);
#pragma unroll
        for (int off = 1; off < 64; off <<= 1) { const float u = __shfl_up(v, off); if (lane >= off) v += u; }
        bc[i] = v; blast[i] = __shfl(v, 63); }
}
__device__ __forceinline__ void pass_a(Frame& F, float* GU, float* DEC, float* BC) {
    const int lane = F.lane, w = F.wave, hi = lane >> 5, r32 = lane & 31;
    att::FragOff fo; att::frag_off_init(fo, lane);
    unsigned dvo[2]; att::dma_off_init(dvo, NAB, w, lane);
    const int et = w >> 1, dt = w & 1, va_et = att::frag_va(lane, et);
    int u = F.vcu; if (u >= BATCH * 4 * 32) return;
    In cur, nxt; int hprev = -1;
    dma_in<false>(F, u, 0, dvo); load_in<false>(F, u, cur, BC);
    for (int it = 0; u < BATCH * 4 * 32; ++it, u += F.G) {
        int b, h, c; decode(u, b, h, c);
        const int un = u + F.G; const bool more = un < BATCH * 4 * 32;
        if (h != hprev) { stage_wl(F, h); hprev = h; }
        asm volatile("s_waitcnt vmcnt(0) lgkmcnt(0)" ::: "memory");
        __syncthreads();
        float gl[16], kf[8];
        unpack8(cur.g0, (float(&)[8])gl[0]); unpack8(cur.g1, (float(&)[8])gl[8]); unpack8(cur.kk, kf);
        asm volatile("" ::: "memory");
        if (more) { dma_in<false>(F, un, (it + 1) & 1, dvo); load_in<false>(F, un, nxt, BC); }
        float bc[8], blast[8];
        gate_scan(F, h, gl, bc, blast);
        const int uid = u;
        { float* bp = BC + ((size_t)uid * 64 + lane) * 64 + 8 * w; *(f32x4*)bp = (f32x4){bc[0], bc[1], bc[2], bc[3]}; *(f32x4*)(bp + 4) = (f32x4){bc[4], bc[5], bc[6], bc[7]}; }
#pragma unroll
        for (int i = 0; i < 8; ++i) *(LAS bf16*)(F.lds + L_K + (8 * w + i) * KP + lane * 2) = (bf16)f2bf(kf[i] * __expf(blast[i] - bc[i]));
        if (lane == 0) {
#pragma unroll
            for (int i = 0; i < 8; ++i) DEC[(size_t)uid * 64 + 8 * w + i] = __expf(blast[i]); }
        asm volatile("s_waitcnt lgkmcnt(0)" ::: "memory");
        __syncthreads();
        const LAS unsigned char* vbuf = F.lds + L_V + (it & 1) * 16384;
        f32x16 acc;
#pragma unroll
        for (int r = 0; r < 16; ++r) acc[r] = 0.f;
#pragma unroll
        for (int kk = 0; kk < 4; ++kk) {
            const LAS unsigned char* kp = F.lds + L_K + (32 * dt + r32) * KP + (16 * kk + 4 * hi) * 2;
            const unsigned long long lo = *(const LAS unsigned long long*)kp, hh = *(const LAS unsigned long long*)(kp + 16);
            u32x4 bw; bw.x = (unsigned)lo; bw.y = (unsigned)(lo >> 32); bw.z = (unsigned)hh; bw.w = (unsigned)(hh >> 32);
            acc = __builtin_amdgcn_mfma_f32_32x32x16_bf16(att::v_frag_rt(vbuf, va_et, fo.vd, kk), __builtin_bit_cast(bf16x8, bw), acc, 0, 0, 0);
        }
        float* gu = GU + (size_t)uid * 8192;
#pragma unroll
        for (int r = 0; r < 16; ++r) gu[(32 * et + att::crow(r, hi)) * 64 + 32 * dt + r32] = acc[r];
        cur = nxt;
    }
    __syncthreads();
}
__device__ __forceinline__ void pass_b(Frame& F, float* GU, const float* DEC) {
    for (int idx = F.vcu * NTHR + F.tid; idx < 64 * 128 * 16; idx += F.G * NTHR) {
        const int bh = idx >> 11, e = (idx >> 4) & 127, dq = idx & 15;
        f32x4 S = (f32x4){0.f, 0.f, 0.f, 0.f};
        for (int c0 = 0; c0 < 32; c0 += 8) {
            f32x4 U[8], dec[8];
#pragma unroll
            for (int i = 0; i < 8; ++i) { const size_t uid = (size_t)bh * 32 + c0 + i; U[i] = *(const f32x4*)(GU + (uid * 128 + e) * 64 + 4 * dq); dec[i] = *(const f32x4*)(DEC + uid * 64 + 4 * dq); }
#pragma unroll
            for (int i = 0; i < 8; ++i) { const size_t uid = (size_t)bh * 32 + c0 + i; *(f32x4*)(GU + (uid * 128 + e) * 64 + 4 * dq) = S; S = dec[i] * S + U[i]; }
        }
    }
}
__device__ __forceinline__ void pass_c(Frame& F, const float* GU, const float* BC) {
    const int lane = F.lane, w = F.wave, hi = lane >> 5, r32 = lane & 31, tid = F.tid;
    LAS unsigned char* lds = F.lds;
    att::FragOff fo; att::frag_off_init(fo, lane);
    unsigned dvo[2]; att::dma_off_init(dvo, NAB, w, lane);
    const int et = w >> 1, tt = w & 1, tl = 32 * tt + r32, va_et = att::frag_va(lane, et);
    int u = F.vcu; if (u >= BATCH * 4 * 32) return;
    In cur, nxt;
    dma_in<true>(F, u, 0, dvo); load_in<true>(F, u, cur, BC);
    for (int it = 0; u < BATCH * 4 * 32; ++it, u += F.G) {
        int b, h, c; decode(u, b, h, c);
        const int un = u + F.G; const bool more = un < BATCH * 4 * 32;
        asm volatile("s_waitcnt vmcnt(0) lgkmcnt(0)" ::: "memory");
        __syncthreads();
        float kf[8], qf[8], bc[8];
        unpack8(cur.kk, kf); unpack8(cur.qq, qf);
#pragma unroll
        for (int i = 0; i < 4; ++i) { bc[i] = cur.b0[i]; bc[4 + i] = cur.b1[i]; }
        asm volatile("" ::: "memory");
        if (more) { dma_in<true>(F, un, (it + 1) & 1, dvo); load_in<true>(F, un, nxt, BC); }
        f32x4 sf[8];
        { const float* gs = GU + ((size_t)u * 128 + 32 * et + r32) * 64;
#pragma unroll
          for (int ks = 0; ks < 4; ++ks) { sf[2 * ks] = *(const f32x4*)(gs + 16 * ks + 8 * hi); sf[2 * ks + 1] = *(const f32x4*)(gs + 16 * ks + 8 * hi + 4); } }
        { float eq[8], ek[8];
#pragma unroll
          for (int i = 0; i < 8; ++i) { eq[i] = qf[i] * 0.125f * __expf(bc[i]); ek[i] = kf[i] * __expf(-bc[i]); }
          *(LAS bf16x8*)(lds + L_Q + lane * KP + 16 * w) = att::pack8(eq[0], eq[1], eq[2], eq[3], eq[4], eq[5], eq[6], eq[7]);
          *(LAS bf16x8*)(lds + L_K + lane * KP + 16 * w) = att::pack8(ek[0], ek[1], ek[2], ek[3], ek[4], ek[5], ek[6], ek[7]); }
        asm volatile("s_waitcnt lgkmcnt(0)" ::: "memory");
        __syncthreads();
        const LAS unsigned char* vbuf = lds + L_V + (it & 1) * 16384; const LAS unsigned char* ogbuf = lds + L_OG + (it & 1) * 16384;
        bf16x8 qfr[4];
#pragma unroll
        for (int ks = 0; ks < 4; ++ks) qfr[ks] = *(const LAS bf16x8*)(lds + L_Q + tl * KP + (16 * ks + 8 * hi) * 2);
        f32x16 p0, p1;
#pragma unroll
        for (int r = 0; r < 16; ++r) { p0[r] = 0.f; p1[r] = 0.f; }
#pragma unroll
        for (int ks = 0; ks < 4; ++ks) {
            const bf16x8 a0 = *(const LAS bf16x8*)(lds + L_K + r32 * KP + (16 * ks + 8 * hi) * 2), a1 = *(const LAS bf16x8*)(lds + L_K + (32 + r32) * KP + (16 * ks + 8 * hi) * 2);
            p0 = __builtin_amdgcn_mfma_f32_32x32x16_bf16(a0, qfr[ks], p0, 0, 0, 0); p1 = __builtin_amdgcn_mfma_f32_32x32x16_bf16(a1, qfr[ks], p1, 0, 0, 0);
        }
        { const int tl4 = tl - 4 * hi;
#pragma unroll
          for (int r = 0; r < 16; ++r) { const int s = (r & 3) + 8 * (r >> 2); if (s > tl4) p0[r] = 0.f; if (s + 32 > tl4) p1[r] = 0.f; } }
        const bf16x8 pa0 = att::pack8(p0[0], p0[1], p0[2], p0[3], p0[4], p0[5], p0[6], p0[7]), pa1 = att::pack8(p0[8], p0[9], p0[10], p0[11], p0[12], p0[13], p0[14], p0[15]);
        const bf16x8 pa2 = att::pack8(p1[0], p1[1], p1[2], p1[3], p1[4], p1[5], p1[6], p1[7]), pa3 = att::pack8(p1[8], p1[9], p1[10], p1[11], p1[12], p1[13], p1[14], p1[15]);
        f32x16 acc;
#pragma unroll
        for (int r = 0; r < 16; ++r) acc[r] = 0.f;
        acc = __builtin_amdgcn_mfma_f32_32x32x16_bf16(att::v_frag_rt(vbuf, va_et, fo.vd, 0), pa0, acc, 0, 0, 0);
        acc = __builtin_amdgcn_mfma_f32_32x32x16_bf16(att::v_frag_rt(vbuf, va_et, fo.vd, 1), pa1, acc, 0, 0, 0);
        acc = __builtin_amdgcn_mfma_f32_32x32x16_bf16(att::v_frag_rt(vbuf, va_et, fo.vd, 2), pa2, acc, 0, 0, 0);
        acc = __builtin_amdgcn_mfma_f32_32x32x16_bf16(att::v_frag_rt(vbuf, va_et, fo.vd, 3), pa3, acc, 0, 0, 0);
#pragma unroll
        for (int ks = 0; ks < 4; ++ks) { const f32x4 s0 = sf[2 * ks], s1 = sf[2 * ks + 1];
            acc = __builtin_amdgcn_mfma_f32_32x32x16_bf16(att::pack8(s0[0], s0[1], s0[2], s0[3], s1[0], s1[1], s1[2], s1[3]), qfr[ks], acc, 0, 0, 0); }
        float ss = 0.f;
#pragma unroll
        for (int r = 0; r < 16; ++r) ss = fmaf(acc[r], acc[r], ss);
        ss += __shfl_xor(ss, 32);
        LAS float* part = (LAS float*)(lds + L_PART);
        if (hi == 0) part[et * 64 + tl] = ss;
        asm volatile("s_waitcnt lgkmcnt(0)" ::: "memory");
        __syncthreads();
        const float rs = rsqrtf(((part[tl] + part[64 + tl]) + (part[128 + tl] + part[192 + tl])) * (1.0f / 128.0f) + EPS);
#pragma unroll
        for (int g = 0; g < 4; ++g) {
            const int e0 = 32 * et + 8 * g + 4 * hi;
            const unsigned long long ow = *(const LAS unsigned long long*)(ogbuf + att::img_off(tl, 4 * et + g) + 8 * hi);
            const f32x4 gg = *(const f32x4*)(F.g_gla + e0);
            float y[4];
#pragma unroll
            for (int i = 0; i < 4; ++i) { const float og = __uint_as_float(((unsigned)(ow >> (16 * i)) & 0xffffu) << 16); y[i] = acc[4 * g + i] * rs * gg[i] * (og * __builtin_amdgcn_rcpf(1.0f + __expf(-og))); }
            *(LAS unsigned long long*)(lds + L_STG + tl * SP + e0 * 2) = (unsigned long long)pg8::cvt_pk_bf16(y[0], y[1]) | ((unsigned long long)pg8::cvt_pk_bf16(y[2], y[3]) << 32);
        }
        asm volatile("s_waitcnt lgkmcnt(0)" ::: "memory");
        __syncthreads();
#pragma unroll
        for (int i = 0; i < 2; ++i) { const int cidx = tid + 512 * i, row = cidx >> 4, ch = cidx & 15;
            *(u32x4*)(F.CAT + (size_t)(b * SEQ + 64 * c + row) * D + 512 + h * 128 + ch * 8) = *(const LAS u32x4*)(lds + L_STG + row * SP + ch * 16); }
        cur = nxt;
    }
    __syncthreads();
}
}
__device__ __forceinline__ void ph_rope_tables(Frame& F, float* R128, float* R64) {
    for (int i = F.vcu * NTHR + F.tid; i < SEQ * 24; i += F.G * NTHR) {
        const int pos = i / 24, k = i % 24;
        if (k < 16) { const float inv = powf(500000.0f, -(float)k * 2.0f / 32.0f), ang = (float)pos * inv; R128[pos * 32 + k] = cosf(ang); R128[pos * 32 + 16 + k] = sinf(ang); }
        else { const int j = k - 16; const float inv = powf(500000.0f, -(float)j * 2.0f / 16.0f), ang = (float)pos * inv; R64[pos * 16 + j] = cosf(ang); R64[pos * 16 + 8 + j] = sinf(ang); }
    }
}
__device__ __forceinline__ float dpp_xor1(float v) { return __builtin_bit_cast(float, __builtin_amdgcn_mov_dpp(__builtin_bit_cast(int, v), 0xB1, 0xF, 0xF, true)); }
__device__ __forceinline__ float dpp_xor2(float v) { return __builtin_bit_cast(float, __builtin_amdgcn_mov_dpp(__builtin_bit_cast(int, v), 0x4E, 0xF, 0xF, true)); }
__device__ __forceinline__ void ph_prep_c_fast(Frame& F) {
    const int gw = F.vcu * NWAVES + F.wave, NGW = F.G * NWAVES, lane = F.lane;
    const float* gn = (lane < 32 ? F.gq_c : F.gk_c) + (lane & 3) * 32;
    const float sc = lane < 32 ? att::C2 : 1.0f;
    float g[32];
#pragma unroll
    for (int i = 0; i < 8; ++i) { const f32x4 v = *(const f32x4*)(gn + 4 * i); g[4 * i] = v[0] * sc; g[4 * i + 1] = v[1] * sc; g[4 * i + 2] = v[2] * sc; g[4 * i + 3] = v[3] * sc; }
    for (int tok = gw; tok < M; tok += NGW) {
        att::u32x4* p = (att::u32x4*)(F.R1 + (size_t)tok * NC + lane * 32);
        att::u32x4 v[4]; float f[32]; float ss = 0.f;
#pragma unroll
        for (int i = 0; i < 4; ++i) v[i] = p[i];
#pragma unroll
        for (int i = 0; i < 4; ++i)
#pragma unroll
            for (int j = 0; j < 4; ++j) { const float a = __uint_as_float(v[i][j] << 16), b = __uint_as_float(v[i][j] & 0xffff0000u); f[8 * i + 2 * j] = a; f[8 * i + 2 * j + 1] = b; ss = fmaf(a, a, fmaf(b, b, ss)); }
        ss += dpp_xor1(ss); ss += dpp_xor2(ss);
        const float rs = rsqrtf(ss * (1.f / 128.f) + EPS);
#pragma unroll
        for (int i = 0; i < 4; ++i) { att::u32x4 o;
#pragma unroll
            for (int j = 0; j < 4; ++j) o[j] = pg8::cvt_pk_bf16(f[8 * i + 2 * j] * rs * g[8 * i + 2 * j], f[8 * i + 2 * j + 1] * rs * g[8 * i + 2 * j + 1]);
            p[i] = o; }
    }
}
__device__ __forceinline__ void ph_prep_a_fast(Frame& F, const float* R128, const float* R64) {
    const int gw = F.vcu * NWAVES + F.wave, NGW = F.G * NWAVES, lane = F.lane, l8 = lane & 7;
    const float* gn = (lane < 32 ? F.gq_a : F.gk_a) + l8 * 16;
    const float sc = lane < 32 ? att::C2 : 1.0f;
    float g[16];
#pragma unroll
    for (int i = 0; i < 4; ++i) { const f32x4 v = *(const f32x4*)(gn + 4 * i); g[4 * i] = v[0] * sc; g[4 * i + 1] = v[1] * sc; g[4 * i + 2] = v[2] * sc; g[4 * i + 3] = v[3] * sc; }
    for (int tok = gw; tok < M; tok += NGW) {
        const int pos = tok & (SEQ - 1);
        bf16* pr = F.R1 + (size_t)tok * NAB;
        {   att::u32x4* p = (att::u32x4*)(pr + lane * 16);
            const att::u32x4 v0 = p[0], v1 = p[1]; float f[16]; float ss = 0.f;
#pragma unroll
            for (int j = 0; j < 4; ++j) { f[2 * j] = __uint_as_float(v0[j] << 16); f[2 * j + 1] = __uint_as_float(v0[j] & 0xffff0000u); f[8 + 2 * j] = __uint_as_float(v1[j] << 16); f[8 + 2 * j + 1] = __uint_as_float(v1[j] & 0xffff0000u); }
#pragma unroll
            for (int i = 0; i < 16; ++i) ss = fmaf(f[i], f[i], ss);
            ss += dpp_xor1(ss); ss += dpp_xor2(ss); ss += __shfl_xor(ss, 4);
            const float rs = rsqrtf(ss * (1.f / 128.f) + EPS);
#pragma unroll
            for (int i = 0; i < 16; ++i) f[i] = f[i] * rs * g[i];
            const float* cs = R128 + pos * 32;
#pragma unroll
            for (int i = 0; i < 16; ++i) { const float other = dpp_xor1(f[i]);
                if (l8 < 2) { const float c = cs[i], s = cs[16 + i]; f[i] = (l8 == 0) ? f[i] * c - other * s : f[i] * c + other * s; } }
            att::u32x4 o0, o1;
#pragma unroll
            for (int j = 0; j < 4; ++j) { o0[j] = pg8::cvt_pk_bf16(f[2 * j], f[2 * j + 1]); o1[j] = pg8::cvt_pk_bf16(f[8 + 2 * j], f[8 + 2 * j + 1]); }
            p[0] = o0; p[1] = o1;
        }
        {
#pragma unroll
            for (int part = 0; part < 2; ++part) {
                if (part == 1 && lane >= 8) break;
                att::u32x4* p = (att::u32x4*)(pr + (part == 0 ? C_IQ + lane * 8 : C_IK + lane * 8));
                const att::u32x4 v0 = p[0]; float f[8];
#pragma unroll
                for (int j = 0; j < 4; ++j) { f[2 * j] = __uint_as_float(v0[j] << 16); f[2 * j + 1] = __uint_as_float(v0[j] & 0xffff0000u); }
                const float* cs = R64 + pos * 16;
#pragma unroll
                for (int i = 0; i < 8; ++i) { const float other = dpp_xor1(f[i]);
                    if (l8 < 2) { const float c = cs[i], s = cs[8 + i]; f[i] = (l8 == 0) ? f[i] * c - other * s : f[i] * c + other * s; } }
                att::u32x4 o0;
#pragma unroll
                for (int j = 0; j < 4; ++j) o0[j] = pg8::cvt_pk_bf16(f[2 * j], f[2 * j + 1]);
                p[0] = o0;
            }
        }
    }
}
#ifndef MK_PER_PHASE
#define MK_PER_PHASE 0
#endif
constexpr int NPH = 14;
struct Args { const float* in[16]; float* out; unsigned char* ws; int ph_lo, ph_hi; };
__global__ void __launch_bounds__(NTHR, 2) mk_fwd(Args args) {
    extern __shared__ __attribute__((aligned(16))) unsigned char lds[];
    Frame F;
    F.lds = (LAS unsigned char*)lds;
    F.MISC = (volatile LAS unsigned*)(F.lds + MISC_OFF);
#ifdef PROBE_TOTAL
    const unsigned long long pt_start = __builtin_amdgcn_s_memrealtime();
#endif
    F.wave = __builtin_amdgcn_readfirstlane((int)threadIdx.x >> 6);
#define RELANE() (F.lane = lane_id_opaque(), F.tid = F.wave * 64 + F.lane, true)
    RELANE();
#ifdef PROBE_ACC
    F.acc_t0 = 0ull; F.acc_sum = 0ull;
#endif
    F.G = gridDim.x; { const int bx = blockIdx.x; F.vcu = (F.G % 8 == 0) ? (bx % 8) * (F.G / 8) + bx / 8 : bx; }
    unsigned char* ws = args.ws;
    F.ctl = (gu32*)(ws + WS_CTL);
    F.x = args.in[0]; F.g_mix = args.in[1]; F.g_ffn = args.in[2]; F.w_in_ab = args.in[3]; F.gq_a = args.in[4]; F.gk_a = args.in[5]; F.w_gate_up = args.in[6]; F.b_gate = args.in[7];
    F.g_gla = args.in[8]; F.w_out_ab = args.in[9]; F.w_in_c = args.in[10]; F.gq_c = args.in[11]; F.gk_c = args.in[12]; F.w_out_c = args.in[13]; F.w_up = args.in[14]; F.w_down = args.in[15];
    F.out = args.out;
    F.Wab = (bf16*)(ws + WS_WAB); F.Woab = (bf16*)(ws + WS_WOAB); F.Wup0 = (bf16*)(ws + WS_WUP0); F.Wdn0 = (bf16*)(ws + WS_WDN0);
    F.Winc = (bf16*)(ws + WS_WINC); F.Woc = (bf16*)(ws + WS_WOC); F.Wup1 = (bf16*)(ws + WS_WUP1); F.Wdn1 = (bf16*)(ws + WS_WDN1);
    F.XB = (bf16*)(ws + WS_XB); F.CAT = (bf16*)(ws + WS_CAT); F.R1 = (bf16*)(ws + WS_R1); F.SSQ = (float*)(ws + WS_SSQ); F.MASK = (unsigned*)(ws + WS_MASK);
    for (int u = F.tid; u < (LDS_BYTES - MISC_OFF) / 4; u += NTHR) ((LAS unsigned*)(F.lds + MISC_OFF))[u] = 0u;
    __syncthreads();
    XcdBarrier bar; bar.bar = (unsigned*)(F.ctl + CW_BAR); bar.x = 0; bar.st = nullptr; bar.wave = F.wave;
    if (!MK_PER_PHASE) bar = xcd_barrier_post((unsigned*)(F.ctl + CW_BAR), F.MISC + 8, F.wave);
    const int lo = args.ph_lo, hi = args.ph_hi;
#ifdef PROBE_PH
    unsigned long long pt0 = 0ull, pt1 = 0ull;
#define STAMP(k) do { if ((k) == PROBE_PH) pt0 = __builtin_amdgcn_s_memrealtime(); if ((k) == PROBE_PH + 1) pt1 = __builtin_amdgcn_s_memrealtime(); } while (0)
#ifdef PROBE_SUB
#define SUBSTAMP(k) do { if ((k) == PROBE_PH) { __syncthreads(); pt0 = __builtin_amdgcn_s_memrealtime(); } } while (0)
#else
#define SUBSTAMP(k) do { } while (0)
#endif
#else
#define STAMP(k) do { } while (0)
#define SUBSTAMP(k) do { } while (0)
#endif
#define IN(k) (lo <= (k) && (k) < hi && RELANE())
#ifdef PROBE_DBLBAR
#define SEAM(k) do { if (lo <= (k) && (k) + 1 < hi) { xcd_barrier(bar); xcd_barrier(bar); } } while (0)
#else
#define SEAM(k) do { if (lo <= (k) && (k) + 1 < hi) xcd_barrier(bar); } while (0)
#endif
    float* const SSQ0 = F.SSQ, *SSQ1 = F.SSQ + (size_t)M * 16, *SSQ2 = F.SSQ + (size_t)2 * M * 16, *SSQ3 = F.SSQ + (size_t)3 * M * 16;
    typedef pg8::StaticOrder SO;
    STAMP(0); float* const R128 = (float*)(ws + WS_ROPE); float* const R64 = R128 + SEQ * 32;
    if (IN(0)) { ph_prologue(F); ph_rope_tables(F, R128, R64); } SEAM(0);
    STAMP(1); if (IN(1)) { pg8::Gemm g{F.XB, F.Wab, M, NAB, D}; SO S; S.init(M, NAB, F.G, (int)blockIdx.x); pg8::EpiProjAB E{F.R1, NAB, SSQ0, F.gq_a, F.gk_a, R128, R64, (LAS float*)(F.lds + RING_BYTES), att::C2};
        pg8::gemm_phase<pg8::EpiProjAB, SO, true, true>(F.lds, g, S, E, F.wave);
        if (F.G == 256 && blockIdx.x >= 128) { RELANE(); prologue_weights<1>(F, ((int)blockIdx.x - 128) * NWAVES + F.wave, 128 * NWAVES); } } SEAM(1);
    float* const GU = (float*)(ws + WS_XB); float* const DEC = (float*)(ws + WS_DEC);
    STAMP(2); if (IN(2)) { SUBSTAMP(2); gla::pass_a(F, GU, DEC, (float*)(ws + WS_BC)); } SEAM(2);
    STAMP(3); if (IN(3)) { gla::pass_b(F, GU, DEC); SUBSTAMP(3); ph_indexer(F); } SEAM(3);
    STAMP(4); if (IN(4)) { ph_dsa(F); SUBSTAMP(4); gla::pass_c(F, GU, (const float*)(ws + WS_BC)); } SEAM(4);
    STAMP(5); if (IN(5)) { pg8::Gemm g{F.CAT, F.Woab, M, D, D}; SO S; S.init(M, D, F.G, (int)blockIdx.x); pg8::EpiResid<0, 0> E{F.x, nullptr, F.XB, SSQ1, nullptr};
        pg8::gemm_phase<pg8::EpiResid<0, 0>, SO, true, true>(F.lds, g, S, E, F.wave); } SEAM(5);
    STAMP(6); if (IN(6)) { pg8::Gemm g{F.XB, F.Wup0, M, FF, D}; SO S; S.init(M, FF, F.G, (int)blockIdx.x); pg8::EpiScale<1> E{F.R1, FF, SSQ1};
        pg8::gemm_phase<pg8::EpiScale<1>, SO, true, true>(F.lds, g, S, E, F.wave); } SEAM(6);
    STAMP(7); if (IN(7)) { pg8::Gemm g{F.R1, F.Wdn0, M, D, FF}; SO S; S.init(M, D, F.G, (int)blockIdx.x); pg8::EpiResid<1, 0> E{F.XB, nullptr, F.XB, SSQ2, SSQ1};
        pg8::gemm_phase<pg8::EpiResid<1, 0>, SO, true, true>(F.lds, g, S, E, F.wave); } SEAM(7);
    STAMP(8); if (IN(8)) { pg8::Gemm g{F.XB, F.Winc, M, NC, D}; SO S; S.init(M, NC, F.G, (int)blockIdx.x); pg8::EpiQKNorm E{F.R1, NC, SSQ2, F.gq_c, F.gk_c, (LAS float*)(F.lds + RING_BYTES), att::C2};
        pg8::gemm_phase<pg8::EpiQKNorm, SO, true, true>(F.lds, g, S, E, F.wave); } SEAM(8);
    STAMP(9);
    STAMP(10); if (IN(10)) { ph_sb(F); } SEAM(10);
    STAMP(11); if (IN(11)) { pg8::Gemm g{F.CAT, F.Woc, M, D, D}; SO S; S.init(M, D, F.G, (int)blockIdx.x); pg8::EpiResid<1, 0> E{F.XB, nullptr, F.XB, SSQ3, nullptr};
        pg8::gemm_phase<pg8::EpiResid<1, 0>, SO, true, true>(F.lds, g, S, E, F.wave); } SEAM(11);
    STAMP(12); if (IN(12)) { pg8::Gemm g{F.XB, F.Wup1, M, FF, D}; SO S; S.init(M, FF, F.G, (int)blockIdx.x); pg8::EpiScale<1> E{F.R1, FF, SSQ3};
        pg8::gemm_phase<pg8::EpiScale<1>, SO, true, true>(F.lds, g, S, E, F.wave); } SEAM(12);
    STAMP(13); if (IN(13)) { pg8::Gemm g{F.R1, F.Wdn1, M, D, FF}; SO S; S.init(M, D, F.G, (int)blockIdx.x); pg8::EpiResid<1, 1> E{F.XB, F.out, nullptr, nullptr, SSQ3};
        pg8::gemm_phase<pg8::EpiResid<1, 1>, SO, true, true>(F.lds, g, S, E, F.wave); }
    STAMP(NPH);
#ifdef PROBE_TOTAL
    if (blockIdx.x == 0) { const unsigned long long t1 = __builtin_amdgcn_s_memrealtime(), dt = (t1 - pt_start); while (__builtin_amdgcn_s_memrealtime() - t1 < dt) __builtin_amdgcn_s_sleep(8); }
#endif
#ifdef PROBE_ACC
    if (blockIdx.x == 0) { const unsigned long long t1 = __builtin_amdgcn_s_memrealtime(), dt = F.acc_sum * PROBE_MULT; while (__builtin_amdgcn_s_memrealtime() - t1 < dt) __builtin_amdgcn_s_sleep(8); }
#endif
#ifdef PROBE_PH
    if (blockIdx.x == 0) { const unsigned long long t1 = __builtin_amdgcn_s_memrealtime(), dt = (pt1 - pt0) * PROBE_MULT; while (__builtin_amdgcn_s_memrealtime() - t1 < dt) __builtin_amdgcn_s_sleep(8); }
#endif
#undef IN
#undef SEAM
}

extern "C" void kernel_launch(void* const* d_in, const int* in_sizes, int n_in, void* d_out, int out_size, void* d_ws, size_t ws_size, hipStream_t stream) {
    static int grid = 0;
    if (grid == 0) {
        if (n_in != 16 || in_sizes[0] != M * D || out_size != M * D || ws_size < WS_END) { fprintf(stderr, "kernel_launch: unexpected shapes / workspace (%d inputs, ws %zu)\n", n_in, ws_size); grid = -1; return; }
        int dev = 0, cus = 0;
        if (hipGetDevice(&dev) != hipSuccess || hipDeviceGetAttribute(&cus, hipDeviceAttributeMultiprocessorCount, dev) != hipSuccess) { grid = -1; return; }
        if (hipFuncSetAttribute((const void*)mk_fwd, hipFuncAttributeMaxDynamicSharedMemorySize, LDS_BYTES) != hipSuccess) { fprintf(stderr, "kernel_launch: hipFuncSetAttribute failed\n"); grid = -1; return; }
        (void)hipGetLastError();
        grid = cus;
    }
    if (grid < 0) return;
    if (hipMemsetAsync((char*)d_ws + WS_CTL, 0, CTL_ZERO_BYTES, stream) != hipSuccess) { fprintf(stderr, "kernel_launch: memset failed\n"); return; }
    Args a{};
    for (int i = 0; i < 16; ++i) a.in[i] = (const float*)d_in[i];
    a.out = (float*)d_out; a.ws = (unsigned char*)d_ws;
#if MK_PER_PHASE
    for (int ph = 0; ph < NPH; ++ph) { a.ph_lo = ph; a.ph_hi = ph + 1; hipLaunchKernelGGL(mk_fwd, dim3(grid), dim3(NTHR), LDS_BYTES, stream, a); }
#else
    a.ph_lo = 0; a.ph_hi = NPH;
    hipLaunchKernelGGL(mk_fwd, dim3(grid), dim3(NTHR), LDS_BYTES, stream, a);
#endif
    const hipError_t le = hipPeekAtLastError();
    if (le != hipSuccess) fprintf(stderr, "kernel_launch: launch failed: %s\n", hipGetErrorName(le));
}
```

```cpp
#include <hip/hip_runtime.h>
#include <cstdio>
#include <cstdint>
namespace pg8 {
#define PG8_LAS __attribute__((address_space(3)))
typedef unsigned short bf16_t;
typedef short bf16x8 __attribute__((ext_vector_type(8)));
typedef float f32x4 __attribute__((ext_vector_type(4)));
typedef unsigned u32x4 __attribute__((ext_vector_type(4)));
constexpr int BM = 256, BK = 64, HALF = 128, HTB = HALF * BK * 2  , STAGE_BYTES = 8 * HTB, NXCD = 8, WGM = 8;

__host__ __device__ __forceinline__ int lds_byte(int r, int c) { const int st = (r >> 4) * 2 + (c >> 5), rr = r & 15, cc = c & 31, ob = rr * 64 + cc * 2; return st * 1024 + (ob ^ (((ob >> 9) & 1) << 5)); }
__host__ __device__ __forceinline__ void stage_rc(int b, int& R, int& C) { const int st = b / 1024, sb = b % 1024, swz = sb ^ (((sb >> 9) & 1) << 5); R = (st >> 1) * 16 + swz / 64; C = (st & 1) * 32 + (swz % 64) / 2; }
__host__ __device__ __forceinline__ int perm32(int rho) { const int n = rho >> 4, i = rho & 15; return 8 * (i >> 2) + 4 * n + (i & 3); }

struct Unit { int pm, pn; };
struct Gemm { const bf16_t* A; const bf16_t* Bt; int M, N, K; };

struct StaticOrder {
    int nM, nN, nwg, G, c;
    __host__ __device__ void init(int M, int N, int G_, int c_) { nM = M / BM; nN = N / BM; nwg = nM * nN; G = G_; c = c_; }
    __host__ __device__ bool next(int i, Unit& u) const {
        const long L = (long)i * G + c; if (L >= nwg) return false;
        int wgid = (int)L; { const int q = nwg / NXCD, r = nwg % NXCD, xcd = wgid % NXCD, off = wgid / NXCD; wgid = (xcd < r ? xcd * (q + 1) : r * (q + 1) + (xcd - r) * q) + off; }
        const int nig = WGM * nN, gid = wgid / nig, fm = gid * WGM, gsz = (nM - fm) < WGM ? (nM - fm) : WGM;
        u.pm = fm + ((wgid % nig) % gsz); u.pn = (wgid % nig) / gsz; return true;
    }
    __device__ __forceinline__ void a_ready(const Unit&) const {}
    __device__ __forceinline__ void done(const Unit&) const {}
};

__device__ __forceinline__ unsigned cvt_pk_bf16(float lo, float hi) { unsigned r; asm volatile("v_cvt_pk_bf16_f32 %0, %1, %2" : "=v"(r) : "v"(lo), "v"(hi)); return r; }
__device__ __forceinline__ float row_rstd(const float* ssqp, int row) {
    const f32x4* p = (const f32x4*)(ssqp + (size_t)row * 16);
    const f32x4 a = p[0], b = p[1], c = p[2], d = p[3];
    const float s = (((a[0] + a[1]) + (a[2] + a[3])) + ((b[0] + b[1]) + (b[2] + b[3]))) + (((c[0] + c[1]) + (c[2] + c[3])) + ((d[0] + d[1]) + (d[2] + d[3])));
    return rsqrtf(s * (1.0f / 1024.0f) + 1e-6f);
}
__device__ __forceinline__ int epi_lane() { int l; asm volatile("v_mbcnt_lo_u32_b32 %0, -1, 0\n\tv_mbcnt_hi_u32_b32 %0, -1, %0" : "=v"(l)); return l; }
template <int ACT  > struct EpiScale {
    static constexpr bool PERM = true, AFTER_DRAIN = false;
    bf16_t* O; int ldc; const float* ssqp;
    __device__ __forceinline__ void operator()(const f32x4 (&acc)[2][2][4][2], const Unit& u, int wr, int wc, int fr, int fq) const {
        const int row0 = u.pm * BM + wr * 64 + fr, col0 = u.pn * BM + wc * 32 + 8 * fq;
#pragma unroll
        for (int ai = 0; ai < 2; ++ai)
#pragma unroll
            for (int m = 0; m < 4; ++m) {
                const int row = row0 + ai * HALF + m * 16;
                const float rs = (ACT == 0) ? row_rstd(ssqp, row) : 1.0f;
                bf16_t* rowp = O + (size_t)row * ldc + col0;
#pragma unroll
                for (int bj = 0; bj < 2; ++bj) {
                    f32x4 v0 = acc[ai][bj][m][0] * rs, v1 = acc[ai][bj][m][1] * rs;
                    if (ACT == 1) {
#pragma unroll
                        for (int e = 0; e < 4; ++e) { const float a0 = fmaxf(v0[e], 0.f), a1 = fmaxf(v1[e], 0.f); v0[e] = a0 * a0; v1[e] = a1 * a1; }
                    }
                    u32x4 w; w.x = cvt_pk_bf16(v0[0], v0[1]); w.y = cvt_pk_bf16(v0[2], v0[3]); w.z = cvt_pk_bf16(v1[0], v1[1]); w.w = cvt_pk_bf16(v1[2], v1[3]);
                    *(u32x4*)(rowp + bj * HALF) = w;
                }
            }
    }
};
template <int RIN, int OUT> struct EpiResid {
    static constexpr bool PERM = true, AFTER_DRAIN = false;
    const void* R; float* out; bf16_t* hb; float* ssqp; const float* ssq_in;
    __device__ __forceinline__ void operator()(const f32x4 (&acc)[2][2][4][2], const Unit& u, int wr, int wc, int fr, int fq) const {
        const int row0 = u.pm * BM + wr * 64 + fr, col0 = u.pn * BM + wc * 32 + 8 * fq;
        constexpr int MB = 2;
        constexpr int NW = (RIN == 0) ? 2 : 1;
#pragma unroll
        for (int ai = 0; ai < 2; ++ai)
#pragma unroll
            for (int m0 = 0; m0 < 4; m0 += MB) {
                u32x4 rw[MB][2][NW]; f32x4 pp[MB][4];
#pragma unroll
                for (int mm = 0; mm < MB; ++mm)
#pragma unroll
                    for (int bj = 0; bj < 2; ++bj) { const unsigned off = (unsigned)((row0 + ai * HALF + (m0 + mm) * 16) * 1024 + col0 + bj * HALF);
                        if (RIN == 0) { rw[mm][bj][0] = *(const u32x4*)((const char*)R + off * 4u); rw[mm][bj][NW - 1] = *(const u32x4*)((const char*)R + off * 4u + 16u); }
                        else rw[mm][bj][0] = *(const u32x4*)((const char*)R + off * 2u); }
                if (ssq_in) {
#pragma unroll
                    for (int mm = 0; mm < MB; ++mm) { const f32x4* p = (const f32x4*)((const char*)ssq_in + (unsigned)(row0 + ai * HALF + (m0 + mm) * 16) * 64u);
#pragma unroll
                        for (int k = 0; k < 4; ++k) pp[mm][k] = p[k]; } }
                asm volatile("" ::: "memory");
#pragma unroll
                for (int mm = 0; mm < MB; ++mm) {
                    const int m = m0 + mm, row = row0 + ai * HALF + m * 16;
                    const unsigned off = (unsigned)(row * 1024 + col0);
                    float sc2 = 1.0f;
                    if (ssq_in) { const f32x4 a = pp[mm][0], b = pp[mm][1], c = pp[mm][2], d = pp[mm][3];
                        const float sum = (((a[0] + a[1]) + (a[2] + a[3])) + ((b[0] + b[1]) + (b[2] + b[3]))) + (((c[0] + c[1]) + (c[2] + c[3])) + ((d[0] + d[1]) + (d[2] + d[3])));
                        const float rs = rsqrtf(sum * (1.0f / 1024.0f) + 1e-6f); sc2 = rs * rs; }
                    float ss = 0.f;
#pragma unroll
                    for (int bj = 0; bj < 2; ++bj) {
                        f32x4 r0, r1;
                        if (RIN == 0) { r0 = __builtin_bit_cast(f32x4, rw[mm][bj][0]); r1 = __builtin_bit_cast(f32x4, rw[mm][bj][NW - 1]); }
                        else { const u32x4 w = rw[mm][bj][0];
                            r0 = (f32x4){__uint_as_float(w.x << 16), __uint_as_float(w.x & 0xffff0000u), __uint_as_float(w.y << 16), __uint_as_float(w.y & 0xffff0000u)};
                            r1 = (f32x4){__uint_as_float(w.z << 16), __uint_as_float(w.z & 0xffff0000u), __uint_as_float(w.w << 16), __uint_as_float(w.w & 0xffff0000u)}; }
                        const f32x4 v0 = acc[ai][bj][m][0] * sc2 + r0, v1 = acc[ai][bj][m][1] * sc2 + r1;
                        if (OUT == 1) { *(f32x4*)((char*)out + (off + bj * HALF) * 4u) = v0; *(f32x4*)((char*)out + (off + bj * HALF) * 4u + 16u) = v1; }
                        else {
                            u32x4 w; w.x = cvt_pk_bf16(v0[0], v0[1]); w.y = cvt_pk_bf16(v0[2], v0[3]); w.z = cvt_pk_bf16(v1[0], v1[1]); w.w = cvt_pk_bf16(v1[2], v1[3]);
                            *(u32x4*)((char*)hb + (off + bj * HALF) * 2u) = w;
                            ss += ((v0[0] * v0[0] + v0[1] * v0[1]) + (v0[2] * v0[2] + v0[3] * v0[3])) + ((v1[0] * v1[0] + v1[1] * v1[1]) + (v1[2] * v1[2] + v1[3] * v1[3]));
                        }
                    }
                    if (OUT == 0) { ss += __shfl_xor(ss, 16); ss += __shfl_xor(ss, 32); if (fq == 0) *(float*)((char*)ssqp + (unsigned)(row * 16 + u.pn * 4 + wc) * 4u) = ss; }
                }
            }
    }
};
struct EpiQKNorm {
    static constexpr bool PERM = true, AFTER_DRAIN = false;
    bf16_t* O; int ldc; const float* ssqp; const float* gq; const float* gk; PG8_LAS float* part; float qscale;
    __device__ __forceinline__ void operator()(const f32x4 (&acc)[2][2][4][2], const Unit& u, int wr, int wc, int fr_, int fq_) const {
        const int ln = epi_lane(), fr = ln & 15, fq = ln >> 4;
        const int row0 = u.pm * BM + wr * 64 + fr, col0 = u.pn * BM + wc * 32 + 8 * fq;
        const bool nrm = u.pn < 8;
        const int pbase = (wr * 64 + fr) * 8;
        PG8_LAS float* pr = part + pbase; PG8_LAS float* pw = pr + wc;
        float rsv[2][4];
#pragma unroll
        for (int ai = 0; ai < 2; ++ai) { f32x4 pp[4][4];
#pragma unroll
            for (int m = 0; m < 4; ++m) { const f32x4* p = (const f32x4*)((const char*)ssqp + (unsigned)(row0 + ai * HALF + m * 16) * 64u);
#pragma unroll
                for (int k = 0; k < 4; ++k) pp[m][k] = p[k]; }
#pragma unroll
            for (int m = 0; m < 4; ++m) { const f32x4 a = pp[m][0], b = pp[m][1], c = pp[m][2], d = pp[m][3];
                const float sum = (((a[0] + a[1]) + (a[2] + a[3])) + ((b[0] + b[1]) + (b[2] + b[3]))) + (((c[0] + c[1]) + (c[2] + c[3])) + ((d[0] + d[1]) + (d[2] + d[3])));
                rsv[ai][m] = rsqrtf(sum * (1.0f / 1024.0f) + 1e-6f); asm volatile("" : "+v"(rsv[ai][m]) :: "memory"); } }
        f32x4 g0 = (f32x4){1.f, 1.f, 1.f, 1.f}, g1 = g0;
        if (nrm) {
#pragma unroll
            for (int ai = 0; ai < 2; ++ai)
#pragma unroll
                for (int m = 0; m < 4; ++m)
#pragma unroll
                    for (int bj = 0; bj < 2; ++bj) { const f32x4 v0 = acc[ai][bj][m][0], v1 = acc[ai][bj][m][1];
                        float ss = ((v0[0] * v0[0] + v0[1] * v0[1]) + (v0[2] * v0[2] + v0[3] * v0[3])) + ((v1[0] * v1[0] + v1[1] * v1[1]) + (v1[2] * v1[2] + v1[3] * v1[3]));
                        ss += __shfl_xor(ss, 16); ss += __shfl_xor(ss, 32);
                        if (fq == 0) pw[((ai * HALF + m * 16) * 2 + bj) * 4] = ss; }
            asm volatile("s_waitcnt lgkmcnt(0)" ::: "memory"); __builtin_amdgcn_s_barrier(); asm volatile("" ::: "memory");
            const float* gp = (u.pn < 4 ? gq : gk) + wc * 32 + 8 * fq; const float sc = (u.pn < 4) ? qscale : 1.0f;
            g0 = *(const f32x4*)gp * sc; g1 = *(const f32x4*)(gp + 4) * sc;
        }
#pragma unroll
        for (int ai = 0; ai < 2; ++ai)
#pragma unroll
            for (int m = 0; m < 4; ++m) {
                const int row = row0 + ai * HALF + m * 16;
                const float rsr = rsv[ai][m];
                bf16_t* rowp = O + (size_t)row * ldc + col0;
#pragma unroll
                for (int bj = 0; bj < 2; ++bj) {
                    float hs = rsr;
                    if (nrm) { const f32x4 pp = *(const PG8_LAS f32x4*)(pr + ((ai * HALF + m * 16) * 2 + bj) * 4);
                        hs *= rsqrtf(((pp[0] + pp[1]) + (pp[2] + pp[3])) * (rsr * rsr * (1.0f / 128.0f)) + 1e-6f); }
                    const f32x4 v0 = acc[ai][bj][m][0] * hs * g0, v1 = acc[ai][bj][m][1] * hs * g1;
                    u32x4 w; w.x = cvt_pk_bf16(v0[0], v0[1]); w.y = cvt_pk_bf16(v0[2], v0[3]); w.z = cvt_pk_bf16(v1[0], v1[1]); w.w = cvt_pk_bf16(v1[2], v1[3]);
                    *(u32x4*)(rowp + bj * HALF) = w;
                }
            }
    }
};
struct EpiProjAB {
    static constexpr bool PERM = true, AFTER_DRAIN = false;
    bf16_t* O; int ldc; const float* ssqp; const float* gq; const float* gk; const float* r128; const float* r64; PG8_LAS float* part; float qscale;
    __device__ __forceinline__ void operator()(const f32x4 (&acc)[2][2][4][2], const Unit& u, int wr, int wc, int fr_, int fq_) const {
        const int ln = epi_lane(), fr = ln & 15, fq = ln >> 4;
        const int cb = wc * 32 + 8 * fq;
        const int row0 = u.pm * BM + wr * 64 + fr, col0 = u.pn * BM + cb, pn = u.pn;
        const bool qk = pn < 4, iq = (pn == 6) || (pn == 7) || (pn == 14);
        const int pbase = (wr * 64 + fr) * 8;
        PG8_LAS float* pr = part + pbase; PG8_LAS float* pw = pr + wc;
        const bool rope_qk = qk && (wc == 0), rope_iq = iq && !(wc & 1) && (pn != 14 || wc == 0);
        float rsv[2][4];
#pragma unroll
        for (int ai = 0; ai < 2; ++ai)
#pragma unroll
            for (int m = 0; m < 4; ++m) rsv[ai][m] = *(const float*)((const char*)ssqp + (unsigned)(row0 + ai * HALF + m * 16) * 64u);
#pragma unroll
        for (int ai = 0; ai < 2; ++ai)
#pragma unroll
            for (int m = 0; m < 4; ++m) rsv[ai][m] = rsqrtf(rsv[ai][m] * (1.0f / 1024.0f) + 1e-6f);
        f32x4 g0 = (f32x4){1.f, 1.f, 1.f, 1.f}, g1 = g0;
        if (qk) {
#pragma unroll
            for (int ai = 0; ai < 2; ++ai)
#pragma unroll
                for (int m = 0; m < 4; ++m)
#pragma unroll
                    for (int bj = 0; bj < 2; ++bj) { const f32x4 v0 = acc[ai][bj][m][0], v1 = acc[ai][bj][m][1];
                        float ss = ((v0[0] * v0[0] + v0[1] * v0[1]) + (v0[2] * v0[2] + v0[3] * v0[3])) + ((v1[0] * v1[0] + v1[1] * v1[1]) + (v1[2] * v1[2] + v1[3] * v1[3]));
                        ss += __shfl_xor(ss, 16); ss += __shfl_xor(ss, 32);
                        if (fq == 0) pw[((ai * HALF + m * 16) * 2 + bj) * 4] = ss; }
            asm volatile("s_waitcnt lgkmcnt(0)" ::: "memory"); __builtin_amdgcn_s_barrier(); asm volatile("" ::: "memory");
            const float* gp = (pn < 2 ? gq : gk) + cb; const float sc = (pn < 2) ? qscale : 1.0f;
            g0 = *(const f32x4*)gp * sc; g1 = *(const f32x4*)(gp + 4) * sc;
        }
#pragma unroll
        for (int ai = 0; ai < 2; ++ai) {
            f32x4 cc[4][4];
            if (rope_qk || rope_iq) {
#pragma unroll
                for (int m = 0; m < 4; ++m) { const int pos = (row0 + ai * HALF + m * 16) & 2047;
                    const float* t = rope_qk ? (r128 + pos * 32 + 8 * (fq & 1)) : (r64 + pos * 16); const int so = rope_qk ? 16 : 8;
                    cc[m][0] = *(const f32x4*)t; cc[m][1] = *(const f32x4*)(t + 4); cc[m][2] = *(const f32x4*)(t + so); cc[m][3] = *(const f32x4*)(t + so + 4); }
            }
#pragma unroll
            for (int m = 0; m < 4; ++m) {
                const int row = row0 + ai * HALF + m * 16;
                const float rsr = rsv[ai][m];
                bf16_t* rowp = O + (size_t)row * ldc + col0;
                const f32x4 c0 = cc[m][0], c1 = cc[m][1], s0 = cc[m][2], s1 = cc[m][3];
#pragma unroll
                for (int bj = 0; bj < 2; ++bj) {
                    float hs = rsr;
                    if (qk) { const f32x4 pp = *(const PG8_LAS f32x4*)(pr + ((ai * HALF + m * 16) * 2 + bj) * 4);
                        hs *= rsqrtf(((pp[0] + pp[1]) + (pp[2] + pp[3])) * (rsr * rsr * (1.0f / 128.0f)) + 1e-6f); }
                    f32x4 v0 = acc[ai][bj][m][0] * hs * g0, v1 = acc[ai][bj][m][1] * hs * g1;
                    if (rope_qk) {
                        f32x4 p0, p1;
#pragma unroll
                        for (int e = 0; e < 4; ++e) { p0[e] = __shfl_xor(v0[e], 32); p1[e] = __shfl_xor(v1[e], 32); }
                        if (fq < 2) { v0 = v0 * c0 - p0 * s0; v1 = v1 * c1 - p1 * s1; } else { v0 = v0 * c0 + p0 * s0; v1 = v1 * c1 + p1 * s1; }
                    } else if (rope_iq && (pn != 14 || bj == 0)) {
                        f32x4 p0, p1;
#pragma unroll
                        for (int e = 0; e < 4; ++e) { p0[e] = __shfl_xor(v0[e], 16); p1[e] = __shfl_xor(v1[e], 16); }
                        if (fq == 0) { v0 = v0 * c0 - p0 * s0; v1 = v1 * c1 - p1 * s1; } else if (fq == 1) { v0 = v0 * c0 + p0 * s0; v1 = v1 * c1 + p1 * s1; }
                    }
                    u32x4 w; w.x = cvt_pk_bf16(v0[0], v0[1]); w.y = cvt_pk_bf16(v0[2], v0[3]); w.z = cvt_pk_bf16(v1[0], v1[1]); w.w = cvt_pk_bf16(v1[2], v1[3]);
                    *(u32x4*)(rowp + bj * HALF) = w;
                }
            }
        }
    }
};
template <class Epi, class Sched, bool ALIGN_EPI = false, bool SP2 = false>
__device__ __forceinline__ void gemm_phase(PG8_LAS unsigned char* lds, const Gemm g, const Sched& S, const Epi& E, const int wave_in) {
    const int wid = wave_in, lane = (int)__builtin_amdgcn_mbcnt_hi(~0u, __builtin_amdgcn_mbcnt_lo(~0u, 0u)), tid = wid * 64 + lane, wr = wid >> 2, wc = wid & 3, fr = lane & 15, fq = lane >> 4;
    const int K = g.K, nt = K / BK;
    unsigned voffA[2], voffB[2];
#pragma unroll
    for (int i = 0; i < 2; ++i) { int R, C; stage_rc(tid * 16 + i * 8192, R, C); const int Rb = Epi::PERM ? ((R & ~31) + perm32(R & 31)) : R;
        voffA[i] = (unsigned)(R * K + C) * 2u; voffB[i] = (unsigned)(Rb * K + C) * 2u; }
    const size_t kstep = (size_t)(BK * 2);
    const size_t hstep = (size_t)HALF * K * 2;
    const size_t tstep = 2 * hstep;
    const unsigned ldsw = (unsigned)wid * 1024u;
    const int aoff = lds_byte(wr * 64 + fr, fq * 8), boff = lds_byte(wc * 32 + fr, fq * 8);
#define PG8_SA(b, h) (((b) * 2 + (h)) * HTB)
#define PG8_SB(b, h) ((4 + (b) * 2 + (h)) * HTB)
#define PG8_STAGE(bufoff, gbase, voff) do { _Pragma("unroll") for (int _i = 0; _i < 2; ++_i) \
        __builtin_amdgcn_global_load_lds((const unsigned*)((const char*)(gbase) + (voff)[_i]), (PG8_LAS unsigned*)(lds + (bufoff) + ldsw + _i * 8192), 16, 0, 0); } while (0)
#define PG8_LDA(dst, b, h) do { _Pragma("unroll") for (int m = 0; m < 4; ++m) _Pragma("unroll") for (int k = 0; k < 2; ++k) dst[m][k] = *(const PG8_LAS bf16x8*)(lds + PG8_SA(b, h) + aoff + m * 2048 + k * 1024); } while (0)
#define PG8_LDB(dst, b, h) do { _Pragma("unroll") for (int n = 0; n < 2; ++n) _Pragma("unroll") for (int k = 0; k < 2; ++k) dst[n][k] = *(const PG8_LAS bf16x8*)(lds + PG8_SB(b, h) + boff + n * 2048 + k * 1024); } while (0)
#define PG8_MMA(ai, bj, At, Bt) do { __builtin_amdgcn_s_setprio(1); _Pragma("unroll") for (int m = 0; m < 4; ++m) _Pragma("unroll") for (int n = 0; n < 2; ++n) _Pragma("unroll") for (int k = 0; k < 2; ++k) \
        acc[ai][bj][m][n] = __builtin_amdgcn_mfma_f32_16x16x32_bf16(Bt[n][k], At[m][k], acc[ai][bj][m][n], 0, 0, 0); __builtin_amdgcn_s_setprio(0); } while (0)
#define PG8_WAIT_V(n) asm volatile("s_waitcnt vmcnt(" #n ")" ::: "memory")
#define PG8_WAIT_L(n) asm volatile("s_waitcnt lgkmcnt(" #n ")" ::: "memory")
#define PG8_BAR __builtin_amdgcn_s_barrier()
#define PG8_SCHED __builtin_amdgcn_sched_barrier(0)
    Unit cur, nxt; int ui = 0;
    if (!S.next(0, cur)) return;
    f32x4 acc[2][2][4][2];
#pragma unroll
    for (int a = 0; a < 2; ++a)
#pragma unroll
        for (int b = 0; b < 2; ++b)
#pragma unroll
            for (int m = 0; m < 4; ++m)
#pragma unroll
                for (int n = 0; n < 2; ++n) acc[a][b][m][n] = (f32x4){0.f, 0.f, 0.f, 0.f};
    bf16x8 At[4][2], B0[2][2], B1[2][2];
    const char* cA = (const char*)g.A + (size_t)cur.pm * tstep; const char* cB = (const char*)g.Bt + (size_t)cur.pn * tstep;
    S.a_ready(cur);
    if constexpr (SP2) {
        PG8_STAGE(PG8_SB(0, 0), cB, voffB); PG8_STAGE(PG8_SB(0, 1), cB + hstep, voffB); PG8_STAGE(PG8_SA(0, 0), cA, voffA); PG8_STAGE(PG8_SA(0, 1), cA + hstep, voffA);
        if (wr == 1) PG8_BAR;
        PG8_WAIT_V(2); PG8_BAR;
        PG8_STAGE(PG8_SB(1, 0), cB + kstep, voffB); PG8_STAGE(PG8_SA(1, 0), cA + kstep, voffA); PG8_STAGE(PG8_SB(1, 1), cB + hstep + kstep, voffB);
        PG8_WAIT_V(6); PG8_BAR;
    } else {
        PG8_STAGE(PG8_SB(0, 0), cB, voffB); PG8_STAGE(PG8_SA(0, 0), cA, voffA); PG8_STAGE(PG8_SB(0, 1), cB + hstep, voffB); PG8_STAGE(PG8_SA(0, 1), cA + hstep, voffA);
        if (wr == 1) PG8_BAR;
        PG8_WAIT_V(4); PG8_BAR;
        PG8_STAGE(PG8_SB(1, 0), cB + kstep, voffB); PG8_STAGE(PG8_SA(1, 0), cA + kstep, voffA); PG8_STAGE(PG8_SB(1, 1), cB + hstep + kstep, voffB);
        PG8_WAIT_V(6); PG8_BAR;
    }
    for (;;) {
        const bool has_next = S.next(ui + 1, nxt);
        const char* nA = has_next ? (const char*)g.A + (size_t)nxt.pm * tstep : cA; const char* nB = has_next ? (const char*)g.Bt + (size_t)nxt.pn * tstep : cB;
        for (int t = 0; t < nt; t += 2) {
            const bool last = (t == nt - 2);
            const char* a1 = cA + (size_t)(t + 1) * kstep;
            const char* a2 = last ? nA : cA + (size_t)(t + 2) * kstep; const char* b2 = last ? nB : cB + (size_t)(t + 2) * kstep;
            const char* a3 = a2 + kstep; const char* b3 = b2 + kstep;
            if (last && has_next) S.a_ready(nxt);
            if constexpr (SP2) {
            PG8_LDB(B0, 0, 0); PG8_LDB(B1, 0, 1); PG8_SCHED; PG8_LDA(At, 0, 0); PG8_STAGE(PG8_SA(1, 1), a1 + hstep, voffA);
            PG8_WAIT_V(8); PG8_WAIT_L(0); PG8_BAR; PG8_MMA(0, 0, At, B0); PG8_MMA(0, 1, At, B1); PG8_BAR; PG8_SCHED;
            PG8_LDA(At, 0, 1); PG8_STAGE(PG8_SB(0, 0), b2, voffB); PG8_STAGE(PG8_SB(0, 1), b2 + hstep, voffB); PG8_STAGE(PG8_SA(0, 0), a2, voffA);
            PG8_WAIT_V(8); PG8_WAIT_L(0); PG8_BAR; PG8_MMA(1, 0, At, B0); PG8_MMA(1, 1, At, B1); PG8_BAR; PG8_SCHED;
            PG8_LDB(B0, 1, 0); PG8_LDB(B1, 1, 1); PG8_SCHED; PG8_LDA(At, 1, 0); PG8_STAGE(PG8_SA(0, 1), a2 + hstep, voffA);
            PG8_WAIT_V(8); PG8_WAIT_L(0); PG8_BAR; PG8_MMA(0, 0, At, B0); PG8_MMA(0, 1, At, B1); PG8_BAR; PG8_SCHED;
            PG8_LDA(At, 1, 1); PG8_STAGE(PG8_SB(1, 0), b3, voffB); PG8_STAGE(PG8_SB(1, 1), b3 + hstep, voffB); PG8_STAGE(PG8_SA(1, 0), a3, voffA);
            PG8_WAIT_V(8); PG8_WAIT_L(0); PG8_BAR; PG8_MMA(1, 0, At, B0); PG8_MMA(1, 1, At, B1); PG8_BAR; PG8_SCHED;
            } else {
            PG8_LDB(B0, 0, 0); PG8_SCHED; PG8_LDA(At, 0, 0); PG8_STAGE(PG8_SA(1, 1), a1 + hstep, voffA);
            PG8_WAIT_L(8); PG8_BAR; PG8_WAIT_L(0); PG8_MMA(0, 0, At, B0); PG8_BAR; PG8_SCHED;
            PG8_LDB(B1, 0, 1); PG8_STAGE(PG8_SB(0, 0), b2, voffB);
            PG8_BAR; PG8_WAIT_L(0); PG8_MMA(0, 1, At, B1); PG8_BAR;
            PG8_LDA(At, 0, 1); PG8_STAGE(PG8_SA(0, 0), a2, voffA);
            PG8_BAR; PG8_WAIT_L(0); PG8_MMA(1, 0, At, B0); PG8_BAR; PG8_SCHED;
            PG8_STAGE(PG8_SB(0, 1), b2 + hstep, voffB);
            PG8_WAIT_V(6); PG8_BAR; PG8_MMA(1, 1, At, B1); PG8_BAR;
            PG8_LDB(B0, 1, 0); PG8_SCHED; PG8_LDA(At, 1, 0); PG8_STAGE(PG8_SA(0, 1), a2 + hstep, voffA);
            PG8_WAIT_L(8); PG8_BAR; PG8_WAIT_L(0); PG8_MMA(0, 0, At, B0); PG8_BAR; PG8_SCHED;
            PG8_LDB(B1, 1, 1); PG8_STAGE(PG8_SB(1, 0), b3, voffB);
            PG8_BAR; PG8_WAIT_L(0); PG8_MMA(0, 1, At, B1); PG8_BAR;
            PG8_LDA(At, 1, 1); PG8_STAGE(PG8_SA(1, 0), a3, voffA);
            PG8_BAR; PG8_WAIT_L(0); PG8_MMA(1, 0, At, B0); PG8_BAR; PG8_SCHED;
            PG8_STAGE(PG8_SB(1, 1), b3 + hstep, voffB);
            PG8_WAIT_V(6); PG8_BAR; PG8_MMA(1, 1, At, B1); PG8_BAR;
            }
        }
        if constexpr (ALIGN_EPI) { if (wr == 0) PG8_BAR; }
        if constexpr (!Epi::AFTER_DRAIN) { E(acc, cur, wr, wc, fr, fq); S.done(cur); }
        if (!has_next) break;
#pragma unroll
        for (int a = 0; a < 2; ++a)
#pragma unroll
            for (int b = 0; b < 2; ++b)
#pragma unroll
                for (int m = 0; m < 4; ++m)
#pragma unroll
                    for (int n = 0; n < 2; ++n) acc[a][b][m][n] = (f32x4){0.f, 0.f, 0.f, 0.f};
        cur = nxt; cA = nA; cB = nB; ++ui;
        if constexpr (ALIGN_EPI) { if (wr == 1) PG8_BAR; }
    }
    PG8_WAIT_V(0);
    if constexpr (!ALIGN_EPI) { if (wr == 0) PG8_BAR; }
    PG8_BAR;
    if constexpr (Epi::AFTER_DRAIN) { E.fused(acc, cur, wr, wc, fr, fq, lds, wid, lane); S.done(cur); }
#undef PG8_SA
#undef PG8_SB
#undef PG8_STAGE
#undef PG8_LDA
#undef PG8_LDB
#undef PG8_MMA
#undef PG8_WAIT_V
#undef PG8_WAIT_L
#undef PG8_BAR
#undef PG8_SCHED
}
}
#include <cmath>
constexpr int NWAVES = 8, NTHR = 512;
constexpr int BATCH = 16, SEQ = 2048, M = BATCH * SEQ, D = 1024, FF = 4096, NAB = 3840, NC = 3072, ABP_OLD = 3672;
constexpr int C_QA = 0, C_KA = 512, C_VA = 1024, C_IQ = 1536, C_QB = 2048, C_KB = 2304, C_VB = 2560, C_OG = 3072, C_IK = 3584, C_IW = 3648, C_GL = 3656;
constexpr float EPS = 1e-6f;
constexpr size_t MiB = 1u << 20;
constexpr size_t WS_CTL = 0, CTL_ZERO_BYTES = 64 * 1024;
constexpr size_t WS_WAB = 1 * MiB, WS_WOAB = 9 * MiB, WS_WUP0 = 11 * MiB, WS_WDN0 = 19 * MiB, WS_WINC = 27 * MiB, WS_WOC = 33 * MiB, WS_WUP1 = 35 * MiB, WS_WDN1 = 43 * MiB;
constexpr size_t WS_SSQ = 51 * MiB, SSQ_BYTES = 2 * MiB;
constexpr size_t WS_DEC = 59 * MiB;
constexpr size_t WS_ROPE = 59 * MiB + 512 * 1024;
constexpr size_t WS_XB = 60 * MiB;
constexpr size_t WS_CAT = 124 * MiB;
constexpr size_t WS_MASK = 188 * MiB;
constexpr size_t WS_R1 = 196 * MiB;
constexpr size_t WS_BC = 452 * MiB;
constexpr size_t WS_END = 484 * MiB;
constexpr int CW_BAR = 4096;
constexpr int RING_BYTES = 131072;
constexpr int LDS_BYTES = 163840;
constexpr int MISC_OFF = LDS_BYTES - 256;
#define GAS __attribute__((address_space(1)))
#define LAS __attribute__((address_space(3)))
typedef unsigned short bf16;
typedef unsigned v4u __attribute__((ext_vector_type(4)));
typedef float f32x4 __attribute__((ext_vector_type(4)));
typedef short bf16x8 __attribute__((ext_vector_type(8)));
typedef GAS unsigned gu32;
typedef GAS unsigned long long gu64;
#define RLX_AGENT __ATOMIC_RELAXED, __HIP_MEMORY_SCOPE_AGENT
#define LDS_WAIT() asm volatile("s_waitcnt lgkmcnt(0)" ::: "memory")
#define VM_WAIT() asm volatile("s_waitcnt vmcnt(0)" ::: "memory")
__device__ __forceinline__ unsigned long long rt() { return __builtin_amdgcn_s_memrealtime(); }
__device__ __forceinline__ unsigned f2bf(float f) { unsigned u = __builtin_bit_cast(unsigned, f); return (u + 0x7fffu + ((u >> 16) & 1u)) >> 16; }
__device__ __forceinline__ unsigned pk2(float lo, float hi) { return f2bf(lo) | (f2bf(hi) << 16); }
#define XB_TMO      128
#define XB_XCNT(j)  (256  + 64 * (j))
#define XB_XSUB(j)  (1280 + 64 * (j))
#define XB_XGEN(j)  (2304 + 64 * (j))
#define XB_TOP      3328
#define XB_TOPGEN   3392
#define XCD_BAR_WORDS 3456
#define XB_SPIN_CAP (1u << 18)

__device__ __forceinline__ unsigned xb_ld(unsigned* p)              { return __hip_atomic_load(p, __ATOMIC_RELAXED, __HIP_MEMORY_SCOPE_AGENT); }
__device__ __forceinline__ unsigned xb_add(unsigned* p, unsigned v) { return __hip_atomic_fetch_add(p, v, __ATOMIC_RELAXED, __HIP_MEMORY_SCOPE_AGENT); }
__device__ __forceinline__ unsigned xb_xcc_id() { return (unsigned)__builtin_amdgcn_s_getreg((3 << 11) | 20) & 0xFu; }
#define XB_SPIN(cond, bar) do { unsigned _sp = 0; while (cond) { __builtin_amdgcn_s_sleep(1); \
    if ((++_sp & 255u) == 0u) { if (xb_ld(&(bar)[XB_TMO])) break; if (_sp > XB_SPIN_CAP) { atomicAdd(&(bar)[XB_TMO], 1u); break; } } } } while (0)

struct XcdBarrier {
    unsigned* bar; unsigned x; int wave;
    volatile LAS unsigned* st;
};

__device__ __forceinline__ bool xb_t0(int wave) { return wave == 0 && __builtin_amdgcn_mbcnt_hi(~0u, __builtin_amdgcn_mbcnt_lo(~0u, 0u)) == 0u; }
__device__ __forceinline__ XcdBarrier xcd_barrier_post(unsigned* bar, volatile LAS unsigned* st, int wave) {
    XcdBarrier b; b.bar = bar; b.x = xb_xcc_id(); b.st = st; b.wave = wave;
    if (xb_t0(wave)) (void)xb_add(&bar[XB_XCNT(b.x)], 1u);
    return b;
}
__device__ __forceinline__ void xcd_barrier_complete(unsigned* bar, unsigned x, unsigned& nloc, unsigned& nx) {
    const unsigned G = gridDim.x * gridDim.y * gridDim.z;
    unsigned sum, cnt, mine, sp = 0u;
    for (;;) {
        sum = 0u; cnt = 0u; mine = 0u;
#pragma unroll
        for (unsigned j = 0; j < 16; ++j) { const unsigned c = xb_ld(&bar[XB_XCNT(j)]); sum += c; cnt += (c > 0u) ? 1u : 0u; mine = (j == x) ? c : mine; }
        if (sum == G) break;
        __builtin_amdgcn_s_sleep(1);
        if ((++sp & 255u) == 0u) { if (xb_ld(&bar[XB_TMO])) break; if (sp > XB_SPIN_CAP) { atomicAdd(&bar[XB_TMO], 1u); break; } }
    }
    nloc = mine > 0u ? mine : 1u; nx = cnt > 0u ? cnt : 1u;
}

__device__ __forceinline__ void xcd_barrier(const XcdBarrier& b) {
    asm volatile("s_waitcnt vmcnt(0)" ::: "memory");
    __syncthreads();
    if (xb_t0(b.wave)) {
        unsigned* bar = b.bar;
        __builtin_amdgcn_s_waitcnt(0);
        unsigned nloc = b.st[0], nx = b.st[1];
        if (nloc == 0u) { xcd_barrier_complete(bar, b.x, nloc, nx); b.st[0] = nloc; b.st[1] = nx; }
        const unsigned old = xb_add(&bar[XB_XSUB(b.x)], 1u);
        const unsigned gen = old / nloc;
        if (old + 1u == (gen + 1u) * nloc) {
            __builtin_amdgcn_fence(__ATOMIC_RELEASE, "agent");
            asm volatile("s_waitcnt vmcnt(0)" ::: "memory");
            const unsigned og = xb_add(&bar[XB_TOP], 1u);
            const unsigned tg = og / nx;
            if (og + 1u == (tg + 1u) * nx) xb_add(&bar[XB_TOPGEN], 1u);
            else XB_SPIN(xb_ld(&bar[XB_TOPGEN]) == tg, bar);
            __builtin_amdgcn_fence(__ATOMIC_ACQUIRE, "agent");
            xb_add(&bar[XB_XGEN(b.x)], 1u);
            asm volatile("s_waitcnt vmcnt(0)" ::: "memory");
        } else {
            XB_SPIN(xb_ld(&bar[XB_XGEN(b.x)]) == gen, bar);
            __builtin_amdgcn_fence(__ATOMIC_ACQUIRE, "agent");
            asm volatile("s_waitcnt vmcnt(0)" ::: "memory");
        }
    }
    __syncthreads();
}
#ifdef PROBE_ACC
#define ACC_BEGIN(F, id) do { if ((id) == PROBE_ACC) { __syncthreads(); (F).acc_t0 = __builtin_amdgcn_s_memrealtime(); } } while (0)
#define ACC_END(F, id) do { if ((id) == PROBE_ACC) { __syncthreads(); (F).acc_sum += __builtin_amdgcn_s_memrealtime() - (F).acc_t0; } } while (0)
#else
#define ACC_BEGIN(F, id) do { } while (0)
#define ACC_END(F, id) do { } while (0)
#endif
struct Frame {
#ifdef PROBE_ACC
    unsigned long long acc_t0, acc_sum;
#endif
    LAS unsigned char* lds;
    volatile LAS unsigned* MISC;
    gu32* ctl;
    int tid, lane, wave, vcu, G;
    const float *x, *g_mix, *g_ffn, *w_in_ab, *gq_a, *gk_a, *w_gate_up, *b_gate, *g_gla, *w_out_ab, *w_in_c, *gq_c, *gk_c, *w_out_c, *w_up, *w_down;
    float* out;
    bf16 *Wab, *Woab, *Wup0, *Wdn0, *Winc, *Woc, *Wup1, *Wdn1;
    bf16 *XB, *CAT, *R1;
    float* SSQ; unsigned* MASK;
};
__device__ __forceinline__ int lane_id_opaque() { int l; asm volatile("v_mbcnt_lo_u32_b32 %0, -1, 0\n\tv_mbcnt_hi_u32_b32 %0, -1, %0" : "=v"(l)); return l; }
__device__ __forceinline__ float bf2f(bf16 v) { return __builtin_bit_cast(float, (unsigned)v << 16); }
__device__ __forceinline__ float wave_sum(float v) {
#pragma unroll
    for (int o = 1; o < 64; o <<= 1) v += __shfl_xor(v, o);
    return v;
}
__device__ __forceinline__ float wave_max(float v) {
#pragma unroll
    for (int o = 1; o < 64; o <<= 1) v = fmaxf(v, __shfl_xor(v, o));
    return v;
}
__device__ __forceinline__ float log_sigmoid(float x) { return fminf(x, 0.f) - log1pf(expf(-fabsf(x))); }

__device__ __forceinline__ int oldcol_ab(int n) {
    if (n < 2048) return n;
    if (n < 2304) return 2120 + (n - 2048);
    if (n < 2560) return 2376 + (n - 2304);
    if (n < 3072) return 2632 + (n - 2560);
    if (n < 3584) return 3160 + (n - 3072);
    if (n < 3648) return 2048 + (n - 3584);
    if (n < 3656) return 2112 + (n - 3648);
    if (n < 3672) return 3144 + (n - 3656);
    return -1;
}
__device__ __forceinline__ void p0_transpose_item(const float* W, int ldw, int K, const float* gain, bf16* WT, bool map, int item, int nblk, int lane) {
    const int kb = item / nblk, nb = item % nblk, ng = lane & 7, ko = lane >> 3, k0 = 64 * kb + 8 * ko, n = 32 * nb + 4 * ng;
    const int oc = map ? oldcol_ab(n) : n;
    f32x4 v[8];
#pragma unroll
    for (int i = 0; i < 8; ++i) { v[i] = (f32x4){0.f, 0.f, 0.f, 0.f}; if (oc >= 0) v[i] = *(const GAS f32x4*)(W + (size_t)(k0 + i) * ldw + oc); }
    if (gain) { const f32x4 g0 = *(const GAS f32x4*)(gain + k0), g1 = *(const GAS f32x4*)(gain + k0 + 4);
#pragma unroll
        for (int i = 0; i < 4; ++i) { v[i] = v[i] * g0[i]; v[4 + i] = v[4 + i] * g1[i]; } }
#pragma unroll
    for (int e = 0; e < 4; ++e) { v4u o; o.x = pk2(v[0][e], v[1][e]); o.y = pk2(v[2][e], v[3][e]); o.z = pk2(v[4][e], v[5][e]); o.w = pk2(v[6][e], v[7][e]);
        *(GAS v4u*)(WT + (size_t)(n + e) * K + k0) = o; }
}
template <int PART> __device__ __forceinline__ void prologue_weights(Frame& F, int gw, int NGW) {
    constexpr int I_AB = (D / 64) * (NAB / 32), I_O = (D / 64) * (D / 32), I_UP = (D / 64) * (FF / 32), I_DN = (FF / 64) * (D / 32), I_C = (D / 64) * (NC / 32);
    if (PART == 0) { for (int it = gw; it < I_AB; it += NGW) p0_transpose_item(F.w_in_ab, ABP_OLD, D, F.g_mix, F.Wab, true, it, NAB / 32, F.lane); return; }
    constexpr int NITEMS = 2 * I_O + 2 * I_UP + 2 * I_DN + I_C;
    for (int it = gw; it < NITEMS; it += NGW) {
        int r = it;
        if (r < I_O) { p0_transpose_item(F.w_out_ab, D, D, nullptr, F.Woab, false, r, D / 32, F.lane); continue; } r -= I_O;
        if (r < I_UP) { p0_transpose_item(F.w_up, FF, D, F.g_ffn, F.Wup0, false, r, FF / 32, F.lane); continue; } r -= I_UP;
        if (r < I_DN) { p0_transpose_item(F.w_down, D, FF, nullptr, F.Wdn0, false, r, D / 32, F.lane); continue; } r -= I_DN;
        if (r < I_C) { p0_transpose_item(F.w_in_c, NC, D, F.g_mix + D, F.Winc, false, r, NC / 32, F.lane); continue; } r -= I_C;
        if (r < I_O) { p0_transpose_item(F.w_out_c, D, D, nullptr, F.Woc, false, r, D / 32, F.lane); continue; } r -= I_O;
        if (r < I_UP) { p0_transpose_item(F.w_up + (size_t)D * FF, FF, D, F.g_ffn + D, F.Wup1, false, r, FF / 32, F.lane); continue; } r -= I_UP;
        p0_transpose_item(F.w_down + (size_t)FF * D, D, FF, nullptr, F.Wdn1, false, r, D / 32, F.lane);
    }
}
__device__ __forceinline__ void ph_prologue(Frame& F) {
    const int gw = F.vcu * NWAVES + F.wave, NGW = F.G * NWAVES;
    prologue_weights<0>(F, gw, NGW);
    if (F.G != 256) prologue_weights<1>(F, gw, NGW);
    for (int m0 = gw; m0 < M; m0 += 4 * NGW) {
        f32x4 v[4][4]; float s[4];
#pragma unroll
        for (int r = 0; r < 4; ++r) { const int m = m0 + r * NGW; const GAS f32x4* xr = (const GAS f32x4*)(F.x + (size_t)(m < M ? m : m0) * D) + F.lane;
#pragma unroll
            for (int j = 0; j < 4; ++j) v[r][j] = xr[64 * j]; }
#pragma unroll
        for (int r = 0; r < 4; ++r) { float t = 0.f;
#pragma unroll
            for (int j = 0; j < 4; ++j) t += (v[r][j].x * v[r][j].x + v[r][j].y * v[r][j].y) + (v[r][j].z * v[r][j].z + v[r][j].w * v[r][j].w);
            s[r] = t; }
#pragma unroll
        for (int o = 1; o < 64; o <<= 1) {
#pragma unroll
            for (int r = 0; r < 4; ++r) s[r] += __shfl_xor(s[r], o); }
#pragma unroll
        for (int r = 0; r < 4; ++r) { const int m = m0 + r * NGW; if (m < M) {
            GAS unsigned long long* o8 = (GAS unsigned long long*)(F.XB + (size_t)m * D) + F.lane;
#pragma unroll
            for (int j = 0; j < 4; ++j) o8[64 * j] = (unsigned long long)pk2(v[r][j].x, v[r][j].y) | ((unsigned long long)pk2(v[r][j].z, v[r][j].w) << 32);
            if (F.lane < 16) F.SSQ[(size_t)m * 16 + F.lane] = (F.lane == 0) ? s[r] : 0.f; } }
    }
}
namespace att {
typedef short s16x4 __attribute__((ext_vector_type(4)));
typedef float f32x16 __attribute__((ext_vector_type(16)));
typedef _Float16 f16x8 __attribute__((ext_vector_type(8)));
typedef unsigned u32x4 __attribute__((ext_vector_type(4)));
typedef short v4i16_t __attribute__((ext_vector_type(4)));
constexpr float C2 = 0.08838834764831845f * 1.4426950408889634f;
__device__ __forceinline__ int crow(int r, int hi) { return (r & 3) + 8 * (r >> 2) + 4 * hi; }
__device__ __forceinline__ int img_off(int row, int ch) { return 256 * row + 16 * (ch ^ (((row & 3) << 2) | ((row >> 2) & 3))); }
__device__ __forceinline__ bf16x8 pack8(float a0, float a1, float a2, float a3, float a4, float a5, float a6, float a7) {
    u32x4 w; w.x = pg8::cvt_pk_bf16(a0, a1); w.y = pg8::cvt_pk_bf16(a2, a3); w.z = pg8::cvt_pk_bf16(a4, a5); w.w = pg8::cvt_pk_bf16(a6, a7);
    return __builtin_bit_cast(bf16x8, w);
}
__device__ __forceinline__ f16x8 pack8h(float a0, float a1, float a2, float a3, float a4, float a5, float a6, float a7) {
    f16x8 r; r[0] = (_Float16)a0; r[1] = (_Float16)a1; r[2] = (_Float16)a2; r[3] = (_Float16)a3; r[4] = (_Float16)a4; r[5] = (_Float16)a5; r[6] = (_Float16)a6; r[7] = (_Float16)a7; return r;
}
__device__ __forceinline__ void dma_off_init(unsigned (&dvo)[2], int ld, int wave, int lane) {
#pragma unroll
    for (int i = 0; i < 2; ++i) { const int pi = 2 * wave + i, row = 4 * pi + (lane >> 4), pc = lane & 15, ch = pc ^ (((row & 3) << 2) | ((row >> 2) & 3)); dvo[i] = (unsigned)(row * ld + ch * 8) * 2u; }
}
__device__ __forceinline__ void tile_dma(const bf16* g, const unsigned (&dvo)[2], LAS unsigned char* buf, int wave) {
#pragma unroll
    for (int i = 0; i < 2; ++i) __builtin_amdgcn_global_load_lds((const unsigned*)((const char*)g + dvo[i]), (LAS unsigned*)(buf + 1024 * (2 * wave + i)), 16, 0, 0);
}
struct FragOff { int k[8]; int va[4]; int vd; };
__device__ __forceinline__ void frag_off_init(FragOff& fo, int lane) {
    const int hi = lane >> 5, r32 = lane & 31, i = lane & 15, q = i >> 2, p = i & 3, x = 2 * ((lane >> 4) & 1) + (p >> 1);
#pragma unroll
    for (int ks = 0; ks < 8; ++ks) fo.k[ks] = img_off(r32, 2 * ks + hi);
#pragma unroll
    for (int ct = 0; ct < 4; ++ct) fo.va[ct] = img_off(4 * hi + q, 4 * ct + x) + 8 * (p & 1);
    fo.vd = img_off(4 * hi + q + 8, x) - img_off(4 * hi + q, x);
}
__device__ __forceinline__ bf16x8 k_frag(const LAS unsigned char* kbuf, const FragOff& fo, int rt, int ks) { return *(const LAS bf16x8*)(kbuf + fo.k[ks] + 8192 * rt); }
__device__ __forceinline__ s16x4 vtr(const LAS unsigned char* p) { return __builtin_bit_cast(s16x4, __builtin_amdgcn_ds_read_tr16_b64_v4i16((LAS v4i16_t*)p)); }
__device__ __forceinline__ bf16x8 v_frag(const LAS unsigned char* vbuf, const FragOff& fo, int ct, int kk) {
    const s16x4 lo = vtr(vbuf + fo.va[ct] + 4096 * kk), hh = vtr(vbuf + fo.va[ct] + fo.vd + 4096 * kk);
    return (bf16x8){lo[0], lo[1], lo[2], lo[3], hh[0], hh[1], hh[2], hh[3]};
}
#define TR_READ(dst, addr, OFF) asm volatile("ds_read_b64_tr_b16 %0, %1 offset:%c2" : "=&v"(dst) : "v"(addr), "i"(OFF) : "memory")
#define LGKM_WAIT0() do { asm volatile("s_waitcnt lgkmcnt(0)" ::: "memory"); __builtin_amdgcn_sched_barrier(0); } while (0)
__device__ __forceinline__ bf16x8 mk_frag(s16x4 lo, s16x4 hh) { return (bf16x8){lo[0], lo[1], lo[2], lo[3], hh[0], hh[1], hh[2], hh[3]}; }
__device__ __forceinline__ int frag_va(int lane, int ct) { const int hi = lane >> 5, i = lane & 15, q = i >> 2, p = i & 3, x = 2 * ((lane >> 4) & 1) + (p >> 1); return img_off(4 * hi + q, 4 * ct + x) + 8 * (p & 1); }
__device__ __forceinline__ bf16x8 v_frag_rt(const LAS unsigned char* vbuf, int va, int vd, int kk) {
    const s16x4 lo = vtr(vbuf + va + 4096 * kk), hh = vtr(vbuf + va + vd + 4096 * kk);
    return (bf16x8){lo[0], lo[1], lo[2], lo[3], hh[0], hh[1], hh[2], hh[3]};
}
__device__ __forceinline__ void store_o(const f32x16 (&o)[4], const float (&rscale)[16], LAS unsigned char* stg, bf16* dst, int ld, int lane) {
    const int hi = lane >> 5, r32 = lane & 31;
#pragma unroll
    for (int r = 0; r < 16; ++r) { const int orow = crow(r, hi);
#pragma unroll
        for (int ct = 0; ct < 4; ++ct) *(LAS bf16*)(stg + orow * 256 + (32 * ct + r32) * 2) = (bf16)f2bf(o[ct][r] * rscale[r]); }
    asm volatile("s_waitcnt lgkmcnt(0)" ::: "memory");
#pragma unroll
    for (int i = 0; i < 8; ++i) { const int c = lane + 64 * i, row = c >> 4, ch = c & 15; const u32x4 v = *(const LAS u32x4*)(stg + row * 256 + ch * 16); *(u32x4*)(dst + (size_t)row * ld + ch * 8) = v; }
}
}
__device__ __forceinline__ void sb_unit(Frame& F, int b, int h, int qb) {
    using namespace att;
    const int tid = F.tid, lane = F.lane, w = F.wave, hi = lane >> 5, r32 = lane & 31;
    const bf16* Qg = F.R1 + (size_t)b * SEQ * NC + h * 128; const bf16* Kg = Qg + 1024; const bf16* Vg = Qg + 2048;
    const int T0 = qb * 256, t0w = T0 + 32 * w, jd = t0w >> 6, jtop = (T0 >> 6) + 3, tl = 32 * (w & 1) + r32, tl4 = tl - 4 * hi;
    LAS unsigned char* lds = F.lds;
    FragOff fo; frag_off_init(fo, lane);
    unsigned dvo[2]; dma_off_init(dvo, NC, w, lane);
    bf16x8 qf[8];
#pragma unroll
    for (int ks = 0; ks < 8; ++ks) qf[ks] = *(const bf16x8*)(Qg + (size_t)(t0w + r32) * NC + 16 * ks + 8 * hi);
    f16x8 T0f, T1f, ONEf;
#pragma unroll
    for (int j = 0; j < 8; ++j) { const int kp = 8 * (j >> 2) + 4 * hi + (j & 3); T0f[j] = (kp >= r32) ? (_Float16)1.0f : (_Float16)0.0f; T1f[j] = (kp + 16 >= r32) ? (_Float16)1.0f : (_Float16)0.0f; ONEf[j] = (_Float16)1.0f; }
    f32x16 o[4];
#pragma unroll
    for (int ct = 0; ct < 4; ++ct)
#pragma unroll
        for (int r = 0; r < 16; ++r) o[ct][r] = 0.f;
    float R2 = 0.f; bool done = false;
    volatile LAS unsigned* flags = F.MISC + 16;
    tile_dma(Kg + (size_t)(64 * jtop) * NC, dvo, lds, w); tile_dma(Vg + (size_t)(64 * jtop) * NC, dvo, lds + 16384, w);
    asm volatile("s_waitcnt vmcnt(0)" ::: "memory");
    __syncthreads();
    for (int j = jtop; j >= 0; --j) {
        const int cur = (jtop - j) & 1;
        const LAS unsigned char* kb = lds + cur * 32768; const LAS unsigned char* vb = kb + 16384;
        if (j > 0) { tile_dma(Kg + (size_t)(64 * (j - 1)) * NC, dvo, lds + (cur ^ 1) * 32768, w); tile_dma(Vg + (size_t)(64 * (j - 1)) * NC, dvo, lds + (cur ^ 1) * 32768 + 16384, w); }
        if (j <= jd && !done) {
            f32x16 p0, p1;
#pragma unroll
            for (int r = 0; r < 16; ++r) { p0[r] = 0.f; p1[r] = 0.f; }
            { bf16x8 kf[8];
#pragma unroll
              for (int ks = 0; ks < 8; ++ks) kf[ks] = k_frag(kb, fo, 0, ks);
#pragma unroll
              for (int ks = 0; ks < 8; ++ks) p0 = __builtin_amdgcn_mfma_f32_32x32x16_bf16(kf[ks], qf[ks], p0, 0, 0, 0);
#pragma unroll
              for (int ks = 0; ks < 8; ++ks) kf[ks] = k_frag(kb, fo, 1, ks);
#pragma unroll
              for (int ks = 0; ks < 8; ++ks) p1 = __builtin_amdgcn_mfma_f32_32x32x16_bf16(kf[ks], qf[ks], p1, 0, 0, 0); }
            s16x4 vl[4], vh[4], wl[4], wh[4];
            unsigned va0[4], va1[4];
#pragma unroll
            for (int ct = 0; ct < 4; ++ct) { va0[ct] = (unsigned)(size_t)vb + (unsigned)fo.va[ct]; va1[ct] = va0[ct] + (unsigned)fo.vd; }
            const bool diag = (j == jd);
            float x0[16], x1[16]; float rs = 0.f;
#pragma unroll
            for (int r = 0; r < 16; ++r) { const int key = (r & 3) + 8 * (r >> 2);
                float l0 = -__builtin_amdgcn_logf(1.0f + __builtin_amdgcn_exp2f(p0[r])), l1 = -__builtin_amdgcn_logf(1.0f + __builtin_amdgcn_exp2f(p1[r]));
                if (diag) { if (!(key < tl4)) l0 = 0.f; if (!(key + 32 < tl4)) l1 = 0.f; }
                x0[r] = l0; x1[r] = l1; rs += l0 + l1; p0[r] += R2; p1[r] += R2; }
            const f16x8 xb00 = pack8h(x0[0], x0[1], x0[2], x0[3], x0[4], x0[5], x0[6], x0[7]), xb01 = pack8h(x0[8], x0[9], x0[10], x0[11], x0[12], x0[13], x0[14], x0[15]);
            const f16x8 xb10 = pack8h(x1[0], x1[1], x1[2], x1[3], x1[4], x1[5], x1[6], x1[7]), xb11 = pack8h(x1[8], x1[9], x1[10], x1[11], x1[12], x1[13], x1[14], x1[15]);
            p0 = __builtin_amdgcn_mfma_f32_32x32x16_f16(T0f, xb00, p0, 0, 0, 0); p0 = __builtin_amdgcn_mfma_f32_32x32x16_f16(T1f, xb01, p0, 0, 0, 0);
            p0 = __builtin_amdgcn_mfma_f32_32x32x16_f16(ONEf, xb10, p0, 0, 0, 0); p0 = __builtin_amdgcn_mfma_f32_32x32x16_f16(ONEf, xb11, p0, 0, 0, 0);
            p1 = __builtin_amdgcn_mfma_f32_32x32x16_f16(T0f, xb10, p1, 0, 0, 0); p1 = __builtin_amdgcn_mfma_f32_32x32x16_f16(T1f, xb11, p1, 0, 0, 0);
#pragma unroll
            for (int r = 0; r < 16; ++r) { const int key = (r & 3) + 8 * (r >> 2);
                float a0 = __builtin_amdgcn_exp2f(p0[r]), a1 = __builtin_amdgcn_exp2f(p1[r]);
                if (diag) { if (!(key < tl4)) a0 = 0.f; if (!(key + 32 < tl4)) a1 = 0.f; }
                p0[r] = a0; p1[r] = a1; }
            const bf16x8 pa0 = pack8(p0[0], p0[1], p0[2], p0[3], p0[4], p0[5], p0[6], p0[7]), pa1 = pack8(p0[8], p0[9], p0[10], p0[11], p0[12], p0[13], p0[14], p0[15]);
            const bf16x8 pa2 = pack8(p1[0], p1[1], p1[2], p1[3], p1[4], p1[5], p1[6], p1[7]), pa3 = pack8(p1[8], p1[9], p1[10], p1[11], p1[12], p1[13], p1[14], p1[15]);
#pragma unroll
            for (int ct = 0; ct < 4; ++ct) { TR_READ(vl[ct], va0[ct], 0); TR_READ(vh[ct], va1[ct], 0); }
            LGKM_WAIT0();
#pragma unroll
            for (int ct = 0; ct < 4; ++ct) { TR_READ(wl[ct], va0[ct], 4096); TR_READ(wh[ct], va1[ct], 4096); }
#pragma unroll
            for (int ct = 0; ct < 4; ++ct) o[ct] = __builtin_amdgcn_mfma_f32_32x32x16_bf16(pa0, mk_frag(vl[ct], vh[ct]), o[ct], 0, 0, 0);
            LGKM_WAIT0();
#pragma unroll
            for (int ct = 0; ct < 4; ++ct) { TR_READ(vl[ct], va0[ct], 8192); TR_READ(vh[ct], va1[ct], 8192); }
#pragma unroll
            for (int ct = 0; ct < 4; ++ct) o[ct] = __builtin_amdgcn_mfma_f32_32x32x16_bf16(pa1, mk_frag(wl[ct], wh[ct]), o[ct], 0, 0, 0);
            LGKM_WAIT0();
#pragma unroll
            for (int ct = 0; ct < 4; ++ct) { TR_READ(wl[ct], va0[ct], 12288); TR_READ(wh[ct], va1[ct], 12288); }
#pragma unroll
            for (int ct = 0; ct < 4; ++ct) o[ct] = __builtin_amdgcn_mfma_f32_32x32x16_bf16(pa2, mk_frag(vl[ct], vh[ct]), o[ct], 0, 0, 0);
            LGKM_WAIT0();
#pragma unroll
            for (int ct = 0; ct < 4; ++ct) o[ct] = __builtin_amdgcn_mfma_f32_32x32x16_bf16(pa3, mk_frag(wl[ct], wh[ct]), o[ct], 0, 0, 0);
            rs += __shfl_xor(rs, 32);
            R2 += rs;
            done = __all(R2 < -152.0f);
        }
        if (lane == 0) flags[cur * 8 + w] = done ? 1u : 0u;
        asm volatile("s_waitcnt vmcnt(0) lgkmcnt(0)" ::: "memory");
        __syncthreads();
        unsigned alld = 1u;
#pragma unroll
        for (int i = 0; i < 8; ++i) alld &= flags[cur * 8 + i];
        if (alld) break;
    }
    float ones[16];
#pragma unroll
    for (int r = 0; r < 16; ++r) ones[r] = 1.0f;
    store_o(o, ones, lds + w * 8192, F.CAT + (size_t)(b * SEQ + t0w) * D + h * 128, D, lane);
    __syncthreads();
}
__device__ __forceinline__ void ph_sb(Frame& F) {
    for (int v = F.vcu; v < BATCH * 8 * 2; v += F.G) {
        const int bh = v >> 1, half = v & 1;
#pragma unroll 1
        for (int i = 0; i < 4; ++i) { const int qb = half ? (i == 0 ? 1 : i == 1 ? 6 : i == 2 ? 2 : 5) : (i == 0 ? 0 : i == 1 ? 7 : i == 2 ? 3 : 4); sb_unit(F, bh >> 3, bh & 7, qb); }
    }
}
__device__ __forceinline__ void dsa_unit(Frame& F, int b, int h, int ub, float mref) {
    using namespace att;
    const int lane = F.lane, w = F.wave, hi = lane >> 5, r32 = lane & 31;
    const bf16* Qg = F.R1 + (size_t)b * SEQ * NAB + C_QA + h * 128; const bf16* Kg = F.R1 + (size_t)b * SEQ * NAB + C_KA + h * 128; const bf16* Vg = F.R1 + (size_t)b * SEQ * NAB + C_VA + h * 128;
    const int t0w = 256 * ub + 32 * w, cw = t0w >> 6, jlast = 4 * ub + 3;
    LAS unsigned char* lds = F.lds;
    LAS unsigned char* mst = lds + 65536 + w * 8448;
    FragOff fo; frag_off_init(fo, lane);
    unsigned dvo[2]; dma_off_init(dvo, NAB, w, lane);
    tile_dma(Kg, dvo, lds, w); tile_dma(Vg, dvo, lds + 16384, w);
    bf16x8 qf[8];
#pragma unroll
    for (int ks = 0; ks < 8; ++ks) qf[ks] = *(const bf16x8*)(Qg + (size_t)(t0w + r32) * NAB + 16 * ks + 8 * hi);
    { const unsigned* mg = F.MASK + (size_t)(b * SEQ + t0w) * 64;
#pragma unroll 2
      for (int i = 0; i < 8; ++i) { const int c = lane + 64 * i, row = c >> 4, c4 = c & 15; const u32x4 v = *(const u32x4*)(mg + row * 64 + c4 * 4);
          *(LAS unsigned long long*)(mst + row * 264 + c4 * 16) = (unsigned long long)v.x | ((unsigned long long)v.y << 32);
          *(LAS unsigned long long*)(mst + row * 264 + c4 * 16 + 8) = (unsigned long long)v.z | ((unsigned long long)v.w << 32); } }
    f32x16 o[4];
#pragma unroll
    for (int ct = 0; ct < 4; ++ct)
#pragma unroll
        for (int r = 0; r < 16; ++r) o[ct][r] = 0.f;
    float lsum = 0.f;
    asm volatile("s_waitcnt vmcnt(0) lgkmcnt(0)" ::: "memory");
    __syncthreads();
    for (int j = 0; j <= jlast; ++j) {
        const int cur = j & 1;
        const LAS unsigned char* kb = lds + cur * 32768; const LAS unsigned char* vb = kb + 16384;
        if (j < jlast) { tile_dma(Kg + (size_t)(64 * (j + 1)) * NAB, dvo, lds + (cur ^ 1) * 32768, w); tile_dma(Vg + (size_t)(64 * (j + 1)) * NAB, dvo, lds + (cur ^ 1) * 32768 + 16384, w); }
        if (j <= cw) {
            const unsigned long long mw = *(const LAS unsigned long long*)(mst + r32 * 264 + j * 8);
            const unsigned mw0 = (unsigned)mw, mw1 = (unsigned)(mw >> 32);
#pragma unroll 1
            for (int half = 0; half < 2; ++half) {
                const unsigned mwh = (half ? mw1 : mw0) >> (4 * hi);
                bf16x8 kf[8];
#pragma unroll
                for (int ks = 0; ks < 8; ++ks) kf[ks] = k_frag(kb, fo, half, ks);
                f32x16 p;
#pragma unroll
                for (int r = 0; r < 16; ++r) p[r] = 0.f;
#pragma unroll
                for (int ks = 0; ks < 8; ++ks) p = __builtin_amdgcn_mfma_f32_32x32x16_bf16(kf[ks], qf[ks], p, 0, 0, 0);
#pragma unroll
                for (int r = 0; r < 16; ++r) { const unsigned keep = (unsigned)(-(int)((mwh >> ((r & 3) + 8 * (r >> 2))) & 1u));
                    const float e = __uint_as_float(__float_as_uint(__builtin_amdgcn_exp2f(p[r] - mref)) & keep); p[r] = e; lsum += e; }
                const bf16x8 pa0 = pack8(p[0], p[1], p[2], p[3], p[4], p[5], p[6], p[7]), pa1 = pack8(p[8], p[9], p[10], p[11], p[12], p[13], p[14], p[15]);
                s16x4 vl[8], vh[8];
                const unsigned vbase = (unsigned)(size_t)vb + 8192u * (unsigned)half;
#pragma unroll
                for (int ct = 0; ct < 4; ++ct) { const unsigned a0 = vbase + (unsigned)fo.va[ct], a1 = a0 + (unsigned)fo.vd;
                    TR_READ(vl[2 * ct], a0, 0); TR_READ(vh[2 * ct], a1, 0); TR_READ(vl[2 * ct + 1], a0, 4096); TR_READ(vh[2 * ct + 1], a1, 4096); }
                LGKM_WAIT0();
#pragma unroll
                for (int ct = 0; ct < 4; ++ct) {
                    o[ct] = __builtin_amdgcn_mfma_f32_32x32x16_bf16(pa0, mk_frag(vl[2 * ct], vh[2 * ct]), o[ct], 0, 0, 0);
                    o[ct] = __builtin_amdgcn_mfma_f32_32x32x16_bf16(pa1, mk_frag(vl[2 * ct + 1], vh[2 * ct + 1]), o[ct], 0, 0, 0);
                }
            }
        }
        asm volatile("s_waitcnt vmcnt(0) lgkmcnt(0)" ::: "memory");
        __syncthreads();
    }
    lsum += __shfl_xor(lsum, 32);
    LAS float* lsc = (LAS float*)mst;
    if (hi == 0) lsc[r32] = 1.0f / lsum;
    asm volatile("s_waitcnt lgkmcnt(0)" ::: "memory");
    float rsc[16];
#pragma unroll
    for (int r = 0; r < 16; ++r) rsc[r] = lsc[crow(r, hi)];
    store_o(o, rsc, lds + w * 8192, F.CAT + (size_t)(b * SEQ + t0w) * D + h * 128, D, lane);
    __syncthreads();
}
__device__ __forceinline__ void ph_dsa(Frame& F) {
    float gm = fmaxf(fabsf(F.gq_a[F.lane]), fabsf(F.gq_a[64 + F.lane])), km = fmaxf(fabsf(F.gk_a[F.lane]), fabsf(F.gk_a[64 + F.lane]));
    gm = wave_max(gm); km = wave_max(km);
    const float mref = att::C2 * 128.0f * gm * km * 1.02f;
    for (int v = F.vcu; v < BATCH * 4 * 4; v += F.G) {
        const int bh = v >> 2, pi = v & 3;
#pragma unroll 1
        for (int k = 0; k < 2; ++k) dsa_unit(F, bh >> 2, bh & 3, k ? 7 - pi : pi, mref);
    }
}
namespace idx {
using att::f32x16;
constexpr int SCP = 2048;
__device__ __forceinline__ unsigned okey(float f) { const unsigned u = __float_as_uint(f); return (u & 0x80000000u) ? ~u : (u | 0x80000000u); }
__device__ __forceinline__ int wave_isum(int c) {
    c += __builtin_amdgcn_mov_dpp(c, 0xB1, 0xF, 0xF, true);
    c += __builtin_amdgcn_mov_dpp(c, 0x4E, 0xF, 0xF, true);
    c += __builtin_amdgcn_mov_dpp(c, 0x141, 0xF, 0xF, true);
    c += __builtin_amdgcn_mov_dpp(c, 0x140, 0xF, 0xF, true);
    return (__builtin_amdgcn_readlane(c, 0) + __builtin_amdgcn_readlane(c, 16)) + (__builtin_amdgcn_readlane(c, 32) + __builtin_amdgcn_readlane(c, 48));
}
__device__ __forceinline__ void bit_transpose32x2(unsigned (&A)[32], unsigned (&B)[32]) {
    unsigned mask = 0x0000FFFFu;
#pragma unroll
    for (int s = 16; s; s >>= 1) {
        unsigned ta[16], tb[16];
#pragma unroll
        for (int k = 0, i = 0; k < 32; ++k) if (!(k & s)) { ta[i] = A[k + s] >> s; tb[i] = B[k + s] >> s; ++i; }
#pragma unroll
        for (int k = 0, i = 0; k < 32; ++k) if (!(k & s)) { ta[i] ^= A[k]; tb[i] ^= B[k]; ++i; }
#pragma unroll
        for (int i = 0; i < 16; ++i) { ta[i] &= mask; tb[i] &= mask; }
#pragma unroll
        for (int k = 0, i = 0; k < 32; ++k) if (!(k & s)) { A[k] ^= ta[i]; B[k] ^= tb[i]; ++i; }
#pragma unroll
        for (int k = 0, i = 0; k < 32; ++k) if (!(k & s)) { A[k + s] ^= ta[i] << s; B[k + s] ^= tb[i] << s; ++i; }
        mask ^= mask << (s >> 1);
    }
}
__device__ __forceinline__ void select_prepare(const LAS float* scA, const LAS float* scB, int E, unsigned (&Wa)[32], unsigned (&Wb)[32], int lane) {
#pragma unroll
    for (int j = 0; j < 32; ++j) { Wa[31 - j] = __float_as_uint(scA[64 * j + lane]); Wb[31 - j] = __float_as_uint(scB[64 * j + lane]); }
#pragma unroll
    for (int j = 0; j < 32; ++j) { const unsigned ua = Wa[31 - j], ub = Wb[31 - j];
        const unsigned ka = (ua & 0x80000000u) ? ~ua : (ua | 0x80000000u), kb = (ub & 0x80000000u) ? ~ub : (ub | 0x80000000u);
        Wa[31 - j] = (j < E) ? ka : 0u; Wb[31 - j] = (j < E) ? kb : 0u; }
    bit_transpose32x2(Wa, Wb);
}
__device__ __forceinline__ void select_finish(const unsigned (&Wa)[32], const unsigned (&Wb)[32], int E, unsigned* mrowA, unsigned* mrowB, int lane) {
    const unsigned valid = (E >= 32) ? 0xFFFFFFFFu : ((1u << E) - 1u);
    unsigned alA = valid, alB = valid, gtA = 0u, gtB = 0u;
    int GA = 0, GB = 0, AA = 64 * E, AB = 64 * E; bool dA = false, dB = false;
#pragma unroll
    for (int b = 0; b < 32; ++b) {
        if (dA && dB) break;
        const unsigned m1a = alA & Wa[b], m1b = alB & Wb[b];
        const int ca = wave_isum(__popc(m1a)), cb = wave_isum(__popc(m1b));
        if (!dA) { if (GA + ca >= 256) { alA = m1a; AA = ca; } else { GA += ca; gtA |= m1a; alA &= ~Wa[b]; AA -= ca; } dA = (GA + AA == 256); }
        if (!dB) { if (GB + cb >= 256) { alB = m1b; AB = cb; } else { GB += cb; gtB |= m1b; alB &= ~Wb[b]; AB -= cb; } dB = (GB + AB == 256); }
    }
#pragma unroll 1
    for (int rr = 0; rr < 2; ++rr) {
        const unsigned al = rr ? alB : alA, gt = rr ? gtB : gtA; const bool done = rr ? dB : dA; unsigned* mrow = rr ? mrowB : mrowA;
        unsigned sel = gt | al;
        if (!done) {
            int need = 256 - (rr ? GB : GA); sel = gt;
            const unsigned long long below = (1ull << lane) - 1ull;
            for (int j = 0; j < E; ++j) { const bool e = (al >> j) & 1u; const unsigned long long eq = __ballot(e);
                if (e && __popcll(eq & below) < need) sel |= 1u << j;
                need -= __popcll(eq); if (need <= 0) break; }
        }
        unsigned long long mine = 0ull;
#pragma unroll
        for (int j = 0; j < 32; ++j) { if (j < E) { const unsigned long long m = __ballot((sel >> j) & 1u); if (lane == j) mine = m; } }
        if (lane < 32) *(unsigned long long*)(mrow + 2 * lane) = mine;
    }
}
__device__ __forceinline__ void decode(int u, int& b, int& c, int& sub) { c = 4 + u % 28; const int rest = u / 28; b = rest >> 2; sub = rest & 3; }
__device__ __forceinline__ void load_af(Frame& F, int u, bf16x8 (&af)[4][4]) {
    int b, c, sub; decode(u, b, c, sub);
    const int r32 = F.lane & 31, hi = F.lane >> 5, t0 = 64 * c + 16 * sub;
    const bf16* P = F.R1 + (size_t)b * SEQ * NAB;
#pragma unroll
    for (int rt = 0; rt < 4; ++rt)
#pragma unroll
        for (int ks = 0; ks < 4; ++ks) af[rt][ks] = *(const bf16x8*)(P + (size_t)(t0 + 4 * rt + (r32 >> 3)) * NAB + C_IQ + (r32 & 7) * 64 + 16 * ks + 8 * hi);
}
__device__ __forceinline__ float load_w(Frame& F, int u) {
    int b, c, sub; decode(u, b, c, sub);
    const int t0 = 64 * c + 16 * sub;
    return (F.tid < 128) ? bf2f(F.R1[(size_t)(b * SEQ + t0 + (F.tid >> 3)) * NAB + C_IW + (F.tid & 7)]) * (0.125f * 0.35355339059327373f) : 0.f;
}
__device__ __forceinline__ void load_bf(Frame& F, int b, int strip, bf16x8 (&bfr)[4]) {
    const bf16* P = F.R1 + (size_t)b * SEQ * NAB;
#pragma unroll
    for (int ks = 0; ks < 4; ++ks) bfr[ks] = *(const bf16x8*)(P + (size_t)(32 * strip + (F.lane & 31)) * NAB + C_IK + 16 * ks + 8 * (F.lane >> 5));
}
__device__ __forceinline__ void run(Frame& F) {
    const int lane = F.lane, w = F.wave, hi = lane >> 5, r32 = lane & 31, tid = F.tid, NU = BATCH * 28 * 4;
    int u = F.vcu; if (u >= NU) return;
    LAS float* sc = (LAS float*)F.lds;
    LAS float* wtb = sc + 16 * SCP;
    bf16x8 af[4][4], bfr[4], bnx[4];
    load_af(F, u, af);
    { const float wv = load_w(F, u); if (tid < 128) wtb[tid] = wv; }
    { int b, c, sub; decode(u, b, c, sub); if (w < 2 * (c + 1)) load_bf(F, b, w, bfr); }
    for (int it = 0; u < NU; ++it, u += F.G) {
        int b, c, sub; decode(u, b, c, sub);
        const int n = 64 * (c + 1), t0 = 64 * c + 16 * sub, nstrip = n >> 5;
        const int un = u + F.G; const bool more = un < NU;
        const LAS float* wt = wtb + (it & 1) * 128;
        __syncthreads();
        const float wnext = more ? load_w(F, un) : 0.f;
        for (int s = w; s < nstrip; s += NWAVES) {
            const bool mstrip = s + NWAVES < nstrip;
            if (mstrip) load_bf(F, b, s + NWAVES, bnx);
#pragma unroll
            for (int rt = 0; rt < 4; ++rt) {
                f32x16 acc;
#pragma unroll
                for (int r = 0; r < 16; ++r) acc[r] = 0.f;
#pragma unroll
                for (int ks = 0; ks < 4; ++ks) acc = __builtin_amdgcn_mfma_f32_32x32x16_bf16(af[rt][ks], bfr[ks], acc, 0, 0, 0);
                float part[4];
#pragma unroll
                for (int qi = 0; qi < 4; ++qi) { const f32x4 wv = *(const LAS f32x4*)(wt + (4 * rt + qi) * 8 + 4 * hi);
                    part[qi] = fmaxf(acc[4 * qi], 0.f) * wv[0] + fmaxf(acc[4 * qi + 1], 0.f) * wv[1] + fmaxf(acc[4 * qi + 2], 0.f) * wv[2] + fmaxf(acc[4 * qi + 3], 0.f) * wv[3]; }
                const float send0 = hi ? part[0] : part[2], send1 = hi ? part[1] : part[3];
                const float got0 = __shfl_xor(send0, 32), got1 = __shfl_xor(send1, 32);
                const float f0 = (hi ? part[2] : part[0]) + got0, f1 = (hi ? part[3] : part[1]) + got1;
                const int q0 = 4 * rt + 2 * hi;
                sc[q0 * SCP + 32 * s + r32] = f0; sc[(q0 + 1) * SCP + 32 * s + r32] = f1;
            }
            if (mstrip) {
#pragma unroll
                for (int ks = 0; ks < 4; ++ks) bfr[ks] = bnx[ks];
            }
        }
        if (more && tid < 128) wtb[((it + 1) & 1) * 128 + tid] = wnext;
        __syncthreads();
        { const int q = 2 * w;
          unsigned* mrowA = F.MASK + (size_t)(b * SEQ + t0 + q) * 64; unsigned* mrowB = mrowA + 64;
          const LAS float* rowA = sc + q * SCP; const LAS float* rowB = rowA + SCP;
          unsigned Wa[32], Wb[32];
          select_prepare(rowA, rowB, n >> 6, Wa, Wb, lane);
          asm volatile("" ::: "memory");
          if (more) load_af(F, un, af);
          select_finish(Wa, Wb, n >> 6, mrowA, mrowB, lane); }
        if (more) { int bn, cn, sn; decode(un, bn, cn, sn); if (w < 2 * (cn + 1)) load_bf(F, bn, w, bfr); }
    }
    __syncthreads();
}
}
__device__ __forceinline__ void ph_indexer(Frame& F) {
    { const int gw = F.vcu * NWAVES + F.wave, NGW = F.G * NWAVES;
      for (int i = gw; i < BATCH * 256; i += NGW) { const int b = i >> 8, pos = i & 255, n = ((pos >> 6) + 1) << 6;
          if (F.lane < 32) { unsigned long long v = 0ull; if (64 * F.lane < n) v = ~0ull; *(unsigned long long*)(F.MASK + (size_t)(b * SEQ + pos) * 64 + 2 * F.lane) = v; } } }
    idx::run(F);
}
namespace gla {
using att::f32x16; using att::u32x4;
constexpr int L_WL = 0, L_V = 4096, L_OG = 36864, L_K = 69632, L_Q = 78848, L_PART = 88064, L_STG = 89088, KP = 144, SP = 272;
struct In { u32x4 g0, g1, kk, qq; f32x4 b0, b1; };
__device__ __forceinline__ void decode(int u, int& b, int& h, int& c) { b = u >> 7; h = (u >> 5) & 3; c = u & 31; }
template <bool PASSC> __device__ __forceinline__ void load_in(Frame& F, int u, In& in, const float* BC) {
    int b, h, c; decode(u, b, h, c);
    const bf16* pr = F.R1 + (size_t)(b * SEQ + 64 * c + F.lane) * NAB;
    in.kk = *(const u32x4*)(pr + C_KB + h * 64 + 8 * F.wave);
    if (PASSC) { in.qq = *(const u32x4*)(pr + C_QB + h * 64 + 8 * F.wave);
        const float* bp = BC + ((size_t)u * 64 + F.lane) * 64 + 8 * F.wave; in.b0 = *(const f32x4*)bp; in.b1 = *(const f32x4*)(bp + 4); }
    else { in.g0 = *(const u32x4*)(pr + C_GL); in.g1 = *(const u32x4*)(pr + C_GL + 8); }
}
template <bool NEEDOG> __device__ __forceinline__ void dma_in(Frame& F, int u, int buf, const unsigned (&dvo)[2]) {
    int b, h, c; decode(u, b, h, c);
    const bf16* P = F.R1 + (size_t)(b * SEQ + 64 * c) * NAB;
    att::tile_dma(P + C_VB + h * 128, dvo, F.lds + L_V + buf * 16384, F.wave);
    if (NEEDOG) att::tile_dma(P + C_OG + h * 128, dvo, F.lds + L_OG + buf * 16384, F.wave);
}
__device__ __forceinline__ void stage_wl(Frame& F, int h) {
    LAS float* wl = (LAS float*)(F.lds + L_WL);
#pragma unroll
    for (int i = 0; i < 2; ++i) { const int e = F.tid + 512 * i, r = e >> 6, d = e & 63; wl[e] = F.w_gate_up[r * 256 + h * 64 + d]; }
}
__device__ __forceinline__ void unpack8(const u32x4 v, float (&f)[8]) {
#pragma unroll
    for (int i = 0; i < 4; ++i) { f[2 * i] = __uint_as_float(v[i] << 16); f[2 * i + 1] = __uint_as_float(v[i] & 0xffff0000u); }
}
__device__ __forceinline__ void gate_scan(Frame& F, int h, const float (&gl)[16], float (&bc)[8], float (&blast)[8]) {
    const int lane = F.lane, d0 = 8 * F.wave;
    const LAS float* wl = (const LAS float*)(F.lds + L_WL);
    float acc[8];
#pragma unroll
    for (int i = 0; i < 8; ++i) acc[i] = F.b_gate[h * 64 + d0 + i];
#pragma unroll
    for (int r = 0; r < 16; ++r) { const f32x4 w0 = *(const LAS f32x4*)(wl + r * 64 + d0), w1 = *(const LAS f32x4*)(wl + r * 64 + d0 + 4);
#pragma unroll
        for (int i = 0; i < 4; ++i) { acc[i] = fmaf(gl[r], w0[i], acc[i]); acc[4 + i] = fmaf(gl[r], w1[i], acc[4 + i]); } }
#pragma unroll
    for (int i = 0; i < 8; ++i) { float v = (fminf(acc[i], 0.f) - __logf(1.0f + __expf(-fabsf(acc[i])))) * (1.0f / 16.0f);
#pragma unroll
        for (int off = 1; off < 64; off <<= 1) { const float u = __shfl_up(v, off); if (lane >= off) v += u; }
        bc[i] = v; blast[i] = __shfl(v, 63); }
}
__device__ __forceinline__ void pass_a(Frame& F, float* GU, float* DEC, float* BC) {
    const int lane = F.lane, w = F.wave, hi = lane >> 5, r32 = lane & 31;
    att::FragOff fo; att::frag_off_init(fo, lane);
    unsigned dvo[2]; att::dma_off_init(dvo, NAB, w, lane);
    const int et = w >> 1, dt = w & 1, va_et = att::frag_va(lane, et);
    int u = F.vcu; if (u >= BATCH * 4 * 32) return;
    In cur, nxt; int hprev = -1;
    dma_in<false>(F, u, 0, dvo); load_in<false>(F, u, cur, BC);
    for (int it = 0; u < BATCH * 4 * 32; ++it, u += F.G) {
        int b, h, c; decode(u, b, h, c);
        const int un = u + F.G; const bool more = un < BATCH * 4 * 32;
        if (h != hprev) { stage_wl(F, h); hprev = h; }
        asm volatile("s_waitcnt vmcnt(0) lgkmcnt(0)" ::: "memory");
        __syncthreads();
        float gl[16], kf[8];
        unpack8(cur.g0, (float(&)[8])gl[0]); unpack8(cur.g1, (float(&)[8])gl[8]); unpack8(cur.kk, kf);
        asm volatile("" ::: "memory");
        if (more) { dma_in<false>(F, un, (it + 1) & 1, dvo); load_in<false>(F, un, nxt, BC); }
        float bc[8], blast[8];
        gate_scan(F, h, gl, bc, blast);
        const int uid = u;
        { float* bp = BC + ((size_t)uid * 64 + lane) * 64 + 8 * w; *(f32x4*)bp = (f32x4){bc[0], bc[1], bc[2], bc[3]}; *(f32x4*)(bp + 4) = (f32x4){bc[4], bc[5], bc[6], bc[7]}; }
#pragma unroll
        for (int i = 0; i < 8; ++i) *(LAS bf16*)(F.lds + L_K + (8 * w + i) * KP + lane * 2) = (bf16)f2bf(kf[i] * __expf(blast[i] - bc[i]));
        if (lane == 0) {
#pragma unroll
            for (int i = 0; i < 8; ++i) DEC[(size_t)uid * 64 + 8 * w + i] = __expf(blast[i]); }
        asm volatile("s_waitcnt lgkmcnt(0)" ::: "memory");
        __syncthreads();
        const LAS unsigned char* vbuf = F.lds + L_V + (it & 1) * 16384;
        f32x16 acc;
#pragma unroll
        for (int r = 0; r < 16; ++r) acc[r] = 0.f;
#pragma unroll
        for (int kk = 0; kk < 4; ++kk) {
            const LAS unsigned char* kp = F.lds + L_K + (32 * dt + r32) * KP + (16 * kk + 4 * hi) * 2;
            const unsigned long long lo = *(const LAS unsigned long long*)kp, hh = *(const LAS unsigned long long*)(kp + 16);
            u32x4 bw; bw.x = (unsigned)lo; bw.y = (unsigned)(lo >> 32); bw.z = (unsigned)hh; bw.w = (unsigned)(hh >> 32);
            acc = __builtin_amdgcn_mfma_f32_32x32x16_bf16(att::v_frag_rt(vbuf, va_et, fo.vd, kk), __builtin_bit_cast(bf16x8, bw), acc, 0, 0, 0);
        }
        float* gu = GU + (size_t)uid * 8192;
#pragma unroll
        for (int r = 0; r < 16; ++r) gu[(32 * et + att::crow(r, hi)) * 64 + 32 * dt + r32] = acc[r];
        cur = nxt;
    }
    __syncthreads();
}
__device__ __forceinline__ void pass_b(Frame& F, float* GU, const float* DEC) {
    for (int idx = F.vcu * NTHR + F.tid; idx < 64 * 128 * 16; idx += F.G * NTHR) {
        const int bh = idx >> 11, e = (idx >> 4) & 127, dq = idx & 15;
        f32x4 S = (f32x4){0.f, 0.f, 0.f, 0.f};
        for (int c0 = 0; c0 < 32; c0 += 8) {
            f32x4 U[8], dec[8];
#pragma unroll
            for (int i = 0; i < 8; ++i) { const size_t uid = (size_t)bh * 32 + c0 + i; U[i] = *(const f32x4*)(GU + (uid * 128 + e) * 64 + 4 * dq); dec[i] = *(const f32x4*)(DEC + uid * 64 + 4 * dq); }
#pragma unroll
            for (int i = 0; i < 8; ++i) { const size_t uid = (size_t)bh * 32 + c0 + i; *(f32x4*)(GU + (uid * 128 + e) * 64 + 4 * dq) = S; S = dec[i] * S + U[i]; }
        }
    }
}
__device__ __forceinline__ void pass_c(Frame& F, const float* GU, const float* BC) {
    const int lane = F.lane, w = F.wave, hi = lane >> 5, r32 = lane & 31, tid = F.tid;
    LAS unsigned char* lds = F.lds;
    att::FragOff fo; att::frag_off_init(fo, lane);
    unsigned dvo[2]; att::dma_off_init(dvo, NAB, w, lane);
    const int et = w >> 1, tt = w & 1, tl = 32 * tt + r32, va_et = att::frag_va(lane, et);
    int u = F.vcu; if (u >= BATCH * 4 * 32) return;
    In cur, nxt;
    dma_in<true>(F, u, 0, dvo); load_in<true>(F, u, cur, BC);
    for (int it = 0; u < BATCH * 4 * 32; ++it, u += F.G) {
        int b, h, c; decode(u, b, h, c);
        const int un = u + F.G; const bool more = un < BATCH * 4 * 32;
        asm volatile("s_waitcnt vmcnt(0) lgkmcnt(0)" ::: "memory");
        __syncthreads();
        float kf[8], qf[8], bc[8];
        unpack8(cur.kk, kf); unpack8(cur.qq, qf);
#pragma unroll
        for (int i = 0; i < 4; ++i) { bc[i] = cur.b0[i]; bc[4 + i] = cur.b1[i]; }
        asm volatile("" ::: "memory");
        if (more) { dma_in<true>(F, un, (it + 1) & 1, dvo); load_in<true>(F, un, nxt, BC); }
        f32x4 sf[8];
        { const float* gs = GU + ((size_t)u * 128 + 32 * et + r32) * 64;
#pragma unroll
          for (int ks = 0; ks < 4; ++ks) { sf[2 * ks] = *(const f32x4*)(gs + 16 * ks + 8 * hi); sf[2 * ks + 1] = *(const f32x4*)(gs + 16 * ks + 8 * hi + 4); } }
        { float eq[8], ek[8];
#pragma unroll
          for (int i = 0; i < 8; ++i) { eq[i] = qf[i] * 0.125f * __expf(bc[i]); ek[i] = kf[i] * __expf(-bc[i]); }
          *(LAS bf16x8*)(lds + L_Q + lane * KP + 16 * w) = att::pack8(eq[0], eq[1], eq[2], eq[3], eq[4], eq[5], eq[6], eq[7]);
          *(LAS bf16x8*)(lds + L_K + lane * KP + 16 * w) = att::pack8(ek[0], ek[1], ek[2], ek[3], ek[4], ek[5], ek[6], ek[7]); }
        asm volatile("s_waitcnt lgkmcnt(0)" ::: "memory");
        __syncthreads();
        const LAS unsigned char* vbuf = lds + L_V + (it & 1) * 16384; const LAS unsigned char* ogbuf = lds + L_OG + (it & 1) * 16384;
        bf16x8 qfr[4];
#pragma unroll
        for (int ks = 0; ks < 4; ++ks) qfr[ks] = *(const LAS bf16x8*)(lds + L_Q + tl * KP + (16 * ks + 8 * hi) * 2);
        f32x16 p0, p1;
#pragma unroll
        for (int r = 0; r < 16; ++r) { p0[r] = 0.f; p1[r] = 0.f; }
#pragma unroll
        for (int ks = 0; ks < 4; ++ks) {
            const bf16x8 a0 = *(const LAS bf16x8*)(lds + L_K + r32 * KP + (16 * ks + 8 * hi) * 2), a1 = *(const LAS bf16x8*)(lds + L_K + (32 + r32) * KP + (16 * ks + 8 * hi) * 2);
            p0 = __builtin_amdgcn_mfma_f32_32x32x16_bf16(a0, qfr[ks], p0, 0, 0, 0); p1 = __builtin_amdgcn_mfma_f32_32x32x16_bf16(a1, qfr[ks], p1, 0, 0, 0);
        }
        { const int tl4 = tl - 4 * hi;
#pragma unroll
          for (int r = 0; r < 16; ++r) { const int s = (r & 3) + 8 * (r >> 2); if (s > tl4) p0[r] = 0.f; if (s + 32 > tl4) p1[r] = 0.f; } }
        const bf16x8 pa0 = att::pack8(p0[0], p0[1], p0[2], p0[3], p0[4], p0[5], p0[6], p0[7]), pa1 = att::pack8(p0[8], p0[9], p0[10], p0[11], p0[12], p0[13], p0[14], p0[15]);
        const bf16x8 pa2 = att::pack8(p1[0], p1[1], p1[2], p1[3], p1[4], p1[5], p1[6], p1[7]), pa3 = att::pack8(p1[8], p1[9], p1[10], p1[11], p1[12], p1[13], p1[14], p1[15]);
        f32x16 acc;
#pragma unroll
        for (int r = 0; r < 16; ++r) acc[r] = 0.f;
        acc = __builtin_amdgcn_mfma_f32_32x32x16_bf16(att::v_frag_rt(vbuf, va_et, fo.vd, 0), pa0, acc, 0, 0, 0);
        acc = __builtin_amdgcn_mfma_f32_32x32x16_bf16(att::v_frag_rt(vbuf, va_et, fo.vd, 1), pa1, acc, 0, 0, 0);
        acc = __builtin_amdgcn_mfma_f32_32x32x16_bf16(att::v_frag_rt(vbuf, va_et, fo.vd, 2), pa2, acc, 0, 0, 0);
        acc = __builtin_amdgcn_mfma_f32_32x32x16_bf16(att::v_frag_rt(vbuf, va_et, fo.vd, 3), pa3, acc, 0, 0, 0);
#pragma unroll
        for (int ks = 0; ks < 4; ++ks) { const f32x4 s0 = sf[2 * ks], s1 = sf[2 * ks + 1];
            acc = __builtin_amdgcn_mfma_f32_32x32x16_bf16(att::pack8(s0[0], s0[1], s0[2], s0[3], s1[0], s1[1], s1[2], s1[3]), qfr[ks], acc, 0, 0, 0); }
        float ss = 0.f;
#pragma unroll
        for (int r = 0; r < 16; ++r) ss = fmaf(acc[r], acc[r], ss);
        ss += __shfl_xor(ss, 32);
        LAS float* part = (LAS float*)(lds + L_PART);
        if (hi == 0) part[et * 64 + tl] = ss;
        asm volatile("s_waitcnt lgkmcnt(0)" ::: "memory");
        __syncthreads();
        const float rs = rsqrtf(((part[tl] + part[64 + tl]) + (part[128 + tl] + part[192 + tl])) * (1.0f / 128.0f) + EPS);
#pragma unroll
        for (int g = 0; g < 4; ++g) {
            const int e0 = 32 * et + 8 * g + 4 * hi;
            const unsigned long long ow = *(const LAS unsigned long long*)(ogbuf + att::img_off(tl, 4 * et + g) + 8 * hi);
            const f32x4 gg = *(const f32x4*)(F.g_gla + e0);
            float y[4];
#pragma unroll
            for (int i = 0; i < 4; ++i) { const float og = __uint_as_float(((unsigned)(ow >> (16 * i)) & 0xffffu) << 16); y[i] = acc[4 * g + i] * rs * gg[i] * (og * __builtin_amdgcn_rcpf(1.0f + __expf(-og))); }
            *(LAS unsigned long long*)(lds + L_STG + tl * SP + e0 * 2) = (unsigned long long)pg8::cvt_pk_bf16(y[0], y[1]) | ((unsigned long long)pg8::cvt_pk_bf16(y[2], y[3]) << 32);
        }
        asm volatile("s_waitcnt lgkmcnt(0)" ::: "memory");
        __syncthreads();
#pragma unroll
        for (int i = 0; i < 2; ++i) { const int cidx = tid + 512 * i, row = cidx >> 4, ch = cidx & 15;
            *(u32x4*)(F.CAT + (size_t)(b * SEQ + 64 * c + row) * D + 512 + h * 128 + ch * 8) = *(const LAS u32x4*)(lds + L_STG + row * SP + ch * 16); }
        cur = nxt;
    }
    __syncthreads();
}
}
__device__ __forceinline__ void ph_rope_tables(Frame& F, float* R128, float* R64) {
    for (int i = F.vcu * NTHR + F.tid; i < SEQ * 24; i += F.G * NTHR) {
        const int pos = i / 24, k = i % 24;
        if (k < 16) { const float inv = powf(500000.0f, -(float)k * 2.0f / 32.0f), ang = (float)pos * inv; R128[pos * 32 + k] = cosf(ang); R128[pos * 32 + 16 + k] = sinf(ang); }
        else { const int j = k - 16; const float inv = powf(500000.0f, -(float)j * 2.0f / 16.0f), ang = (float)pos * inv; R64[pos * 16 + j] = cosf(ang); R64[pos * 16 + 8 + j] = sinf(ang); }
    }
}
__device__ __forceinline__ float dpp_xor1(float v) { return __builtin_bit_cast(float, __builtin_amdgcn_mov_dpp(__builtin_bit_cast(int, v), 0xB1, 0xF, 0xF, true)); }
__device__ __forceinline__ float dpp_xor2(float v) { return __builtin_bit_cast(float, __builtin_amdgcn_mov_dpp(__builtin_bit_cast(int, v), 0x4E, 0xF, 0xF, true)); }
__device__ __forceinline__ void ph_prep_c_fast(Frame& F) {
    const int gw = F.vcu * NWAVES + F.wave, NGW = F.G * NWAVES, lane = F.lane;
    const float* gn = (lane < 32 ? F.gq_c : F.gk_c) + (lane & 3) * 32;
    const float sc = lane < 32 ? att::C2 : 1.0f;
    float g[32];
#pragma unroll
    for (int i = 0; i < 8; ++i) { const f32x4 v = *(const f32x4*)(gn + 4 * i); g[4 * i] = v[0] * sc; g[4 * i + 1] = v[1] * sc; g[4 * i + 2] = v[2] * sc; g[4 * i + 3] = v[3] * sc; }
    for (int tok = gw; tok < M; tok += NGW) {
        att::u32x4* p = (att::u32x4*)(F.R1 + (size_t)tok * NC + lane * 32);
        att::u32x4 v[4]; float f[32]; float ss = 0.f;
#pragma unroll
        for (int i = 0; i < 4; ++i) v[i] = p[i];
#pragma unroll
        for (int i = 0; i < 4; ++i)
#pragma unroll
            for (int j = 0; j < 4; ++j) { const float a = __uint_as_float(v[i][j] << 16), b = __uint_as_float(v[i][j] & 0xffff0000u); f[8 * i + 2 * j] = a; f[8 * i + 2 * j + 1] = b; ss = fmaf(a, a, fmaf(b, b, ss)); }
        ss += dpp_xor1(ss); ss += dpp_xor2(ss);
        const float rs = rsqrtf(ss * (1.f / 128.f) + EPS);
#pragma unroll
        for (int i = 0; i < 4; ++i) { att::u32x4 o;
#pragma unroll
            for (int j = 0; j < 4; ++j) o[j] = pg8::cvt_pk_bf16(f[8 * i + 2 * j] * rs * g[8 * i + 2 * j], f[8 * i + 2 * j + 1] * rs * g[8 * i + 2 * j + 1]);
            p[i] = o; }
    }
}
__device__ __forceinline__ void ph_prep_a_fast(Frame& F, const float* R128, const float* R64) {
    const int gw = F.vcu * NWAVES + F.wave, NGW = F.G * NWAVES, lane = F.lane, l8 = lane & 7;
    const float* gn = (lane < 32 ? F.gq_a : F.gk_a) + l8 * 16;
    const float sc = lane < 32 ? att::C2 : 1.0f;
    float g[16];
#pragma unroll
    for (int i = 0; i < 4; ++i) { const f32x4 v = *(const f32x4*)(gn + 4 * i); g[4 * i] = v[0] * sc; g[4 * i + 1] = v[1] * sc; g[4 * i + 2] = v[2] * sc; g[4 * i + 3] = v[3] * sc; }
    for (int tok = gw; tok < M; tok += NGW) {
        const int pos = tok & (SEQ - 1);
        bf16* pr = F.R1 + (size_t)tok * NAB;
        {   att::u32x4* p = (att::u32x4*)(pr + lane * 16);
            const att::u32x4 v0 = p[0], v1 = p[1]; float f[16]; float ss = 0.f;
#pragma unroll
            for (int j = 0; j < 4; ++j) { f[2 * j] = __uint_as_float(v0[j] << 16); f[2 * j + 1] = __uint_as_float(v0[j] & 0xffff0000u); f[8 + 2 * j] = __uint_as_float(v1[j] << 16); f[8 + 2 * j + 1] = __uint_as_float(v1[j] & 0xffff0000u); }
#pragma unroll
            for (int i = 0; i < 16; ++i) ss = fmaf(f[i], f[i], ss);
            ss += dpp_xor1(ss); ss += dpp_xor2(ss); ss += __shfl_xor(ss, 4);
            const float rs = rsqrtf(ss * (1.f / 128.f) + EPS);
#pragma unroll
            for (int i = 0; i < 16; ++i) f[i] = f[i] * rs * g[i];
            const float* cs = R128 + pos * 32;
#pragma unroll
            for (int i = 0; i < 16; ++i) { const float other = dpp_xor1(f[i]);
                if (l8 < 2) { const float c = cs[i], s = cs[16 + i]; f[i] = (l8 == 0) ? f[i] * c - other * s : f[i] * c + other * s; } }
            att::u32x4 o0, o1;
#pragma unroll
            for (int j = 0; j < 4; ++j) { o0[j] = pg8::cvt_pk_bf16(f[2 * j], f[2 * j + 1]); o1[j] = pg8::cvt_pk_bf16(f[8 + 2 * j], f[8 + 2 * j + 1]); }
            p[0] = o0; p[1] = o1;
        }
        {
#pragma unroll
            for (int part = 0; part < 2; ++part) {
                if (part == 1 && lane >= 8) break;
                att::u32x4* p = (att::u32x4*)(pr + (part == 0 ? C_IQ + lane * 8 : C_IK + lane * 8));
                const att::u32x4 v0 = p[0]; float f[8];
#pragma unroll
                for (int j = 0; j < 4; ++j) { f[2 * j] = __uint_as_float(v0[j] << 16); f[2 * j + 1] = __uint_as_float(v0[j] & 0xffff0000u); }
                const float* cs = R64 + pos * 16;
#pragma unroll
                for (int i = 0; i < 8; ++i) { const float other = dpp_xor1(f[i]);
                    if (l8 < 2) { const float c = cs[i], s = cs[8 + i]; f[i] = (l8 == 0) ? f[i] * c - other * s : f[i] * c + other * s; } }
                att::u32x4 o0;
#pragma unroll
                for (int j = 0; j < 4; ++j) o0[j] = pg8::cvt_pk_bf16(f[2 * j], f[2 * j + 1]);
                p[0] = o0;
            }
        }
    }
}
#ifndef MK_PER_PHASE
#define MK_PER_PHASE 0
#endif
constexpr int NPH = 14;
struct Args { const float* in[16]; float* out; unsigned char* ws; int ph_lo, ph_hi; };
__global__ void __launch_bounds__(NTHR, 2) mk_fwd(Args args) {
    extern __shared__ __attribute__((aligned(16))) unsigned char lds[];
    Frame F;
    F.lds = (LAS unsigned char*)lds;
    F.MISC = (volatile LAS unsigned*)(F.lds + MISC_OFF);
#ifdef PROBE_TOTAL
    const unsigned long long pt_start = __builtin_amdgcn_s_memrealtime();
#endif
    F.wave = __builtin_amdgcn_readfirstlane((int)threadIdx.x >> 6);
#define RELANE() (F.lane = lane_id_opaque(), F.tid = F.wave * 64 + F.lane, true)
    RELANE();
#ifdef PROBE_ACC
    F.acc_t0 = 0ull; F.acc_sum = 0ull;
#endif
    F.G = gridDim.x; { const int bx = blockIdx.x; F.vcu = (F.G % 8 == 0) ? (bx % 8) * (F.G / 8) + bx / 8 : bx; }
    unsigned char* ws = args.ws;
    F.ctl = (gu32*)(ws + WS_CTL);
    F.x = args.in[0]; F.g_mix = args.in[1]; F.g_ffn = args.in[2]; F.w_in_ab = args.in[3]; F.gq_a = args.in[4]; F.gk_a = args.in[5]; F.w_gate_up = args.in[6]; F.b_gate = args.in[7];
    F.g_gla = args.in[8]; F.w_out_ab = args.in[9]; F.w_in_c = args.in[10]; F.gq_c = args.in[11]; F.gk_c = args.in[12]; F.w_out_c = args.in[13]; F.w_up = args.in[14]; F.w_down = args.in[15];
    F.out = args.out;
    F.Wab = (bf16*)(ws + WS_WAB); F.Woab = (bf16*)(ws + WS_WOAB); F.Wup0 = (bf16*)(ws + WS_WUP0); F.Wdn0 = (bf16*)(ws + WS_WDN0);
    F.Winc = (bf16*)(ws + WS_WINC); F.Woc = (bf16*)(ws + WS_WOC); F.Wup1 = (bf16*)(ws + WS_WUP1); F.Wdn1 = (bf16*)(ws + WS_WDN1);
    F.XB = (bf16*)(ws + WS_XB); F.CAT = (bf16*)(ws + WS_CAT); F.R1 = (bf16*)(ws + WS_R1); F.SSQ = (float*)(ws + WS_SSQ); F.MASK = (unsigned*)(ws + WS_MASK);
    for (int u = F.tid; u < (LDS_BYTES - MISC_OFF) / 4; u += NTHR) ((LAS unsigned*)(F.lds + MISC_OFF))[u] = 0u;
    __syncthreads();
    XcdBarrier bar; bar.bar = (unsigned*)(F.ctl + CW_BAR); bar.x = 0; bar.st = nullptr; bar.wave = F.wave;
    if (!MK_PER_PHASE) bar = xcd_barrier_post((unsigned*)(F.ctl + CW_BAR), F.MISC + 8, F.wave);
    const int lo = args.ph_lo, hi = args.ph_hi;
#ifdef PROBE_PH
    unsigned long long pt0 = 0ull, pt1 = 0ull;
#define STAMP(k) do { if ((k) == PROBE_PH) pt0 = __builtin_amdgcn_s_memrealtime(); if ((k) == PROBE_PH + 1) pt1 = __builtin_amdgcn_s_memrealtime(); } while (0)
#ifdef PROBE_SUB
#define SUBSTAMP(k) do { if ((k) == PROBE_PH) { __syncthreads(); pt0 = __builtin_amdgcn_s_memrealtime(); } } while (0)
#else
#define SUBSTAMP(k) do { } while (0)
#endif
#else
#define STAMP(k) do { } while (0)
#define SUBSTAMP(k) do { } while (0)
#endif
#define IN(k) (lo <= (k) && (k) < hi && RELANE())
#ifdef PROBE_DBLBAR
#define SEAM(k) do { if (lo <= (k) && (k) + 1 < hi) { xcd_barrier(bar); xcd_barrier(bar); } } while (0)
#else
#define SEAM(k) do { if (lo <= (k) && (k) + 1 < hi) xcd_barrier(bar); } while (0)
#endif
    float* const SSQ0 = F.SSQ, *SSQ1 = F.SSQ + (size_t)M * 16, *SSQ2 = F.SSQ + (size_t)2 * M * 16, *SSQ3 = F.SSQ + (size_t)3 * M * 16;
    typedef pg8::StaticOrder SO;
    STAMP(0); float* const R128 = (float*)(ws + WS_ROPE); float* const R64 = R128 + SEQ * 32;
    if (IN(0)) { ph_prologue(F); ph_rope_tables(F, R128, R64); } SEAM(0);
    STAMP(1); if (IN(1)) { pg8::Gemm g{F.XB, F.Wab, M, NAB, D}; SO S; S.init(M, NAB, F.G, (int)blockIdx.x); pg8::EpiProjAB E{F.R1, NAB, SSQ0, F.gq_a, F.gk_a, R128, R64, (LAS float*)(F.lds + RING_BYTES), att::C2};
        pg8::gemm_phase<pg8::EpiProjAB, SO, true, true>(F.lds, g, S, E, F.wave);
        if (F.G == 256 && blockIdx.x >= 128) { RELANE(); prologue_weights<1>(F, ((int)blockIdx.x - 128) * NWAVES + F.wave, 128 * NWAVES); } } SEAM(1);
    float* const GU = (float*)(ws + WS_XB); float* const DEC = (float*)(ws + WS_DEC);
    STAMP(2); if (IN(2)) { SUBSTAMP(2); gla::pass_a(F, GU, DEC, (float*)(ws + WS_BC)); } SEAM(2);
    STAMP(3); if (IN(3)) { gla::pass_b(F, GU, DEC); SUBSTAMP(3); ph_indexer(F); } SEAM(3);
    STAMP(4); if (IN(4)) { ph_dsa(F); SUBSTAMP(4); gla::pass_c(F, GU, (const float*)(ws + WS_BC)); } SEAM(4);
    STAMP(5); if (IN(5)) { pg8::Gemm g{F.CAT, F.Woab, M, D, D}; SO S; S.init(M, D, F.G, (int)blockIdx.x); pg8::EpiResid<0, 0> E{F.x, nullptr, F.XB, SSQ1, nullptr};
        pg8::gemm_phase<pg8::EpiResid<0, 0>, SO, true, true>(F.lds, g, S, E, F.wave); } SEAM(5);
    STAMP(6); if (IN(6)) { pg8::Gemm g{F.XB, F.Wup0, M, FF, D}; SO S; S.init(M, FF, F.G, (int)blockIdx.x); pg8::EpiScale<1> E{F.R1, FF, SSQ1};
        pg8::gemm_phase<pg8::EpiScale<1>, SO, true, true>(F.lds, g, S, E, F.wave); } SEAM(6);
    STAMP(7); if (IN(7)) { pg8::Gemm g{F.R1, F.Wdn0, M, D, FF}; SO S; S.init(M, D, F.G, (int)blockIdx.x); pg8::EpiResid<1, 0> E{F.XB, nullptr, F.XB, SSQ2, SSQ1};
        pg8::gemm_phase<pg8::EpiResid<1, 0>, SO, true, true>(F.lds, g, S, E, F.wave); } SEAM(7);
    STAMP(8); if (IN(8)) { pg8::Gemm g{F.XB, F.Winc, M, NC, D}; SO S; S.init(M, NC, F.G, (int)blockIdx.x); pg8::EpiQKNorm E{F.R1, NC, SSQ2, F.gq_c, F.gk_c, (LAS float*)(F.lds + RING_BYTES), att::C2};
        pg8::gemm_phase<pg8::EpiQKNorm, SO, true, true>(F.lds, g, S, E, F.wave); } SEAM(8);
    STAMP(9);
    STAMP(10); if (IN(10)) { ph_sb(F); } SEAM(10);
    STAMP(11); if (IN(11)) { pg8::Gemm g{F.CAT, F.Woc, M, D, D}; SO S; S.init(M, D, F.G, (int)blockIdx.x); pg8::EpiResid<1, 0> E{F.XB, nullptr, F.XB, SSQ3, nullptr};
        pg8::gemm_phase<pg8::EpiResid<1, 0>, SO, true, true>(F.lds, g, S, E, F.wave); } SEAM(11);
    STAMP(12); if (IN(12)) { pg8::Gemm g{F.XB, F.Wup1, M, FF, D}; SO S; S.init(M, FF, F.G, (int)blockIdx.x); pg8::EpiScale<1> E{F.R1, FF, SSQ3};
        pg8::gemm_phase<pg8::EpiScale<1>, SO, true, true>(F.lds, g, S, E, F.wave); } SEAM(12);
    STAMP(13); if (IN(13)) { pg8::Gemm g{F.R1, F.Wdn1, M, D, FF}; SO S; S.init(M, D, F.G, (int)blockIdx.x); pg8::EpiResid<1, 1> E{F.XB, F.out, nullptr, nullptr, SSQ3};
        pg8::gemm_phase<pg8::EpiResid<1, 1>, SO, true, true>(F.lds, g, S, E, F.wave); }
    STAMP(NPH);
#ifdef PROBE_TOTAL
    if (blockIdx.x == 0) { const unsigned long long t1 = __builtin_amdgcn_s_memrealtime(), dt = (t1 - pt_start); while (__builtin_amdgcn_s_memrealtime() - t1 < dt) __builtin_amdgcn_s_sleep(8); }
#endif
#ifdef PROBE_ACC
    if (blockIdx.x == 0) { const unsigned long long t1 = __builtin_amdgcn_s_memrealtime(), dt = F.acc_sum * PROBE_MULT; while (__builtin_amdgcn_s_memrealtime() - t1 < dt) __builtin_amdgcn_s_sleep(8); }
#endif
#ifdef PROBE_PH
    if (blockIdx.x == 0) { const unsigned long long t1 = __builtin_amdgcn_s_memrealtime(), dt = (pt1 - pt0) * PROBE_MULT; while (__builtin_amdgcn_s_memrealtime() - t1 < dt) __builtin_amdgcn_s_sleep(8); }
#endif
#undef IN
#undef SEAM
}

extern "C" void kernel_launch(void* const* d_in, const int* in_sizes, int n_in, void* d_out, int out_size, void* d_ws, size_t ws_size, hipStream_t stream) {
    static int grid = 0;
    if (grid == 0) {
        if (n_in != 16 || in_sizes[0] != M * D || out_size != M * D || ws_size < WS_END) { fprintf(stderr, "kernel_launch: unexpected shapes / workspace (%d inputs, ws %zu)\n", n_in, ws_size); grid = -1; return; }
        int dev = 0, cus = 0;
        if (hipGetDevice(&dev) != hipSuccess || hipDeviceGetAttribute(&cus, hipDeviceAttributeMultiprocessorCount, dev) != hipSuccess) { grid = -1; return; }
        if (hipFuncSetAttribute((const void*)mk_fwd, hipFuncAttributeMaxDynamicSharedMemorySize, LDS_BYTES) != hipSuccess) { fprintf(stderr, "kernel_launch: hipFuncSetAttribute failed\n"); grid = -1; return; }
        (void)hipGetLastError();
        grid = cus;
    }
    if (grid < 0) return;
    if (hipMemsetAsync((char*)d_ws + WS_CTL, 0, CTL_ZERO_BYTES, stream) != hipSuccess) { fprintf(stderr, "kernel_launch: memset failed\n"); return; }
    Args a{};
    for (int i = 0; i < 16; ++i) a.in[i] = (const float*)d_in[i];
    a.out = (float*)d_out; a.ws = (unsigned char*)d_ws;
#if MK_PER_PHASE
    for (int ph = 0; ph < NPH; ++ph) { a.ph_lo = ph; a.ph_hi = ph + 1; hipLaunchKernelGGL(mk_fwd, dim3(grid), dim3(NTHR), LDS_BYTES, stream, a); }
#else
    a.ph_lo = 0; a.ph_hi = NPH;
    hipLaunchKernelGGL(mk_fwd, dim3(grid), dim3(NTHR), LDS_BYTES, stream, a);
#endif
    const hipError_t le = hipPeekAtLastError();
    if (le != hipSuccess) fprintf(stderr, "kernel_launch: launch failed: %s\n", hipGetErrorName(le));
}
```

```cpp
#include <hip/hip_runtime.h>
#include <cstdio>
#include <cstdint>
namespace pg8 {
#define PG8_LAS __attribute__((address_space(3)))
typedef unsigned short bf16_t;
typedef short bf16x8 __attribute__((ext_vector_type(8)));
typedef float f32x4 __attribute__((ext_vector_type(4)));
typedef unsigned u32x4 __attribute__((ext_vector_type(4)));
constexpr int BM = 256, BK = 64, HALF = 128, HTB = HALF * BK * 2  , STAGE_BYTES = 8 * HTB, NXCD = 8, WGM = 8;

__host__ __device__ __forceinline__ int lds_byte(int r, int c) { const int st = (r >> 4) * 2 + (c >> 5), rr = r & 15, cc = c & 31, ob = rr * 64 + cc * 2; return st * 1024 + (ob ^ (((ob >> 9) & 1) << 5)); }
__host__ __device__ __forceinline__ void stage_rc(int b, int& R, int& C) { const int st = b / 1024, sb = b % 1024, swz = sb ^ (((sb >> 9) & 1) << 5); R = (st >> 1) * 16 + swz / 64; C = (st & 1) * 32 + (swz % 64) / 2; }
__host__ __device__ __forceinline__ int perm32(int rho) { const int n = rho >> 4, i = rho & 15; return 8 * (i >> 2) + 4 * n + (i & 3); }

struct Unit { int pm, pn; };
struct Gemm { const bf16_t* A; const bf16_t* Bt; int M, N, K; };

struct StaticOrder {
    int nM, nN, nwg, G, c;
    __host__ __device__ void init(int M, int N, int G_, int c_) { nM = M / BM; nN = N / BM; nwg = nM * nN; G = G_; c = c_; }
    __host__ __device__ bool next(int i, Unit& u) const {
        const long L = (long)i * G + c; if (L >= nwg) return false;
        int wgid = (int)L; { const int q = nwg / NXCD, r = nwg % NXCD, xcd = wgid % NXCD, off = wgid / NXCD; wgid = (xcd < r ? xcd * (q + 1) : r * (q + 1) + (xcd - r) * q) + off; }
        const int nig = WGM * nN, gid = wgid / nig, fm = gid * WGM, gsz = (nM - fm) < WGM ? (nM - fm) : WGM;
        u.pm = fm + ((wgid % nig) % gsz); u.pn = (wgid % nig) / gsz; return true;
    }
    __device__ __forceinline__ void a_ready(const Unit&) const {}
    __device__ __forceinline__ void done(const Unit&) const {}
};

__device__ __forceinline__ unsigned cvt_pk_bf16(float lo, float hi) { unsigned r; asm volatile("v_cvt_pk_bf16_f32 %0, %1, %2" : "=v"(r) : "v"(lo), "v"(hi)); return r; }
__device__ __forceinline__ float row_rstd(const float* ssqp, int row) {
    const f32x4* p = (const f32x4*)(ssqp + (size_t)row * 16);
    const f32x4 a = p[0], b = p[1], c = p[2], d = p[3];
    const float s = (((a[0] + a[1]) + (a[2] + a[3])) + ((b[0] + b[1]) + (b[2] + b[3]))) + (((c[0] + c[1]) + (c[2] + c[3])) + ((d[0] + d[1]) + (d[2] + d[3])));
    return rsqrtf(s * (1.0f / 1024.0f) + 1e-6f);
}
__device__ __forceinline__ int epi_lane() { int l; asm volatile("v_mbcnt_lo_u32_b32 %0, -1, 0\n\tv_mbcnt_hi_u32_b32 %0, -1, %0" : "=v"(l)); return l; }
template <int ACT  > struct EpiScale {
    static constexpr bool PERM = true, AFTER_DRAIN = false;
    bf16_t* O; int ldc; const float* ssqp;
    __device__ __forceinline__ void operator()(const f32x4 (&acc)[2][2][4][2], const Unit& u, int wr, int wc, int fr, int fq) const {
        const int row0 = u.pm * BM + wr * 64 + fr, col0 = u.pn * BM + wc * 32 + 8 * fq;
#pragma unroll
        for (int ai = 0; ai < 2; ++ai)
#pragma unroll
            for (int m = 0; m < 4; ++m) {
                const int row = row0 + ai * HALF + m * 16;
                const float rs = (ACT == 0) ? row_rstd(ssqp, row) : 1.0f;
                bf16_t* rowp = O + (size_t)row * ldc + col0;
#pragma unroll
                for (int bj = 0; bj < 2; ++bj) {
                    f32x4 v0 = acc[ai][bj][m][0] * rs, v1 = acc[ai][bj][m][1] * rs;
                    if (ACT == 1) {
#pragma unroll
                        for (int e = 0; e < 4; ++e) { const float a0 = fmaxf(v0[e], 0.f), a1 = fmaxf(v1[e], 0.f); v0[e] = a0 * a0; v1[e] = a1 * a1; }
                    }
                    u32x4 w; w.x = cvt_pk_bf16(v0[0], v0[1]); w.y = cvt_pk_bf16(v0[2], v0[3]); w.z = cvt_pk_bf16(v1[0], v1[1]); w.w = cvt_pk_bf16(v1[2], v1[3]);
                    *(u32x4*)(rowp + bj * HALF) = w;
                }
            }
    }
};
template <int RIN, int OUT> struct EpiResid {
    static constexpr bool PERM = true, AFTER_DRAIN = false;
    const void* R; float* out; bf16_t* hb; float* ssqp; const float* ssq_in;
    __device__ __forceinline__ void operator()(const f32x4 (&acc)[2][2][4][2], const Unit& u, int wr, int wc, int fr, int fq) const {
        const int row0 = u.pm * BM + wr * 64 + fr, col0 = u.pn * BM + wc * 32 + 8 * fq;
        constexpr int MB = 2;
        constexpr int NW = (RIN == 0) ? 2 : 1;
#pragma unroll
        for (int ai = 0; ai < 2; ++ai)
#pragma unroll
            for (int m0 = 0; m0 < 4; m0 += MB) {
                u32x4 rw[MB][2][NW]; f32x4 pp[MB][4];
#pragma unroll
                for (int mm = 0; mm < MB; ++mm)
#pragma unroll
                    for (int bj = 0; bj < 2; ++bj) { const unsigned off = (unsigned)((row0 + ai * HALF + (m0 + mm) * 16) * 1024 + col0 + bj * HALF);
                        if (RIN == 0) { rw[mm][bj][0] = *(const u32x4*)((const char*)R + off * 4u); rw[mm][bj][NW - 1] = *(const u32x4*)((const char*)R + off * 4u + 16u); }
                        else rw[mm][bj][0] = *(const u32x4*)((const char*)R + off * 2u); }
                if (ssq_in) {
#pragma unroll
                    for (int mm = 0; mm < MB; ++mm) { const f32x4* p = (const f32x4*)((const char*)ssq_in + (unsigned)(row0 + ai * HALF + (m0 + mm) * 16) * 64u);
#pragma unroll
                        for (int k = 0; k < 4; ++k) pp[mm][k] = p[k]; } }
                asm volatile("" ::: "memory");
#pragma unroll
                for (int mm = 0; mm < MB; ++mm) {
                    const int m = m0 + mm, row = row0 + ai * HALF + m * 16;
                    const unsigned off = (unsigned)(row * 1024 + col0);
                    float sc2 = 1.0f;
                    if (ssq_in) { const f32x4 a = pp[mm][0], b = pp[mm][1], c = pp[mm][2], d = pp[mm][3];
                        const float sum = (((a[0] + a[1]) + (a[2] + a[3])) + ((b[0] + b[1]) + (b[2] + b[3]))) + (((c[0] + c[1]) + (c[2] + c[3])) + ((d[0] + d[1]) + (d[2] + d[3])));
                        const float rs = rsqrtf(sum * (1.0f / 1024.0f) + 1e-6f); sc2 = rs * rs; }
                    float ss = 0.f;
#pragma unroll
                    for (int bj = 0; bj < 2; ++bj) {
                        f32x4 r0, r1;
                        if (RIN == 0) { r0 = __builtin_bit_cast(f32x4, rw[mm][bj][0]); r1 = __builtin_bit_cast(f32x4, rw[mm][bj][NW - 1]); }
                        else { const u32x4 w = rw[mm][bj][0];
                            r0 = (f32x4){__uint_as_float(w.x << 16), __uint_as_float(w.x & 0xffff0000u), __uint_as_float(w.y << 16), __uint_as_float(w.y & 0xffff0000u)};
                            r1 = (f32x4){__uint_as_float(w.z << 16), __uint_as_float(w.z & 0xffff0000u), __uint_as_float(w.w << 16), __uint_as_float(w.w & 0xffff0000u)}; }
                        const f32x4 v0 = acc[ai][bj][m][0] * sc2 + r0, v1 = acc[ai][bj][m][1] * sc2 + r1;
                        if (OUT == 1) { *(f32x4*)((char*)out + (off + bj * HALF) * 4u) = v0; *(f32x4*)((char*)out + (off + bj * HALF) * 4u + 16u) = v1; }
                        else {
                            u32x4 w; w.x = cvt_pk_bf16(v0[0], v0[1]); w.y = cvt_pk_bf16(v0[2], v0[3]); w.z = cvt_pk_bf16(v1[0], v1[1]); w.w = cvt_pk_bf16(v1[2], v1[3]);
                            *(u32x4*)((char*)hb + (off + bj * HALF) * 2u) = w;
                            ss += ((v0[0] * v0[0] + v0[1] * v0[1]) + (v0[2] * v0[2] + v0[3] * v0[3])) + ((v1[0] * v1[0] + v1[1] * v1[1]) + (v1[2] * v1[2] + v1[3] * v1[3]));
                        }
                    }
                    if (OUT == 0) { ss += __shfl_xor(ss, 16); ss += __shfl_xor(ss, 32); if (fq == 0) *(float*)((char*)ssqp + (unsigned)(row * 16 + u.pn * 4 + wc) * 4u) = ss; }
                }
            }
    }
};
struct EpiQKNorm {
    static constexpr bool PERM = true, AFTER_DRAIN = false;
    bf16_t* O; int ldc; const float* ssqp; const float* gq; const float* gk; PG8_LAS float* part; float qscale;
    __device__ __forceinline__ void operator()(const f32x4 (&acc)[2][2][4][2], const Unit& u, int wr, int wc, int fr_, int fq_) const {
        const int ln = epi_lane(), fr = ln & 15, fq = ln >> 4;
        const int row0 = u.pm * BM + wr * 64 + fr, col0 = u.pn * BM + wc * 32 + 8 * fq;
        const bool nrm = u.pn < 8;
        const int pbase = (wr * 64 + fr) * 8;
        PG8_LAS float* pr = part + pbase; PG8_LAS float* pw = pr + wc;
        float rsv[2][4];
#pragma unroll
        for (int ai = 0; ai < 2; ++ai) { f32x4 pp[4][4];
#pragma unroll
            for (int m = 0; m < 4; ++m) { const f32x4* p = (const f32x4*)((const char*)ssqp + (unsigned)(row0 + ai * HALF + m * 16) * 64u);
#pragma unroll
                for (int k = 0; k < 4; ++k) pp[m][k] = p[k]; }
#pragma unroll
            for (int m = 0; m < 4; ++m) { const f32x4 a = pp[m][0], b = pp[m][1], c = pp[m][2], d = pp[m][3];
                const float sum = (((a[0] + a[1]) + (a[2] + a[3])) + ((b[0] + b[1]) + (b[2] + b[3]))) + (((c[0] + c[1]) + (c[2] + c[3])) + ((d[0] + d[1]) + (d[2] + d[3])));
                rsv[ai][m] = rsqrtf(sum * (1.0f / 1024.0f) + 1e-6f); asm volatile("" : "+v"(rsv[ai][m]) :: "memory"); } }
        f32x4 g0 = (f32x4){1.f, 1.f, 1.f, 1.f}, g1 = g0;
        if (nrm) {
#pragma unroll
            for (int ai = 0; ai < 2; ++ai)
#pragma unroll
                for (int m = 0; m < 4; ++m)
#pragma unroll
                    for (int bj = 0; bj < 2; ++bj) { const f32x4 v0 = acc[ai][bj][m][0], v1 = acc[ai][bj][m][1];
                        float ss = ((v0[0] * v0[0] + v0[1] * v0[1]) + (v0[2] * v0[2] + v0[3] * v0[3])) + ((v1[0] * v1[0] + v1[1] * v1[1]) + (v1[2] * v1[2] + v1[3] * v1[3]));
                        ss += __shfl_xor(ss, 16); ss += __shfl_xor(ss, 32);
                        if (fq == 0) pw[((ai * HALF + m * 16) * 2 + bj) * 4] = ss; }
            asm volatile("s_waitcnt lgkmcnt(0)" ::: "memory"); __builtin_amdgcn_s_barrier(); asm volatile("" ::: "memory");
            const float* gp = (u.pn < 4 ? gq : gk) + wc * 32 + 8 * fq; const float sc = (u.pn < 4) ? qscale : 1.0f;
            g0 = *(const f32x4*)gp * sc; g1 = *(const f32x4*)(gp + 4) * sc;
        }
#pragma unroll
        for (int ai = 0; ai < 2; ++ai)
#pragma unroll
            for (int m = 0; m < 4; ++m) {
                const int row = row0 + ai * HALF + m * 16;
                const float rsr = rsv[ai][m];
                bf16_t* rowp = O + (size_t)row * ldc + col0;
#pragma unroll
                for (int bj = 0; bj < 2; ++bj) {
                    float hs = rsr;
                    if (nrm) { const f32x4 pp = *(const PG8_LAS f32x4*)(pr + ((ai * HALF + m * 16) * 2 + bj) * 4);
                        hs *= rsqrtf(((pp[0] + pp[1]) + (pp[2] + pp[3])) * (rsr * rsr * (1.0f / 128.0f)) + 1e-6f); }
                    const f32x4 v0 = acc[ai][bj][m][0] * hs * g0, v1 = acc[ai][bj][m][1] * hs * g1;
                    u32x4 w; w.x = cvt_pk_bf16(v0[0], v0[1]); w.y = cvt_pk_bf16(v0[2], v0[3]); w.z = cvt_pk_bf16(v1[0], v1[1]); w.w = cvt_pk_bf16(v1[2], v1[3]);
                    *(u32x4*)(rowp + bj * HALF) = w;
                }
            }
    }
};
struct EpiProjAB {
    static constexpr bool PERM = true, AFTER_DRAIN = false;
    bf16_t* O; int ldc; const float* ssqp; const float* gq; const float* gk; const float* r128; const float* r64; PG8_LAS float* part; float qscale;
    __device__ __forceinline__ void operator()(const f32x4 (&acc)[2][2][4][2], const Unit& u, int wr, int wc, int fr_, int fq_) const {
        const int ln = epi_lane(), fr = ln & 15, fq = ln >> 4;
        const int cb = wc * 32 + 8 * fq;
        const int row0 = u.pm * BM + wr * 64 + fr, col0 = u.pn * BM + cb, pn = u.pn;
        const bool qk = pn < 4, iq = (pn == 6) || (pn == 7) || (pn == 14);
        const int pbase = (wr * 64 + fr) * 8;
        PG8_LAS float* pr = part + pbase; PG8_LAS float* pw = pr + wc;
        const bool rope_qk = qk && (wc == 0), rope_iq = iq && !(wc & 1) && (pn != 14 || wc == 0);
        float rsv[2][4];
#pragma unroll
        for (int ai = 0; ai < 2; ++ai)
#pragma unroll
            for (int m = 0; m < 4; ++m) rsv[ai][m] = *(const float*)((const char*)ssqp + (unsigned)(row0 + ai * HALF + m * 16) * 64u);
#pragma unroll
        for (int ai = 0; ai < 2; ++ai)
#pragma unroll
            for (int m = 0; m < 4; ++m) rsv[ai][m] = rsqrtf(rsv[ai][m] * (1.0f / 1024.0f) + 1e-6f);
        f32x4 g0 = (f32x4){1.f, 1.f, 1.f, 1.f}, g1 = g0;
        if (qk) {
#pragma unroll
            for (int ai = 0; ai < 2; ++ai)
#pragma unroll
                for (int m = 0; m < 4; ++m)
#pragma unroll
                    for (int bj = 0; bj < 2; ++bj) { const f32x4 v0 = acc[ai][bj][m][0], v1 = acc[ai][bj][m][1];
                        float ss = ((v0[0] * v0[0] + v0[1] * v0[1]) + (v0[2] * v0[2] + v0[3] * v0[3])) + ((v1[0] * v1[0] + v1[1] * v1[1]) + (v1[2] * v1[2] + v1[3] * v1[3]));
                        ss += __shfl_xor(ss, 16); ss += __shfl_xor(ss, 32);
                        if (fq == 0) pw[((ai * HALF + m * 16) * 2 + bj) * 4] = ss; }
            asm volatile("s_waitcnt lgkmcnt(0)" ::: "memory"); __builtin_amdgcn_s_barrier(); asm volatile("" ::: "memory");
            const float* gp = (pn < 2 ? gq : gk) + cb; const float sc = (pn < 2) ? qscale : 1.0f;
            g0 = *(const f32x4*)gp * sc; g1 = *(const f32x4*)(gp + 4) * sc;
        }
#pragma unroll
        for (int ai = 0; ai < 2; ++ai) {
            f32x4 cc[4][4];
            if (rope_qk || rope_iq) {
#pragma unroll
                for (int m = 0; m < 4; ++m) { const int pos = (row0 + ai * HALF + m * 16) & 2047;
                    const float* t = rope_qk ? (r128 + pos * 32 + 8 * (fq & 1)) : (r64 + pos * 16); const int so = rope_qk ? 16 : 8;
                    cc[m][0] = *(const f32x4*)t; cc[m][1] = *(const f32x4*)(t + 4); cc[m][2] = *(const f32x4*)(t + so); cc[m][3] = *(const f32x4*)(t + so + 4); }
            }
#pragma unroll
            for (int m = 0; m < 4; ++m) {
                const int row = row0 + ai * HALF + m * 16;
                const float rsr = rsv[ai][m];
                bf16_t* rowp = O + (size_t)row * ldc + col0;
                const f32x4 c0 = cc[m][0], c1 = cc[m][1], s0 = cc[m][2], s1 = cc[m][3];
#pragma unroll
                for (int bj = 0; bj < 2; ++bj) {
                    float hs = rsr;
                    if (qk) { const f32x4 pp = *(const PG8_LAS f32x4*)(pr + ((ai * HALF + m * 16) * 2 + bj) * 4);
                        hs *= rsqrtf(((pp[0] + pp[1]) + (pp[2] + pp[3])) * (rsr * rsr * (1.0f / 128.0f)) + 1e-6f); }
                    f32x4 v0 = acc[ai][bj][m][0] * hs * g0, v1 = acc[ai][bj][m][1] * hs * g1;
                    if (rope_qk) {
                        f32x4 p0, p1;
#pragma unroll
                        for (int e = 0; e < 4; ++e) { p0[e] = __shfl_xor(v0[e], 32); p1[e] = __shfl_xor(v1[e], 32); }
                        if (fq < 2) { v0 = v0 * c0 - p0 * s0; v1 = v1 * c1 - p1 * s1; } else { v0 = v0 * c0 + p0 * s0; v1 = v1 * c1 + p1 * s1; }
                    } else if (rope_iq && (pn != 14 || bj == 0)) {
                        f32x4 p0, p1;
#pragma unroll
                        for (int e = 0; e < 4; ++e) { p0[e] = __shfl_xor(v0[e], 16); p1[e] = __shfl_xor(v1[e], 16); }
                        if (fq == 0) { v0 = v0 * c0 - p0 * s0; v1 = v1 * c1 - p1 * s1; } else if (fq == 1) { v0 = v0 * c0 + p0 * s0; v1 = v1 * c1 + p1 * s1; }
                    }
                    u32x4 w; w.x = cvt_pk_bf16(v0[0], v0[1]); w.y = cvt_pk_bf16(v0[2], v0[3]); w.z = cvt_pk_bf16(v1[0], v1[1]); w.w = cvt_pk_bf16(v1[2], v1[3]);
                    *(u32x4*)(rowp + bj * HALF) = w;
                }
            }
        }
    }
};
template <class Epi, class Sched, bool ALIGN_EPI = false, bool SP2 = false>
__device__ __forceinline__ void gemm_phase(PG8_LAS unsigned char* lds, const Gemm g, const Sched& S, const Epi& E, const int wave_in) {
    const int wid = wave_in, lane = (int)__builtin_amdgcn_mbcnt_hi(~0u, __builtin_amdgcn_mbcnt_lo(~0u, 0u)), tid = wid * 64 + lane, wr = wid >> 2, wc = wid & 3, fr = lane & 15, fq = lane >> 4;
    const int K = g.K, nt = K / BK;
    unsigned voffA[2], voffB[2];
#pragma unroll
    for (int i = 0; i < 2; ++i) { int R, C; stage_rc(tid * 16 + i * 8192, R, C); const int Rb = Epi::PERM ? ((R & ~31) + perm32(R & 31)) : R;
        voffA[i] = (unsigned)(R * K + C) * 2u; voffB[i] = (unsigned)(Rb * K + C) * 2u; }
    const size_t kstep = (size_t)(BK * 2);
    const size_t hstep = (size_t)HALF * K * 2;
    const size_t tstep = 2 * hstep;
    const unsigned ldsw = (unsigned)wid * 1024u;
    const int aoff = lds_byte(wr * 64 + fr, fq * 8), boff = lds_byte(wc * 32 + fr, fq * 8);
#define PG8_SA(b, h) (((b) * 2 + (h)) * HTB)
#define PG8_SB(b, h) ((4 + (b) * 2 + (h)) * HTB)
#define PG8_STAGE(bufoff, gbase, voff) do { _Pragma("unroll") for (int _i = 0; _i < 2; ++_i) \
        __builtin_amdgcn_global_load_lds((const unsigned*)((const char*)(gbase) + (voff)[_i]), (PG8_LAS unsigned*)(lds + (bufoff) + ldsw + _i * 8192), 16, 0, 0); } while (0)
#define PG8_LDA(dst, b, h) do { _Pragma("unroll") for (int m = 0; m < 4; ++m) _Pragma("unroll") for (int k = 0; k < 2; ++k) dst[m][k] = *(const PG8_LAS bf16x8*)(lds + PG8_SA(b, h) + aoff + m * 2048 + k * 1024); } while (0)
#define PG8_LDB(dst, b, h) do { _Pragma("unroll") for (int n = 0; n < 2; ++n) _Pragma("unroll") for (int k = 0; k < 2; ++k) dst[n][k] = *(const PG8_LAS bf16x8*)(lds + PG8_SB(b, h) + boff + n * 2048 + k * 1024); } while (0)
#define PG8_MMA(ai, bj, At, Bt) do { __builtin_amdgcn_s_setprio(1); _Pragma("unroll") for (int m = 0; m < 4; ++m) _Pragma("unroll") for (int n = 0; n < 2; ++n) _Pragma("unroll") for (int k = 0; k < 2; ++k) \
        acc[ai][bj][m][n] = __builtin_amdgcn_mfma_f32_16x16x32_bf16(Bt[n][k], At[m][k], acc[ai][bj][m][n], 0, 0, 0); __builtin_amdgcn_s_setprio(0); } while (0)
#define PG8_WAIT_V(n) asm volatile("s_waitcnt vmcnt(" #n ")" ::: "memory")
#define PG8_WAIT_L(n) asm volatile("s_waitcnt lgkmcnt(" #n ")" ::: "memory")
#define PG8_BAR __builtin_amdgcn_s_barrier()
#define PG8_SCHED __builtin_amdgcn_sched_barrier(0)
    Unit cur, nxt; int ui = 0;
    if (!S.next(0, cur)) return;
    f32x4 acc[2][2][4][2];
#pragma unroll
    for (int a = 0; a < 2; ++a)
#pragma unroll
        for (int b = 0; b < 2; ++b)
#pragma unroll
            for (int m = 0; m < 4; ++m)
#pragma unroll
                for (int n = 0; n < 2; ++n) acc[a][b][m][n] = (f32x4){0.f, 0.f, 0.f, 0.f};
    bf16x8 At[4][2], B0[2][2], B1[2][2];
    const char* cA = (const char*)g.A + (size_t)cur.pm * tstep; const char* cB = (const char*)g.Bt + (size_t)cur.pn * tstep;
    S.a_ready(cur);
    if constexpr (SP2) {
        PG8_STAGE(PG8_SB(0, 0), cB, voffB); PG8_STAGE(PG8_SB(0, 1), cB + hstep, voffB); PG8_STAGE(PG8_SA(0, 0), cA, voffA); PG8_STAGE(PG8_SA(0, 1), cA + hstep, voffA);
        if (wr == 1) PG8_BAR;
        PG8_WAIT_V(2); PG8_BAR;
        PG8_STAGE(PG8_SB(1, 0), cB + kstep, voffB); PG8_STAGE(PG8_SA(1, 0), cA + kstep, voffA); PG8_STAGE(PG8_SB(1, 1), cB + hstep + kstep, voffB);
        PG8_WAIT_V(6); PG8_BAR;
    } else {
        PG8_STAGE(PG8_SB(0, 0), cB, voffB); PG8_STAGE(PG8_SA(0, 0), cA, voffA); PG8_STAGE(PG8_SB(0, 1), cB + hstep, voffB); PG8_STAGE(PG8_SA(0, 1), cA + hstep, voffA);
        if (wr == 1) PG8_BAR;
        PG8_WAIT_V(4); PG8_BAR;
        PG8_STAGE(PG8_SB(1, 0), cB + kstep, voffB); PG8_STAGE(PG8_SA(1, 0), cA + kstep, voffA); PG8_STAGE(PG8_SB(1, 1), cB + hstep + kstep, voffB);
        PG8_WAIT_V(6); PG8_BAR;
    }
    for (;;) {
        const bool has_next = S.next(ui + 1, nxt);
        const char* nA = has_next ? (const char*)g.A + (size_t)nxt.pm * tstep : cA; const char* nB = has_next ? (const char*)g.Bt + (size_t)nxt.pn * tstep : cB;
        for (int t = 0; t < nt; t += 2) {
            const bool last = (t == nt - 2);
            const char* a1 = cA + (size_t)(t + 1) * kstep;
            const char* a2 = last ? nA : cA + (size_t)(t + 2) * kstep; const char* b2 = last ? nB : cB + (size_t)(t + 2) * kstep;
            const char* a3 = a2 + kstep; const char* b3 = b2 + kstep;
            if (last && has_next) S.a_ready(nxt);
            if constexpr (SP2) {
            PG8_LDB(B0, 0, 0); PG8_LDB(B1, 0, 1); PG8_SCHED; PG8_LDA(At, 0, 0); PG8_STAGE(PG8_SA(1, 1), a1 + hstep, voffA);
            PG8_WAIT_V(8); PG8_WAIT_L(0); PG8_BAR; PG8_MMA(0, 0, At, B0); PG8_MMA(0, 1, At, B1); PG8_BAR; PG8_SCHED;
            PG8_LDA(At, 0, 1); PG8_STAGE(PG8_SB(0, 0), b2, voffB); PG8_STAGE(PG8_SB(0, 1), b2 + hstep, voffB); PG8_STAGE(PG8_SA(0, 0), a2, voffA);
            PG8_WAIT_V(8); PG8_WAIT_L(0); PG8_BAR; PG8_MMA(1, 0, At, B0); PG8_MMA(1, 1, At, B1); PG8_BAR; PG8_SCHED;
            PG8_LDB(B0, 1, 0); PG8_LDB(B1, 1, 1); PG8_SCHED; PG8_LDA(At, 1, 0); PG8_STAGE(PG8_SA(0, 1), a2 + hstep, voffA);
            PG8_WAIT_V(8); PG8_WAIT_L(0); PG8_BAR; PG8_MMA(0, 0, At, B0); PG8_MMA(0, 1, At, B1); PG8_BAR; PG8_SCHED;
            PG8_LDA(At, 1, 1); PG8_STAGE(PG8_SB(1, 0), b3, voffB); PG8_STAGE(PG8_SB(1, 1), b3 + hstep, voffB); PG8_STAGE(PG8_SA(1, 0), a3, voffA);
            PG8_WAIT_V(8); PG8_WAIT_L(0); PG8_BAR; PG8_MMA(1, 0, At, B0); PG8_MMA(1, 1, At, B1); PG8_BAR; PG8_SCHED;
            } else {
            PG8_LDB(B0, 0, 0); PG8_SCHED; PG8_LDA(At, 0, 0); PG8_STAGE(PG8_SA(1, 1), a1 + hstep, voffA);
            PG8_WAIT_L(8); PG8_BAR; PG8_WAIT_L(0); PG8_MMA(0, 0, At, B0); PG8_BAR; PG8_SCHED;
            PG8_LDB(B1, 0, 1); PG8_STAGE(PG8_SB(0, 0), b2, voffB);
            PG8_BAR; PG8_WAIT_L(0); PG8_MMA(0, 1, At, B1); PG8_BAR;
            PG8_LDA(At, 0, 1); PG8_STAGE(PG8_SA(0, 0), a2, voffA);
            PG8_BAR; PG8_WAIT_L(0); PG8_MMA(1, 0, At, B0); PG8_BAR; PG8_SCHED;
            PG8_STAGE(PG8_SB(0, 1), b2 + hstep, voffB);
            PG8_WAIT_V(6); PG8_BAR; PG8_MMA(1, 1, At, B1); PG8_BAR;
            PG8_LDB(B0, 1, 0); PG8_SCHED; PG8_LDA(At, 1, 0); PG8_STAGE(PG8_SA(0, 1), a2 + hstep, voffA);
            PG8_WAIT_L(8); PG8_BAR; PG8_WAIT_L(0); PG8_MMA(0, 0, At, B0); PG8_BAR; PG8_SCHED;
            PG8_LDB(B1, 1, 1); PG8_STAGE(PG8_SB(1, 0), b3, voffB);
            PG8_BAR; PG8_WAIT_L(0); PG8_MMA(0, 1, At, B1); PG8_BAR;
            PG8_LDA(At, 1, 1); PG8_STAGE(PG8_SA(1, 0), a3, voffA);
            PG8_BAR; PG8_WAIT_L(0); PG8_MMA(1, 0, At, B0); PG8_BAR; PG8_SCHED;
            PG8_STAGE(PG8_SB(1, 1), b3 + hstep, voffB);
            PG8_WAIT_V(6); PG8_BAR; PG8_MMA(1, 1, At, B1); PG8_BAR;
            }
        }
        if constexpr (ALIGN_EPI) { if (wr == 0) PG8_BAR; }
        if constexpr (!Epi::AFTER_DRAIN) { E(acc, cur, wr, wc, fr, fq); S.done(cur); }
        if (!has_next) break;
#pragma unroll
        for (int a = 0; a < 2; ++a)
#pragma unroll
            for (int b = 0; b < 2; ++b)
#pragma unroll
                for (int m = 0; m < 4; ++m)
#pragma unroll
                    for (int n = 0; n < 2; ++n) acc[a][b][m][n] = (f32x4){0.f, 0.f, 0.f, 0.f};
        cur = nxt; cA = nA; cB = nB; ++ui;
        if constexpr (ALIGN_EPI) { if (wr == 1) PG8_BAR; }
    }
    PG8_WAIT_V(0);
    if constexpr (!ALIGN_EPI) { if (wr == 0) PG8_BAR; }
    PG8_BAR;
    if constexpr (Epi::AFTER_DRAIN) { E.fused(acc, cur, wr, wc, fr, fq, lds, wid, lane); S.done(cur); }
#undef PG8_SA
#undef PG8_SB
#undef PG8_STAGE
#undef PG8_LDA
#undef PG8_LDB
#undef PG8_MMA
#undef PG8_WAIT_V
#undef PG8_WAIT_L
#undef PG8_BAR
#undef PG8_SCHED
}
}
#include <cmath>
constexpr int NWAVES = 8, NTHR = 512;
constexpr int BATCH = 16, SEQ = 2048, M = BATCH * SEQ, D = 1024, FF = 4096, NAB = 3840, NC = 3072, ABP_OLD = 3672;
constexpr int C_QA = 0, C_KA = 512, C_VA = 1024, C_IQ = 1536, C_QB = 2048, C_KB = 2304, C_VB = 2560, C_OG = 3072, C_IK = 3584, C_IW = 3648, C_GL = 3656;
constexpr float EPS = 1e-6f;
constexpr size_t MiB = 1u << 20;
constexpr size_t WS_CTL = 0, CTL_ZERO_BYTES = 64 * 1024;
constexpr size_t WS_WAB = 1 * MiB, WS_WOAB = 9 * MiB, WS_WUP0 = 11 * MiB, WS_WDN0 = 19 * MiB, WS_WINC = 27 * MiB, WS_WOC = 33 * MiB, WS_WUP1 = 35 * MiB, WS_WDN1 = 43 * MiB;
constexpr size_t WS_SSQ = 51 * MiB, SSQ_BYTES = 2 * MiB;
constexpr size_t WS_DEC = 59 * MiB;
constexpr size_t WS_ROPE = 59 * MiB + 512 * 1024;
constexpr size_t WS_XB = 60 * MiB;
constexpr size_t WS_CAT = 124 * MiB;
constexpr size_t WS_MASK = 188 * MiB;
constexpr size_t WS_R1 = 196 * MiB;
constexpr size_t WS_BC = 452 * MiB;
constexpr size_t WS_END = 484 * MiB;
constexpr int CW_BAR = 4096;
constexpr int RING_BYTES = 131072;
constexpr int LDS_BYTES = 163840;
constexpr int MISC_OFF = LDS_BYTES - 256;
#define GAS __attribute__((address_space(1)))
#define LAS __attribute__((address_space(3)))
typedef unsigned short bf16;
typedef unsigned v4u __attribute__((ext_vector_type(4)));
typedef float f32x4 __attribute__((ext_vector_type(4)));
typedef short bf16x8 __attribute__((ext_vector_type(8)));
typedef GAS unsigned gu32;
typedef GAS unsigned long long gu64;
#define RLX_AGENT __ATOMIC_RELAXED, __HIP_MEMORY_SCOPE_AGENT
#define LDS_WAIT() asm volatile("s_waitcnt lgkmcnt(0)" ::: "memory")
#define VM_WAIT() asm volatile("s_waitcnt vmcnt(0)" ::: "memory")
__device__ __forceinline__ unsigned long long rt() { return __builtin_amdgcn_s_memrealtime(); }
__device__ __forceinline__ unsigned f2bf(float f) { unsigned u = __builtin_bit_cast(unsigned, f); return (u + 0x7fffu + ((u >> 16) & 1u)) >> 16; }
__device__ __forceinline__ unsigned pk2(float lo, float hi) { return f2bf(lo) | (f2bf(hi) << 16); }
#define XB_TMO      128
#define XB_XCNT(j)  (256  + 64 * (j))
#define XB_XSUB(j)  (1280 + 64 * (j))
#define XB_XGEN(j)  (2304 + 64 * (j))
#define XB_TOP      3328
#define XB_TOPGEN   3392
#define XCD_BAR_WORDS 3456
#define XB_SPIN_CAP (1u << 18)

__device__ __forceinline__ unsigned xb_ld(unsigned* p)              { return __hip_atomic_load(p, __ATOMIC_RELAXED, __HIP_MEMORY_SCOPE_AGENT); }
__device__ __forceinline__ unsigned xb_add(unsigned* p, unsigned v) { return __hip_atomic_fetch_add(p, v, __ATOMIC_RELAXED, __HIP_MEMORY_SCOPE_AGENT); }
__device__ __forceinline__ unsigned xb_xcc_id() { return (unsigned)__builtin_amdgcn_s_getreg((3 << 11) | 20) & 0xFu; }
#define XB_SPIN(cond, bar) do { unsigned _sp = 0; while (cond) { __builtin_amdgcn_s_sleep(1); \
    if ((++_sp & 255u) == 0u) { if (xb_ld(&(bar)[XB_TMO])) break; if (_sp > XB_SPIN_CAP) { atomicAdd(&(bar)[XB_TMO], 1u); break; } } } } while (0)

struct XcdBarrier {
    unsigned* bar; unsigned x; int wave;
    volatile LAS unsigned* st;
};

__device__ __forceinline__ bool xb_t0(int wave) { return wave == 0 && __builtin_amdgcn_mbcnt_hi(~0u, __builtin_amdgcn_mbcnt_lo(~0u, 0u)) == 0u; }
__device__ __forceinline__ XcdBarrier xcd_barrier_post(unsigned* bar, volatile LAS unsigned* st, int wave) {
    XcdBarrier b; b.bar = bar; b.x = xb_xcc_id(); b.st = st; b.wave = wave;
    if (xb_t0(wave)) (void)xb_add(&bar[XB_XCNT(b.x)], 1u);
    return b;
}
__device__ __forceinline__ void xcd_barrier_complete(unsigned* bar, unsigned x, unsigned& nloc, unsigned& nx) {
    const unsigned G = gridDim.x * gridDim.y * gridDim.z;
    unsigned sum, cnt, mine, sp = 0u;
    for (;;) {
        sum = 0u; cnt = 0u; mine = 0u;
#pragma unroll
        for (unsigned j = 0; j < 16; ++j) { const unsigned c = xb_ld(&bar[XB_XCNT(j)]); sum += c; cnt += (c > 0u) ? 1u : 0u; mine = (j == x) ? c : mine; }
        if (sum == G) break;
        __builtin_amdgcn_s_sleep(1);
        if ((++sp & 255u) == 0u) { if (xb_ld(&bar[XB_TMO])) break; if (sp > XB_SPIN_CAP) { atomicAdd(&bar[XB_TMO], 1u); break; } }
    }
    nloc = mine > 0u ? mine : 1u; nx = cnt > 0u ? cnt : 1u;
}

__device__ __forceinline__ void xcd_barrier(const XcdBarrier& b) {
    asm volatile("s_waitcnt vmcnt(0)" ::: "memory");
    __syncthreads();
    if (xb_t0(b.wave)) {
        unsigned* bar = b.bar;
        __builtin_amdgcn_s_waitcnt(0);
        unsigned nloc = b.st[0], nx = b.st[1];
        if (nloc == 0u) { xcd_barrier_complete(bar, b.x, nloc, nx); b.st[0] = nloc; b.st[1] = nx; }
        const unsigned old = xb_add(&bar[XB_XSUB(b.x)], 1u);
        const unsigned gen = old / nloc;
        if (old + 1u == (gen + 1u) * nloc) {
            __builtin_amdgcn_fence(__ATOMIC_RELEASE, "agent");
            asm volatile("s_waitcnt vmcnt(0)" ::: "memory");
            const unsigned og = xb_add(&bar[XB_TOP], 1u);
            const unsigned tg = og / nx;
            if (og + 1u == (tg + 1u) * nx) xb_add(&bar[XB_TOPGEN], 1u);
            else XB_SPIN(xb_ld(&bar[XB_TOPGEN]) == tg, bar);
            __builtin_amdgcn_fence(__ATOMIC_ACQUIRE, "agent");
            xb_add(&bar[XB_XGEN(b.x)], 1u);
            asm volatile("s_waitcnt vmcnt(0)" ::: "memory");
        } else {
            XB_SPIN(xb_ld(&bar[XB_XGEN(b.x)]) == gen, bar);
            __builtin_amdgcn_fence(__ATOMIC_ACQUIRE, "agent");
            asm volatile("s_waitcnt vmcnt(0)" ::: "memory");
        }
    }
    __syncthreads();
}
#ifdef PROBE_ACC
#ifdef PROBE_NOSYNC
#define ACC_BEGIN(F, id) do { if ((id) == PROBE_ACC) { asm volatile("" ::: "memory"); (F).acc_t0 = __builtin_amdgcn_s_memrealtime(); asm volatile("" ::: "memory"); } } while (0)
#define ACC_END(F, id) do { if ((id) == PROBE_ACC) { asm volatile("" ::: "memory"); (F).acc_sum += __builtin_amdgcn_s_memrealtime() - (F).acc_t0; asm volatile("" ::: "memory"); } } while (0)
#else
#define ACC_BEGIN(F, id) do { if ((id) == PROBE_ACC) { __syncthreads(); (F).acc_t0 = __builtin_amdgcn_s_memrealtime(); } } while (0)
#define ACC_END(F, id) do { if ((id) == PROBE_ACC) { __syncthreads(); (F).acc_sum += __builtin_amdgcn_s_memrealtime() - (F).acc_t0; } } while (0)
#endif
#else
#define ACC_BEGIN(F, id) do { } while (0)
#define ACC_END(F, id) do { } while (0)
#endif
struct Frame {
#ifdef PROBE_ACC
    unsigned long long acc_t0, acc_sum;
#endif
    LAS unsigned char* lds;
    volatile LAS unsigned* MISC;
    gu32* ctl;
    int tid, lane, wave, vcu, G;
    const float *x, *g_mix, *g_ffn, *w_in_ab, *gq_a, *gk_a, *w_gate_up, *b_gate, *g_gla, *w_out_ab, *w_in_c, *gq_c, *gk_c, *w_out_c, *w_up, *w_down;
    float* out;
    bf16 *Wab, *Woab, *Wup0, *Wdn0, *Winc, *Woc, *Wup1, *Wdn1;
    bf16 *XB, *CAT, *R1;
    float* SSQ; unsigned* MASK;
};
__device__ __forceinline__ int lane_id_opaque() { int l; asm volatile("v_mbcnt_lo_u32_b32 %0, -1, 0\n\tv_mbcnt_hi_u32_b32 %0, -1, %0" : "=v"(l)); return l; }
__device__ __forceinline__ float bf2f(bf16 v) { return __builtin_bit_cast(float, (unsigned)v << 16); }
__device__ __forceinline__ float wave_sum(float v) {
#pragma unroll
    for (int o = 1; o < 64; o <<= 1) v += __shfl_xor(v, o);
    return v;
}
__device__ __forceinline__ float wave_max(float v) {
#pragma unroll
    for (int o = 1; o < 64; o <<= 1) v = fmaxf(v, __shfl_xor(v, o));
    return v;
}
__device__ __forceinline__ float log_sigmoid(float x) { return fminf(x, 0.f) - log1pf(expf(-fabsf(x))); }

__device__ __forceinline__ int oldcol_ab(int n) {
    if (n < 2048) return n;
    if (n < 2304) return 2120 + (n - 2048);
    if (n < 2560) return 2376 + (n - 2304);
    if (n < 3072) return 2632 + (n - 2560);
    if (n < 3584) return 3160 + (n - 3072);
    if (n < 3648) return 2048 + (n - 3584);
    if (n < 3656) return 2112 + (n - 3648);
    if (n < 3672) return 3144 + (n - 3656);
    return -1;
}
__device__ __forceinline__ void p0_transpose_item(const float* W, int ldw, int K, const float* gain, bf16* WT, bool map, int item, int nblk, int lane) {
    const int kb = item / nblk, nb = item % nblk, ng = lane & 7, ko = lane >> 3, k0 = 64 * kb + 8 * ko, n = 32 * nb + 4 * ng;
    const int oc = map ? oldcol_ab(n) : n;
    f32x4 v[8];
#pragma unroll
    for (int i = 0; i < 8; ++i) { v[i] = (f32x4){0.f, 0.f, 0.f, 0.f}; if (oc >= 0) v[i] = *(const GAS f32x4*)(W + (size_t)(k0 + i) * ldw + oc); }
    if (gain) { const f32x4 g0 = *(const GAS f32x4*)(gain + k0), g1 = *(const GAS f32x4*)(gain + k0 + 4);
#pragma unroll
        for (int i = 0; i < 4; ++i) { v[i] = v[i] * g0[i]; v[4 + i] = v[4 + i] * g1[i]; } }
#pragma unroll
    for (int e = 0; e < 4; ++e) { v4u o; o.x = pk2(v[0][e], v[1][e]); o.y = pk2(v[2][e], v[3][e]); o.z = pk2(v[4][e], v[5][e]); o.w = pk2(v[6][e], v[7][e]);
        *(GAS v4u*)(WT + (size_t)(n + e) * K + k0) = o; }
}
template <int PART> __device__ __forceinline__ void prologue_weights(Frame& F, int gw, int NGW) {
    constexpr int I_AB = (D / 64) * (NAB / 32), I_O = (D / 64) * (D / 32), I_UP = (D / 64) * (FF / 32), I_DN = (FF / 64) * (D / 32), I_C = (D / 64) * (NC / 32);
    if (PART == 0) { for (int it = gw; it < I_AB; it += NGW) p0_transpose_item(F.w_in_ab, ABP_OLD, D, F.g_mix, F.Wab, true, it, NAB / 32, F.lane); return; }
    constexpr int NITEMS = 2 * I_O + 2 * I_UP + 2 * I_DN + I_C;
    for (int it = gw; it < NITEMS; it += NGW) {
        int r = it;
        if (r < I_O) { p0_transpose_item(F.w_out_ab, D, D, nullptr, F.Woab, false, r, D / 32, F.lane); continue; } r -= I_O;
        if (r < I_UP) { p0_transpose_item(F.w_up, FF, D, F.g_ffn, F.Wup0, false, r, FF / 32, F.lane); continue; } r -= I_UP;
        if (r < I_DN) { p0_transpose_item(F.w_down, D, FF, nullptr, F.Wdn0, false, r, D / 32, F.lane); continue; } r -= I_DN;
        if (r < I_C) { p0_transpose_item(F.w_in_c, NC, D, F.g_mix + D, F.Winc, false, r, NC / 32, F.lane); continue; } r -= I_C;
        if (r < I_O) { p0_transpose_item(F.w_out_c, D, D, nullptr, F.Woc, false, r, D / 32, F.lane); continue; } r -= I_O;
        if (r < I_UP) { p0_transpose_item(F.w_up + (size_t)D * FF, FF, D, F.g_ffn + D, F.Wup1, false, r, FF / 32, F.lane); continue; } r -= I_UP;
        p0_transpose_item(F.w_down + (size_t)FF * D, D, FF, nullptr, F.Wdn1, false, r, D / 32, F.lane);
    }
}
__device__ __forceinline__ void ph_prologue(Frame& F) {
    const int gw = F.vcu * NWAVES + F.wave, NGW = F.G * NWAVES;
    prologue_weights<0>(F, gw, NGW);
    if (F.G != 256) prologue_weights<1>(F, gw, NGW);
    for (int m0 = gw; m0 < M; m0 += 4 * NGW) {
        f32x4 v[4][4]; float s[4];
#pragma unroll
        for (int r = 0; r < 4; ++r) { const int m = m0 + r * NGW; const GAS f32x4* xr = (const GAS f32x4*)(F.x + (size_t)(m < M ? m : m0) * D) + F.lane;
#pragma unroll
            for (int j = 0; j < 4; ++j) v[r][j] = xr[64 * j]; }
#pragma unroll
        for (int r = 0; r < 4; ++r) { float t = 0.f;
#pragma unroll
            for (int j = 0; j < 4; ++j) t += (v[r][j].x * v[r][j].x + v[r][j].y * v[r][j].y) + (v[r][j].z * v[r][j].z + v[r][j].w * v[r][j].w);
            s[r] = t; }
#pragma unroll
        for (int o = 1; o < 64; o <<= 1) {
#pragma unroll
            for (int r = 0; r < 4; ++r) s[r] += __shfl_xor(s[r], o); }
#pragma unroll
        for (int r = 0; r < 4; ++r) { const int m = m0 + r * NGW; if (m < M) {
            GAS unsigned long long* o8 = (GAS unsigned long long*)(F.XB + (size_t)m * D) + F.lane;
#pragma unroll
            for (int j = 0; j < 4; ++j) o8[64 * j] = (unsigned long long)pk2(v[r][j].x, v[r][j].y) | ((unsigned long long)pk2(v[r][j].z, v[r][j].w) << 32);
            if (F.lane < 16) F.SSQ[(size_t)m * 16 + F.lane] = (F.lane == 0) ? s[r] : 0.f; } }
    }
}
namespace att {
typedef short s16x4 __attribute__((ext_vector_type(4)));
typedef float f32x16 __attribute__((ext_vector_type(16)));
typedef _Float16 f16x8 __attribute__((ext_vector_type(8)));
typedef unsigned u32x4 __attribute__((ext_vector_type(4)));
typedef short v4i16_t __attribute__((ext_vector_type(4)));
constexpr float C2 = 0.08838834764831845f * 1.4426950408889634f;
__device__ __forceinline__ int crow(int r, int hi) { return (r & 3) + 8 * (r >> 2) + 4 * hi; }
__device__ __forceinline__ int img_off(int row, int ch) { return 256 * row + 16 * (ch ^ (((row & 3) << 2) | ((row >> 2) & 3))); }
__device__ __forceinline__ bf16x8 pack8(float a0, float a1, float a2, float a3, float a4, float a5, float a6, float a7) {
    u32x4 w; w.x = pg8::cvt_pk_bf16(a0, a1); w.y = pg8::cvt_pk_bf16(a2, a3); w.z = pg8::cvt_pk_bf16(a4, a5); w.w = pg8::cvt_pk_bf16(a6, a7);
    return __builtin_bit_cast(bf16x8, w);
}
__device__ __forceinline__ f16x8 pack8h(float a0, float a1, float a2, float a3, float a4, float a5, float a6, float a7) {
    f16x8 r; r[0] = (_Float16)a0; r[1] = (_Float16)a1; r[2] = (_Float16)a2; r[3] = (_Float16)a3; r[4] = (_Float16)a4; r[5] = (_Float16)a5; r[6] = (_Float16)a6; r[7] = (_Float16)a7; return r;
}
__device__ __forceinline__ void dma_off_init(unsigned (&dvo)[2], int ld, int wave, int lane) {
#pragma unroll
    for (int i = 0; i < 2; ++i) { const int pi = 2 * wave + i, row = 4 * pi + (lane >> 4), pc = lane & 15, ch = pc ^ (((row & 3) << 2) | ((row >> 2) & 3)); dvo[i] = (unsigned)(row * ld + ch * 8) * 2u; }
}
__device__ __forceinline__ void tile_dma(const bf16* g, const unsigned (&dvo)[2], LAS unsigned char* buf, int wave) {
#pragma unroll
    for (int i = 0; i < 2; ++i) __builtin_amdgcn_global_load_lds((const unsigned*)((const char*)g + dvo[i]), (LAS unsigned*)(buf + 1024 * (2 * wave + i)), 16, 0, 0);
}
struct FragOff { int k[8]; int va[4]; int vd; };
__device__ __forceinline__ void frag_off_init(FragOff& fo, int lane) {
    const int hi = lane >> 5, r32 = lane & 31, i = lane & 15, q = i >> 2, p = i & 3, x = 2 * ((lane >> 4) & 1) + (p >> 1);
#pragma unroll
    for (int ks = 0; ks < 8; ++ks) fo.k[ks] = img_off(r32, 2 * ks + hi);
#pragma unroll
    for (int ct = 0; ct < 4; ++ct) fo.va[ct] = img_off(4 * hi + q, 4 * ct + x) + 8 * (p & 1);
    fo.vd = img_off(4 * hi + q + 8, x) - img_off(4 * hi + q, x);
}
__device__ __forceinline__ bf16x8 k_frag(const LAS unsigned char* kbuf, const FragOff& fo, int rt, int ks) { return *(const LAS bf16x8*)(kbuf + fo.k[ks] + 8192 * rt); }
__device__ __forceinline__ s16x4 vtr(const LAS unsigned char* p) { return __builtin_bit_cast(s16x4, __builtin_amdgcn_ds_read_tr16_b64_v4i16((LAS v4i16_t*)p)); }
__device__ __forceinline__ bf16x8 v_frag(const LAS unsigned char* vbuf, const FragOff& fo, int ct, int kk) {
    const s16x4 lo = vtr(vbuf + fo.va[ct] + 4096 * kk), hh = vtr(vbuf + fo.va[ct] + fo.vd + 4096 * kk);
    return (bf16x8){lo[0], lo[1], lo[2], lo[3], hh[0], hh[1], hh[2], hh[3]};
}
#define TR_READ(dst, addr, OFF) asm volatile("ds_read_b64_tr_b16 %0, %1 offset:%c2" : "=&v"(dst) : "v"(addr), "i"(OFF) : "memory")
#define LGKM_WAIT0() do { asm volatile("s_waitcnt lgkmcnt(0)" ::: "memory"); __builtin_amdgcn_sched_barrier(0); } while (0)
__device__ __forceinline__ bf16x8 mk_frag(s16x4 lo, s16x4 hh) { return (bf16x8){lo[0], lo[1], lo[2], lo[3], hh[0], hh[1], hh[2], hh[3]}; }
__device__ __forceinline__ int frag_va(int lane, int ct) { const int hi = lane >> 5, i = lane & 15, q = i >> 2, p = i & 3, x = 2 * ((lane >> 4) & 1) + (p >> 1); return img_off(4 * hi + q, 4 * ct + x) + 8 * (p & 1); }
__device__ __forceinline__ bf16x8 v_frag_rt(const LAS unsigned char* vbuf, int va, int vd, int kk) {
    const s16x4 lo = vtr(vbuf + va + 4096 * kk), hh = vtr(vbuf + va + vd + 4096 * kk);
    return (bf16x8){lo[0], lo[1], lo[2], lo[3], hh[0], hh[1], hh[2], hh[3]};
}
__device__ __forceinline__ void store_o(const f32x16 (&o)[4], const float (&rscale)[16], LAS unsigned char* stg, bf16* dst, int ld, int lane) {
    const int hi = lane >> 5, r32 = lane & 31;
#pragma unroll
    for (int r = 0; r < 16; ++r) { const int orow = crow(r, hi);
#pragma unroll
        for (int ct = 0; ct < 4; ++ct) *(LAS bf16*)(stg + orow * 256 + (32 * ct + r32) * 2) = (bf16)f2bf(o[ct][r] * rscale[r]); }
    asm volatile("s_waitcnt lgkmcnt(0)" ::: "memory");
#pragma unroll
    for (int i = 0; i < 8; ++i) { const int c = lane + 64 * i, row = c >> 4, ch = c & 15; const u32x4 v = *(const LAS u32x4*)(stg + row * 256 + ch * 16); *(u32x4*)(dst + (size_t)row * ld + ch * 8) = v; }
}
}
__device__ __forceinline__ void sb_unit(Frame& F, int b, int h, int qb) {
    using namespace att;
    const int tid = F.tid, lane = F.lane, w = F.wave, hi = lane >> 5, r32 = lane & 31;
    const bf16* Qg = F.R1 + (size_t)b * SEQ * NC + h * 128; const bf16* Kg = Qg + 1024; const bf16* Vg = Qg + 2048;
    const int T0 = qb * 256, t0w = T0 + 32 * w, jd = t0w >> 6, jtop = (T0 >> 6) + 3, tl = 32 * (w & 1) + r32, tl4 = tl - 4 * hi;
    LAS unsigned char* lds = F.lds;
    FragOff fo; frag_off_init(fo, lane);
    unsigned dvo[2]; dma_off_init(dvo, NC, w, lane);
    bf16x8 qf[8];
#pragma unroll
    for (int ks = 0; ks < 8; ++ks) qf[ks] = *(const bf16x8*)(Qg + (size_t)(t0w + r32) * NC + 16 * ks + 8 * hi);
    f16x8 T0f, T1f, ONEf;
#pragma unroll
    for (int j = 0; j < 8; ++j) { const int kp = 8 * (j >> 2) + 4 * hi + (j & 3); T0f[j] = (kp >= r32) ? (_Float16)1.0f : (_Float16)0.0f; T1f[j] = (kp + 16 >= r32) ? (_Float16)1.0f : (_Float16)0.0f; ONEf[j] = (_Float16)1.0f; }
    f32x16 o[4];
#pragma unroll
    for (int ct = 0; ct < 4; ++ct)
#pragma unroll
        for (int r = 0; r < 16; ++r) o[ct][r] = 0.f;
    float R2 = 0.f; bool done = false;
    volatile LAS unsigned* flags = F.MISC + 16;
    tile_dma(Kg + (size_t)(64 * jtop) * NC, dvo, lds, w); tile_dma(Vg + (size_t)(64 * jtop) * NC, dvo, lds + 16384, w);
    asm volatile("s_waitcnt vmcnt(0)" ::: "memory");
    __syncthreads();
    for (int j = jtop; j >= 0; --j) {
        const int cur = (jtop - j) & 1;
        const LAS unsigned char* kb = lds + cur * 32768; const LAS unsigned char* vb = kb + 16384;
        if (j > 0) { tile_dma(Kg + (size_t)(64 * (j - 1)) * NC, dvo, lds + (cur ^ 1) * 32768, w); tile_dma(Vg + (size_t)(64 * (j - 1)) * NC, dvo, lds + (cur ^ 1) * 32768 + 16384, w); }
        if (j <= jd && !done) {
            f32x16 p0, p1;
#pragma unroll
            for (int r = 0; r < 16; ++r) { p0[r] = 0.f; p1[r] = 0.f; }
            { bf16x8 kf[8];
#pragma unroll
              for (int ks = 0; ks < 8; ++ks) kf[ks] = k_frag(kb, fo, 0, ks);
#pragma unroll
              for (int ks = 0; ks < 8; ++ks) p0 = __builtin_amdgcn_mfma_f32_32x32x16_bf16(kf[ks], qf[ks], p0, 0, 0, 0);
#pragma unroll
              for (int ks = 0; ks < 8; ++ks) kf[ks] = k_frag(kb, fo, 1, ks);
#pragma unroll
              for (int ks = 0; ks < 8; ++ks) p1 = __builtin_amdgcn_mfma_f32_32x32x16_bf16(kf[ks], qf[ks], p1, 0, 0, 0); }
            s16x4 vl[4], vh[4], wl[4], wh[4];
            unsigned va0[4], va1[4];
#pragma unroll
            for (int ct = 0; ct < 4; ++ct) { va0[ct] = (unsigned)(size_t)vb + (unsigned)fo.va[ct]; va1[ct] = va0[ct] + (unsigned)fo.vd; }
            const bool diag = (j == jd);
            float x0[16], x1[16]; float rs = 0.f;
#pragma unroll
            for (int r = 0; r < 16; ++r) { const int key = (r & 3) + 8 * (r >> 2);
                float l0 = -__builtin_amdgcn_logf(1.0f + __builtin_amdgcn_exp2f(p0[r])), l1 = -__builtin_amdgcn_logf(1.0f + __builtin_amdgcn_exp2f(p1[r]));
                if (diag) { if (!(key < tl4)) l0 = 0.f; if (!(key + 32 < tl4)) l1 = 0.f; }
                x0[r] = l0; x1[r] = l1; rs += l0 + l1; p0[r] += R2; p1[r] += R2; }
            const f16x8 xb00 = pack8h(x0[0], x0[1], x0[2], x0[3], x0[4], x0[5], x0[6], x0[7]), xb01 = pack8h(x0[8], x0[9], x0[10], x0[11], x0[12], x0[13], x0[14], x0[15]);
            const f16x8 xb10 = pack8h(x1[0], x1[1], x1[2], x1[3], x1[4], x1[5], x1[6], x1[7]), xb11 = pack8h(x1[8], x1[9], x1[10], x1[11], x1[12], x1[13], x1[14], x1[15]);
            p0 = __builtin_amdgcn_mfma_f32_32x32x16_f16(T0f, xb00, p0, 0, 0, 0); p0 = __builtin_amdgcn_mfma_f32_32x32x16_f16(T1f, xb01, p0, 0, 0, 0);
            p0 = __builtin_amdgcn_mfma_f32_32x32x16_f16(ONEf, xb10, p0, 0, 0, 0); p0 = __builtin_amdgcn_mfma_f32_32x32x16_f16(ONEf, xb11, p0, 0, 0, 0);
            p1 = __builtin_amdgcn_mfma_f32_32x32x16_f16(T0f, xb10, p1, 0, 0, 0); p1 = __builtin_amdgcn_mfma_f32_32x32x16_f16(T1f, xb11, p1, 0, 0, 0);
#pragma unroll
            for (int r = 0; r < 16; ++r) { const int key = (r & 3) + 8 * (r >> 2);
                float a0 = __builtin_amdgcn_exp2f(p0[r]), a1 = __builtin_amdgcn_exp2f(p1[r]);
                if (diag) { if (!(key < tl4)) a0 = 0.f; if (!(key + 32 < tl4)) a1 = 0.f; }
                p0[r] = a0; p1[r] = a1; }
            const bf16x8 pa0 = pack8(p0[0], p0[1], p0[2], p0[3], p0[4], p0[5], p0[6], p0[7]), pa1 = pack8(p0[8], p0[9], p0[10], p0[11], p0[12], p0[13], p0[14], p0[15]);
            const bf16x8 pa2 = pack8(p1[0], p1[1], p1[2], p1[3], p1[4], p1[5], p1[6], p1[7]), pa3 = pack8(p1[8], p1[9], p1[10], p1[11], p1[12], p1[13], p1[14], p1[15]);
#pragma unroll
            for (int ct = 0; ct < 4; ++ct) { TR_READ(vl[ct], va0[ct], 0); TR_READ(vh[ct], va1[ct], 0); }
            LGKM_WAIT0();
#pragma unroll
            for (int ct = 0; ct < 4; ++ct) { TR_READ(wl[ct], va0[ct], 4096); TR_READ(wh[ct], va1[ct], 4096); }
#pragma unroll
            for (int ct = 0; ct < 4; ++ct) o[ct] = __builtin_amdgcn_mfma_f32_32x32x16_bf16(pa0, mk_frag(vl[ct], vh[ct]), o[ct], 0, 0, 0);
            LGKM_WAIT0();
#pragma unroll
            for (int ct = 0; ct < 4; ++ct) { TR_READ(vl[ct], va0[ct], 8192); TR_READ(vh[ct], va1[ct], 8192); }
#pragma unroll
            for (int ct = 0; ct < 4; ++ct) o[ct] = __builtin_amdgcn_mfma_f32_32x32x16_bf16(pa1, mk_frag(wl[ct], wh[ct]), o[ct], 0, 0, 0);
            LGKM_WAIT0();
#pragma unroll
            for (int ct = 0; ct < 4; ++ct) { TR_READ(wl[ct], va0[ct], 12288); TR_READ(wh[ct], va1[ct], 12288); }
#pragma unroll
            for (int ct = 0; ct < 4; ++ct) o[ct] = __builtin_amdgcn_mfma_f32_32x32x16_bf16(pa2, mk_frag(vl[ct], vh[ct]), o[ct], 0, 0, 0);
            LGKM_WAIT0();
#pragma unroll
            for (int ct = 0; ct < 4; ++ct) o[ct] = __builtin_amdgcn_mfma_f32_32x32x16_bf16(pa3, mk_frag(wl[ct], wh[ct]), o[ct], 0, 0, 0);
            rs += __shfl_xor(rs, 32);
            R2 += rs;
            done = __all(R2 < -152.0f);
        }
        if (lane == 0) flags[cur * 8 + w] = done ? 1u : 0u;
        asm volatile("s_waitcnt vmcnt(0) lgkmcnt(0)" ::: "memory");
        __syncthreads();
        unsigned alld = 1u;
#pragma unroll
        for (int i = 0; i < 8; ++i) alld &= flags[cur * 8 + i];
        if (alld) break;
    }
    float ones[16];
#pragma unroll
    for (int r = 0; r < 16; ++r) ones[r] = 1.0f;
    store_o(o, ones, lds + w * 8192, F.CAT + (size_t)(b * SEQ + t0w) * D + h * 128, D, lane);
    __syncthreads();
}
__device__ __forceinline__ void ph_sb(Frame& F) {
    for (int v = F.vcu; v < BATCH * 8 * 2; v += F.G) {
        const int bh = v >> 1, half = v & 1;
#pragma unroll 1
        for (int i = 0; i < 4; ++i) { const int qb = half ? (i == 0 ? 1 : i == 1 ? 6 : i == 2 ? 2 : 5) : (i == 0 ? 0 : i == 1 ? 7 : i == 2 ? 3 : 4); sb_unit(F, bh >> 3, bh & 7, qb); }
    }
}
__device__ __forceinline__ void dsa_unit(Frame& F, int b, int h, int ub, float mref) {
    using namespace att;
    const int lane = F.lane, w = F.wave, hi = lane >> 5, r32 = lane & 31;
    const bf16* Qg = F.R1 + (size_t)b * SEQ * NAB + C_QA + h * 128; const bf16* Kg = F.R1 + (size_t)b * SEQ * NAB + C_KA + h * 128; const bf16* Vg = F.R1 + (size_t)b * SEQ * NAB + C_VA + h * 128;
    const int t0w = 256 * ub + 32 * w, cw = t0w >> 6, jlast = 4 * ub + 3;
    LAS unsigned char* lds = F.lds;
    LAS unsigned char* mst = lds + 65536 + w * 8448;
    FragOff fo; frag_off_init(fo, lane);
    unsigned dvo[2]; dma_off_init(dvo, NAB, w, lane);
    tile_dma(Kg, dvo, lds, w); tile_dma(Vg, dvo, lds + 16384, w);
    bf16x8 qf[8];
#pragma unroll
    for (int ks = 0; ks < 8; ++ks) qf[ks] = *(const bf16x8*)(Qg + (size_t)(t0w + r32) * NAB + 16 * ks + 8 * hi);
    { const unsigned* mg = F.MASK + (size_t)(b * SEQ + t0w) * 64;
#pragma unroll 2
      for (int i = 0; i < 8; ++i) { const int c = lane + 64 * i, row = c >> 4, c4 = c & 15; const u32x4 v = *(const u32x4*)(mg + row * 64 + c4 * 4);
          *(LAS unsigned long long*)(mst + row * 264 + c4 * 16) = (unsigned long long)v.x | ((unsigned long long)v.y << 32);
          *(LAS unsigned long long*)(mst + row * 264 + c4 * 16 + 8) = (unsigned long long)v.z | ((unsigned long long)v.w << 32); } }
    f32x16 o[4];
#pragma unroll
    for (int ct = 0; ct < 4; ++ct)
#pragma unroll
        for (int r = 0; r < 16; ++r) o[ct][r] = 0.f;
    float lsum = 0.f;
    asm volatile("s_waitcnt vmcnt(0) lgkmcnt(0)" ::: "memory");
    __syncthreads();
    for (int j = 0; j <= jlast; ++j) {
        const int cur = j & 1;
        const LAS unsigned char* kb = lds + cur * 32768; const LAS unsigned char* vb = kb + 16384;
        if (j < jlast) { tile_dma(Kg + (size_t)(64 * (j + 1)) * NAB, dvo, lds + (cur ^ 1) * 32768, w); tile_dma(Vg + (size_t)(64 * (j + 1)) * NAB, dvo, lds + (cur ^ 1) * 32768 + 16384, w); }
        if (j <= cw) {
            const unsigned long long mw = *(const LAS unsigned long long*)(mst + r32 * 264 + j * 8);
            const unsigned mw0 = (unsigned)mw, mw1 = (unsigned)(mw >> 32);
#pragma unroll 1
            for (int half = 0; half < 2; ++half) {
                const unsigned mwh = (half ? mw1 : mw0) >> (4 * hi);
                bf16x8 kf[8];
#pragma unroll
                for (int ks = 0; ks < 8; ++ks) kf[ks] = k_frag(kb, fo, half, ks);
                f32x16 p;
#pragma unroll
                for (int r = 0; r < 16; ++r) p[r] = 0.f;
#pragma unroll
                for (int ks = 0; ks < 8; ++ks) p = __builtin_amdgcn_mfma_f32_32x32x16_bf16(kf[ks], qf[ks], p, 0, 0, 0);
#pragma unroll
                for (int r = 0; r < 16; ++r) { const unsigned keep = (unsigned)(-(int)((mwh >> ((r & 3) + 8 * (r >> 2))) & 1u));
                    const float e = __uint_as_float(__float_as_uint(__builtin_amdgcn_exp2f(p[r] - mref)) & keep); p[r] = e; lsum += e; }
                const bf16x8 pa0 = pack8(p[0], p[1], p[2], p[3], p[4], p[5], p[6], p[7]), pa1 = pack8(p[8], p[9], p[10], p[11], p[12], p[13], p[14], p[15]);
                s16x4 vl[8], vh[8];
                const unsigned vbase = (unsigned)(size_t)vb + 8192u * (unsigned)half;
#pragma unroll
                for (int ct = 0; ct < 4; ++ct) { const unsigned a0 = vbase + (unsigned)fo.va[ct], a1 = a0 + (unsigned)fo.vd;
                    TR_READ(vl[2 * ct], a0, 0); TR_READ(vh[2 * ct], a1, 0); TR_READ(vl[2 * ct + 1], a0, 4096); TR_READ(vh[2 * ct + 1], a1, 4096); }
                LGKM_WAIT0();
#pragma unroll
                for (int ct = 0; ct < 4; ++ct) {
                    o[ct] = __builtin_amdgcn_mfma_f32_32x32x16_bf16(pa0, mk_frag(vl[2 * ct], vh[2 * ct]), o[ct], 0, 0, 0);
                    o[ct] = __builtin_amdgcn_mfma_f32_32x32x16_bf16(pa1, mk_frag(vl[2 * ct + 1], vh[2 * ct + 1]), o[ct], 0, 0, 0);
                }
            }
        }
        asm volatile("s_waitcnt vmcnt(0) lgkmcnt(0)" ::: "memory");
        __syncthreads();
    }
    lsum += __shfl_xor(lsum, 32);
    LAS float* lsc = (LAS float*)mst;
    if (hi == 0) lsc[r32] = 1.0f / lsum;
    asm volatile("s_waitcnt lgkmcnt(0)" ::: "memory");
    float rsc[16];
#pragma unroll
    for (int r = 0; r < 16; ++r) rsc[r] = lsc[crow(r, hi)];
    store_o(o, rsc, lds + w * 8192, F.CAT + (size_t)(b * SEQ + t0w) * D + h * 128, D, lane);
    __syncthreads();
}
__device__ __forceinline__ void ph_dsa(Frame& F) {
    float gm = fmaxf(fabsf(F.gq_a[F.lane]), fabsf(F.gq_a[64 + F.lane])), km = fmaxf(fabsf(F.gk_a[F.lane]), fabsf(F.gk_a[64 + F.lane]));
    gm = wave_max(gm); km = wave_max(km);
    const float mref = att::C2 * 128.0f * gm * km * 1.02f;
    for (int v = F.vcu; v < BATCH * 4 * 4; v += F.G) {
        const int bh = v >> 2, pi = v & 3;
#pragma unroll 1
        for (int k = 0; k < 2; ++k) dsa_unit(F, bh >> 2, bh & 3, k ? 7 - pi : pi, mref);
    }
}
namespace idx {
using att::f32x16;
constexpr int SCP = 2048;
__device__ __forceinline__ unsigned okey(float f) { const unsigned u = __float_as_uint(f); return (u & 0x80000000u) ? ~u : (u | 0x80000000u); }
__device__ __forceinline__ int wave_isum(int c) {
    c += __builtin_amdgcn_mov_dpp(c, 0xB1, 0xF, 0xF, true);
    c += __builtin_amdgcn_mov_dpp(c, 0x4E, 0xF, 0xF, true);
    c += __builtin_amdgcn_mov_dpp(c, 0x141, 0xF, 0xF, true);
    c += __builtin_amdgcn_mov_dpp(c, 0x140, 0xF, 0xF, true);
    return (__builtin_amdgcn_readlane(c, 0) + __builtin_amdgcn_readlane(c, 16)) + (__builtin_amdgcn_readlane(c, 32) + __builtin_amdgcn_readlane(c, 48));
}
__device__ __forceinline__ unsigned bfi32(unsigned m, unsigned x, unsigned y) { return (x & m) | (y & ~m); }
__device__ __forceinline__ void bit_transpose32x2(unsigned (&A)[32], unsigned (&B)[32]) {
#pragma unroll
    for (int k = 0; k < 16; ++k) { const unsigned a0 = A[k], a1 = A[k + 16], b0 = B[k], b1 = B[k + 16];
        A[k] = __builtin_amdgcn_perm(a0, a1, 0x07060302u); A[k + 16] = __builtin_amdgcn_perm(a0, a1, 0x05040100u);
        B[k] = __builtin_amdgcn_perm(b0, b1, 0x07060302u); B[k + 16] = __builtin_amdgcn_perm(b0, b1, 0x05040100u); }
#pragma unroll
    for (int k = 0; k < 32; ++k) if (!(k & 8)) { const unsigned a0 = A[k], a1 = A[k + 8], b0 = B[k], b1 = B[k + 8];
        A[k] = __builtin_amdgcn_perm(a0, a1, 0x07030501u); A[k + 8] = __builtin_amdgcn_perm(a0, a1, 0x06020400u);
        B[k] = __builtin_amdgcn_perm(b0, b1, 0x07030501u); B[k + 8] = __builtin_amdgcn_perm(b0, b1, 0x06020400u); }
    unsigned mask = 0x0F0F0F0Fu;
#pragma unroll
    for (int s = 4; s; s >>= 1) {
#pragma unroll
        for (int k = 0; k < 32; ++k) if (!(k & s)) { const unsigned a0 = A[k], a1 = A[k + s], b0 = B[k], b1 = B[k + s];
            A[k] = bfi32(mask, a1 >> s, a0); A[k + s] = bfi32(mask, a1, a0 << s);
            B[k] = bfi32(mask, b1 >> s, b0); B[k + s] = bfi32(mask, b1, b0 << s); }
        mask ^= mask << (s >> 1);
    }
}
__device__ __forceinline__ void select_prepare(const LAS float* scA, const LAS float* scB, int E, unsigned (&Wa)[32], unsigned (&Wb)[32], int lane) {
#pragma unroll
    for (int j = 0; j < 32; ++j) { Wa[31 - j] = __float_as_uint(scA[64 * j + lane]); Wb[31 - j] = __float_as_uint(scB[64 * j + lane]); }
#pragma unroll
    for (int j = 0; j < 32; ++j) { Wa[j] ^= (unsigned)((int)Wa[j] >> 31) | 0x80000000u; Wb[j] ^= (unsigned)((int)Wb[j] >> 31) | 0x80000000u; }
    bit_transpose32x2(Wa, Wb);
}
__device__ __forceinline__ void select_finish(const unsigned (&Wa)[32], const unsigned (&Wb)[32], int E, unsigned* mrowA, unsigned* mrowB, int lane) {
    const unsigned valid = (E >= 32) ? 0xFFFFFFFFu : ((1u << E) - 1u);
    unsigned alA = valid, alB = valid, gtA = 0u, gtB = 0u;
    int GA = 0, GB = 0, AA = 64 * E, AB = 64 * E;
#pragma unroll
    for (int b0 = 0; b0 < 32; b0 += 4) {
        if (GA + AA == 256 && GB + AB == 256) break;
#pragma unroll
        for (int bb = 0; bb < 4; ++bb) { const int b = b0 + bb;
            const unsigned m1a = alA & Wa[b], m1b = alB & Wb[b];
            const int cab = wave_isum(__popc(m1a) | (__popc(m1b) << 16)), ca = cab & 0xFFFF, cb = cab >> 16;
            const bool ta = GA + ca >= 256, tb = GB + cb >= 256;
            alA = ta ? m1a : (alA ^ m1a); gtA = ta ? gtA : (gtA | m1a); AA = ta ? ca : AA - ca; GA = ta ? GA : GA + ca;
            alB = tb ? m1b : (alB ^ m1b); gtB = tb ? gtB : (gtB | m1b); AB = tb ? cb : AB - cb; GB = tb ? GB : GB + cb; }
    }
    const bool dA = (GA + AA == 256), dB = (GB + AB == 256);
#pragma unroll 1
    for (int rr = 0; rr < 2; ++rr) {
        const unsigned al = rr ? alB : alA, gt = rr ? gtB : gtA; const bool done = rr ? dB : dA; unsigned* mrow = rr ? mrowB : mrowA;
        unsigned sel = gt | al;
        if (!done) {
            int need = 256 - (rr ? GB : GA); sel = gt;
            const unsigned long long below = (1ull << lane) - 1ull;
            for (int j = 0; j < E; ++j) { const bool e = (al >> j) & 1u; const unsigned long long eq = __ballot(e);
                if (e && __popcll(eq & below) < need) sel |= 1u << j;
                need -= __popcll(eq); if (need <= 0) break; }
        }
        unsigned long long mine = 0ull;
#pragma unroll
        for (int j = 0; j < 32; ++j) { if (j < E) { const unsigned long long m = __ballot((sel >> j) & 1u); if (lane == j) mine = m; } }
        if (lane < 32) *(unsigned long long*)(mrow + 2 * lane) = mine;
    }
}
__device__ __forceinline__ void decode(int u, int& b, int& c, int& sub) { c = 4 + u % 28; const int rest = u / 28; b = rest >> 2; sub = rest & 3; }
__device__ __forceinline__ void load_af(Frame& F, int u, bf16x8 (&af)[4][4]) {
    int b, c, sub; decode(u, b, c, sub);
    const int r32 = F.lane & 31, hi = F.lane >> 5, t0 = 64 * c + 16 * sub;
    const bf16* P = F.R1 + (size_t)b * SEQ * NAB;
#pragma unroll
    for (int rt = 0; rt < 4; ++rt)
#pragma unroll
        for (int ks = 0; ks < 4; ++ks) af[rt][ks] = *(const bf16x8*)(P + (size_t)(t0 + 4 * rt + (r32 >> 3)) * NAB + C_IQ + (r32 & 7) * 64 + 16 * ks + 8 * hi);
}
__device__ __forceinline__ float load_w(Frame& F, int u) {
    int b, c, sub; decode(u, b, c, sub);
    const int t0 = 64 * c + 16 * sub;
    return (F.tid < 128) ? bf2f(F.R1[(size_t)(b * SEQ + t0 + (F.tid >> 3)) * NAB + C_IW + (F.tid & 7)]) * (0.125f * 0.35355339059327373f) : 0.f;
}
__device__ __forceinline__ void load_bf(Frame& F, int b, int strip, bf16x8 (&bfr)[4]) {
    const bf16* P = F.R1 + (size_t)b * SEQ * NAB;
#pragma unroll
    for (int ks = 0; ks < 4; ++ks) bfr[ks] = *(const bf16x8*)(P + (size_t)(32 * strip + (F.lane & 31)) * NAB + C_IK + 16 * ks + 8 * (F.lane >> 5));
}
__device__ __forceinline__ void run(Frame& F) {
    const int lane = F.lane, w = F.wave, hi = lane >> 5, r32 = lane & 31, tid = F.tid, NU = BATCH * 28 * 4;
    int u = F.vcu; if (u >= NU) return;
    LAS float* sc = (LAS float*)F.lds;
    LAS float* wtb = sc + 16 * SCP;
    bf16x8 af[4][4], bfr[4], bnx[4];
    load_af(F, u, af);
    { const float wv = load_w(F, u); if (tid < 128) wtb[tid] = wv; }
    { int b, c, sub; decode(u, b, c, sub); if (w < 2 * (c + 1)) load_bf(F, b, w, bfr); }
    for (int it = 0; u < NU; ++it, u += F.G) {
        int b, c, sub; decode(u, b, c, sub);
        const int n = 64 * (c + 1), t0 = 64 * c + 16 * sub, nstrip = n >> 5;
        const int un = u + F.G; const bool more = un < NU;
        const LAS float* wt = wtb + (it & 1) * 128;
        __syncthreads();
        const float wnext = more ? load_w(F, un) : 0.f;
        for (int s = w; s < nstrip; s += NWAVES) {
            const bool mstrip = s + NWAVES < nstrip;
            if (mstrip) load_bf(F, b, s + NWAVES, bnx);
#pragma unroll
            for (int rt = 0; rt < 4; ++rt) {
                f32x16 acc;
#pragma unroll
                for (int r = 0; r < 16; ++r) acc[r] = 0.f;
#pragma unroll
                for (int ks = 0; ks < 4; ++ks) acc = __builtin_amdgcn_mfma_f32_32x32x16_bf16(af[rt][ks], bfr[ks], acc, 0, 0, 0);
                float part[4];
#pragma unroll
                for (int qi = 0; qi < 4; ++qi) { const f32x4 wv = *(const LAS f32x4*)(wt + (4 * rt + qi) * 8 + 4 * hi);
                    part[qi] = fmaxf(acc[4 * qi], 0.f) * wv[0] + fmaxf(acc[4 * qi + 1], 0.f) * wv[1] + fmaxf(acc[4 * qi + 2], 0.f) * wv[2] + fmaxf(acc[4 * qi + 3], 0.f) * wv[3]; }
                const float send0 = hi ? part[0] : part[2], send1 = hi ? part[1] : part[3];
                const float got0 = __shfl_xor(send0, 32), got1 = __shfl_xor(send1, 32);
                const float f0 = (hi ? part[2] : part[0]) + got0, f1 = (hi ? part[3] : part[1]) + got1;
                const int q0 = 4 * rt + 2 * hi;
                sc[q0 * SCP + 32 * s + r32] = f0; sc[(q0 + 1) * SCP + 32 * s + r32] = f1;
            }
            if (mstrip) {
#pragma unroll
                for (int ks = 0; ks < 4; ++ks) bfr[ks] = bnx[ks];
            }
        }
        if (more && tid < 128) wtb[((it + 1) & 1) * 128 + tid] = wnext;
        __syncthreads();
        { const int q = 2 * w;
          unsigned* mrowA = F.MASK + (size_t)(b * SEQ + t0 + q) * 64; unsigned* mrowB = mrowA + 64;
          const LAS float* rowA = sc + q * SCP; const LAS float* rowB = rowA + SCP;
          unsigned Wa[32], Wb[32];
          select_prepare(rowA, rowB, n >> 6, Wa, Wb, lane);
          asm volatile("" ::: "memory");
          if (more) load_af(F, un, af);
          select_finish(Wa, Wb, n >> 6, mrowA, mrowB, lane); }
        if (more) { int bn, cn, sn; decode(un, bn, cn, sn); if (w < 2 * (cn + 1)) load_bf(F, bn, w, bfr); }
    }
    __syncthreads();
}
}
__device__ __forceinline__ void ph_indexer(Frame& F) {
    { const int gw = F.vcu * NWAVES + F.wave, NGW = F.G * NWAVES;
      for (int i = gw; i < BATCH * 256; i += NGW) { const int b = i >> 8, pos = i & 255, n = ((pos >> 6) + 1) << 6;
          if (F.lane < 32) { unsigned long long v = 0ull; if (64 * F.lane < n) v = ~0ull; *(unsigned long long*)(F.MASK + (size_t)(b * SEQ + pos) * 64 + 2 * F.lane) = v; } } }
    idx::run(F);
}
namespace gla {
using att::f32x16; using att::u32x4;
constexpr int L_WL = 0, L_V = 4096, L_OG = 36864, L_K = 69632, L_Q = 78848, L_PART = 88064, L_STG = 89088, KP = 144, SP = 272;
struct In { u32x4 g0, g1, kk, qq; f32x4 b0, b1; };
__device__ __forceinline__ void decode(int u, int& b, int& h, int& c) { b = u >> 7; h = (u >> 5) & 3; c = u & 31; }
template <bool PASSC> __device__ __forceinline__ void load_in(Frame& F, int u, In& in, const float* BC) {
    int b, h, c; decode(u, b, h, c);
    const bf16* pr = F.R1 + (size_t)(b * SEQ + 64 * c + F.lane) * NAB;
    in.kk = *(const u32x4*)(pr + C_KB + h * 64 + 8 * F.wave);
    if (PASSC) { in.qq = *(const u32x4*)(pr + C_QB + h * 64 + 8 * F.wave);
        const float* bp = BC + ((size_t)u * 64 + F.lane) * 64 + 8 * F.wave; in.b0 = *(const f32x4*)bp; in.b1 = *(const f32x4*)(bp + 4); }
    else { in.g0 = *(const u32x4*)(pr + C_GL); in.g1 = *(const u32x4*)(pr + C_GL + 8); }
}
template <bool NEEDOG> __device__ __forceinline__ void dma_in(Frame& F, int u, int buf, const unsigned (&dvo)[2]) {
    int b, h, c; decode(u, b, h, c);
    const bf16* P = F.R1 + (size_t)(b * SEQ + 64 * c) * NAB;
    att::tile_dma(P + C_VB + h * 128, dvo, F.lds + L_V + buf * 16384, F.wave);
    if (NEEDOG) att::tile_dma(P + C_OG + h * 128, dvo, F.lds + L_OG + buf * 16384, F.wave);
}
__device__ __forceinline__ void stage_wl(Frame& F, int h) {
    LAS float* wl = (LAS float*)(F.lds + L_WL);
#pragma unroll
    for (int i = 0; i < 2; ++i) { const int e = F.tid + 512 * i, r = e >> 6, d = e & 63; wl[e] = F.w_gate_up[r * 256 + h * 64 + d]; }
}
__device__ __forceinline__ void unpack8(const u32x4 v, float (&f)[8]) {
#pragma unroll
    for (int i = 0; i < 4; ++i) { f[2 * i] = __uint_as_float(v[i] << 16); f[2 * i + 1] = __uint_as_float(v[i] & 0xffff0000u); }
}
__device__ __forceinline__ void gate_scan(Frame& F, int h, const float (&gl)[16], float (&bc)[8], float (&blast)[8]) {
    const int lane = F.lane, d0 = 8 * F.wave;
    const LAS float* wl = (const LAS float*)(F.lds + L_WL);
    float acc[8];
#pragma unroll
    for (int i = 0; i < 8; ++i) acc[i] = F.b_gate[h * 64 + d0 + i];
#pragma unroll
    for (int r = 0; r < 16; ++r) { const f32x4 w0 = *(const LAS f32x4*)(wl + r * 64 + d0), w1 = *(const LAS f32x4*)(wl + r * 64 + d0 + 4);
#pragma unroll
        for (int i = 0; i < 4; ++i) { acc[i] = fmaf(gl[r], w0[i], acc[i]); acc[4 + i] = fmaf(gl[r], w1[i], acc[4 + i]); } }
#pragma unroll
    for (int i = 0; i < 8; ++i) { float v = (fminf(acc[i], 0.f) - __logf(1.0f + __expf(-fabsf(acc[i])))) * (1.0f / 16.0f);
#pragma unroll
        for (int off = 1; off < 64; off <<= 1) { const float u = __shfl_up(v, off); if (lane >= off) v += u; }
        bc[i] = v; blast[i] = __shfl(v, 63); }
}
__device__ __forceinline__ void pass_a(Frame& F, float* GU, float* DEC, float* BC) {
    const int lane = F.lane, w = F.wave, hi = lane >> 5, r32 = lane & 31;
    att::FragOff fo; att::frag_off_init(fo, lane);
    unsigned dvo[2]; att::dma_off_init(dvo, NAB, w, lane);
    const int et = w >> 1, dt = w & 1, va_et = att::frag_va(lane, et);
    int u = F.vcu; if (u >= BATCH * 4 * 32) return;
    In cur, nxt; int hprev = -1;
    dma_in<false>(F, u, 0, dvo); load_in<false>(F, u, cur, BC);
    for (int it = 0; u < BATCH * 4 * 32; ++it, u += F.G) {
        int b, h, c; decode(u, b, h, c);
        const int un = u + F.G; const bool more = un < BATCH * 4 * 32;
        if (h != hprev) { stage_wl(F, h); hprev = h; }
        asm volatile("s_waitcnt vmcnt(0) lgkmcnt(0)" ::: "memory");
        __syncthreads();
        float gl[16], kf[8];
        unpack8(cur.g0, (float(&)[8])gl[0]); unpack8(cur.g1, (float(&)[8])gl[8]); unpack8(cur.kk, kf);
        asm volatile("" ::: "memory");
        if (more) { dma_in<false>(F, un, (it + 1) & 1, dvo); load_in<false>(F, un, nxt, BC); }
        float bc[8], blast[8];
        gate_scan(F, h, gl, bc, blast);
        const int uid = u;
        { float* bp = BC + ((size_t)uid * 64 + lane) * 64 + 8 * w; *(f32x4*)bp = (f32x4){bc[0], bc[1], bc[2], bc[3]}; *(f32x4*)(bp + 4) = (f32x4){bc[4], bc[5], bc[6], bc[7]}; }
#pragma unroll
        for (int i = 0; i < 8; ++i) *(LAS bf16*)(F.lds + L_K + (8 * w + i) * KP + lane * 2) = (bf16)f2bf(kf[i] * __expf(blast[i] - bc[i]));
        if (lane == 0) {
#pragma unroll
            for (int i = 0; i < 8; ++i) DEC[(size_t)uid * 64 + 8 * w + i] = __expf(blast[i]); }
        asm volatile("s_waitcnt lgkmcnt(0)" ::: "memory");
        __syncthreads();
        const LAS unsigned char* vbuf = F.lds + L_V + (it & 1) * 16384;
        f32x16 acc;
#pragma unroll
        for (int r = 0; r < 16; ++r) acc[r] = 0.f;
#pragma unroll
        for (int kk = 0; kk < 4; ++kk) {
            const LAS unsigned char* kp = F.lds + L_K + (32 * dt + r32) * KP + (16 * kk + 4 * hi) * 2;
            const unsigned long long lo = *(const LAS unsigned long long*)kp, hh = *(const LAS unsigned long long*)(kp + 16);
            u32x4 bw; bw.x = (unsigned)lo; bw.y = (unsigned)(lo >> 32); bw.z = (unsigned)hh; bw.w = (unsigned)(hh >> 32);
            acc = __builtin_amdgcn_mfma_f32_32x32x16_bf16(att::v_frag_rt(vbuf, va_et, fo.vd, kk), __builtin_bit_cast(bf16x8, bw), acc, 0, 0, 0);
        }
        float* gu = GU + (size_t)uid * 8192;
#pragma unroll
        for (int r = 0; r < 16; ++r) gu[(32 * et + att::crow(r, hi)) * 64 + 32 * dt + r32] = acc[r];
        cur = nxt;
    }
    __syncthreads();
}
__device__ __forceinline__ void pass_b(Frame& F, float* GU, const float* DEC) {
    for (int idx = F.vcu * NTHR + F.tid; idx < 64 * 128 * 16; idx += F.G * NTHR) {
        const int bh = idx >> 11, e = (idx >> 4) & 127, dq = idx & 15;
        f32x4 S = (f32x4){0.f, 0.f, 0.f, 0.f};
        for (int c0 = 0; c0 < 32; c0 += 8) {
            f32x4 U[8], dec[8];
#pragma unroll
            for (int i = 0; i < 8; ++i) { const size_t uid = (size_t)bh * 32 + c0 + i; U[i] = *(const f32x4*)(GU + (uid * 128 + e) * 64 + 4 * dq); dec[i] = *(const f32x4*)(DEC + uid * 64 + 4 * dq); }
#pragma unroll
            for (int i = 0; i < 8; ++i) { const size_t uid = (size_t)bh * 32 + c0 + i; *(f32x4*)(GU + (uid * 128 + e) * 64 + 4 * dq) = S; S = dec[i] * S + U[i]; }
        }
    }
}
__device__ __forceinline__ void pass_c(Frame& F, const float* GU, const float* BC) {
    const int lane = F.lane, w = F.wave, hi = lane >> 5, r32 = lane & 31, tid = F.tid;
    LAS unsigned char* lds = F.lds;
    att::FragOff fo; att::frag_off_init(fo, lane);
    unsigned dvo[2]; att::dma_off_init(dvo, NAB, w, lane);
    const int et = w >> 1, tt = w & 1, tl = 32 * tt + r32, va_et = att::frag_va(lane, et);
    int u = F.vcu; if (u >= BATCH * 4 * 32) return;
    In cur, nxt;
    dma_in<true>(F, u, 0, dvo); load_in<true>(F, u, cur, BC);
    for (int it = 0; u < BATCH * 4 * 32; ++it, u += F.G) {
        int b, h, c; decode(u, b, h, c);
        const int un = u + F.G; const bool more = un < BATCH * 4 * 32;
        asm volatile("s_waitcnt vmcnt(0) lgkmcnt(0)" ::: "memory");
        __syncthreads();
        float kf[8], qf[8], bc[8];
        unpack8(cur.kk, kf); unpack8(cur.qq, qf);
#pragma unroll
        for (int i = 0; i < 4; ++i) { bc[i] = cur.b0[i]; bc[4 + i] = cur.b1[i]; }
        asm volatile("" ::: "memory");
        if (more) { dma_in<true>(F, un, (it + 1) & 1, dvo); load_in<true>(F, un, nxt, BC); }
        f32x4 sf[8];
        { const float* gs = GU + ((size_t)u * 128 + 32 * et + r32) * 64;
#pragma unroll
          for (int ks = 0; ks < 4; ++ks) { sf[2 * ks] = *(const f32x4*)(gs + 16 * ks + 8 * hi); sf[2 * ks + 1] = *(const f32x4*)(gs + 16 * ks + 8 * hi + 4); } }
        { float eq[8], ek[8];
#pragma unroll
          for (int i = 0; i < 8; ++i) { eq[i] = qf[i] * 0.125f * __expf(bc[i]); ek[i] = kf[i] * __expf(-bc[i]); }
          *(LAS bf16x8*)(lds + L_Q + lane * KP + 16 * w) = att::pack8(eq[0], eq[1], eq[2], eq[3], eq[4], eq[5], eq[6], eq[7]);
          *(LAS bf16x8*)(lds + L_K + lane * KP + 16 * w) = att::pack8(ek[0], ek[1], ek[2], ek[3], ek[4], ek[5], ek[6], ek[7]); }
        asm volatile("s_waitcnt lgkmcnt(0)" ::: "memory");
        __syncthreads();
        const LAS unsigned char* vbuf = lds + L_V + (it & 1) * 16384; const LAS unsigned char* ogbuf = lds + L_OG + (it & 1) * 16384;
        bf16x8 qfr[4];
#pragma unroll
        for (int ks = 0; ks < 4; ++ks) qfr[ks] = *(const LAS bf16x8*)(lds + L_Q + tl * KP + (16 * ks + 8 * hi) * 2);
        f32x16 p0, p1;
#pragma unroll
        for (int r = 0; r < 16; ++r) { p0[r] = 0.f; p1[r] = 0.f; }
#pragma unroll
        for (int ks = 0; ks < 4; ++ks) {
            const bf16x8 a0 = *(const LAS bf16x8*)(lds + L_K + r32 * KP + (16 * ks + 8 * hi) * 2), a1 = *(const LAS bf16x8*)(lds + L_K + (32 + r32) * KP + (16 * ks + 8 * hi) * 2);
            p0 = __builtin_amdgcn_mfma_f32_32x32x16_bf16(a0, qfr[ks], p0, 0, 0, 0); p1 = __builtin_amdgcn_mfma_f32_32x32x16_bf16(a1, qfr[ks], p1, 0, 0, 0);
        }
        { const int tl4 = tl - 4 * hi;
#pragma unroll
          for (int r = 0; r < 16; ++r) { const int s = (r & 3) + 8 * (r >> 2); if (s > tl4) p0[r] = 0.f; if (s + 32 > tl4) p1[r] = 0.f; } }
        const bf16x8 pa0 = att::pack8(p0[0], p0[1], p0[2], p0[3], p0[4], p0[5], p0[6], p0[7]), pa1 = att::pack8(p0[8], p0[9], p0[10], p0[11], p0[12], p0[13], p0[14], p0[15]);
        const bf16x8 pa2 = att::pack8(p1[0], p1[1], p1[2], p1[3], p1[4], p1[5], p1[6], p1[7]), pa3 = att::pack8(p1[8], p1[9], p1[10], p1[11], p1[12], p1[13], p1[14], p1[15]);
        f32x16 acc;
#pragma unroll
        for (int r = 0; r < 16; ++r) acc[r] = 0.f;
        acc = __builtin_amdgcn_mfma_f32_32x32x16_bf16(att::v_frag_rt(vbuf, va_et, fo.vd, 0), pa0, acc, 0, 0, 0);
        acc = __builtin_amdgcn_mfma_f32_32x32x16_bf16(att::v_frag_rt(vbuf, va_et, fo.vd, 1), pa1, acc, 0, 0, 0);
        acc = __builtin_amdgcn_mfma_f32_32x32x16_bf16(att::v_frag_rt(vbuf, va_et, fo.vd, 2), pa2, acc, 0, 0, 0);
        acc = __builtin_amdgcn_mfma_f32_32x32x16_bf16(att::v_frag_rt(vbuf, va_et, fo.vd, 3), pa3, acc, 0, 0, 0);
#pragma unroll
        for (int ks = 0; ks < 4; ++ks) { const f32x4 s0 = sf[2 * ks], s1 = sf[2 * ks + 1];
            acc = __builtin_amdgcn_mfma_f32_32x32x16_bf16(att::pack8(s0[0], s0[1], s0[2], s0[3], s1[0], s1[1], s1[2], s1[3]), qfr[ks], acc, 0, 0, 0); }
        float ss = 0.f;
#pragma unroll
        for (int r = 0; r < 16; ++r) ss = fmaf(acc[r], acc[r], ss);
        ss += __shfl_xor(ss, 32);
        LAS float* part = (LAS float*)(lds + L_PART);
        if (hi == 0) part[et * 64 + tl] = ss;
        asm volatile("s_waitcnt lgkmcnt(0)" ::: "memory");
        __syncthreads();
        const float rs = rsqrtf(((part[tl] + part[64 + tl]) + (part[128 + tl] + part[192 + tl])) * (1.0f / 128.0f) + EPS);
#pragma unroll
        for (int g = 0; g < 4; ++g) {
            const int e0 = 32 * et + 8 * g + 4 * hi;
            const unsigned long long ow = *(const LAS unsigned long long*)(ogbuf + att::img_off(tl, 4 * et + g) + 8 * hi);
            const f32x4 gg = *(const f32x4*)(F.g_gla + e0);
            float y[4];
#pragma unroll
            for (int i = 0; i < 4; ++i) { const float og = __uint_as_float(((unsigned)(ow >> (16 * i)) & 0xffffu) << 16); y[i] = acc[4 * g + i] * rs * gg[i] * (og * __builtin_amdgcn_rcpf(1.0f + __expf(-og))); }
            *(LAS unsigned long long*)(lds + L_STG + tl * SP + e0 * 2) = (unsigned long long)pg8::cvt_pk_bf16(y[0], y[1]) | ((unsigned long long)pg8::cvt_pk_bf16(y[2], y[3]) << 32);
        }
        asm volatile("s_waitcnt lgkmcnt(0)" ::: "memory");
        __syncthreads();
#pragma unroll
        for (int i = 0; i < 2; ++i) { const int cidx = tid + 512 * i, row = cidx >> 4, ch = cidx & 15;
            *(u32x4*)(F.CAT + (size_t)(b * SEQ + 64 * c + row) * D + 512 + h * 128 + ch * 8) = *(const LAS u32x4*)(lds + L_STG + row * SP + ch * 16); }
        cur = nxt;
    }
    __syncthreads();
}
}
__device__ __forceinline__ void ph_rope_tables(Frame& F, float* R128, float* R64) {
    for (int i = F.vcu * NTHR + F.tid; i < SEQ * 24; i += F.G * NTHR) {
        const int pos = i / 24, k = i % 24;
        if (k < 16) { const float inv = powf(500000.0f, -(float)k * 2.0f / 32.0f), ang = (float)pos * inv; R128[pos * 32 + k] = cosf(ang); R128[pos * 32 + 16 + k] = sinf(ang); }
        else { const int j = k - 16; const float inv = powf(500000.0f, -(float)j * 2.0f / 16.0f), ang = (float)pos * inv; R64[pos * 16 + j] = cosf(ang); R64[pos * 16 + 8 + j] = sinf(ang); }
    }
}
__device__ __forceinline__ float dpp_xor1(float v) { return __builtin_bit_cast(float, __builtin_amdgcn_mov_dpp(__builtin_bit_cast(int, v), 0xB1, 0xF, 0xF, true)); }
__device__ __forceinline__ float dpp_xor2(float v) { return __builtin_bit_cast(float, __builtin_amdgcn_mov_dpp(__builtin_bit_cast(int, v), 0x4E, 0xF, 0xF, true)); }
__device__ __forceinline__ void ph_prep_c_fast(Frame& F) {
    const int gw = F.vcu * NWAVES + F.wave, NGW = F.G * NWAVES, lane = F.lane;
    const float* gn = (lane < 32 ? F.gq_c : F.gk_c) + (lane & 3) * 32;
    const float sc = lane < 32 ? att::C2 : 1.0f;
    float g[32];
#pragma unroll
    for (int i = 0; i < 8; ++i) { const f32x4 v = *(const f32x4*)(gn + 4 * i); g[4 * i] = v[0] * sc; g[4 * i + 1] = v[1] * sc; g[4 * i + 2] = v[2] * sc; g[4 * i + 3] = v[3] * sc; }
    for (int tok = gw; tok < M; tok += NGW) {
        att::u32x4* p = (att::u32x4*)(F.R1 + (size_t)tok * NC + lane * 32);
        att::u32x4 v[4]; float f[32]; float ss = 0.f;
#pragma unroll
        for (int i = 0; i < 4; ++i) v[i] = p[i];
#pragma unroll
        for (int i = 0; i < 4; ++i)
#pragma unroll
            for (int j = 0; j < 4; ++j) { const float a = __uint_as_float(v[i][j] << 16), b = __uint_as_float(v[i][j] & 0xffff0000u); f[8 * i + 2 * j] = a; f[8 * i + 2 * j + 1] = b; ss = fmaf(a, a, fmaf(b, b, ss)); }
        ss += dpp_xor1(ss); ss += dpp_xor2(ss);
        const float rs = rsqrtf(ss * (1.f / 128.f) + EPS);
#pragma unroll
        for (int i = 0; i < 4; ++i) { att::u32x4 o;
#pragma unroll
            for (int j = 0; j < 4; ++j) o[j] = pg8::cvt_pk_bf16(f[8 * i + 2 * j] * rs * g[8 * i + 2 * j], f[8 * i + 2 * j + 1] * rs * g[8 * i + 2 * j + 1]);
            p[i] = o; }
    }
}
__device__ __forceinline__ void ph_prep_a_fast(Frame& F, const float* R128, const float* R64) {
    const int gw = F.vcu * NWAVES + F.wave, NGW = F.G * NWAVES, lane = F.lane, l8 = lane & 7;
    const float* gn = (lane < 32 ? F.gq_a : F.gk_a) + l8 * 16;
    const float sc = lane < 32 ? att::C2 : 1.0f;
    float g[16];
#pragma unroll
    for (int i = 0; i < 4; ++i) { const f32x4 v = *(const f32x4*)(gn + 4 * i); g[4 * i] = v[0] * sc; g[4 * i + 1] = v[1] * sc; g[4 * i + 2] = v[2] * sc; g[4 * i + 3] = v[3] * sc; }
    for (int tok = gw; tok < M; tok += NGW) {
        const int pos = tok & (SEQ - 1);
        bf16* pr = F.R1 + (size_t)tok * NAB;
        {   att::u32x4* p = (att::u32x4*)(pr + lane * 16);
            const att::u32x4 v0 = p[0], v1 = p[1]; float f[16]; float ss = 0.f;
#pragma unroll
            for (int j = 0; j < 4; ++j) { f[2 * j] = __uint_as_float(v0[j] << 16); f[2 * j + 1] = __uint_as_float(v0[j] & 0xffff0000u); f[8 + 2 * j] = __uint_as_float(v1[j] << 16); f[8 + 2 * j + 1] = __uint_as_float(v1[j] & 0xffff0000u); }
#pragma unroll
            for (int i = 0; i < 16; ++i) ss = fmaf(f[i], f[i], ss);
            ss += dpp_xor1(ss); ss += dpp_xor2(ss); ss += __shfl_xor(ss, 4);
            const float rs = rsqrtf(ss * (1.f / 128.f) + EPS);
#pragma unroll
            for (int i = 0; i < 16; ++i) f[i] = f[i] * rs * g[i];
            const float* cs = R128 + pos * 32;
#pragma unroll
            for (int i = 0; i < 16; ++i) { const float other = dpp_xor1(f[i]);
                if (l8 < 2) { const float c = cs[i], s = cs[16 + i]; f[i] = (l8 == 0) ? f[i] * c - other * s : f[i] * c + other * s; } }
            att::u32x4 o0, o1;
#pragma unroll
            for (int j = 0; j < 4; ++j) { o0[j] = pg8::cvt_pk_bf16(f[2 * j], f[2 * j + 1]); o1[j] = pg8::cvt_pk_bf16(f[8 + 2 * j], f[8 + 2 * j + 1]); }
            p[0] = o0; p[1] = o1;
        }
        {
#pragma unroll
            for (int part = 0; part < 2; ++part) {
                if (part == 1 && lane >= 8) break;
                att::u32x4* p = (att::u32x4*)(pr + (part == 0 ? C_IQ + lane * 8 : C_IK + lane * 8));
                const att::u32x4 v0 = p[0]; float f[8];
#pragma unroll
                for (int j = 0; j < 4; ++j) { f[2 * j] = __uint_as_float(v0[j] << 16); f[2 * j + 1] = __uint_as_float(v0[j] & 0xffff0000u); }
                const float* cs = R64 + pos * 16;
#pragma unroll
                for (int i = 0; i < 8; ++i) { const float other = dpp_xor1(f[i]);
                    if (l8 < 2) { const float c = cs[i], s = cs[8 + i]; f[i] = (l8 == 0) ? f[i] * c - other * s : f[i] * c + other * s; } }
                att::u32x4 o0;
#pragma unroll
                for (int j = 0; j < 4; ++j) o0[j] = pg8::cvt_pk_bf16(f[2 * j], f[2 * j + 1]);
                p[0] = o0;
            }
        }
    }
}
#ifndef MK_PER_PHASE
#define MK_PER_PHASE 0
#endif
constexpr int NPH = 14;
struct Args { const float* in[16]; float* out; unsigned char* ws; int ph_lo, ph_hi; };
__global__ void __launch_bounds__(NTHR, 2) mk_fwd(Args args) {
    extern __shared__ __attribute__((aligned(16))) unsigned char lds[];
    Frame F;
    F.lds = (LAS unsigned char*)lds;
    F.MISC = (volatile LAS unsigned*)(F.lds + MISC_OFF);
#ifdef PROBE_TOTAL
    const unsigned long long pt_start = __builtin_amdgcn_s_memrealtime();
#endif
    F.wave = __builtin_amdgcn_readfirstlane((int)threadIdx.x >> 6);
#define RELANE() (F.lane = lane_id_opaque(), F.tid = F.wave * 64 + F.lane, true)
    RELANE();
#ifdef PROBE_ACC
    F.acc_t0 = 0ull; F.acc_sum = 0ull;
#endif
    F.G = gridDim.x; { const int bx = blockIdx.x; F.vcu = (F.G % 8 == 0) ? (bx % 8) * (F.G / 8) + bx / 8 : bx; }
    unsigned char* ws = args.ws;
    F.ctl = (gu32*)(ws + WS_CTL);
    F.x = args.in[0]; F.g_mix = args.in[1]; F.g_ffn = args.in[2]; F.w_in_ab = args.in[3]; F.gq_a = args.in[4]; F.gk_a = args.in[5]; F.w_gate_up = args.in[6]; F.b_gate = args.in[7];
    F.g_gla = args.in[8]; F.w_out_ab = args.in[9]; F.w_in_c = args.in[10]; F.gq_c = args.in[11]; F.gk_c = args.in[12]; F.w_out_c = args.in[13]; F.w_up = args.in[14]; F.w_down = args.in[15];
    F.out = args.out;
    F.Wab = (bf16*)(ws + WS_WAB); F.Woab = (bf16*)(ws + WS_WOAB); F.Wup0 = (bf16*)(ws + WS_WUP0); F.Wdn0 = (bf16*)(ws + WS_WDN0);
    F.Winc = (bf16*)(ws + WS_WINC); F.Woc = (bf16*)(ws + WS_WOC); F.Wup1 = (bf16*)(ws + WS_WUP1); F.Wdn1 = (bf16*)(ws + WS_WDN1);
    F.XB = (bf16*)(ws + WS_XB); F.CAT = (bf16*)(ws + WS_CAT); F.R1 = (bf16*)(ws + WS_R1); F.SSQ = (float*)(ws + WS_SSQ); F.MASK = (unsigned*)(ws + WS_MASK);
    for (int u = F.tid; u < (LDS_BYTES - MISC_OFF) / 4; u += NTHR) ((LAS unsigned*)(F.lds + MISC_OFF))[u] = 0u;
    __syncthreads();
    XcdBarrier bar; bar.bar = (unsigned*)(F.ctl + CW_BAR); bar.x = 0; bar.st = nullptr; bar.wave = F.wave;
    if (!MK_PER_PHASE) bar = xcd_barrier_post((unsigned*)(F.ctl + CW_BAR), F.MISC + 8, F.wave);
    const int lo = args.ph_lo, hi = args.ph_hi;
#ifdef PROBE_PH
    unsigned long long pt0 = 0ull, pt1 = 0ull;
#define STAMP(k) do { if ((k) == PROBE_PH) pt0 = __builtin_amdgcn_s_memrealtime(); if ((k) == PROBE_PH + 1) pt1 = __builtin_amdgcn_s_memrealtime(); } while (0)
#ifdef PROBE_SUB
#define SUBSTAMP(k) do { if ((k) == PROBE_PH) { __syncthreads(); pt0 = __builtin_amdgcn_s_memrealtime(); } } while (0)
#else
#define SUBSTAMP(k) do { } while (0)
#endif
#else
#define STAMP(k) do { } while (0)
#define SUBSTAMP(k) do { } while (0)
#endif
#define IN(k) (lo <= (k) && (k) < hi && RELANE())
#ifdef PROBE_DBLBAR
#define SEAM(k) do { if (lo <= (k) && (k) + 1 < hi) { xcd_barrier(bar); xcd_barrier(bar); } } while (0)
#else
#define SEAM(k) do { if (lo <= (k) && (k) + 1 < hi) xcd_barrier(bar); } while (0)
#endif
    float* const SSQ0 = F.SSQ, *SSQ1 = F.SSQ + (size_t)M * 16, *SSQ2 = F.SSQ + (size_t)2 * M * 16, *SSQ3 = F.SSQ + (size_t)3 * M * 16;
    typedef pg8::StaticOrder SO;
    STAMP(0); float* const R128 = (float*)(ws + WS_ROPE); float* const R64 = R128 + SEQ * 32;
    if (IN(0)) { ph_prologue(F); ph_rope_tables(F, R128, R64); } SEAM(0);
    STAMP(1); if (IN(1)) { pg8::Gemm g{F.XB, F.Wab, M, NAB, D}; SO S; S.init(M, NAB, F.G, (int)blockIdx.x); pg8::EpiProjAB E{F.R1, NAB, SSQ0, F.gq_a, F.gk_a, R128, R64, (LAS float*)(F.lds + RING_BYTES), att::C2};
        pg8::gemm_phase<pg8::EpiProjAB, SO, true, true>(F.lds, g, S, E, F.wave);
        if (F.G == 256 && blockIdx.x >= 128) { RELANE(); prologue_weights<1>(F, ((int)blockIdx.x - 128) * NWAVES + F.wave, 128 * NWAVES); } } SEAM(1);
    float* const GU = (float*)(ws + WS_XB); float* const DEC = (float*)(ws + WS_DEC);
    STAMP(2); if (IN(2)) { SUBSTAMP(2); gla::pass_a(F, GU, DEC, (float*)(ws + WS_BC)); } SEAM(2);
    STAMP(3); if (IN(3)) { gla::pass_b(F, GU, DEC); SUBSTAMP(3); ph_indexer(F); } SEAM(3);
    STAMP(4); if (IN(4)) { ph_dsa(F); SUBSTAMP(4); gla::pass_c(F, GU, (const float*)(ws + WS_BC)); } SEAM(4);
    STAMP(5); if (IN(5)) { pg8::Gemm g{F.CAT, F.Woab, M, D, D}; SO S; S.init(M, D, F.G, (int)blockIdx.x); pg8::EpiResid<0, 0> E{F.x, nullptr, F.XB, SSQ1, nullptr};
        pg8::gemm_phase<pg8::EpiResid<0, 0>, SO, true, true>(F.lds, g, S, E, F.wave); } SEAM(5);
    STAMP(6); if (IN(6)) { pg8::Gemm g{F.XB, F.Wup0, M, FF, D}; SO S; S.init(M, FF, F.G, (int)blockIdx.x); pg8::EpiScale<1> E{F.R1, FF, SSQ1};
        pg8::gemm_phase<pg8::EpiScale<1>, SO, true, true>(F.lds, g, S, E, F.wave); } SEAM(6);
    STAMP(7); if (IN(7)) { pg8::Gemm g{F.R1, F.Wdn0, M, D, FF}; SO S; S.init(M, D, F.G, (int)blockIdx.x); pg8::EpiResid<1, 0> E{F.XB, nullptr, F.XB, SSQ2, SSQ1};
        pg8::gemm_phase<pg8::EpiResid<1, 0>, SO, true, true>(F.lds, g, S, E, F.wave); } SEAM(7);
    STAMP(8); if (IN(8)) { pg8::Gemm g{F.XB, F.Winc, M, NC, D}; SO S; S.init(M, NC, F.G, (int)blockIdx.x); pg8::EpiQKNorm E{F.R1, NC, SSQ2, F.gq_c, F.gk_c, (LAS float*)(F.lds + RING_BYTES), att::C2};
        pg8::gemm_phase<pg8::EpiQKNorm, SO, true, true>(F.lds, g, S, E, F.wave); } SEAM(8);
    STAMP(9);
    STAMP(10); if (IN(10)) { ph_sb(F); } SEAM(10);
    STAMP(11); if (IN(11)) { pg8::Gemm g{F.CAT, F.Woc, M, D, D}; SO S; S.init(M, D, F.G, (int)blockIdx.x); pg8::EpiResid<1, 0> E{F.XB, nullptr, F.XB, SSQ3, nullptr};
        pg8::gemm_phase<pg8::EpiResid<1, 0>, SO, true, true>(F.lds, g, S, E, F.wave); } SEAM(11);
    STAMP(12); if (IN(12)) { pg8::Gemm g{F.XB, F.Wup1, M, FF, D}; SO S; S.init(M, FF, F.G, (int)blockIdx.x); pg8::EpiScale<1> E{F.R1, FF, SSQ3};
        pg8::gemm_phase<pg8::EpiScale<1>, SO, true, true>(F.lds, g, S, E, F.wave); } SEAM(12);
    STAMP(13); if (IN(13)) { pg8::Gemm g{F.R1, F.Wdn1, M, D, FF}; SO S; S.init(M, D, F.G, (int)blockIdx.x); pg8::EpiResid<1, 1> E{F.XB, F.out, nullptr, nullptr, SSQ3};
        pg8::gemm_phase<pg8::EpiResid<1, 1>, SO, true, true>(F.lds, g, S, E, F.wave); }
    STAMP(NPH);
#ifdef PROBE_TOTAL
    if (blockIdx.x == 0) { const unsigned long long t1 = __builtin_amdgcn_s_memrealtime(), dt = (t1 - pt_start); while (__builtin_amdgcn_s_memrealtime() - t1 < dt) __builtin_amdgcn_s_sleep(8); }
#endif
#ifdef PROBE_ACC
    if (blockIdx.x == 0) { const unsigned long long t1 = __builtin_amdgcn_s_memrealtime(), dt = F.acc_sum * PROBE_MULT; while (__builtin_amdgcn_s_memrealtime() - t1 < dt) __builtin_amdgcn_s_sleep(8); }
#endif
#ifdef PROBE_PH
    if (blockIdx.x == 0) { const unsigned long long t1 = __builtin_amdgcn_s_memrealtime(), dt = (pt1 - pt0) * PROBE_MULT; while (__builtin_amdgcn_s_memrealtime() - t1 < dt) __builtin_amdgcn_s_sleep(8); }
#endif
#undef IN
#undef SEAM
}

extern "C" void kernel_launch(void* const* d_in, const int* in_sizes, int n_in, void* d_out, int out_size, void* d_ws, size_t ws_size, hipStream_t stream) {
    static int grid = 0;
    if (grid == 0) {
        if (n_in != 16 || in_sizes[0] != M * D || out_size != M * D || ws_size < WS_END) { fprintf(stderr, "kernel_launch: unexpected shapes / workspace (%d inputs, ws %zu)\n", n_in, ws_size); grid = -1; return; }
        int dev = 0, cus = 0;
        if (hipGetDevice(&dev) != hipSuccess || hipDeviceGetAttribute(&cus, hipDeviceAttributeMultiprocessorCount, dev) != hipSuccess) { grid = -1; return; }
        if (hipFuncSetAttribute((const void*)mk_fwd, hipFuncAttributeMaxDynamicSharedMemorySize, LDS_BYTES) != hipSuccess) { fprintf(stderr, "kernel_launch: hipFuncSetAttribute failed\n"); grid = -1; return; }
        (void)hipGetLastError();
        grid = cus;
    }
    if (grid < 0) return;
    if (hipMemsetAsync((char*)d_ws + WS_CTL, 0, CTL_ZERO_BYTES, stream) != hipSuccess) { fprintf(stderr, "kernel_launch: memset failed\n"); return; }
    Args a{};
    for (int i = 0; i < 16; ++i) a.in[i] = (const float*)d_in[i];
    a.out = (float*)d_out; a.ws = (unsigned char*)d_ws;
#if MK_PER_PHASE
    for (int ph = 0; ph < NPH; ++ph) { a.ph_lo = ph; a.ph_hi = ph + 1; hipLaunchKernelGGL(mk_fwd, dim3(grid), dim3(NTHR), LDS_BYTES, stream, a); }
#else
    a.ph_lo = 0; a.ph_hi = NPH;
    hipLaunchKernelGGL(mk_fwd, dim3(grid), dim3(NTHR), LDS_BYTES, stream, a);
#endif
    const hipError_t le = hipPeekAtLastError();
    if (le != hipSuccess) fprintf(stderr, "kernel_launch: launch failed: %s\n", hipGetErrorName(le));
}
```

```cpp
#include <hip/hip_runtime.h>
#include <cstdio>
#include <cstdint>
namespace pg8 {
#define PG8_LAS __attribute__((address_space(3)))
typedef unsigned short bf16_t;
typedef short bf16x8 __attribute__((ext_vector_type(8)));
typedef float f32x4 __attribute__((ext_vector_type(4)));
typedef unsigned u32x4 __attribute__((ext_vector_type(4)));
constexpr int BM = 256, BK = 64, HALF = 128, HTB = HALF * BK * 2  , STAGE_BYTES = 8 * HTB, NXCD = 8, WGM = 8;

__host__ __device__ __forceinline__ int lds_byte(int r, int c) { const int st = (r >> 4) * 2 + (c >> 5), rr = r & 15, cc = c & 31, ob = rr * 64 + cc * 2; return st * 1024 + (ob ^ (((ob >> 9) & 1) << 5)); }
__host__ __device__ __forceinline__ void stage_rc(int b, int& R, int& C) { const int st = b / 1024, sb = b % 1024, swz = sb ^ (((sb >> 9) & 1) << 5); R = (st >> 1) * 16 + swz / 64; C = (st & 1) * 32 + (swz % 64) / 2; }
__host__ __device__ __forceinline__ int perm32(int rho) { const int n = rho >> 4, i = rho & 15; return 8 * (i >> 2) + 4 * n + (i & 3); }

struct Unit { int pm, pn; };
struct Gemm { const bf16_t* A; const bf16_t* Bt; int M, N, K; };

struct StaticOrder {
    int nM, nN, nwg, G, c;
    __host__ __device__ void init(int M, int N, int G_, int c_) { nM = M / BM; nN = N / BM; nwg = nM * nN; G = G_; c = c_; }
    __host__ __device__ bool next(int i, Unit& u) const {
        const long L = (long)i * G + c; if (L >= nwg) return false;
        int wgid = (int)L; { const int q = nwg / NXCD, r = nwg % NXCD, xcd = wgid % NXCD, off = wgid / NXCD; wgid = (xcd < r ? xcd * (q + 1) : r * (q + 1) + (xcd - r) * q) + off; }
        const int nig = WGM * nN, gid = wgid / nig, fm = gid * WGM, gsz = (nM - fm) < WGM ? (nM - fm) : WGM;
        u.pm = fm + ((wgid % nig) % gsz); u.pn = (wgid % nig) / gsz; return true;
    }
    __device__ __forceinline__ void a_ready(const Unit&) const {}
    __device__ __forceinline__ void done(const Unit&) const {}
};

__device__ __forceinline__ unsigned cvt_pk_bf16(float lo, float hi) { unsigned r; asm volatile("v_cvt_pk_bf16_f32 %0, %1, %2" : "=v"(r) : "v"(lo), "v"(hi)); return r; }
__device__ __forceinline__ float row_rstd(const float* ssqp, int row) {
    const f32x4* p = (const f32x4*)(ssqp + (size_t)row * 16);
    const f32x4 a = p[0], b = p[1], c = p[2], d = p[3];
    const float s = (((a[0] + a[1]) + (a[2] + a[3])) + ((b[0] + b[1]) + (b[2] + b[3]))) + (((c[0] + c[1]) + (c[2] + c[3])) + ((d[0] + d[1]) + (d[2] + d[3])));
    return rsqrtf(s * (1.0f / 1024.0f) + 1e-6f);
}
__device__ __forceinline__ int epi_lane() { int l; asm volatile("v_mbcnt_lo_u32_b32 %0, -1, 0\n\tv_mbcnt_hi_u32_b32 %0, -1, %0" : "=v"(l)); return l; }
template <int ACT  > struct EpiScale {
    static constexpr bool PERM = true, AFTER_DRAIN = false;
    bf16_t* O; int ldc; const float* ssqp;
    __device__ __forceinline__ void operator()(const f32x4 (&acc)[2][2][4][2], const Unit& u, int wr, int wc, int fr, int fq) const {
        const int row0 = u.pm * BM + wr * 64 + fr, col0 = u.pn * BM + wc * 32 + 8 * fq;
#pragma unroll
        for (int ai = 0; ai < 2; ++ai)
#pragma unroll
            for (int m = 0; m < 4; ++m) {
                const int row = row0 + ai * HALF + m * 16;
                const float rs = (ACT == 0) ? row_rstd(ssqp, row) : 1.0f;
                bf16_t* rowp = O + (size_t)row * ldc + col0;
#pragma unroll
                for (int bj = 0; bj < 2; ++bj) {
                    f32x4 v0 = acc[ai][bj][m][0] * rs, v1 = acc[ai][bj][m][1] * rs;
                    if (ACT == 1) {
#pragma unroll
                        for (int e = 0; e < 4; ++e) { const float a0 = fmaxf(v0[e], 0.f), a1 = fmaxf(v1[e], 0.f); v0[e] = a0 * a0; v1[e] = a1 * a1; }
                    }
                    u32x4 w; w.x = cvt_pk_bf16(v0[0], v0[1]); w.y = cvt_pk_bf16(v0[2], v0[3]); w.z = cvt_pk_bf16(v1[0], v1[1]); w.w = cvt_pk_bf16(v1[2], v1[3]);
                    *(u32x4*)(rowp + bj * HALF) = w;
                }
            }
    }
};
template <int RIN, int OUT> struct EpiResid {
    static constexpr bool PERM = true, AFTER_DRAIN = false;
    const void* R; float* out; bf16_t* hb; float* ssqp; const float* ssq_in;
    __device__ __forceinline__ void operator()(const f32x4 (&acc)[2][2][4][2], const Unit& u, int wr, int wc, int fr, int fq) const {
        const int row0 = u.pm * BM + wr * 64 + fr, col0 = u.pn * BM + wc * 32 + 8 * fq;
        constexpr int MB = 2;
        constexpr int NW = (RIN == 0) ? 2 : 1;
#pragma unroll
        for (int ai = 0; ai < 2; ++ai)
#pragma unroll
            for (int m0 = 0; m0 < 4; m0 += MB) {
                u32x4 rw[MB][2][NW]; f32x4 pp[MB][4];
#pragma unroll
                for (int mm = 0; mm < MB; ++mm)
#pragma unroll
                    for (int bj = 0; bj < 2; ++bj) { const unsigned off = (unsigned)((row0 + ai * HALF + (m0 + mm) * 16) * 1024 + col0 + bj * HALF);
                        if (RIN == 0) { rw[mm][bj][0] = *(const u32x4*)((const char*)R + off * 4u); rw[mm][bj][NW - 1] = *(const u32x4*)((const char*)R + off * 4u + 16u); }
                        else rw[mm][bj][0] = *(const u32x4*)((const char*)R + off * 2u); }
                if (ssq_in) {
#pragma unroll
                    for (int mm = 0; mm < MB; ++mm) { const f32x4* p = (const f32x4*)((const char*)ssq_in + (unsigned)(row0 + ai * HALF + (m0 + mm) * 16) * 64u);
#pragma unroll
                        for (int k = 0; k < 4; ++k) pp[mm][k] = p[k]; } }
                asm volatile("" ::: "memory");
#pragma unroll
                for (int mm = 0; mm < MB; ++mm) {
                    const int m = m0 + mm, row = row0 + ai * HALF + m * 16;
                    const unsigned off = (unsigned)(row * 1024 + col0);
                    float sc2 = 1.0f;
                    if (ssq_in) { const f32x4 a = pp[mm][0], b = pp[mm][1], c = pp[mm][2], d = pp[mm][3];
                        const float sum = (((a[0] + a[1]) + (a[2] + a[3])) + ((b[0] + b[1]) + (b[2] + b[3]))) + (((c[0] + c[1]) + (c[2] + c[3])) + ((d[0] + d[1]) + (d[2] + d[3])));
                        const float rs = rsqrtf(sum * (1.0f / 1024.0f) + 1e-6f); sc2 = rs * rs; }
                    float ss = 0.f;
#pragma unroll
                    for (int bj = 0; bj < 2; ++bj) {
                        f32x4 r0, r1;
                        if (RIN == 0) { r0 = __builtin_bit_cast(f32x4, rw[mm][bj][0]); r1 = __builtin_bit_cast(f32x4, rw[mm][bj][NW - 1]); }
                        else { const u32x4 w = rw[mm][bj][0];
                            r0 = (f32x4){__uint_as_float(w.x << 16), __uint_as_float(w.x & 0xffff0000u), __uint_as_float(w.y << 16), __uint_as_float(w.y & 0xffff0000u)};
                            r1 = (f32x4){__uint_as_float(w.z << 16), __uint_as_float(w.z & 0xffff0000u), __uint_as_float(w.w << 16), __uint_as_float(w.w & 0xffff0000u)}; }
                        const f32x4 v0 = acc[ai][bj][m][0] * sc2 + r0, v1 = acc[ai][bj][m][1] * sc2 + r1;
                        if (OUT == 1) { *(f32x4*)((char*)out + (off + bj * HALF) * 4u) = v0; *(f32x4*)((char*)out + (off + bj * HALF) * 4u + 16u) = v1; }
                        else {
                            u32x4 w; w.x = cvt_pk_bf16(v0[0], v0[1]); w.y = cvt_pk_bf16(v0[2], v0[3]); w.z = cvt_pk_bf16(v1[0], v1[1]); w.w = cvt_pk_bf16(v1[2], v1[3]);
                            *(u32x4*)((char*)hb + (off + bj * HALF) * 2u) = w;
                            ss += ((v0[0] * v0[0] + v0[1] * v0[1]) + (v0[2] * v0[2] + v0[3] * v0[3])) + ((v1[0] * v1[0] + v1[1] * v1[1]) + (v1[2] * v1[2] + v1[3] * v1[3]));
                        }
                    }
                    if (OUT == 0) { ss += __shfl_xor(ss, 16); ss += __shfl_xor(ss, 32); if (fq == 0) *(float*)((char*)ssqp + (unsigned)(row * 16 + u.pn * 4 + wc) * 4u) = ss; }
                }
            }
    }
};
struct EpiQKNorm {
    static constexpr bool PERM = true, AFTER_DRAIN = false;
    bf16_t* O; int ldc; const float* ssqp; const float* gq; const float* gk; PG8_LAS float* part; float qscale;
    __device__ __forceinline__ void operator()(const f32x4 (&acc)[2][2][4][2], const Unit& u, int wr, int wc, int fr_, int fq_) const {
        const int ln = epi_lane(), fr = ln & 15, fq = ln >> 4;
        const int row0 = u.pm * BM + wr * 64 + fr, col0 = u.pn * BM + wc * 32 + 8 * fq;
        const bool nrm = u.pn < 8;
        const int pbase = (wr * 64 + fr) * 8;
        PG8_LAS float* pr = part + pbase; PG8_LAS float* pw = pr + wc;
        float rsv[2][4];
#pragma unroll
        for (int ai = 0; ai < 2; ++ai) { f32x4 pp[4][4];
#pragma unroll
            for (int m = 0; m < 4; ++m) { const f32x4* p = (const f32x4*)((const char*)ssqp + (unsigned)(row0 + ai * HALF + m * 16) * 64u);
#pragma unroll
                for (int k = 0; k < 4; ++k) pp[m][k] = p[k]; }
#pragma unroll
            for (int m = 0; m < 4; ++m) { const f32x4 a = pp[m][0], b = pp[m][1], c = pp[m][2], d = pp[m][3];
                const float sum = (((a[0] + a[1]) + (a[2] + a[3])) + ((b[0] + b[1]) + (b[2] + b[3]))) + (((c[0] + c[1]) + (c[2] + c[3])) + ((d[0] + d[1]) + (d[2] + d[3])));
                rsv[ai][m] = rsqrtf(sum * (1.0f / 1024.0f) + 1e-6f); asm volatile("" : "+v"(rsv[ai][m]) :: "memory"); } }
        f32x4 g0 = (f32x4){1.f, 1.f, 1.f, 1.f}, g1 = g0;
        if (nrm) {
#pragma unroll
            for (int ai = 0; ai < 2; ++ai)
#pragma unroll
                for (int m = 0; m < 4; ++m)
#pragma unroll
                    for (int bj = 0; bj < 2; ++bj) { const f32x4 v0 = acc[ai][bj][m][0], v1 = acc[ai][bj][m][1];
                        float ss = ((v0[0] * v0[0] + v0[1] * v0[1]) + (v0[2] * v0[2] + v0[3] * v0[3])) + ((v1[0] * v1[0] + v1[1] * v1[1]) + (v1[2] * v1[2] + v1[3] * v1[3]));
                        ss += __shfl_xor(ss, 16); ss += __shfl_xor(ss, 32);
                        if (fq == 0) pw[((ai * HALF + m * 16) * 2 + bj) * 4] = ss; }
            asm volatile("s_waitcnt lgkmcnt(0)" ::: "memory"); __builtin_amdgcn_s_barrier(); asm volatile("" ::: "memory");
            const float* gp = (u.pn < 4 ? gq : gk) + wc * 32 + 8 * fq; const float sc = (u.pn < 4) ? qscale : 1.0f;
            g0 = *(const f32x4*)gp * sc; g1 = *(const f32x4*)(gp + 4) * sc;
        }
#pragma unroll
        for (int ai = 0; ai < 2; ++ai)
#pragma unroll
            for (int m = 0; m < 4; ++m) {
                const int row = row0 + ai * HALF + m * 16;
                const float rsr = rsv[ai][m];
                bf16_t* rowp = O + (size_t)row * ldc + col0;
#pragma unroll
                for (int bj = 0; bj < 2; ++bj) {
                    float hs = rsr;
                    if (nrm) { const f32x4 pp = *(const PG8_LAS f32x4*)(pr + ((ai * HALF + m * 16) * 2 + bj) * 4);
                        hs *= rsqrtf(((pp[0] + pp[1]) + (pp[2] + pp[3])) * (rsr * rsr * (1.0f / 128.0f)) + 1e-6f); }
                    const f32x4 v0 = acc[ai][bj][m][0] * hs * g0, v1 = acc[ai][bj][m][1] * hs * g1;
                    u32x4 w; w.x = cvt_pk_bf16(v0[0], v0[1]); w.y = cvt_pk_bf16(v0[2], v0[3]); w.z = cvt_pk_bf16(v1[0], v1[1]); w.w = cvt_pk_bf16(v1[2], v1[3]);
                    *(u32x4*)(rowp + bj * HALF) = w;
                }
            }
    }
};
struct EpiProjAB {
    static constexpr bool PERM = true, AFTER_DRAIN = false;
    bf16_t* O; int ldc; const float* ssqp; const float* gq; const float* gk; const float* r128; const float* r64; PG8_LAS float* part; float qscale;
    __device__ __forceinline__ void operator()(const f32x4 (&acc)[2][2][4][2], const Unit& u, int wr, int wc, int fr_, int fq_) const {
        const int ln = epi_lane(), fr = ln & 15, fq = ln >> 4;
        const int cb = wc * 32 + 8 * fq;
        const int row0 = u.pm * BM + wr * 64 + fr, col0 = u.pn * BM + cb, pn = u.pn;
        const bool qk = pn < 4, iq = (pn == 6) || (pn == 7) || (pn == 14);
        const int pbase = (wr * 64 + fr) * 8;
        PG8_LAS float* pr = part + pbase; PG8_LAS float* pw = pr + wc;
        const bool rope_qk = qk && (wc == 0), rope_iq = iq && !(wc & 1) && (pn != 14 || wc == 0);
        float rsv[2][4];
#pragma unroll
        for (int ai = 0; ai < 2; ++ai)
#pragma unroll
            for (int m = 0; m < 4; ++m) rsv[ai][m] = *(const float*)((const char*)ssqp + (unsigned)(row0 + ai * HALF + m * 16) * 64u);
#pragma unroll
        for (int ai = 0; ai < 2; ++ai)
#pragma unroll
            for (int m = 0; m < 4; ++m) rsv[ai][m] = rsqrtf(rsv[ai][m] * (1.0f / 1024.0f) + 1e-6f);
        f32x4 g0 = (f32x4){1.f, 1.f, 1.f, 1.f}, g1 = g0;
        if (qk) {
#pragma unroll
            for (int ai = 0; ai < 2; ++ai)
#pragma unroll
                for (int m = 0; m < 4; ++m)
#pragma unroll
                    for (int bj = 0; bj < 2; ++bj) { const f32x4 v0 = acc[ai][bj][m][0], v1 = acc[ai][bj][m][1];
                        float ss = ((v0[0] * v0[0] + v0[1] * v0[1]) + (v0[2] * v0[2] + v0[3] * v0[3])) + ((v1[0] * v1[0] + v1[1] * v1[1]) + (v1[2] * v1[2] + v1[3] * v1[3]));
                        ss += __shfl_xor(ss, 16); ss += __shfl_xor(ss, 32);
                        if (fq == 0) pw[((ai * HALF + m * 16) * 2 + bj) * 4] = ss; }
            asm volatile("s_waitcnt lgkmcnt(0)" ::: "memory"); __builtin_amdgcn_s_barrier(); asm volatile("" ::: "memory");
            const float* gp = (pn < 2 ? gq : gk) + cb; const float sc = (pn < 2) ? qscale : 1.0f;
            g0 = *(const f32x4*)gp * sc; g1 = *(const f32x4*)(gp + 4) * sc;
        }
#pragma unroll
        for (int ai = 0; ai < 2; ++ai) {
            f32x4 cc[4][4];
            if (rope_qk || rope_iq) {
#pragma unroll
                for (int m = 0; m < 4; ++m) { const int pos = (row0 + ai * HALF + m * 16) & 2047;
                    const float* t = rope_qk ? (r128 + pos * 32 + 8 * (fq & 1)) : (r64 + pos * 16); const int so = rope_qk ? 16 : 8;
                    cc[m][0] = *(const f32x4*)t; cc[m][1] = *(const f32x4*)(t + 4); cc[m][2] = *(const f32x4*)(t + so); cc[m][3] = *(const f32x4*)(t + so + 4); }
            }
#pragma unroll
            for (int m = 0; m < 4; ++m) {
                const int row = row0 + ai * HALF + m * 16;
                const float rsr = rsv[ai][m];
                bf16_t* rowp = O + (size_t)row * ldc + col0;
                const f32x4 c0 = cc[m][0], c1 = cc[m][1], s0 = cc[m][2], s1 = cc[m][3];
#pragma unroll
                for (int bj = 0; bj < 2; ++bj) {
                    float hs = rsr;
                    if (qk) { const f32x4 pp = *(const PG8_LAS f32x4*)(pr + ((ai * HALF + m * 16) * 2 + bj) * 4);
                        hs *= rsqrtf(((pp[0] + pp[1]) + (pp[2] + pp[3])) * (rsr * rsr * (1.0f / 128.0f)) + 1e-6f); }
                    f32x4 v0 = acc[ai][bj][m][0] * hs * g0, v1 = acc[ai][bj][m][1] * hs * g1;
                    if (rope_qk) {
                        f32x4 p0, p1;
#pragma unroll
                        for (int e = 0; e < 4; ++e) { p0[e] = __shfl_xor(v0[e], 32); p1[e] = __shfl_xor(v1[e], 32); }
                        if (fq < 2) { v0 = v0 * c0 - p0 * s0; v1 = v1 * c1 - p1 * s1; } else { v0 = v0 * c0 + p0 * s0; v1 = v1 * c1 + p1 * s1; }
                    } else if (rope_iq && (pn != 14 || bj == 0)) {
                        f32x4 p0, p1;
#pragma unroll
                        for (int e = 0; e < 4; ++e) { p0[e] = __shfl_xor(v0[e], 16); p1[e] = __shfl_xor(v1[e], 16); }
                        if (fq == 0) { v0 = v0 * c0 - p0 * s0; v1 = v1 * c1 - p1 * s1; } else if (fq == 1) { v0 = v0 * c0 + p0 * s0; v1 = v1 * c1 + p1 * s1; }
                    }
                    u32x4 w; w.x = cvt_pk_bf16(v0[0], v0[1]); w.y = cvt_pk_bf16(v0[2], v0[3]); w.z = cvt_pk_bf16(v1[0], v1[1]); w.w = cvt_pk_bf16(v1[2], v1[3]);
                    *(u32x4*)(rowp + bj * HALF) = w;
                }
            }
        }
    }
};
template <class Epi, class Sched, bool ALIGN_EPI = false, bool SP2 = false>
__device__ __forceinline__ void gemm_phase(PG8_LAS unsigned char* lds, const Gemm g, const Sched& S, const Epi& E, const int wave_in) {
    const int wid = wave_in, lane = (int)__builtin_amdgcn_mbcnt_hi(~0u, __builtin_amdgcn_mbcnt_lo(~0u, 0u)), tid = wid * 64 + lane, wr = wid >> 2, wc = wid & 3, fr = lane & 15, fq = lane >> 4;
    const int K = g.K, nt = K / BK;
    unsigned voffA[2], voffB[2];
#pragma unroll
    for (int i = 0; i < 2; ++i) { int R, C; stage_rc(tid * 16 + i * 8192, R, C); const int Rb = Epi::PERM ? ((R & ~31) + perm32(R & 31)) : R;
        voffA[i] = (unsigned)(R * K + C) * 2u; voffB[i] = (unsigned)(Rb * K + C) * 2u; }
    const size_t kstep = (size_t)(BK * 2);
    const size_t hstep = (size_t)HALF * K * 2;
    const size_t tstep = 2 * hstep;
    const unsigned ldsw = (unsigned)wid * 1024u;
    const int aoff = lds_byte(wr * 64 + fr, fq * 8), boff = lds_byte(wc * 32 + fr, fq * 8);
#define PG8_SA(b, h) (((b) * 2 + (h)) * HTB)
#define PG8_SB(b, h) ((4 + (b) * 2 + (h)) * HTB)
#define PG8_STAGE(bufoff, gbase, voff) do { _Pragma("unroll") for (int _i = 0; _i < 2; ++_i) \
        __builtin_amdgcn_global_load_lds((const unsigned*)((const char*)(gbase) + (voff)[_i]), (PG8_LAS unsigned*)(lds + (bufoff) + ldsw + _i * 8192), 16, 0, 0); } while (0)
#define PG8_LDA(dst, b, h) do { _Pragma("unroll") for (int m = 0; m < 4; ++m) _Pragma("unroll") for (int k = 0; k < 2; ++k) dst[m][k] = *(const PG8_LAS bf16x8*)(lds + PG8_SA(b, h) + aoff + m * 2048 + k * 1024); } while (0)
#define PG8_LDB(dst, b, h) do { _Pragma("unroll") for (int n = 0; n < 2; ++n) _Pragma("unroll") for (int k = 0; k < 2; ++k) dst[n][k] = *(const PG8_LAS bf16x8*)(lds + PG8_SB(b, h) + boff + n * 2048 + k * 1024); } while (0)
#define PG8_MMA(ai, bj, At, Bt) do { __builtin_amdgcn_s_setprio(1); _Pragma("unroll") for (int m = 0; m < 4; ++m) _Pragma("unroll") for (int n = 0; n < 2; ++n) _Pragma("unroll") for (int k = 0; k < 2; ++k) \
        acc[ai][bj][m][n] = __builtin_amdgcn_mfma_f32_16x16x32_bf16(Bt[n][k], At[m][k], acc[ai][bj][m][n], 0, 0, 0); __builtin_amdgcn_s_setprio(0); } while (0)
#define PG8_WAIT_V(n) asm volatile("s_waitcnt vmcnt(" #n ")" ::: "memory")
#define PG8_WAIT_L(n) asm volatile("s_waitcnt lgkmcnt(" #n ")" ::: "memory")
#define PG8_BAR __builtin_amdgcn_s_barrier()
#define PG8_SCHED __builtin_amdgcn_sched_barrier(0)
    Unit cur, nxt; int ui = 0;
    if (!S.next(0, cur)) return;
    f32x4 acc[2][2][4][2];
#pragma unroll
    for (int a = 0; a < 2; ++a)
#pragma unroll
        for (int b = 0; b < 2; ++b)
#pragma unroll
            for (int m = 0; m < 4; ++m)
#pragma unroll
                for (int n = 0; n < 2; ++n) acc[a][b][m][n] = (f32x4){0.f, 0.f, 0.f, 0.f};
    bf16x8 At[4][2], B0[2][2], B1[2][2];
    const char* cA = (const char*)g.A + (size_t)cur.pm * tstep; const char* cB = (const char*)g.Bt + (size_t)cur.pn * tstep;
    S.a_ready(cur);
    if constexpr (SP2) {
        PG8_STAGE(PG8_SB(0, 0), cB, voffB); PG8_STAGE(PG8_SB(0, 1), cB + hstep, voffB); PG8_STAGE(PG8_SA(0, 0), cA, voffA); PG8_STAGE(PG8_SA(0, 1), cA + hstep, voffA);
        if (wr == 1) PG8_BAR;
        PG8_WAIT_V(2); PG8_BAR;
        PG8_STAGE(PG8_SB(1, 0), cB + kstep, voffB); PG8_STAGE(PG8_SA(1, 0), cA + kstep, voffA); PG8_STAGE(PG8_SB(1, 1), cB + hstep + kstep, voffB);
        PG8_WAIT_V(6); PG8_BAR;
    } else {
        PG8_STAGE(PG8_SB(0, 0), cB, voffB); PG8_STAGE(PG8_SA(0, 0), cA, voffA); PG8_STAGE(PG8_SB(0, 1), cB + hstep, voffB); PG8_STAGE(PG8_SA(0, 1), cA + hstep, voffA);
        if (wr == 1) PG8_BAR;
        PG8_WAIT_V(4); PG8_BAR;
        PG8_STAGE(PG8_SB(1, 0), cB + kstep, voffB); PG8_STAGE(PG8_SA(1, 0), cA + kstep, voffA); PG8_STAGE(PG8_SB(1, 1), cB + hstep + kstep, voffB);
        PG8_WAIT_V(6); PG8_BAR;
    }
    for (;;) {
        const bool has_next = S.next(ui + 1, nxt);
        const char* nA = has_next ? (const char*)g.A + (size_t)nxt.pm * tstep : cA; const char* nB = has_next ? (const char*)g.Bt + (size_t)nxt.pn * tstep : cB;
        for (int t = 0; t < nt; t += 2) {
            const bool last = (t == nt - 2);
            const char* a1 = cA + (size_t)(t + 1) * kstep;
            const char* a2 = last ? nA : cA + (size_t)(t + 2) * kstep; const char* b2 = last ? nB : cB + (size_t)(t + 2) * kstep;
            const char* a3 = a2 + kstep; const char* b3 = b2 + kstep;
            if (last && has_next) S.a_ready(nxt);
            if constexpr (SP2) {
            PG8_LDB(B0, 0, 0); PG8_LDB(B1, 0, 1); PG8_SCHED; PG8_LDA(At, 0, 0); PG8_STAGE(PG8_SA(1, 1), a1 + hstep, voffA);
            PG8_WAIT_V(8); PG8_WAIT_L(0); PG8_BAR; PG8_MMA(0, 0, At, B0); PG8_MMA(0, 1, At, B1); PG8_BAR; PG8_SCHED;
            PG8_LDA(At, 0, 1); PG8_STAGE(PG8_SB(0, 0), b2, voffB); PG8_STAGE(PG8_SB(0, 1), b2 + hstep, voffB); PG8_STAGE(PG8_SA(0, 0), a2, voffA);
            PG8_WAIT_V(8); PG8_WAIT_L(0); PG8_BAR; PG8_MMA(1, 0, At, B0); PG8_MMA(1, 1, At, B1); PG8_BAR; PG8_SCHED;
            PG8_LDB(B0, 1, 0); PG8_LDB(B1, 1, 1); PG8_SCHED; PG8_LDA(At, 1, 0); PG8_STAGE(PG8_SA(0, 1), a2 + hstep, voffA);
            PG8_WAIT_V(8); PG8_WAIT_L(0); PG8_BAR; PG8_MMA(0, 0, At, B0); PG8_MMA(0, 1, At, B1); PG8_BAR; PG8_SCHED;
            PG8_LDA(At, 1, 1); PG8_STAGE(PG8_SB(1, 0), b3, voffB); PG8_STAGE(PG8_SB(1, 1), b3 + hstep, voffB); PG8_STAGE(PG8_SA(1, 0), a3, voffA);
            PG8_WAIT_V(8); PG8_WAIT_L(0); PG8_BAR; PG8_MMA(1, 0, At, B0); PG8_MMA(1, 1, At, B1); PG8_BAR; PG8_SCHED;
            } else {
            PG8_LDB(B0, 0, 0); PG8_SCHED; PG8_LDA(At, 0, 0); PG8_STAGE(PG8_SA(1, 1), a1 + hstep, voffA);
            PG8_WAIT_L(8); PG8_BAR; PG8_WAIT_L(0); PG8_MMA(0, 0, At, B0); PG8_BAR; PG8_SCHED;
            PG8_LDB(B1, 0, 1); PG8_STAGE(PG8_SB(0, 0), b2, voffB);
            PG8_BAR; PG8_WAIT_L(0); PG8_MMA(0, 1, At, B1); PG8_BAR;
            PG8_LDA(At, 0, 1); PG8_STAGE(PG8_SA(0, 0), a2, voffA);
            PG8_BAR; PG8_WAIT_L(0); PG8_MMA(1, 0, At, B0); PG8_BAR; PG8_SCHED;
            PG8_STAGE(PG8_SB(0, 1), b2 + hstep, voffB);
            PG8_WAIT_V(6); PG8_BAR; PG8_MMA(1, 1, At, B1); PG8_BAR;
            PG8_LDB(B0, 1, 0); PG8_SCHED; PG8_LDA(At, 1, 0); PG8_STAGE(PG8_SA(0, 1), a2 + hstep, voffA);
            PG8_WAIT_L(8); PG8_BAR; PG8_WAIT_L(0); PG8_MMA(0, 0, At, B0); PG8_BAR; PG8_SCHED;
            PG8_LDB(B1, 1, 1); PG8_STAGE(PG8_SB(1, 0), b3, voffB);
            PG8_BAR; PG8_WAIT_L(0); PG8_MMA(0, 1, At, B1); PG8_BAR;
            PG8_LDA(At, 1, 1); PG8_STAGE(PG8_SA(1, 0), a3, voffA);
            PG8_BAR; PG8_WAIT_L(0); PG8_MMA(1, 0, At, B0); PG8_BAR; PG8_SCHED;
            PG8_STAGE(PG8_SB(1, 1), b3 + hstep, voffB);
            PG8_WAIT_V(6); PG8_BAR; PG8_MMA(1, 1, At, B1); PG8_BAR;
            }
        }
        if constexpr (ALIGN_EPI) { if (wr == 0) PG8_BAR; }
        if constexpr (!Epi::AFTER_DRAIN) { E(acc, cur, wr, wc, fr, fq); S.done(cur); }
        if (!has_next) break;
#pragma unroll
        for (int a = 0; a < 2; ++a)
#pragma unroll
            for (int b = 0; b < 2; ++b)
#pragma unroll
                for (int m = 0; m < 4; ++m)
#pragma unroll
                    for (int n = 0; n < 2; ++n) acc[a][b][m][n] = (f32x4){0.f, 0.f, 0.f, 0.f};
        cur = nxt; cA = nA; cB = nB; ++ui;
        if constexpr (ALIGN_EPI) { if (wr == 1) PG8_BAR; }
    }
    PG8_WAIT_V(0);
    if constexpr (!ALIGN_EPI) { if (wr == 0) PG8_BAR; }
    PG8_BAR;
    if constexpr (Epi::AFTER_DRAIN) { E.fused(acc, cur, wr, wc, fr, fq, lds, wid, lane); S.done(cur); }
#undef PG8_SA
#undef PG8_SB
#undef PG8_STAGE
#undef PG8_LDA
#undef PG8_LDB
#undef PG8_MMA
#undef PG8_WAIT_V
#undef PG8_WAIT_L
#undef PG8_BAR
#undef PG8_SCHED
}
}
#include <cmath>
constexpr int NWAVES = 8, NTHR = 512;
constexpr int BATCH = 16, SEQ = 2048, M = BATCH * SEQ, D = 1024, FF = 4096, NAB = 3840, NC = 3072, ABP_OLD = 3672;
constexpr int C_QA = 0, C_KA = 512, C_VA = 1024, C_IQ = 1536, C_QB = 2048, C_KB = 2304, C_VB = 2560, C_OG = 3072, C_IK = 3584, C_IW = 3648, C_GL = 3656;
constexpr float EPS = 1e-6f;
constexpr size_t MiB = 1u << 20;
constexpr size_t WS_CTL = 0, CTL_ZERO_BYTES = 64 * 1024;
constexpr size_t WS_WAB = 1 * MiB, WS_WOAB = 9 * MiB, WS_WUP0 = 11 * MiB, WS_WDN0 = 19 * MiB, WS_WINC = 27 * MiB, WS_WOC = 33 * MiB, WS_WUP1 = 35 * MiB, WS_WDN1 = 43 * MiB;
constexpr size_t WS_SSQ = 51 * MiB, SSQ_BYTES = 2 * MiB;
constexpr size_t WS_DEC = 59 * MiB;
constexpr size_t WS_ROPE = 59 * MiB + 512 * 1024;
constexpr size_t WS_XB = 60 * MiB;
constexpr size_t WS_CAT = 124 * MiB;
constexpr size_t WS_MASK = 188 * MiB;
constexpr size_t WS_R1 = 196 * MiB;
constexpr size_t WS_BC = 452 * MiB;
constexpr size_t WS_END = 484 * MiB;
constexpr int CW_BAR = 4096;
constexpr int RING_BYTES = 131072;
constexpr int LDS_BYTES = 163840;
constexpr int MISC_OFF = LDS_BYTES - 256;
#define GAS __attribute__((address_space(1)))
#define LAS __attribute__((address_space(3)))
typedef unsigned short bf16;
typedef unsigned v4u __attribute__((ext_vector_type(4)));
typedef float f32x4 __attribute__((ext_vector_type(4)));
typedef short bf16x8 __attribute__((ext_vector_type(8)));
typedef GAS unsigned gu32;
typedef GAS unsigned long long gu64;
#define RLX_AGENT __ATOMIC_RELAXED, __HIP_MEMORY_SCOPE_AGENT
#define LDS_WAIT() asm volatile("s_waitcnt lgkmcnt(0)" ::: "memory")
#define VM_WAIT() asm volatile("s_waitcnt vmcnt(0)" ::: "memory")
__device__ __forceinline__ unsigned long long rt() { return __builtin_amdgcn_s_memrealtime(); }
__device__ __forceinline__ unsigned f2bf(float f) { unsigned u = __builtin_bit_cast(unsigned, f); return (u + 0x7fffu + ((u >> 16) & 1u)) >> 16; }
__device__ __forceinline__ unsigned pk2(float lo, float hi) { return f2bf(lo) | (f2bf(hi) << 16); }
#define XB_TMO      128
#define XB_XCNT(j)  (256  + 64 * (j))
#define XB_XSUB(j)  (1280 + 64 * (j))
#define XB_XGEN(j)  (2304 + 64 * (j))
#define XB_TOP      3328
#define XB_TOPGEN   3392
#define XCD_BAR_WORDS 3456
#define XB_SPIN_CAP (1u << 18)

__device__ __forceinline__ unsigned xb_ld(unsigned* p)              { return __hip_atomic_load(p, __ATOMIC_RELAXED, __HIP_MEMORY_SCOPE_AGENT); }
__device__ __forceinline__ unsigned xb_add(unsigned* p, unsigned v) { return __hip_atomic_fetch_add(p, v, __ATOMIC_RELAXED, __HIP_MEMORY_SCOPE_AGENT); }
__device__ __forceinline__ unsigned xb_xcc_id() { return (unsigned)__builtin_amdgcn_s_getreg((3 << 11) | 20) & 0xFu; }
#define XB_SPIN(cond, bar) do { unsigned _sp = 0; while (cond) { __builtin_amdgcn_s_sleep(1); \
    if ((++_sp & 255u) == 0u) { if (xb_ld(&(bar)[XB_TMO])) break; if (_sp > XB_SPIN_CAP) { atomicAdd(&(bar)[XB_TMO], 1u); break; } } } } while (0)

struct XcdBarrier {
    unsigned* bar; unsigned x; int wave;
    volatile LAS unsigned* st;
};

__device__ __forceinline__ bool xb_t0(int wave) { return wave == 0 && __builtin_amdgcn_mbcnt_hi(~0u, __builtin_amdgcn_mbcnt_lo(~0u, 0u)) == 0u; }
__device__ __forceinline__ XcdBarrier xcd_barrier_post(unsigned* bar, volatile LAS unsigned* st, int wave) {
    XcdBarrier b; b.bar = bar; b.x = xb_xcc_id(); b.st = st; b.wave = wave;
    if (xb_t0(wave)) (void)xb_add(&bar[XB_XCNT(b.x)], 1u);
    return b;
}
__device__ __forceinline__ void xcd_barrier_complete(unsigned* bar, unsigned x, unsigned& nloc, unsigned& nx) {
    const unsigned G = gridDim.x * gridDim.y * gridDim.z;
    unsigned sum, cnt, mine, sp = 0u;
    for (;;) {
        sum = 0u; cnt = 0u; mine = 0u;
#pragma unroll
        for (unsigned j = 0; j < 16; ++j) { const unsigned c = xb_ld(&bar[XB_XCNT(j)]); sum += c; cnt += (c > 0u) ? 1u : 0u; mine = (j == x) ? c : mine; }
        if (sum == G) break;
        __builtin_amdgcn_s_sleep(1);
        if ((++sp & 255u) == 0u) { if (xb_ld(&bar[XB_TMO])) break; if (sp > XB_SPIN_CAP) { atomicAdd(&bar[XB_TMO], 1u); break; } }
    }
    nloc = mine > 0u ? mine : 1u; nx = cnt > 0u ? cnt : 1u;
}

__device__ __forceinline__ void xcd_barrier(const XcdBarrier& b) {
    asm volatile("s_waitcnt vmcnt(0)" ::: "memory");
    __syncthreads();
    if (xb_t0(b.wave)) {
        unsigned* bar = b.bar;
        __builtin_amdgcn_s_waitcnt(0);
        unsigned nloc = b.st[0], nx = b.st[1];
        if (nloc == 0u) { xcd_barrier_complete(bar, b.x, nloc, nx); b.st[0] = nloc; b.st[1] = nx; }
        const unsigned old = xb_add(&bar[XB_XSUB(b.x)], 1u);
        const unsigned gen = old / nloc;
        if (old + 1u == (gen + 1u) * nloc) {
            __builtin_amdgcn_fence(__ATOMIC_RELEASE, "agent");
            asm volatile("s_waitcnt vmcnt(0)" ::: "memory");
            const unsigned og = xb_add(&bar[XB_TOP], 1u);
            const unsigned tg = og / nx;
            if (og + 1u == (tg + 1u) * nx) xb_add(&bar[XB_TOPGEN], 1u);
            else XB_SPIN(xb_ld(&bar[XB_TOPGEN]) == tg, bar);
            __builtin_amdgcn_fence(__ATOMIC_ACQUIRE, "agent");
            xb_add(&bar[XB_XGEN(b.x)], 1u);
            asm volatile("s_waitcnt vmcnt(0)" ::: "memory");
        } else {
            XB_SPIN(xb_ld(&bar[XB_XGEN(b.x)]) == gen, bar);
            __builtin_amdgcn_fence(__ATOMIC_ACQUIRE, "agent");
            asm volatile("s_waitcnt vmcnt(0)" ::: "memory");
        }
    }
    __syncthreads();
}
#ifdef PROBE_ACC
#ifdef PROBE_NOSYNC
#define ACC_BEGIN(F, id) do { if ((id) == PROBE_ACC) { asm volatile("" ::: "memory"); (F).acc_t0 = __builtin_amdgcn_s_memrealtime(); asm volatile("" ::: "memory"); } } while (0)
#define ACC_END(F, id) do { if ((id) == PROBE_ACC) { asm volatile("" ::: "memory"); (F).acc_sum += __builtin_amdgcn_s_memrealtime() - (F).acc_t0; asm volatile("" ::: "memory"); } } while (0)
#else
#define ACC_BEGIN(F, id) do { if ((id) == PROBE_ACC) { __syncthreads(); (F).acc_t0 = __builtin_amdgcn_s_memrealtime(); } } while (0)
#define ACC_END(F, id) do { if ((id) == PROBE_ACC) { __syncthreads(); (F).acc_sum += __builtin_amdgcn_s_memrealtime() - (F).acc_t0; } } while (0)
#endif
#else
#define ACC_BEGIN(F, id) do { } while (0)
#define ACC_END(F, id) do { } while (0)
#endif
struct Frame {
#ifdef PROBE_ACC
    unsigned long long acc_t0, acc_sum;
#endif
    LAS unsigned char* lds;
    volatile LAS unsigned* MISC;
    gu32* ctl;
    int tid, lane, wave, vcu, G;
    const float *x, *g_mix, *g_ffn, *w_in_ab, *gq_a, *gk_a, *w_gate_up, *b_gate, *g_gla, *w_out_ab, *w_in_c, *gq_c, *gk_c, *w_out_c, *w_up, *w_down;
    float* out;
    bf16 *Wab, *Woab, *Wup0, *Wdn0, *Winc, *Woc, *Wup1, *Wdn1;
    bf16 *XB, *CAT, *R1;
    float* SSQ; unsigned* MASK;
};
__device__ __forceinline__ int lane_id_opaque() { int l; asm volatile("v_mbcnt_lo_u32_b32 %0, -1, 0\n\tv_mbcnt_hi_u32_b32 %0, -1, %0" : "=v"(l)); return l; }
__device__ __forceinline__ float bf2f(bf16 v) { return __builtin_bit_cast(float, (unsigned)v << 16); }
__device__ __forceinline__ float wave_sum(float v) {
#pragma unroll
    for (int o = 1; o < 64; o <<= 1) v += __shfl_xor(v, o);
    return v;
}
__device__ __forceinline__ float wave_max(float v) {
#pragma unroll
    for (int o = 1; o < 64; o <<= 1) v = fmaxf(v, __shfl_xor(v, o));
    return v;
}
__device__ __forceinline__ float log_sigmoid(float x) { return fminf(x, 0.f) - log1pf(expf(-fabsf(x))); }

__device__ __forceinline__ int oldcol_ab(int n) {
    if (n < 2048) return n;
    if (n < 2304) return 2120 + (n - 2048);
    if (n < 2560) return 2376 + (n - 2304);
    if (n < 3072) return 2632 + (n - 2560);
    if (n < 3584) return 3160 + (n - 3072);
    if (n < 3648) return 2048 + (n - 3584);
    if (n < 3656) return 2112 + (n - 3648);
    if (n < 3672) return 3144 + (n - 3656);
    return -1;
}
__device__ __forceinline__ void p0_transpose_item(const float* W, int ldw, int K, const float* gain, bf16* WT, bool map, int item, int nblk, int lane) {
    const int kb = item / nblk, nb = item % nblk, ng = lane & 7, ko = lane >> 3, k0 = 64 * kb + 8 * ko, n = 32 * nb + 4 * ng;
    const int oc = map ? oldcol_ab(n) : n;
    f32x4 v[8];
#pragma unroll
    for (int i = 0; i < 8; ++i) { v[i] = (f32x4){0.f, 0.f, 0.f, 0.f}; if (oc >= 0) v[i] = *(const GAS f32x4*)(W + (size_t)(k0 + i) * ldw + oc); }
    if (gain) { const f32x4 g0 = *(const GAS f32x4*)(gain + k0), g1 = *(const GAS f32x4*)(gain + k0 + 4);
#pragma unroll
        for (int i = 0; i < 4; ++i) { v[i] = v[i] * g0[i]; v[4 + i] = v[4 + i] * g1[i]; } }
#pragma unroll
    for (int e = 0; e < 4; ++e) { v4u o; o.x = pk2(v[0][e], v[1][e]); o.y = pk2(v[2][e], v[3][e]); o.z = pk2(v[4][e], v[5][e]); o.w = pk2(v[6][e], v[7][e]);
        *(GAS v4u*)(WT + (size_t)(n + e) * K + k0) = o; }
}
template <int PART> __device__ __forceinline__ void prologue_weights(Frame& F, int gw, int NGW) {
    constexpr int I_AB = (D / 64) * (NAB / 32), I_O = (D / 64) * (D / 32), I_UP = (D / 64) * (FF / 32), I_DN = (FF / 64) * (D / 32), I_C = (D / 64) * (NC / 32);
    if (PART == 0) { for (int it = gw; it < I_AB; it += NGW) p0_transpose_item(F.w_in_ab, ABP_OLD, D, F.g_mix, F.Wab, true, it, NAB / 32, F.lane); return; }
    constexpr int NITEMS = 2 * I_O + 2 * I_UP + 2 * I_DN + I_C;
    for (int it = gw; it < NITEMS; it += NGW) {
        int r = it;
        if (r < I_O) { p0_transpose_item(F.w_out_ab, D, D, nullptr, F.Woab, false, r, D / 32, F.lane); continue; } r -= I_O;
        if (r < I_UP) { p0_transpose_item(F.w_up, FF, D, F.g_ffn, F.Wup0, false, r, FF / 32, F.lane); continue; } r -= I_UP;
        if (r < I_DN) { p0_transpose_item(F.w_down, D, FF, nullptr, F.Wdn0, false, r, D / 32, F.lane); continue; } r -= I_DN;
        if (r < I_C) { p0_transpose_item(F.w_in_c, NC, D, F.g_mix + D, F.Winc, false, r, NC / 32, F.lane); continue; } r -= I_C;
        if (r < I_O) { p0_transpose_item(F.w_out_c, D, D, nullptr, F.Woc, false, r, D / 32, F.lane); continue; } r -= I_O;
        if (r < I_UP) { p0_transpose_item(F.w_up + (size_t)D * FF, FF, D, F.g_ffn + D, F.Wup1, false, r, FF / 32, F.lane); continue; } r -= I_UP;
        p0_transpose_item(F.w_down + (size_t)FF * D, D, FF, nullptr, F.Wdn1, false, r, D / 32, F.lane);
    }
}
__device__ __forceinline__ void ph_prologue(Frame& F) {
    const int gw = F.vcu * NWAVES + F.wave, NGW = F.G * NWAVES;
    prologue_weights<0>(F, gw, NGW);
    if (F.G != 256) prologue_weights<1>(F, gw, NGW);
    for (int m0 = gw; m0 < M; m0 += 4 * NGW) {
        f32x4 v[4][4]; float s[4];
#pragma unroll
        for (int r = 0; r < 4; ++r) { const int m = m0 + r * NGW; const GAS f32x4* xr = (const GAS f32x4*)(F.x + (size_t)(m < M ? m : m0) * D) + F.lane;
#pragma unroll
            for (int j = 0; j < 4; ++j) v[r][j] = xr[64 * j]; }
#pragma unroll
        for (int r = 0; r < 4; ++r) { float t = 0.f;
#pragma unroll
            for (int j = 0; j < 4; ++j) t += (v[r][j].x * v[r][j].x + v[r][j].y * v[r][j].y) + (v[r][j].z * v[r][j].z + v[r][j].w * v[r][j].w);
            s[r] = t; }
#pragma unroll
        for (int o = 1; o < 64; o <<= 1) {
#pragma unroll
            for (int r = 0; r < 4; ++r) s[r] += __shfl_xor(s[r], o); }
#pragma unroll
        for (int r = 0; r < 4; ++r) { const int m = m0 + r * NGW; if (m < M) {
            GAS unsigned long long* o8 = (GAS unsigned long long*)(F.XB + (size_t)m * D) + F.lane;
#pragma unroll
            for (int j = 0; j < 4; ++j) o8[64 * j] = (unsigned long long)pk2(v[r][j].x, v[r][j].y) | ((unsigned long long)pk2(v[r][j].z, v[r][j].w) << 32);
            if (F.lane < 16) F.SSQ[(size_t)m * 16 + F.lane] = (F.lane == 0) ? s[r] : 0.f; } }
    }
}
namespace att {
typedef short s16x4 __attribute__((ext_vector_type(4)));
typedef float f32x16 __attribute__((ext_vector_type(16)));
typedef _Float16 f16x8 __attribute__((ext_vector_type(8)));
typedef unsigned u32x4 __attribute__((ext_vector_type(4)));
typedef short v4i16_t __attribute__((ext_vector_type(4)));
constexpr float C2 = 0.08838834764831845f * 1.4426950408889634f;
__device__ __forceinline__ int crow(int r, int hi) { return (r & 3) + 8 * (r >> 2) + 4 * hi; }
__device__ __forceinline__ int img_off(int row, int ch) { return 256 * row + 16 * (ch ^ (((row & 3) << 2) | ((row >> 2) & 3))); }
__device__ __forceinline__ bf16x8 pack8(float a0, float a1, float a2, float a3, float a4, float a5, float a6, float a7) {
    u32x4 w; w.x = pg8::cvt_pk_bf16(a0, a1); w.y = pg8::cvt_pk_bf16(a2, a3); w.z = pg8::cvt_pk_bf16(a4, a5); w.w = pg8::cvt_pk_bf16(a6, a7);
    return __builtin_bit_cast(bf16x8, w);
}
__device__ __forceinline__ f16x8 pack8h(float a0, float a1, float a2, float a3, float a4, float a5, float a6, float a7) {
    f16x8 r; r[0] = (_Float16)a0; r[1] = (_Float16)a1; r[2] = (_Float16)a2; r[3] = (_Float16)a3; r[4] = (_Float16)a4; r[5] = (_Float16)a5; r[6] = (_Float16)a6; r[7] = (_Float16)a7; return r;
}
__device__ __forceinline__ void dma_off_init(unsigned (&dvo)[2], int ld, int wave, int lane) {
#pragma unroll
    for (int i = 0; i < 2; ++i) { const int pi = 2 * wave + i, row = 4 * pi + (lane >> 4), pc = lane & 15, ch = pc ^ (((row & 3) << 2) | ((row >> 2) & 3)); dvo[i] = (unsigned)(row * ld + ch * 8) * 2u; }
}
__device__ __forceinline__ void tile_dma(const bf16* g, const unsigned (&dvo)[2], LAS unsigned char* buf, int wave) {
#pragma unroll
    for (int i = 0; i < 2; ++i) __builtin_amdgcn_global_load_lds((const unsigned*)((const char*)g + dvo[i]), (LAS unsigned*)(buf + 1024 * (2 * wave + i)), 16, 0, 0);
}
struct FragOff { int k[8]; int va[4]; int vd; };
__device__ __forceinline__ void frag_off_init(FragOff& fo, int lane) {
    const int hi = lane >> 5, r32 = lane & 31, i = lane & 15, q = i >> 2, p = i & 3, x = 2 * ((lane >> 4) & 1) + (p >> 1);
#pragma unroll
    for (int ks = 0; ks < 8; ++ks) fo.k[ks] = img_off(r32, 2 * ks + hi);
#pragma unroll
    for (int ct = 0; ct < 4; ++ct) fo.va[ct] = img_off(4 * hi + q, 4 * ct + x) + 8 * (p & 1);
    fo.vd = img_off(4 * hi + q + 8, x) - img_off(4 * hi + q, x);
}
__device__ __forceinline__ bf16x8 k_frag(const LAS unsigned char* kbuf, const FragOff& fo, int rt, int ks) { return *(const LAS bf16x8*)(kbuf + fo.k[ks] + 8192 * rt); }
__device__ __forceinline__ s16x4 vtr(const LAS unsigned char* p) { return __builtin_bit_cast(s16x4, __builtin_amdgcn_ds_read_tr16_b64_v4i16((LAS v4i16_t*)p)); }
__device__ __forceinline__ bf16x8 v_frag(const LAS unsigned char* vbuf, const FragOff& fo, int ct, int kk) {
    const s16x4 lo = vtr(vbuf + fo.va[ct] + 4096 * kk), hh = vtr(vbuf + fo.va[ct] + fo.vd + 4096 * kk);
    return (bf16x8){lo[0], lo[1], lo[2], lo[3], hh[0], hh[1], hh[2], hh[3]};
}
#define TR_READ(dst, addr, OFF) asm volatile("ds_read_b64_tr_b16 %0, %1 offset:%c2" : "=&v"(dst) : "v"(addr), "i"(OFF) : "memory")
#define LGKM_WAIT0() do { asm volatile("s_waitcnt lgkmcnt(0)" ::: "memory"); __builtin_amdgcn_sched_barrier(0); } while (0)
__device__ __forceinline__ bf16x8 mk_frag(s16x4 lo, s16x4 hh) { return (bf16x8){lo[0], lo[1], lo[2], lo[3], hh[0], hh[1], hh[2], hh[3]}; }
__device__ __forceinline__ int frag_va(int lane, int ct) { const int hi = lane >> 5, i = lane & 15, q = i >> 2, p = i & 3, x = 2 * ((lane >> 4) & 1) + (p >> 1); return img_off(4 * hi + q, 4 * ct + x) + 8 * (p & 1); }
__device__ __forceinline__ bf16x8 v_frag_rt(const LAS unsigned char* vbuf, int va, int vd, int kk) {
    const s16x4 lo = vtr(vbuf + va + 4096 * kk), hh = vtr(vbuf + va + vd + 4096 * kk);
    return (bf16x8){lo[0], lo[1], lo[2], lo[3], hh[0], hh[1], hh[2], hh[3]};
}
__device__ __forceinline__ void store_o(const f32x16 (&o)[4], const float (&rscale)[16], LAS unsigned char* stg, bf16* dst, int ld, int lane) {
    const int hi = lane >> 5, r32 = lane & 31;
#pragma unroll
    for (int r = 0; r < 16; ++r) { const int orow = crow(r, hi);
#pragma unroll
        for (int ct = 0; ct < 4; ++ct) *(LAS bf16*)(stg + orow * 256 + (32 * ct + r32) * 2) = (bf16)f2bf(o[ct][r] * rscale[r]); }
    asm volatile("s_waitcnt lgkmcnt(0)" ::: "memory");
#pragma unroll
    for (int i = 0; i < 8; ++i) { const int c = lane + 64 * i, row = c >> 4, ch = c & 15; const u32x4 v = *(const LAS u32x4*)(stg + row * 256 + ch * 16); *(u32x4*)(dst + (size_t)row * ld + ch * 8) = v; }
}
}
__device__ __forceinline__ void sb_unit(Frame& F, int b, int h, int qb) {
    using namespace att;
    const int tid = F.tid, lane = F.lane, w = F.wave, hi = lane >> 5, r32 = lane & 31;
    const bf16* Qg = F.R1 + (size_t)b * SEQ * NC + h * 128; const bf16* Kg = Qg + 1024; const bf16* Vg = Qg + 2048;
    const int T0 = qb * 256, t0w = T0 + 32 * w, jd = t0w >> 6, jtop = (T0 >> 6) + 3, tl = 32 * (w & 1) + r32, tl4 = tl - 4 * hi;
    LAS unsigned char* lds = F.lds;
    FragOff fo; frag_off_init(fo, lane);
    unsigned dvo[2]; dma_off_init(dvo, NC, w, lane);
    bf16x8 qf[8];
#pragma unroll
    for (int ks = 0; ks < 8; ++ks) qf[ks] = *(const bf16x8*)(Qg + (size_t)(t0w + r32) * NC + 16 * ks + 8 * hi);
    f16x8 T0f, T1f, ONEf;
#pragma unroll
    for (int j = 0; j < 8; ++j) { const int kp = 8 * (j >> 2) + 4 * hi + (j & 3); T0f[j] = (kp >= r32) ? (_Float16)1.0f : (_Float16)0.0f; T1f[j] = (kp + 16 >= r32) ? (_Float16)1.0f : (_Float16)0.0f; ONEf[j] = (_Float16)1.0f; }
    f32x16 o[4];
#pragma unroll
    for (int ct = 0; ct < 4; ++ct)
#pragma unroll
        for (int r = 0; r < 16; ++r) o[ct][r] = 0.f;
    float R2 = 0.f; bool done = false;
    volatile LAS unsigned* flags = F.MISC + 16;
    tile_dma(Kg + (size_t)(64 * jtop) * NC, dvo, lds, w); tile_dma(Vg + (size_t)(64 * jtop) * NC, dvo, lds + 16384, w);
    asm volatile("s_waitcnt vmcnt(0)" ::: "memory");
    __syncthreads();
    for (int j = jtop; j >= 0; --j) {
        const int cur = (jtop - j) & 1;
        const LAS unsigned char* kb = lds + cur * 32768; const LAS unsigned char* vb = kb + 16384;
        if (j > 0) { tile_dma(Kg + (size_t)(64 * (j - 1)) * NC, dvo, lds + (cur ^ 1) * 32768, w); tile_dma(Vg + (size_t)(64 * (j - 1)) * NC, dvo, lds + (cur ^ 1) * 32768 + 16384, w); }
        if (j <= jd && !done) {
            f32x16 p0, p1;
#pragma unroll
            for (int r = 0; r < 16; ++r) { p0[r] = 0.f; p1[r] = 0.f; }
            { bf16x8 kf[8];
#pragma unroll
              for (int ks = 0; ks < 8; ++ks) kf[ks] = k_frag(kb, fo, 0, ks);
#pragma unroll
              for (int ks = 0; ks < 8; ++ks) p0 = __builtin_amdgcn_mfma_f32_32x32x16_bf16(kf[ks], qf[ks], p0, 0, 0, 0);
#pragma unroll
              for (int ks = 0; ks < 8; ++ks) kf[ks] = k_frag(kb, fo, 1, ks);
#pragma unroll
              for (int ks = 0; ks < 8; ++ks) p1 = __builtin_amdgcn_mfma_f32_32x32x16_bf16(kf[ks], qf[ks], p1, 0, 0, 0); }
            s16x4 vl[4], vh[4], wl[4], wh[4];
            unsigned va0[4], va1[4];
#pragma unroll
            for (int ct = 0; ct < 4; ++ct) { va0[ct] = (unsigned)(size_t)vb + (unsigned)fo.va[ct]; va1[ct] = va0[ct] + (unsigned)fo.vd; }
            const bool diag = (j == jd);
            float x0[16], x1[16]; float rs = 0.f;
#pragma unroll
            for (int r = 0; r < 16; ++r) { const int key = (r & 3) + 8 * (r >> 2);
                float l0 = -__builtin_amdgcn_logf(1.0f + __builtin_amdgcn_exp2f(p0[r])), l1 = -__builtin_amdgcn_logf(1.0f + __builtin_amdgcn_exp2f(p1[r]));
                if (diag) { if (!(key < tl4)) l0 = 0.f; if (!(key + 32 < tl4)) l1 = 0.f; }
                x0[r] = l0; x1[r] = l1; rs += l0 + l1; p0[r] += R2; p1[r] += R2; }
            const f16x8 xb00 = pack8h(x0[0], x0[1], x0[2], x0[3], x0[4], x0[5], x0[6], x0[7]), xb01 = pack8h(x0[8], x0[9], x0[10], x0[11], x0[12], x0[13], x0[14], x0[15]);
            const f16x8 xb10 = pack8h(x1[0], x1[1], x1[2], x1[3], x1[4], x1[5], x1[6], x1[7]), xb11 = pack8h(x1[8], x1[9], x1[10], x1[11], x1[12], x1[13], x1[14], x1[15]);
            p0 = __builtin_amdgcn_mfma_f32_32x32x16_f16(T0f, xb00, p0, 0, 0, 0); p0 = __builtin_amdgcn_mfma_f32_32x32x16_f16(T1f, xb01, p0, 0, 0, 0);
            p0 = __builtin_amdgcn_mfma_f32_32x32x16_f16(ONEf, xb10, p0, 0, 0, 0); p0 = __builtin_amdgcn_mfma_f32_32x32x16_f16(ONEf, xb11, p0, 0, 0, 0);
            p1 = __builtin_amdgcn_mfma_f32_32x32x16_f16(T0f, xb10, p1, 0, 0, 0); p1 = __builtin_amdgcn_mfma_f32_32x32x16_f16(T1f, xb11, p1, 0, 0, 0);
#pragma unroll
            for (int r = 0; r < 16; ++r) { const int key = (r & 3) + 8 * (r >> 2);
                float a0 = __builtin_amdgcn_exp2f(p0[r]), a1 = __builtin_amdgcn_exp2f(p1[r]);
                if (diag) { if (!(key < tl4)) a0 = 0.f; if (!(key + 32 < tl4)) a1 = 0.f; }
                p0[r] = a0; p1[r] = a1; }
            const bf16x8 pa0 = pack8(p0[0], p0[1], p0[2], p0[3], p0[4], p0[5], p0[6], p0[7]), pa1 = pack8(p0[8], p0[9], p0[10], p0[11], p0[12], p0[13], p0[14], p0[15]);
            const bf16x8 pa2 = pack8(p1[0], p1[1], p1[2], p1[3], p1[4], p1[5], p1[6], p1[7]), pa3 = pack8(p1[8], p1[9], p1[10], p1[11], p1[12], p1[13], p1[14], p1[15]);
#pragma unroll
            for (int ct = 0; ct < 4; ++ct) { TR_READ(vl[ct], va0[ct], 0); TR_READ(vh[ct], va1[ct], 0); }
            LGKM_WAIT0();
#pragma unroll
            for (int ct = 0; ct < 4; ++ct) { TR_READ(wl[ct], va0[ct], 4096); TR_READ(wh[ct], va1[ct], 4096); }
#pragma unroll
            for (int ct = 0; ct < 4; ++ct) o[ct] = __builtin_amdgcn_mfma_f32_32x32x16_bf16(pa0, mk_frag(vl[ct], vh[ct]), o[ct], 0, 0, 0);
            LGKM_WAIT0();
#pragma unroll
            for (int ct = 0; ct < 4; ++ct) { TR_READ(vl[ct], va0[ct], 8192); TR_READ(vh[ct], va1[ct], 8192); }
#pragma unroll
            for (int ct = 0; ct < 4; ++ct) o[ct] = __builtin_amdgcn_mfma_f32_32x32x16_bf16(pa1, mk_frag(wl[ct], wh[ct]), o[ct], 0, 0, 0);
            LGKM_WAIT0();
#pragma unroll
            for (int ct = 0; ct < 4; ++ct) { TR_READ(wl[ct], va0[ct], 12288); TR_READ(wh[ct], va1[ct], 12288); }
#pragma unroll
            for (int ct = 0; ct < 4; ++ct) o[ct] = __builtin_amdgcn_mfma_f32_32x32x16_bf16(pa2, mk_frag(vl[ct], vh[ct]), o[ct], 0, 0, 0);
            LGKM_WAIT0();
#pragma unroll
            for (int ct = 0; ct < 4; ++ct) o[ct] = __builtin_amdgcn_mfma_f32_32x32x16_bf16(pa3, mk_frag(wl[ct], wh[ct]), o[ct], 0, 0, 0);
            rs += __shfl_xor(rs, 32);
            R2 += rs;
            done = __all(R2 < -152.0f);
        }
        if (lane == 0) flags[cur * 8 + w] = done ? 1u : 0u;
        asm volatile("s_waitcnt vmcnt(0) lgkmcnt(0)" ::: "memory");
        __syncthreads();
        unsigned alld = 1u;
#pragma unroll
        for (int i = 0; i < 8; ++i) alld &= flags[cur * 8 + i];
        if (alld) break;
    }
    float ones[16];
#pragma unroll
    for (int r = 0; r < 16; ++r) ones[r] = 1.0f;
    store_o(o, ones, lds + w * 8192, F.CAT + (size_t)(b * SEQ + t0w) * D + h * 128, D, lane);
    __syncthreads();
}
__device__ __forceinline__ void ph_sb(Frame& F) {
    for (int v = F.vcu; v < BATCH * 8 * 2; v += F.G) {
        const int bh = v >> 1, half = v & 1;
#pragma unroll 1
        for (int i = 0; i < 4; ++i) { const int qb = half ? (i == 0 ? 1 : i == 1 ? 6 : i == 2 ? 2 : 5) : (i == 0 ? 0 : i == 1 ? 7 : i == 2 ? 3 : 4); sb_unit(F, bh >> 3, bh & 7, qb); }
    }
}
__device__ __forceinline__ void dsa_unit(Frame& F, int b, int h, int ub, float mref) {
    using namespace att;
    const int lane = F.lane, w = F.wave, hi = lane >> 5, r32 = lane & 31;
    const bf16* Qg = F.R1 + (size_t)b * SEQ * NAB + C_QA + h * 128; const bf16* Kg = F.R1 + (size_t)b * SEQ * NAB + C_KA + h * 128; const bf16* Vg = F.R1 + (size_t)b * SEQ * NAB + C_VA + h * 128;
    const int t0w = 256 * ub + 32 * w, cw = t0w >> 6, jlast = 4 * ub + 3;
    LAS unsigned char* lds = F.lds;
    LAS unsigned char* mst = lds + 65536 + w * 8448;
    FragOff fo; frag_off_init(fo, lane);
    unsigned dvo[2]; dma_off_init(dvo, NAB, w, lane);
    tile_dma(Kg, dvo, lds, w); tile_dma(Vg, dvo, lds + 16384, w);
    bf16x8 qf[8];
#pragma unroll
    for (int ks = 0; ks < 8; ++ks) qf[ks] = *(const bf16x8*)(Qg + (size_t)(t0w + r32) * NAB + 16 * ks + 8 * hi);
    { const unsigned* mg = F.MASK + (size_t)(b * SEQ + t0w) * 64;
#pragma unroll 2
      for (int i = 0; i < 8; ++i) { const int c = lane + 64 * i, row = c >> 4, c4 = c & 15; const u32x4 v = *(const u32x4*)(mg + row * 64 + c4 * 4);
          *(LAS unsigned long long*)(mst + row * 264 + c4 * 16) = (unsigned long long)v.x | ((unsigned long long)v.y << 32);
          *(LAS unsigned long long*)(mst + row * 264 + c4 * 16 + 8) = (unsigned long long)v.z | ((unsigned long long)v.w << 32); } }
    f32x16 o[4];
#pragma unroll
    for (int ct = 0; ct < 4; ++ct)
#pragma unroll
        for (int r = 0; r < 16; ++r) o[ct][r] = 0.f;
    float lsum = 0.f;
    asm volatile("s_waitcnt vmcnt(0) lgkmcnt(0)" ::: "memory");
    __syncthreads();
    for (int j = 0; j <= jlast; ++j) {
        const int cur = j & 1;
        const LAS unsigned char* kb = lds + cur * 32768; const LAS unsigned char* vb = kb + 16384;
        if (j < jlast) { tile_dma(Kg + (size_t)(64 * (j + 1)) * NAB, dvo, lds + (cur ^ 1) * 32768, w); tile_dma(Vg + (size_t)(64 * (j + 1)) * NAB, dvo, lds + (cur ^ 1) * 32768 + 16384, w); }
        if (j <= cw) {
            const unsigned long long mw = *(const LAS unsigned long long*)(mst + r32 * 264 + j * 8);
            const unsigned mw0 = (unsigned)mw, mw1 = (unsigned)(mw >> 32);
#pragma unroll 1
            for (int half = 0; half < 2; ++half) {
                const unsigned mwh = (half ? mw1 : mw0) >> (4 * hi);
                bf16x8 kf[8];
#pragma unroll
                for (int ks = 0; ks < 8; ++ks) kf[ks] = k_frag(kb, fo, half, ks);
                f32x16 p;
#pragma unroll
                for (int r = 0; r < 16; ++r) p[r] = 0.f;
#pragma unroll
                for (int ks = 0; ks < 8; ++ks) p = __builtin_amdgcn_mfma_f32_32x32x16_bf16(kf[ks], qf[ks], p, 0, 0, 0);
#pragma unroll
                for (int r = 0; r < 16; ++r) { const unsigned keep = (unsigned)(-(int)((mwh >> ((r & 3) + 8 * (r >> 2))) & 1u));
                    const float e = __uint_as_float(__float_as_uint(__builtin_amdgcn_exp2f(p[r] - mref)) & keep); p[r] = e; lsum += e; }
                const bf16x8 pa0 = pack8(p[0], p[1], p[2], p[3], p[4], p[5], p[6], p[7]), pa1 = pack8(p[8], p[9], p[10], p[11], p[12], p[13], p[14], p[15]);
                s16x4 vl[8], vh[8];
                const unsigned vbase = (unsigned)(size_t)vb + 8192u * (unsigned)half;
#pragma unroll
                for (int ct = 0; ct < 4; ++ct) { const unsigned a0 = vbase + (unsigned)fo.va[ct], a1 = a0 + (unsigned)fo.vd;
                    TR_READ(vl[2 * ct], a0, 0); TR_READ(vh[2 * ct], a1, 0); TR_READ(vl[2 * ct + 1], a0, 4096); TR_READ(vh[2 * ct + 1], a1, 4096); }
                LGKM_WAIT0();
#pragma unroll
                for (int ct = 0; ct < 4; ++ct) {
                    o[ct] = __builtin_amdgcn_mfma_f32_32x32x16_bf16(pa0, mk_frag(vl[2 * ct], vh[2 * ct]), o[ct], 0, 0, 0);
                    o[ct] = __builtin_amdgcn_mfma_f32_32x32x16_bf16(pa1, mk_frag(vl[2 * ct + 1], vh[2 * ct + 1]), o[ct], 0, 0, 0);
                }
            }
        }
        asm volatile("s_waitcnt vmcnt(0) lgkmcnt(0)" ::: "memory");
        __syncthreads();
    }
    lsum += __shfl_xor(lsum, 32);
    LAS float* lsc = (LAS float*)mst;
    if (hi == 0) lsc[r32] = 1.0f / lsum;
    asm volatile("s_waitcnt lgkmcnt(0)" ::: "memory");
    float rsc[16];
#pragma unroll
    for (int r = 0; r < 16; ++r) rsc[r] = lsc[crow(r, hi)];
    store_o(o, rsc, lds + w * 8192, F.CAT + (size_t)(b * SEQ + t0w) * D + h * 128, D, lane);
    __syncthreads();
}
__device__ __forceinline__ void ph_dsa(Frame& F) {
    float gm = fmaxf(fabsf(F.gq_a[F.lane]), fabsf(F.gq_a[64 + F.lane])), km = fmaxf(fabsf(F.gk_a[F.lane]), fabsf(F.gk_a[64 + F.lane]));
    gm = wave_max(gm); km = wave_max(km);
    const float mref = att::C2 * 128.0f * gm * km * 1.02f;
    for (int v = F.vcu; v < BATCH * 4 * 4; v += F.G) {
        const int bh = v >> 2, pi = v & 3;
#pragma unroll 1
        for (int k = 0; k < 2; ++k) dsa_unit(F, bh >> 2, bh & 3, k ? 7 - pi : pi, mref);
    }
}
namespace idx {
using att::f32x16;
constexpr int SCP = 2048;
__device__ __forceinline__ unsigned okey(float f) { const unsigned u = __float_as_uint(f); return (u & 0x80000000u) ? ~u : (u | 0x80000000u); }
__device__ __forceinline__ int wave_isum(int c) {
    c += __builtin_amdgcn_mov_dpp(c, 0xB1, 0xF, 0xF, true);
    c += __builtin_amdgcn_mov_dpp(c, 0x4E, 0xF, 0xF, true);
    c += __builtin_amdgcn_mov_dpp(c, 0x141, 0xF, 0xF, true);
    c += __builtin_amdgcn_mov_dpp(c, 0x140, 0xF, 0xF, true);
    return (__builtin_amdgcn_readlane(c, 0) + __builtin_amdgcn_readlane(c, 16)) + (__builtin_amdgcn_readlane(c, 32) + __builtin_amdgcn_readlane(c, 48));
}
__device__ __forceinline__ unsigned bfi32(unsigned m, unsigned x, unsigned y) { return (x & m) | (y & ~m); }
__device__ __forceinline__ void bit_transpose32x2(unsigned (&A)[32], unsigned (&B)[32]) {
#pragma unroll
    for (int k = 0; k < 16; ++k) { const unsigned a0 = A[k], a1 = A[k + 16], b0 = B[k], b1 = B[k + 16];
        A[k] = __builtin_amdgcn_perm(a0, a1, 0x07060302u); A[k + 16] = __builtin_amdgcn_perm(a0, a1, 0x05040100u);
        B[k] = __builtin_amdgcn_perm(b0, b1, 0x07060302u); B[k + 16] = __builtin_amdgcn_perm(b0, b1, 0x05040100u); }
#pragma unroll
    for (int k = 0; k < 32; ++k) if (!(k & 8)) { const unsigned a0 = A[k], a1 = A[k + 8], b0 = B[k], b1 = B[k + 8];
        A[k] = __builtin_amdgcn_perm(a0, a1, 0x07030501u); A[k + 8] = __builtin_amdgcn_perm(a0, a1, 0x06020400u);
        B[k] = __builtin_amdgcn_perm(b0, b1, 0x07030501u); B[k + 8] = __builtin_amdgcn_perm(b0, b1, 0x06020400u); }
    unsigned mask = 0x0F0F0F0Fu;
#pragma unroll
    for (int s = 4; s; s >>= 1) {
#pragma unroll
        for (int k = 0; k < 32; ++k) if (!(k & s)) { const unsigned a0 = A[k], a1 = A[k + s], b0 = B[k], b1 = B[k + s];
            A[k] = bfi32(mask, a1 >> s, a0); A[k + s] = bfi32(mask, a1, a0 << s);
            B[k] = bfi32(mask, b1 >> s, b0); B[k + s] = bfi32(mask, b1, b0 << s); }
        mask ^= mask << (s >> 1);
    }
}
__device__ __forceinline__ void select_prepare(const LAS float* scA, const LAS float* scB, int E, unsigned (&Wa)[32], unsigned (&Wb)[32], int lane) {
#pragma unroll
    for (int j = 0; j < 32; ++j) { Wa[31 - j] = __float_as_uint(scA[64 * j + lane]); Wb[31 - j] = __float_as_uint(scB[64 * j + lane]); }
#pragma unroll
    for (int j = 0; j < 32; ++j) { Wa[j] ^= (unsigned)((int)Wa[j] >> 31) | 0x80000000u; Wb[j] ^= (unsigned)((int)Wb[j] >> 31) | 0x80000000u; }
    bit_transpose32x2(Wa, Wb);
}
__device__ __forceinline__ void select_finish(const unsigned (&Wa)[32], const unsigned (&Wb)[32], int E, unsigned* mrowA, unsigned* mrowB, int lane) {
    const unsigned valid = (E >= 32) ? 0xFFFFFFFFu : ((1u << E) - 1u);
    unsigned alA = valid, alB = valid, gtA = 0u, gtB = 0u;
    int GA = 0, GB = 0, AA = 64 * E, AB = 64 * E;
#pragma unroll
    for (int b0 = 0; b0 < 32; b0 += 4) {
        if (GA + AA == 256 && GB + AB == 256) break;
#pragma unroll
        for (int bb = 0; bb < 4; ++bb) { const int b = b0 + bb;
            const unsigned m1a = alA & Wa[b], m1b = alB & Wb[b];
            const int cab = wave_isum(__popc(m1a) | (__popc(m1b) << 16)), ca = cab & 0xFFFF, cb = cab >> 16;
            const bool ta = GA + ca >= 256, tb = GB + cb >= 256;
            alA = ta ? m1a : (alA ^ m1a); gtA = ta ? gtA : (gtA | m1a); AA = ta ? ca : AA - ca; GA = ta ? GA : GA + ca;
            alB = tb ? m1b : (alB ^ m1b); gtB = tb ? gtB : (gtB | m1b); AB = tb ? cb : AB - cb; GB = tb ? GB : GB + cb; }
    }
    const bool dA = (GA + AA == 256), dB = (GB + AB == 256);
#pragma unroll 1
    for (int rr = 0; rr < 2; ++rr) {
        const unsigned al = rr ? alB : alA, gt = rr ? gtB : gtA; const bool done = rr ? dB : dA; unsigned* mrow = rr ? mrowB : mrowA;
        unsigned sel = gt | al;
        if (!done) {
            int need = 256 - (rr ? GB : GA); sel = gt;
            const unsigned long long below = (1ull << lane) - 1ull;
            for (int j = 0; j < E; ++j) { const bool e = (al >> j) & 1u; const unsigned long long eq = __ballot(e);
                if (e && __popcll(eq & below) < need) sel |= 1u << j;
                need -= __popcll(eq); if (need <= 0) break; }
        }
        unsigned long long mine = 0ull;
#pragma unroll
        for (int j = 0; j < 32; ++j) { if (j < E) { const unsigned long long m = __ballot((sel >> j) & 1u); if (lane == j) mine = m; } }
        if (lane < 32) *(unsigned long long*)(mrow + 2 * lane) = mine;
    }
}
__device__ __forceinline__ void decode(int u, int& b, int& c, int& sub) { c = 4 + u % 28; const int rest = u / 28; b = rest >> 2; sub = rest & 3; }
__device__ __forceinline__ void load_af(Frame& F, int u, bf16x8 (&af)[4][4]) {
    int b, c, sub; decode(u, b, c, sub);
    const int r32 = F.lane & 31, hi = F.lane >> 5, t0 = 64 * c + 16 * sub, g = r32 >> 3, hh = (r32 >> 2) & 1, j = r32 & 3, qo = 2 * hh + (g >> 1), hd = 4 * (g & 1) + j;
    const bf16* P = F.R1 + (size_t)b * SEQ * NAB;
#pragma unroll
    for (int rt = 0; rt < 4; ++rt)
#pragma unroll
        for (int ks = 0; ks < 4; ++ks) af[rt][ks] = *(const bf16x8*)(P + (size_t)(t0 + 4 * rt + qo) * NAB + C_IQ + hd * 64 + 16 * ks + 8 * hi);
}
__device__ __forceinline__ float load_w(Frame& F, int u) {
    int b, c, sub; decode(u, b, c, sub);
    const int t0 = 64 * c + 16 * sub;
    return (F.tid < 128) ? bf2f(F.R1[(size_t)(b * SEQ + t0 + (F.tid >> 3)) * NAB + C_IW + (F.tid & 7)]) * (0.125f * 0.35355339059327373f) : 0.f;
}
__device__ __forceinline__ void load_bf(Frame& F, int b, int strip, bf16x8 (&bfr)[4]) {
    const bf16* P = F.R1 + (size_t)b * SEQ * NAB;
#pragma unroll
    for (int ks = 0; ks < 4; ++ks) bfr[ks] = *(const bf16x8*)(P + (size_t)(32 * strip + (F.lane & 31)) * NAB + C_IK + 16 * ks + 8 * (F.lane >> 5));
}
__device__ __forceinline__ float relu1(float x) { const int i = __float_as_int(x); return __int_as_float(i > 0 ? i : 0); }
__device__ __forceinline__ void run(Frame& F) {
    const int lane = F.lane, w = F.wave, hi = lane >> 5, r32 = lane & 31, tid = F.tid, NU = BATCH * 28 * 4;
    int u = F.vcu; if (u >= NU) return;
    LAS float* sc = (LAS float*)F.lds;
    LAS float* wtb = sc + 16 * SCP;
    bf16x8 af[4][4], bfr[4], bnx[4];
    load_af(F, u, af);
    { const float wv = load_w(F, u); if (tid < 128) wtb[tid] = wv; }
    { int b, c, sub; decode(u, b, c, sub); if (w < 2 * (c + 1)) load_bf(F, b, w, bfr); }
    for (int it = 0; u < NU; ++it, u += F.G) {
        int b, c, sub; decode(u, b, c, sub);
        const int n = 64 * (c + 1), t0 = 64 * c + 16 * sub, nstrip = n >> 5;
        const int un = u + F.G; const bool more = un < NU;
        const LAS float* wt = wtb + (it & 1) * 128;
        __syncthreads();
        const float wnext = more ? load_w(F, un) : 0.f;
        for (int s = w; s < nstrip; s += NWAVES) {
            const bool mstrip = s + NWAVES < nstrip;
            if (mstrip) load_bf(F, b, s + NWAVES, bnx);
#pragma unroll
            for (int rt = 0; rt < 4; ++rt) {
                f32x16 acc;
#pragma unroll
                for (int r = 0; r < 16; ++r) acc[r] = 0.f;
#pragma unroll
                for (int ks = 0; ks < 4; ++ks) acc = __builtin_amdgcn_mfma_f32_32x32x16_bf16(af[rt][ks], bfr[ks], acc, 0, 0, 0);
                const int q0 = 4 * rt + 2 * hi;
                float f0, f1;
                { const f32x4 wa = *(const LAS f32x4*)(wt + q0 * 8), wb = *(const LAS f32x4*)(wt + q0 * 8 + 4), wc = *(const LAS f32x4*)(wt + q0 * 8 + 8), wd = *(const LAS f32x4*)(wt + q0 * 8 + 12);
                  f0 = relu1(acc[0]) * wa[0]; f1 = relu1(acc[8]) * wc[0];
#pragma unroll
                  for (int e = 1; e < 4; ++e) { f0 = fmaf(relu1(acc[e]), wa[e], f0); f1 = fmaf(relu1(acc[8 + e]), wc[e], f1); }
#pragma unroll
                  for (int e = 0; e < 4; ++e) { f0 = fmaf(relu1(acc[4 + e]), wb[e], f0); f1 = fmaf(relu1(acc[12 + e]), wd[e], f1); } }
                sc[q0 * SCP + 32 * s + r32] = f0; sc[(q0 + 1) * SCP + 32 * s + r32] = f1;
            }
            if (mstrip) {
#pragma unroll
                for (int ks = 0; ks < 4; ++ks) bfr[ks] = bnx[ks];
            }
        }
        if (more && tid < 128) wtb[((it + 1) & 1) * 128 + tid] = wnext;
        __syncthreads();
        { const int q = 2 * w;
          unsigned* mrowA = F.MASK + (size_t)(b * SEQ + t0 + q) * 64; unsigned* mrowB = mrowA + 64;
          const LAS float* rowA = sc + q * SCP; const LAS float* rowB = rowA + SCP;
          unsigned Wa[32], Wb[32];
          select_prepare(rowA, rowB, n >> 6, Wa, Wb, lane);
          asm volatile("" ::: "memory");
          if (more) load_af(F, un, af);
          select_finish(Wa, Wb, n >> 6, mrowA, mrowB, lane); }
        if (more) { int bn, cn, sn; decode(un, bn, cn, sn); if (w < 2 * (cn + 1)) load_bf(F, bn, w, bfr); }
    }
    __syncthreads();
}
}
__device__ __forceinline__ void ph_indexer(Frame& F) {
    { const int gw = F.vcu * NWAVES + F.wave, NGW = F.G * NWAVES;
      for (int i = gw; i < BATCH * 256; i += NGW) { const int b = i >> 8, pos = i & 255, n = ((pos >> 6) + 1) << 6;
          if (F.lane < 32) { unsigned long long v = 0ull; if (64 * F.lane < n) v = ~0ull; *(unsigned long long*)(F.MASK + (size_t)(b * SEQ + pos) * 64 + 2 * F.lane) = v; } } }
    idx::run(F);
}
namespace gla {
using att::f32x16; using att::u32x4;
constexpr int L_WL = 0, L_V = 4096, L_OG = 36864, L_K = 69632, L_Q = 78848, L_PART = 88064, L_STG = 89088, KP = 144, SP = 272;
struct In { u32x4 g0, g1, kk, qq; f32x4 b0, b1; };
__device__ __forceinline__ void decode(int u, int& b, int& h, int& c) { b = u >> 7; h = (u >> 5) & 3; c = u & 31; }
template <bool PASSC> __device__ __forceinline__ void load_in(Frame& F, int u, In& in, const float* BC) {
    int b, h, c; decode(u, b, h, c);
    const bf16* pr = F.R1 + (size_t)(b * SEQ + 64 * c + F.lane) * NAB;
    in.kk = *(const u32x4*)(pr + C_KB + h * 64 + 8 * F.wave);
    if (PASSC) { in.qq = *(const u32x4*)(pr + C_QB + h * 64 + 8 * F.wave);
        const float* bp = BC + ((size_t)u * 64 + F.lane) * 64 + 8 * F.wave; in.b0 = *(const f32x4*)bp; in.b1 = *(const f32x4*)(bp + 4); }
    else { in.g0 = *(const u32x4*)(pr + C_GL); in.g1 = *(const u32x4*)(pr + C_GL + 8); }
}
template <bool NEEDOG> __device__ __forceinline__ void dma_in(Frame& F, int u, int buf, const unsigned (&dvo)[2]) {
    int b, h, c; decode(u, b, h, c);
    const bf16* P = F.R1 + (size_t)(b * SEQ + 64 * c) * NAB;
    att::tile_dma(P + C_VB + h * 128, dvo, F.lds + L_V + buf * 16384, F.wave);
    if (NEEDOG) att::tile_dma(P + C_OG + h * 128, dvo, F.lds + L_OG + buf * 16384, F.wave);
}
__device__ __forceinline__ void stage_wl(Frame& F, int h) {
    LAS float* wl = (LAS float*)(F.lds + L_WL);
#pragma unroll
    for (int i = 0; i < 2; ++i) { const int e = F.tid + 512 * i, r = e >> 6, d = e & 63; wl[e] = F.w_gate_up[r * 256 + h * 64 + d]; }
}
__device__ __forceinline__ void unpack8(const u32x4 v, float (&f)[8]) {
#pragma unroll
    for (int i = 0; i < 4; ++i) { f[2 * i] = __uint_as_float(v[i] << 16); f[2 * i + 1] = __uint_as_float(v[i] & 0xffff0000u); }
}
__device__ __forceinline__ void gate_scan(Frame& F, int h, const float (&gl)[16], float (&bc)[8], float (&blast)[8]) {
    const int lane = F.lane, d0 = 8 * F.wave;
    const LAS float* wl = (const LAS float*)(F.lds + L_WL);
    float acc[8];
#pragma unroll
    for (int i = 0; i < 8; ++i) acc[i] = F.b_gate[h * 64 + d0 + i];
#pragma unroll
    for (int r = 0; r < 16; ++r) { const f32x4 w0 = *(const LAS f32x4*)(wl + r * 64 + d0), w1 = *(const LAS f32x4*)(wl + r * 64 + d0 + 4);
#pragma unroll
        for (int i = 0; i < 4; ++i) { acc[i] = fmaf(gl[r], w0[i], acc[i]); acc[4 + i] = fmaf(gl[r], w1[i], acc[4 + i]); } }
#pragma unroll
    for (int i = 0; i < 8; ++i) { float v = (fminf(acc[i], 0.f) - __logf(1.0f + __expf(-fabsf(acc[i])))) * (1.0f / 16.0f);
#pragma unroll
        for (int off = 1; off < 64; off <<= 1) { const float u = __shfl_up(v, off); if (lane >= off) v += u; }
        bc[i] = v; blast[i] = __shfl(v, 63); }
}
__device__ __forceinline__ void pass_a(Frame& F, float* GU, float* DEC, float* BC) {
    const int lane = F.lane, w = F.wave, hi = lane >> 5, r32 = lane & 31;
    att::FragOff fo; att::frag_off_init(fo, lane);
    unsigned dvo[2]; att::dma_off_init(dvo, NAB, w, lane);
    const int et = w >> 1, dt = w & 1, va_et = att::frag_va(lane, et);
    int u = F.vcu; if (u >= BATCH * 4 * 32) return;
    In cur, nxt; int hprev = -1;
    dma_in<false>(F, u, 0, dvo); load_in<false>(F, u, cur, BC);
    for (int it = 0; u < BATCH * 4 * 32; ++it, u += F.G) {
        int b, h, c; decode(u, b, h, c);
        const int un = u + F.G; const bool more = un < BATCH * 4 * 32;
        if (h != hprev) { stage_wl(F, h); hprev = h; }
        asm volatile("s_waitcnt vmcnt(0) lgkmcnt(0)" ::: "memory");
        __syncthreads();
        float gl[16], kf[8];
        unpack8(cur.g0, (float(&)[8])gl[0]); unpack8(cur.g1, (float(&)[8])gl[8]); unpack8(cur.kk, kf);
        asm volatile("" ::: "memory");
        if (more) { dma_in<false>(F, un, (it + 1) & 1, dvo); load_in<false>(F, un, nxt, BC); }
        float bc[8], blast[8];
        gate_scan(F, h, gl, bc, blast);
        const int uid = u;
        { float* bp = BC + ((size_t)uid * 64 + lane) * 64 + 8 * w; *(f32x4*)bp = (f32x4){bc[0], bc[1], bc[2], bc[3]}; *(f32x4*)(bp + 4) = (f32x4){bc[4], bc[5], bc[6], bc[7]}; }
#pragma unroll
        for (int i = 0; i < 8; ++i) *(LAS bf16*)(F.lds + L_K + (8 * w + i) * KP + lane * 2) = (bf16)f2bf(kf[i] * __expf(blast[i] - bc[i]));
        if (lane == 0) {
#pragma unroll
            for (int i = 0; i < 8; ++i) DEC[(size_t)uid * 64 + 8 * w + i] = __expf(blast[i]); }
        asm volatile("s_waitcnt lgkmcnt(0)" ::: "memory");
        __syncthreads();
        const LAS unsigned char* vbuf = F.lds + L_V + (it & 1) * 16384;
        f32x16 acc;
#pragma unroll
        for (int r = 0; r < 16; ++r) acc[r] = 0.f;
#pragma unroll
        for (int kk = 0; kk < 4; ++kk) {
            const LAS unsigned char* kp = F.lds + L_K + (32 * dt + r32) * KP + (16 * kk + 4 * hi) * 2;
            const unsigned long long lo = *(const LAS unsigned long long*)kp, hh = *(const LAS unsigned long long*)(kp + 16);
            u32x4 bw; bw.x = (unsigned)lo; bw.y = (unsigned)(lo >> 32); bw.z = (unsigned)hh; bw.w = (unsigned)(hh >> 32);
            acc = __builtin_amdgcn_mfma_f32_32x32x16_bf16(att::v_frag_rt(vbuf, va_et, fo.vd, kk), __builtin_bit_cast(bf16x8, bw), acc, 0, 0, 0);
        }
        float* gu = GU + (size_t)uid * 8192;
#pragma unroll
        for (int r = 0; r < 16; ++r) gu[(32 * et + att::crow(r, hi)) * 64 + 32 * dt + r32] = acc[r];
        cur = nxt;
    }
    __syncthreads();
}
__device__ __forceinline__ void pass_b(Frame& F, float* GU, const float* DEC) {
    for (int idx = F.vcu * NTHR + F.tid; idx < 64 * 128 * 16; idx += F.G * NTHR) {
        const int bh = idx >> 11, e = (idx >> 4) & 127, dq = idx & 15;
        f32x4 S = (f32x4){0.f, 0.f, 0.f, 0.f};
        for (int c0 = 0; c0 < 32; c0 += 8) {
            f32x4 U[8], dec[8];
#pragma unroll
            for (int i = 0; i < 8; ++i) { const size_t uid = (size_t)bh * 32 + c0 + i; U[i] = *(const f32x4*)(GU + (uid * 128 + e) * 64 + 4 * dq); dec[i] = *(const f32x4*)(DEC + uid * 64 + 4 * dq); }
#pragma unroll
            for (int i = 0; i < 8; ++i) { const size_t uid = (size_t)bh * 32 + c0 + i; *(f32x4*)(GU + (uid * 128 + e) * 64 + 4 * dq) = S; S = dec[i] * S + U[i]; }
        }
    }
}
__device__ __forceinline__ void pass_c(Frame& F, const float* GU, const float* BC) {
    const int lane = F.lane, w = F.wave, hi = lane >> 5, r32 = lane & 31, tid = F.tid;
    LAS unsigned char* lds = F.lds;
    att::FragOff fo; att::frag_off_init(fo, lane);
    unsigned dvo[2]; att::dma_off_init(dvo, NAB, w, lane);
    const int et = w >> 1, tt = w & 1, tl = 32 * tt + r32, va_et = att::frag_va(lane, et);
    int u = F.vcu; if (u >= BATCH * 4 * 32) return;
    In cur, nxt;
    dma_in<true>(F, u, 0, dvo); load_in<true>(F, u, cur, BC);
    for (int it = 0; u < BATCH * 4 * 32; ++it, u += F.G) {
        int b, h, c; decode(u, b, h, c);
        const int un = u + F.G; const bool more = un < BATCH * 4 * 32;
        asm volatile("s_waitcnt vmcnt(0) lgkmcnt(0)" ::: "memory");
        __syncthreads();
        float kf[8], qf[8], bc[8];
        unpack8(cur.kk, kf); unpack8(cur.qq, qf);
#pragma unroll
        for (int i = 0; i < 4; ++i) { bc[i] = cur.b0[i]; bc[4 + i] = cur.b1[i]; }
        asm volatile("" ::: "memory");
        if (more) { dma_in<true>(F, un, (it + 1) & 1, dvo); load_in<true>(F, un, nxt, BC); }
        f32x4 sf[8];
        { const float* gs = GU + ((size_t)u * 128 + 32 * et + r32) * 64;
#pragma unroll
          for (int ks = 0; ks < 4; ++ks) { sf[2 * ks] = *(const f32x4*)(gs + 16 * ks + 8 * hi); sf[2 * ks + 1] = *(const f32x4*)(gs + 16 * ks + 8 * hi + 4); } }
        { float eq[8], ek[8];
#pragma unroll
          for (int i = 0; i < 8; ++i) { eq[i] = qf[i] * 0.125f * __expf(bc[i]); ek[i] = kf[i] * __expf(-bc[i]); }
          *(LAS bf16x8*)(lds + L_Q + lane * KP + 16 * w) = att::pack8(eq[0], eq[1], eq[2], eq[3], eq[4], eq[5], eq[6], eq[7]);
          *(LAS bf16x8*)(lds + L_K + lane * KP + 16 * w) = att::pack8(ek[0], ek[1], ek[2], ek[3], ek[4], ek[5], ek[6], ek[7]); }
        asm volatile("s_waitcnt lgkmcnt(0)" ::: "memory");
        __syncthreads();
        const LAS unsigned char* vbuf = lds + L_V + (it & 1) * 16384; const LAS unsigned char* ogbuf = lds + L_OG + (it & 1) * 16384;
        bf16x8 qfr[4];
#pragma unroll
        for (int ks = 0; ks < 4; ++ks) qfr[ks] = *(const LAS bf16x8*)(lds + L_Q + tl * KP + (16 * ks + 8 * hi) * 2);
        f32x16 p0, p1;
#pragma unroll
        for (int r = 0; r < 16; ++r) { p0[r] = 0.f; p1[r] = 0.f; }
#pragma unroll
        for (int ks = 0; ks < 4; ++ks) {
            const bf16x8 a0 = *(const LAS bf16x8*)(lds + L_K + r32 * KP + (16 * ks + 8 * hi) * 2), a1 = *(const LAS bf16x8*)(lds + L_K + (32 + r32) * KP + (16 * ks + 8 * hi) * 2);
            p0 = __builtin_amdgcn_mfma_f32_32x32x16_bf16(a0, qfr[ks], p0, 0, 0, 0); p1 = __builtin_amdgcn_mfma_f32_32x32x16_bf16(a1, qfr[ks], p1, 0, 0, 0);
        }
        { const int tl4 = tl - 4 * hi;
#pragma unroll
          for (int r = 0; r < 16; ++r) { const int s = (r & 3) + 8 * (r >> 2); if (s > tl4) p0[r] = 0.f; if (s + 32 > tl4) p1[r] = 0.f; } }
        const bf16x8 pa0 = att::pack8(p0[0], p0[1], p0[2], p0[3], p0[4], p0[5], p0[6], p0[7]), pa1 = att::pack8(p0[8], p0[9], p0[10], p0[11], p0[12], p0[13], p0[14], p0[15]);
        const bf16x8 pa2 = att::pack8(p1[0], p1[1], p1[2], p1[3], p1[4], p1[5], p1[6], p1[7]), pa3 = att::pack8(p1[8], p1[9], p1[10], p1[11], p1[12], p1[13], p1[14], p1[15]);
        f32x16 acc;
#pragma unroll
        for (int r = 0; r < 16; ++r) acc[r] = 0.f;
        acc = __builtin_amdgcn_mfma_f32_32x32x16_bf16(att::v_frag_rt(vbuf, va_et, fo.vd, 0), pa0, acc, 0, 0, 0);
        acc = __builtin_amdgcn_mfma_f32_32x32x16_bf16(att::v_frag_rt(vbuf, va_et, fo.vd, 1), pa1, acc, 0, 0, 0);
        acc = __builtin_amdgcn_mfma_f32_32x32x16_bf16(att::v_frag_rt(vbuf, va_et, fo.vd, 2), pa2, acc, 0, 0, 0);
        acc = __builtin_amdgcn_mfma_f32_32x32x16_bf16(att::v_frag_rt(vbuf, va_et, fo.vd, 3), pa3, acc, 0, 0, 0);
#pragma unroll
        for (int ks = 0; ks < 4; ++ks) { const f32x4 s0 = sf[2 * ks], s1 = sf[2 * ks + 1];
            acc = __builtin_amdgcn_mfma_f32_32x32x16_bf16(att::pack8(s0[0], s0[1], s0[2], s0[3], s1[0], s1[1], s1[2], s1[3]), qfr[ks], acc, 0, 0, 0); }
        float ss = 0.f;
#pragma unroll
        for (int r = 0; r < 16; ++r) ss = fmaf(acc[r], acc[r], ss);
        ss += __shfl_xor(ss, 32);
        LAS float* part = (LAS float*)(lds + L_PART);
        if (hi == 0) part[et * 64 + tl] = ss;
        asm volatile("s_waitcnt lgkmcnt(0)" ::: "memory");
        __syncthreads();
        const float rs = rsqrtf(((part[tl] + part[64 + tl]) + (part[128 + tl] + part[192 + tl])) * (1.0f / 128.0f) + EPS);
#pragma unroll
        for (int g = 0; g < 4; ++g) {
            const int e0 = 32 * et + 8 * g + 4 * hi;
            const unsigned long long ow = *(const LAS unsigned long long*)(ogbuf + att::img_off(tl, 4 * et + g) + 8 * hi);
            const f32x4 gg = *(const f32x4*)(F.g_gla + e0);
            float y[4];
#pragma unroll
            for (int i = 0; i < 4; ++i) { const float og = __uint_as_float(((unsigned)(ow >> (16 * i)) & 0xffffu) << 16); y[i] = acc[4 * g + i] * rs * gg[i] * (og * __builtin_amdgcn_rcpf(1.0f + __expf(-og))); }
            *(LAS unsigned long long*)(lds + L_STG + tl * SP + e0 * 2) = (unsigned long long)pg8::cvt_pk_bf16(y[0], y[1]) | ((unsigned long long)pg8::cvt_pk_bf16(y[2], y[3]) << 32);
        }
        asm volatile("s_waitcnt lgkmcnt(0)" ::: "memory");
        __syncthreads();
#pragma unroll
        for (int i = 0; i < 2; ++i) { const int cidx = tid + 512 * i, row = cidx >> 4, ch = cidx & 15;
            *(u32x4*)(F.CAT + (size_t)(b * SEQ + 64 * c + row) * D + 512 + h * 128 + ch * 8) = *(const LAS u32x4*)(lds + L_STG + row * SP + ch * 16); }
        cur = nxt;
    }
    __syncthreads();
}
}
__device__ __forceinline__ void ph_rope_tables(Frame& F, float* R128, float* R64) {
    for (int i = F.vcu * NTHR + F.tid; i < SEQ * 24; i += F.G * NTHR) {
        const int pos = i / 24, k = i % 24;
        if (k < 16) { const float inv = powf(500000.0f, -(float)k * 2.0f / 32.0f), ang = (float)pos * inv; R128[pos * 32 + k] = cosf(ang); R128[pos * 32 + 16 + k] = sinf(ang); }
        else { const int j = k - 16; const float inv = powf(500000.0f, -(float)j * 2.0f / 16.0f), ang = (float)pos * inv; R64[pos * 16 + j] = cosf(ang); R64[pos * 16 + 8 + j] = sinf(ang); }
    }
}
__device__ __forceinline__ float dpp_xor1(float v) { return __builtin_bit_cast(float, __builtin_amdgcn_mov_dpp(__builtin_bit_cast(int, v), 0xB1, 0xF, 0xF, true)); }
__device__ __forceinline__ float dpp_xor2(float v) { return __builtin_bit_cast(float, __builtin_amdgcn_mov_dpp(__builtin_bit_cast(int, v), 0x4E, 0xF, 0xF, true)); }
__device__ __forceinline__ void ph_prep_c_fast(Frame& F) {
    const int gw = F.vcu * NWAVES + F.wave, NGW = F.G * NWAVES, lane = F.lane;
    const float* gn = (lane < 32 ? F.gq_c : F.gk_c) + (lane & 3) * 32;
    const float sc = lane < 32 ? att::C2 : 1.0f;
    float g[32];
#pragma unroll
    for (int i = 0; i < 8; ++i) { const f32x4 v = *(const f32x4*)(gn + 4 * i); g[4 * i] = v[0] * sc; g[4 * i + 1] = v[1] * sc; g[4 * i + 2] = v[2] * sc; g[4 * i + 3] = v[3] * sc; }
    for (int tok = gw; tok < M; tok += NGW) {
        att::u32x4* p = (att::u32x4*)(F.R1 + (size_t)tok * NC + lane * 32);
        att::u32x4 v[4]; float f[32]; float ss = 0.f;
#pragma unroll
        for (int i = 0; i < 4; ++i) v[i] = p[i];
#pragma unroll
        for (int i = 0; i < 4; ++i)
#pragma unroll
            for (int j = 0; j < 4; ++j) { const float a = __uint_as_float(v[i][j] << 16), b = __uint_as_float(v[i][j] & 0xffff0000u); f[8 * i + 2 * j] = a; f[8 * i + 2 * j + 1] = b; ss = fmaf(a, a, fmaf(b, b, ss)); }
        ss += dpp_xor1(ss); ss += dpp_xor2(ss);
        const float rs = rsqrtf(ss * (1.f / 128.f) + EPS);
#pragma unroll
        for (int i = 0; i < 4; ++i) { att::u32x4 o;
#pragma unroll
            for (int j = 0; j < 4; ++j) o[j] = pg8::cvt_pk_bf16(f[8 * i + 2 * j] * rs * g[8 * i + 2 * j], f[8 * i + 2 * j + 1] * rs * g[8 * i + 2 * j + 1]);
            p[i] = o; }
    }
}
__device__ __forceinline__ void ph_prep_a_fast(Frame& F, const float* R128, const float* R64) {
    const int gw = F.vcu * NWAVES + F.wave, NGW = F.G * NWAVES, lane = F.lane, l8 = lane & 7;
    const float* gn = (lane < 32 ? F.gq_a : F.gk_a) + l8 * 16;
    const float sc = lane < 32 ? att::C2 : 1.0f;
    float g[16];
#pragma unroll
    for (int i = 0; i < 4; ++i) { const f32x4 v = *(const f32x4*)(gn + 4 * i); g[4 * i] = v[0] * sc; g[4 * i + 1] = v[1] * sc; g[4 * i + 2] = v[2] * sc; g[4 * i + 3] = v[3] * sc; }
    for (int tok = gw; tok < M; tok += NGW) {
        const int pos = tok & (SEQ - 1);
        bf16* pr = F.R1 + (size_t)tok * NAB;
        {   att::u32x4* p = (att::u32x4*)(pr + lane * 16);
            const att::u32x4 v0 = p[0], v1 = p[1]; float f[16]; float ss = 0.f;
#pragma unroll
            for (int j = 0; j < 4; ++j) { f[2 * j] = __uint_as_float(v0[j] << 16); f[2 * j + 1] = __uint_as_float(v0[j] & 0xffff0000u); f[8 + 2 * j] = __uint_as_float(v1[j] << 16); f[8 + 2 * j + 1] = __uint_as_float(v1[j] & 0xffff0000u); }
#pragma unroll
            for (int i = 0; i < 16; ++i) ss = fmaf(f[i], f[i], ss);
            ss += dpp_xor1(ss); ss += dpp_xor2(ss); ss += __shfl_xor(ss, 4);
            const float rs = rsqrtf(ss * (1.f / 128.f) + EPS);
#pragma unroll
            for (int i = 0; i < 16; ++i) f[i] = f[i] * rs * g[i];
            const float* cs = R128 + pos * 32;
#pragma unroll
            for (int i = 0; i < 16; ++i) { const float other = dpp_xor1(f[i]);
                if (l8 < 2) { const float c = cs[i], s = cs[16 + i]; f[i] = (l8 == 0) ? f[i] * c - other * s : f[i] * c + other * s; } }
            att::u32x4 o0, o1;
#pragma unroll
            for (int j = 0; j < 4; ++j) { o0[j] = pg8::cvt_pk_bf16(f[2 * j], f[2 * j + 1]); o1[j] = pg8::cvt_pk_bf16(f[8 + 2 * j], f[8 + 2 * j + 1]); }
            p[0] = o0; p[1] = o1;
        }
        {
#pragma unroll
            for (int part = 0; part < 2; ++part) {
                if (part == 1 && lane >= 8) break;
                att::u32x4* p = (att::u32x4*)(pr + (part == 0 ? C_IQ + lane * 8 : C_IK + lane * 8));
                const att::u32x4 v0 = p[0]; float f[8];
#pragma unroll
                for (int j = 0; j < 4; ++j) { f[2 * j] = __uint_as_float(v0[j] << 16); f[2 * j + 1] = __uint_as_float(v0[j] & 0xffff0000u); }
                const float* cs = R64 + pos * 16;
#pragma unroll
                for (int i = 0; i < 8; ++i) { const float other = dpp_xor1(f[i]);
                    if (l8 < 2) { const float c = cs[i], s = cs[8 + i]; f[i] = (l8 == 0) ? f[i] * c - other * s : f[i] * c + other * s; } }
                att::u32x4 o0;
#pragma unroll
                for (int j = 0; j < 4; ++j) o0[j] = pg8::cvt_pk_bf16(f[2 * j], f[2 * j + 1]);
                p[0] = o0;
            }
        }
    }
}
#ifndef MK_PER_PHASE
#define MK_PER_PHASE 0
#endif
constexpr int NPH = 14;
struct Args { const float* in[16]; float* out; unsigned char* ws; int ph_lo, ph_hi; };
__global__ void __launch_bounds__(NTHR, 2) mk_fwd(Args args) {
    extern __shared__ __attribute__((aligned(16))) unsigned char lds[];
    Frame F;
    F.lds = (LAS unsigned char*)lds;
    F.MISC = (volatile LAS unsigned*)(F.lds + MISC_OFF);
#ifdef PROBE_TOTAL
    const unsigned long long pt_start = __builtin_amdgcn_s_memrealtime();
#endif
    F.wave = __builtin_amdgcn_readfirstlane((int)threadIdx.x >> 6);
#define RELANE() (F.lane = lane_id_opaque(), F.tid = F.wave * 64 + F.lane, true)
    RELANE();
#ifdef PROBE_ACC
    F.acc_t0 = 0ull; F.acc_sum = 0ull;
#endif
    F.G = gridDim.x; { const int bx = blockIdx.x; F.vcu = (F.G % 8 == 0) ? (bx % 8) * (F.G / 8) + bx / 8 : bx; }
    unsigned char* ws = args.ws;
    F.ctl = (gu32*)(ws + WS_CTL);
    F.x = args.in[0]; F.g_mix = args.in[1]; F.g_ffn = args.in[2]; F.w_in_ab = args.in[3]; F.gq_a = args.in[4]; F.gk_a = args.in[5]; F.w_gate_up = args.in[6]; F.b_gate = args.in[7];
    F.g_gla = args.in[8]; F.w_out_ab = args.in[9]; F.w_in_c = args.in[10]; F.gq_c = args.in[11]; F.gk_c = args.in[12]; F.w_out_c = args.in[13]; F.w_up = args.in[14]; F.w_down = args.in[15];
    F.out = args.out;
    F.Wab = (bf16*)(ws + WS_WAB); F.Woab = (bf16*)(ws + WS_WOAB); F.Wup0 = (bf16*)(ws + WS_WUP0); F.Wdn0 = (bf16*)(ws + WS_WDN0);
    F.Winc = (bf16*)(ws + WS_WINC); F.Woc = (bf16*)(ws + WS_WOC); F.Wup1 = (bf16*)(ws + WS_WUP1); F.Wdn1 = (bf16*)(ws + WS_WDN1);
    F.XB = (bf16*)(ws + WS_XB); F.CAT = (bf16*)(ws + WS_CAT); F.R1 = (bf16*)(ws + WS_R1); F.SSQ = (float*)(ws + WS_SSQ); F.MASK = (unsigned*)(ws + WS_MASK);
    for (int u = F.tid; u < (LDS_BYTES - MISC_OFF) / 4; u += NTHR) ((LAS unsigned*)(F.lds + MISC_OFF))[u] = 0u;
    __syncthreads();
    XcdBarrier bar; bar.bar = (unsigned*)(F.ctl + CW_BAR); bar.x = 0; bar.st = nullptr; bar.wave = F.wave;
    if (!MK_PER_PHASE) bar = xcd_barrier_post((unsigned*)(F.ctl + CW_BAR), F.MISC + 8, F.wave);
    const int lo = args.ph_lo, hi = args.ph_hi;
#ifdef PROBE_PH
    unsigned long long pt0 = 0ull, pt1 = 0ull;
#define STAMP(k) do { if ((k) == PROBE_PH) pt0 = __builtin_amdgcn_s_memrealtime(); if ((k) == PROBE_PH + 1) pt1 = __builtin_amdgcn_s_memrealtime(); } while (0)
#ifdef PROBE_SUB
#define SUBSTAMP(k) do { if ((k) == PROBE_PH) { __syncthreads(); pt0 = __builtin_amdgcn_s_memrealtime(); } } while (0)
#else
#define SUBSTAMP(k) do { } while (0)
#endif
#else
#define STAMP(k) do { } while (0)
#define SUBSTAMP(k) do { } while (0)
#endif
#define IN(k) (lo <= (k) && (k) < hi && RELANE())
#ifdef PROBE_DBLBAR
#define SEAM(k) do { if (lo <= (k) && (k) + 1 < hi) { xcd_barrier(bar); xcd_barrier(bar); } } while (0)
#else
#define SEAM(k) do { if (lo <= (k) && (k) + 1 < hi) xcd_barrier(bar); } while (0)
#endif
    float* const SSQ0 = F.SSQ, *SSQ1 = F.SSQ + (size_t)M * 16, *SSQ2 = F.SSQ + (size_t)2 * M * 16, *SSQ3 = F.SSQ + (size_t)3 * M * 16;
    typedef pg8::StaticOrder SO;
    STAMP(0); float* const R128 = (float*)(ws + WS_ROPE); float* const R64 = R128 + SEQ * 32;
    if (IN(0)) { ph_prologue(F); ph_rope_tables(F, R128, R64); } SEAM(0);
    STAMP(1); if (IN(1)) { pg8::Gemm g{F.XB, F.Wab, M, NAB, D}; SO S; S.init(M, NAB, F.G, (int)blockIdx.x); pg8::EpiProjAB E{F.R1, NAB, SSQ0, F.gq_a, F.gk_a, R128, R64, (LAS float*)(F.lds + RING_BYTES), att::C2};
        pg8::gemm_phase<pg8::EpiProjAB, SO, true, true>(F.lds, g, S, E, F.wave);
        if (F.G == 256 && blockIdx.x >= 128) { RELANE(); prologue_weights<1>(F, ((int)blockIdx.x - 128) * NWAVES + F.wave, 128 * NWAVES); } } SEAM(1);
    float* const GU = (float*)(ws + WS_XB); float* const DEC = (float*)(ws + WS_DEC);
    STAMP(2); if (IN(2)) { SUBSTAMP(2); gla::pass_a(F, GU, DEC, (float*)(ws + WS_BC)); } SEAM(2);
    STAMP(3); if (IN(3)) { gla::pass_b(F, GU, DEC); SUBSTAMP(3); ph_indexer(F); } SEAM(3);
    STAMP(4); if (IN(4)) { ph_dsa(F); SUBSTAMP(4); gla::pass_c(F, GU, (const float*)(ws + WS_BC)); } SEAM(4);
    STAMP(5); if (IN(5)) { pg8::Gemm g{F.CAT, F.Woab, M, D, D}; SO S; S.init(M, D, F.G, (int)blockIdx.x); pg8::EpiResid<0, 0> E{F.x, nullptr, F.XB, SSQ1, nullptr};
        pg8::gemm_phase<pg8::EpiResid<0, 0>, SO, true, true>(F.lds, g, S, E, F.wave); } SEAM(5);
    STAMP(6); if (IN(6)) { pg8::Gemm g{F.XB, F.Wup0, M, FF, D}; SO S; S.init(M, FF, F.G, (int)blockIdx.x); pg8::EpiScale<1> E{F.R1, FF, SSQ1};
        pg8::gemm_phase<pg8::EpiScale<1>, SO, true, true>(F.lds, g, S, E, F.wave); } SEAM(6);
    STAMP(7); if (IN(7)) { pg8::Gemm g{F.R1, F.Wdn0, M, D, FF}; SO S; S.init(M, D, F.G, (int)blockIdx.x); pg8::EpiResid<1, 0> E{F.XB, nullptr, F.XB, SSQ2, SSQ1};
        pg8::gemm_phase<pg8::EpiResid<1, 0>, SO, true, true>(F.lds, g, S, E, F.wave); } SEAM(7);
    STAMP(8); if (IN(8)) { pg8::Gemm g{F.XB, F.Winc, M, NC, D}; SO S; S.init(M, NC, F.G, (int)blockIdx.x); pg8::EpiQKNorm E{F.R1, NC, SSQ2, F.gq_c, F.gk_c, (LAS float*)(F.lds + RING_BYTES), att::C2};
        pg8::gemm_phase<pg8::EpiQKNorm, SO, true, true>(F.lds, g, S, E, F.wave); } SEAM(8);
    STAMP(9);
    STAMP(10); if (IN(10)) { ph_sb(F); } SEAM(10);
    STAMP(11); if (IN(11)) { pg8::Gemm g{F.CAT, F.Woc, M, D, D}; SO S; S.init(M, D, F.G, (int)blockIdx.x); pg8::EpiResid<1, 0> E{F.XB, nullptr, F.XB, SSQ3, nullptr};
        pg8::gemm_phase<pg8::EpiResid<1, 0>, SO, true, true>(F.lds, g, S, E, F.wave); } SEAM(11);
    STAMP(12); if (IN(12)) { pg8::Gemm g{F.XB, F.Wup1, M, FF, D}; SO S; S.init(M, FF, F.G, (int)blockIdx.x); pg8::EpiScale<1> E{F.R1, FF, SSQ3};
        pg8::gemm_phase<pg8::EpiScale<1>, SO, true, true>(F.lds, g, S, E, F.wave); } SEAM(12);
    STAMP(13); if (IN(13)) { pg8::Gemm g{F.R1, F.Wdn1, M, D, FF}; SO S; S.init(M, D, F.G, (int)blockIdx.x); pg8::EpiResid<1, 1> E{F.XB, F.out, nullptr, nullptr, SSQ3};
        pg8::gemm_phase<pg8::EpiResid<1, 1>, SO, true, true>(F.lds, g, S, E, F.wave); }
    STAMP(NPH);
#ifdef PROBE_TOTAL
    if (blockIdx.x == 0) { const unsigned long long t1 = __builtin_amdgcn_s_memrealtime(), dt = (t1 - pt_start); while (__builtin_amdgcn_s_memrealtime() - t1 < dt) __builtin_amdgcn_s_sleep(8); }
#endif
#ifdef PROBE_ACC
    if (blockIdx.x == 0) { const unsigned long long t1 = __builtin_amdgcn_s_memrealtime(), dt = F.acc_sum * PROBE_MULT; while (__builtin_amdgcn_s_memrealtime() - t1 < dt) __builtin_amdgcn_s_sleep(8); }
#endif
#ifdef PROBE_PH
    if (blockIdx.x == 0) { const unsigned long long t1 = __builtin_amdgcn_s_memrealtime(), dt = (pt1 - pt0) * PROBE_MULT; while (__builtin_amdgcn_s_memrealtime() - t1 < dt) __builtin_amdgcn_s_sleep(8); }
#endif
#undef IN
#undef SEAM
}

extern "C" void kernel_launch(void* const* d_in, const int* in_sizes, int n_in, void* d_out, int out_size, void* d_ws, size_t ws_size, hipStream_t stream) {
    static int grid = 0;
    if (grid == 0) {
        if (n_in != 16 || in_sizes[0] != M * D || out_size != M * D || ws_size < WS_END) { fprintf(stderr, "kernel_launch: unexpected shapes / workspace (%d inputs, ws %zu)\n", n_in, ws_size); grid = -1; return; }
        int dev = 0, cus = 0;
        if (hipGetDevice(&dev) != hipSuccess || hipDeviceGetAttribute(&cus, hipDeviceAttributeMultiprocessorCount, dev) != hipSuccess) { grid = -1; return; }
        if (hipFuncSetAttribute((const void*)mk_fwd, hipFuncAttributeMaxDynamicSharedMemorySize, LDS_BYTES) != hipSuccess) { fprintf(stderr, "kernel_launch: hipFuncSetAttribute failed\n"); grid = -1; return; }
        (void)hipGetLastError();
        grid = cus;
    }
    if (grid < 0) return;
    if (hipMemsetAsync((char*)d_ws + WS_CTL, 0, CTL_ZERO_BYTES, stream) != hipSuccess) { fprintf(stderr, "kernel_launch: memset failed\n"); return; }
    Args a{};
    for (int i = 0; i < 16; ++i) a.in[i] = (const float*)d_in[i];
    a.out = (float*)d_out; a.ws = (unsigned char*)d_ws;
#if MK_PER_PHASE
    for (int ph = 0; ph < NPH; ++ph) { a.ph_lo = ph; a.ph_hi = ph + 1; hipLaunchKernelGGL(mk_fwd, dim3(grid), dim3(NTHR), LDS_BYTES, stream, a); }
#else
    a.ph_lo = 0; a.ph_hi = NPH;
    hipLaunchKernelGGL(mk_fwd, dim3(grid), dim3(NTHR), LDS_BYTES, stream, a);
#endif
    const hipError_t le = hipPeekAtLastError();
    if (le != hipSuccess) fprintf(stderr, "kernel_launch: launch failed: %s\n", hipGetErrorName(le));
}
```

```cpp
#include <hip/hip_runtime.h>
#include <cstdio>
#include <cstdint>
namespace pg8 {
#define PG8_LAS __attribute__((address_space(3)))
typedef unsigned short bf16_t;
typedef short bf16x8 __attribute__((ext_vector_type(8)));
typedef float f32x4 __attribute__((ext_vector_type(4)));
typedef unsigned u32x4 __attribute__((ext_vector_type(4)));
constexpr int BM = 256, BK = 64, HALF = 128, HTB = HALF * BK * 2  , STAGE_BYTES = 8 * HTB, NXCD = 8, WGM = 8;

__host__ __device__ __forceinline__ int lds_byte(int r, int c) { const int st = (r >> 4) * 2 + (c >> 5), rr = r & 15, cc = c & 31, ob = rr * 64 + cc * 2; return st * 1024 + (ob ^ (((ob >> 9) & 1) << 5)); }
__host__ __device__ __forceinline__ void stage_rc(int b, int& R, int& C) { const int st = b / 1024, sb = b % 1024, swz = sb ^ (((sb >> 9) & 1) << 5); R = (st >> 1) * 16 + swz / 64; C = (st & 1) * 32 + (swz % 64) / 2; }
__host__ __device__ __forceinline__ int perm32(int rho) { const int n = rho >> 4, i = rho & 15; return 8 * (i >> 2) + 4 * n + (i & 3); }

struct Unit { int pm, pn; };
struct Gemm { const bf16_t* A; const bf16_t* Bt; int M, N, K; };

struct StaticOrder {
    int nM, nN, nwg, G, c;
    __host__ __device__ void init(int M, int N, int G_, int c_) { nM = M / BM; nN = N / BM; nwg = nM * nN; G = G_; c = c_; }
    __host__ __device__ bool next(int i, Unit& u) const {
        const long L = (long)i * G + c; if (L >= nwg) return false;
        int wgid = (int)L; { const int q = nwg / NXCD, r = nwg % NXCD, xcd = wgid % NXCD, off = wgid / NXCD; wgid = (xcd < r ? xcd * (q + 1) : r * (q + 1) + (xcd - r) * q) + off; }
        const int nig = WGM * nN, gid = wgid / nig, fm = gid * WGM, gsz = (nM - fm) < WGM ? (nM - fm) : WGM;
        u.pm = fm + ((wgid % nig) % gsz); u.pn = (wgid % nig) / gsz; return true;
    }
    __device__ __forceinline__ void a_ready(const Unit&) const {}
    __device__ __forceinline__ void done(const Unit&) const {}
};

__device__ __forceinline__ unsigned cvt_pk_bf16(float lo, float hi) { unsigned r; asm volatile("v_cvt_pk_bf16_f32 %0, %1, %2" : "=v"(r) : "v"(lo), "v"(hi)); return r; }
__device__ __forceinline__ float row_rstd(const float* ssqp, int row) {
    const f32x4* p = (const f32x4*)(ssqp + (size_t)row * 16);
    const f32x4 a = p[0], b = p[1], c = p[2], d = p[3];
    const float s = (((a[0] + a[1]) + (a[2] + a[3])) + ((b[0] + b[1]) + (b[2] + b[3]))) + (((c[0] + c[1]) + (c[2] + c[3])) + ((d[0] + d[1]) + (d[2] + d[3])));
    return rsqrtf(s * (1.0f / 1024.0f) + 1e-6f);
}
__device__ __forceinline__ int epi_lane() { int l; asm volatile("v_mbcnt_lo_u32_b32 %0, -1, 0\n\tv_mbcnt_hi_u32_b32 %0, -1, %0" : "=v"(l)); return l; }
__device__ __forceinline__ float relu_bits(float x) { const int i = __builtin_bit_cast(int, x); return __builtin_bit_cast(float, i > 0 ? i : 0); }
template <int ACT  > struct EpiScale {
    static constexpr bool PERM = true, AFTER_DRAIN = false;
    bf16_t* O; int ldc; const float* ssqp;
    __device__ __forceinline__ void operator()(const f32x4 (&acc)[2][2][4][2], const Unit& u, int wr, int wc, int fr, int fq) const {
        const int row0 = u.pm * BM + wr * 64 + fr, col0 = u.pn * BM + wc * 32 + 8 * fq;
#pragma unroll
        for (int ai = 0; ai < 2; ++ai)
#pragma unroll
            for (int m = 0; m < 4; ++m) {
                const int row = row0 + ai * HALF + m * 16;
                const float rs = (ACT == 0) ? row_rstd(ssqp, row) : 1.0f;
                bf16_t* rowp = O + (size_t)row * ldc + col0;
#pragma unroll
                for (int bj = 0; bj < 2; ++bj) {
                    f32x4 v0 = acc[ai][bj][m][0] * rs, v1 = acc[ai][bj][m][1] * rs;
                    if (ACT == 1) {
#pragma unroll
                        for (int e = 0; e < 4; ++e) { const float a0 = relu_bits(v0[e]), a1 = relu_bits(v1[e]); v0[e] = a0 * a0; v1[e] = a1 * a1; }
                    }
                    u32x4 w; w.x = cvt_pk_bf16(v0[0], v0[1]); w.y = cvt_pk_bf16(v0[2], v0[3]); w.z = cvt_pk_bf16(v1[0], v1[1]); w.w = cvt_pk_bf16(v1[2], v1[3]);
                    *(u32x4*)(rowp + bj * HALF) = w;
                }
            }
    }
};
template <int RIN, int OUT> struct EpiResid {
    static constexpr bool PERM = true, AFTER_DRAIN = false;
    const void* R; float* out; bf16_t* hb; float* ssqp; const float* ssq_in;
    __device__ __forceinline__ void operator()(const f32x4 (&acc)[2][2][4][2], const Unit& u, int wr, int wc, int fr, int fq) const {
        const int row0 = u.pm * BM + wr * 64 + fr, col0 = u.pn * BM + wc * 32 + 8 * fq;
        constexpr int MB = 2;
        constexpr int NW = (RIN == 0) ? 2 : 1;
#pragma unroll
        for (int ai = 0; ai < 2; ++ai)
#pragma unroll
            for (int m0 = 0; m0 < 4; m0 += MB) {
                u32x4 rw[MB][2][NW]; f32x4 pp[MB][4];
#pragma unroll
                for (int mm = 0; mm < MB; ++mm)
#pragma unroll
                    for (int bj = 0; bj < 2; ++bj) { const unsigned off = (unsigned)((row0 + ai * HALF + (m0 + mm) * 16) * 1024 + col0 + bj * HALF);
                        if (RIN == 0) { rw[mm][bj][0] = *(const u32x4*)((const char*)R + off * 4u); rw[mm][bj][NW - 1] = *(const u32x4*)((const char*)R + off * 4u + 16u); }
                        else rw[mm][bj][0] = *(const u32x4*)((const char*)R + off * 2u); }
                if (ssq_in) {
#pragma unroll
                    for (int mm = 0; mm < MB; ++mm) { const f32x4* p = (const f32x4*)((const char*)ssq_in + (unsigned)(row0 + ai * HALF + (m0 + mm) * 16) * 64u);
#pragma unroll
                        for (int k = 0; k < 4; ++k) pp[mm][k] = p[k]; } }
                asm volatile("" ::: "memory");
#pragma unroll
                for (int mm = 0; mm < MB; ++mm) {
                    const int m = m0 + mm, row = row0 + ai * HALF + m * 16;
                    const unsigned off = (unsigned)(row * 1024 + col0);
                    float sc2 = 1.0f;
                    if (ssq_in) { const f32x4 a = pp[mm][0], b = pp[mm][1], c = pp[mm][2], d = pp[mm][3];
                        const float sum = (((a[0] + a[1]) + (a[2] + a[3])) + ((b[0] + b[1]) + (b[2] + b[3]))) + (((c[0] + c[1]) + (c[2] + c[3])) + ((d[0] + d[1]) + (d[2] + d[3])));
                        const float rs = rsqrtf(sum * (1.0f / 1024.0f) + 1e-6f); sc2 = rs * rs; }
                    float ss = 0.f;
#pragma unroll
                    for (int bj = 0; bj < 2; ++bj) {
                        f32x4 r0, r1;
                        if (RIN == 0) { r0 = __builtin_bit_cast(f32x4, rw[mm][bj][0]); r1 = __builtin_bit_cast(f32x4, rw[mm][bj][NW - 1]); }
                        else { const u32x4 w = rw[mm][bj][0];
                            r0 = (f32x4){__uint_as_float(w.x << 16), __uint_as_float(w.x & 0xffff0000u), __uint_as_float(w.y << 16), __uint_as_float(w.y & 0xffff0000u)};
                            r1 = (f32x4){__uint_as_float(w.z << 16), __uint_as_float(w.z & 0xffff0000u), __uint_as_float(w.w << 16), __uint_as_float(w.w & 0xffff0000u)}; }
                        const f32x4 v0 = acc[ai][bj][m][0] * sc2 + r0, v1 = acc[ai][bj][m][1] * sc2 + r1;
                        if (OUT == 1) { *(f32x4*)((char*)out + (off + bj * HALF) * 4u) = v0; *(f32x4*)((char*)out + (off + bj * HALF) * 4u + 16u) = v1; }
                        else {
                            u32x4 w; w.x = cvt_pk_bf16(v0[0], v0[1]); w.y = cvt_pk_bf16(v0[2], v0[3]); w.z = cvt_pk_bf16(v1[0], v1[1]); w.w = cvt_pk_bf16(v1[2], v1[3]);
                            *(u32x4*)((char*)hb + (off + bj * HALF) * 2u) = w;
                            ss += ((v0[0] * v0[0] + v0[1] * v0[1]) + (v0[2] * v0[2] + v0[3] * v0[3])) + ((v1[0] * v1[0] + v1[1] * v1[1]) + (v1[2] * v1[2] + v1[3] * v1[3]));
                        }
                    }
                    if (OUT == 0) { ss += __shfl_xor(ss, 16); ss += __shfl_xor(ss, 32); if (fq == 0) *(float*)((char*)ssqp + (unsigned)(row * 16 + u.pn * 4 + wc) * 4u) = ss; }
                }
            }
    }
};
struct EpiQKNorm {
    static constexpr bool PERM = true, AFTER_DRAIN = false;
    bf16_t* O; int ldc; const float* ssqp; const float* gq; const float* gk; PG8_LAS float* part; float qscale;
    __device__ __forceinline__ void operator()(const f32x4 (&acc)[2][2][4][2], const Unit& u, int wr, int wc, int fr_, int fq_) const {
        const int ln = epi_lane(), fr = ln & 15, fq = ln >> 4;
        const int row0 = u.pm * BM + wr * 64 + fr, col0 = u.pn * BM + wc * 32 + 8 * fq;
        const bool nrm = u.pn < 8;
        const int pbase = (wr * 64 + fr) * 8;
        PG8_LAS float* pr = part + pbase; PG8_LAS float* pw = pr + wc;
        float rsv[2][4];
#pragma unroll
        for (int ai = 0; ai < 2; ++ai) { f32x4 pp[4][4];
#pragma unroll
            for (int m = 0; m < 4; ++m) { const f32x4* p = (const f32x4*)((const char*)ssqp + (unsigned)(row0 + ai * HALF + m * 16) * 64u);
#pragma unroll
                for (int k = 0; k < 4; ++k) pp[m][k] = p[k]; }
#pragma unroll
            for (int m = 0; m < 4; ++m) { const f32x4 a = pp[m][0], b = pp[m][1], c = pp[m][2], d = pp[m][3];
                const float sum = (((a[0] + a[1]) + (a[2] + a[3])) + ((b[0] + b[1]) + (b[2] + b[3]))) + (((c[0] + c[1]) + (c[2] + c[3])) + ((d[0] + d[1]) + (d[2] + d[3])));
                rsv[ai][m] = rsqrtf(sum * (1.0f / 1024.0f) + 1e-6f); asm volatile("" : "+v"(rsv[ai][m]) :: "memory"); } }
        f32x4 g0 = (f32x4){1.f, 1.f, 1.f, 1.f}, g1 = g0;
        if (nrm) {
#pragma unroll
            for (int ai = 0; ai < 2; ++ai)
#pragma unroll
                for (int m = 0; m < 4; ++m)
#pragma unroll
                    for (int bj = 0; bj < 2; ++bj) { const f32x4 v0 = acc[ai][bj][m][0], v1 = acc[ai][bj][m][1];
                        float ss = ((v0[0] * v0[0] + v0[1] * v0[1]) + (v0[2] * v0[2] + v0[3] * v0[3])) + ((v1[0] * v1[0] + v1[1] * v1[1]) + (v1[2] * v1[2] + v1[3] * v1[3]));
                        ss += __shfl_xor(ss, 16); ss += __shfl_xor(ss, 32);
                        if (fq == 0) pw[((ai * HALF + m * 16) * 2 + bj) * 4] = ss; }
            asm volatile("s_waitcnt lgkmcnt(0)" ::: "memory"); __builtin_amdgcn_s_barrier(); asm volatile("" ::: "memory");
            const float* gp = (u.pn < 4 ? gq : gk) + wc * 32 + 8 * fq; const float sc = (u.pn < 4) ? qscale : 1.0f;
            g0 = *(const f32x4*)gp * sc; g1 = *(const f32x4*)(gp + 4) * sc;
        }
#pragma unroll
        for (int ai = 0; ai < 2; ++ai)
#pragma unroll
            for (int m = 0; m < 4; ++m) {
                const int row = row0 + ai * HALF + m * 16;
                const float rsr = rsv[ai][m];
                bf16_t* rowp = O + (size_t)row * ldc + col0;
#pragma unroll
                for (int bj = 0; bj < 2; ++bj) {
                    float hs = rsr;
                    if (nrm) { const f32x4 pp = *(const PG8_LAS f32x4*)(pr + ((ai * HALF + m * 16) * 2 + bj) * 4);
                        hs *= rsqrtf(((pp[0] + pp[1]) + (pp[2] + pp[3])) * (rsr * rsr * (1.0f / 128.0f)) + 1e-6f); }
                    const f32x4 v0 = acc[ai][bj][m][0] * hs * g0, v1 = acc[ai][bj][m][1] * hs * g1;
                    u32x4 w; w.x = cvt_pk_bf16(v0[0], v0[1]); w.y = cvt_pk_bf16(v0[2], v0[3]); w.z = cvt_pk_bf16(v1[0], v1[1]); w.w = cvt_pk_bf16(v1[2], v1[3]);
                    *(u32x4*)(rowp + bj * HALF) = w;
                }
            }
    }
};
struct EpiProjAB {
    static constexpr bool PERM = true, AFTER_DRAIN = false;
    bf16_t* O; int ldc; const float* ssqp; const float* gq; const float* gk; const float* r128; const float* r64; PG8_LAS float* part; float qscale;
    __device__ __forceinline__ void operator()(const f32x4 (&acc)[2][2][4][2], const Unit& u, int wr, int wc, int fr_, int fq_) const {
        const int ln = epi_lane(), fr = ln & 15, fq = ln >> 4;
        const int cb = wc * 32 + 8 * fq;
        const int row0 = u.pm * BM + wr * 64 + fr, col0 = u.pn * BM + cb, pn = u.pn;
        const bool qk = pn < 4, iq = (pn == 6) || (pn == 7) || (pn == 14);
        const int pbase = (wr * 64 + fr) * 8;
        PG8_LAS float* pr = part + pbase; PG8_LAS float* pw = pr + wc;
        const bool rope_qk = qk && (wc == 0), rope_iq = iq && !(wc & 1) && (pn != 14 || wc == 0);
        float rsv[2][4];
#pragma unroll
        for (int ai = 0; ai < 2; ++ai)
#pragma unroll
            for (int m = 0; m < 4; ++m) rsv[ai][m] = *(const float*)((const char*)ssqp + (unsigned)(row0 + ai * HALF + m * 16) * 64u);
#pragma unroll
        for (int ai = 0; ai < 2; ++ai)
#pragma unroll
            for (int m = 0; m < 4; ++m) rsv[ai][m] = rsqrtf(rsv[ai][m] * (1.0f / 1024.0f) + 1e-6f);
        f32x4 g0 = (f32x4){1.f, 1.f, 1.f, 1.f}, g1 = g0;
        if (qk) {
#pragma unroll
            for (int ai = 0; ai < 2; ++ai)
#pragma unroll
                for (int m = 0; m < 4; ++m)
#pragma unroll
                    for (int bj = 0; bj < 2; ++bj) { const f32x4 v0 = acc[ai][bj][m][0], v1 = acc[ai][bj][m][1];
                        float ss = ((v0[0] * v0[0] + v0[1] * v0[1]) + (v0[2] * v0[2] + v0[3] * v0[3])) + ((v1[0] * v1[0] + v1[1] * v1[1]) + (v1[2] * v1[2] + v1[3] * v1[3]));
                        ss += __shfl_xor(ss, 16); ss += __shfl_xor(ss, 32);
                        if (fq == 0) pw[((ai * HALF + m * 16) * 2 + bj) * 4] = ss; }
            asm volatile("s_waitcnt lgkmcnt(0)" ::: "memory"); __builtin_amdgcn_s_barrier(); asm volatile("" ::: "memory");
            const float* gp = (pn < 2 ? gq : gk) + cb; const float sc = (pn < 2) ? qscale : 1.0f;
            g0 = *(const f32x4*)gp * sc; g1 = *(const f32x4*)(gp + 4) * sc;
        }
#pragma unroll
        for (int ai = 0; ai < 2; ++ai) {
            f32x4 cc[4][4];
            if (rope_qk || rope_iq) {
#pragma unroll
                for (int m = 0; m < 4; ++m) { const int pos = (row0 + ai * HALF + m * 16) & 2047;
                    const float* t = rope_qk ? (r128 + pos * 32 + 8 * (fq & 1)) : (r64 + pos * 16); const int so = rope_qk ? 16 : 8;
                    cc[m][0] = *(const f32x4*)t; cc[m][1] = *(const f32x4*)(t + 4); cc[m][2] = *(const f32x4*)(t + so); cc[m][3] = *(const f32x4*)(t + so + 4); }
            }
#pragma unroll
            for (int m = 0; m < 4; ++m) {
                const int row = row0 + ai * HALF + m * 16;
                const float rsr = rsv[ai][m];
                bf16_t* rowp = O + (size_t)row * ldc + col0;
                const f32x4 c0 = cc[m][0], c1 = cc[m][1], s0 = cc[m][2], s1 = cc[m][3];
#pragma unroll
                for (int bj = 0; bj < 2; ++bj) {
                    float hs = rsr;
                    if (qk) { const f32x4 pp = *(const PG8_LAS f32x4*)(pr + ((ai * HALF + m * 16) * 2 + bj) * 4);
                        hs *= rsqrtf(((pp[0] + pp[1]) + (pp[2] + pp[3])) * (rsr * rsr * (1.0f / 128.0f)) + 1e-6f); }
                    f32x4 v0 = acc[ai][bj][m][0] * hs * g0, v1 = acc[ai][bj][m][1] * hs * g1;
                    if (rope_qk) {
                        f32x4 p0, p1;
#pragma unroll
                        for (int e = 0; e < 4; ++e) { p0[e] = __shfl_xor(v0[e], 32); p1[e] = __shfl_xor(v1[e], 32); }
                        if (fq < 2) { v0 = v0 * c0 - p0 * s0; v1 = v1 * c1 - p1 * s1; } else { v0 = v0 * c0 + p0 * s0; v1 = v1 * c1 + p1 * s1; }
                    } else if (rope_iq && (pn != 14 || bj == 0)) {
                        f32x4 p0, p1;
#pragma unroll
                        for (int e = 0; e < 4; ++e) { p0[e] = __shfl_xor(v0[e], 16); p1[e] = __shfl_xor(v1[e], 16); }
                        if (fq == 0) { v0 = v0 * c0 - p0 * s0; v1 = v1 * c1 - p1 * s1; } else if (fq == 1) { v0 = v0 * c0 + p0 * s0; v1 = v1 * c1 + p1 * s1; }
                    }
                    u32x4 w; w.x = cvt_pk_bf16(v0[0], v0[1]); w.y = cvt_pk_bf16(v0[2], v0[3]); w.z = cvt_pk_bf16(v1[0], v1[1]); w.w = cvt_pk_bf16(v1[2], v1[3]);
                    *(u32x4*)(rowp + bj * HALF) = w;
                }
            }
        }
    }
};
template <class Epi, class Sched, bool ALIGN_EPI = false, bool SP2 = false>
__device__ __forceinline__ void gemm_phase(PG8_LAS unsigned char* lds, const Gemm g, const Sched& S, const Epi& E, const int wave_in) {
    const int wid = wave_in, lane = (int)__builtin_amdgcn_mbcnt_hi(~0u, __builtin_amdgcn_mbcnt_lo(~0u, 0u)), tid = wid * 64 + lane, wr = wid >> 2, wc = wid & 3, fr = lane & 15, fq = lane >> 4;
    const int K = g.K, nt = K / BK;
    unsigned voffA[2], voffB[2];
#pragma unroll
    for (int i = 0; i < 2; ++i) { int R, C; stage_rc(tid * 16 + i * 8192, R, C); const int Rb = Epi::PERM ? ((R & ~31) + perm32(R & 31)) : R;
        voffA[i] = (unsigned)(R * K + C) * 2u; voffB[i] = (unsigned)(Rb * K + C) * 2u; }
    const size_t kstep = (size_t)(BK * 2);
    const size_t hstep = (size_t)HALF * K * 2;
    const size_t tstep = 2 * hstep;
    const unsigned ldsw = (unsigned)wid * 1024u;
    const int aoff = lds_byte(wr * 64 + fr, fq * 8), boff = lds_byte(wc * 32 + fr, fq * 8);
#define PG8_SA(b, h) (((b) * 2 + (h)) * HTB)
#define PG8_SB(b, h) ((4 + (b) * 2 + (h)) * HTB)
#define PG8_STAGE(bufoff, gbase, voff) do { _Pragma("unroll") for (int _i = 0; _i < 2; ++_i) \
        __builtin_amdgcn_global_load_lds((const unsigned*)((const char*)(gbase) + (voff)[_i]), (PG8_LAS unsigned*)(lds + (bufoff) + ldsw + _i * 8192), 16, 0, 0); } while (0)
#define PG8_LDA(dst, b, h) do { _Pragma("unroll") for (int m = 0; m < 4; ++m) _Pragma("unroll") for (int k = 0; k < 2; ++k) dst[m][k] = *(const PG8_LAS bf16x8*)(lds + PG8_SA(b, h) + aoff + m * 2048 + k * 1024); } while (0)
#define PG8_LDB(dst, b, h) do { _Pragma("unroll") for (int n = 0; n < 2; ++n) _Pragma("unroll") for (int k = 0; k < 2; ++k) dst[n][k] = *(const PG8_LAS bf16x8*)(lds + PG8_SB(b, h) + boff + n * 2048 + k * 1024); } while (0)
#define PG8_MMA(ai, bj, At, Bt) do { __builtin_amdgcn_s_setprio(1); _Pragma("unroll") for (int m = 0; m < 4; ++m) _Pragma("unroll") for (int n = 0; n < 2; ++n) _Pragma("unroll") for (int k = 0; k < 2; ++k) \
        acc[ai][bj][m][n] = __builtin_amdgcn_mfma_f32_16x16x32_bf16(Bt[n][k], At[m][k], acc[ai][bj][m][n], 0, 0, 0); __builtin_amdgcn_s_setprio(0); } while (0)
#define PG8_WAIT_V(n) asm volatile("s_waitcnt vmcnt(" #n ")" ::: "memory")
#define PG8_WAIT_L(n) asm volatile("s_waitcnt lgkmcnt(" #n ")" ::: "memory")
#define PG8_BAR __builtin_amdgcn_s_barrier()
#define PG8_SCHED __builtin_amdgcn_sched_barrier(0)
    Unit cur, nxt; int ui = 0;
    if (!S.next(0, cur)) return;
    f32x4 acc[2][2][4][2];
#pragma unroll
    for (int a = 0; a < 2; ++a)
#pragma unroll
        for (int b = 0; b < 2; ++b)
#pragma unroll
            for (int m = 0; m < 4; ++m)
#pragma unroll
                for (int n = 0; n < 2; ++n) acc[a][b][m][n] = (f32x4){0.f, 0.f, 0.f, 0.f};
    bf16x8 At[4][2], B0[2][2], B1[2][2];
    const char* cA = (const char*)g.A + (size_t)cur.pm * tstep; const char* cB = (const char*)g.Bt + (size_t)cur.pn * tstep;
    S.a_ready(cur);
    if constexpr (SP2) {
        PG8_STAGE(PG8_SB(0, 0), cB, voffB); PG8_STAGE(PG8_SB(0, 1), cB + hstep, voffB); PG8_STAGE(PG8_SA(0, 0), cA, voffA); PG8_STAGE(PG8_SA(0, 1), cA + hstep, voffA);
        if (wr == 1) PG8_BAR;
        PG8_WAIT_V(2); PG8_BAR;
        PG8_STAGE(PG8_SB(1, 0), cB + kstep, voffB); PG8_STAGE(PG8_SA(1, 0), cA + kstep, voffA); PG8_STAGE(PG8_SB(1, 1), cB + hstep + kstep, voffB);
        PG8_WAIT_V(6); PG8_BAR;
    } else {
        PG8_STAGE(PG8_SB(0, 0), cB, voffB); PG8_STAGE(PG8_SA(0, 0), cA, voffA); PG8_STAGE(PG8_SB(0, 1), cB + hstep, voffB); PG8_STAGE(PG8_SA(0, 1), cA + hstep, voffA);
        if (wr == 1) PG8_BAR;
        PG8_WAIT_V(4); PG8_BAR;
        PG8_STAGE(PG8_SB(1, 0), cB + kstep, voffB); PG8_STAGE(PG8_SA(1, 0), cA + kstep, voffA); PG8_STAGE(PG8_SB(1, 1), cB + hstep + kstep, voffB);
        PG8_WAIT_V(6); PG8_BAR;
    }
    for (;;) {
        const bool has_next = S.next(ui + 1, nxt);
        const char* nA = has_next ? (const char*)g.A + (size_t)nxt.pm * tstep : cA; const char* nB = has_next ? (const char*)g.Bt + (size_t)nxt.pn * tstep : cB;
        for (int t = 0; t < nt; t += 2) {
            const bool last = (t == nt - 2);
            const char* a1 = cA + (size_t)(t + 1) * kstep;
            const char* a2 = last ? nA : cA + (size_t)(t + 2) * kstep; const char* b2 = last ? nB : cB + (size_t)(t + 2) * kstep;
            const char* a3 = a2 + kstep; const char* b3 = b2 + kstep;
            if (last && has_next) S.a_ready(nxt);
            if constexpr (SP2) {
            PG8_LDB(B0, 0, 0); PG8_LDB(B1, 0, 1); PG8_SCHED; PG8_LDA(At, 0, 0); PG8_STAGE(PG8_SA(1, 1), a1 + hstep, voffA);
            PG8_WAIT_V(8); PG8_WAIT_L(0); PG8_BAR; PG8_MMA(0, 0, At, B0); PG8_MMA(0, 1, At, B1); PG8_BAR; PG8_SCHED;
            PG8_LDA(At, 0, 1); PG8_STAGE(PG8_SB(0, 0), b2, voffB); PG8_STAGE(PG8_SB(0, 1), b2 + hstep, voffB); PG8_STAGE(PG8_SA(0, 0), a2, voffA);
            PG8_WAIT_V(8); PG8_WAIT_L(0); PG8_BAR; PG8_MMA(1, 0, At, B0); PG8_MMA(1, 1, At, B1); PG8_BAR; PG8_SCHED;
            PG8_LDB(B0, 1, 0); PG8_LDB(B1, 1, 1); PG8_SCHED; PG8_LDA(At, 1, 0); PG8_STAGE(PG8_SA(0, 1), a2 + hstep, voffA);
            PG8_WAIT_V(8); PG8_WAIT_L(0); PG8_BAR; PG8_MMA(0, 0, At, B0); PG8_MMA(0, 1, At, B1); PG8_BAR; PG8_SCHED;
            PG8_LDA(At, 1, 1); PG8_STAGE(PG8_SB(1, 0), b3, voffB); PG8_STAGE(PG8_SB(1, 1), b3 + hstep, voffB); PG8_STAGE(PG8_SA(1, 0), a3, voffA);
            PG8_WAIT_V(8); PG8_WAIT_L(0); PG8_BAR; PG8_MMA(1, 0, At, B0); PG8_MMA(1, 1, At, B1); PG8_BAR; PG8_SCHED;
            } else {
            PG8_LDB(B0, 0, 0); PG8_SCHED; PG8_LDA(At, 0, 0); PG8_STAGE(PG8_SA(1, 1), a1 + hstep, voffA);
            PG8_WAIT_L(8); PG8_BAR; PG8_WAIT_L(0); PG8_MMA(0, 0, At, B0); PG8_BAR; PG8_SCHED;
            PG8_LDB(B1, 0, 1); PG8_STAGE(PG8_SB(0, 0), b2, voffB);
            PG8_BAR; PG8_WAIT_L(0); PG8_MMA(0, 1, At, B1); PG8_BAR;
            PG8_LDA(At, 0, 1); PG8_STAGE(PG8_SA(0, 0), a2, voffA);
            PG8_BAR; PG8_WAIT_L(0); PG8_MMA(1, 0, At, B0); PG8_BAR; PG8_SCHED;
            PG8_STAGE(PG8_SB(0, 1), b2 + hstep, voffB);
            PG8_WAIT_V(6); PG8_BAR; PG8_MMA(1, 1, At, B1); PG8_BAR;
            PG8_LDB(B0, 1, 0); PG8_SCHED; PG8_LDA(At, 1, 0); PG8_STAGE(PG8_SA(0, 1), a2 + hstep, voffA);
            PG8_WAIT_L(8); PG8_BAR; PG8_WAIT_L(0); PG8_MMA(0, 0, At, B0); PG8_BAR; PG8_SCHED;
            PG8_LDB(B1, 1, 1); PG8_STAGE(PG8_SB(1, 0), b3, voffB);
            PG8_BAR; PG8_WAIT_L(0); PG8_MMA(0, 1, At, B1); PG8_BAR;
            PG8_LDA(At, 1, 1); PG8_STAGE(PG8_SA(1, 0), a3, voffA);
            PG8_BAR; PG8_WAIT_L(0); PG8_MMA(1, 0, At, B0); PG8_BAR; PG8_SCHED;
            PG8_STAGE(PG8_SB(1, 1), b3 + hstep, voffB);
            PG8_WAIT_V(6); PG8_BAR; PG8_MMA(1, 1, At, B1); PG8_BAR;
            }
        }
        if constexpr (ALIGN_EPI) { if (wr == 0) PG8_BAR; }
        if constexpr (!Epi::AFTER_DRAIN) { E(acc, cur, wr, wc, fr, fq); S.done(cur); }
        if (!has_next) break;
#pragma unroll
        for (int a = 0; a < 2; ++a)
#pragma unroll
            for (int b = 0; b < 2; ++b)
#pragma unroll
                for (int m = 0; m < 4; ++m)
#pragma unroll
                    for (int n = 0; n < 2; ++n) acc[a][b][m][n] = (f32x4){0.f, 0.f, 0.f, 0.f};
        cur = nxt; cA = nA; cB = nB; ++ui;
        if constexpr (ALIGN_EPI) { if (wr == 1) PG8_BAR; }
    }
    PG8_WAIT_V(0);
    if constexpr (!ALIGN_EPI) { if (wr == 0) PG8_BAR; }
    PG8_BAR;
    if constexpr (Epi::AFTER_DRAIN) { E.fused(acc, cur, wr, wc, fr, fq, lds, wid, lane); S.done(cur); }
#undef PG8_SA
#undef PG8_SB
#undef PG8_STAGE
#undef PG8_LDA
#undef PG8_LDB
#undef PG8_MMA
#undef PG8_WAIT_V
#undef PG8_WAIT_L
#undef PG8_BAR
#undef PG8_SCHED
}
}
#include <cmath>
constexpr int NWAVES = 8, NTHR = 512;
constexpr int BATCH = 16, SEQ = 2048, M = BATCH * SEQ, D = 1024, FF = 4096, NAB = 3840, NC = 3072, ABP_OLD = 3672;
constexpr int C_QA = 0, C_KA = 512, C_VA = 1024, C_IQ = 1536, C_QB = 2048, C_KB = 2304, C_VB = 2560, C_OG = 3072, C_IK = 3584, C_IW = 3648, C_GL = 3656;
constexpr float EPS = 1e-6f;
constexpr size_t MiB = 1u << 20;
constexpr size_t WS_CTL = 0, CTL_ZERO_BYTES = 64 * 1024;
constexpr size_t WS_WAB = 1 * MiB, WS_WOAB = 9 * MiB, WS_WUP0 = 11 * MiB, WS_WDN0 = 19 * MiB, WS_WINC = 27 * MiB, WS_WOC = 33 * MiB, WS_WUP1 = 35 * MiB, WS_WDN1 = 43 * MiB;
constexpr size_t WS_SSQ = 51 * MiB, SSQ_BYTES = 2 * MiB;
constexpr size_t WS_DEC = 59 * MiB;
constexpr size_t WS_ROPE = 59 * MiB + 512 * 1024;
constexpr size_t WS_XB = 60 * MiB;
constexpr size_t WS_CAT = 124 * MiB;
constexpr size_t WS_MASK = 188 * MiB;
constexpr size_t WS_R1 = 196 * MiB;
constexpr size_t WS_BC = 452 * MiB;
constexpr size_t WS_END = 484 * MiB;
constexpr int CW_BAR = 4096;
constexpr int RING_BYTES = 131072;
constexpr int LDS_BYTES = 163840;
constexpr int MISC_OFF = LDS_BYTES - 256;
#define GAS __attribute__((address_space(1)))
#define LAS __attribute__((address_space(3)))
typedef unsigned short bf16;
typedef unsigned v4u __attribute__((ext_vector_type(4)));
typedef float f32x4 __attribute__((ext_vector_type(4)));
typedef short bf16x8 __attribute__((ext_vector_type(8)));
typedef GAS unsigned gu32;
typedef GAS unsigned long long gu64;
#define RLX_AGENT __ATOMIC_RELAXED, __HIP_MEMORY_SCOPE_AGENT
#define LDS_WAIT() asm volatile("s_waitcnt lgkmcnt(0)" ::: "memory")
#define VM_WAIT() asm volatile("s_waitcnt vmcnt(0)" ::: "memory")
__device__ __forceinline__ unsigned long long rt() { return __builtin_amdgcn_s_memrealtime(); }
__device__ __forceinline__ unsigned f2bf(float f) { unsigned u = __builtin_bit_cast(unsigned, f); return (u + 0x7fffu + ((u >> 16) & 1u)) >> 16; }
__device__ __forceinline__ unsigned pk2(float lo, float hi) { return f2bf(lo) | (f2bf(hi) << 16); }
#define XB_TMO      128
#define XB_XCNT(j)  (256  + 64 * (j))
#define XB_XSUB(j)  (1280 + 64 * (j))
#define XB_XGEN(j)  (2304 + 64 * (j))
#define XB_TOP      3328
#define XB_TOPGEN   3392
#define XCD_BAR_WORDS 3456
#define XB_SPIN_CAP (1u << 18)

__device__ __forceinline__ unsigned xb_ld(unsigned* p)              { return __hip_atomic_load(p, __ATOMIC_RELAXED, __HIP_MEMORY_SCOPE_AGENT); }
__device__ __forceinline__ unsigned xb_add(unsigned* p, unsigned v) { return __hip_atomic_fetch_add(p, v, __ATOMIC_RELAXED, __HIP_MEMORY_SCOPE_AGENT); }
__device__ __forceinline__ unsigned xb_xcc_id() { return (unsigned)__builtin_amdgcn_s_getreg((3 << 11) | 20) & 0xFu; }
#define XB_SPIN(cond, bar) do { unsigned _sp = 0; while (cond) { __builtin_amdgcn_s_sleep(1); \
    if ((++_sp & 255u) == 0u) { if (xb_ld(&(bar)[XB_TMO])) break; if (_sp > XB_SPIN_CAP) { atomicAdd(&(bar)[XB_TMO], 1u); break; } } } } while (0)

struct XcdBarrier {
    unsigned* bar; unsigned x; int wave;
    volatile LAS unsigned* st;
};

__device__ __forceinline__ bool xb_t0(int wave) { return wave == 0 && __builtin_amdgcn_mbcnt_hi(~0u, __builtin_amdgcn_mbcnt_lo(~0u, 0u)) == 0u; }
__device__ __forceinline__ XcdBarrier xcd_barrier_post(unsigned* bar, volatile LAS unsigned* st, int wave) {
    XcdBarrier b; b.bar = bar; b.x = xb_xcc_id(); b.st = st; b.wave = wave;
    if (xb_t0(wave)) (void)xb_add(&bar[XB_XCNT(b.x)], 1u);
    return b;
}
__device__ __forceinline__ void xcd_barrier_complete(unsigned* bar, unsigned x, unsigned& nloc, unsigned& nx) {
    const unsigned G = gridDim.x * gridDim.y * gridDim.z;
    unsigned sum, cnt, mine, sp = 0u;
    for (;;) {
        sum = 0u; cnt = 0u; mine = 0u;
#pragma unroll
        for (unsigned j = 0; j < 16; ++j) { const unsigned c = xb_ld(&bar[XB_XCNT(j)]); sum += c; cnt += (c > 0u) ? 1u : 0u; mine = (j == x) ? c : mine; }
        if (sum == G) break;
        __builtin_amdgcn_s_sleep(1);
        if ((++sp & 255u) == 0u) { if (xb_ld(&bar[XB_TMO])) break; if (sp > XB_SPIN_CAP) { atomicAdd(&bar[XB_TMO], 1u); break; } }
    }
    nloc = mine > 0u ? mine : 1u; nx = cnt > 0u ? cnt : 1u;
}

__device__ __forceinline__ void xcd_barrier(const XcdBarrier& b) {
    asm volatile("s_waitcnt vmcnt(0)" ::: "memory");
    __syncthreads();
    if (xb_t0(b.wave)) {
        unsigned* bar = b.bar;
        __builtin_amdgcn_s_waitcnt(0);
        unsigned nloc = b.st[0], nx = b.st[1];
        if (nloc == 0u) { xcd_barrier_complete(bar, b.x, nloc, nx); b.st[0] = nloc; b.st[1] = nx; }
        const unsigned old = xb_add(&bar[XB_XSUB(b.x)], 1u);
        const unsigned gen = old / nloc;
        if (old + 1u == (gen + 1u) * nloc) {
            __builtin_amdgcn_fence(__ATOMIC_RELEASE, "agent");
            asm volatile("s_waitcnt vmcnt(0)" ::: "memory");
            const unsigned og = xb_add(&bar[XB_TOP], 1u);
            const unsigned tg = og / nx;
            if (og + 1u == (tg + 1u) * nx) xb_add(&bar[XB_TOPGEN], 1u);
            else XB_SPIN(xb_ld(&bar[XB_TOPGEN]) == tg, bar);
            __builtin_amdgcn_fence(__ATOMIC_ACQUIRE, "agent");
            xb_add(&bar[XB_XGEN(b.x)], 1u);
            asm volatile("s_waitcnt vmcnt(0)" ::: "memory");
        } else {
            XB_SPIN(xb_ld(&bar[XB_XGEN(b.x)]) == gen, bar);
            __builtin_amdgcn_fence(__ATOMIC_ACQUIRE, "agent");
            asm volatile("s_waitcnt vmcnt(0)" ::: "memory");
        }
    }
    __syncthreads();
}
#ifdef PROBE_ACC
#ifdef PROBE_NOSYNC
#define ACC_BEGIN(F, id) do { if ((id) == PROBE_ACC) { asm volatile("" ::: "memory"); (F).acc_t0 = __builtin_amdgcn_s_memrealtime(); asm volatile("" ::: "memory"); } } while (0)
#define ACC_END(F, id) do { if ((id) == PROBE_ACC) { asm volatile("" ::: "memory"); (F).acc_sum += __builtin_amdgcn_s_memrealtime() - (F).acc_t0; asm volatile("" ::: "memory"); } } while (0)
#else
#define ACC_BEGIN(F, id) do { if ((id) == PROBE_ACC) { __syncthreads(); (F).acc_t0 = __builtin_amdgcn_s_memrealtime(); } } while (0)
#define ACC_END(F, id) do { if ((id) == PROBE_ACC) { __syncthreads(); (F).acc_sum += __builtin_amdgcn_s_memrealtime() - (F).acc_t0; } } while (0)
#endif
#else
#define ACC_BEGIN(F, id) do { } while (0)
#define ACC_END(F, id) do { } while (0)
#endif
struct Frame {
#ifdef PROBE_ACC
    unsigned long long acc_t0, acc_sum;
#endif
    LAS unsigned char* lds;
    volatile LAS unsigned* MISC;
    gu32* ctl;
    int tid, lane, wave, vcu, G;
    const float *x, *g_mix, *g_ffn, *w_in_ab, *gq_a, *gk_a, *w_gate_up, *b_gate, *g_gla, *w_out_ab, *w_in_c, *gq_c, *gk_c, *w_out_c, *w_up, *w_down;
    float* out;
    bf16 *Wab, *Woab, *Wup0, *Wdn0, *Winc, *Woc, *Wup1, *Wdn1;
    bf16 *XB, *CAT, *R1;
    float* SSQ; unsigned* MASK;
};
__device__ __forceinline__ int lane_id_opaque() { int l; asm volatile("v_mbcnt_lo_u32_b32 %0, -1, 0\n\tv_mbcnt_hi_u32_b32 %0, -1, %0" : "=v"(l)); return l; }
__device__ __forceinline__ float bf2f(bf16 v) { return __builtin_bit_cast(float, (unsigned)v << 16); }
__device__ __forceinline__ float wave_sum(float v) {
#pragma unroll
    for (int o = 1; o < 64; o <<= 1) v += __shfl_xor(v, o);
    return v;
}
__device__ __forceinline__ float wave_max(float v) {
#pragma unroll
    for (int o = 1; o < 64; o <<= 1) v = fmaxf(v, __shfl_xor(v, o));
    return v;
}
__device__ __forceinline__ float log_sigmoid(float x) { return fminf(x, 0.f) - log1pf(expf(-fabsf(x))); }

__device__ __forceinline__ int oldcol_ab(int n) {
    if (n < 2048) return n;
    if (n < 2304) return 2120 + (n - 2048);
    if (n < 2560) return 2376 + (n - 2304);
    if (n < 3072) return 2632 + (n - 2560);
    if (n < 3584) return 3160 + (n - 3072);
    if (n < 3648) return 2048 + (n - 3584);
    if (n < 3656) return 2112 + (n - 3648);
    if (n < 3672) return 3144 + (n - 3656);
    return -1;
}
__device__ __forceinline__ void p0_transpose_item(const float* W, int ldw, int K, const float* gain, bf16* WT, bool map, int item, int nblk, int lane) {
    const int kb = item / nblk, nb = item % nblk, ng = lane & 7, ko = lane >> 3, k0 = 64 * kb + 8 * ko, n = 32 * nb + 4 * ng;
    const int oc = map ? oldcol_ab(n) : n;
    f32x4 v[8];
#pragma unroll
    for (int i = 0; i < 8; ++i) { v[i] = (f32x4){0.f, 0.f, 0.f, 0.f}; if (oc >= 0) v[i] = *(const GAS f32x4*)(W + (size_t)(k0 + i) * ldw + oc); }
    if (gain) { const f32x4 g0 = *(const GAS f32x4*)(gain + k0), g1 = *(const GAS f32x4*)(gain + k0 + 4);
#pragma unroll
        for (int i = 0; i < 4; ++i) { v[i] = v[i] * g0[i]; v[4 + i] = v[4 + i] * g1[i]; } }
#pragma unroll
    for (int e = 0; e < 4; ++e) { v4u o; o.x = pk2(v[0][e], v[1][e]); o.y = pk2(v[2][e], v[3][e]); o.z = pk2(v[4][e], v[5][e]); o.w = pk2(v[6][e], v[7][e]);
        *(GAS v4u*)(WT + (size_t)(n + e) * K + k0) = o; }
}
template <int PART> __device__ __forceinline__ void prologue_weights(Frame& F, int gw, int NGW) {
    constexpr int I_AB = (D / 64) * (NAB / 32), I_O = (D / 64) * (D / 32), I_UP = (D / 64) * (FF / 32), I_DN = (FF / 64) * (D / 32), I_C = (D / 64) * (NC / 32);
    if (PART == 0) { for (int it = gw; it < I_AB; it += NGW) p0_transpose_item(F.w_in_ab, ABP_OLD, D, F.g_mix, F.Wab, true, it, NAB / 32, F.lane); return; }
    constexpr int NITEMS = 2 * I_O + 2 * I_UP + 2 * I_DN + I_C;
    for (int it = gw; it < NITEMS; it += NGW) {
        int r = it;
        if (r < I_O) { p0_transpose_item(F.w_out_ab, D, D, nullptr, F.Woab, false, r, D / 32, F.lane); continue; } r -= I_O;
        if (r < I_UP) { p0_transpose_item(F.w_up, FF, D, F.g_ffn, F.Wup0, false, r, FF / 32, F.lane); continue; } r -= I_UP;
        if (r < I_DN) { p0_transpose_item(F.w_down, D, FF, nullptr, F.Wdn0, false, r, D / 32, F.lane); continue; } r -= I_DN;
        if (r < I_C) { p0_transpose_item(F.w_in_c, NC, D, F.g_mix + D, F.Winc, false, r, NC / 32, F.lane); continue; } r -= I_C;
        if (r < I_O) { p0_transpose_item(F.w_out_c, D, D, nullptr, F.Woc, false, r, D / 32, F.lane); continue; } r -= I_O;
        if (r < I_UP) { p0_transpose_item(F.w_up + (size_t)D * FF, FF, D, F.g_ffn + D, F.Wup1, false, r, FF / 32, F.lane); continue; } r -= I_UP;
        p0_transpose_item(F.w_down + (size_t)FF * D, D, FF, nullptr, F.Wdn1, false, r, D / 32, F.lane);
    }
}
__device__ __forceinline__ void ph_prologue(Frame& F) {
    const int gw = F.vcu * NWAVES + F.wave, NGW = F.G * NWAVES;
    prologue_weights<0>(F, gw, NGW);
    if (F.G != 256) prologue_weights<1>(F, gw, NGW);
    for (int m0 = gw; m0 < M; m0 += 4 * NGW) {
        f32x4 v[4][4]; float s[4];
#pragma unroll
        for (int r = 0; r < 4; ++r) { const int m = m0 + r * NGW; const GAS f32x4* xr = (const GAS f32x4*)(F.x + (size_t)(m < M ? m : m0) * D) + F.lane;
#pragma unroll
            for (int j = 0; j < 4; ++j) v[r][j] = xr[64 * j]; }
#pragma unroll
        for (int r = 0; r < 4; ++r) { float t = 0.f;
#pragma unroll
            for (int j = 0; j < 4; ++j) t += (v[r][j].x * v[r][j].x + v[r][j].y * v[r][j].y) + (v[r][j].z * v[r][j].z + v[r][j].w * v[r][j].w);
            s[r] = t; }
#pragma unroll
        for (int o = 1; o < 64; o <<= 1) {
#pragma unroll
            for (int r = 0; r < 4; ++r) s[r] += __shfl_xor(s[r], o); }
#pragma unroll
        for (int r = 0; r < 4; ++r) { const int m = m0 + r * NGW; if (m < M) {
            GAS unsigned long long* o8 = (GAS unsigned long long*)(F.XB + (size_t)m * D) + F.lane;
#pragma unroll
            for (int j = 0; j < 4; ++j) o8[64 * j] = (unsigned long long)pk2(v[r][j].x, v[r][j].y) | ((unsigned long long)pk2(v[r][j].z, v[r][j].w) << 32);
            if (F.lane < 16) F.SSQ[(size_t)m * 16 + F.lane] = (F.lane == 0) ? s[r] : 0.f; } }
    }
}
namespace att {
typedef short s16x4 __attribute__((ext_vector_type(4)));
typedef float f32x16 __attribute__((ext_vector_type(16)));
typedef _Float16 f16x8 __attribute__((ext_vector_type(8)));
typedef unsigned u32x4 __attribute__((ext_vector_type(4)));
typedef short v4i16_t __attribute__((ext_vector_type(4)));
constexpr float C2 = 0.08838834764831845f * 1.4426950408889634f;
__device__ __forceinline__ int crow(int r, int hi) { return (r & 3) + 8 * (r >> 2) + 4 * hi; }
__device__ __forceinline__ int img_off(int row, int ch) { return 256 * row + 16 * (ch ^ (((row & 3) << 2) | ((row >> 2) & 3))); }
__device__ __forceinline__ bf16x8 pack8(float a0, float a1, float a2, float a3, float a4, float a5, float a6, float a7) {
    u32x4 w; w.x = pg8::cvt_pk_bf16(a0, a1); w.y = pg8::cvt_pk_bf16(a2, a3); w.z = pg8::cvt_pk_bf16(a4, a5); w.w = pg8::cvt_pk_bf16(a6, a7);
    return __builtin_bit_cast(bf16x8, w);
}
__device__ __forceinline__ f16x8 pack8h(float a0, float a1, float a2, float a3, float a4, float a5, float a6, float a7) {
    f16x8 r; r[0] = (_Float16)a0; r[1] = (_Float16)a1; r[2] = (_Float16)a2; r[3] = (_Float16)a3; r[4] = (_Float16)a4; r[5] = (_Float16)a5; r[6] = (_Float16)a6; r[7] = (_Float16)a7; return r;
}
__device__ __forceinline__ void dma_off_init(unsigned (&dvo)[2], int ld, int wave, int lane) {
#pragma unroll
    for (int i = 0; i < 2; ++i) { const int pi = 2 * wave + i, row = 4 * pi + (lane >> 4), pc = lane & 15, ch = pc ^ (((row & 3) << 2) | ((row >> 2) & 3)); dvo[i] = (unsigned)(row * ld + ch * 8) * 2u; }
}
__device__ __forceinline__ void tile_dma(const bf16* g, const unsigned (&dvo)[2], LAS unsigned char* buf, int wave) {
#pragma unroll
    for (int i = 0; i < 2; ++i) __builtin_amdgcn_global_load_lds((const unsigned*)((const char*)g + dvo[i]), (LAS unsigned*)(buf + 1024 * (2 * wave + i)), 16, 0, 0);
}
struct FragOff { int k[8]; int va[4]; int vd; };
__device__ __forceinline__ void frag_off_init(FragOff& fo, int lane) {
    const int hi = lane >> 5, r32 = lane & 31, i = lane & 15, q = i >> 2, p = i & 3, x = 2 * ((lane >> 4) & 1) + (p >> 1);
#pragma unroll
    for (int ks = 0; ks < 8; ++ks) fo.k[ks] = img_off(r32, 2 * ks + hi);
#pragma unroll
    for (int ct = 0; ct < 4; ++ct) fo.va[ct] = img_off(4 * hi + q, 4 * ct + x) + 8 * (p & 1);
    fo.vd = img_off(4 * hi + q + 8, x) - img_off(4 * hi + q, x);
}
__device__ __forceinline__ bf16x8 k_frag(const LAS unsigned char* kbuf, const FragOff& fo, int rt, int ks) { return *(const LAS bf16x8*)(kbuf + fo.k[ks] + 8192 * rt); }
__device__ __forceinline__ s16x4 vtr(const LAS unsigned char* p) { return __builtin_bit_cast(s16x4, __builtin_amdgcn_ds_read_tr16_b64_v4i16((LAS v4i16_t*)p)); }
__device__ __forceinline__ bf16x8 v_frag(const LAS unsigned char* vbuf, const FragOff& fo, int ct, int kk) {
    const s16x4 lo = vtr(vbuf + fo.va[ct] + 4096 * kk), hh = vtr(vbuf + fo.va[ct] + fo.vd + 4096 * kk);
    return (bf16x8){lo[0], lo[1], lo[2], lo[3], hh[0], hh[1], hh[2], hh[3]};
}
#define TR_READ(dst, addr, OFF) asm volatile("ds_read_b64_tr_b16 %0, %1 offset:%c2" : "=&v"(dst) : "v"(addr), "i"(OFF) : "memory")
#define LGKM_WAIT0() do { asm volatile("s_waitcnt lgkmcnt(0)" ::: "memory"); __builtin_amdgcn_sched_barrier(0); } while (0)
__device__ __forceinline__ bf16x8 mk_frag(s16x4 lo, s16x4 hh) { return (bf16x8){lo[0], lo[1], lo[2], lo[3], hh[0], hh[1], hh[2], hh[3]}; }
__device__ __forceinline__ int frag_va(int lane, int ct) { const int hi = lane >> 5, i = lane & 15, q = i >> 2, p = i & 3, x = 2 * ((lane >> 4) & 1) + (p >> 1); return img_off(4 * hi + q, 4 * ct + x) + 8 * (p & 1); }
__device__ __forceinline__ bf16x8 v_frag_rt(const LAS unsigned char* vbuf, int va, int vd, int kk) {
    const s16x4 lo = vtr(vbuf + va + 4096 * kk), hh = vtr(vbuf + va + vd + 4096 * kk);
    return (bf16x8){lo[0], lo[1], lo[2], lo[3], hh[0], hh[1], hh[2], hh[3]};
}
__device__ __forceinline__ void store_o(const f32x16 (&o)[4], const float (&rscale)[16], LAS unsigned char* stg, bf16* dst, int ld, int lane) {
    const int hi = lane >> 5, r32 = lane & 31;
#pragma unroll
    for (int r = 0; r < 16; ++r) { const int orow = crow(r, hi);
#pragma unroll
        for (int ct = 0; ct < 4; ++ct) *(LAS bf16*)(stg + orow * 256 + (32 * ct + r32) * 2) = (bf16)f2bf(o[ct][r] * rscale[r]); }
    asm volatile("s_waitcnt lgkmcnt(0)" ::: "memory");
#pragma unroll
    for (int i = 0; i < 8; ++i) { const int c = lane + 64 * i, row = c >> 4, ch = c & 15; const u32x4 v = *(const LAS u32x4*)(stg + row * 256 + ch * 16); *(u32x4*)(dst + (size_t)row * ld + ch * 8) = v; }
}
}
__device__ __forceinline__ void sb_unit(Frame& F, int b, int h, int qb) {
    using namespace att;
    const int tid = F.tid, lane = F.lane, w = F.wave, hi = lane >> 5, r32 = lane & 31;
    const bf16* Qg = F.R1 + (size_t)b * SEQ * NC + h * 128; const bf16* Kg = Qg + 1024; const bf16* Vg = Qg + 2048;
    const int T0 = qb * 256, t0w = T0 + 32 * w, jd = t0w >> 6, jtop = (T0 >> 6) + 3, tl = 32 * (w & 1) + r32, tl4 = tl - 4 * hi;
    LAS unsigned char* lds = F.lds;
    FragOff fo; frag_off_init(fo, lane);
    unsigned dvo[2]; dma_off_init(dvo, NC, w, lane);
    bf16x8 qf[8];
#pragma unroll
    for (int ks = 0; ks < 8; ++ks) qf[ks] = *(const bf16x8*)(Qg + (size_t)(t0w + r32) * NC + 16 * ks + 8 * hi);
    f16x8 T0f, T1f, ONEf;
#pragma unroll
    for (int j = 0; j < 8; ++j) { const int kp = 8 * (j >> 2) + 4 * hi + (j & 3); T0f[j] = (kp >= r32) ? (_Float16)1.0f : (_Float16)0.0f; T1f[j] = (kp + 16 >= r32) ? (_Float16)1.0f : (_Float16)0.0f; ONEf[j] = (_Float16)1.0f; }
    f32x16 o[4];
#pragma unroll
    for (int ct = 0; ct < 4; ++ct)
#pragma unroll
        for (int r = 0; r < 16; ++r) o[ct][r] = 0.f;
    float R2 = 0.f; bool done = false;
    volatile LAS unsigned* flags = F.MISC + 16;
    tile_dma(Kg + (size_t)(64 * jtop) * NC, dvo, lds, w); tile_dma(Vg + (size_t)(64 * jtop) * NC, dvo, lds + 16384, w);
    asm volatile("s_waitcnt vmcnt(0)" ::: "memory");
    __syncthreads();
    for (int j = jtop; j >= 0; --j) {
        const int cur = (jtop - j) & 1;
        const LAS unsigned char* kb = lds + cur * 32768; const LAS unsigned char* vb = kb + 16384;
        if (j > 0) { tile_dma(Kg + (size_t)(64 * (j - 1)) * NC, dvo, lds + (cur ^ 1) * 32768, w); tile_dma(Vg + (size_t)(64 * (j - 1)) * NC, dvo, lds + (cur ^ 1) * 32768 + 16384, w); }
        if (j <= jd && !done) {
            f32x16 p0, p1;
#pragma unroll
            for (int r = 0; r < 16; ++r) { p0[r] = 0.f; p1[r] = 0.f; }
            { bf16x8 kf[8];
#pragma unroll
              for (int ks = 0; ks < 8; ++ks) kf[ks] = k_frag(kb, fo, 0, ks);
#pragma unroll
              for (int ks = 0; ks < 8; ++ks) p0 = __builtin_amdgcn_mfma_f32_32x32x16_bf16(kf[ks], qf[ks], p0, 0, 0, 0);
#pragma unroll
              for (int ks = 0; ks < 8; ++ks) kf[ks] = k_frag(kb, fo, 1, ks);
#pragma unroll
              for (int ks = 0; ks < 8; ++ks) p1 = __builtin_amdgcn_mfma_f32_32x32x16_bf16(kf[ks], qf[ks], p1, 0, 0, 0); }
            s16x4 vl[4], vh[4], wl[4], wh[4];
            unsigned va0[4], va1[4];
#pragma unroll
            for (int ct = 0; ct < 4; ++ct) { va0[ct] = (unsigned)(size_t)vb + (unsigned)fo.va[ct]; va1[ct] = va0[ct] + (unsigned)fo.vd; }
            const bool diag = (j == jd);
            float x0[16], x1[16]; float rs = 0.f;
#pragma unroll
            for (int r = 0; r < 16; ++r) { const int key = (r & 3) + 8 * (r >> 2);
                float l0 = -__builtin_amdgcn_logf(1.0f + __builtin_amdgcn_exp2f(p0[r])), l1 = -__builtin_amdgcn_logf(1.0f + __builtin_amdgcn_exp2f(p1[r]));
                if (diag) { if (!(key < tl4)) l0 = 0.f; if (!(key + 32 < tl4)) l1 = 0.f; }
                x0[r] = l0; x1[r] = l1; rs += l0 + l1; p0[r] += R2; p1[r] += R2; }
            const f16x8 xb00 = pack8h(x0[0], x0[1], x0[2], x0[3], x0[4], x0[5], x0[6], x0[7]), xb01 = pack8h(x0[8], x0[9], x0[10], x0[11], x0[12], x0[13], x0[14], x0[15]);
            const f16x8 xb10 = pack8h(x1[0], x1[1], x1[2], x1[3], x1[4], x1[5], x1[6], x1[7]), xb11 = pack8h(x1[8], x1[9], x1[10], x1[11], x1[12], x1[13], x1[14], x1[15]);
            p0 = __builtin_amdgcn_mfma_f32_32x32x16_f16(T0f, xb00, p0, 0, 0, 0); p0 = __builtin_amdgcn_mfma_f32_32x32x16_f16(T1f, xb01, p0, 0, 0, 0);
            p0 = __builtin_amdgcn_mfma_f32_32x32x16_f16(ONEf, xb10, p0, 0, 0, 0); p0 = __builtin_amdgcn_mfma_f32_32x32x16_f16(ONEf, xb11, p0, 0, 0, 0);
            p1 = __builtin_amdgcn_mfma_f32_32x32x16_f16(T0f, xb10, p1, 0, 0, 0); p1 = __builtin_amdgcn_mfma_f32_32x32x16_f16(T1f, xb11, p1, 0, 0, 0);
#pragma unroll
            for (int r = 0; r < 16; ++r) { const int key = (r & 3) + 8 * (r >> 2);
                float a0 = __builtin_amdgcn_exp2f(p0[r]), a1 = __builtin_amdgcn_exp2f(p1[r]);
                if (diag) { if (!(key < tl4)) a0 = 0.f; if (!(key + 32 < tl4)) a1 = 0.f; }
                p0[r] = a0; p1[r] = a1; }
            const bf16x8 pa0 = pack8(p0[0], p0[1], p0[2], p0[3], p0[4], p0[5], p0[6], p0[7]), pa1 = pack8(p0[8], p0[9], p0[10], p0[11], p0[12], p0[13], p0[14], p0[15]);
            const bf16x8 pa2 = pack8(p1[0], p1[1], p1[2], p1[3], p1[4], p1[5], p1[6], p1[7]), pa3 = pack8(p1[8], p1[9], p1[10], p1[11], p1[12], p1[13], p1[14], p1[15]);
#pragma unroll
            for (int ct = 0; ct < 4; ++ct) { TR_READ(vl[ct], va0[ct], 0); TR_READ(vh[ct], va1[ct], 0); }
            LGKM_WAIT0();
#pragma unroll
            for (int ct = 0; ct < 4; ++ct) { TR_READ(wl[ct], va0[ct], 4096); TR_READ(wh[ct], va1[ct], 4096); }
#pragma unroll
            for (int ct = 0; ct < 4; ++ct) o[ct] = __builtin_amdgcn_mfma_f32_32x32x16_bf16(pa0, mk_frag(vl[ct], vh[ct]), o[ct], 0, 0, 0);
            LGKM_WAIT0();
#pragma unroll
            for (int ct = 0; ct < 4; ++ct) { TR_READ(vl[ct], va0[ct], 8192); TR_READ(vh[ct], va1[ct], 8192); }
#pragma unroll
            for (int ct = 0; ct < 4; ++ct) o[ct] = __builtin_amdgcn_mfma_f32_32x32x16_bf16(pa1, mk_frag(wl[ct], wh[ct]), o[ct], 0, 0, 0);
            LGKM_WAIT0();
#pragma unroll
            for (int ct = 0; ct < 4; ++ct) { TR_READ(wl[ct], va0[ct], 12288); TR_READ(wh[ct], va1[ct], 12288); }
#pragma unroll
            for (int ct = 0; ct < 4; ++ct) o[ct] = __builtin_amdgcn_mfma_f32_32x32x16_bf16(pa2, mk_frag(vl[ct], vh[ct]), o[ct], 0, 0, 0);
            LGKM_WAIT0();
#pragma unroll
            for (int ct = 0; ct < 4; ++ct) o[ct] = __builtin_amdgcn_mfma_f32_32x32x16_bf16(pa3, mk_frag(wl[ct], wh[ct]), o[ct], 0, 0, 0);
            rs += __shfl_xor(rs, 32);
            R2 += rs;
            done = __all(R2 < -152.0f);
        }
        if (lane == 0) flags[cur * 8 + w] = done ? 1u : 0u;
        asm volatile("s_waitcnt vmcnt(0) lgkmcnt(0)" ::: "memory");
        __syncthreads();
        unsigned alld = 1u;
#pragma unroll
        for (int i = 0; i < 8; ++i) alld &= flags[cur * 8 + i];
        if (alld) break;
    }
    float ones[16];
#pragma unroll
    for (int r = 0; r < 16; ++r) ones[r] = 1.0f;
    store_o(o, ones, lds + w * 8192, F.CAT + (size_t)(b * SEQ + t0w) * D + h * 128, D, lane);
    __syncthreads();
}
__device__ __forceinline__ void ph_sb(Frame& F) {
    for (int v = F.vcu; v < BATCH * 8 * 2; v += F.G) {
        const int bh = v >> 1, half = v & 1;
#pragma unroll 1
        for (int i = 0; i < 4; ++i) { const int qb = half ? (i == 0 ? 1 : i == 1 ? 6 : i == 2 ? 2 : 5) : (i == 0 ? 0 : i == 1 ? 7 : i == 2 ? 3 : 4); sb_unit(F, bh >> 3, bh & 7, qb); }
    }
}
__device__ __forceinline__ void dsa_unit(Frame& F, int b, int h, int ub, float mref) {
    using namespace att;
    const int lane = F.lane, w = F.wave, hi = lane >> 5, r32 = lane & 31;
    const bf16* Qg = F.R1 + (size_t)b * SEQ * NAB + C_QA + h * 128; const bf16* Kg = F.R1 + (size_t)b * SEQ * NAB + C_KA + h * 128; const bf16* Vg = F.R1 + (size_t)b * SEQ * NAB + C_VA + h * 128;
    const int t0w = 256 * ub + 32 * w, cw = t0w >> 6, jlast = 4 * ub + 3;
    LAS unsigned char* lds = F.lds;
    LAS unsigned char* mst = lds + 65536 + w * 8448;
    FragOff fo; frag_off_init(fo, lane);
    unsigned dvo[2]; dma_off_init(dvo, NAB, w, lane);
    tile_dma(Kg, dvo, lds, w); tile_dma(Vg, dvo, lds + 16384, w);
    bf16x8 qf[8];
#pragma unroll
    for (int ks = 0; ks < 8; ++ks) qf[ks] = *(const bf16x8*)(Qg + (size_t)(t0w + r32) * NAB + 16 * ks + 8 * hi);
    { const unsigned* mg = F.MASK + (size_t)(b * SEQ + t0w) * 64;
#pragma unroll 2
      for (int i = 0; i < 8; ++i) { const int c = lane + 64 * i, row = c >> 4, c4 = c & 15; const u32x4 v = *(const u32x4*)(mg + row * 64 + c4 * 4);
          *(LAS unsigned long long*)(mst + row * 264 + c4 * 16) = (unsigned long long)v.x | ((unsigned long long)v.y << 32);
          *(LAS unsigned long long*)(mst + row * 264 + c4 * 16 + 8) = (unsigned long long)v.z | ((unsigned long long)v.w << 32); } }
    f32x16 o[4];
#pragma unroll
    for (int ct = 0; ct < 4; ++ct)
#pragma unroll
        for (int r = 0; r < 16; ++r) o[ct][r] = 0.f;
    float lsum = 0.f;
    asm volatile("s_waitcnt vmcnt(0) lgkmcnt(0)" ::: "memory");
    __syncthreads();
    for (int j = 0; j <= jlast; ++j) {
        const int cur = j & 1;
        const LAS unsigned char* kb = lds + cur * 32768; const LAS unsigned char* vb = kb + 16384;
        if (j < jlast) { tile_dma(Kg + (size_t)(64 * (j + 1)) * NAB, dvo, lds + (cur ^ 1) * 32768, w); tile_dma(Vg + (size_t)(64 * (j + 1)) * NAB, dvo, lds + (cur ^ 1) * 32768 + 16384, w); }
        if (j <= cw) {
            const unsigned long long mw = *(const LAS unsigned long long*)(mst + r32 * 264 + j * 8);
            const unsigned mw0 = (unsigned)mw, mw1 = (unsigned)(mw >> 32);
#pragma unroll 1
            for (int half = 0; half < 2; ++half) {
                const unsigned mwh = (half ? mw1 : mw0) >> (4 * hi);
                bf16x8 kf[8];
#pragma unroll
                for (int ks = 0; ks < 8; ++ks) kf[ks] = k_frag(kb, fo, half, ks);
                f32x16 p;
#pragma unroll
                for (int r = 0; r < 16; ++r) p[r] = 0.f;
#pragma unroll
                for (int ks = 0; ks < 8; ++ks) p = __builtin_amdgcn_mfma_f32_32x32x16_bf16(kf[ks], qf[ks], p, 0, 0, 0);
#pragma unroll
                for (int r = 0; r < 16; ++r) { const unsigned keep = (unsigned)(-(int)((mwh >> ((r & 3) + 8 * (r >> 2))) & 1u));
                    const float e = __uint_as_float(__float_as_uint(__builtin_amdgcn_exp2f(p[r] - mref)) & keep); p[r] = e; lsum += e; }
                const bf16x8 pa0 = pack8(p[0], p[1], p[2], p[3], p[4], p[5], p[6], p[7]), pa1 = pack8(p[8], p[9], p[10], p[11], p[12], p[13], p[14], p[15]);
                s16x4 vl[8], vh[8];
                const unsigned vbase = (unsigned)(size_t)vb + 8192u * (unsigned)half;
#pragma unroll
                for (int ct = 0; ct < 4; ++ct) { const unsigned a0 = vbase + (unsigned)fo.va[ct], a1 = a0 + (unsigned)fo.vd;
                    TR_READ(vl[2 * ct], a0, 0); TR_READ(vh[2 * ct], a1, 0); TR_READ(vl[2 * ct + 1], a0, 4096); TR_READ(vh[2 * ct + 1], a1, 4096); }
                LGKM_WAIT0();
#pragma unroll
                for (int ct = 0; ct < 4; ++ct) {
                    o[ct] = __builtin_amdgcn_mfma_f32_32x32x16_bf16(pa0, mk_frag(vl[2 * ct], vh[2 * ct]), o[ct], 0, 0, 0);
                    o[ct] = __builtin_amdgcn_mfma_f32_32x32x16_bf16(pa1, mk_frag(vl[2 * ct + 1], vh[2 * ct + 1]), o[ct], 0, 0, 0);
                }
            }
        }
        asm volatile("s_waitcnt vmcnt(0) lgkmcnt(0)" ::: "memory");
        __syncthreads();
    }
    lsum += __shfl_xor(lsum, 32);
    LAS float* lsc = (LAS float*)mst;
    if (hi == 0) lsc[r32] = 1.0f / lsum;
    asm volatile("s_waitcnt lgkmcnt(0)" ::: "memory");
    float rsc[16];
#pragma unroll
    for (int r = 0; r < 16; ++r) rsc[r] = lsc[crow(r, hi)];
    store_o(o, rsc, lds + w * 8192, F.CAT + (size_t)(b * SEQ + t0w) * D + h * 128, D, lane);
    __syncthreads();
}
__device__ __forceinline__ void ph_dsa(Frame& F) {
    float gm = fmaxf(fabsf(F.gq_a[F.lane]), fabsf(F.gq_a[64 + F.lane])), km = fmaxf(fabsf(F.gk_a[F.lane]), fabsf(F.gk_a[64 + F.lane]));
    gm = wave_max(gm); km = wave_max(km);
    const float mref = att::C2 * 128.0f * gm * km * 1.02f;
    for (int v = F.vcu; v < BATCH * 4 * 4; v += F.G) {
        const int bh = v >> 2, pi = v & 3;
#pragma unroll 1
        for (int k = 0; k < 2; ++k) dsa_unit(F, bh >> 2, bh & 3, k ? 7 - pi : pi, mref);
    }
}
namespace idx {
using att::f32x16;
constexpr int SCP = 2048;
__device__ __forceinline__ unsigned okey(float f) { const unsigned u = __float_as_uint(f); return (u & 0x80000000u) ? ~u : (u | 0x80000000u); }
__device__ __forceinline__ int wave_isum(int c) {
    c += __builtin_amdgcn_mov_dpp(c, 0xB1, 0xF, 0xF, true);
    c += __builtin_amdgcn_mov_dpp(c, 0x4E, 0xF, 0xF, true);
    c += __builtin_amdgcn_mov_dpp(c, 0x141, 0xF, 0xF, true);
    c += __builtin_amdgcn_mov_dpp(c, 0x140, 0xF, 0xF, true);
    return (__builtin_amdgcn_readlane(c, 0) + __builtin_amdgcn_readlane(c, 16)) + (__builtin_amdgcn_readlane(c, 32) + __builtin_amdgcn_readlane(c, 48));
}
__device__ __forceinline__ unsigned bfi32(unsigned m, unsigned x, unsigned y) { return (x & m) | (y & ~m); }
__device__ __forceinline__ void bit_transpose32x2(unsigned (&A)[32], unsigned (&B)[32]) {
#pragma unroll
    for (int k = 0; k < 16; ++k) { const unsigned a0 = A[k], a1 = A[k + 16], b0 = B[k], b1 = B[k + 16];
        A[k] = __builtin_amdgcn_perm(a0, a1, 0x07060302u); A[k + 16] = __builtin_amdgcn_perm(a0, a1, 0x05040100u);
        B[k] = __builtin_amdgcn_perm(b0, b1, 0x07060302u); B[k + 16] = __builtin_amdgcn_perm(b0, b1, 0x05040100u); }
#pragma unroll
    for (int k = 0; k < 32; ++k) if (!(k & 8)) { const unsigned a0 = A[k], a1 = A[k + 8], b0 = B[k], b1 = B[k + 8];
        A[k] = __builtin_amdgcn_perm(a0, a1, 0x07030501u); A[k + 8] = __builtin_amdgcn_perm(a0, a1, 0x06020400u);
        B[k] = __builtin_amdgcn_perm(b0, b1, 0x07030501u); B[k + 8] = __builtin_amdgcn_perm(b0, b1, 0x06020400u); }
    unsigned mask = 0x0F0F0F0Fu;
#pragma unroll
    for (int s = 4; s; s >>= 1) {
#pragma unroll
        for (int k = 0; k < 32; ++k) if (!(k & s)) { const unsigned a0 = A[k], a1 = A[k + s], b0 = B[k], b1 = B[k + s];
            A[k] = bfi32(mask, a1 >> s, a0); A[k + s] = bfi32(mask, a1, a0 << s);
            B[k] = bfi32(mask, b1 >> s, b0); B[k + s] = bfi32(mask, b1, b0 << s); }
        mask ^= mask << (s >> 1);
    }
}
__device__ __forceinline__ void select_prepare(const LAS float* scA, const LAS float* scB, int E, unsigned (&Wa)[32], unsigned (&Wb)[32], int lane) {
#pragma unroll
    for (int j = 0; j < 32; ++j) { Wa[31 - j] = __float_as_uint(scA[64 * j + lane]); Wb[31 - j] = __float_as_uint(scB[64 * j + lane]); }
#pragma unroll
    for (int j = 0; j < 32; ++j) { Wa[j] ^= (unsigned)((int)Wa[j] >> 31) | 0x80000000u; Wb[j] ^= (unsigned)((int)Wb[j] >> 31) | 0x80000000u; }
    bit_transpose32x2(Wa, Wb);
}
__device__ __forceinline__ void select_finish(const unsigned (&Wa)[32], const unsigned (&Wb)[32], int E, unsigned* mrowA, unsigned* mrowB, int lane) {
    const unsigned valid = (E >= 32) ? 0xFFFFFFFFu : ((1u << E) - 1u);
    unsigned alA = valid, alB = valid, gtA = 0u, gtB = 0u;
    int GA = 0, GB = 0, AA = 64 * E, AB = 64 * E;
#pragma unroll
    for (int b0 = 0; b0 < 32; b0 += 4) {
        if (GA + AA == 256 && GB + AB == 256) break;
#pragma unroll
        for (int bb = 0; bb < 4; ++bb) { const int b = b0 + bb;
            const unsigned m1a = alA & Wa[b], m1b = alB & Wb[b];
            const int cab = wave_isum(__popc(m1a) | (__popc(m1b) << 16)), ca = cab & 0xFFFF, cb = cab >> 16;
            const bool ta = GA + ca >= 256, tb = GB + cb >= 256;
            alA = ta ? m1a : (alA ^ m1a); gtA = ta ? gtA : (gtA | m1a); AA = ta ? ca : AA - ca; GA = ta ? GA : GA + ca;
            alB = tb ? m1b : (alB ^ m1b); gtB = tb ? gtB : (gtB | m1b); AB = tb ? cb : AB - cb; GB = tb ? GB : GB + cb; }
    }
    const bool dA = (GA + AA == 256), dB = (GB + AB == 256);
#pragma unroll 1
    for (int rr = 0; rr < 2; ++rr) {
        const unsigned al = rr ? alB : alA, gt = rr ? gtB : gtA; const bool done = rr ? dB : dA; unsigned* mrow = rr ? mrowB : mrowA;
        unsigned sel = gt | al;
        if (!done) {
            int need = 256 - (rr ? GB : GA); sel = gt;
            const unsigned long long below = (1ull << lane) - 1ull;
            for (int j = 0; j < E; ++j) { const bool e = (al >> j) & 1u; const unsigned long long eq = __ballot(e);
                if (e && __popcll(eq & below) < need) sel |= 1u << j;
                need -= __popcll(eq); if (need <= 0) break; }
        }
        unsigned long long mine = 0ull;
#pragma unroll
        for (int j = 0; j < 32; ++j) { if (j < E) { const unsigned long long m = __ballot((sel >> j) & 1u); if (lane == j) mine = m; } }
        if (lane < 32) *(unsigned long long*)(mrow + 2 * lane) = mine;
    }
}
__device__ __forceinline__ void decode(int u, int& b, int& c, int& sub) { c = 4 + u % 28; const int rest = u / 28; b = rest >> 2; sub = rest & 3; }
__device__ __forceinline__ void load_af(Frame& F, int u, bf16x8 (&af)[4][4]) {
    int b, c, sub; decode(u, b, c, sub);
    const int r32 = F.lane & 31, hi = F.lane >> 5, t0 = 64 * c + 16 * sub, g = r32 >> 3, hh = (r32 >> 2) & 1, j = r32 & 3, qo = 2 * hh + (g >> 1), hd = 4 * (g & 1) + j;
    const bf16* P = F.R1 + (size_t)b * SEQ * NAB;
#pragma unroll
    for (int rt = 0; rt < 4; ++rt)
#pragma unroll
        for (int ks = 0; ks < 4; ++ks) af[rt][ks] = *(const bf16x8*)(P + (size_t)(t0 + 4 * rt + qo) * NAB + C_IQ + hd * 64 + 16 * ks + 8 * hi);
}
__device__ __forceinline__ float load_w(Frame& F, int u) {
    int b, c, sub; decode(u, b, c, sub);
    const int t0 = 64 * c + 16 * sub;
    return (F.tid < 128) ? bf2f(F.R1[(size_t)(b * SEQ + t0 + (F.tid >> 3)) * NAB + C_IW + (F.tid & 7)]) * (0.125f * 0.35355339059327373f) : 0.f;
}
__device__ __forceinline__ void load_bf(Frame& F, int b, int strip, bf16x8 (&bfr)[4]) {
    const bf16* P = F.R1 + (size_t)b * SEQ * NAB;
#pragma unroll
    for (int ks = 0; ks < 4; ++ks) bfr[ks] = *(const bf16x8*)(P + (size_t)(32 * strip + (F.lane & 31)) * NAB + C_IK + 16 * ks + 8 * (F.lane >> 5));
}
__device__ __forceinline__ float relu1(float x) { const int i = __float_as_int(x); return __int_as_float(i > 0 ? i : 0); }
__device__ __forceinline__ void run(Frame& F) {
    const int lane = F.lane, w = F.wave, hi = lane >> 5, r32 = lane & 31, tid = F.tid, NU = BATCH * 28 * 4;
    int u = F.vcu; if (u >= NU) return;
    LAS float* sc = (LAS float*)F.lds;
    LAS float* wtb = sc + 16 * SCP;
    bf16x8 af[4][4], bfr[4], bnx[4];
    load_af(F, u, af);
    { const float wv = load_w(F, u); if (tid < 128) wtb[tid] = wv; }
    { int b, c, sub; decode(u, b, c, sub); if (w < 2 * (c + 1)) load_bf(F, b, w, bfr); }
    for (int it = 0; u < NU; ++it, u += F.G) {
        int b, c, sub; decode(u, b, c, sub);
        const int n = 64 * (c + 1), t0 = 64 * c + 16 * sub, nstrip = n >> 5;
        const int un = u + F.G; const bool more = un < NU;
        const LAS float* wt = wtb + (it & 1) * 128;
        __syncthreads();
        const float wnext = more ? load_w(F, un) : 0.f;
        for (int s = w; s < nstrip; s += NWAVES) {
            const bool mstrip = s + NWAVES < nstrip;
            if (mstrip) load_bf(F, b, s + NWAVES, bnx);
#pragma unroll
            for (int rt = 0; rt < 4; ++rt) {
                f32x16 acc;
#pragma unroll
                for (int r = 0; r < 16; ++r) acc[r] = 0.f;
#pragma unroll
                for (int ks = 0; ks < 4; ++ks) acc = __builtin_amdgcn_mfma_f32_32x32x16_bf16(af[rt][ks], bfr[ks], acc, 0, 0, 0);
                const int q0 = 4 * rt + 2 * hi;
                float f0, f1;
                { const f32x4 wa = *(const LAS f32x4*)(wt + q0 * 8), wb = *(const LAS f32x4*)(wt + q0 * 8 + 4), wc = *(const LAS f32x4*)(wt + q0 * 8 + 8), wd = *(const LAS f32x4*)(wt + q0 * 8 + 12);
                  f0 = relu1(acc[0]) * wa[0]; f1 = relu1(acc[8]) * wc[0];
#pragma unroll
                  for (int e = 1; e < 4; ++e) { f0 = fmaf(relu1(acc[e]), wa[e], f0); f1 = fmaf(relu1(acc[8 + e]), wc[e], f1); }
#pragma unroll
                  for (int e = 0; e < 4; ++e) { f0 = fmaf(relu1(acc[4 + e]), wb[e], f0); f1 = fmaf(relu1(acc[12 + e]), wd[e], f1); } }
                sc[q0 * SCP + 32 * s + r32] = f0; sc[(q0 + 1) * SCP + 32 * s + r32] = f1;
            }
            if (mstrip) {
#pragma unroll
                for (int ks = 0; ks < 4; ++ks) bfr[ks] = bnx[ks];
            }
        }
        if (more && tid < 128) wtb[((it + 1) & 1) * 128 + tid] = wnext;
        __syncthreads();
        { const int q = 2 * w;
          unsigned* mrowA = F.MASK + (size_t)(b * SEQ + t0 + q) * 64; unsigned* mrowB = mrowA + 64;
          const LAS float* rowA = sc + q * SCP; const LAS float* rowB = rowA + SCP;
          unsigned Wa[32], Wb[32];
          select_prepare(rowA, rowB, n >> 6, Wa, Wb, lane);
          asm volatile("" ::: "memory");
          if (more) load_af(F, un, af);
          select_finish(Wa, Wb, n >> 6, mrowA, mrowB, lane); }
        if (more) { int bn, cn, sn; decode(un, bn, cn, sn); if (w < 2 * (cn + 1)) load_bf(F, bn, w, bfr); }
    }
    __syncthreads();
}
}
__device__ __forceinline__ void ph_indexer(Frame& F) {
    { const int gw = F.vcu * NWAVES + F.wave, NGW = F.G * NWAVES;
      for (int i = gw; i < BATCH * 256; i += NGW) { const int b = i >> 8, pos = i & 255, n = ((pos >> 6) + 1) << 6;
          if (F.lane < 32) { unsigned long long v = 0ull; if (64 * F.lane < n) v = ~0ull; *(unsigned long long*)(F.MASK + (size_t)(b * SEQ + pos) * 64 + 2 * F.lane) = v; } } }
    idx::run(F);
}
namespace gla {
using att::f32x16; using att::u32x4;
constexpr int L_BG = 106496  , L_WL = 0, L_V = 4096, L_OG = 36864, L_K = 69632, L_Q = 78848, L_PART = 88064, L_STG = 89088, KP = 144, SP = 272;
struct In { u32x4 g0, g1, kk, qq; f32x4 b0, b1; };
__device__ __forceinline__ void decode(int u, int& b, int& h, int& c) { b = u >> 7; h = (u >> 5) & 3; c = u & 31; }
template <bool PASSC> __device__ __forceinline__ void load_in(Frame& F, int u, In& in, const float* BC) {
    int b, h, c; decode(u, b, h, c);
    const bf16* pr = F.R1 + (size_t)(b * SEQ + 64 * c + F.lane) * NAB;
    in.kk = *(const u32x4*)(pr + C_KB + h * 64 + 8 * F.wave);
    if (PASSC) { in.qq = *(const u32x4*)(pr + C_QB + h * 64 + 8 * F.wave);
        const float* bp = BC + ((size_t)u * 64 + F.lane) * 64 + 8 * F.wave; in.b0 = *(const f32x4*)bp; in.b1 = *(const f32x4*)(bp + 4); }
    else { in.g0 = *(const u32x4*)(pr + C_GL); in.g1 = *(const u32x4*)(pr + C_GL + 8); }
}
template <bool NEEDOG> __device__ __forceinline__ void dma_in(Frame& F, int u, int buf, const unsigned (&dvo)[2]) {
    int b, h, c; decode(u, b, h, c);
    const bf16* P = F.R1 + (size_t)(b * SEQ + 64 * c) * NAB;
    att::tile_dma(P + C_VB + h * 128, dvo, F.lds + L_V + buf * 16384, F.wave);
    if (NEEDOG) att::tile_dma(P + C_OG + h * 128, dvo, F.lds + L_OG + buf * 16384, F.wave);
}
__device__ __forceinline__ void stage_wl(Frame& F, int h) {
    LAS float* wl = (LAS float*)(F.lds + L_WL);
#pragma unroll
    for (int i = 0; i < 2; ++i) { const int e = F.tid + 512 * i, r = e >> 6, d = e & 63; wl[e] = F.w_gate_up[r * 256 + h * 64 + d]; }
    if (F.tid < 64) ((LAS float*)(F.lds + L_BG))[F.tid] = F.b_gate[h * 64 + F.tid];
}
__device__ __forceinline__ void unpack8(const u32x4 v, float (&f)[8]) {
#pragma unroll
    for (int i = 0; i < 4; ++i) { f[2 * i] = __uint_as_float(v[i] << 16); f[2 * i + 1] = __uint_as_float(v[i] & 0xffff0000u); }
}
#define GLA_DPP_F(v, ctrl, row_mask) __builtin_bit_cast(float, __builtin_amdgcn_update_dpp(0, __builtin_bit_cast(int, (v)), (ctrl), (row_mask), 0xF, false))
__device__ __forceinline__ float wave_scan_incl(float v) {
    v += GLA_DPP_F(v, 0x111, 0xF); v += GLA_DPP_F(v, 0x112, 0xF); v += GLA_DPP_F(v, 0x114, 0xF); v += GLA_DPP_F(v, 0x118, 0xF);
    v += GLA_DPP_F(v, 0x142, 0xA); v += GLA_DPP_F(v, 0x143, 0xC);
    return v;
}
__device__ __forceinline__ void gate_scan(Frame& F, int h, const float (&gl)[16], float (&bc)[8], float (&blast)[8]) {
    const int d0 = 8 * F.wave;
    const LAS float* wl = (const LAS float*)(F.lds + L_WL);
    float acc[8];
    { const f32x4 g0 = *(const LAS f32x4*)(F.lds + L_BG + d0 * 4), g1 = *(const LAS f32x4*)(F.lds + L_BG + d0 * 4 + 16);
#pragma unroll
      for (int i = 0; i < 4; ++i) { acc[i] = g0[i]; acc[4 + i] = g1[i]; } }
#pragma unroll
    for (int r = 0; r < 16; ++r) { const f32x4 w0 = *(const LAS f32x4*)(wl + r * 64 + d0), w1 = *(const LAS f32x4*)(wl + r * 64 + d0 + 4);
#pragma unroll
        for (int i = 0; i < 4; ++i) { acc[i] = fmaf(gl[r], w0[i], acc[i]); acc[4 + i] = fmaf(gl[r], w1[i], acc[4 + i]); } }
#pragma unroll
    for (int i = 0; i < 8; ++i) { float v = (fminf(acc[i], 0.f) - __logf(1.0f + __expf(-fabsf(acc[i])))) * (1.0f / 16.0f);
        v = wave_scan_incl(v);
        bc[i] = v; blast[i] = __builtin_bit_cast(float, __builtin_amdgcn_readlane(__builtin_bit_cast(int, v), 63)); }
}
__device__ __forceinline__ void pass_a(Frame& F, float* GU, float* DEC, float* BC) {
    const int lane = F.lane, w = F.wave, hi = lane >> 5, r32 = lane & 31;
    att::FragOff fo; att::frag_off_init(fo, lane);
    unsigned dvo[2]; att::dma_off_init(dvo, NAB, w, lane);
    const int et = w >> 1, dt = w & 1, va_et = att::frag_va(lane, et);
    int u = F.vcu; if (u >= BATCH * 4 * 32) return;
    In cur, nxt; int hprev = -1;
    dma_in<false>(F, u, 0, dvo); load_in<false>(F, u, cur, BC);
    for (int it = 0; u < BATCH * 4 * 32; ++it, u += F.G) {
        int b, h, c; decode(u, b, h, c);
        const int un = u + F.G; const bool more = un < BATCH * 4 * 32;
        if (h != hprev) { stage_wl(F, h); hprev = h; }
        asm volatile("s_waitcnt vmcnt(0) lgkmcnt(0)" ::: "memory");
        __syncthreads();
        float gl[16], kf[8];
        unpack8(cur.g0, (float(&)[8])gl[0]); unpack8(cur.g1, (float(&)[8])gl[8]); unpack8(cur.kk, kf);
        asm volatile("" ::: "memory");
        if (more) { dma_in<false>(F, un, (it + 1) & 1, dvo); load_in<false>(F, un, nxt, BC); }
        float bc[8], blast[8];
        gate_scan(F, h, gl, bc, blast);
        const int uid = u;
        { float* bp = BC + ((size_t)uid * 64 + lane) * 64 + 8 * w; *(f32x4*)bp = (f32x4){bc[0], bc[1], bc[2], bc[3]}; *(f32x4*)(bp + 4) = (f32x4){bc[4], bc[5], bc[6], bc[7]}; }
#pragma unroll
        for (int i = 0; i < 8; ++i) *(LAS bf16*)(F.lds + L_K + (8 * w + i) * KP + lane * 2) = (bf16)f2bf(kf[i] * __expf(blast[i] - bc[i]));
        if (lane == 0) {
#pragma unroll
            for (int i = 0; i < 8; ++i) DEC[(size_t)uid * 64 + 8 * w + i] = __expf(blast[i]); }
        asm volatile("s_waitcnt lgkmcnt(0)" ::: "memory");
        __syncthreads();
        const LAS unsigned char* vbuf = F.lds + L_V + (it & 1) * 16384;
        f32x16 acc;
#pragma unroll
        for (int r = 0; r < 16; ++r) acc[r] = 0.f;
#pragma unroll
        for (int kk = 0; kk < 4; ++kk) {
            const LAS unsigned char* kp = F.lds + L_K + (32 * dt + r32) * KP + (16 * kk + 4 * hi) * 2;
            const unsigned long long lo = *(const LAS unsigned long long*)kp, hh = *(const LAS unsigned long long*)(kp + 16);
            u32x4 bw; bw.x = (unsigned)lo; bw.y = (unsigned)(lo >> 32); bw.z = (unsigned)hh; bw.w = (unsigned)(hh >> 32);
            acc = __builtin_amdgcn_mfma_f32_32x32x16_bf16(att::v_frag_rt(vbuf, va_et, fo.vd, kk), __builtin_bit_cast(bf16x8, bw), acc, 0, 0, 0);
        }
        float* gu = GU + (size_t)uid * 8192;
#pragma unroll
        for (int r = 0; r < 16; ++r) gu[(32 * et + att::crow(r, hi)) * 64 + 32 * dt + r32] = acc[r];
        cur = nxt;
    }
    __syncthreads();
}
__device__ __forceinline__ void pass_b(Frame& F, float* GU, const float* DEC) {
    for (int idx = F.vcu * NTHR + F.tid; idx < 64 * 128 * 16; idx += F.G * NTHR) {
        const int bh = idx >> 11, e = (idx >> 4) & 127, dq = idx & 15;
        f32x4 S = (f32x4){0.f, 0.f, 0.f, 0.f};
        for (int c0 = 0; c0 < 32; c0 += 8) {
            f32x4 U[8], dec[8];
#pragma unroll
            for (int i = 0; i < 8; ++i) { const size_t uid = (size_t)bh * 32 + c0 + i; U[i] = *(const f32x4*)(GU + (uid * 128 + e) * 64 + 4 * dq); dec[i] = *(const f32x4*)(DEC + uid * 64 + 4 * dq); }
#pragma unroll
            for (int i = 0; i < 8; ++i) { const size_t uid = (size_t)bh * 32 + c0 + i; *(f32x4*)(GU + (uid * 128 + e) * 64 + 4 * dq) = S; S = dec[i] * S + U[i]; }
        }
    }
}
__device__ __forceinline__ void pass_c(Frame& F, const float* GU, const float* BC) {
    const int lane = F.lane, w = F.wave, hi = lane >> 5, r32 = lane & 31, tid = F.tid;
    LAS unsigned char* lds = F.lds;
    att::FragOff fo; att::frag_off_init(fo, lane);
    unsigned dvo[2]; att::dma_off_init(dvo, NAB, w, lane);
    const int et = w >> 1, tt = w & 1, tl = 32 * tt + r32, va_et = att::frag_va(lane, et);
    int u = F.vcu; if (u >= BATCH * 4 * 32) return;
    In cur, nxt;
    dma_in<true>(F, u, 0, dvo); load_in<true>(F, u, cur, BC);
    for (int it = 0; u < BATCH * 4 * 32; ++it, u += F.G) {
        int b, h, c; decode(u, b, h, c);
        const int un = u + F.G; const bool more = un < BATCH * 4 * 32;
        asm volatile("s_waitcnt vmcnt(0) lgkmcnt(0)" ::: "memory");
        __syncthreads();
        float kf[8], qf[8], bc[8];
        unpack8(cur.kk, kf); unpack8(cur.qq, qf);
#pragma unroll
        for (int i = 0; i < 4; ++i) { bc[i] = cur.b0[i]; bc[4 + i] = cur.b1[i]; }
        asm volatile("" ::: "memory");
        if (more) { dma_in<true>(F, un, (it + 1) & 1, dvo); load_in<true>(F, un, nxt, BC); }
        f32x4 sf[8];
        { const float* gs = GU + ((size_t)u * 128 + 32 * et + r32) * 64;
#pragma unroll
          for (int ks = 0; ks < 4; ++ks) { sf[2 * ks] = *(const f32x4*)(gs + 16 * ks + 8 * hi); sf[2 * ks + 1] = *(const f32x4*)(gs + 16 * ks + 8 * hi + 4); } }
        { float eq[8], ek[8];
#pragma unroll
          for (int i = 0; i < 8; ++i) { eq[i] = qf[i] * 0.125f * __expf(bc[i]); ek[i] = kf[i] * __expf(-bc[i]); }
          *(LAS bf16x8*)(lds + L_Q + lane * KP + 16 * w) = att::pack8(eq[0], eq[1], eq[2], eq[3], eq[4], eq[5], eq[6], eq[7]);
          *(LAS bf16x8*)(lds + L_K + lane * KP + 16 * w) = att::pack8(ek[0], ek[1], ek[2], ek[3], ek[4], ek[5], ek[6], ek[7]); }
        asm volatile("s_waitcnt lgkmcnt(0)" ::: "memory");
        __syncthreads();
        const LAS unsigned char* vbuf = lds + L_V + (it & 1) * 16384; const LAS unsigned char* ogbuf = lds + L_OG + (it & 1) * 16384;
        bf16x8 qfr[4];
#pragma unroll
        for (int ks = 0; ks < 4; ++ks) qfr[ks] = *(const LAS bf16x8*)(lds + L_Q + tl * KP + (16 * ks + 8 * hi) * 2);
        f32x16 p0, p1;
#pragma unroll
        for (int r = 0; r < 16; ++r) { p0[r] = 0.f; p1[r] = 0.f; }
#pragma unroll
        for (int ks = 0; ks < 4; ++ks) {
            const bf16x8 a0 = *(const LAS bf16x8*)(lds + L_K + r32 * KP + (16 * ks + 8 * hi) * 2), a1 = *(const LAS bf16x8*)(lds + L_K + (32 + r32) * KP + (16 * ks + 8 * hi) * 2);
            p0 = __builtin_amdgcn_mfma_f32_32x32x16_bf16(a0, qfr[ks], p0, 0, 0, 0); p1 = __builtin_amdgcn_mfma_f32_32x32x16_bf16(a1, qfr[ks], p1, 0, 0, 0);
        }
        { const int tl4 = tl - 4 * hi;
#pragma unroll
          for (int r = 0; r < 16; ++r) { const int s = (r & 3) + 8 * (r >> 2); if (s > tl4) p0[r] = 0.f; if (s + 32 > tl4) p1[r] = 0.f; } }
        const bf16x8 pa0 = att::pack8(p0[0], p0[1], p0[2], p0[3], p0[4], p0[5], p0[6], p0[7]), pa1 = att::pack8(p0[8], p0[9], p0[10], p0[11], p0[12], p0[13], p0[14], p0[15]);
        const bf16x8 pa2 = att::pack8(p1[0], p1[1], p1[2], p1[3], p1[4], p1[5], p1[6], p1[7]), pa3 = att::pack8(p1[8], p1[9], p1[10], p1[11], p1[12], p1[13], p1[14], p1[15]);
        f32x16 acc;
#pragma unroll
        for (int r = 0; r < 16; ++r) acc[r] = 0.f;
        acc = __builtin_amdgcn_mfma_f32_32x32x16_bf16(att::v_frag_rt(vbuf, va_et, fo.vd, 0), pa0, acc, 0, 0, 0);
        acc = __builtin_amdgcn_mfma_f32_32x32x16_bf16(att::v_frag_rt(vbuf, va_et, fo.vd, 1), pa1, acc, 0, 0, 0);
        acc = __builtin_amdgcn_mfma_f32_32x32x16_bf16(att::v_frag_rt(vbuf, va_et, fo.vd, 2), pa2, acc, 0, 0, 0);
        acc = __builtin_amdgcn_mfma_f32_32x32x16_bf16(att::v_frag_rt(vbuf, va_et, fo.vd, 3), pa3, acc, 0, 0, 0);
#pragma unroll
        for (int ks = 0; ks < 4; ++ks) { const f32x4 s0 = sf[2 * ks], s1 = sf[2 * ks + 1];
            acc = __builtin_amdgcn_mfma_f32_32x32x16_bf16(att::pack8(s0[0], s0[1], s0[2], s0[3], s1[0], s1[1], s1[2], s1[3]), qfr[ks], acc, 0, 0, 0); }
        float ss = 0.f;
#pragma unroll
        for (int r = 0; r < 16; ++r) ss = fmaf(acc[r], acc[r], ss);
        ss += __shfl_xor(ss, 32);
        LAS float* part = (LAS float*)(lds + L_PART);
        if (hi == 0) part[et * 64 + tl] = ss;
        asm volatile("s_waitcnt lgkmcnt(0)" ::: "memory");
        __syncthreads();
        const float rs = rsqrtf(((part[tl] + part[64 + tl]) + (part[128 + tl] + part[192 + tl])) * (1.0f / 128.0f) + EPS);
#pragma unroll
        for (int g = 0; g < 4; ++g) {
            const int e0 = 32 * et + 8 * g + 4 * hi;
            const unsigned long long ow = *(const LAS unsigned long long*)(ogbuf + att::img_off(tl, 4 * et + g) + 8 * hi);
            const f32x4 gg = *(const f32x4*)(F.g_gla + e0);
            float y[4];
#pragma unroll
            for (int i = 0; i < 4; ++i) { const float og = __uint_as_float(((unsigned)(ow >> (16 * i)) & 0xffffu) << 16); y[i] = acc[4 * g + i] * rs * gg[i] * (og * __builtin_amdgcn_rcpf(1.0f + __expf(-og))); }
            *(LAS unsigned long long*)(lds + L_STG + tl * SP + e0 * 2) = (unsigned long long)pg8::cvt_pk_bf16(y[0], y[1]) | ((unsigned long long)pg8::cvt_pk_bf16(y[2], y[3]) << 32);
        }
        asm volatile("s_waitcnt lgkmcnt(0)" ::: "memory");
        __syncthreads();
#pragma unroll
        for (int i = 0; i < 2; ++i) { const int cidx = tid + 512 * i, row = cidx >> 4, ch = cidx & 15;
            *(u32x4*)(F.CAT + (size_t)(b * SEQ + 64 * c + row) * D + 512 + h * 128 + ch * 8) = *(const LAS u32x4*)(lds + L_STG + row * SP + ch * 16); }
        cur = nxt;
    }
    __syncthreads();
}
}
__device__ __forceinline__ void ph_rope_tables(Frame& F, float* R128, float* R64) {
    for (int i = F.vcu * NTHR + F.tid; i < SEQ * 24; i += F.G * NTHR) {
        const int pos = i / 24, k = i % 24;
        if (k < 16) { const float inv = powf(500000.0f, -(float)k * 2.0f / 32.0f), ang = (float)pos * inv; R128[pos * 32 + k] = cosf(ang); R128[pos * 32 + 16 + k] = sinf(ang); }
        else { const int j = k - 16; const float inv = powf(500000.0f, -(float)j * 2.0f / 16.0f), ang = (float)pos * inv; R64[pos * 16 + j] = cosf(ang); R64[pos * 16 + 8 + j] = sinf(ang); }
    }
}
__device__ __forceinline__ float dpp_xor1(float v) { return __builtin_bit_cast(float, __builtin_amdgcn_mov_dpp(__builtin_bit_cast(int, v), 0xB1, 0xF, 0xF, true)); }
__device__ __forceinline__ float dpp_xor2(float v) { return __builtin_bit_cast(float, __builtin_amdgcn_mov_dpp(__builtin_bit_cast(int, v), 0x4E, 0xF, 0xF, true)); }
__device__ __forceinline__ void ph_prep_c_fast(Frame& F) {
    const int gw = F.vcu * NWAVES + F.wave, NGW = F.G * NWAVES, lane = F.lane;
    const float* gn = (lane < 32 ? F.gq_c : F.gk_c) + (lane & 3) * 32;
    const float sc = lane < 32 ? att::C2 : 1.0f;
    float g[32];
#pragma unroll
    for (int i = 0; i < 8; ++i) { const f32x4 v = *(const f32x4*)(gn + 4 * i); g[4 * i] = v[0] * sc; g[4 * i + 1] = v[1] * sc; g[4 * i + 2] = v[2] * sc; g[4 * i + 3] = v[3] * sc; }
    for (int tok = gw; tok < M; tok += NGW) {
        att::u32x4* p = (att::u32x4*)(F.R1 + (size_t)tok * NC + lane * 32);
        att::u32x4 v[4]; float f[32]; float ss = 0.f;
#pragma unroll
        for (int i = 0; i < 4; ++i) v[i] = p[i];
#pragma unroll
        for (int i = 0; i < 4; ++i)
#pragma unroll
            for (int j = 0; j < 4; ++j) { const float a = __uint_as_float(v[i][j] << 16), b = __uint_as_float(v[i][j] & 0xffff0000u); f[8 * i + 2 * j] = a; f[8 * i + 2 * j + 1] = b; ss = fmaf(a, a, fmaf(b, b, ss)); }
        ss += dpp_xor1(ss); ss += dpp_xor2(ss);
        const float rs = rsqrtf(ss * (1.f / 128.f) + EPS);
#pragma unroll
        for (int i = 0; i < 4; ++i) { att::u32x4 o;
#pragma unroll
            for (int j = 0; j < 4; ++j) o[j] = pg8::cvt_pk_bf16(f[8 * i + 2 * j] * rs * g[8 * i + 2 * j], f[8 * i + 2 * j + 1] * rs * g[8 * i + 2 * j + 1]);
            p[i] = o; }
    }
}
__device__ __forceinline__ void ph_prep_a_fast(Frame& F, const float* R128, const float* R64) {
    const int gw = F.vcu * NWAVES + F.wave, NGW = F.G * NWAVES, lane = F.lane, l8 = lane & 7;
    const float* gn = (lane < 32 ? F.gq_a : F.gk_a) + l8 * 16;
    const float sc = lane < 32 ? att::C2 : 1.0f;
    float g[16];
#pragma unroll
    for (int i = 0; i < 4; ++i) { const f32x4 v = *(const f32x4*)(gn + 4 * i); g[4 * i] = v[0] * sc; g[4 * i + 1] = v[1] * sc; g[4 * i + 2] = v[2] * sc; g[4 * i + 3] = v[3] * sc; }
    for (int tok = gw; tok < M; tok += NGW) {
        const int pos = tok & (SEQ - 1);
        bf16* pr = F.R1 + (size_t)tok * NAB;
        {   att::u32x4* p = (att::u32x4*)(pr + lane * 16);
            const att::u32x4 v0 = p[0], v1 = p[1]; float f[16]; float ss = 0.f;
#pragma unroll
            for (int j = 0; j < 4; ++j) { f[2 * j] = __uint_as_float(v0[j] << 16); f[2 * j + 1] = __uint_as_float(v0[j] & 0xffff0000u); f[8 + 2 * j] = __uint_as_float(v1[j] << 16); f[8 + 2 * j + 1] = __uint_as_float(v1[j] & 0xffff0000u); }
#pragma unroll
            for (int i = 0; i < 16; ++i) ss = fmaf(f[i], f[i], ss);
            ss += dpp_xor1(ss); ss += dpp_xor2(ss); ss += __shfl_xor(ss, 4);
            const float rs = rsqrtf(ss * (1.f / 128.f) + EPS);
#pragma unroll
            for (int i = 0; i < 16; ++i) f[i] = f[i] * rs * g[i];
            const float* cs = R128 + pos * 32;
#pragma unroll
            for (int i = 0; i < 16; ++i) { const float other = dpp_xor1(f[i]);
                if (l8 < 2) { const float c = cs[i], s = cs[16 + i]; f[i] = (l8 == 0) ? f[i] * c - other * s : f[i] * c + other * s; } }
            att::u32x4 o0, o1;
#pragma unroll
            for (int j = 0; j < 4; ++j) { o0[j] = pg8::cvt_pk_bf16(f[2 * j], f[2 * j + 1]); o1[j] = pg8::cvt_pk_bf16(f[8 + 2 * j], f[8 + 2 * j + 1]); }
            p[0] = o0; p[1] = o1;
        }
        {
#pragma unroll
            for (int part = 0; part < 2; ++part) {
                if (part == 1 && lane >= 8) break;
                att::u32x4* p = (att::u32x4*)(pr + (part == 0 ? C_IQ + lane * 8 : C_IK + lane * 8));
                const att::u32x4 v0 = p[0]; float f[8];
#pragma unroll
                for (int j = 0; j < 4; ++j) { f[2 * j] = __uint_as_float(v0[j] << 16); f[2 * j + 1] = __uint_as_float(v0[j] & 0xffff0000u); }
                const float* cs = R64 + pos * 16;
#pragma unroll
                for (int i = 0; i < 8; ++i) { const float other = dpp_xor1(f[i]);
                    if (l8 < 2) { const float c = cs[i], s = cs[8 + i]; f[i] = (l8 == 0) ? f[i] * c - other * s : f[i] * c + other * s; } }
                att::u32x4 o0;
#pragma unroll
                for (int j = 0; j < 4; ++j) o0[j] = pg8::cvt_pk_bf16(f[2 * j], f[2 * j + 1]);
                p[0] = o0;
            }
        }
    }
}
#ifndef MK_PER_PHASE
#define MK_PER_PHASE 0
#endif
constexpr int NPH = 14;
struct Args { const float* in[16]; float* out; unsigned char* ws; int ph_lo, ph_hi; };
__global__ void __launch_bounds__(NTHR, 2) mk_fwd(Args args) {
    extern __shared__ __attribute__((aligned(16))) unsigned char lds[];
    Frame F;
    F.lds = (LAS unsigned char*)lds;
    F.MISC = (volatile LAS unsigned*)(F.lds + MISC_OFF);
#ifdef PROBE_TOTAL
    const unsigned long long pt_start = __builtin_amdgcn_s_memrealtime();
#endif
    F.wave = __builtin_amdgcn_readfirstlane((int)threadIdx.x >> 6);
#define RELANE() (F.lane = lane_id_opaque(), F.tid = F.wave * 64 + F.lane, true)
    RELANE();
#ifdef PROBE_ACC
    F.acc_t0 = 0ull; F.acc_sum = 0ull;
#endif
    F.G = gridDim.x; { const int bx = blockIdx.x; F.vcu = (F.G % 8 == 0) ? (bx % 8) * (F.G / 8) + bx / 8 : bx; }
    unsigned char* ws = args.ws;
    F.ctl = (gu32*)(ws + WS_CTL);
    F.x = args.in[0]; F.g_mix = args.in[1]; F.g_ffn = args.in[2]; F.w_in_ab = args.in[3]; F.gq_a = args.in[4]; F.gk_a = args.in[5]; F.w_gate_up = args.in[6]; F.b_gate = args.in[7];
    F.g_gla = args.in[8]; F.w_out_ab = args.in[9]; F.w_in_c = args.in[10]; F.gq_c = args.in[11]; F.gk_c = args.in[12]; F.w_out_c = args.in[13]; F.w_up = args.in[14]; F.w_down = args.in[15];
    F.out = args.out;
    F.Wab = (bf16*)(ws + WS_WAB); F.Woab = (bf16*)(ws + WS_WOAB); F.Wup0 = (bf16*)(ws + WS_WUP0); F.Wdn0 = (bf16*)(ws + WS_WDN0);
    F.Winc = (bf16*)(ws + WS_WINC); F.Woc = (bf16*)(ws + WS_WOC); F.Wup1 = (bf16*)(ws + WS_WUP1); F.Wdn1 = (bf16*)(ws + WS_WDN1);
    F.XB = (bf16*)(ws + WS_XB); F.CAT = (bf16*)(ws + WS_CAT); F.R1 = (bf16*)(ws + WS_R1); F.SSQ = (float*)(ws + WS_SSQ); F.MASK = (unsigned*)(ws + WS_MASK);
    for (int u = F.tid; u < (LDS_BYTES - MISC_OFF) / 4; u += NTHR) ((LAS unsigned*)(F.lds + MISC_OFF))[u] = 0u;
    __syncthreads();
    XcdBarrier bar; bar.bar = (unsigned*)(F.ctl + CW_BAR); bar.x = 0; bar.st = nullptr; bar.wave = F.wave;
    if (!MK_PER_PHASE) bar = xcd_barrier_post((unsigned*)(F.ctl + CW_BAR), F.MISC + 8, F.wave);
    const int lo = args.ph_lo, hi = args.ph_hi;
#ifdef PROBE_PH
    unsigned long long pt0 = 0ull, pt1 = 0ull;
#define STAMP(k) do { if ((k) == PROBE_PH) pt0 = __builtin_amdgcn_s_memrealtime(); if ((k) == PROBE_PH + 1) pt1 = __builtin_amdgcn_s_memrealtime(); } while (0)
#ifdef PROBE_SUB
#define SUBSTAMP(k) do { if ((k) == PROBE_PH) { __syncthreads(); pt0 = __builtin_amdgcn_s_memrealtime(); } } while (0)
#else
#define SUBSTAMP(k) do { } while (0)
#endif
#else
#define STAMP(k) do { } while (0)
#define SUBSTAMP(k) do { } while (0)
#endif
#define IN(k) (lo <= (k) && (k) < hi && RELANE())
#ifdef PROBE_DBLBAR
#define SEAM(k) do { if (lo <= (k) && (k) + 1 < hi) { xcd_barrier(bar); xcd_barrier(bar); } } while (0)
#else
#define SEAM(k) do { if (lo <= (k) && (k) + 1 < hi) xcd_barrier(bar); } while (0)
#endif
    float* const SSQ0 = F.SSQ, *SSQ1 = F.SSQ + (size_t)M * 16, *SSQ2 = F.SSQ + (size_t)2 * M * 16, *SSQ3 = F.SSQ + (size_t)3 * M * 16;
    typedef pg8::StaticOrder SO;
    STAMP(0); float* const R128 = (float*)(ws + WS_ROPE); float* const R64 = R128 + SEQ * 32;
    if (IN(0)) { ph_prologue(F); ph_rope_tables(F, R128, R64); } SEAM(0);
    STAMP(1); if (IN(1)) { pg8::Gemm g{F.XB, F.Wab, M, NAB, D}; SO S; S.init(M, NAB, F.G, (int)blockIdx.x); pg8::EpiProjAB E{F.R1, NAB, SSQ0, F.gq_a, F.gk_a, R128, R64, (LAS float*)(F.lds + RING_BYTES), att::C2};
        pg8::gemm_phase<pg8::EpiProjAB, SO, true, true>(F.lds, g, S, E, F.wave);
        if (F.G == 256 && blockIdx.x >= 128) { RELANE(); prologue_weights<1>(F, ((int)blockIdx.x - 128) * NWAVES + F.wave, 128 * NWAVES); } } SEAM(1);
    float* const GU = (float*)(ws + WS_XB); float* const DEC = (float*)(ws + WS_DEC);
    STAMP(2); if (IN(2)) { SUBSTAMP(2); gla::pass_a(F, GU, DEC, (float*)(ws + WS_BC)); } SEAM(2);
    STAMP(3); if (IN(3)) { gla::pass_b(F, GU, DEC); SUBSTAMP(3); ph_indexer(F); } SEAM(3);
    STAMP(4); if (IN(4)) { ph_dsa(F); SUBSTAMP(4); gla::pass_c(F, GU, (const float*)(ws + WS_BC)); } SEAM(4);
    STAMP(5); if (IN(5)) { pg8::Gemm g{F.CAT, F.Woab, M, D, D}; SO S; S.init(M, D, F.G, (int)blockIdx.x); pg8::EpiResid<0, 0> E{F.x, nullptr, F.XB, SSQ1, nullptr};
        pg8::gemm_phase<pg8::EpiResid<0, 0>, SO, true, true>(F.lds, g, S, E, F.wave); } SEAM(5);
    STAMP(6); if (IN(6)) { pg8::Gemm g{F.XB, F.Wup0, M, FF, D}; SO S; S.init(M, FF, F.G, (int)blockIdx.x); pg8::EpiScale<1> E{F.R1, FF, SSQ1};
        pg8::gemm_phase<pg8::EpiScale<1>, SO, true, true>(F.lds, g, S, E, F.wave); } SEAM(6);
    STAMP(7); if (IN(7)) { pg8::Gemm g{F.R1, F.Wdn0, M, D, FF}; SO S; S.init(M, D, F.G, (int)blockIdx.x); pg8::EpiResid<1, 0> E{F.XB, nullptr, F.XB, SSQ2, SSQ1};
        pg8::gemm_phase<pg8::EpiResid<1, 0>, SO, true, true>(F.lds, g, S, E, F.wave); } SEAM(7);
    STAMP(8); if (IN(8)) { pg8::Gemm g{F.XB, F.Winc, M, NC, D}; SO S; S.init(M, NC, F.G, (int)blockIdx.x); pg8::EpiQKNorm E{F.R1, NC, SSQ2, F.gq_c, F.gk_c, (LAS float*)(F.lds + RING_BYTES), att::C2};
        pg8::gemm_phase<pg8::EpiQKNorm, SO, true, true>(F.lds, g, S, E, F.wave); } SEAM(8);
    STAMP(9);
    STAMP(10); if (IN(10)) { ph_sb(F); } SEAM(10);
    STAMP(11); if (IN(11)) { pg8::Gemm g{F.CAT, F.Woc, M, D, D}; SO S; S.init(M, D, F.G, (int)blockIdx.x); pg8::EpiResid<1, 0> E{F.XB, nullptr, F.XB, SSQ3, nullptr};
        pg8::gemm_phase<pg8::EpiResid<1, 0>, SO, true, true>(F.lds, g, S, E, F.wave); } SEAM(11);
    STAMP(12); if (IN(12)) { pg8::Gemm g{F.XB, F.Wup1, M, FF, D}; SO S; S.init(M, FF, F.G, (int)blockIdx.x); pg8::EpiScale<1> E{F.R1, FF, SSQ3};
        pg8::gemm_phase<pg8::EpiScale<1>, SO, true, true>(F.lds, g, S, E, F.wave); } SEAM(12);
    STAMP(13); if (IN(13)) { pg8::Gemm g{F.R1, F.Wdn1, M, D, FF}; SO S; S.init(M, D, F.G, (int)blockIdx.x); pg8::EpiResid<1, 1> E{F.XB, F.out, nullptr, nullptr, SSQ3};
        pg8::gemm_phase<pg8::EpiResid<1, 1>, SO, true, true>(F.lds, g, S, E, F.wave); }
    STAMP(NPH);
#ifdef PROBE_TOTAL
    if (blockIdx.x == 0) { const unsigned long long t1 = __builtin_amdgcn_s_memrealtime(), dt = (t1 - pt_start); while (__builtin_amdgcn_s_memrealtime() - t1 < dt) __builtin_amdgcn_s_sleep(8); }
#endif
#ifdef PROBE_ACC
    if (blockIdx.x == 0) { const unsigned long long t1 = __builtin_amdgcn_s_memrealtime(), dt = F.acc_sum * PROBE_MULT; while (__builtin_amdgcn_s_memrealtime() - t1 < dt) __builtin_amdgcn_s_sleep(8); }
#endif
#ifdef PROBE_PH
    if (blockIdx.x == 0) { const unsigned long long t1 = __builtin_amdgcn_s_memrealtime(), dt = (pt1 - pt0) * PROBE_MULT; while (__builtin_amdgcn_s_memrealtime() - t1 < dt) __builtin_amdgcn_s_sleep(8); }
#endif
#undef IN
#undef SEAM
}

extern "C" void kernel_launch(void* const* d_in, const int* in_sizes, int n_in, void* d_out, int out_size, void* d_ws, size_t ws_size, hipStream_t stream) {
    static int grid = 0;
    if (grid == 0) {
        if (n_in != 16 || in_sizes[0] != M * D || out_size != M * D || ws_size < WS_END) { fprintf(stderr, "kernel_launch: unexpected shapes / workspace (%d inputs, ws %zu)\n", n_in, ws_size); grid = -1; return; }
        int dev = 0, cus = 0;
        if (hipGetDevice(&dev) != hipSuccess || hipDeviceGetAttribute(&cus, hipDeviceAttributeMultiprocessorCount, dev) != hipSuccess) { grid = -1; return; }
        if (hipFuncSetAttribute((const void*)mk_fwd, hipFuncAttributeMaxDynamicSharedMemorySize, LDS_BYTES) != hipSuccess) { fprintf(stderr, "kernel_launch: hipFuncSetAttribute failed\n"); grid = -1; return; }
        (void)hipGetLastError();
        grid = cus;
    }
    if (grid < 0) return;
    if (hipMemsetAsync((char*)d_ws + WS_CTL, 0, CTL_ZERO_BYTES, stream) != hipSuccess) { fprintf(stderr, "kernel_launch: memset failed\n"); return; }
    Args a{};
    for (int i = 0; i < 16; ++i) a.in[i] = (const float*)d_in[i];
    a.out = (float*)d_out; a.ws = (unsigned char*)d_ws;
#if MK_PER_PHASE
    for (int ph = 0; ph < NPH; ++ph) { a.ph_lo = ph; a.ph_hi = ph + 1; hipLaunchKernelGGL(mk_fwd, dim3(grid), dim3(NTHR), LDS_BYTES, stream, a); }
#else
    a.ph_lo = 0; a.ph_hi = NPH;
    hipLaunchKernelGGL(mk_fwd, dim3(grid), dim3(NTHR), LDS_BYTES, stream, a);
#endif
    const hipError_t le = hipPeekAtLastError();
    if (le != hipSuccess) fprintf(stderr, "kernel_launch: launch failed: %s\n", hipGetErrorName(le));
}
```

```cpp
#include <hip/hip_runtime.h>
#include <cstdio>
#include <cstdint>
namespace pg8 {
#define PG8_LAS __attribute__((address_space(3)))
typedef unsigned short bf16_t;
typedef short bf16x8 __attribute__((ext_vector_type(8)));
typedef float f32x4 __attribute__((ext_vector_type(4)));
typedef unsigned u32x4 __attribute__((ext_vector_type(4)));
constexpr int BM = 256, BK = 64, HALF = 128, HTB = HALF * BK * 2  , STAGE_BYTES = 8 * HTB, NXCD = 8, WGM = 8;

__host__ __device__ __forceinline__ int lds_byte(int r, int c) { const int st = (r >> 4) * 2 + (c >> 5), rr = r & 15, cc = c & 31, ob = rr * 64 + cc * 2; return st * 1024 + (ob ^ (((ob >> 9) & 1) << 5)); }
__host__ __device__ __forceinline__ void stage_rc(int b, int& R, int& C) { const int st = b / 1024, sb = b % 1024, swz = sb ^ (((sb >> 9) & 1) << 5); R = (st >> 1) * 16 + swz / 64; C = (st & 1) * 32 + (swz % 64) / 2; }
__host__ __device__ __forceinline__ int perm32(int rho) { const int n = rho >> 4, i = rho & 15; return 8 * (i >> 2) + 4 * n + (i & 3); }

struct Unit { int pm, pn; };
struct Gemm { const bf16_t* A; const bf16_t* Bt; int M, N, K; };

struct StaticOrder {
    int nM, nN, nwg, G, c;
    __host__ __device__ void init(int M, int N, int G_, int c_) { nM = M / BM; nN = N / BM; nwg = nM * nN; G = G_; c = c_; }
    __host__ __device__ bool next(int i, Unit& u) const {
        const long L = (long)i * G + c; if (L >= nwg) return false;
        int wgid = (int)L; { const int q = nwg / NXCD, r = nwg % NXCD, xcd = wgid % NXCD, off = wgid / NXCD; wgid = (xcd < r ? xcd * (q + 1) : r * (q + 1) + (xcd - r) * q) + off; }
        const int nig = WGM * nN, gid = wgid / nig, fm = gid * WGM, gsz = (nM - fm) < WGM ? (nM - fm) : WGM;
        u.pm = fm + ((wgid % nig) % gsz); u.pn = (wgid % nig) / gsz; return true;
    }
    __device__ __forceinline__ void a_ready(const Unit&) const {}
    __device__ __forceinline__ void done(const Unit&) const {}
};

__device__ __forceinline__ unsigned cvt_pk_bf16(float lo, float hi) { unsigned r; asm volatile("v_cvt_pk_bf16_f32 %0, %1, %2" : "=v"(r) : "v"(lo), "v"(hi)); return r; }
__device__ __forceinline__ float row_rstd(const float* ssqp, int row) {
    const f32x4* p = (const f32x4*)(ssqp + (size_t)row * 16);
    const f32x4 a = p[0], b = p[1], c = p[2], d = p[3];
    const float s = (((a[0] + a[1]) + (a[2] + a[3])) + ((b[0] + b[1]) + (b[2] + b[3]))) + (((c[0] + c[1]) + (c[2] + c[3])) + ((d[0] + d[1]) + (d[2] + d[3])));
    return rsqrtf(s * (1.0f / 1024.0f) + 1e-6f);
}
__device__ __forceinline__ int epi_lane() { int l; asm volatile("v_mbcnt_lo_u32_b32 %0, -1, 0\n\tv_mbcnt_hi_u32_b32 %0, -1, %0" : "=v"(l)); return l; }
__device__ __forceinline__ float relu_bits(float x) { const int i = __builtin_bit_cast(int, x); return __builtin_bit_cast(float, i > 0 ? i : 0); }
template <int ACT  > struct EpiScale {
    static constexpr bool PERM = true, AFTER_DRAIN = false;
    bf16_t* O; int ldc; const float* ssqp;
    __device__ __forceinline__ void operator()(const f32x4 (&acc)[2][2][4][2], const Unit& u, int wr, int wc, int fr, int fq) const {
        const int row0 = u.pm * BM + wr * 64 + fr, col0 = u.pn * BM + wc * 32 + 8 * fq;
#pragma unroll
        for (int ai = 0; ai < 2; ++ai)
#pragma unroll
            for (int m = 0; m < 4; ++m) {
                const int row = row0 + ai * HALF + m * 16;
                const float rs = (ACT == 0) ? row_rstd(ssqp, row) : 1.0f;
                bf16_t* rowp = O + (size_t)row * ldc + col0;
#pragma unroll
                for (int bj = 0; bj < 2; ++bj) {
                    f32x4 v0 = acc[ai][bj][m][0] * rs, v1 = acc[ai][bj][m][1] * rs;
                    if (ACT == 1) {
#pragma unroll
                        for (int e = 0; e < 4; ++e) { const float a0 = relu_bits(v0[e]), a1 = relu_bits(v1[e]); v0[e] = a0 * a0; v1[e] = a1 * a1; }
                    }
                    u32x4 w; w.x = cvt_pk_bf16(v0[0], v0[1]); w.y = cvt_pk_bf16(v0[2], v0[3]); w.z = cvt_pk_bf16(v1[0], v1[1]); w.w = cvt_pk_bf16(v1[2], v1[3]);
                    *(u32x4*)(rowp + bj * HALF) = w;
                }
            }
    }
};
template <int RIN, int OUT> struct EpiResid {
    static constexpr bool PERM = true, AFTER_DRAIN = false;
    const void* R; float* out; bf16_t* hb; float* ssqp; const float* ssq_in;
    __device__ __forceinline__ void operator()(const f32x4 (&acc)[2][2][4][2], const Unit& u, int wr, int wc, int fr, int fq) const {
        const int row0 = u.pm * BM + wr * 64 + fr, col0 = u.pn * BM + wc * 32 + 8 * fq;
        constexpr int MB = 2;
        constexpr int NW = (RIN == 0) ? 2 : 1;
#pragma unroll
        for (int ai = 0; ai < 2; ++ai)
#pragma unroll
            for (int m0 = 0; m0 < 4; m0 += MB) {
                u32x4 rw[MB][2][NW]; f32x4 pp[MB][4];
#pragma unroll
                for (int mm = 0; mm < MB; ++mm)
#pragma unroll
                    for (int bj = 0; bj < 2; ++bj) { const unsigned off = (unsigned)((row0 + ai * HALF + (m0 + mm) * 16) * 1024 + col0 + bj * HALF);
                        if (RIN == 0) { rw[mm][bj][0] = *(const u32x4*)((const char*)R + off * 4u); rw[mm][bj][NW - 1] = *(const u32x4*)((const char*)R + off * 4u + 16u); }
                        else rw[mm][bj][0] = *(const u32x4*)((const char*)R + off * 2u); }
                if (ssq_in) {
#pragma unroll
                    for (int mm = 0; mm < MB; ++mm) { const f32x4* p = (const f32x4*)((const char*)ssq_in + (unsigned)(row0 + ai * HALF + (m0 + mm) * 16) * 64u);
#pragma unroll
                        for (int k = 0; k < 4; ++k) pp[mm][k] = p[k]; } }
                asm volatile("" ::: "memory");
#pragma unroll
                for (int mm = 0; mm < MB; ++mm) {
                    const int m = m0 + mm, row = row0 + ai * HALF + m * 16;
                    const unsigned off = (unsigned)(row * 1024 + col0);
                    float sc2 = 1.0f;
                    if (ssq_in) { const f32x4 a = pp[mm][0], b = pp[mm][1], c = pp[mm][2], d = pp[mm][3];
                        const float sum = (((a[0] + a[1]) + (a[2] + a[3])) + ((b[0] + b[1]) + (b[2] + b[3]))) + (((c[0] + c[1]) + (c[2] + c[3])) + ((d[0] + d[1]) + (d[2] + d[3])));
                        const float rs = rsqrtf(sum * (1.0f / 1024.0f) + 1e-6f); sc2 = rs * rs; }
                    float ss = 0.f;
#pragma unroll
                    for (int bj = 0; bj < 2; ++bj) {
                        f32x4 r0, r1;
                        if (RIN == 0) { r0 = __builtin_bit_cast(f32x4, rw[mm][bj][0]); r1 = __builtin_bit_cast(f32x4, rw[mm][bj][NW - 1]); }
                        else { const u32x4 w = rw[mm][bj][0];
                            r0 = (f32x4){__uint_as_float(w.x << 16), __uint_as_float(w.x & 0xffff0000u), __uint_as_float(w.y << 16), __uint_as_float(w.y & 0xffff0000u)};
                            r1 = (f32x4){__uint_as_float(w.z << 16), __uint_as_float(w.z & 0xffff0000u), __uint_as_float(w.w << 16), __uint_as_float(w.w & 0xffff0000u)}; }
                        const f32x4 v0 = acc[ai][bj][m][0] * sc2 + r0, v1 = acc[ai][bj][m][1] * sc2 + r1;
                        if (OUT == 1) { *(f32x4*)((char*)out + (off + bj * HALF) * 4u) = v0; *(f32x4*)((char*)out + (off + bj * HALF) * 4u + 16u) = v1; }
                        else {
                            u32x4 w; w.x = cvt_pk_bf16(v0[0], v0[1]); w.y = cvt_pk_bf16(v0[2], v0[3]); w.z = cvt_pk_bf16(v1[0], v1[1]); w.w = cvt_pk_bf16(v1[2], v1[3]);
                            *(u32x4*)((char*)hb + (off + bj * HALF) * 2u) = w;
                            ss += ((v0[0] * v0[0] + v0[1] * v0[1]) + (v0[2] * v0[2] + v0[3] * v0[3])) + ((v1[0] * v1[0] + v1[1] * v1[1]) + (v1[2] * v1[2] + v1[3] * v1[3]));
                        }
                    }
                    if (OUT == 0) { ss += __shfl_xor(ss, 16); ss += __shfl_xor(ss, 32); if (fq == 0) *(float*)((char*)ssqp + (unsigned)(row * 16 + u.pn * 4 + wc) * 4u) = ss; }
                }
            }
    }
};
struct EpiQKNorm {
    static constexpr bool PERM = true, AFTER_DRAIN = false;
    bf16_t* O; int ldc; const float* ssqp; const float* gq; const float* gk; PG8_LAS float* part; float qscale;
    __device__ __forceinline__ void operator()(const f32x4 (&acc)[2][2][4][2], const Unit& u, int wr, int wc, int fr_, int fq_) const {
        const int ln = epi_lane(), fr = ln & 15, fq = ln >> 4;
        const int row0 = u.pm * BM + wr * 64 + fr, col0 = u.pn * BM + wc * 32 + 8 * fq;
        const bool nrm = u.pn < 8;
        const int pbase = (wr * 64 + fr) * 8;
        PG8_LAS float* pr = part + pbase; PG8_LAS float* pw = pr + wc;
        float rsv[2][4];
#pragma unroll
        for (int ai = 0; ai < 2; ++ai) { f32x4 pp[4][4];
#pragma unroll
            for (int m = 0; m < 4; ++m) { const f32x4* p = (const f32x4*)((const char*)ssqp + (unsigned)(row0 + ai * HALF + m * 16) * 64u);
#pragma unroll
                for (int k = 0; k < 4; ++k) pp[m][k] = p[k]; }
#pragma unroll
            for (int m = 0; m < 4; ++m) { const f32x4 a = pp[m][0], b = pp[m][1], c = pp[m][2], d = pp[m][3];
                const float sum = (((a[0] + a[1]) + (a[2] + a[3])) + ((b[0] + b[1]) + (b[2] + b[3]))) + (((c[0] + c[1]) + (c[2] + c[3])) + ((d[0] + d[1]) + (d[2] + d[3])));
                rsv[ai][m] = rsqrtf(sum * (1.0f / 1024.0f) + 1e-6f); asm volatile("" : "+v"(rsv[ai][m]) :: "memory"); } }
        f32x4 g0 = (f32x4){1.f, 1.f, 1.f, 1.f}, g1 = g0;
        if (nrm) {
#pragma unroll
            for (int ai = 0; ai < 2; ++ai)
#pragma unroll
                for (int m = 0; m < 4; ++m)
#pragma unroll
                    for (int bj = 0; bj < 2; ++bj) { const f32x4 v0 = acc[ai][bj][m][0], v1 = acc[ai][bj][m][1];
                        float ss = ((v0[0] * v0[0] + v0[1] * v0[1]) + (v0[2] * v0[2] + v0[3] * v0[3])) + ((v1[0] * v1[0] + v1[1] * v1[1]) + (v1[2] * v1[2] + v1[3] * v1[3]));
                        ss += __shfl_xor(ss, 16); ss += __shfl_xor(ss, 32);
                        if (fq == 0) pw[((ai * HALF + m * 16) * 2 + bj) * 4] = ss; }
            asm volatile("s_waitcnt lgkmcnt(0)" ::: "memory"); __builtin_amdgcn_s_barrier(); asm volatile("" ::: "memory");
            const float* gp = (u.pn < 4 ? gq : gk) + wc * 32 + 8 * fq; const float sc = (u.pn < 4) ? qscale : 1.0f;
            g0 = *(const f32x4*)gp * sc; g1 = *(const f32x4*)(gp + 4) * sc;
        }
#pragma unroll
        for (int ai = 0; ai < 2; ++ai)
#pragma unroll
            for (int m = 0; m < 4; ++m) {
                const int row = row0 + ai * HALF + m * 16;
                const float rsr = rsv[ai][m];
                bf16_t* rowp = O + (size_t)row * ldc + col0;
#pragma unroll
                for (int bj = 0; bj < 2; ++bj) {
                    float hs = rsr;
                    if (nrm) { const f32x4 pp = *(const PG8_LAS f32x4*)(pr + ((ai * HALF + m * 16) * 2 + bj) * 4);
                        hs *= rsqrtf(((pp[0] + pp[1]) + (pp[2] + pp[3])) * (rsr * rsr * (1.0f / 128.0f)) + 1e-6f); }
                    const f32x4 v0 = acc[ai][bj][m][0] * hs * g0, v1 = acc[ai][bj][m][1] * hs * g1;
                    u32x4 w; w.x = cvt_pk_bf16(v0[0], v0[1]); w.y = cvt_pk_bf16(v0[2], v0[3]); w.z = cvt_pk_bf16(v1[0], v1[1]); w.w = cvt_pk_bf16(v1[2], v1[3]);
                    *(u32x4*)(rowp + bj * HALF) = w;
                }
            }
    }
};
struct EpiProjAB {
    static constexpr bool PERM = true, AFTER_DRAIN = false;
    bf16_t* O; int ldc; const float* ssqp; const float* gq; const float* gk; const float* r128; const float* r64; PG8_LAS float* part; float qscale;
    __device__ __forceinline__ void operator()(const f32x4 (&acc)[2][2][4][2], const Unit& u, int wr, int wc, int fr_, int fq_) const {
        const int ln = epi_lane(), fr = ln & 15, fq = ln >> 4;
        const int cb = wc * 32 + 8 * fq;
        const int row0 = u.pm * BM + wr * 64 + fr, col0 = u.pn * BM + cb, pn = u.pn;
        const bool qk = pn < 4, iq = (pn == 6) || (pn == 7) || (pn == 14);
        const int pbase = (wr * 64 + fr) * 8;
        PG8_LAS float* pr = part + pbase; PG8_LAS float* pw = pr + wc;
        const bool rope_qk = qk && (wc == 0), rope_iq = iq && !(wc & 1) && (pn != 14 || wc == 0);
        float rsv[2][4];
#pragma unroll
        for (int ai = 0; ai < 2; ++ai)
#pragma unroll
            for (int m = 0; m < 4; ++m) rsv[ai][m] = *(const float*)((const char*)ssqp + (unsigned)(row0 + ai * HALF + m * 16) * 64u);
#pragma unroll
        for (int ai = 0; ai < 2; ++ai)
#pragma unroll
            for (int m = 0; m < 4; ++m) rsv[ai][m] = rsqrtf(rsv[ai][m] * (1.0f / 1024.0f) + 1e-6f);
        f32x4 g0 = (f32x4){1.f, 1.f, 1.f, 1.f}, g1 = g0;
        if (qk) {
#pragma unroll
            for (int ai = 0; ai < 2; ++ai)
#pragma unroll
                for (int m = 0; m < 4; ++m)
#pragma unroll
                    for (int bj = 0; bj < 2; ++bj) { const f32x4 v0 = acc[ai][bj][m][0], v1 = acc[ai][bj][m][1];
                        float ss = ((v0[0] * v0[0] + v0[1] * v0[1]) + (v0[2] * v0[2] + v0[3] * v0[3])) + ((v1[0] * v1[0] + v1[1] * v1[1]) + (v1[2] * v1[2] + v1[3] * v1[3]));
                        ss += __shfl_xor(ss, 16); ss += __shfl_xor(ss, 32);
                        if (fq == 0) pw[((ai * HALF + m * 16) * 2 + bj) * 4] = ss; }
            asm volatile("s_waitcnt lgkmcnt(0)" ::: "memory"); __builtin_amdgcn_s_barrier(); asm volatile("" ::: "memory");
            const float* gp = (pn < 2 ? gq : gk) + cb; const float sc = (pn < 2) ? qscale : 1.0f;
            g0 = *(const f32x4*)gp * sc; g1 = *(const f32x4*)(gp + 4) * sc;
        }
#pragma unroll
        for (int ai = 0; ai < 2; ++ai) {
            f32x4 cc[4][4];
            if (rope_qk || rope_iq) {
#pragma unroll
                for (int m = 0; m < 4; ++m) { const int pos = (row0 + ai * HALF + m * 16) & 2047;
                    const float* t = rope_qk ? (r128 + pos * 32 + 8 * (fq & 1)) : (r64 + pos * 16); const int so = rope_qk ? 16 : 8;
                    cc[m][0] = *(const f32x4*)t; cc[m][1] = *(const f32x4*)(t + 4); cc[m][2] = *(const f32x4*)(t + so); cc[m][3] = *(const f32x4*)(t + so + 4); }
            }
#pragma unroll
            for (int m = 0; m < 4; ++m) {
                const int row = row0 + ai * HALF + m * 16;
                const float rsr = rsv[ai][m];
                bf16_t* rowp = O + (size_t)row * ldc + col0;
                const f32x4 c0 = cc[m][0], c1 = cc[m][1], s0 = cc[m][2], s1 = cc[m][3];
#pragma unroll
                for (int bj = 0; bj < 2; ++bj) {
                    float hs = rsr;
                    if (qk) { const f32x4 pp = *(const PG8_LAS f32x4*)(pr + ((ai * HALF + m * 16) * 2 + bj) * 4);
                        hs *= rsqrtf(((pp[0] + pp[1]) + (pp[2] + pp[3])) * (rsr * rsr * (1.0f / 128.0f)) + 1e-6f); }
                    f32x4 v0 = acc[ai][bj][m][0] * hs * g0, v1 = acc[ai][bj][m][1] * hs * g1;
                    if (rope_qk) {
                        f32x4 p0, p1;
#pragma unroll
                        for (int e = 0; e < 4; ++e) { p0[e] = __shfl_xor(v0[e], 32); p1[e] = __shfl_xor(v1[e], 32); }
                        if (fq < 2) { v0 = v0 * c0 - p0 * s0; v1 = v1 * c1 - p1 * s1; } else { v0 = v0 * c0 + p0 * s0; v1 = v1 * c1 + p1 * s1; }
                    } else if (rope_iq && (pn != 14 || bj == 0)) {
                        f32x4 p0, p1;
#pragma unroll
                        for (int e = 0; e < 4; ++e) { p0[e] = __shfl_xor(v0[e], 16); p1[e] = __shfl_xor(v1[e], 16); }
                        if (fq == 0) { v0 = v0 * c0 - p0 * s0; v1 = v1 * c1 - p1 * s1; } else if (fq == 1) { v0 = v0 * c0 + p0 * s0; v1 = v1 * c1 + p1 * s1; }
                    }
                    u32x4 w; w.x = cvt_pk_bf16(v0[0], v0[1]); w.y = cvt_pk_bf16(v0[2], v0[3]); w.z = cvt_pk_bf16(v1[0], v1[1]); w.w = cvt_pk_bf16(v1[2], v1[3]);
                    *(u32x4*)(rowp + bj * HALF) = w;
                }
            }
        }
    }
};
template <class Epi, class Sched, bool ALIGN_EPI = false, bool SP2 = false>
__device__ __forceinline__ void gemm_phase(PG8_LAS unsigned char* lds, const Gemm g, const Sched& S, const Epi& E, const int wave_in) {
    const int wid = wave_in, lane = (int)__builtin_amdgcn_mbcnt_hi(~0u, __builtin_amdgcn_mbcnt_lo(~0u, 0u)), tid = wid * 64 + lane, wr = wid >> 2, wc = wid & 3, fr = lane & 15, fq = lane >> 4;
    const int K = g.K, nt = K / BK;
    unsigned voffA[2], voffB[2];
#pragma unroll
    for (int i = 0; i < 2; ++i) { int R, C; stage_rc(tid * 16 + i * 8192, R, C); const int Rb = Epi::PERM ? ((R & ~31) + perm32(R & 31)) : R;
        voffA[i] = (unsigned)(R * K + C) * 2u; voffB[i] = (unsigned)(Rb * K + C) * 2u; }
    const size_t kstep = (size_t)(BK * 2);
    const size_t hstep = (size_t)HALF * K * 2;
    const size_t tstep = 2 * hstep;
    const unsigned ldsw = (unsigned)wid * 1024u;
    const int aoff = lds_byte(wr * 64 + fr, fq * 8), boff = lds_byte(wc * 32 + fr, fq * 8);
#define PG8_SA(b, h) (((b) * 2 + (h)) * HTB)
#define PG8_SB(b, h) ((4 + (b) * 2 + (h)) * HTB)
#define PG8_STAGE(bufoff, gbase, voff) do { _Pragma("unroll") for (int _i = 0; _i < 2; ++_i) \
        __builtin_amdgcn_global_load_lds((const unsigned*)((const char*)(gbase) + (voff)[_i]), (PG8_LAS unsigned*)(lds + (bufoff) + ldsw + _i * 8192), 16, 0, 0); } while (0)
#define PG8_LDA(dst, b, h) do { _Pragma("unroll") for (int m = 0; m < 4; ++m) _Pragma("unroll") for (int k = 0; k < 2; ++k) dst[m][k] = *(const PG8_LAS bf16x8*)(lds + PG8_SA(b, h) + aoff + m * 2048 + k * 1024); } while (0)
#define PG8_LDB(dst, b, h) do { _Pragma("unroll") for (int n = 0; n < 2; ++n) _Pragma("unroll") for (int k = 0; k < 2; ++k) dst[n][k] = *(const PG8_LAS bf16x8*)(lds + PG8_SB(b, h) + boff + n * 2048 + k * 1024); } while (0)
#define PG8_MMA(ai, bj, At, Bt) do { __builtin_amdgcn_s_setprio(1); _Pragma("unroll") for (int m = 0; m < 4; ++m) _Pragma("unroll") for (int n = 0; n < 2; ++n) _Pragma("unroll") for (int k = 0; k < 2; ++k) \
        acc[ai][bj][m][n] = __builtin_amdgcn_mfma_f32_16x16x32_bf16(Bt[n][k], At[m][k], acc[ai][bj][m][n], 0, 0, 0); __builtin_amdgcn_s_setprio(0); } while (0)
#define PG8_WAIT_V(n) asm volatile("s_waitcnt vmcnt(" #n ")" ::: "memory")
#define PG8_WAIT_L(n) asm volatile("s_waitcnt lgkmcnt(" #n ")" ::: "memory")
#define PG8_BAR __builtin_amdgcn_s_barrier()
#define PG8_SCHED __builtin_amdgcn_sched_barrier(0)
    Unit cur, nxt; int ui = 0;
    if (!S.next(0, cur)) return;
    f32x4 acc[2][2][4][2];
#pragma unroll
    for (int a = 0; a < 2; ++a)
#pragma unroll
        for (int b = 0; b < 2; ++b)
#pragma unroll
            for (int m = 0; m < 4; ++m)
#pragma unroll
                for (int n = 0; n < 2; ++n) acc[a][b][m][n] = (f32x4){0.f, 0.f, 0.f, 0.f};
    bf16x8 At[4][2], B0[2][2], B1[2][2];
    const char* cA = (const char*)g.A + (size_t)cur.pm * tstep; const char* cB = (const char*)g.Bt + (size_t)cur.pn * tstep;
    S.a_ready(cur);
    if constexpr (SP2) {
        PG8_STAGE(PG8_SB(0, 0), cB, voffB); PG8_STAGE(PG8_SB(0, 1), cB + hstep, voffB); PG8_STAGE(PG8_SA(0, 0), cA, voffA); PG8_STAGE(PG8_SA(0, 1), cA + hstep, voffA);
        if (wr == 1) PG8_BAR;
        PG8_WAIT_V(2); PG8_BAR;
        PG8_STAGE(PG8_SB(1, 0), cB + kstep, voffB); PG8_STAGE(PG8_SA(1, 0), cA + kstep, voffA); PG8_STAGE(PG8_SB(1, 1), cB + hstep + kstep, voffB);
        PG8_WAIT_V(6); PG8_BAR;
    } else {
        PG8_STAGE(PG8_SB(0, 0), cB, voffB); PG8_STAGE(PG8_SA(0, 0), cA, voffA); PG8_STAGE(PG8_SB(0, 1), cB + hstep, voffB); PG8_STAGE(PG8_SA(0, 1), cA + hstep, voffA);
        if (wr == 1) PG8_BAR;
        PG8_WAIT_V(4); PG8_BAR;
        PG8_STAGE(PG8_SB(1, 0), cB + kstep, voffB); PG8_STAGE(PG8_SA(1, 0), cA + kstep, voffA); PG8_STAGE(PG8_SB(1, 1), cB + hstep + kstep, voffB);
        PG8_WAIT_V(6); PG8_BAR;
    }
    for (;;) {
        const bool has_next = S.next(ui + 1, nxt);
        const char* nA = has_next ? (const char*)g.A + (size_t)nxt.pm * tstep : cA; const char* nB = has_next ? (const char*)g.Bt + (size_t)nxt.pn * tstep : cB;
        for (int t = 0; t < nt; t += 2) {
            const bool last = (t == nt - 2);
            const char* a1 = cA + (size_t)(t + 1) * kstep;
            const char* a2 = last ? nA : cA + (size_t)(t + 2) * kstep; const char* b2 = last ? nB : cB + (size_t)(t + 2) * kstep;
            const char* a3 = a2 + kstep; const char* b3 = b2 + kstep;
            if (last && has_next) S.a_ready(nxt);
            if constexpr (SP2) {
            PG8_LDB(B0, 0, 0); PG8_LDB(B1, 0, 1); PG8_SCHED; PG8_LDA(At, 0, 0); PG8_STAGE(PG8_SA(1, 1), a1 + hstep, voffA);
            PG8_WAIT_V(8); PG8_WAIT_L(0); PG8_BAR; PG8_MMA(0, 0, At, B0); PG8_MMA(0, 1, At, B1); PG8_BAR; PG8_SCHED;
            PG8_LDA(At, 0, 1); PG8_STAGE(PG8_SB(0, 0), b2, voffB); PG8_STAGE(PG8_SB(0, 1), b2 + hstep, voffB); PG8_STAGE(PG8_SA(0, 0), a2, voffA);
            PG8_WAIT_V(8); PG8_WAIT_L(0); PG8_BAR; PG8_MMA(1, 0, At, B0); PG8_MMA(1, 1, At, B1); PG8_BAR; PG8_SCHED;
            PG8_LDB(B0, 1, 0); PG8_LDB(B1, 1, 1); PG8_SCHED; PG8_LDA(At, 1, 0); PG8_STAGE(PG8_SA(0, 1), a2 + hstep, voffA);
            PG8_WAIT_V(8); PG8_WAIT_L(0); PG8_BAR; PG8_MMA(0, 0, At, B0); PG8_MMA(0, 1, At, B1); PG8_BAR; PG8_SCHED;
            PG8_LDA(At, 1, 1); PG8_STAGE(PG8_SB(1, 0), b3, voffB); PG8_STAGE(PG8_SB(1, 1), b3 + hstep, voffB); PG8_STAGE(PG8_SA(1, 0), a3, voffA);
            PG8_WAIT_V(8); PG8_WAIT_L(0); PG8_BAR; PG8_MMA(1, 0, At, B0); PG8_MMA(1, 1, At, B1); PG8_BAR; PG8_SCHED;
            } else {
            PG8_LDB(B0, 0, 0); PG8_SCHED; PG8_LDA(At, 0, 0); PG8_STAGE(PG8_SA(1, 1), a1 + hstep, voffA);
            PG8_WAIT_L(8); PG8_BAR; PG8_WAIT_L(0); PG8_MMA(0, 0, At, B0); PG8_BAR; PG8_SCHED;
            PG8_LDB(B1, 0, 1); PG8_STAGE(PG8_SB(0, 0), b2, voffB);
            PG8_BAR; PG8_WAIT_L(0); PG8_MMA(0, 1, At, B1); PG8_BAR;
            PG8_LDA(At, 0, 1); PG8_STAGE(PG8_SA(0, 0), a2, voffA);
            PG8_BAR; PG8_WAIT_L(0); PG8_MMA(1, 0, At, B0); PG8_BAR; PG8_SCHED;
            PG8_STAGE(PG8_SB(0, 1), b2 + hstep, voffB);
            PG8_WAIT_V(6); PG8_BAR; PG8_MMA(1, 1, At, B1); PG8_BAR;
            PG8_LDB(B0, 1, 0); PG8_SCHED; PG8_LDA(At, 1, 0); PG8_STAGE(PG8_SA(0, 1), a2 + hstep, voffA);
            PG8_WAIT_L(8); PG8_BAR; PG8_WAIT_L(0); PG8_MMA(0, 0, At, B0); PG8_BAR; PG8_SCHED;
            PG8_LDB(B1, 1, 1); PG8_STAGE(PG8_SB(1, 0), b3, voffB);
            PG8_BAR; PG8_WAIT_L(0); PG8_MMA(0, 1, At, B1); PG8_BAR;
            PG8_LDA(At, 1, 1); PG8_STAGE(PG8_SA(1, 0), a3, voffA);
            PG8_BAR; PG8_WAIT_L(0); PG8_MMA(1, 0, At, B0); PG8_BAR; PG8_SCHED;
            PG8_STAGE(PG8_SB(1, 1), b3 + hstep, voffB);
            PG8_WAIT_V(6); PG8_BAR; PG8_MMA(1, 1, At, B1); PG8_BAR;
            }
        }
        if constexpr (ALIGN_EPI) { if (wr == 0) PG8_BAR; }
        if constexpr (!Epi::AFTER_DRAIN) { E(acc, cur, wr, wc, fr, fq); S.done(cur); }
        if (!has_next) break;
#pragma unroll
        for (int a = 0; a < 2; ++a)
#pragma unroll
            for (int b = 0; b < 2; ++b)
#pragma unroll
                for (int m = 0; m < 4; ++m)
#pragma unroll
                    for (int n = 0; n < 2; ++n) acc[a][b][m][n] = (f32x4){0.f, 0.f, 0.f, 0.f};
        cur = nxt; cA = nA; cB = nB; ++ui;
        if constexpr (ALIGN_EPI) { if (wr == 1) PG8_BAR; }
    }
    PG8_WAIT_V(0);
    if constexpr (!ALIGN_EPI) { if (wr == 0) PG8_BAR; }
    PG8_BAR;
    if constexpr (Epi::AFTER_DRAIN) { E.fused(acc, cur, wr, wc, fr, fq, lds, wid, lane); S.done(cur); }
#undef PG8_SA
#undef PG8_SB
#undef PG8_STAGE
#undef PG8_LDA
#undef PG8_LDB
#undef PG8_MMA
#undef PG8_WAIT_V
#undef PG8_WAIT_L
#undef PG8_BAR
#undef PG8_SCHED
}
}
#include <cmath>
constexpr int NWAVES = 8, NTHR = 512;
constexpr int BATCH = 16, SEQ = 2048, M = BATCH * SEQ, D = 1024, FF = 4096, NAB = 3840, NC = 3072, ABP_OLD = 3672;
constexpr int C_QA = 0, C_KA = 512, C_VA = 1024, C_IQ = 1536, C_QB = 2048, C_KB = 2304, C_VB = 2560, C_OG = 3072, C_IK = 3584, C_IW = 3648, C_GL = 3656;
constexpr float EPS = 1e-6f;
constexpr size_t MiB = 1u << 20;
constexpr size_t WS_CTL = 0, CTL_ZERO_BYTES = 64 * 1024;
constexpr size_t WS_WAB = 1 * MiB, WS_WOAB = 9 * MiB, WS_WUP0 = 11 * MiB, WS_WDN0 = 19 * MiB, WS_WINC = 27 * MiB, WS_WOC = 33 * MiB, WS_WUP1 = 35 * MiB, WS_WDN1 = 43 * MiB;
constexpr size_t WS_SSQ = 51 * MiB, SSQ_BYTES = 2 * MiB;
constexpr size_t WS_DEC = 59 * MiB;
constexpr size_t WS_ROPE = 59 * MiB + 512 * 1024;
constexpr size_t WS_XB = 60 * MiB;
constexpr size_t WS_CAT = 124 * MiB;
constexpr size_t WS_MASK = 188 * MiB;
constexpr size_t WS_R1 = 196 * MiB;
constexpr size_t WS_BC = 452 * MiB;
constexpr size_t WS_END = 484 * MiB;
constexpr int CW_BAR = 4096;
constexpr int RING_BYTES = 131072;
constexpr int LDS_BYTES = 163840;
constexpr int MISC_OFF = LDS_BYTES - 256;
#define GAS __attribute__((address_space(1)))
#define LAS __attribute__((address_space(3)))
typedef unsigned short bf16;
typedef unsigned v4u __attribute__((ext_vector_type(4)));
typedef float f32x4 __attribute__((ext_vector_type(4)));
typedef short bf16x8 __attribute__((ext_vector_type(8)));
typedef GAS unsigned gu32;
typedef GAS unsigned long long gu64;
#define RLX_AGENT __ATOMIC_RELAXED, __HIP_MEMORY_SCOPE_AGENT
#define LDS_WAIT() asm volatile("s_waitcnt lgkmcnt(0)" ::: "memory")
#define VM_WAIT() asm volatile("s_waitcnt vmcnt(0)" ::: "memory")
__device__ __forceinline__ unsigned long long rt() { return __builtin_amdgcn_s_memrealtime(); }
__device__ __forceinline__ unsigned f2bf(float f) { unsigned u = __builtin_bit_cast(unsigned, f); return (u + 0x7fffu + ((u >> 16) & 1u)) >> 16; }
__device__ __forceinline__ unsigned pk2(float lo, float hi) { return f2bf(lo) | (f2bf(hi) << 16); }
#define XB_TMO      128
#define XB_XCNT(j)  (256  + 64 * (j))
#define XB_XSUB(j)  (1280 + 64 * (j))
#define XB_XGEN(j)  (2304 + 64 * (j))
#define XB_TOP      3328
#define XB_TOPGEN   3392
#define XCD_BAR_WORDS 3456
#define XB_SPIN_CAP (1u << 18)

__device__ __forceinline__ unsigned xb_ld(unsigned* p)              { return __hip_atomic_load(p, __ATOMIC_RELAXED, __HIP_MEMORY_SCOPE_AGENT); }
__device__ __forceinline__ unsigned xb_add(unsigned* p, unsigned v) { return __hip_atomic_fetch_add(p, v, __ATOMIC_RELAXED, __HIP_MEMORY_SCOPE_AGENT); }
__device__ __forceinline__ unsigned xb_xcc_id() { return (unsigned)__builtin_amdgcn_s_getreg((3 << 11) | 20) & 0xFu; }
#define XB_SPIN(cond, bar) do { unsigned _sp = 0; while (cond) { __builtin_amdgcn_s_sleep(1); \
    if ((++_sp & 255u) == 0u) { if (xb_ld(&(bar)[XB_TMO])) break; if (_sp > XB_SPIN_CAP) { atomicAdd(&(bar)[XB_TMO], 1u); break; } } } } while (0)

struct XcdBarrier {
    unsigned* bar; unsigned x; int wave;
    volatile LAS unsigned* st;
};

__device__ __forceinline__ bool xb_t0(int wave) { return wave == 0 && __builtin_amdgcn_mbcnt_hi(~0u, __builtin_amdgcn_mbcnt_lo(~0u, 0u)) == 0u; }
__device__ __forceinline__ XcdBarrier xcd_barrier_post(unsigned* bar, volatile LAS unsigned* st, int wave) {
    XcdBarrier b; b.bar = bar; b.x = xb_xcc_id(); b.st = st; b.wave = wave;
    if (xb_t0(wave)) (void)xb_add(&bar[XB_XCNT(b.x)], 1u);
    return b;
}
__device__ __forceinline__ void xcd_barrier_complete(unsigned* bar, unsigned x, unsigned& nloc, unsigned& nx) {
    const unsigned G = gridDim.x * gridDim.y * gridDim.z;
    unsigned sum, cnt, mine, sp = 0u;
    for (;;) {
        sum = 0u; cnt = 0u; mine = 0u;
#pragma unroll
        for (unsigned j = 0; j < 16; ++j) { const unsigned c = xb_ld(&bar[XB_XCNT(j)]); sum += c; cnt += (c > 0u) ? 1u : 0u; mine = (j == x) ? c : mine; }
        if (sum == G) break;
        __builtin_amdgcn_s_sleep(1);
        if ((++sp & 255u) == 0u) { if (xb_ld(&bar[XB_TMO])) break; if (sp > XB_SPIN_CAP) { atomicAdd(&bar[XB_TMO], 1u); break; } }
    }
    nloc = mine > 0u ? mine : 1u; nx = cnt > 0u ? cnt : 1u;
}

__device__ __forceinline__ void xcd_barrier(const XcdBarrier& b) {
    asm volatile("s_waitcnt vmcnt(0)" ::: "memory");
    __syncthreads();
    if (xb_t0(b.wave)) {
        unsigned* bar = b.bar;
        __builtin_amdgcn_s_waitcnt(0);
        unsigned nloc = b.st[0], nx = b.st[1];
        if (nloc == 0u) { xcd_barrier_complete(bar, b.x, nloc, nx); b.st[0] = nloc; b.st[1] = nx; }
        const unsigned old = xb_add(&bar[XB_XSUB(b.x)], 1u);
        const unsigned gen = old / nloc;
        if (old + 1u == (gen + 1u) * nloc) {
            __builtin_amdgcn_fence(__ATOMIC_RELEASE, "agent");
            asm volatile("s_waitcnt vmcnt(0)" ::: "memory");
            const unsigned og = xb_add(&bar[XB_TOP], 1u);
            const unsigned tg = og / nx;
            if (og + 1u == (tg + 1u) * nx) xb_add(&bar[XB_TOPGEN], 1u);
            else XB_SPIN(xb_ld(&bar[XB_TOPGEN]) == tg, bar);
            __builtin_amdgcn_fence(__ATOMIC_ACQUIRE, "agent");
            xb_add(&bar[XB_XGEN(b.x)], 1u);
            asm volatile("s_waitcnt vmcnt(0)" ::: "memory");
        } else {
            XB_SPIN(xb_ld(&bar[XB_XGEN(b.x)]) == gen, bar);
            __builtin_amdgcn_fence(__ATOMIC_ACQUIRE, "agent");
            asm volatile("s_waitcnt vmcnt(0)" ::: "memory");
        }
    }
    __syncthreads();
}
#ifdef PROBE_ACC
#ifdef PROBE_NOSYNC
#define ACC_BEGIN(F, id) do { if ((id) == PROBE_ACC) { asm volatile("" ::: "memory"); (F).acc_t0 = __builtin_amdgcn_s_memrealtime(); asm volatile("" ::: "memory"); } } while (0)
#define ACC_END(F, id) do { if ((id) == PROBE_ACC) { asm volatile("" ::: "memory"); (F).acc_sum += __builtin_amdgcn_s_memrealtime() - (F).acc_t0; asm volatile("" ::: "memory"); } } while (0)
#else
#define ACC_BEGIN(F, id) do { if ((id) == PROBE_ACC) { __syncthreads(); (F).acc_t0 = __builtin_amdgcn_s_memrealtime(); } } while (0)
#define ACC_END(F, id) do { if ((id) == PROBE_ACC) { __syncthreads(); (F).acc_sum += __builtin_amdgcn_s_memrealtime() - (F).acc_t0; } } while (0)
#endif
#else
#define ACC_BEGIN(F, id) do { } while (0)
#define ACC_END(F, id) do { } while (0)
#endif
struct Frame {
#ifdef PROBE_ACC
    unsigned long long acc_t0, acc_sum;
#endif
    LAS unsigned char* lds;
    volatile LAS unsigned* MISC;
    gu32* ctl;
    int tid, lane, wave, vcu, G;
    const float *x, *g_mix, *g_ffn, *w_in_ab, *gq_a, *gk_a, *w_gate_up, *b_gate, *g_gla, *w_out_ab, *w_in_c, *gq_c, *gk_c, *w_out_c, *w_up, *w_down;
    float* out;
    bf16 *Wab, *Woab, *Wup0, *Wdn0, *Winc, *Woc, *Wup1, *Wdn1;
    bf16 *XB, *CAT, *R1;
    float* SSQ; unsigned* MASK;
};
__device__ __forceinline__ int lane_id_opaque() { int l; asm volatile("v_mbcnt_lo_u32_b32 %0, -1, 0\n\tv_mbcnt_hi_u32_b32 %0, -1, %0" : "=v"(l)); return l; }
__device__ __forceinline__ float bf2f(bf16 v) { return __builtin_bit_cast(float, (unsigned)v << 16); }
__device__ __forceinline__ float wave_sum(float v) {
#pragma unroll
    for (int o = 1; o < 64; o <<= 1) v += __shfl_xor(v, o);
    return v;
}
__device__ __forceinline__ float wave_max(float v) {
#pragma unroll
    for (int o = 1; o < 64; o <<= 1) v = fmaxf(v, __shfl_xor(v, o));
    return v;
}
__device__ __forceinline__ float log_sigmoid(float x) { return fminf(x, 0.f) - log1pf(expf(-fabsf(x))); }

__device__ __forceinline__ int oldcol_ab(int n) {
    if (n < 2048) return n;
    if (n < 2304) return 2120 + (n - 2048);
    if (n < 2560) return 2376 + (n - 2304);
    if (n < 3072) return 2632 + (n - 2560);
    if (n < 3584) return 3160 + (n - 3072);
    if (n < 3648) return 2048 + (n - 3584);
    if (n < 3656) return 2112 + (n - 3648);
    if (n < 3672) return 3144 + (n - 3656);
    return -1;
}
__device__ __forceinline__ void p0_transpose_item(const float* W, int ldw, int K, const float* gain, bf16* WT, bool map, int item, int nblk, int lane) {
    const int kb = item / nblk, nb = item % nblk, ng = lane & 7, ko = lane >> 3, k0 = 64 * kb + 8 * ko, n = 32 * nb + 4 * ng;
    const int oc = map ? oldcol_ab(n) : n;
    f32x4 v[8];
#pragma unroll
    for (int i = 0; i < 8; ++i) { v[i] = (f32x4){0.f, 0.f, 0.f, 0.f}; if (oc >= 0) v[i] = *(const GAS f32x4*)(W + (size_t)(k0 + i) * ldw + oc); }
    if (gain) { const f32x4 g0 = *(const GAS f32x4*)(gain + k0), g1 = *(const GAS f32x4*)(gain + k0 + 4);
#pragma unroll
        for (int i = 0; i < 4; ++i) { v[i] = v[i] * g0[i]; v[4 + i] = v[4 + i] * g1[i]; } }
#pragma unroll
    for (int e = 0; e < 4; ++e) { v4u o; o.x = pk2(v[0][e], v[1][e]); o.y = pk2(v[2][e], v[3][e]); o.z = pk2(v[4][e], v[5][e]); o.w = pk2(v[6][e], v[7][e]);
        *(GAS v4u*)(WT + (size_t)(n + e) * K + k0) = o; }
}
template <int PART> __device__ __forceinline__ void prologue_weights(Frame& F, int gw, int NGW) {
    constexpr int I_AB = (D / 64) * (NAB / 32), I_O = (D / 64) * (D / 32), I_UP = (D / 64) * (FF / 32), I_DN = (FF / 64) * (D / 32), I_C = (D / 64) * (NC / 32);
    if (PART == 0) { for (int it = gw; it < I_AB; it += NGW) p0_transpose_item(F.w_in_ab, ABP_OLD, D, F.g_mix, F.Wab, true, it, NAB / 32, F.lane); return; }
    constexpr int NITEMS = 2 * I_O + 2 * I_UP + 2 * I_DN + I_C;
    for (int it = gw; it < NITEMS; it += NGW) {
        int r = it;
        if (r < I_O) { p0_transpose_item(F.w_out_ab, D, D, nullptr, F.Woab, false, r, D / 32, F.lane); continue; } r -= I_O;
        if (r < I_UP) { p0_transpose_item(F.w_up, FF, D, F.g_ffn, F.Wup0, false, r, FF / 32, F.lane); continue; } r -= I_UP;
        if (r < I_DN) { p0_transpose_item(F.w_down, D, FF, nullptr, F.Wdn0, false, r, D / 32, F.lane); continue; } r -= I_DN;
        if (r < I_C) { p0_transpose_item(F.w_in_c, NC, D, F.g_mix + D, F.Winc, false, r, NC / 32, F.lane); continue; } r -= I_C;
        if (r < I_O) { p0_transpose_item(F.w_out_c, D, D, nullptr, F.Woc, false, r, D / 32, F.lane); continue; } r -= I_O;
        if (r < I_UP) { p0_transpose_item(F.w_up + (size_t)D * FF, FF, D, F.g_ffn + D, F.Wup1, false, r, FF / 32, F.lane); continue; } r -= I_UP;
        p0_transpose_item(F.w_down + (size_t)FF * D, D, FF, nullptr, F.Wdn1, false, r, D / 32, F.lane);
    }
}
__device__ __forceinline__ void ph_prologue(Frame& F) {
    const int gw = F.vcu * NWAVES + F.wave, NGW = F.G * NWAVES;
    prologue_weights<0>(F, gw, NGW);
    if (F.G != 256) prologue_weights<1>(F, gw, NGW);
    for (int m0 = gw; m0 < M; m0 += 4 * NGW) {
        f32x4 v[4][4]; float s[4];
#pragma unroll
        for (int r = 0; r < 4; ++r) { const int m = m0 + r * NGW; const GAS f32x4* xr = (const GAS f32x4*)(F.x + (size_t)(m < M ? m : m0) * D) + F.lane;
#pragma unroll
            for (int j = 0; j < 4; ++j) v[r][j] = xr[64 * j]; }
#pragma unroll
        for (int r = 0; r < 4; ++r) { float t = 0.f;
#pragma unroll
            for (int j = 0; j < 4; ++j) t += (v[r][j].x * v[r][j].x + v[r][j].y * v[r][j].y) + (v[r][j].z * v[r][j].z + v[r][j].w * v[r][j].w);
            s[r] = t; }
#pragma unroll
        for (int o = 1; o < 64; o <<= 1) {
#pragma unroll
            for (int r = 0; r < 4; ++r) s[r] += __shfl_xor(s[r], o); }
#pragma unroll
        for (int r = 0; r < 4; ++r) { const int m = m0 + r * NGW; if (m < M) {
            GAS unsigned long long* o8 = (GAS unsigned long long*)(F.XB + (size_t)m * D) + F.lane;
#pragma unroll
            for (int j = 0; j < 4; ++j) o8[64 * j] = (unsigned long long)pk2(v[r][j].x, v[r][j].y) | ((unsigned long long)pk2(v[r][j].z, v[r][j].w) << 32);
            if (F.lane < 16) F.SSQ[(size_t)m * 16 + F.lane] = (F.lane == 0) ? s[r] : 0.f; } }
    }
}
namespace att {
typedef short s16x4 __attribute__((ext_vector_type(4)));
typedef float f32x16 __attribute__((ext_vector_type(16)));
typedef _Float16 f16x8 __attribute__((ext_vector_type(8)));
typedef unsigned u32x4 __attribute__((ext_vector_type(4)));
typedef short v4i16_t __attribute__((ext_vector_type(4)));
constexpr float C2 = 0.08838834764831845f * 1.4426950408889634f;
__device__ __forceinline__ int crow(int r, int hi) { return (r & 3) + 8 * (r >> 2) + 4 * hi; }
__device__ __forceinline__ int img_off(int row, int ch) { return 256 * row + 16 * (ch ^ (((row & 3) << 2) | ((row >> 2) & 3))); }
__device__ __forceinline__ bf16x8 pack8(float a0, float a1, float a2, float a3, float a4, float a5, float a6, float a7) {
    u32x4 w; w.x = pg8::cvt_pk_bf16(a0, a1); w.y = pg8::cvt_pk_bf16(a2, a3); w.z = pg8::cvt_pk_bf16(a4, a5); w.w = pg8::cvt_pk_bf16(a6, a7);
    return __builtin_bit_cast(bf16x8, w);
}
__device__ __forceinline__ f16x8 pack8h(float a0, float a1, float a2, float a3, float a4, float a5, float a6, float a7) {
    f16x8 r; r[0] = (_Float16)a0; r[1] = (_Float16)a1; r[2] = (_Float16)a2; r[3] = (_Float16)a3; r[4] = (_Float16)a4; r[5] = (_Float16)a5; r[6] = (_Float16)a6; r[7] = (_Float16)a7; return r;
}
__device__ __forceinline__ void dma_off_init(unsigned (&dvo)[2], int ld, int wave, int lane) {
#pragma unroll
    for (int i = 0; i < 2; ++i) { const int pi = 2 * wave + i, row = 4 * pi + (lane >> 4), pc = lane & 15, ch = pc ^ (((row & 3) << 2) | ((row >> 2) & 3)); dvo[i] = (unsigned)(row * ld + ch * 8) * 2u; }
}
__device__ __forceinline__ void tile_dma(const bf16* g, const unsigned (&dvo)[2], LAS unsigned char* buf, int wave) {
#pragma unroll
    for (int i = 0; i < 2; ++i) __builtin_amdgcn_global_load_lds((const unsigned*)((const char*)g + dvo[i]), (LAS unsigned*)(buf + 1024 * (2 * wave + i)), 16, 0, 0);
}
struct FragOff { int k[8]; int va[4]; int vd; };
__device__ __forceinline__ void frag_off_init(FragOff& fo, int lane) {
    const int hi = lane >> 5, r32 = lane & 31, i = lane & 15, q = i >> 2, p = i & 3, x = 2 * ((lane >> 4) & 1) + (p >> 1);
#pragma unroll
    for (int ks = 0; ks < 8; ++ks) fo.k[ks] = img_off(r32, 2 * ks + hi);
#pragma unroll
    for (int ct = 0; ct < 4; ++ct) fo.va[ct] = img_off(4 * hi + q, 4 * ct + x) + 8 * (p & 1);
    fo.vd = img_off(4 * hi + q + 8, x) - img_off(4 * hi + q, x);
}
__device__ __forceinline__ bf16x8 k_frag(const LAS unsigned char* kbuf, const FragOff& fo, int rt, int ks) { return *(const LAS bf16x8*)(kbuf + fo.k[ks] + 8192 * rt); }
__device__ __forceinline__ s16x4 vtr(const LAS unsigned char* p) { return __builtin_bit_cast(s16x4, __builtin_amdgcn_ds_read_tr16_b64_v4i16((LAS v4i16_t*)p)); }
__device__ __forceinline__ bf16x8 v_frag(const LAS unsigned char* vbuf, const FragOff& fo, int ct, int kk) {
    const s16x4 lo = vtr(vbuf + fo.va[ct] + 4096 * kk), hh = vtr(vbuf + fo.va[ct] + fo.vd + 4096 * kk);
    return (bf16x8){lo[0], lo[1], lo[2], lo[3], hh[0], hh[1], hh[2], hh[3]};
}
#define TR_READ(dst, addr, OFF) asm volatile("ds_read_b64_tr_b16 %0, %1 offset:%c2" : "=&v"(dst) : "v"(addr), "i"(OFF) : "memory")
#define LGKM_WAIT0() do { asm volatile("s_waitcnt lgkmcnt(0)" ::: "memory"); __builtin_amdgcn_sched_barrier(0); } while (0)
__device__ __forceinline__ bf16x8 mk_frag(s16x4 lo, s16x4 hh) { return (bf16x8){lo[0], lo[1], lo[2], lo[3], hh[0], hh[1], hh[2], hh[3]}; }
__device__ __forceinline__ int frag_va(int lane, int ct) { const int hi = lane >> 5, i = lane & 15, q = i >> 2, p = i & 3, x = 2 * ((lane >> 4) & 1) + (p >> 1); return img_off(4 * hi + q, 4 * ct + x) + 8 * (p & 1); }
__device__ __forceinline__ bf16x8 v_frag_rt(const LAS unsigned char* vbuf, int va, int vd, int kk) {
    const s16x4 lo = vtr(vbuf + va + 4096 * kk), hh = vtr(vbuf + va + vd + 4096 * kk);
    return (bf16x8){lo[0], lo[1], lo[2], lo[3], hh[0], hh[1], hh[2], hh[3]};
}
__device__ __forceinline__ void store_o(const f32x16 (&o)[4], const float (&rscale)[16], LAS unsigned char* stg, bf16* dst, int ld, int lane) {
    const int hi = lane >> 5, r32 = lane & 31;
#pragma unroll
    for (int r = 0; r < 16; ++r) { const int orow = crow(r, hi);
#pragma unroll
        for (int ct = 0; ct < 4; ++ct) *(LAS bf16*)(stg + orow * 256 + (32 * ct + r32) * 2) = (bf16)f2bf(o[ct][r] * rscale[r]); }
    asm volatile("s_waitcnt lgkmcnt(0)" ::: "memory");
#pragma unroll
    for (int i = 0; i < 8; ++i) { const int c = lane + 64 * i, row = c >> 4, ch = c & 15; const u32x4 v = *(const LAS u32x4*)(stg + row * 256 + ch * 16); *(u32x4*)(dst + (size_t)row * ld + ch * 8) = v; }
}
}
__device__ __forceinline__ void sb_unit(Frame& F, int b, int h, int qb) {
    using namespace att;
    const int tid = F.tid, lane = F.lane, w = F.wave, hi = lane >> 5, r32 = lane & 31;
    const bf16* Qg = F.R1 + (size_t)b * SEQ * NC + h * 128; const bf16* Kg = Qg + 1024; const bf16* Vg = Qg + 2048;
    const int T0 = qb * 256, t0w = T0 + 32 * w, jd = t0w >> 6, jtop = (T0 >> 6) + 3, tl = 32 * (w & 1) + r32, tl4 = tl - 4 * hi;
    LAS unsigned char* lds = F.lds;
    FragOff fo; frag_off_init(fo, lane);
    unsigned dvo[2]; dma_off_init(dvo, NC, w, lane);
    bf16x8 qf[8];
#pragma unroll
    for (int ks = 0; ks < 8; ++ks) qf[ks] = *(const bf16x8*)(Qg + (size_t)(t0w + r32) * NC + 16 * ks + 8 * hi);
    f16x8 T0f, T1f, ONEf;
#pragma unroll
    for (int j = 0; j < 8; ++j) { const int kp = 8 * (j >> 2) + 4 * hi + (j & 3); T0f[j] = (kp >= r32) ? (_Float16)1.0f : (_Float16)0.0f; T1f[j] = (kp + 16 >= r32) ? (_Float16)1.0f : (_Float16)0.0f; ONEf[j] = (_Float16)1.0f; }
    f32x16 o[4];
#pragma unroll
    for (int ct = 0; ct < 4; ++ct)
#pragma unroll
        for (int r = 0; r < 16; ++r) o[ct][r] = 0.f;
    float R2 = 0.f; bool done = false;
    volatile LAS unsigned* flags = F.MISC + 16;
    tile_dma(Kg + (size_t)(64 * jtop) * NC, dvo, lds, w); tile_dma(Vg + (size_t)(64 * jtop) * NC, dvo, lds + 16384, w);
    asm volatile("s_waitcnt vmcnt(0)" ::: "memory");
    __syncthreads();
    for (int j = jtop; j >= 0; --j) {
        const int cur = (jtop - j) & 1;
        const LAS unsigned char* kb = lds + cur * 32768; const LAS unsigned char* vb = kb + 16384;
        if (j > 0) { tile_dma(Kg + (size_t)(64 * (j - 1)) * NC, dvo, lds + (cur ^ 1) * 32768, w); tile_dma(Vg + (size_t)(64 * (j - 1)) * NC, dvo, lds + (cur ^ 1) * 32768 + 16384, w); }
        if (j <= jd && !done) {
            f32x16 p0, p1;
#pragma unroll
            for (int r = 0; r < 16; ++r) { p0[r] = 0.f; p1[r] = 0.f; }
            { bf16x8 kf[8];
#pragma unroll
              for (int ks = 0; ks < 8; ++ks) kf[ks] = k_frag(kb, fo, 0, ks);
#pragma unroll
              for (int ks = 0; ks < 8; ++ks) p0 = __builtin_amdgcn_mfma_f32_32x32x16_bf16(kf[ks], qf[ks], p0, 0, 0, 0);
#pragma unroll
              for (int ks = 0; ks < 8; ++ks) kf[ks] = k_frag(kb, fo, 1, ks);
#pragma unroll
              for (int ks = 0; ks < 8; ++ks) p1 = __builtin_amdgcn_mfma_f32_32x32x16_bf16(kf[ks], qf[ks], p1, 0, 0, 0); }
            s16x4 vl[4], vh[4], wl[4], wh[4];
            unsigned va0[4], va1[4];
#pragma unroll
            for (int ct = 0; ct < 4; ++ct) { va0[ct] = (unsigned)(size_t)vb + (unsigned)fo.va[ct]; va1[ct] = va0[ct] + (unsigned)fo.vd; }
            const bool diag = (j == jd);
            float x0[16], x1[16]; float rs = 0.f;
#pragma unroll
            for (int r = 0; r < 16; ++r) { const int key = (r & 3) + 8 * (r >> 2);
                float l0 = -__builtin_amdgcn_logf(1.0f + __builtin_amdgcn_exp2f(p0[r])), l1 = -__builtin_amdgcn_logf(1.0f + __builtin_amdgcn_exp2f(p1[r]));
                if (diag) { if (!(key < tl4)) l0 = 0.f; if (!(key + 32 < tl4)) l1 = 0.f; }
                x0[r] = l0; x1[r] = l1; rs += l0 + l1; p0[r] += R2; p1[r] += R2; }
            const f16x8 xb00 = pack8h(x0[0], x0[1], x0[2], x0[3], x0[4], x0[5], x0[6], x0[7]), xb01 = pack8h(x0[8], x0[9], x0[10], x0[11], x0[12], x0[13], x0[14], x0[15]);
            const f16x8 xb10 = pack8h(x1[0], x1[1], x1[2], x1[3], x1[4], x1[5], x1[6], x1[7]), xb11 = pack8h(x1[8], x1[9], x1[10], x1[11], x1[12], x1[13], x1[14], x1[15]);
            p0 = __builtin_amdgcn_mfma_f32_32x32x16_f16(T0f, xb00, p0, 0, 0, 0); p0 = __builtin_amdgcn_mfma_f32_32x32x16_f16(T1f, xb01, p0, 0, 0, 0);
            p0 = __builtin_amdgcn_mfma_f32_32x32x16_f16(ONEf, xb10, p0, 0, 0, 0); p0 = __builtin_amdgcn_mfma_f32_32x32x16_f16(ONEf, xb11, p0, 0, 0, 0);
            p1 = __builtin_amdgcn_mfma_f32_32x32x16_f16(T0f, xb10, p1, 0, 0, 0); p1 = __builtin_amdgcn_mfma_f32_32x32x16_f16(T1f, xb11, p1, 0, 0, 0);
#pragma unroll
            for (int r = 0; r < 16; ++r) { const int key = (r & 3) + 8 * (r >> 2);
                float a0 = __builtin_amdgcn_exp2f(p0[r]), a1 = __builtin_amdgcn_exp2f(p1[r]);
                if (diag) { if (!(key < tl4)) a0 = 0.f; if (!(key + 32 < tl4)) a1 = 0.f; }
                p0[r] = a0; p1[r] = a1; }
            const bf16x8 pa0 = pack8(p0[0], p0[1], p0[2], p0[3], p0[4], p0[5], p0[6], p0[7]), pa1 = pack8(p0[8], p0[9], p0[10], p0[11], p0[12], p0[13], p0[14], p0[15]);
            const bf16x8 pa2 = pack8(p1[0], p1[1], p1[2], p1[3], p1[4], p1[5], p1[6], p1[7]), pa3 = pack8(p1[8], p1[9], p1[10], p1[11], p1[12], p1[13], p1[14], p1[15]);
#pragma unroll
            for (int ct = 0; ct < 4; ++ct) { TR_READ(vl[ct], va0[ct], 0); TR_READ(vh[ct], va1[ct], 0); }
            LGKM_WAIT0();
#pragma unroll
            for (int ct = 0; ct < 4; ++ct) { TR_READ(wl[ct], va0[ct], 4096); TR_READ(wh[ct], va1[ct], 4096); }
#pragma unroll
            for (int ct = 0; ct < 4; ++ct) o[ct] = __builtin_amdgcn_mfma_f32_32x32x16_bf16(pa0, mk_frag(vl[ct], vh[ct]), o[ct], 0, 0, 0);
            LGKM_WAIT0();
#pragma unroll
            for (int ct = 0; ct < 4; ++ct) { TR_READ(vl[ct], va0[ct], 8192); TR_READ(vh[ct], va1[ct], 8192); }
#pragma unroll
            for (int ct = 0; ct < 4; ++ct) o[ct] = __builtin_amdgcn_mfma_f32_32x32x16_bf16(pa1, mk_frag(wl[ct], wh[ct]), o[ct], 0, 0, 0);
            LGKM_WAIT0();
#pragma unroll
            for (int ct = 0; ct < 4; ++ct) { TR_READ(wl[ct], va0[ct], 12288); TR_READ(wh[ct], va1[ct], 12288); }
#pragma unroll
            for (int ct = 0; ct < 4; ++ct) o[ct] = __builtin_amdgcn_mfma_f32_32x32x16_bf16(pa2, mk_frag(vl[ct], vh[ct]), o[ct], 0, 0, 0);
            LGKM_WAIT0();
#pragma unroll
            for (int ct = 0; ct < 4; ++ct) o[ct] = __builtin_amdgcn_mfma_f32_32x32x16_bf16(pa3, mk_frag(wl[ct], wh[ct]), o[ct], 0, 0, 0);
            rs += __shfl_xor(rs, 32);
            R2 += rs;
            done = __all(R2 < -152.0f);
        }
        if (lane == 0) flags[cur * 8 + w] = done ? 1u : 0u;
        asm volatile("s_waitcnt vmcnt(0) lgkmcnt(0)" ::: "memory");
        __syncthreads();
        unsigned alld = 1u;
#pragma unroll
        for (int i = 0; i < 8; ++i) alld &= flags[cur * 8 + i];
        if (alld) break;
    }
    float ones[16];
#pragma unroll
    for (int r = 0; r < 16; ++r) ones[r] = 1.0f;
    store_o(o, ones, lds + w * 8192, F.CAT + (size_t)(b * SEQ + t0w) * D + h * 128, D, lane);
    __syncthreads();
}
__device__ __forceinline__ void ph_sb(Frame& F) {
    for (int v = F.vcu; v < BATCH * 8 * 2; v += F.G) {
        const int bh = v >> 1, half = v & 1;
#pragma unroll 1
        for (int i = 0; i < 4; ++i) { const int qb = half ? (i == 0 ? 1 : i == 1 ? 6 : i == 2 ? 2 : 5) : (i == 0 ? 0 : i == 1 ? 7 : i == 2 ? 3 : 4); sb_unit(F, bh >> 3, bh & 7, qb); }
    }
}
__device__ __forceinline__ void dsa_unit(Frame& F, int b, int h, int ub, float mref) {
    using namespace att;
    const int lane = F.lane, w = F.wave, hi = lane >> 5, r32 = lane & 31;
    const bf16* Qg = F.R1 + (size_t)b * SEQ * NAB + C_QA + h * 128; const bf16* Kg = F.R1 + (size_t)b * SEQ * NAB + C_KA + h * 128; const bf16* Vg = F.R1 + (size_t)b * SEQ * NAB + C_VA + h * 128;
    const int t0w = 256 * ub + 32 * w, cw = t0w >> 6, jlast = 4 * ub + 3;
    LAS unsigned char* lds = F.lds;
    LAS unsigned char* mst = lds + 65536 + w * 8448;
    FragOff fo; frag_off_init(fo, lane);
    unsigned dvo[2]; dma_off_init(dvo, NAB, w, lane);
    tile_dma(Kg, dvo, lds, w); tile_dma(Vg, dvo, lds + 16384, w);
    bf16x8 qf[8];
#pragma unroll
    for (int ks = 0; ks < 8; ++ks) qf[ks] = *(const bf16x8*)(Qg + (size_t)(t0w + r32) * NAB + 16 * ks + 8 * hi);
    { const unsigned* mg = F.MASK + (size_t)(b * SEQ + t0w) * 64;
#pragma unroll 2
      for (int i = 0; i < 8; ++i) { const int c = lane + 64 * i, row = c >> 4, c4 = c & 15; const u32x4 v = *(const u32x4*)(mg + row * 64 + c4 * 4);
          *(LAS unsigned long long*)(mst + row * 264 + c4 * 16) = (unsigned long long)v.x | ((unsigned long long)v.y << 32);
          *(LAS unsigned long long*)(mst + row * 264 + c4 * 16 + 8) = (unsigned long long)v.z | ((unsigned long long)v.w << 32); } }
    f32x16 o[4];
#pragma unroll
    for (int ct = 0; ct < 4; ++ct)
#pragma unroll
        for (int r = 0; r < 16; ++r) o[ct][r] = 0.f;
    float lsum = 0.f;
    asm volatile("s_waitcnt vmcnt(0) lgkmcnt(0)" ::: "memory");
    __syncthreads();
    for (int j = 0; j <= jlast; ++j) {
        const int cur = j & 1;
        const LAS unsigned char* kb = lds + cur * 32768; const LAS unsigned char* vb = kb + 16384;
        if (j < jlast) { tile_dma(Kg + (size_t)(64 * (j + 1)) * NAB, dvo, lds + (cur ^ 1) * 32768, w); tile_dma(Vg + (size_t)(64 * (j + 1)) * NAB, dvo, lds + (cur ^ 1) * 32768 + 16384, w); }
        if (j <= cw) {
            const unsigned long long mw = *(const LAS unsigned long long*)(mst + r32 * 264 + j * 8);
            const unsigned mw0 = (unsigned)mw, mw1 = (unsigned)(mw >> 32);
#pragma unroll 1
            for (int half = 0; half < 2; ++half) {
                const unsigned mwh = (half ? mw1 : mw0) >> (4 * hi);
                bf16x8 kf[8];
#pragma unroll
                for (int ks = 0; ks < 8; ++ks) kf[ks] = k_frag(kb, fo, half, ks);
                f32x16 p;
#pragma unroll
                for (int r = 0; r < 16; ++r) p[r] = 0.f;
#pragma unroll
                for (int ks = 0; ks < 8; ++ks) p = __builtin_amdgcn_mfma_f32_32x32x16_bf16(kf[ks], qf[ks], p, 0, 0, 0);
#pragma unroll
                for (int r = 0; r < 16; ++r) { const unsigned keep = (unsigned)(-(int)((mwh >> ((r & 3) + 8 * (r >> 2))) & 1u));
                    const float e = __uint_as_float(__float_as_uint(__builtin_amdgcn_exp2f(p[r] - mref)) & keep); p[r] = e; lsum += e; }
                const bf16x8 pa0 = pack8(p[0], p[1], p[2], p[3], p[4], p[5], p[6], p[7]), pa1 = pack8(p[8], p[9], p[10], p[11], p[12], p[13], p[14], p[15]);
                s16x4 vl[8], vh[8];
                const unsigned vbase = (unsigned)(size_t)vb + 8192u * (unsigned)half;
#pragma unroll
                for (int ct = 0; ct < 4; ++ct) { const unsigned a0 = vbase + (unsigned)fo.va[ct], a1 = a0 + (unsigned)fo.vd;
                    TR_READ(vl[2 * ct], a0, 0); TR_READ(vh[2 * ct], a1, 0); TR_READ(vl[2 * ct + 1], a0, 4096); TR_READ(vh[2 * ct + 1], a1, 4096); }
                LGKM_WAIT0();
#pragma unroll
                for (int ct = 0; ct < 4; ++ct) {
                    o[ct] = __builtin_amdgcn_mfma_f32_32x32x16_bf16(pa0, mk_frag(vl[2 * ct], vh[2 * ct]), o[ct], 0, 0, 0);
                    o[ct] = __builtin_amdgcn_mfma_f32_32x32x16_bf16(pa1, mk_frag(vl[2 * ct + 1], vh[2 * ct + 1]), o[ct], 0, 0, 0);
                }
            }
        }
        asm volatile("s_waitcnt vmcnt(0) lgkmcnt(0)" ::: "memory");
        __syncthreads();
    }
    lsum += __shfl_xor(lsum, 32);
    LAS float* lsc = (LAS float*)mst;
    if (hi == 0) lsc[r32] = 1.0f / lsum;
    asm volatile("s_waitcnt lgkmcnt(0)" ::: "memory");
    float rsc[16];
#pragma unroll
    for (int r = 0; r < 16; ++r) rsc[r] = lsc[crow(r, hi)];
    store_o(o, rsc, lds + w * 8192, F.CAT + (size_t)(b * SEQ + t0w) * D + h * 128, D, lane);
    __syncthreads();
}
__device__ __forceinline__ void ph_dsa(Frame& F) {
    float gm = fmaxf(fabsf(F.gq_a[F.lane]), fabsf(F.gq_a[64 + F.lane])), km = fmaxf(fabsf(F.gk_a[F.lane]), fabsf(F.gk_a[64 + F.lane]));
    gm = wave_max(gm); km = wave_max(km);
    const float mref = att::C2 * 128.0f * gm * km * 1.02f;
    for (int v = F.vcu; v < BATCH * 4 * 4; v += F.G) {
        const int bh = v >> 2, pi = v & 3;
#pragma unroll 1
        for (int k = 0; k < 2; ++k) dsa_unit(F, bh >> 2, bh & 3, k ? 7 - pi : pi, mref);
    }
}
namespace idx {
using att::f32x16;
constexpr int SCP = 2048;
__device__ __forceinline__ unsigned okey(float f) { const unsigned u = __float_as_uint(f); return (u & 0x80000000u) ? ~u : (u | 0x80000000u); }
__device__ __forceinline__ int wave_isum(int c) {
    c += __builtin_amdgcn_mov_dpp(c, 0xB1, 0xF, 0xF, true);
    c += __builtin_amdgcn_mov_dpp(c, 0x4E, 0xF, 0xF, true);
    c += __builtin_amdgcn_mov_dpp(c, 0x141, 0xF, 0xF, true);
    c += __builtin_amdgcn_mov_dpp(c, 0x140, 0xF, 0xF, true);
    return (__builtin_amdgcn_readlane(c, 0) + __builtin_amdgcn_readlane(c, 16)) + (__builtin_amdgcn_readlane(c, 32) + __builtin_amdgcn_readlane(c, 48));
}
__device__ __forceinline__ unsigned bfi32(unsigned m, unsigned x, unsigned y) { return (x & m) | (y & ~m); }
__device__ __forceinline__ void bit_transpose32x2(unsigned (&A)[32], unsigned (&B)[32]) {
#pragma unroll
    for (int k = 0; k < 16; ++k) { const unsigned a0 = A[k], a1 = A[k + 16], b0 = B[k], b1 = B[k + 16];
        A[k] = __builtin_amdgcn_perm(a0, a1, 0x07060302u); A[k + 16] = __builtin_amdgcn_perm(a0, a1, 0x05040100u);
        B[k] = __builtin_amdgcn_perm(b0, b1, 0x07060302u); B[k + 16] = __builtin_amdgcn_perm(b0, b1, 0x05040100u); }
#pragma unroll
    for (int k = 0; k < 32; ++k) if (!(k & 8)) { const unsigned a0 = A[k], a1 = A[k + 8], b0 = B[k], b1 = B[k + 8];
        A[k] = __builtin_amdgcn_perm(a0, a1, 0x07030501u); A[k + 8] = __builtin_amdgcn_perm(a0, a1, 0x06020400u);
        B[k] = __builtin_amdgcn_perm(b0, b1, 0x07030501u); B[k + 8] = __builtin_amdgcn_perm(b0, b1, 0x06020400u); }
    unsigned mask = 0x0F0F0F0Fu;
#pragma unroll
    for (int s = 4; s; s >>= 1) {
#pragma unroll
        for (int k = 0; k < 32; ++k) if (!(k & s)) { const unsigned a0 = A[k], a1 = A[k + s], b0 = B[k], b1 = B[k + s];
            A[k] = bfi32(mask, a1 >> s, a0); A[k + s] = bfi32(mask, a1, a0 << s);
            B[k] = bfi32(mask, b1 >> s, b0); B[k + s] = bfi32(mask, b1, b0 << s); }
        mask ^= mask << (s >> 1);
    }
}
__device__ __forceinline__ void select_prepare(const LAS float* scA, const LAS float* scB, int E, unsigned (&Wa)[32], unsigned (&Wb)[32], int lane) {
#pragma unroll
    for (int j = 0; j < 32; ++j) { Wa[31 - j] = __float_as_uint(scA[64 * j + lane]); Wb[31 - j] = __float_as_uint(scB[64 * j + lane]); }
#pragma unroll
    for (int j = 0; j < 32; ++j) { Wa[j] ^= (unsigned)((int)Wa[j] >> 31) | 0x80000000u; Wb[j] ^= (unsigned)((int)Wb[j] >> 31) | 0x80000000u; }
    bit_transpose32x2(Wa, Wb);
}
__device__ __forceinline__ void select_finish(const unsigned (&Wa)[32], const unsigned (&Wb)[32], int E, unsigned* mrowA, unsigned* mrowB, int lane) {
    const unsigned valid = (E >= 32) ? 0xFFFFFFFFu : ((1u << E) - 1u);
    unsigned alA = valid, alB = valid, gtA = 0u, gtB = 0u;
    int GA = 0, GB = 0, AA = 64 * E, AB = 64 * E;
#pragma unroll
    for (int b0 = 0; b0 < 32; b0 += 4) {
        if (GA + AA == 256 && GB + AB == 256) break;
#pragma unroll
        for (int bb = 0; bb < 4; ++bb) { const int b = b0 + bb;
            const unsigned m1a = alA & Wa[b], m1b = alB & Wb[b];
            const int cab = wave_isum(__popc(m1a) | (__popc(m1b) << 16)), ca = cab & 0xFFFF, cb = cab >> 16;
            const bool ta = GA + ca >= 256, tb = GB + cb >= 256;
            alA = ta ? m1a : (alA ^ m1a); gtA = ta ? gtA : (gtA | m1a); AA = ta ? ca : AA - ca; GA = ta ? GA : GA + ca;
            alB = tb ? m1b : (alB ^ m1b); gtB = tb ? gtB : (gtB | m1b); AB = tb ? cb : AB - cb; GB = tb ? GB : GB + cb; }
    }
    const bool dA = (GA + AA == 256), dB = (GB + AB == 256);
#pragma unroll 1
    for (int rr = 0; rr < 2; ++rr) {
        const unsigned al = rr ? alB : alA, gt = rr ? gtB : gtA; const bool done = rr ? dB : dA; unsigned* mrow = rr ? mrowB : mrowA;
        unsigned sel = gt | al;
        if (!done) {
            int need = 256 - (rr ? GB : GA); sel = gt;
            const unsigned long long below = (1ull << lane) - 1ull;
            for (int j = 0; j < E; ++j) { const bool e = (al >> j) & 1u; const unsigned long long eq = __ballot(e);
                if (e && __popcll(eq & below) < need) sel |= 1u << j;
                need -= __popcll(eq); if (need <= 0) break; }
        }
        unsigned long long mine = 0ull;
#pragma unroll
        for (int j = 0; j < 32; ++j) { if (j < E) { const unsigned long long m = __ballot((sel >> j) & 1u); if (lane == j) mine = m; } }
        if (lane < 32) *(unsigned long long*)(mrow + 2 * lane) = mine;
    }
}
__device__ __forceinline__ void decode(int u, int& b, int& c, int& sub) { c = 4 + u % 28; const int rest = u / 28; b = rest >> 2; sub = rest & 3; }
__device__ __forceinline__ void load_af(Frame& F, int u, bf16x8 (&af)[4][4]) {
    int b, c, sub; decode(u, b, c, sub);
    const int r32 = F.lane & 31, hi = F.lane >> 5, t0 = 64 * c + 16 * sub, g = r32 >> 3, hh = (r32 >> 2) & 1, j = r32 & 3, qo = 2 * hh + (g >> 1), hd = 4 * (g & 1) + j;
    const bf16* P = F.R1 + (size_t)b * SEQ * NAB;
#pragma unroll
    for (int rt = 0; rt < 4; ++rt)
#pragma unroll
        for (int ks = 0; ks < 4; ++ks) af[rt][ks] = *(const bf16x8*)(P + (size_t)(t0 + 4 * rt + qo) * NAB + C_IQ + hd * 64 + 16 * ks + 8 * hi);
}
__device__ __forceinline__ float load_w(Frame& F, int u) {
    int b, c, sub; decode(u, b, c, sub);
    const int t0 = 64 * c + 16 * sub;
    return (F.tid < 128) ? bf2f(F.R1[(size_t)(b * SEQ + t0 + (F.tid >> 3)) * NAB + C_IW + (F.tid & 7)]) * (0.125f * 0.35355339059327373f) : 0.f;
}
__device__ __forceinline__ void load_bf(Frame& F, int b, int strip, bf16x8 (&bfr)[4]) {
    const bf16* P = F.R1 + (size_t)b * SEQ * NAB;
#pragma unroll
    for (int ks = 0; ks < 4; ++ks) bfr[ks] = *(const bf16x8*)(P + (size_t)(32 * strip + (F.lane & 31)) * NAB + C_IK + 16 * ks + 8 * (F.lane >> 5));
}
__device__ __forceinline__ float relu1(float x) { const int i = __float_as_int(x); return __int_as_float(i > 0 ? i : 0); }
__device__ __forceinline__ void run(Frame& F) {
    const int lane = F.lane, w = F.wave, hi = lane >> 5, r32 = lane & 31, tid = F.tid, NU = BATCH * 28 * 4;
    int u = F.vcu; if (u >= NU) return;
    LAS float* sc = (LAS float*)F.lds;
    LAS float* wtb = sc + 16 * SCP;
    bf16x8 af[4][4], bfr[4], bnx[4];
    load_af(F, u, af);
    { const float wv = load_w(F, u); if (tid < 128) wtb[tid] = wv; }
    { int b, c, sub; decode(u, b, c, sub); if (w < 2 * (c + 1)) load_bf(F, b, w, bfr); }
    for (int it = 0; u < NU; ++it, u += F.G) {
        int b, c, sub; decode(u, b, c, sub);
        const int n = 64 * (c + 1), t0 = 64 * c + 16 * sub, nstrip = n >> 5;
        const int un = u + F.G; const bool more = un < NU;
        const LAS float* wt = wtb + (it & 1) * 128;
        __syncthreads();
        const float wnext = more ? load_w(F, un) : 0.f;
        for (int s = w; s < nstrip; s += NWAVES) {
            const bool mstrip = s + NWAVES < nstrip;
            if (mstrip) load_bf(F, b, s + NWAVES, bnx);
#pragma unroll
            for (int rt = 0; rt < 4; ++rt) {
                f32x16 acc;
#pragma unroll
                for (int r = 0; r < 16; ++r) acc[r] = 0.f;
#pragma unroll
                for (int ks = 0; ks < 4; ++ks) acc = __builtin_amdgcn_mfma_f32_32x32x16_bf16(af[rt][ks], bfr[ks], acc, 0, 0, 0);
                const int q0 = 4 * rt + 2 * hi;
                float f0, f1;
                { const f32x4 wa = *(const LAS f32x4*)(wt + q0 * 8), wb = *(const LAS f32x4*)(wt + q0 * 8 + 4), wc = *(const LAS f32x4*)(wt + q0 * 8 + 8), wd = *(const LAS f32x4*)(wt + q0 * 8 + 12);
                  f0 = relu1(acc[0]) * wa[0]; f1 = relu1(acc[8]) * wc[0];
#pragma unroll
                  for (int e = 1; e < 4; ++e) { f0 = fmaf(relu1(acc[e]), wa[e], f0); f1 = fmaf(relu1(acc[8 + e]), wc[e], f1); }
#pragma unroll
                  for (int e = 0; e < 4; ++e) { f0 = fmaf(relu1(acc[4 + e]), wb[e], f0); f1 = fmaf(relu1(acc[12 + e]), wd[e], f1); } }
                sc[q0 * SCP + 32 * s + r32] = f0; sc[(q0 + 1) * SCP + 32 * s + r32] = f1;
            }
            if (mstrip) {
#pragma unroll
                for (int ks = 0; ks < 4; ++ks) bfr[ks] = bnx[ks];
            }
        }
        if (more && tid < 128) wtb[((it + 1) & 1) * 128 + tid] = wnext;
        __syncthreads();
        { const int q = 2 * w;
          unsigned* mrowA = F.MASK + (size_t)(b * SEQ + t0 + q) * 64; unsigned* mrowB = mrowA + 64;
          const LAS float* rowA = sc + q * SCP; const LAS float* rowB = rowA + SCP;
          unsigned Wa[32], Wb[32];
          select_prepare(rowA, rowB, n >> 6, Wa, Wb, lane);
          asm volatile("" ::: "memory");
          if (more) load_af(F, un, af);
          select_finish(Wa, Wb, n >> 6, mrowA, mrowB, lane); }
        if (more) { int bn, cn, sn; decode(un, bn, cn, sn); if (w < 2 * (cn + 1)) load_bf(F, bn, w, bfr); }
    }
    __syncthreads();
}
}
__device__ __forceinline__ void ph_indexer(Frame& F) {
    { const int gw = F.vcu * NWAVES + F.wave, NGW = F.G * NWAVES;
      for (int i = gw; i < BATCH * 256; i += NGW) { const int b = i >> 8, pos = i & 255, n = ((pos >> 6) + 1) << 6;
          if (F.lane < 32) { unsigned long long v = 0ull; if (64 * F.lane < n) v = ~0ull; *(unsigned long long*)(F.MASK + (size_t)(b * SEQ + pos) * 64 + 2 * F.lane) = v; } } }
    idx::run(F);
}
namespace gla {
using att::f32x16; using att::u32x4;
constexpr int L_WL = 0, L_V = 4096  , L_OG = 36864  , L_K = 69632, L_Q = 78848, L_PART = 88064, L_STG = 89088, L_BG = 106496  ,
              L_GG = 106752  , L_KT = 107264  , L_S = 116480  , L_DEC = 134912  , KP = 144, SP = 272;
#define GLA_BAR() do { asm volatile("s_waitcnt lgkmcnt(0)" ::: "memory"); __builtin_amdgcn_s_barrier(); asm volatile("" ::: "memory"); } while (0)
struct In { u32x4 g0, g1, kk, qq; u32x4 vt[2], ot[2]; };
template <bool PASSC> __device__ __forceinline__ void load_in(Frame& F, int b, int h, int c, In& in, const unsigned (&dvo)[2]) {
    const bf16* P = F.R1 + (size_t)(b * SEQ + 64 * c) * NAB;
    const bf16* pr = P + (size_t)F.lane * NAB;
    in.kk = *(const u32x4*)(pr + C_KB + h * 64 + 8 * F.wave);
    in.g0 = *(const u32x4*)(pr + C_GL); in.g1 = *(const u32x4*)(pr + C_GL + 8);
#pragma unroll
    for (int i = 0; i < 2; ++i) in.vt[i] = *(const u32x4*)((const char*)(P + C_VB + h * 128) + dvo[i]);
    if (PASSC) { in.qq = *(const u32x4*)(pr + C_QB + h * 64 + 8 * F.wave);
#pragma unroll
        for (int i = 0; i < 2; ++i) in.ot[i] = *(const u32x4*)((const char*)(P + C_OG + h * 128) + dvo[i]); }
}
__device__ __forceinline__ void put_tile(LAS unsigned char* buf, const u32x4 (&t)[2], int wave, int lane) {
#pragma unroll
    for (int i = 0; i < 2; ++i) *(LAS u32x4*)(buf + 1024 * (2 * wave + i) + 16 * lane) = t[i];
}
__device__ __forceinline__ void stage_wl(Frame& F, int h) {
    LAS float* wl = (LAS float*)(F.lds + L_WL);
#pragma unroll
    for (int i = 0; i < 2; ++i) { const int e = F.tid + 512 * i, r = e >> 6, d = e & 63; wl[e] = F.w_gate_up[r * 256 + h * 64 + d]; }
    if (F.tid < 64) ((LAS float*)(F.lds + L_BG))[F.tid] = F.b_gate[h * 64 + F.tid];
}
__device__ __forceinline__ void unpack8(const u32x4 v, float (&f)[8]) {
#pragma unroll
    for (int i = 0; i < 4; ++i) { f[2 * i] = __uint_as_float(v[i] << 16); f[2 * i + 1] = __uint_as_float(v[i] & 0xffff0000u); }
}
#define GLA_DPP_F(v, ctrl, row_mask) __builtin_bit_cast(float, __builtin_amdgcn_update_dpp(0, __builtin_bit_cast(int, (v)), (ctrl), (row_mask), 0xF, false))
__device__ __forceinline__ float wave_scan_incl(float v) {
    v += GLA_DPP_F(v, 0x111, 0xF); v += GLA_DPP_F(v, 0x112, 0xF); v += GLA_DPP_F(v, 0x114, 0xF); v += GLA_DPP_F(v, 0x118, 0xF);
    v += GLA_DPP_F(v, 0x142, 0xA); v += GLA_DPP_F(v, 0x143, 0xC);
    return v;
}
__device__ __forceinline__ void gate_scan(Frame& F, int h, const float (&gl)[16], float (&bc)[8], float (&blast)[8]) {
    const int d0 = 8 * F.wave;
    const LAS float* wl = (const LAS float*)(F.lds + L_WL);
    float acc[8];
    { const f32x4 g0 = *(const LAS f32x4*)(F.lds + L_BG + d0 * 4), g1 = *(const LAS f32x4*)(F.lds + L_BG + d0 * 4 + 16);
#pragma unroll
      for (int i = 0; i < 4; ++i) { acc[i] = g0[i]; acc[4 + i] = g1[i]; } }
#pragma unroll
    for (int r = 0; r < 16; ++r) { const f32x4 w0 = *(const LAS f32x4*)(wl + r * 64 + d0), w1 = *(const LAS f32x4*)(wl + r * 64 + d0 + 4);
#pragma unroll
        for (int i = 0; i < 4; ++i) { acc[i] = fmaf(gl[r], w0[i], acc[i]); acc[4 + i] = fmaf(gl[r], w1[i], acc[4 + i]); } }
#pragma unroll
    for (int i = 0; i < 8; ++i) { float v = (fminf(acc[i], 0.f) - __logf(1.0f + __expf(-fabsf(acc[i])))) * (1.0f / 16.0f);
        v = wave_scan_incl(v);
        bc[i] = v; blast[i] = __builtin_bit_cast(float, __builtin_amdgcn_readlane(__builtin_bit_cast(int, v), 63)); }
}
__device__ __forceinline__ void put_kt_dec(LAS unsigned char* lds, int ktoff, int decoff, const float (&kf)[8], const float (&bc)[8], const float (&blast)[8], int w, int lane) {
#pragma unroll
    for (int i = 0; i < 8; ++i) *(LAS bf16*)(lds + ktoff + (8 * w + i) * KP + lane * 2) = (bf16)f2bf(kf[i] * __expf(blast[i] - bc[i]));
    if (lane == 0) { *(LAS f32x4*)(lds + decoff + 32 * w) = (f32x4){__expf(blast[0]), __expf(blast[1]), __expf(blast[2]), __expf(blast[3])};
                     *(LAS f32x4*)(lds + decoff + 32 * w + 16) = (f32x4){__expf(blast[4]), __expf(blast[5]), __expf(blast[6]), __expf(blast[7])}; }
}
__device__ __forceinline__ void state_step(f32x16& S, const LAS unsigned char* lds, const LAS unsigned char* vbuf, int ktoff, int decoff, int va_et, int vd, int dt, int hi, int r32) {
    f32x16 U;
#pragma unroll
    for (int r = 0; r < 16; ++r) U[r] = 0.f;
#pragma unroll
    for (int kk = 0; kk < 4; ++kk) {
        const LAS unsigned char* kp = lds + ktoff + (32 * dt + r32) * KP + (16 * kk + 4 * hi) * 2;
        const unsigned long long lo = *(const LAS unsigned long long*)kp, hh = *(const LAS unsigned long long*)(kp + 16);
        u32x4 bw; bw.x = (unsigned)lo; bw.y = (unsigned)(lo >> 32); bw.z = (unsigned)hh; bw.w = (unsigned)(hh >> 32);
        U = __builtin_amdgcn_mfma_f32_32x32x16_bf16(att::v_frag_rt(vbuf, va_et, vd, kk), __builtin_bit_cast(bf16x8, bw), U, 0, 0, 0);
    }
    const float dec = *(const LAS float*)(lds + decoff + (32 * dt + r32) * 4);
#pragma unroll
    for (int r = 0; r < 16; ++r) S[r] = fmaf(dec, S[r], U[r]);
}
__device__ __forceinline__ void pass_a(Frame& F, float* FS, float* DT) {
    const int lane = F.lane, w = F.wave, hi = lane >> 5, r32 = lane & 31;
    att::FragOff fo; att::frag_off_init(fo, lane);
    unsigned dvo[2]; att::dma_off_init(dvo, NAB, w, lane);
    const int et = w >> 1, dt = w & 1, va_et = att::frag_va(lane, et);
    for (int sg = F.vcu; sg < 256; sg += F.G) {
        const int bh = sg >> 2, seg = sg & 3, b = bh >> 2, h = bh & 3;
        In cur, nxt;
        load_in<false>(F, b, h, 8 * seg, cur, dvo);
        stage_wl(F, h);
        GLA_BAR();
        f32x16 S;
#pragma unroll
        for (int r = 0; r < 16; ++r) S[r] = 0.f;
        float bsum[8];
#pragma unroll
        for (int i = 0; i < 8; ++i) bsum[i] = 0.f;
#pragma unroll 1
        for (int i = 0; i < 8; ++i) {
            const int par = i & 1, ktoff = par ? L_KT : L_K, decoff = L_DEC + 256 * par;
            LAS unsigned char* vbuf = F.lds + L_V + par * 16384;
            put_tile(vbuf, cur.vt, w, lane);
            float gl[16], kf[8];
            unpack8(cur.g0, (float(&)[8])gl[0]); unpack8(cur.g1, (float(&)[8])gl[8]); unpack8(cur.kk, kf);
            if (i < 7) load_in<false>(F, b, h, 8 * seg + i + 1, nxt, dvo);
            float bc[8], blast[8];
            gate_scan(F, h, gl, bc, blast);
            put_kt_dec(F.lds, ktoff, decoff, kf, bc, blast, w, lane);
#pragma unroll
            for (int j = 0; j < 8; ++j) bsum[j] += blast[j];
            GLA_BAR();
            state_step(S, F.lds, vbuf, ktoff, decoff, va_et, fo.vd, dt, hi, r32);
            cur = nxt;
        }
        float* fs = FS + (size_t)sg * 8192;
#pragma unroll
        for (int r = 0; r < 16; ++r) fs[(32 * et + att::crow(r, hi)) * 64 + 32 * dt + r32] = S[r];
        if (lane == 0) {
#pragma unroll
            for (int j = 0; j < 8; ++j) DT[(size_t)sg * 64 + 8 * w + j] = __expf(bsum[j]); }
        GLA_BAR();
    }
    __syncthreads();
}
__device__ __forceinline__ void pass_c(Frame& F, const float* FS, const float* DT) {
    const int lane = F.lane, w = F.wave, hi = lane >> 5, r32 = lane & 31, tid = F.tid;
    LAS unsigned char* lds = F.lds;
    att::FragOff fo; att::frag_off_init(fo, lane);
    unsigned dvo[2]; att::dma_off_init(dvo, NAB, w, lane);
    const int et = w >> 1, tt = w & 1, dt = tt, tl = 32 * tt + r32, va_et = att::frag_va(lane, et);
    if (tid < 128) ((LAS float*)(lds + L_GG))[tid] = F.g_gla[tid];
    LAS unsigned char* const vbuf = lds + L_V; LAS unsigned char* const ogbuf = lds + L_OG;
    for (int sg = F.vcu; sg < 256; sg += F.G) {
        const int bh = sg >> 2, seg = sg & 3, b = bh >> 2, h = bh & 3;
        In cur, nxt;
        load_in<true>(F, b, h, 8 * seg, cur, dvo);
        stage_wl(F, h);
        f32x16 S;
#pragma unroll
        for (int r = 0; r < 16; ++r) S[r] = 0.f;
        for (int j = 0; j < seg; ++j) {
            const int sj = 4 * bh + j; const float dj = DT[(size_t)sj * 64 + 32 * dt + r32]; const float* fs = FS + (size_t)sj * 8192;
#pragma unroll
            for (int r = 0; r < 16; ++r) S[r] = fmaf(dj, S[r], fs[(32 * et + att::crow(r, hi)) * 64 + 32 * dt + r32]);
        }
        GLA_BAR();
#pragma unroll 1
        for (int i = 0; i < 8; ++i) {
            const int c = 8 * seg + i;
            put_tile(vbuf, cur.vt, w, lane); put_tile(ogbuf, cur.ot, w, lane);
            float gl[16], kf[8], qf[8];
            unpack8(cur.g0, (float(&)[8])gl[0]); unpack8(cur.g1, (float(&)[8])gl[8]); unpack8(cur.kk, kf); unpack8(cur.qq, qf);
            if (i < 7) load_in<true>(F, b, h, c + 1, nxt, dvo);
#pragma unroll
            for (int r = 0; r < 16; ++r) *(LAS bf16*)(lds + L_S + (32 * et + att::crow(r, hi)) * KP + (32 * dt + r32) * 2) = (bf16)f2bf(S[r]);
            float bc[8], blast[8];
            gate_scan(F, h, gl, bc, blast);
            { float eq[8], ek[8];
#pragma unroll
              for (int j = 0; j < 8; ++j) { eq[j] = qf[j] * 0.125f * __expf(bc[j]); ek[j] = kf[j] * __expf(-bc[j]); }
              *(LAS bf16x8*)(lds + L_Q + lane * KP + 16 * w) = att::pack8(eq[0], eq[1], eq[2], eq[3], eq[4], eq[5], eq[6], eq[7]);
              *(LAS bf16x8*)(lds + L_K + lane * KP + 16 * w) = att::pack8(ek[0], ek[1], ek[2], ek[3], ek[4], ek[5], ek[6], ek[7]); }
            put_kt_dec(lds, L_KT, L_DEC, kf, bc, blast, w, lane);
            GLA_BAR();
            bf16x8 qfr[4];
#pragma unroll
            for (int ks = 0; ks < 4; ++ks) qfr[ks] = *(const LAS bf16x8*)(lds + L_Q + tl * KP + (16 * ks + 8 * hi) * 2);
            f32x16 p0, p1;
#pragma unroll
            for (int r = 0; r < 16; ++r) { p0[r] = 0.f; p1[r] = 0.f; }
#pragma unroll
            for (int ks = 0; ks < 4; ++ks) {
                const bf16x8 a0 = *(const LAS bf16x8*)(lds + L_K + r32 * KP + (16 * ks + 8 * hi) * 2), a1 = *(const LAS bf16x8*)(lds + L_K + (32 + r32) * KP + (16 * ks + 8 * hi) * 2);
                p0 = __builtin_amdgcn_mfma_f32_32x32x16_bf16(a0, qfr[ks], p0, 0, 0, 0); p1 = __builtin_amdgcn_mfma_f32_32x32x16_bf16(a1, qfr[ks], p1, 0, 0, 0);
            }
            { const int tl4 = tl - 4 * hi;
#pragma unroll
              for (int r = 0; r < 16; ++r) { const int sx = (r & 3) + 8 * (r >> 2); if (sx > tl4) p0[r] = 0.f; if (sx + 32 > tl4) p1[r] = 0.f; } }
            const bf16x8 pa0 = att::pack8(p0[0], p0[1], p0[2], p0[3], p0[4], p0[5], p0[6], p0[7]), pa1 = att::pack8(p0[8], p0[9], p0[10], p0[11], p0[12], p0[13], p0[14], p0[15]);
            const bf16x8 pa2 = att::pack8(p1[0], p1[1], p1[2], p1[3], p1[4], p1[5], p1[6], p1[7]), pa3 = att::pack8(p1[8], p1[9], p1[10], p1[11], p1[12], p1[13], p1[14], p1[15]);
            f32x16 acc;
#pragma unroll
            for (int r = 0; r < 16; ++r) acc[r] = 0.f;
            acc = __builtin_amdgcn_mfma_f32_32x32x16_bf16(att::v_frag_rt(vbuf, va_et, fo.vd, 0), pa0, acc, 0, 0, 0);
            acc = __builtin_amdgcn_mfma_f32_32x32x16_bf16(att::v_frag_rt(vbuf, va_et, fo.vd, 1), pa1, acc, 0, 0, 0);
            acc = __builtin_amdgcn_mfma_f32_32x32x16_bf16(att::v_frag_rt(vbuf, va_et, fo.vd, 2), pa2, acc, 0, 0, 0);
            acc = __builtin_amdgcn_mfma_f32_32x32x16_bf16(att::v_frag_rt(vbuf, va_et, fo.vd, 3), pa3, acc, 0, 0, 0);
#pragma unroll
            for (int ks = 0; ks < 4; ++ks) acc = __builtin_amdgcn_mfma_f32_32x32x16_bf16(*(const LAS bf16x8*)(lds + L_S + (32 * et + r32) * KP + (16 * ks + 8 * hi) * 2), qfr[ks], acc, 0, 0, 0);
            state_step(S, lds, vbuf, L_KT, L_DEC, va_et, fo.vd, dt, hi, r32);
            float ss = 0.f;
#pragma unroll
            for (int r = 0; r < 16; ++r) ss = fmaf(acc[r], acc[r], ss);
            ss += __shfl_xor(ss, 32);
            LAS float* part = (LAS float*)(lds + L_PART);
            if (hi == 0) part[et * 64 + tl] = ss;
            GLA_BAR();
            const float rs = rsqrtf(((part[tl] + part[64 + tl]) + (part[128 + tl] + part[192 + tl])) * (1.0f / 128.0f) + EPS);
#pragma unroll
            for (int g = 0; g < 4; ++g) {
                const int e0 = 32 * et + 8 * g + 4 * hi;
                const unsigned long long ow = *(const LAS unsigned long long*)(ogbuf + att::img_off(tl, 4 * et + g) + 8 * hi);
                const f32x4 gg = *(const LAS f32x4*)(lds + L_GG + e0 * 4);
                float y[4];
#pragma unroll
                for (int j = 0; j < 4; ++j) { const float og = __uint_as_float(((unsigned)(ow >> (16 * j)) & 0xffffu) << 16); y[j] = acc[4 * g + j] * rs * gg[j] * (og * __builtin_amdgcn_rcpf(1.0f + __expf(-og))); }
                *(LAS unsigned long long*)(lds + L_STG + tl * SP + e0 * 2) = (unsigned long long)pg8::cvt_pk_bf16(y[0], y[1]) | ((unsigned long long)pg8::cvt_pk_bf16(y[2], y[3]) << 32);
            }
            GLA_BAR();
#pragma unroll
            for (int k2 = 0; k2 < 2; ++k2) { const int cidx = tid + 512 * k2, row = cidx >> 4, ch = cidx & 15;
                *(u32x4*)(F.CAT + (size_t)(b * SEQ + 64 * c + row) * D + 512 + h * 128 + ch * 8) = *(const LAS u32x4*)(lds + L_STG + row * SP + ch * 16); }
            cur = nxt;
        }
    }
    __syncthreads();
}
}
__device__ __forceinline__ void ph_rope_tables(Frame& F, float* R128, float* R64) {
    for (int i = F.vcu * NTHR + F.tid; i < SEQ * 24; i += F.G * NTHR) {
        const int pos = i / 24, k = i % 24;
        if (k < 16) { const float inv = powf(500000.0f, -(float)k * 2.0f / 32.0f), ang = (float)pos * inv; R128[pos * 32 + k] = cosf(ang); R128[pos * 32 + 16 + k] = sinf(ang); }
        else { const int j = k - 16; const float inv = powf(500000.0f, -(float)j * 2.0f / 16.0f), ang = (float)pos * inv; R64[pos * 16 + j] = cosf(ang); R64[pos * 16 + 8 + j] = sinf(ang); }
    }
}
__device__ __forceinline__ float dpp_xor1(float v) { return __builtin_bit_cast(float, __builtin_amdgcn_mov_dpp(__builtin_bit_cast(int, v), 0xB1, 0xF, 0xF, true)); }
__device__ __forceinline__ float dpp_xor2(float v) { return __builtin_bit_cast(float, __builtin_amdgcn_mov_dpp(__builtin_bit_cast(int, v), 0x4E, 0xF, 0xF, true)); }
__device__ __forceinline__ void ph_prep_c_fast(Frame& F) {
    const int gw = F.vcu * NWAVES + F.wave, NGW = F.G * NWAVES, lane = F.lane;
    const float* gn = (lane < 32 ? F.gq_c : F.gk_c) + (lane & 3) * 32;
    const float sc = lane < 32 ? att::C2 : 1.0f;
    float g[32];
#pragma unroll
    for (int i = 0; i < 8; ++i) { const f32x4 v = *(const f32x4*)(gn + 4 * i); g[4 * i] = v[0] * sc; g[4 * i + 1] = v[1] * sc; g[4 * i + 2] = v[2] * sc; g[4 * i + 3] = v[3] * sc; }
    for (int tok = gw; tok < M; tok += NGW) {
        att::u32x4* p = (att::u32x4*)(F.R1 + (size_t)tok * NC + lane * 32);
        att::u32x4 v[4]; float f[32]; float ss = 0.f;
#pragma unroll
        for (int i = 0; i < 4; ++i) v[i] = p[i];
#pragma unroll
        for (int i = 0; i < 4; ++i)
#pragma unroll
            for (int j = 0; j < 4; ++j) { const float a = __uint_as_float(v[i][j] << 16), b = __uint_as_float(v[i][j] & 0xffff0000u); f[8 * i + 2 * j] = a; f[8 * i + 2 * j + 1] = b; ss = fmaf(a, a, fmaf(b, b, ss)); }
        ss += dpp_xor1(ss); ss += dpp_xor2(ss);
        const float rs = rsqrtf(ss * (1.f / 128.f) + EPS);
#pragma unroll
        for (int i = 0; i < 4; ++i) { att::u32x4 o;
#pragma unroll
            for (int j = 0; j < 4; ++j) o[j] = pg8::cvt_pk_bf16(f[8 * i + 2 * j] * rs * g[8 * i + 2 * j], f[8 * i + 2 * j + 1] * rs * g[8 * i + 2 * j + 1]);
            p[i] = o; }
    }
}
__device__ __forceinline__ void ph_prep_a_fast(Frame& F, const float* R128, const float* R64) {
    const int gw = F.vcu * NWAVES + F.wave, NGW = F.G * NWAVES, lane = F.lane, l8 = lane & 7;
    const float* gn = (lane < 32 ? F.gq_a : F.gk_a) + l8 * 16;
    const float sc = lane < 32 ? att::C2 : 1.0f;
    float g[16];
#pragma unroll
    for (int i = 0; i < 4; ++i) { const f32x4 v = *(const f32x4*)(gn + 4 * i); g[4 * i] = v[0] * sc; g[4 * i + 1] = v[1] * sc; g[4 * i + 2] = v[2] * sc; g[4 * i + 3] = v[3] * sc; }
    for (int tok = gw; tok < M; tok += NGW) {
        const int pos = tok & (SEQ - 1);
        bf16* pr = F.R1 + (size_t)tok * NAB;
        {   att::u32x4* p = (att::u32x4*)(pr + lane * 16);
            const att::u32x4 v0 = p[0], v1 = p[1]; float f[16]; float ss = 0.f;
#pragma unroll
            for (int j = 0; j < 4; ++j) { f[2 * j] = __uint_as_float(v0[j] << 16); f[2 * j + 1] = __uint_as_float(v0[j] & 0xffff0000u); f[8 + 2 * j] = __uint_as_float(v1[j] << 16); f[8 + 2 * j + 1] = __uint_as_float(v1[j] & 0xffff0000u); }
#pragma unroll
            for (int i = 0; i < 16; ++i) ss = fmaf(f[i], f[i], ss);
            ss += dpp_xor1(ss); ss += dpp_xor2(ss); ss += __shfl_xor(ss, 4);
            const float rs = rsqrtf(ss * (1.f / 128.f) + EPS);
#pragma unroll
            for (int i = 0; i < 16; ++i) f[i] = f[i] * rs * g[i];
            const float* cs = R128 + pos * 32;
#pragma unroll
            for (int i = 0; i < 16; ++i) { const float other = dpp_xor1(f[i]);
                if (l8 < 2) { const float c = cs[i], s = cs[16 + i]; f[i] = (l8 == 0) ? f[i] * c - other * s : f[i] * c + other * s; } }
            att::u32x4 o0, o1;
#pragma unroll
            for (int j = 0; j < 4; ++j) { o0[j] = pg8::cvt_pk_bf16(f[2 * j], f[2 * j + 1]); o1[j] = pg8::cvt_pk_bf16(f[8 + 2 * j], f[8 + 2 * j + 1]); }
            p[0] = o0; p[1] = o1;
        }
        {
#pragma unroll
            for (int part = 0; part < 2; ++part) {
                if (part == 1 && lane >= 8) break;
                att::u32x4* p = (att::u32x4*)(pr + (part == 0 ? C_IQ + lane * 8 : C_IK + lane * 8));
                const att::u32x4 v0 = p[0]; float f[8];
#pragma unroll
                for (int j = 0; j < 4; ++j) { f[2 * j] = __uint_as_float(v0[j] << 16); f[2 * j + 1] = __uint_as_float(v0[j] & 0xffff0000u); }
                const float* cs = R64 + pos * 16;
#pragma unroll
                for (int i = 0; i < 8; ++i) { const float other = dpp_xor1(f[i]);
                    if (l8 < 2) { const float c = cs[i], s = cs[8 + i]; f[i] = (l8 == 0) ? f[i] * c - other * s : f[i] * c + other * s; } }
                att::u32x4 o0;
#pragma unroll
                for (int j = 0; j < 4; ++j) o0[j] = pg8::cvt_pk_bf16(f[2 * j], f[2 * j + 1]);
                p[0] = o0;
            }
        }
    }
}
#ifndef MK_PER_PHASE
#define MK_PER_PHASE 0
#endif
constexpr int NPH = 14;
struct Args { const float* in[16]; float* out; unsigned char* ws; int ph_lo, ph_hi; };
__global__ void __launch_bounds__(NTHR, 2) mk_fwd(Args args) {
    extern __shared__ __attribute__((aligned(16))) unsigned char lds[];
    Frame F;
    F.lds = (LAS unsigned char*)lds;
    F.MISC = (volatile LAS unsigned*)(F.lds + MISC_OFF);
#ifdef PROBE_TOTAL
    const unsigned long long pt_start = __builtin_amdgcn_s_memrealtime();
#endif
    F.wave = __builtin_amdgcn_readfirstlane((int)threadIdx.x >> 6);
#define RELANE() (F.lane = lane_id_opaque(), F.tid = F.wave * 64 + F.lane, true)
    RELANE();
#ifdef PROBE_ACC
    F.acc_t0 = 0ull; F.acc_sum = 0ull;
#endif
    F.G = gridDim.x; { const int bx = blockIdx.x; F.vcu = (F.G % 8 == 0) ? (bx % 8) * (F.G / 8) + bx / 8 : bx; }
    unsigned char* ws = args.ws;
    F.ctl = (gu32*)(ws + WS_CTL);
    F.x = args.in[0]; F.g_mix = args.in[1]; F.g_ffn = args.in[2]; F.w_in_ab = args.in[3]; F.gq_a = args.in[4]; F.gk_a = args.in[5]; F.w_gate_up = args.in[6]; F.b_gate = args.in[7];
    F.g_gla = args.in[8]; F.w_out_ab = args.in[9]; F.w_in_c = args.in[10]; F.gq_c = args.in[11]; F.gk_c = args.in[12]; F.w_out_c = args.in[13]; F.w_up = args.in[14]; F.w_down = args.in[15];
    F.out = args.out;
    F.Wab = (bf16*)(ws + WS_WAB); F.Woab = (bf16*)(ws + WS_WOAB); F.Wup0 = (bf16*)(ws + WS_WUP0); F.Wdn0 = (bf16*)(ws + WS_WDN0);
    F.Winc = (bf16*)(ws + WS_WINC); F.Woc = (bf16*)(ws + WS_WOC); F.Wup1 = (bf16*)(ws + WS_WUP1); F.Wdn1 = (bf16*)(ws + WS_WDN1);
    F.XB = (bf16*)(ws + WS_XB); F.CAT = (bf16*)(ws + WS_CAT); F.R1 = (bf16*)(ws + WS_R1); F.SSQ = (float*)(ws + WS_SSQ); F.MASK = (unsigned*)(ws + WS_MASK);
    for (int u = F.tid; u < (LDS_BYTES - MISC_OFF) / 4; u += NTHR) ((LAS unsigned*)(F.lds + MISC_OFF))[u] = 0u;
    __syncthreads();
    XcdBarrier bar; bar.bar = (unsigned*)(F.ctl + CW_BAR); bar.x = 0; bar.st = nullptr; bar.wave = F.wave;
    if (!MK_PER_PHASE) bar = xcd_barrier_post((unsigned*)(F.ctl + CW_BAR), F.MISC + 8, F.wave);
    const int lo = args.ph_lo, hi = args.ph_hi;
#ifdef PROBE_PH
    unsigned long long pt0 = 0ull, pt1 = 0ull;
#define STAMP(k) do { if ((k) == PROBE_PH) pt0 = __builtin_amdgcn_s_memrealtime(); if ((k) == PROBE_PH + 1) pt1 = __builtin_amdgcn_s_memrealtime(); } while (0)
#ifdef PROBE_SUB
#define SUBSTAMP(k) do { if ((k) == PROBE_PH) { __syncthreads(); pt0 = __builtin_amdgcn_s_memrealtime(); } } while (0)
#else
#define SUBSTAMP(k) do { } while (0)
#endif
#else
#define STAMP(k) do { } while (0)
#define SUBSTAMP(k) do { } while (0)
#endif
#define IN(k) (lo <= (k) && (k) < hi && RELANE())
#ifdef PROBE_DBLBAR
#define SEAM(k) do { if (lo <= (k) && (k) + 1 < hi) { xcd_barrier(bar); xcd_barrier(bar); } } while (0)
#else
#define SEAM(k) do { if (lo <= (k) && (k) + 1 < hi) xcd_barrier(bar); } while (0)
#endif
    float* const SSQ0 = F.SSQ, *SSQ1 = F.SSQ + (size_t)M * 16, *SSQ2 = F.SSQ + (size_t)2 * M * 16, *SSQ3 = F.SSQ + (size_t)3 * M * 16;
    typedef pg8::StaticOrder SO;
    STAMP(0); float* const R128 = (float*)(ws + WS_ROPE); float* const R64 = R128 + SEQ * 32;
    if (IN(0)) { ph_prologue(F); ph_rope_tables(F, R128, R64); } SEAM(0);
    STAMP(1); if (IN(1)) { pg8::Gemm g{F.XB, F.Wab, M, NAB, D}; SO S; S.init(M, NAB, F.G, (int)blockIdx.x); pg8::EpiProjAB E{F.R1, NAB, SSQ0, F.gq_a, F.gk_a, R128, R64, (LAS float*)(F.lds + RING_BYTES), att::C2};
        pg8::gemm_phase<pg8::EpiProjAB, SO, true, true>(F.lds, g, S, E, F.wave);
        if (F.G == 256 && blockIdx.x >= 128) { RELANE(); prologue_weights<1>(F, ((int)blockIdx.x - 128) * NWAVES + F.wave, 128 * NWAVES); } } SEAM(1);
    float* const FS = (float*)(ws + WS_XB); float* const DT = (float*)(ws + WS_DEC);
    STAMP(2); if (IN(2)) { SUBSTAMP(2); gla::pass_a(F, FS, DT); } SEAM(2);
    STAMP(3); if (IN(3)) { SUBSTAMP(3); ph_indexer(F); } SEAM(3);
    STAMP(4); if (IN(4)) { ph_dsa(F); SUBSTAMP(4); gla::pass_c(F, FS, DT); } SEAM(4);
    STAMP(5); if (IN(5)) { pg8::Gemm g{F.CAT, F.Woab, M, D, D}; SO S; S.init(M, D, F.G, (int)blockIdx.x); pg8::EpiResid<0, 0> E{F.x, nullptr, F.XB, SSQ1, nullptr};
        pg8::gemm_phase<pg8::EpiResid<0, 0>, SO, true, true>(F.lds, g, S, E, F.wave); } SEAM(5);
    STAMP(6); if (IN(6)) { pg8::Gemm g{F.XB, F.Wup0, M, FF, D}; SO S; S.init(M, FF, F.G, (int)blockIdx.x); pg8::EpiScale<1> E{F.R1, FF, SSQ1};
        pg8::gemm_phase<pg8::EpiScale<1>, SO, true, true>(F.lds, g, S, E, F.wave); } SEAM(6);
    STAMP(7); if (IN(7)) { pg8::Gemm g{F.R1, F.Wdn0, M, D, FF}; SO S; S.init(M, D, F.G, (int)blockIdx.x); pg8::EpiResid<1, 0> E{F.XB, nullptr, F.XB, SSQ2, SSQ1};
        pg8::gemm_phase<pg8::EpiResid<1, 0>, SO, true, true>(F.lds, g, S, E, F.wave); } SEAM(7);
    STAMP(8); if (IN(8)) { pg8::Gemm g{F.XB, F.Winc, M, NC, D}; SO S; S.init(M, NC, F.G, (int)blockIdx.x); pg8::EpiQKNorm E{F.R1, NC, SSQ2, F.gq_c, F.gk_c, (LAS float*)(F.lds + RING_BYTES), att::C2};
        pg8::gemm_phase<pg8::EpiQKNorm, SO, true, true>(F.lds, g, S, E, F.wave); } SEAM(8);
    STAMP(9);
    STAMP(10); if (IN(10)) { ph_sb(F); } SEAM(10);
    STAMP(11); if (IN(11)) { pg8::Gemm g{F.CAT, F.Woc, M, D, D}; SO S; S.init(M, D, F.G, (int)blockIdx.x); pg8::EpiResid<1, 0> E{F.XB, nullptr, F.XB, SSQ3, nullptr};
        pg8::gemm_phase<pg8::EpiResid<1, 0>, SO, true, true>(F.lds, g, S, E, F.wave); } SEAM(11);
    STAMP(12); if (IN(12)) { pg8::Gemm g{F.XB, F.Wup1, M, FF, D}; SO S; S.init(M, FF, F.G, (int)blockIdx.x); pg8::EpiScale<1> E{F.R1, FF, SSQ3};
        pg8::gemm_phase<pg8::EpiScale<1>, SO, true, true>(F.lds, g, S, E, F.wave); } SEAM(12);
    STAMP(13); if (IN(13)) { pg8::Gemm g{F.R1, F.Wdn1, M, D, FF}; SO S; S.init(M, D, F.G, (int)blockIdx.x); pg8::EpiResid<1, 1> E{F.XB, F.out, nullptr, nullptr, SSQ3};
        pg8::gemm_phase<pg8::EpiResid<1, 1>, SO, true, true>(F.lds, g, S, E, F.wave); }
    STAMP(NPH);
#ifdef PROBE_TOTAL
    if (blockIdx.x == 0) { const unsigned long long t1 = __builtin_amdgcn_s_memrealtime(), dt = (t1 - pt_start); while (__builtin_amdgcn_s_memrealtime() - t1 < dt) __builtin_amdgcn_s_sleep(8); }
#endif
#ifdef PROBE_ACC
    if (blockIdx.x == 0) { const unsigned long long t1 = __builtin_amdgcn_s_memrealtime(), dt = F.acc_sum * PROBE_MULT; while (__builtin_amdgcn_s_memrealtime() - t1 < dt) __builtin_amdgcn_s_sleep(8); }
#endif
#ifdef PROBE_PH
    if (blockIdx.x == 0) { const unsigned long long t1 = __builtin_amdgcn_s_memrealtime(), dt = (pt1 - pt0) * PROBE_MULT; while (__builtin_amdgcn_s_memrealtime() - t1 < dt) __builtin_amdgcn_s_sleep(8); }
#endif
#undef IN
#undef SEAM
}

extern "C" void kernel_launch(void* const* d_in, const int* in_sizes, int n_in, void* d_out, int out_size, void* d_ws, size_t ws_size, hipStream_t stream) {
    static int grid = 0;
    if (grid == 0) {
        if (n_in != 16 || in_sizes[0] != M * D || out_size != M * D || ws_size < WS_END) { fprintf(stderr, "kernel_launch: unexpected shapes / workspace (%d inputs, ws %zu)\n", n_in, ws_size); grid = -1; return; }
        int dev = 0, cus = 0;
        if (hipGetDevice(&dev) != hipSuccess || hipDeviceGetAttribute(&cus, hipDeviceAttributeMultiprocessorCount, dev) != hipSuccess) { grid = -1; return; }
        if (hipFuncSetAttribute((const void*)mk_fwd, hipFuncAttributeMaxDynamicSharedMemorySize, LDS_BYTES) != hipSuccess) { fprintf(stderr, "kernel_launch: hipFuncSetAttribute failed\n"); grid = -1; return; }
        (void)hipGetLastError();
        grid = cus;
    }
    if (grid < 0) return;
    if (hipMemsetAsync((char*)d_ws + WS_CTL, 0, CTL_ZERO_BYTES, stream) != hipSuccess) { fprintf(stderr, "kernel_launch: memset failed\n"); return; }
    Args a{};
    for (int i = 0; i < 16; ++i) a.in[i] = (const float*)d_in[i];
    a.out = (float*)d_out; a.ws = (unsigned char*)d_ws;
#if MK_PER_PHASE
    for (int ph = 0; ph < NPH; ++ph) { a.ph_lo = ph; a.ph_hi = ph + 1; hipLaunchKernelGGL(mk_fwd, dim3(grid), dim3(NTHR), LDS_BYTES, stream, a); }
#else
    a.ph_lo = 0; a.ph_hi = NPH;
    hipLaunchKernelGGL(mk_fwd, dim3(grid), dim3(NTHR), LDS_BYTES, stream, a);
#endif
    const hipError_t le = hipPeekAtLastError();
    if (le != hipSuccess) fprintf(stderr, "kernel_launch: launch failed: %s\n", hipGetErrorName(le));
}
```

```cpp
#include <hip/hip_runtime.h>
#include <cstdio>
#include <cstdint>
namespace pg8 {
#define PG8_LAS __attribute__((address_space(3)))
typedef unsigned short bf16_t;
typedef short bf16x8 __attribute__((ext_vector_type(8)));
typedef float f32x4 __attribute__((ext_vector_type(4)));
typedef unsigned u32x4 __attribute__((ext_vector_type(4)));
constexpr int BM = 256, BK = 64, HALF = 128, HTB = HALF * BK * 2  , STAGE_BYTES = 8 * HTB, NXCD = 8, WGM = 4;

__host__ __device__ __forceinline__ int lds_byte(int r, int c) { const int st = (r >> 4) * 2 + (c >> 5), rr = r & 15, cc = c & 31, ob = rr * 64 + cc * 2; return st * 1024 + (ob ^ (((ob >> 9) & 1) << 5)); }
__host__ __device__ __forceinline__ void stage_rc(int b, int& R, int& C) { const int st = b / 1024, sb = b % 1024, swz = sb ^ (((sb >> 9) & 1) << 5); R = (st >> 1) * 16 + swz / 64; C = (st & 1) * 32 + (swz % 64) / 2; }
__host__ __device__ __forceinline__ int perm32(int rho) { const int n = rho >> 4, i = rho & 15; return 8 * (i >> 2) + 4 * n + (i & 3); }

struct Unit { int pm, pn; };
struct Gemm { const bf16_t* A; const bf16_t* Bt; int M, N, K; };

struct StaticOrder {
    int nM, nN, nwg, G, c, wgm;
    __host__ __device__ void init(int M, int N, int G_, int c_, int wgm_ = WGM) { nM = M / BM; nN = N / BM; nwg = nM * nN; G = G_; c = c_; wgm = wgm_; }
    __host__ __device__ bool next(int i, Unit& u) const {
        const long L = (long)i * G + c; if (L >= nwg) return false;
        int wgid = (int)L; { const int q = nwg / NXCD, r = nwg % NXCD, xcd = wgid % NXCD, off = wgid / NXCD; wgid = (xcd < r ? xcd * (q + 1) : r * (q + 1) + (xcd - r) * q) + off; }
        const int nig = wgm * nN, gid = wgid / nig, fm = gid * wgm, gsz = (nM - fm) < wgm ? (nM - fm) : wgm;
        u.pm = fm + ((wgid % nig) % gsz); u.pn = (wgid % nig) / gsz; return true;
    }
    __device__ __forceinline__ void a_ready(const Unit&) const {}
    __device__ __forceinline__ void done(const Unit&) const {}
};

__device__ __forceinline__ unsigned cvt_pk_bf16(float lo, float hi) { unsigned r; asm volatile("v_cvt_pk_bf16_f32 %0, %1, %2" : "=v"(r) : "v"(lo), "v"(hi)); return r; }
__device__ __forceinline__ float row_rstd(const float* ssqp, int row) {
    const f32x4* p = (const f32x4*)(ssqp + (size_t)row * 16);
    const f32x4 a = p[0], b = p[1], c = p[2], d = p[3];
    const float s = (((a[0] + a[1]) + (a[2] + a[3])) + ((b[0] + b[1]) + (b[2] + b[3]))) + (((c[0] + c[1]) + (c[2] + c[3])) + ((d[0] + d[1]) + (d[2] + d[3])));
    return rsqrtf(s * (1.0f / 1024.0f) + 1e-6f);
}
__device__ __forceinline__ int epi_lane() { int l; asm volatile("v_mbcnt_lo_u32_b32 %0, -1, 0\n\tv_mbcnt_hi_u32_b32 %0, -1, %0" : "=v"(l)); return l; }
#define EPI_ST_NT(p, v) __builtin_nontemporal_store((v), (p))
#define EPI_ST_PLAIN(p, v) (*(p) = (v))
#ifndef EPI_ST_ACT
#define EPI_ST_ACT EPI_ST_NT
#endif
#ifndef EPI_ST_QKV
#define EPI_ST_QKV EPI_ST_NT
#endif
#ifndef EPI_ST_PROJ
#define EPI_ST_PROJ EPI_ST_PLAIN
#endif
__device__ __forceinline__ float relu_bits(float x) { const int i = __builtin_bit_cast(int, x); return __builtin_bit_cast(float, i > 0 ? i : 0); }
template <int ACT  > struct EpiScale {
    static constexpr bool PERM = true, AFTER_DRAIN = false, HAS_PRE = false;
    bf16_t* O; int ldc; const float* ssqp;
    __device__ __forceinline__ void operator()(const f32x4 (&acc)[2][2][4][2], const Unit& u, int wr, int wc, int fr, int fq) const {
        const int row0 = u.pm * BM + wr * 64 + fr, col0 = u.pn * BM + wc * 32 + 8 * fq;
#pragma unroll
        for (int ai = 0; ai < 2; ++ai)
#pragma unroll
            for (int m = 0; m < 4; ++m) {
                const int row = row0 + ai * HALF + m * 16;
                const float rs = (ACT == 0) ? row_rstd(ssqp, row) : 1.0f;
                bf16_t* rowp = O + (size_t)row * ldc + col0;
#pragma unroll
                for (int bj = 0; bj < 2; ++bj) {
                    f32x4 v0 = acc[ai][bj][m][0] * rs, v1 = acc[ai][bj][m][1] * rs;
                    if (ACT == 1) {
#pragma unroll
                        for (int e = 0; e < 4; ++e) { const float a0 = relu_bits(v0[e]), a1 = relu_bits(v1[e]); v0[e] = a0 * a0; v1[e] = a1 * a1; }
                    }
                    u32x4 w; w.x = cvt_pk_bf16(v0[0], v0[1]); w.y = cvt_pk_bf16(v0[2], v0[3]); w.z = cvt_pk_bf16(v1[0], v1[1]); w.w = cvt_pk_bf16(v1[2], v1[3]);
                    EPI_ST_ACT((u32x4*)(rowp + bj * HALF), w);
                }
            }
    }
};
template <int RIN, int OUT, bool PF = false> struct EpiResid {
    static_assert(RIN == 1, "the residual stream is bf16 everywhere");
    static constexpr bool PERM = true, AFTER_DRAIN = false, HAS_PRE = PF;
    const void* R; float* out; bf16_t* hb; float* ssqp; const float* ssq_in;
    struct Pre { u32x4 r[4][2]; };
    __device__ __forceinline__ void prefetch(Pre& p, const Unit& u, int wr, int wc) const { const int ln = epi_lane(); load_half(p, u, wr, wc, ln & 15, ln >> 4); }
    template <bool WITHPRE> __device__ __forceinline__ void body(const f32x4 (&acc)[2][2][4][2], const Unit& u, int wr, int wc, Pre* pre, bool has_next, const Unit& nxt) const {
        const int ln = epi_lane(), fr = ln & 15, fq = ln >> 4;
        const int row0 = u.pm * BM + wr * 64 + fr, col0 = u.pn * BM + wc * 32 + 8 * fq;
        u32x4 rw[2][4][2]; f32x4 pq[2][4];
        if (WITHPRE) {
#pragma unroll
            for (int m = 0; m < 4; ++m)
#pragma unroll
                for (int bj = 0; bj < 2; ++bj) rw[0][m][bj] = pre->r[m][bj];
            if (has_next) load_half(*pre, nxt, wr, wc, fr, fq);
        }
#pragma unroll
        for (int ai = WITHPRE ? 1 : 0; ai < 2; ++ai)
#pragma unroll
            for (int m = 0; m < 4; ++m)
#pragma unroll
                for (int bj = 0; bj < 2; ++bj) { const unsigned off = (unsigned)((row0 + ai * HALF + m * 16) * 1024 + col0 + bj * HALF);
                    rw[ai][m][bj] = *(const u32x4*)((const char*)R + off * 2u); }
        if (ssq_in) {
#pragma unroll
            for (int ai = 0; ai < 2; ++ai)
#pragma unroll
                for (int m = 0; m < 4; ++m) pq[ai][m] = *(const f32x4*)((const char*)ssq_in + (unsigned)(row0 + ai * HALF + m * 16) * 64u + (unsigned)fq * 16u);
        }
        asm volatile("" ::: "memory");
#pragma unroll
        for (int ai = 0; ai < 2; ++ai)
#pragma unroll
            for (int m = 0; m < 4; ++m) {
                const int row = row0 + ai * HALF + m * 16;
                const unsigned off = (unsigned)(row * 1024 + col0);
                float sc2 = 1.0f;
                if (ssq_in) { const f32x4 a = pq[ai][m]; float sum = (a[0] + a[1]) + (a[2] + a[3]); sum += __shfl_xor(sum, 16); sum += __shfl_xor(sum, 32);
                    const float rs = rsqrtf(sum * (1.0f / 1024.0f) + 1e-6f); sc2 = rs * rs; }
                float ss = 0.f;
#pragma unroll
                for (int bj = 0; bj < 2; ++bj) {
                    const u32x4 w0 = rw[ai][m][bj];
                    const f32x4 r0 = (f32x4){__uint_as_float(w0.x << 16), __uint_as_float(w0.x & 0xffff0000u), __uint_as_float(w0.y << 16), __uint_as_float(w0.y & 0xffff0000u)};
                    const f32x4 r1 = (f32x4){__uint_as_float(w0.z << 16), __uint_as_float(w0.z & 0xffff0000u), __uint_as_float(w0.w << 16), __uint_as_float(w0.w & 0xffff0000u)};
                    const f32x4 v0 = acc[ai][bj][m][0] * sc2 + r0, v1 = acc[ai][bj][m][1] * sc2 + r1;
                    if (OUT == 1) { __builtin_nontemporal_store(v0, (f32x4*)((char*)out + (off + bj * HALF) * 4u)); __builtin_nontemporal_store(v1, (f32x4*)((char*)out + (off + bj * HALF) * 4u + 16u)); }
                    else {
                        u32x4 w; w.x = cvt_pk_bf16(v0[0], v0[1]); w.y = cvt_pk_bf16(v0[2], v0[3]); w.z = cvt_pk_bf16(v1[0], v1[1]); w.w = cvt_pk_bf16(v1[2], v1[3]);
                        *(u32x4*)((char*)hb + (off + bj * HALF) * 2u) = w;
                        ss += ((v0[0] * v0[0] + v0[1] * v0[1]) + (v0[2] * v0[2] + v0[3] * v0[3])) + ((v1[0] * v1[0] + v1[1] * v1[1]) + (v1[2] * v1[2] + v1[3] * v1[3]));
                    }
                }
                if (OUT == 0) { ss += __shfl_xor(ss, 16); ss += __shfl_xor(ss, 32); if (fq == 0) *(float*)((char*)ssqp + (unsigned)(row * 16 + u.pn * 4 + wc) * 4u) = ss; }
            }
    }
    __device__ __forceinline__ void load_half(Pre& p, const Unit& u, int wr, int wc, int fr, int fq) const {
        const int row0 = u.pm * BM + wr * 64 + fr, col0 = u.pn * BM + wc * 32 + 8 * fq;
#pragma unroll
        for (int m = 0; m < 4; ++m)
#pragma unroll
            for (int bj = 0; bj < 2; ++bj) p.r[m][bj] = *(const u32x4*)((const char*)R + (unsigned)((row0 + m * 16) * 1024 + col0 + bj * HALF) * 2u);
    }
    __device__ __forceinline__ void operator()(const f32x4 (&acc)[2][2][4][2], const Unit& u, int wr, int wc, int fr_, int fq_) const { const Unit dummy{0, 0}; body<false>(acc, u, wr, wc, nullptr, false, dummy); }
    __device__ __forceinline__ void operator()(const f32x4 (&acc)[2][2][4][2], const Unit& u, int wr, int wc, int fr_, int fq_, Pre& pre, bool has_next, const Unit& nxt) const { body<true>(acc, u, wr, wc, &pre, has_next, nxt); }
};
struct EpiQKNorm {
    static constexpr bool PERM = true, AFTER_DRAIN = false, HAS_PRE = false;
    bf16_t* O; int ldc; const float* ssqp; const float* gq; const float* gk; PG8_LAS float* part; float qscale;
    __device__ __forceinline__ void operator()(const f32x4 (&acc)[2][2][4][2], const Unit& u, int wr, int wc, int fr_, int fq_) const {
        const int ln = epi_lane(), fr = ln & 15, fq = ln >> 4;
        const int row0 = u.pm * BM + wr * 64 + fr, col0 = u.pn * BM + wc * 32 + 8 * fq;
        const bool nrm = u.pn < 8;
        const int pbase = (wr * 64 + fr) * 8;
        PG8_LAS float* pr = part + pbase; PG8_LAS float* pw = pr + wc;
        f32x4 pq[2][4];
#pragma unroll
        for (int ai = 0; ai < 2; ++ai)
#pragma unroll
            for (int m = 0; m < 4; ++m) pq[ai][m] = *(const f32x4*)((const char*)ssqp + (unsigned)(row0 + ai * HALF + m * 16) * 64u + (unsigned)fq * 16u);
        f32x4 g0 = (f32x4){1.f, 1.f, 1.f, 1.f}, g1 = g0;
        if (nrm) {
            { const float* gp = (u.pn < 4 ? gq : gk) + wc * 32 + 8 * fq; g0 = *(const f32x4*)gp; g1 = *(const f32x4*)(gp + 4); }
#pragma unroll
            for (int ai = 0; ai < 2; ++ai)
#pragma unroll
                for (int m = 0; m < 4; ++m)
#pragma unroll
                    for (int bj = 0; bj < 2; ++bj) { const f32x4 v0 = acc[ai][bj][m][0], v1 = acc[ai][bj][m][1];
                        float ss = ((v0[0] * v0[0] + v0[1] * v0[1]) + (v0[2] * v0[2] + v0[3] * v0[3])) + ((v1[0] * v1[0] + v1[1] * v1[1]) + (v1[2] * v1[2] + v1[3] * v1[3]));
                        ss += __shfl_xor(ss, 16); ss += __shfl_xor(ss, 32);
                        if (fq == 0) pw[((ai * HALF + m * 16) * 2 + bj) * 4] = ss; }
            asm volatile("s_waitcnt lgkmcnt(0)" ::: "memory"); __builtin_amdgcn_s_barrier(); asm volatile("" ::: "memory");
            const float sc = (u.pn < 4) ? qscale : 1.0f;
            g0 = g0 * sc; g1 = g1 * sc;
        }
        float rsv[2][4];
#pragma unroll
        for (int ai = 0; ai < 2; ++ai)
#pragma unroll
            for (int m = 0; m < 4; ++m) { const f32x4 a = pq[ai][m]; float sum = (a[0] + a[1]) + (a[2] + a[3]); sum += __shfl_xor(sum, 16); sum += __shfl_xor(sum, 32);
                rsv[ai][m] = rsqrtf(sum * (1.0f / 1024.0f) + 1e-6f); }
#pragma unroll
        for (int ai = 0; ai < 2; ++ai)
#pragma unroll
            for (int m = 0; m < 4; ++m) {
                const int row = row0 + ai * HALF + m * 16;
                const float rsr = rsv[ai][m];
                bf16_t* rowp = O + (size_t)row * ldc + col0;
#pragma unroll
                for (int bj = 0; bj < 2; ++bj) {
                    float hs = rsr;
                    if (nrm) { const f32x4 pp = *(const PG8_LAS f32x4*)(pr + ((ai * HALF + m * 16) * 2 + bj) * 4);
                        hs *= rsqrtf(((pp[0] + pp[1]) + (pp[2] + pp[3])) * (rsr * rsr * (1.0f / 128.0f)) + 1e-6f); }
                    const f32x4 v0 = acc[ai][bj][m][0] * hs * g0, v1 = acc[ai][bj][m][1] * hs * g1;
                    u32x4 w; w.x = cvt_pk_bf16(v0[0], v0[1]); w.y = cvt_pk_bf16(v0[2], v0[3]); w.z = cvt_pk_bf16(v1[0], v1[1]); w.w = cvt_pk_bf16(v1[2], v1[3]);
                    EPI_ST_QKV((u32x4*)(rowp + bj * HALF), w);
                }
            }
    }
};
struct EpiProjAB {
    static constexpr bool PERM = true, AFTER_DRAIN = false, HAS_PRE = true;
    bf16_t* O; int ldc; const float* ssqp; const float* gq; const float* gk; const float* r128; const float* r64; PG8_LAS float* part; float qscale;
    struct Pre { float v[2][4]; };
    __device__ __forceinline__ void prefetch(Pre& p, const Unit& u, int wr, int wc = 0) const { const int ln = epi_lane(), fr = ln & 15; const int row0 = u.pm * BM + wr * 64 + fr;
#pragma unroll
        for (int ai = 0; ai < 2; ++ai)
#pragma unroll
            for (int m = 0; m < 4; ++m) p.v[ai][m] = *(const float*)((const char*)ssqp + (unsigned)(row0 + ai * HALF + m * 16) * 64u); }
    __device__ __forceinline__ void operator()(const f32x4 (&acc)[2][2][4][2], const Unit& u, int wr, int wc, int fr_, int fq_, Pre& pre, bool has_next, const Unit& nxt) const {
        const int ln = epi_lane(), fr = ln & 15, fq = ln >> 4;
        const int cb = wc * 32 + 8 * fq;
        const int row0 = u.pm * BM + wr * 64 + fr, col0 = u.pn * BM + cb, pn = u.pn;
        const bool qk = pn < 4, iq = (pn == 6) || (pn == 7) || (pn == 14);
        const int pbase = (wr * 64 + fr) * 8;
        PG8_LAS float* pr = part + pbase; PG8_LAS float* pw = pr + wc;
        const bool rope_qk = qk && (wc == 0), rope_iq = iq && !(wc & 1) && (pn != 14 || wc == 0);
        float rsv[2][4];
#pragma unroll
        for (int ai = 0; ai < 2; ++ai)
#pragma unroll
            for (int m = 0; m < 4; ++m) rsv[ai][m] = pre.v[ai][m];
        f32x4 g0 = (f32x4){1.f, 1.f, 1.f, 1.f}, g1 = g0;
        if (qk) {
            { const float* gp = (pn < 2 ? gq : gk) + cb; g0 = *(const f32x4*)gp; g1 = *(const f32x4*)(gp + 4); }
#pragma unroll
            for (int ai = 0; ai < 2; ++ai)
#pragma unroll
                for (int m = 0; m < 4; ++m)
#pragma unroll
                    for (int bj = 0; bj < 2; ++bj) { const f32x4 v0 = acc[ai][bj][m][0], v1 = acc[ai][bj][m][1];
                        float ss = ((v0[0] * v0[0] + v0[1] * v0[1]) + (v0[2] * v0[2] + v0[3] * v0[3])) + ((v1[0] * v1[0] + v1[1] * v1[1]) + (v1[2] * v1[2] + v1[3] * v1[3]));
                        ss += __shfl_xor(ss, 16); ss += __shfl_xor(ss, 32);
                        if (fq == 0) pw[((ai * HALF + m * 16) * 2 + bj) * 4] = ss; }
            asm volatile("s_waitcnt lgkmcnt(0)" ::: "memory"); __builtin_amdgcn_s_barrier(); asm volatile("" ::: "memory");
            const float sc = (pn < 2) ? qscale : 1.0f;
            g0 = g0 * sc; g1 = g1 * sc;
        }
#pragma unroll
        for (int ai = 0; ai < 2; ++ai)
#pragma unroll
            for (int m = 0; m < 4; ++m) rsv[ai][m] = rsqrtf(rsv[ai][m] * (1.0f / 1024.0f) + 1e-6f);
#pragma unroll
        for (int ai = 0; ai < 2; ++ai) {
            f32x4 cc[4][4];
            if (rope_qk || rope_iq) {
#pragma unroll
                for (int m = 0; m < 4; ++m) { const int pos = (row0 + ai * HALF + m * 16) & 2047;
                    const float* t = rope_qk ? (r128 + pos * 32 + 8 * (fq & 1)) : (r64 + pos * 16); const int so = rope_qk ? 16 : 8;
                    cc[m][0] = *(const f32x4*)t; cc[m][1] = *(const f32x4*)(t + 4); cc[m][2] = *(const f32x4*)(t + so); cc[m][3] = *(const f32x4*)(t + so + 4); }
            }
#pragma unroll
            for (int m = 0; m < 4; ++m) {
                const int row = row0 + ai * HALF + m * 16;
                const float rsr = rsv[ai][m];
                bf16_t* rowp = O + (size_t)row * ldc + col0;
                const f32x4 c0 = cc[m][0], c1 = cc[m][1], s0 = cc[m][2], s1 = cc[m][3];
#pragma unroll
                for (int bj = 0; bj < 2; ++bj) {
                    float hs = rsr;
                    if (qk) { const f32x4 pp = *(const PG8_LAS f32x4*)(pr + ((ai * HALF + m * 16) * 2 + bj) * 4);
                        hs *= rsqrtf(((pp[0] + pp[1]) + (pp[2] + pp[3])) * (rsr * rsr * (1.0f / 128.0f)) + 1e-6f); }
                    f32x4 v0 = acc[ai][bj][m][0] * hs * g0, v1 = acc[ai][bj][m][1] * hs * g1;
                    if (rope_qk) {
                        f32x4 p0, p1;
#pragma unroll
                        for (int e = 0; e < 4; ++e) { p0[e] = __shfl_xor(v0[e], 32); p1[e] = __shfl_xor(v1[e], 32); }
                        if (fq < 2) { v0 = v0 * c0 - p0 * s0; v1 = v1 * c1 - p1 * s1; } else { v0 = v0 * c0 + p0 * s0; v1 = v1 * c1 + p1 * s1; }
                    } else if (rope_iq && (pn != 14 || bj == 0)) {
                        f32x4 p0, p1;
#pragma unroll
                        for (int e = 0; e < 4; ++e) { p0[e] = __shfl_xor(v0[e], 16); p1[e] = __shfl_xor(v1[e], 16); }
                        if (fq == 0) { v0 = v0 * c0 - p0 * s0; v1 = v1 * c1 - p1 * s1; } else if (fq == 1) { v0 = v0 * c0 + p0 * s0; v1 = v1 * c1 + p1 * s1; }
                    }
                    u32x4 w; w.x = cvt_pk_bf16(v0[0], v0[1]); w.y = cvt_pk_bf16(v0[2], v0[3]); w.z = cvt_pk_bf16(v1[0], v1[1]); w.w = cvt_pk_bf16(v1[2], v1[3]);
                    EPI_ST_PROJ((u32x4*)(rowp + bj * HALF), w);
                }
            }
        }
        if (has_next) prefetch(pre, nxt, wr);
    }
};
template <class E_, bool H> struct PreOf { struct type {}; };
template <class E_> struct PreOf<E_, true> { typedef typename E_::Pre type; };
template <class Epi, class Sched, bool ALIGN_EPI = false, bool SP2 = false>
__device__ __forceinline__ void gemm_phase(PG8_LAS unsigned char* lds, const Gemm g, const Sched& S, const Epi& E, const int wave_in) {
    const int wid = wave_in, lane = (int)__builtin_amdgcn_mbcnt_hi(~0u, __builtin_amdgcn_mbcnt_lo(~0u, 0u)), tid = wid * 64 + lane, wr = wid >> 2, wc = wid & 3, fr = lane & 15, fq = lane >> 4;
    const int K = g.K, nt = K / BK;
    unsigned voffA[2], voffB[2];
#pragma unroll
    for (int i = 0; i < 2; ++i) { int R, C; stage_rc(tid * 16 + i * 8192, R, C); const int Rb = Epi::PERM ? ((R & ~31) + perm32(R & 31)) : R;
        voffA[i] = (unsigned)(R * K + C) * 2u; voffB[i] = (unsigned)(Rb * K + C) * 2u; }
    const size_t kstep = (size_t)(BK * 2);
    const size_t hstep = (size_t)HALF * K * 2;
    const size_t tstep = 2 * hstep;
    const unsigned ldsw = (unsigned)wid * 1024u;
    const int aoff = lds_byte(wr * 64 + fr, fq * 8), boff = lds_byte(wc * 32 + fr, fq * 8);
#define PG8_SA(b, h) (((b) * 2 + (h)) * HTB)
#define PG8_SB(b, h) ((4 + (b) * 2 + (h)) * HTB)
#define PG8_STAGE(bufoff, gbase, voff) do { _Pragma("unroll") for (int _i = 0; _i < 2; ++_i) \
        __builtin_amdgcn_global_load_lds((const unsigned*)((const char*)(gbase) + (voff)[_i]), (PG8_LAS unsigned*)(lds + (bufoff) + ldsw + _i * 8192), 16, 0, 0); } while (0)
#define PG8_LDA(dst, b, h) do { _Pragma("unroll") for (int m = 0; m < 4; ++m) _Pragma("unroll") for (int k = 0; k < 2; ++k) dst[m][k] = *(const PG8_LAS bf16x8*)(lds + PG8_SA(b, h) + aoff + m * 2048 + k * 1024); } while (0)
#define PG8_LDB(dst, b, h) do { _Pragma("unroll") for (int n = 0; n < 2; ++n) _Pragma("unroll") for (int k = 0; k < 2; ++k) dst[n][k] = *(const PG8_LAS bf16x8*)(lds + PG8_SB(b, h) + boff + n * 2048 + k * 1024); } while (0)
#define PG8_MMA(ai, bj, At, Bt) do { __builtin_amdgcn_s_setprio(1); _Pragma("unroll") for (int m = 0; m < 4; ++m) _Pragma("unroll") for (int n = 0; n < 2; ++n) _Pragma("unroll") for (int k = 0; k < 2; ++k) \
        acc[ai][bj][m][n] = __builtin_amdgcn_mfma_f32_16x16x32_bf16(Bt[n][k], At[m][k], acc[ai][bj][m][n], 0, 0, 0); __builtin_amdgcn_s_setprio(0); } while (0)
#define PG8_WAIT_V(n) asm volatile("s_waitcnt vmcnt(" #n ")" ::: "memory")
#define PG8_WAIT_L(n) asm volatile("s_waitcnt lgkmcnt(" #n ")" ::: "memory")
#define PG8_BAR __builtin_amdgcn_s_barrier()
#define PG8_SCHED __builtin_amdgcn_sched_barrier(0)
    Unit cur, nxt; int ui = 0;
    if (!S.next(0, cur)) return;
    struct NoPre {}; typename std::conditional<Epi::HAS_PRE, typename PreOf<Epi, Epi::HAS_PRE>::type, NoPre>::type pre;
    if constexpr (Epi::HAS_PRE) E.prefetch(pre, cur, wr, wc);
    f32x4 acc[2][2][4][2];
#pragma unroll
    for (int a = 0; a < 2; ++a)
#pragma unroll
        for (int b = 0; b < 2; ++b)
#pragma unroll
            for (int m = 0; m < 4; ++m)
#pragma unroll
                for (int n = 0; n < 2; ++n) acc[a][b][m][n] = (f32x4){0.f, 0.f, 0.f, 0.f};
    bf16x8 At[4][2], B0[2][2], B1[2][2];
    const char* cA = (const char*)g.A + (size_t)cur.pm * tstep; const char* cB = (const char*)g.Bt + (size_t)cur.pn * tstep;
    S.a_ready(cur);
    if constexpr (SP2) {
        PG8_STAGE(PG8_SB(0, 0), cB, voffB); PG8_STAGE(PG8_SB(0, 1), cB + hstep, voffB); PG8_STAGE(PG8_SA(0, 0), cA, voffA); PG8_STAGE(PG8_SA(0, 1), cA + hstep, voffA);
        if (wr == 1) PG8_BAR;
        PG8_WAIT_V(2); PG8_BAR;
        PG8_STAGE(PG8_SB(1, 0), cB + kstep, voffB); PG8_STAGE(PG8_SA(1, 0), cA + kstep, voffA); PG8_STAGE(PG8_SB(1, 1), cB + hstep + kstep, voffB);
        PG8_WAIT_V(6); PG8_BAR;
    } else {
        PG8_STAGE(PG8_SB(0, 0), cB, voffB); PG8_STAGE(PG8_SA(0, 0), cA, voffA); PG8_STAGE(PG8_SB(0, 1), cB + hstep, voffB); PG8_STAGE(PG8_SA(0, 1), cA + hstep, voffA);
        if (wr == 1) PG8_BAR;
        PG8_WAIT_V(4); PG8_BAR;
        PG8_STAGE(PG8_SB(1, 0), cB + kstep, voffB); PG8_STAGE(PG8_SA(1, 0), cA + kstep, voffA); PG8_STAGE(PG8_SB(1, 1), cB + hstep + kstep, voffB);
        PG8_WAIT_V(6); PG8_BAR;
    }
    for (;;) {
        const bool has_next = S.next(ui + 1, nxt);
        const char* nA = has_next ? (const char*)g.A + (size_t)nxt.pm * tstep : cA; const char* nB = has_next ? (const char*)g.Bt + (size_t)nxt.pn * tstep : cB;
        for (int t = 0; t < nt; t += 2) {
            const bool last = (t == nt - 2);
            const char* a1 = cA + (size_t)(t + 1) * kstep;
            const char* a2 = last ? nA : cA + (size_t)(t + 2) * kstep; const char* b2 = last ? nB : cB + (size_t)(t + 2) * kstep;
            const char* a3 = a2 + kstep; const char* b3 = b2 + kstep;
            if (last && has_next) S.a_ready(nxt);
            if constexpr (SP2) {
            PG8_LDB(B0, 0, 0); PG8_LDB(B1, 0, 1); PG8_SCHED; PG8_LDA(At, 0, 0); PG8_STAGE(PG8_SA(1, 1), a1 + hstep, voffA);
            PG8_WAIT_V(8); PG8_WAIT_L(0); PG8_BAR; PG8_MMA(0, 0, At, B0); PG8_MMA(0, 1, At, B1); PG8_BAR; PG8_SCHED;
            PG8_LDA(At, 0, 1); PG8_STAGE(PG8_SB(0, 0), b2, voffB); PG8_STAGE(PG8_SB(0, 1), b2 + hstep, voffB); PG8_STAGE(PG8_SA(0, 0), a2, voffA);
            PG8_WAIT_V(8); PG8_WAIT_L(0); PG8_BAR; PG8_MMA(1, 0, At, B0); PG8_MMA(1, 1, At, B1); PG8_BAR; PG8_SCHED;
            PG8_LDB(B0, 1, 0); PG8_LDB(B1, 1, 1); PG8_SCHED; PG8_LDA(At, 1, 0); PG8_STAGE(PG8_SA(0, 1), a2 + hstep, voffA);
            PG8_WAIT_V(8); PG8_WAIT_L(0); PG8_BAR; PG8_MMA(0, 0, At, B0); PG8_MMA(0, 1, At, B1); PG8_BAR; PG8_SCHED;
            PG8_LDA(At, 1, 1); PG8_STAGE(PG8_SB(1, 0), b3, voffB); PG8_STAGE(PG8_SB(1, 1), b3 + hstep, voffB); PG8_STAGE(PG8_SA(1, 0), a3, voffA);
            PG8_WAIT_V(8); PG8_WAIT_L(0); PG8_BAR; PG8_MMA(1, 0, At, B0); PG8_MMA(1, 1, At, B1); PG8_BAR; PG8_SCHED;
            } else {
            PG8_LDB(B0, 0, 0); PG8_SCHED; PG8_LDA(At, 0, 0); PG8_STAGE(PG8_SA(1, 1), a1 + hstep, voffA);
            PG8_WAIT_L(8); PG8_BAR; PG8_WAIT_L(0); PG8_MMA(0, 0, At, B0); PG8_BAR; PG8_SCHED;
            PG8_LDB(B1, 0, 1); PG8_STAGE(PG8_SB(0, 0), b2, voffB);
            PG8_BAR; PG8_WAIT_L(0); PG8_MMA(0, 1, At, B1); PG8_BAR;
            PG8_LDA(At, 0, 1); PG8_STAGE(PG8_SA(0, 0), a2, voffA);
            PG8_BAR; PG8_WAIT_L(0); PG8_MMA(1, 0, At, B0); PG8_BAR; PG8_SCHED;
            PG8_STAGE(PG8_SB(0, 1), b2 + hstep, voffB);
            PG8_WAIT_V(6); PG8_BAR; PG8_MMA(1, 1, At, B1); PG8_BAR;
            PG8_LDB(B0, 1, 0); PG8_SCHED; PG8_LDA(At, 1, 0); PG8_STAGE(PG8_SA(0, 1), a2 + hstep, voffA);
            PG8_WAIT_L(8); PG8_BAR; PG8_WAIT_L(0); PG8_MMA(0, 0, At, B0); PG8_BAR; PG8_SCHED;
            PG8_LDB(B1, 1, 1); PG8_STAGE(PG8_SB(1, 0), b3, voffB);
            PG8_BAR; PG8_WAIT_L(0); PG8_MMA(0, 1, At, B1); PG8_BAR;
            PG8_LDA(At, 1, 1); PG8_STAGE(PG8_SA(1, 0), a3, voffA);
            PG8_BAR; PG8_WAIT_L(0); PG8_MMA(1, 0, At, B0); PG8_BAR; PG8_SCHED;
            PG8_STAGE(PG8_SB(1, 1), b3 + hstep, voffB);
            PG8_WAIT_V(6); PG8_BAR; PG8_MMA(1, 1, At, B1); PG8_BAR;
            }
        }
        if constexpr (ALIGN_EPI) { if (wr == 0) PG8_BAR; }
        if constexpr (!Epi::AFTER_DRAIN) { if constexpr (Epi::HAS_PRE) E(acc, cur, wr, wc, fr, fq, pre, has_next, nxt); else E(acc, cur, wr, wc, fr, fq); S.done(cur); }
        if (!has_next) break;
#pragma unroll
        for (int a = 0; a < 2; ++a)
#pragma unroll
            for (int b = 0; b < 2; ++b)
#pragma unroll
                for (int m = 0; m < 4; ++m)
#pragma unroll
                    for (int n = 0; n < 2; ++n) acc[a][b][m][n] = (f32x4){0.f, 0.f, 0.f, 0.f};
        cur = nxt; cA = nA; cB = nB; ++ui;
        if constexpr (ALIGN_EPI) { if (wr == 1) PG8_BAR; }
    }
    PG8_WAIT_V(0);
    if constexpr (!ALIGN_EPI) { if (wr == 0) PG8_BAR; }
    PG8_BAR;
    if constexpr (Epi::AFTER_DRAIN) { E.fused(acc, cur, wr, wc, fr, fq, lds, wid, lane); S.done(cur); }
#undef PG8_SA
#undef PG8_SB
#undef PG8_STAGE
#undef PG8_LDA
#undef PG8_LDB
#undef PG8_MMA
#undef PG8_WAIT_V
#undef PG8_WAIT_L
#undef PG8_BAR
#undef PG8_SCHED
}
}
#include <cmath>
constexpr int NWAVES = 8, NTHR = 512;
constexpr int BATCH = 16, SEQ = 2048, M = BATCH * SEQ, D = 1024, FF = 4096, NAB = 3840, NC = 3072, ABP_OLD = 3672;
constexpr int C_QA = 0, C_KA = 512, C_VA = 1024, C_IQ = 1536, C_QB = 2048, C_KB = 2304, C_VB = 2560, C_OG = 3072, C_IK = 3584, C_IW = 3648, C_GL = 3656;
constexpr float EPS = 1e-6f;
constexpr size_t MiB = 1u << 20;
constexpr size_t WS_CTL = 0, CTL_ZERO_BYTES = 64 * 1024;
constexpr size_t WS_WAB = 1 * MiB, WS_WOAB = 9 * MiB, WS_WUP0 = 11 * MiB, WS_WDN0 = 19 * MiB, WS_WINC = 27 * MiB, WS_WOC = 33 * MiB, WS_WUP1 = 35 * MiB, WS_WDN1 = 43 * MiB;
constexpr size_t WS_SSQ = 51 * MiB, SSQ_BYTES = 2 * MiB;
constexpr size_t WS_DEC = 59 * MiB;
constexpr size_t WS_ROPE = 59 * MiB + 512 * 1024;
constexpr size_t WS_XB = 60 * MiB;
constexpr size_t WS_CAT = 124 * MiB;
constexpr size_t WS_MASK = 188 * MiB;
constexpr size_t WS_R1 = 196 * MiB;
constexpr size_t WS_BC = 452 * MiB;
constexpr size_t WS_FS = 484 * MiB;
constexpr size_t WS_END = 492 * MiB;
constexpr int CW_BAR = 4096;
constexpr int RING_BYTES = 131072;
constexpr int LDS_BYTES = 163840;
constexpr int MISC_OFF = LDS_BYTES - 256;
#define GAS __attribute__((address_space(1)))
#define LAS __attribute__((address_space(3)))
typedef unsigned short bf16;
typedef unsigned v4u __attribute__((ext_vector_type(4)));
typedef float f32x4 __attribute__((ext_vector_type(4)));
typedef short bf16x8 __attribute__((ext_vector_type(8)));
typedef GAS unsigned gu32;
typedef GAS unsigned long long gu64;
#define RLX_AGENT __ATOMIC_RELAXED, __HIP_MEMORY_SCOPE_AGENT
#define LDS_WAIT() asm volatile("s_waitcnt lgkmcnt(0)" ::: "memory")
#define VM_WAIT() asm volatile("s_waitcnt vmcnt(0)" ::: "memory")
__device__ __forceinline__ unsigned long long rt() { return __builtin_amdgcn_s_memrealtime(); }
__device__ __forceinline__ unsigned f2bf(float f) { unsigned u = __builtin_bit_cast(unsigned, f); return (u + 0x7fffu + ((u >> 16) & 1u)) >> 16; }
__device__ __forceinline__ unsigned pk2(float lo, float hi) { return f2bf(lo) | (f2bf(hi) << 16); }
#define XB_TMO      128
#define XB_XCNT(j)  (256  + 64 * (j))
#define XB_XSUB(j)  (1280 + 64 * (j))
#define XB_XGEN(j)  (2304 + 64 * (j))
#define XB_TOP      3328
#define XB_TOPGEN   3392
#define XCD_BAR_WORDS 3456
#define XB_SPIN_CAP (1u << 18)

__device__ __forceinline__ unsigned xb_ld(unsigned* p)              { return __hip_atomic_load(p, __ATOMIC_RELAXED, __HIP_MEMORY_SCOPE_AGENT); }
__device__ __forceinline__ unsigned xb_add(unsigned* p, unsigned v) { return __hip_atomic_fetch_add(p, v, __ATOMIC_RELAXED, __HIP_MEMORY_SCOPE_AGENT); }
__device__ __forceinline__ unsigned xb_xcc_id() { return (unsigned)__builtin_amdgcn_s_getreg((3 << 11) | 20) & 0xFu; }
#define XB_SPIN(cond, bar) do { unsigned _sp = 0; while (cond) { __builtin_amdgcn_s_sleep(1); \
    if ((++_sp & 255u) == 0u) { if (xb_ld(&(bar)[XB_TMO])) break; if (_sp > XB_SPIN_CAP) { atomicAdd(&(bar)[XB_TMO], 1u); break; } } } } while (0)

struct XcdBarrier {
    unsigned* bar; unsigned x; int wave;
    volatile LAS unsigned* st;
};

__device__ __forceinline__ bool xb_t0(int wave) { return wave == 0 && __builtin_amdgcn_mbcnt_hi(~0u, __builtin_amdgcn_mbcnt_lo(~0u, 0u)) == 0u; }
__device__ __forceinline__ XcdBarrier xcd_barrier_post(unsigned* bar, volatile LAS unsigned* st, int wave) {
    XcdBarrier b; b.bar = bar; b.x = xb_xcc_id(); b.st = st; b.wave = wave;
    if (xb_t0(wave)) (void)xb_add(&bar[XB_XCNT(b.x)], 1u);
    return b;
}
__device__ __forceinline__ void xcd_barrier_complete(unsigned* bar, unsigned x, unsigned& nloc, unsigned& nx) {
    const unsigned G = gridDim.x * gridDim.y * gridDim.z;
    unsigned sum, cnt, mine, sp = 0u;
    for (;;) {
        sum = 0u; cnt = 0u; mine = 0u;
#pragma unroll
        for (unsigned j = 0; j < 16; ++j) { const unsigned c = xb_ld(&bar[XB_XCNT(j)]); sum += c; cnt += (c > 0u) ? 1u : 0u; mine = (j == x) ? c : mine; }
        if (sum == G) break;
        __builtin_amdgcn_s_sleep(1);
        if ((++sp & 255u) == 0u) { if (xb_ld(&bar[XB_TMO])) break; if (sp > XB_SPIN_CAP) { atomicAdd(&bar[XB_TMO], 1u); break; } }
    }
    nloc = mine > 0u ? mine : 1u; nx = cnt > 0u ? cnt : 1u;
}

__device__ __forceinline__ void xcd_barrier(const XcdBarrier& b) {
    asm volatile("s_waitcnt vmcnt(0)" ::: "memory");
    __syncthreads();
    if (xb_t0(b.wave)) {
        unsigned* bar = b.bar;
        __builtin_amdgcn_s_waitcnt(0);
        unsigned nloc = b.st[0], nx = b.st[1];
        if (nloc == 0u) { xcd_barrier_complete(bar, b.x, nloc, nx); b.st[0] = nloc; b.st[1] = nx; }
        const unsigned old = xb_add(&bar[XB_XSUB(b.x)], 1u);
        const unsigned gen = old / nloc;
        if (old + 1u == (gen + 1u) * nloc) {
            __builtin_amdgcn_fence(__ATOMIC_RELEASE, "agent");
            asm volatile("s_waitcnt vmcnt(0)" ::: "memory");
            const unsigned og = xb_add(&bar[XB_TOP], 1u);
            const unsigned tg = og / nx;
            if (og + 1u == (tg + 1u) * nx) xb_add(&bar[XB_TOPGEN], 1u);
            else XB_SPIN(xb_ld(&bar[XB_TOPGEN]) == tg, bar);
            __builtin_amdgcn_fence(__ATOMIC_ACQUIRE, "agent");
            xb_add(&bar[XB_XGEN(b.x)], 1u);
            asm volatile("s_waitcnt vmcnt(0)" ::: "memory");
        } else {
            XB_SPIN(xb_ld(&bar[XB_XGEN(b.x)]) == gen, bar);
            __builtin_amdgcn_fence(__ATOMIC_ACQUIRE, "agent");
            asm volatile("s_waitcnt vmcnt(0)" ::: "memory");
        }
    }
    __syncthreads();
}
#ifdef PROBE_ACC
#ifdef PROBE_NOSYNC
#define ACC_BEGIN(F, id) do { if ((id) == PROBE_ACC) { asm volatile("" ::: "memory"); (F).acc_t0 = __builtin_amdgcn_s_memrealtime(); asm volatile("" ::: "memory"); } } while (0)
#define ACC_END(F, id) do { if ((id) == PROBE_ACC) { asm volatile("" ::: "memory"); (F).acc_sum += __builtin_amdgcn_s_memrealtime() - (F).acc_t0; asm volatile("" ::: "memory"); } } while (0)
#else
#define ACC_BEGIN(F, id) do { if ((id) == PROBE_ACC) { __syncthreads(); (F).acc_t0 = __builtin_amdgcn_s_memrealtime(); } } while (0)
#define ACC_END(F, id) do { if ((id) == PROBE_ACC) { __syncthreads(); (F).acc_sum += __builtin_amdgcn_s_memrealtime() - (F).acc_t0; } } while (0)
#endif
#else
#define ACC_BEGIN(F, id) do { } while (0)
#define ACC_END(F, id) do { } while (0)
#endif
struct Frame {
#ifdef PROBE_ACC
    unsigned long long acc_t0, acc_sum;
#endif
    LAS unsigned char* lds;
    volatile LAS unsigned* MISC;
    gu32* ctl;
    int tid, lane, wave, vcu, G;
    const float *x, *g_mix, *g_ffn, *w_in_ab, *gq_a, *gk_a, *w_gate_up, *b_gate, *g_gla, *w_out_ab, *w_in_c, *gq_c, *gk_c, *w_out_c, *w_up, *w_down;
    float* out;
    bf16 *Wab, *Woab, *Wup0, *Wdn0, *Winc, *Woc, *Wup1, *Wdn1;
    bf16 *XB, *CAT, *R1;
    float* SSQ; unsigned* MASK;
};
__device__ __forceinline__ int lane_id_opaque() { int l; asm volatile("v_mbcnt_lo_u32_b32 %0, -1, 0\n\tv_mbcnt_hi_u32_b32 %0, -1, %0" : "=v"(l)); return l; }
__device__ __forceinline__ float bf2f(bf16 v) { return __builtin_bit_cast(float, (unsigned)v << 16); }
__device__ __forceinline__ float wave_sum(float v) {
#pragma unroll
    for (int o = 1; o < 64; o <<= 1) v += __shfl_xor(v, o);
    return v;
}
__device__ __forceinline__ float wave_max(float v) {
#pragma unroll
    for (int o = 1; o < 64; o <<= 1) v = fmaxf(v, __shfl_xor(v, o));
    return v;
}
__device__ __forceinline__ float log_sigmoid(float x) { return fminf(x, 0.f) - log1pf(expf(-fabsf(x))); }

__device__ __forceinline__ int oldcol_ab(int n) {
    if (n < 2048) return n;
    if (n < 2304) return 2120 + (n - 2048);
    if (n < 2560) return 2376 + (n - 2304);
    if (n < 3072) return 2632 + (n - 2560);
    if (n < 3584) return 3160 + (n - 3072);
    if (n < 3648) return 2048 + (n - 3584);
    if (n < 3656) return 2112 + (n - 3648);
    if (n < 3672) return 3144 + (n - 3656);
    return -1;
}
__device__ __forceinline__ void p0_transpose_item(const float* W, int ldw, int K, const float* gain, bf16* WT, bool map, int item, int nblk, int lane) {
    const int kb = item / nblk, nb = item % nblk, ng = lane & 7, ko = lane >> 3, k0 = 64 * kb + 8 * ko, n = 32 * nb + 4 * ng;
    const int oc = map ? oldcol_ab(n) : n;
    f32x4 v[8];
#pragma unroll
    for (int i = 0; i < 8; ++i) { v[i] = (f32x4){0.f, 0.f, 0.f, 0.f}; if (oc >= 0) v[i] = __builtin_nontemporal_load((const GAS f32x4*)(W + (size_t)(k0 + i) * ldw + oc)); }
    if (gain) { const f32x4 g0 = *(const GAS f32x4*)(gain + k0), g1 = *(const GAS f32x4*)(gain + k0 + 4);
#pragma unroll
        for (int i = 0; i < 4; ++i) { v[i] = v[i] * g0[i]; v[4 + i] = v[4 + i] * g1[i]; } }
#pragma unroll
    for (int e = 0; e < 4; ++e) { v4u o; o.x = pk2(v[0][e], v[1][e]); o.y = pk2(v[2][e], v[3][e]); o.z = pk2(v[4][e], v[5][e]); o.w = pk2(v[6][e], v[7][e]);
        *(GAS v4u*)(WT + (size_t)(n + e) * K + k0) = o; }
}
template <int PART> __device__ __forceinline__ void prologue_weights(Frame& F, int gw, int NGW) {
    constexpr int I_AB = (D / 64) * (NAB / 32), I_O = (D / 64) * (D / 32), I_UP = (D / 64) * (FF / 32), I_DN = (FF / 64) * (D / 32), I_C = (D / 64) * (NC / 32);
    if (PART == 0) { for (int it = gw; it < I_AB; it += NGW) p0_transpose_item(F.w_in_ab, ABP_OLD, D, F.g_mix, F.Wab, true, it, NAB / 32, F.lane); return; }
    constexpr int NITEMS = 2 * I_O + 2 * I_UP + 2 * I_DN + I_C;
    for (int it = gw; it < NITEMS; it += NGW) {
        int r = it;
        if (r < I_O) { p0_transpose_item(F.w_out_ab, D, D, nullptr, F.Woab, false, r, D / 32, F.lane); continue; } r -= I_O;
        if (r < I_UP) { p0_transpose_item(F.w_up, FF, D, F.g_ffn, F.Wup0, false, r, FF / 32, F.lane); continue; } r -= I_UP;
        if (r < I_DN) { p0_transpose_item(F.w_down, D, FF, nullptr, F.Wdn0, false, r, D / 32, F.lane); continue; } r -= I_DN;
        if (r < I_C) { p0_transpose_item(F.w_in_c, NC, D, F.g_mix + D, F.Winc, false, r, NC / 32, F.lane); continue; } r -= I_C;
        if (r < I_O) { p0_transpose_item(F.w_out_c, D, D, nullptr, F.Woc, false, r, D / 32, F.lane); continue; } r -= I_O;
        if (r < I_UP) { p0_transpose_item(F.w_up + (size_t)D * FF, FF, D, F.g_ffn + D, F.Wup1, false, r, FF / 32, F.lane); continue; } r -= I_UP;
        p0_transpose_item(F.w_down + (size_t)FF * D, D, FF, nullptr, F.Wdn1, false, r, D / 32, F.lane);
    }
}
#define XLOAD(p) __builtin_nontemporal_load(p)
__device__ __forceinline__ void p0ab_load(Frame& F, int item, f32x4 (&v)[8], f32x4& g0, f32x4& g1) {
    constexpr int nblk = NAB / 32; const int lane = F.lane;
    const int kb = item / nblk, nb = item % nblk, ng = lane & 7, ko = lane >> 3, k0 = 64 * kb + 8 * ko, n = 32 * nb + 4 * ng, oc = oldcol_ab(n);
#pragma unroll
    for (int i = 0; i < 8; ++i) { v[i] = (f32x4){0.f, 0.f, 0.f, 0.f}; if (oc >= 0) v[i] = __builtin_nontemporal_load((const GAS f32x4*)(F.w_in_ab + (size_t)(k0 + i) * ABP_OLD + oc)); }
    g0 = *(const GAS f32x4*)(F.g_mix + k0); g1 = *(const GAS f32x4*)(F.g_mix + k0 + 4);
}
__device__ __forceinline__ void p0ab_store(Frame& F, int item, f32x4 (&v)[8], const f32x4 g0, const f32x4 g1) {
    constexpr int nblk = NAB / 32; const int lane = F.lane;
    const int kb = item / nblk, nb = item % nblk, ng = lane & 7, ko = lane >> 3, k0 = 64 * kb + 8 * ko, n = 32 * nb + 4 * ng;
#pragma unroll
    for (int i = 0; i < 4; ++i) { v[i] = v[i] * g0[i]; v[4 + i] = v[4 + i] * g1[i]; }
#pragma unroll
    for (int e = 0; e < 4; ++e) { v4u o; o.x = pk2(v[0][e], v[1][e]); o.y = pk2(v[2][e], v[3][e]); o.z = pk2(v[4][e], v[5][e]); o.w = pk2(v[6][e], v[7][e]);
        *(GAS v4u*)(F.Wab + (size_t)(n + e) * D + k0) = o; }
}
__device__ __forceinline__ void ph_prologue(Frame& F) {
    const int gw = F.vcu * NWAVES + F.wave, NGW = F.G * NWAVES;
    constexpr int I_AB0 = (D / 64) * (NAB / 32);
    f32x4 wv[8], wg0, wg1; const bool witem = gw < I_AB0;
    if (witem) p0ab_load(F, gw, wv, wg0, wg1);
    bool wpending = witem;
    if (F.G != 256) prologue_weights<1>(F, gw, NGW);
#define P0_XLOAD(V, G) do { _Pragma("unroll") for (int r = 0; r < 4; ++r) { const int m = gw + (4 * (G) + r) * NGW; const GAS f32x4* xr = (const GAS f32x4*)(F.x + (size_t)(m < M ? m : gw) * D) + F.lane; \
        _Pragma("unroll") for (int j = 0; j < 4; ++j) V[r][j] = XLOAD(xr + 64 * j); } } while (0)
#define P0_XPROC(V, G) do { float s[4]; \
        _Pragma("unroll") for (int r = 0; r < 4; ++r) { float t = 0.f; \
            _Pragma("unroll") for (int j = 0; j < 4; ++j) t += (V[r][j].x * V[r][j].x + V[r][j].y * V[r][j].y) + (V[r][j].z * V[r][j].z + V[r][j].w * V[r][j].w); \
            s[r] = t; } \
        _Pragma("unroll") for (int o = 1; o < 64; o <<= 1) { _Pragma("unroll") for (int r = 0; r < 4; ++r) s[r] += __shfl_xor(s[r], o); } \
        _Pragma("unroll") for (int r = 0; r < 4; ++r) { const int m = gw + (4 * (G) + r) * NGW; if (m < M) { \
            GAS unsigned long long* o8 = (GAS unsigned long long*)(F.XB + (size_t)m * D) + F.lane; \
            _Pragma("unroll") for (int j = 0; j < 4; ++j) o8[64 * j] = (unsigned long long)pk2(V[r][j].x, V[r][j].y) | ((unsigned long long)pk2(V[r][j].z, V[r][j].w) << 32); \
            if (F.lane < 16) F.SSQ[(size_t)m * 16 + F.lane] = (F.lane == 0) ? s[r] : 0.f; } } } while (0)
    { const int ng = (gw < M) ? (M - gw + 4 * NGW - 1) / (4 * NGW) : 0;
      f32x4 va[4][4], vb[4][4];
      if (ng > 0) P0_XLOAD(va, 0);
      if (ng > 1) P0_XLOAD(vb, 1);
      if (wpending) { p0ab_store(F, gw, wv, wg0, wg1); wpending = false; }
      for (int g = 0; g < ng; g += 2) {
          P0_XPROC(va, g); if (g + 2 < ng) P0_XLOAD(va, g + 2);
          if (g + 1 < ng) { P0_XPROC(vb, g + 1); if (g + 3 < ng) P0_XLOAD(vb, g + 3); }
      } }
#undef P0_XLOAD
#undef P0_XPROC
    if (wpending) p0ab_store(F, gw, wv, wg0, wg1);
    for (int it = gw + NGW; it < I_AB0; it += NGW) p0_transpose_item(F.w_in_ab, ABP_OLD, D, F.g_mix, F.Wab, true, it, NAB / 32, F.lane);
}
namespace att {
typedef short s16x4 __attribute__((ext_vector_type(4)));
typedef float f32x16 __attribute__((ext_vector_type(16)));
typedef _Float16 f16x8 __attribute__((ext_vector_type(8)));
typedef unsigned u32x4 __attribute__((ext_vector_type(4)));
typedef short v4i16_t __attribute__((ext_vector_type(4)));
constexpr float C2 = 0.08838834764831845f * 1.4426950408889634f;
__device__ __forceinline__ int crow(int r, int hi) { return (r & 3) + 8 * (r >> 2) + 4 * hi; }
__device__ __forceinline__ int img_off(int row, int ch) { return 256 * row + 16 * (ch ^ (((row & 3) << 2) | ((row >> 2) & 3))); }
__device__ __forceinline__ bf16x8 pack8(float a0, float a1, float a2, float a3, float a4, float a5, float a6, float a7) {
    u32x4 w; w.x = pg8::cvt_pk_bf16(a0, a1); w.y = pg8::cvt_pk_bf16(a2, a3); w.z = pg8::cvt_pk_bf16(a4, a5); w.w = pg8::cvt_pk_bf16(a6, a7);
    return __builtin_bit_cast(bf16x8, w);
}
__device__ __forceinline__ f16x8 pack8h(float a0, float a1, float a2, float a3, float a4, float a5, float a6, float a7) {
    f16x8 r; r[0] = (_Float16)a0; r[1] = (_Float16)a1; r[2] = (_Float16)a2; r[3] = (_Float16)a3; r[4] = (_Float16)a4; r[5] = (_Float16)a5; r[6] = (_Float16)a6; r[7] = (_Float16)a7; return r;
}
__device__ __forceinline__ void dma_off_init(unsigned (&dvo)[2], int ld, int wave, int lane) {
#pragma unroll
    for (int i = 0; i < 2; ++i) { const int pi = 2 * wave + i, row = 4 * pi + (lane >> 4), pc = lane & 15, ch = pc ^ (((row & 3) << 2) | ((row >> 2) & 3)); dvo[i] = (unsigned)(row * ld + ch * 8) * 2u; }
}
__device__ __forceinline__ void tile_dma(const bf16* g, const unsigned (&dvo)[2], LAS unsigned char* buf, int wave) {
#pragma unroll
    for (int i = 0; i < 2; ++i) __builtin_amdgcn_global_load_lds((const unsigned*)((const char*)g + dvo[i]), (LAS unsigned*)(buf + 1024 * (2 * wave + i)), 16, 0, 0);
}
struct FragOff { int k[8]; int va[4]; int vd; };
__device__ __forceinline__ void frag_off_init(FragOff& fo, int lane) {
    const int hi = lane >> 5, r32 = lane & 31, i = lane & 15, q = i >> 2, p = i & 3, x = 2 * ((lane >> 4) & 1) + (p >> 1);
#pragma unroll
    for (int ks = 0; ks < 8; ++ks) fo.k[ks] = img_off(r32, 2 * ks + hi);
#pragma unroll
    for (int ct = 0; ct < 4; ++ct) fo.va[ct] = img_off(4 * hi + q, 4 * ct + x) + 8 * (p & 1);
    fo.vd = img_off(4 * hi + q + 8, x) - img_off(4 * hi + q, x);
}
__device__ __forceinline__ bf16x8 k_frag(const LAS unsigned char* kbuf, const FragOff& fo, int rt, int ks) { return *(const LAS bf16x8*)(kbuf + fo.k[ks] + 8192 * rt); }
__device__ __forceinline__ s16x4 vtr(const LAS unsigned char* p) { return __builtin_bit_cast(s16x4, __builtin_amdgcn_ds_read_tr16_b64_v4i16((LAS v4i16_t*)p)); }
__device__ __forceinline__ bf16x8 v_frag(const LAS unsigned char* vbuf, const FragOff& fo, int ct, int kk) {
    const s16x4 lo = vtr(vbuf + fo.va[ct] + 4096 * kk), hh = vtr(vbuf + fo.va[ct] + fo.vd + 4096 * kk);
    return (bf16x8){lo[0], lo[1], lo[2], lo[3], hh[0], hh[1], hh[2], hh[3]};
}
#define TR_READ(dst, addr, OFF) asm volatile("ds_read_b64_tr_b16 %0, %1 offset:%c2" : "=&v"(dst) : "v"(addr), "i"(OFF) : "memory")
#define LGKM_WAIT0() do { asm volatile("s_waitcnt lgkmcnt(0)" ::: "memory"); __builtin_amdgcn_sched_barrier(0); } while (0)
__device__ __forceinline__ bf16x8 mk_frag(s16x4 lo, s16x4 hh) { return (bf16x8){lo[0], lo[1], lo[2], lo[3], hh[0], hh[1], hh[2], hh[3]}; }
__device__ __forceinline__ int frag_va(int lane, int ct) { const int hi = lane >> 5, i = lane & 15, q = i >> 2, p = i & 3, x = 2 * ((lane >> 4) & 1) + (p >> 1); return img_off(4 * hi + q, 4 * ct + x) + 8 * (p & 1); }
__device__ __forceinline__ bf16x8 v_frag_rt(const LAS unsigned char* vbuf, int va, int vd, int kk) {
    const s16x4 lo = vtr(vbuf + va + 4096 * kk), hh = vtr(vbuf + va + vd + 4096 * kk);
    return (bf16x8){lo[0], lo[1], lo[2], lo[3], hh[0], hh[1], hh[2], hh[3]};
}
__device__ __forceinline__ void store_o(const f32x16 (&o)[4], const float (&rscale)[16], LAS unsigned char* stg, bf16* dst, int ld, int lane) {
    const int hi = lane >> 5, r32 = lane & 31;
#pragma unroll
    for (int r = 0; r < 16; ++r) { const int orow = crow(r, hi);
#pragma unroll
        for (int ct = 0; ct < 4; ++ct) *(LAS bf16*)(stg + orow * 256 + (32 * ct + r32) * 2) = (bf16)f2bf(o[ct][r] * rscale[r]); }
    asm volatile("s_waitcnt lgkmcnt(0)" ::: "memory");
#pragma unroll
    for (int i = 0; i < 8; ++i) { const int c = lane + 64 * i, row = c >> 4, ch = c & 15; const u32x4 v = *(const LAS u32x4*)(stg + row * 256 + ch * 16); *(u32x4*)(dst + (size_t)row * ld + ch * 8) = v; }
}
}
__device__ __forceinline__ void sb_unit(Frame& F, int b, int h, int qb) {
    using namespace att;
    const int tid = F.tid, lane = F.lane, w = F.wave, hi = lane >> 5, r32 = lane & 31;
    const bf16* Qg = F.R1 + (size_t)b * SEQ * NC + h * 128; const bf16* Kg = Qg + 1024; const bf16* Vg = Qg + 2048;
    const int T0 = qb * 256, t0w = T0 + 32 * w, jd = t0w >> 6, jtop = (T0 >> 6) + 3, tl = 32 * (w & 1) + r32, tl4 = tl - 4 * hi;
    LAS unsigned char* lds = F.lds;
    FragOff fo; frag_off_init(fo, lane);
    unsigned dvo[2]; dma_off_init(dvo, NC, w, lane);
    bf16x8 qf[8];
#pragma unroll
    for (int ks = 0; ks < 8; ++ks) qf[ks] = *(const bf16x8*)(Qg + (size_t)(t0w + r32) * NC + 16 * ks + 8 * hi);
    f16x8 T0f, T1f, ONEf;
#pragma unroll
    for (int j = 0; j < 8; ++j) { const int kp = 8 * (j >> 2) + 4 * hi + (j & 3); T0f[j] = (kp >= r32) ? (_Float16)1.0f : (_Float16)0.0f; T1f[j] = (kp + 16 >= r32) ? (_Float16)1.0f : (_Float16)0.0f; ONEf[j] = (_Float16)1.0f; }
    f32x16 o[4];
#pragma unroll
    for (int ct = 0; ct < 4; ++ct)
#pragma unroll
        for (int r = 0; r < 16; ++r) o[ct][r] = 0.f;
    float R2 = 0.f; bool done = false;
    volatile LAS unsigned* flags = F.MISC + 16;
    tile_dma(Kg + (size_t)(64 * jtop) * NC, dvo, lds, w); tile_dma(Vg + (size_t)(64 * jtop) * NC, dvo, lds + 16384, w);
    asm volatile("s_waitcnt vmcnt(0)" ::: "memory");
    __syncthreads();
    for (int j = jtop; j >= 0; --j) {
        const int cur = (jtop - j) & 1;
        const LAS unsigned char* kb = lds + cur * 32768; const LAS unsigned char* vb = kb + 16384;
        if (j > 0) { tile_dma(Kg + (size_t)(64 * (j - 1)) * NC, dvo, lds + (cur ^ 1) * 32768, w); tile_dma(Vg + (size_t)(64 * (j - 1)) * NC, dvo, lds + (cur ^ 1) * 32768 + 16384, w); }
        if (j <= jd && !done) {
            f32x16 p0, p1;
#pragma unroll
            for (int r = 0; r < 16; ++r) { p0[r] = 0.f; p1[r] = 0.f; }
            { bf16x8 kf[8];
#pragma unroll
              for (int ks = 0; ks < 8; ++ks) kf[ks] = k_frag(kb, fo, 0, ks);
#pragma unroll
              for (int ks = 0; ks < 8; ++ks) p0 = __builtin_amdgcn_mfma_f32_32x32x16_bf16(kf[ks], qf[ks], p0, 0, 0, 0);
#pragma unroll
              for (int ks = 0; ks < 8; ++ks) kf[ks] = k_frag(kb, fo, 1, ks);
#pragma unroll
              for (int ks = 0; ks < 8; ++ks) p1 = __builtin_amdgcn_mfma_f32_32x32x16_bf16(kf[ks], qf[ks], p1, 0, 0, 0); }
            s16x4 vl[4], vh[4], wl[4], wh[4];
            unsigned va0[4], va1[4];
#pragma unroll
            for (int ct = 0; ct < 4; ++ct) { va0[ct] = (unsigned)(size_t)vb + (unsigned)fo.va[ct]; va1[ct] = va0[ct] + (unsigned)fo.vd; }
            const bool diag = (j == jd);
            float x0[16], x1[16]; float rs = 0.f;
#pragma unroll
            for (int r = 0; r < 16; ++r) { const int key = (r & 3) + 8 * (r >> 2);
                float l0 = -__builtin_amdgcn_logf(1.0f + __builtin_amdgcn_exp2f(p0[r])), l1 = -__builtin_amdgcn_logf(1.0f + __builtin_amdgcn_exp2f(p1[r]));
                if (diag) { if (!(key < tl4)) l0 = 0.f; if (!(key + 32 < tl4)) l1 = 0.f; }
                x0[r] = l0; x1[r] = l1; rs += l0 + l1; p0[r] += R2; p1[r] += R2; }
            const f16x8 xb00 = pack8h(x0[0], x0[1], x0[2], x0[3], x0[4], x0[5], x0[6], x0[7]), xb01 = pack8h(x0[8], x0[9], x0[10], x0[11], x0[12], x0[13], x0[14], x0[15]);
            const f16x8 xb10 = pack8h(x1[0], x1[1], x1[2], x1[3], x1[4], x1[5], x1[6], x1[7]), xb11 = pack8h(x1[8], x1[9], x1[10], x1[11], x1[12], x1[13], x1[14], x1[15]);
            p0 = __builtin_amdgcn_mfma_f32_32x32x16_f16(T0f, xb00, p0, 0, 0, 0); p0 = __builtin_amdgcn_mfma_f32_32x32x16_f16(T1f, xb01, p0, 0, 0, 0);
            p0 = __builtin_amdgcn_mfma_f32_32x32x16_f16(ONEf, xb10, p0, 0, 0, 0); p0 = __builtin_amdgcn_mfma_f32_32x32x16_f16(ONEf, xb11, p0, 0, 0, 0);
            p1 = __builtin_amdgcn_mfma_f32_32x32x16_f16(T0f, xb10, p1, 0, 0, 0); p1 = __builtin_amdgcn_mfma_f32_32x32x16_f16(T1f, xb11, p1, 0, 0, 0);
#pragma unroll
            for (int r = 0; r < 16; ++r) { const int key = (r & 3) + 8 * (r >> 2);
                float a0 = __builtin_amdgcn_exp2f(p0[r]), a1 = __builtin_amdgcn_exp2f(p1[r]);
                if (diag) { if (!(key < tl4)) a0 = 0.f; if (!(key + 32 < tl4)) a1 = 0.f; }
                p0[r] = a0; p1[r] = a1; }
            const bf16x8 pa0 = pack8(p0[0], p0[1], p0[2], p0[3], p0[4], p0[5], p0[6], p0[7]), pa1 = pack8(p0[8], p0[9], p0[10], p0[11], p0[12], p0[13], p0[14], p0[15]);
            const bf16x8 pa2 = pack8(p1[0], p1[1], p1[2], p1[3], p1[4], p1[5], p1[6], p1[7]), pa3 = pack8(p1[8], p1[9], p1[10], p1[11], p1[12], p1[13], p1[14], p1[15]);
#pragma unroll
            for (int ct = 0; ct < 4; ++ct) { TR_READ(vl[ct], va0[ct], 0); TR_READ(vh[ct], va1[ct], 0); }
            LGKM_WAIT0();
#pragma unroll
            for (int ct = 0; ct < 4; ++ct) { TR_READ(wl[ct], va0[ct], 4096); TR_READ(wh[ct], va1[ct], 4096); }
#pragma unroll
            for (int ct = 0; ct < 4; ++ct) o[ct] = __builtin_amdgcn_mfma_f32_32x32x16_bf16(pa0, mk_frag(vl[ct], vh[ct]), o[ct], 0, 0, 0);
            LGKM_WAIT0();
#pragma unroll
            for (int ct = 0; ct < 4; ++ct) { TR_READ(vl[ct], va0[ct], 8192); TR_READ(vh[ct], va1[ct], 8192); }
#pragma unroll
            for (int ct = 0; ct < 4; ++ct) o[ct] = __builtin_amdgcn_mfma_f32_32x32x16_bf16(pa1, mk_frag(wl[ct], wh[ct]), o[ct], 0, 0, 0);
            LGKM_WAIT0();
#pragma unroll
            for (int ct = 0; ct < 4; ++ct) { TR_READ(wl[ct], va0[ct], 12288); TR_READ(wh[ct], va1[ct], 12288); }
#pragma unroll
            for (int ct = 0; ct < 4; ++ct) o[ct] = __builtin_amdgcn_mfma_f32_32x32x16_bf16(pa2, mk_frag(vl[ct], vh[ct]), o[ct], 0, 0, 0);
            LGKM_WAIT0();
#pragma unroll
            for (int ct = 0; ct < 4; ++ct) o[ct] = __builtin_amdgcn_mfma_f32_32x32x16_bf16(pa3, mk_frag(wl[ct], wh[ct]), o[ct], 0, 0, 0);
            rs += __shfl_xor(rs, 32);
            R2 += rs;
            done = __all(R2 < -152.0f);
        }
        if (lane == 0) flags[cur * 8 + w] = done ? 1u : 0u;
        asm volatile("s_waitcnt vmcnt(0) lgkmcnt(0)" ::: "memory");
        __syncthreads();
        unsigned alld = 1u;
#pragma unroll
        for (int i = 0; i < 8; ++i) alld &= flags[cur * 8 + i];
        if (alld) break;
    }
    float ones[16];
#pragma unroll
    for (int r = 0; r < 16; ++r) ones[r] = 1.0f;
    store_o(o, ones, lds + w * 8192, F.CAT + (size_t)(b * SEQ + t0w) * D + h * 128, D, lane);
    __syncthreads();
}
__device__ __forceinline__ void ph_sb(Frame& F) {
    for (int v = F.vcu; v < BATCH * 8 * 2; v += F.G) {
        const int bh = v >> 1, half = v & 1;
#pragma unroll 1
        for (int i = 0; i < 4; ++i) { const int qb = half ? (i == 0 ? 1 : i == 1 ? 6 : i == 2 ? 2 : 5) : (i == 0 ? 0 : i == 1 ? 7 : i == 2 ? 3 : 4); sb_unit(F, bh >> 3, bh & 7, qb); }
    }
}
__device__ __forceinline__ void dsa_unit(Frame& F, int b, int h, int ub, float mref) {
    using namespace att;
    const int lane = F.lane, w = F.wave, hi = lane >> 5, r32 = lane & 31;
    const bf16* Qg = F.R1 + (size_t)b * SEQ * NAB + C_QA + h * 128; const bf16* Kg = F.R1 + (size_t)b * SEQ * NAB + C_KA + h * 128; const bf16* Vg = F.R1 + (size_t)b * SEQ * NAB + C_VA + h * 128;
    const int t0w = 256 * ub + 32 * w, cw = t0w >> 6, jlast = 4 * ub + 3;
    LAS unsigned char* lds = F.lds;
    LAS unsigned char* mst = lds + 65536 + w * 8448;
    FragOff fo; frag_off_init(fo, lane);
    unsigned dvo[2]; dma_off_init(dvo, NAB, w, lane);
    tile_dma(Kg, dvo, lds, w); tile_dma(Vg, dvo, lds + 16384, w);
    bf16x8 qf[8];
#pragma unroll
    for (int ks = 0; ks < 8; ++ks) qf[ks] = *(const bf16x8*)(Qg + (size_t)(t0w + r32) * NAB + 16 * ks + 8 * hi);
    { const unsigned* mg = F.MASK + (size_t)(b * SEQ + t0w) * 64;
#pragma unroll 2
      for (int i = 0; i < 8; ++i) { const int c = lane + 64 * i, row = c >> 4, c4 = c & 15; const u32x4 v = *(const u32x4*)(mg + row * 64 + c4 * 4);
          *(LAS unsigned long long*)(mst + row * 264 + c4 * 16) = (unsigned long long)v.x | ((unsigned long long)v.y << 32);
          *(LAS unsigned long long*)(mst + row * 264 + c4 * 16 + 8) = (unsigned long long)v.z | ((unsigned long long)v.w << 32); } }
    f32x16 o[4];
#pragma unroll
    for (int ct = 0; ct < 4; ++ct)
#pragma unroll
        for (int r = 0; r < 16; ++r) o[ct][r] = 0.f;
    float lsum = 0.f;
    asm volatile("s_waitcnt vmcnt(0) lgkmcnt(0)" ::: "memory");
    __syncthreads();
    const float nmref = -mref;
    for (int j = 0; j <= jlast; ++j) {
        const int cur = j & 1;
        const LAS unsigned char* kb = lds + cur * 32768; const LAS unsigned char* vb = kb + 16384;
        if (j < jlast) { tile_dma(Kg + (size_t)(64 * (j + 1)) * NAB, dvo, lds + (cur ^ 1) * 32768, w); tile_dma(Vg + (size_t)(64 * (j + 1)) * NAB, dvo, lds + (cur ^ 1) * 32768 + 16384, w); }
        if (j <= cw) {
            const unsigned long long mw = *(const LAS unsigned long long*)(mst + r32 * 264 + j * 8);
            const unsigned mw0 = (unsigned)mw, mw1 = (unsigned)(mw >> 32);
#pragma unroll 1
            for (int half = 0; half < 2; ++half) {
                const unsigned mwh = (half ? mw1 : mw0) >> (4 * hi);
                bf16x8 kf[8];
#pragma unroll
                for (int ks = 0; ks < 8; ++ks) kf[ks] = k_frag(kb, fo, half, ks);
                f32x16 p;
#pragma unroll
                for (int r = 0; r < 16; ++r) p[r] = nmref;
#pragma unroll
                for (int ks = 0; ks < 8; ++ks) p = __builtin_amdgcn_mfma_f32_32x32x16_bf16(kf[ks], qf[ks], p, 0, 0, 0);
#pragma unroll
                for (int r = 0; r < 16; ++r) { const unsigned keep = (unsigned)__builtin_amdgcn_sbfe((int)mwh, (r & 3) + 8 * (r >> 2), 1);
                    const float e = __uint_as_float(__float_as_uint(__builtin_amdgcn_exp2f(p[r])) & keep); p[r] = e; lsum += e; }
                const bf16x8 pa0 = pack8(p[0], p[1], p[2], p[3], p[4], p[5], p[6], p[7]), pa1 = pack8(p[8], p[9], p[10], p[11], p[12], p[13], p[14], p[15]);
                s16x4 vl[8], vh[8];
                const unsigned vbase = (unsigned)(size_t)vb + 8192u * (unsigned)half;
#pragma unroll
                for (int ct = 0; ct < 4; ++ct) { const unsigned a0 = vbase + (unsigned)fo.va[ct], a1 = a0 + (unsigned)fo.vd;
                    TR_READ(vl[2 * ct], a0, 0); TR_READ(vh[2 * ct], a1, 0); TR_READ(vl[2 * ct + 1], a0, 4096); TR_READ(vh[2 * ct + 1], a1, 4096); }
                LGKM_WAIT0();
#pragma unroll
                for (int ct = 0; ct < 4; ++ct) {
                    o[ct] = __builtin_amdgcn_mfma_f32_32x32x16_bf16(pa0, mk_frag(vl[2 * ct], vh[2 * ct]), o[ct], 0, 0, 0);
                    o[ct] = __builtin_amdgcn_mfma_f32_32x32x16_bf16(pa1, mk_frag(vl[2 * ct + 1], vh[2 * ct + 1]), o[ct], 0, 0, 0);
                }
            }
        }
        asm volatile("s_waitcnt vmcnt(0) lgkmcnt(0)" ::: "memory");
        __syncthreads();
    }
    lsum += __shfl_xor(lsum, 32);
    LAS float* lsc = (LAS float*)mst;
    if (hi == 0) lsc[r32] = 1.0f / lsum;
    asm volatile("s_waitcnt lgkmcnt(0)" ::: "memory");
    float rsc[16];
#pragma unroll
    for (int r = 0; r < 16; ++r) rsc[r] = lsc[crow(r, hi)];
    store_o(o, rsc, lds + w * 8192, F.CAT + (size_t)(b * SEQ + t0w) * D + h * 128, D, lane);
    __syncthreads();
}
__device__ __forceinline__ void ph_dsa(Frame& F) {
    float gm = fmaxf(fabsf(F.gq_a[F.lane]), fabsf(F.gq_a[64 + F.lane])), km = fmaxf(fabsf(F.gk_a[F.lane]), fabsf(F.gk_a[64 + F.lane]));
    gm = wave_max(gm); km = wave_max(km);
    const float mref = att::C2 * 128.0f * gm * km * 1.02f;
    for (int v = F.vcu; v < BATCH * 4 * 4; v += F.G) {
        const int bh = v >> 2, pi = v & 3;
#pragma unroll 1
        for (int k = 0; k < 2; ++k) dsa_unit(F, bh >> 2, bh & 3, k ? 7 - pi : pi, mref);
    }
}
namespace idx {
using att::f32x16;
constexpr int SCP = 2080;
__device__ __forceinline__ unsigned okey(float f) { const unsigned u = __float_as_uint(f); return (u & 0x80000000u) ? ~u : (u | 0x80000000u); }
__device__ __forceinline__ int wave_isum(int c) {
    c += __builtin_amdgcn_mov_dpp(c, 0xB1, 0xF, 0xF, true);
    c += __builtin_amdgcn_mov_dpp(c, 0x4E, 0xF, 0xF, true);
    c += __builtin_amdgcn_mov_dpp(c, 0x141, 0xF, 0xF, true);
    c += __builtin_amdgcn_mov_dpp(c, 0x140, 0xF, 0xF, true);
    return (__builtin_amdgcn_readlane(c, 0) + __builtin_amdgcn_readlane(c, 16)) + (__builtin_amdgcn_readlane(c, 32) + __builtin_amdgcn_readlane(c, 48));
}
__device__ __forceinline__ unsigned bfi32(unsigned m, unsigned x, unsigned y) { return (x & m) | (y & ~m); }
__device__ __forceinline__ void bit_transpose32x2(unsigned (&A)[32], unsigned (&B)[32]) {
#pragma unroll
    for (int k = 0; k < 16; ++k) { const unsigned a0 = A[k], a1 = A[k + 16], b0 = B[k], b1 = B[k + 16];
        A[k] = __builtin_amdgcn_perm(a0, a1, 0x07060302u); A[k + 16] = __builtin_amdgcn_perm(a0, a1, 0x05040100u);
        B[k] = __builtin_amdgcn_perm(b0, b1, 0x07060302u); B[k + 16] = __builtin_amdgcn_perm(b0, b1, 0x05040100u); }
#pragma unroll
    for (int k = 0; k < 32; ++k) if (!(k & 8)) { const unsigned a0 = A[k], a1 = A[k + 8], b0 = B[k], b1 = B[k + 8];
        A[k] = __builtin_amdgcn_perm(a0, a1, 0x07030501u); A[k + 8] = __builtin_amdgcn_perm(a0, a1, 0x06020400u);
        B[k] = __builtin_amdgcn_perm(b0, b1, 0x07030501u); B[k + 8] = __builtin_amdgcn_perm(b0, b1, 0x06020400u); }
    unsigned mask = 0x0F0F0F0Fu;
#pragma unroll
    for (int s = 4; s; s >>= 1) {
#pragma unroll
        for (int k = 0; k < 32; ++k) if (!(k & s)) { const unsigned a0 = A[k], a1 = A[k + s], b0 = B[k], b1 = B[k + s];
            A[k] = bfi32(mask, a1 >> s, a0); A[k + s] = bfi32(mask, a1, a0 << s);
            B[k] = bfi32(mask, b1 >> s, b0); B[k + s] = bfi32(mask, b1, b0 << s); }
        mask ^= mask << (s >> 1);
    }
}
__device__ __forceinline__ void select_prepare(const LAS float* scA, const LAS float* scB, int E, unsigned (&Wa)[32], unsigned (&Wb)[32], int lane) {
#pragma unroll
    for (int j = 0; j < 32; ++j) { Wa[31 - j] = __float_as_uint(scA[65 * j + lane]); Wb[31 - j] = __float_as_uint(scB[65 * j + lane]); }
#pragma unroll
    for (int j = 0; j < 32; ++j) { Wa[j] ^= (unsigned)((int)Wa[j] >> 31) | 0x80000000u; Wb[j] ^= (unsigned)((int)Wb[j] >> 31) | 0x80000000u; }
    bit_transpose32x2(Wa, Wb);
}
__device__ __forceinline__ void select_finish(const unsigned (&Wa)[32], const unsigned (&Wb)[32], int E, unsigned* mrowA, unsigned* mrowB, int lane) {
    const unsigned valid = (lane < 2 * E) ? 0xFFFFFFFFu : 0u;
    unsigned alA = valid, alB = valid, gtA = 0u, gtB = 0u;
    int GA = 0, GB = 0, AA = 64 * E, AB = 64 * E;
#pragma unroll
    for (int b0 = 0; b0 < 32; b0 += 4) {
        if (GA + AA == 256 && GB + AB == 256) break;
#pragma unroll
        for (int bb = 0; bb < 4; ++bb) { const int b = b0 + bb;
            const unsigned m1a = alA & Wa[b], m1b = alB & Wb[b];
            const int cab = wave_isum(__popc(m1a) | (__popc(m1b) << 16)), ca = cab & 0xFFFF, cb = cab >> 16;
            const bool ta = GA + ca >= 256, tb = GB + cb >= 256;
            alA = ta ? m1a : (alA ^ m1a); gtA = ta ? gtA : (gtA | m1a); AA = ta ? ca : AA - ca; GA = ta ? GA : GA + ca;
            alB = tb ? m1b : (alB ^ m1b); gtB = tb ? gtB : (gtB | m1b); AB = tb ? cb : AB - cb; GB = tb ? GB : GB + cb; }
    }
    const bool dA = (GA + AA == 256), dB = (GB + AB == 256);
#pragma unroll 1
    for (int rr = 0; rr < 2; ++rr) {
        const unsigned al = rr ? alB : alA, gt = rr ? gtB : gtA; const bool done = rr ? dB : dA; unsigned* mrow = rr ? mrowB : mrowA;
        unsigned sel = gt | al;
        if (!done) {
            const int need = 256 - (rr ? GB : GA), cnt = __popc(al);
            int incl = cnt;
            for (int off = 1; off < 64; off <<= 1) { const int up = __shfl_up(incl, off); if (lane >= off) incl += up; }
            int room = need - (incl - cnt);
            sel = gt;
            for (int j = 0; j < 32; ++j) if (((al >> j) & 1u) && room > 0) { sel |= 1u << j; --room; }
        }
        mrow[lane] = sel;
    }
}
__device__ __forceinline__ void decode(int u, int& b, int& c, int& sub) { c = 4 + u % 28; const int rest = u / 28; b = rest >> 2; sub = rest & 3; }
__device__ __forceinline__ void load_af(Frame& F, int u, bf16x8 (&af)[4][4]) {
    int b, c, sub; decode(u, b, c, sub);
    const int r32 = F.lane & 31, hi = F.lane >> 5, t0 = 64 * c + 16 * sub, g = r32 >> 3, hh = (r32 >> 2) & 1, j = r32 & 3, qo = 2 * hh + (g >> 1), hd = 4 * (g & 1) + j;
    const bf16* P = F.R1 + (size_t)b * SEQ * NAB;
#pragma unroll
    for (int rt = 0; rt < 4; ++rt)
#pragma unroll
        for (int ks = 0; ks < 4; ++ks) af[rt][ks] = *(const bf16x8*)(P + (size_t)(t0 + 4 * rt + qo) * NAB + C_IQ + hd * 64 + 16 * ks + 8 * hi);
}
__device__ __forceinline__ float load_w(Frame& F, int u) {
    int b, c, sub; decode(u, b, c, sub);
    const int t0 = 64 * c + 16 * sub;
    return (F.tid < 128) ? bf2f(F.R1[(size_t)(b * SEQ + t0 + (F.tid >> 3)) * NAB + C_IW + (F.tid & 7)]) * (0.125f * 0.35355339059327373f) : 0.f;
}
__device__ __forceinline__ void load_bf(Frame& F, int b, int strip, bf16x8 (&bfr)[4]) {
    const bf16* P = F.R1 + (size_t)b * SEQ * NAB;
#pragma unroll
    for (int ks = 0; ks < 4; ++ks) bfr[ks] = *(const bf16x8*)(P + (size_t)(32 * strip + (F.lane & 31)) * NAB + C_IK + 16 * ks + 8 * (F.lane >> 5));
}
__device__ __forceinline__ float relu1(float x) { const int i = __float_as_int(x); return __int_as_float(i > 0 ? i : 0); }
__device__ __forceinline__ void prelude(Frame& F) {
    const int gw = F.vcu * NWAVES + F.wave, NGW = F.G * NWAVES;
    for (int i = gw; i < BATCH * 256; i += NGW) { const int b = i >> 8, pos = i & 255, n = ((pos >> 6) + 1) << 6;
        if (F.lane < 32) { unsigned long long v = 0ull; if (64 * F.lane < n) v = ~0ull; *(unsigned long long*)(F.MASK + (size_t)(b * SEQ + pos) * 64 + 2 * F.lane) = v; } }
}
__device__ __forceinline__ void run(Frame& F) {
    const int lane = F.lane, w = F.wave, hi = lane >> 5, r32 = lane & 31, tid = F.tid, NU = BATCH * 28 * 4;
    int u = F.vcu; if (u >= NU) { prelude(F); return; }
    LAS float* sc = (LAS float*)F.lds;
    LAS float* wtb = sc + 16 * SCP;
    bf16x8 af[4][4], bfr[4], bnx[4];
    load_af(F, u, af);
    { const float wv = load_w(F, u); if (tid < 128) wtb[tid] = wv; }
    { int b, c, sub; decode(u, b, c, sub); if (w < 2 * (c + 1)) load_bf(F, b, w, bfr); }
    prelude(F);
    for (int it = 0; u < NU; ++it, u += F.G) {
        int b, c, sub; decode(u, b, c, sub);
        const int n = 64 * (c + 1), t0 = 64 * c + 16 * sub, nstrip = n >> 5;
        const int un = u + F.G; const bool more = un < NU;
        const LAS float* wt = wtb + (it & 1) * 128;
        __syncthreads();
        const float wnext = more ? load_w(F, un) : 0.f;
        for (int s = w; s < nstrip; s += NWAVES) {
            const bool mstrip = s + NWAVES < nstrip;
            if (mstrip) load_bf(F, b, s + NWAVES, bnx);
#pragma unroll
            for (int rt = 0; rt < 4; ++rt) {
                f32x16 acc;
#pragma unroll
                for (int r = 0; r < 16; ++r) acc[r] = 0.f;
#pragma unroll
                for (int ks = 0; ks < 4; ++ks) acc = __builtin_amdgcn_mfma_f32_32x32x16_bf16(af[rt][ks], bfr[ks], acc, 0, 0, 0);
                const int q0 = 4 * rt + 2 * hi;
                float f0, f1;
                { const f32x4 wa = *(const LAS f32x4*)(wt + q0 * 8), wb = *(const LAS f32x4*)(wt + q0 * 8 + 4), wc = *(const LAS f32x4*)(wt + q0 * 8 + 8), wd = *(const LAS f32x4*)(wt + q0 * 8 + 12);
                  f0 = relu1(acc[0]) * wa[0]; f1 = relu1(acc[8]) * wc[0];
#pragma unroll
                  for (int e = 1; e < 4; ++e) { f0 = fmaf(relu1(acc[e]), wa[e], f0); f1 = fmaf(relu1(acc[8 + e]), wc[e], f1); }
#pragma unroll
                  for (int e = 0; e < 4; ++e) { f0 = fmaf(relu1(acc[4 + e]), wb[e], f0); f1 = fmaf(relu1(acc[12 + e]), wd[e], f1); } }
                sc[q0 * SCP + 65 * r32 + s] = f0; sc[(q0 + 1) * SCP + 65 * r32 + s] = f1;
            }
            if (mstrip) {
#pragma unroll
                for (int ks = 0; ks < 4; ++ks) bfr[ks] = bnx[ks];
            }
        }
        if (more && tid < 128) wtb[((it + 1) & 1) * 128 + tid] = wnext;
        __syncthreads();
        { const int q = 2 * w;
          unsigned* mrowA = F.MASK + (size_t)(b * SEQ + t0 + q) * 64; unsigned* mrowB = mrowA + 64;
          const LAS float* rowA = sc + q * SCP; const LAS float* rowB = rowA + SCP;
          unsigned Wa[32], Wb[32];
          select_prepare(rowA, rowB, n >> 6, Wa, Wb, lane);
          asm volatile("" ::: "memory");
          if (more) load_af(F, un, af);
          select_finish(Wa, Wb, n >> 6, mrowA, mrowB, lane); }
        if (more) { int bn, cn, sn; decode(un, bn, cn, sn); if (w < 2 * (cn + 1)) load_bf(F, bn, w, bfr); }
    }
    __syncthreads();
}
}
__device__ __forceinline__ void ph_indexer(Frame& F) {
    idx::run(F);
}
namespace gla {
using att::f32x16; using att::u32x4;
constexpr int L_WL = 0, L_V = 4096  , L_OG = 36864  , L_K = 69632, L_Q = 78848, L_PART = 88064, L_STG = 89088, L_BG = 106496  ,
              L_GG = 106752  , L_KT = 107264  , L_S = 116480  , L_DEC = 134912  , KP = 144, SP = 272;
#define GLA_BAR() do { asm volatile("s_waitcnt lgkmcnt(0)" ::: "memory"); __builtin_amdgcn_s_barrier(); asm volatile("" ::: "memory"); } while (0)
struct In { u32x4 g0, g1, kk, qq; f32x4 b0, b1; u32x4 vt[2], ot[2]; };
template <bool PASSC> __device__ __forceinline__ void load_in(Frame& F, int b, int h, int c, In& in, const unsigned (&dvo)[2], const float* BC) {
    const bf16* P = F.R1 + (size_t)(b * SEQ + 64 * c) * NAB;
    const bf16* pr = P + (size_t)F.lane * NAB;
    in.kk = *(const u32x4*)(pr + C_KB + h * 64 + 8 * F.wave);
#pragma unroll
    for (int i = 0; i < 2; ++i) in.vt[i] = *(const u32x4*)((const char*)(P + C_VB + h * 128) + dvo[i]);
    if (!PASSC) { in.g0 = *(const u32x4*)(pr + C_GL); in.g1 = *(const u32x4*)(pr + C_GL + 8); }
    if (PASSC) { in.qq = *(const u32x4*)(pr + C_QB + h * 64 + 8 * F.wave);
        const float* bp = BC + ((size_t)(((4 * b + h) * 32 + c) * 64 + F.lane)) * 64 + 8 * F.wave; in.b0 = *(const f32x4*)bp; in.b1 = *(const f32x4*)(bp + 4);
#pragma unroll
        for (int i = 0; i < 2; ++i) in.ot[i] = *(const u32x4*)((const char*)(P + C_OG + h * 128) + dvo[i]); }
}
__device__ __forceinline__ void put_tile(LAS unsigned char* buf, const u32x4 (&t)[2], int wave, int lane) {
#pragma unroll
    for (int i = 0; i < 2; ++i) *(LAS u32x4*)(buf + 1024 * (2 * wave + i) + 16 * lane) = t[i];
}
__device__ __forceinline__ void stage_wl(Frame& F, int h) {
    LAS float* wl = (LAS float*)(F.lds + L_WL);
#pragma unroll
    for (int i = 0; i < 2; ++i) { const int e = F.tid + 512 * i, r = e >> 6, d = e & 63; wl[e] = F.w_gate_up[r * 256 + h * 64 + d]; }
    if (F.tid < 64) ((LAS float*)(F.lds + L_BG))[F.tid] = F.b_gate[h * 64 + F.tid];
}
__device__ __forceinline__ void unpack8(const u32x4 v, float (&f)[8]) {
#pragma unroll
    for (int i = 0; i < 4; ++i) { f[2 * i] = __uint_as_float(v[i] << 16); f[2 * i + 1] = __uint_as_float(v[i] & 0xffff0000u); }
}
#define GLA_DPP_F(v, ctrl, row_mask) __builtin_bit_cast(float, __builtin_amdgcn_update_dpp(0, __builtin_bit_cast(int, (v)), (ctrl), (row_mask), 0xF, false))
__device__ __forceinline__ float wave_scan_incl(float v) {
    v += GLA_DPP_F(v, 0x111, 0xF); v += GLA_DPP_F(v, 0x112, 0xF); v += GLA_DPP_F(v, 0x114, 0xF); v += GLA_DPP_F(v, 0x118, 0xF);
    v += GLA_DPP_F(v, 0x142, 0xA); v += GLA_DPP_F(v, 0x143, 0xC);
    return v;
}
__device__ __forceinline__ void gate_scan(Frame& F, int h, const float (&gl)[16], float (&bc)[8], float (&blast)[8]) {
    const int d0 = 8 * F.wave;
    const LAS float* wl = (const LAS float*)(F.lds + L_WL);
    float acc[8];
    { const f32x4 g0 = *(const LAS f32x4*)(F.lds + L_BG + d0 * 4), g1 = *(const LAS f32x4*)(F.lds + L_BG + d0 * 4 + 16);
#pragma unroll
      for (int i = 0; i < 4; ++i) { acc[i] = g0[i]; acc[4 + i] = g1[i]; } }
#pragma unroll
    for (int r = 0; r < 16; ++r) { const f32x4 w0 = *(const LAS f32x4*)(wl + r * 64 + d0), w1 = *(const LAS f32x4*)(wl + r * 64 + d0 + 4);
#pragma unroll
        for (int i = 0; i < 4; ++i) { acc[i] = fmaf(gl[r], w0[i], acc[i]); acc[4 + i] = fmaf(gl[r], w1[i], acc[4 + i]); } }
#pragma unroll
    for (int i = 0; i < 8; ++i) { float v = (fminf(acc[i], 0.f) - __logf(1.0f + __expf(-fabsf(acc[i])))) * (1.0f / 16.0f);
        v = wave_scan_incl(v);
        bc[i] = v; blast[i] = __builtin_bit_cast(float, __builtin_amdgcn_readlane(__builtin_bit_cast(int, v), 63)); }
}
__device__ __forceinline__ void put_kt_dec(LAS unsigned char* lds, int ktoff, int decoff, const float (&kf)[8], const float (&bc)[8], const float (&blast)[8], int w, int lane) {
#pragma unroll
    for (int i = 0; i < 8; ++i) *(LAS bf16*)(lds + ktoff + (8 * w + i) * KP + lane * 2) = (bf16)f2bf(kf[i] * __expf(blast[i] - bc[i]));
    if (lane == 0) { *(LAS f32x4*)(lds + decoff + 32 * w) = (f32x4){__expf(blast[0]), __expf(blast[1]), __expf(blast[2]), __expf(blast[3])};
                     *(LAS f32x4*)(lds + decoff + 32 * w + 16) = (f32x4){__expf(blast[4]), __expf(blast[5]), __expf(blast[6]), __expf(blast[7])}; }
}
__device__ __forceinline__ void state_step(f32x16& S, const LAS unsigned char* lds, const LAS unsigned char* vbuf, int ktoff, int decoff, int va_et, int vd, int dt, int hi, int r32) {
    f32x16 U;
#pragma unroll
    for (int r = 0; r < 16; ++r) U[r] = 0.f;
#pragma unroll
    for (int kk = 0; kk < 4; ++kk) {
        const LAS unsigned char* kp = lds + ktoff + (32 * dt + r32) * KP + (16 * kk + 4 * hi) * 2;
        const unsigned long long lo = *(const LAS unsigned long long*)kp, hh = *(const LAS unsigned long long*)(kp + 16);
        u32x4 bw; bw.x = (unsigned)lo; bw.y = (unsigned)(lo >> 32); bw.z = (unsigned)hh; bw.w = (unsigned)(hh >> 32);
        U = __builtin_amdgcn_mfma_f32_32x32x16_bf16(att::v_frag_rt(vbuf, va_et, vd, kk), __builtin_bit_cast(bf16x8, bw), U, 0, 0, 0);
    }
    const float dec = *(const LAS float*)(lds + decoff + (32 * dt + r32) * 4);
#pragma unroll
    for (int r = 0; r < 16; ++r) S[r] = fmaf(dec, S[r], U[r]);
}
__device__ __forceinline__ void pass_a(Frame& F, float* FS, float* DT, float* BC) {
    const int lane = F.lane, w = F.wave, hi = lane >> 5, r32 = lane & 31;
    att::FragOff fo; att::frag_off_init(fo, lane);
    unsigned dvo[2]; att::dma_off_init(dvo, NAB, w, lane);
    const int et = w >> 1, dt = w & 1, va_et = att::frag_va(lane, et);
    for (int sg = F.vcu; sg < 256; sg += F.G) {
        const int bh = sg >> 2, seg = sg & 3, b = bh >> 2, h = bh & 3;
        In ring[3];
        load_in<false>(F, b, h, 8 * seg, ring[0], dvo, BC); load_in<false>(F, b, h, 8 * seg + 1, ring[1], dvo, BC);
        stage_wl(F, h);
        GLA_BAR();
        f32x16 S;
#pragma unroll
        for (int r = 0; r < 16; ++r) S[r] = 0.f;
        float bsum[8];
#pragma unroll
        for (int i = 0; i < 8; ++i) bsum[i] = 0.f;
#pragma unroll
        for (int i = 0; i < 8; ++i) {
            In& cur = ring[i % 3];
            const int par = i & 1, ktoff = par ? L_KT : L_K, decoff = L_DEC + 256 * par;
            LAS unsigned char* vbuf = F.lds + L_V + par * 16384;
            put_tile(vbuf, cur.vt, w, lane);
            float gl[16], kf[8];
            unpack8(cur.g0, (float(&)[8])gl[0]); unpack8(cur.g1, (float(&)[8])gl[8]); unpack8(cur.kk, kf);
            if (i < 6) load_in<false>(F, b, h, 8 * seg + i + 2, ring[(i + 2) % 3], dvo, BC);
            float bc[8], blast[8];
            gate_scan(F, h, gl, bc, blast);
            { float* bp = BC + ((size_t)((bh * 32 + 8 * seg + i) * 64 + lane)) * 64 + 8 * w; *(f32x4*)bp = (f32x4){bc[0], bc[1], bc[2], bc[3]}; *(f32x4*)(bp + 4) = (f32x4){bc[4], bc[5], bc[6], bc[7]}; }
            put_kt_dec(F.lds, ktoff, decoff, kf, bc, blast, w, lane);
#pragma unroll
            for (int j = 0; j < 8; ++j) bsum[j] += blast[j];
            GLA_BAR();
            state_step(S, F.lds, vbuf, ktoff, decoff, va_et, fo.vd, dt, hi, r32);
        }
        float* fs = FS + (size_t)sg * 8192;
#pragma unroll
        for (int r = 0; r < 16; ++r) fs[(32 * et + att::crow(r, hi)) * 64 + 32 * dt + r32] = S[r];
        if (lane == 0) {
#pragma unroll
            for (int j = 0; j < 8; ++j) DT[(size_t)sg * 64 + 8 * w + j] = __expf(bsum[j]); }
        GLA_BAR();
    }
    __syncthreads();
}
__device__ __forceinline__ void pass_c(Frame& F, const float* FS, const float* DT, const float* BC) {
    const int lane = F.lane, w = F.wave, hi = lane >> 5, r32 = lane & 31, tid = F.tid;
    LAS unsigned char* lds = F.lds;
    att::FragOff fo; att::frag_off_init(fo, lane);
    unsigned dvo[2]; att::dma_off_init(dvo, NAB, w, lane);
    const int et = w >> 1, tt = w & 1, dt = tt, tl = 32 * tt + r32, va_et = att::frag_va(lane, et);
    if (tid < 128) ((LAS float*)(lds + L_GG))[tid] = F.g_gla[tid];
    LAS unsigned char* const vbuf = lds + L_V; LAS unsigned char* const ogbuf = lds + L_OG;
    for (int sg = F.vcu; sg < 256; sg += F.G) {
        const int bh = sg >> 2, seg = sg & 3, b = bh >> 2, h = bh & 3;
        In ring[3];
        load_in<true>(F, b, h, 8 * seg, ring[0], dvo, BC); load_in<true>(F, b, h, 8 * seg + 1, ring[1], dvo, BC);
        f32x16 S;
#pragma unroll
        for (int r = 0; r < 16; ++r) S[r] = 0.f;
        for (int j = 0; j < seg; ++j) {
            const int sj = 4 * bh + j; const float dj = DT[(size_t)sj * 64 + 32 * dt + r32]; const float* fs = FS + (size_t)sj * 8192;
#pragma unroll
            for (int r = 0; r < 16; ++r) S[r] = fmaf(dj, S[r], fs[(32 * et + att::crow(r, hi)) * 64 + 32 * dt + r32]);
        }
        GLA_BAR();
#pragma unroll
        for (int i = 0; i < 8; ++i) {
            const int c = 8 * seg + i;
            In& cur = ring[i % 3];
            put_tile(vbuf, cur.vt, w, lane); put_tile(ogbuf, cur.ot, w, lane);
            float kf[8], qf[8], bc[8], blast[8];
            unpack8(cur.kk, kf); unpack8(cur.qq, qf);
#pragma unroll
            for (int j = 0; j < 4; ++j) { bc[j] = cur.b0[j]; bc[4 + j] = cur.b1[j]; }
#pragma unroll
            for (int j = 0; j < 8; ++j) blast[j] = __builtin_bit_cast(float, __builtin_amdgcn_readlane(__builtin_bit_cast(int, bc[j]), 63));
            if (i < 6) load_in<true>(F, b, h, c + 2, ring[(i + 2) % 3], dvo, BC);
#pragma unroll
            for (int g = 0; g < 4; ++g)
                *(LAS unsigned long long*)(lds + L_S + att::img_off(32 * dt + r32, 4 * et + g) + 8 * hi) = (unsigned long long)pg8::cvt_pk_bf16(S[4 * g], S[4 * g + 1]) | ((unsigned long long)pg8::cvt_pk_bf16(S[4 * g + 2], S[4 * g + 3]) << 32);
            { float eq[8], ek[8];
#pragma unroll
              for (int j = 0; j < 8; ++j) { eq[j] = qf[j] * 0.125f * __expf(bc[j]); ek[j] = kf[j] * __expf(-bc[j]); }
              *(LAS bf16x8*)(lds + L_Q + lane * KP + 16 * w) = att::pack8(eq[0], eq[1], eq[2], eq[3], eq[4], eq[5], eq[6], eq[7]);
              *(LAS bf16x8*)(lds + L_K + lane * KP + 16 * w) = att::pack8(ek[0], ek[1], ek[2], ek[3], ek[4], ek[5], ek[6], ek[7]); }
            put_kt_dec(lds, L_KT, L_DEC, kf, bc, blast, w, lane);
            GLA_BAR();
            bf16x8 qfr[4];
#pragma unroll
            for (int ks = 0; ks < 4; ++ks) qfr[ks] = *(const LAS bf16x8*)(lds + L_Q + tl * KP + (16 * ks + 8 * hi) * 2);
            f32x16 p0, p1;
#pragma unroll
            for (int r = 0; r < 16; ++r) { p0[r] = 0.f; p1[r] = 0.f; }
#pragma unroll
            for (int ks = 0; ks < 4; ++ks) {
                const bf16x8 a0 = *(const LAS bf16x8*)(lds + L_K + r32 * KP + (16 * ks + 8 * hi) * 2), a1 = *(const LAS bf16x8*)(lds + L_K + (32 + r32) * KP + (16 * ks + 8 * hi) * 2);
                p0 = __builtin_amdgcn_mfma_f32_32x32x16_bf16(a0, qfr[ks], p0, 0, 0, 0); p1 = __builtin_amdgcn_mfma_f32_32x32x16_bf16(a1, qfr[ks], p1, 0, 0, 0);
            }
            { const int tl4 = tl - 4 * hi;
#pragma unroll
              for (int r = 0; r < 16; ++r) { const int sx = (r & 3) + 8 * (r >> 2); if (sx > tl4) p0[r] = 0.f; if (sx + 32 > tl4) p1[r] = 0.f; } }
            const bf16x8 pa0 = att::pack8(p0[0], p0[1], p0[2], p0[3], p0[4], p0[5], p0[6], p0[7]), pa1 = att::pack8(p0[8], p0[9], p0[10], p0[11], p0[12], p0[13], p0[14], p0[15]);
            const bf16x8 pa2 = att::pack8(p1[0], p1[1], p1[2], p1[3], p1[4], p1[5], p1[6], p1[7]), pa3 = att::pack8(p1[8], p1[9], p1[10], p1[11], p1[12], p1[13], p1[14], p1[15]);
            f32x16 acc;
#pragma unroll
            for (int r = 0; r < 16; ++r) acc[r] = 0.f;
            acc = __builtin_amdgcn_mfma_f32_32x32x16_bf16(att::v_frag_rt(vbuf, va_et, fo.vd, 0), pa0, acc, 0, 0, 0);
            acc = __builtin_amdgcn_mfma_f32_32x32x16_bf16(att::v_frag_rt(vbuf, va_et, fo.vd, 1), pa1, acc, 0, 0, 0);
            acc = __builtin_amdgcn_mfma_f32_32x32x16_bf16(att::v_frag_rt(vbuf, va_et, fo.vd, 2), pa2, acc, 0, 0, 0);
            acc = __builtin_amdgcn_mfma_f32_32x32x16_bf16(att::v_frag_rt(vbuf, va_et, fo.vd, 3), pa3, acc, 0, 0, 0);
#pragma unroll
            for (int ks = 0; ks < 4; ++ks) {
                const LAS unsigned char* qp = lds + L_Q + tl * KP + (16 * ks + 4 * hi) * 2;
                const unsigned long long lo = *(const LAS unsigned long long*)qp, hh = *(const LAS unsigned long long*)(qp + 16);
                u32x4 bw; bw.x = (unsigned)lo; bw.y = (unsigned)(lo >> 32); bw.z = (unsigned)hh; bw.w = (unsigned)(hh >> 32);
                acc = __builtin_amdgcn_mfma_f32_32x32x16_bf16(att::v_frag_rt(lds + L_S, va_et, fo.vd, ks), __builtin_bit_cast(bf16x8, bw), acc, 0, 0, 0); }
            state_step(S, lds, vbuf, L_KT, L_DEC, va_et, fo.vd, dt, hi, r32);
            float ss = 0.f;
#pragma unroll
            for (int r = 0; r < 16; ++r) ss = fmaf(acc[r], acc[r], ss);
            ss += __shfl_xor(ss, 32);
            LAS float* part = (LAS float*)(lds + L_PART);
            if (hi == 0) part[et * 64 + tl] = ss;
            GLA_BAR();
            const float rs = rsqrtf(((part[tl] + part[64 + tl]) + (part[128 + tl] + part[192 + tl])) * (1.0f / 128.0f) + EPS);
#pragma unroll
            for (int g = 0; g < 4; ++g) {
                const int e0 = 32 * et + 8 * g + 4 * hi;
                const unsigned long long ow = *(const LAS unsigned long long*)(ogbuf + att::img_off(tl, 4 * et + g) + 8 * hi);
                const f32x4 gg = *(const LAS f32x4*)(lds + L_GG + e0 * 4);
                float y[4];
#pragma unroll
                for (int j = 0; j < 4; ++j) { const float og = __uint_as_float(((unsigned)(ow >> (16 * j)) & 0xffffu) << 16); y[j] = acc[4 * g + j] * rs * gg[j] * (og * __builtin_amdgcn_rcpf(1.0f + __expf(-og))); }
                *(LAS unsigned long long*)(lds + L_STG + tl * SP + e0 * 2) = (unsigned long long)pg8::cvt_pk_bf16(y[0], y[1]) | ((unsigned long long)pg8::cvt_pk_bf16(y[2], y[3]) << 32);
            }
            GLA_BAR();
#pragma unroll
            for (int k2 = 0; k2 < 2; ++k2) { const int cidx = tid + 512 * k2, row = cidx >> 4, ch = cidx & 15;
                *(u32x4*)(F.CAT + (size_t)(b * SEQ + 64 * c + row) * D + 512 + h * 128 + ch * 8) = *(const LAS u32x4*)(lds + L_STG + row * SP + ch * 16); }
        }
    }
    __syncthreads();
}
}
__device__ __forceinline__ void ph_rope_tables(Frame& F, float* R128, float* R64) {
    for (int i = F.vcu * NTHR + F.tid; i < SEQ * 24; i += F.G * NTHR) {
        const int pos = i / 24, k = i % 24;
        if (k < 16) { const float inv = powf(500000.0f, -(float)k * 2.0f / 32.0f), ang = (float)pos * inv; R128[pos * 32 + k] = cosf(ang); R128[pos * 32 + 16 + k] = sinf(ang); }
        else { const int j = k - 16; const float inv = powf(500000.0f, -(float)j * 2.0f / 16.0f), ang = (float)pos * inv; R64[pos * 16 + j] = cosf(ang); R64[pos * 16 + 8 + j] = sinf(ang); }
    }
}
__device__ __forceinline__ float dpp_xor1(float v) { return __builtin_bit_cast(float, __builtin_amdgcn_mov_dpp(__builtin_bit_cast(int, v), 0xB1, 0xF, 0xF, true)); }
__device__ __forceinline__ float dpp_xor2(float v) { return __builtin_bit_cast(float, __builtin_amdgcn_mov_dpp(__builtin_bit_cast(int, v), 0x4E, 0xF, 0xF, true)); }
__device__ __forceinline__ void ph_prep_c_fast(Frame& F) {
    const int gw = F.vcu * NWAVES + F.wave, NGW = F.G * NWAVES, lane = F.lane;
    const float* gn = (lane < 32 ? F.gq_c : F.gk_c) + (lane & 3) * 32;
    const float sc = lane < 32 ? att::C2 : 1.0f;
    float g[32];
#pragma unroll
    for (int i = 0; i < 8; ++i) { const f32x4 v = *(const f32x4*)(gn + 4 * i); g[4 * i] = v[0] * sc; g[4 * i + 1] = v[1] * sc; g[4 * i + 2] = v[2] * sc; g[4 * i + 3] = v[3] * sc; }
    for (int tok = gw; tok < M; tok += NGW) {
        att::u32x4* p = (att::u32x4*)(F.R1 + (size_t)tok * NC + lane * 32);
        att::u32x4 v[4]; float f[32]; float ss = 0.f;
#pragma unroll
        for (int i = 0; i < 4; ++i) v[i] = p[i];
#pragma unroll
        for (int i = 0; i < 4; ++i)
#pragma unroll
            for (int j = 0; j < 4; ++j) { const float a = __uint_as_float(v[i][j] << 16), b = __uint_as_float(v[i][j] & 0xffff0000u); f[8 * i + 2 * j] = a; f[8 * i + 2 * j + 1] = b; ss = fmaf(a, a, fmaf(b, b, ss)); }
        ss += dpp_xor1(ss); ss += dpp_xor2(ss);
        const float rs = rsqrtf(ss * (1.f / 128.f) + EPS);
#pragma unroll
        for (int i = 0; i < 4; ++i) { att::u32x4 o;
#pragma unroll
            for (int j = 0; j < 4; ++j) o[j] = pg8::cvt_pk_bf16(f[8 * i + 2 * j] * rs * g[8 * i + 2 * j], f[8 * i + 2 * j + 1] * rs * g[8 * i + 2 * j + 1]);
            p[i] = o; }
    }
}
__device__ __forceinline__ void ph_prep_a_fast(Frame& F, const float* R128, const float* R64) {
    const int gw = F.vcu * NWAVES + F.wave, NGW = F.G * NWAVES, lane = F.lane, l8 = lane & 7;
    const float* gn = (lane < 32 ? F.gq_a : F.gk_a) + l8 * 16;
    const float sc = lane < 32 ? att::C2 : 1.0f;
    float g[16];
#pragma unroll
    for (int i = 0; i < 4; ++i) { const f32x4 v = *(const f32x4*)(gn + 4 * i); g[4 * i] = v[0] * sc; g[4 * i + 1] = v[1] * sc; g[4 * i + 2] = v[2] * sc; g[4 * i + 3] = v[3] * sc; }
    for (int tok = gw; tok < M; tok += NGW) {
        const int pos = tok & (SEQ - 1);
        bf16* pr = F.R1 + (size_t)tok * NAB;
        {   att::u32x4* p = (att::u32x4*)(pr + lane * 16);
            const att::u32x4 v0 = p[0], v1 = p[1]; float f[16]; float ss = 0.f;
#pragma unroll
            for (int j = 0; j < 4; ++j) { f[2 * j] = __uint_as_float(v0[j] << 16); f[2 * j + 1] = __uint_as_float(v0[j] & 0xffff0000u); f[8 + 2 * j] = __uint_as_float(v1[j] << 16); f[8 + 2 * j + 1] = __uint_as_float(v1[j] & 0xffff0000u); }
#pragma unroll
            for (int i = 0; i < 16; ++i) ss = fmaf(f[i], f[i], ss);
            ss += dpp_xor1(ss); ss += dpp_xor2(ss); ss += __shfl_xor(ss, 4);
            const float rs = rsqrtf(ss * (1.f / 128.f) + EPS);
#pragma unroll
            for (int i = 0; i < 16; ++i) f[i] = f[i] * rs * g[i];
            const float* cs = R128 + pos * 32;
#pragma unroll
            for (int i = 0; i < 16; ++i) { const float other = dpp_xor1(f[i]);
                if (l8 < 2) { const float c = cs[i], s = cs[16 + i]; f[i] = (l8 == 0) ? f[i] * c - other * s : f[i] * c + other * s; } }
            att::u32x4 o0, o1;
#pragma unroll
            for (int j = 0; j < 4; ++j) { o0[j] = pg8::cvt_pk_bf16(f[2 * j], f[2 * j + 1]); o1[j] = pg8::cvt_pk_bf16(f[8 + 2 * j], f[8 + 2 * j + 1]); }
            p[0] = o0; p[1] = o1;
        }
        {
#pragma unroll
            for (int part = 0; part < 2; ++part) {
                if (part == 1 && lane >= 8) break;
                att::u32x4* p = (att::u32x4*)(pr + (part == 0 ? C_IQ + lane * 8 : C_IK + lane * 8));
                const att::u32x4 v0 = p[0]; float f[8];
#pragma unroll
                for (int j = 0; j < 4; ++j) { f[2 * j] = __uint_as_float(v0[j] << 16); f[2 * j + 1] = __uint_as_float(v0[j] & 0xffff0000u); }
                const float* cs = R64 + pos * 16;
#pragma unroll
                for (int i = 0; i < 8; ++i) { const float other = dpp_xor1(f[i]);
                    if (l8 < 2) { const float c = cs[i], s = cs[8 + i]; f[i] = (l8 == 0) ? f[i] * c - other * s : f[i] * c + other * s; } }
                att::u32x4 o0;
#pragma unroll
                for (int j = 0; j < 4; ++j) o0[j] = pg8::cvt_pk_bf16(f[2 * j], f[2 * j + 1]);
                p[0] = o0;
            }
        }
    }
}
#ifndef MK_PER_PHASE
#define MK_PER_PHASE 0
#endif
constexpr int NPH = 14;
struct Args { const float* in[16]; float* out; unsigned char* ws; int ph_lo, ph_hi; };
__global__ void __launch_bounds__(NTHR, 2) mk_fwd(Args args) {
    extern __shared__ __attribute__((aligned(16))) unsigned char lds[];
    Frame F;
    F.lds = (LAS unsigned char*)lds;
    F.MISC = (volatile LAS unsigned*)(F.lds + MISC_OFF);
#ifdef PROBE_TOTAL
    const unsigned long long pt_start = __builtin_amdgcn_s_memrealtime();
#endif
    F.wave = __builtin_amdgcn_readfirstlane((int)threadIdx.x >> 6);
#define RELANE() (F.lane = lane_id_opaque(), F.tid = F.wave * 64 + F.lane, true)
    RELANE();
#ifdef PROBE_ACC
    F.acc_t0 = 0ull; F.acc_sum = 0ull;
#endif
    F.G = gridDim.x; { const int bx = blockIdx.x; F.vcu = (F.G % 8 == 0) ? (bx % 8) * (F.G / 8) + bx / 8 : bx; }
    unsigned char* ws = args.ws;
    F.ctl = (gu32*)(ws + WS_CTL);
    F.x = args.in[0]; F.g_mix = args.in[1]; F.g_ffn = args.in[2]; F.w_in_ab = args.in[3]; F.gq_a = args.in[4]; F.gk_a = args.in[5]; F.w_gate_up = args.in[6]; F.b_gate = args.in[7];
    F.g_gla = args.in[8]; F.w_out_ab = args.in[9]; F.w_in_c = args.in[10]; F.gq_c = args.in[11]; F.gk_c = args.in[12]; F.w_out_c = args.in[13]; F.w_up = args.in[14]; F.w_down = args.in[15];
    F.out = args.out;
    F.Wab = (bf16*)(ws + WS_WAB); F.Woab = (bf16*)(ws + WS_WOAB); F.Wup0 = (bf16*)(ws + WS_WUP0); F.Wdn0 = (bf16*)(ws + WS_WDN0);
    F.Winc = (bf16*)(ws + WS_WINC); F.Woc = (bf16*)(ws + WS_WOC); F.Wup1 = (bf16*)(ws + WS_WUP1); F.Wdn1 = (bf16*)(ws + WS_WDN1);
    F.XB = (bf16*)(ws + WS_XB); F.CAT = (bf16*)(ws + WS_CAT); F.R1 = (bf16*)(ws + WS_R1); F.SSQ = (float*)(ws + WS_SSQ); F.MASK = (unsigned*)(ws + WS_MASK);
    for (int u = F.tid; u < (LDS_BYTES - MISC_OFF) / 4; u += NTHR) ((LAS unsigned*)(F.lds + MISC_OFF))[u] = 0u;
    __syncthreads();
    XcdBarrier bar; bar.bar = (unsigned*)(F.ctl + CW_BAR); bar.x = 0; bar.st = nullptr; bar.wave = F.wave;
    if (!MK_PER_PHASE) bar = xcd_barrier_post((unsigned*)(F.ctl + CW_BAR), F.MISC + 8, F.wave);
    const int lo = args.ph_lo, hi = args.ph_hi;
#ifdef PROBE_PH
    unsigned long long pt0 = 0ull, pt1 = 0ull;
#define STAMP(k) do { if ((k) == PROBE_PH) pt0 = __builtin_amdgcn_s_memrealtime(); if ((k) == PROBE_PH + 1) pt1 = __builtin_amdgcn_s_memrealtime(); } while (0)
#ifdef PROBE_SUB
#define SUBSTAMP(k) do { if ((k) == PROBE_PH) { __syncthreads(); pt0 = __builtin_amdgcn_s_memrealtime(); } } while (0)
#else
#define SUBSTAMP(k) do { } while (0)
#endif
#else
#define STAMP(k) do { } while (0)
#define SUBSTAMP(k) do { } while (0)
#endif
#define IN(k) (lo <= (k) && (k) < hi && RELANE())
#ifdef PROBE_DBLBAR
#define SEAM(k) do { if (lo <= (k) && (k) + 1 < hi) { xcd_barrier(bar); xcd_barrier(bar); } } while (0)
#else
#define SEAM(k) do { if (lo <= (k) && (k) + 1 < hi) xcd_barrier(bar); } while (0)
#endif
    float* const SSQ0 = F.SSQ, *SSQ1 = F.SSQ + (size_t)M * 16, *SSQ2 = F.SSQ + (size_t)2 * M * 16, *SSQ3 = F.SSQ + (size_t)3 * M * 16;
#ifndef OUT_PF
#define OUT_PF true
#endif
#ifndef DN_PF
#define DN_PF false
#endif
    typedef pg8::StaticOrder SO;
#ifndef WGM_P1
#define WGM_P1 4
#endif
#ifndef WGM_OUT
#define WGM_OUT 4
#endif
#ifndef WGM_UP
#define WGM_UP 4
#endif
#ifndef WGM_DN
#define WGM_DN 4
#endif
#ifndef WGM_P8
#define WGM_P8 4
#endif
    STAMP(0); float* const R128 = (float*)(ws + WS_ROPE); float* const R64 = R128 + SEQ * 32;
    if (IN(0)) { ph_prologue(F); ph_rope_tables(F, R128, R64); } SEAM(0);
    STAMP(1); if (IN(1)) { pg8::Gemm g{F.XB, F.Wab, M, NAB, D}; SO S; S.init(M, NAB, F.G, (int)blockIdx.x, WGM_P1); pg8::EpiProjAB E{F.R1, NAB, SSQ0, F.gq_a, F.gk_a, R128, R64, (LAS float*)(F.lds + RING_BYTES), att::C2};
        pg8::gemm_phase<pg8::EpiProjAB, SO, true, true>(F.lds, g, S, E, F.wave);
        if (F.G == 256 && blockIdx.x >= 128) { RELANE(); prologue_weights<1>(F, ((int)blockIdx.x - 128) * NWAVES + F.wave, 128 * NWAVES); } } SEAM(1);
    float* const FS = (float*)(ws + WS_FS); float* const DT = (float*)(ws + WS_DEC);
    STAMP(2); if (IN(2)) { SUBSTAMP(2); gla::pass_a(F, FS, DT, (float*)(ws + WS_BC)); }
    STAMP(3); if (IN(3)) { SUBSTAMP(3); ph_indexer(F); } SEAM(3);
    STAMP(4); if (IN(4)) { ph_dsa(F); SUBSTAMP(4); gla::pass_c(F, FS, DT, (const float*)(ws + WS_BC)); } SEAM(4);
    STAMP(5); if (IN(5)) { pg8::Gemm g{F.CAT, F.Woab, M, D, D}; SO S; S.init(M, D, F.G, (int)blockIdx.x, WGM_OUT); pg8::EpiResid<1, 0, OUT_PF> E{F.XB, nullptr, F.XB, SSQ1, nullptr};
        pg8::gemm_phase<pg8::EpiResid<1, 0, OUT_PF>, SO, true, true>(F.lds, g, S, E, F.wave); } SEAM(5);
    STAMP(6); if (IN(6)) { pg8::Gemm g{F.XB, F.Wup0, M, FF, D}; SO S; S.init(M, FF, F.G, (int)blockIdx.x, WGM_UP); pg8::EpiScale<1> E{F.R1, FF, SSQ1};
        pg8::gemm_phase<pg8::EpiScale<1>, SO, true, true>(F.lds, g, S, E, F.wave); } SEAM(6);
    STAMP(7); if (IN(7)) { pg8::Gemm g{F.R1, F.Wdn0, M, D, FF}; SO S; S.init(M, D, F.G, (int)blockIdx.x, WGM_DN); pg8::EpiResid<1, 0, DN_PF> E{F.XB, nullptr, F.XB, SSQ2, SSQ1};
        pg8::gemm_phase<pg8::EpiResid<1, 0, DN_PF>, SO, true, true>(F.lds, g, S, E, F.wave); } SEAM(7);
    STAMP(8); if (IN(8)) { pg8::Gemm g{F.XB, F.Winc, M, NC, D}; SO S; S.init(M, NC, F.G, (int)blockIdx.x, WGM_P8); pg8::EpiQKNorm E{F.R1, NC, SSQ2, F.gq_c, F.gk_c, (LAS float*)(F.lds + RING_BYTES), att::C2};
        pg8::gemm_phase<pg8::EpiQKNorm, SO, true, true>(F.lds, g, S, E, F.wave); } SEAM(8);
    STAMP(9);
    STAMP(10); if (IN(10)) { ph_sb(F); } SEAM(10);
    STAMP(11); if (IN(11)) { pg8::Gemm g{F.CAT, F.Woc, M, D, D}; SO S; S.init(M, D, F.G, (int)blockIdx.x, WGM_OUT); pg8::EpiResid<1, 0, OUT_PF> E{F.XB, nullptr, F.XB, SSQ3, nullptr};
        pg8::gemm_phase<pg8::EpiResid<1, 0, OUT_PF>, SO, true, true>(F.lds, g, S, E, F.wave); } SEAM(11);
    STAMP(12); if (IN(12)) { pg8::Gemm g{F.XB, F.Wup1, M, FF, D}; SO S; S.init(M, FF, F.G, (int)blockIdx.x, WGM_UP); pg8::EpiScale<1> E{F.R1, FF, SSQ3};
        pg8::gemm_phase<pg8::EpiScale<1>, SO, true, true>(F.lds, g, S, E, F.wave); } SEAM(12);
    STAMP(13); if (IN(13)) { pg8::Gemm g{F.R1, F.Wdn1, M, D, FF}; SO S; S.init(M, D, F.G, (int)blockIdx.x, WGM_DN); pg8::EpiResid<1, 1, DN_PF> E{F.XB, F.out, nullptr, nullptr, SSQ3};
        pg8::gemm_phase<pg8::EpiResid<1, 1, DN_PF>, SO, true, true>(F.lds, g, S, E, F.wave); }
    STAMP(NPH);
#ifdef PROBE_TOTAL
    if (blockIdx.x == 0) { const unsigned long long t1 = __builtin_amdgcn_s_memrealtime(), dt = (t1 - pt_start); while (__builtin_amdgcn_s_memrealtime() - t1 < dt) __builtin_amdgcn_s_sleep(8); }
#endif
#ifdef PROBE_ACC
    if (blockIdx.x == 0) { const unsigned long long t1 = __builtin_amdgcn_s_memrealtime(), dt = F.acc_sum * PROBE_MULT; while (__builtin_amdgcn_s_memrealtime() - t1 < dt) __builtin_amdgcn_s_sleep(8); }
#endif
#ifdef PROBE_PH
    if (blockIdx.x == 0) { const unsigned long long t1 = __builtin_amdgcn_s_memrealtime(), dt = (pt1 - pt0) * PROBE_MULT; while (__builtin_amdgcn_s_memrealtime() - t1 < dt) __builtin_amdgcn_s_sleep(8); }
#endif
#undef IN
#undef SEAM
}

extern "C" void kernel_launch(void* const* d_in, const int* in_sizes, int n_in, void* d_out, int out_size, void* d_ws, size_t ws_size, hipStream_t stream) {
    static int grid = 0;
    if (grid == 0) {
        if (n_in != 16 || in_sizes[0] != M * D || out_size != M * D || ws_size < WS_END) { fprintf(stderr, "kernel_launch: unexpected shapes / workspace (%d inputs, ws %zu)\n", n_in, ws_size); grid = -1; return; }
        int dev = 0, cus = 0;
        if (hipGetDevice(&dev) != hipSuccess || hipDeviceGetAttribute(&cus, hipDeviceAttributeMultiprocessorCount, dev) != hipSuccess) { grid = -1; return; }
        if (hipFuncSetAttribute((const void*)mk_fwd, hipFuncAttributeMaxDynamicSharedMemorySize, LDS_BYTES) != hipSuccess) { fprintf(stderr, "kernel_launch: hipFuncSetAttribute failed\n"); grid = -1; return; }
        (void)hipGetLastError();
        grid = cus;
    }
    if (grid < 0) return;
    if (hipMemsetAsync((char*)d_ws + WS_CTL, 0, CTL_ZERO_BYTES, stream) != hipSuccess) { fprintf(stderr, "kernel_launch: memset failed\n"); return; }
    Args a{};
    for (int i = 0; i < 16; ++i) a.in[i] = (const float*)d_in[i];
    a.out = (float*)d_out; a.ws = (unsigned char*)d_ws;
#if MK_PER_PHASE
    for (int ph = 0; ph < NPH; ++ph) { a.ph_lo = ph; a.ph_hi = ph + 1; hipLaunchKernelGGL(mk_fwd, dim3(grid), dim3(NTHR), LDS_BYTES, stream, a); }
#else
    a.ph_lo = 0; a.ph_hi = NPH;
    hipLaunchKernelGGL(mk_fwd, dim3(grid), dim3(NTHR), LDS_BYTES, stream, a);
#endif
    const hipError_t le = hipPeekAtLastError();
    if (le != hipSuccess) fprintf(stderr, "kernel_launch: launch failed: %s\n", hipGetErrorName(le));
}
```
